# Optimizing an MI355X kernel written in HIP

```python
import jax, jax.numpy as jnp
from jax import lax
import numpy as np

D_MODEL = 1024
BATCH = 4
SEQ = 4096
DEPTH = 1

D_MIX = D_MODEL
GDN_HEADS = 4
GDN_DK = 128
GDN_DV = 128
MLSTM_HEADS = 4
MLSTM_DK = 128
MLSTM_DV = 128
N_DIR = 2
CONV_K = 5
CHUNK = 64
PEER_HEADS = 8
PEER_NKEYS = 128
PEER_N = PEER_NKEYS * PEER_NKEYS
PEER_DKEY = 256
PEER_TOPK = 16
PEER_BLOCK = 128
EPS = 1e-6

GDN_QK = GDN_HEADS * GDN_DK
GDN_V = GDN_HEADS * GDN_DV
ML_QK = MLSTM_HEADS * MLSTM_DK
ML_V = MLSTM_HEADS * MLSTM_DV
SPLIT_SIZES = (GDN_QK, GDN_QK, GDN_V, GDN_V, N_DIR * GDN_HEADS, N_DIR * GDN_HEADS,
               ML_QK, ML_QK, ML_V, ML_V, N_DIR * MLSTM_HEADS, N_DIR * MLSTM_HEADS)
D_IN = sum(SPLIT_SIZES)

kernel_name = "hybrid_gdn_mlstm_peer_block"


def _rmsnorm(x, g):
    x32 = x.astype(jnp.float32)
    y = x32 * lax.rsqrt(jnp.mean(x32 * x32, axis=-1, keepdims=True) + EPS)
    return (y * g.astype(jnp.float32)).astype(x.dtype)


def _l2norm(x):
    return x * lax.rsqrt(jnp.sum(x * x, axis=-1, keepdims=True) + EPS)


def _to_heads(x, n_heads):
    b, s, _ = x.shape
    return x.astype(jnp.float32).reshape(b, s, n_heads, -1).transpose(0, 2, 1, 3)


def _chunk(x):
    b, h, s = x.shape[:3]
    return x.reshape(b, h, s // CHUNK, CHUNK, *x.shape[3:])


def _flip(x):
    return jnp.flip(x, axis=2)


def _conv_centred(x, w):
    c = x.shape[-1]
    rhs = w.astype(jnp.float32).T[:, None, :]
    return lax.conv_general_dilated(x, rhs, window_strides=(1,),
                                    padding=[(CONV_K // 2, CONV_K // 2)],
                                    dimension_numbers=("NWC", "WIO", "NWC"),
                                    feature_group_count=c)


def _gated_delta_rule(q, k, v, g, beta):
    b_, h_, s_, dk = q.shape
    dv = v.shape[-1]
    q, k, v, g, beta = (_chunk(a) for a in (q, k, v, g, beta))
    g = jnp.cumsum(g, axis=-1)
    incl = jnp.tril(jnp.ones((CHUNK, CHUNK), dtype=bool))
    strict = jnp.tril(jnp.ones((CHUNK, CHUNK), dtype=bool), k=-1)
    decay = jnp.exp(jnp.where(incl, g[..., :, None] - g[..., None, :], -jnp.inf))
    k_beta = k * beta[..., None]
    a_mat = jnp.where(strict, jnp.einsum("bhncd,bhnsd->bhncs", k_beta, k) * decay, 0.0)
    eye = jnp.eye(CHUNK, dtype=q.dtype)
    t_mat = lax.linalg.triangular_solve(eye + a_mat, jnp.broadcast_to(eye, a_mat.shape),
                                        left_side=True, lower=True)
    u = jnp.einsum("bhncs,bhnse->bhnce", t_mat, v * beta[..., None])
    w = jnp.einsum("bhncs,bhnsd->bhncd", t_mat, k_beta * jnp.exp(g)[..., None])
    qk = jnp.where(incl, jnp.einsum("bhncd,bhnsd->bhncs", q, k) * decay, 0.0)
    q_dec = q * jnp.exp(g)[..., None]
    k_dec = k * jnp.exp(g[..., -1:] - g)[..., None]
    g_tot = jnp.exp(g[..., -1])

    def step(state, inp):
        u_c, w_c, qk_c, qd_c, kd_c, gt_c = inp
        v_new = u_c - jnp.einsum("bhcd,bhde->bhce", w_c, state)
        o_c = (jnp.einsum("bhcd,bhde->bhce", qd_c, state)
               + jnp.einsum("bhcs,bhse->bhce", qk_c, v_new))
        state = state * gt_c[..., None, None] + jnp.einsum("bhcd,bhce->bhde", kd_c, v_new)
        return state, o_c

    xs = tuple(jnp.moveaxis(a, 2, 0) for a in (u, w, qk, q_dec, k_dec, g_tot))
    _, o = lax.scan(step, jnp.zeros((b_, h_, dk, dv), q.dtype), xs)
    return jnp.moveaxis(o, 0, 2).reshape(b_, h_, s_, dv)


def _mlstm(q, k, v, i_pre, f_pre):
    b_, h_, s_, dk = q.shape
    dv = v.shape[-1]
    q, k, v, i_pre, f_pre = (_chunk(a) for a in (q, k, v, i_pre, f_pre))
    incl = jnp.tril(jnp.ones((CHUNK, CHUNK), dtype=bool))
    bcum = jnp.cumsum(jax.nn.log_sigmoid(f_pre), axis=-1)
    d_log = jnp.where(incl, bcum[..., :, None] - bcum[..., None, :] + i_pre[..., None, :], -jnp.inf)
    m_intra = jnp.max(d_log, axis=-1)
    p = jnp.exp(d_log - m_intra[..., None]) * jnp.einsum("bhncd,bhnsd->bhncs", q, k)
    num_intra = jnp.einsum("bhncs,bhnse->bhnce", p, v)
    den_intra = jnp.sum(p, axis=-1)
    b_last = bcum[..., -1]
    w_log = b_last[..., None] - bcum + i_pre
    m_w = jnp.max(w_log, axis=-1)
    wgt = jnp.exp(w_log - m_w[..., None])
    dc = jnp.einsum("bhnc,bhncd,bhnce->bhnde", wgt, k, v)
    dn = jnp.einsum("bhnc,bhncd->bhnd", wgt, k)

    def step(carry, inp):
        c_st, n_st, m_st = carry
        q_c, b_c, mi_c, num_c, den_c, bl_c, mw_c, dc_c, dn_c = inp
        inter_log = b_c + m_st[..., None]
        m_t = jnp.maximum(inter_log, mi_c)
        s_inter = jnp.exp(inter_log - m_t)
        s_intra = jnp.exp(mi_c - m_t)
        num = (s_inter[..., None] * jnp.einsum("bhcd,bhde->bhce", q_c, c_st)
               + s_intra[..., None] * num_c)
        den = s_inter * jnp.einsum("bhcd,bhd->bhc", q_c, n_st) + s_intra * den_c
        h = num / jnp.maximum(jnp.abs(den), jnp.exp(-m_t))[..., None]
        m_new = jnp.maximum(bl_c + m_st, mw_c)
        s_old = jnp.exp(bl_c + m_st - m_new)
        s_new = jnp.exp(mw_c - m_new)
        c_st = s_old[..., None, None] * c_st + s_new[..., None, None] * dc_c
        n_st = s_old[..., None] * n_st + s_new[..., None] * dn_c
        return (c_st, n_st, m_new), h

    xs = tuple(jnp.moveaxis(a, 2, 0) for a in
               (q, bcum, m_intra, num_intra, den_intra, b_last, m_w, dc, dn))
    init = (jnp.zeros((b_, h_, dk, dv), q.dtype), jnp.zeros((b_, h_, dk), q.dtype),
            jnp.zeros((b_, h_), q.dtype))
    _, h = lax.scan(step, init, xs)
    return jnp.moveaxis(h, 0, 2).reshape(b_, h_, s_, dv)


def _gdn_group(q, k, v, z, a, bb, conv_w, a_log, dt_bias, norm_g):
    bsz, s, _ = q.shape
    qkv = jax.nn.silu(_conv_centred(jnp.concatenate([q, k, v], axis=-1).astype(jnp.float32), conv_w))
    qh = _l2norm(_to_heads(qkv[..., :GDN_QK], GDN_HEADS)) * (GDN_DK ** -0.5)
    kh = _l2norm(_to_heads(qkv[..., GDN_QK:2 * GDN_QK], GDN_HEADS))
    vh = _to_heads(qkv[..., 2 * GDN_QK:], GDN_HEADS)
    a = a.astype(jnp.float32).reshape(bsz, s, N_DIR, GDN_HEADS)
    bb = bb.astype(jnp.float32).reshape(bsz, s, N_DIR, GDN_HEADS)
    g = -jnp.exp(a_log.astype(jnp.float32)) * jax.nn.softplus(a + dt_bias.astype(jnp.float32))
    beta = jax.nn.sigmoid(bb)
    g = g.transpose(2, 0, 3, 1)
    beta = beta.transpose(2, 0, 3, 1)
    o_f = _gated_delta_rule(qh, kh, vh, g[0], beta[0])
    o_b = _flip(_gated_delta_rule(_flip(qh), _flip(kh), _flip(vh), _flip(g[1]), _flip(beta[1])))
    o = (o_f + o_b).transpose(0, 2, 1, 3)
    o = o * lax.rsqrt(jnp.mean(o * o, axis=-1, keepdims=True) + EPS) * norm_g.astype(jnp.float32)
    return o.reshape(bsz, s, GDN_V) * jax.nn.silu(z.astype(jnp.float32))


def _mlstm_group(q, k, v, o_gate, i_in, f_in, i_bias, f_bias, norm_g):
    bsz, s, _ = q.shape
    qh = _to_heads(q, MLSTM_HEADS)
    kh = _to_heads(k, MLSTM_HEADS) * (MLSTM_DK ** -0.5)
    vh = _to_heads(v, MLSTM_HEADS)
    i_pre = (i_in.astype(jnp.float32).reshape(bsz, s, N_DIR, MLSTM_HEADS)
             + i_bias.astype(jnp.float32)).transpose(2, 0, 3, 1)
    f_pre = (f_in.astype(jnp.float32).reshape(bsz, s, N_DIR, MLSTM_HEADS)
             + f_bias.astype(jnp.float32)).transpose(2, 0, 3, 1)
    h_f = _mlstm(qh, kh, vh, i_pre[0], f_pre[0])
    h_b = _flip(_mlstm(_flip(qh), _flip(kh), _flip(vh), _flip(i_pre[1]), _flip(f_pre[1])))
    h = (h_f + h_b).transpose(0, 2, 1, 3)
    h = (h * lax.rsqrt(jnp.mean(h * h, axis=-1, keepdims=True) + EPS)).reshape(bsz, s, ML_V)
    return h * norm_g.astype(jnp.float32) * jax.nn.sigmoid(o_gate.astype(jnp.float32))


def _peer(h, w_q, sub_keys, u_tab, v_tab):
    bsz, s, d = h.shape
    t = h.reshape(-1, d)
    n_tok = t.shape[0]
    qry = (t @ w_q).astype(jnp.float32).reshape(n_tok, PEER_HEADS, 2, PEER_DKEY // 2)
    scores = jnp.einsum("thpd,hpkd->thpk", qry, sub_keys.astype(jnp.float32))
    s_top, i_top = lax.top_k(scores, PEER_TOPK)
    cand = (s_top[:, :, 0, :, None] + s_top[:, :, 1, None, :]).reshape(n_tok, PEER_HEADS, -1)
    cand_idx = (i_top[:, :, 0, :, None] * PEER_NKEYS + i_top[:, :, 1, None, :]).reshape(n_tok, PEER_HEADS, -1)
    best, pos = lax.top_k(cand, PEER_TOPK)
    idx = jnp.take_along_axis(cand_idx, pos, axis=-1)
    gate = jax.nn.softmax(best, axis=-1)
    nb = n_tok // PEER_BLOCK

    def block_fn(args):
        tb, ib, gb = args
        u = u_tab[ib]
        act = jax.nn.gelu(jnp.einsum("td,thkd->thk", tb, u).astype(jnp.float32), approximate=False)
        vv = v_tab[ib]
        return jnp.einsum("thk,thkd->td", (gb * act).astype(vv.dtype), vv)

    out = lax.map(block_fn, (t.reshape(nb, PEER_BLOCK, d),
                             idx.reshape(nb, PEER_BLOCK, PEER_HEADS, PEER_TOPK),
                             gate.reshape(nb, PEER_BLOCK, PEER_HEADS, PEER_TOPK)))
    return out.reshape(bsz, s, d).astype(h.dtype)


def setup_inputs(seed: int = 0) -> dict:
    key = jax.random.key(seed)
    ks = jax.random.split(key, 20)
    f32 = jnp.float32
    nrm = lambda k, shp, sc: jax.random.normal(k, shp, f32) * sc
    dt = jnp.exp(jax.random.uniform(ks[5], (DEPTH, N_DIR, GDN_HEADS), f32,
                                    np.log(1e-3).astype(np.float32), np.log(1e-1).astype(np.float32)))
    return {
        "x": nrm(ks[0], (BATCH, SEQ, D_MODEL), 1.0),
        "norm1_g": 1.0 + nrm(ks[1], (DEPTH, D_MODEL), 0.02),
        "w_in": nrm(ks[2], (DEPTH, D_MODEL, D_IN), D_MODEL ** -0.5),
        "conv_w": nrm(ks[3], (DEPTH, 2 * GDN_QK + GDN_V, CONV_K), CONV_K ** -0.5),
        "gdn_a_log": jnp.log(jax.random.uniform(ks[4], (DEPTH, N_DIR, GDN_HEADS), f32, 1.0, 16.0)),
        "gdn_dt_bias": jnp.log(jnp.expm1(dt)),
        "gdn_norm_g": 1.0 + nrm(ks[6], (DEPTH, GDN_DV), 0.02),
        "mlstm_i_bias": nrm(ks[7], (DEPTH, N_DIR, MLSTM_HEADS), 0.1),
        "mlstm_f_bias": jax.random.uniform(ks[8], (DEPTH, N_DIR, MLSTM_HEADS), f32, 3.0, 6.0),
        "mlstm_norm_g": 1.0 + nrm(ks[9], (DEPTH, ML_V), 0.02),
        "w_out": nrm(ks[10], (DEPTH, D_MIX, D_MODEL), D_MIX ** -0.5),
        "norm2_g": 1.0 + nrm(ks[11], (DEPTH, D_MODEL), 0.02),
        "peer_wq": nrm(ks[12], (DEPTH, D_MODEL, PEER_HEADS * PEER_DKEY), D_MODEL ** -0.5),
        "peer_keys": nrm(ks[13], (DEPTH, PEER_HEADS, 2, PEER_NKEYS, PEER_DKEY // 2), (PEER_DKEY // 2) ** -0.5),
        "peer_u": nrm(ks[14], (DEPTH, PEER_N, D_MODEL), D_MODEL ** -0.5),
        "peer_v": nrm(ks[15], (DEPTH, PEER_N, D_MODEL), PEER_HEADS ** -0.5),
        "normf_g": 1.0 + nrm(ks[16], (D_MODEL,), 0.02),
    }


def reference(x, norm1_g, w_in, conv_w, gdn_a_log, gdn_dt_bias, gdn_norm_g, mlstm_i_bias,
              mlstm_f_bias, mlstm_norm_g, w_out, norm2_g, peer_wq, peer_keys, peer_u, peer_v,
              normf_g):
    offsets = [int(o) for o in np.cumsum(SPLIT_SIZES)[:-1]]
    for l in range(DEPTH):
        h = _rmsnorm(x, norm1_g[l])
        p = h @ w_in[l]
        (gq, gk, gv, gz, ga, gb, mq, mk, mv, mo, mi, mf) = jnp.split(p, offsets, axis=-1)
        y_a = _gdn_group(gq, gk, gv, gz, ga, gb, conv_w[l], gdn_a_log[l], gdn_dt_bias[l], gdn_norm_g[l])
        y_b = _mlstm_group(mq, mk, mv, mo, mi, mf, mlstm_i_bias[l], mlstm_f_bias[l], mlstm_norm_g[l])
        y = jnp.concatenate([y_a, y_b], axis=-1).astype(x.dtype)
        x = x + y @ w_out[l]
        h2 = _rmsnorm(x, norm2_g[l])
        x = x + _peer(h2, peer_wq[l], peer_keys[l], peer_u[l], peer_v[l])
    return _rmsnorm(x, normf_g)
```

```cpp
#include <hip/hip_runtime.h>
#include <hip/hip_bf16.h>
#include <stdint.h>

typedef __hip_bfloat16 bf16;
typedef __attribute__((ext_vector_type(8))) short bf16x8;
typedef __attribute__((ext_vector_type(4))) float f32x4;

constexpr int DM = 1024;
constexpr int NB = 4;
constexpr int SEQ = 4096;
constexpr int NT = NB * SEQ;
constexpr int DIN = 4128;
constexpr int NPAD_IN = 4224;
constexpr float EPSF = 1e-6f;

__device__ __forceinline__ float bf2f(unsigned short u) { return __uint_as_float(((unsigned)u) << 16); }
__device__ __forceinline__ unsigned short f2bf(float f) {
  unsigned u = __float_as_uint(f);
  u += 0x7fffu + ((u >> 16) & 1u);
  return (unsigned short)(u >> 16);
}
__device__ __forceinline__ float wave_sum(float v) {
#pragma unroll
  for (int o = 32; o > 0; o >>= 1) v += __shfl_xor(v, o, 64);
  return v;
}
__device__ __forceinline__ float softplusf(float x) { return fmaxf(x, 0.f) + log1pf(expf(-fabsf(x))); }
__device__ __forceinline__ float sigmoidf(float x) { return 1.f / (1.f + expf(-x)); }

__global__ void __launch_bounds__(256) k_prep_x(const float* __restrict__ x, unsigned short* __restrict__ xb,
                                                float* __restrict__ rs) {
  int t = blockIdx.x * 4 + (threadIdx.x >> 6);
  int lane = threadIdx.x & 63;
  const float4* xr = (const float4*)(x + (size_t)t * DM);
  float ss = 0.f;
#pragma unroll
  for (int i = 0; i < 4; ++i) {
    float4 v = xr[lane + 64 * i];
    ss += v.x * v.x + v.y * v.y + v.z * v.z + v.w * v.w;
    ushort4 o;
    o.x = f2bf(v.x); o.y = f2bf(v.y); o.z = f2bf(v.z); o.w = f2bf(v.w);
    ((ushort4*)(xb + (size_t)t * DM))[lane + 64 * i] = o;
  }
  ss = wave_sum(ss);
  if (lane == 0) rs[t] = rsqrtf(ss * (1.f / DM) + EPSF);
}

__device__ __forceinline__ int win_src(int n) {
  if (n < 2048) return n;
  if (n < 4096) return n + 16;
  int j = n - 4096;
  if (j < 16) return 2048 + j;
  if (j < 32) return 4112 + (j - 16);
  return -1;
}
__global__ void __launch_bounds__(256) k_transpose_w(const float* __restrict__ in, int ldn, const float* __restrict__ g,
                                                     unsigned short* __restrict__ out, int nrows, int mode) {
  size_t id = (size_t)blockIdx.x * 256 + threadIdx.x;
  if (id >= (size_t)nrows * DM) return;
  int n = (int)(id >> 10);
  int k = (int)(id & 1023);
  int src = mode ? win_src(n) : n;
  float v = 0.f;
  if (src >= 0) v = in[(size_t)k * ldn + src] * (g ? g[k] : 1.f);
  out[id] = f2bf(v);
}
__global__ void __launch_bounds__(256) k_make_mt(const float* __restrict__ wq, const float* __restrict__ keys,
                                                 const float* __restrict__ g2, unsigned short* __restrict__ mt) {
  int n = blockIdx.x >> 2;
  int d = (blockIdx.x & 3) * 256 + threadIdx.x;
  int hp = n >> 7;
  const float4* kr = (const float4*)(keys + (size_t)n * 128);
  const float4* wr = (const float4*)(wq + (size_t)d * 2048 + hp * 128);
  float s = 0.f;
#pragma unroll 8
  for (int j = 0; j < 32; ++j) {
    float4 a = kr[j], b = wr[j];
    s += a.x * b.x + a.y * b.y + a.z * b.z + a.w * b.w;
  }
  mt[(size_t)n * DM + d] = f2bf(s * g2[d]);
}

constexpr int GBM = 128, GBN = 128, GBK = 64, GLD = 72;
struct GemmP {
  const unsigned short* A; const unsigned short* Bt; int lda, ldb, K;
  const float* rowscale;
  unsigned short* obf; int ldo;
  float* of32; int ldf;
  const float* resid;
};
enum { EPI_INPROJ = 0, EPI_OUTPROJ = 1, EPI_SCORES = 2 };

template <int EPI>
__device__ __forceinline__ void gemm_tile(const GemmP p, int tm, int tn, unsigned short* smem) {
  unsigned short* As = smem;
  unsigned short* Bs = smem + 2 * GBM * GLD;
  const int tid = threadIdx.x, lane = tid & 63, wid = tid >> 6;
  const int wm = wid >> 1, wn = wid & 1;
  const int m0 = tm * GBM, n0 = tn * GBN;
  f32x4 acc[4][4];
#pragma unroll
  for (int i = 0; i < 4; ++i)
#pragma unroll
    for (int j = 0; j < 4; ++j) acc[i][j] = (f32x4){0.f, 0.f, 0.f, 0.f};

  uint4 ra0, ra1, ra2, ra3, rb0, rb1, rb2, rb3;
  const int nk = p.K / GBK;
  const int lrow = tid >> 3, lc8 = tid & 7;
  const unsigned short* Ag = p.A + (size_t)(m0 + lrow) * p.lda + lc8 * 8;
  const unsigned short* Bg = p.Bt + (size_t)(n0 + lrow) * p.ldb + lc8 * 8;
  const size_t a32 = (size_t)32 * p.lda, b32 = (size_t)32 * p.ldb;
#define GLOAD(kt)                                                        \
  {                                                                      \
    ra0 = *(const uint4*)(Ag + (kt) * GBK);                              \
    ra1 = *(const uint4*)(Ag + a32 + (kt) * GBK);                        \
    ra2 = *(const uint4*)(Ag + 2 * a32 + (kt) * GBK);                    \
    ra3 = *(const uint4*)(Ag + 3 * a32 + (kt) * GBK);                    \
    rb0 = *(const uint4*)(Bg + (kt) * GBK);                              \
    rb1 = *(const uint4*)(Bg + b32 + (kt) * GBK);                        \
    rb2 = *(const uint4*)(Bg + 2 * b32 + (kt) * GBK);                    \
    rb3 = *(const uint4*)(Bg + 3 * b32 + (kt) * GBK);                    \
  }
#define SSTORE(buf)                                                      \
  {                                                                      \
    unsigned short* ad = As + (size_t)(buf) * GBM * GLD + lrow * GLD + lc8 * 8; \
    unsigned short* bd = Bs + (size_t)(buf) * GBN * GLD + lrow * GLD + lc8 * 8; \
    *(uint4*)(ad) = ra0; *(uint4*)(ad + 32 * GLD) = ra1; *(uint4*)(ad + 64 * GLD) = ra2; *(uint4*)(ad + 96 * GLD) = ra3; \
    *(uint4*)(bd) = rb0; *(uint4*)(bd + 32 * GLD) = rb1; *(uint4*)(bd + 64 * GLD) = rb2; *(uint4*)(bd + 96 * GLD) = rb3; \
  }
  GLOAD(0);
  SSTORE(0);
  __syncthreads();
  for (int kt = 0; kt < nk; ++kt) {
    const int buf = kt & 1;
    if (kt + 1 < nk) GLOAD(kt + 1);
    const unsigned short* Ab = As + (size_t)buf * GBM * GLD;
    const unsigned short* Bb = Bs + (size_t)buf * GBN * GLD;
#pragma unroll
    for (int ks = 0; ks < 2; ++ks) {
      bf16x8 a[4], b[4];
      const int kc = ks * 32 + (lane >> 4) * 8;
#pragma unroll
      for (int i = 0; i < 4; ++i) a[i] = *(const bf16x8*)(Ab + (wm * 64 + i * 16 + (lane & 15)) * GLD + kc);
#pragma unroll
      for (int j = 0; j < 4; ++j) b[j] = *(const bf16x8*)(Bb + (wn * 64 + j * 16 + (lane & 15)) * GLD + kc);
#pragma unroll
      for (int i = 0; i < 4; ++i)
#pragma unroll
        for (int j = 0; j < 4; ++j) acc[i][j] = __builtin_amdgcn_mfma_f32_16x16x32_bf16(a[i], b[j], acc[i][j], 0, 0, 0);
    }
    if (kt + 1 < nk) SSTORE(buf ^ 1);
    __syncthreads();
  }
#undef GLOAD
#undef SSTORE
#pragma unroll
  for (int i = 0; i < 4; ++i) {
#pragma unroll
    for (int r = 0; r < 4; ++r) {
      const int row = m0 + wm * 64 + i * 16 + (lane >> 4) * 4 + r;
      float rsc = 1.f;
      if (EPI == EPI_INPROJ || EPI == EPI_SCORES) rsc = p.rowscale[row];
#pragma unroll
      for (int j = 0; j < 4; ++j) {
        const int col = n0 + wn * 64 + j * 16 + (lane & 15);
        float v = acc[i][j][r] * rsc;
        if (EPI == EPI_INPROJ) {
          if (col < 4096) p.obf[(size_t)row * p.ldo + col] = f2bf(v);
          else if (col < 4128) p.of32[(size_t)row * p.ldf + (col - 4096)] = v;
        } else if (EPI == EPI_OUTPROJ) {
          p.of32[(size_t)row * p.ldf + col] = v + p.resid[(size_t)row * p.ldf + col];
        } else {
          p.obf[(size_t)row * p.ldo + col] = f2bf(v);
        }
      }
    }
  }
}

template <int EPI>
__global__ void __launch_bounds__(256) k_gemm(GemmP p, int ntm, int ntn) {
  __shared__ __attribute__((aligned(16))) unsigned short smem[4 * 128 * GLD];
  for (int tile = blockIdx.x; tile < ntm * ntn; tile += gridDim.x) {
    int tm = tile / ntn, tn = tile % ntn;
    gemm_tile<EPI>(p, tm, tn, smem);
    __syncthreads();
  }
}

__global__ void __launch_bounds__(256) k_conv(const unsigned short* __restrict__ pm, const float* __restrict__ pg,
                                              const float* __restrict__ conv_w, const float* __restrict__ a_log,
                                              const float* __restrict__ dt_bias, const float* __restrict__ i_bias,
                                              const float* __restrict__ f_bias, unsigned short* __restrict__ qkv,
                                              float* __restrict__ gt) {
  int t = blockIdx.x * 4 + (threadIdx.x >> 6);
  int lane = threadIdx.x & 63;
  int s = t & (SEQ - 1);
  for (int sec = 0; sec < 3; ++sec) {
    for (int h = 0; h < 4; ++h) {
      int c0 = sec * 512 + h * 128 + 2 * lane;
      float a0 = 0.f, a1 = 0.f;
#pragma unroll
      for (int j = 0; j < 5; ++j) {
        int sp = s + j - 2;
        if (sp >= 0 && sp < SEQ) {
          unsigned v = *(const unsigned*)(pm + (size_t)(t + j - 2) * 4096 + c0);
          a0 += conv_w[c0 * 5 + j] * bf2f((unsigned short)(v & 0xffff));
          a1 += conv_w[(c0 + 1) * 5 + j] * bf2f((unsigned short)(v >> 16));
        }
      }
      a0 = a0 * sigmoidf(a0);
      a1 = a1 * sigmoidf(a1);
      if (sec < 2) {
        float ss = wave_sum(a0 * a0 + a1 * a1);
        float sc = rsqrtf(ss + EPSF);
        if (sec == 0) sc *= 0.08838834764831845f;
        a0 *= sc; a1 *= sc;
      }
      unsigned o = (unsigned)f2bf(a0) | ((unsigned)f2bf(a1) << 16);
      *(unsigned*)(qkv + (size_t)t * 1536 + c0) = o;
    }
  }
  if (lane < 32) {
    float v = pg[(size_t)t * 32 + lane];
    int j = lane & 7;
    float o;
    if (lane < 8) o = -expf(a_log[j]) * softplusf(v + dt_bias[j]);
    else if (lane < 16) o = sigmoidf(v);
    else if (lane < 24) o = v + i_bias[j];
    else o = -softplusf(-(v + f_bias[j]));
    gt[(size_t)t * 32 + lane] = o;
  }
}

__global__ void __launch_bounds__(128) k_gdn_rec(const unsigned short* __restrict__ qkv, const float* __restrict__ gt,
                                                 unsigned short* __restrict__ oA) {
  __shared__ float sq[128], sk[128];
  const int bh = blockIdx.x >> 1, dir = blockIdx.x & 1;
  const int b = bh >> 2, h = bh & 3;
  const int e = threadIdx.x;
  float S[128];
#pragma unroll
  for (int d = 0; d < 128; ++d) S[d] = 0.f;
  for (int it = 0; it < SEQ; ++it) {
    const int s = dir ? (SEQ - 1 - it) : it;
    const size_t t = (size_t)b * SEQ + s;
    __syncthreads();
    sq[e] = bf2f(qkv[t * 1536 + h * 128 + e]);
    sk[e] = bf2f(qkv[t * 1536 + 512 + h * 128 + e]);
    const float v = bf2f(qkv[t * 1536 + 1024 + h * 128 + e]);
    const float g = gt[t * 32 + dir * 4 + h];
    const float beta = gt[t * 32 + 8 + dir * 4 + h];
    __syncthreads();
    const float a = expf(g);
    float k0 = 0.f, k1 = 0.f, k2 = 0.f, k3 = 0.f;
#pragma unroll
    for (int d = 0; d < 128; d += 4) {
      k0 += sk[d] * S[d]; k1 += sk[d + 1] * S[d + 1]; k2 += sk[d + 2] * S[d + 2]; k3 += sk[d + 3] * S[d + 3];
    }
    const float kS = a * ((k0 + k1) + (k2 + k3));
    const float vn = beta * (v - kS);
    float o0 = 0.f, o1 = 0.f, o2 = 0.f, o3 = 0.f;
#pragma unroll
    for (int d = 0; d < 128; d += 4) {
      S[d] = a * S[d] + sk[d] * vn;             o0 += sq[d] * S[d];
      S[d + 1] = a * S[d + 1] + sk[d + 1] * vn; o1 += sq[d + 1] * S[d + 1];
      S[d + 2] = a * S[d + 2] + sk[d + 2] * vn; o2 += sq[d + 2] * S[d + 2];
      S[d + 3] = a * S[d + 3] + sk[d + 3] * vn; o3 += sq[d + 3] * S[d + 3];
    }
    oA[((size_t)dir * NT + t) * 512 + h * 128 + e] = f2bf((o0 + o1) + (o2 + o3));
  }
}

__global__ void __launch_bounds__(128) k_mlstm_rec(const unsigned short* __restrict__ pm, const float* __restrict__ gt,
                                                   unsigned short* __restrict__ oM) {
  __shared__ float sq[128], sk[128];
  const int bh = blockIdx.x >> 1, dir = blockIdx.x & 1;
  const int b = bh >> 2, h = bh & 3;
  const int e = threadIdx.x, lane = e & 63;
  float C[128];
#pragma unroll
  for (int d = 0; d < 128; ++d) C[d] = 0.f;
  float n0 = 0.f, n1 = 0.f, m = 0.f;
  for (int it = 0; it < SEQ; ++it) {
    const int s = dir ? (SEQ - 1 - it) : it;
    const size_t t = (size_t)b * SEQ + s;
    __syncthreads();
    sq[e] = bf2f(pm[t * 4096 + 2048 + h * 128 + e]);
    sk[e] = bf2f(pm[t * 4096 + 2560 + h * 128 + e]) * 0.08838834764831845f;
    const float v = bf2f(pm[t * 4096 + 3072 + h * 128 + e]);
    const float ip = gt[t * 32 + 16 + dir * 4 + h];
    const float lf = gt[t * 32 + 24 + dir * 4 + h];
    __syncthreads();
    const float mn = fmaxf(lf + m, ip);
    const float fs = expf(lf + m - mn);
    const float is = expf(ip - mn);
    m = mn;
    n0 = fs * n0 + is * sk[lane];
    n1 = fs * n1 + is * sk[lane + 64];
    const float den = wave_sum(n0 * sq[lane] + n1 * sq[lane + 64]);
    const float iv = is * v;
    float o0 = 0.f, o1 = 0.f, o2 = 0.f, o3 = 0.f;
#pragma unroll
    for (int d = 0; d < 128; d += 4) {
      C[d] = fs * C[d] + sk[d] * iv;             o0 += sq[d] * C[d];
      C[d + 1] = fs * C[d + 1] + sk[d + 1] * iv; o1 += sq[d + 1] * C[d + 1];
      C[d + 2] = fs * C[d + 2] + sk[d + 2] * iv; o2 += sq[d + 2] * C[d + 2];
      C[d + 3] = fs * C[d + 3] + sk[d + 3] * iv; o3 += sq[d + 3] * C[d + 3];
    }
    const float num = (o0 + o1) + (o2 + o3);
    const float hh = num / fmaxf(fabsf(den), expf(-mn));
    oM[((size_t)dir * NT + t) * 512 + h * 128 + e] = f2bf(hh);
  }
}

__global__ void __launch_bounds__(256) k_combine(const unsigned short* __restrict__ oA, const unsigned short* __restrict__ oM,
                                                 const unsigned short* __restrict__ pm, const float* __restrict__ gdn_g,
                                                 const float* __restrict__ ml_g, unsigned short* __restrict__ y) {
  int t = blockIdx.x * 4 + (threadIdx.x >> 6);
  int lane = threadIdx.x & 63;
  for (int h = 0; h < 4; ++h) {
    int c = h * 128 + 2 * lane;
    {
      unsigned vf = *(const unsigned*)(oA + (size_t)t * 512 + c);
      unsigned vb = *(const unsigned*)(oA + ((size_t)NT + t) * 512 + c);
      float o0 = bf2f(vf & 0xffff) + bf2f(vb & 0xffff);
      float o1 = bf2f(vf >> 16) + bf2f(vb >> 16);
      float ss = wave_sum(o0 * o0 + o1 * o1);
      float sc = rsqrtf(ss * (1.f / 128.f) + EPSF);
      unsigned z = *(const unsigned*)(pm + (size_t)t * 4096 + 1536 + c);
      float z0 = bf2f(z & 0xffff), z1 = bf2f(z >> 16);
      o0 = o0 * sc * gdn_g[2 * lane] * (z0 * sigmoidf(z0));
      o1 = o1 * sc * gdn_g[2 * lane + 1] * (z1 * sigmoidf(z1));
      *(unsigned*)(y + (size_t)t * DM + c) = (unsigned)f2bf(o0) | ((unsigned)f2bf(o1) << 16);
    }
    {
      unsigned vf = *(const unsigned*)(oM + (size_t)t * 512 + c);
      unsigned vb = *(const unsigned*)(oM + ((size_t)NT + t) * 512 + c);
      float o0 = bf2f(vf & 0xffff) + bf2f(vb & 0xffff);
      float o1 = bf2f(vf >> 16) + bf2f(vb >> 16);
      float ss = wave_sum(o0 * o0 + o1 * o1);
      float sc = rsqrtf(ss * (1.f / 128.f) + EPSF);
      unsigned z = *(const unsigned*)(pm + (size_t)t * 4096 + 3584 + c);
      float z0 = bf2f(z & 0xffff), z1 = bf2f(z >> 16);
      o0 = o0 * sc * ml_g[c] * sigmoidf(z0);
      o1 = o1 * sc * ml_g[c + 1] * sigmoidf(z1);
      *(unsigned*)(y + (size_t)t * DM + 512 + c) = (unsigned)f2bf(o0) | ((unsigned)f2bf(o1) << 16);
    }
  }
}

__global__ void __launch_bounds__(256) k_prep_x1(const float* __restrict__ x1, unsigned short* __restrict__ xb,
                                                 float* __restrict__ rs) {
  int t = blockIdx.x * 4 + (threadIdx.x >> 6);
  int lane = threadIdx.x & 63;
  const float4* xr = (const float4*)(x1 + (size_t)t * DM);
  float ss = 0.f;
#pragma unroll
  for (int i = 0; i < 4; ++i) {
    float4 v = xr[lane + 64 * i];
    ss += v.x * v.x + v.y * v.y + v.z * v.z + v.w * v.w;
    ushort4 o;
    o.x = f2bf(v.x); o.y = f2bf(v.y); o.z = f2bf(v.z); o.w = f2bf(v.w);
    ((ushort4*)(xb + (size_t)t * DM))[lane + 64 * i] = o;
  }
  ss = wave_sum(ss);
  if (lane == 0) rs[t] = rsqrtf(ss * (1.f / DM) + EPSF);
}

__device__ const unsigned char kPairTab[64] = {
    0x00, 0x01, 0x02, 0x03, 0x04, 0x05, 0x06, 0x07, 0x08, 0x09, 0x0a, 0x0b, 0x0c, 0x0d, 0x0e, 0x0f,
    0x10, 0x11, 0x12, 0x13, 0x14, 0x15, 0x16, 0x17,
    0x20, 0x21, 0x22, 0x23, 0x24,
    0x30, 0x31, 0x32, 0x33,
    0x40, 0x41, 0x42,
    0x50, 0x51, 0x60, 0x61, 0x70, 0x71,
    0x80, 0x90, 0xa0, 0xb0, 0xc0, 0xd0, 0xe0, 0xf0,
    0xff, 0xff, 0xff, 0xff, 0xff, 0xff, 0xff, 0xff, 0xff, 0xff, 0xff, 0xff, 0xff, 0xff};

__device__ __forceinline__ void wave_top16(float va, int ia, float vb, int ib, int lane, float& outv, int& outi) {
  outv = -INFINITY; outi = 0;
  for (int r = 0; r < 16; ++r) {
    float bv; int bi;
    if (va >= vb) { bv = va; bi = ia; } else { bv = vb; bi = ib; }
#pragma unroll
    for (int o = 32; o > 0; o >>= 1) {
      float ov = __shfl_xor(bv, o, 64);
      int oi = __shfl_xor(bi, o, 64);
      if (ov > bv || (ov == bv && oi < bi)) { bv = ov; bi = oi; }
    }
    if (lane == r) { outv = bv; outi = bi; }
    if (bi == ia) va = -INFINITY;
    if (bi == ib) vb = -INFINITY;
  }
}

__global__ void __launch_bounds__(256) k_topk(const unsigned short* __restrict__ scores, int* __restrict__ idx_out,
                                              float* __restrict__ gate_out) {
  const int w = blockIdx.x * 4 + (threadIdx.x >> 6);
  const int lane = threadIdx.x & 63;
  const int t = w >> 3, h = w & 7;
  const unsigned short* sp = scores + (size_t)t * 2048 + h * 256;
  float s0v, s1v; int i0v, i1v;
  wave_top16(bf2f(sp[lane]), lane, bf2f(sp[lane + 64]), lane + 64, lane, s0v, i0v);
  wave_top16(bf2f(sp[128 + lane]), lane, bf2f(sp[128 + lane + 64]), lane + 64, lane, s1v, i1v);
  const int pr = kPairTab[lane];
  const int pi = (pr >> 4) & 15, pj = pr & 15;
  float c0 = __shfl(s0v, pi, 64) + __shfl(s1v, pj, 64);
  int ci = __shfl(i0v, pi, 64) * 128 + __shfl(i1v, pj, 64);
  if (pr == 0xff) { c0 = -INFINITY; ci = 0x7fffffff; }
  float bestv; int besti;
  wave_top16(c0, ci, -INFINITY, -1, lane, bestv, besti);
  float mx = __shfl(bestv, 0, 64);
  float ev = (lane < 16) ? expf(bestv - mx) : 0.f;
  float sum = wave_sum(ev);
  if (lane < 16) {
    idx_out[(size_t)t * 128 + h * 16 + lane] = besti;
    gate_out[(size_t)t * 128 + h * 16 + lane] = ev / sum;
  }
}

__global__ void __launch_bounds__(256) k_peer(const float* __restrict__ x1, const float* __restrict__ rs2,
                                              const float* __restrict__ g2, const int* __restrict__ idx,
                                              const float* __restrict__ gate, const float* __restrict__ pu,
                                              const float* __restrict__ pv, const float* __restrict__ gf,
                                              float* __restrict__ out) {
  const int t = blockIdx.x * 4 + (threadIdx.x >> 6);
  const int lane = threadIdx.x & 63;
  const float r2 = rs2[t];
  float4 xv[4], hv[4], acc[4];
#pragma unroll
  for (int i = 0; i < 4; ++i) {
    xv[i] = ((const float4*)(x1 + (size_t)t * DM))[lane + 64 * i];
    float4 g = ((const float4*)g2)[lane + 64 * i];
    hv[i].x = xv[i].x * r2 * g.x; hv[i].y = xv[i].y * r2 * g.y; hv[i].z = xv[i].z * r2 * g.z; hv[i].w = xv[i].w * r2 * g.w;
    acc[i] = make_float4(0.f, 0.f, 0.f, 0.f);
  }
  for (int e = 0; e < 128; ++e) {
    const int id = idx[(size_t)t * 128 + e];
    const float gt = gate[(size_t)t * 128 + e];
    const float4* ur = (const float4*)(pu + (size_t)id * DM);
    const float4* vr = (const float4*)(pv + (size_t)id * DM);
    float4 vv[4];
    float d = 0.f;
#pragma unroll
    for (int i = 0; i < 4; ++i) {
      float4 u = ur[lane + 64 * i];
      vv[i] = vr[lane + 64 * i];
      d += u.x * hv[i].x + u.y * hv[i].y + u.z * hv[i].z + u.w * hv[i].w;
    }
    d = wave_sum(d);
    const float act = 0.5f * d * (1.f + erff(d * 0.7071067811865476f));
    const float wgt = gt * act;
#pragma unroll
    for (int i = 0; i < 4; ++i) {
      acc[i].x += wgt * vv[i].x; acc[i].y += wgt * vv[i].y; acc[i].z += wgt * vv[i].z; acc[i].w += wgt * vv[i].w;
    }
  }
  float ss = 0.f;
#pragma unroll
  for (int i = 0; i < 4; ++i) {
    acc[i].x += xv[i].x; acc[i].y += xv[i].y; acc[i].z += xv[i].z; acc[i].w += xv[i].w;
    ss += acc[i].x * acc[i].x + acc[i].y * acc[i].y + acc[i].z * acc[i].z + acc[i].w * acc[i].w;
  }
  ss = wave_sum(ss);
  const float sc = rsqrtf(ss * (1.f / DM) + EPSF);
#pragma unroll
  for (int i = 0; i < 4; ++i) {
    float4 g = ((const float4*)gf)[lane + 64 * i];
    float4 o;
    o.x = acc[i].x * sc * g.x; o.y = acc[i].y * sc * g.y; o.z = acc[i].z * sc * g.z; o.w = acc[i].w * sc * g.w;
    ((float4*)(out + (size_t)t * DM))[lane + 64 * i] = o;
  }
}

extern "C" void kernel_launch(void* const* d_in, const int* in_sizes, int n_in, void* d_out, int out_size, void* d_ws,
                              size_t ws_size, hipStream_t stream) {
  const float* x = (const float*)d_in[0];
  const float* norm1_g = (const float*)d_in[1];
  const float* w_in = (const float*)d_in[2];
  const float* conv_w = (const float*)d_in[3];
  const float* a_log = (const float*)d_in[4];
  const float* dt_bias = (const float*)d_in[5];
  const float* gdn_g = (const float*)d_in[6];
  const float* i_bias = (const float*)d_in[7];
  const float* f_bias = (const float*)d_in[8];
  const float* ml_g = (const float*)d_in[9];
  const float* w_out = (const float*)d_in[10];
  const float* norm2_g = (const float*)d_in[11];
  const float* peer_wq = (const float*)d_in[12];
  const float* peer_keys = (const float*)d_in[13];
  const float* peer_u = (const float*)d_in[14];
  const float* peer_v = (const float*)d_in[15];
  const float* normf_g = (const float*)d_in[16];
  float* out = (float*)d_out;

  char* ws = (char*)d_ws;
  const size_t MB = 1024 * 1024;
  unsigned short* pm = (unsigned short*)(ws);
  float* x1 = (float*)(ws);
  unsigned short* x1b = (unsigned short*)(ws + 64 * MB);
  char* rb = ws + 128 * MB;
  unsigned short* woutT = (unsigned short*)(rb);
  unsigned short* mt = (unsigned short*)(rb + 2 * MB);
  float* rs1 = (float*)(rb + 6 * MB);
  float* rs2 = (float*)(rb + 6 * MB + 65536);
  float* pg = (float*)(rb + 7 * MB);
  float* gt = (float*)(rb + 9 * MB);
  char* dyn = rb + 11 * MB;
  unsigned short* xb = (unsigned short*)(dyn);
  unsigned short* winT = (unsigned short*)(dyn + 32 * MB);
  unsigned short* qkv = (unsigned short*)(dyn);
  unsigned short* oA = (unsigned short*)(dyn + 48 * MB);
  unsigned short* oM = (unsigned short*)(dyn + 80 * MB);
  unsigned short* yb = (unsigned short*)(dyn);
  unsigned short* scores = (unsigned short*)(dyn);
  int* idxb = (int*)(dyn + 64 * MB);
  float* gateb = (float*)(dyn + 72 * MB);

  k_prep_x<<<NT / 4, 256, 0, stream>>>(x, xb, rs1);
  k_transpose_w<<<(NPAD_IN * DM) / 256, 256, 0, stream>>>(w_in, DIN, norm1_g, winT, NPAD_IN, 1);
  k_transpose_w<<<(1024 * DM) / 256, 256, 0, stream>>>(w_out, 1024, nullptr, woutT, 1024, 0);
  k_make_mt<<<2048 * 4, 256, 0, stream>>>(peer_wq, peer_keys, norm2_g, mt);
  {
    GemmP p{};
    p.A = xb; p.lda = DM; p.Bt = winT; p.ldb = DM; p.K = DM;
    p.rowscale = rs1; p.obf = pm; p.ldo = 4096; p.of32 = pg; p.ldf = 32; p.resid = nullptr;
    k_gemm<EPI_INPROJ><<<(NT / 128) * 33, 256, 0, stream>>>(p, NT / 128, 33);
  }
  k_conv<<<NT / 4, 256, 0, stream>>>(pm, pg, conv_w, a_log, dt_bias, i_bias, f_bias, qkv, gt);
  k_gdn_rec<<<32, 128, 0, stream>>>(qkv, gt, oA);
  k_mlstm_rec<<<32, 128, 0, stream>>>(pm, gt, oM);
  k_combine<<<NT / 4, 256, 0, stream>>>(oA, oM, pm, gdn_g, ml_g, yb);
  {
    GemmP p{};
    p.A = yb; p.lda = DM; p.Bt = woutT; p.ldb = DM; p.K = DM;
    p.rowscale = nullptr; p.obf = nullptr; p.ldo = 0; p.of32 = x1; p.ldf = DM; p.resid = x;
    k_gemm<EPI_OUTPROJ><<<(NT / 128) * 8, 256, 0, stream>>>(p, NT / 128, 8);
  }
  k_prep_x1<<<NT / 4, 256, 0, stream>>>(x1, x1b, rs2);
  {
    GemmP p{};
    p.A = x1b; p.lda = DM; p.Bt = mt; p.ldb = DM; p.K = DM;
    p.rowscale = rs2; p.obf = scores; p.ldo = 2048; p.of32 = nullptr; p.ldf = 0; p.resid = nullptr;
    k_gemm<EPI_SCORES><<<(NT / 128) * 16, 256, 0, stream>>>(p, NT / 128, 16);
  }
  k_topk<<<NT * 8 / 4, 256, 0, stream>>>(scores, idxb, gateb);
  k_peer<<<NT / 4, 256, 0, stream>>>(x1, rs2, norm2_g, idxb, gateb, peer_u, peer_v, normf_g, out);
}
```

```cpp
#include <hip/hip_runtime.h>
#include <hip/hip_bf16.h>
#include <stdint.h>
#include <hip/hip_cooperative_groups.h>
#include <cstdio>
namespace cg = cooperative_groups;

typedef __hip_bfloat16 bf16;
typedef __attribute__((ext_vector_type(8))) short bf16x8;
typedef __attribute__((ext_vector_type(4))) float f32x4;

constexpr int DM = 1024;
constexpr int NB = 4;
constexpr int SEQ = 4096;
constexpr int NT = NB * SEQ;
constexpr int DIN = 4128;
constexpr int NPAD_IN = 4224;
constexpr float EPSF = 1e-6f;

__device__ __forceinline__ float bf2f(unsigned short u) { return __uint_as_float(((unsigned)u) << 16); }
__device__ __forceinline__ unsigned short f2bf(float f) {
  unsigned u = __float_as_uint(f);
  u += 0x7fffu + ((u >> 16) & 1u);
  return (unsigned short)(u >> 16);
}
__device__ __forceinline__ float wave_sum(float v) {
#pragma unroll
  for (int o = 32; o > 0; o >>= 1) v += __shfl_xor(v, o, 64);
  return v;
}
__device__ __forceinline__ float softplusf(float x) { return fmaxf(x, 0.f) + log1pf(expf(-fabsf(x))); }
__device__ __forceinline__ float sigmoidf(float x) { return 1.f / (1.f + expf(-x)); }

__device__ __forceinline__ void d_prep_x(int item, const float* __restrict__ x, unsigned short* __restrict__ xb,
                                                float* __restrict__ rs) {
  int t = item * 4 + (threadIdx.x >> 6);
  int lane = threadIdx.x & 63;
  const float4* xr = (const float4*)(x + (size_t)t * DM);
  float ss = 0.f;
#pragma unroll
  for (int i = 0; i < 4; ++i) {
    float4 v = xr[lane + 64 * i];
    ss += v.x * v.x + v.y * v.y + v.z * v.z + v.w * v.w;
    ushort4 o;
    o.x = f2bf(v.x); o.y = f2bf(v.y); o.z = f2bf(v.z); o.w = f2bf(v.w);
    ((ushort4*)(xb + (size_t)t * DM))[lane + 64 * i] = o;
  }
  ss = wave_sum(ss);
  if (lane == 0) rs[t] = rsqrtf(ss * (1.f / DM) + EPSF);
}

__device__ __forceinline__ int win_src(int n) {
  if (n < 2048) return n;
  if (n < 4096) return n + 16;
  int j = n - 4096;
  if (j < 16) return 2048 + j;
  if (j < 32) return 4112 + (j - 16);
  return -1;
}
__device__ __forceinline__ void d_transpose_w(int item, const float* __restrict__ in, int ldn, const float* __restrict__ g,
                                                     unsigned short* __restrict__ out, int nrows, int mode) {
  size_t id = (size_t)item * 256 + threadIdx.x;
  if (id >= (size_t)nrows * DM) return;
  int n = (int)(id >> 10);
  int k = (int)(id & 1023);
  int src = mode ? win_src(n) : n;
  float v = 0.f;
  if (src >= 0) v = in[(size_t)k * ldn + src] * (g ? g[k] : 1.f);
  out[id] = f2bf(v);
}
__device__ __forceinline__ void d_make_mt(int item, const float* __restrict__ wq, const float* __restrict__ keys,
                                                 const float* __restrict__ g2, unsigned short* __restrict__ mt) {
  int n = item >> 2;
  int d = (item & 3) * 256 + threadIdx.x;
  int hp = n >> 7;
  const float4* kr = (const float4*)(keys + (size_t)n * 128);
  const float4* wr = (const float4*)(wq + (size_t)d * 2048 + hp * 128);
  float s = 0.f;
#pragma unroll 8
  for (int j = 0; j < 32; ++j) {
    float4 a = kr[j], b = wr[j];
    s += a.x * b.x + a.y * b.y + a.z * b.z + a.w * b.w;
  }
  mt[(size_t)n * DM + d] = f2bf(s * g2[d]);
}

constexpr int GBM = 128, GBN = 128, GBK = 64, GLD = 72;
struct GemmP {
  const unsigned short* A; const unsigned short* Bt; int lda, ldb, K;
  const float* rowscale;
  unsigned short* obf; int ldo;
  float* of32; int ldf;
  const float* resid;
};
enum { EPI_INPROJ = 0, EPI_OUTPROJ = 1, EPI_SCORES = 2 };

template <int EPI>
__device__ __forceinline__ void gemm_tile(const GemmP p, int tm, int tn, unsigned short* smem) {
  unsigned short* As = smem;
  unsigned short* Bs = smem + 2 * GBM * GLD;
  const int tid = threadIdx.x, lane = tid & 63, wid = tid >> 6;
  const int wm = wid >> 1, wn = wid & 1;
  const int m0 = tm * GBM, n0 = tn * GBN;
  f32x4 acc[4][4];
#pragma unroll
  for (int i = 0; i < 4; ++i)
#pragma unroll
    for (int j = 0; j < 4; ++j) acc[i][j] = (f32x4){0.f, 0.f, 0.f, 0.f};

  uint4 ra0, ra1, ra2, ra3, rb0, rb1, rb2, rb3;
  const int nk = p.K / GBK;
  const int lrow = tid >> 3, lc8 = tid & 7;
  const unsigned short* Ag = p.A + (size_t)(m0 + lrow) * p.lda + lc8 * 8;
  const unsigned short* Bg = p.Bt + (size_t)(n0 + lrow) * p.ldb + lc8 * 8;
  const size_t a32 = (size_t)32 * p.lda, b32 = (size_t)32 * p.ldb;
#define GLOAD(kt)                                                        \
  {                                                                      \
    ra0 = *(const uint4*)(Ag + (kt) * GBK);                              \
    ra1 = *(const uint4*)(Ag + a32 + (kt) * GBK);                        \
    ra2 = *(const uint4*)(Ag + 2 * a32 + (kt) * GBK);                    \
    ra3 = *(const uint4*)(Ag + 3 * a32 + (kt) * GBK);                    \
    rb0 = *(const uint4*)(Bg + (kt) * GBK);                              \
    rb1 = *(const uint4*)(Bg + b32 + (kt) * GBK);                        \
    rb2 = *(const uint4*)(Bg + 2 * b32 + (kt) * GBK);                    \
    rb3 = *(const uint4*)(Bg + 3 * b32 + (kt) * GBK);                    \
  }
#define SSTORE(buf)                                                      \
  {                                                                      \
    unsigned short* ad = As + (size_t)(buf) * GBM * GLD + lrow * GLD + lc8 * 8; \
    unsigned short* bd = Bs + (size_t)(buf) * GBN * GLD + lrow * GLD + lc8 * 8; \
    *(uint4*)(ad) = ra0; *(uint4*)(ad + 32 * GLD) = ra1; *(uint4*)(ad + 64 * GLD) = ra2; *(uint4*)(ad + 96 * GLD) = ra3; \
    *(uint4*)(bd) = rb0; *(uint4*)(bd + 32 * GLD) = rb1; *(uint4*)(bd + 64 * GLD) = rb2; *(uint4*)(bd + 96 * GLD) = rb3; \
  }
  GLOAD(0);
  SSTORE(0);
  __syncthreads();
  for (int kt = 0; kt < nk; ++kt) {
    const int buf = kt & 1;
    if (kt + 1 < nk) GLOAD(kt + 1);
    const unsigned short* Ab = As + (size_t)buf * GBM * GLD;
    const unsigned short* Bb = Bs + (size_t)buf * GBN * GLD;
#pragma unroll
    for (int ks = 0; ks < 2; ++ks) {
      bf16x8 a[4], b[4];
      const int kc = ks * 32 + (lane >> 4) * 8;
#pragma unroll
      for (int i = 0; i < 4; ++i) a[i] = *(const bf16x8*)(Ab + (wm * 64 + i * 16 + (lane & 15)) * GLD + kc);
#pragma unroll
      for (int j = 0; j < 4; ++j) b[j] = *(const bf16x8*)(Bb + (wn * 64 + j * 16 + (lane & 15)) * GLD + kc);
#pragma unroll
      for (int i = 0; i < 4; ++i)
#pragma unroll
        for (int j = 0; j < 4; ++j) acc[i][j] = __builtin_amdgcn_mfma_f32_16x16x32_bf16(a[i], b[j], acc[i][j], 0, 0, 0);
    }
    if (kt + 1 < nk) SSTORE(buf ^ 1);
    __syncthreads();
  }
#undef GLOAD
#undef SSTORE
#pragma unroll
  for (int i = 0; i < 4; ++i) {
#pragma unroll
    for (int r = 0; r < 4; ++r) {
      const int row = m0 + wm * 64 + i * 16 + (lane >> 4) * 4 + r;
      float rsc = 1.f;
      if (EPI == EPI_INPROJ || EPI == EPI_SCORES) rsc = p.rowscale[row];
#pragma unroll
      for (int j = 0; j < 4; ++j) {
        const int col = n0 + wn * 64 + j * 16 + (lane & 15);
        float v = acc[i][j][r] * rsc;
        if (EPI == EPI_INPROJ) {
          if (col < 4096) p.obf[(size_t)row * p.ldo + col] = f2bf(v);
          else if (col < 4128) p.of32[(size_t)row * p.ldf + (col - 4096)] = v;
        } else if (EPI == EPI_OUTPROJ) {
          p.of32[(size_t)row * p.ldf + col] = v + p.resid[(size_t)row * p.ldf + col];
        } else {
          p.obf[(size_t)row * p.ldo + col] = f2bf(v);
        }
      }
    }
  }
}

__device__ __forceinline__ void d_conv(int item, const unsigned short* __restrict__ pm, const float* __restrict__ pg,
                                              const float* __restrict__ conv_w, const float* __restrict__ a_log,
                                              const float* __restrict__ dt_bias, const float* __restrict__ i_bias,
                                              const float* __restrict__ f_bias, unsigned short* __restrict__ qkv,
                                              float* __restrict__ gt) {
  int t = item * 4 + (threadIdx.x >> 6);
  int lane = threadIdx.x & 63;
  int s = t & (SEQ - 1);
  for (int sec = 0; sec < 3; ++sec) {
    for (int h = 0; h < 4; ++h) {
      int c0 = sec * 512 + h * 128 + 2 * lane;
      float a0 = 0.f, a1 = 0.f;
#pragma unroll
      for (int j = 0; j < 5; ++j) {
        int sp = s + j - 2;
        if (sp >= 0 && sp < SEQ) {
          unsigned v = *(const unsigned*)(pm + (size_t)(t + j - 2) * 4096 + c0);
          a0 += conv_w[c0 * 5 + j] * bf2f((unsigned short)(v & 0xffff));
          a1 += conv_w[(c0 + 1) * 5 + j] * bf2f((unsigned short)(v >> 16));
        }
      }
      a0 = a0 * sigmoidf(a0);
      a1 = a1 * sigmoidf(a1);
      if (sec < 2) {
        float ss = wave_sum(a0 * a0 + a1 * a1);
        float sc = rsqrtf(ss + EPSF);
        if (sec == 0) sc *= 0.08838834764831845f;
        a0 *= sc; a1 *= sc;
      }
      unsigned o = (unsigned)f2bf(a0) | ((unsigned)f2bf(a1) << 16);
      *(unsigned*)(qkv + (size_t)t * 1536 + c0) = o;
    }
  }
  if (lane < 32) {
    float v = pg[(size_t)t * 32 + lane];
    int j = lane & 7;
    float o;
    if (lane < 8) o = -expf(a_log[j]) * softplusf(v + dt_bias[j]);
    else if (lane < 16) o = sigmoidf(v);
    else if (lane < 24) o = v + i_bias[j];
    else o = -softplusf(-(v + f_bias[j]));
    gt[(size_t)t * 32 + lane] = o;
  }
}

__device__ __forceinline__ void d_gdn_rec(int chain, float* sq, float* sk, const unsigned short* __restrict__ qkv,
                                                 const float* __restrict__ gt, unsigned short* __restrict__ oA) {
  const int bh = chain >> 1, dir = chain & 1;
  const int b = bh >> 2, h = bh & 3;
  const int e = threadIdx.x & 127;
  float S[128];
#pragma unroll
  for (int d = 0; d < 128; ++d) S[d] = 0.f;
  for (int it = 0; it < SEQ; ++it) {
    const int s = dir ? (SEQ - 1 - it) : it;
    const size_t t = (size_t)b * SEQ + s;
    __syncthreads();
    sq[e] = bf2f(qkv[t * 1536 + h * 128 + e]);
    sk[e] = bf2f(qkv[t * 1536 + 512 + h * 128 + e]);
    const float v = bf2f(qkv[t * 1536 + 1024 + h * 128 + e]);
    const float g = gt[t * 32 + dir * 4 + h];
    const float beta = gt[t * 32 + 8 + dir * 4 + h];
    __syncthreads();
    const float a = expf(g);
    float k0 = 0.f, k1 = 0.f, k2 = 0.f, k3 = 0.f;
#pragma unroll
    for (int d = 0; d < 128; d += 4) {
      k0 += sk[d] * S[d]; k1 += sk[d + 1] * S[d + 1]; k2 += sk[d + 2] * S[d + 2]; k3 += sk[d + 3] * S[d + 3];
    }
    const float kS = a * ((k0 + k1) + (k2 + k3));
    const float vn = beta * (v - kS);
    float o0 = 0.f, o1 = 0.f, o2 = 0.f, o3 = 0.f;
#pragma unroll
    for (int d = 0; d < 128; d += 4) {
      S[d] = a * S[d] + sk[d] * vn;             o0 += sq[d] * S[d];
      S[d + 1] = a * S[d + 1] + sk[d + 1] * vn; o1 += sq[d + 1] * S[d + 1];
      S[d + 2] = a * S[d + 2] + sk[d + 2] * vn; o2 += sq[d + 2] * S[d + 2];
      S[d + 3] = a * S[d + 3] + sk[d + 3] * vn; o3 += sq[d + 3] * S[d + 3];
    }
    oA[((size_t)dir * NT + t) * 512 + h * 128 + e] = f2bf((o0 + o1) + (o2 + o3));
  }
}

__device__ __forceinline__ void d_mlstm_rec(int chain, float* sq, float* sk, const unsigned short* __restrict__ pm,
                                                   const float* __restrict__ gt, unsigned short* __restrict__ oM) {
  const int bh = chain >> 1, dir = chain & 1;
  const int b = bh >> 2, h = bh & 3;
  const int e = threadIdx.x & 127, lane = e & 63;
  float C[128];
#pragma unroll
  for (int d = 0; d < 128; ++d) C[d] = 0.f;
  float n0 = 0.f, n1 = 0.f, m = 0.f;
  for (int it = 0; it < SEQ; ++it) {
    const int s = dir ? (SEQ - 1 - it) : it;
    const size_t t = (size_t)b * SEQ + s;
    __syncthreads();
    sq[e] = bf2f(pm[t * 4096 + 2048 + h * 128 + e]);
    sk[e] = bf2f(pm[t * 4096 + 2560 + h * 128 + e]) * 0.08838834764831845f;
    const float v = bf2f(pm[t * 4096 + 3072 + h * 128 + e]);
    const float ip = gt[t * 32 + 16 + dir * 4 + h];
    const float lf = gt[t * 32 + 24 + dir * 4 + h];
    __syncthreads();
    const float mn = fmaxf(lf + m, ip);
    const float fs = expf(lf + m - mn);
    const float is = expf(ip - mn);
    m = mn;
    n0 = fs * n0 + is * sk[lane];
    n1 = fs * n1 + is * sk[lane + 64];
    const float den = wave_sum(n0 * sq[lane] + n1 * sq[lane + 64]);
    const float iv = is * v;
    float o0 = 0.f, o1 = 0.f, o2 = 0.f, o3 = 0.f;
#pragma unroll
    for (int d = 0; d < 128; d += 4) {
      C[d] = fs * C[d] + sk[d] * iv;             o0 += sq[d] * C[d];
      C[d + 1] = fs * C[d + 1] + sk[d + 1] * iv; o1 += sq[d + 1] * C[d + 1];
      C[d + 2] = fs * C[d + 2] + sk[d + 2] * iv; o2 += sq[d + 2] * C[d + 2];
      C[d + 3] = fs * C[d + 3] + sk[d + 3] * iv; o3 += sq[d + 3] * C[d + 3];
    }
    const float num = (o0 + o1) + (o2 + o3);
    const float hh = num / fmaxf(fabsf(den), expf(-mn));
    oM[((size_t)dir * NT + t) * 512 + h * 128 + e] = f2bf(hh);
  }
}

__device__ __forceinline__ void d_combine(int item, const unsigned short* __restrict__ oA, const unsigned short* __restrict__ oM,
                                                 const unsigned short* __restrict__ pm, const float* __restrict__ gdn_g,
                                                 const float* __restrict__ ml_g, unsigned short* __restrict__ y) {
  int t = item * 4 + (threadIdx.x >> 6);
  int lane = threadIdx.x & 63;
  for (int h = 0; h < 4; ++h) {
    int c = h * 128 + 2 * lane;
    {
      unsigned vf = *(const unsigned*)(oA + (size_t)t * 512 + c);
      unsigned vb = *(const unsigned*)(oA + ((size_t)NT + t) * 512 + c);
      float o0 = bf2f(vf & 0xffff) + bf2f(vb & 0xffff);
      float o1 = bf2f(vf >> 16) + bf2f(vb >> 16);
      float ss = wave_sum(o0 * o0 + o1 * o1);
      float sc = rsqrtf(ss * (1.f / 128.f) + EPSF);
      unsigned z = *(const unsigned*)(pm + (size_t)t * 4096 + 1536 + c);
      float z0 = bf2f(z & 0xffff), z1 = bf2f(z >> 16);
      o0 = o0 * sc * gdn_g[2 * lane] * (z0 * sigmoidf(z0));
      o1 = o1 * sc * gdn_g[2 * lane + 1] * (z1 * sigmoidf(z1));
      *(unsigned*)(y + (size_t)t * DM + c) = (unsigned)f2bf(o0) | ((unsigned)f2bf(o1) << 16);
    }
    {
      unsigned vf = *(const unsigned*)(oM + (size_t)t * 512 + c);
      unsigned vb = *(const unsigned*)(oM + ((size_t)NT + t) * 512 + c);
      float o0 = bf2f(vf & 0xffff) + bf2f(vb & 0xffff);
      float o1 = bf2f(vf >> 16) + bf2f(vb >> 16);
      float ss = wave_sum(o0 * o0 + o1 * o1);
      float sc = rsqrtf(ss * (1.f / 128.f) + EPSF);
      unsigned z = *(const unsigned*)(pm + (size_t)t * 4096 + 3584 + c);
      float z0 = bf2f(z & 0xffff), z1 = bf2f(z >> 16);
      o0 = o0 * sc * ml_g[c] * sigmoidf(z0);
      o1 = o1 * sc * ml_g[c + 1] * sigmoidf(z1);
      *(unsigned*)(y + (size_t)t * DM + 512 + c) = (unsigned)f2bf(o0) | ((unsigned)f2bf(o1) << 16);
    }
  }
}

__device__ __forceinline__ void d_prep_x1(int item, const float* __restrict__ x1, unsigned short* __restrict__ xb,
                                                 float* __restrict__ rs) {
  int t = item * 4 + (threadIdx.x >> 6);
  int lane = threadIdx.x & 63;
  const float4* xr = (const float4*)(x1 + (size_t)t * DM);
  float ss = 0.f;
#pragma unroll
  for (int i = 0; i < 4; ++i) {
    float4 v = xr[lane + 64 * i];
    ss += v.x * v.x + v.y * v.y + v.z * v.z + v.w * v.w;
    ushort4 o;
    o.x = f2bf(v.x); o.y = f2bf(v.y); o.z = f2bf(v.z); o.w = f2bf(v.w);
    ((ushort4*)(xb + (size_t)t * DM))[lane + 64 * i] = o;
  }
  ss = wave_sum(ss);
  if (lane == 0) rs[t] = rsqrtf(ss * (1.f / DM) + EPSF);
}

__device__ const unsigned char kPairTab[64] = {
    0x00, 0x01, 0x02, 0x03, 0x04, 0x05, 0x06, 0x07, 0x08, 0x09, 0x0a, 0x0b, 0x0c, 0x0d, 0x0e, 0x0f,
    0x10, 0x11, 0x12, 0x13, 0x14, 0x15, 0x16, 0x17,
    0x20, 0x21, 0x22, 0x23, 0x24,
    0x30, 0x31, 0x32, 0x33,
    0x40, 0x41, 0x42,
    0x50, 0x51, 0x60, 0x61, 0x70, 0x71,
    0x80, 0x90, 0xa0, 0xb0, 0xc0, 0xd0, 0xe0, 0xf0,
    0xff, 0xff, 0xff, 0xff, 0xff, 0xff, 0xff, 0xff, 0xff, 0xff, 0xff, 0xff, 0xff, 0xff};

__device__ __forceinline__ void wave_top16(float va, int ia, float vb, int ib, int lane, float& outv, int& outi) {
  outv = -INFINITY; outi = 0;
  for (int r = 0; r < 16; ++r) {
    float bv; int bi;
    if (va >= vb) { bv = va; bi = ia; } else { bv = vb; bi = ib; }
#pragma unroll
    for (int o = 32; o > 0; o >>= 1) {
      float ov = __shfl_xor(bv, o, 64);
      int oi = __shfl_xor(bi, o, 64);
      if (ov > bv || (ov == bv && oi < bi)) { bv = ov; bi = oi; }
    }
    if (lane == r) { outv = bv; outi = bi; }
    if (bi == ia) va = -INFINITY;
    if (bi == ib) vb = -INFINITY;
  }
}

__device__ __forceinline__ void d_topk(int item, const unsigned short* __restrict__ scores, int* __restrict__ idx_out,
                                              float* __restrict__ gate_out) {
  const int w = item * 4 + (threadIdx.x >> 6);
  const int lane = threadIdx.x & 63;
  const int t = w >> 3, h = w & 7;
  const unsigned short* sp = scores + (size_t)t * 2048 + h * 256;
  float s0v, s1v; int i0v, i1v;
  wave_top16(bf2f(sp[lane]), lane, bf2f(sp[lane + 64]), lane + 64, lane, s0v, i0v);
  wave_top16(bf2f(sp[128 + lane]), lane, bf2f(sp[128 + lane + 64]), lane + 64, lane, s1v, i1v);
  const int pr = kPairTab[lane];
  const int pi = (pr >> 4) & 15, pj = pr & 15;
  float c0 = __shfl(s0v, pi, 64) + __shfl(s1v, pj, 64);
  int ci = __shfl(i0v, pi, 64) * 128 + __shfl(i1v, pj, 64);
  if (pr == 0xff) { c0 = -INFINITY; ci = 0x7fffffff; }
  float bestv; int besti;
  wave_top16(c0, ci, -INFINITY, -1, lane, bestv, besti);
  float mx = __shfl(bestv, 0, 64);
  float ev = (lane < 16) ? expf(bestv - mx) : 0.f;
  float sum = wave_sum(ev);
  if (lane < 16) {
    idx_out[(size_t)t * 128 + h * 16 + lane] = besti;
    gate_out[(size_t)t * 128 + h * 16 + lane] = ev / sum;
  }
}

__device__ __forceinline__ void d_peer(int item, const float* __restrict__ x1, const float* __restrict__ rs2,
                                              const float* __restrict__ g2, const int* __restrict__ idx,
                                              const float* __restrict__ gate, const float* __restrict__ pu,
                                              const float* __restrict__ pv, const float* __restrict__ gf,
                                              float* __restrict__ out) {
  const int t = item * 4 + (threadIdx.x >> 6);
  const int lane = threadIdx.x & 63;
  const float r2 = rs2[t];
  float4 xv[4], hv[4], acc[4];
#pragma unroll
  for (int i = 0; i < 4; ++i) {
    xv[i] = ((const float4*)(x1 + (size_t)t * DM))[lane + 64 * i];
    float4 g = ((const float4*)g2)[lane + 64 * i];
    hv[i].x = xv[i].x * r2 * g.x; hv[i].y = xv[i].y * r2 * g.y; hv[i].z = xv[i].z * r2 * g.z; hv[i].w = xv[i].w * r2 * g.w;
    acc[i] = make_float4(0.f, 0.f, 0.f, 0.f);
  }
  for (int e = 0; e < 128; ++e) {
    const int id = idx[(size_t)t * 128 + e];
    const float gt = gate[(size_t)t * 128 + e];
    const float4* ur = (const float4*)(pu + (size_t)id * DM);
    const float4* vr = (const float4*)(pv + (size_t)id * DM);
    float4 vv[4];
    float d = 0.f;
#pragma unroll
    for (int i = 0; i < 4; ++i) {
      float4 u = ur[lane + 64 * i];
      vv[i] = vr[lane + 64 * i];
      d += u.x * hv[i].x + u.y * hv[i].y + u.z * hv[i].z + u.w * hv[i].w;
    }
    d = wave_sum(d);
    const float act = 0.5f * d * (1.f + erff(d * 0.7071067811865476f));
    const float wgt = gt * act;
#pragma unroll
    for (int i = 0; i < 4; ++i) {
      acc[i].x += wgt * vv[i].x; acc[i].y += wgt * vv[i].y; acc[i].z += wgt * vv[i].z; acc[i].w += wgt * vv[i].w;
    }
  }
  float ss = 0.f;
#pragma unroll
  for (int i = 0; i < 4; ++i) {
    acc[i].x += xv[i].x; acc[i].y += xv[i].y; acc[i].z += xv[i].z; acc[i].w += xv[i].w;
    ss += acc[i].x * acc[i].x + acc[i].y * acc[i].y + acc[i].z * acc[i].z + acc[i].w * acc[i].w;
  }
  ss = wave_sum(ss);
  const float sc = rsqrtf(ss * (1.f / DM) + EPSF);
#pragma unroll
  for (int i = 0; i < 4; ++i) {
    float4 g = ((const float4*)gf)[lane + 64 * i];
    float4 o;
    o.x = acc[i].x * sc * g.x; o.y = acc[i].y * sc * g.y; o.z = acc[i].z * sc * g.z; o.w = acc[i].w * sc * g.w;
    ((float4*)(out + (size_t)t * DM))[lane + 64 * i] = o;
  }
}

struct MKP {
  const float *x, *norm1_g, *w_in, *conv_w, *a_log, *dt_bias, *gdn_g, *i_bias, *f_bias, *ml_g, *w_out, *norm2_g, *peer_wq,
      *peer_keys, *peer_u, *peer_v, *normf_g;
  float* out;
  unsigned short *pm, *x1b, *woutT, *mt, *xb, *winT, *qkv, *oA, *oM, *yb, *scores;
  float *x1, *rs1, *rs2, *pg, *gt, *gateb;
  int* idxb;
};

__global__ void __launch_bounds__(256) k_mega(MKP P) {
  cg::grid_group grid = cg::this_grid();
  __shared__ __attribute__((aligned(16))) unsigned short smem[4 * 128 * GLD];
  const int nb = gridDim.x, bid = blockIdx.x;
  for (int it = bid; it < NT / 4; it += nb) d_prep_x(it, P.x, P.xb, P.rs1);
  for (int it = bid; it < NPAD_IN * DM / 256; it += nb) d_transpose_w(it, P.w_in, DIN, P.norm1_g, P.winT, NPAD_IN, 1);
  for (int it = bid; it < 1024 * DM / 256; it += nb) d_transpose_w(it, P.w_out, 1024, nullptr, P.woutT, 1024, 0);
  for (int it = bid; it < 2048 * 4; it += nb) d_make_mt(it, P.peer_wq, P.peer_keys, P.norm2_g, P.mt);
  grid.sync();
  {
    GemmP p{};
    p.A = P.xb; p.lda = DM; p.Bt = P.winT; p.ldb = DM; p.K = DM;
    p.rowscale = P.rs1; p.obf = P.pm; p.ldo = 4096; p.of32 = P.pg; p.ldf = 32; p.resid = nullptr;
    for (int tile = bid; tile < (NT / 128) * 33; tile += nb) {
      gemm_tile<EPI_INPROJ>(p, tile / 33, tile % 33, smem);
      __syncthreads();
    }
  }
  grid.sync();
  for (int it = bid; it < NT / 4; it += nb) d_conv(it, P.pm, P.pg, P.conv_w, P.a_log, P.dt_bias, P.i_bias, P.f_bias, P.qkv, P.gt);
  grid.sync();
  if (bid < 32) {
    const int half = threadIdx.x >> 7;
    float* sq = (float*)smem + half * 256;
    float* sk = sq + 128;
    const int chain = bid * 2 + half;
    if (bid < 16) d_gdn_rec(chain, sq, sk, P.qkv, P.gt, P.oA);
    else d_mlstm_rec(chain - 32, sq, sk, P.pm, P.gt, P.oM);
  }
  grid.sync();
  for (int it = bid; it < NT / 4; it += nb) d_combine(it, P.oA, P.oM, P.pm, P.gdn_g, P.ml_g, P.yb);
  grid.sync();
  {
    GemmP p{};
    p.A = P.yb; p.lda = DM; p.Bt = P.woutT; p.ldb = DM; p.K = DM;
    p.rowscale = nullptr; p.obf = nullptr; p.ldo = 0; p.of32 = P.x1; p.ldf = DM; p.resid = P.x;
    for (int tile = bid; tile < (NT / 128) * 8; tile += nb) {
      gemm_tile<EPI_OUTPROJ>(p, tile / 8, tile % 8, smem);
      __syncthreads();
    }
  }
  grid.sync();
  for (int it = bid; it < NT / 4; it += nb) d_prep_x1(it, P.x1, P.x1b, P.rs2);
  grid.sync();
  {
    GemmP p{};
    p.A = P.x1b; p.lda = DM; p.Bt = P.mt; p.ldb = DM; p.K = DM;
    p.rowscale = P.rs2; p.obf = P.scores; p.ldo = 2048; p.of32 = nullptr; p.ldf = 0; p.resid = nullptr;
    for (int tile = bid; tile < (NT / 128) * 16; tile += nb) {
      gemm_tile<EPI_SCORES>(p, tile / 16, tile % 16, smem);
      __syncthreads();
    }
  }
  grid.sync();
  for (int it = bid; it < NT * 8 / 4; it += nb) d_topk(it, P.scores, P.idxb, P.gateb);
  grid.sync();
  for (int it = bid; it < NT / 4; it += nb) d_peer(it, P.x1, P.rs2, P.norm2_g, P.idxb, P.gateb, P.peer_u, P.peer_v, P.normf_g, P.out);
}

extern "C" void kernel_launch(void* const* d_in, const int* in_sizes, int n_in, void* d_out, int out_size, void* d_ws,
                              size_t ws_size, hipStream_t stream) {
  MKP P{};
  P.x = (const float*)d_in[0];
  P.norm1_g = (const float*)d_in[1];
  P.w_in = (const float*)d_in[2];
  P.conv_w = (const float*)d_in[3];
  P.a_log = (const float*)d_in[4];
  P.dt_bias = (const float*)d_in[5];
  P.gdn_g = (const float*)d_in[6];
  P.i_bias = (const float*)d_in[7];
  P.f_bias = (const float*)d_in[8];
  P.ml_g = (const float*)d_in[9];
  P.w_out = (const float*)d_in[10];
  P.norm2_g = (const float*)d_in[11];
  P.peer_wq = (const float*)d_in[12];
  P.peer_keys = (const float*)d_in[13];
  P.peer_u = (const float*)d_in[14];
  P.peer_v = (const float*)d_in[15];
  P.normf_g = (const float*)d_in[16];
  P.out = (float*)d_out;

  char* ws = (char*)d_ws;
  const size_t MB = 1024 * 1024;
  P.pm = (unsigned short*)(ws);
  P.x1 = (float*)(ws);
  P.x1b = (unsigned short*)(ws + 64 * MB);
  char* rb = ws + 128 * MB;
  P.woutT = (unsigned short*)(rb);
  P.mt = (unsigned short*)(rb + 2 * MB);
  P.rs1 = (float*)(rb + 6 * MB);
  P.rs2 = (float*)(rb + 6 * MB + 65536);
  P.pg = (float*)(rb + 7 * MB);
  P.gt = (float*)(rb + 9 * MB);
  char* dyn = rb + 11 * MB;
  P.xb = (unsigned short*)(dyn);
  P.winT = (unsigned short*)(dyn + 32 * MB);
  P.qkv = (unsigned short*)(dyn);
  P.oA = (unsigned short*)(dyn + 48 * MB);
  P.oM = (unsigned short*)(dyn + 80 * MB);
  P.yb = (unsigned short*)(dyn);
  P.scores = (unsigned short*)(dyn);
  P.idxb = (int*)(dyn + 64 * MB);
  P.gateb = (float*)(dyn + 72 * MB);

  static int grid_blocks = 0;
  if (!grid_blocks) {
    int dev = 0, cus = 0, per_cu = 0;
    (void)hipGetDevice(&dev);
    (void)hipDeviceGetAttribute(&cus, hipDeviceAttributeMultiprocessorCount, dev);
    (void)hipOccupancyMaxActiveBlocksPerMultiprocessor(&per_cu, k_mega, 256, 0);
    if (per_cu > 1) per_cu = 1;
    if (per_cu < 1) per_cu = 1;
    grid_blocks = cus * per_cu;
  }
  void* args[] = {&P};
  hipError_t e = hipLaunchCooperativeKernel((void*)k_mega, dim3(grid_blocks), dim3(256), args, 0, stream);
  if (e != hipSuccess) fprintf(stderr, "cooperative launch failed: %s (grid %d)\n", hipGetErrorString(e), grid_blocks);
}
```

```cpp
#include <hip/hip_runtime.h>
#include <hip/hip_bf16.h>
#include <stdint.h>
#include <hip/hip_cooperative_groups.h>
#include <cstdio>
namespace cg = cooperative_groups;

typedef __hip_bfloat16 bf16;
typedef __attribute__((ext_vector_type(8))) short bf16x8;
typedef __attribute__((ext_vector_type(4))) float f32x4;

constexpr int DM = 1024;
constexpr int NB = 4;
constexpr int SEQ = 4096;
constexpr int NT = NB * SEQ;
constexpr int DIN = 4128;
constexpr int NPAD_IN = 4224;
constexpr float EPSF = 1e-6f;

__device__ __forceinline__ float bf2f(unsigned short u) { return __uint_as_float(((unsigned)u) << 16); }
__device__ __forceinline__ unsigned short f2bf(float f) {
  unsigned u = __float_as_uint(f);
  u += 0x7fffu + ((u >> 16) & 1u);
  return (unsigned short)(u >> 16);
}
__device__ __forceinline__ float wave_sum(float v) {
#pragma unroll
  for (int o = 32; o > 0; o >>= 1) v += __shfl_xor(v, o, 64);
  return v;
}
__device__ __forceinline__ float softplusf(float x) { return fmaxf(x, 0.f) + log1pf(expf(-fabsf(x))); }
__device__ __forceinline__ float sigmoidf(float x) { return 1.f / (1.f + expf(-x)); }

__device__ __forceinline__ void d_prep_x(int item, const float* __restrict__ x, unsigned short* __restrict__ xb,
                                                float* __restrict__ rs) {
  int t = item * 4 + (threadIdx.x >> 6);
  int lane = threadIdx.x & 63;
  const float4* xr = (const float4*)(x + (size_t)t * DM);
  float ss = 0.f;
#pragma unroll
  for (int i = 0; i < 4; ++i) {
    float4 v = xr[lane + 64 * i];
    ss += v.x * v.x + v.y * v.y + v.z * v.z + v.w * v.w;
    ushort4 o;
    o.x = f2bf(v.x); o.y = f2bf(v.y); o.z = f2bf(v.z); o.w = f2bf(v.w);
    ((ushort4*)(xb + (size_t)t * DM))[lane + 64 * i] = o;
  }
  ss = wave_sum(ss);
  if (lane == 0) rs[t] = rsqrtf(ss * (1.f / DM) + EPSF);
}

__device__ __forceinline__ int win_src(int n) {
  if (n < 2048) return n;
  if (n < 4096) return n + 16;
  int j = n - 4096;
  if (j < 16) return 2048 + j;
  if (j < 32) return 4112 + (j - 16);
  return -1;
}
__device__ __forceinline__ void d_transpose_w(int item, const float* __restrict__ in, int ldn, const float* __restrict__ g,
                                                     unsigned short* __restrict__ out, int nrows, int mode) {
  size_t id = (size_t)item * 256 + threadIdx.x;
  if (id >= (size_t)nrows * DM) return;
  int n = (int)(id >> 10);
  int k = (int)(id & 1023);
  int src = mode ? win_src(n) : n;
  float v = 0.f;
  if (src >= 0) v = in[(size_t)k * ldn + src] * (g ? g[k] : 1.f);
  out[id] = f2bf(v);
}
__device__ __forceinline__ void d_make_mt(int item, const float* __restrict__ wq, const float* __restrict__ keys,
                                                 const float* __restrict__ g2, unsigned short* __restrict__ mt) {
  int n = item >> 2;
  int d = (item & 3) * 256 + threadIdx.x;
  int hp = n >> 7;
  const float4* kr = (const float4*)(keys + (size_t)n * 128);
  const float4* wr = (const float4*)(wq + (size_t)d * 2048 + hp * 128);
  float s = 0.f;
#pragma unroll 8
  for (int j = 0; j < 32; ++j) {
    float4 a = kr[j], b = wr[j];
    s += a.x * b.x + a.y * b.y + a.z * b.z + a.w * b.w;
  }
  mt[(size_t)n * DM + d] = f2bf(s * g2[d]);
}

constexpr int GBM = 128, GBN = 128, GBK = 64, GLD = 72;
struct GemmP {
  const unsigned short* A; const unsigned short* Bt; int lda, ldb, K;
  const float* rowscale;
  unsigned short* obf; int ldo;
  float* of32; int ldf;
  const float* resid;
  const float *a_log, *dt_bias, *i_bias, *f_bias;
};
enum { EPI_INPROJ = 0, EPI_OUTPROJ = 1, EPI_SCORES = 2 };

template <int EPI>
__device__ __forceinline__ void gemm_tile(const GemmP p, int tm, int tn, unsigned short* smem) {
  unsigned short* As = smem;
  unsigned short* Bs = smem + 2 * GBM * GLD;
  const int tid = threadIdx.x, lane = tid & 63, wid = tid >> 6;
  const int wm = wid >> 1, wn = wid & 1;
  const int m0 = tm * GBM, n0 = tn * GBN;
  f32x4 acc[4][4];
#pragma unroll
  for (int i = 0; i < 4; ++i)
#pragma unroll
    for (int j = 0; j < 4; ++j) acc[i][j] = (f32x4){0.f, 0.f, 0.f, 0.f};

  uint4 ra0, ra1, ra2, ra3, rb0, rb1, rb2, rb3;
  const int nk = p.K / GBK;
  const int lrow = tid >> 3, lc8 = tid & 7;
  const unsigned short* Ag = p.A + (size_t)(m0 + lrow) * p.lda + lc8 * 8;
  const unsigned short* Bg = p.Bt + (size_t)(n0 + lrow) * p.ldb + lc8 * 8;
  const size_t a32 = (size_t)32 * p.lda, b32 = (size_t)32 * p.ldb;
#define GLOAD(kt)                                                        \
  {                                                                      \
    ra0 = *(const uint4*)(Ag + (kt) * GBK);                              \
    ra1 = *(const uint4*)(Ag + a32 + (kt) * GBK);                        \
    ra2 = *(const uint4*)(Ag + 2 * a32 + (kt) * GBK);                    \
    ra3 = *(const uint4*)(Ag + 3 * a32 + (kt) * GBK);                    \
    rb0 = *(const uint4*)(Bg + (kt) * GBK);                              \
    rb1 = *(const uint4*)(Bg + b32 + (kt) * GBK);                        \
    rb2 = *(const uint4*)(Bg + 2 * b32 + (kt) * GBK);                    \
    rb3 = *(const uint4*)(Bg + 3 * b32 + (kt) * GBK);                    \
  }
#define SSTORE(buf)                                                      \
  {                                                                      \
    unsigned short* ad = As + (size_t)(buf) * GBM * GLD + lrow * GLD + lc8 * 8; \
    unsigned short* bd = Bs + (size_t)(buf) * GBN * GLD + lrow * GLD + lc8 * 8; \
    *(uint4*)(ad) = ra0; *(uint4*)(ad + 32 * GLD) = ra1; *(uint4*)(ad + 64 * GLD) = ra2; *(uint4*)(ad + 96 * GLD) = ra3; \
    *(uint4*)(bd) = rb0; *(uint4*)(bd + 32 * GLD) = rb1; *(uint4*)(bd + 64 * GLD) = rb2; *(uint4*)(bd + 96 * GLD) = rb3; \
  }
  GLOAD(0);
  SSTORE(0);
  __syncthreads();
  for (int kt = 0; kt < nk; ++kt) {
    const int buf = kt & 1;
    if (kt + 1 < nk) GLOAD(kt + 1);
    const unsigned short* Ab = As + (size_t)buf * GBM * GLD;
    const unsigned short* Bb = Bs + (size_t)buf * GBN * GLD;
#pragma unroll
    for (int ks = 0; ks < 2; ++ks) {
      bf16x8 a[4], b[4];
      const int kc = ks * 32 + (lane >> 4) * 8;
#pragma unroll
      for (int i = 0; i < 4; ++i) a[i] = *(const bf16x8*)(Ab + (wm * 64 + i * 16 + (lane & 15)) * GLD + kc);
#pragma unroll
      for (int j = 0; j < 4; ++j) b[j] = *(const bf16x8*)(Bb + (wn * 64 + j * 16 + (lane & 15)) * GLD + kc);
#pragma unroll
      for (int i = 0; i < 4; ++i)
#pragma unroll
        for (int j = 0; j < 4; ++j) acc[i][j] = __builtin_amdgcn_mfma_f32_16x16x32_bf16(a[i], b[j], acc[i][j], 0, 0, 0);
    }
    if (kt + 1 < nk) SSTORE(buf ^ 1);
    __syncthreads();
  }
#undef GLOAD
#undef SSTORE
#pragma unroll
  for (int i = 0; i < 4; ++i) {
#pragma unroll
    for (int r = 0; r < 4; ++r) {
      const int row = m0 + wm * 64 + i * 16 + (lane >> 4) * 4 + r;
      float rsc = 1.f;
      if (EPI == EPI_INPROJ || EPI == EPI_SCORES) rsc = p.rowscale[row];
#pragma unroll
      for (int j = 0; j < 4; ++j) {
        const int col = n0 + wn * 64 + j * 16 + (lane & 15);
        float v = acc[i][j][r] * rsc;
        if (EPI == EPI_INPROJ) {
          if (col < 4096) p.obf[(size_t)row * p.ldo + col] = f2bf(v);
          else if (col < 4128) {
            const int j = col - 4096, jj = j & 7;
            float o;
            if (j < 8) o = -expf(p.a_log[jj]) * softplusf(v + p.dt_bias[jj]);
            else if (j < 16) o = sigmoidf(v);
            else if (j < 24) o = v + p.i_bias[jj];
            else o = -softplusf(-(v + p.f_bias[jj]));
            p.of32[(size_t)row * p.ldf + j] = o;
          }
        } else if (EPI == EPI_OUTPROJ) {
          p.of32[(size_t)row * p.ldf + col] = v + p.resid[(size_t)row * p.ldf + col];
        } else {
          p.obf[(size_t)row * p.ldo + col] = f2bf(v);
        }
      }
    }
  }
}

__device__ __forceinline__ void d_conv(int item, const unsigned short* __restrict__ pm, const float* __restrict__ pg,
                                              const float* __restrict__ conv_w, const float* __restrict__ a_log,
                                              const float* __restrict__ dt_bias, const float* __restrict__ i_bias,
                                              const float* __restrict__ f_bias, unsigned short* __restrict__ qkv,
                                              float* __restrict__ gt) {
  int t = item * 4 + (threadIdx.x >> 6);
  int lane = threadIdx.x & 63;
  int s = t & (SEQ - 1);
  for (int sec = 0; sec < 3; ++sec) {
    for (int h = 0; h < 4; ++h) {
      int c0 = sec * 512 + h * 128 + 2 * lane;
      float a0 = 0.f, a1 = 0.f;
#pragma unroll
      for (int j = 0; j < 5; ++j) {
        int sp = s + j - 2;
        if (sp >= 0 && sp < SEQ) {
          unsigned v = *(const unsigned*)(pm + (size_t)(t + j - 2) * 4096 + c0);
          a0 += conv_w[c0 * 5 + j] * bf2f((unsigned short)(v & 0xffff));
          a1 += conv_w[(c0 + 1) * 5 + j] * bf2f((unsigned short)(v >> 16));
        }
      }
      a0 = a0 * sigmoidf(a0);
      a1 = a1 * sigmoidf(a1);
      if (sec < 2) {
        float ss = wave_sum(a0 * a0 + a1 * a1);
        float sc = rsqrtf(ss + EPSF);
        if (sec == 0) sc *= 0.08838834764831845f;
        a0 *= sc; a1 *= sc;
      }
      unsigned o = (unsigned)f2bf(a0) | ((unsigned)f2bf(a1) << 16);
      *(unsigned*)(qkv + (size_t)t * 1536 + c0) = o;
    }
  }
}

__device__ __forceinline__ void d_gdn_rec(int chain, float* sq, float* sk, const unsigned short* __restrict__ qkv,
                                                 const float* __restrict__ gt, unsigned short* __restrict__ oA, int ntok) {
  const int bh = chain >> 1, dir = chain & 1;
  const int b = bh >> 2, h = bh & 3;
  const int e = threadIdx.x & 127;
  float S[128];
#pragma unroll
  for (int d = 0; d < 128; ++d) S[d] = 0.f;
  for (int it = 0; it < SEQ; ++it) {
    const int s = dir ? (SEQ - 1 - it) : it;
    const size_t t = (size_t)b * SEQ + s;
    __syncthreads();
    sq[e] = bf2f(qkv[t * 1536 + h * 128 + e]);
    sk[e] = bf2f(qkv[t * 1536 + 512 + h * 128 + e]);
    const float v = bf2f(qkv[t * 1536 + 1024 + h * 128 + e]);
    const float g = gt[t * 32 + dir * 4 + h];
    const float beta = gt[t * 32 + 8 + dir * 4 + h];
    __syncthreads();
    const float a = expf(g);
    float k0 = 0.f, k1 = 0.f, k2 = 0.f, k3 = 0.f;
#pragma unroll
    for (int d = 0; d < 128; d += 4) {
      k0 += sk[d] * S[d]; k1 += sk[d + 1] * S[d + 1]; k2 += sk[d + 2] * S[d + 2]; k3 += sk[d + 3] * S[d + 3];
    }
    const float kS = a * ((k0 + k1) + (k2 + k3));
    const float vn = beta * (v - kS);
    float o0 = 0.f, o1 = 0.f, o2 = 0.f, o3 = 0.f;
#pragma unroll
    for (int d = 0; d < 128; d += 4) {
      S[d] = a * S[d] + sk[d] * vn;             o0 += sq[d] * S[d];
      S[d + 1] = a * S[d + 1] + sk[d + 1] * vn; o1 += sq[d + 1] * S[d + 1];
      S[d + 2] = a * S[d + 2] + sk[d + 2] * vn; o2 += sq[d + 2] * S[d + 2];
      S[d + 3] = a * S[d + 3] + sk[d + 3] * vn; o3 += sq[d + 3] * S[d + 3];
    }
    oA[((size_t)dir * ntok + t) * 512 + h * 128 + e] = f2bf((o0 + o1) + (o2 + o3));
  }
}

__device__ __forceinline__ void d_mlstm_rec(int chain, float* sq, float* sk, const unsigned short* __restrict__ pm,
                                                   const float* __restrict__ gt, unsigned short* __restrict__ oM, int ntok) {
  const int bh = chain >> 1, dir = chain & 1;
  const int b = bh >> 2, h = bh & 3;
  const int e = threadIdx.x & 127, lane = e & 63;
  float C[128];
#pragma unroll
  for (int d = 0; d < 128; ++d) C[d] = 0.f;
  float n0 = 0.f, n1 = 0.f, m = 0.f;
  for (int it = 0; it < SEQ; ++it) {
    const int s = dir ? (SEQ - 1 - it) : it;
    const size_t t = (size_t)b * SEQ + s;
    __syncthreads();
    sq[e] = bf2f(pm[t * 4096 + 2048 + h * 128 + e]);
    sk[e] = bf2f(pm[t * 4096 + 2560 + h * 128 + e]) * 0.08838834764831845f;
    const float v = bf2f(pm[t * 4096 + 3072 + h * 128 + e]);
    const float ip = gt[t * 32 + 16 + dir * 4 + h];
    const float lf = gt[t * 32 + 24 + dir * 4 + h];
    __syncthreads();
    const float mn = fmaxf(lf + m, ip);
    const float fs = expf(lf + m - mn);
    const float is = expf(ip - mn);
    m = mn;
    n0 = fs * n0 + is * sk[lane];
    n1 = fs * n1 + is * sk[lane + 64];
    const float den = wave_sum(n0 * sq[lane] + n1 * sq[lane + 64]);
    const float iv = is * v;
    float o0 = 0.f, o1 = 0.f, o2 = 0.f, o3 = 0.f;
#pragma unroll
    for (int d = 0; d < 128; d += 4) {
      C[d] = fs * C[d] + sk[d] * iv;             o0 += sq[d] * C[d];
      C[d + 1] = fs * C[d + 1] + sk[d + 1] * iv; o1 += sq[d + 1] * C[d + 1];
      C[d + 2] = fs * C[d + 2] + sk[d + 2] * iv; o2 += sq[d + 2] * C[d + 2];
      C[d + 3] = fs * C[d + 3] + sk[d + 3] * iv; o3 += sq[d + 3] * C[d + 3];
    }
    const float num = (o0 + o1) + (o2 + o3);
    const float hh = num / fmaxf(fabsf(den), expf(-mn));
    oM[((size_t)dir * ntok + t) * 512 + h * 128 + e] = f2bf(hh);
  }
}

__device__ __forceinline__ void d_combine(int item, const unsigned short* __restrict__ uo, const unsigned short* __restrict__ oM,
                                                 const unsigned short* __restrict__ pm, const float* __restrict__ gdn_g,
                                                 const float* __restrict__ ml_g, unsigned short* __restrict__ y) {
  int t = item * 4 + (threadIdx.x >> 6);
  int lane = threadIdx.x & 63;
  const int b = t >> 12, cc = (t >> 6) & 63, ii = t & 63;
  for (int h = 0; h < 4; ++h) {
    int c = h * 128 + 2 * lane;
    {
      const int chain0 = (b * 4 + h) * 2;
      const size_t off = (size_t)cc * 8192 + (lane >> 4) * 2048 + ii * 32 + ((2 * lane) & 31);
      unsigned vf = *(const unsigned*)(uo + (size_t)chain0 * 64 * 8192 + off);
      unsigned vb = *(const unsigned*)(uo + (size_t)(chain0 + 1) * 64 * 8192 + off);
      float o0 = bf2f(vf & 0xffff) + bf2f(vb & 0xffff);
      float o1 = bf2f(vf >> 16) + bf2f(vb >> 16);
      float ss = wave_sum(o0 * o0 + o1 * o1);
      float sc = rsqrtf(ss * (1.f / 128.f) + EPSF);
      unsigned z = *(const unsigned*)(pm + (size_t)t * 4096 + 1536 + c);
      float z0 = bf2f(z & 0xffff), z1 = bf2f(z >> 16);
      o0 = o0 * sc * gdn_g[2 * lane] * (z0 * sigmoidf(z0));
      o1 = o1 * sc * gdn_g[2 * lane + 1] * (z1 * sigmoidf(z1));
      *(unsigned*)(y + (size_t)t * DM + c) = (unsigned)f2bf(o0) | ((unsigned)f2bf(o1) << 16);
    }
    {
      unsigned vf = *(const unsigned*)(oM + (size_t)t * 512 + c);
      unsigned vb = *(const unsigned*)(oM + ((size_t)NT + t) * 512 + c);
      float o0 = bf2f(vf & 0xffff) + bf2f(vb & 0xffff);
      float o1 = bf2f(vf >> 16) + bf2f(vb >> 16);
      float ss = wave_sum(o0 * o0 + o1 * o1);
      float sc = rsqrtf(ss * (1.f / 128.f) + EPSF);
      unsigned z = *(const unsigned*)(pm + (size_t)t * 4096 + 3584 + c);
      float z0 = bf2f(z & 0xffff), z1 = bf2f(z >> 16);
      o0 = o0 * sc * ml_g[c] * sigmoidf(z0);
      o1 = o1 * sc * ml_g[c + 1] * sigmoidf(z1);
      *(unsigned*)(y + (size_t)t * DM + 512 + c) = (unsigned)f2bf(o0) | ((unsigned)f2bf(o1) << 16);
    }
  }
}

#ifdef DBG_CHECK
__device__ __forceinline__ void d_dbg_cmp(int item, const unsigned short* __restrict__ uo, const unsigned short* __restrict__ oAd,
                                          float* __restrict__ dbg) {
  int t = item * 4 + (threadIdx.x >> 6);
  int lane = threadIdx.x & 63;
  const int cc = (t >> 6) & 63, ii = t & 63;
  float sd = 0.f, sr = 0.f;
  for (int h = 0; h < 4; ++h) {
    for (int dir = 0; dir < 2; ++dir) {
      const int chain = h * 2 + dir;
      const size_t off = (size_t)cc * 8192 + (lane >> 4) * 2048 + ii * 32 + ((2 * lane) & 31);
      unsigned vn = *(const unsigned*)(uo + (size_t)chain * 64 * 8192 + off);
      unsigned vr = *(const unsigned*)(oAd + ((size_t)dir * 4096 + t) * 512 + h * 128 + 2 * lane);
      float n0 = bf2f(vn & 0xffff), n1 = bf2f(vn >> 16), r0 = bf2f(vr & 0xffff), r1 = bf2f(vr >> 16);
      sd += (n0 - r0) * (n0 - r0) + (n1 - r1) * (n1 - r1);
      sr += r0 * r0 + r1 * r1;
    }
  }
  sd = wave_sum(sd); sr = wave_sum(sr);
  if (lane == 0) { atomicAdd(&dbg[0], sd); atomicAdd(&dbg[1], sr); }
}
__device__ __forceinline__ void d_dbg_cmp_m(int item, const unsigned short* __restrict__ oM, const unsigned short* __restrict__ oMd,
                                            float* __restrict__ dbg) {
  int t = item * 4 + (threadIdx.x >> 6);
  int lane = threadIdx.x & 63;
  float sd = 0.f, sr = 0.f;
  for (int dir = 0; dir < 2; ++dir)
    for (int q = 0; q < 4; ++q) {
      unsigned vn = *(const unsigned*)(oM + ((size_t)dir * NT + t) * 512 + q * 128 + 2 * lane);
      unsigned vr = *(const unsigned*)(oMd + ((size_t)dir * 4096 + t) * 512 + q * 128 + 2 * lane);
      float n0 = bf2f(vn & 0xffff), n1 = bf2f(vn >> 16), r0 = bf2f(vr & 0xffff), r1 = bf2f(vr >> 16);
      sd += (n0 - r0) * (n0 - r0) + (n1 - r1) * (n1 - r1);
      sr += r0 * r0 + r1 * r1;
    }
  sd = wave_sum(sd); sr = wave_sum(sr);
  if (lane == 0) { atomicAdd(&dbg[0], sd); atomicAdd(&dbg[1], sr); }
}
#endif

__device__ __forceinline__ void d_prep_x1(int item, const float* __restrict__ x1, unsigned short* __restrict__ xb,
                                                 float* __restrict__ rs) {
  int t = item * 4 + (threadIdx.x >> 6);
  int lane = threadIdx.x & 63;
  const float4* xr = (const float4*)(x1 + (size_t)t * DM);
  float ss = 0.f;
#pragma unroll
  for (int i = 0; i < 4; ++i) {
    float4 v = xr[lane + 64 * i];
    ss += v.x * v.x + v.y * v.y + v.z * v.z + v.w * v.w;
    ushort4 o;
    o.x = f2bf(v.x); o.y = f2bf(v.y); o.z = f2bf(v.z); o.w = f2bf(v.w);
    ((ushort4*)(xb + (size_t)t * DM))[lane + 64 * i] = o;
  }
  ss = wave_sum(ss);
  if (lane == 0) rs[t] = rsqrtf(ss * (1.f / DM) + EPSF);
}

__device__ const unsigned char kPairTab[64] = {
    0x00, 0x01, 0x02, 0x03, 0x04, 0x05, 0x06, 0x07, 0x08, 0x09, 0x0a, 0x0b, 0x0c, 0x0d, 0x0e, 0x0f,
    0x10, 0x11, 0x12, 0x13, 0x14, 0x15, 0x16, 0x17,
    0x20, 0x21, 0x22, 0x23, 0x24,
    0x30, 0x31, 0x32, 0x33,
    0x40, 0x41, 0x42,
    0x50, 0x51, 0x60, 0x61, 0x70, 0x71,
    0x80, 0x90, 0xa0, 0xb0, 0xc0, 0xd0, 0xe0, 0xf0,
    0xff, 0xff, 0xff, 0xff, 0xff, 0xff, 0xff, 0xff, 0xff, 0xff, 0xff, 0xff, 0xff, 0xff};

__device__ __forceinline__ void wave_top16(float va, int ia, float vb, int ib, int lane, float& outv, int& outi) {
  outv = -INFINITY; outi = 0;
  for (int r = 0; r < 16; ++r) {
    float bv; int bi;
    if (va >= vb) { bv = va; bi = ia; } else { bv = vb; bi = ib; }
#pragma unroll
    for (int o = 32; o > 0; o >>= 1) {
      float ov = __shfl_xor(bv, o, 64);
      int oi = __shfl_xor(bi, o, 64);
      if (ov > bv || (ov == bv && oi < bi)) { bv = ov; bi = oi; }
    }
    if (lane == r) { outv = bv; outi = bi; }
    if (bi == ia) va = -INFINITY;
    if (bi == ib) vb = -INFINITY;
  }
}

__device__ __forceinline__ void d_topk(int item, const unsigned short* __restrict__ scores, int* __restrict__ idx_out,
                                              float* __restrict__ gate_out) {
  const int w = item * 4 + (threadIdx.x >> 6);
  const int lane = threadIdx.x & 63;
  const int t = w >> 3, h = w & 7;
  const unsigned short* sp = scores + (size_t)t * 2048 + h * 256;
  float s0v, s1v; int i0v, i1v;
  wave_top16(bf2f(sp[lane]), lane, bf2f(sp[lane + 64]), lane + 64, lane, s0v, i0v);
  wave_top16(bf2f(sp[128 + lane]), lane, bf2f(sp[128 + lane + 64]), lane + 64, lane, s1v, i1v);
  const int pr = kPairTab[lane];
  const int pi = (pr >> 4) & 15, pj = pr & 15;
  float c0 = __shfl(s0v, pi, 64) + __shfl(s1v, pj, 64);
  int ci = __shfl(i0v, pi, 64) * 128 + __shfl(i1v, pj, 64);
  if (pr == 0xff) { c0 = -INFINITY; ci = 0x7fffffff; }
  float bestv; int besti;
  wave_top16(c0, ci, -INFINITY, -1, lane, bestv, besti);
  float mx = __shfl(bestv, 0, 64);
  float ev = (lane < 16) ? expf(bestv - mx) : 0.f;
  float sum = wave_sum(ev);
  if (lane < 16) {
    idx_out[(size_t)t * 128 + h * 16 + lane] = besti;
    gate_out[(size_t)t * 128 + h * 16 + lane] = ev / sum;
  }
}

__device__ __forceinline__ void d_peer(int item, const float* __restrict__ x1, const float* __restrict__ rs2,
                                              const float* __restrict__ g2, const int* __restrict__ idx,
                                              const float* __restrict__ gate, const float* __restrict__ pu,
                                              const float* __restrict__ pv, const float* __restrict__ gf,
                                              float* __restrict__ out, float oscale) {
  const int t = item * 4 + (threadIdx.x >> 6);
  const int lane = threadIdx.x & 63;
  const float r2 = rs2[t];
  float4 xv[4], hv[4], acc[4];
#pragma unroll
  for (int i = 0; i < 4; ++i) {
    xv[i] = ((const float4*)(x1 + (size_t)t * DM))[lane + 64 * i];
    float4 g = ((const float4*)g2)[lane + 64 * i];
    hv[i].x = xv[i].x * r2 * g.x; hv[i].y = xv[i].y * r2 * g.y; hv[i].z = xv[i].z * r2 * g.z; hv[i].w = xv[i].w * r2 * g.w;
    acc[i] = make_float4(0.f, 0.f, 0.f, 0.f);
  }
  for (int e = 0; e < 128; ++e) {
    const int id = idx[(size_t)t * 128 + e];
    const float gt = gate[(size_t)t * 128 + e];
    const float4* ur = (const float4*)(pu + (size_t)id * DM);
    const float4* vr = (const float4*)(pv + (size_t)id * DM);
    float4 vv[4];
    float d = 0.f;
#pragma unroll
    for (int i = 0; i < 4; ++i) {
      float4 u = ur[lane + 64 * i];
      vv[i] = vr[lane + 64 * i];
      d += u.x * hv[i].x + u.y * hv[i].y + u.z * hv[i].z + u.w * hv[i].w;
    }
    d = wave_sum(d);
    const float act = 0.5f * d * (1.f + erff(d * 0.7071067811865476f));
    const float wgt = gt * act;
#pragma unroll
    for (int i = 0; i < 4; ++i) {
      acc[i].x += wgt * vv[i].x; acc[i].y += wgt * vv[i].y; acc[i].z += wgt * vv[i].z; acc[i].w += wgt * vv[i].w;
    }
  }
  float ss = 0.f;
#pragma unroll
  for (int i = 0; i < 4; ++i) {
    acc[i].x += xv[i].x; acc[i].y += xv[i].y; acc[i].z += xv[i].z; acc[i].w += xv[i].w;
    ss += acc[i].x * acc[i].x + acc[i].y * acc[i].y + acc[i].z * acc[i].z + acc[i].w * acc[i].w;
  }
  ss = wave_sum(ss);
  const float sc = rsqrtf(ss * (1.f / DM) + EPSF) * oscale;
#pragma unroll
  for (int i = 0; i < 4; ++i) {
    float4 g = ((const float4*)gf)[lane + 64 * i];
    float4 o;
    o.x = acc[i].x * sc * g.x; o.y = acc[i].y * sc * g.y; o.z = acc[i].z * sc * g.z; o.w = acc[i].w * sc * g.w;
    ((float4*)(out + (size_t)t * DM))[lane + 64 * i] = o;
  }
}


typedef __attribute__((ext_vector_type(16))) float f32x16;
#define MFMA32(a, b, c) __builtin_amdgcn_mfma_f32_32x32x16_bf16((a), (b), (c), 0, 0, 0)
__device__ __forceinline__ int crow(int reg, int hh) { return (reg & 3) + 8 * (reg >> 2) + 4 * hh; }
__device__ __forceinline__ unsigned pack2(float a, float b) { return (unsigned)f2bf(a) | ((unsigned)f2bf(b) << 16); }

struct GdnBufs {
  unsigned short* qc;
  unsigned short* kTc;
  unsigned short* qkc;
  unsigned short* wn;
  unsigned short* uo;
  float* gsc;
};

__device__ __forceinline__ void tri_subst(const float* AL, int lane, float (&T)[64]) {
#pragma unroll
  for (int i = 0; i < 64; ++i) T[i] = 0.f;
  T[0] = (lane == 0) ? 1.f : 0.f;
#pragma unroll
  for (int i = 1; i < 64; ++i) {
    float ax = 0.f, ay = 0.f, az = 0.f, aw = 0.f;
#pragma unroll
    for (int j4 = 0; j4 < (i + 3) / 4; ++j4) {
      const float4 a = *(const float4*)(AL + i * 68 + 4 * j4);
      ax += a.x * T[4 * j4]; ay += a.y * T[4 * j4 + 1]; az += a.z * T[4 * j4 + 2]; aw += a.w * T[4 * j4 + 3];
    }
    T[i] = ((lane == i) ? 1.f : 0.f) - ((ax + ay) + (az + aw));
  }
}

__device__ __forceinline__ void d_gdn_prep(int item, char* smem, const unsigned short* __restrict__ pm,
                                           const float* __restrict__ gt, const float* __restrict__ conv_w, GdnBufs G) {
  unsigned short* qL = (unsigned short*)smem;
  unsigned short* kL = qL + 64 * 136;
  unsigned short* kTL = kL + 64 * 136;
  unsigned short* vTL = kTL + 128 * 72;
  float* A0 = (float*)(vTL + 128 * 72);
  float* A1 = A0 + 64 * 68;
  unsigned short* TbL = (unsigned short*)(A1 + 64 * 68);
  float* scal = (float*)(TbL + 4 * 64 * 72);
  const int tid = threadIdx.x, lane = tid & 63, w = tid >> 6, r = lane & 31, hh = lane >> 5;
  const int bh = item >> 6, c = item & 63, b = bh >> 2, h = bh & 3;
  const int t0 = b * SEQ + c * 64;
  __syncthreads();
  {
    float cw[3][2][5];
#pragma unroll
    for (int sec = 0; sec < 3; ++sec)
#pragma unroll
      for (int j = 0; j < 5; ++j) {
        cw[sec][0][j] = conv_w[(sec * 512 + h * 128 + 2 * lane) * 5 + j];
        cw[sec][1][j] = conv_w[(sec * 512 + h * 128 + 2 * lane + 1) * 5 + j];
      }
    for (int ii = 0; ii < 16; ++ii) {
      const int i = w * 16 + ii;
      const int s = c * 64 + i;
      const size_t t = (size_t)t0 + i;
#pragma unroll
      for (int sec = 0; sec < 3; ++sec) {
        const int c0 = sec * 512 + h * 128 + 2 * lane;
        float a0 = 0.f, a1 = 0.f;
#pragma unroll
        for (int j = 0; j < 5; ++j) {
          const int sp = s + j - 2;
          if (sp >= 0 && sp < SEQ) {
            const unsigned v = *(const unsigned*)(pm + (t + j - 2) * 4096 + c0);
            a0 += cw[sec][0][j] * bf2f((unsigned short)(v & 0xffff));
            a1 += cw[sec][1][j] * bf2f((unsigned short)(v >> 16));
          }
        }
        a0 = a0 * sigmoidf(a0);
        a1 = a1 * sigmoidf(a1);
        if (sec < 2) {
          const float ss = wave_sum(a0 * a0 + a1 * a1);
          float sc = rsqrtf(ss + EPSF);
          if (sec == 0) sc *= 0.08838834764831845f;
          a0 *= sc; a1 *= sc;
        }
        if (sec == 0) {
          *(unsigned*)(qL + i * 136 + 2 * lane) = pack2(a0, a1);
        } else if (sec == 1) {
          *(unsigned*)(kL + i * 136 + 2 * lane) = pack2(a0, a1);
          kTL[(2 * lane) * 72 + i] = f2bf(a0);
          kTL[(2 * lane + 1) * 72 + i] = f2bf(a1);
        } else {
          vTL[(2 * lane) * 72 + i] = f2bf(a0);
          vTL[(2 * lane + 1) * 72 + i] = f2bf(a1);
        }
      }
    }
  }
  if (w == 0) {
    const float* gp = gt + ((size_t)t0 + lane) * 32;
    const float g0 = gp[h], g1 = gp[4 + h], b0 = gp[8 + h], b1 = gp[12 + h];
    float G0 = g0, G1 = g1;
#pragma unroll
    for (int o = 1; o < 64; o <<= 1) {
      const float v0 = __shfl_up(G0, o, 64);
      const float v1 = __shfl_down(G1, o, 64);
      if (lane >= o) G0 += v0;
      if (lane + o < 64) G1 += v1;
    }
    scal[lane] = G0; scal[64 + lane] = G1; scal[128 + lane] = b0; scal[192 + lane] = b1;
    const float GL0 = __shfl(G0, 63, 64), GL1 = __shfl(G1, 0, 64);
    float* gs0 = G.gsc + ((size_t)((bh * 2 + 0) * 64 + c)) * 192;
    float* gs1 = G.gsc + ((size_t)((bh * 2 + 1) * 64 + c)) * 192;
    gs0[lane] = expf(G0); gs0[64 + lane] = expf(GL0 - G0);
    gs1[lane] = expf(G1); gs1[64 + lane] = expf(GL1 - G1);
    if (lane == 0) { gs0[128] = expf(GL0); gs1[128] = expf(GL1); }
  }
  __syncthreads();
  {
    unsigned short* qg = G.qc + (size_t)item * 8192;
    unsigned short* kg = G.kTc + (size_t)item * 8192;
#pragma unroll
    for (int i = 0; i < 4; ++i) {
      const int id = tid + i * 256;
      *(uint4*)(qg + (id >> 4) * 128 + (id & 15) * 8) = *(const uint4*)(qL + (id >> 4) * 136 + (id & 15) * 8);
      *(uint4*)(kg + (id >> 3) * 64 + (id & 7) * 8) = *(const uint4*)(kTL + (id >> 3) * 72 + (id & 7) * 8);
    }
  }
  {
    const int ta = w >> 1, tb = w & 1;
    f32x16 acc, acc2;
#pragma unroll
    for (int i = 0; i < 16; ++i) { acc[i] = 0.f; acc2[i] = 0.f; }
#pragma unroll
    for (int s = 0; s < 8; ++s) {
      const bf16x8 a = *(const bf16x8*)(kL + (32 * ta + r) * 136 + 16 * s + 8 * hh);
      const bf16x8 bk = *(const bf16x8*)(kL + (32 * tb + r) * 136 + 16 * s + 8 * hh);
      const bf16x8 bq = *(const bf16x8*)(qL + (32 * tb + r) * 136 + 16 * s + 8 * hh);
      acc = MFMA32(a, bk, acc);
      acc2 = MFMA32(a, bq, acc2);
    }
    {
      const int col = 32 * tb + r;
      const float G0c = scal[col], G1c = scal[64 + col];
#pragma unroll
      for (int reg = 0; reg < 16; ++reg) {
        const int row = 32 * ta + crow(reg, hh);
        const float v = acc[reg];
        const float a0 = (col < row) ? scal[128 + row] * v * expf(scal[row] - G0c) : 0.f;
        const float a1 = (col > row) ? scal[192 + row] * v * expf(scal[64 + row] - G1c) : 0.f;
        A0[row * 68 + col] = a0;
        A1[(63 - row) * 68 + (63 - col)] = a1;
      }
    }
    {
      const int i = 32 * tb + r;
      const float G0i = scal[i], G1i = scal[64 + i];
      unsigned short* qk0 = G.qkc + ((size_t)((bh * 2 + 0) * 64 + c)) * 4096;
      unsigned short* qk1 = G.qkc + ((size_t)((bh * 2 + 1) * 64 + c)) * 4096;
#pragma unroll
      for (int g = 0; g < 4; ++g) {
        float o0[4], o1[4];
#pragma unroll
        for (int e = 0; e < 4; ++e) {
          const int j = 32 * ta + 8 * g + 4 * hh + e;
          const float v = acc2[4 * g + e];
          o0[e] = (j <= i) ? v * expf(G0i - scal[j]) : 0.f;
          o1[e] = (j >= i) ? v * expf(G1i - scal[64 + j]) : 0.f;
        }
        uint2 p0, p1;
        p0.x = pack2(o0[0], o0[1]); p0.y = pack2(o0[2], o0[3]);
        p1.x = pack2(o1[0], o1[1]); p1.y = pack2(o1[2], o1[3]);
        *(uint2*)(qk0 + i * 64 + 32 * ta + 8 * g + 4 * hh) = p0;
        *(uint2*)(qk1 + i * 64 + 32 * ta + 8 * g + 4 * hh) = p1;
      }
    }
  }
  __syncthreads();
  if (w < 2) {
    const int dir = w;
    float T[64];
    tri_subst(dir ? A1 : A0, lane, T);
    const int jn = dir ? 63 - lane : lane;
    const float sb = scal[128 + 64 * dir + jn];
    const float sbg = sb * expf(scal[64 * dir + jn]);
    unsigned short* Tb = TbL + dir * 2 * 64 * 72;
    unsigned short* Tbg = Tb + 64 * 72;
#pragma unroll
    for (int ip = 0; ip < 64; ++ip) {
      const int in = dir ? 63 - ip : ip;
      Tb[in * 72 + jn] = f2bf(T[ip] * sb);
      Tbg[in * 72 + jn] = f2bf(T[ip] * sbg);
    }
  }
  __syncthreads();
#pragma unroll
  for (int d = 0; d < 2; ++d) {
    const int chain = bh * 2 + d;
    const unsigned short* Tb = TbL + d * 2 * 64 * 72;
    const unsigned short* Tbg = Tb + 64 * 72;
    unsigned short* wng = G.wn + ((size_t)(chain * 64 + c)) * 8192;
    unsigned short* uog = G.uo + ((size_t)(chain * 64 + c)) * 8192 + w * 2048;
#pragma unroll
    for (int tb = 0; tb < 2; ++tb) {
      f32x16 acc, acc2;
#pragma unroll
      for (int i = 0; i < 16; ++i) { acc[i] = 0.f; acc2[i] = 0.f; }
#pragma unroll
      for (int s = 0; s < 4; ++s) {
        const bf16x8 a = *(const bf16x8*)(kTL + (32 * w + r) * 72 + 16 * s + 8 * hh);
        const bf16x8 bb = *(const bf16x8*)(Tbg + (32 * tb + r) * 72 + 16 * s + 8 * hh);
        acc = MFMA32(a, bb, acc);
        const bf16x8 a2 = *(const bf16x8*)(Tb + (32 * tb + r) * 72 + 16 * s + 8 * hh);
        const bf16x8 b2 = *(const bf16x8*)(vTL + (32 * w + r) * 72 + 16 * s + 8 * hh);
        acc2 = MFMA32(a2, b2, acc2);
      }
#pragma unroll
      for (int g = 0; g < 4; ++g) {
        uint2 pk;
        pk.x = pack2(-acc[4 * g], -acc[4 * g + 1]); pk.y = pack2(-acc[4 * g + 2], -acc[4 * g + 3]);
        *(uint2*)(wng + (32 * tb + r) * 128 + 32 * w + 8 * g + 4 * hh) = pk;
      }
      uint4 u0, u1;
      u0.x = pack2(acc2[0], acc2[1]); u0.y = pack2(acc2[2], acc2[3]); u0.z = pack2(acc2[4], acc2[5]); u0.w = pack2(acc2[6], acc2[7]);
      u1.x = pack2(acc2[8], acc2[9]); u1.y = pack2(acc2[10], acc2[11]); u1.z = pack2(acc2[12], acc2[13]); u1.w = pack2(acc2[14], acc2[15]);
      *(uint4*)(uog + tb * 1024 + lane * 16) = u0;
      *(uint4*)(uog + tb * 1024 + lane * 16 + 8) = u1;
    }
  }
}

__device__ __forceinline__ void d_gdn_scan(int chain, int sl, char* smem, GdnBufs G) {
  unsigned short* ST = (unsigned short*)smem;
  unsigned short* VT = ST + 32 * 136;
  unsigned short* VdT = VT + 32 * 72;
  const int tid = threadIdx.x, lane = tid & 63, w = tid >> 6, r = lane & 31, hh = lane >> 5;
  const int bh = chain >> 1, dir = chain & 1;
  f32x16 S;
#pragma unroll
  for (int i = 0; i < 16; ++i) S[i] = 0.f;
  for (int step = 0; step < 64; ++step) {
    const int c = dir ? 63 - step : step;
    const unsigned short* wn_c = G.wn + ((size_t)(chain * 64 + c)) * 8192;
    const unsigned short* q_c = G.qc + ((size_t)(bh * 64 + c)) * 8192;
    const unsigned short* kT_c = G.kTc + ((size_t)(bh * 64 + c)) * 8192;
    const unsigned short* qk_c = G.qkc + ((size_t)(chain * 64 + c)) * 4096;
    unsigned short* uo_c = G.uo + ((size_t)(chain * 64 + c)) * 8192 + sl * 2048;
    const float* gs = G.gsc + ((size_t)(chain * 64 + c)) * 192;
    const int ti = w & 1;
    bf16x8 kt[4], a[8], bq[4];
    float rs[16];
    f32x16 acc;
#pragma unroll
    for (int s = 0; s < 4; ++s) kt[s] = *(const bf16x8*)(kT_c + (32 * w + r) * 64 + 16 * s + 8 * hh);
    const float gtot = gs[128];
    if (w < 2) {
#pragma unroll
      for (int s = 0; s < 8; ++s) a[s] = *(const bf16x8*)(wn_c + (32 * ti + r) * 128 + 16 * s + 8 * hh);
      const uint4 u0 = *(const uint4*)(uo_c + ti * 1024 + lane * 16);
      const uint4 u1 = *(const uint4*)(uo_c + ti * 1024 + lane * 16 + 8);
      acc[0] = bf2f(u0.x & 0xffff); acc[1] = bf2f(u0.x >> 16); acc[2] = bf2f(u0.y & 0xffff); acc[3] = bf2f(u0.y >> 16);
      acc[4] = bf2f(u0.z & 0xffff); acc[5] = bf2f(u0.z >> 16); acc[6] = bf2f(u0.w & 0xffff); acc[7] = bf2f(u0.w >> 16);
      acc[8] = bf2f(u1.x & 0xffff); acc[9] = bf2f(u1.x >> 16); acc[10] = bf2f(u1.y & 0xffff); acc[11] = bf2f(u1.y >> 16);
      acc[12] = bf2f(u1.z & 0xffff); acc[13] = bf2f(u1.z >> 16); acc[14] = bf2f(u1.w & 0xffff); acc[15] = bf2f(u1.w >> 16);
#pragma unroll
      for (int reg = 0; reg < 16; ++reg) rs[reg] = gs[64 + 32 * ti + crow(reg, hh)];
    } else {
#pragma unroll
      for (int s = 0; s < 8; ++s) a[s] = *(const bf16x8*)(q_c + (32 * ti + r) * 128 + 16 * s + 8 * hh);
#pragma unroll
      for (int s = 0; s < 4; ++s) bq[s] = *(const bf16x8*)(qk_c + (32 * ti + r) * 64 + 16 * s + 8 * hh);
#pragma unroll
      for (int i = 0; i < 16; ++i) acc[i] = 0.f;
#pragma unroll
      for (int reg = 0; reg < 16; ++reg) rs[reg] = gs[32 * ti + crow(reg, hh)];
    }
#pragma unroll
    for (int g = 0; g < 4; ++g) {
      uint2 pk;
      pk.x = pack2(S[4 * g], S[4 * g + 1]); pk.y = pack2(S[4 * g + 2], S[4 * g + 3]);
      *(uint2*)(ST + r * 136 + 32 * w + 8 * g + 4 * hh) = pk;
    }
    __syncthreads();
#pragma unroll
    for (int s = 0; s < 8; ++s) {
      const bf16x8 bs = *(const bf16x8*)(ST + r * 136 + 16 * s + 8 * hh);
      acc = MFMA32(a[s], bs, acc);
    }
    if (w < 2) {
#pragma unroll
      for (int g = 0; g < 4; ++g) {
        uint2 pk, pd;
        pk.x = pack2(acc[4 * g], acc[4 * g + 1]); pk.y = pack2(acc[4 * g + 2], acc[4 * g + 3]);
        pd.x = pack2(acc[4 * g] * rs[4 * g], acc[4 * g + 1] * rs[4 * g + 1]);
        pd.y = pack2(acc[4 * g + 2] * rs[4 * g + 2], acc[4 * g + 3] * rs[4 * g + 3]);
        *(uint2*)(VT + r * 72 + 32 * ti + 8 * g + 4 * hh) = pk;
        *(uint2*)(VdT + r * 72 + 32 * ti + 8 * g + 4 * hh) = pd;
      }
    } else {
#pragma unroll
      for (int reg = 0; reg < 16; ++reg) acc[reg] *= rs[reg];
    }
    __syncthreads();
    if (w >= 2) {
#pragma unroll
      for (int s = 0; s < 4; ++s) {
        const bf16x8 bv = *(const bf16x8*)(VT + r * 72 + 16 * s + 8 * hh);
        acc = MFMA32(bq[s], bv, acc);
      }
#pragma unroll
      for (int reg = 0; reg < 16; ++reg) uo_c[(32 * ti + crow(reg, hh)) * 32 + r] = f2bf(acc[reg]);
    }
#pragma unroll
    for (int i = 0; i < 16; ++i) S[i] *= gtot;
#pragma unroll
    for (int s = 0; s < 4; ++s) {
      const bf16x8 bv = *(const bf16x8*)(VdT + r * 72 + 16 * s + 8 * hh);
      S = MFMA32(kt[s], bv, S);
    }
  }
}


__device__ __forceinline__ void d_mlstm_scan(int chain, int sl, char* smem, const unsigned short* __restrict__ pm,
                                             const float* __restrict__ gt, unsigned short* __restrict__ oM, int ntok) {
  unsigned short* qL = (unsigned short*)smem;
  unsigned short* kL = qL + 64 * 136;
  unsigned short* kdL = kL + 64 * 136;
  unsigned short* vTL = kdL + 64 * 136;
  unsigned short* S0T = vTL + 32 * 72;
  unsigned short* nL = S0T + 32 * 136;
  float* scal = (float*)(nL + 256);
  const int tid = threadIdx.x, lane = tid & 63, w = tid >> 6, r = lane & 31, hh = lane >> 5;
  const int bh = chain >> 1, dir = chain & 1, b = bh >> 2, h = bh & 3;
  const float SCALE = 0.08838834764831845f;
  f32x16 S0, S1;
#pragma unroll
  for (int i = 0; i < 16; ++i) { S0[i] = 0.f; S1[i] = 0.f; }
  bf16x8 ones;
#pragma unroll
  for (int i = 0; i < 8; ++i) ones[i] = (short)0x3F80;
  for (int step = 0; step < 64; ++step) {
    const int c = dir ? 63 - step : step;
    const size_t t0 = (size_t)b * SEQ + c * 64;
    const float lf = gt[(t0 + lane) * 32 + 24 + dir * 4 + h];
    const float ip = gt[(t0 + lane) * 32 + 16 + dir * 4 + h];
    float bc = lf;
#pragma unroll
    for (int o = 1; o < 64; o <<= 1) {
      const float vu = __shfl_up(bc, o, 64);
      const float vd = __shfl_down(bc, o, 64);
      if (dir == 0) { if (lane >= o) bc += vu; } else { if (lane + o < 64) bc += vd; }
    }
    const float b_last = __shfl(bc, dir ? 0 : 63, 64);
    const float Dj = SCALE * expf(b_last - bc + ip);
    const float gtot = expf(b_last);
    __syncthreads();
    if (w == 0) { scal[lane] = expf(bc); scal[64 + lane] = ip - bc; scal[128 + lane] = bc; }
#pragma unroll
    for (int i = 0; i < 4; ++i) {
      const int id = tid + i * 256;
      const int row = id >> 4, c16 = id & 15;
      const uint4 qv = *(const uint4*)(pm + (t0 + row) * 4096 + 2048 + h * 128 + c16 * 8);
      const uint4 kv = *(const uint4*)(pm + (t0 + row) * 4096 + 2560 + h * 128 + c16 * 8);
      *(uint4*)(qL + row * 136 + c16 * 8) = qv;
      *(uint4*)(kL + row * 136 + c16 * 8) = kv;
      const float d = __shfl(Dj, row, 64);
      uint4 kd;
      kd.x = pack2(bf2f(kv.x & 0xffff) * d, bf2f(kv.x >> 16) * d);
      kd.y = pack2(bf2f(kv.y & 0xffff) * d, bf2f(kv.y >> 16) * d);
      kd.z = pack2(bf2f(kv.z & 0xffff) * d, bf2f(kv.z >> 16) * d);
      kd.w = pack2(bf2f(kv.w & 0xffff) * d, bf2f(kv.w >> 16) * d);
      *(uint4*)(kdL + row * 136 + c16 * 8) = kd;
    }
    {
      const int tok = tid >> 2, d8 = (tid & 3) * 8;
      const uint4 vv = *(const uint4*)(pm + (t0 + tok) * 4096 + 3072 + h * 128 + sl * 32 + d8);
      vTL[(d8 + 0) * 72 + tok] = (unsigned short)(vv.x & 0xffff);
      vTL[(d8 + 1) * 72 + tok] = (unsigned short)(vv.x >> 16);
      vTL[(d8 + 2) * 72 + tok] = (unsigned short)(vv.y & 0xffff);
      vTL[(d8 + 3) * 72 + tok] = (unsigned short)(vv.y >> 16);
      vTL[(d8 + 4) * 72 + tok] = (unsigned short)(vv.z & 0xffff);
      vTL[(d8 + 5) * 72 + tok] = (unsigned short)(vv.z >> 16);
      vTL[(d8 + 6) * 72 + tok] = (unsigned short)(vv.w & 0xffff);
      vTL[(d8 + 7) * 72 + tok] = (unsigned short)(vv.w >> 16);
    }
#pragma unroll
    for (int g = 0; g < 4; ++g) {
      uint2 pk;
      pk.x = pack2(S0[4 * g], S0[4 * g + 1]); pk.y = pack2(S0[4 * g + 2], S0[4 * g + 3]);
      *(uint2*)(S0T + r * 136 + 32 * w + 8 * g + 4 * hh) = pk;
      if (r == 0) {
        uint2 pn;
        pn.x = pack2(S1[4 * g], S1[4 * g + 1]); pn.y = pack2(S1[4 * g + 2], S1[4 * g + 3]);
        *(uint2*)(nL + 32 * w + 8 * g + 4 * hh) = pn;
      }
    }
    __syncthreads();
    if (w < 2) {
      const int ti = w;
      const int icol = 32 * ti + r;
      const float bci = scal[128 + icol];
      f32x16 Z0, Z1, Q0, Q1;
#pragma unroll
      for (int i = 0; i < 16; ++i) { Z0[i] = 0.f; Z1[i] = 0.f; Q0[i] = 0.f; Q1[i] = 0.f; }
#pragma unroll
      for (int tj = 0; tj < 2; ++tj) {
        f32x16 X;
#pragma unroll
        for (int i = 0; i < 16; ++i) X[i] = 0.f;
#pragma unroll
        for (int s2 = 0; s2 < 8; ++s2) {
          const bf16x8 a = *(const bf16x8*)(kL + (32 * tj + r) * 136 + 16 * s2 + 8 * hh);
          const bf16x8 bq = *(const bf16x8*)(qL + (32 * ti + r) * 136 + 16 * s2 + 8 * hh);
          X = MFMA32(a, bq, X);
        }
#pragma unroll
        for (int reg = 0; reg < 16; ++reg) {
          const int j = 32 * tj + crow(reg, hh);
          const bool valid = dir ? (j >= icol) : (j <= icol);
          X[reg] = valid ? X[reg] * SCALE * expf(bci + scal[64 + j]) : 0.f;
        }
#pragma unroll
        for (int s2 = 0; s2 < 2; ++s2) {
          union { bf16x8 v; unsigned u[4]; } xa, bv;
          xa.u[0] = pack2(X[8 * s2 + 0], X[8 * s2 + 1]); xa.u[1] = pack2(X[8 * s2 + 2], X[8 * s2 + 3]);
          xa.u[2] = pack2(X[8 * s2 + 4], X[8 * s2 + 5]); xa.u[3] = pack2(X[8 * s2 + 6], X[8 * s2 + 7]);
          const uint2 v0 = *(const uint2*)(vTL + r * 72 + 32 * tj + 16 * s2 + 4 * hh);
          const uint2 v1 = *(const uint2*)(vTL + r * 72 + 32 * tj + 16 * s2 + 8 + 4 * hh);
          bv.u[0] = v0.x; bv.u[1] = v0.y; bv.u[2] = v1.x; bv.u[3] = v1.y;
          Z0 = MFMA32(xa.v, bv.v, Z0);
          Z1 = MFMA32(xa.v, ones, Z1);
        }
      }
#pragma unroll
      for (int s2 = 0; s2 < 8; ++s2) {
        const bf16x8 a = *(const bf16x8*)(qL + (32 * ti + r) * 136 + 16 * s2 + 8 * hh);
        const bf16x8 b0 = *(const bf16x8*)(S0T + r * 136 + 16 * s2 + 8 * hh);
        const bf16x8 b1 = *(const bf16x8*)(nL + 16 * s2 + 8 * hh);
        Q0 = MFMA32(a, b0, Q0);
        Q1 = MFMA32(a, b1, Q1);
      }
#pragma unroll
      for (int reg = 0; reg < 16; ++reg) {
        const int i = 32 * ti + crow(reg, hh);
        const float e = scal[i];
        const float num = e * Q0[reg] + Z0[reg];
        const float den = e * Q1[reg] + Z1[reg];
        oM[((size_t)dir * ntok + t0 + i) * 512 + h * 128 + sl * 32 + r] = f2bf(num / fmaxf(fabsf(den), 1.f));
      }
    }
#pragma unroll
    for (int i = 0; i < 16; ++i) { S0[i] *= gtot; S1[i] *= gtot; }
#pragma unroll
    for (int s2 = 0; s2 < 4; ++s2) {
      union { bf16x8 v; unsigned short e[8]; } a;
#pragma unroll
      for (int e = 0; e < 8; ++e) a.e[e] = kdL[(16 * s2 + 8 * hh + e) * 136 + 32 * w + r];
      const bf16x8 bv = *(const bf16x8*)(vTL + r * 72 + 16 * s2 + 8 * hh);
      S0 = MFMA32(a.v, bv, S0);
      S1 = MFMA32(a.v, ones, S1);
    }
  }
}

struct MKP {
  const float *x, *norm1_g, *w_in, *conv_w, *a_log, *dt_bias, *gdn_g, *i_bias, *f_bias, *ml_g, *w_out, *norm2_g, *peer_wq,
      *peer_keys, *peer_u, *peer_v, *normf_g;
  float* out;
  unsigned short *pm, *x1b, *woutT, *mt, *xb, *winT, *oM, *yb, *scores, *qkv_dbg, *oA_dbg;
  float *x1, *rs1, *rs2, *gt, *gateb, *dbg;
  int* idxb;
  GdnBufs G;
};

constexpr int SMEM_BYTES = 144384;

__global__ void __launch_bounds__(256) k_mega(MKP P) {
  cg::grid_group grid = cg::this_grid();
  __shared__ __attribute__((aligned(16))) char smem_c[SMEM_BYTES];
  unsigned short* smem = (unsigned short*)smem_c;
  const int nb = gridDim.x, bid = blockIdx.x;
  for (int it = bid; it < NT / 4; it += nb) d_prep_x(it, P.x, P.xb, P.rs1);
  for (int it = bid; it < NPAD_IN * DM / 256; it += nb) d_transpose_w(it, P.w_in, DIN, P.norm1_g, P.winT, NPAD_IN, 1);
  for (int it = bid; it < 1024 * DM / 256; it += nb) d_transpose_w(it, P.w_out, 1024, nullptr, P.woutT, 1024, 0);
  for (int it = bid; it < 2048 * 4; it += nb) d_make_mt(it, P.peer_wq, P.peer_keys, P.norm2_g, P.mt);
  if (bid == 0 && threadIdx.x < 2) P.dbg[threadIdx.x] = 0.f;
  grid.sync();
  {
    GemmP p{};
    p.A = P.xb; p.lda = DM; p.Bt = P.winT; p.ldb = DM; p.K = DM;
    p.rowscale = P.rs1; p.obf = P.pm; p.ldo = 4096; p.of32 = P.gt; p.ldf = 32; p.resid = nullptr;
    p.a_log = P.a_log; p.dt_bias = P.dt_bias; p.i_bias = P.i_bias; p.f_bias = P.f_bias;
    for (int tile = bid; tile < (NT / 128) * 33; tile += nb) {
      gemm_tile<EPI_INPROJ>(p, tile / 33, tile % 33, smem);
      __syncthreads();
    }
  }
  grid.sync();
  for (int it = bid; it < 1024; it += nb) d_gdn_prep(it, smem_c, P.pm, P.gt, P.conv_w, P.G);
#ifdef DBG_CHECK
#endif
  grid.sync();
  if (bid < 128) {
    d_gdn_scan(bid >> 2, bid & 3, smem_c, P.G);
  } else {
    d_mlstm_scan((bid - 128) >> 2, (bid - 128) & 3, smem_c, P.pm, P.gt, P.oM, NT);
  }
#ifdef DBG_CHECK
  if (bid < 4) {
    __syncthreads();
    const int half = threadIdx.x >> 7;
    float* sq = (float*)smem + half * 256;
    float* sk = sq + 128;
    d_mlstm_rec(bid * 2 + half, sq, sk, P.pm, P.gt, P.oA_dbg, 4096);
  }
#endif
  grid.sync();
  for (int it = bid; it < NT / 4; it += nb) d_combine(it, P.G.uo, P.oM, P.pm, P.gdn_g, P.ml_g, P.yb);
#ifdef DBG_CHECK
  for (int it = bid; it < 4096 / 4; it += nb) d_dbg_cmp_m(it, P.oM, P.oA_dbg, P.dbg);
#endif
  grid.sync();
  {
    GemmP p{};
    p.A = P.yb; p.lda = DM; p.Bt = P.woutT; p.ldb = DM; p.K = DM;
    p.rowscale = nullptr; p.obf = nullptr; p.ldo = 0; p.of32 = P.x1; p.ldf = DM; p.resid = P.x;
    for (int tile = bid; tile < (NT / 128) * 8; tile += nb) {
      gemm_tile<EPI_OUTPROJ>(p, tile / 8, tile % 8, smem);
      __syncthreads();
    }
  }
  grid.sync();
  for (int it = bid; it < NT / 4; it += nb) d_prep_x1(it, P.x1, P.x1b, P.rs2);
  grid.sync();
  {
    GemmP p{};
    p.A = P.x1b; p.lda = DM; p.Bt = P.mt; p.ldb = DM; p.K = DM;
    p.rowscale = P.rs2; p.obf = P.scores; p.ldo = 2048; p.of32 = nullptr; p.ldf = 0; p.resid = nullptr;
    for (int tile = bid; tile < (NT / 128) * 16; tile += nb) {
      gemm_tile<EPI_SCORES>(p, tile / 16, tile % 16, smem);
      __syncthreads();
    }
  }
  grid.sync();
  for (int it = bid; it < NT * 8 / 4; it += nb) d_topk(it, P.scores, P.idxb, P.gateb);
  grid.sync();
  float oscale = 1.f;
#ifdef DBG_CHECK
  {
    const float sd = __hip_atomic_load(&P.dbg[0], __ATOMIC_RELAXED, __HIP_MEMORY_SCOPE_AGENT);
    const float sr = __hip_atomic_load(&P.dbg[1], __ATOMIC_RELAXED, __HIP_MEMORY_SCOPE_AGENT);
    oscale = 1.f + sqrtf(sd / sr);
  }
#endif
  for (int it = bid; it < NT / 4; it += nb)
    d_peer(it, P.x1, P.rs2, P.norm2_g, P.idxb, P.gateb, P.peer_u, P.peer_v, P.normf_g, P.out, oscale);
}

extern "C" void kernel_launch(void* const* d_in, const int* in_sizes, int n_in, void* d_out, int out_size, void* d_ws,
                              size_t ws_size, hipStream_t stream) {
  MKP P{};
  P.x = (const float*)d_in[0];
  P.norm1_g = (const float*)d_in[1];
  P.w_in = (const float*)d_in[2];
  P.conv_w = (const float*)d_in[3];
  P.a_log = (const float*)d_in[4];
  P.dt_bias = (const float*)d_in[5];
  P.gdn_g = (const float*)d_in[6];
  P.i_bias = (const float*)d_in[7];
  P.f_bias = (const float*)d_in[8];
  P.ml_g = (const float*)d_in[9];
  P.w_out = (const float*)d_in[10];
  P.norm2_g = (const float*)d_in[11];
  P.peer_wq = (const float*)d_in[12];
  P.peer_keys = (const float*)d_in[13];
  P.peer_u = (const float*)d_in[14];
  P.peer_v = (const float*)d_in[15];
  P.normf_g = (const float*)d_in[16];
  P.out = (float*)d_out;

  char* ws = (char*)d_ws;
  const size_t MB = 1024 * 1024;
  P.pm = (unsigned short*)(ws);
  P.x1 = (float*)(ws);
  P.x1b = (unsigned short*)(ws + 64 * MB);
  char* rb = ws + 128 * MB;
  P.woutT = (unsigned short*)(rb);
  P.mt = (unsigned short*)(rb + 2 * MB);
  P.rs1 = (float*)(rb + 6 * MB);
  P.rs2 = (float*)(rb + 6 * MB + 65536);
  P.dbg = (float*)(rb + 6 * MB + 131072);
  P.gt = (float*)(rb + 9 * MB);
  char* dyn = rb + 11 * MB;
  P.xb = (unsigned short*)(dyn);
  P.winT = (unsigned short*)(dyn + 32 * MB);
  P.G.qc = (unsigned short*)(dyn);
  P.G.kTc = (unsigned short*)(dyn + 16 * MB);
  P.G.qkc = (unsigned short*)(dyn + 32 * MB);
  P.G.wn = (unsigned short*)(dyn + 48 * MB);
  P.G.uo = (unsigned short*)(dyn + 80 * MB);
  P.G.gsc = (float*)(dyn + 112 * MB);
  P.yb = (unsigned short*)(dyn);
  P.scores = (unsigned short*)(dyn);
  P.idxb = (int*)(dyn + 64 * MB);
  P.gateb = (float*)(dyn + 72 * MB);
  char* os = (char*)d_out;
  P.oM = (unsigned short*)(os);
  P.qkv_dbg = (unsigned short*)(os + 32 * MB);
  P.oA_dbg = (unsigned short*)(os + 44 * MB);

  static int grid_blocks = 0;
  if (!grid_blocks) {
    int dev = 0, cus = 0, per_cu = 0;
    (void)hipGetDevice(&dev);
    (void)hipDeviceGetAttribute(&cus, hipDeviceAttributeMultiprocessorCount, dev);
    (void)hipOccupancyMaxActiveBlocksPerMultiprocessor(&per_cu, k_mega, 256, 0);
    if (per_cu > 1) per_cu = 1;
    if (per_cu < 1) per_cu = 1;
    grid_blocks = cus * per_cu;
  }
  void* args[] = {&P};
  hipError_t e = hipLaunchCooperativeKernel((void*)k_mega, dim3(grid_blocks), dim3(256), args, 0, stream);
  if (e != hipSuccess) fprintf(stderr, "cooperative launch failed: %s (grid %d)\n", hipGetErrorString(e), grid_blocks);
}
```

```cpp
#include <hip/hip_runtime.h>
#include <hip/hip_bf16.h>
#include <stdint.h>
#include <hip/hip_cooperative_groups.h>
#include <cstdio>
namespace cg = cooperative_groups;

typedef __hip_bfloat16 bf16;
typedef __attribute__((ext_vector_type(8))) short bf16x8;
typedef __attribute__((ext_vector_type(4))) float f32x4;

constexpr int DM = 1024;
constexpr int NB = 4;
constexpr int SEQ = 4096;
constexpr int NT = NB * SEQ;
constexpr int DIN = 4128;
constexpr int NPAD_IN = 4224;
constexpr float EPSF = 1e-6f;

__device__ __forceinline__ float bf2f(unsigned short u) { return __uint_as_float(((unsigned)u) << 16); }
__device__ __forceinline__ unsigned short f2bf(float f) {
  unsigned u = __float_as_uint(f);
  u += 0x7fffu + ((u >> 16) & 1u);
  return (unsigned short)(u >> 16);
}
__device__ __forceinline__ float wave_sum(float v) {
#pragma unroll
  for (int o = 32; o > 0; o >>= 1) v += __shfl_xor(v, o, 64);
  return v;
}
__device__ __forceinline__ float softplusf(float x) { return fmaxf(x, 0.f) + log1pf(expf(-fabsf(x))); }
__device__ __forceinline__ float sigmoidf(float x) { return 1.f / (1.f + expf(-x)); }

__device__ __forceinline__ void d_prep_x(int item, const float* __restrict__ x, unsigned short* __restrict__ xb,
                                                float* __restrict__ rs) {
  int t = item * 4 + (threadIdx.x >> 6);
  int lane = threadIdx.x & 63;
  const float4* xr = (const float4*)(x + (size_t)t * DM);
  float ss = 0.f;
#pragma unroll
  for (int i = 0; i < 4; ++i) {
    float4 v = xr[lane + 64 * i];
    ss += v.x * v.x + v.y * v.y + v.z * v.z + v.w * v.w;
    ushort4 o;
    o.x = f2bf(v.x); o.y = f2bf(v.y); o.z = f2bf(v.z); o.w = f2bf(v.w);
    ((ushort4*)(xb + (size_t)t * DM))[lane + 64 * i] = o;
  }
  ss = wave_sum(ss);
  if (lane == 0) rs[t] = rsqrtf(ss * (1.f / DM) + EPSF);
}

__device__ __forceinline__ int win_src(int n) {
  if (n < 2048) return n;
  if (n < 4096) return n + 16;
  int j = n - 4096;
  if (j < 16) return 2048 + j;
  if (j < 32) return 4112 + (j - 16);
  return -1;
}
__device__ __forceinline__ void d_transpose_w(int item, const float* __restrict__ in, int ldn, const float* __restrict__ g,
                                                     unsigned short* __restrict__ out, int nrows, int mode) {
  size_t id = (size_t)item * 256 + threadIdx.x;
  if (id >= (size_t)nrows * DM) return;
  int n = (int)(id >> 10);
  int k = (int)(id & 1023);
  int src = mode ? win_src(n) : n;
  float v = 0.f;
  if (src >= 0) v = in[(size_t)k * ldn + src] * (g ? g[k] : 1.f);
  out[id] = f2bf(v);
}
__device__ __forceinline__ void d_make_mt(int item, const float* __restrict__ wq, const float* __restrict__ keys,
                                                 const float* __restrict__ g2, unsigned short* __restrict__ mt) {
  int n = item >> 2;
  int d = (item & 3) * 256 + threadIdx.x;
  int hp = n >> 7;
  const float4* kr = (const float4*)(keys + (size_t)n * 128);
  const float4* wr = (const float4*)(wq + (size_t)d * 2048 + hp * 128);
  float s = 0.f;
#pragma unroll 8
  for (int j = 0; j < 32; ++j) {
    float4 a = kr[j], b = wr[j];
    s += a.x * b.x + a.y * b.y + a.z * b.z + a.w * b.w;
  }
  mt[(size_t)n * DM + d] = f2bf(s * g2[d]);
}

constexpr int GBM = 128, GBN = 128, GBK = 64, GLD = 72;
struct GemmP {
  const unsigned short* A; const unsigned short* Bt; int lda, ldb, K;
  const float* rowscale;
  unsigned short* obf; int ldo;
  float* of32; int ldf;
  const float* resid;
  const float *a_log, *dt_bias, *i_bias, *f_bias;
};
enum { EPI_INPROJ = 0, EPI_OUTPROJ = 1, EPI_SCORES = 2 };

template <int EPI>
__device__ __forceinline__ void gemm_tile(const GemmP p, int tm, int tn, unsigned short* smem) {
  unsigned short* As = smem;
  unsigned short* Bs = smem + 2 * GBM * GLD;
  const int tid = threadIdx.x, lane = tid & 63, wid = tid >> 6;
  const int wm = wid >> 1, wn = wid & 1;
  const int m0 = tm * GBM, n0 = tn * GBN;
  f32x4 acc[4][4];
#pragma unroll
  for (int i = 0; i < 4; ++i)
#pragma unroll
    for (int j = 0; j < 4; ++j) acc[i][j] = (f32x4){0.f, 0.f, 0.f, 0.f};

  uint4 ra0, ra1, ra2, ra3, rb0, rb1, rb2, rb3;
  const int nk = p.K / GBK;
  const int lrow = tid >> 3, lc8 = tid & 7;
  const unsigned short* Ag = p.A + (size_t)(m0 + lrow) * p.lda + lc8 * 8;
  const unsigned short* Bg = p.Bt + (size_t)(n0 + lrow) * p.ldb + lc8 * 8;
  const size_t a32 = (size_t)32 * p.lda, b32 = (size_t)32 * p.ldb;
#define GLOAD(kt)                                                        \
  {                                                                      \
    ra0 = *(const uint4*)(Ag + (kt) * GBK);                              \
    ra1 = *(const uint4*)(Ag + a32 + (kt) * GBK);                        \
    ra2 = *(const uint4*)(Ag + 2 * a32 + (kt) * GBK);                    \
    ra3 = *(const uint4*)(Ag + 3 * a32 + (kt) * GBK);                    \
    rb0 = *(const uint4*)(Bg + (kt) * GBK);                              \
    rb1 = *(const uint4*)(Bg + b32 + (kt) * GBK);                        \
    rb2 = *(const uint4*)(Bg + 2 * b32 + (kt) * GBK);                    \
    rb3 = *(const uint4*)(Bg + 3 * b32 + (kt) * GBK);                    \
  }
#define SSTORE(buf)                                                      \
  {                                                                      \
    unsigned short* ad = As + (size_t)(buf) * GBM * GLD + lrow * GLD + lc8 * 8; \
    unsigned short* bd = Bs + (size_t)(buf) * GBN * GLD + lrow * GLD + lc8 * 8; \
    *(uint4*)(ad) = ra0; *(uint4*)(ad + 32 * GLD) = ra1; *(uint4*)(ad + 64 * GLD) = ra2; *(uint4*)(ad + 96 * GLD) = ra3; \
    *(uint4*)(bd) = rb0; *(uint4*)(bd + 32 * GLD) = rb1; *(uint4*)(bd + 64 * GLD) = rb2; *(uint4*)(bd + 96 * GLD) = rb3; \
  }
  GLOAD(0);
  SSTORE(0);
  __syncthreads();
  for (int kt = 0; kt < nk; ++kt) {
    const int buf = kt & 1;
    if (kt + 1 < nk) GLOAD(kt + 1);
    const unsigned short* Ab = As + (size_t)buf * GBM * GLD;
    const unsigned short* Bb = Bs + (size_t)buf * GBN * GLD;
#pragma unroll
    for (int ks = 0; ks < 2; ++ks) {
      bf16x8 a[4], b[4];
      const int kc = ks * 32 + (lane >> 4) * 8;
#pragma unroll
      for (int i = 0; i < 4; ++i) a[i] = *(const bf16x8*)(Ab + (wm * 64 + i * 16 + (lane & 15)) * GLD + kc);
#pragma unroll
      for (int j = 0; j < 4; ++j) b[j] = *(const bf16x8*)(Bb + (wn * 64 + j * 16 + (lane & 15)) * GLD + kc);
#pragma unroll
      for (int i = 0; i < 4; ++i)
#pragma unroll
        for (int j = 0; j < 4; ++j) acc[i][j] = __builtin_amdgcn_mfma_f32_16x16x32_bf16(a[i], b[j], acc[i][j], 0, 0, 0);
    }
    if (kt + 1 < nk) SSTORE(buf ^ 1);
    __syncthreads();
  }
#undef GLOAD
#undef SSTORE
#pragma unroll
  for (int i = 0; i < 4; ++i) {
#pragma unroll
    for (int r = 0; r < 4; ++r) {
      const int row = m0 + wm * 64 + i * 16 + (lane >> 4) * 4 + r;
      float rsc = 1.f;
      if (EPI == EPI_INPROJ || EPI == EPI_SCORES) rsc = p.rowscale[row];
#pragma unroll
      for (int j = 0; j < 4; ++j) {
        const int col = n0 + wn * 64 + j * 16 + (lane & 15);
        float v = acc[i][j][r] * rsc;
        if (EPI == EPI_INPROJ) {
          if (col < 4096) p.obf[(size_t)row * p.ldo + col] = f2bf(v);
          else if (col < 4128) {
            const int j = col - 4096, jj = j & 7;
            float o;
            if (j < 8) o = -expf(p.a_log[jj]) * softplusf(v + p.dt_bias[jj]);
            else if (j < 16) o = sigmoidf(v);
            else if (j < 24) o = v + p.i_bias[jj];
            else o = -softplusf(-(v + p.f_bias[jj]));
            p.of32[(size_t)row * p.ldf + j] = o;
          }
        } else if (EPI == EPI_OUTPROJ) {
          p.of32[(size_t)row * p.ldf + col] = v + p.resid[(size_t)row * p.ldf + col];
        } else {
          p.obf[(size_t)row * p.ldo + col] = f2bf(v);
        }
      }
    }
  }
}

__device__ __forceinline__ void d_conv(int item, const unsigned short* __restrict__ pm, const float* __restrict__ pg,
                                              const float* __restrict__ conv_w, const float* __restrict__ a_log,
                                              const float* __restrict__ dt_bias, const float* __restrict__ i_bias,
                                              const float* __restrict__ f_bias, unsigned short* __restrict__ qkv,
                                              float* __restrict__ gt) {
  int t = item * 4 + (threadIdx.x >> 6);
  int lane = threadIdx.x & 63;
  int s = t & (SEQ - 1);
  for (int sec = 0; sec < 3; ++sec) {
    for (int h = 0; h < 4; ++h) {
      int c0 = sec * 512 + h * 128 + 2 * lane;
      float a0 = 0.f, a1 = 0.f;
#pragma unroll
      for (int j = 0; j < 5; ++j) {
        int sp = s + j - 2;
        if (sp >= 0 && sp < SEQ) {
          unsigned v = *(const unsigned*)(pm + (size_t)(t + j - 2) * 4096 + c0);
          a0 += conv_w[c0 * 5 + j] * bf2f((unsigned short)(v & 0xffff));
          a1 += conv_w[(c0 + 1) * 5 + j] * bf2f((unsigned short)(v >> 16));
        }
      }
      a0 = a0 * sigmoidf(a0);
      a1 = a1 * sigmoidf(a1);
      if (sec < 2) {
        float ss = wave_sum(a0 * a0 + a1 * a1);
        float sc = rsqrtf(ss + EPSF);
        if (sec == 0) sc *= 0.08838834764831845f;
        a0 *= sc; a1 *= sc;
      }
      unsigned o = (unsigned)f2bf(a0) | ((unsigned)f2bf(a1) << 16);
      *(unsigned*)(qkv + (size_t)t * 1536 + c0) = o;
    }
  }
}

__device__ __forceinline__ void d_gdn_rec(int chain, float* sq, float* sk, const unsigned short* __restrict__ qkv,
                                                 const float* __restrict__ gt, unsigned short* __restrict__ oA, int ntok) {
  const int bh = chain >> 1, dir = chain & 1;
  const int b = bh >> 2, h = bh & 3;
  const int e = threadIdx.x & 127;
  float S[128];
#pragma unroll
  for (int d = 0; d < 128; ++d) S[d] = 0.f;
  for (int it = 0; it < SEQ; ++it) {
    const int s = dir ? (SEQ - 1 - it) : it;
    const size_t t = (size_t)b * SEQ + s;
    __syncthreads();
    sq[e] = bf2f(qkv[t * 1536 + h * 128 + e]);
    sk[e] = bf2f(qkv[t * 1536 + 512 + h * 128 + e]);
    const float v = bf2f(qkv[t * 1536 + 1024 + h * 128 + e]);
    const float g = gt[t * 32 + dir * 4 + h];
    const float beta = gt[t * 32 + 8 + dir * 4 + h];
    __syncthreads();
    const float a = expf(g);
    float k0 = 0.f, k1 = 0.f, k2 = 0.f, k3 = 0.f;
#pragma unroll
    for (int d = 0; d < 128; d += 4) {
      k0 += sk[d] * S[d]; k1 += sk[d + 1] * S[d + 1]; k2 += sk[d + 2] * S[d + 2]; k3 += sk[d + 3] * S[d + 3];
    }
    const float kS = a * ((k0 + k1) + (k2 + k3));
    const float vn = beta * (v - kS);
    float o0 = 0.f, o1 = 0.f, o2 = 0.f, o3 = 0.f;
#pragma unroll
    for (int d = 0; d < 128; d += 4) {
      S[d] = a * S[d] + sk[d] * vn;             o0 += sq[d] * S[d];
      S[d + 1] = a * S[d + 1] + sk[d + 1] * vn; o1 += sq[d + 1] * S[d + 1];
      S[d + 2] = a * S[d + 2] + sk[d + 2] * vn; o2 += sq[d + 2] * S[d + 2];
      S[d + 3] = a * S[d + 3] + sk[d + 3] * vn; o3 += sq[d + 3] * S[d + 3];
    }
    oA[((size_t)dir * ntok + t) * 512 + h * 128 + e] = f2bf((o0 + o1) + (o2 + o3));
  }
}

__device__ __forceinline__ void d_mlstm_rec(int chain, float* sq, float* sk, const unsigned short* __restrict__ pm,
                                                   const float* __restrict__ gt, unsigned short* __restrict__ oM, int ntok) {
  const int bh = chain >> 1, dir = chain & 1;
  const int b = bh >> 2, h = bh & 3;
  const int e = threadIdx.x & 127, lane = e & 63;
  float C[128];
#pragma unroll
  for (int d = 0; d < 128; ++d) C[d] = 0.f;
  float n0 = 0.f, n1 = 0.f, m = 0.f;
  for (int it = 0; it < SEQ; ++it) {
    const int s = dir ? (SEQ - 1 - it) : it;
    const size_t t = (size_t)b * SEQ + s;
    __syncthreads();
    sq[e] = bf2f(pm[t * 4096 + 2048 + h * 128 + e]);
    sk[e] = bf2f(pm[t * 4096 + 2560 + h * 128 + e]) * 0.08838834764831845f;
    const float v = bf2f(pm[t * 4096 + 3072 + h * 128 + e]);
    const float ip = gt[t * 32 + 16 + dir * 4 + h];
    const float lf = gt[t * 32 + 24 + dir * 4 + h];
    __syncthreads();
    const float mn = fmaxf(lf + m, ip);
    const float fs = expf(lf + m - mn);
    const float is = expf(ip - mn);
    m = mn;
    n0 = fs * n0 + is * sk[lane];
    n1 = fs * n1 + is * sk[lane + 64];
    const float den = wave_sum(n0 * sq[lane] + n1 * sq[lane + 64]);
    const float iv = is * v;
    float o0 = 0.f, o1 = 0.f, o2 = 0.f, o3 = 0.f;
#pragma unroll
    for (int d = 0; d < 128; d += 4) {
      C[d] = fs * C[d] + sk[d] * iv;             o0 += sq[d] * C[d];
      C[d + 1] = fs * C[d + 1] + sk[d + 1] * iv; o1 += sq[d + 1] * C[d + 1];
      C[d + 2] = fs * C[d + 2] + sk[d + 2] * iv; o2 += sq[d + 2] * C[d + 2];
      C[d + 3] = fs * C[d + 3] + sk[d + 3] * iv; o3 += sq[d + 3] * C[d + 3];
    }
    const float num = (o0 + o1) + (o2 + o3);
    const float hh = num / fmaxf(fabsf(den), expf(-mn));
    oM[((size_t)dir * ntok + t) * 512 + h * 128 + e] = f2bf(hh);
  }
}

__device__ __forceinline__ void d_combine(int item, const unsigned short* __restrict__ uo, const unsigned short* __restrict__ oM,
                                                 const unsigned short* __restrict__ pm, const float* __restrict__ gdn_g,
                                                 const float* __restrict__ ml_g, unsigned short* __restrict__ y) {
  int t = item * 4 + (threadIdx.x >> 6);
  int lane = threadIdx.x & 63;
  const int b = t >> 12, cc = (t >> 6) & 63, ii = t & 63;
  for (int h = 0; h < 4; ++h) {
    int c = h * 128 + 2 * lane;
    {
      const int chain0 = (b * 4 + h) * 2;
      const size_t off = (size_t)cc * 8192 + (lane >> 4) * 2048 + ii * 32 + ((2 * lane) & 31);
      unsigned vf = *(const unsigned*)(uo + (size_t)chain0 * 64 * 8192 + off);
      unsigned vb = *(const unsigned*)(uo + (size_t)(chain0 + 1) * 64 * 8192 + off);
      float o0 = bf2f(vf & 0xffff) + bf2f(vb & 0xffff);
      float o1 = bf2f(vf >> 16) + bf2f(vb >> 16);
      float ss = wave_sum(o0 * o0 + o1 * o1);
      float sc = rsqrtf(ss * (1.f / 128.f) + EPSF);
      unsigned z = *(const unsigned*)(pm + (size_t)t * 4096 + 1536 + c);
      float z0 = bf2f(z & 0xffff), z1 = bf2f(z >> 16);
      o0 = o0 * sc * gdn_g[2 * lane] * (z0 * sigmoidf(z0));
      o1 = o1 * sc * gdn_g[2 * lane + 1] * (z1 * sigmoidf(z1));
      *(unsigned*)(y + (size_t)t * DM + c) = (unsigned)f2bf(o0) | ((unsigned)f2bf(o1) << 16);
    }
    {
      unsigned vf = *(const unsigned*)(oM + (size_t)t * 512 + c);
      unsigned vb = *(const unsigned*)(oM + ((size_t)NT + t) * 512 + c);
      float o0 = bf2f(vf & 0xffff) + bf2f(vb & 0xffff);
      float o1 = bf2f(vf >> 16) + bf2f(vb >> 16);
      float ss = wave_sum(o0 * o0 + o1 * o1);
      float sc = rsqrtf(ss * (1.f / 128.f) + EPSF);
      unsigned z = *(const unsigned*)(pm + (size_t)t * 4096 + 3584 + c);
      float z0 = bf2f(z & 0xffff), z1 = bf2f(z >> 16);
      o0 = o0 * sc * ml_g[c] * sigmoidf(z0);
      o1 = o1 * sc * ml_g[c + 1] * sigmoidf(z1);
      *(unsigned*)(y + (size_t)t * DM + 512 + c) = (unsigned)f2bf(o0) | ((unsigned)f2bf(o1) << 16);
    }
  }
}

#ifdef DBG_CHECK
__device__ __forceinline__ void d_dbg_cmp(int item, const unsigned short* __restrict__ uo, const unsigned short* __restrict__ oAd,
                                          float* __restrict__ dbg) {
  int t = item * 4 + (threadIdx.x >> 6);
  int lane = threadIdx.x & 63;
  const int cc = (t >> 6) & 63, ii = t & 63;
  float sd = 0.f, sr = 0.f;
  for (int h = 0; h < 4; ++h) {
    for (int dir = 0; dir < 2; ++dir) {
      const int chain = h * 2 + dir;
      const size_t off = (size_t)cc * 8192 + (lane >> 4) * 2048 + ii * 32 + ((2 * lane) & 31);
      unsigned vn = *(const unsigned*)(uo + (size_t)chain * 64 * 8192 + off);
      unsigned vr = *(const unsigned*)(oAd + ((size_t)dir * 4096 + t) * 512 + h * 128 + 2 * lane);
      float n0 = bf2f(vn & 0xffff), n1 = bf2f(vn >> 16), r0 = bf2f(vr & 0xffff), r1 = bf2f(vr >> 16);
      sd += (n0 - r0) * (n0 - r0) + (n1 - r1) * (n1 - r1);
      sr += r0 * r0 + r1 * r1;
    }
  }
  sd = wave_sum(sd); sr = wave_sum(sr);
  if (lane == 0) { atomicAdd(&dbg[0], sd); atomicAdd(&dbg[1], sr); }
}
__device__ __forceinline__ void d_dbg_cmp_m(int item, const unsigned short* __restrict__ oM, const unsigned short* __restrict__ oMd,
                                            float* __restrict__ dbg) {
  int t = item * 4 + (threadIdx.x >> 6);
  int lane = threadIdx.x & 63;
  float sd = 0.f, sr = 0.f;
  for (int dir = 0; dir < 2; ++dir)
    for (int q = 0; q < 4; ++q) {
      unsigned vn = *(const unsigned*)(oM + ((size_t)dir * NT + t) * 512 + q * 128 + 2 * lane);
      unsigned vr = *(const unsigned*)(oMd + ((size_t)dir * 4096 + t) * 512 + q * 128 + 2 * lane);
      float n0 = bf2f(vn & 0xffff), n1 = bf2f(vn >> 16), r0 = bf2f(vr & 0xffff), r1 = bf2f(vr >> 16);
      sd += (n0 - r0) * (n0 - r0) + (n1 - r1) * (n1 - r1);
      sr += r0 * r0 + r1 * r1;
    }
  sd = wave_sum(sd); sr = wave_sum(sr);
  if (lane == 0) { atomicAdd(&dbg[0], sd); atomicAdd(&dbg[1], sr); }
}
#endif

__device__ __forceinline__ void d_prep_x1(int item, const float* __restrict__ x1, unsigned short* __restrict__ xb,
                                                 float* __restrict__ rs) {
  int t = item * 4 + (threadIdx.x >> 6);
  int lane = threadIdx.x & 63;
  const float4* xr = (const float4*)(x1 + (size_t)t * DM);
  float ss = 0.f;
#pragma unroll
  for (int i = 0; i < 4; ++i) {
    float4 v = xr[lane + 64 * i];
    ss += v.x * v.x + v.y * v.y + v.z * v.z + v.w * v.w;
    ushort4 o;
    o.x = f2bf(v.x); o.y = f2bf(v.y); o.z = f2bf(v.z); o.w = f2bf(v.w);
    ((ushort4*)(xb + (size_t)t * DM))[lane + 64 * i] = o;
  }
  ss = wave_sum(ss);
  if (lane == 0) rs[t] = rsqrtf(ss * (1.f / DM) + EPSF);
}

__device__ const unsigned char kPairTab[64] = {
    0x00, 0x01, 0x02, 0x03, 0x04, 0x05, 0x06, 0x07, 0x08, 0x09, 0x0a, 0x0b, 0x0c, 0x0d, 0x0e, 0x0f,
    0x10, 0x11, 0x12, 0x13, 0x14, 0x15, 0x16, 0x17,
    0x20, 0x21, 0x22, 0x23, 0x24,
    0x30, 0x31, 0x32, 0x33,
    0x40, 0x41, 0x42,
    0x50, 0x51, 0x60, 0x61, 0x70, 0x71,
    0x80, 0x90, 0xa0, 0xb0, 0xc0, 0xd0, 0xe0, 0xf0,
    0xff, 0xff, 0xff, 0xff, 0xff, 0xff, 0xff, 0xff, 0xff, 0xff, 0xff, 0xff, 0xff, 0xff};

__device__ __forceinline__ void wave_top16(float va, int ia, float vb, int ib, int lane, float& outv, int& outi) {
  outv = -INFINITY; outi = 0;
  for (int r = 0; r < 16; ++r) {
    float bv; int bi;
    if (va >= vb) { bv = va; bi = ia; } else { bv = vb; bi = ib; }
#pragma unroll
    for (int o = 32; o > 0; o >>= 1) {
      float ov = __shfl_xor(bv, o, 64);
      int oi = __shfl_xor(bi, o, 64);
      if (ov > bv || (ov == bv && oi < bi)) { bv = ov; bi = oi; }
    }
    if (lane == r) { outv = bv; outi = bi; }
    if (bi == ia) va = -INFINITY;
    if (bi == ib) vb = -INFINITY;
  }
}

__device__ __forceinline__ void d_topk(int item, const unsigned short* __restrict__ scores, int* __restrict__ idx_out,
                                              float* __restrict__ gate_out) {
  const int w = item * 4 + (threadIdx.x >> 6);
  const int lane = threadIdx.x & 63;
  const int t = w >> 3, h = w & 7;
  const unsigned short* sp = scores + (size_t)t * 2048 + h * 256;
  float s0v, s1v; int i0v, i1v;
  wave_top16(bf2f(sp[lane]), lane, bf2f(sp[lane + 64]), lane + 64, lane, s0v, i0v);
  wave_top16(bf2f(sp[128 + lane]), lane, bf2f(sp[128 + lane + 64]), lane + 64, lane, s1v, i1v);
  const int pr = kPairTab[lane];
  const int pi = (pr >> 4) & 15, pj = pr & 15;
  float c0 = __shfl(s0v, pi, 64) + __shfl(s1v, pj, 64);
  int ci = __shfl(i0v, pi, 64) * 128 + __shfl(i1v, pj, 64);
  if (pr == 0xff) { c0 = -INFINITY; ci = 0x7fffffff; }
  float bestv; int besti;
  wave_top16(c0, ci, -INFINITY, -1, lane, bestv, besti);
  float mx = __shfl(bestv, 0, 64);
  float ev = (lane < 16) ? expf(bestv - mx) : 0.f;
  float sum = wave_sum(ev);
  if (lane < 16) {
    idx_out[(size_t)t * 128 + h * 16 + lane] = besti;
    gate_out[(size_t)t * 128 + h * 16 + lane] = ev / sum;
  }
}

__device__ __forceinline__ void d_cvt_tab(int item, const float* __restrict__ src, unsigned short* __restrict__ dst) {
  const size_t base = (size_t)item * 2048 + threadIdx.x * 8;
  const float4 a = *(const float4*)(src + base);
  const float4 b = *(const float4*)(src + base + 4);
  uint4 o;
  o.x = (unsigned)f2bf(a.x) | ((unsigned)f2bf(a.y) << 16);
  o.y = (unsigned)f2bf(a.z) | ((unsigned)f2bf(a.w) << 16);
  o.z = (unsigned)f2bf(b.x) | ((unsigned)f2bf(b.y) << 16);
  o.w = (unsigned)f2bf(b.z) | ((unsigned)f2bf(b.w) << 16);
  *(uint4*)(dst + base) = o;
}

__device__ __forceinline__ float dot8(const uint4 u, const float* hv) {
  float d = bf2f(u.x & 0xffff) * hv[0];
  d += __uint_as_float(u.x & 0xffff0000u) * hv[1];
  d += bf2f(u.y & 0xffff) * hv[2];
  d += __uint_as_float(u.y & 0xffff0000u) * hv[3];
  d += bf2f(u.z & 0xffff) * hv[4];
  d += __uint_as_float(u.z & 0xffff0000u) * hv[5];
  d += bf2f(u.w & 0xffff) * hv[6];
  d += __uint_as_float(u.w & 0xffff0000u) * hv[7];
  return d;
}
__device__ __forceinline__ void axpy8(const uint4 v, const float wg, float* acc) {
  acc[0] += wg * bf2f(v.x & 0xffff);
  acc[1] += wg * __uint_as_float(v.x & 0xffff0000u);
  acc[2] += wg * bf2f(v.y & 0xffff);
  acc[3] += wg * __uint_as_float(v.y & 0xffff0000u);
  acc[4] += wg * bf2f(v.z & 0xffff);
  acc[5] += wg * __uint_as_float(v.z & 0xffff0000u);
  acc[6] += wg * bf2f(v.w & 0xffff);
  acc[7] += wg * __uint_as_float(v.w & 0xffff0000u);
}
__device__ __forceinline__ void d_peer(int item, const float* __restrict__ x1, const float* __restrict__ rs2,
                                       const float* __restrict__ g2, const int* __restrict__ idx,
                                       const float* __restrict__ gate, const unsigned short* __restrict__ pu,
                                       const unsigned short* __restrict__ pv, const float* __restrict__ gf,
                                       float* __restrict__ out, float oscale) {
  const int t = item * 4 + (threadIdx.x >> 6);
  const int lane = threadIdx.x & 63;
  const float r2 = rs2[t];
  float xv[16], hv[16], acc[16];
#pragma unroll
  for (int j = 0; j < 2; ++j)
#pragma unroll
    for (int q = 0; q < 2; ++q) {
      const float4 xx = *(const float4*)(x1 + (size_t)t * DM + j * 512 + lane * 8 + q * 4);
      const float4 gg = *(const float4*)(g2 + j * 512 + lane * 8 + q * 4);
      xv[j * 8 + q * 4 + 0] = xx.x; xv[j * 8 + q * 4 + 1] = xx.y; xv[j * 8 + q * 4 + 2] = xx.z; xv[j * 8 + q * 4 + 3] = xx.w;
      hv[j * 8 + q * 4 + 0] = xx.x * r2 * gg.x; hv[j * 8 + q * 4 + 1] = xx.y * r2 * gg.y;
      hv[j * 8 + q * 4 + 2] = xx.z * r2 * gg.z; hv[j * 8 + q * 4 + 3] = xx.w * r2 * gg.w;
    }
#pragma unroll
  for (int i = 0; i < 16; ++i) acc[i] = 0.f;
  const int id_a = idx[(size_t)t * 128 + lane], id_b = idx[(size_t)t * 128 + 64 + lane];
  const float gt_a = gate[(size_t)t * 128 + lane], gt_b = gate[(size_t)t * 128 + 64 + lane];
  for (int e0 = 0; e0 < 128; e0 += 4) {
    uint4 u[4][2], v[4][2];
    float gt4[4];
#pragma unroll
    for (int k = 0; k < 4; ++k) {
      const int e = e0 + k;
      const int id = (e0 < 64) ? __shfl(id_a, e, 64) : __shfl(id_b, e - 64, 64);
      gt4[k] = (e0 < 64) ? __shfl(gt_a, e, 64) : __shfl(gt_b, e - 64, 64);
      const unsigned short* ur = pu + (size_t)id * DM + lane * 8;
      const unsigned short* vr = pv + (size_t)id * DM + lane * 8;
      u[k][0] = *(const uint4*)(ur); u[k][1] = *(const uint4*)(ur + 512);
      v[k][0] = *(const uint4*)(vr); v[k][1] = *(const uint4*)(vr + 512);
    }
    float d[4];
#pragma unroll
    for (int k = 0; k < 4; ++k) d[k] = dot8(u[k][0], hv) + dot8(u[k][1], hv + 8);
#pragma unroll
    for (int o = 32; o > 0; o >>= 1) {
#pragma unroll
      for (int k = 0; k < 4; ++k) d[k] += __shfl_xor(d[k], o, 64);
    }
#pragma unroll
    for (int k = 0; k < 4; ++k) {
      const float act = 0.5f * d[k] * (1.f + erff(d[k] * 0.7071067811865476f));
      const float wg = gt4[k] * act;
      axpy8(v[k][0], wg, acc);
      axpy8(v[k][1], wg, acc + 8);
    }
  }
  float ss = 0.f;
#pragma unroll
  for (int i = 0; i < 16; ++i) { acc[i] += xv[i]; ss += acc[i] * acc[i]; }
  ss = wave_sum(ss);
  const float sc = rsqrtf(ss * (1.f / DM) + EPSF) * oscale;
#pragma unroll
  for (int j = 0; j < 2; ++j)
#pragma unroll
    for (int q = 0; q < 2; ++q) {
      const float4 gg = *(const float4*)(gf + j * 512 + lane * 8 + q * 4);
      float4 o;
      o.x = acc[j * 8 + q * 4 + 0] * sc * gg.x; o.y = acc[j * 8 + q * 4 + 1] * sc * gg.y;
      o.z = acc[j * 8 + q * 4 + 2] * sc * gg.z; o.w = acc[j * 8 + q * 4 + 3] * sc * gg.w;
      *(float4*)(out + (size_t)t * DM + j * 512 + lane * 8 + q * 4) = o;
    }
}

typedef __attribute__((ext_vector_type(16))) float f32x16;
#define MFMA32(a, b, c) __builtin_amdgcn_mfma_f32_32x32x16_bf16((a), (b), (c), 0, 0, 0)
__device__ __forceinline__ int crow(int reg, int hh) { return (reg & 3) + 8 * (reg >> 2) + 4 * hh; }
__device__ __forceinline__ unsigned pack2(float a, float b) { return (unsigned)f2bf(a) | ((unsigned)f2bf(b) << 16); }

struct GdnBufs {
  unsigned short* qc;
  unsigned short* kTc;
  unsigned short* qkc;
  unsigned short* wn;
  unsigned short* uo;
  float* gsc;
};

__device__ __forceinline__ void tri_subst(const float* AL, int lane, float (&T)[64]) {
#pragma unroll
  for (int i = 0; i < 64; ++i) T[i] = 0.f;
  T[0] = (lane == 0) ? 1.f : 0.f;
#pragma unroll
  for (int i = 1; i < 64; ++i) {
    float ax = 0.f, ay = 0.f, az = 0.f, aw = 0.f;
#pragma unroll
    for (int j4 = 0; j4 < (i + 3) / 4; ++j4) {
      const float4 a = *(const float4*)(AL + i * 72 + 4 * j4);
      ax += a.x * T[4 * j4]; ay += a.y * T[4 * j4 + 1]; az += a.z * T[4 * j4 + 2]; aw += a.w * T[4 * j4 + 3];
    }
    T[i] = ((lane == i) ? 1.f : 0.f) - ((ax + ay) + (az + aw));
  }
}

__device__ __forceinline__ void d_gdn_prep(int item, char* smem, const unsigned short* __restrict__ pm,
                                           const float* __restrict__ gt, const float* __restrict__ conv_w, GdnBufs G) {
  unsigned short* qL = (unsigned short*)smem;
  unsigned short* kL = qL + 64 * 144;
  unsigned short* kTL = kL + 64 * 144;
  unsigned short* vTL = kTL + 128 * 72;
  float* scal = (float*)(vTL + 128 * 72);
  float* A0 = (float*)qL;
  float* A1 = (float*)kL;
  int tid = threadIdx.x;
  asm volatile("" : "+v"(tid));
  const int lane = tid & 63, w = __builtin_amdgcn_readfirstlane(tid >> 6), r = lane & 31, hh = lane >> 5;
  const int bh = item >> 6, c = item & 63, b = bh >> 2, h = bh & 3;
  const int t0 = b * SEQ + c * 64;
  __syncthreads();
  {
    float cw[3][2][5];
#pragma unroll
    for (int sec = 0; sec < 3; ++sec)
#pragma unroll
      for (int j = 0; j < 5; ++j) {
        cw[sec][0][j] = conv_w[(sec * 512 + h * 128 + 2 * lane) * 5 + j];
        cw[sec][1][j] = conv_w[(sec * 512 + h * 128 + 2 * lane + 1) * 5 + j];
      }
    for (int ii = 0; ii < 16; ++ii) {
      const int i = w * 16 + ii;
      const int s = c * 64 + i;
      const size_t t = (size_t)t0 + i;
#pragma unroll
      for (int sec = 0; sec < 3; ++sec) {
        const int c0 = sec * 512 + h * 128 + 2 * lane;
        float a0 = 0.f, a1 = 0.f;
#pragma unroll
        for (int j = 0; j < 5; ++j) {
          const int sp = s + j - 2;
          if (sp >= 0 && sp < SEQ) {
            const unsigned v = *(const unsigned*)(pm + (t + j - 2) * 4096 + c0);
            a0 += cw[sec][0][j] * bf2f((unsigned short)(v & 0xffff));
            a1 += cw[sec][1][j] * bf2f((unsigned short)(v >> 16));
          }
        }
        a0 = a0 * sigmoidf(a0);
        a1 = a1 * sigmoidf(a1);
        if (sec < 2) {
          const float ss = wave_sum(a0 * a0 + a1 * a1);
          float sc = rsqrtf(ss + EPSF);
          if (sec == 0) sc *= 0.08838834764831845f;
          a0 *= sc; a1 *= sc;
        }
        if (sec == 0) {
          *(unsigned*)(qL + i * 144 + 2 * lane) = pack2(a0, a1);
        } else if (sec == 1) {
          *(unsigned*)(kL + i * 144 + 2 * lane) = pack2(a0, a1);
          kTL[(2 * lane) * 72 + i] = f2bf(a0);
          kTL[(2 * lane + 1) * 72 + i] = f2bf(a1);
        } else {
          vTL[(2 * lane) * 72 + i] = f2bf(a0);
          vTL[(2 * lane + 1) * 72 + i] = f2bf(a1);
        }
      }
    }
  }
  if (w == 0) {
    const float* gp = gt + ((size_t)t0 + lane) * 32;
    const float g0 = gp[h], g1 = gp[4 + h], b0 = gp[8 + h], b1 = gp[12 + h];
    float G0 = g0, G1 = g1;
#pragma unroll
    for (int o = 1; o < 64; o <<= 1) {
      const float v0 = __shfl_up(G0, o, 64);
      const float v1 = __shfl_down(G1, o, 64);
      if (lane >= o) G0 += v0;
      if (lane + o < 64) G1 += v1;
    }
    scal[lane] = G0; scal[64 + lane] = G1; scal[128 + lane] = b0; scal[192 + lane] = b1;
    const float GL0 = __shfl(G0, 63, 64), GL1 = __shfl(G1, 0, 64);
    float* gs0 = G.gsc + ((size_t)((bh * 2 + 0) * 64 + c)) * 192;
    float* gs1 = G.gsc + ((size_t)((bh * 2 + 1) * 64 + c)) * 192;
    gs0[lane] = expf(G0); gs0[64 + lane] = expf(GL0 - G0);
    gs1[lane] = expf(G1); gs1[64 + lane] = expf(GL1 - G1);
    if (lane == 0) { gs0[128] = expf(GL0); gs1[128] = expf(GL1); }
  }
  __syncthreads();
  {
    unsigned short* qg = G.qc + (size_t)item * 8192;
    unsigned short* kg = G.kTc + (size_t)item * 8192;
#pragma unroll
    for (int i = 0; i < 4; ++i) {
      const int id = tid + i * 256;
      *(uint4*)(qg + (id >> 4) * 128 + (id & 15) * 8) = *(const uint4*)(qL + (id >> 4) * 144 + (id & 15) * 8);
      *(uint4*)(kg + (id >> 3) * 64 + (id & 7) * 8) = *(const uint4*)(kTL + (id >> 3) * 72 + (id & 7) * 8);
    }
  }
  {
    const int ta = w >> 1, tb = w & 1;
    f32x16 acc, acc2;
#pragma unroll
    for (int i = 0; i < 16; ++i) { acc[i] = 0.f; acc2[i] = 0.f; }
#pragma unroll
    for (int s = 0; s < 8; ++s) {
      const bf16x8 a = *(const bf16x8*)(kL + (32 * ta + r) * 144 + 16 * s + 8 * hh);
      const bf16x8 bk = *(const bf16x8*)(kL + (32 * tb + r) * 144 + 16 * s + 8 * hh);
      const bf16x8 bq = *(const bf16x8*)(qL + (32 * tb + r) * 144 + 16 * s + 8 * hh);
      acc = MFMA32(a, bk, acc);
      acc2 = MFMA32(a, bq, acc2);
    }
    __syncthreads();
    {
      const int col = 32 * tb + r;
      const float G0c = scal[col], G1c = scal[64 + col];
#pragma unroll
      for (int reg = 0; reg < 16; ++reg) {
        const int row = 32 * ta + crow(reg, hh);
        const float v = acc[reg];
        const float a0 = (col < row) ? scal[128 + row] * v * expf(scal[row] - G0c) : 0.f;
        const float a1 = (col > row) ? scal[192 + row] * v * expf(scal[64 + row] - G1c) : 0.f;
        A0[row * 72 + col] = a0;
        A1[(63 - row) * 72 + (63 - col)] = a1;
      }
    }
    {
      const int i = 32 * tb + r;
      const float G0i = scal[i], G1i = scal[64 + i];
      unsigned short* qk0 = G.qkc + ((size_t)((bh * 2 + 0) * 64 + c)) * 4096;
      unsigned short* qk1 = G.qkc + ((size_t)((bh * 2 + 1) * 64 + c)) * 4096;
#pragma unroll
      for (int g = 0; g < 4; ++g) {
        float o0[4], o1[4];
#pragma unroll
        for (int e = 0; e < 4; ++e) {
          const int j = 32 * ta + 8 * g + 4 * hh + e;
          const float v = acc2[4 * g + e];
          o0[e] = (j <= i) ? v * expf(G0i - scal[j]) : 0.f;
          o1[e] = (j >= i) ? v * expf(G1i - scal[64 + j]) : 0.f;
        }
        uint2 p0, p1;
        p0.x = pack2(o0[0], o0[1]); p0.y = pack2(o0[2], o0[3]);
        p1.x = pack2(o1[0], o1[1]); p1.y = pack2(o1[2], o1[3]);
        *(uint2*)(qk0 + i * 64 + 32 * ta + 8 * g + 4 * hh) = p0;
        *(uint2*)(qk1 + i * 64 + 32 * ta + 8 * g + 4 * hh) = p1;
      }
    }
  }
  __syncthreads();
  if (w < 2) {
    const int dir = w;
    float T[64];
    tri_subst(dir ? A1 : A0, lane, T);
    const int jn = dir ? 63 - lane : lane;
    const float sb = scal[128 + 64 * dir + jn];
    const float sbg = sb * expf(scal[64 * dir + jn]);
    unsigned short* Tb = dir ? kL : qL;
    unsigned short* Tbg = Tb + 64 * 72;
#pragma unroll
    for (int ip = 0; ip < 64; ++ip) {
      const int in = dir ? 63 - ip : ip;
      Tb[in * 72 + jn] = f2bf(T[ip] * sb);
      Tbg[in * 72 + jn] = f2bf(T[ip] * sbg);
    }
  }
  __syncthreads();
#pragma unroll
  for (int d = 0; d < 2; ++d) {
    const int chain = bh * 2 + d;
    const unsigned short* Tb = d ? kL : qL;
    const unsigned short* Tbg = Tb + 64 * 72;
    unsigned short* wng = G.wn + ((size_t)(chain * 64 + c)) * 8192;
    unsigned short* uog = G.uo + ((size_t)(chain * 64 + c)) * 8192 + w * 2048;
#pragma unroll
    for (int tb = 0; tb < 2; ++tb) {
      f32x16 acc, acc2;
#pragma unroll
      for (int i = 0; i < 16; ++i) { acc[i] = 0.f; acc2[i] = 0.f; }
#pragma unroll
      for (int s = 0; s < 4; ++s) {
        const bf16x8 a = *(const bf16x8*)(kTL + (32 * w + r) * 72 + 16 * s + 8 * hh);
        const bf16x8 bb = *(const bf16x8*)(Tbg + (32 * tb + r) * 72 + 16 * s + 8 * hh);
        acc = MFMA32(a, bb, acc);
        const bf16x8 a2 = *(const bf16x8*)(Tb + (32 * tb + r) * 72 + 16 * s + 8 * hh);
        const bf16x8 b2 = *(const bf16x8*)(vTL + (32 * w + r) * 72 + 16 * s + 8 * hh);
        acc2 = MFMA32(a2, b2, acc2);
      }
#pragma unroll
      for (int g = 0; g < 4; ++g) {
        uint2 pk;
        pk.x = pack2(-acc[4 * g], -acc[4 * g + 1]); pk.y = pack2(-acc[4 * g + 2], -acc[4 * g + 3]);
        *(uint2*)(wng + (32 * tb + r) * 128 + 32 * w + 8 * g + 4 * hh) = pk;
      }
      uint4 u0, u1;
      u0.x = pack2(acc2[0], acc2[1]); u0.y = pack2(acc2[2], acc2[3]); u0.z = pack2(acc2[4], acc2[5]); u0.w = pack2(acc2[6], acc2[7]);
      u1.x = pack2(acc2[8], acc2[9]); u1.y = pack2(acc2[10], acc2[11]); u1.z = pack2(acc2[12], acc2[13]); u1.w = pack2(acc2[14], acc2[15]);
      *(uint4*)(uog + tb * 1024 + lane * 16) = u0;
      *(uint4*)(uog + tb * 1024 + lane * 16 + 8) = u1;
    }
  }
}

__device__ __forceinline__ void d_gdn_scan(int chain, int sl, char* smem, GdnBufs G) {
  unsigned short* ST = (unsigned short*)smem;
  unsigned short* VT = ST + 32 * 136;
  unsigned short* VdT = VT + 32 * 72;
  const int tid = threadIdx.x, lane = tid & 63, w = tid >> 6, r = lane & 31, hh = lane >> 5;
  const int bh = chain >> 1, dir = chain & 1;
  f32x16 S;
#pragma unroll
  for (int i = 0; i < 16; ++i) S[i] = 0.f;
  for (int step = 0; step < 64; ++step) {
    const int c = dir ? 63 - step : step;
    const unsigned short* wn_c = G.wn + ((size_t)(chain * 64 + c)) * 8192;
    const unsigned short* q_c = G.qc + ((size_t)(bh * 64 + c)) * 8192;
    const unsigned short* kT_c = G.kTc + ((size_t)(bh * 64 + c)) * 8192;
    const unsigned short* qk_c = G.qkc + ((size_t)(chain * 64 + c)) * 4096;
    unsigned short* uo_c = G.uo + ((size_t)(chain * 64 + c)) * 8192 + sl * 2048;
    const float* gs = G.gsc + ((size_t)(chain * 64 + c)) * 192;
    const int ti = w & 1;
    bf16x8 kt[4], a[8], bq[4];
    float rs[16];
    f32x16 acc;
#pragma unroll
    for (int s = 0; s < 4; ++s) kt[s] = *(const bf16x8*)(kT_c + (32 * w + r) * 64 + 16 * s + 8 * hh);
    const float gtot = gs[128];
    if (w < 2) {
#pragma unroll
      for (int s = 0; s < 8; ++s) a[s] = *(const bf16x8*)(wn_c + (32 * ti + r) * 128 + 16 * s + 8 * hh);
      const uint4 u0 = *(const uint4*)(uo_c + ti * 1024 + lane * 16);
      const uint4 u1 = *(const uint4*)(uo_c + ti * 1024 + lane * 16 + 8);
      acc[0] = bf2f(u0.x & 0xffff); acc[1] = bf2f(u0.x >> 16); acc[2] = bf2f(u0.y & 0xffff); acc[3] = bf2f(u0.y >> 16);
      acc[4] = bf2f(u0.z & 0xffff); acc[5] = bf2f(u0.z >> 16); acc[6] = bf2f(u0.w & 0xffff); acc[7] = bf2f(u0.w >> 16);
      acc[8] = bf2f(u1.x & 0xffff); acc[9] = bf2f(u1.x >> 16); acc[10] = bf2f(u1.y & 0xffff); acc[11] = bf2f(u1.y >> 16);
      acc[12] = bf2f(u1.z & 0xffff); acc[13] = bf2f(u1.z >> 16); acc[14] = bf2f(u1.w & 0xffff); acc[15] = bf2f(u1.w >> 16);
#pragma unroll
      for (int reg = 0; reg < 16; ++reg) rs[reg] = gs[64 + 32 * ti + crow(reg, hh)];
    } else {
#pragma unroll
      for (int s = 0; s < 8; ++s) a[s] = *(const bf16x8*)(q_c + (32 * ti + r) * 128 + 16 * s + 8 * hh);
#pragma unroll
      for (int s = 0; s < 4; ++s) bq[s] = *(const bf16x8*)(qk_c + (32 * ti + r) * 64 + 16 * s + 8 * hh);
#pragma unroll
      for (int i = 0; i < 16; ++i) acc[i] = 0.f;
#pragma unroll
      for (int reg = 0; reg < 16; ++reg) rs[reg] = gs[32 * ti + crow(reg, hh)];
    }
#pragma unroll
    for (int g = 0; g < 4; ++g) {
      uint2 pk;
      pk.x = pack2(S[4 * g], S[4 * g + 1]); pk.y = pack2(S[4 * g + 2], S[4 * g + 3]);
      *(uint2*)(ST + r * 136 + 32 * w + 8 * g + 4 * hh) = pk;
    }
    __syncthreads();
#pragma unroll
    for (int s = 0; s < 8; ++s) {
      const bf16x8 bs = *(const bf16x8*)(ST + r * 136 + 16 * s + 8 * hh);
      acc = MFMA32(a[s], bs, acc);
    }
    if (w < 2) {
#pragma unroll
      for (int g = 0; g < 4; ++g) {
        uint2 pk, pd;
        pk.x = pack2(acc[4 * g], acc[4 * g + 1]); pk.y = pack2(acc[4 * g + 2], acc[4 * g + 3]);
        pd.x = pack2(acc[4 * g] * rs[4 * g], acc[4 * g + 1] * rs[4 * g + 1]);
        pd.y = pack2(acc[4 * g + 2] * rs[4 * g + 2], acc[4 * g + 3] * rs[4 * g + 3]);
        *(uint2*)(VT + r * 72 + 32 * ti + 8 * g + 4 * hh) = pk;
        *(uint2*)(VdT + r * 72 + 32 * ti + 8 * g + 4 * hh) = pd;
      }
    } else {
#pragma unroll
      for (int reg = 0; reg < 16; ++reg) acc[reg] *= rs[reg];
    }
    __syncthreads();
    if (w >= 2) {
#pragma unroll
      for (int s = 0; s < 4; ++s) {
        const bf16x8 bv = *(const bf16x8*)(VT + r * 72 + 16 * s + 8 * hh);
        acc = MFMA32(bq[s], bv, acc);
      }
#pragma unroll
      for (int reg = 0; reg < 16; ++reg) uo_c[(32 * ti + crow(reg, hh)) * 32 + r] = f2bf(acc[reg]);
    }
#pragma unroll
    for (int i = 0; i < 16; ++i) S[i] *= gtot;
#pragma unroll
    for (int s = 0; s < 4; ++s) {
      const bf16x8 bv = *(const bf16x8*)(VdT + r * 72 + 16 * s + 8 * hh);
      S = MFMA32(kt[s], bv, S);
    }
  }
}


__device__ __forceinline__ void d_mlstm_scan(int chain, int sl, char* smem, const unsigned short* __restrict__ pm,
                                             const float* __restrict__ gt, unsigned short* __restrict__ oM, int ntok) {
  unsigned short* qL = (unsigned short*)smem;
  unsigned short* kL = qL + 64 * 136;
  unsigned short* kdL = kL + 64 * 136;
  unsigned short* vTL = kdL + 64 * 136;
  unsigned short* S0T = vTL + 32 * 72;
  unsigned short* nL = S0T + 32 * 136;
  float* scal = (float*)(nL + 256);
  const int tid = threadIdx.x, lane = tid & 63, w = tid >> 6, r = lane & 31, hh = lane >> 5;
  const int bh = chain >> 1, dir = chain & 1, b = bh >> 2, h = bh & 3;
  const float SCALE = 0.08838834764831845f;
  f32x16 S0, S1;
#pragma unroll
  for (int i = 0; i < 16; ++i) { S0[i] = 0.f; S1[i] = 0.f; }
  bf16x8 ones;
#pragma unroll
  for (int i = 0; i < 8; ++i) ones[i] = (short)0x3F80;
  for (int step = 0; step < 64; ++step) {
    const int c = dir ? 63 - step : step;
    const size_t t0 = (size_t)b * SEQ + c * 64;
    const float lf = gt[(t0 + lane) * 32 + 24 + dir * 4 + h];
    const float ip = gt[(t0 + lane) * 32 + 16 + dir * 4 + h];
    float bc = lf;
#pragma unroll
    for (int o = 1; o < 64; o <<= 1) {
      const float vu = __shfl_up(bc, o, 64);
      const float vd = __shfl_down(bc, o, 64);
      if (dir == 0) { if (lane >= o) bc += vu; } else { if (lane + o < 64) bc += vd; }
    }
    const float b_last = __shfl(bc, dir ? 0 : 63, 64);
    const float Dj = SCALE * expf(b_last - bc + ip);
    const float gtot = expf(b_last);
    __syncthreads();
    if (w == 0) { scal[lane] = expf(bc); scal[64 + lane] = ip - bc; scal[128 + lane] = bc; }
#pragma unroll
    for (int i = 0; i < 4; ++i) {
      const int id = tid + i * 256;
      const int row = id >> 4, c16 = id & 15;
      const uint4 qv = *(const uint4*)(pm + (t0 + row) * 4096 + 2048 + h * 128 + c16 * 8);
      const uint4 kv = *(const uint4*)(pm + (t0 + row) * 4096 + 2560 + h * 128 + c16 * 8);
      *(uint4*)(qL + row * 136 + c16 * 8) = qv;
      *(uint4*)(kL + row * 136 + c16 * 8) = kv;
      const float d = __shfl(Dj, row, 64);
      uint4 kd;
      kd.x = pack2(bf2f(kv.x & 0xffff) * d, bf2f(kv.x >> 16) * d);
      kd.y = pack2(bf2f(kv.y & 0xffff) * d, bf2f(kv.y >> 16) * d);
      kd.z = pack2(bf2f(kv.z & 0xffff) * d, bf2f(kv.z >> 16) * d);
      kd.w = pack2(bf2f(kv.w & 0xffff) * d, bf2f(kv.w >> 16) * d);
      *(uint4*)(kdL + row * 136 + c16 * 8) = kd;
    }
    {
      const int tok = tid >> 2, d8 = (tid & 3) * 8;
      const uint4 vv = *(const uint4*)(pm + (t0 + tok) * 4096 + 3072 + h * 128 + sl * 32 + d8);
      vTL[(d8 + 0) * 72 + tok] = (unsigned short)(vv.x & 0xffff);
      vTL[(d8 + 1) * 72 + tok] = (unsigned short)(vv.x >> 16);
      vTL[(d8 + 2) * 72 + tok] = (unsigned short)(vv.y & 0xffff);
      vTL[(d8 + 3) * 72 + tok] = (unsigned short)(vv.y >> 16);
      vTL[(d8 + 4) * 72 + tok] = (unsigned short)(vv.z & 0xffff);
      vTL[(d8 + 5) * 72 + tok] = (unsigned short)(vv.z >> 16);
      vTL[(d8 + 6) * 72 + tok] = (unsigned short)(vv.w & 0xffff);
      vTL[(d8 + 7) * 72 + tok] = (unsigned short)(vv.w >> 16);
    }
#pragma unroll
    for (int g = 0; g < 4; ++g) {
      uint2 pk;
      pk.x = pack2(S0[4 * g], S0[4 * g + 1]); pk.y = pack2(S0[4 * g + 2], S0[4 * g + 3]);
      *(uint2*)(S0T + r * 136 + 32 * w + 8 * g + 4 * hh) = pk;
      if (r == 0) {
        uint2 pn;
        pn.x = pack2(S1[4 * g], S1[4 * g + 1]); pn.y = pack2(S1[4 * g + 2], S1[4 * g + 3]);
        *(uint2*)(nL + 32 * w + 8 * g + 4 * hh) = pn;
      }
    }
    __syncthreads();
    if (w < 2) {
      const int ti = w;
      const int icol = 32 * ti + r;
      const float bci = scal[128 + icol];
      f32x16 Q0, Q1;
#pragma unroll
      for (int i = 0; i < 16; ++i) { Q0[i] = 0.f; Q1[i] = 0.f; }
#pragma unroll
      for (int s2 = 0; s2 < 8; ++s2) {
        const bf16x8 a = *(const bf16x8*)(qL + (32 * ti + r) * 136 + 16 * s2 + 8 * hh);
        const bf16x8 b0 = *(const bf16x8*)(S0T + r * 136 + 16 * s2 + 8 * hh);
        const bf16x8 b1 = *(const bf16x8*)(nL + 16 * s2 + 8 * hh);
        Q0 = MFMA32(a, b0, Q0);
        Q1 = MFMA32(a, b1, Q1);
      }
#pragma unroll
      for (int reg = 0; reg < 16; ++reg) {
        const float e = scal[32 * ti + crow(reg, hh)];
        Q0[reg] *= e; Q1[reg] *= e;
      }
#pragma unroll
      for (int tj = 0; tj < 2; ++tj) {
        f32x16 X;
#pragma unroll
        for (int i = 0; i < 16; ++i) X[i] = 0.f;
#pragma unroll
        for (int s2 = 0; s2 < 8; ++s2) {
          const bf16x8 a = *(const bf16x8*)(kL + (32 * tj + r) * 136 + 16 * s2 + 8 * hh);
          const bf16x8 bq = *(const bf16x8*)(qL + (32 * ti + r) * 136 + 16 * s2 + 8 * hh);
          X = MFMA32(a, bq, X);
        }
#pragma unroll
        for (int reg = 0; reg < 16; ++reg) {
          const int j = 32 * tj + crow(reg, hh);
          const bool valid = dir ? (j >= icol) : (j <= icol);
          X[reg] = valid ? X[reg] * SCALE * expf(bci + scal[64 + j]) : 0.f;
        }
#pragma unroll
        for (int s2 = 0; s2 < 2; ++s2) {
          union { bf16x8 v; unsigned u[4]; } xa, bv;
          xa.u[0] = pack2(X[8 * s2 + 0], X[8 * s2 + 1]); xa.u[1] = pack2(X[8 * s2 + 2], X[8 * s2 + 3]);
          xa.u[2] = pack2(X[8 * s2 + 4], X[8 * s2 + 5]); xa.u[3] = pack2(X[8 * s2 + 6], X[8 * s2 + 7]);
          const uint2 v0 = *(const uint2*)(vTL + r * 72 + 32 * tj + 16 * s2 + 4 * hh);
          const uint2 v1 = *(const uint2*)(vTL + r * 72 + 32 * tj + 16 * s2 + 8 + 4 * hh);
          bv.u[0] = v0.x; bv.u[1] = v0.y; bv.u[2] = v1.x; bv.u[3] = v1.y;
          Q0 = MFMA32(xa.v, bv.v, Q0);
          Q1 = MFMA32(xa.v, ones, Q1);
        }
      }
#pragma unroll
      for (int reg = 0; reg < 16; ++reg) {
        const int i = 32 * ti + crow(reg, hh);
        oM[((size_t)dir * ntok + t0 + i) * 512 + h * 128 + sl * 32 + r] = f2bf(Q0[reg] / fmaxf(fabsf(Q1[reg]), 1.f));
      }
    }
#pragma unroll
    for (int i = 0; i < 16; ++i) { S0[i] *= gtot; S1[i] *= gtot; }
#pragma unroll
    for (int s2 = 0; s2 < 4; ++s2) {
      union { bf16x8 v; unsigned short e[8]; } a;
#pragma unroll
      for (int e = 0; e < 8; ++e) a.e[e] = kdL[(16 * s2 + 8 * hh + e) * 136 + 32 * w + r];
      const bf16x8 bv = *(const bf16x8*)(vTL + r * 72 + 16 * s2 + 8 * hh);
      S0 = MFMA32(a.v, bv, S0);
      S1 = MFMA32(a.v, ones, S1);
    }
  }
}

struct MKP {
  const float *x, *norm1_g, *w_in, *conv_w, *a_log, *dt_bias, *gdn_g, *i_bias, *f_bias, *ml_g, *w_out, *norm2_g, *peer_wq,
      *peer_keys, *peer_u, *peer_v, *normf_g;
  float* out;
  unsigned short *pm, *x1b, *woutT, *mt, *xb, *winT, *oM, *yb, *scores, *qkv_dbg, *oA_dbg, *utab, *vtab;
  float *x1, *rs1, *rs2, *gt, *gateb, *dbg;
  int* idxb;
  GdnBufs G;
};

constexpr int SMEM_BYTES = 74752;

__global__ void __launch_bounds__(256, 2) k_mega(MKP P) {
  cg::grid_group grid = cg::this_grid();
  __shared__ __attribute__((aligned(16))) char smem_c[SMEM_BYTES];
  unsigned short* smem = (unsigned short*)smem_c;
  const int nb = gridDim.x, bid = blockIdx.x;
  for (int it = bid; it < NT / 4; it += nb) d_prep_x(it, P.x, P.xb, P.rs1);
  for (int it = bid; it < NPAD_IN * DM / 256; it += nb) d_transpose_w(it, P.w_in, DIN, P.norm1_g, P.winT, NPAD_IN, 1);
  for (int it = bid; it < 1024 * DM / 256; it += nb) d_transpose_w(it, P.w_out, 1024, nullptr, P.woutT, 1024, 0);
  for (int it = bid; it < 2048 * 4; it += nb) d_make_mt(it, P.peer_wq, P.peer_keys, P.norm2_g, P.mt);
  if (bid == 0 && threadIdx.x < 2) P.dbg[threadIdx.x] = 0.f;
  grid.sync();
  {
    GemmP p{};
    p.A = P.xb; p.lda = DM; p.Bt = P.winT; p.ldb = DM; p.K = DM;
    p.rowscale = P.rs1; p.obf = P.pm; p.ldo = 4096; p.of32 = P.gt; p.ldf = 32; p.resid = nullptr;
    p.a_log = P.a_log; p.dt_bias = P.dt_bias; p.i_bias = P.i_bias; p.f_bias = P.f_bias;
    for (int tile = bid; tile < (NT / 128) * 33; tile += nb) {
      gemm_tile<EPI_INPROJ>(p, tile / 33, tile % 33, smem);
      __syncthreads();
    }
  }
  grid.sync();
  for (int it = bid; it < 1024; it += nb) d_gdn_prep(it, smem_c, P.pm, P.gt, P.conv_w, P.G);
#ifdef DBG_CHECK
#endif
  grid.sync();
  if (bid < 128) {
    d_gdn_scan(bid >> 2, bid & 3, smem_c, P.G);
  } else if (bid < 256) {
    d_mlstm_scan((bid - 128) >> 2, (bid - 128) & 3, smem_c, P.pm, P.gt, P.oM, NT);
  }
#ifdef DBG_CHECK
  if (bid < 4) {
    __syncthreads();
    const int half = threadIdx.x >> 7;
    float* sq = (float*)smem + half * 256;
    float* sk = sq + 128;
    d_mlstm_rec(bid * 2 + half, sq, sk, P.pm, P.gt, P.oA_dbg, 4096);
  }
#endif
  grid.sync();
  for (int it = bid; it < NT / 4; it += nb) d_combine(it, P.G.uo, P.oM, P.pm, P.gdn_g, P.ml_g, P.yb);
#ifdef DBG_CHECK
  for (int it = bid; it < 4096 / 4; it += nb) d_dbg_cmp_m(it, P.oM, P.oA_dbg, P.dbg);
#endif
  grid.sync();
  {
    GemmP p{};
    p.A = P.yb; p.lda = DM; p.Bt = P.woutT; p.ldb = DM; p.K = DM;
    p.rowscale = nullptr; p.obf = nullptr; p.ldo = 0; p.of32 = P.x1; p.ldf = DM; p.resid = P.x;
    for (int tile = bid; tile < (NT / 128) * 8; tile += nb) {
      gemm_tile<EPI_OUTPROJ>(p, tile / 8, tile % 8, smem);
      __syncthreads();
    }
  }
  grid.sync();
  for (int it = bid; it < NT / 4; it += nb) d_prep_x1(it, P.x1, P.x1b, P.rs2);
  grid.sync();
  {
    GemmP p{};
    p.A = P.x1b; p.lda = DM; p.Bt = P.mt; p.ldb = DM; p.K = DM;
    p.rowscale = P.rs2; p.obf = P.scores; p.ldo = 2048; p.of32 = nullptr; p.ldf = 0; p.resid = nullptr;
    for (int tile = bid; tile < (NT / 128) * 16; tile += nb) {
      gemm_tile<EPI_SCORES>(p, tile / 16, tile % 16, smem);
      __syncthreads();
    }
  }
  grid.sync();
  for (int it = bid; it < 8192; it += nb) { d_cvt_tab(it, P.peer_u, P.utab); d_cvt_tab(it, P.peer_v, P.vtab); }
  for (int it = bid; it < NT * 8 / 4; it += nb) d_topk(it, P.scores, P.idxb, P.gateb);
  grid.sync();
  float oscale = 1.f;
#ifdef DBG_CHECK
  {
    const float sd = __hip_atomic_load(&P.dbg[0], __ATOMIC_RELAXED, __HIP_MEMORY_SCOPE_AGENT);
    const float sr = __hip_atomic_load(&P.dbg[1], __ATOMIC_RELAXED, __HIP_MEMORY_SCOPE_AGENT);
    oscale = 1.f + sqrtf(sd / sr);
  }
#endif
  for (int it = bid; it < NT / 4; it += nb)
    d_peer(it, P.x1, P.rs2, P.norm2_g, P.idxb, P.gateb, P.utab, P.vtab, P.normf_g, P.out, oscale);
}

extern "C" void kernel_launch(void* const* d_in, const int* in_sizes, int n_in, void* d_out, int out_size, void* d_ws,
                              size_t ws_size, hipStream_t stream) {
  MKP P{};
  P.x = (const float*)d_in[0];
  P.norm1_g = (const float*)d_in[1];
  P.w_in = (const float*)d_in[2];
  P.conv_w = (const float*)d_in[3];
  P.a_log = (const float*)d_in[4];
  P.dt_bias = (const float*)d_in[5];
  P.gdn_g = (const float*)d_in[6];
  P.i_bias = (const float*)d_in[7];
  P.f_bias = (const float*)d_in[8];
  P.ml_g = (const float*)d_in[9];
  P.w_out = (const float*)d_in[10];
  P.norm2_g = (const float*)d_in[11];
  P.peer_wq = (const float*)d_in[12];
  P.peer_keys = (const float*)d_in[13];
  P.peer_u = (const float*)d_in[14];
  P.peer_v = (const float*)d_in[15];
  P.normf_g = (const float*)d_in[16];
  P.out = (float*)d_out;

  char* ws = (char*)d_ws;
  const size_t MB = 1024 * 1024;
  P.pm = (unsigned short*)(ws);
  P.x1 = (float*)(ws);
  P.x1b = (unsigned short*)(ws + 64 * MB);
  P.utab = (unsigned short*)(ws + 64 * MB);
  P.vtab = (unsigned short*)(ws + 96 * MB);
  char* rb = ws + 128 * MB;
  P.woutT = (unsigned short*)(rb);
  P.mt = (unsigned short*)(rb + 2 * MB);
  P.rs1 = (float*)(rb + 6 * MB);
  P.rs2 = (float*)(rb + 6 * MB + 65536);
  P.dbg = (float*)(rb + 6 * MB + 131072);
  P.gt = (float*)(rb + 9 * MB);
  char* dyn = rb + 11 * MB;
  P.xb = (unsigned short*)(dyn);
  P.winT = (unsigned short*)(dyn + 32 * MB);
  P.G.qc = (unsigned short*)(dyn);
  P.G.kTc = (unsigned short*)(dyn + 16 * MB);
  P.G.qkc = (unsigned short*)(dyn + 32 * MB);
  P.G.wn = (unsigned short*)(dyn + 48 * MB);
  P.G.uo = (unsigned short*)(dyn + 80 * MB);
  P.G.gsc = (float*)(dyn + 112 * MB);
  P.yb = (unsigned short*)(dyn);
  P.scores = (unsigned short*)(dyn);
  P.idxb = (int*)(dyn + 64 * MB);
  P.gateb = (float*)(dyn + 72 * MB);
  char* os = (char*)d_out;
  P.oM = (unsigned short*)(os);
  P.qkv_dbg = (unsigned short*)(os + 32 * MB);
  P.oA_dbg = (unsigned short*)(os + 44 * MB);

  static int grid_blocks = 0;
  if (!grid_blocks) {
    int dev = 0, cus = 0, per_cu = 0;
    (void)hipGetDevice(&dev);
    (void)hipDeviceGetAttribute(&cus, hipDeviceAttributeMultiprocessorCount, dev);
    (void)hipOccupancyMaxActiveBlocksPerMultiprocessor(&per_cu, k_mega, 256, 0);
    if (per_cu > 2) per_cu = 2;
    if (per_cu < 1) per_cu = 1;
    grid_blocks = cus * per_cu;
  }
  void* args[] = {&P};
  hipError_t e = hipLaunchCooperativeKernel((void*)k_mega, dim3(grid_blocks), dim3(256), args, 0, stream);
  if (e != hipSuccess) fprintf(stderr, "cooperative launch failed: %s (grid %d)\n", hipGetErrorString(e), grid_blocks);
}
```

```cpp
#include <hip/hip_runtime.h>
#include <hip/hip_bf16.h>
#include <stdint.h>
#include <cstdio>

#define XB_TMO      128
#define XB_XCNT(j)  (256  + 64 * (j))
#define XB_XSUB(j)  (1280 + 64 * (j))
#define XB_XGEN(j)  (2304 + 64 * (j))
#define XB_TOP      3328
#define XB_TOPGEN   3392
#define XCD_BAR_WORDS 3456
#define XB_SPIN_CAP (1u << 18)
#define LAS __attribute__((address_space(3)))

__device__ __forceinline__ unsigned xb_ld(unsigned* p)              { return __hip_atomic_load(p, __ATOMIC_RELAXED, __HIP_MEMORY_SCOPE_AGENT); }
__device__ __forceinline__ unsigned xb_add(unsigned* p, unsigned v) { return __hip_atomic_fetch_add(p, v, __ATOMIC_RELAXED, __HIP_MEMORY_SCOPE_AGENT); }
__device__ __forceinline__ unsigned xb_xcc_id() { return (unsigned)__builtin_amdgcn_s_getreg((3 << 11) | 20) & 0xFu; }
#define XB_SPIN(cond, bar) do { unsigned _sp = 0; while (cond) { __builtin_amdgcn_s_sleep(1); \
    if ((++_sp & 255u) == 0u) { if (xb_ld(&(bar)[XB_TMO])) break; if (_sp > XB_SPIN_CAP) { atomicAdd(&(bar)[XB_TMO], 1u); break; } } } } while (0)

struct XcdBarrier {
    unsigned* bar; unsigned x;
    volatile LAS unsigned* st;
};

__device__ __forceinline__ XcdBarrier xcd_barrier_post(unsigned* bar, volatile LAS unsigned* st) {
    XcdBarrier b; b.bar = bar; b.x = xb_xcc_id(); b.st = st;
    if (threadIdx.x == 0) (void)xb_add(&bar[XB_XCNT(b.x)], 1u);
    return b;
}
__device__ __forceinline__ void xcd_barrier_complete(unsigned* bar, unsigned x, unsigned& nloc, unsigned& nx) {
    const unsigned G = gridDim.x * gridDim.y * gridDim.z;
    unsigned sum, cnt, mine, sp = 0u;
    for (;;) {
        sum = 0u; cnt = 0u; mine = 0u;
#pragma unroll
        for (unsigned j = 0; j < 16; ++j) { const unsigned c = xb_ld(&bar[XB_XCNT(j)]); sum += c; cnt += (c > 0u) ? 1u : 0u; mine = (j == x) ? c : mine; }
        if (sum == G) break;
        __builtin_amdgcn_s_sleep(1);
        if ((++sp & 255u) == 0u) { if (xb_ld(&bar[XB_TMO])) break; if (sp > XB_SPIN_CAP) { atomicAdd(&bar[XB_TMO], 1u); break; } }
    }
    nloc = mine > 0u ? mine : 1u; nx = cnt > 0u ? cnt : 1u;
}

__device__ __forceinline__ void xcd_barrier(const XcdBarrier& b) {
    asm volatile("s_waitcnt vmcnt(0)" ::: "memory");
    __syncthreads();
    if (threadIdx.x == 0) {
        unsigned* bar = b.bar;
        __builtin_amdgcn_s_waitcnt(0);
        unsigned nloc = b.st[0], nx = b.st[1];
        if (nloc == 0u) { xcd_barrier_complete(bar, b.x, nloc, nx); b.st[0] = nloc; b.st[1] = nx; }
        const unsigned old = xb_add(&bar[XB_XSUB(b.x)], 1u);
        const unsigned gen = old / nloc;
        if (old + 1u == (gen + 1u) * nloc) {
            __builtin_amdgcn_fence(__ATOMIC_RELEASE, "agent");
            asm volatile("s_waitcnt vmcnt(0)" ::: "memory");
            const unsigned og = xb_add(&bar[XB_TOP], 1u);
            const unsigned tg = og / nx;
            if (og + 1u == (tg + 1u) * nx) xb_add(&bar[XB_TOPGEN], 1u);
            else XB_SPIN(xb_ld(&bar[XB_TOPGEN]) == tg, bar);
            __builtin_amdgcn_fence(__ATOMIC_ACQUIRE, "agent");
            xb_add(&bar[XB_XGEN(b.x)], 1u);
            asm volatile("s_waitcnt vmcnt(0)" ::: "memory");
        } else {
            XB_SPIN(xb_ld(&bar[XB_XGEN(b.x)]) == gen, bar);
            __builtin_amdgcn_fence(__ATOMIC_ACQUIRE, "agent");
            asm volatile("s_waitcnt vmcnt(0)" ::: "memory");
        }
    }
    __syncthreads();
}


typedef __hip_bfloat16 bf16;
typedef __attribute__((ext_vector_type(8))) short bf16x8;
typedef __attribute__((ext_vector_type(4))) float f32x4;

constexpr int DM = 1024;
constexpr int NB = 4;
constexpr int SEQ = 4096;
constexpr int NT = NB * SEQ;
constexpr int DIN = 4128;
constexpr int NPAD_IN = 4224;
constexpr float EPSF = 1e-6f;

__device__ __forceinline__ float bf2f(unsigned short u) { return __uint_as_float(((unsigned)u) << 16); }
__device__ __forceinline__ unsigned short f2bf(float f) {
  unsigned u = __float_as_uint(f);
  u += 0x7fffu + ((u >> 16) & 1u);
  return (unsigned short)(u >> 16);
}
__device__ __forceinline__ float wave_sum(float v) {
#pragma unroll
  for (int o = 32; o > 0; o >>= 1) v += __shfl_xor(v, o, 64);
  return v;
}
__device__ __forceinline__ float softplusf(float x) { return fmaxf(x, 0.f) + log1pf(expf(-fabsf(x))); }
__device__ __forceinline__ float sigmoidf(float x) { return 1.f / (1.f + expf(-x)); }

__device__ __forceinline__ void d_prep_x(int item, const float* __restrict__ x, unsigned short* __restrict__ xb,
                                                float* __restrict__ rs) {
  int t = item * 4 + (threadIdx.x >> 6);
  int lane = threadIdx.x & 63;
  const float4* xr = (const float4*)(x + (size_t)t * DM);
  float ss = 0.f;
#pragma unroll
  for (int i = 0; i < 4; ++i) {
    float4 v = xr[lane + 64 * i];
    ss += v.x * v.x + v.y * v.y + v.z * v.z + v.w * v.w;
    ushort4 o;
    o.x = f2bf(v.x); o.y = f2bf(v.y); o.z = f2bf(v.z); o.w = f2bf(v.w);
    ((ushort4*)(xb + (size_t)t * DM))[lane + 64 * i] = o;
  }
  ss = wave_sum(ss);
  if (lane == 0) rs[t] = rsqrtf(ss * (1.f / DM) + EPSF);
}

__device__ __forceinline__ int win_src(int n) {
  if (n < 2048) return n;
  if (n < 4096) return n + 16;
  int j = n - 4096;
  if (j < 16) return 2048 + j;
  if (j < 32) return 4112 + (j - 16);
  return -1;
}
__device__ __forceinline__ void d_transpose_w(int item, const float* __restrict__ in, int ldn, const float* __restrict__ g,
                                                     unsigned short* __restrict__ out, int nrows, int mode) {
  size_t id = (size_t)item * 256 + threadIdx.x;
  if (id >= (size_t)nrows * DM) return;
  int n = (int)(id >> 10);
  int k = (int)(id & 1023);
  int src = mode ? win_src(n) : n;
  float v = 0.f;
  if (src >= 0) v = in[(size_t)k * ldn + src] * (g ? g[k] : 1.f);
  out[id] = f2bf(v);
}
__device__ __forceinline__ void d_make_mt(int item, const float* __restrict__ wq, const float* __restrict__ keys,
                                                 const float* __restrict__ g2, unsigned short* __restrict__ mt) {
  int n = item >> 2;
  int d = (item & 3) * 256 + threadIdx.x;
  int hp = n >> 7;
  const float4* kr = (const float4*)(keys + (size_t)n * 128);
  const float4* wr = (const float4*)(wq + (size_t)d * 2048 + hp * 128);
  float s = 0.f;
#pragma unroll 8
  for (int j = 0; j < 32; ++j) {
    float4 a = kr[j], b = wr[j];
    s += a.x * b.x + a.y * b.y + a.z * b.z + a.w * b.w;
  }
  mt[(size_t)n * DM + d] = f2bf(s * g2[d]);
}

constexpr int GBM = 128, GBN = 128, GBK = 64, GLD = 72;
struct GemmP {
  const unsigned short* A; const unsigned short* Bt; int lda, ldb, K;
  const float* rowscale;
  unsigned short* obf; int ldo;
  float* of32; int ldf;
  const float* resid;
  const float *a_log, *dt_bias, *i_bias, *f_bias;
  float* rowacc;
};
enum { EPI_INPROJ = 0, EPI_OUTPROJ = 1, EPI_SCORES = 2 };

template <int EPI>
__device__ __forceinline__ void gemm_tile(const GemmP p, int tm, int tn, unsigned short* smem) {
  unsigned short* As = smem;
  unsigned short* Bs = smem + 2 * GBM * GLD;
  const int tid = threadIdx.x, lane = tid & 63, wid = tid >> 6;
  const int wm = wid >> 1, wn = wid & 1;
  const int m0 = tm * GBM, n0 = tn * GBN;
  f32x4 acc[4][4];
#pragma unroll
  for (int i = 0; i < 4; ++i)
#pragma unroll
    for (int j = 0; j < 4; ++j) acc[i][j] = (f32x4){0.f, 0.f, 0.f, 0.f};

  uint4 ra0, ra1, ra2, ra3, rb0, rb1, rb2, rb3;
  const int nk = p.K / GBK;
  const int lrow = tid >> 3, lc8 = tid & 7;
  const unsigned short* Ag = p.A + (size_t)(m0 + lrow) * p.lda + lc8 * 8;
  const unsigned short* Bg = p.Bt + (size_t)(n0 + lrow) * p.ldb + lc8 * 8;
  const size_t a32 = (size_t)32 * p.lda, b32 = (size_t)32 * p.ldb;
#define GLOAD(kt)                                                        \
  {                                                                      \
    ra0 = *(const uint4*)(Ag + (kt) * GBK);                              \
    ra1 = *(const uint4*)(Ag + a32 + (kt) * GBK);                        \
    ra2 = *(const uint4*)(Ag + 2 * a32 + (kt) * GBK);                    \
    ra3 = *(const uint4*)(Ag + 3 * a32 + (kt) * GBK);                    \
    rb0 = *(const uint4*)(Bg + (kt) * GBK);                              \
    rb1 = *(const uint4*)(Bg + b32 + (kt) * GBK);                        \
    rb2 = *(const uint4*)(Bg + 2 * b32 + (kt) * GBK);                    \
    rb3 = *(const uint4*)(Bg + 3 * b32 + (kt) * GBK);                    \
  }
#define SSTORE(buf)                                                      \
  {                                                                      \
    unsigned short* ad = As + (size_t)(buf) * GBM * GLD + lrow * GLD + lc8 * 8; \
    unsigned short* bd = Bs + (size_t)(buf) * GBN * GLD + lrow * GLD + lc8 * 8; \
    *(uint4*)(ad) = ra0; *(uint4*)(ad + 32 * GLD) = ra1; *(uint4*)(ad + 64 * GLD) = ra2; *(uint4*)(ad + 96 * GLD) = ra3; \
    *(uint4*)(bd) = rb0; *(uint4*)(bd + 32 * GLD) = rb1; *(uint4*)(bd + 64 * GLD) = rb2; *(uint4*)(bd + 96 * GLD) = rb3; \
  }
  GLOAD(0);
  SSTORE(0);
  __syncthreads();
  for (int kt = 0; kt < nk; ++kt) {
    const int buf = kt & 1;
    if (kt + 1 < nk) GLOAD(kt + 1);
    const unsigned short* Ab = As + (size_t)buf * GBM * GLD;
    const unsigned short* Bb = Bs + (size_t)buf * GBN * GLD;
#pragma unroll
    for (int ks = 0; ks < 2; ++ks) {
      bf16x8 a[4], b[4];
      const int kc = ks * 32 + (lane >> 4) * 8;
#pragma unroll
      for (int i = 0; i < 4; ++i) a[i] = *(const bf16x8*)(Ab + (wm * 64 + i * 16 + (lane & 15)) * GLD + kc);
#pragma unroll
      for (int j = 0; j < 4; ++j) b[j] = *(const bf16x8*)(Bb + (wn * 64 + j * 16 + (lane & 15)) * GLD + kc);
#pragma unroll
      for (int i = 0; i < 4; ++i)
#pragma unroll
        for (int j = 0; j < 4; ++j) acc[i][j] = __builtin_amdgcn_mfma_f32_16x16x32_bf16(a[i], b[j], acc[i][j], 0, 0, 0);
    }
    if (kt + 1 < nk) SSTORE(buf ^ 1);
    __syncthreads();
  }
#undef GLOAD
#undef SSTORE
#pragma unroll
  for (int i = 0; i < 4; ++i) {
#pragma unroll
    for (int r = 0; r < 4; ++r) {
      const int row = m0 + wm * 64 + i * 16 + (lane >> 4) * 4 + r;
      float rsc = 1.f;
      float rowss = 0.f;
      if (EPI == EPI_INPROJ) rsc = p.rowscale[row];
      if (EPI == EPI_SCORES) {
        const float4* pr = (const float4*)(p.rowscale + (size_t)row * 16);
        const float4 s0 = pr[0], s1 = pr[1], s2 = pr[2], s3 = pr[3];
        const float ssq = ((s0.x + s0.y) + (s0.z + s0.w)) + ((s1.x + s1.y) + (s1.z + s1.w)) + ((s2.x + s2.y) + (s2.z + s2.w)) + ((s3.x + s3.y) + (s3.z + s3.w));
        rsc = rsqrtf(ssq * (1.f / DM) + EPSF);
      }
#pragma unroll
      for (int j = 0; j < 4; ++j) {
        const int col = n0 + wn * 64 + j * 16 + (lane & 15);
        float v = acc[i][j][r] * rsc;
        if (EPI == EPI_INPROJ) {
          if (col < 4096) p.obf[(size_t)row * p.ldo + col] = f2bf(v);
          else if (col < 4128) {
            const int j = col - 4096, jj = j & 7;
            float o;
            if (j < 8) o = -expf(p.a_log[jj]) * softplusf(v + p.dt_bias[jj]);
            else if (j < 16) o = sigmoidf(v);
            else if (j < 24) o = v + p.i_bias[jj];
            else o = -softplusf(-(v + p.f_bias[jj]));
            p.of32[(size_t)row * p.ldf + j] = o;
          }
        } else if (EPI == EPI_OUTPROJ) {
          const float xo = v + p.resid[(size_t)row * p.ldf + col];
          p.of32[(size_t)row * p.ldf + col] = xo;
          p.obf[(size_t)row * p.ldo + col] = f2bf(xo);
          rowss += xo * xo;
        } else {
          p.obf[(size_t)row * p.ldo + col] = f2bf(v);
        }
      }
      if (EPI == EPI_OUTPROJ) {
        rowss += __shfl_xor(rowss, 1, 64); rowss += __shfl_xor(rowss, 2, 64);
        rowss += __shfl_xor(rowss, 4, 64); rowss += __shfl_xor(rowss, 8, 64);
        if ((lane & 15) == 0) p.rowacc[(size_t)row * 16 + tn * 2 + wn] = rowss;
      }
    }
  }
}

__device__ __forceinline__ void d_conv(int item, const unsigned short* __restrict__ pm, const float* __restrict__ pg,
                                              const float* __restrict__ conv_w, const float* __restrict__ a_log,
                                              const float* __restrict__ dt_bias, const float* __restrict__ i_bias,
                                              const float* __restrict__ f_bias, unsigned short* __restrict__ qkv,
                                              float* __restrict__ gt) {
  int t = item * 4 + (threadIdx.x >> 6);
  int lane = threadIdx.x & 63;
  int s = t & (SEQ - 1);
  for (int sec = 0; sec < 3; ++sec) {
    for (int h = 0; h < 4; ++h) {
      int c0 = sec * 512 + h * 128 + 2 * lane;
      float a0 = 0.f, a1 = 0.f;
#pragma unroll
      for (int j = 0; j < 5; ++j) {
        int sp = s + j - 2;
        if (sp >= 0 && sp < SEQ) {
          unsigned v = *(const unsigned*)(pm + (size_t)(t + j - 2) * 4096 + c0);
          a0 += conv_w[c0 * 5 + j] * bf2f((unsigned short)(v & 0xffff));
          a1 += conv_w[(c0 + 1) * 5 + j] * bf2f((unsigned short)(v >> 16));
        }
      }
      a0 = a0 * sigmoidf(a0);
      a1 = a1 * sigmoidf(a1);
      if (sec < 2) {
        float ss = wave_sum(a0 * a0 + a1 * a1);
        float sc = rsqrtf(ss + EPSF);
        if (sec == 0) sc *= 0.08838834764831845f;
        a0 *= sc; a1 *= sc;
      }
      unsigned o = (unsigned)f2bf(a0) | ((unsigned)f2bf(a1) << 16);
      *(unsigned*)(qkv + (size_t)t * 1536 + c0) = o;
    }
  }
}

__device__ __forceinline__ void d_gdn_rec(int chain, float* sq, float* sk, const unsigned short* __restrict__ qkv,
                                                 const float* __restrict__ gt, unsigned short* __restrict__ oA, int ntok) {
  const int bh = chain >> 1, dir = chain & 1;
  const int b = bh >> 2, h = bh & 3;
  const int e = threadIdx.x & 127;
  float S[128];
#pragma unroll
  for (int d = 0; d < 128; ++d) S[d] = 0.f;
  for (int it = 0; it < SEQ; ++it) {
    const int s = dir ? (SEQ - 1 - it) : it;
    const size_t t = (size_t)b * SEQ + s;
    __syncthreads();
    sq[e] = bf2f(qkv[t * 1536 + h * 128 + e]);
    sk[e] = bf2f(qkv[t * 1536 + 512 + h * 128 + e]);
    const float v = bf2f(qkv[t * 1536 + 1024 + h * 128 + e]);
    const float g = gt[t * 32 + dir * 4 + h];
    const float beta = gt[t * 32 + 8 + dir * 4 + h];
    __syncthreads();
    const float a = expf(g);
    float k0 = 0.f, k1 = 0.f, k2 = 0.f, k3 = 0.f;
#pragma unroll
    for (int d = 0; d < 128; d += 4) {
      k0 += sk[d] * S[d]; k1 += sk[d + 1] * S[d + 1]; k2 += sk[d + 2] * S[d + 2]; k3 += sk[d + 3] * S[d + 3];
    }
    const float kS = a * ((k0 + k1) + (k2 + k3));
    const float vn = beta * (v - kS);
    float o0 = 0.f, o1 = 0.f, o2 = 0.f, o3 = 0.f;
#pragma unroll
    for (int d = 0; d < 128; d += 4) {
      S[d] = a * S[d] + sk[d] * vn;             o0 += sq[d] * S[d];
      S[d + 1] = a * S[d + 1] + sk[d + 1] * vn; o1 += sq[d + 1] * S[d + 1];
      S[d + 2] = a * S[d + 2] + sk[d + 2] * vn; o2 += sq[d + 2] * S[d + 2];
      S[d + 3] = a * S[d + 3] + sk[d + 3] * vn; o3 += sq[d + 3] * S[d + 3];
    }
    oA[((size_t)dir * ntok + t) * 512 + h * 128 + e] = f2bf((o0 + o1) + (o2 + o3));
  }
}

__device__ __forceinline__ void d_mlstm_rec(int chain, float* sq, float* sk, const unsigned short* __restrict__ pm,
                                                   const float* __restrict__ gt, unsigned short* __restrict__ oM, int ntok) {
  const int bh = chain >> 1, dir = chain & 1;
  const int b = bh >> 2, h = bh & 3;
  const int e = threadIdx.x & 127, lane = e & 63;
  float C[128];
#pragma unroll
  for (int d = 0; d < 128; ++d) C[d] = 0.f;
  float n0 = 0.f, n1 = 0.f, m = 0.f;
  for (int it = 0; it < SEQ; ++it) {
    const int s = dir ? (SEQ - 1 - it) : it;
    const size_t t = (size_t)b * SEQ + s;
    __syncthreads();
    sq[e] = bf2f(pm[t * 4096 + 2048 + h * 128 + e]);
    sk[e] = bf2f(pm[t * 4096 + 2560 + h * 128 + e]) * 0.08838834764831845f;
    const float v = bf2f(pm[t * 4096 + 3072 + h * 128 + e]);
    const float ip = gt[t * 32 + 16 + dir * 4 + h];
    const float lf = gt[t * 32 + 24 + dir * 4 + h];
    __syncthreads();
    const float mn = fmaxf(lf + m, ip);
    const float fs = expf(lf + m - mn);
    const float is = expf(ip - mn);
    m = mn;
    n0 = fs * n0 + is * sk[lane];
    n1 = fs * n1 + is * sk[lane + 64];
    const float den = wave_sum(n0 * sq[lane] + n1 * sq[lane + 64]);
    const float iv = is * v;
    float o0 = 0.f, o1 = 0.f, o2 = 0.f, o3 = 0.f;
#pragma unroll
    for (int d = 0; d < 128; d += 4) {
      C[d] = fs * C[d] + sk[d] * iv;             o0 += sq[d] * C[d];
      C[d + 1] = fs * C[d + 1] + sk[d + 1] * iv; o1 += sq[d + 1] * C[d + 1];
      C[d + 2] = fs * C[d + 2] + sk[d + 2] * iv; o2 += sq[d + 2] * C[d + 2];
      C[d + 3] = fs * C[d + 3] + sk[d + 3] * iv; o3 += sq[d + 3] * C[d + 3];
    }
    const float num = (o0 + o1) + (o2 + o3);
    const float hh = num / fmaxf(fabsf(den), expf(-mn));
    oM[((size_t)dir * ntok + t) * 512 + h * 128 + e] = f2bf(hh);
  }
}

__device__ __forceinline__ void d_combine(int item, const unsigned short* __restrict__ uo, const unsigned short* __restrict__ oM,
                                                 const unsigned short* __restrict__ pm, const float* __restrict__ gdn_g,
                                                 const float* __restrict__ ml_g, unsigned short* __restrict__ y) {
  int t = item * 4 + (threadIdx.x >> 6);
  int lane = threadIdx.x & 63;
  const int b = t >> 12, cc = (t >> 6) & 63, ii = t & 63;
  for (int h = 0; h < 4; ++h) {
    int c = h * 128 + 2 * lane;
    {
      const int chain0 = (b * 4 + h) * 2;
      const size_t off = (size_t)cc * 8192 + (lane >> 4) * 2048 + ii * 32 + ((2 * lane) & 31);
      unsigned vf = *(const unsigned*)(uo + (size_t)chain0 * 64 * 8192 + off);
      unsigned vb = *(const unsigned*)(uo + (size_t)(chain0 + 1) * 64 * 8192 + off);
      float o0 = bf2f(vf & 0xffff) + bf2f(vb & 0xffff);
      float o1 = bf2f(vf >> 16) + bf2f(vb >> 16);
      float ss = wave_sum(o0 * o0 + o1 * o1);
      float sc = rsqrtf(ss * (1.f / 128.f) + EPSF);
      unsigned z = *(const unsigned*)(pm + (size_t)t * 4096 + 1536 + c);
      float z0 = bf2f(z & 0xffff), z1 = bf2f(z >> 16);
      o0 = o0 * sc * gdn_g[2 * lane] * (z0 * sigmoidf(z0));
      o1 = o1 * sc * gdn_g[2 * lane + 1] * (z1 * sigmoidf(z1));
      *(unsigned*)(y + (size_t)t * DM + c) = (unsigned)f2bf(o0) | ((unsigned)f2bf(o1) << 16);
    }
    {
      unsigned vf = *(const unsigned*)(oM + (size_t)t * 512 + c);
      unsigned vb = *(const unsigned*)(oM + ((size_t)NT + t) * 512 + c);
      float o0 = bf2f(vf & 0xffff) + bf2f(vb & 0xffff);
      float o1 = bf2f(vf >> 16) + bf2f(vb >> 16);
      float ss = wave_sum(o0 * o0 + o1 * o1);
      float sc = rsqrtf(ss * (1.f / 128.f) + EPSF);
      unsigned z = *(const unsigned*)(pm + (size_t)t * 4096 + 3584 + c);
      float z0 = bf2f(z & 0xffff), z1 = bf2f(z >> 16);
      o0 = o0 * sc * ml_g[c] * sigmoidf(z0);
      o1 = o1 * sc * ml_g[c + 1] * sigmoidf(z1);
      *(unsigned*)(y + (size_t)t * DM + 512 + c) = (unsigned)f2bf(o0) | ((unsigned)f2bf(o1) << 16);
    }
  }
}

#ifdef DBG_CHECK
__device__ __forceinline__ void d_dbg_cmp(int item, const unsigned short* __restrict__ uo, const unsigned short* __restrict__ oAd,
                                          float* __restrict__ dbg) {
  int t = item * 4 + (threadIdx.x >> 6);
  int lane = threadIdx.x & 63;
  const int cc = (t >> 6) & 63, ii = t & 63;
  float sd = 0.f, sr = 0.f;
  for (int h = 0; h < 4; ++h) {
    for (int dir = 0; dir < 2; ++dir) {
      const int chain = h * 2 + dir;
      const size_t off = (size_t)cc * 8192 + (lane >> 4) * 2048 + ii * 32 + ((2 * lane) & 31);
      unsigned vn = *(const unsigned*)(uo + (size_t)chain * 64 * 8192 + off);
      unsigned vr = *(const unsigned*)(oAd + ((size_t)dir * 4096 + t) * 512 + h * 128 + 2 * lane);
      float n0 = bf2f(vn & 0xffff), n1 = bf2f(vn >> 16), r0 = bf2f(vr & 0xffff), r1 = bf2f(vr >> 16);
      sd += (n0 - r0) * (n0 - r0) + (n1 - r1) * (n1 - r1);
      sr += r0 * r0 + r1 * r1;
    }
  }
  sd = wave_sum(sd); sr = wave_sum(sr);
  if (lane == 0) { atomicAdd(&dbg[0], sd); atomicAdd(&dbg[1], sr); }
}
__device__ __forceinline__ void d_dbg_cmp_m(int item, const unsigned short* __restrict__ oM, const unsigned short* __restrict__ oMd,
                                            float* __restrict__ dbg) {
  int t = item * 4 + (threadIdx.x >> 6);
  int lane = threadIdx.x & 63;
  float sd = 0.f, sr = 0.f;
  for (int dir = 0; dir < 2; ++dir)
    for (int q = 0; q < 4; ++q) {
      unsigned vn = *(const unsigned*)(oM + ((size_t)dir * NT + t) * 512 + q * 128 + 2 * lane);
      unsigned vr = *(const unsigned*)(oMd + ((size_t)dir * 4096 + t) * 512 + q * 128 + 2 * lane);
      float n0 = bf2f(vn & 0xffff), n1 = bf2f(vn >> 16), r0 = bf2f(vr & 0xffff), r1 = bf2f(vr >> 16);
      sd += (n0 - r0) * (n0 - r0) + (n1 - r1) * (n1 - r1);
      sr += r0 * r0 + r1 * r1;
    }
  sd = wave_sum(sd); sr = wave_sum(sr);
  if (lane == 0) { atomicAdd(&dbg[0], sd); atomicAdd(&dbg[1], sr); }
}
#endif

__device__ __forceinline__ void d_prep_x1(int item, const float* __restrict__ x1, unsigned short* __restrict__ xb,
                                                 float* __restrict__ rs) {
  int t = item * 4 + (threadIdx.x >> 6);
  int lane = threadIdx.x & 63;
  const float4* xr = (const float4*)(x1 + (size_t)t * DM);
  float ss = 0.f;
#pragma unroll
  for (int i = 0; i < 4; ++i) {
    float4 v = xr[lane + 64 * i];
    ss += v.x * v.x + v.y * v.y + v.z * v.z + v.w * v.w;
    ushort4 o;
    o.x = f2bf(v.x); o.y = f2bf(v.y); o.z = f2bf(v.z); o.w = f2bf(v.w);
    ((ushort4*)(xb + (size_t)t * DM))[lane + 64 * i] = o;
  }
  ss = wave_sum(ss);
  if (lane == 0) rs[t] = rsqrtf(ss * (1.f / DM) + EPSF);
}

__device__ const unsigned char kPairTab[64] = {
    0x00, 0x01, 0x02, 0x03, 0x04, 0x05, 0x06, 0x07, 0x08, 0x09, 0x0a, 0x0b, 0x0c, 0x0d, 0x0e, 0x0f,
    0x10, 0x11, 0x12, 0x13, 0x14, 0x15, 0x16, 0x17,
    0x20, 0x21, 0x22, 0x23, 0x24,
    0x30, 0x31, 0x32, 0x33,
    0x40, 0x41, 0x42,
    0x50, 0x51, 0x60, 0x61, 0x70, 0x71,
    0x80, 0x90, 0xa0, 0xb0, 0xc0, 0xd0, 0xe0, 0xf0,
    0xff, 0xff, 0xff, 0xff, 0xff, 0xff, 0xff, 0xff, 0xff, 0xff, 0xff, 0xff, 0xff, 0xff};

__device__ __forceinline__ void wave_top16(float va, int ia, float vb, int ib, int lane, float& outv, int& outi) {
  outv = -INFINITY; outi = 0;
  for (int r = 0; r < 16; ++r) {
    float bv; int bi;
    if (va >= vb) { bv = va; bi = ia; } else { bv = vb; bi = ib; }
#pragma unroll
    for (int o = 32; o > 0; o >>= 1) {
      float ov = __shfl_xor(bv, o, 64);
      int oi = __shfl_xor(bi, o, 64);
      if (ov > bv || (ov == bv && oi < bi)) { bv = ov; bi = oi; }
    }
    if (lane == r) { outv = bv; outi = bi; }
    if (bi == ia) va = -INFINITY;
    if (bi == ib) vb = -INFINITY;
  }
}

__device__ __forceinline__ void d_topk(int item, const unsigned short* __restrict__ scores, int* __restrict__ idx_out,
                                              float* __restrict__ gate_out) {
  const int w = item * 4 + (threadIdx.x >> 6);
  const int lane = threadIdx.x & 63;
  const int t = w >> 3, h = w & 7;
  const unsigned short* sp = scores + (size_t)t * 2048 + h * 256;
  float s0v, s1v; int i0v, i1v;
  wave_top16(bf2f(sp[lane]), lane, bf2f(sp[lane + 64]), lane + 64, lane, s0v, i0v);
  wave_top16(bf2f(sp[128 + lane]), lane, bf2f(sp[128 + lane + 64]), lane + 64, lane, s1v, i1v);
  const int pr = kPairTab[lane];
  const int pi = (pr >> 4) & 15, pj = pr & 15;
  float c0 = __shfl(s0v, pi, 64) + __shfl(s1v, pj, 64);
  int ci = __shfl(i0v, pi, 64) * 128 + __shfl(i1v, pj, 64);
  if (pr == 0xff) { c0 = -INFINITY; ci = 0x7fffffff; }
  float bestv; int besti;
  wave_top16(c0, ci, -INFINITY, -1, lane, bestv, besti);
  float mx = __shfl(bestv, 0, 64);
  float ev = (lane < 16) ? expf(bestv - mx) : 0.f;
  float sum = wave_sum(ev);
  if (lane < 16) {
    idx_out[(size_t)t * 128 + h * 16 + lane] = besti;
    gate_out[(size_t)t * 128 + h * 16 + lane] = ev / sum;
  }
}

__device__ __forceinline__ void d_cvt_tab(int item, const float* __restrict__ src, unsigned short* __restrict__ dst) {
  const size_t base = (size_t)item * 2048 + threadIdx.x * 8;
  const float4 a = *(const float4*)(src + base);
  const float4 b = *(const float4*)(src + base + 4);
  uint4 o;
  o.x = (unsigned)f2bf(a.x) | ((unsigned)f2bf(a.y) << 16);
  o.y = (unsigned)f2bf(a.z) | ((unsigned)f2bf(a.w) << 16);
  o.z = (unsigned)f2bf(b.x) | ((unsigned)f2bf(b.y) << 16);
  o.w = (unsigned)f2bf(b.z) | ((unsigned)f2bf(b.w) << 16);
  *(uint4*)(dst + base) = o;
}

__device__ __forceinline__ float dot8(const uint4 u, const float* hv) {
  float d = bf2f(u.x & 0xffff) * hv[0];
  d += __uint_as_float(u.x & 0xffff0000u) * hv[1];
  d += bf2f(u.y & 0xffff) * hv[2];
  d += __uint_as_float(u.y & 0xffff0000u) * hv[3];
  d += bf2f(u.z & 0xffff) * hv[4];
  d += __uint_as_float(u.z & 0xffff0000u) * hv[5];
  d += bf2f(u.w & 0xffff) * hv[6];
  d += __uint_as_float(u.w & 0xffff0000u) * hv[7];
  return d;
}
__device__ __forceinline__ void axpy8(const uint4 v, const float wg, float* acc) {
  acc[0] += wg * bf2f(v.x & 0xffff);
  acc[1] += wg * __uint_as_float(v.x & 0xffff0000u);
  acc[2] += wg * bf2f(v.y & 0xffff);
  acc[3] += wg * __uint_as_float(v.y & 0xffff0000u);
  acc[4] += wg * bf2f(v.z & 0xffff);
  acc[5] += wg * __uint_as_float(v.z & 0xffff0000u);
  acc[6] += wg * bf2f(v.w & 0xffff);
  acc[7] += wg * __uint_as_float(v.w & 0xffff0000u);
}
__device__ __forceinline__ void d_peer(int item, const float* __restrict__ x1, const float* __restrict__ rs2,
                                       const float* __restrict__ g2, const int* __restrict__ idx,
                                       const float* __restrict__ gate, const unsigned short* __restrict__ pu,
                                       const unsigned short* __restrict__ pv, const float* __restrict__ gf,
                                       float* __restrict__ out, float oscale) {
  const int t = item * 4 + (threadIdx.x >> 6);
  const int lane = threadIdx.x & 63;
  float r2;
  {
    const float4* pr = (const float4*)(rs2 + (size_t)t * 16);
    const float4 s0 = pr[0], s1 = pr[1], s2 = pr[2], s3 = pr[3];
    const float ssq = ((s0.x + s0.y) + (s0.z + s0.w)) + ((s1.x + s1.y) + (s1.z + s1.w)) + ((s2.x + s2.y) + (s2.z + s2.w)) + ((s3.x + s3.y) + (s3.z + s3.w));
    r2 = rsqrtf(ssq * (1.f / DM) + EPSF);
  }
  float xv[16], hv[16], acc[16];
#pragma unroll
  for (int j = 0; j < 2; ++j)
#pragma unroll
    for (int q = 0; q < 2; ++q) {
      const float4 xx = *(const float4*)(x1 + (size_t)t * DM + j * 512 + lane * 8 + q * 4);
      const float4 gg = *(const float4*)(g2 + j * 512 + lane * 8 + q * 4);
      xv[j * 8 + q * 4 + 0] = xx.x; xv[j * 8 + q * 4 + 1] = xx.y; xv[j * 8 + q * 4 + 2] = xx.z; xv[j * 8 + q * 4 + 3] = xx.w;
      hv[j * 8 + q * 4 + 0] = xx.x * r2 * gg.x; hv[j * 8 + q * 4 + 1] = xx.y * r2 * gg.y;
      hv[j * 8 + q * 4 + 2] = xx.z * r2 * gg.z; hv[j * 8 + q * 4 + 3] = xx.w * r2 * gg.w;
    }
#pragma unroll
  for (int i = 0; i < 16; ++i) acc[i] = 0.f;
  const int id_a = idx[(size_t)t * 128 + lane], id_b = idx[(size_t)t * 128 + 64 + lane];
  const float gt_a = gate[(size_t)t * 128 + lane], gt_b = gate[(size_t)t * 128 + 64 + lane];
  for (int e0 = 0; e0 < 128; e0 += 4) {
    uint4 u[4][2], v[4][2];
    float gt4[4];
#pragma unroll
    for (int k = 0; k < 4; ++k) {
      const int e = e0 + k;
      const int id = (e0 < 64) ? __shfl(id_a, e, 64) : __shfl(id_b, e - 64, 64);
      gt4[k] = (e0 < 64) ? __shfl(gt_a, e, 64) : __shfl(gt_b, e - 64, 64);
      const unsigned short* ur = pu + (size_t)id * DM + lane * 8;
      const unsigned short* vr = pv + (size_t)id * DM + lane * 8;
      u[k][0] = *(const uint4*)(ur); u[k][1] = *(const uint4*)(ur + 512);
      v[k][0] = *(const uint4*)(vr); v[k][1] = *(const uint4*)(vr + 512);
    }
    float d[4];
#pragma unroll
    for (int k = 0; k < 4; ++k) d[k] = dot8(u[k][0], hv) + dot8(u[k][1], hv + 8);
#pragma unroll
    for (int o = 32; o > 0; o >>= 1) {
#pragma unroll
      for (int k = 0; k < 4; ++k) d[k] += __shfl_xor(d[k], o, 64);
    }
#pragma unroll
    for (int k = 0; k < 4; ++k) {
      const float act = 0.5f * d[k] * (1.f + erff(d[k] * 0.7071067811865476f));
      const float wg = gt4[k] * act;
      axpy8(v[k][0], wg, acc);
      axpy8(v[k][1], wg, acc + 8);
    }
  }
  float ss = 0.f;
#pragma unroll
  for (int i = 0; i < 16; ++i) { acc[i] += xv[i]; ss += acc[i] * acc[i]; }
  ss = wave_sum(ss);
  const float sc = rsqrtf(ss * (1.f / DM) + EPSF) * oscale;
#pragma unroll
  for (int j = 0; j < 2; ++j)
#pragma unroll
    for (int q = 0; q < 2; ++q) {
      const float4 gg = *(const float4*)(gf + j * 512 + lane * 8 + q * 4);
      float4 o;
      o.x = acc[j * 8 + q * 4 + 0] * sc * gg.x; o.y = acc[j * 8 + q * 4 + 1] * sc * gg.y;
      o.z = acc[j * 8 + q * 4 + 2] * sc * gg.z; o.w = acc[j * 8 + q * 4 + 3] * sc * gg.w;
      *(float4*)(out + (size_t)t * DM + j * 512 + lane * 8 + q * 4) = o;
    }
}

typedef __attribute__((ext_vector_type(16))) float f32x16;
#define MFMA32(a, b, c) __builtin_amdgcn_mfma_f32_32x32x16_bf16((a), (b), (c), 0, 0, 0)
__device__ __forceinline__ int crow(int reg, int hh) { return (reg & 3) + 8 * (reg >> 2) + 4 * hh; }
__device__ __forceinline__ unsigned pack2(float a, float b) { return (unsigned)f2bf(a) | ((unsigned)f2bf(b) << 16); }

struct GdnBufs {
  unsigned short* qc;
  unsigned short* kTc;
  unsigned short* qkc;
  unsigned short* wn;
  unsigned short* uo;
  float* gsc;
};

__device__ __forceinline__ void tri_subst(const float* AL, int lane, float (&T)[64]) {
#pragma unroll
  for (int i = 0; i < 64; ++i) T[i] = 0.f;
  T[0] = (lane == 0) ? 1.f : 0.f;
#pragma unroll
  for (int i = 1; i < 64; ++i) {
    float ax = 0.f, ay = 0.f, az = 0.f, aw = 0.f;
#pragma unroll
    for (int j4 = 0; j4 < (i + 3) / 4; ++j4) {
      const float4 a = *(const float4*)(AL + i * 72 + 4 * j4);
      ax += a.x * T[4 * j4]; ay += a.y * T[4 * j4 + 1]; az += a.z * T[4 * j4 + 2]; aw += a.w * T[4 * j4 + 3];
    }
    T[i] = ((lane == i) ? 1.f : 0.f) - ((ax + ay) + (az + aw));
  }
}

__device__ __forceinline__ void d_gdn_prep(int item, char* smem, const unsigned short* __restrict__ pm,
                                           const float* __restrict__ gt, const float* __restrict__ conv_w, GdnBufs G) {
  unsigned short* qL = (unsigned short*)smem;
  unsigned short* kL = qL + 64 * 144;
  unsigned short* kTL = kL + 64 * 144;
  unsigned short* vTL = kTL + 128 * 72;
  float* scal = (float*)(vTL + 128 * 72);
  float* A0 = (float*)qL;
  float* A1 = (float*)kL;
  int tid = threadIdx.x;
  asm volatile("" : "+v"(tid));
  const int lane = tid & 63, w = __builtin_amdgcn_readfirstlane(tid >> 6), r = lane & 31, hh = lane >> 5;
  const int bh = item >> 6, c = item & 63, b = bh >> 2, h = bh & 3;
  const int t0 = b * SEQ + c * 64;
  __syncthreads();
  {
    float cw[3][2][5];
#pragma unroll
    for (int sec = 0; sec < 3; ++sec)
#pragma unroll
      for (int j = 0; j < 5; ++j) {
        cw[sec][0][j] = conv_w[(sec * 512 + h * 128 + 2 * lane) * 5 + j];
        cw[sec][1][j] = conv_w[(sec * 512 + h * 128 + 2 * lane + 1) * 5 + j];
      }
    for (int ii = 0; ii < 16; ++ii) {
      const int i = w * 16 + ii;
      const int s = c * 64 + i;
      const size_t t = (size_t)t0 + i;
#pragma unroll
      for (int sec = 0; sec < 3; ++sec) {
        const int c0 = sec * 512 + h * 128 + 2 * lane;
        float a0 = 0.f, a1 = 0.f;
#pragma unroll
        for (int j = 0; j < 5; ++j) {
          const int sp = s + j - 2;
          if (sp >= 0 && sp < SEQ) {
            const unsigned v = *(const unsigned*)(pm + (t + j - 2) * 4096 + c0);
            a0 += cw[sec][0][j] * bf2f((unsigned short)(v & 0xffff));
            a1 += cw[sec][1][j] * bf2f((unsigned short)(v >> 16));
          }
        }
        a0 = a0 * sigmoidf(a0);
        a1 = a1 * sigmoidf(a1);
        if (sec < 2) {
          const float ss = wave_sum(a0 * a0 + a1 * a1);
          float sc = rsqrtf(ss + EPSF);
          if (sec == 0) sc *= 0.08838834764831845f;
          a0 *= sc; a1 *= sc;
        }
        if (sec == 0) {
          *(unsigned*)(qL + i * 144 + 2 * lane) = pack2(a0, a1);
        } else if (sec == 1) {
          *(unsigned*)(kL + i * 144 + 2 * lane) = pack2(a0, a1);
          kTL[(2 * lane) * 72 + i] = f2bf(a0);
          kTL[(2 * lane + 1) * 72 + i] = f2bf(a1);
        } else {
          vTL[(2 * lane) * 72 + i] = f2bf(a0);
          vTL[(2 * lane + 1) * 72 + i] = f2bf(a1);
        }
      }
    }
  }
  if (w == 0) {
    const float* gp = gt + ((size_t)t0 + lane) * 32;
    const float g0 = gp[h], g1 = gp[4 + h], b0 = gp[8 + h], b1 = gp[12 + h];
    float G0 = g0, G1 = g1;
#pragma unroll
    for (int o = 1; o < 64; o <<= 1) {
      const float v0 = __shfl_up(G0, o, 64);
      const float v1 = __shfl_down(G1, o, 64);
      if (lane >= o) G0 += v0;
      if (lane + o < 64) G1 += v1;
    }
    scal[lane] = G0; scal[64 + lane] = G1; scal[128 + lane] = b0; scal[192 + lane] = b1;
    const float GL0 = __shfl(G0, 63, 64), GL1 = __shfl(G1, 0, 64);
    float* gs0 = G.gsc + ((size_t)((bh * 2 + 0) * 64 + c)) * 192;
    float* gs1 = G.gsc + ((size_t)((bh * 2 + 1) * 64 + c)) * 192;
    gs0[lane] = expf(G0); gs0[64 + lane] = expf(GL0 - G0);
    gs1[lane] = expf(G1); gs1[64 + lane] = expf(GL1 - G1);
    if (lane == 0) { gs0[128] = expf(GL0); gs1[128] = expf(GL1); }
  }
  __syncthreads();
  {
    unsigned short* qg = G.qc + (size_t)item * 8192;
    unsigned short* kg = G.kTc + (size_t)item * 8192;
#pragma unroll
    for (int i = 0; i < 4; ++i) {
      const int id = tid + i * 256;
      *(uint4*)(qg + (id >> 4) * 128 + (id & 15) * 8) = *(const uint4*)(qL + (id >> 4) * 144 + (id & 15) * 8);
      *(uint4*)(kg + (id >> 3) * 64 + (id & 7) * 8) = *(const uint4*)(kTL + (id >> 3) * 72 + (id & 7) * 8);
    }
  }
  {
    const int ta = w >> 1, tb = w & 1;
    f32x16 acc, acc2;
#pragma unroll
    for (int i = 0; i < 16; ++i) { acc[i] = 0.f; acc2[i] = 0.f; }
#pragma unroll
    for (int s = 0; s < 8; ++s) {
      const bf16x8 a = *(const bf16x8*)(kL + (32 * ta + r) * 144 + 16 * s + 8 * hh);
      const bf16x8 bk = *(const bf16x8*)(kL + (32 * tb + r) * 144 + 16 * s + 8 * hh);
      const bf16x8 bq = *(const bf16x8*)(qL + (32 * tb + r) * 144 + 16 * s + 8 * hh);
      acc = MFMA32(a, bk, acc);
      acc2 = MFMA32(a, bq, acc2);
    }
    __syncthreads();
    {
      const int col = 32 * tb + r;
      const float G0c = scal[col], G1c = scal[64 + col];
#pragma unroll
      for (int reg = 0; reg < 16; ++reg) {
        const int row = 32 * ta + crow(reg, hh);
        const float v = acc[reg];
        const float a0 = (col < row) ? scal[128 + row] * v * expf(scal[row] - G0c) : 0.f;
        const float a1 = (col > row) ? scal[192 + row] * v * expf(scal[64 + row] - G1c) : 0.f;
        A0[row * 72 + col] = a0;
        A1[(63 - row) * 72 + (63 - col)] = a1;
      }
    }
    {
      const int i = 32 * tb + r;
      const float G0i = scal[i], G1i = scal[64 + i];
      unsigned short* qk0 = G.qkc + ((size_t)((bh * 2 + 0) * 64 + c)) * 4096;
      unsigned short* qk1 = G.qkc + ((size_t)((bh * 2 + 1) * 64 + c)) * 4096;
#pragma unroll
      for (int g = 0; g < 4; ++g) {
        float o0[4], o1[4];
#pragma unroll
        for (int e = 0; e < 4; ++e) {
          const int j = 32 * ta + 8 * g + 4 * hh + e;
          const float v = acc2[4 * g + e];
          o0[e] = (j <= i) ? v * expf(G0i - scal[j]) : 0.f;
          o1[e] = (j >= i) ? v * expf(G1i - scal[64 + j]) : 0.f;
        }
        uint2 p0, p1;
        p0.x = pack2(o0[0], o0[1]); p0.y = pack2(o0[2], o0[3]);
        p1.x = pack2(o1[0], o1[1]); p1.y = pack2(o1[2], o1[3]);
        *(uint2*)(qk0 + i * 64 + 32 * ta + 8 * g + 4 * hh) = p0;
        *(uint2*)(qk1 + i * 64 + 32 * ta + 8 * g + 4 * hh) = p1;
      }
    }
  }
  __syncthreads();
  if (w < 2) {
    const int dir = w;
    float T[64];
    tri_subst(dir ? A1 : A0, lane, T);
    const int jn = dir ? 63 - lane : lane;
    const float sb = scal[128 + 64 * dir + jn];
    const float sbg = sb * expf(scal[64 * dir + jn]);
    unsigned short* Tb = dir ? kL : qL;
    unsigned short* Tbg = Tb + 64 * 72;
#pragma unroll
    for (int ip = 0; ip < 64; ++ip) {
      const int in = dir ? 63 - ip : ip;
      Tb[in * 72 + jn] = f2bf(T[ip] * sb);
      Tbg[in * 72 + jn] = f2bf(T[ip] * sbg);
    }
  }
  __syncthreads();
#pragma unroll
  for (int d = 0; d < 2; ++d) {
    const int chain = bh * 2 + d;
    const unsigned short* Tb = d ? kL : qL;
    const unsigned short* Tbg = Tb + 64 * 72;
    unsigned short* wng = G.wn + ((size_t)(chain * 64 + c)) * 8192;
    unsigned short* uog = G.uo + ((size_t)(chain * 64 + c)) * 8192 + w * 2048;
#pragma unroll
    for (int tb = 0; tb < 2; ++tb) {
      f32x16 acc, acc2;
#pragma unroll
      for (int i = 0; i < 16; ++i) { acc[i] = 0.f; acc2[i] = 0.f; }
#pragma unroll
      for (int s = 0; s < 4; ++s) {
        const bf16x8 a = *(const bf16x8*)(kTL + (32 * w + r) * 72 + 16 * s + 8 * hh);
        const bf16x8 bb = *(const bf16x8*)(Tbg + (32 * tb + r) * 72 + 16 * s + 8 * hh);
        acc = MFMA32(a, bb, acc);
        const bf16x8 a2 = *(const bf16x8*)(Tb + (32 * tb + r) * 72 + 16 * s + 8 * hh);
        const bf16x8 b2 = *(const bf16x8*)(vTL + (32 * w + r) * 72 + 16 * s + 8 * hh);
        acc2 = MFMA32(a2, b2, acc2);
      }
#pragma unroll
      for (int g = 0; g < 4; ++g) {
        uint2 pk;
        pk.x = pack2(-acc[4 * g], -acc[4 * g + 1]); pk.y = pack2(-acc[4 * g + 2], -acc[4 * g + 3]);
        *(uint2*)(wng + (32 * tb + r) * 128 + 32 * w + 8 * g + 4 * hh) = pk;
      }
      uint4 u0, u1;
      u0.x = pack2(acc2[0], acc2[1]); u0.y = pack2(acc2[2], acc2[3]); u0.z = pack2(acc2[4], acc2[5]); u0.w = pack2(acc2[6], acc2[7]);
      u1.x = pack2(acc2[8], acc2[9]); u1.y = pack2(acc2[10], acc2[11]); u1.z = pack2(acc2[12], acc2[13]); u1.w = pack2(acc2[14], acc2[15]);
      *(uint4*)(uog + tb * 1024 + lane * 16) = u0;
      *(uint4*)(uog + tb * 1024 + lane * 16 + 8) = u1;
    }
  }
}

__device__ __forceinline__ void d_gdn_scan(int chain, int sl, char* smem, GdnBufs G) {
  unsigned short* ST = (unsigned short*)smem;
  unsigned short* VT = ST + 32 * 136;
  unsigned short* VdT = VT + 32 * 72;
  const int tid = threadIdx.x, lane = tid & 63, w = tid >> 6, r = lane & 31, hh = lane >> 5;
  const int bh = chain >> 1, dir = chain & 1;
  f32x16 S;
#pragma unroll
  for (int i = 0; i < 16; ++i) S[i] = 0.f;
  for (int step = 0; step < 64; ++step) {
    const int c = dir ? 63 - step : step;
    const unsigned short* wn_c = G.wn + ((size_t)(chain * 64 + c)) * 8192;
    const unsigned short* q_c = G.qc + ((size_t)(bh * 64 + c)) * 8192;
    const unsigned short* kT_c = G.kTc + ((size_t)(bh * 64 + c)) * 8192;
    const unsigned short* qk_c = G.qkc + ((size_t)(chain * 64 + c)) * 4096;
    unsigned short* uo_c = G.uo + ((size_t)(chain * 64 + c)) * 8192 + sl * 2048;
    const float* gs = G.gsc + ((size_t)(chain * 64 + c)) * 192;
    const int ti = w & 1;
    bf16x8 kt[4], a[8], bq[4];
    float rs[16];
    f32x16 acc;
#pragma unroll
    for (int s = 0; s < 4; ++s) kt[s] = *(const bf16x8*)(kT_c + (32 * w + r) * 64 + 16 * s + 8 * hh);
    const float gtot = gs[128];
    if (w < 2) {
#pragma unroll
      for (int s = 0; s < 8; ++s) a[s] = *(const bf16x8*)(wn_c + (32 * ti + r) * 128 + 16 * s + 8 * hh);
      const uint4 u0 = *(const uint4*)(uo_c + ti * 1024 + lane * 16);
      const uint4 u1 = *(const uint4*)(uo_c + ti * 1024 + lane * 16 + 8);
      acc[0] = bf2f(u0.x & 0xffff); acc[1] = bf2f(u0.x >> 16); acc[2] = bf2f(u0.y & 0xffff); acc[3] = bf2f(u0.y >> 16);
      acc[4] = bf2f(u0.z & 0xffff); acc[5] = bf2f(u0.z >> 16); acc[6] = bf2f(u0.w & 0xffff); acc[7] = bf2f(u0.w >> 16);
      acc[8] = bf2f(u1.x & 0xffff); acc[9] = bf2f(u1.x >> 16); acc[10] = bf2f(u1.y & 0xffff); acc[11] = bf2f(u1.y >> 16);
      acc[12] = bf2f(u1.z & 0xffff); acc[13] = bf2f(u1.z >> 16); acc[14] = bf2f(u1.w & 0xffff); acc[15] = bf2f(u1.w >> 16);
#pragma unroll
      for (int reg = 0; reg < 16; ++reg) rs[reg] = gs[64 + 32 * ti + crow(reg, hh)];
    } else {
#pragma unroll
      for (int s = 0; s < 8; ++s) a[s] = *(const bf16x8*)(q_c + (32 * ti + r) * 128 + 16 * s + 8 * hh);
#pragma unroll
      for (int s = 0; s < 4; ++s) bq[s] = *(const bf16x8*)(qk_c + (32 * ti + r) * 64 + 16 * s + 8 * hh);
#pragma unroll
      for (int i = 0; i < 16; ++i) acc[i] = 0.f;
#pragma unroll
      for (int reg = 0; reg < 16; ++reg) rs[reg] = gs[32 * ti + crow(reg, hh)];
    }
#pragma unroll
    for (int g = 0; g < 4; ++g) {
      uint2 pk;
      pk.x = pack2(S[4 * g], S[4 * g + 1]); pk.y = pack2(S[4 * g + 2], S[4 * g + 3]);
      *(uint2*)(ST + r * 136 + 32 * w + 8 * g + 4 * hh) = pk;
    }
    __syncthreads();
#pragma unroll
    for (int s = 0; s < 8; ++s) {
      const bf16x8 bs = *(const bf16x8*)(ST + r * 136 + 16 * s + 8 * hh);
      acc = MFMA32(a[s], bs, acc);
    }
    if (w < 2) {
#pragma unroll
      for (int g = 0; g < 4; ++g) {
        uint2 pk, pd;
        pk.x = pack2(acc[4 * g], acc[4 * g + 1]); pk.y = pack2(acc[4 * g + 2], acc[4 * g + 3]);
        pd.x = pack2(acc[4 * g] * rs[4 * g], acc[4 * g + 1] * rs[4 * g + 1]);
        pd.y = pack2(acc[4 * g + 2] * rs[4 * g + 2], acc[4 * g + 3] * rs[4 * g + 3]);
        *(uint2*)(VT + r * 72 + 32 * ti + 8 * g + 4 * hh) = pk;
        *(uint2*)(VdT + r * 72 + 32 * ti + 8 * g + 4 * hh) = pd;
      }
    } else {
#pragma unroll
      for (int reg = 0; reg < 16; ++reg) acc[reg] *= rs[reg];
    }
    __syncthreads();
    if (w >= 2) {
#pragma unroll
      for (int s = 0; s < 4; ++s) {
        const bf16x8 bv = *(const bf16x8*)(VT + r * 72 + 16 * s + 8 * hh);
        acc = MFMA32(bq[s], bv, acc);
      }
#pragma unroll
      for (int reg = 0; reg < 16; ++reg) uo_c[(32 * ti + crow(reg, hh)) * 32 + r] = f2bf(acc[reg]);
    }
#pragma unroll
    for (int i = 0; i < 16; ++i) S[i] *= gtot;
#pragma unroll
    for (int s = 0; s < 4; ++s) {
      const bf16x8 bv = *(const bf16x8*)(VdT + r * 72 + 16 * s + 8 * hh);
      S = MFMA32(kt[s], bv, S);
    }
  }
}


__device__ __forceinline__ void d_mlstm_scan(int chain, int sl, char* smem, const unsigned short* __restrict__ pm,
                                             const float* __restrict__ gt, unsigned short* __restrict__ oM, int ntok) {
  unsigned short* qL = (unsigned short*)smem;
  unsigned short* kL = qL + 64 * 136;
  unsigned short* kdL = kL + 64 * 136;
  unsigned short* vTL = kdL + 64 * 136;
  unsigned short* S0T = vTL + 32 * 72;
  unsigned short* nL = S0T + 32 * 136;
  float* scal = (float*)(nL + 256);
  const int tid = threadIdx.x, lane = tid & 63, w = tid >> 6, r = lane & 31, hh = lane >> 5;
  const int bh = chain >> 1, dir = chain & 1, b = bh >> 2, h = bh & 3;
  const float SCALE = 0.08838834764831845f;
  f32x16 S0, S1;
#pragma unroll
  for (int i = 0; i < 16; ++i) { S0[i] = 0.f; S1[i] = 0.f; }
  bf16x8 ones;
#pragma unroll
  for (int i = 0; i < 8; ++i) ones[i] = (short)0x3F80;
  for (int step = 0; step < 64; ++step) {
    const int c = dir ? 63 - step : step;
    const size_t t0 = (size_t)b * SEQ + c * 64;
    const float lf = gt[(t0 + lane) * 32 + 24 + dir * 4 + h];
    const float ip = gt[(t0 + lane) * 32 + 16 + dir * 4 + h];
    float bc = lf;
#pragma unroll
    for (int o = 1; o < 64; o <<= 1) {
      const float vu = __shfl_up(bc, o, 64);
      const float vd = __shfl_down(bc, o, 64);
      if (dir == 0) { if (lane >= o) bc += vu; } else { if (lane + o < 64) bc += vd; }
    }
    const float b_last = __shfl(bc, dir ? 0 : 63, 64);
    const float Dj = SCALE * expf(b_last - bc + ip);
    const float gtot = expf(b_last);
    __syncthreads();
    if (w == 0) { scal[lane] = expf(bc); scal[64 + lane] = ip - bc; scal[128 + lane] = bc; }
#pragma unroll
    for (int i = 0; i < 4; ++i) {
      const int id = tid + i * 256;
      const int row = id >> 4, c16 = id & 15;
      const uint4 qv = *(const uint4*)(pm + (t0 + row) * 4096 + 2048 + h * 128 + c16 * 8);
      const uint4 kv = *(const uint4*)(pm + (t0 + row) * 4096 + 2560 + h * 128 + c16 * 8);
      *(uint4*)(qL + row * 136 + c16 * 8) = qv;
      *(uint4*)(kL + row * 136 + c16 * 8) = kv;
      const float d = __shfl(Dj, row, 64);
      uint4 kd;
      kd.x = pack2(bf2f(kv.x & 0xffff) * d, bf2f(kv.x >> 16) * d);
      kd.y = pack2(bf2f(kv.y & 0xffff) * d, bf2f(kv.y >> 16) * d);
      kd.z = pack2(bf2f(kv.z & 0xffff) * d, bf2f(kv.z >> 16) * d);
      kd.w = pack2(bf2f(kv.w & 0xffff) * d, bf2f(kv.w >> 16) * d);
      *(uint4*)(kdL + row * 136 + c16 * 8) = kd;
    }
    {
      const int tok = tid >> 2, d8 = (tid & 3) * 8;
      const uint4 vv = *(const uint4*)(pm + (t0 + tok) * 4096 + 3072 + h * 128 + sl * 32 + d8);
      vTL[(d8 + 0) * 72 + tok] = (unsigned short)(vv.x & 0xffff);
      vTL[(d8 + 1) * 72 + tok] = (unsigned short)(vv.x >> 16);
      vTL[(d8 + 2) * 72 + tok] = (unsigned short)(vv.y & 0xffff);
      vTL[(d8 + 3) * 72 + tok] = (unsigned short)(vv.y >> 16);
      vTL[(d8 + 4) * 72 + tok] = (unsigned short)(vv.z & 0xffff);
      vTL[(d8 + 5) * 72 + tok] = (unsigned short)(vv.z >> 16);
      vTL[(d8 + 6) * 72 + tok] = (unsigned short)(vv.w & 0xffff);
      vTL[(d8 + 7) * 72 + tok] = (unsigned short)(vv.w >> 16);
    }
#pragma unroll
    for (int g = 0; g < 4; ++g) {
      uint2 pk;
      pk.x = pack2(S0[4 * g], S0[4 * g + 1]); pk.y = pack2(S0[4 * g + 2], S0[4 * g + 3]);
      *(uint2*)(S0T + r * 136 + 32 * w + 8 * g + 4 * hh) = pk;
      if (r == 0) {
        uint2 pn;
        pn.x = pack2(S1[4 * g], S1[4 * g + 1]); pn.y = pack2(S1[4 * g + 2], S1[4 * g + 3]);
        *(uint2*)(nL + 32 * w + 8 * g + 4 * hh) = pn;
      }
    }
    __syncthreads();
    if (w < 2) {
      const int ti = w;
      const int icol = 32 * ti + r;
      const float bci = scal[128 + icol];
      f32x16 Q0, Q1;
#pragma unroll
      for (int i = 0; i < 16; ++i) { Q0[i] = 0.f; Q1[i] = 0.f; }
#pragma unroll
      for (int s2 = 0; s2 < 8; ++s2) {
        const bf16x8 a = *(const bf16x8*)(qL + (32 * ti + r) * 136 + 16 * s2 + 8 * hh);
        const bf16x8 b0 = *(const bf16x8*)(S0T + r * 136 + 16 * s2 + 8 * hh);
        const bf16x8 b1 = *(const bf16x8*)(nL + 16 * s2 + 8 * hh);
        Q0 = MFMA32(a, b0, Q0);
        Q1 = MFMA32(a, b1, Q1);
      }
#pragma unroll
      for (int reg = 0; reg < 16; ++reg) {
        const float e = scal[32 * ti + crow(reg, hh)];
        Q0[reg] *= e; Q1[reg] *= e;
      }
#pragma unroll
      for (int tj = 0; tj < 2; ++tj) {
        f32x16 X;
#pragma unroll
        for (int i = 0; i < 16; ++i) X[i] = 0.f;
#pragma unroll
        for (int s2 = 0; s2 < 8; ++s2) {
          const bf16x8 a = *(const bf16x8*)(kL + (32 * tj + r) * 136 + 16 * s2 + 8 * hh);
          const bf16x8 bq = *(const bf16x8*)(qL + (32 * ti + r) * 136 + 16 * s2 + 8 * hh);
          X = MFMA32(a, bq, X);
        }
#pragma unroll
        for (int reg = 0; reg < 16; ++reg) {
          const int j = 32 * tj + crow(reg, hh);
          const bool valid = dir ? (j >= icol) : (j <= icol);
          X[reg] = valid ? X[reg] * SCALE * expf(bci + scal[64 + j]) : 0.f;
        }
#pragma unroll
        for (int s2 = 0; s2 < 2; ++s2) {
          union { bf16x8 v; unsigned u[4]; } xa, bv;
          xa.u[0] = pack2(X[8 * s2 + 0], X[8 * s2 + 1]); xa.u[1] = pack2(X[8 * s2 + 2], X[8 * s2 + 3]);
          xa.u[2] = pack2(X[8 * s2 + 4], X[8 * s2 + 5]); xa.u[3] = pack2(X[8 * s2 + 6], X[8 * s2 + 7]);
          const uint2 v0 = *(const uint2*)(vTL + r * 72 + 32 * tj + 16 * s2 + 4 * hh);
          const uint2 v1 = *(const uint2*)(vTL + r * 72 + 32 * tj + 16 * s2 + 8 + 4 * hh);
          bv.u[0] = v0.x; bv.u[1] = v0.y; bv.u[2] = v1.x; bv.u[3] = v1.y;
          Q0 = MFMA32(xa.v, bv.v, Q0);
          Q1 = MFMA32(xa.v, ones, Q1);
        }
      }
#pragma unroll
      for (int reg = 0; reg < 16; ++reg) {
        const int i = 32 * ti + crow(reg, hh);
        oM[((size_t)dir * ntok + t0 + i) * 512 + h * 128 + sl * 32 + r] = f2bf(Q0[reg] / fmaxf(fabsf(Q1[reg]), 1.f));
      }
    }
#pragma unroll
    for (int i = 0; i < 16; ++i) { S0[i] *= gtot; S1[i] *= gtot; }
#pragma unroll
    for (int s2 = 0; s2 < 4; ++s2) {
      union { bf16x8 v; unsigned short e[8]; } a;
#pragma unroll
      for (int e = 0; e < 8; ++e) a.e[e] = kdL[(16 * s2 + 8 * hh + e) * 136 + 32 * w + r];
      const bf16x8 bv = *(const bf16x8*)(vTL + r * 72 + 16 * s2 + 8 * hh);
      S0 = MFMA32(a.v, bv, S0);
      S1 = MFMA32(a.v, ones, S1);
    }
  }
}

struct MKP {
  const float *x, *norm1_g, *w_in, *conv_w, *a_log, *dt_bias, *gdn_g, *i_bias, *f_bias, *ml_g, *w_out, *norm2_g, *peer_wq,
      *peer_keys, *peer_u, *peer_v, *normf_g;
  float* out;
  unsigned short *pm, *x1b, *woutT, *mt, *xb, *winT, *oM, *yb, *scores, *qkv_dbg, *oA_dbg, *utab, *vtab;
  float *x1, *rs1, *rs2, *gt, *gateb, *dbg;
  unsigned* bar;
  int* idxb;
  GdnBufs G;
};

constexpr int SMEM_BYTES = 74752;

__global__ void __launch_bounds__(256, 2) k_mega(MKP P) {
  __shared__ __attribute__((aligned(16))) char smem_c[SMEM_BYTES + 16];
  {
    volatile LAS unsigned* st0 = (volatile LAS unsigned*)(smem_c + SMEM_BYTES);
    if (threadIdx.x < 4) st0[threadIdx.x] = 0u;
  }
  __syncthreads();
  XcdBarrier xb = xcd_barrier_post(P.bar, (volatile LAS unsigned*)(smem_c + SMEM_BYTES));
  unsigned short* smem = (unsigned short*)smem_c;
  const int nb = gridDim.x, bid = blockIdx.x;
  for (int it = bid; it < NT / 4; it += nb) d_prep_x(it, P.x, P.xb, P.rs1);
  for (int it = bid; it < NPAD_IN * DM / 256; it += nb) d_transpose_w(it, P.w_in, DIN, P.norm1_g, P.winT, NPAD_IN, 1);
  for (int it = bid; it < 1024 * DM / 256; it += nb) d_transpose_w(it, P.w_out, 1024, nullptr, P.woutT, 1024, 0);
  for (int it = bid; it < 2048 * 4; it += nb) d_make_mt(it, P.peer_wq, P.peer_keys, P.norm2_g, P.mt);
  if (bid == 0 && threadIdx.x < 2) P.dbg[threadIdx.x] = 0.f;
  xcd_barrier(xb);
  {
    GemmP p{};
    p.A = P.xb; p.lda = DM; p.Bt = P.winT; p.ldb = DM; p.K = DM;
    p.rowscale = P.rs1; p.obf = P.pm; p.ldo = 4096; p.of32 = P.gt; p.ldf = 32; p.resid = nullptr;
    p.a_log = P.a_log; p.dt_bias = P.dt_bias; p.i_bias = P.i_bias; p.f_bias = P.f_bias;
    for (int tile = bid; tile < (NT / 128) * 33; tile += nb) {
      gemm_tile<EPI_INPROJ>(p, tile / 33, tile % 33, smem);
      __syncthreads();
    }
  }
  xcd_barrier(xb);
  for (int it = bid; it < 1024; it += nb) d_gdn_prep(it, smem_c, P.pm, P.gt, P.conv_w, P.G);
#ifdef DBG_CHECK
#endif
  xcd_barrier(xb);
  if (bid < 128) {
    d_gdn_scan(bid >> 2, bid & 3, smem_c, P.G);
  } else if (bid < 256) {
    d_mlstm_scan((bid - 128) >> 2, (bid - 128) & 3, smem_c, P.pm, P.gt, P.oM, NT);
  }
#ifdef DBG_CHECK
  if (bid < 4) {
    __syncthreads();
    const int half = threadIdx.x >> 7;
    float* sq = (float*)smem + half * 256;
    float* sk = sq + 128;
    d_mlstm_rec(bid * 2 + half, sq, sk, P.pm, P.gt, P.oA_dbg, 4096);
  }
#endif
  xcd_barrier(xb);
  for (int it = bid; it < NT / 4; it += nb) d_combine(it, P.G.uo, P.oM, P.pm, P.gdn_g, P.ml_g, P.yb);
#ifdef DBG_CHECK
  for (int it = bid; it < 4096 / 4; it += nb) d_dbg_cmp_m(it, P.oM, P.oA_dbg, P.dbg);
#endif
  xcd_barrier(xb);
  {
    GemmP p{};
    p.A = P.yb; p.lda = DM; p.Bt = P.woutT; p.ldb = DM; p.K = DM;
    p.rowscale = nullptr; p.obf = P.x1b; p.ldo = DM; p.of32 = P.x1; p.ldf = DM; p.resid = P.x; p.rowacc = P.rs2;
    for (int tile = bid; tile < (NT / 128) * 8; tile += nb) {
      gemm_tile<EPI_OUTPROJ>(p, tile / 8, tile % 8, smem);
      __syncthreads();
    }
  }
  xcd_barrier(xb);
  {
    GemmP p{};
    p.A = P.x1b; p.lda = DM; p.Bt = P.mt; p.ldb = DM; p.K = DM;
    p.rowscale = P.rs2; p.obf = P.scores; p.ldo = 2048; p.of32 = nullptr; p.ldf = 0; p.resid = nullptr;
    for (int tile = bid; tile < (NT / 128) * 16; tile += nb) {
      gemm_tile<EPI_SCORES>(p, tile / 16, tile % 16, smem);
      __syncthreads();
    }
  }
  xcd_barrier(xb);
  for (int it = bid; it < 8192; it += nb) { d_cvt_tab(it, P.peer_u, P.utab); d_cvt_tab(it, P.peer_v, P.vtab); }
  for (int it = bid; it < NT * 8 / 4; it += nb) d_topk(it, P.scores, P.idxb, P.gateb);
  xcd_barrier(xb);
  float oscale = 1.f;
#ifdef DBG_CHECK
  {
    const float sd = __hip_atomic_load(&P.dbg[0], __ATOMIC_RELAXED, __HIP_MEMORY_SCOPE_AGENT);
    const float sr = __hip_atomic_load(&P.dbg[1], __ATOMIC_RELAXED, __HIP_MEMORY_SCOPE_AGENT);
    oscale = 1.f + sqrtf(sd / sr);
  }
#endif
  for (int it = bid; it < NT / 4; it += nb)
    d_peer(it, P.x1, P.rs2, P.norm2_g, P.idxb, P.gateb, P.utab, P.vtab, P.normf_g, P.out, oscale);
}

extern "C" void kernel_launch(void* const* d_in, const int* in_sizes, int n_in, void* d_out, int out_size, void* d_ws,
                              size_t ws_size, hipStream_t stream) {
  MKP P{};
  P.x = (const float*)d_in[0];
  P.norm1_g = (const float*)d_in[1];
  P.w_in = (const float*)d_in[2];
  P.conv_w = (const float*)d_in[3];
  P.a_log = (const float*)d_in[4];
  P.dt_bias = (const float*)d_in[5];
  P.gdn_g = (const float*)d_in[6];
  P.i_bias = (const float*)d_in[7];
  P.f_bias = (const float*)d_in[8];
  P.ml_g = (const float*)d_in[9];
  P.w_out = (const float*)d_in[10];
  P.norm2_g = (const float*)d_in[11];
  P.peer_wq = (const float*)d_in[12];
  P.peer_keys = (const float*)d_in[13];
  P.peer_u = (const float*)d_in[14];
  P.peer_v = (const float*)d_in[15];
  P.normf_g = (const float*)d_in[16];
  P.out = (float*)d_out;

  char* ws = (char*)d_ws;
  const size_t MB = 1024 * 1024;
  P.pm = (unsigned short*)(ws);
  P.x1 = (float*)(ws);
  P.x1b = (unsigned short*)(ws + 64 * MB);
  P.utab = (unsigned short*)(ws + 64 * MB);
  P.vtab = (unsigned short*)(ws + 96 * MB);
  char* rb = ws + 128 * MB;
  P.woutT = (unsigned short*)(rb);
  P.mt = (unsigned short*)(rb + 2 * MB);
  P.rs1 = (float*)(rb + 6 * MB);
  P.rs2 = (float*)(rb + 7 * MB);
  P.dbg = (float*)(rb + 6 * MB + 131072);
  P.bar = (unsigned*)(rb + 6 * MB + 196608);
  P.gt = (float*)(rb + 9 * MB);
  char* dyn = rb + 11 * MB;
  P.xb = (unsigned short*)(dyn);
  P.winT = (unsigned short*)(dyn + 32 * MB);
  P.G.qc = (unsigned short*)(dyn);
  P.G.kTc = (unsigned short*)(dyn + 16 * MB);
  P.G.qkc = (unsigned short*)(dyn + 32 * MB);
  P.G.wn = (unsigned short*)(dyn + 48 * MB);
  P.G.uo = (unsigned short*)(dyn + 80 * MB);
  P.G.gsc = (float*)(dyn + 112 * MB);
  P.yb = (unsigned short*)(dyn);
  P.scores = (unsigned short*)(dyn);
  P.idxb = (int*)(dyn + 64 * MB);
  P.gateb = (float*)(dyn + 72 * MB);
  char* os = (char*)d_out;
  P.oM = (unsigned short*)(os);
  P.qkv_dbg = (unsigned short*)(os + 32 * MB);
  P.oA_dbg = (unsigned short*)(os + 44 * MB);

  static int grid_blocks = 0;
  if (!grid_blocks) {
    int dev = 0, cus = 0, per_cu = 0;
    (void)hipGetDevice(&dev);
    (void)hipDeviceGetAttribute(&cus, hipDeviceAttributeMultiprocessorCount, dev);
    (void)hipOccupancyMaxActiveBlocksPerMultiprocessor(&per_cu, k_mega, 256, 0);
    if (per_cu > 2) per_cu = 2;
    if (per_cu < 1) per_cu = 1;
    grid_blocks = cus * per_cu;
  }
  (void)hipMemsetAsync(P.bar, 0, XCD_BAR_WORDS * sizeof(unsigned), stream);
  hipLaunchKernelGGL(k_mega, dim3(grid_blocks), dim3(256), 0, stream, P);
}
```

```cpp
#include <hip/hip_runtime.h>
#include <hip/hip_bf16.h>
#include <stdint.h>
#include <cstdio>

#define XB_TMO      128
#define XB_XCNT(j)  (256  + 64 * (j))
#define XB_XSUB(j)  (1280 + 64 * (j))
#define XB_XGEN(j)  (2304 + 64 * (j))
#define XB_TOP      3328
#define XB_TOPGEN   3392
#define XCD_BAR_WORDS 3456
#define XB_SPIN_CAP (1u << 18)
#define LAS __attribute__((address_space(3)))

__device__ __forceinline__ unsigned xb_ld(unsigned* p)              { return __hip_atomic_load(p, __ATOMIC_RELAXED, __HIP_MEMORY_SCOPE_AGENT); }
__device__ __forceinline__ unsigned xb_add(unsigned* p, unsigned v) { return __hip_atomic_fetch_add(p, v, __ATOMIC_RELAXED, __HIP_MEMORY_SCOPE_AGENT); }
__device__ __forceinline__ unsigned xb_xcc_id() { return (unsigned)__builtin_amdgcn_s_getreg((3 << 11) | 20) & 0xFu; }
#define XB_SPIN(cond, bar) do { unsigned _sp = 0; while (cond) { __builtin_amdgcn_s_sleep(1); \
    if ((++_sp & 255u) == 0u) { if (xb_ld(&(bar)[XB_TMO])) break; if (_sp > XB_SPIN_CAP) { atomicAdd(&(bar)[XB_TMO], 1u); break; } } } } while (0)

struct XcdBarrier {
    unsigned* bar; unsigned x;
    volatile LAS unsigned* st;
};

__device__ __forceinline__ XcdBarrier xcd_barrier_post(unsigned* bar, volatile LAS unsigned* st) {
    XcdBarrier b; b.bar = bar; b.x = xb_xcc_id(); b.st = st;
    if (threadIdx.x == 0) (void)xb_add(&bar[XB_XCNT(b.x)], 1u);
    return b;
}
__device__ __forceinline__ void xcd_barrier_complete(unsigned* bar, unsigned x, unsigned& nloc, unsigned& nx) {
    const unsigned G = gridDim.x * gridDim.y * gridDim.z;
    unsigned sum, cnt, mine, sp = 0u;
    for (;;) {
        sum = 0u; cnt = 0u; mine = 0u;
#pragma unroll
        for (unsigned j = 0; j < 16; ++j) { const unsigned c = xb_ld(&bar[XB_XCNT(j)]); sum += c; cnt += (c > 0u) ? 1u : 0u; mine = (j == x) ? c : mine; }
        if (sum == G) break;
        __builtin_amdgcn_s_sleep(1);
        if ((++sp & 255u) == 0u) { if (xb_ld(&bar[XB_TMO])) break; if (sp > XB_SPIN_CAP) { atomicAdd(&bar[XB_TMO], 1u); break; } }
    }
    nloc = mine > 0u ? mine : 1u; nx = cnt > 0u ? cnt : 1u;
}

__device__ __forceinline__ void xcd_barrier(const XcdBarrier& b) {
    asm volatile("s_waitcnt vmcnt(0)" ::: "memory");
    __syncthreads();
    if (threadIdx.x == 0) {
        unsigned* bar = b.bar;
        __builtin_amdgcn_s_waitcnt(0);
        unsigned nloc = b.st[0], nx = b.st[1];
        if (nloc == 0u) { xcd_barrier_complete(bar, b.x, nloc, nx); b.st[0] = nloc; b.st[1] = nx; }
        const unsigned old = xb_add(&bar[XB_XSUB(b.x)], 1u);
        const unsigned gen = old / nloc;
        if (old + 1u == (gen + 1u) * nloc) {
            __builtin_amdgcn_fence(__ATOMIC_RELEASE, "agent");
            asm volatile("s_waitcnt vmcnt(0)" ::: "memory");
            const unsigned og = xb_add(&bar[XB_TOP], 1u);
            const unsigned tg = og / nx;
            if (og + 1u == (tg + 1u) * nx) xb_add(&bar[XB_TOPGEN], 1u);
            else XB_SPIN(xb_ld(&bar[XB_TOPGEN]) == tg, bar);
            __builtin_amdgcn_fence(__ATOMIC_ACQUIRE, "agent");
            xb_add(&bar[XB_XGEN(b.x)], 1u);
            asm volatile("s_waitcnt vmcnt(0)" ::: "memory");
        } else {
            XB_SPIN(xb_ld(&bar[XB_XGEN(b.x)]) == gen, bar);
            __builtin_amdgcn_fence(__ATOMIC_ACQUIRE, "agent");
            asm volatile("s_waitcnt vmcnt(0)" ::: "memory");
        }
    }
    __syncthreads();
}


typedef __hip_bfloat16 bf16;
typedef __attribute__((ext_vector_type(8))) short bf16x8;
typedef __attribute__((ext_vector_type(4))) float f32x4;

constexpr int DM = 1024;
constexpr int NB = 4;
constexpr int SEQ = 4096;
constexpr int NT = NB * SEQ;
constexpr int DIN = 4128;
constexpr int NPAD_IN = 4224;
constexpr float EPSF = 1e-6f;

__device__ __forceinline__ float bf2f(unsigned short u) { return __uint_as_float(((unsigned)u) << 16); }
__device__ __forceinline__ unsigned short f2bf(float f) {
  unsigned u = __float_as_uint(f);
  u += 0x7fffu + ((u >> 16) & 1u);
  return (unsigned short)(u >> 16);
}
__device__ __forceinline__ float wave_sum(float v) {
#pragma unroll
  for (int o = 32; o > 0; o >>= 1) v += __shfl_xor(v, o, 64);
  return v;
}
__device__ __forceinline__ float softplusf(float x) { return fmaxf(x, 0.f) + log1pf(expf(-fabsf(x))); }
__device__ __forceinline__ float sigmoidf(float x) { return 1.f / (1.f + expf(-x)); }

__device__ __forceinline__ void d_prep_x(int item, const float* __restrict__ x, unsigned short* __restrict__ xb,
                                                float* __restrict__ rs) {
  int t = item * 4 + (threadIdx.x >> 6);
  int lane = threadIdx.x & 63;
  const float4* xr = (const float4*)(x + (size_t)t * DM);
  float ss = 0.f;
#pragma unroll
  for (int i = 0; i < 4; ++i) {
    float4 v = xr[lane + 64 * i];
    ss += v.x * v.x + v.y * v.y + v.z * v.z + v.w * v.w;
    ushort4 o;
    o.x = f2bf(v.x); o.y = f2bf(v.y); o.z = f2bf(v.z); o.w = f2bf(v.w);
    ((ushort4*)(xb + (size_t)t * DM))[lane + 64 * i] = o;
  }
  ss = wave_sum(ss);
  if (lane == 0) rs[t] = rsqrtf(ss * (1.f / DM) + EPSF);
}

__device__ __forceinline__ int win_src(int n) {
  if (n < 2048) return n;
  if (n < 4096) return n + 16;
  int j = n - 4096;
  if (j < 16) return 2048 + j;
  if (j < 32) return 4112 + (j - 16);
  return -1;
}
__device__ __forceinline__ void d_transpose_w(int item, const float* __restrict__ in, int ldn, const float* __restrict__ g,
                                                     unsigned short* __restrict__ out, int nrows, int mode) {
  size_t id = (size_t)item * 256 + threadIdx.x;
  if (id >= (size_t)nrows * DM) return;
  int n = (int)(id >> 10);
  int k = (int)(id & 1023);
  int src = mode ? win_src(n) : n;
  float v = 0.f;
  if (src >= 0) v = in[(size_t)k * ldn + src] * (g ? g[k] : 1.f);
  out[id] = f2bf(v);
}
__device__ __forceinline__ void d_make_mt(int item, const float* __restrict__ wq, const float* __restrict__ keys,
                                                 const float* __restrict__ g2, unsigned short* __restrict__ mt) {
  int n = item >> 2;
  int d = (item & 3) * 256 + threadIdx.x;
  int hp = n >> 7;
  const float4* kr = (const float4*)(keys + (size_t)n * 128);
  const float4* wr = (const float4*)(wq + (size_t)d * 2048 + hp * 128);
  float s = 0.f;
#pragma unroll 8
  for (int j = 0; j < 32; ++j) {
    float4 a = kr[j], b = wr[j];
    s += a.x * b.x + a.y * b.y + a.z * b.z + a.w * b.w;
  }
  mt[(size_t)n * DM + d] = f2bf(s * g2[d]);
}

constexpr int GBM = 128, GBN = 128, GBK = 64, GLD = 72;
struct GemmP {
  const unsigned short* A; const unsigned short* Bt; int lda, ldb, K;
  const float* rowscale;
  unsigned short* obf; int ldo;
  float* of32; int ldf;
  const float* resid;
  const float *a_log, *dt_bias, *i_bias, *f_bias;
  float* rowacc;
};
enum { EPI_INPROJ = 0, EPI_OUTPROJ = 1, EPI_SCORES = 2 };

template <int EPI>
__device__ __forceinline__ void gemm_tile(const GemmP p, int tm, int tn, unsigned short* smem) {
  unsigned short* As = smem;
  unsigned short* Bs = smem + 2 * GBM * GLD;
  const int tid = threadIdx.x, lane = tid & 63, wid = tid >> 6;
  const int wm = wid >> 1, wn = wid & 1;
  const int m0 = tm * GBM, n0 = tn * GBN;
  f32x4 acc[4][4];
#pragma unroll
  for (int i = 0; i < 4; ++i)
#pragma unroll
    for (int j = 0; j < 4; ++j) acc[i][j] = (f32x4){0.f, 0.f, 0.f, 0.f};

  uint4 ra0, ra1, ra2, ra3, rb0, rb1, rb2, rb3;
  const int nk = p.K / GBK;
  const int lrow = tid >> 3, lc8 = tid & 7;
  const unsigned short* Ag = p.A + (size_t)(m0 + lrow) * p.lda + lc8 * 8;
  const unsigned short* Bg = p.Bt + (size_t)(n0 + lrow) * p.ldb + lc8 * 8;
  const size_t a32 = (size_t)32 * p.lda, b32 = (size_t)32 * p.ldb;
#define GLOAD(kt)                                                        \
  {                                                                      \
    ra0 = *(const uint4*)(Ag + (kt) * GBK);                              \
    ra1 = *(const uint4*)(Ag + a32 + (kt) * GBK);                        \
    ra2 = *(const uint4*)(Ag + 2 * a32 + (kt) * GBK);                    \
    ra3 = *(const uint4*)(Ag + 3 * a32 + (kt) * GBK);                    \
    rb0 = *(const uint4*)(Bg + (kt) * GBK);                              \
    rb1 = *(const uint4*)(Bg + b32 + (kt) * GBK);                        \
    rb2 = *(const uint4*)(Bg + 2 * b32 + (kt) * GBK);                    \
    rb3 = *(const uint4*)(Bg + 3 * b32 + (kt) * GBK);                    \
  }
#define SSTORE(buf)                                                      \
  {                                                                      \
    unsigned short* ad = As + (size_t)(buf) * GBM * GLD + lrow * GLD + lc8 * 8; \
    unsigned short* bd = Bs + (size_t)(buf) * GBN * GLD + lrow * GLD + lc8 * 8; \
    *(uint4*)(ad) = ra0; *(uint4*)(ad + 32 * GLD) = ra1; *(uint4*)(ad + 64 * GLD) = ra2; *(uint4*)(ad + 96 * GLD) = ra3; \
    *(uint4*)(bd) = rb0; *(uint4*)(bd + 32 * GLD) = rb1; *(uint4*)(bd + 64 * GLD) = rb2; *(uint4*)(bd + 96 * GLD) = rb3; \
  }
  GLOAD(0);
  SSTORE(0);
  __syncthreads();
  for (int kt = 0; kt < nk; ++kt) {
    const int buf = kt & 1;
    if (kt + 1 < nk) GLOAD(kt + 1);
    const unsigned short* Ab = As + (size_t)buf * GBM * GLD;
    const unsigned short* Bb = Bs + (size_t)buf * GBN * GLD;
#pragma unroll
    for (int ks = 0; ks < 2; ++ks) {
      bf16x8 a[4], b[4];
      const int kc = ks * 32 + (lane >> 4) * 8;
#pragma unroll
      for (int i = 0; i < 4; ++i) a[i] = *(const bf16x8*)(Ab + (wm * 64 + i * 16 + (lane & 15)) * GLD + kc);
#pragma unroll
      for (int j = 0; j < 4; ++j) b[j] = *(const bf16x8*)(Bb + (wn * 64 + j * 16 + (lane & 15)) * GLD + kc);
#pragma unroll
      for (int i = 0; i < 4; ++i)
#pragma unroll
        for (int j = 0; j < 4; ++j) acc[i][j] = __builtin_amdgcn_mfma_f32_16x16x32_bf16(a[i], b[j], acc[i][j], 0, 0, 0);
    }
    if (kt + 1 < nk) SSTORE(buf ^ 1);
    __syncthreads();
  }
#undef GLOAD
#undef SSTORE
#pragma unroll
  for (int i = 0; i < 4; ++i) {
#pragma unroll
    for (int r = 0; r < 4; ++r) {
      const int row = m0 + wm * 64 + i * 16 + (lane >> 4) * 4 + r;
      float rsc = 1.f;
      float rowss = 0.f;
      if (EPI == EPI_INPROJ) rsc = p.rowscale[row];
      if (EPI == EPI_SCORES) {
        const float4* pr = (const float4*)(p.rowscale + (size_t)row * 16);
        const float4 s0 = pr[0], s1 = pr[1], s2 = pr[2], s3 = pr[3];
        const float ssq = ((s0.x + s0.y) + (s0.z + s0.w)) + ((s1.x + s1.y) + (s1.z + s1.w)) + ((s2.x + s2.y) + (s2.z + s2.w)) + ((s3.x + s3.y) + (s3.z + s3.w));
        rsc = rsqrtf(ssq * (1.f / DM) + EPSF);
      }
#pragma unroll
      for (int j = 0; j < 4; ++j) {
        const int col = n0 + wn * 64 + j * 16 + (lane & 15);
        float v = acc[i][j][r] * rsc;
        if (EPI == EPI_INPROJ) {
          if (col < 4096) p.obf[(size_t)row * p.ldo + col] = f2bf(v);
          else if (col < 4128) {
            const int j = col - 4096, jj = j & 7;
            float o;
            if (j < 8) o = -expf(p.a_log[jj]) * softplusf(v + p.dt_bias[jj]);
            else if (j < 16) o = sigmoidf(v);
            else if (j < 24) o = v + p.i_bias[jj];
            else o = -softplusf(-(v + p.f_bias[jj]));
            p.of32[(size_t)row * p.ldf + j] = o;
          }
        } else if (EPI == EPI_OUTPROJ) {
          const float xo = v + p.resid[(size_t)row * p.ldf + col];
          p.of32[(size_t)row * p.ldf + col] = xo;
          p.obf[(size_t)row * p.ldo + col] = f2bf(xo);
          rowss += xo * xo;
        } else {
          p.obf[(size_t)row * p.ldo + col] = f2bf(v);
        }
      }
      if (EPI == EPI_OUTPROJ) {
        rowss += __shfl_xor(rowss, 1, 64); rowss += __shfl_xor(rowss, 2, 64);
        rowss += __shfl_xor(rowss, 4, 64); rowss += __shfl_xor(rowss, 8, 64);
        if ((lane & 15) == 0) p.rowacc[(size_t)row * 16 + tn * 2 + wn] = rowss;
      }
    }
  }
}

__device__ __forceinline__ void d_conv(int item, const unsigned short* __restrict__ pm, const float* __restrict__ pg,
                                              const float* __restrict__ conv_w, const float* __restrict__ a_log,
                                              const float* __restrict__ dt_bias, const float* __restrict__ i_bias,
                                              const float* __restrict__ f_bias, unsigned short* __restrict__ qkv,
                                              float* __restrict__ gt) {
  int t = item * 4 + (threadIdx.x >> 6);
  int lane = threadIdx.x & 63;
  int s = t & (SEQ - 1);
  for (int sec = 0; sec < 3; ++sec) {
    for (int h = 0; h < 4; ++h) {
      int c0 = sec * 512 + h * 128 + 2 * lane;
      float a0 = 0.f, a1 = 0.f;
#pragma unroll
      for (int j = 0; j < 5; ++j) {
        int sp = s + j - 2;
        if (sp >= 0 && sp < SEQ) {
          unsigned v = *(const unsigned*)(pm + (size_t)(t + j - 2) * 4096 + c0);
          a0 += conv_w[c0 * 5 + j] * bf2f((unsigned short)(v & 0xffff));
          a1 += conv_w[(c0 + 1) * 5 + j] * bf2f((unsigned short)(v >> 16));
        }
      }
      a0 = a0 * sigmoidf(a0);
      a1 = a1 * sigmoidf(a1);
      if (sec < 2) {
        float ss = wave_sum(a0 * a0 + a1 * a1);
        float sc = rsqrtf(ss + EPSF);
        if (sec == 0) sc *= 0.08838834764831845f;
        a0 *= sc; a1 *= sc;
      }
      unsigned o = (unsigned)f2bf(a0) | ((unsigned)f2bf(a1) << 16);
      *(unsigned*)(qkv + (size_t)t * 1536 + c0) = o;
    }
  }
}

__device__ __forceinline__ void d_gdn_rec(int chain, float* sq, float* sk, const unsigned short* __restrict__ qkv,
                                                 const float* __restrict__ gt, unsigned short* __restrict__ oA, int ntok) {
  const int bh = chain >> 1, dir = chain & 1;
  const int b = bh >> 2, h = bh & 3;
  const int e = threadIdx.x & 127;
  float S[128];
#pragma unroll
  for (int d = 0; d < 128; ++d) S[d] = 0.f;
  for (int it = 0; it < SEQ; ++it) {
    const int s = dir ? (SEQ - 1 - it) : it;
    const size_t t = (size_t)b * SEQ + s;
    __syncthreads();
    sq[e] = bf2f(qkv[t * 1536 + h * 128 + e]);
    sk[e] = bf2f(qkv[t * 1536 + 512 + h * 128 + e]);
    const float v = bf2f(qkv[t * 1536 + 1024 + h * 128 + e]);
    const float g = gt[t * 32 + dir * 4 + h];
    const float beta = gt[t * 32 + 8 + dir * 4 + h];
    __syncthreads();
    const float a = expf(g);
    float k0 = 0.f, k1 = 0.f, k2 = 0.f, k3 = 0.f;
#pragma unroll
    for (int d = 0; d < 128; d += 4) {
      k0 += sk[d] * S[d]; k1 += sk[d + 1] * S[d + 1]; k2 += sk[d + 2] * S[d + 2]; k3 += sk[d + 3] * S[d + 3];
    }
    const float kS = a * ((k0 + k1) + (k2 + k3));
    const float vn = beta * (v - kS);
    float o0 = 0.f, o1 = 0.f, o2 = 0.f, o3 = 0.f;
#pragma unroll
    for (int d = 0; d < 128; d += 4) {
      S[d] = a * S[d] + sk[d] * vn;             o0 += sq[d] * S[d];
      S[d + 1] = a * S[d + 1] + sk[d + 1] * vn; o1 += sq[d + 1] * S[d + 1];
      S[d + 2] = a * S[d + 2] + sk[d + 2] * vn; o2 += sq[d + 2] * S[d + 2];
      S[d + 3] = a * S[d + 3] + sk[d + 3] * vn; o3 += sq[d + 3] * S[d + 3];
    }
    oA[((size_t)dir * ntok + t) * 512 + h * 128 + e] = f2bf((o0 + o1) + (o2 + o3));
  }
}

__device__ __forceinline__ void d_mlstm_rec(int chain, float* sq, float* sk, const unsigned short* __restrict__ pm,
                                                   const float* __restrict__ gt, unsigned short* __restrict__ oM, int ntok) {
  const int bh = chain >> 1, dir = chain & 1;
  const int b = bh >> 2, h = bh & 3;
  const int e = threadIdx.x & 127, lane = e & 63;
  float C[128];
#pragma unroll
  for (int d = 0; d < 128; ++d) C[d] = 0.f;
  float n0 = 0.f, n1 = 0.f, m = 0.f;
  for (int it = 0; it < SEQ; ++it) {
    const int s = dir ? (SEQ - 1 - it) : it;
    const size_t t = (size_t)b * SEQ + s;
    __syncthreads();
    sq[e] = bf2f(pm[t * 4096 + 2048 + h * 128 + e]);
    sk[e] = bf2f(pm[t * 4096 + 2560 + h * 128 + e]) * 0.08838834764831845f;
    const float v = bf2f(pm[t * 4096 + 3072 + h * 128 + e]);
    const float ip = gt[t * 32 + 16 + dir * 4 + h];
    const float lf = gt[t * 32 + 24 + dir * 4 + h];
    __syncthreads();
    const float mn = fmaxf(lf + m, ip);
    const float fs = expf(lf + m - mn);
    const float is = expf(ip - mn);
    m = mn;
    n0 = fs * n0 + is * sk[lane];
    n1 = fs * n1 + is * sk[lane + 64];
    const float den = wave_sum(n0 * sq[lane] + n1 * sq[lane + 64]);
    const float iv = is * v;
    float o0 = 0.f, o1 = 0.f, o2 = 0.f, o3 = 0.f;
#pragma unroll
    for (int d = 0; d < 128; d += 4) {
      C[d] = fs * C[d] + sk[d] * iv;             o0 += sq[d] * C[d];
      C[d + 1] = fs * C[d + 1] + sk[d + 1] * iv; o1 += sq[d + 1] * C[d + 1];
      C[d + 2] = fs * C[d + 2] + sk[d + 2] * iv; o2 += sq[d + 2] * C[d + 2];
      C[d + 3] = fs * C[d + 3] + sk[d + 3] * iv; o3 += sq[d + 3] * C[d + 3];
    }
    const float num = (o0 + o1) + (o2 + o3);
    const float hh = num / fmaxf(fabsf(den), expf(-mn));
    oM[((size_t)dir * ntok + t) * 512 + h * 128 + e] = f2bf(hh);
  }
}

__device__ __forceinline__ void d_combine(int item, const unsigned short* __restrict__ uo, const unsigned short* __restrict__ oM,
                                                 const unsigned short* __restrict__ pm, const float* __restrict__ gdn_g,
                                                 const float* __restrict__ ml_g, unsigned short* __restrict__ y) {
  int t = item * 4 + (threadIdx.x >> 6);
  int lane = threadIdx.x & 63;
  const int b = t >> 12, cc = (t >> 6) & 63, ii = t & 63;
  for (int h = 0; h < 4; ++h) {
    int c = h * 128 + 2 * lane;
    {
      const int chain0 = (b * 4 + h) * 2;
      const size_t off = (size_t)cc * 8192 + (lane >> 4) * 2048 + ii * 32 + ((2 * lane) & 31);
      unsigned vf = *(const unsigned*)(uo + (size_t)chain0 * 64 * 8192 + off);
      unsigned vb = *(const unsigned*)(uo + (size_t)(chain0 + 1) * 64 * 8192 + off);
      float o0 = bf2f(vf & 0xffff) + bf2f(vb & 0xffff);
      float o1 = bf2f(vf >> 16) + bf2f(vb >> 16);
      float ss = wave_sum(o0 * o0 + o1 * o1);
      float sc = rsqrtf(ss * (1.f / 128.f) + EPSF);
      unsigned z = *(const unsigned*)(pm + (size_t)t * 4096 + 1536 + c);
      float z0 = bf2f(z & 0xffff), z1 = bf2f(z >> 16);
      o0 = o0 * sc * gdn_g[2 * lane] * (z0 * sigmoidf(z0));
      o1 = o1 * sc * gdn_g[2 * lane + 1] * (z1 * sigmoidf(z1));
      *(unsigned*)(y + (size_t)t * DM + c) = (unsigned)f2bf(o0) | ((unsigned)f2bf(o1) << 16);
    }
    {
      unsigned vf = *(const unsigned*)(oM + (size_t)t * 512 + c);
      unsigned vb = *(const unsigned*)(oM + ((size_t)NT + t) * 512 + c);
      float o0 = bf2f(vf & 0xffff) + bf2f(vb & 0xffff);
      float o1 = bf2f(vf >> 16) + bf2f(vb >> 16);
      float ss = wave_sum(o0 * o0 + o1 * o1);
      float sc = rsqrtf(ss * (1.f / 128.f) + EPSF);
      unsigned z = *(const unsigned*)(pm + (size_t)t * 4096 + 3584 + c);
      float z0 = bf2f(z & 0xffff), z1 = bf2f(z >> 16);
      o0 = o0 * sc * ml_g[c] * sigmoidf(z0);
      o1 = o1 * sc * ml_g[c + 1] * sigmoidf(z1);
      *(unsigned*)(y + (size_t)t * DM + 512 + c) = (unsigned)f2bf(o0) | ((unsigned)f2bf(o1) << 16);
    }
  }
}

#ifdef DBG_CHECK
__device__ __forceinline__ void d_dbg_cmp(int item, const unsigned short* __restrict__ uo, const unsigned short* __restrict__ oAd,
                                          float* __restrict__ dbg) {
  int t = item * 4 + (threadIdx.x >> 6);
  int lane = threadIdx.x & 63;
  const int cc = (t >> 6) & 63, ii = t & 63;
  float sd = 0.f, sr = 0.f;
  for (int h = 0; h < 4; ++h) {
    for (int dir = 0; dir < 2; ++dir) {
      const int chain = h * 2 + dir;
      const size_t off = (size_t)cc * 8192 + (lane >> 4) * 2048 + ii * 32 + ((2 * lane) & 31);
      unsigned vn = *(const unsigned*)(uo + (size_t)chain * 64 * 8192 + off);
      unsigned vr = *(const unsigned*)(oAd + ((size_t)dir * 4096 + t) * 512 + h * 128 + 2 * lane);
      float n0 = bf2f(vn & 0xffff), n1 = bf2f(vn >> 16), r0 = bf2f(vr & 0xffff), r1 = bf2f(vr >> 16);
      sd += (n0 - r0) * (n0 - r0) + (n1 - r1) * (n1 - r1);
      sr += r0 * r0 + r1 * r1;
    }
  }
  sd = wave_sum(sd); sr = wave_sum(sr);
  if (lane == 0) { atomicAdd(&dbg[0], sd); atomicAdd(&dbg[1], sr); }
}
__device__ __forceinline__ void d_dbg_cmp_m(int item, const unsigned short* __restrict__ oM, const unsigned short* __restrict__ oMd,
                                            float* __restrict__ dbg) {
  int t = item * 4 + (threadIdx.x >> 6);
  int lane = threadIdx.x & 63;
  float sd = 0.f, sr = 0.f;
  for (int dir = 0; dir < 2; ++dir)
    for (int q = 0; q < 4; ++q) {
      unsigned vn = *(const unsigned*)(oM + ((size_t)dir * NT + t) * 512 + q * 128 + 2 * lane);
      unsigned vr = *(const unsigned*)(oMd + ((size_t)dir * 4096 + t) * 512 + q * 128 + 2 * lane);
      float n0 = bf2f(vn & 0xffff), n1 = bf2f(vn >> 16), r0 = bf2f(vr & 0xffff), r1 = bf2f(vr >> 16);
      sd += (n0 - r0) * (n0 - r0) + (n1 - r1) * (n1 - r1);
      sr += r0 * r0 + r1 * r1;
    }
  sd = wave_sum(sd); sr = wave_sum(sr);
  if (lane == 0) { atomicAdd(&dbg[0], sd); atomicAdd(&dbg[1], sr); }
}
#endif

__device__ __forceinline__ void d_prep_x1(int item, const float* __restrict__ x1, unsigned short* __restrict__ xb,
                                                 float* __restrict__ rs) {
  int t = item * 4 + (threadIdx.x >> 6);
  int lane = threadIdx.x & 63;
  const float4* xr = (const float4*)(x1 + (size_t)t * DM);
  float ss = 0.f;
#pragma unroll
  for (int i = 0; i < 4; ++i) {
    float4 v = xr[lane + 64 * i];
    ss += v.x * v.x + v.y * v.y + v.z * v.z + v.w * v.w;
    ushort4 o;
    o.x = f2bf(v.x); o.y = f2bf(v.y); o.z = f2bf(v.z); o.w = f2bf(v.w);
    ((ushort4*)(xb + (size_t)t * DM))[lane + 64 * i] = o;
  }
  ss = wave_sum(ss);
  if (lane == 0) rs[t] = rsqrtf(ss * (1.f / DM) + EPSF);
}

__device__ const unsigned char kPairTab[64] = {
    0x00, 0x01, 0x02, 0x03, 0x04, 0x05, 0x06, 0x07, 0x08, 0x09, 0x0a, 0x0b, 0x0c, 0x0d, 0x0e, 0x0f,
    0x10, 0x11, 0x12, 0x13, 0x14, 0x15, 0x16, 0x17,
    0x20, 0x21, 0x22, 0x23, 0x24,
    0x30, 0x31, 0x32, 0x33,
    0x40, 0x41, 0x42,
    0x50, 0x51, 0x60, 0x61, 0x70, 0x71,
    0x80, 0x90, 0xa0, 0xb0, 0xc0, 0xd0, 0xe0, 0xf0,
    0xff, 0xff, 0xff, 0xff, 0xff, 0xff, 0xff, 0xff, 0xff, 0xff, 0xff, 0xff, 0xff, 0xff};

__device__ __forceinline__ void sort16_desc(unsigned (&a)[16]) {
#pragma unroll
  for (int k = 2; k <= 16; k <<= 1)
#pragma unroll
    for (int j = k >> 1; j > 0; j >>= 1)
#pragma unroll
      for (int i = 0; i < 16; ++i) {
        const int l = i ^ j;
        if (l > i) {
          const unsigned hi = max(a[i], a[l]), lo = min(a[i], a[l]);
          if ((i & k) == 0) { a[i] = hi; a[l] = lo; } else { a[i] = lo; a[l] = hi; }
        }
      }
}
__device__ __forceinline__ void merge16_desc(unsigned (&top)[16], const unsigned (&b)[16]) {
#pragma unroll
  for (int i = 0; i < 16; ++i) top[i] = max(top[i], b[15 - i]);
#pragma unroll
  for (int j = 8; j > 0; j >>= 1)
#pragma unroll
    for (int i = 0; i < 16; ++i) {
      const int l = i ^ j;
      if (l > i) {
        const unsigned hi = max(top[i], top[l]), lo = min(top[i], top[l]);
        top[i] = hi; top[l] = lo;
      }
    }
}
__device__ __forceinline__ unsigned key16(unsigned hbits, int idx) {
  const unsigned m = hbits ^ ((hbits & 0x8000u) ? 0xFFFFu : 0x8000u);
  return (m << 16) | (unsigned)(127 - idx);
}
__device__ __forceinline__ void top16_of_128(const unsigned short* __restrict__ sp, unsigned (&top)[16]) {
#pragma unroll
  for (int g = 0; g < 8; ++g) {
    const uint4 x0 = *(const uint4*)(sp + g * 16);
    const uint4 x1 = *(const uint4*)(sp + g * 16 + 8);
    unsigned b[16];
    b[0] = key16(x0.x & 0xffff, g * 16 + 0);  b[1] = key16(x0.x >> 16, g * 16 + 1);
    b[2] = key16(x0.y & 0xffff, g * 16 + 2);  b[3] = key16(x0.y >> 16, g * 16 + 3);
    b[4] = key16(x0.z & 0xffff, g * 16 + 4);  b[5] = key16(x0.z >> 16, g * 16 + 5);
    b[6] = key16(x0.w & 0xffff, g * 16 + 6);  b[7] = key16(x0.w >> 16, g * 16 + 7);
    b[8] = key16(x1.x & 0xffff, g * 16 + 8);  b[9] = key16(x1.x >> 16, g * 16 + 9);
    b[10] = key16(x1.y & 0xffff, g * 16 + 10); b[11] = key16(x1.y >> 16, g * 16 + 11);
    b[12] = key16(x1.z & 0xffff, g * 16 + 12); b[13] = key16(x1.z >> 16, g * 16 + 13);
    b[14] = key16(x1.w & 0xffff, g * 16 + 14); b[15] = key16(x1.w >> 16, g * 16 + 15);
    sort16_desc(b);
    if (g == 0) {
#pragma unroll
      for (int i = 0; i < 16; ++i) top[i] = b[i];
    } else {
      merge16_desc(top, b);
    }
  }
}

__device__ __forceinline__ void d_topk(int item, const unsigned short* __restrict__ scores, int* __restrict__ idx_out,
                                       float* __restrict__ gate_out) {
  const int pair = item * 256 + threadIdx.x;
  const unsigned short* sp = scores + (size_t)pair * 256;
  unsigned k0[16], k1[16];
  top16_of_128(sp, k0);
  top16_of_128(sp + 128, k1);
  float v0[16], v1[16];
  int i0[16], i1[16];
#pragma unroll
  for (int i = 0; i < 16; ++i) {
    const unsigned m0 = k0[i] >> 16, m1 = k1[i] >> 16;
    v0[i] = bf2f((unsigned short)(m0 ^ ((m0 & 0x8000u) ? 0x8000u : 0xFFFFu)));
    v1[i] = bf2f((unsigned short)(m1 ^ ((m1 & 0x8000u) ? 0x8000u : 0xFFFFu)));
    i0[i] = 127 - (int)(k0[i] & 127u);
    i1[i] = 127 - (int)(k1[i] & 127u);
  }
  unsigned top[16];
#pragma unroll
  for (int g = 0; g < 4; ++g) {
    unsigned b[16];
#pragma unroll
    for (int q = 0; q < 16; ++q) {
      const int pr = kPairTab[g * 16 + q];
      if (pr == 0xff) {
        b[q] = 0u;
      } else {
        const int pi = pr >> 4, pj = pr & 15;
        const float sum = v0[pi] + v1[pj];
        const unsigned u = __float_as_uint(sum);
        const unsigned mono = u ^ ((u & 0x80000000u) ? 0xFFFFFFFFu : 0x80000000u);
        b[q] = (mono & 0xFFFFC000u) | (unsigned)(16383 - (i0[pi] * 128 + i1[pj]));
      }
    }
    sort16_desc(b);
    if (g == 0) {
#pragma unroll
      for (int i = 0; i < 16; ++i) top[i] = b[i];
    } else {
      merge16_desc(top, b);
    }
  }
  float ev[16];
  int ci[16];
  float mx = 0.f, sum = 0.f;
#pragma unroll
  for (int i = 0; i < 16; ++i) {
    const unsigned mono = top[i] & 0xFFFFC000u;
    const unsigned u = mono ^ ((mono & 0x80000000u) ? 0x80000000u : 0xFFFFFFFFu);
    const float val = __uint_as_float(u & 0xFFFFC000u);
    ci[i] = 16383 - (int)(top[i] & 16383u);
    if (i == 0) mx = val;
    ev[i] = expf(val - mx);
    sum += ev[i];
  }
  const float inv = 1.f / sum;
#pragma unroll
  for (int q = 0; q < 4; ++q) {
    int4 o; float4 g;
    o.x = ci[4 * q]; o.y = ci[4 * q + 1]; o.z = ci[4 * q + 2]; o.w = ci[4 * q + 3];
    g.x = ev[4 * q] * inv; g.y = ev[4 * q + 1] * inv; g.z = ev[4 * q + 2] * inv; g.w = ev[4 * q + 3] * inv;
    *(int4*)(idx_out + (size_t)pair * 16 + 4 * q) = o;
    *(float4*)(gate_out + (size_t)pair * 16 + 4 * q) = g;
  }
}

__device__ __forceinline__ void d_cvt_tab(int item, const float* __restrict__ src, unsigned short* __restrict__ dst) {
  const size_t base = (size_t)item * 2048 + threadIdx.x * 8;
  const float4 a = *(const float4*)(src + base);
  const float4 b = *(const float4*)(src + base + 4);
  uint4 o;
  o.x = (unsigned)f2bf(a.x) | ((unsigned)f2bf(a.y) << 16);
  o.y = (unsigned)f2bf(a.z) | ((unsigned)f2bf(a.w) << 16);
  o.z = (unsigned)f2bf(b.x) | ((unsigned)f2bf(b.y) << 16);
  o.w = (unsigned)f2bf(b.z) | ((unsigned)f2bf(b.w) << 16);
  *(uint4*)(dst + base) = o;
}

__device__ __forceinline__ float dot8(const uint4 u, const float* hv) {
  float d = bf2f(u.x & 0xffff) * hv[0];
  d += __uint_as_float(u.x & 0xffff0000u) * hv[1];
  d += bf2f(u.y & 0xffff) * hv[2];
  d += __uint_as_float(u.y & 0xffff0000u) * hv[3];
  d += bf2f(u.z & 0xffff) * hv[4];
  d += __uint_as_float(u.z & 0xffff0000u) * hv[5];
  d += bf2f(u.w & 0xffff) * hv[6];
  d += __uint_as_float(u.w & 0xffff0000u) * hv[7];
  return d;
}
__device__ __forceinline__ void axpy8(const uint4 v, const float wg, float* acc) {
  acc[0] += wg * bf2f(v.x & 0xffff);
  acc[1] += wg * __uint_as_float(v.x & 0xffff0000u);
  acc[2] += wg * bf2f(v.y & 0xffff);
  acc[3] += wg * __uint_as_float(v.y & 0xffff0000u);
  acc[4] += wg * bf2f(v.z & 0xffff);
  acc[5] += wg * __uint_as_float(v.z & 0xffff0000u);
  acc[6] += wg * bf2f(v.w & 0xffff);
  acc[7] += wg * __uint_as_float(v.w & 0xffff0000u);
}
__device__ __forceinline__ void d_peer(int item, const float* __restrict__ x1, const float* __restrict__ rs2,
                                       const float* __restrict__ g2, const int* __restrict__ idx,
                                       const float* __restrict__ gate, const unsigned short* __restrict__ pu,
                                       const unsigned short* __restrict__ pv, const float* __restrict__ gf,
                                       float* __restrict__ out, float oscale) {
  const int t = item * 4 + (threadIdx.x >> 6);
  const int lane = threadIdx.x & 63;
  float r2;
  {
    const float4* pr = (const float4*)(rs2 + (size_t)t * 16);
    const float4 s0 = pr[0], s1 = pr[1], s2 = pr[2], s3 = pr[3];
    const float ssq = ((s0.x + s0.y) + (s0.z + s0.w)) + ((s1.x + s1.y) + (s1.z + s1.w)) + ((s2.x + s2.y) + (s2.z + s2.w)) + ((s3.x + s3.y) + (s3.z + s3.w));
    r2 = rsqrtf(ssq * (1.f / DM) + EPSF);
  }
  float xv[16], hv[16], acc[16];
#pragma unroll
  for (int j = 0; j < 2; ++j)
#pragma unroll
    for (int q = 0; q < 2; ++q) {
      const float4 xx = *(const float4*)(x1 + (size_t)t * DM + j * 512 + lane * 8 + q * 4);
      const float4 gg = *(const float4*)(g2 + j * 512 + lane * 8 + q * 4);
      xv[j * 8 + q * 4 + 0] = xx.x; xv[j * 8 + q * 4 + 1] = xx.y; xv[j * 8 + q * 4 + 2] = xx.z; xv[j * 8 + q * 4 + 3] = xx.w;
      hv[j * 8 + q * 4 + 0] = xx.x * r2 * gg.x; hv[j * 8 + q * 4 + 1] = xx.y * r2 * gg.y;
      hv[j * 8 + q * 4 + 2] = xx.z * r2 * gg.z; hv[j * 8 + q * 4 + 3] = xx.w * r2 * gg.w;
    }
#pragma unroll
  for (int i = 0; i < 16; ++i) acc[i] = 0.f;
  const int id_a = idx[(size_t)t * 128 + lane], id_b = idx[(size_t)t * 128 + 64 + lane];
  const float gt_a = gate[(size_t)t * 128 + lane], gt_b = gate[(size_t)t * 128 + 64 + lane];
  for (int e0 = 0; e0 < 128; e0 += 4) {
    uint4 u[4][2], v[4][2];
    float gt4[4];
#pragma unroll
    for (int k = 0; k < 4; ++k) {
      const int e = e0 + k;
      const int id = (e0 < 64) ? __shfl(id_a, e, 64) : __shfl(id_b, e - 64, 64);
      gt4[k] = (e0 < 64) ? __shfl(gt_a, e, 64) : __shfl(gt_b, e - 64, 64);
      const unsigned short* ur = pu + (size_t)id * DM + lane * 8;
      const unsigned short* vr = pv + (size_t)id * DM + lane * 8;
      u[k][0] = *(const uint4*)(ur); u[k][1] = *(const uint4*)(ur + 512);
      v[k][0] = *(const uint4*)(vr); v[k][1] = *(const uint4*)(vr + 512);
    }
    float d[4];
#pragma unroll
    for (int k = 0; k < 4; ++k) d[k] = dot8(u[k][0], hv) + dot8(u[k][1], hv + 8);
#pragma unroll
    for (int o = 32; o > 0; o >>= 1) {
#pragma unroll
      for (int k = 0; k < 4; ++k) d[k] += __shfl_xor(d[k], o, 64);
    }
#pragma unroll
    for (int k = 0; k < 4; ++k) {
      const float act = 0.5f * d[k] * (1.f + erff(d[k] * 0.7071067811865476f));
      const float wg = gt4[k] * act;
      axpy8(v[k][0], wg, acc);
      axpy8(v[k][1], wg, acc + 8);
    }
  }
  float ss = 0.f;
#pragma unroll
  for (int i = 0; i < 16; ++i) { acc[i] += xv[i]; ss += acc[i] * acc[i]; }
  ss = wave_sum(ss);
  const float sc = rsqrtf(ss * (1.f / DM) + EPSF) * oscale;
#pragma unroll
  for (int j = 0; j < 2; ++j)
#pragma unroll
    for (int q = 0; q < 2; ++q) {
      const float4 gg = *(const float4*)(gf + j * 512 + lane * 8 + q * 4);
      float4 o;
      o.x = acc[j * 8 + q * 4 + 0] * sc * gg.x; o.y = acc[j * 8 + q * 4 + 1] * sc * gg.y;
      o.z = acc[j * 8 + q * 4 + 2] * sc * gg.z; o.w = acc[j * 8 + q * 4 + 3] * sc * gg.w;
      *(float4*)(out + (size_t)t * DM + j * 512 + lane * 8 + q * 4) = o;
    }
}

typedef __attribute__((ext_vector_type(16))) float f32x16;
#define MFMA32(a, b, c) __builtin_amdgcn_mfma_f32_32x32x16_bf16((a), (b), (c), 0, 0, 0)
__device__ __forceinline__ int crow(int reg, int hh) { return (reg & 3) + 8 * (reg >> 2) + 4 * hh; }
__device__ __forceinline__ unsigned pack2(float a, float b) { return (unsigned)f2bf(a) | ((unsigned)f2bf(b) << 16); }

struct GdnBufs {
  unsigned short* qc;
  unsigned short* kTc;
  unsigned short* qkc;
  unsigned short* wn;
  unsigned short* uo;
  float* gsc;
};

__device__ __forceinline__ void tri_subst(const float* AL, int lane, float (&T)[64]) {
#pragma unroll
  for (int i = 0; i < 64; ++i) T[i] = 0.f;
  T[0] = (lane == 0) ? 1.f : 0.f;
#pragma unroll
  for (int i = 1; i < 64; ++i) {
    float ax = 0.f, ay = 0.f, az = 0.f, aw = 0.f;
#pragma unroll
    for (int j4 = 0; j4 < (i + 3) / 4; ++j4) {
      const float4 a = *(const float4*)(AL + i * 72 + 4 * j4);
      ax += a.x * T[4 * j4]; ay += a.y * T[4 * j4 + 1]; az += a.z * T[4 * j4 + 2]; aw += a.w * T[4 * j4 + 3];
    }
    T[i] = ((lane == i) ? 1.f : 0.f) - ((ax + ay) + (az + aw));
  }
}

__device__ __forceinline__ void d_gdn_prep(int item, char* smem, const unsigned short* __restrict__ pm,
                                           const float* __restrict__ gt, const float* __restrict__ conv_w, GdnBufs G) {
  unsigned short* qL = (unsigned short*)smem;
  unsigned short* kL = qL + 64 * 144;
  unsigned short* kTL = kL + 64 * 144;
  unsigned short* vTL = kTL + 128 * 72;
  float* scal = (float*)(vTL + 128 * 72);
  float* A0 = (float*)qL;
  float* A1 = (float*)kL;
  int tid = threadIdx.x;
  asm volatile("" : "+v"(tid));
  const int lane = tid & 63, w = __builtin_amdgcn_readfirstlane(tid >> 6), r = lane & 31, hh = lane >> 5;
  const int bh = item >> 6, c = item & 63, b = bh >> 2, h = bh & 3;
  const int t0 = b * SEQ + c * 64;
  __syncthreads();
  {
    float cw[3][2][5];
#pragma unroll
    for (int sec = 0; sec < 3; ++sec)
#pragma unroll
      for (int j = 0; j < 5; ++j) {
        cw[sec][0][j] = conv_w[(sec * 512 + h * 128 + 2 * lane) * 5 + j];
        cw[sec][1][j] = conv_w[(sec * 512 + h * 128 + 2 * lane + 1) * 5 + j];
      }
    for (int ii = 0; ii < 16; ++ii) {
      const int i = w * 16 + ii;
      const int s = c * 64 + i;
      const size_t t = (size_t)t0 + i;
#pragma unroll
      for (int sec = 0; sec < 3; ++sec) {
        const int c0 = sec * 512 + h * 128 + 2 * lane;
        float a0 = 0.f, a1 = 0.f;
#pragma unroll
        for (int j = 0; j < 5; ++j) {
          const int sp = s + j - 2;
          if (sp >= 0 && sp < SEQ) {
            const unsigned v = *(const unsigned*)(pm + (t + j - 2) * 4096 + c0);
            a0 += cw[sec][0][j] * bf2f((unsigned short)(v & 0xffff));
            a1 += cw[sec][1][j] * bf2f((unsigned short)(v >> 16));
          }
        }
        a0 = a0 * sigmoidf(a0);
        a1 = a1 * sigmoidf(a1);
        if (sec < 2) {
          const float ss = wave_sum(a0 * a0 + a1 * a1);
          float sc = rsqrtf(ss + EPSF);
          if (sec == 0) sc *= 0.08838834764831845f;
          a0 *= sc; a1 *= sc;
        }
        if (sec == 0) {
          *(unsigned*)(qL + i * 144 + 2 * lane) = pack2(a0, a1);
        } else if (sec == 1) {
          *(unsigned*)(kL + i * 144 + 2 * lane) = pack2(a0, a1);
          kTL[(2 * lane) * 72 + i] = f2bf(a0);
          kTL[(2 * lane + 1) * 72 + i] = f2bf(a1);
        } else {
          vTL[(2 * lane) * 72 + i] = f2bf(a0);
          vTL[(2 * lane + 1) * 72 + i] = f2bf(a1);
        }
      }
    }
  }
  if (w == 0) {
    const float* gp = gt + ((size_t)t0 + lane) * 32;
    const float g0 = gp[h], g1 = gp[4 + h], b0 = gp[8 + h], b1 = gp[12 + h];
    float G0 = g0, G1 = g1;
#pragma unroll
    for (int o = 1; o < 64; o <<= 1) {
      const float v0 = __shfl_up(G0, o, 64);
      const float v1 = __shfl_down(G1, o, 64);
      if (lane >= o) G0 += v0;
      if (lane + o < 64) G1 += v1;
    }
    scal[lane] = G0; scal[64 + lane] = G1; scal[128 + lane] = b0; scal[192 + lane] = b1;
    const float GL0 = __shfl(G0, 63, 64), GL1 = __shfl(G1, 0, 64);
    float* gs0 = G.gsc + ((size_t)((bh * 2 + 0) * 64 + c)) * 192;
    float* gs1 = G.gsc + ((size_t)((bh * 2 + 1) * 64 + c)) * 192;
    gs0[lane] = expf(G0); gs0[64 + lane] = expf(GL0 - G0);
    gs1[lane] = expf(G1); gs1[64 + lane] = expf(GL1 - G1);
    if (lane == 0) { gs0[128] = expf(GL0); gs1[128] = expf(GL1); }
  }
  __syncthreads();
  {
    unsigned short* qg = G.qc + (size_t)item * 8192;
    unsigned short* kg = G.kTc + (size_t)item * 8192;
#pragma unroll
    for (int i = 0; i < 4; ++i) {
      const int id = tid + i * 256;
      *(uint4*)(qg + (id >> 4) * 128 + (id & 15) * 8) = *(const uint4*)(qL + (id >> 4) * 144 + (id & 15) * 8);
      *(uint4*)(kg + (id >> 3) * 64 + (id & 7) * 8) = *(const uint4*)(kTL + (id >> 3) * 72 + (id & 7) * 8);
    }
  }
  {
    const int ta = w >> 1, tb = w & 1;
    f32x16 acc, acc2;
#pragma unroll
    for (int i = 0; i < 16; ++i) { acc[i] = 0.f; acc2[i] = 0.f; }
#pragma unroll
    for (int s = 0; s < 8; ++s) {
      const bf16x8 a = *(const bf16x8*)(kL + (32 * ta + r) * 144 + 16 * s + 8 * hh);
      const bf16x8 bk = *(const bf16x8*)(kL + (32 * tb + r) * 144 + 16 * s + 8 * hh);
      const bf16x8 bq = *(const bf16x8*)(qL + (32 * tb + r) * 144 + 16 * s + 8 * hh);
      acc = MFMA32(a, bk, acc);
      acc2 = MFMA32(a, bq, acc2);
    }
    __syncthreads();
    {
      const int col = 32 * tb + r;
      const float G0c = scal[col], G1c = scal[64 + col];
#pragma unroll
      for (int reg = 0; reg < 16; ++reg) {
        const int row = 32 * ta + crow(reg, hh);
        const float v = acc[reg];
        const float a0 = (col < row) ? scal[128 + row] * v * expf(scal[row] - G0c) : 0.f;
        const float a1 = (col > row) ? scal[192 + row] * v * expf(scal[64 + row] - G1c) : 0.f;
        A0[row * 72 + col] = a0;
        A1[(63 - row) * 72 + (63 - col)] = a1;
      }
    }
    {
      const int i = 32 * tb + r;
      const float G0i = scal[i], G1i = scal[64 + i];
      unsigned short* qk0 = G.qkc + ((size_t)((bh * 2 + 0) * 64 + c)) * 4096;
      unsigned short* qk1 = G.qkc + ((size_t)((bh * 2 + 1) * 64 + c)) * 4096;
#pragma unroll
      for (int g = 0; g < 4; ++g) {
        float o0[4], o1[4];
#pragma unroll
        for (int e = 0; e < 4; ++e) {
          const int j = 32 * ta + 8 * g + 4 * hh + e;
          const float v = acc2[4 * g + e];
          o0[e] = (j <= i) ? v * expf(G0i - scal[j]) : 0.f;
          o1[e] = (j >= i) ? v * expf(G1i - scal[64 + j]) : 0.f;
        }
        uint2 p0, p1;
        p0.x = pack2(o0[0], o0[1]); p0.y = pack2(o0[2], o0[3]);
        p1.x = pack2(o1[0], o1[1]); p1.y = pack2(o1[2], o1[3]);
        *(uint2*)(qk0 + i * 64 + 32 * ta + 8 * g + 4 * hh) = p0;
        *(uint2*)(qk1 + i * 64 + 32 * ta + 8 * g + 4 * hh) = p1;
      }
    }
  }
  __syncthreads();
  if (w < 2) {
    const int dir = w;
    float T[64];
    tri_subst(dir ? A1 : A0, lane, T);
    const int jn = dir ? 63 - lane : lane;
    const float sb = scal[128 + 64 * dir + jn];
    const float sbg = sb * expf(scal[64 * dir + jn]);
    unsigned short* Tb = dir ? kL : qL;
    unsigned short* Tbg = Tb + 64 * 72;
#pragma unroll
    for (int ip = 0; ip < 64; ++ip) {
      const int in = dir ? 63 - ip : ip;
      Tb[in * 72 + jn] = f2bf(T[ip] * sb);
      Tbg[in * 72 + jn] = f2bf(T[ip] * sbg);
    }
  }
  __syncthreads();
#pragma unroll
  for (int d = 0; d < 2; ++d) {
    const int chain = bh * 2 + d;
    const unsigned short* Tb = d ? kL : qL;
    const unsigned short* Tbg = Tb + 64 * 72;
    unsigned short* wng = G.wn + ((size_t)(chain * 64 + c)) * 8192;
    unsigned short* uog = G.uo + ((size_t)(chain * 64 + c)) * 8192 + w * 2048;
#pragma unroll
    for (int tb = 0; tb < 2; ++tb) {
      f32x16 acc, acc2;
#pragma unroll
      for (int i = 0; i < 16; ++i) { acc[i] = 0.f; acc2[i] = 0.f; }
#pragma unroll
      for (int s = 0; s < 4; ++s) {
        const bf16x8 a = *(const bf16x8*)(kTL + (32 * w + r) * 72 + 16 * s + 8 * hh);
        const bf16x8 bb = *(const bf16x8*)(Tbg + (32 * tb + r) * 72 + 16 * s + 8 * hh);
        acc = MFMA32(a, bb, acc);
        const bf16x8 a2 = *(const bf16x8*)(Tb + (32 * tb + r) * 72 + 16 * s + 8 * hh);
        const bf16x8 b2 = *(const bf16x8*)(vTL + (32 * w + r) * 72 + 16 * s + 8 * hh);
        acc2 = MFMA32(a2, b2, acc2);
      }
#pragma unroll
      for (int g = 0; g < 4; ++g) {
        uint2 pk;
        pk.x = pack2(-acc[4 * g], -acc[4 * g + 1]); pk.y = pack2(-acc[4 * g + 2], -acc[4 * g + 3]);
        *(uint2*)(wng + (32 * tb + r) * 128 + 32 * w + 8 * g + 4 * hh) = pk;
      }
      uint4 u0, u1;
      u0.x = pack2(acc2[0], acc2[1]); u0.y = pack2(acc2[2], acc2[3]); u0.z = pack2(acc2[4], acc2[5]); u0.w = pack2(acc2[6], acc2[7]);
      u1.x = pack2(acc2[8], acc2[9]); u1.y = pack2(acc2[10], acc2[11]); u1.z = pack2(acc2[12], acc2[13]); u1.w = pack2(acc2[14], acc2[15]);
      *(uint4*)(uog + tb * 1024 + lane * 16) = u0;
      *(uint4*)(uog + tb * 1024 + lane * 16 + 8) = u1;
    }
  }
}

__device__ __forceinline__ void d_gdn_scan(int chain, int sl, char* smem, GdnBufs G) {
  unsigned short* ST = (unsigned short*)smem;
  unsigned short* VT = ST + 32 * 136;
  unsigned short* VdT = VT + 32 * 72;
  const int tid = threadIdx.x, lane = tid & 63, w = tid >> 6, r = lane & 31, hh = lane >> 5;
  const int bh = chain >> 1, dir = chain & 1;
  f32x16 S;
#pragma unroll
  for (int i = 0; i < 16; ++i) S[i] = 0.f;
  for (int step = 0; step < 64; ++step) {
    const int c = dir ? 63 - step : step;
    const unsigned short* wn_c = G.wn + ((size_t)(chain * 64 + c)) * 8192;
    const unsigned short* q_c = G.qc + ((size_t)(bh * 64 + c)) * 8192;
    const unsigned short* kT_c = G.kTc + ((size_t)(bh * 64 + c)) * 8192;
    const unsigned short* qk_c = G.qkc + ((size_t)(chain * 64 + c)) * 4096;
    unsigned short* uo_c = G.uo + ((size_t)(chain * 64 + c)) * 8192 + sl * 2048;
    const float* gs = G.gsc + ((size_t)(chain * 64 + c)) * 192;
    const int ti = w & 1;
    bf16x8 kt[4], a[8], bq[4];
    float rs[16];
    f32x16 acc;
#pragma unroll
    for (int s = 0; s < 4; ++s) kt[s] = *(const bf16x8*)(kT_c + (32 * w + r) * 64 + 16 * s + 8 * hh);
    const float gtot = gs[128];
    if (w < 2) {
#pragma unroll
      for (int s = 0; s < 8; ++s) a[s] = *(const bf16x8*)(wn_c + (32 * ti + r) * 128 + 16 * s + 8 * hh);
      const uint4 u0 = *(const uint4*)(uo_c + ti * 1024 + lane * 16);
      const uint4 u1 = *(const uint4*)(uo_c + ti * 1024 + lane * 16 + 8);
      acc[0] = bf2f(u0.x & 0xffff); acc[1] = bf2f(u0.x >> 16); acc[2] = bf2f(u0.y & 0xffff); acc[3] = bf2f(u0.y >> 16);
      acc[4] = bf2f(u0.z & 0xffff); acc[5] = bf2f(u0.z >> 16); acc[6] = bf2f(u0.w & 0xffff); acc[7] = bf2f(u0.w >> 16);
      acc[8] = bf2f(u1.x & 0xffff); acc[9] = bf2f(u1.x >> 16); acc[10] = bf2f(u1.y & 0xffff); acc[11] = bf2f(u1.y >> 16);
      acc[12] = bf2f(u1.z & 0xffff); acc[13] = bf2f(u1.z >> 16); acc[14] = bf2f(u1.w & 0xffff); acc[15] = bf2f(u1.w >> 16);
#pragma unroll
      for (int reg = 0; reg < 16; ++reg) rs[reg] = gs[64 + 32 * ti + crow(reg, hh)];
    } else {
#pragma unroll
      for (int s = 0; s < 8; ++s) a[s] = *(const bf16x8*)(q_c + (32 * ti + r) * 128 + 16 * s + 8 * hh);
#pragma unroll
      for (int s = 0; s < 4; ++s) bq[s] = *(const bf16x8*)(qk_c + (32 * ti + r) * 64 + 16 * s + 8 * hh);
#pragma unroll
      for (int i = 0; i < 16; ++i) acc[i] = 0.f;
#pragma unroll
      for (int reg = 0; reg < 16; ++reg) rs[reg] = gs[32 * ti + crow(reg, hh)];
    }
#pragma unroll
    for (int g = 0; g < 4; ++g) {
      uint2 pk;
      pk.x = pack2(S[4 * g], S[4 * g + 1]); pk.y = pack2(S[4 * g + 2], S[4 * g + 3]);
      *(uint2*)(ST + r * 136 + 32 * w + 8 * g + 4 * hh) = pk;
    }
    __syncthreads();
#pragma unroll
    for (int s = 0; s < 8; ++s) {
      const bf16x8 bs = *(const bf16x8*)(ST + r * 136 + 16 * s + 8 * hh);
      acc = MFMA32(a[s], bs, acc);
    }
    if (w < 2) {
#pragma unroll
      for (int g = 0; g < 4; ++g) {
        uint2 pk, pd;
        pk.x = pack2(acc[4 * g], acc[4 * g + 1]); pk.y = pack2(acc[4 * g + 2], acc[4 * g + 3]);
        pd.x = pack2(acc[4 * g] * rs[4 * g], acc[4 * g + 1] * rs[4 * g + 1]);
        pd.y = pack2(acc[4 * g + 2] * rs[4 * g + 2], acc[4 * g + 3] * rs[4 * g + 3]);
        *(uint2*)(VT + r * 72 + 32 * ti + 8 * g + 4 * hh) = pk;
        *(uint2*)(VdT + r * 72 + 32 * ti + 8 * g + 4 * hh) = pd;
      }
    } else {
#pragma unroll
      for (int reg = 0; reg < 16; ++reg) acc[reg] *= rs[reg];
    }
    __syncthreads();
    if (w >= 2) {
#pragma unroll
      for (int s = 0; s < 4; ++s) {
        const bf16x8 bv = *(const bf16x8*)(VT + r * 72 + 16 * s + 8 * hh);
        acc = MFMA32(bq[s], bv, acc);
      }
#pragma unroll
      for (int reg = 0; reg < 16; ++reg) uo_c[(32 * ti + crow(reg, hh)) * 32 + r] = f2bf(acc[reg]);
    }
#pragma unroll
    for (int i = 0; i < 16; ++i) S[i] *= gtot;
#pragma unroll
    for (int s = 0; s < 4; ++s) {
      const bf16x8 bv = *(const bf16x8*)(VdT + r * 72 + 16 * s + 8 * hh);
      S = MFMA32(kt[s], bv, S);
    }
  }
}


__device__ __forceinline__ void d_mlstm_scan(int chain, int sl, char* smem, const unsigned short* __restrict__ pm,
                                             const float* __restrict__ gt, unsigned short* __restrict__ oM, int ntok) {
  unsigned short* qL = (unsigned short*)smem;
  unsigned short* kL = qL + 64 * 136;
  unsigned short* kdL = kL + 64 * 136;
  unsigned short* vTL = kdL + 64 * 136;
  unsigned short* S0T = vTL + 32 * 72;
  unsigned short* nL = S0T + 32 * 136;
  float* scal = (float*)(nL + 256);
  const int tid = threadIdx.x, lane = tid & 63, w = tid >> 6, r = lane & 31, hh = lane >> 5;
  const int bh = chain >> 1, dir = chain & 1, b = bh >> 2, h = bh & 3;
  const float SCALE = 0.08838834764831845f;
  f32x16 S0, S1;
#pragma unroll
  for (int i = 0; i < 16; ++i) { S0[i] = 0.f; S1[i] = 0.f; }
  bf16x8 ones;
#pragma unroll
  for (int i = 0; i < 8; ++i) ones[i] = (short)0x3F80;
  for (int step = 0; step < 64; ++step) {
    const int c = dir ? 63 - step : step;
    const size_t t0 = (size_t)b * SEQ + c * 64;
    const float lf = gt[(t0 + lane) * 32 + 24 + dir * 4 + h];
    const float ip = gt[(t0 + lane) * 32 + 16 + dir * 4 + h];
    float bc = lf;
#pragma unroll
    for (int o = 1; o < 64; o <<= 1) {
      const float vu = __shfl_up(bc, o, 64);
      const float vd = __shfl_down(bc, o, 64);
      if (dir == 0) { if (lane >= o) bc += vu; } else { if (lane + o < 64) bc += vd; }
    }
    const float b_last = __shfl(bc, dir ? 0 : 63, 64);
    const float Dj = SCALE * expf(b_last - bc + ip);
    const float gtot = expf(b_last);
    __syncthreads();
    if (w == 0) { scal[lane] = expf(bc); scal[64 + lane] = ip - bc; scal[128 + lane] = bc; }
#pragma unroll
    for (int i = 0; i < 4; ++i) {
      const int id = tid + i * 256;
      const int row = id >> 4, c16 = id & 15;
      const uint4 qv = *(const uint4*)(pm + (t0 + row) * 4096 + 2048 + h * 128 + c16 * 8);
      const uint4 kv = *(const uint4*)(pm + (t0 + row) * 4096 + 2560 + h * 128 + c16 * 8);
      *(uint4*)(qL + row * 136 + c16 * 8) = qv;
      *(uint4*)(kL + row * 136 + c16 * 8) = kv;
      const float d = __shfl(Dj, row, 64);
      uint4 kd;
      kd.x = pack2(bf2f(kv.x & 0xffff) * d, bf2f(kv.x >> 16) * d);
      kd.y = pack2(bf2f(kv.y & 0xffff) * d, bf2f(kv.y >> 16) * d);
      kd.z = pack2(bf2f(kv.z & 0xffff) * d, bf2f(kv.z >> 16) * d);
      kd.w = pack2(bf2f(kv.w & 0xffff) * d, bf2f(kv.w >> 16) * d);
      *(uint4*)(kdL + row * 136 + c16 * 8) = kd;
    }
    {
      const int tok = tid >> 2, d8 = (tid & 3) * 8;
      const uint4 vv = *(const uint4*)(pm + (t0 + tok) * 4096 + 3072 + h * 128 + sl * 32 + d8);
      vTL[(d8 + 0) * 72 + tok] = (unsigned short)(vv.x & 0xffff);
      vTL[(d8 + 1) * 72 + tok] = (unsigned short)(vv.x >> 16);
      vTL[(d8 + 2) * 72 + tok] = (unsigned short)(vv.y & 0xffff);
      vTL[(d8 + 3) * 72 + tok] = (unsigned short)(vv.y >> 16);
      vTL[(d8 + 4) * 72 + tok] = (unsigned short)(vv.z & 0xffff);
      vTL[(d8 + 5) * 72 + tok] = (unsigned short)(vv.z >> 16);
      vTL[(d8 + 6) * 72 + tok] = (unsigned short)(vv.w & 0xffff);
      vTL[(d8 + 7) * 72 + tok] = (unsigned short)(vv.w >> 16);
    }
#pragma unroll
    for (int g = 0; g < 4; ++g) {
      uint2 pk;
      pk.x = pack2(S0[4 * g], S0[4 * g + 1]); pk.y = pack2(S0[4 * g + 2], S0[4 * g + 3]);
      *(uint2*)(S0T + r * 136 + 32 * w + 8 * g + 4 * hh) = pk;
      if (r == 0) {
        uint2 pn;
        pn.x = pack2(S1[4 * g], S1[4 * g + 1]); pn.y = pack2(S1[4 * g + 2], S1[4 * g + 3]);
        *(uint2*)(nL + 32 * w + 8 * g + 4 * hh) = pn;
      }
    }
    __syncthreads();
    if (w < 2) {
      const int ti = w;
      const int icol = 32 * ti + r;
      const float bci = scal[128 + icol];
      f32x16 Q0, Q1;
#pragma unroll
      for (int i = 0; i < 16; ++i) { Q0[i] = 0.f; Q1[i] = 0.f; }
#pragma unroll
      for (int s2 = 0; s2 < 8; ++s2) {
        const bf16x8 a = *(const bf16x8*)(qL + (32 * ti + r) * 136 + 16 * s2 + 8 * hh);
        const bf16x8 b0 = *(const bf16x8*)(S0T + r * 136 + 16 * s2 + 8 * hh);
        const bf16x8 b1 = *(const bf16x8*)(nL + 16 * s2 + 8 * hh);
        Q0 = MFMA32(a, b0, Q0);
        Q1 = MFMA32(a, b1, Q1);
      }
#pragma unroll
      for (int reg = 0; reg < 16; ++reg) {
        const float e = scal[32 * ti + crow(reg, hh)];
        Q0[reg] *= e; Q1[reg] *= e;
      }
#pragma unroll
      for (int tj = 0; tj < 2; ++tj) {
        f32x16 X;
#pragma unroll
        for (int i = 0; i < 16; ++i) X[i] = 0.f;
#pragma unroll
        for (int s2 = 0; s2 < 8; ++s2) {
          const bf16x8 a = *(const bf16x8*)(kL + (32 * tj + r) * 136 + 16 * s2 + 8 * hh);
          const bf16x8 bq = *(const bf16x8*)(qL + (32 * ti + r) * 136 + 16 * s2 + 8 * hh);
          X = MFMA32(a, bq, X);
        }
#pragma unroll
        for (int reg = 0; reg < 16; ++reg) {
          const int j = 32 * tj + crow(reg, hh);
          const bool valid = dir ? (j >= icol) : (j <= icol);
          X[reg] = valid ? X[reg] * SCALE * expf(bci + scal[64 + j]) : 0.f;
        }
#pragma unroll
        for (int s2 = 0; s2 < 2; ++s2) {
          union { bf16x8 v; unsigned u[4]; } xa, bv;
          xa.u[0] = pack2(X[8 * s2 + 0], X[8 * s2 + 1]); xa.u[1] = pack2(X[8 * s2 + 2], X[8 * s2 + 3]);
          xa.u[2] = pack2(X[8 * s2 + 4], X[8 * s2 + 5]); xa.u[3] = pack2(X[8 * s2 + 6], X[8 * s2 + 7]);
          const uint2 v0 = *(const uint2*)(vTL + r * 72 + 32 * tj + 16 * s2 + 4 * hh);
          const uint2 v1 = *(const uint2*)(vTL + r * 72 + 32 * tj + 16 * s2 + 8 + 4 * hh);
          bv.u[0] = v0.x; bv.u[1] = v0.y; bv.u[2] = v1.x; bv.u[3] = v1.y;
          Q0 = MFMA32(xa.v, bv.v, Q0);
          Q1 = MFMA32(xa.v, ones, Q1);
        }
      }
#pragma unroll
      for (int reg = 0; reg < 16; ++reg) {
        const int i = 32 * ti + crow(reg, hh);
        oM[((size_t)dir * ntok + t0 + i) * 512 + h * 128 + sl * 32 + r] = f2bf(Q0[reg] / fmaxf(fabsf(Q1[reg]), 1.f));
      }
    }
#pragma unroll
    for (int i = 0; i < 16; ++i) { S0[i] *= gtot; S1[i] *= gtot; }
#pragma unroll
    for (int s2 = 0; s2 < 4; ++s2) {
      union { bf16x8 v; unsigned short e[8]; } a;
#pragma unroll
      for (int e = 0; e < 8; ++e) a.e[e] = kdL[(16 * s2 + 8 * hh + e) * 136 + 32 * w + r];
      const bf16x8 bv = *(const bf16x8*)(vTL + r * 72 + 16 * s2 + 8 * hh);
      S0 = MFMA32(a.v, bv, S0);
      S1 = MFMA32(a.v, ones, S1);
    }
  }
}

struct MKP {
  const float *x, *norm1_g, *w_in, *conv_w, *a_log, *dt_bias, *gdn_g, *i_bias, *f_bias, *ml_g, *w_out, *norm2_g, *peer_wq,
      *peer_keys, *peer_u, *peer_v, *normf_g;
  float* out;
  unsigned short *pm, *x1b, *woutT, *mt, *xb, *winT, *oM, *yb, *scores, *qkv_dbg, *oA_dbg, *utab, *vtab;
  float *x1, *rs1, *rs2, *gt, *gateb, *dbg;
  unsigned* bar;
  int* idxb;
  GdnBufs G;
};

constexpr int SMEM_BYTES = 74752;
#ifndef REP_S0
#define REP_S0 1
#endif
#ifndef REP_S1
#define REP_S1 1
#endif
#ifndef REP_S23
#define REP_S23 1
#endif
#ifndef REP_S2
#define REP_S2 1
#endif
#ifndef REP_S4
#define REP_S4 1
#endif
#ifndef REP_S5
#define REP_S5 1
#endif
#ifndef REP_S7
#define REP_S7 1
#endif
#ifndef REP_S8
#define REP_S8 1
#endif
#ifndef REP_S9
#define REP_S9 1
#endif

__global__ void __launch_bounds__(256, 2) k_mega(MKP P) {
  __shared__ __attribute__((aligned(16))) char smem_c[SMEM_BYTES + 16];
  {
    volatile LAS unsigned* st0 = (volatile LAS unsigned*)(smem_c + SMEM_BYTES);
    if (threadIdx.x < 4) st0[threadIdx.x] = 0u;
  }
  __syncthreads();
  XcdBarrier xb = xcd_barrier_post(P.bar, (volatile LAS unsigned*)(smem_c + SMEM_BYTES));
  unsigned short* smem = (unsigned short*)smem_c;
  const int nb = gridDim.x, bid = blockIdx.x;
  for (int rep = 0; rep < REP_S0; ++rep) {
  for (int it = bid; it < NT / 4; it += nb) d_prep_x(it, P.x, P.xb, P.rs1);
  for (int it = bid; it < NPAD_IN * DM / 256; it += nb) d_transpose_w(it, P.w_in, DIN, P.norm1_g, P.winT, NPAD_IN, 1);
  for (int it = bid; it < 1024 * DM / 256; it += nb) d_transpose_w(it, P.w_out, 1024, nullptr, P.woutT, 1024, 0);
  for (int it = bid; it < 2048 * 4; it += nb) d_make_mt(it, P.peer_wq, P.peer_keys, P.norm2_g, P.mt);
  if (bid == 0 && threadIdx.x < 2) P.dbg[threadIdx.x] = 0.f;
  xcd_barrier(xb);
  }
  for (int rep = 0; rep < REP_S1; ++rep) {
  {
    GemmP p{};
    p.A = P.xb; p.lda = DM; p.Bt = P.winT; p.ldb = DM; p.K = DM;
    p.rowscale = P.rs1; p.obf = P.pm; p.ldo = 4096; p.of32 = P.gt; p.ldf = 32; p.resid = nullptr;
    p.a_log = P.a_log; p.dt_bias = P.dt_bias; p.i_bias = P.i_bias; p.f_bias = P.f_bias;
    for (int tile = bid; tile < (NT / 128) * 33; tile += nb) {
      gemm_tile<EPI_INPROJ>(p, tile / 33, tile % 33, smem);
      __syncthreads();
    }
  }
  xcd_barrier(xb);
  }
  for (int rep23 = 0; rep23 < REP_S23; ++rep23) {
  for (int rep = 0; rep < REP_S2; ++rep) {
  for (int it = bid; it < 1024; it += nb) d_gdn_prep(it, smem_c, P.pm, P.gt, P.conv_w, P.G);
#ifdef DBG_CHECK
#endif
  xcd_barrier(xb);
  }
  if (bid < 128) {
    d_gdn_scan(bid >> 2, bid & 3, smem_c, P.G);
  } else if (bid < 256) {
    d_mlstm_scan((bid - 128) >> 2, (bid - 128) & 3, smem_c, P.pm, P.gt, P.oM, NT);
  }
#ifdef DBG_CHECK
  if (bid < 4) {
    __syncthreads();
    const int half = threadIdx.x >> 7;
    float* sq = (float*)smem + half * 256;
    float* sk = sq + 128;
    d_mlstm_rec(bid * 2 + half, sq, sk, P.pm, P.gt, P.oA_dbg, 4096);
  }
#endif
  xcd_barrier(xb);
  }
  for (int rep = 0; rep < REP_S4; ++rep) {
  for (int it = bid; it < NT / 4; it += nb) d_combine(it, P.G.uo, P.oM, P.pm, P.gdn_g, P.ml_g, P.yb);
#ifdef DBG_CHECK
  for (int it = bid; it < 4096 / 4; it += nb) d_dbg_cmp_m(it, P.oM, P.oA_dbg, P.dbg);
#endif
  xcd_barrier(xb);
  }
  for (int rep = 0; rep < REP_S5; ++rep) {
  {
    GemmP p{};
    p.A = P.yb; p.lda = DM; p.Bt = P.woutT; p.ldb = DM; p.K = DM;
    p.rowscale = nullptr; p.obf = P.x1b; p.ldo = DM; p.of32 = P.x1; p.ldf = DM; p.resid = P.x; p.rowacc = P.rs2;
    for (int tile = bid; tile < (NT / 128) * 8; tile += nb) {
      gemm_tile<EPI_OUTPROJ>(p, tile / 8, tile % 8, smem);
      __syncthreads();
    }
  }
  xcd_barrier(xb);
  }
  for (int rep = 0; rep < REP_S7; ++rep) {
  {
    GemmP p{};
    p.A = P.x1b; p.lda = DM; p.Bt = P.mt; p.ldb = DM; p.K = DM;
    p.rowscale = P.rs2; p.obf = P.scores; p.ldo = 2048; p.of32 = nullptr; p.ldf = 0; p.resid = nullptr;
    for (int tile = bid; tile < (NT / 128) * 16; tile += nb) {
      gemm_tile<EPI_SCORES>(p, tile / 16, tile % 16, smem);
      __syncthreads();
    }
  }
  xcd_barrier(xb);
  }
  for (int rep = 0; rep < REP_S8; ++rep) {
  for (int it = bid; it < 8192; it += nb) { d_cvt_tab(it, P.peer_u, P.utab); d_cvt_tab(it, P.peer_v, P.vtab); }
  for (int it = bid; it < NT * 8 / 256; it += nb) d_topk(it, P.scores, P.idxb, P.gateb);
  xcd_barrier(xb);
  }
  float oscale = 1.f;
#ifdef DBG_CHECK
  {
    const float sd = __hip_atomic_load(&P.dbg[0], __ATOMIC_RELAXED, __HIP_MEMORY_SCOPE_AGENT);
    const float sr = __hip_atomic_load(&P.dbg[1], __ATOMIC_RELAXED, __HIP_MEMORY_SCOPE_AGENT);
    oscale = 1.f + sqrtf(sd / sr);
  }
#endif
  for (int rep = 0; rep < REP_S9; ++rep)
  for (int it = bid; it < NT / 4; it += nb)
    d_peer(it, P.x1, P.rs2, P.norm2_g, P.idxb, P.gateb, P.utab, P.vtab, P.normf_g, P.out, oscale);
}

extern "C" void kernel_launch(void* const* d_in, const int* in_sizes, int n_in, void* d_out, int out_size, void* d_ws,
                              size_t ws_size, hipStream_t stream) {
  MKP P{};
  P.x = (const float*)d_in[0];
  P.norm1_g = (const float*)d_in[1];
  P.w_in = (const float*)d_in[2];
  P.conv_w = (const float*)d_in[3];
  P.a_log = (const float*)d_in[4];
  P.dt_bias = (const float*)d_in[5];
  P.gdn_g = (const float*)d_in[6];
  P.i_bias = (const float*)d_in[7];
  P.f_bias = (const float*)d_in[8];
  P.ml_g = (const float*)d_in[9];
  P.w_out = (const float*)d_in[10];
  P.norm2_g = (const float*)d_in[11];
  P.peer_wq = (const float*)d_in[12];
  P.peer_keys = (const float*)d_in[13];
  P.peer_u = (const float*)d_in[14];
  P.peer_v = (const float*)d_in[15];
  P.normf_g = (const float*)d_in[16];
  P.out = (float*)d_out;

  char* ws = (char*)d_ws;
  const size_t MB = 1024 * 1024;
  P.pm = (unsigned short*)(ws);
  P.x1 = (float*)(ws);
  P.x1b = (unsigned short*)(ws + 64 * MB);
  P.utab = (unsigned short*)(ws + 64 * MB);
  P.vtab = (unsigned short*)(ws + 96 * MB);
  char* rb = ws + 128 * MB;
  P.woutT = (unsigned short*)(rb);
  P.mt = (unsigned short*)(rb + 2 * MB);
  P.rs1 = (float*)(rb + 6 * MB);
  P.rs2 = (float*)(rb + 7 * MB);
  P.dbg = (float*)(rb + 6 * MB + 131072);
  P.bar = (unsigned*)(rb + 6 * MB + 196608);
  P.gt = (float*)(rb + 9 * MB);
  char* dyn = rb + 11 * MB;
  P.xb = (unsigned short*)(dyn);
  P.winT = (unsigned short*)(dyn + 32 * MB);
  P.G.qc = (unsigned short*)(dyn);
  P.G.kTc = (unsigned short*)(dyn + 16 * MB);
  P.G.qkc = (unsigned short*)(dyn + 32 * MB);
  P.G.wn = (unsigned short*)(dyn + 48 * MB);
  P.G.uo = (unsigned short*)(dyn + 80 * MB);
  P.G.gsc = (float*)(dyn + 112 * MB);
  P.yb = (unsigned short*)(dyn);
  P.scores = (unsigned short*)(dyn);
  P.idxb = (int*)(dyn + 64 * MB);
  P.gateb = (float*)(dyn + 72 * MB);
  char* os = (char*)d_out;
  P.oM = (unsigned short*)(os);
  P.qkv_dbg = (unsigned short*)(os + 32 * MB);
  P.oA_dbg = (unsigned short*)(os + 44 * MB);

  static int grid_blocks = 0;
  if (!grid_blocks) {
    int dev = 0, cus = 0, per_cu = 0;
    (void)hipGetDevice(&dev);
    (void)hipDeviceGetAttribute(&cus, hipDeviceAttributeMultiprocessorCount, dev);
    (void)hipOccupancyMaxActiveBlocksPerMultiprocessor(&per_cu, k_mega, 256, 0);
    if (per_cu > 2) per_cu = 2;
    if (per_cu < 1) per_cu = 1;
    grid_blocks = cus * per_cu;
  }
  (void)hipMemsetAsync(P.bar, 0, XCD_BAR_WORDS * sizeof(unsigned), stream);
  hipLaunchKernelGGL(k_mega, dim3(grid_blocks), dim3(256), 0, stream, P);
}
```

```cpp
#include <hip/hip_runtime.h>
#include <hip/hip_bf16.h>
#include <stdint.h>
#include <cstdio>

#define XB_TMO      128
#define XB_XCNT(j)  (256  + 64 * (j))
#define XB_XSUB(j)  (1280 + 64 * (j))
#define XB_XGEN(j)  (2304 + 64 * (j))
#define XB_TOP      3328
#define XB_TOPGEN   3392
#define XCD_BAR_WORDS 3456
#define XB_SPIN_CAP (1u << 18)
#define LAS __attribute__((address_space(3)))

__device__ __forceinline__ unsigned xb_ld(unsigned* p)              { return __hip_atomic_load(p, __ATOMIC_RELAXED, __HIP_MEMORY_SCOPE_AGENT); }
__device__ __forceinline__ unsigned xb_add(unsigned* p, unsigned v) { return __hip_atomic_fetch_add(p, v, __ATOMIC_RELAXED, __HIP_MEMORY_SCOPE_AGENT); }
__device__ __forceinline__ unsigned xb_xcc_id() { return (unsigned)__builtin_amdgcn_s_getreg((3 << 11) | 20) & 0xFu; }
#define XB_SPIN(cond, bar) do { unsigned _sp = 0; while (cond) { __builtin_amdgcn_s_sleep(1); \
    if ((++_sp & 255u) == 0u) { if (xb_ld(&(bar)[XB_TMO])) break; if (_sp > XB_SPIN_CAP) { atomicAdd(&(bar)[XB_TMO], 1u); break; } } } } while (0)

struct XcdBarrier {
    unsigned* bar; unsigned x;
    volatile LAS unsigned* st;
};

__device__ __forceinline__ XcdBarrier xcd_barrier_post(unsigned* bar, volatile LAS unsigned* st) {
    XcdBarrier b; b.bar = bar; b.x = xb_xcc_id(); b.st = st;
    if (threadIdx.x == 0) (void)xb_add(&bar[XB_XCNT(b.x)], 1u);
    return b;
}
__device__ __forceinline__ void xcd_barrier_complete(unsigned* bar, unsigned x, unsigned& nloc, unsigned& nx) {
    const unsigned G = gridDim.x * gridDim.y * gridDim.z;
    unsigned sum, cnt, mine, sp = 0u;
    for (;;) {
        sum = 0u; cnt = 0u; mine = 0u;
#pragma unroll
        for (unsigned j = 0; j < 16; ++j) { const unsigned c = xb_ld(&bar[XB_XCNT(j)]); sum += c; cnt += (c > 0u) ? 1u : 0u; mine = (j == x) ? c : mine; }
        if (sum == G) break;
        __builtin_amdgcn_s_sleep(1);
        if ((++sp & 255u) == 0u) { if (xb_ld(&bar[XB_TMO])) break; if (sp > XB_SPIN_CAP) { atomicAdd(&bar[XB_TMO], 1u); break; } }
    }
    nloc = mine > 0u ? mine : 1u; nx = cnt > 0u ? cnt : 1u;
}

__device__ __forceinline__ void xcd_barrier(const XcdBarrier& b) {
    asm volatile("s_waitcnt vmcnt(0)" ::: "memory");
    __syncthreads();
    if (threadIdx.x == 0) {
        unsigned* bar = b.bar;
        __builtin_amdgcn_s_waitcnt(0);
        unsigned nloc = b.st[0], nx = b.st[1];
        if (nloc == 0u) { xcd_barrier_complete(bar, b.x, nloc, nx); b.st[0] = nloc; b.st[1] = nx; }
        const unsigned old = xb_add(&bar[XB_XSUB(b.x)], 1u);
        const unsigned gen = old / nloc;
        if (old + 1u == (gen + 1u) * nloc) {
            __builtin_amdgcn_fence(__ATOMIC_RELEASE, "agent");
            asm volatile("s_waitcnt vmcnt(0)" ::: "memory");
            const unsigned og = xb_add(&bar[XB_TOP], 1u);
            const unsigned tg = og / nx;
            if (og + 1u == (tg + 1u) * nx) xb_add(&bar[XB_TOPGEN], 1u);
            else XB_SPIN(xb_ld(&bar[XB_TOPGEN]) == tg, bar);
            __builtin_amdgcn_fence(__ATOMIC_ACQUIRE, "agent");
            xb_add(&bar[XB_XGEN(b.x)], 1u);
            asm volatile("s_waitcnt vmcnt(0)" ::: "memory");
        } else {
            XB_SPIN(xb_ld(&bar[XB_XGEN(b.x)]) == gen, bar);
            __builtin_amdgcn_fence(__ATOMIC_ACQUIRE, "agent");
            asm volatile("s_waitcnt vmcnt(0)" ::: "memory");
        }
    }
    __syncthreads();
}


typedef __hip_bfloat16 bf16;
typedef __attribute__((ext_vector_type(8))) short bf16x8;
typedef __attribute__((ext_vector_type(4))) float f32x4;

constexpr int DM = 1024;
constexpr int NB = 4;
constexpr int SEQ = 4096;
constexpr int NT = NB * SEQ;
constexpr int DIN = 4128;
constexpr int NPAD_IN = 4224;
constexpr float EPSF = 1e-6f;

__device__ __forceinline__ float bf2f(unsigned short u) { return __uint_as_float(((unsigned)u) << 16); }
__device__ __forceinline__ unsigned short f2bf(float f) {
  unsigned u = __float_as_uint(f);
  u += 0x7fffu + ((u >> 16) & 1u);
  return (unsigned short)(u >> 16);
}
__device__ __forceinline__ float wave_sum(float v) {
#pragma unroll
  for (int o = 32; o > 0; o >>= 1) v += __shfl_xor(v, o, 64);
  return v;
}
__device__ __forceinline__ float softplusf(float x) { return fmaxf(x, 0.f) + log1pf(expf(-fabsf(x))); }
__device__ __forceinline__ float sigmoidf(float x) { return 1.f / (1.f + expf(-x)); }

__device__ __forceinline__ void d_prep_x(int item, const float* __restrict__ x, unsigned short* __restrict__ xb,
                                                float* __restrict__ rs) {
  int t = item * 4 + (threadIdx.x >> 6);
  int lane = threadIdx.x & 63;
  const float4* xr = (const float4*)(x + (size_t)t * DM);
  float ss = 0.f;
#pragma unroll
  for (int i = 0; i < 4; ++i) {
    float4 v = xr[lane + 64 * i];
    ss += v.x * v.x + v.y * v.y + v.z * v.z + v.w * v.w;
    ushort4 o;
    o.x = f2bf(v.x); o.y = f2bf(v.y); o.z = f2bf(v.z); o.w = f2bf(v.w);
    ((ushort4*)(xb + (size_t)t * DM))[lane + 64 * i] = o;
  }
  ss = wave_sum(ss);
  if (lane == 0) rs[t] = rsqrtf(ss * (1.f / DM) + EPSF);
}

__device__ __forceinline__ int win_src(int n) {
  if (n < 2048) return n;
  if (n < 4096) return n + 16;
  int j = n - 4096;
  if (j < 16) return 2048 + j;
  if (j < 32) return 4112 + (j - 16);
  return -1;
}
__device__ __forceinline__ void d_transpose_w(int item, const float* __restrict__ in, int ldn, const float* __restrict__ g,
                                                     unsigned short* __restrict__ out, int nrows, int mode) {
  size_t id = (size_t)item * 256 + threadIdx.x;
  if (id >= (size_t)nrows * DM) return;
  int n = (int)(id >> 10);
  int k = (int)(id & 1023);
  int src = mode ? win_src(n) : n;
  float v = 0.f;
  if (src >= 0) v = in[(size_t)k * ldn + src] * (g ? g[k] : 1.f);
  out[id] = f2bf(v);
}
__device__ __forceinline__ void d_make_mt(int item, const float* __restrict__ wq, const float* __restrict__ keys,
                                                 const float* __restrict__ g2, unsigned short* __restrict__ mt) {
  int n = item >> 2;
  int d = (item & 3) * 256 + threadIdx.x;
  int hp = n >> 7;
  const float4* kr = (const float4*)(keys + (size_t)n * 128);
  const float4* wr = (const float4*)(wq + (size_t)d * 2048 + hp * 128);
  float s = 0.f;
#pragma unroll 8
  for (int j = 0; j < 32; ++j) {
    float4 a = kr[j], b = wr[j];
    s += a.x * b.x + a.y * b.y + a.z * b.z + a.w * b.w;
  }
  mt[(size_t)n * DM + d] = f2bf(s * g2[d]);
}

constexpr int GBM = 128, GBN = 128, GBK = 64, GLD = 72;
struct GemmP {
  const unsigned short* A; const unsigned short* Bt; int lda, ldb, K;
  const float* rowscale;
  unsigned short* obf; int ldo;
  float* of32; int ldf;
  const float* resid;
  const float *a_log, *dt_bias, *i_bias, *f_bias;
  float* rowacc;
};
enum { EPI_INPROJ = 0, EPI_OUTPROJ = 1, EPI_SCORES = 2 };

template <int EPI>
__device__ __forceinline__ void gemm_tile(const GemmP p, int tm, int tn, unsigned short* smem) {
  unsigned short* As = smem;
  unsigned short* Bs = smem + 2 * GBM * GLD;
  const int tid = threadIdx.x, lane = tid & 63, wid = tid >> 6;
  const int wm = wid >> 1, wn = wid & 1;
  const int m0 = tm * GBM, n0 = tn * GBN;
  f32x4 acc[4][4];
#pragma unroll
  for (int i = 0; i < 4; ++i)
#pragma unroll
    for (int j = 0; j < 4; ++j) acc[i][j] = (f32x4){0.f, 0.f, 0.f, 0.f};

  uint4 ra0, ra1, ra2, ra3, rb0, rb1, rb2, rb3;
  const int nk = p.K / GBK;
  const int lrow = tid >> 3, lc8 = tid & 7;
  const unsigned short* Ag = p.A + (size_t)(m0 + lrow) * p.lda + lc8 * 8;
  const unsigned short* Bg = p.Bt + (size_t)(n0 + lrow) * p.ldb + lc8 * 8;
  const size_t a32 = (size_t)32 * p.lda, b32 = (size_t)32 * p.ldb;
#define GLOAD(kt)                                                        \
  {                                                                      \
    ra0 = *(const uint4*)(Ag + (kt) * GBK);                              \
    ra1 = *(const uint4*)(Ag + a32 + (kt) * GBK);                        \
    ra2 = *(const uint4*)(Ag + 2 * a32 + (kt) * GBK);                    \
    ra3 = *(const uint4*)(Ag + 3 * a32 + (kt) * GBK);                    \
    rb0 = *(const uint4*)(Bg + (kt) * GBK);                              \
    rb1 = *(const uint4*)(Bg + b32 + (kt) * GBK);                        \
    rb2 = *(const uint4*)(Bg + 2 * b32 + (kt) * GBK);                    \
    rb3 = *(const uint4*)(Bg + 3 * b32 + (kt) * GBK);                    \
  }
#define SSTORE(buf)                                                      \
  {                                                                      \
    unsigned short* ad = As + (size_t)(buf) * GBM * GLD + lrow * GLD + lc8 * 8; \
    unsigned short* bd = Bs + (size_t)(buf) * GBN * GLD + lrow * GLD + lc8 * 8; \
    *(uint4*)(ad) = ra0; *(uint4*)(ad + 32 * GLD) = ra1; *(uint4*)(ad + 64 * GLD) = ra2; *(uint4*)(ad + 96 * GLD) = ra3; \
    *(uint4*)(bd) = rb0; *(uint4*)(bd + 32 * GLD) = rb1; *(uint4*)(bd + 64 * GLD) = rb2; *(uint4*)(bd + 96 * GLD) = rb3; \
  }
  GLOAD(0);
  SSTORE(0);
  __syncthreads();
  for (int kt = 0; kt < nk; ++kt) {
    const int buf = kt & 1;
    if (kt + 1 < nk) GLOAD(kt + 1);
    const unsigned short* Ab = As + (size_t)buf * GBM * GLD;
    const unsigned short* Bb = Bs + (size_t)buf * GBN * GLD;
#pragma unroll
    for (int ks = 0; ks < 2; ++ks) {
      bf16x8 a[4], b[4];
      const int kc = ks * 32 + (lane >> 4) * 8;
#pragma unroll
      for (int i = 0; i < 4; ++i) a[i] = *(const bf16x8*)(Ab + (wm * 64 + i * 16 + (lane & 15)) * GLD + kc);
#pragma unroll
      for (int j = 0; j < 4; ++j) b[j] = *(const bf16x8*)(Bb + (wn * 64 + j * 16 + (lane & 15)) * GLD + kc);
#pragma unroll
      for (int i = 0; i < 4; ++i)
#pragma unroll
        for (int j = 0; j < 4; ++j) acc[i][j] = __builtin_amdgcn_mfma_f32_16x16x32_bf16(a[i], b[j], acc[i][j], 0, 0, 0);
    }
    if (kt + 1 < nk) SSTORE(buf ^ 1);
    __syncthreads();
  }
#undef GLOAD
#undef SSTORE
#pragma unroll
  for (int i = 0; i < 4; ++i) {
#pragma unroll
    for (int r = 0; r < 4; ++r) {
      const int row = m0 + wm * 64 + i * 16 + (lane >> 4) * 4 + r;
      float rsc = 1.f;
      float rowss = 0.f;
      if (EPI == EPI_INPROJ) rsc = p.rowscale[row];
      if (EPI == EPI_SCORES) {
        const float4* pr = (const float4*)(p.rowscale + (size_t)row * 16);
        const float4 s0 = pr[0], s1 = pr[1], s2 = pr[2], s3 = pr[3];
        const float ssq = ((s0.x + s0.y) + (s0.z + s0.w)) + ((s1.x + s1.y) + (s1.z + s1.w)) + ((s2.x + s2.y) + (s2.z + s2.w)) + ((s3.x + s3.y) + (s3.z + s3.w));
        rsc = rsqrtf(ssq * (1.f / DM) + EPSF);
      }
#pragma unroll
      for (int j = 0; j < 4; ++j) {
        const int col = n0 + wn * 64 + j * 16 + (lane & 15);
        float v = acc[i][j][r] * rsc;
        if (EPI == EPI_INPROJ) {
          if (col < 4096) p.obf[(size_t)row * p.ldo + col] = f2bf(v);
          else if (col < 4128) {
            const int j = col - 4096, jj = j & 7;
            float o;
            if (j < 8) o = -expf(p.a_log[jj]) * softplusf(v + p.dt_bias[jj]);
            else if (j < 16) o = sigmoidf(v);
            else if (j < 24) o = v + p.i_bias[jj];
            else o = -softplusf(-(v + p.f_bias[jj]));
            p.of32[(size_t)row * p.ldf + j] = o;
          }
        } else if (EPI == EPI_OUTPROJ) {
          const float xo = v + p.resid[(size_t)row * p.ldf + col];
          p.of32[(size_t)row * p.ldf + col] = xo;
          p.obf[(size_t)row * p.ldo + col] = f2bf(xo);
          rowss += xo * xo;
        } else {
          p.obf[(size_t)row * p.ldo + col] = f2bf(v);
        }
      }
      if (EPI == EPI_OUTPROJ) {
        rowss += __shfl_xor(rowss, 1, 64); rowss += __shfl_xor(rowss, 2, 64);
        rowss += __shfl_xor(rowss, 4, 64); rowss += __shfl_xor(rowss, 8, 64);
        if ((lane & 15) == 0) p.rowacc[(size_t)row * 16 + tn * 2 + wn] = rowss;
      }
    }
  }
}

__device__ __forceinline__ void d_conv(int item, const unsigned short* __restrict__ pm, const float* __restrict__ pg,
                                              const float* __restrict__ conv_w, const float* __restrict__ a_log,
                                              const float* __restrict__ dt_bias, const float* __restrict__ i_bias,
                                              const float* __restrict__ f_bias, unsigned short* __restrict__ qkv,
                                              float* __restrict__ gt) {
  int t = item * 4 + (threadIdx.x >> 6);
  int lane = threadIdx.x & 63;
  int s = t & (SEQ - 1);
  for (int sec = 0; sec < 3; ++sec) {
    for (int h = 0; h < 4; ++h) {
      int c0 = sec * 512 + h * 128 + 2 * lane;
      float a0 = 0.f, a1 = 0.f;
#pragma unroll
      for (int j = 0; j < 5; ++j) {
        int sp = s + j - 2;
        if (sp >= 0 && sp < SEQ) {
          unsigned v = *(const unsigned*)(pm + (size_t)(t + j - 2) * 4096 + c0);
          a0 += conv_w[c0 * 5 + j] * bf2f((unsigned short)(v & 0xffff));
          a1 += conv_w[(c0 + 1) * 5 + j] * bf2f((unsigned short)(v >> 16));
        }
      }
      a0 = a0 * sigmoidf(a0);
      a1 = a1 * sigmoidf(a1);
      if (sec < 2) {
        float ss = wave_sum(a0 * a0 + a1 * a1);
        float sc = rsqrtf(ss + EPSF);
        if (sec == 0) sc *= 0.08838834764831845f;
        a0 *= sc; a1 *= sc;
      }
      unsigned o = (unsigned)f2bf(a0) | ((unsigned)f2bf(a1) << 16);
      *(unsigned*)(qkv + (size_t)t * 1536 + c0) = o;
    }
  }
}

__device__ __forceinline__ void d_gdn_rec(int chain, float* sq, float* sk, const unsigned short* __restrict__ qkv,
                                                 const float* __restrict__ gt, unsigned short* __restrict__ oA, int ntok) {
  const int bh = chain >> 1, dir = chain & 1;
  const int b = bh >> 2, h = bh & 3;
  const int e = threadIdx.x & 127;
  float S[128];
#pragma unroll
  for (int d = 0; d < 128; ++d) S[d] = 0.f;
  for (int it = 0; it < SEQ; ++it) {
    const int s = dir ? (SEQ - 1 - it) : it;
    const size_t t = (size_t)b * SEQ + s;
    __syncthreads();
    sq[e] = bf2f(qkv[t * 1536 + h * 128 + e]);
    sk[e] = bf2f(qkv[t * 1536 + 512 + h * 128 + e]);
    const float v = bf2f(qkv[t * 1536 + 1024 + h * 128 + e]);
    const float g = gt[t * 32 + dir * 4 + h];
    const float beta = gt[t * 32 + 8 + dir * 4 + h];
    __syncthreads();
    const float a = expf(g);
    float k0 = 0.f, k1 = 0.f, k2 = 0.f, k3 = 0.f;
#pragma unroll
    for (int d = 0; d < 128; d += 4) {
      k0 += sk[d] * S[d]; k1 += sk[d + 1] * S[d + 1]; k2 += sk[d + 2] * S[d + 2]; k3 += sk[d + 3] * S[d + 3];
    }
    const float kS = a * ((k0 + k1) + (k2 + k3));
    const float vn = beta * (v - kS);
    float o0 = 0.f, o1 = 0.f, o2 = 0.f, o3 = 0.f;
#pragma unroll
    for (int d = 0; d < 128; d += 4) {
      S[d] = a * S[d] + sk[d] * vn;             o0 += sq[d] * S[d];
      S[d + 1] = a * S[d + 1] + sk[d + 1] * vn; o1 += sq[d + 1] * S[d + 1];
      S[d + 2] = a * S[d + 2] + sk[d + 2] * vn; o2 += sq[d + 2] * S[d + 2];
      S[d + 3] = a * S[d + 3] + sk[d + 3] * vn; o3 += sq[d + 3] * S[d + 3];
    }
    oA[((size_t)dir * ntok + t) * 512 + h * 128 + e] = f2bf((o0 + o1) + (o2 + o3));
  }
}

__device__ __forceinline__ void d_mlstm_rec(int chain, float* sq, float* sk, const unsigned short* __restrict__ pm,
                                                   const float* __restrict__ gt, unsigned short* __restrict__ oM, int ntok) {
  const int bh = chain >> 1, dir = chain & 1;
  const int b = bh >> 2, h = bh & 3;
  const int e = threadIdx.x & 127, lane = e & 63;
  float C[128];
#pragma unroll
  for (int d = 0; d < 128; ++d) C[d] = 0.f;
  float n0 = 0.f, n1 = 0.f, m = 0.f;
  for (int it = 0; it < SEQ; ++it) {
    const int s = dir ? (SEQ - 1 - it) : it;
    const size_t t = (size_t)b * SEQ + s;
    __syncthreads();
    sq[e] = bf2f(pm[t * 4096 + 2048 + h * 128 + e]);
    sk[e] = bf2f(pm[t * 4096 + 2560 + h * 128 + e]) * 0.08838834764831845f;
    const float v = bf2f(pm[t * 4096 + 3072 + h * 128 + e]);
    const float ip = gt[t * 32 + 16 + dir * 4 + h];
    const float lf = gt[t * 32 + 24 + dir * 4 + h];
    __syncthreads();
    const float mn = fmaxf(lf + m, ip);
    const float fs = expf(lf + m - mn);
    const float is = expf(ip - mn);
    m = mn;
    n0 = fs * n0 + is * sk[lane];
    n1 = fs * n1 + is * sk[lane + 64];
    const float den = wave_sum(n0 * sq[lane] + n1 * sq[lane + 64]);
    const float iv = is * v;
    float o0 = 0.f, o1 = 0.f, o2 = 0.f, o3 = 0.f;
#pragma unroll
    for (int d = 0; d < 128; d += 4) {
      C[d] = fs * C[d] + sk[d] * iv;             o0 += sq[d] * C[d];
      C[d + 1] = fs * C[d + 1] + sk[d + 1] * iv; o1 += sq[d + 1] * C[d + 1];
      C[d + 2] = fs * C[d + 2] + sk[d + 2] * iv; o2 += sq[d + 2] * C[d + 2];
      C[d + 3] = fs * C[d + 3] + sk[d + 3] * iv; o3 += sq[d + 3] * C[d + 3];
    }
    const float num = (o0 + o1) + (o2 + o3);
    const float hh = num / fmaxf(fabsf(den), expf(-mn));
    oM[((size_t)dir * ntok + t) * 512 + h * 128 + e] = f2bf(hh);
  }
}

__device__ __forceinline__ void d_combine(int item, const unsigned short* __restrict__ uo, const unsigned short* __restrict__ oM,
                                                 const unsigned short* __restrict__ pm, const float* __restrict__ gdn_g,
                                                 const float* __restrict__ ml_g, unsigned short* __restrict__ y) {
  int t = item * 4 + (threadIdx.x >> 6);
  int lane = threadIdx.x & 63;
  const int b = t >> 12, cc = (t >> 6) & 63, ii = t & 63;
  for (int h = 0; h < 4; ++h) {
    int c = h * 128 + 2 * lane;
    {
      const int chain0 = (b * 4 + h) * 2;
      const size_t off = (size_t)cc * 8192 + (lane >> 4) * 2048 + ii * 32 + ((2 * lane) & 31);
      unsigned vf = *(const unsigned*)(uo + (size_t)chain0 * 64 * 8192 + off);
      unsigned vb = *(const unsigned*)(uo + (size_t)(chain0 + 1) * 64 * 8192 + off);
      float o0 = bf2f(vf & 0xffff) + bf2f(vb & 0xffff);
      float o1 = bf2f(vf >> 16) + bf2f(vb >> 16);
      float ss = wave_sum(o0 * o0 + o1 * o1);
      float sc = rsqrtf(ss * (1.f / 128.f) + EPSF);
      unsigned z = *(const unsigned*)(pm + (size_t)t * 4096 + 1536 + c);
      float z0 = bf2f(z & 0xffff), z1 = bf2f(z >> 16);
      o0 = o0 * sc * gdn_g[2 * lane] * (z0 * sigmoidf(z0));
      o1 = o1 * sc * gdn_g[2 * lane + 1] * (z1 * sigmoidf(z1));
      *(unsigned*)(y + (size_t)t * DM + c) = (unsigned)f2bf(o0) | ((unsigned)f2bf(o1) << 16);
    }
    {
      unsigned vf = *(const unsigned*)(oM + (size_t)t * 512 + c);
      unsigned vb = *(const unsigned*)(oM + ((size_t)NT + t) * 512 + c);
      float o0 = bf2f(vf & 0xffff) + bf2f(vb & 0xffff);
      float o1 = bf2f(vf >> 16) + bf2f(vb >> 16);
      float ss = wave_sum(o0 * o0 + o1 * o1);
      float sc = rsqrtf(ss * (1.f / 128.f) + EPSF);
      unsigned z = *(const unsigned*)(pm + (size_t)t * 4096 + 3584 + c);
      float z0 = bf2f(z & 0xffff), z1 = bf2f(z >> 16);
      o0 = o0 * sc * ml_g[c] * sigmoidf(z0);
      o1 = o1 * sc * ml_g[c + 1] * sigmoidf(z1);
      *(unsigned*)(y + (size_t)t * DM + 512 + c) = (unsigned)f2bf(o0) | ((unsigned)f2bf(o1) << 16);
    }
  }
}

#ifdef DBG_CHECK
__device__ __forceinline__ void d_dbg_cmp(int item, const unsigned short* __restrict__ uo, const unsigned short* __restrict__ oAd,
                                          float* __restrict__ dbg) {
  int t = item * 4 + (threadIdx.x >> 6);
  int lane = threadIdx.x & 63;
  const int cc = (t >> 6) & 63, ii = t & 63;
  float sd = 0.f, sr = 0.f;
  for (int h = 0; h < 4; ++h) {
    for (int dir = 0; dir < 2; ++dir) {
      const int chain = h * 2 + dir;
      const size_t off = (size_t)cc * 8192 + (lane >> 4) * 2048 + ii * 32 + ((2 * lane) & 31);
      unsigned vn = *(const unsigned*)(uo + (size_t)chain * 64 * 8192 + off);
      unsigned vr = *(const unsigned*)(oAd + ((size_t)dir * 4096 + t) * 512 + h * 128 + 2 * lane);
      float n0 = bf2f(vn & 0xffff), n1 = bf2f(vn >> 16), r0 = bf2f(vr & 0xffff), r1 = bf2f(vr >> 16);
      sd += (n0 - r0) * (n0 - r0) + (n1 - r1) * (n1 - r1);
      sr += r0 * r0 + r1 * r1;
    }
  }
  sd = wave_sum(sd); sr = wave_sum(sr);
  if (lane == 0) { atomicAdd(&dbg[0], sd); atomicAdd(&dbg[1], sr); }
}
__device__ __forceinline__ void d_dbg_cmp_m(int item, const unsigned short* __restrict__ oM, const unsigned short* __restrict__ oMd,
                                            float* __restrict__ dbg) {
  int t = item * 4 + (threadIdx.x >> 6);
  int lane = threadIdx.x & 63;
  float sd = 0.f, sr = 0.f;
  for (int dir = 0; dir < 2; ++dir)
    for (int q = 0; q < 4; ++q) {
      unsigned vn = *(const unsigned*)(oM + ((size_t)dir * NT + t) * 512 + q * 128 + 2 * lane);
      unsigned vr = *(const unsigned*)(oMd + ((size_t)dir * 4096 + t) * 512 + q * 128 + 2 * lane);
      float n0 = bf2f(vn & 0xffff), n1 = bf2f(vn >> 16), r0 = bf2f(vr & 0xffff), r1 = bf2f(vr >> 16);
      sd += (n0 - r0) * (n0 - r0) + (n1 - r1) * (n1 - r1);
      sr += r0 * r0 + r1 * r1;
    }
  sd = wave_sum(sd); sr = wave_sum(sr);
  if (lane == 0) { atomicAdd(&dbg[0], sd); atomicAdd(&dbg[1], sr); }
}
#endif

__device__ __forceinline__ void d_prep_x1(int item, const float* __restrict__ x1, unsigned short* __restrict__ xb,
                                                 float* __restrict__ rs) {
  int t = item * 4 + (threadIdx.x >> 6);
  int lane = threadIdx.x & 63;
  const float4* xr = (const float4*)(x1 + (size_t)t * DM);
  float ss = 0.f;
#pragma unroll
  for (int i = 0; i < 4; ++i) {
    float4 v = xr[lane + 64 * i];
    ss += v.x * v.x + v.y * v.y + v.z * v.z + v.w * v.w;
    ushort4 o;
    o.x = f2bf(v.x); o.y = f2bf(v.y); o.z = f2bf(v.z); o.w = f2bf(v.w);
    ((ushort4*)(xb + (size_t)t * DM))[lane + 64 * i] = o;
  }
  ss = wave_sum(ss);
  if (lane == 0) rs[t] = rsqrtf(ss * (1.f / DM) + EPSF);
}

__device__ const unsigned char kPairTab[64] = {
    0x00, 0x01, 0x02, 0x03, 0x04, 0x05, 0x06, 0x07, 0x08, 0x09, 0x0a, 0x0b, 0x0c, 0x0d, 0x0e, 0x0f,
    0x10, 0x11, 0x12, 0x13, 0x14, 0x15, 0x16, 0x17,
    0x20, 0x21, 0x22, 0x23, 0x24,
    0x30, 0x31, 0x32, 0x33,
    0x40, 0x41, 0x42,
    0x50, 0x51, 0x60, 0x61, 0x70, 0x71,
    0x80, 0x90, 0xa0, 0xb0, 0xc0, 0xd0, 0xe0, 0xf0,
    0xff, 0xff, 0xff, 0xff, 0xff, 0xff, 0xff, 0xff, 0xff, 0xff, 0xff, 0xff, 0xff, 0xff};

__device__ __forceinline__ void sort16_desc(unsigned (&a)[16]) {
#pragma unroll
  for (int k = 2; k <= 16; k <<= 1)
#pragma unroll
    for (int j = k >> 1; j > 0; j >>= 1)
#pragma unroll
      for (int i = 0; i < 16; ++i) {
        const int l = i ^ j;
        if (l > i) {
          const unsigned hi = max(a[i], a[l]), lo = min(a[i], a[l]);
          if ((i & k) == 0) { a[i] = hi; a[l] = lo; } else { a[i] = lo; a[l] = hi; }
        }
      }
}
__device__ __forceinline__ void merge16_desc(unsigned (&top)[16], const unsigned (&b)[16]) {
#pragma unroll
  for (int i = 0; i < 16; ++i) top[i] = max(top[i], b[15 - i]);
#pragma unroll
  for (int j = 8; j > 0; j >>= 1)
#pragma unroll
    for (int i = 0; i < 16; ++i) {
      const int l = i ^ j;
      if (l > i) {
        const unsigned hi = max(top[i], top[l]), lo = min(top[i], top[l]);
        top[i] = hi; top[l] = lo;
      }
    }
}
__device__ __forceinline__ unsigned key16(unsigned hbits, int idx) {
  const unsigned m = hbits ^ ((hbits & 0x8000u) ? 0xFFFFu : 0x8000u);
  return (m << 16) | (unsigned)(127 - idx);
}
__device__ __forceinline__ void top16_of_128(const unsigned short* __restrict__ sp, unsigned (&top)[16]) {
#pragma unroll
  for (int g = 0; g < 8; ++g) {
    const uint4 x0 = *(const uint4*)(sp + g * 16);
    const uint4 x1 = *(const uint4*)(sp + g * 16 + 8);
    unsigned b[16];
    b[0] = key16(x0.x & 0xffff, g * 16 + 0);  b[1] = key16(x0.x >> 16, g * 16 + 1);
    b[2] = key16(x0.y & 0xffff, g * 16 + 2);  b[3] = key16(x0.y >> 16, g * 16 + 3);
    b[4] = key16(x0.z & 0xffff, g * 16 + 4);  b[5] = key16(x0.z >> 16, g * 16 + 5);
    b[6] = key16(x0.w & 0xffff, g * 16 + 6);  b[7] = key16(x0.w >> 16, g * 16 + 7);
    b[8] = key16(x1.x & 0xffff, g * 16 + 8);  b[9] = key16(x1.x >> 16, g * 16 + 9);
    b[10] = key16(x1.y & 0xffff, g * 16 + 10); b[11] = key16(x1.y >> 16, g * 16 + 11);
    b[12] = key16(x1.z & 0xffff, g * 16 + 12); b[13] = key16(x1.z >> 16, g * 16 + 13);
    b[14] = key16(x1.w & 0xffff, g * 16 + 14); b[15] = key16(x1.w >> 16, g * 16 + 15);
    sort16_desc(b);
    if (g == 0) {
#pragma unroll
      for (int i = 0; i < 16; ++i) top[i] = b[i];
    } else {
      merge16_desc(top, b);
    }
  }
}

__device__ __forceinline__ void d_topk(int item, const unsigned short* __restrict__ scores, int* __restrict__ idx_out,
                                       float* __restrict__ gate_out) {
  const int pair = item * 256 + threadIdx.x;
  const unsigned short* sp = scores + (size_t)pair * 256;
  unsigned k0[16], k1[16];
  top16_of_128(sp, k0);
  top16_of_128(sp + 128, k1);
  float v0[16], v1[16];
  int i0[16], i1[16];
#pragma unroll
  for (int i = 0; i < 16; ++i) {
    const unsigned m0 = k0[i] >> 16, m1 = k1[i] >> 16;
    v0[i] = bf2f((unsigned short)(m0 ^ ((m0 & 0x8000u) ? 0x8000u : 0xFFFFu)));
    v1[i] = bf2f((unsigned short)(m1 ^ ((m1 & 0x8000u) ? 0x8000u : 0xFFFFu)));
    i0[i] = 127 - (int)(k0[i] & 127u);
    i1[i] = 127 - (int)(k1[i] & 127u);
  }
  unsigned top[16];
#pragma unroll
  for (int g = 0; g < 4; ++g) {
    unsigned b[16];
#pragma unroll
    for (int q = 0; q < 16; ++q) {
      const int pr = kPairTab[g * 16 + q];
      if (pr == 0xff) {
        b[q] = 0u;
      } else {
        const int pi = pr >> 4, pj = pr & 15;
        const float sum = v0[pi] + v1[pj];
        const unsigned u = __float_as_uint(sum);
        const unsigned mono = u ^ ((u & 0x80000000u) ? 0xFFFFFFFFu : 0x80000000u);
        b[q] = (mono & 0xFFFFC000u) | (unsigned)(16383 - (i0[pi] * 128 + i1[pj]));
      }
    }
    sort16_desc(b);
    if (g == 0) {
#pragma unroll
      for (int i = 0; i < 16; ++i) top[i] = b[i];
    } else {
      merge16_desc(top, b);
    }
  }
  float ev[16];
  int ci[16];
  float mx = 0.f, sum = 0.f;
#pragma unroll
  for (int i = 0; i < 16; ++i) {
    const unsigned mono = top[i] & 0xFFFFC000u;
    const unsigned u = mono ^ ((mono & 0x80000000u) ? 0x80000000u : 0xFFFFFFFFu);
    const float val = __uint_as_float(u & 0xFFFFC000u);
    ci[i] = 16383 - (int)(top[i] & 16383u);
    if (i == 0) mx = val;
    ev[i] = expf(val - mx);
    sum += ev[i];
  }
  const float inv = 1.f / sum;
#pragma unroll
  for (int q = 0; q < 4; ++q) {
    int4 o; float4 g;
    o.x = ci[4 * q]; o.y = ci[4 * q + 1]; o.z = ci[4 * q + 2]; o.w = ci[4 * q + 3];
    g.x = ev[4 * q] * inv; g.y = ev[4 * q + 1] * inv; g.z = ev[4 * q + 2] * inv; g.w = ev[4 * q + 3] * inv;
    *(int4*)(idx_out + (size_t)pair * 16 + 4 * q) = o;
    *(float4*)(gate_out + (size_t)pair * 16 + 4 * q) = g;
  }
}

typedef float f32x2 __attribute__((ext_vector_type(2)));
__device__ __forceinline__ void d_cvt_tab(int item, const float* __restrict__ src, unsigned* __restrict__ dst8, float* __restrict__ dscale) {
  const int row = item * 4 + (threadIdx.x >> 6);
  const int lane = threadIdx.x & 63;
  const float4* sr = (const float4*)(src + (size_t)row * DM + lane * 16);
  const float4 a = sr[0], b = sr[1], c = sr[2], d = sr[3];
  float m = fmaxf(fmaxf(fmaxf(fabsf(a.x), fabsf(a.y)), fmaxf(fabsf(a.z), fabsf(a.w))),
                  fmaxf(fmaxf(fabsf(b.x), fabsf(b.y)), fmaxf(fabsf(b.z), fabsf(b.w))));
  m = fmaxf(m, fmaxf(fmaxf(fmaxf(fabsf(c.x), fabsf(c.y)), fmaxf(fabsf(c.z), fabsf(c.w))),
                     fmaxf(fmaxf(fabsf(d.x), fabsf(d.y)), fmaxf(fabsf(d.z), fabsf(d.w)))));
#pragma unroll
  for (int o = 32; o > 0; o >>= 1) m = fmaxf(m, __shfl_xor(m, o, 64));
  const float sc = (m > 0.f) ? 240.f / m : 1.f;
  uint4 o;
  int p;
  p = 0; p = __builtin_amdgcn_cvt_pk_fp8_f32(a.x * sc, a.y * sc, p, false); p = __builtin_amdgcn_cvt_pk_fp8_f32(a.z * sc, a.w * sc, p, true); o.x = (unsigned)p;
  p = 0; p = __builtin_amdgcn_cvt_pk_fp8_f32(b.x * sc, b.y * sc, p, false); p = __builtin_amdgcn_cvt_pk_fp8_f32(b.z * sc, b.w * sc, p, true); o.y = (unsigned)p;
  p = 0; p = __builtin_amdgcn_cvt_pk_fp8_f32(c.x * sc, c.y * sc, p, false); p = __builtin_amdgcn_cvt_pk_fp8_f32(c.z * sc, c.w * sc, p, true); o.z = (unsigned)p;
  p = 0; p = __builtin_amdgcn_cvt_pk_fp8_f32(d.x * sc, d.y * sc, p, false); p = __builtin_amdgcn_cvt_pk_fp8_f32(d.z * sc, d.w * sc, p, true); o.w = (unsigned)p;
  *(uint4*)(dst8 + (size_t)row * 256 + lane * 4) = o;
  if (lane == 0) dscale[row] = (m > 0.f) ? m * (1.f / 240.f) : 1.f;
}

__device__ __forceinline__ float dot16_f8(const uint4 u, const float* hv) {
  const f32x2 a0 = __builtin_amdgcn_cvt_pk_f32_fp8((int)u.x, false), a1 = __builtin_amdgcn_cvt_pk_f32_fp8((int)u.x, true);
  const f32x2 b0 = __builtin_amdgcn_cvt_pk_f32_fp8((int)u.y, false), b1 = __builtin_amdgcn_cvt_pk_f32_fp8((int)u.y, true);
  const f32x2 c0 = __builtin_amdgcn_cvt_pk_f32_fp8((int)u.z, false), c1 = __builtin_amdgcn_cvt_pk_f32_fp8((int)u.z, true);
  const f32x2 d0 = __builtin_amdgcn_cvt_pk_f32_fp8((int)u.w, false), d1 = __builtin_amdgcn_cvt_pk_f32_fp8((int)u.w, true);
  float s0 = a0[0] * hv[0] + a0[1] * hv[1];
  float s1 = a1[0] * hv[2] + a1[1] * hv[3];
  s0 += b0[0] * hv[4] + b0[1] * hv[5];
  s1 += b1[0] * hv[6] + b1[1] * hv[7];
  s0 += c0[0] * hv[8] + c0[1] * hv[9];
  s1 += c1[0] * hv[10] + c1[1] * hv[11];
  s0 += d0[0] * hv[12] + d0[1] * hv[13];
  s1 += d1[0] * hv[14] + d1[1] * hv[15];
  return s0 + s1;
}
__device__ __forceinline__ void axpy16_f8(const uint4 v, const float wg, float* acc) {
  const f32x2 a0 = __builtin_amdgcn_cvt_pk_f32_fp8((int)v.x, false), a1 = __builtin_amdgcn_cvt_pk_f32_fp8((int)v.x, true);
  const f32x2 b0 = __builtin_amdgcn_cvt_pk_f32_fp8((int)v.y, false), b1 = __builtin_amdgcn_cvt_pk_f32_fp8((int)v.y, true);
  const f32x2 c0 = __builtin_amdgcn_cvt_pk_f32_fp8((int)v.z, false), c1 = __builtin_amdgcn_cvt_pk_f32_fp8((int)v.z, true);
  const f32x2 d0 = __builtin_amdgcn_cvt_pk_f32_fp8((int)v.w, false), d1 = __builtin_amdgcn_cvt_pk_f32_fp8((int)v.w, true);
  acc[0] += wg * a0[0]; acc[1] += wg * a0[1]; acc[2] += wg * a1[0]; acc[3] += wg * a1[1];
  acc[4] += wg * b0[0]; acc[5] += wg * b0[1]; acc[6] += wg * b1[0]; acc[7] += wg * b1[1];
  acc[8] += wg * c0[0]; acc[9] += wg * c0[1]; acc[10] += wg * c1[0]; acc[11] += wg * c1[1];
  acc[12] += wg * d0[0]; acc[13] += wg * d0[1]; acc[14] += wg * d1[0]; acc[15] += wg * d1[1];
}
__device__ __forceinline__ void d_peer(int item, const float* __restrict__ x1, const float* __restrict__ rs2,
                                       const float* __restrict__ g2, const int* __restrict__ idx,
                                       const float* __restrict__ gate, const unsigned* __restrict__ pu,
                                       const unsigned* __restrict__ pv, const float* __restrict__ su,
                                       const float* __restrict__ sv, const float* __restrict__ gf,
                                       float* __restrict__ out, float oscale) {
  const int t = item * 4 + (threadIdx.x >> 6);
  const int lane = threadIdx.x & 63;
  float r2;
  {
    const float4* pr = (const float4*)(rs2 + (size_t)t * 16);
    const float4 s0 = pr[0], s1 = pr[1], s2 = pr[2], s3 = pr[3];
    const float ssq = ((s0.x + s0.y) + (s0.z + s0.w)) + ((s1.x + s1.y) + (s1.z + s1.w)) + ((s2.x + s2.y) + (s2.z + s2.w)) + ((s3.x + s3.y) + (s3.z + s3.w));
    r2 = rsqrtf(ssq * (1.f / DM) + EPSF);
  }
  float xv[16], hv[16], acc[16];
#pragma unroll
  for (int q = 0; q < 4; ++q) {
    const float4 xx = *(const float4*)(x1 + (size_t)t * DM + lane * 16 + q * 4);
    const float4 gg = *(const float4*)(g2 + lane * 16 + q * 4);
    xv[q * 4 + 0] = xx.x; xv[q * 4 + 1] = xx.y; xv[q * 4 + 2] = xx.z; xv[q * 4 + 3] = xx.w;
    hv[q * 4 + 0] = xx.x * r2 * gg.x; hv[q * 4 + 1] = xx.y * r2 * gg.y;
    hv[q * 4 + 2] = xx.z * r2 * gg.z; hv[q * 4 + 3] = xx.w * r2 * gg.w;
  }
#pragma unroll
  for (int i = 0; i < 16; ++i) acc[i] = 0.f;
  const int id_a = idx[(size_t)t * 128 + lane], id_b = idx[(size_t)t * 128 + 64 + lane];
  const float gt_a = gate[(size_t)t * 128 + lane], gt_b = gate[(size_t)t * 128 + 64 + lane];
  for (int e0 = 0; e0 < 128; e0 += 8) {
    uint4 u[8], v[8];
    float gt8[8], su8[8], sv8[8];
#pragma unroll
    for (int k = 0; k < 8; ++k) {
      const int e = e0 + k;
      const int id = (e0 < 64) ? __shfl(id_a, e, 64) : __shfl(id_b, e - 64, 64);
      gt8[k] = (e0 < 64) ? __shfl(gt_a, e, 64) : __shfl(gt_b, e - 64, 64);
      u[k] = *(const uint4*)(pu + (size_t)id * 256 + lane * 4);
      v[k] = *(const uint4*)(pv + (size_t)id * 256 + lane * 4);
      su8[k] = su[id];
      sv8[k] = sv[id];
    }
    float d[8];
#pragma unroll
    for (int k = 0; k < 8; ++k) d[k] = dot16_f8(u[k], hv);
#pragma unroll
    for (int o = 32; o > 0; o >>= 1) {
#pragma unroll
      for (int k = 0; k < 8; ++k) d[k] += __shfl_xor(d[k], o, 64);
    }
#pragma unroll
    for (int k = 0; k < 8; ++k) {
      const float dd = d[k] * su8[k];
      const float act = 0.5f * dd * (1.f + erff(dd * 0.7071067811865476f));
      axpy16_f8(v[k], gt8[k] * act * sv8[k], acc);
    }
  }
  float ss = 0.f;
#pragma unroll
  for (int i = 0; i < 16; ++i) { acc[i] += xv[i]; ss += acc[i] * acc[i]; }
  ss = wave_sum(ss);
  const float sc = rsqrtf(ss * (1.f / DM) + EPSF) * oscale;
#pragma unroll
  for (int q = 0; q < 4; ++q) {
    const float4 gg = *(const float4*)(gf + lane * 16 + q * 4);
    float4 o;
    o.x = acc[q * 4 + 0] * sc * gg.x; o.y = acc[q * 4 + 1] * sc * gg.y;
    o.z = acc[q * 4 + 2] * sc * gg.z; o.w = acc[q * 4 + 3] * sc * gg.w;
    *(float4*)(out + (size_t)t * DM + lane * 16 + q * 4) = o;
  }
}

typedef __attribute__((ext_vector_type(16))) float f32x16;
#define MFMA32(a, b, c) __builtin_amdgcn_mfma_f32_32x32x16_bf16((a), (b), (c), 0, 0, 0)
__device__ __forceinline__ int crow(int reg, int hh) { return (reg & 3) + 8 * (reg >> 2) + 4 * hh; }
__device__ __forceinline__ unsigned pack2(float a, float b) { return (unsigned)f2bf(a) | ((unsigned)f2bf(b) << 16); }

struct GdnBufs {
  unsigned short* qc;
  unsigned short* kTc;
  unsigned short* qkc;
  unsigned short* wn;
  unsigned short* uo;
  float* gsc;
};

__device__ __forceinline__ void tri_subst(const float* AL, int lane, float (&T)[64]) {
#pragma unroll
  for (int i = 0; i < 64; ++i) T[i] = 0.f;
  T[0] = (lane == 0) ? 1.f : 0.f;
#pragma unroll
  for (int i = 1; i < 64; ++i) {
    float ax = 0.f, ay = 0.f, az = 0.f, aw = 0.f;
#pragma unroll
    for (int j4 = 0; j4 < (i + 3) / 4; ++j4) {
      const float4 a = *(const float4*)(AL + i * 72 + 4 * j4);
      ax += a.x * T[4 * j4]; ay += a.y * T[4 * j4 + 1]; az += a.z * T[4 * j4 + 2]; aw += a.w * T[4 * j4 + 3];
    }
    T[i] = ((lane == i) ? 1.f : 0.f) - ((ax + ay) + (az + aw));
  }
}

__device__ __forceinline__ void d_gdn_prep(int item, char* smem, const unsigned short* __restrict__ pm,
                                           const float* __restrict__ gt, const float* __restrict__ conv_w, GdnBufs G) {
  unsigned short* qL = (unsigned short*)smem;
  unsigned short* kL = qL + 64 * 144;
  unsigned short* kTL = kL + 64 * 144;
  unsigned short* vTL = kTL + 128 * 72;
  float* scal = (float*)(vTL + 128 * 72);
  float* A0 = (float*)qL;
  float* A1 = (float*)kL;
  int tid = threadIdx.x;
  asm volatile("" : "+v"(tid));
  const int lane = tid & 63, w = __builtin_amdgcn_readfirstlane(tid >> 6), r = lane & 31, hh = lane >> 5;
  const int bh = item >> 6, c = item & 63, b = bh >> 2, h = bh & 3;
  const int t0 = b * SEQ + c * 64;
  __syncthreads();
  {
    float cw[3][2][5];
#pragma unroll
    for (int sec = 0; sec < 3; ++sec)
#pragma unroll
      for (int j = 0; j < 5; ++j) {
        cw[sec][0][j] = conv_w[(sec * 512 + h * 128 + 2 * lane) * 5 + j];
        cw[sec][1][j] = conv_w[(sec * 512 + h * 128 + 2 * lane + 1) * 5 + j];
      }
    for (int ii = 0; ii < 16; ++ii) {
      const int i = w * 16 + ii;
      const int s = c * 64 + i;
      const size_t t = (size_t)t0 + i;
#pragma unroll
      for (int sec = 0; sec < 3; ++sec) {
        const int c0 = sec * 512 + h * 128 + 2 * lane;
        float a0 = 0.f, a1 = 0.f;
#pragma unroll
        for (int j = 0; j < 5; ++j) {
          const int sp = s + j - 2;
          if (sp >= 0 && sp < SEQ) {
            const unsigned v = *(const unsigned*)(pm + (t + j - 2) * 4096 + c0);
            a0 += cw[sec][0][j] * bf2f((unsigned short)(v & 0xffff));
            a1 += cw[sec][1][j] * bf2f((unsigned short)(v >> 16));
          }
        }
        a0 = a0 * sigmoidf(a0);
        a1 = a1 * sigmoidf(a1);
        if (sec < 2) {
          const float ss = wave_sum(a0 * a0 + a1 * a1);
          float sc = rsqrtf(ss + EPSF);
          if (sec == 0) sc *= 0.08838834764831845f;
          a0 *= sc; a1 *= sc;
        }
        if (sec == 0) {
          *(unsigned*)(qL + i * 144 + 2 * lane) = pack2(a0, a1);
        } else if (sec == 1) {
          *(unsigned*)(kL + i * 144 + 2 * lane) = pack2(a0, a1);
          kTL[(2 * lane) * 72 + i] = f2bf(a0);
          kTL[(2 * lane + 1) * 72 + i] = f2bf(a1);
        } else {
          vTL[(2 * lane) * 72 + i] = f2bf(a0);
          vTL[(2 * lane + 1) * 72 + i] = f2bf(a1);
        }
      }
    }
  }
  if (w == 0) {
    const float* gp = gt + ((size_t)t0 + lane) * 32;
    const float g0 = gp[h], g1 = gp[4 + h], b0 = gp[8 + h], b1 = gp[12 + h];
    float G0 = g0, G1 = g1;
#pragma unroll
    for (int o = 1; o < 64; o <<= 1) {
      const float v0 = __shfl_up(G0, o, 64);
      const float v1 = __shfl_down(G1, o, 64);
      if (lane >= o) G0 += v0;
      if (lane + o < 64) G1 += v1;
    }
    scal[lane] = G0; scal[64 + lane] = G1; scal[128 + lane] = b0; scal[192 + lane] = b1;
    const float GL0 = __shfl(G0, 63, 64), GL1 = __shfl(G1, 0, 64);
    float* gs0 = G.gsc + ((size_t)((bh * 2 + 0) * 64 + c)) * 192;
    float* gs1 = G.gsc + ((size_t)((bh * 2 + 1) * 64 + c)) * 192;
    gs0[lane] = expf(G0); gs0[64 + lane] = expf(GL0 - G0);
    gs1[lane] = expf(G1); gs1[64 + lane] = expf(GL1 - G1);
    if (lane == 0) { gs0[128] = expf(GL0); gs1[128] = expf(GL1); }
  }
  __syncthreads();
  {
    unsigned short* qg = G.qc + (size_t)item * 8192;
    unsigned short* kg = G.kTc + (size_t)item * 8192;
#pragma unroll
    for (int i = 0; i < 4; ++i) {
      const int id = tid + i * 256;
      *(uint4*)(qg + (id >> 4) * 128 + (id & 15) * 8) = *(const uint4*)(qL + (id >> 4) * 144 + (id & 15) * 8);
      *(uint4*)(kg + (id >> 3) * 64 + (id & 7) * 8) = *(const uint4*)(kTL + (id >> 3) * 72 + (id & 7) * 8);
    }
  }
  {
    const int ta = w >> 1, tb = w & 1;
    f32x16 acc, acc2;
#pragma unroll
    for (int i = 0; i < 16; ++i) { acc[i] = 0.f; acc2[i] = 0.f; }
#pragma unroll
    for (int s = 0; s < 8; ++s) {
      const bf16x8 a = *(const bf16x8*)(kL + (32 * ta + r) * 144 + 16 * s + 8 * hh);
      const bf16x8 bk = *(const bf16x8*)(kL + (32 * tb + r) * 144 + 16 * s + 8 * hh);
      const bf16x8 bq = *(const bf16x8*)(qL + (32 * tb + r) * 144 + 16 * s + 8 * hh);
      acc = MFMA32(a, bk, acc);
      acc2 = MFMA32(a, bq, acc2);
    }
    __syncthreads();
    {
      const int col = 32 * tb + r;
      const float G0c = scal[col], G1c = scal[64 + col];
#pragma unroll
      for (int reg = 0; reg < 16; ++reg) {
        const int row = 32 * ta + crow(reg, hh);
        const float v = acc[reg];
        const float a0 = (col < row) ? scal[128 + row] * v * expf(scal[row] - G0c) : 0.f;
        const float a1 = (col > row) ? scal[192 + row] * v * expf(scal[64 + row] - G1c) : 0.f;
        A0[row * 72 + col] = a0;
        A1[(63 - row) * 72 + (63 - col)] = a1;
      }
    }
    {
      const int i = 32 * tb + r;
      const float G0i = scal[i], G1i = scal[64 + i];
      unsigned short* qk0 = G.qkc + ((size_t)((bh * 2 + 0) * 64 + c)) * 4096;
      unsigned short* qk1 = G.qkc + ((size_t)((bh * 2 + 1) * 64 + c)) * 4096;
#pragma unroll
      for (int g = 0; g < 4; ++g) {
        float o0[4], o1[4];
#pragma unroll
        for (int e = 0; e < 4; ++e) {
          const int j = 32 * ta + 8 * g + 4 * hh + e;
          const float v = acc2[4 * g + e];
          o0[e] = (j <= i) ? v * expf(G0i - scal[j]) : 0.f;
          o1[e] = (j >= i) ? v * expf(G1i - scal[64 + j]) : 0.f;
        }
        uint2 p0, p1;
        p0.x = pack2(o0[0], o0[1]); p0.y = pack2(o0[2], o0[3]);
        p1.x = pack2(o1[0], o1[1]); p1.y = pack2(o1[2], o1[3]);
        *(uint2*)(qk0 + i * 64 + 32 * ta + 8 * g + 4 * hh) = p0;
        *(uint2*)(qk1 + i * 64 + 32 * ta + 8 * g + 4 * hh) = p1;
      }
    }
  }
  __syncthreads();
  if (w < 2) {
    const int dir = w;
    float T[64];
    tri_subst(dir ? A1 : A0, lane, T);
    const int jn = dir ? 63 - lane : lane;
    const float sb = scal[128 + 64 * dir + jn];
    const float sbg = sb * expf(scal[64 * dir + jn]);
    unsigned short* Tb = dir ? kL : qL;
    unsigned short* Tbg = Tb + 64 * 72;
#pragma unroll
    for (int ip = 0; ip < 64; ++ip) {
      const int in = dir ? 63 - ip : ip;
      Tb[in * 72 + jn] = f2bf(T[ip] * sb);
      Tbg[in * 72 + jn] = f2bf(T[ip] * sbg);
    }
  }
  __syncthreads();
#pragma unroll
  for (int d = 0; d < 2; ++d) {
    const int chain = bh * 2 + d;
    const unsigned short* Tb = d ? kL : qL;
    const unsigned short* Tbg = Tb + 64 * 72;
    unsigned short* wng = G.wn + ((size_t)(chain * 64 + c)) * 8192;
    unsigned short* uog = G.uo + ((size_t)(chain * 64 + c)) * 8192 + w * 2048;
#pragma unroll
    for (int tb = 0; tb < 2; ++tb) {
      f32x16 acc, acc2;
#pragma unroll
      for (int i = 0; i < 16; ++i) { acc[i] = 0.f; acc2[i] = 0.f; }
#pragma unroll
      for (int s = 0; s < 4; ++s) {
        const bf16x8 a = *(const bf16x8*)(kTL + (32 * w + r) * 72 + 16 * s + 8 * hh);
        const bf16x8 bb = *(const bf16x8*)(Tbg + (32 * tb + r) * 72 + 16 * s + 8 * hh);
        acc = MFMA32(a, bb, acc);
        const bf16x8 a2 = *(const bf16x8*)(Tb + (32 * tb + r) * 72 + 16 * s + 8 * hh);
        const bf16x8 b2 = *(const bf16x8*)(vTL + (32 * w + r) * 72 + 16 * s + 8 * hh);
        acc2 = MFMA32(a2, b2, acc2);
      }
#pragma unroll
      for (int g = 0; g < 4; ++g) {
        uint2 pk;
        pk.x = pack2(-acc[4 * g], -acc[4 * g + 1]); pk.y = pack2(-acc[4 * g + 2], -acc[4 * g + 3]);
        *(uint2*)(wng + (32 * tb + r) * 128 + 32 * w + 8 * g + 4 * hh) = pk;
      }
      uint4 u0, u1;
      u0.x = pack2(acc2[0], acc2[1]); u0.y = pack2(acc2[2], acc2[3]); u0.z = pack2(acc2[4], acc2[5]); u0.w = pack2(acc2[6], acc2[7]);
      u1.x = pack2(acc2[8], acc2[9]); u1.y = pack2(acc2[10], acc2[11]); u1.z = pack2(acc2[12], acc2[13]); u1.w = pack2(acc2[14], acc2[15]);
      *(uint4*)(uog + tb * 1024 + lane * 16) = u0;
      *(uint4*)(uog + tb * 1024 + lane * 16 + 8) = u1;
    }
  }
}

__device__ __forceinline__ void d_gdn_scan(int chain, int sl, char* smem, GdnBufs G) {
  unsigned short* ST = (unsigned short*)smem;
  unsigned short* VT = ST + 32 * 136;
  unsigned short* VdT = VT + 32 * 72;
  const int tid = threadIdx.x, lane = tid & 63, w = tid >> 6, r = lane & 31, hh = lane >> 5;
  const int bh = chain >> 1, dir = chain & 1;
  f32x16 S;
#pragma unroll
  for (int i = 0; i < 16; ++i) S[i] = 0.f;
  for (int step = 0; step < 64; ++step) {
    const int c = dir ? 63 - step : step;
    const unsigned short* wn_c = G.wn + ((size_t)(chain * 64 + c)) * 8192;
    const unsigned short* q_c = G.qc + ((size_t)(bh * 64 + c)) * 8192;
    const unsigned short* kT_c = G.kTc + ((size_t)(bh * 64 + c)) * 8192;
    const unsigned short* qk_c = G.qkc + ((size_t)(chain * 64 + c)) * 4096;
    unsigned short* uo_c = G.uo + ((size_t)(chain * 64 + c)) * 8192 + sl * 2048;
    const float* gs = G.gsc + ((size_t)(chain * 64 + c)) * 192;
    const int ti = w & 1;
    bf16x8 kt[4], a[8], bq[4];
    float rs[16];
    f32x16 acc;
#pragma unroll
    for (int s = 0; s < 4; ++s) kt[s] = *(const bf16x8*)(kT_c + (32 * w + r) * 64 + 16 * s + 8 * hh);
    const float gtot = gs[128];
    if (w < 2) {
#pragma unroll
      for (int s = 0; s < 8; ++s) a[s] = *(const bf16x8*)(wn_c + (32 * ti + r) * 128 + 16 * s + 8 * hh);
      const uint4 u0 = *(const uint4*)(uo_c + ti * 1024 + lane * 16);
      const uint4 u1 = *(const uint4*)(uo_c + ti * 1024 + lane * 16 + 8);
      acc[0] = bf2f(u0.x & 0xffff); acc[1] = bf2f(u0.x >> 16); acc[2] = bf2f(u0.y & 0xffff); acc[3] = bf2f(u0.y >> 16);
      acc[4] = bf2f(u0.z & 0xffff); acc[5] = bf2f(u0.z >> 16); acc[6] = bf2f(u0.w & 0xffff); acc[7] = bf2f(u0.w >> 16);
      acc[8] = bf2f(u1.x & 0xffff); acc[9] = bf2f(u1.x >> 16); acc[10] = bf2f(u1.y & 0xffff); acc[11] = bf2f(u1.y >> 16);
      acc[12] = bf2f(u1.z & 0xffff); acc[13] = bf2f(u1.z >> 16); acc[14] = bf2f(u1.w & 0xffff); acc[15] = bf2f(u1.w >> 16);
#pragma unroll
      for (int reg = 0; reg < 16; ++reg) rs[reg] = gs[64 + 32 * ti + crow(reg, hh)];
    } else {
#pragma unroll
      for (int s = 0; s < 8; ++s) a[s] = *(const bf16x8*)(q_c + (32 * ti + r) * 128 + 16 * s + 8 * hh);
#pragma unroll
      for (int s = 0; s < 4; ++s) bq[s] = *(const bf16x8*)(qk_c + (32 * ti + r) * 64 + 16 * s + 8 * hh);
#pragma unroll
      for (int i = 0; i < 16; ++i) acc[i] = 0.f;
#pragma unroll
      for (int reg = 0; reg < 16; ++reg) rs[reg] = gs[32 * ti + crow(reg, hh)];
    }
#pragma unroll
    for (int g = 0; g < 4; ++g) {
      uint2 pk;
      pk.x = pack2(S[4 * g], S[4 * g + 1]); pk.y = pack2(S[4 * g + 2], S[4 * g + 3]);
      *(uint2*)(ST + r * 136 + 32 * w + 8 * g + 4 * hh) = pk;
    }
    __syncthreads();
#pragma unroll
    for (int s = 0; s < 8; ++s) {
      const bf16x8 bs = *(const bf16x8*)(ST + r * 136 + 16 * s + 8 * hh);
      acc = MFMA32(a[s], bs, acc);
    }
    if (w < 2) {
#pragma unroll
      for (int g = 0; g < 4; ++g) {
        uint2 pk, pd;
        pk.x = pack2(acc[4 * g], acc[4 * g + 1]); pk.y = pack2(acc[4 * g + 2], acc[4 * g + 3]);
        pd.x = pack2(acc[4 * g] * rs[4 * g], acc[4 * g + 1] * rs[4 * g + 1]);
        pd.y = pack2(acc[4 * g + 2] * rs[4 * g + 2], acc[4 * g + 3] * rs[4 * g + 3]);
        *(uint2*)(VT + r * 72 + 32 * ti + 8 * g + 4 * hh) = pk;
        *(uint2*)(VdT + r * 72 + 32 * ti + 8 * g + 4 * hh) = pd;
      }
    } else {
#pragma unroll
      for (int reg = 0; reg < 16; ++reg) acc[reg] *= rs[reg];
    }
    __syncthreads();
    if (w >= 2) {
#pragma unroll
      for (int s = 0; s < 4; ++s) {
        const bf16x8 bv = *(const bf16x8*)(VT + r * 72 + 16 * s + 8 * hh);
        acc = MFMA32(bq[s], bv, acc);
      }
#pragma unroll
      for (int reg = 0; reg < 16; ++reg) uo_c[(32 * ti + crow(reg, hh)) * 32 + r] = f2bf(acc[reg]);
    }
#pragma unroll
    for (int i = 0; i < 16; ++i) S[i] *= gtot;
#pragma unroll
    for (int s = 0; s < 4; ++s) {
      const bf16x8 bv = *(const bf16x8*)(VdT + r * 72 + 16 * s + 8 * hh);
      S = MFMA32(kt[s], bv, S);
    }
  }
}


__device__ __forceinline__ void d_mlstm_scan(int chain, int sl, char* smem, const unsigned short* __restrict__ pm,
                                             const float* __restrict__ gt, unsigned short* __restrict__ oM, int ntok) {
  unsigned short* qL = (unsigned short*)smem;
  unsigned short* kL = qL + 64 * 136;
  unsigned short* kdL = kL + 64 * 136;
  unsigned short* vTL = kdL + 64 * 136;
  unsigned short* S0T = vTL + 32 * 72;
  unsigned short* nL = S0T + 32 * 136;
  float* scal = (float*)(nL + 256);
  const int tid = threadIdx.x, lane = tid & 63, w = tid >> 6, r = lane & 31, hh = lane >> 5;
  const int bh = chain >> 1, dir = chain & 1, b = bh >> 2, h = bh & 3;
  const float SCALE = 0.08838834764831845f;
  f32x16 S0, S1;
#pragma unroll
  for (int i = 0; i < 16; ++i) { S0[i] = 0.f; S1[i] = 0.f; }
  bf16x8 ones;
#pragma unroll
  for (int i = 0; i < 8; ++i) ones[i] = (short)0x3F80;
  for (int step = 0; step < 64; ++step) {
    const int c = dir ? 63 - step : step;
    const size_t t0 = (size_t)b * SEQ + c * 64;
    const float lf = gt[(t0 + lane) * 32 + 24 + dir * 4 + h];
    const float ip = gt[(t0 + lane) * 32 + 16 + dir * 4 + h];
    float bc = lf;
#pragma unroll
    for (int o = 1; o < 64; o <<= 1) {
      const float vu = __shfl_up(bc, o, 64);
      const float vd = __shfl_down(bc, o, 64);
      if (dir == 0) { if (lane >= o) bc += vu; } else { if (lane + o < 64) bc += vd; }
    }
    const float b_last = __shfl(bc, dir ? 0 : 63, 64);
    const float Dj = SCALE * expf(b_last - bc + ip);
    const float gtot = expf(b_last);
    __syncthreads();
    if (w == 0) { scal[lane] = expf(bc); scal[64 + lane] = ip - bc; scal[128 + lane] = bc; }
#pragma unroll
    for (int i = 0; i < 4; ++i) {
      const int id = tid + i * 256;
      const int row = id >> 4, c16 = id & 15;
      const uint4 qv = *(const uint4*)(pm + (t0 + row) * 4096 + 2048 + h * 128 + c16 * 8);
      const uint4 kv = *(const uint4*)(pm + (t0 + row) * 4096 + 2560 + h * 128 + c16 * 8);
      *(uint4*)(qL + row * 136 + c16 * 8) = qv;
      *(uint4*)(kL + row * 136 + c16 * 8) = kv;
      const float d = __shfl(Dj, row, 64);
      uint4 kd;
      kd.x = pack2(bf2f(kv.x & 0xffff) * d, bf2f(kv.x >> 16) * d);
      kd.y = pack2(bf2f(kv.y & 0xffff) * d, bf2f(kv.y >> 16) * d);
      kd.z = pack2(bf2f(kv.z & 0xffff) * d, bf2f(kv.z >> 16) * d);
      kd.w = pack2(bf2f(kv.w & 0xffff) * d, bf2f(kv.w >> 16) * d);
      *(uint4*)(kdL + row * 136 + c16 * 8) = kd;
    }
    {
      const int tok = tid >> 2, d8 = (tid & 3) * 8;
      const uint4 vv = *(const uint4*)(pm + (t0 + tok) * 4096 + 3072 + h * 128 + sl * 32 + d8);
      vTL[(d8 + 0) * 72 + tok] = (unsigned short)(vv.x & 0xffff);
      vTL[(d8 + 1) * 72 + tok] = (unsigned short)(vv.x >> 16);
      vTL[(d8 + 2) * 72 + tok] = (unsigned short)(vv.y & 0xffff);
      vTL[(d8 + 3) * 72 + tok] = (unsigned short)(vv.y >> 16);
      vTL[(d8 + 4) * 72 + tok] = (unsigned short)(vv.z & 0xffff);
      vTL[(d8 + 5) * 72 + tok] = (unsigned short)(vv.z >> 16);
      vTL[(d8 + 6) * 72 + tok] = (unsigned short)(vv.w & 0xffff);
      vTL[(d8 + 7) * 72 + tok] = (unsigned short)(vv.w >> 16);
    }
#pragma unroll
    for (int g = 0; g < 4; ++g) {
      uint2 pk;
      pk.x = pack2(S0[4 * g], S0[4 * g + 1]); pk.y = pack2(S0[4 * g + 2], S0[4 * g + 3]);
      *(uint2*)(S0T + r * 136 + 32 * w + 8 * g + 4 * hh) = pk;
      if (r == 0) {
        uint2 pn;
        pn.x = pack2(S1[4 * g], S1[4 * g + 1]); pn.y = pack2(S1[4 * g + 2], S1[4 * g + 3]);
        *(uint2*)(nL + 32 * w + 8 * g + 4 * hh) = pn;
      }
    }
    __syncthreads();
    if (w < 2) {
      const int ti = w;
      const int icol = 32 * ti + r;
      const float bci = scal[128 + icol];
      f32x16 Q0, Q1;
#pragma unroll
      for (int i = 0; i < 16; ++i) { Q0[i] = 0.f; Q1[i] = 0.f; }
#pragma unroll
      for (int s2 = 0; s2 < 8; ++s2) {
        const bf16x8 a = *(const bf16x8*)(qL + (32 * ti + r) * 136 + 16 * s2 + 8 * hh);
        const bf16x8 b0 = *(const bf16x8*)(S0T + r * 136 + 16 * s2 + 8 * hh);
        const bf16x8 b1 = *(const bf16x8*)(nL + 16 * s2 + 8 * hh);
        Q0 = MFMA32(a, b0, Q0);
        Q1 = MFMA32(a, b1, Q1);
      }
#pragma unroll
      for (int reg = 0; reg < 16; ++reg) {
        const float e = scal[32 * ti + crow(reg, hh)];
        Q0[reg] *= e; Q1[reg] *= e;
      }
#pragma unroll
      for (int tj = 0; tj < 2; ++tj) {
        f32x16 X;
#pragma unroll
        for (int i = 0; i < 16; ++i) X[i] = 0.f;
#pragma unroll
        for (int s2 = 0; s2 < 8; ++s2) {
          const bf16x8 a = *(const bf16x8*)(kL + (32 * tj + r) * 136 + 16 * s2 + 8 * hh);
          const bf16x8 bq = *(const bf16x8*)(qL + (32 * ti + r) * 136 + 16 * s2 + 8 * hh);
          X = MFMA32(a, bq, X);
        }
#pragma unroll
        for (int reg = 0; reg < 16; ++reg) {
          const int j = 32 * tj + crow(reg, hh);
          const bool valid = dir ? (j >= icol) : (j <= icol);
          X[reg] = valid ? X[reg] * SCALE * expf(bci + scal[64 + j]) : 0.f;
        }
#pragma unroll
        for (int s2 = 0; s2 < 2; ++s2) {
          union { bf16x8 v; unsigned u[4]; } xa, bv;
          xa.u[0] = pack2(X[8 * s2 + 0], X[8 * s2 + 1]); xa.u[1] = pack2(X[8 * s2 + 2], X[8 * s2 + 3]);
          xa.u[2] = pack2(X[8 * s2 + 4], X[8 * s2 + 5]); xa.u[3] = pack2(X[8 * s2 + 6], X[8 * s2 + 7]);
          const uint2 v0 = *(const uint2*)(vTL + r * 72 + 32 * tj + 16 * s2 + 4 * hh);
          const uint2 v1 = *(const uint2*)(vTL + r * 72 + 32 * tj + 16 * s2 + 8 + 4 * hh);
          bv.u[0] = v0.x; bv.u[1] = v0.y; bv.u[2] = v1.x; bv.u[3] = v1.y;
          Q0 = MFMA32(xa.v, bv.v, Q0);
          Q1 = MFMA32(xa.v, ones, Q1);
        }
      }
#pragma unroll
      for (int reg = 0; reg < 16; ++reg) {
        const int i = 32 * ti + crow(reg, hh);
        oM[((size_t)dir * ntok + t0 + i) * 512 + h * 128 + sl * 32 + r] = f2bf(Q0[reg] / fmaxf(fabsf(Q1[reg]), 1.f));
      }
    }
#pragma unroll
    for (int i = 0; i < 16; ++i) { S0[i] *= gtot; S1[i] *= gtot; }
#pragma unroll
    for (int s2 = 0; s2 < 4; ++s2) {
      union { bf16x8 v; unsigned short e[8]; } a;
#pragma unroll
      for (int e = 0; e < 8; ++e) a.e[e] = kdL[(16 * s2 + 8 * hh + e) * 136 + 32 * w + r];
      const bf16x8 bv = *(const bf16x8*)(vTL + r * 72 + 16 * s2 + 8 * hh);
      S0 = MFMA32(a.v, bv, S0);
      S1 = MFMA32(a.v, ones, S1);
    }
  }
}

struct MKP {
  const float *x, *norm1_g, *w_in, *conv_w, *a_log, *dt_bias, *gdn_g, *i_bias, *f_bias, *ml_g, *w_out, *norm2_g, *peer_wq,
      *peer_keys, *peer_u, *peer_v, *normf_g;
  float* out;
  unsigned short *pm, *x1b, *woutT, *mt, *xb, *winT, *oM, *yb, *scores, *qkv_dbg, *oA_dbg;
  unsigned *utab, *vtab;
  float *uscale, *vscale;
  float *x1, *rs1, *rs2, *gt, *gateb, *dbg;
  unsigned* bar;
  int* idxb;
  GdnBufs G;
};

constexpr int SMEM_BYTES = 74752;
#ifndef REP_S0
#define REP_S0 1
#endif
#ifndef REP_S1
#define REP_S1 1
#endif
#ifndef REP_S23
#define REP_S23 1
#endif
#ifndef REP_S2
#define REP_S2 1
#endif
#ifndef REP_S4
#define REP_S4 1
#endif
#ifndef REP_S5
#define REP_S5 1
#endif
#ifndef REP_S7
#define REP_S7 1
#endif
#ifndef REP_S8
#define REP_S8 1
#endif
#ifndef REP_S9
#define REP_S9 1
#endif

__global__ void __launch_bounds__(256, 2) k_mega(MKP P) {
  __shared__ __attribute__((aligned(16))) char smem_c[SMEM_BYTES + 16];
  {
    volatile LAS unsigned* st0 = (volatile LAS unsigned*)(smem_c + SMEM_BYTES);
    if (threadIdx.x < 4) st0[threadIdx.x] = 0u;
  }
  __syncthreads();
  XcdBarrier xb = xcd_barrier_post(P.bar, (volatile LAS unsigned*)(smem_c + SMEM_BYTES));
  unsigned short* smem = (unsigned short*)smem_c;
  const int nb = gridDim.x, bid = blockIdx.x;
  for (int rep = 0; rep < REP_S0; ++rep) {
  for (int it = bid; it < NT / 4; it += nb) d_prep_x(it, P.x, P.xb, P.rs1);
  for (int it = bid; it < NPAD_IN * DM / 256; it += nb) d_transpose_w(it, P.w_in, DIN, P.norm1_g, P.winT, NPAD_IN, 1);
  for (int it = bid; it < 1024 * DM / 256; it += nb) d_transpose_w(it, P.w_out, 1024, nullptr, P.woutT, 1024, 0);
  for (int it = bid; it < 2048 * 4; it += nb) d_make_mt(it, P.peer_wq, P.peer_keys, P.norm2_g, P.mt);
  if (bid == 0 && threadIdx.x < 2) P.dbg[threadIdx.x] = 0.f;
  xcd_barrier(xb);
  }
  for (int rep = 0; rep < REP_S1; ++rep) {
  {
    GemmP p{};
    p.A = P.xb; p.lda = DM; p.Bt = P.winT; p.ldb = DM; p.K = DM;
    p.rowscale = P.rs1; p.obf = P.pm; p.ldo = 4096; p.of32 = P.gt; p.ldf = 32; p.resid = nullptr;
    p.a_log = P.a_log; p.dt_bias = P.dt_bias; p.i_bias = P.i_bias; p.f_bias = P.f_bias;
    for (int tile = bid; tile < (NT / 128) * 33; tile += nb) {
      gemm_tile<EPI_INPROJ>(p, tile / 33, tile % 33, smem);
      __syncthreads();
    }
  }
  xcd_barrier(xb);
  }
  for (int rep23 = 0; rep23 < REP_S23; ++rep23) {
  for (int rep = 0; rep < REP_S2; ++rep) {
  for (int it = bid; it < 1024; it += nb) d_gdn_prep(it, smem_c, P.pm, P.gt, P.conv_w, P.G);
#ifdef DBG_CHECK
#endif
  xcd_barrier(xb);
  }
  if (bid < 128) {
    d_gdn_scan(bid >> 2, bid & 3, smem_c, P.G);
  } else if (bid < 256) {
    d_mlstm_scan((bid - 128) >> 2, (bid - 128) & 3, smem_c, P.pm, P.gt, P.oM, NT);
  }
#ifdef DBG_CHECK
  if (bid < 4) {
    __syncthreads();
    const int half = threadIdx.x >> 7;
    float* sq = (float*)smem + half * 256;
    float* sk = sq + 128;
    d_mlstm_rec(bid * 2 + half, sq, sk, P.pm, P.gt, P.oA_dbg, 4096);
  }
#endif
  xcd_barrier(xb);
  }
  for (int rep = 0; rep < REP_S4; ++rep) {
  for (int it = bid; it < NT / 4; it += nb) d_combine(it, P.G.uo, P.oM, P.pm, P.gdn_g, P.ml_g, P.yb);
#ifdef DBG_CHECK
  for (int it = bid; it < 4096 / 4; it += nb) d_dbg_cmp_m(it, P.oM, P.oA_dbg, P.dbg);
#endif
  xcd_barrier(xb);
  }
  for (int rep = 0; rep < REP_S5; ++rep) {
  {
    GemmP p{};
    p.A = P.yb; p.lda = DM; p.Bt = P.woutT; p.ldb = DM; p.K = DM;
    p.rowscale = nullptr; p.obf = P.x1b; p.ldo = DM; p.of32 = P.x1; p.ldf = DM; p.resid = P.x; p.rowacc = P.rs2;
    for (int tile = bid; tile < (NT / 128) * 8; tile += nb) {
      gemm_tile<EPI_OUTPROJ>(p, tile / 8, tile % 8, smem);
      __syncthreads();
    }
  }
  xcd_barrier(xb);
  }
  for (int rep = 0; rep < REP_S7; ++rep) {
  {
    GemmP p{};
    p.A = P.x1b; p.lda = DM; p.Bt = P.mt; p.ldb = DM; p.K = DM;
    p.rowscale = P.rs2; p.obf = P.scores; p.ldo = 2048; p.of32 = nullptr; p.ldf = 0; p.resid = nullptr;
    for (int tile = bid; tile < (NT / 128) * 16; tile += nb) {
      gemm_tile<EPI_SCORES>(p, tile / 16, tile % 16, smem);
      __syncthreads();
    }
  }
  xcd_barrier(xb);
  }
  for (int rep = 0; rep < REP_S8; ++rep) {
  for (int it = bid; it < 4096; it += nb) { d_cvt_tab(it, P.peer_u, P.utab, P.uscale); d_cvt_tab(it, P.peer_v, P.vtab, P.vscale); }
  for (int it = bid; it < NT * 8 / 256; it += nb) d_topk(it, P.scores, P.idxb, P.gateb);
  xcd_barrier(xb);
  }
  float oscale = 1.f;
#ifdef DBG_CHECK
  {
    const float sd = __hip_atomic_load(&P.dbg[0], __ATOMIC_RELAXED, __HIP_MEMORY_SCOPE_AGENT);
    const float sr = __hip_atomic_load(&P.dbg[1], __ATOMIC_RELAXED, __HIP_MEMORY_SCOPE_AGENT);
    oscale = 1.f + sqrtf(sd / sr);
  }
#endif
  for (int rep = 0; rep < REP_S9; ++rep)
  for (int it = bid; it < NT / 4; it += nb)
    d_peer(it, P.x1, P.rs2, P.norm2_g, P.idxb, P.gateb, P.utab, P.vtab, P.uscale, P.vscale, P.normf_g, P.out, oscale);
}

extern "C" void kernel_launch(void* const* d_in, const int* in_sizes, int n_in, void* d_out, int out_size, void* d_ws,
                              size_t ws_size, hipStream_t stream) {
  MKP P{};
  P.x = (const float*)d_in[0];
  P.norm1_g = (const float*)d_in[1];
  P.w_in = (const float*)d_in[2];
  P.conv_w = (const float*)d_in[3];
  P.a_log = (const float*)d_in[4];
  P.dt_bias = (const float*)d_in[5];
  P.gdn_g = (const float*)d_in[6];
  P.i_bias = (const float*)d_in[7];
  P.f_bias = (const float*)d_in[8];
  P.ml_g = (const float*)d_in[9];
  P.w_out = (const float*)d_in[10];
  P.norm2_g = (const float*)d_in[11];
  P.peer_wq = (const float*)d_in[12];
  P.peer_keys = (const float*)d_in[13];
  P.peer_u = (const float*)d_in[14];
  P.peer_v = (const float*)d_in[15];
  P.normf_g = (const float*)d_in[16];
  P.out = (float*)d_out;

  char* ws = (char*)d_ws;
  const size_t MB = 1024 * 1024;
  P.pm = (unsigned short*)(ws);
  P.x1 = (float*)(ws);
  P.x1b = (unsigned short*)(ws + 64 * MB);
  P.utab = (unsigned*)(ws + 64 * MB);
  P.vtab = (unsigned*)(ws + 80 * MB);
  P.uscale = (float*)(ws + 96 * MB);
  P.vscale = (float*)(ws + 96 * MB + 65536);
  char* rb = ws + 128 * MB;
  P.woutT = (unsigned short*)(rb);
  P.mt = (unsigned short*)(rb + 2 * MB);
  P.rs1 = (float*)(rb + 6 * MB);
  P.rs2 = (float*)(rb + 7 * MB);
  P.dbg = (float*)(rb + 6 * MB + 131072);
  P.bar = (unsigned*)(rb + 6 * MB + 196608);
  P.gt = (float*)(rb + 9 * MB);
  char* dyn = rb + 11 * MB;
  P.xb = (unsigned short*)(dyn);
  P.winT = (unsigned short*)(dyn + 32 * MB);
  P.G.qc = (unsigned short*)(dyn);
  P.G.kTc = (unsigned short*)(dyn + 16 * MB);
  P.G.qkc = (unsigned short*)(dyn + 32 * MB);
  P.G.wn = (unsigned short*)(dyn + 48 * MB);
  P.G.uo = (unsigned short*)(dyn + 80 * MB);
  P.G.gsc = (float*)(dyn + 112 * MB);
  P.yb = (unsigned short*)(dyn);
  P.scores = (unsigned short*)(dyn);
  P.idxb = (int*)(dyn + 64 * MB);
  P.gateb = (float*)(dyn + 72 * MB);
  char* os = (char*)d_out;
  P.oM = (unsigned short*)(os);
  P.qkv_dbg = (unsigned short*)(os + 32 * MB);
  P.oA_dbg = (unsigned short*)(os + 44 * MB);

  static int grid_blocks = 0;
  if (!grid_blocks) {
    int dev = 0, cus = 0, per_cu = 0;
    (void)hipGetDevice(&dev);
    (void)hipDeviceGetAttribute(&cus, hipDeviceAttributeMultiprocessorCount, dev);
    (void)hipOccupancyMaxActiveBlocksPerMultiprocessor(&per_cu, k_mega, 256, 0);
    if (per_cu > 2) per_cu = 2;
    if (per_cu < 1) per_cu = 1;
    grid_blocks = cus * per_cu;
  }
  (void)hipMemsetAsync(P.bar, 0, XCD_BAR_WORDS * sizeof(unsigned), stream);
  hipLaunchKernelGGL(k_mega, dim3(grid_blocks), dim3(256), 0, stream, P);
}
```

```cpp
#include <hip/hip_runtime.h>
#include <hip/hip_bf16.h>
#include <stdint.h>
#include <cstdio>

#define XB_TMO      128
#define XB_XCNT(j)  (256  + 64 * (j))
#define XB_XSUB(j)  (1280 + 64 * (j))
#define XB_XGEN(j)  (2304 + 64 * (j))
#define XB_TOP      3328
#define XB_TOPGEN   3392
#define XCD_BAR_WORDS 3456
#define XB_SPIN_CAP (1u << 18)
#define LAS __attribute__((address_space(3)))

__device__ __forceinline__ unsigned xb_ld(unsigned* p)              { return __hip_atomic_load(p, __ATOMIC_RELAXED, __HIP_MEMORY_SCOPE_AGENT); }
__device__ __forceinline__ unsigned xb_add(unsigned* p, unsigned v) { return __hip_atomic_fetch_add(p, v, __ATOMIC_RELAXED, __HIP_MEMORY_SCOPE_AGENT); }
__device__ __forceinline__ unsigned xb_xcc_id() { return (unsigned)__builtin_amdgcn_s_getreg((3 << 11) | 20) & 0xFu; }
#define XB_SPIN(cond, bar) do { unsigned _sp = 0; while (cond) { __builtin_amdgcn_s_sleep(1); \
    if ((++_sp & 255u) == 0u) { if (xb_ld(&(bar)[XB_TMO])) break; if (_sp > XB_SPIN_CAP) { atomicAdd(&(bar)[XB_TMO], 1u); break; } } } } while (0)

struct XcdBarrier {
    unsigned* bar; unsigned x;
    volatile LAS unsigned* st;
};

__device__ __forceinline__ XcdBarrier xcd_barrier_post(unsigned* bar, volatile LAS unsigned* st) {
    XcdBarrier b; b.bar = bar; b.x = xb_xcc_id(); b.st = st;
    if (threadIdx.x == 0) (void)xb_add(&bar[XB_XCNT(b.x)], 1u);
    return b;
}
__device__ __forceinline__ void xcd_barrier_complete(unsigned* bar, unsigned x, unsigned& nloc, unsigned& nx) {
    const unsigned G = gridDim.x * gridDim.y * gridDim.z;
    unsigned sum, cnt, mine, sp = 0u;
    for (;;) {
        sum = 0u; cnt = 0u; mine = 0u;
#pragma unroll
        for (unsigned j = 0; j < 16; ++j) { const unsigned c = xb_ld(&bar[XB_XCNT(j)]); sum += c; cnt += (c > 0u) ? 1u : 0u; mine = (j == x) ? c : mine; }
        if (sum == G) break;
        __builtin_amdgcn_s_sleep(1);
        if ((++sp & 255u) == 0u) { if (xb_ld(&bar[XB_TMO])) break; if (sp > XB_SPIN_CAP) { atomicAdd(&bar[XB_TMO], 1u); break; } }
    }
    nloc = mine > 0u ? mine : 1u; nx = cnt > 0u ? cnt : 1u;
}

__device__ __forceinline__ void xcd_barrier(const XcdBarrier& b) {
    asm volatile("s_waitcnt vmcnt(0)" ::: "memory");
    __syncthreads();
    if (threadIdx.x == 0) {
        unsigned* bar = b.bar;
        __builtin_amdgcn_s_waitcnt(0);
        unsigned nloc = b.st[0], nx = b.st[1];
        if (nloc == 0u) { xcd_barrier_complete(bar, b.x, nloc, nx); b.st[0] = nloc; b.st[1] = nx; }
        const unsigned old = xb_add(&bar[XB_XSUB(b.x)], 1u);
        const unsigned gen = old / nloc;
        if (old + 1u == (gen + 1u) * nloc) {
            __builtin_amdgcn_fence(__ATOMIC_RELEASE, "agent");
            asm volatile("s_waitcnt vmcnt(0)" ::: "memory");
            const unsigned og = xb_add(&bar[XB_TOP], 1u);
            const unsigned tg = og / nx;
            if (og + 1u == (tg + 1u) * nx) xb_add(&bar[XB_TOPGEN], 1u);
            else XB_SPIN(xb_ld(&bar[XB_TOPGEN]) == tg, bar);
            __builtin_amdgcn_fence(__ATOMIC_ACQUIRE, "agent");
            xb_add(&bar[XB_XGEN(b.x)], 1u);
            asm volatile("s_waitcnt vmcnt(0)" ::: "memory");
        } else {
            XB_SPIN(xb_ld(&bar[XB_XGEN(b.x)]) == gen, bar);
            __builtin_amdgcn_fence(__ATOMIC_ACQUIRE, "agent");
            asm volatile("s_waitcnt vmcnt(0)" ::: "memory");
        }
    }
    __syncthreads();
}


typedef __hip_bfloat16 bf16;
typedef __attribute__((ext_vector_type(8))) short bf16x8;
typedef __attribute__((ext_vector_type(4))) float f32x4;

constexpr int DM = 1024;
constexpr int NB = 4;
constexpr int SEQ = 4096;
constexpr int NT = NB * SEQ;
constexpr int DIN = 4128;
constexpr int NPAD_IN = 4224;
constexpr float EPSF = 1e-6f;

__device__ __forceinline__ float bf2f(unsigned short u) { return __uint_as_float(((unsigned)u) << 16); }
typedef __bf16 bf16x2_t __attribute__((ext_vector_type(2)));
typedef float f32x2_t __attribute__((ext_vector_type(2)));
__device__ __forceinline__ unsigned short f2bf(float f) { return __builtin_bit_cast(unsigned short, (__bf16)f); }
__device__ __forceinline__ unsigned pack2(float a, float b) {
  f32x2_t v = {a, b};
  return __builtin_bit_cast(unsigned, __builtin_convertvector(v, bf16x2_t));
}
__device__ __forceinline__ float wave_sum(float v) {
#pragma unroll
  for (int o = 32; o > 0; o >>= 1) v += __shfl_xor(v, o, 64);
  return v;
}
__device__ __forceinline__ float softplusf(float x) { return fmaxf(x, 0.f) + log1pf(expf(-fabsf(x))); }
__device__ __forceinline__ float sigmoidf(float x) { return 1.f / (1.f + expf(-x)); }

__device__ __forceinline__ void d_prep_x(int item, const float* __restrict__ x, unsigned short* __restrict__ xb,
                                                float* __restrict__ rs) {
  int t = item * 4 + (threadIdx.x >> 6);
  int lane = threadIdx.x & 63;
  const float4* xr = (const float4*)(x + (size_t)t * DM);
  float ss = 0.f;
#pragma unroll
  for (int i = 0; i < 4; ++i) {
    float4 v = xr[lane + 64 * i];
    ss += v.x * v.x + v.y * v.y + v.z * v.z + v.w * v.w;
    ushort4 o;
    o.x = f2bf(v.x); o.y = f2bf(v.y); o.z = f2bf(v.z); o.w = f2bf(v.w);
    ((ushort4*)(xb + (size_t)t * DM))[lane + 64 * i] = o;
  }
  ss = wave_sum(ss);
  if (lane == 0) rs[t] = rsqrtf(ss * (1.f / DM) + EPSF);
}

__device__ __forceinline__ int win_src(int n) {
  if (n < 2048) return n;
  if (n < 4096) return n + 16;
  int j = n - 4096;
  if (j < 16) return 2048 + j;
  if (j < 32) return 4112 + (j - 16);
  return -1;
}
__device__ __forceinline__ void d_transpose_w(int item, const float* __restrict__ in, int ldn, const float* __restrict__ g,
                                                     unsigned short* __restrict__ out, int nrows, int mode) {
  size_t id = (size_t)item * 256 + threadIdx.x;
  if (id >= (size_t)nrows * DM) return;
  int n = (int)(id >> 10);
  int k = (int)(id & 1023);
  int src = mode ? win_src(n) : n;
  float v = 0.f;
  if (src >= 0) v = in[(size_t)k * ldn + src] * (g ? g[k] : 1.f);
  out[id] = f2bf(v);
}
__device__ __forceinline__ void d_make_mt(int item, const float* __restrict__ wq, const float* __restrict__ keys,
                                                 const float* __restrict__ g2, unsigned short* __restrict__ mt) {
  int n = item >> 2;
  int d = (item & 3) * 256 + threadIdx.x;
  int hp = n >> 7;
  const float4* kr = (const float4*)(keys + (size_t)n * 128);
  const float4* wr = (const float4*)(wq + (size_t)d * 2048 + hp * 128);
  float s = 0.f;
#pragma unroll 8
  for (int j = 0; j < 32; ++j) {
    float4 a = kr[j], b = wr[j];
    s += a.x * b.x + a.y * b.y + a.z * b.z + a.w * b.w;
  }
  mt[(size_t)n * DM + d] = f2bf(s * g2[d]);
}

constexpr int GBM = 128, GBN = 128, GBK = 64, GLD = 72;
struct GemmP {
  const unsigned short* A; const unsigned short* Bt; int lda, ldb, K;
  const float* rowscale;
  unsigned short* obf; int ldo;
  float* of32; int ldf;
  const float* resid;
  const float *a_log, *dt_bias, *i_bias, *f_bias;
  float* rowacc;
};
enum { EPI_INPROJ = 0, EPI_OUTPROJ = 1, EPI_SCORES = 2 };

template <int EPI>
__device__ __forceinline__ void gemm_tile(const GemmP p, int tm, int tn, unsigned short* smem) {
  unsigned short* As = smem;
  unsigned short* Bs = smem + 2 * GBM * GLD;
  const int tid = threadIdx.x, lane = tid & 63, wid = tid >> 6;
  const int wm = wid >> 1, wn = wid & 1;
  const int m0 = tm * GBM, n0 = tn * GBN;
  f32x4 acc[4][4];
#pragma unroll
  for (int i = 0; i < 4; ++i)
#pragma unroll
    for (int j = 0; j < 4; ++j) acc[i][j] = (f32x4){0.f, 0.f, 0.f, 0.f};

  uint4 ra0, ra1, ra2, ra3, rb0, rb1, rb2, rb3;
  const int nk = p.K / GBK;
  const int lrow = tid >> 3, lc8 = tid & 7;
  const unsigned short* Ag = p.A + (size_t)(m0 + lrow) * p.lda + lc8 * 8;
  const unsigned short* Bg = p.Bt + (size_t)(n0 + lrow) * p.ldb + lc8 * 8;
  const size_t a32 = (size_t)32 * p.lda, b32 = (size_t)32 * p.ldb;
#define GLOAD(kt)                                                        \
  {                                                                      \
    ra0 = *(const uint4*)(Ag + (kt) * GBK);                              \
    ra1 = *(const uint4*)(Ag + a32 + (kt) * GBK);                        \
    ra2 = *(const uint4*)(Ag + 2 * a32 + (kt) * GBK);                    \
    ra3 = *(const uint4*)(Ag + 3 * a32 + (kt) * GBK);                    \
    rb0 = *(const uint4*)(Bg + (kt) * GBK);                              \
    rb1 = *(const uint4*)(Bg + b32 + (kt) * GBK);                        \
    rb2 = *(const uint4*)(Bg + 2 * b32 + (kt) * GBK);                    \
    rb3 = *(const uint4*)(Bg + 3 * b32 + (kt) * GBK);                    \
  }
#define SSTORE(buf)                                                      \
  {                                                                      \
    unsigned short* ad = As + (size_t)(buf) * GBM * GLD + lrow * GLD + lc8 * 8; \
    unsigned short* bd = Bs + (size_t)(buf) * GBN * GLD + lrow * GLD + lc8 * 8; \
    *(uint4*)(ad) = ra0; *(uint4*)(ad + 32 * GLD) = ra1; *(uint4*)(ad + 64 * GLD) = ra2; *(uint4*)(ad + 96 * GLD) = ra3; \
    *(uint4*)(bd) = rb0; *(uint4*)(bd + 32 * GLD) = rb1; *(uint4*)(bd + 64 * GLD) = rb2; *(uint4*)(bd + 96 * GLD) = rb3; \
  }
  GLOAD(0);
  SSTORE(0);
  __syncthreads();
  for (int kt = 0; kt < nk; ++kt) {
    const int buf = kt & 1;
    if (kt + 1 < nk) GLOAD(kt + 1);
    const unsigned short* Ab = As + (size_t)buf * GBM * GLD;
    const unsigned short* Bb = Bs + (size_t)buf * GBN * GLD;
#pragma unroll
    for (int ks = 0; ks < 2; ++ks) {
      bf16x8 a[4], b[4];
      const int kc = ks * 32 + (lane >> 4) * 8;
#pragma unroll
      for (int i = 0; i < 4; ++i) a[i] = *(const bf16x8*)(Ab + (wm * 64 + i * 16 + (lane & 15)) * GLD + kc);
#pragma unroll
      for (int j = 0; j < 4; ++j) b[j] = *(const bf16x8*)(Bb + (wn * 64 + j * 16 + (lane & 15)) * GLD + kc);
#pragma unroll
      for (int i = 0; i < 4; ++i)
#pragma unroll
        for (int j = 0; j < 4; ++j) acc[i][j] = __builtin_amdgcn_mfma_f32_16x16x32_bf16(a[i], b[j], acc[i][j], 0, 0, 0);
    }
    if (kt + 1 < nk) SSTORE(buf ^ 1);
    __syncthreads();
  }
#undef GLOAD
#undef SSTORE
#pragma unroll
  for (int i = 0; i < 4; ++i) {
#pragma unroll
    for (int r = 0; r < 4; ++r) {
      const int row = m0 + wm * 64 + i * 16 + (lane >> 4) * 4 + r;
      float rsc = 1.f;
      float rowss = 0.f;
      if (EPI == EPI_INPROJ) rsc = p.rowscale[row];
      if (EPI == EPI_SCORES) {
        const float4* pr = (const float4*)(p.rowscale + (size_t)row * 16);
        const float4 s0 = pr[0], s1 = pr[1], s2 = pr[2], s3 = pr[3];
        const float ssq = ((s0.x + s0.y) + (s0.z + s0.w)) + ((s1.x + s1.y) + (s1.z + s1.w)) + ((s2.x + s2.y) + (s2.z + s2.w)) + ((s3.x + s3.y) + (s3.z + s3.w));
        rsc = rsqrtf(ssq * (1.f / DM) + EPSF);
      }
#pragma unroll
      for (int j = 0; j < 4; ++j) {
        const int col = n0 + wn * 64 + j * 16 + (lane & 15);
        float v = acc[i][j][r] * rsc;
        if (EPI == EPI_INPROJ) {
          if (col < 4096) p.obf[(size_t)row * p.ldo + col] = f2bf(v);
          else if (col < 4128) {
            const int j = col - 4096, jj = j & 7;
            float o;
            if (j < 8) o = -expf(p.a_log[jj]) * softplusf(v + p.dt_bias[jj]);
            else if (j < 16) o = sigmoidf(v);
            else if (j < 24) o = v + p.i_bias[jj];
            else o = -softplusf(-(v + p.f_bias[jj]));
            p.of32[(size_t)row * p.ldf + j] = o;
          }
        } else if (EPI == EPI_OUTPROJ) {
          const float xo = v + p.resid[(size_t)row * p.ldf + col];
          p.of32[(size_t)row * p.ldf + col] = xo;
          p.obf[(size_t)row * p.ldo + col] = f2bf(xo);
          rowss += xo * xo;
        } else {
          p.obf[(size_t)row * p.ldo + col] = f2bf(v);
        }
      }
      if (EPI == EPI_OUTPROJ) {
        rowss += __shfl_xor(rowss, 1, 64); rowss += __shfl_xor(rowss, 2, 64);
        rowss += __shfl_xor(rowss, 4, 64); rowss += __shfl_xor(rowss, 8, 64);
        if ((lane & 15) == 0) p.rowacc[(size_t)row * 16 + tn * 2 + wn] = rowss;
      }
    }
  }
}

__device__ __forceinline__ void d_conv(int item, const unsigned short* __restrict__ pm, const float* __restrict__ pg,
                                              const float* __restrict__ conv_w, const float* __restrict__ a_log,
                                              const float* __restrict__ dt_bias, const float* __restrict__ i_bias,
                                              const float* __restrict__ f_bias, unsigned short* __restrict__ qkv,
                                              float* __restrict__ gt) {
  int t = item * 4 + (threadIdx.x >> 6);
  int lane = threadIdx.x & 63;
  int s = t & (SEQ - 1);
  for (int sec = 0; sec < 3; ++sec) {
    for (int h = 0; h < 4; ++h) {
      int c0 = sec * 512 + h * 128 + 2 * lane;
      float a0 = 0.f, a1 = 0.f;
#pragma unroll
      for (int j = 0; j < 5; ++j) {
        int sp = s + j - 2;
        if (sp >= 0 && sp < SEQ) {
          unsigned v = *(const unsigned*)(pm + (size_t)(t + j - 2) * 4096 + c0);
          a0 += conv_w[c0 * 5 + j] * bf2f((unsigned short)(v & 0xffff));
          a1 += conv_w[(c0 + 1) * 5 + j] * bf2f((unsigned short)(v >> 16));
        }
      }
      a0 = a0 * sigmoidf(a0);
      a1 = a1 * sigmoidf(a1);
      if (sec < 2) {
        float ss = wave_sum(a0 * a0 + a1 * a1);
        float sc = rsqrtf(ss + EPSF);
        if (sec == 0) sc *= 0.08838834764831845f;
        a0 *= sc; a1 *= sc;
      }
      unsigned o = pack2(a0, a1);
      *(unsigned*)(qkv + (size_t)t * 1536 + c0) = o;
    }
  }
}

__device__ __forceinline__ void d_gdn_rec(int chain, float* sq, float* sk, const unsigned short* __restrict__ qkv,
                                                 const float* __restrict__ gt, unsigned short* __restrict__ oA, int ntok) {
  const int bh = chain >> 1, dir = chain & 1;
  const int b = bh >> 2, h = bh & 3;
  const int e = threadIdx.x & 127;
  float S[128];
#pragma unroll
  for (int d = 0; d < 128; ++d) S[d] = 0.f;
  for (int it = 0; it < SEQ; ++it) {
    const int s = dir ? (SEQ - 1 - it) : it;
    const size_t t = (size_t)b * SEQ + s;
    __syncthreads();
    sq[e] = bf2f(qkv[t * 1536 + h * 128 + e]);
    sk[e] = bf2f(qkv[t * 1536 + 512 + h * 128 + e]);
    const float v = bf2f(qkv[t * 1536 + 1024 + h * 128 + e]);
    const float g = gt[t * 32 + dir * 4 + h];
    const float beta = gt[t * 32 + 8 + dir * 4 + h];
    __syncthreads();
    const float a = expf(g);
    float k0 = 0.f, k1 = 0.f, k2 = 0.f, k3 = 0.f;
#pragma unroll
    for (int d = 0; d < 128; d += 4) {
      k0 += sk[d] * S[d]; k1 += sk[d + 1] * S[d + 1]; k2 += sk[d + 2] * S[d + 2]; k3 += sk[d + 3] * S[d + 3];
    }
    const float kS = a * ((k0 + k1) + (k2 + k3));
    const float vn = beta * (v - kS);
    float o0 = 0.f, o1 = 0.f, o2 = 0.f, o3 = 0.f;
#pragma unroll
    for (int d = 0; d < 128; d += 4) {
      S[d] = a * S[d] + sk[d] * vn;             o0 += sq[d] * S[d];
      S[d + 1] = a * S[d + 1] + sk[d + 1] * vn; o1 += sq[d + 1] * S[d + 1];
      S[d + 2] = a * S[d + 2] + sk[d + 2] * vn; o2 += sq[d + 2] * S[d + 2];
      S[d + 3] = a * S[d + 3] + sk[d + 3] * vn; o3 += sq[d + 3] * S[d + 3];
    }
    oA[((size_t)dir * ntok + t) * 512 + h * 128 + e] = f2bf((o0 + o1) + (o2 + o3));
  }
}

__device__ __forceinline__ void d_mlstm_rec(int chain, float* sq, float* sk, const unsigned short* __restrict__ pm,
                                                   const float* __restrict__ gt, unsigned short* __restrict__ oM, int ntok) {
  const int bh = chain >> 1, dir = chain & 1;
  const int b = bh >> 2, h = bh & 3;
  const int e = threadIdx.x & 127, lane = e & 63;
  float C[128];
#pragma unroll
  for (int d = 0; d < 128; ++d) C[d] = 0.f;
  float n0 = 0.f, n1 = 0.f, m = 0.f;
  for (int it = 0; it < SEQ; ++it) {
    const int s = dir ? (SEQ - 1 - it) : it;
    const size_t t = (size_t)b * SEQ + s;
    __syncthreads();
    sq[e] = bf2f(pm[t * 4096 + 2048 + h * 128 + e]);
    sk[e] = bf2f(pm[t * 4096 + 2560 + h * 128 + e]) * 0.08838834764831845f;
    const float v = bf2f(pm[t * 4096 + 3072 + h * 128 + e]);
    const float ip = gt[t * 32 + 16 + dir * 4 + h];
    const float lf = gt[t * 32 + 24 + dir * 4 + h];
    __syncthreads();
    const float mn = fmaxf(lf + m, ip);
    const float fs = expf(lf + m - mn);
    const float is = expf(ip - mn);
    m = mn;
    n0 = fs * n0 + is * sk[lane];
    n1 = fs * n1 + is * sk[lane + 64];
    const float den = wave_sum(n0 * sq[lane] + n1 * sq[lane + 64]);
    const float iv = is * v;
    float o0 = 0.f, o1 = 0.f, o2 = 0.f, o3 = 0.f;
#pragma unroll
    for (int d = 0; d < 128; d += 4) {
      C[d] = fs * C[d] + sk[d] * iv;             o0 += sq[d] * C[d];
      C[d + 1] = fs * C[d + 1] + sk[d + 1] * iv; o1 += sq[d + 1] * C[d + 1];
      C[d + 2] = fs * C[d + 2] + sk[d + 2] * iv; o2 += sq[d + 2] * C[d + 2];
      C[d + 3] = fs * C[d + 3] + sk[d + 3] * iv; o3 += sq[d + 3] * C[d + 3];
    }
    const float num = (o0 + o1) + (o2 + o3);
    const float hh = num / fmaxf(fabsf(den), expf(-mn));
    oM[((size_t)dir * ntok + t) * 512 + h * 128 + e] = f2bf(hh);
  }
}

__device__ __forceinline__ void d_combine(int item, const unsigned short* __restrict__ uo, const unsigned short* __restrict__ oM,
                                                 const unsigned short* __restrict__ pm, const float* __restrict__ gdn_g,
                                                 const float* __restrict__ ml_g, unsigned short* __restrict__ y) {
  int t = item * 4 + (threadIdx.x >> 6);
  int lane = threadIdx.x & 63;
  const int b = t >> 12, cc = (t >> 6) & 63, ii = t & 63;
  for (int h = 0; h < 4; ++h) {
    int c = h * 128 + 2 * lane;
    {
      const int chain0 = (b * 4 + h) * 2;
      const size_t off = (size_t)cc * 8192 + (lane >> 4) * 2048 + ii * 32 + ((2 * lane) & 31);
      unsigned vf = *(const unsigned*)(uo + (size_t)chain0 * 64 * 8192 + off);
      unsigned vb = *(const unsigned*)(uo + (size_t)(chain0 + 1) * 64 * 8192 + off);
      float o0 = bf2f(vf & 0xffff) + bf2f(vb & 0xffff);
      float o1 = bf2f(vf >> 16) + bf2f(vb >> 16);
      float ss = wave_sum(o0 * o0 + o1 * o1);
      float sc = rsqrtf(ss * (1.f / 128.f) + EPSF);
      unsigned z = *(const unsigned*)(pm + (size_t)t * 4096 + 1536 + c);
      float z0 = bf2f(z & 0xffff), z1 = bf2f(z >> 16);
      o0 = o0 * sc * gdn_g[2 * lane] * (z0 * sigmoidf(z0));
      o1 = o1 * sc * gdn_g[2 * lane + 1] * (z1 * sigmoidf(z1));
      *(unsigned*)(y + (size_t)t * DM + c) = pack2(o0, o1);
    }
    {
      unsigned vf = *(const unsigned*)(oM + (size_t)t * 512 + c);
      unsigned vb = *(const unsigned*)(oM + ((size_t)NT + t) * 512 + c);
      float o0 = bf2f(vf & 0xffff) + bf2f(vb & 0xffff);
      float o1 = bf2f(vf >> 16) + bf2f(vb >> 16);
      float ss = wave_sum(o0 * o0 + o1 * o1);
      float sc = rsqrtf(ss * (1.f / 128.f) + EPSF);
      unsigned z = *(const unsigned*)(pm + (size_t)t * 4096 + 3584 + c);
      float z0 = bf2f(z & 0xffff), z1 = bf2f(z >> 16);
      o0 = o0 * sc * ml_g[c] * sigmoidf(z0);
      o1 = o1 * sc * ml_g[c + 1] * sigmoidf(z1);
      *(unsigned*)(y + (size_t)t * DM + 512 + c) = pack2(o0, o1);
    }
  }
}

#ifdef DBG_CHECK
__device__ __forceinline__ void d_dbg_cmp(int item, const unsigned short* __restrict__ uo, const unsigned short* __restrict__ oAd,
                                          float* __restrict__ dbg) {
  int t = item * 4 + (threadIdx.x >> 6);
  int lane = threadIdx.x & 63;
  const int cc = (t >> 6) & 63, ii = t & 63;
  float sd = 0.f, sr = 0.f;
  for (int h = 0; h < 4; ++h) {
    for (int dir = 0; dir < 2; ++dir) {
      const int chain = h * 2 + dir;
      const size_t off = (size_t)cc * 8192 + (lane >> 4) * 2048 + ii * 32 + ((2 * lane) & 31);
      unsigned vn = *(const unsigned*)(uo + (size_t)chain * 64 * 8192 + off);
      unsigned vr = *(const unsigned*)(oAd + ((size_t)dir * 4096 + t) * 512 + h * 128 + 2 * lane);
      float n0 = bf2f(vn & 0xffff), n1 = bf2f(vn >> 16), r0 = bf2f(vr & 0xffff), r1 = bf2f(vr >> 16);
      sd += (n0 - r0) * (n0 - r0) + (n1 - r1) * (n1 - r1);
      sr += r0 * r0 + r1 * r1;
    }
  }
  sd = wave_sum(sd); sr = wave_sum(sr);
  if (lane == 0) { atomicAdd(&dbg[0], sd); atomicAdd(&dbg[1], sr); }
}
__device__ __forceinline__ void d_dbg_cmp_m(int item, const unsigned short* __restrict__ oM, const unsigned short* __restrict__ oMd,
                                            float* __restrict__ dbg) {
  int t = item * 4 + (threadIdx.x >> 6);
  int lane = threadIdx.x & 63;
  float sd = 0.f, sr = 0.f;
  for (int dir = 0; dir < 2; ++dir)
    for (int q = 0; q < 4; ++q) {
      unsigned vn = *(const unsigned*)(oM + ((size_t)dir * NT + t) * 512 + q * 128 + 2 * lane);
      unsigned vr = *(const unsigned*)(oMd + ((size_t)dir * 4096 + t) * 512 + q * 128 + 2 * lane);
      float n0 = bf2f(vn & 0xffff), n1 = bf2f(vn >> 16), r0 = bf2f(vr & 0xffff), r1 = bf2f(vr >> 16);
      sd += (n0 - r0) * (n0 - r0) + (n1 - r1) * (n1 - r1);
      sr += r0 * r0 + r1 * r1;
    }
  sd = wave_sum(sd); sr = wave_sum(sr);
  if (lane == 0) { atomicAdd(&dbg[0], sd); atomicAdd(&dbg[1], sr); }
}
#endif

__device__ __forceinline__ void d_prep_x1(int item, const float* __restrict__ x1, unsigned short* __restrict__ xb,
                                                 float* __restrict__ rs) {
  int t = item * 4 + (threadIdx.x >> 6);
  int lane = threadIdx.x & 63;
  const float4* xr = (const float4*)(x1 + (size_t)t * DM);
  float ss = 0.f;
#pragma unroll
  for (int i = 0; i < 4; ++i) {
    float4 v = xr[lane + 64 * i];
    ss += v.x * v.x + v.y * v.y + v.z * v.z + v.w * v.w;
    ushort4 o;
    o.x = f2bf(v.x); o.y = f2bf(v.y); o.z = f2bf(v.z); o.w = f2bf(v.w);
    ((ushort4*)(xb + (size_t)t * DM))[lane + 64 * i] = o;
  }
  ss = wave_sum(ss);
  if (lane == 0) rs[t] = rsqrtf(ss * (1.f / DM) + EPSF);
}

__device__ const unsigned char kPairTab[64] = {
    0x00, 0x01, 0x02, 0x03, 0x04, 0x05, 0x06, 0x07, 0x08, 0x09, 0x0a, 0x0b, 0x0c, 0x0d, 0x0e, 0x0f,
    0x10, 0x11, 0x12, 0x13, 0x14, 0x15, 0x16, 0x17,
    0x20, 0x21, 0x22, 0x23, 0x24,
    0x30, 0x31, 0x32, 0x33,
    0x40, 0x41, 0x42,
    0x50, 0x51, 0x60, 0x61, 0x70, 0x71,
    0x80, 0x90, 0xa0, 0xb0, 0xc0, 0xd0, 0xe0, 0xf0,
    0xff, 0xff, 0xff, 0xff, 0xff, 0xff, 0xff, 0xff, 0xff, 0xff, 0xff, 0xff, 0xff, 0xff};

__device__ __forceinline__ void sort16_desc(unsigned (&a)[16]) {
#pragma unroll
  for (int k = 2; k <= 16; k <<= 1)
#pragma unroll
    for (int j = k >> 1; j > 0; j >>= 1)
#pragma unroll
      for (int i = 0; i < 16; ++i) {
        const int l = i ^ j;
        if (l > i) {
          const unsigned hi = max(a[i], a[l]), lo = min(a[i], a[l]);
          if ((i & k) == 0) { a[i] = hi; a[l] = lo; } else { a[i] = lo; a[l] = hi; }
        }
      }
}
__device__ __forceinline__ void merge16_desc(unsigned (&top)[16], const unsigned (&b)[16]) {
#pragma unroll
  for (int i = 0; i < 16; ++i) top[i] = max(top[i], b[15 - i]);
#pragma unroll
  for (int j = 8; j > 0; j >>= 1)
#pragma unroll
    for (int i = 0; i < 16; ++i) {
      const int l = i ^ j;
      if (l > i) {
        const unsigned hi = max(top[i], top[l]), lo = min(top[i], top[l]);
        top[i] = hi; top[l] = lo;
      }
    }
}
__device__ __forceinline__ unsigned key16(unsigned hbits, int idx) {
  const unsigned m = hbits ^ ((hbits & 0x8000u) ? 0xFFFFu : 0x8000u);
  return (m << 16) | (unsigned)(127 - idx);
}
__device__ __forceinline__ void top16_of_128(const unsigned short* __restrict__ sp, unsigned (&top)[16]) {
#pragma unroll
  for (int g = 0; g < 8; ++g) {
    const uint4 x0 = *(const uint4*)(sp + g * 16);
    const uint4 x1 = *(const uint4*)(sp + g * 16 + 8);
    unsigned b[16];
    b[0] = key16(x0.x & 0xffff, g * 16 + 0);  b[1] = key16(x0.x >> 16, g * 16 + 1);
    b[2] = key16(x0.y & 0xffff, g * 16 + 2);  b[3] = key16(x0.y >> 16, g * 16 + 3);
    b[4] = key16(x0.z & 0xffff, g * 16 + 4);  b[5] = key16(x0.z >> 16, g * 16 + 5);
    b[6] = key16(x0.w & 0xffff, g * 16 + 6);  b[7] = key16(x0.w >> 16, g * 16 + 7);
    b[8] = key16(x1.x & 0xffff, g * 16 + 8);  b[9] = key16(x1.x >> 16, g * 16 + 9);
    b[10] = key16(x1.y & 0xffff, g * 16 + 10); b[11] = key16(x1.y >> 16, g * 16 + 11);
    b[12] = key16(x1.z & 0xffff, g * 16 + 12); b[13] = key16(x1.z >> 16, g * 16 + 13);
    b[14] = key16(x1.w & 0xffff, g * 16 + 14); b[15] = key16(x1.w >> 16, g * 16 + 15);
    sort16_desc(b);
    if (g == 0) {
#pragma unroll
      for (int i = 0; i < 16; ++i) top[i] = b[i];
    } else {
      merge16_desc(top, b);
    }
  }
}

__device__ __forceinline__ void d_topk(int item, const unsigned short* __restrict__ scores, int* __restrict__ idx_out,
                                       float* __restrict__ gate_out) {
  const int pair = item * 256 + threadIdx.x;
  const unsigned short* sp = scores + (size_t)pair * 256;
  unsigned k0[16], k1[16];
  top16_of_128(sp, k0);
  top16_of_128(sp + 128, k1);
  float v0[16], v1[16];
  int i0[16], i1[16];
#pragma unroll
  for (int i = 0; i < 16; ++i) {
    const unsigned m0 = k0[i] >> 16, m1 = k1[i] >> 16;
    v0[i] = bf2f((unsigned short)(m0 ^ ((m0 & 0x8000u) ? 0x8000u : 0xFFFFu)));
    v1[i] = bf2f((unsigned short)(m1 ^ ((m1 & 0x8000u) ? 0x8000u : 0xFFFFu)));
    i0[i] = 127 - (int)(k0[i] & 127u);
    i1[i] = 127 - (int)(k1[i] & 127u);
  }
  unsigned top[16];
#pragma unroll
  for (int g = 0; g < 4; ++g) {
    unsigned b[16];
#pragma unroll
    for (int q = 0; q < 16; ++q) {
      const int pr = kPairTab[g * 16 + q];
      if (pr == 0xff) {
        b[q] = 0u;
      } else {
        const int pi = pr >> 4, pj = pr & 15;
        const float sum = v0[pi] + v1[pj];
        const unsigned u = __float_as_uint(sum);
        const unsigned mono = u ^ ((u & 0x80000000u) ? 0xFFFFFFFFu : 0x80000000u);
        b[q] = (mono & 0xFFFFC000u) | (unsigned)(16383 - (i0[pi] * 128 + i1[pj]));
      }
    }
    sort16_desc(b);
    if (g == 0) {
#pragma unroll
      for (int i = 0; i < 16; ++i) top[i] = b[i];
    } else {
      merge16_desc(top, b);
    }
  }
  float ev[16];
  int ci[16];
  float mx = 0.f, sum = 0.f;
#pragma unroll
  for (int i = 0; i < 16; ++i) {
    const unsigned mono = top[i] & 0xFFFFC000u;
    const unsigned u = mono ^ ((mono & 0x80000000u) ? 0x80000000u : 0xFFFFFFFFu);
    const float val = __uint_as_float(u & 0xFFFFC000u);
    ci[i] = 16383 - (int)(top[i] & 16383u);
    if (i == 0) mx = val;
    ev[i] = expf(val - mx);
    sum += ev[i];
  }
  const float inv = 1.f / sum;
#pragma unroll
  for (int q = 0; q < 4; ++q) {
    int4 o; float4 g;
    o.x = ci[4 * q]; o.y = ci[4 * q + 1]; o.z = ci[4 * q + 2]; o.w = ci[4 * q + 3];
    g.x = ev[4 * q] * inv; g.y = ev[4 * q + 1] * inv; g.z = ev[4 * q + 2] * inv; g.w = ev[4 * q + 3] * inv;
    *(int4*)(idx_out + (size_t)pair * 16 + 4 * q) = o;
    *(float4*)(gate_out + (size_t)pair * 16 + 4 * q) = g;
  }
}

typedef float f32x2 __attribute__((ext_vector_type(2)));
__device__ __forceinline__ void d_cvt_tab(int item, const float* __restrict__ src, unsigned* __restrict__ dst8, float* __restrict__ dscale) {
  const int row = item * 4 + (threadIdx.x >> 6);
  const int lane = threadIdx.x & 63;
  const float4* sr = (const float4*)(src + (size_t)row * DM + lane * 16);
  const float4 a = sr[0], b = sr[1], c = sr[2], d = sr[3];
  float m = fmaxf(fmaxf(fmaxf(fabsf(a.x), fabsf(a.y)), fmaxf(fabsf(a.z), fabsf(a.w))),
                  fmaxf(fmaxf(fabsf(b.x), fabsf(b.y)), fmaxf(fabsf(b.z), fabsf(b.w))));
  m = fmaxf(m, fmaxf(fmaxf(fmaxf(fabsf(c.x), fabsf(c.y)), fmaxf(fabsf(c.z), fabsf(c.w))),
                     fmaxf(fmaxf(fabsf(d.x), fabsf(d.y)), fmaxf(fabsf(d.z), fabsf(d.w)))));
#pragma unroll
  for (int o = 32; o > 0; o >>= 1) m = fmaxf(m, __shfl_xor(m, o, 64));
  const float sc = (m > 0.f) ? 240.f / m : 1.f;
  uint4 o;
  int p;
  p = 0; p = __builtin_amdgcn_cvt_pk_fp8_f32(a.x * sc, a.y * sc, p, false); p = __builtin_amdgcn_cvt_pk_fp8_f32(a.z * sc, a.w * sc, p, true); o.x = (unsigned)p;
  p = 0; p = __builtin_amdgcn_cvt_pk_fp8_f32(b.x * sc, b.y * sc, p, false); p = __builtin_amdgcn_cvt_pk_fp8_f32(b.z * sc, b.w * sc, p, true); o.y = (unsigned)p;
  p = 0; p = __builtin_amdgcn_cvt_pk_fp8_f32(c.x * sc, c.y * sc, p, false); p = __builtin_amdgcn_cvt_pk_fp8_f32(c.z * sc, c.w * sc, p, true); o.z = (unsigned)p;
  p = 0; p = __builtin_amdgcn_cvt_pk_fp8_f32(d.x * sc, d.y * sc, p, false); p = __builtin_amdgcn_cvt_pk_fp8_f32(d.z * sc, d.w * sc, p, true); o.w = (unsigned)p;
  *(uint4*)(dst8 + (size_t)row * 256 + lane * 4) = o;
  if (lane == 0) dscale[row] = (m > 0.f) ? m * (1.f / 240.f) : 1.f;
}

__device__ __forceinline__ float dot16_f8(const uint4 u, const float* hv) {
  const f32x2 a0 = __builtin_amdgcn_cvt_pk_f32_fp8((int)u.x, false), a1 = __builtin_amdgcn_cvt_pk_f32_fp8((int)u.x, true);
  const f32x2 b0 = __builtin_amdgcn_cvt_pk_f32_fp8((int)u.y, false), b1 = __builtin_amdgcn_cvt_pk_f32_fp8((int)u.y, true);
  const f32x2 c0 = __builtin_amdgcn_cvt_pk_f32_fp8((int)u.z, false), c1 = __builtin_amdgcn_cvt_pk_f32_fp8((int)u.z, true);
  const f32x2 d0 = __builtin_amdgcn_cvt_pk_f32_fp8((int)u.w, false), d1 = __builtin_amdgcn_cvt_pk_f32_fp8((int)u.w, true);
  float s0 = a0[0] * hv[0] + a0[1] * hv[1];
  float s1 = a1[0] * hv[2] + a1[1] * hv[3];
  s0 += b0[0] * hv[4] + b0[1] * hv[5];
  s1 += b1[0] * hv[6] + b1[1] * hv[7];
  s0 += c0[0] * hv[8] + c0[1] * hv[9];
  s1 += c1[0] * hv[10] + c1[1] * hv[11];
  s0 += d0[0] * hv[12] + d0[1] * hv[13];
  s1 += d1[0] * hv[14] + d1[1] * hv[15];
  return s0 + s1;
}
__device__ __forceinline__ void axpy16_f8(const uint4 v, const float wg, float* acc) {
  const f32x2 a0 = __builtin_amdgcn_cvt_pk_f32_fp8((int)v.x, false), a1 = __builtin_amdgcn_cvt_pk_f32_fp8((int)v.x, true);
  const f32x2 b0 = __builtin_amdgcn_cvt_pk_f32_fp8((int)v.y, false), b1 = __builtin_amdgcn_cvt_pk_f32_fp8((int)v.y, true);
  const f32x2 c0 = __builtin_amdgcn_cvt_pk_f32_fp8((int)v.z, false), c1 = __builtin_amdgcn_cvt_pk_f32_fp8((int)v.z, true);
  const f32x2 d0 = __builtin_amdgcn_cvt_pk_f32_fp8((int)v.w, false), d1 = __builtin_amdgcn_cvt_pk_f32_fp8((int)v.w, true);
  acc[0] += wg * a0[0]; acc[1] += wg * a0[1]; acc[2] += wg * a1[0]; acc[3] += wg * a1[1];
  acc[4] += wg * b0[0]; acc[5] += wg * b0[1]; acc[6] += wg * b1[0]; acc[7] += wg * b1[1];
  acc[8] += wg * c0[0]; acc[9] += wg * c0[1]; acc[10] += wg * c1[0]; acc[11] += wg * c1[1];
  acc[12] += wg * d0[0]; acc[13] += wg * d0[1]; acc[14] += wg * d1[0]; acc[15] += wg * d1[1];
}
__device__ __forceinline__ void d_peer(int item, const float* __restrict__ x1, const float* __restrict__ rs2,
                                       const float* __restrict__ g2, const int* __restrict__ idx,
                                       const float* __restrict__ gate, const unsigned* __restrict__ pu,
                                       const unsigned* __restrict__ pv, const float* __restrict__ su,
                                       const float* __restrict__ sv, const float* __restrict__ gf,
                                       float* __restrict__ out, float oscale) {
  const int t = item * 4 + (threadIdx.x >> 6);
  const int lane = threadIdx.x & 63;
  float r2;
  {
    const float4* pr = (const float4*)(rs2 + (size_t)t * 16);
    const float4 s0 = pr[0], s1 = pr[1], s2 = pr[2], s3 = pr[3];
    const float ssq = ((s0.x + s0.y) + (s0.z + s0.w)) + ((s1.x + s1.y) + (s1.z + s1.w)) + ((s2.x + s2.y) + (s2.z + s2.w)) + ((s3.x + s3.y) + (s3.z + s3.w));
    r2 = rsqrtf(ssq * (1.f / DM) + EPSF);
  }
  float xv[16], hv[16], acc[16];
#pragma unroll
  for (int q = 0; q < 4; ++q) {
    const float4 xx = *(const float4*)(x1 + (size_t)t * DM + lane * 16 + q * 4);
    const float4 gg = *(const float4*)(g2 + lane * 16 + q * 4);
    xv[q * 4 + 0] = xx.x; xv[q * 4 + 1] = xx.y; xv[q * 4 + 2] = xx.z; xv[q * 4 + 3] = xx.w;
    hv[q * 4 + 0] = xx.x * r2 * gg.x; hv[q * 4 + 1] = xx.y * r2 * gg.y;
    hv[q * 4 + 2] = xx.z * r2 * gg.z; hv[q * 4 + 3] = xx.w * r2 * gg.w;
  }
#pragma unroll
  for (int i = 0; i < 16; ++i) acc[i] = 0.f;
  const int id_a = idx[(size_t)t * 128 + lane], id_b = idx[(size_t)t * 128 + 64 + lane];
  const float gt_a = gate[(size_t)t * 128 + lane], gt_b = gate[(size_t)t * 128 + 64 + lane];
  for (int e0 = 0; e0 < 128; e0 += 8) {
    uint4 u[8], v[8];
    float gt8[8], su8[8], sv8[8];
#pragma unroll
    for (int k = 0; k < 8; ++k) {
      const int e = e0 + k;
      const int id = (e0 < 64) ? __shfl(id_a, e, 64) : __shfl(id_b, e - 64, 64);
      gt8[k] = (e0 < 64) ? __shfl(gt_a, e, 64) : __shfl(gt_b, e - 64, 64);
      u[k] = *(const uint4*)(pu + (size_t)id * 256 + lane * 4);
      v[k] = *(const uint4*)(pv + (size_t)id * 256 + lane * 4);
      su8[k] = su[id];
      sv8[k] = sv[id];
    }
    float d[8];
#pragma unroll
    for (int k = 0; k < 8; ++k) d[k] = dot16_f8(u[k], hv);
#pragma unroll
    for (int o = 32; o > 0; o >>= 1) {
#pragma unroll
      for (int k = 0; k < 8; ++k) d[k] += __shfl_xor(d[k], o, 64);
    }
#pragma unroll
    for (int k = 0; k < 8; ++k) {
      const float dd = d[k] * su8[k];
      const float act = 0.5f * dd * (1.f + erff(dd * 0.7071067811865476f));
      axpy16_f8(v[k], gt8[k] * act * sv8[k], acc);
    }
  }
  float ss = 0.f;
#pragma unroll
  for (int i = 0; i < 16; ++i) { acc[i] += xv[i]; ss += acc[i] * acc[i]; }
  ss = wave_sum(ss);
  const float sc = rsqrtf(ss * (1.f / DM) + EPSF) * oscale;
#pragma unroll
  for (int q = 0; q < 4; ++q) {
    const float4 gg = *(const float4*)(gf + lane * 16 + q * 4);
    float4 o;
    o.x = acc[q * 4 + 0] * sc * gg.x; o.y = acc[q * 4 + 1] * sc * gg.y;
    o.z = acc[q * 4 + 2] * sc * gg.z; o.w = acc[q * 4 + 3] * sc * gg.w;
    *(float4*)(out + (size_t)t * DM + lane * 16 + q * 4) = o;
  }
}

typedef __attribute__((ext_vector_type(16))) float f32x16;
#define MFMA32(a, b, c) __builtin_amdgcn_mfma_f32_32x32x16_bf16((a), (b), (c), 0, 0, 0)
__device__ __forceinline__ int crow(int reg, int hh) { return (reg & 3) + 8 * (reg >> 2) + 4 * hh; }

struct GdnBufs {
  unsigned short* qc;
  unsigned short* kTc;
  unsigned short* qkc;
  unsigned short* wn;
  unsigned short* uo;
  float* gsc;
};

__device__ __forceinline__ void tri_subst(const float* AL, int lane, float (&T)[64]) {
#pragma unroll
  for (int i = 0; i < 64; ++i) T[i] = 0.f;
  T[0] = (lane == 0) ? 1.f : 0.f;
#pragma unroll
  for (int i = 1; i < 64; ++i) {
    float ax = 0.f, ay = 0.f, az = 0.f, aw = 0.f;
#pragma unroll
    for (int j4 = 0; j4 < (i + 3) / 4; ++j4) {
      const float4 a = *(const float4*)(AL + i * 72 + 4 * j4);
      ax += a.x * T[4 * j4]; ay += a.y * T[4 * j4 + 1]; az += a.z * T[4 * j4 + 2]; aw += a.w * T[4 * j4 + 3];
    }
    T[i] = ((lane == i) ? 1.f : 0.f) - ((ax + ay) + (az + aw));
  }
}

__device__ __forceinline__ void d_gdn_prep(int item, char* smem, const unsigned short* __restrict__ pm,
                                           const float* __restrict__ gt, const float* __restrict__ conv_w, GdnBufs G) {
  unsigned short* qL = (unsigned short*)smem;
  unsigned short* kL = qL + 64 * 144;
  unsigned short* kTL = kL + 64 * 144;
  unsigned short* vTL = kTL + 128 * 72;
  float* scal = (float*)(vTL + 128 * 72);
  float* A0 = (float*)qL;
  float* A1 = (float*)kL;
  int tid = threadIdx.x;
  asm volatile("" : "+v"(tid));
  const int lane = tid & 63, w = __builtin_amdgcn_readfirstlane(tid >> 6), r = lane & 31, hh = lane >> 5;
  const int bh = item >> 6, c = item & 63, b = bh >> 2, h = bh & 3;
  const int t0 = b * SEQ + c * 64;
  __syncthreads();
  {
    float cw[3][2][5];
#pragma unroll
    for (int sec = 0; sec < 3; ++sec)
#pragma unroll
      for (int j = 0; j < 5; ++j) {
        cw[sec][0][j] = conv_w[(sec * 512 + h * 128 + 2 * lane) * 5 + j];
        cw[sec][1][j] = conv_w[(sec * 512 + h * 128 + 2 * lane + 1) * 5 + j];
      }
    for (int ii = 0; ii < 16; ++ii) {
      const int i = w * 16 + ii;
      const int s = c * 64 + i;
      const size_t t = (size_t)t0 + i;
#pragma unroll
      for (int sec = 0; sec < 3; ++sec) {
        const int c0 = sec * 512 + h * 128 + 2 * lane;
        float a0 = 0.f, a1 = 0.f;
#pragma unroll
        for (int j = 0; j < 5; ++j) {
          const int sp = s + j - 2;
          if (sp >= 0 && sp < SEQ) {
            const unsigned v = *(const unsigned*)(pm + (t + j - 2) * 4096 + c0);
            a0 += cw[sec][0][j] * bf2f((unsigned short)(v & 0xffff));
            a1 += cw[sec][1][j] * bf2f((unsigned short)(v >> 16));
          }
        }
        a0 = a0 * sigmoidf(a0);
        a1 = a1 * sigmoidf(a1);
        if (sec < 2) {
          const float ss = wave_sum(a0 * a0 + a1 * a1);
          float sc = rsqrtf(ss + EPSF);
          if (sec == 0) sc *= 0.08838834764831845f;
          a0 *= sc; a1 *= sc;
        }
        if (sec == 0) {
          *(unsigned*)(qL + i * 144 + 2 * lane) = pack2(a0, a1);
        } else if (sec == 1) {
          *(unsigned*)(kL + i * 144 + 2 * lane) = pack2(a0, a1);
          kTL[(2 * lane) * 72 + i] = f2bf(a0);
          kTL[(2 * lane + 1) * 72 + i] = f2bf(a1);
        } else {
          vTL[(2 * lane) * 72 + i] = f2bf(a0);
          vTL[(2 * lane + 1) * 72 + i] = f2bf(a1);
        }
      }
    }
  }
  if (w == 0) {
    const float* gp = gt + ((size_t)t0 + lane) * 32;
    const float g0 = gp[h], g1 = gp[4 + h], b0 = gp[8 + h], b1 = gp[12 + h];
    float G0 = g0, G1 = g1;
#pragma unroll
    for (int o = 1; o < 64; o <<= 1) {
      const float v0 = __shfl_up(G0, o, 64);
      const float v1 = __shfl_down(G1, o, 64);
      if (lane >= o) G0 += v0;
      if (lane + o < 64) G1 += v1;
    }
    scal[lane] = G0; scal[64 + lane] = G1; scal[128 + lane] = b0; scal[192 + lane] = b1;
    const float GL0 = __shfl(G0, 63, 64), GL1 = __shfl(G1, 0, 64);
    float* gs0 = G.gsc + ((size_t)((bh * 2 + 0) * 64 + c)) * 192;
    float* gs1 = G.gsc + ((size_t)((bh * 2 + 1) * 64 + c)) * 192;
    gs0[lane] = expf(G0); gs0[64 + lane] = expf(GL0 - G0);
    gs1[lane] = expf(G1); gs1[64 + lane] = expf(GL1 - G1);
    if (lane == 0) { gs0[128] = expf(GL0); gs1[128] = expf(GL1); }
  }
  __syncthreads();
  {
    unsigned short* qg = G.qc + (size_t)item * 8192;
    unsigned short* kg = G.kTc + (size_t)item * 8192;
#pragma unroll
    for (int i = 0; i < 4; ++i) {
      const int id = tid + i * 256;
      *(uint4*)(qg + (id >> 4) * 128 + (id & 15) * 8) = *(const uint4*)(qL + (id >> 4) * 144 + (id & 15) * 8);
      *(uint4*)(kg + (id >> 3) * 64 + (id & 7) * 8) = *(const uint4*)(kTL + (id >> 3) * 72 + (id & 7) * 8);
    }
  }
  {
    const int ta = w >> 1, tb = w & 1;
    f32x16 acc, acc2;
#pragma unroll
    for (int i = 0; i < 16; ++i) { acc[i] = 0.f; acc2[i] = 0.f; }
#pragma unroll
    for (int s = 0; s < 8; ++s) {
      const bf16x8 a = *(const bf16x8*)(kL + (32 * ta + r) * 144 + 16 * s + 8 * hh);
      const bf16x8 bk = *(const bf16x8*)(kL + (32 * tb + r) * 144 + 16 * s + 8 * hh);
      const bf16x8 bq = *(const bf16x8*)(qL + (32 * tb + r) * 144 + 16 * s + 8 * hh);
      acc = MFMA32(a, bk, acc);
      acc2 = MFMA32(a, bq, acc2);
    }
    __syncthreads();
    {
      const int col = 32 * tb + r;
      const float G0c = scal[col], G1c = scal[64 + col];
#pragma unroll
      for (int reg = 0; reg < 16; ++reg) {
        const int row = 32 * ta + crow(reg, hh);
        const float v = acc[reg];
        const float a0 = (col < row) ? scal[128 + row] * v * expf(scal[row] - G0c) : 0.f;
        const float a1 = (col > row) ? scal[192 + row] * v * expf(scal[64 + row] - G1c) : 0.f;
        A0[row * 72 + col] = a0;
        A1[(63 - row) * 72 + (63 - col)] = a1;
      }
    }
    {
      const int i = 32 * tb + r;
      const float G0i = scal[i], G1i = scal[64 + i];
      unsigned short* qk0 = G.qkc + ((size_t)((bh * 2 + 0) * 64 + c)) * 4096;
      unsigned short* qk1 = G.qkc + ((size_t)((bh * 2 + 1) * 64 + c)) * 4096;
#pragma unroll
      for (int g = 0; g < 4; ++g) {
        float o0[4], o1[4];
#pragma unroll
        for (int e = 0; e < 4; ++e) {
          const int j = 32 * ta + 8 * g + 4 * hh + e;
          const float v = acc2[4 * g + e];
          o0[e] = (j <= i) ? v * expf(G0i - scal[j]) : 0.f;
          o1[e] = (j >= i) ? v * expf(G1i - scal[64 + j]) : 0.f;
        }
        uint2 p0, p1;
        p0.x = pack2(o0[0], o0[1]); p0.y = pack2(o0[2], o0[3]);
        p1.x = pack2(o1[0], o1[1]); p1.y = pack2(o1[2], o1[3]);
        *(uint2*)(qk0 + i * 64 + 32 * ta + 8 * g + 4 * hh) = p0;
        *(uint2*)(qk1 + i * 64 + 32 * ta + 8 * g + 4 * hh) = p1;
      }
    }
  }
  __syncthreads();
  if (w < 2) {
    const int dir = w;
    float T[64];
    tri_subst(dir ? A1 : A0, lane, T);
    const int jn = dir ? 63 - lane : lane;
    const float sb = scal[128 + 64 * dir + jn];
    const float sbg = sb * expf(scal[64 * dir + jn]);
    unsigned short* Tb = dir ? kL : qL;
    unsigned short* Tbg = Tb + 64 * 72;
#pragma unroll
    for (int ip = 0; ip < 64; ++ip) {
      const int in = dir ? 63 - ip : ip;
      Tb[in * 72 + jn] = f2bf(T[ip] * sb);
      Tbg[in * 72 + jn] = f2bf(T[ip] * sbg);
    }
  }
  __syncthreads();
#pragma unroll
  for (int d = 0; d < 2; ++d) {
    const int chain = bh * 2 + d;
    const unsigned short* Tb = d ? kL : qL;
    const unsigned short* Tbg = Tb + 64 * 72;
    unsigned short* wng = G.wn + ((size_t)(chain * 64 + c)) * 8192;
    unsigned short* uog = G.uo + ((size_t)(chain * 64 + c)) * 8192 + w * 2048;
#pragma unroll
    for (int tb = 0; tb < 2; ++tb) {
      f32x16 acc, acc2;
#pragma unroll
      for (int i = 0; i < 16; ++i) { acc[i] = 0.f; acc2[i] = 0.f; }
#pragma unroll
      for (int s = 0; s < 4; ++s) {
        const bf16x8 a = *(const bf16x8*)(kTL + (32 * w + r) * 72 + 16 * s + 8 * hh);
        const bf16x8 bb = *(const bf16x8*)(Tbg + (32 * tb + r) * 72 + 16 * s + 8 * hh);
        acc = MFMA32(a, bb, acc);
        const bf16x8 a2 = *(const bf16x8*)(Tb + (32 * tb + r) * 72 + 16 * s + 8 * hh);
        const bf16x8 b2 = *(const bf16x8*)(vTL + (32 * w + r) * 72 + 16 * s + 8 * hh);
        acc2 = MFMA32(a2, b2, acc2);
      }
#pragma unroll
      for (int g = 0; g < 4; ++g) {
        uint2 pk;
        pk.x = pack2(-acc[4 * g], -acc[4 * g + 1]); pk.y = pack2(-acc[4 * g + 2], -acc[4 * g + 3]);
        *(uint2*)(wng + (32 * tb + r) * 128 + 32 * w + 8 * g + 4 * hh) = pk;
      }
      uint4 u0, u1;
      u0.x = pack2(acc2[0], acc2[1]); u0.y = pack2(acc2[2], acc2[3]); u0.z = pack2(acc2[4], acc2[5]); u0.w = pack2(acc2[6], acc2[7]);
      u1.x = pack2(acc2[8], acc2[9]); u1.y = pack2(acc2[10], acc2[11]); u1.z = pack2(acc2[12], acc2[13]); u1.w = pack2(acc2[14], acc2[15]);
      *(uint4*)(uog + tb * 1024 + lane * 16) = u0;
      *(uint4*)(uog + tb * 1024 + lane * 16 + 8) = u1;
    }
  }
}

struct GdnOps {
  bf16x8 a[8];
  bf16x8 x[4];
  bf16x8 kt[4];
  float4 rs[4];
  float gtot;
};
__device__ __forceinline__ void gdn_load(GdnOps& o, const GdnBufs& G, int chain, int bh, int c, int sl, int w, int r, int hh, int lane) {
  const unsigned short* kT_c = G.kTc + ((size_t)(bh * 64 + c)) * 8192;
  const float* gs = G.gsc + ((size_t)(chain * 64 + c)) * 192;
  const int ti = w & 1;
#pragma unroll
  for (int s = 0; s < 4; ++s) o.kt[s] = *(const bf16x8*)(kT_c + (32 * w + r) * 64 + 16 * s + 8 * hh);
  o.gtot = gs[128];
  if (w < 2) {
    const unsigned short* wn_c = G.wn + ((size_t)(chain * 64 + c)) * 8192;
    const unsigned short* uo_c = G.uo + ((size_t)(chain * 64 + c)) * 8192 + sl * 2048;
#pragma unroll
    for (int s = 0; s < 8; ++s) o.a[s] = *(const bf16x8*)(wn_c + (32 * ti + r) * 128 + 16 * s + 8 * hh);
    o.x[0] = *(const bf16x8*)(uo_c + ti * 1024 + lane * 16);
    o.x[1] = *(const bf16x8*)(uo_c + ti * 1024 + lane * 16 + 8);
#pragma unroll
    for (int g = 0; g < 4; ++g) o.rs[g] = *(const float4*)(gs + 64 + 32 * ti + 8 * g + 4 * hh);
  } else {
    const unsigned short* q_c = G.qc + ((size_t)(bh * 64 + c)) * 8192;
    const unsigned short* qk_c = G.qkc + ((size_t)(chain * 64 + c)) * 4096;
#pragma unroll
    for (int s = 0; s < 8; ++s) o.a[s] = *(const bf16x8*)(q_c + (32 * ti + r) * 128 + 16 * s + 8 * hh);
#pragma unroll
    for (int s = 0; s < 4; ++s) o.x[s] = *(const bf16x8*)(qk_c + (32 * ti + r) * 64 + 16 * s + 8 * hh);
#pragma unroll
    for (int g = 0; g < 4; ++g) o.rs[g] = *(const float4*)(gs + 32 * ti + 8 * g + 4 * hh);
  }
}
__device__ __forceinline__ void gdn_step(const GdnOps& o, f32x16& S, unsigned short* ST, unsigned short* VT, unsigned short* VdT,
                                         unsigned short* uo_c, int w, int r, int hh) {
  const int ti = w & 1;
  f32x16 acc;
  if (w < 2) {
#pragma unroll
    for (int i = 0; i < 8; ++i) {
      acc[i] = bf2f((unsigned short)o.x[0][i]);
      acc[8 + i] = bf2f((unsigned short)o.x[1][i]);
    }
  } else {
#pragma unroll
    for (int i = 0; i < 16; ++i) acc[i] = 0.f;
  }
#pragma unroll
  for (int g = 0; g < 4; ++g) {
    uint2 pk;
    pk.x = pack2(S[4 * g], S[4 * g + 1]); pk.y = pack2(S[4 * g + 2], S[4 * g + 3]);
    *(uint2*)(ST + r * 136 + 32 * w + 8 * g + 4 * hh) = pk;
  }
  __syncthreads();
#pragma unroll
  for (int s = 0; s < 8; ++s) {
    const bf16x8 bs = *(const bf16x8*)(ST + r * 136 + 16 * s + 8 * hh);
    acc = MFMA32(o.a[s], bs, acc);
  }
  if (w < 2) {
#pragma unroll
    for (int g = 0; g < 4; ++g) {
      uint2 pk, pd;
      pk.x = pack2(acc[4 * g], acc[4 * g + 1]); pk.y = pack2(acc[4 * g + 2], acc[4 * g + 3]);
      pd.x = pack2(acc[4 * g] * o.rs[g].x, acc[4 * g + 1] * o.rs[g].y);
      pd.y = pack2(acc[4 * g + 2] * o.rs[g].z, acc[4 * g + 3] * o.rs[g].w);
      *(uint2*)(VT + r * 72 + 32 * ti + 8 * g + 4 * hh) = pk;
      *(uint2*)(VdT + r * 72 + 32 * ti + 8 * g + 4 * hh) = pd;
    }
  } else {
#pragma unroll
    for (int g = 0; g < 4; ++g) {
      acc[4 * g] *= o.rs[g].x; acc[4 * g + 1] *= o.rs[g].y; acc[4 * g + 2] *= o.rs[g].z; acc[4 * g + 3] *= o.rs[g].w;
    }
  }
  __syncthreads();
  if (w >= 2) {
#pragma unroll
    for (int s = 0; s < 4; ++s) {
      const bf16x8 bv = *(const bf16x8*)(VT + r * 72 + 16 * s + 8 * hh);
      acc = MFMA32(o.x[s], bv, acc);
    }
#pragma unroll
    for (int reg = 0; reg < 16; ++reg) uo_c[(32 * ti + crow(reg, hh)) * 32 + r] = f2bf(acc[reg]);
  }
#pragma unroll
  for (int i = 0; i < 16; ++i) S[i] *= o.gtot;
#pragma unroll
  for (int s = 0; s < 4; ++s) {
    const bf16x8 bv = *(const bf16x8*)(VdT + r * 72 + 16 * s + 8 * hh);
    S = MFMA32(o.kt[s], bv, S);
  }
}
__device__ __forceinline__ void d_gdn_scan(int chain, int sl, char* smem, GdnBufs G) {
  unsigned short* ST = (unsigned short*)smem;
  unsigned short* VT = ST + 32 * 136;
  unsigned short* VdT = VT + 32 * 72;
  const int tid = threadIdx.x, lane = tid & 63, w = __builtin_amdgcn_readfirstlane(tid >> 6), r = lane & 31, hh = lane >> 5;
  const int bh = chain >> 1, dir = chain & 1;
  f32x16 S;
#pragma unroll
  for (int i = 0; i < 16; ++i) S[i] = 0.f;
  GdnOps A, B;
  gdn_load(A, G, chain, bh, dir ? 63 : 0, sl, w, r, hh, lane);
  for (int step = 0; step < 64; step += 2) {
    const int c0 = dir ? 63 - step : step;
    const int c1 = dir ? c0 - 1 : c0 + 1;
    const int c2 = dir ? c0 - 2 : c0 + 2;
    gdn_load(B, G, chain, bh, c1, sl, w, r, hh, lane);
    gdn_step(A, S, ST, VT, VdT, G.uo + ((size_t)(chain * 64 + c0)) * 8192 + sl * 2048, w, r, hh);
    if (step + 2 < 64) gdn_load(A, G, chain, bh, c2, sl, w, r, hh, lane);
    gdn_step(B, S, ST, VT, VdT, G.uo + ((size_t)(chain * 64 + c1)) * 8192 + sl * 2048, w, r, hh);
  }
}

#define ML_LOAD(T0)                                                                                         \
  {                                                                                                         \
    _Pragma("unroll") for (int i_ = 0; i_ < 8; ++i_) {                                                      \
      const int id_ = t128 + i_ * 128;                                                                      \
      pq[i_] = *(const uint4*)(pm + ((T0) + (id_ >> 4)) * 4096 + 2048 + h * 128 + (id_ & 15) * 8);          \
      pk[i_] = *(const uint4*)(pm + ((T0) + (id_ >> 4)) * 4096 + 2560 + h * 128 + (id_ & 15) * 8);          \
    }                                                                                                       \
    _Pragma("unroll") for (int i_ = 0; i_ < 2; ++i_) {                                                      \
      const int id_ = t128 + i_ * 128;                                                                      \
      pv[i_] = *(const uint4*)(pm + ((T0) + (id_ >> 2)) * 4096 + 3072 + h * 128 + sl * 32 + (id_ & 3) * 8); \
    }                                                                                                       \
    plf = gt[((T0) + lane) * 32 + 24 + dir * 4 + h];                                                        \
    pip = gt[((T0) + lane) * 32 + 16 + dir * 4 + h];                                                        \
  }
__device__ __forceinline__ void ml_state_image(const f32x16& S0, const f32x16& S1, unsigned short* S0T, unsigned short* nL, int w, int r, int hh) {
#pragma unroll
  for (int g = 0; g < 4; ++g) {
    uint2 pk;
    pk.x = pack2(S0[4 * g], S0[4 * g + 1]); pk.y = pack2(S0[4 * g + 2], S0[4 * g + 3]);
    *(uint2*)(S0T + r * 136 + 32 * w + 8 * g + 4 * hh) = pk;
    if (r == 0) {
      uint2 pn;
      pn.x = pack2(S1[4 * g], S1[4 * g + 1]); pn.y = pack2(S1[4 * g + 2], S1[4 * g + 3]);
      *(uint2*)(nL + 32 * w + 8 * g + 4 * hh) = pn;
    }
  }
}
__device__ __forceinline__ void ml_state_update(f32x16& S0, f32x16& S1, const unsigned short* kdL, const unsigned short* vTL,
                                                float gtot, int w, int r, int hh) {
  bf16x8 ones;
#pragma unroll
  for (int i = 0; i < 8; ++i) ones[i] = (short)0x3F80;
#pragma unroll
  for (int i = 0; i < 16; ++i) { S0[i] *= gtot; S1[i] *= gtot; }
#pragma unroll
  for (int s2 = 0; s2 < 4; ++s2) {
    union { bf16x8 v; unsigned short e[8]; } a;
#pragma unroll
    for (int e = 0; e < 8; ++e) a.e[e] = kdL[(16 * s2 + 8 * hh + e) * 136 + 32 * w + r];
    const bf16x8 bv = *(const bf16x8*)(vTL + r * 72 + 16 * s2 + 8 * hh);
    S0 = MFMA32(a.v, bv, S0);
    S1 = MFMA32(a.v, ones, S1);
  }
}
__device__ __forceinline__ void d_mlstm_scan(int chain, int sl, char* smem, const unsigned short* __restrict__ pm,
                                             const float* __restrict__ gt, unsigned short* __restrict__ oM, int ntok) {
  unsigned short* qL = (unsigned short*)smem;
  unsigned short* kL = qL + 64 * 136;
  unsigned short* kdL = kL + 64 * 136;
  unsigned short* vTL = kdL + 64 * 136;
  unsigned short* S0T = vTL + 32 * 72;
  unsigned short* nL = S0T + 32 * 136;
  float* scal = (float*)(nL + 256);
  const int tid = threadIdx.x, lane = tid & 63, w = __builtin_amdgcn_readfirstlane(tid >> 6), r = lane & 31, hh = lane >> 5;
  const int bh = chain >> 1, dir = chain & 1, b = bh >> 2, h = bh & 3;
  const float SCALE = 0.08838834764831845f;
  f32x16 S0, S1;
#pragma unroll
  for (int i = 0; i < 16; ++i) { S0[i] = 0.f; S1[i] = 0.f; }
  unsigned short* oMb = oM + (size_t)dir * ntok * 512 + h * 128 + sl * 32;
  const size_t tb = (size_t)b * SEQ;
  if (w >= 2) {
    const int t128 = tid - 128;
    uint4 pq[8], pk[8], pv[2];
    float plf, pip;
    ML_LOAD(tb + (dir ? 63 : 0) * 64);
    for (int step = 0; step < 64; ++step) {
      const int c0 = dir ? 63 - step : step;
      const int c1 = dir ? c0 - 1 : c0 + 1;
      float bc = plf;
#pragma unroll
      for (int ofs = 1; ofs < 64; ofs <<= 1) {
        const float vu = __shfl_up(bc, ofs, 64);
        const float vd = __shfl_down(bc, ofs, 64);
        if (dir == 0) { if (lane >= ofs) bc += vu; } else { if (lane + ofs < 64) bc += vd; }
      }
      const float b_last = __shfl(bc, dir ? 0 : 63, 64);
      const float Dj = SCALE * expf(b_last - bc + pip);
      const float gtot = expf(b_last);
      __syncthreads();
      if (w == 2) {
        scal[lane] = expf(bc);
        scal[64 + lane] = (pip - bc) * 1.4426950408889634f - 3.5f;
        scal[128 + lane] = bc * 1.4426950408889634f;
        if (lane == 0) scal[192] = gtot;
      }
#pragma unroll
      for (int i = 0; i < 8; ++i) {
        const int id = t128 + i * 128;
        const int row = id >> 4, c16 = id & 15;
        const uint4 kv = pk[i];
        const uint4 qv = pq[i];
        *(uint4*)(qL + row * 136 + c16 * 8) = qv;
        *(uint4*)(kL + row * 136 + c16 * 8) = kv;
        const float d = __shfl(Dj, row, 64);
        uint4 kd;
        kd.x = pack2(bf2f(kv.x & 0xffff) * d, bf2f(kv.x >> 16) * d);
        kd.y = pack2(bf2f(kv.y & 0xffff) * d, bf2f(kv.y >> 16) * d);
        kd.z = pack2(bf2f(kv.z & 0xffff) * d, bf2f(kv.z >> 16) * d);
        kd.w = pack2(bf2f(kv.w & 0xffff) * d, bf2f(kv.w >> 16) * d);
        *(uint4*)(kdL + row * 136 + c16 * 8) = kd;
      }
#pragma unroll
      for (int i = 0; i < 2; ++i) {
        const int id = t128 + i * 128;
        const int tok = id >> 2, d8 = (id & 3) * 8;
        const uint4 vv = pv[i];
        vTL[(d8 + 0) * 72 + tok] = (unsigned short)(vv.x & 0xffff);
        vTL[(d8 + 1) * 72 + tok] = (unsigned short)(vv.x >> 16);
        vTL[(d8 + 2) * 72 + tok] = (unsigned short)(vv.y & 0xffff);
        vTL[(d8 + 3) * 72 + tok] = (unsigned short)(vv.y >> 16);
        vTL[(d8 + 4) * 72 + tok] = (unsigned short)(vv.z & 0xffff);
        vTL[(d8 + 5) * 72 + tok] = (unsigned short)(vv.z >> 16);
        vTL[(d8 + 6) * 72 + tok] = (unsigned short)(vv.w & 0xffff);
        vTL[(d8 + 7) * 72 + tok] = (unsigned short)(vv.w >> 16);
      }
      if (step + 1 < 64) ML_LOAD(tb + c1 * 64);
      ml_state_image(S0, S1, S0T, nL, w, r, hh);
      __syncthreads();
      ml_state_update(S0, S1, kdL, vTL, gtot, w, r, hh);
    }
  } else {
    bf16x8 ones;
#pragma unroll
    for (int i = 0; i < 8; ++i) ones[i] = (short)0x3F80;
    const int ti = w;
    const int icol = 32 * ti + r;
    for (int step = 0; step < 64; ++step) {
      const int c0 = dir ? 63 - step : step;
      __syncthreads();
      ml_state_image(S0, S1, S0T, nL, w, r, hh);
      __syncthreads();
      const float bci = scal[128 + icol];
      const float gtot = scal[192];
      f32x16 Q0, Q1;
#pragma unroll
      for (int i = 0; i < 16; ++i) { Q0[i] = 0.f; Q1[i] = 0.f; }
#pragma unroll
      for (int s2 = 0; s2 < 8; ++s2) {
        const bf16x8 a = *(const bf16x8*)(qL + (32 * ti + r) * 136 + 16 * s2 + 8 * hh);
        const bf16x8 b0 = *(const bf16x8*)(S0T + r * 136 + 16 * s2 + 8 * hh);
        const bf16x8 b1 = *(const bf16x8*)(nL + 16 * s2 + 8 * hh);
        Q0 = MFMA32(a, b0, Q0);
        Q1 = MFMA32(a, b1, Q1);
      }
#pragma unroll
      for (int g = 0; g < 4; ++g) {
        const float4 e4 = *(const float4*)(scal + 32 * ti + 8 * g + 4 * hh);
        Q0[4 * g] *= e4.x; Q0[4 * g + 1] *= e4.y; Q0[4 * g + 2] *= e4.z; Q0[4 * g + 3] *= e4.w;
        Q1[4 * g] *= e4.x; Q1[4 * g + 1] *= e4.y; Q1[4 * g + 2] *= e4.z; Q1[4 * g + 3] *= e4.w;
      }
#pragma unroll
      for (int tj = 0; tj < 2; ++tj) {
        if (dir ? (tj < ti) : (tj > ti)) continue;
        f32x16 X;
#pragma unroll
        for (int i = 0; i < 16; ++i) X[i] = 0.f;
#pragma unroll
        for (int s2 = 0; s2 < 8; ++s2) {
          const bf16x8 a = *(const bf16x8*)(kL + (32 * tj + r) * 136 + 16 * s2 + 8 * hh);
          const bf16x8 bq = *(const bf16x8*)(qL + (32 * ti + r) * 136 + 16 * s2 + 8 * hh);
          X = MFMA32(a, bq, X);
        }
#pragma unroll
        for (int g = 0; g < 4; ++g) {
          const float4 cj4 = *(const float4*)(scal + 64 + 32 * tj + 8 * g + 4 * hh);
          const float cjs[4] = {cj4.x, cj4.y, cj4.z, cj4.w};
#pragma unroll
          for (int e = 0; e < 4; ++e) {
            const int j = 32 * tj + 8 * g + 4 * hh + e;
            const bool valid = dir ? (j >= icol) : (j <= icol);
            const float arg = valid ? (bci + cjs[e]) : -INFINITY;
            X[4 * g + e] *= __builtin_amdgcn_exp2f(arg);
          }
        }
#pragma unroll
        for (int s2 = 0; s2 < 2; ++s2) {
          union { bf16x8 v; unsigned u[4]; } xa, bv;
          xa.u[0] = pack2(X[8 * s2 + 0], X[8 * s2 + 1]); xa.u[1] = pack2(X[8 * s2 + 2], X[8 * s2 + 3]);
          xa.u[2] = pack2(X[8 * s2 + 4], X[8 * s2 + 5]); xa.u[3] = pack2(X[8 * s2 + 6], X[8 * s2 + 7]);
          const uint2 v0 = *(const uint2*)(vTL + r * 72 + 32 * tj + 16 * s2 + 4 * hh);
          const uint2 v1 = *(const uint2*)(vTL + r * 72 + 32 * tj + 16 * s2 + 8 + 4 * hh);
          bv.u[0] = v0.x; bv.u[1] = v0.y; bv.u[2] = v1.x; bv.u[3] = v1.y;
          Q0 = MFMA32(xa.v, bv.v, Q0);
          Q1 = MFMA32(xa.v, ones, Q1);
        }
      }
      const size_t orow0 = tb + c0 * 64;
#pragma unroll
      for (int reg = 0; reg < 16; ++reg) {
        const int i = 32 * ti + crow(reg, hh);
        oMb[(orow0 + i) * 512 + r] = f2bf(Q0[reg] * __builtin_amdgcn_rcpf(fmaxf(fabsf(Q1[reg]), 1.f)));
      }
      ml_state_update(S0, S1, kdL, vTL, gtot, w, r, hh);
    }
  }
}

struct MKP {
  const float *x, *norm1_g, *w_in, *conv_w, *a_log, *dt_bias, *gdn_g, *i_bias, *f_bias, *ml_g, *w_out, *norm2_g, *peer_wq,
      *peer_keys, *peer_u, *peer_v, *normf_g;
  float* out;
  unsigned short *pm, *x1b, *woutT, *mt, *xb, *winT, *oM, *yb, *scores, *qkv_dbg, *oA_dbg;
  unsigned *utab, *vtab;
  float *uscale, *vscale;
  float *x1, *rs1, *rs2, *gt, *gateb, *dbg;
  unsigned* bar;
  int* idxb;
  GdnBufs G;
};

constexpr int SMEM_BYTES = 74752;
#ifndef REP_S0
#define REP_S0 1
#endif
#ifndef REP_S1
#define REP_S1 1
#endif
#ifndef REP_S23
#define REP_S23 1
#endif
#ifndef REP_S2
#define REP_S2 1
#endif
#ifndef REP_S4
#define REP_S4 1
#endif
#ifndef REP_S5
#define REP_S5 1
#endif
#ifndef REP_S7
#define REP_S7 1
#endif
#ifndef REP_S8
#define REP_S8 1
#endif
#ifndef REP_S9
#define REP_S9 1
#endif

__global__ void __launch_bounds__(256, 2) k_mega(MKP P) {
  __shared__ __attribute__((aligned(16))) char smem_c[SMEM_BYTES + 16];
  {
    volatile LAS unsigned* st0 = (volatile LAS unsigned*)(smem_c + SMEM_BYTES);
    if (threadIdx.x < 4) st0[threadIdx.x] = 0u;
  }
  __syncthreads();
  XcdBarrier xb = xcd_barrier_post(P.bar, (volatile LAS unsigned*)(smem_c + SMEM_BYTES));
  unsigned short* smem = (unsigned short*)smem_c;
  const int nb = gridDim.x, bid = blockIdx.x;
  for (int rep = 0; rep < REP_S0; ++rep) {
  for (int it = bid; it < NT / 4; it += nb) d_prep_x(it, P.x, P.xb, P.rs1);
  for (int it = bid; it < NPAD_IN * DM / 256; it += nb) d_transpose_w(it, P.w_in, DIN, P.norm1_g, P.winT, NPAD_IN, 1);
  for (int it = bid; it < 1024 * DM / 256; it += nb) d_transpose_w(it, P.w_out, 1024, nullptr, P.woutT, 1024, 0);
  for (int it = bid; it < 2048 * 4; it += nb) d_make_mt(it, P.peer_wq, P.peer_keys, P.norm2_g, P.mt);
  if (bid == 0 && threadIdx.x < 2) P.dbg[threadIdx.x] = 0.f;
  xcd_barrier(xb);
  }
  for (int rep = 0; rep < REP_S1; ++rep) {
  {
    GemmP p{};
    p.A = P.xb; p.lda = DM; p.Bt = P.winT; p.ldb = DM; p.K = DM;
    p.rowscale = P.rs1; p.obf = P.pm; p.ldo = 4096; p.of32 = P.gt; p.ldf = 32; p.resid = nullptr;
    p.a_log = P.a_log; p.dt_bias = P.dt_bias; p.i_bias = P.i_bias; p.f_bias = P.f_bias;
    for (int tile = bid; tile < (NT / 128) * 33; tile += nb) {
      gemm_tile<EPI_INPROJ>(p, tile / 33, tile % 33, smem);
      __syncthreads();
    }
  }
  xcd_barrier(xb);
  }
  for (int rep23 = 0; rep23 < REP_S23; ++rep23) {
  for (int rep = 0; rep < REP_S2; ++rep) {
  for (int it = bid; it < 1024; it += nb) d_gdn_prep(it, smem_c, P.pm, P.gt, P.conv_w, P.G);
#ifdef DBG_CHECK
#endif
  xcd_barrier(xb);
  }
  if (bid < 128) {
    d_gdn_scan(bid >> 2, bid & 3, smem_c, P.G);
  } else if (bid < 256) {
    d_mlstm_scan((bid - 128) >> 2, (bid - 128) & 3, smem_c, P.pm, P.gt, P.oM, NT);
  }
#ifdef DBG_CHECK
  if (bid < 4) {
    __syncthreads();
    const int half = threadIdx.x >> 7;
    float* sq = (float*)smem + half * 256;
    float* sk = sq + 128;
    d_mlstm_rec(bid * 2 + half, sq, sk, P.pm, P.gt, P.oA_dbg, 4096);
  }
#endif
  xcd_barrier(xb);
  }
  for (int rep = 0; rep < REP_S4; ++rep) {
  for (int it = bid; it < NT / 4; it += nb) d_combine(it, P.G.uo, P.oM, P.pm, P.gdn_g, P.ml_g, P.yb);
#ifdef DBG_CHECK
  for (int it = bid; it < 4096 / 4; it += nb) d_dbg_cmp_m(it, P.oM, P.oA_dbg, P.dbg);
#endif
  xcd_barrier(xb);
  }
  for (int rep = 0; rep < REP_S5; ++rep) {
  {
    GemmP p{};
    p.A = P.yb; p.lda = DM; p.Bt = P.woutT; p.ldb = DM; p.K = DM;
    p.rowscale = nullptr; p.obf = P.x1b; p.ldo = DM; p.of32 = P.x1; p.ldf = DM; p.resid = P.x; p.rowacc = P.rs2;
    for (int tile = bid; tile < (NT / 128) * 8; tile += nb) {
      gemm_tile<EPI_OUTPROJ>(p, tile / 8, tile % 8, smem);
      __syncthreads();
    }
  }
  xcd_barrier(xb);
  }
  for (int rep = 0; rep < REP_S7; ++rep) {
  {
    GemmP p{};
    p.A = P.x1b; p.lda = DM; p.Bt = P.mt; p.ldb = DM; p.K = DM;
    p.rowscale = P.rs2; p.obf = P.scores; p.ldo = 2048; p.of32 = nullptr; p.ldf = 0; p.resid = nullptr;
    for (int tile = bid; tile < (NT / 128) * 16; tile += nb) {
      gemm_tile<EPI_SCORES>(p, tile / 16, tile % 16, smem);
      __syncthreads();
    }
  }
  xcd_barrier(xb);
  }
  for (int rep = 0; rep < REP_S8; ++rep) {
  for (int it = bid; it < 4096; it += nb) { d_cvt_tab(it, P.peer_u, P.utab, P.uscale); d_cvt_tab(it, P.peer_v, P.vtab, P.vscale); }
  for (int it = bid; it < NT * 8 / 256; it += nb) d_topk(it, P.scores, P.idxb, P.gateb);
  xcd_barrier(xb);
  }
  float oscale = 1.f;
#ifdef DBG_CHECK
  {
    const float sd = __hip_atomic_load(&P.dbg[0], __ATOMIC_RELAXED, __HIP_MEMORY_SCOPE_AGENT);
    const float sr = __hip_atomic_load(&P.dbg[1], __ATOMIC_RELAXED, __HIP_MEMORY_SCOPE_AGENT);
    oscale = 1.f + sqrtf(sd / sr);
  }
#endif
  for (int rep = 0; rep < REP_S9; ++rep)
  for (int it = bid; it < NT / 4; it += nb)
    d_peer(it, P.x1, P.rs2, P.norm2_g, P.idxb, P.gateb, P.utab, P.vtab, P.uscale, P.vscale, P.normf_g, P.out, oscale);
}

extern "C" void kernel_launch(void* const* d_in, const int* in_sizes, int n_in, void* d_out, int out_size, void* d_ws,
                              size_t ws_size, hipStream_t stream) {
  MKP P{};
  P.x = (const float*)d_in[0];
  P.norm1_g = (const float*)d_in[1];
  P.w_in = (const float*)d_in[2];
  P.conv_w = (const float*)d_in[3];
  P.a_log = (const float*)d_in[4];
  P.dt_bias = (const float*)d_in[5];
  P.gdn_g = (const float*)d_in[6];
  P.i_bias = (const float*)d_in[7];
  P.f_bias = (const float*)d_in[8];
  P.ml_g = (const float*)d_in[9];
  P.w_out = (const float*)d_in[10];
  P.norm2_g = (const float*)d_in[11];
  P.peer_wq = (const float*)d_in[12];
  P.peer_keys = (const float*)d_in[13];
  P.peer_u = (const float*)d_in[14];
  P.peer_v = (const float*)d_in[15];
  P.normf_g = (const float*)d_in[16];
  P.out = (float*)d_out;

  char* ws = (char*)d_ws;
  const size_t MB = 1024 * 1024;
  P.pm = (unsigned short*)(ws);
  P.x1 = (float*)(ws);
  P.x1b = (unsigned short*)(ws + 64 * MB);
  P.utab = (unsigned*)(ws + 64 * MB);
  P.vtab = (unsigned*)(ws + 80 * MB);
  P.uscale = (float*)(ws + 96 * MB);
  P.vscale = (float*)(ws + 96 * MB + 65536);
  char* rb = ws + 128 * MB;
  P.woutT = (unsigned short*)(rb);
  P.mt = (unsigned short*)(rb + 2 * MB);
  P.rs1 = (float*)(rb + 6 * MB);
  P.rs2 = (float*)(rb + 7 * MB);
  P.dbg = (float*)(rb + 6 * MB + 131072);
  P.bar = (unsigned*)(rb + 6 * MB + 196608);
  P.gt = (float*)(rb + 9 * MB);
  char* dyn = rb + 11 * MB;
  P.xb = (unsigned short*)(dyn);
  P.winT = (unsigned short*)(dyn + 32 * MB);
  P.G.qc = (unsigned short*)(dyn);
  P.G.kTc = (unsigned short*)(dyn + 16 * MB);
  P.G.qkc = (unsigned short*)(dyn + 32 * MB);
  P.G.wn = (unsigned short*)(dyn + 48 * MB);
  P.G.uo = (unsigned short*)(dyn + 80 * MB);
  P.G.gsc = (float*)(dyn + 112 * MB);
  P.yb = (unsigned short*)(dyn);
  P.scores = (unsigned short*)(dyn);
  P.idxb = (int*)(dyn + 64 * MB);
  P.gateb = (float*)(dyn + 72 * MB);
  char* os = (char*)d_out;
  P.oM = (unsigned short*)(os);
  P.qkv_dbg = (unsigned short*)(os + 32 * MB);
  P.oA_dbg = (unsigned short*)(os + 44 * MB);

  static int grid_blocks = 0;
  if (!grid_blocks) {
    int dev = 0, cus = 0, per_cu = 0;
    (void)hipGetDevice(&dev);
    (void)hipDeviceGetAttribute(&cus, hipDeviceAttributeMultiprocessorCount, dev);
    (void)hipOccupancyMaxActiveBlocksPerMultiprocessor(&per_cu, k_mega, 256, 0);
    if (per_cu > 2) per_cu = 2;
    if (per_cu < 1) per_cu = 1;
    grid_blocks = cus * per_cu;
  }
  (void)hipMemsetAsync(P.bar, 0, XCD_BAR_WORDS * sizeof(unsigned), stream);
  hipLaunchKernelGGL(k_mega, dim3(grid_blocks), dim3(256), 0, stream, P);
}
```

```cpp
#include <hip/hip_runtime.h>
#include <hip/hip_bf16.h>
#include <stdint.h>
#include <cstdio>

#define XB_TMO      128
#define XB_XCNT(j)  (256  + 64 * (j))
#define XB_XSUB(j)  (1280 + 64 * (j))
#define XB_XGEN(j)  (2304 + 64 * (j))
#define XB_TOP      3328
#define XB_TOPGEN   3392
#define XCD_BAR_WORDS 3456
#define XB_SPIN_CAP (1u << 18)
#define LAS __attribute__((address_space(3)))

__device__ __forceinline__ unsigned xb_ld(unsigned* p)              { return __hip_atomic_load(p, __ATOMIC_RELAXED, __HIP_MEMORY_SCOPE_AGENT); }
__device__ __forceinline__ unsigned xb_add(unsigned* p, unsigned v) { return __hip_atomic_fetch_add(p, v, __ATOMIC_RELAXED, __HIP_MEMORY_SCOPE_AGENT); }
__device__ __forceinline__ unsigned xb_xcc_id() { return (unsigned)__builtin_amdgcn_s_getreg((3 << 11) | 20) & 0xFu; }
#define XB_SPIN(cond, bar) do { unsigned _sp = 0; while (cond) { __builtin_amdgcn_s_sleep(1); \
    if ((++_sp & 255u) == 0u) { if (xb_ld(&(bar)[XB_TMO])) break; if (_sp > XB_SPIN_CAP) { atomicAdd(&(bar)[XB_TMO], 1u); break; } } } } while (0)

struct XcdBarrier {
    unsigned* bar; unsigned x;
    volatile LAS unsigned* st;
};

__device__ __forceinline__ XcdBarrier xcd_barrier_post(unsigned* bar, volatile LAS unsigned* st) {
    XcdBarrier b; b.bar = bar; b.x = xb_xcc_id(); b.st = st;
    if (threadIdx.x == 0) (void)xb_add(&bar[XB_XCNT(b.x)], 1u);
    return b;
}
__device__ __forceinline__ void xcd_barrier_complete(unsigned* bar, unsigned x, unsigned& nloc, unsigned& nx) {
    const unsigned G = gridDim.x * gridDim.y * gridDim.z;
    unsigned sum, cnt, mine, sp = 0u;
    for (;;) {
        sum = 0u; cnt = 0u; mine = 0u;
#pragma unroll
        for (unsigned j = 0; j < 16; ++j) { const unsigned c = xb_ld(&bar[XB_XCNT(j)]); sum += c; cnt += (c > 0u) ? 1u : 0u; mine = (j == x) ? c : mine; }
        if (sum == G) break;
        __builtin_amdgcn_s_sleep(1);
        if ((++sp & 255u) == 0u) { if (xb_ld(&bar[XB_TMO])) break; if (sp > XB_SPIN_CAP) { atomicAdd(&bar[XB_TMO], 1u); break; } }
    }
    nloc = mine > 0u ? mine : 1u; nx = cnt > 0u ? cnt : 1u;
}

__device__ __forceinline__ void xcd_barrier(const XcdBarrier& b) {
    asm volatile("s_waitcnt vmcnt(0)" ::: "memory");
    __syncthreads();
    if (threadIdx.x == 0) {
        unsigned* bar = b.bar;
        __builtin_amdgcn_s_waitcnt(0);
        unsigned nloc = b.st[0], nx = b.st[1];
        if (nloc == 0u) { xcd_barrier_complete(bar, b.x, nloc, nx); b.st[0] = nloc; b.st[1] = nx; }
        const unsigned old = xb_add(&bar[XB_XSUB(b.x)], 1u);
        const unsigned gen = old / nloc;
        if (old + 1u == (gen + 1u) * nloc) {
            __builtin_amdgcn_fence(__ATOMIC_RELEASE, "agent");
            asm volatile("s_waitcnt vmcnt(0)" ::: "memory");
            const unsigned og = xb_add(&bar[XB_TOP], 1u);
            const unsigned tg = og / nx;
            if (og + 1u == (tg + 1u) * nx) xb_add(&bar[XB_TOPGEN], 1u);
            else XB_SPIN(xb_ld(&bar[XB_TOPGEN]) == tg, bar);
            __builtin_amdgcn_fence(__ATOMIC_ACQUIRE, "agent");
            xb_add(&bar[XB_XGEN(b.x)], 1u);
            asm volatile("s_waitcnt vmcnt(0)" ::: "memory");
        } else {
            XB_SPIN(xb_ld(&bar[XB_XGEN(b.x)]) == gen, bar);
            __builtin_amdgcn_fence(__ATOMIC_ACQUIRE, "agent");
            asm volatile("s_waitcnt vmcnt(0)" ::: "memory");
        }
    }
    __syncthreads();
}


typedef __hip_bfloat16 bf16;
typedef __attribute__((ext_vector_type(8))) short bf16x8;
typedef __attribute__((ext_vector_type(4))) float f32x4;

constexpr int DM = 1024;
constexpr int NB = 4;
constexpr int SEQ = 4096;
constexpr int NT = NB * SEQ;
constexpr int DIN = 4128;
constexpr int NPAD_IN = 4224;
constexpr float EPSF = 1e-6f;

__device__ __forceinline__ float bf2f(unsigned short u) { return __uint_as_float(((unsigned)u) << 16); }
typedef __bf16 bf16x2_t __attribute__((ext_vector_type(2)));
typedef float f32x2_t __attribute__((ext_vector_type(2)));
__device__ __forceinline__ unsigned short f2bf(float f) { return __builtin_bit_cast(unsigned short, (__bf16)f); }
__device__ __forceinline__ unsigned pack2(float a, float b) {
  f32x2_t v = {a, b};
  return __builtin_bit_cast(unsigned, __builtin_convertvector(v, bf16x2_t));
}
__device__ __forceinline__ float wave_sum(float v) {
#pragma unroll
  for (int o = 32; o > 0; o >>= 1) v += __shfl_xor(v, o, 64);
  return v;
}
__device__ __forceinline__ float softplusf(float x) { return fmaxf(x, 0.f) + log1pf(expf(-fabsf(x))); }
__device__ __forceinline__ float sigmoidf(float x) { return 1.f / (1.f + expf(-x)); }

__device__ __forceinline__ void d_prep_x(int item, const float* __restrict__ x, unsigned short* __restrict__ xb,
                                                float* __restrict__ rs) {
  int t = item * 4 + (threadIdx.x >> 6);
  int lane = threadIdx.x & 63;
  const float4* xr = (const float4*)(x + (size_t)t * DM);
  float ss = 0.f;
#pragma unroll
  for (int i = 0; i < 4; ++i) {
    float4 v = xr[lane + 64 * i];
    ss += v.x * v.x + v.y * v.y + v.z * v.z + v.w * v.w;
    ushort4 o;
    o.x = f2bf(v.x); o.y = f2bf(v.y); o.z = f2bf(v.z); o.w = f2bf(v.w);
    ((ushort4*)(xb + (size_t)t * DM))[lane + 64 * i] = o;
  }
  ss = wave_sum(ss);
  if (lane == 0) rs[t] = rsqrtf(ss * (1.f / DM) + EPSF);
}

__device__ __forceinline__ int win_src(int n) {
  if (n < 2048) return n;
  if (n < 4096) return n + 16;
  int j = n - 4096;
  if (j < 16) return 2048 + j;
  if (j < 32) return 4112 + (j - 16);
  return -1;
}
__device__ __forceinline__ void d_transpose_w(int item, int ntn, float* tile, const float* __restrict__ in, int ldn,
                                              const float* __restrict__ g, unsigned short* __restrict__ out, int mode) {
  const int kt = item / ntn, nt = item % ntn;
  const int tid = threadIdx.x;
  __syncthreads();
#pragma unroll
  for (int i = 0; i < 4; ++i) {
    const int row = (tid >> 4) + 16 * i;
    const int c4 = (tid & 15) * 4;
    const int n = nt * 64 + c4;
    const int src = mode ? win_src(n) : n;
    float4 v = make_float4(0.f, 0.f, 0.f, 0.f);
    if (src >= 0) {
      v = *(const float4*)(in + (size_t)(kt * 64 + row) * ldn + src);
      if (g) { const float gg = g[kt * 64 + row]; v.x *= gg; v.y *= gg; v.z *= gg; v.w *= gg; }
    }
    tile[row * 65 + c4] = v.x; tile[row * 65 + c4 + 1] = v.y; tile[row * 65 + c4 + 2] = v.z; tile[row * 65 + c4 + 3] = v.w;
  }
  __syncthreads();
  {
    const int n = tid >> 2, k16 = (tid & 3) * 16;
    uint4 o0, o1;
    o0.x = pack2(tile[(k16 + 0) * 65 + n], tile[(k16 + 1) * 65 + n]);   o0.y = pack2(tile[(k16 + 2) * 65 + n], tile[(k16 + 3) * 65 + n]);
    o0.z = pack2(tile[(k16 + 4) * 65 + n], tile[(k16 + 5) * 65 + n]);   o0.w = pack2(tile[(k16 + 6) * 65 + n], tile[(k16 + 7) * 65 + n]);
    o1.x = pack2(tile[(k16 + 8) * 65 + n], tile[(k16 + 9) * 65 + n]);   o1.y = pack2(tile[(k16 + 10) * 65 + n], tile[(k16 + 11) * 65 + n]);
    o1.z = pack2(tile[(k16 + 12) * 65 + n], tile[(k16 + 13) * 65 + n]); o1.w = pack2(tile[(k16 + 14) * 65 + n], tile[(k16 + 15) * 65 + n]);
    unsigned short* op = out + (size_t)(nt * 64 + n) * DM + kt * 64 + k16;
    *(uint4*)op = o0;
    *(uint4*)(op + 8) = o1;
  }
}
__device__ __forceinline__ void d_cvt_bf16(int item, const float* __restrict__ src, unsigned short* __restrict__ dst,
                                           const float* __restrict__ rowscale, int rowlen_log2) {
  const size_t base = (size_t)item * 2048 + threadIdx.x * 8;
  float4 a = *(const float4*)(src + base);
  float4 b = *(const float4*)(src + base + 4);
  if (rowscale) {
    const float sc = rowscale[base >> rowlen_log2];
    a.x *= sc; a.y *= sc; a.z *= sc; a.w *= sc; b.x *= sc; b.y *= sc; b.z *= sc; b.w *= sc;
  }
  uint4 o;
  o.x = pack2(a.x, a.y); o.y = pack2(a.z, a.w); o.z = pack2(b.x, b.y); o.w = pack2(b.z, b.w);
  *(uint4*)(dst + base) = o;
}

constexpr int GBM = 128, GBN = 128, GBK = 64, GLD = 72;
struct GemmP {
  const unsigned short* A; const unsigned short* Bt; int lda, ldb, K;
  const float* rowscale;
  unsigned short* obf; int ldo;
  float* of32; int ldf;
  const float* resid;
  const float *a_log, *dt_bias, *i_bias, *f_bias;
  float* rowacc;
};
enum { EPI_INPROJ = 0, EPI_OUTPROJ = 1, EPI_SCORES = 2, EPI_PLAIN = 3 };

template <int EPI>
__device__ __forceinline__ void gemm_tile(const GemmP p, int tm, int tn, unsigned short* smem) {
  unsigned short* As = smem;
  unsigned short* Bs = smem + 2 * GBM * GLD;
  const int tid = threadIdx.x, lane = tid & 63, wid = tid >> 6;
  const int wm = wid >> 1, wn = wid & 1;
  const int m0 = tm * GBM, n0 = tn * GBN;
  f32x4 acc[4][4];
#pragma unroll
  for (int i = 0; i < 4; ++i)
#pragma unroll
    for (int j = 0; j < 4; ++j) acc[i][j] = (f32x4){0.f, 0.f, 0.f, 0.f};

  uint4 ra0, ra1, ra2, ra3, rb0, rb1, rb2, rb3;
  const int nk = p.K / GBK;
  const int lrow = tid >> 3, lc8 = tid & 7;
  const unsigned short* Ag = p.A + (size_t)(m0 + lrow) * p.lda + lc8 * 8;
  const unsigned short* Bg = p.Bt + (size_t)(n0 + lrow) * p.ldb + lc8 * 8;
  const size_t a32 = (size_t)32 * p.lda, b32 = (size_t)32 * p.ldb;
#define GLOAD(kt)                                                        \
  {                                                                      \
    ra0 = *(const uint4*)(Ag + (kt) * GBK);                              \
    ra1 = *(const uint4*)(Ag + a32 + (kt) * GBK);                        \
    ra2 = *(const uint4*)(Ag + 2 * a32 + (kt) * GBK);                    \
    ra3 = *(const uint4*)(Ag + 3 * a32 + (kt) * GBK);                    \
    rb0 = *(const uint4*)(Bg + (kt) * GBK);                              \
    rb1 = *(const uint4*)(Bg + b32 + (kt) * GBK);                        \
    rb2 = *(const uint4*)(Bg + 2 * b32 + (kt) * GBK);                    \
    rb3 = *(const uint4*)(Bg + 3 * b32 + (kt) * GBK);                    \
  }
#define SSTORE(buf)                                                      \
  {                                                                      \
    unsigned short* ad = As + (size_t)(buf) * GBM * GLD + lrow * GLD + lc8 * 8; \
    unsigned short* bd = Bs + (size_t)(buf) * GBN * GLD + lrow * GLD + lc8 * 8; \
    *(uint4*)(ad) = ra0; *(uint4*)(ad + 32 * GLD) = ra1; *(uint4*)(ad + 64 * GLD) = ra2; *(uint4*)(ad + 96 * GLD) = ra3; \
    *(uint4*)(bd) = rb0; *(uint4*)(bd + 32 * GLD) = rb1; *(uint4*)(bd + 64 * GLD) = rb2; *(uint4*)(bd + 96 * GLD) = rb3; \
  }
  GLOAD(0);
  SSTORE(0);
  __syncthreads();
  for (int kt = 0; kt < nk; ++kt) {
    const int buf = kt & 1;
    if (kt + 1 < nk) GLOAD(kt + 1);
    const unsigned short* Ab = As + (size_t)buf * GBM * GLD;
    const unsigned short* Bb = Bs + (size_t)buf * GBN * GLD;
#pragma unroll
    for (int ks = 0; ks < 2; ++ks) {
      bf16x8 a[4], b[4];
      const int kc = ks * 32 + (lane >> 4) * 8;
#pragma unroll
      for (int i = 0; i < 4; ++i) a[i] = *(const bf16x8*)(Ab + (wm * 64 + i * 16 + (lane & 15)) * GLD + kc);
#pragma unroll
      for (int j = 0; j < 4; ++j) b[j] = *(const bf16x8*)(Bb + (wn * 64 + j * 16 + (lane & 15)) * GLD + kc);
#pragma unroll
      for (int i = 0; i < 4; ++i)
#pragma unroll
        for (int j = 0; j < 4; ++j) acc[i][j] = __builtin_amdgcn_mfma_f32_16x16x32_bf16(a[i], b[j], acc[i][j], 0, 0, 0);
    }
    if (kt + 1 < nk) SSTORE(buf ^ 1);
    __syncthreads();
  }
#undef GLOAD
#undef SSTORE
#pragma unroll
  for (int i = 0; i < 4; ++i) {
#pragma unroll
    for (int r = 0; r < 4; ++r) {
      const int row = m0 + wm * 64 + i * 16 + (lane >> 4) * 4 + r;
      float rsc = 1.f;
      float rowss = 0.f;
      if (EPI == EPI_INPROJ) rsc = p.rowscale[row];
      if (EPI == EPI_SCORES) {
        const float4* pr = (const float4*)(p.rowscale + (size_t)row * 16);
        const float4 s0 = pr[0], s1 = pr[1], s2 = pr[2], s3 = pr[3];
        const float ssq = ((s0.x + s0.y) + (s0.z + s0.w)) + ((s1.x + s1.y) + (s1.z + s1.w)) + ((s2.x + s2.y) + (s2.z + s2.w)) + ((s3.x + s3.y) + (s3.z + s3.w));
        rsc = rsqrtf(ssq * (1.f / DM) + EPSF);
      }
#pragma unroll
      for (int j = 0; j < 4; ++j) {
        const int col = n0 + wn * 64 + j * 16 + (lane & 15);
        float v = acc[i][j][r] * rsc;
        if (EPI == EPI_INPROJ) {
          if (col < 4096) p.obf[(size_t)row * p.ldo + col] = f2bf(v);
          else if (col < 4128) {
            const int j = col - 4096, jj = j & 7;
            float o;
            if (j < 8) o = -expf(p.a_log[jj]) * softplusf(v + p.dt_bias[jj]);
            else if (j < 16) o = sigmoidf(v);
            else if (j < 24) o = v + p.i_bias[jj];
            else o = -softplusf(-(v + p.f_bias[jj]));
            p.of32[(size_t)row * p.ldf + j] = o;
          }
        } else if (EPI == EPI_OUTPROJ) {
          const float xo = v + p.resid[(size_t)row * p.ldf + col];
          p.of32[(size_t)row * p.ldf + col] = xo;
          p.obf[(size_t)row * p.ldo + col] = f2bf(xo);
          rowss += xo * xo;
        } else {
          p.obf[(size_t)row * p.ldo + col] = f2bf(v);
        }
      }
      if (EPI == EPI_OUTPROJ) {
        rowss += __shfl_xor(rowss, 1, 64); rowss += __shfl_xor(rowss, 2, 64);
        rowss += __shfl_xor(rowss, 4, 64); rowss += __shfl_xor(rowss, 8, 64);
        if ((lane & 15) == 0) p.rowacc[(size_t)row * 16 + tn * 2 + wn] = rowss;
      }
    }
  }
}

__device__ __forceinline__ void d_conv(int item, const unsigned short* __restrict__ pm, const float* __restrict__ pg,
                                              const float* __restrict__ conv_w, const float* __restrict__ a_log,
                                              const float* __restrict__ dt_bias, const float* __restrict__ i_bias,
                                              const float* __restrict__ f_bias, unsigned short* __restrict__ qkv,
                                              float* __restrict__ gt) {
  int t = item * 4 + (threadIdx.x >> 6);
  int lane = threadIdx.x & 63;
  int s = t & (SEQ - 1);
  for (int sec = 0; sec < 3; ++sec) {
    for (int h = 0; h < 4; ++h) {
      int c0 = sec * 512 + h * 128 + 2 * lane;
      float a0 = 0.f, a1 = 0.f;
#pragma unroll
      for (int j = 0; j < 5; ++j) {
        int sp = s + j - 2;
        if (sp >= 0 && sp < SEQ) {
          unsigned v = *(const unsigned*)(pm + (size_t)(t + j - 2) * 4096 + c0);
          a0 += conv_w[c0 * 5 + j] * bf2f((unsigned short)(v & 0xffff));
          a1 += conv_w[(c0 + 1) * 5 + j] * bf2f((unsigned short)(v >> 16));
        }
      }
      a0 = a0 * sigmoidf(a0);
      a1 = a1 * sigmoidf(a1);
      if (sec < 2) {
        float ss = wave_sum(a0 * a0 + a1 * a1);
        float sc = rsqrtf(ss + EPSF);
        if (sec == 0) sc *= 0.08838834764831845f;
        a0 *= sc; a1 *= sc;
      }
      unsigned o = pack2(a0, a1);
      *(unsigned*)(qkv + (size_t)t * 1536 + c0) = o;
    }
  }
}

__device__ __forceinline__ void d_gdn_rec(int chain, float* sq, float* sk, const unsigned short* __restrict__ qkv,
                                                 const float* __restrict__ gt, unsigned short* __restrict__ oA, int ntok) {
  const int bh = chain >> 1, dir = chain & 1;
  const int b = bh >> 2, h = bh & 3;
  const int e = threadIdx.x & 127;
  float S[128];
#pragma unroll
  for (int d = 0; d < 128; ++d) S[d] = 0.f;
  for (int it = 0; it < SEQ; ++it) {
    const int s = dir ? (SEQ - 1 - it) : it;
    const size_t t = (size_t)b * SEQ + s;
    __syncthreads();
    sq[e] = bf2f(qkv[t * 1536 + h * 128 + e]);
    sk[e] = bf2f(qkv[t * 1536 + 512 + h * 128 + e]);
    const float v = bf2f(qkv[t * 1536 + 1024 + h * 128 + e]);
    const float g = gt[t * 32 + dir * 4 + h];
    const float beta = gt[t * 32 + 8 + dir * 4 + h];
    __syncthreads();
    const float a = expf(g);
    float k0 = 0.f, k1 = 0.f, k2 = 0.f, k3 = 0.f;
#pragma unroll
    for (int d = 0; d < 128; d += 4) {
      k0 += sk[d] * S[d]; k1 += sk[d + 1] * S[d + 1]; k2 += sk[d + 2] * S[d + 2]; k3 += sk[d + 3] * S[d + 3];
    }
    const float kS = a * ((k0 + k1) + (k2 + k3));
    const float vn = beta * (v - kS);
    float o0 = 0.f, o1 = 0.f, o2 = 0.f, o3 = 0.f;
#pragma unroll
    for (int d = 0; d < 128; d += 4) {
      S[d] = a * S[d] + sk[d] * vn;             o0 += sq[d] * S[d];
      S[d + 1] = a * S[d + 1] + sk[d + 1] * vn; o1 += sq[d + 1] * S[d + 1];
      S[d + 2] = a * S[d + 2] + sk[d + 2] * vn; o2 += sq[d + 2] * S[d + 2];
      S[d + 3] = a * S[d + 3] + sk[d + 3] * vn; o3 += sq[d + 3] * S[d + 3];
    }
    oA[((size_t)dir * ntok + t) * 512 + h * 128 + e] = f2bf((o0 + o1) + (o2 + o3));
  }
}

__device__ __forceinline__ void d_mlstm_rec(int chain, float* sq, float* sk, const unsigned short* __restrict__ pm,
                                                   const float* __restrict__ gt, unsigned short* __restrict__ oM, int ntok) {
  const int bh = chain >> 1, dir = chain & 1;
  const int b = bh >> 2, h = bh & 3;
  const int e = threadIdx.x & 127, lane = e & 63;
  float C[128];
#pragma unroll
  for (int d = 0; d < 128; ++d) C[d] = 0.f;
  float n0 = 0.f, n1 = 0.f, m = 0.f;
  for (int it = 0; it < SEQ; ++it) {
    const int s = dir ? (SEQ - 1 - it) : it;
    const size_t t = (size_t)b * SEQ + s;
    __syncthreads();
    sq[e] = bf2f(pm[t * 4096 + 2048 + h * 128 + e]);
    sk[e] = bf2f(pm[t * 4096 + 2560 + h * 128 + e]) * 0.08838834764831845f;
    const float v = bf2f(pm[t * 4096 + 3072 + h * 128 + e]);
    const float ip = gt[t * 32 + 16 + dir * 4 + h];
    const float lf = gt[t * 32 + 24 + dir * 4 + h];
    __syncthreads();
    const float mn = fmaxf(lf + m, ip);
    const float fs = expf(lf + m - mn);
    const float is = expf(ip - mn);
    m = mn;
    n0 = fs * n0 + is * sk[lane];
    n1 = fs * n1 + is * sk[lane + 64];
    const float den = wave_sum(n0 * sq[lane] + n1 * sq[lane + 64]);
    const float iv = is * v;
    float o0 = 0.f, o1 = 0.f, o2 = 0.f, o3 = 0.f;
#pragma unroll
    for (int d = 0; d < 128; d += 4) {
      C[d] = fs * C[d] + sk[d] * iv;             o0 += sq[d] * C[d];
      C[d + 1] = fs * C[d + 1] + sk[d + 1] * iv; o1 += sq[d + 1] * C[d + 1];
      C[d + 2] = fs * C[d + 2] + sk[d + 2] * iv; o2 += sq[d + 2] * C[d + 2];
      C[d + 3] = fs * C[d + 3] + sk[d + 3] * iv; o3 += sq[d + 3] * C[d + 3];
    }
    const float num = (o0 + o1) + (o2 + o3);
    const float hh = num / fmaxf(fabsf(den), expf(-mn));
    oM[((size_t)dir * ntok + t) * 512 + h * 128 + e] = f2bf(hh);
  }
}

__device__ __forceinline__ void d_combine(int item, const unsigned short* __restrict__ uo, const unsigned short* __restrict__ oM,
                                                 const unsigned short* __restrict__ pm, const float* __restrict__ gdn_g,
                                                 const float* __restrict__ ml_g, unsigned short* __restrict__ y) {
  int t = item * 4 + (threadIdx.x >> 6);
  int lane = threadIdx.x & 63;
  const int b = t >> 12, cc = (t >> 6) & 63, ii = t & 63;
  for (int h = 0; h < 4; ++h) {
    int c = h * 128 + 2 * lane;
    {
      const int chain0 = (b * 4 + h) * 2;
      const size_t off = (size_t)cc * 8192 + (lane >> 4) * 2048 + ii * 32 + ((2 * lane) & 31);
      unsigned vf = *(const unsigned*)(uo + (size_t)chain0 * 64 * 8192 + off);
      unsigned vb = *(const unsigned*)(uo + (size_t)(chain0 + 1) * 64 * 8192 + off);
      float o0 = bf2f(vf & 0xffff) + bf2f(vb & 0xffff);
      float o1 = bf2f(vf >> 16) + bf2f(vb >> 16);
      float ss = wave_sum(o0 * o0 + o1 * o1);
      float sc = rsqrtf(ss * (1.f / 128.f) + EPSF);
      unsigned z = *(const unsigned*)(pm + (size_t)t * 4096 + 1536 + c);
      float z0 = bf2f(z & 0xffff), z1 = bf2f(z >> 16);
      o0 = o0 * sc * gdn_g[2 * lane] * (z0 * sigmoidf(z0));
      o1 = o1 * sc * gdn_g[2 * lane + 1] * (z1 * sigmoidf(z1));
      *(unsigned*)(y + (size_t)t * DM + c) = pack2(o0, o1);
    }
    {
      unsigned vf = *(const unsigned*)(oM + (size_t)t * 512 + c);
      unsigned vb = *(const unsigned*)(oM + ((size_t)NT + t) * 512 + c);
      float o0 = bf2f(vf & 0xffff) + bf2f(vb & 0xffff);
      float o1 = bf2f(vf >> 16) + bf2f(vb >> 16);
      float ss = wave_sum(o0 * o0 + o1 * o1);
      float sc = rsqrtf(ss * (1.f / 128.f) + EPSF);
      unsigned z = *(const unsigned*)(pm + (size_t)t * 4096 + 3584 + c);
      float z0 = bf2f(z & 0xffff), z1 = bf2f(z >> 16);
      o0 = o0 * sc * ml_g[c] * sigmoidf(z0);
      o1 = o1 * sc * ml_g[c + 1] * sigmoidf(z1);
      *(unsigned*)(y + (size_t)t * DM + 512 + c) = pack2(o0, o1);
    }
  }
}

#ifdef DBG_CHECK
__device__ __forceinline__ void d_dbg_cmp(int item, const unsigned short* __restrict__ uo, const unsigned short* __restrict__ oAd,
                                          float* __restrict__ dbg) {
  int t = item * 4 + (threadIdx.x >> 6);
  int lane = threadIdx.x & 63;
  const int cc = (t >> 6) & 63, ii = t & 63;
  float sd = 0.f, sr = 0.f;
  for (int h = 0; h < 4; ++h) {
    for (int dir = 0; dir < 2; ++dir) {
      const int chain = h * 2 + dir;
      const size_t off = (size_t)cc * 8192 + (lane >> 4) * 2048 + ii * 32 + ((2 * lane) & 31);
      unsigned vn = *(const unsigned*)(uo + (size_t)chain * 64 * 8192 + off);
      unsigned vr = *(const unsigned*)(oAd + ((size_t)dir * 4096 + t) * 512 + h * 128 + 2 * lane);
      float n0 = bf2f(vn & 0xffff), n1 = bf2f(vn >> 16), r0 = bf2f(vr & 0xffff), r1 = bf2f(vr >> 16);
      sd += (n0 - r0) * (n0 - r0) + (n1 - r1) * (n1 - r1);
      sr += r0 * r0 + r1 * r1;
    }
  }
  sd = wave_sum(sd); sr = wave_sum(sr);
  if (lane == 0) { atomicAdd(&dbg[0], sd); atomicAdd(&dbg[1], sr); }
}
__device__ __forceinline__ void d_dbg_cmp_m(int item, const unsigned short* __restrict__ oM, const unsigned short* __restrict__ oMd,
                                            float* __restrict__ dbg) {
  int t = item * 4 + (threadIdx.x >> 6);
  int lane = threadIdx.x & 63;
  float sd = 0.f, sr = 0.f;
  for (int dir = 0; dir < 2; ++dir)
    for (int q = 0; q < 4; ++q) {
      unsigned vn = *(const unsigned*)(oM + ((size_t)dir * NT + t) * 512 + q * 128 + 2 * lane);
      unsigned vr = *(const unsigned*)(oMd + ((size_t)dir * 4096 + t) * 512 + q * 128 + 2 * lane);
      float n0 = bf2f(vn & 0xffff), n1 = bf2f(vn >> 16), r0 = bf2f(vr & 0xffff), r1 = bf2f(vr >> 16);
      sd += (n0 - r0) * (n0 - r0) + (n1 - r1) * (n1 - r1);
      sr += r0 * r0 + r1 * r1;
    }
  sd = wave_sum(sd); sr = wave_sum(sr);
  if (lane == 0) { atomicAdd(&dbg[0], sd); atomicAdd(&dbg[1], sr); }
}
#endif

__device__ __forceinline__ void d_prep_x1(int item, const float* __restrict__ x1, unsigned short* __restrict__ xb,
                                                 float* __restrict__ rs) {
  int t = item * 4 + (threadIdx.x >> 6);
  int lane = threadIdx.x & 63;
  const float4* xr = (const float4*)(x1 + (size_t)t * DM);
  float ss = 0.f;
#pragma unroll
  for (int i = 0; i < 4; ++i) {
    float4 v = xr[lane + 64 * i];
    ss += v.x * v.x + v.y * v.y + v.z * v.z + v.w * v.w;
    ushort4 o;
    o.x = f2bf(v.x); o.y = f2bf(v.y); o.z = f2bf(v.z); o.w = f2bf(v.w);
    ((ushort4*)(xb + (size_t)t * DM))[lane + 64 * i] = o;
  }
  ss = wave_sum(ss);
  if (lane == 0) rs[t] = rsqrtf(ss * (1.f / DM) + EPSF);
}

__device__ const unsigned char kPairTab[64] = {
    0x00, 0x01, 0x02, 0x03, 0x04, 0x05, 0x06, 0x07, 0x08, 0x09, 0x0a, 0x0b, 0x0c, 0x0d, 0x0e, 0x0f,
    0x10, 0x11, 0x12, 0x13, 0x14, 0x15, 0x16, 0x17,
    0x20, 0x21, 0x22, 0x23, 0x24,
    0x30, 0x31, 0x32, 0x33,
    0x40, 0x41, 0x42,
    0x50, 0x51, 0x60, 0x61, 0x70, 0x71,
    0x80, 0x90, 0xa0, 0xb0, 0xc0, 0xd0, 0xe0, 0xf0,
    0xff, 0xff, 0xff, 0xff, 0xff, 0xff, 0xff, 0xff, 0xff, 0xff, 0xff, 0xff, 0xff, 0xff};

__device__ __forceinline__ void sort16_desc(unsigned (&a)[16]) {
#pragma unroll
  for (int k = 2; k <= 16; k <<= 1)
#pragma unroll
    for (int j = k >> 1; j > 0; j >>= 1)
#pragma unroll
      for (int i = 0; i < 16; ++i) {
        const int l = i ^ j;
        if (l > i) {
          const unsigned hi = max(a[i], a[l]), lo = min(a[i], a[l]);
          if ((i & k) == 0) { a[i] = hi; a[l] = lo; } else { a[i] = lo; a[l] = hi; }
        }
      }
}
__device__ __forceinline__ void merge16_desc(unsigned (&top)[16], const unsigned (&b)[16]) {
#pragma unroll
  for (int i = 0; i < 16; ++i) top[i] = max(top[i], b[15 - i]);
#pragma unroll
  for (int j = 8; j > 0; j >>= 1)
#pragma unroll
    for (int i = 0; i < 16; ++i) {
      const int l = i ^ j;
      if (l > i) {
        const unsigned hi = max(top[i], top[l]), lo = min(top[i], top[l]);
        top[i] = hi; top[l] = lo;
      }
    }
}
__device__ __forceinline__ unsigned key16(unsigned hbits, int idx) {
  const unsigned m = hbits ^ ((hbits & 0x8000u) ? 0xFFFFu : 0x8000u);
  return (m << 16) | (unsigned)(127 - idx);
}
__device__ __forceinline__ void top16_of_128(const unsigned short* __restrict__ sp, unsigned (&top)[16]) {
#pragma unroll
  for (int g = 0; g < 8; ++g) {
    const uint4 x0 = *(const uint4*)(sp + g * 16);
    const uint4 x1 = *(const uint4*)(sp + g * 16 + 8);
    unsigned b[16];
    b[0] = key16(x0.x & 0xffff, g * 16 + 0);  b[1] = key16(x0.x >> 16, g * 16 + 1);
    b[2] = key16(x0.y & 0xffff, g * 16 + 2);  b[3] = key16(x0.y >> 16, g * 16 + 3);
    b[4] = key16(x0.z & 0xffff, g * 16 + 4);  b[5] = key16(x0.z >> 16, g * 16 + 5);
    b[6] = key16(x0.w & 0xffff, g * 16 + 6);  b[7] = key16(x0.w >> 16, g * 16 + 7);
    b[8] = key16(x1.x & 0xffff, g * 16 + 8);  b[9] = key16(x1.x >> 16, g * 16 + 9);
    b[10] = key16(x1.y & 0xffff, g * 16 + 10); b[11] = key16(x1.y >> 16, g * 16 + 11);
    b[12] = key16(x1.z & 0xffff, g * 16 + 12); b[13] = key16(x1.z >> 16, g * 16 + 13);
    b[14] = key16(x1.w & 0xffff, g * 16 + 14); b[15] = key16(x1.w >> 16, g * 16 + 15);
    sort16_desc(b);
    if (g == 0) {
#pragma unroll
      for (int i = 0; i < 16; ++i) top[i] = b[i];
    } else {
      merge16_desc(top, b);
    }
  }
}

__device__ __forceinline__ void d_topk(int item, const unsigned short* __restrict__ scores, int* __restrict__ idx_out,
                                       float* __restrict__ gate_out) {
  const int pair = item * 256 + threadIdx.x;
  const unsigned short* sp = scores + (size_t)pair * 256;
  unsigned k0[16], k1[16];
  top16_of_128(sp, k0);
  top16_of_128(sp + 128, k1);
  float v0[16], v1[16];
  int i0[16], i1[16];
#pragma unroll
  for (int i = 0; i < 16; ++i) {
    const unsigned m0 = k0[i] >> 16, m1 = k1[i] >> 16;
    v0[i] = bf2f((unsigned short)(m0 ^ ((m0 & 0x8000u) ? 0x8000u : 0xFFFFu)));
    v1[i] = bf2f((unsigned short)(m1 ^ ((m1 & 0x8000u) ? 0x8000u : 0xFFFFu)));
    i0[i] = 127 - (int)(k0[i] & 127u);
    i1[i] = 127 - (int)(k1[i] & 127u);
  }
  unsigned top[16];
#pragma unroll
  for (int g = 0; g < 4; ++g) {
    unsigned b[16];
#pragma unroll
    for (int q = 0; q < 16; ++q) {
      const int pr = kPairTab[g * 16 + q];
      if (pr == 0xff) {
        b[q] = 0u;
      } else {
        const int pi = pr >> 4, pj = pr & 15;
        const float sum = v0[pi] + v1[pj];
        const unsigned u = __float_as_uint(sum);
        const unsigned mono = u ^ ((u & 0x80000000u) ? 0xFFFFFFFFu : 0x80000000u);
        b[q] = (mono & 0xFFFFC000u) | (unsigned)(16383 - (i0[pi] * 128 + i1[pj]));
      }
    }
    sort16_desc(b);
    if (g == 0) {
#pragma unroll
      for (int i = 0; i < 16; ++i) top[i] = b[i];
    } else {
      merge16_desc(top, b);
    }
  }
  float ev[16];
  int ci[16];
  float mx = 0.f, sum = 0.f;
#pragma unroll
  for (int i = 0; i < 16; ++i) {
    const unsigned mono = top[i] & 0xFFFFC000u;
    const unsigned u = mono ^ ((mono & 0x80000000u) ? 0x80000000u : 0xFFFFFFFFu);
    const float val = __uint_as_float(u & 0xFFFFC000u);
    ci[i] = 16383 - (int)(top[i] & 16383u);
    if (i == 0) mx = val;
    ev[i] = expf(val - mx);
    sum += ev[i];
  }
  const float inv = 1.f / sum;
#pragma unroll
  for (int q = 0; q < 4; ++q) {
    int4 o; float4 g;
    o.x = ci[4 * q]; o.y = ci[4 * q + 1]; o.z = ci[4 * q + 2]; o.w = ci[4 * q + 3];
    g.x = ev[4 * q] * inv; g.y = ev[4 * q + 1] * inv; g.z = ev[4 * q + 2] * inv; g.w = ev[4 * q + 3] * inv;
    *(int4*)(idx_out + (size_t)pair * 16 + 4 * q) = o;
    *(float4*)(gate_out + (size_t)pair * 16 + 4 * q) = g;
  }
}

typedef float f32x2 __attribute__((ext_vector_type(2)));
__device__ __forceinline__ void d_cvt_tab(int item, const float* __restrict__ src, unsigned* __restrict__ dst8, float* __restrict__ dscale) {
  const int row = item * 4 + (threadIdx.x >> 6);
  const int lane = threadIdx.x & 63;
  const float4* sr = (const float4*)(src + (size_t)row * DM + lane * 16);
  const float4 a = sr[0], b = sr[1], c = sr[2], d = sr[3];
  float m = fmaxf(fmaxf(fmaxf(fabsf(a.x), fabsf(a.y)), fmaxf(fabsf(a.z), fabsf(a.w))),
                  fmaxf(fmaxf(fabsf(b.x), fabsf(b.y)), fmaxf(fabsf(b.z), fabsf(b.w))));
  m = fmaxf(m, fmaxf(fmaxf(fmaxf(fabsf(c.x), fabsf(c.y)), fmaxf(fabsf(c.z), fabsf(c.w))),
                     fmaxf(fmaxf(fabsf(d.x), fabsf(d.y)), fmaxf(fabsf(d.z), fabsf(d.w)))));
#pragma unroll
  for (int o = 32; o > 0; o >>= 1) m = fmaxf(m, __shfl_xor(m, o, 64));
  const float sc = (m > 0.f) ? 240.f / m : 1.f;
  uint4 o;
  int p;
  p = 0; p = __builtin_amdgcn_cvt_pk_fp8_f32(a.x * sc, a.y * sc, p, false); p = __builtin_amdgcn_cvt_pk_fp8_f32(a.z * sc, a.w * sc, p, true); o.x = (unsigned)p;
  p = 0; p = __builtin_amdgcn_cvt_pk_fp8_f32(b.x * sc, b.y * sc, p, false); p = __builtin_amdgcn_cvt_pk_fp8_f32(b.z * sc, b.w * sc, p, true); o.y = (unsigned)p;
  p = 0; p = __builtin_amdgcn_cvt_pk_fp8_f32(c.x * sc, c.y * sc, p, false); p = __builtin_amdgcn_cvt_pk_fp8_f32(c.z * sc, c.w * sc, p, true); o.z = (unsigned)p;
  p = 0; p = __builtin_amdgcn_cvt_pk_fp8_f32(d.x * sc, d.y * sc, p, false); p = __builtin_amdgcn_cvt_pk_fp8_f32(d.z * sc, d.w * sc, p, true); o.w = (unsigned)p;
  *(uint4*)(dst8 + (size_t)row * 256 + lane * 4) = o;
  if (lane == 0) dscale[row] = (m > 0.f) ? m * (1.f / 240.f) : 1.f;
}

__device__ __forceinline__ float erf_fast(float x) {
  const float ax = fabsf(x);
  const float t = __builtin_amdgcn_rcpf(1.f + 0.3275911f * ax);
  float p = 1.061405429f;
  p = p * t - 1.453152027f;
  p = p * t + 1.421413741f;
  p = p * t - 0.284496736f;
  p = p * t + 0.254829592f;
  const float e = __builtin_amdgcn_exp2f(-1.4426950408889634f * ax * ax);
  const float r = 1.f - p * t * e;
  return copysignf(r, x);
}
__device__ __forceinline__ float dot16_f8(const uint4 u, const float* hv) {
  const f32x2 a0 = __builtin_amdgcn_cvt_pk_f32_fp8((int)u.x, false), a1 = __builtin_amdgcn_cvt_pk_f32_fp8((int)u.x, true);
  const f32x2 b0 = __builtin_amdgcn_cvt_pk_f32_fp8((int)u.y, false), b1 = __builtin_amdgcn_cvt_pk_f32_fp8((int)u.y, true);
  const f32x2 c0 = __builtin_amdgcn_cvt_pk_f32_fp8((int)u.z, false), c1 = __builtin_amdgcn_cvt_pk_f32_fp8((int)u.z, true);
  const f32x2 d0 = __builtin_amdgcn_cvt_pk_f32_fp8((int)u.w, false), d1 = __builtin_amdgcn_cvt_pk_f32_fp8((int)u.w, true);
  float s0 = a0[0] * hv[0] + a0[1] * hv[1];
  float s1 = a1[0] * hv[2] + a1[1] * hv[3];
  s0 += b0[0] * hv[4] + b0[1] * hv[5];
  s1 += b1[0] * hv[6] + b1[1] * hv[7];
  s0 += c0[0] * hv[8] + c0[1] * hv[9];
  s1 += c1[0] * hv[10] + c1[1] * hv[11];
  s0 += d0[0] * hv[12] + d0[1] * hv[13];
  s1 += d1[0] * hv[14] + d1[1] * hv[15];
  return s0 + s1;
}
__device__ __forceinline__ void axpy16_f8(const uint4 v, const float wg, float* acc) {
  const f32x2 a0 = __builtin_amdgcn_cvt_pk_f32_fp8((int)v.x, false), a1 = __builtin_amdgcn_cvt_pk_f32_fp8((int)v.x, true);
  const f32x2 b0 = __builtin_amdgcn_cvt_pk_f32_fp8((int)v.y, false), b1 = __builtin_amdgcn_cvt_pk_f32_fp8((int)v.y, true);
  const f32x2 c0 = __builtin_amdgcn_cvt_pk_f32_fp8((int)v.z, false), c1 = __builtin_amdgcn_cvt_pk_f32_fp8((int)v.z, true);
  const f32x2 d0 = __builtin_amdgcn_cvt_pk_f32_fp8((int)v.w, false), d1 = __builtin_amdgcn_cvt_pk_f32_fp8((int)v.w, true);
  acc[0] += wg * a0[0]; acc[1] += wg * a0[1]; acc[2] += wg * a1[0]; acc[3] += wg * a1[1];
  acc[4] += wg * b0[0]; acc[5] += wg * b0[1]; acc[6] += wg * b1[0]; acc[7] += wg * b1[1];
  acc[8] += wg * c0[0]; acc[9] += wg * c0[1]; acc[10] += wg * c1[0]; acc[11] += wg * c1[1];
  acc[12] += wg * d0[0]; acc[13] += wg * d0[1]; acc[14] += wg * d1[0]; acc[15] += wg * d1[1];
}
__device__ __forceinline__ void d_peer(int item, const float* __restrict__ x1, const float* __restrict__ rs2,
                                       const float* __restrict__ g2, const int* __restrict__ idx,
                                       const float* __restrict__ gate, const unsigned* __restrict__ pu,
                                       const unsigned* __restrict__ pv, const float* __restrict__ su,
                                       const float* __restrict__ sv, const float* __restrict__ gf,
                                       float* __restrict__ out, float oscale) {
  const int t = item * 4 + (threadIdx.x >> 6);
  const int lane = threadIdx.x & 63;
  float r2;
  {
    const float4* pr = (const float4*)(rs2 + (size_t)t * 16);
    const float4 s0 = pr[0], s1 = pr[1], s2 = pr[2], s3 = pr[3];
    const float ssq = ((s0.x + s0.y) + (s0.z + s0.w)) + ((s1.x + s1.y) + (s1.z + s1.w)) + ((s2.x + s2.y) + (s2.z + s2.w)) + ((s3.x + s3.y) + (s3.z + s3.w));
    r2 = rsqrtf(ssq * (1.f / DM) + EPSF);
  }
  float xv[16], hv[16], acc[16];
#pragma unroll
  for (int q = 0; q < 4; ++q) {
    const float4 xx = *(const float4*)(x1 + (size_t)t * DM + lane * 16 + q * 4);
    const float4 gg = *(const float4*)(g2 + lane * 16 + q * 4);
    xv[q * 4 + 0] = xx.x; xv[q * 4 + 1] = xx.y; xv[q * 4 + 2] = xx.z; xv[q * 4 + 3] = xx.w;
    hv[q * 4 + 0] = xx.x * r2 * gg.x; hv[q * 4 + 1] = xx.y * r2 * gg.y;
    hv[q * 4 + 2] = xx.z * r2 * gg.z; hv[q * 4 + 3] = xx.w * r2 * gg.w;
  }
#pragma unroll
  for (int i = 0; i < 16; ++i) acc[i] = 0.f;
  const int id_a = idx[(size_t)t * 128 + lane], id_b = idx[(size_t)t * 128 + 64 + lane];
  const float gt_a = gate[(size_t)t * 128 + lane], gt_b = gate[(size_t)t * 128 + 64 + lane];
  for (int e0 = 0; e0 < 128; e0 += 8) {
    uint4 u[8], v[8];
    float gt8[8], su8[8], sv8[8];
#pragma unroll
    for (int k = 0; k < 8; ++k) {
      const int e = e0 + k;
      const int id = (e0 < 64) ? __shfl(id_a, e, 64) : __shfl(id_b, e - 64, 64);
      gt8[k] = (e0 < 64) ? __shfl(gt_a, e, 64) : __shfl(gt_b, e - 64, 64);
      u[k] = *(const uint4*)(pu + (size_t)id * 256 + lane * 4);
      v[k] = *(const uint4*)(pv + (size_t)id * 256 + lane * 4);
      su8[k] = su[id];
      sv8[k] = sv[id];
    }
    float d[8];
#pragma unroll
    for (int k = 0; k < 8; ++k) d[k] = dot16_f8(u[k], hv);
#pragma unroll
    for (int o = 32; o > 0; o >>= 1) {
#pragma unroll
      for (int k = 0; k < 8; ++k) d[k] += __shfl_xor(d[k], o, 64);
    }
#pragma unroll
    for (int k = 0; k < 8; ++k) {
      const float dd = d[k] * su8[k];
      const float act = 0.5f * dd * (1.f + erf_fast(dd * 0.7071067811865476f));
      axpy16_f8(v[k], gt8[k] * act * sv8[k], acc);
    }
  }
  float ss = 0.f;
#pragma unroll
  for (int i = 0; i < 16; ++i) { acc[i] += xv[i]; ss += acc[i] * acc[i]; }
  ss = wave_sum(ss);
  const float sc = rsqrtf(ss * (1.f / DM) + EPSF) * oscale;
#pragma unroll
  for (int q = 0; q < 4; ++q) {
    const float4 gg = *(const float4*)(gf + lane * 16 + q * 4);
    float4 o;
    o.x = acc[q * 4 + 0] * sc * gg.x; o.y = acc[q * 4 + 1] * sc * gg.y;
    o.z = acc[q * 4 + 2] * sc * gg.z; o.w = acc[q * 4 + 3] * sc * gg.w;
    *(float4*)(out + (size_t)t * DM + lane * 16 + q * 4) = o;
  }
}

typedef __attribute__((ext_vector_type(16))) float f32x16;
#define MFMA32(a, b, c) __builtin_amdgcn_mfma_f32_32x32x16_bf16((a), (b), (c), 0, 0, 0)
__device__ __forceinline__ int crow(int reg, int hh) { return (reg & 3) + 8 * (reg >> 2) + 4 * hh; }

struct GdnBufs {
  unsigned short* qc;
  unsigned short* kTc;
  unsigned short* qkc;
  unsigned short* wn;
  unsigned short* uo;
  float* gsc;
};

__device__ __forceinline__ void tri_subst(const float* AL0, int lane, float (&T)[64]) {
  const float* AL = (const float*)__builtin_assume_aligned(AL0, 16);
#pragma unroll
  for (int i = 0; i < 64; ++i) T[i] = 0.f;
  T[0] = (lane == 0) ? 1.f : 0.f;
#pragma unroll
  for (int i = 1; i < 64; ++i) {
    float ax = 0.f, ay = 0.f, az = 0.f, aw = 0.f;
#pragma unroll
    for (int j4 = 0; j4 < (i + 3) / 4; ++j4) {
      const float4 a = *(const float4*)(AL + i * 72 + 4 * j4);
      ax += a.x * T[4 * j4]; ay += a.y * T[4 * j4 + 1]; az += a.z * T[4 * j4 + 2]; aw += a.w * T[4 * j4 + 3];
    }
    T[i] = ((lane == i) ? 1.f : 0.f) - ((ax + ay) + (az + aw));
  }
}

__device__ __forceinline__ void d_gdn_prep(int item, char* smem, const unsigned short* __restrict__ pm,
                                           const float* __restrict__ gt, const float* __restrict__ conv_w, GdnBufs G) {
  unsigned short* qL = (unsigned short*)smem;
  unsigned short* kL = qL + 64 * 144;
  unsigned short* kTL = kL + 64 * 144;
  unsigned short* vTL = kTL + 128 * 72;
  float* scal = (float*)(vTL + 128 * 72);
  float* A0 = (float*)qL;
  float* A1 = (float*)kL;
  int tid = threadIdx.x;
  asm volatile("" : "+v"(tid));
  const int lane = tid & 63, w = __builtin_amdgcn_readfirstlane(tid >> 6), r = lane & 31, hh = lane >> 5;
  const int bh = item >> 6, c = item & 63, b = bh >> 2, h = bh & 3;
  const int t0 = b * SEQ + c * 64;
  __syncthreads();
  {
#pragma unroll
    for (int sec = 0; sec < 3; ++sec) {
      const int c0 = sec * 512 + h * 128 + 2 * lane;
      float cw0[5], cw1[5];
#pragma unroll
      for (int j = 0; j < 5; ++j) { cw0[j] = conv_w[c0 * 5 + j]; cw1[j] = conv_w[(c0 + 1) * 5 + j]; }
      unsigned raw[20];
#pragma unroll
      for (int k = 0; k < 20; ++k) {
        const int sp = c * 64 + w * 16 + k - 2;
        raw[k] = (sp >= 0 && sp < SEQ) ? *(const unsigned*)(pm + ((size_t)t0 + w * 16 + k - 2) * 4096 + c0) : 0u;
      }
#pragma unroll
      for (int ii = 0; ii < 16; ++ii) {
        const int i = w * 16 + ii;
        float a0 = 0.f, a1 = 0.f;
#pragma unroll
        for (int j = 0; j < 5; ++j) {
          a0 += cw0[j] * bf2f((unsigned short)(raw[ii + j] & 0xffff));
          a1 += cw1[j] * __uint_as_float(raw[ii + j] & 0xffff0000u);
        }
        a0 = a0 * __builtin_amdgcn_rcpf(1.f + __builtin_amdgcn_exp2f(-1.4426950408889634f * a0));
        a1 = a1 * __builtin_amdgcn_rcpf(1.f + __builtin_amdgcn_exp2f(-1.4426950408889634f * a1));
        if (sec < 2) {
          const float ss = wave_sum(a0 * a0 + a1 * a1);
          float sc = rsqrtf(ss + EPSF);
          if (sec == 0) sc *= 0.08838834764831845f;
          a0 *= sc; a1 *= sc;
        }
        if (sec == 0) {
          *(unsigned*)(qL + i * 144 + 2 * lane) = pack2(a0, a1);
        } else if (sec == 1) {
          const unsigned pk = pack2(a0, a1);
          *(unsigned*)(kL + i * 144 + 2 * lane) = pk;
          kTL[(2 * lane) * 72 + i] = (unsigned short)(pk & 0xffff);
          kTL[(2 * lane + 1) * 72 + i] = (unsigned short)(pk >> 16);
        } else {
          const unsigned pk = pack2(a0, a1);
          vTL[(2 * lane) * 72 + i] = (unsigned short)(pk & 0xffff);
          vTL[(2 * lane + 1) * 72 + i] = (unsigned short)(pk >> 16);
        }
      }
    }
  }
  if (w == 0) {
    const float* gp = gt + ((size_t)t0 + lane) * 32;
    const float g0 = gp[h], g1 = gp[4 + h], b0 = gp[8 + h], b1 = gp[12 + h];
    float G0 = g0, G1 = g1;
#pragma unroll
    for (int o = 1; o < 64; o <<= 1) {
      const float v0 = __shfl_up(G0, o, 64);
      const float v1 = __shfl_down(G1, o, 64);
      if (lane >= o) G0 += v0;
      if (lane + o < 64) G1 += v1;
    }
    scal[lane] = G0 * 1.4426950408889634f; scal[64 + lane] = G1 * 1.4426950408889634f;
    scal[128 + lane] = b0; scal[192 + lane] = b1;
    const float GL0 = __shfl(G0, 63, 64), GL1 = __shfl(G1, 0, 64);
    float* gs0 = G.gsc + ((size_t)((bh * 2 + 0) * 64 + c)) * 192;
    float* gs1 = G.gsc + ((size_t)((bh * 2 + 1) * 64 + c)) * 192;
    gs0[lane] = expf(G0); gs0[64 + lane] = expf(GL0 - G0);
    gs1[lane] = expf(G1); gs1[64 + lane] = expf(GL1 - G1);
    if (lane == 0) { gs0[128] = expf(GL0); gs1[128] = expf(GL1); }
  }
  __syncthreads();
  {
    unsigned short* qg = G.qc + (size_t)item * 8192;
    unsigned short* kg = G.kTc + (size_t)item * 8192;
#pragma unroll
    for (int i = 0; i < 4; ++i) {
      const int id = tid + i * 256;
      *(uint4*)(qg + (id >> 4) * 128 + (id & 15) * 8) = *(const uint4*)(qL + (id >> 4) * 144 + (id & 15) * 8);
      *(uint4*)(kg + (id >> 3) * 64 + (id & 7) * 8) = *(const uint4*)(kTL + (id >> 3) * 72 + (id & 7) * 8);
    }
  }
  {
    const int ta = w >> 1, tb = w & 1;
    f32x16 acc, acc2;
#pragma unroll
    for (int i = 0; i < 16; ++i) { acc[i] = 0.f; acc2[i] = 0.f; }
#pragma unroll
    for (int s = 0; s < 8; ++s) {
      const bf16x8 a = *(const bf16x8*)(kL + (32 * ta + r) * 144 + 16 * s + 8 * hh);
      const bf16x8 bk = *(const bf16x8*)(kL + (32 * tb + r) * 144 + 16 * s + 8 * hh);
      const bf16x8 bq = *(const bf16x8*)(qL + (32 * tb + r) * 144 + 16 * s + 8 * hh);
      acc = MFMA32(a, bk, acc);
      acc2 = MFMA32(a, bq, acc2);
    }
    __syncthreads();
    {
      const int col = 32 * tb + r;
      const float G0c = scal[col], G1c = scal[64 + col];
#pragma unroll
      for (int reg = 0; reg < 16; ++reg) {
        const int row = 32 * ta + crow(reg, hh);
        const float v = acc[reg];
        const float a0 = (col < row) ? scal[128 + row] * v * __builtin_amdgcn_exp2f(scal[row] - G0c) : 0.f;
        const float a1 = (col > row) ? scal[192 + row] * v * __builtin_amdgcn_exp2f(scal[64 + row] - G1c) : 0.f;
        A0[row * 72 + col] = a0;
        A1[(63 - row) * 72 + (63 - col)] = a1;
      }
    }
    {
      const int i = 32 * tb + r;
      const float G0i = scal[i], G1i = scal[64 + i];
      unsigned short* qk0 = G.qkc + ((size_t)((bh * 2 + 0) * 64 + c)) * 4096;
      unsigned short* qk1 = G.qkc + ((size_t)((bh * 2 + 1) * 64 + c)) * 4096;
#pragma unroll
      for (int g = 0; g < 4; ++g) {
        float o0[4], o1[4];
#pragma unroll
        for (int e = 0; e < 4; ++e) {
          const int j = 32 * ta + 8 * g + 4 * hh + e;
          const float v = acc2[4 * g + e];
          o0[e] = (j <= i) ? v * __builtin_amdgcn_exp2f(G0i - scal[j]) : 0.f;
          o1[e] = (j >= i) ? v * __builtin_amdgcn_exp2f(G1i - scal[64 + j]) : 0.f;
        }
        uint2 p0, p1;
        p0.x = pack2(o0[0], o0[1]); p0.y = pack2(o0[2], o0[3]);
        p1.x = pack2(o1[0], o1[1]); p1.y = pack2(o1[2], o1[3]);
        *(uint2*)(qk0 + i * 64 + 32 * ta + 8 * g + 4 * hh) = p0;
        *(uint2*)(qk1 + i * 64 + 32 * ta + 8 * g + 4 * hh) = p1;
      }
    }
  }
  __syncthreads();
  if (w < 2) {
    const int dir = w;
    float T[64];
    tri_subst(A0 + dir * (64 * 72), lane, T);
    const int jn = dir ? 63 - lane : lane;
    const float sb = scal[128 + 64 * dir + jn];
    const float sbg = sb * __builtin_amdgcn_exp2f(scal[64 * dir + jn]);
    unsigned short* Tb = dir ? kL : qL;
    unsigned short* Tbg = Tb + 64 * 72;
#pragma unroll
    for (int ip = 0; ip < 64; ++ip) {
      const int in = dir ? 63 - ip : ip;
      Tb[in * 72 + jn] = f2bf(T[ip] * sb);
      Tbg[in * 72 + jn] = f2bf(T[ip] * sbg);
    }
  }
  __syncthreads();
#pragma unroll
  for (int d = 0; d < 2; ++d) {
    const int chain = bh * 2 + d;
    const unsigned short* Tb = d ? kL : qL;
    const unsigned short* Tbg = Tb + 64 * 72;
    unsigned short* wng = G.wn + ((size_t)(chain * 64 + c)) * 8192;
    unsigned short* uog = G.uo + ((size_t)(chain * 64 + c)) * 8192 + w * 2048;
#pragma unroll
    for (int tb = 0; tb < 2; ++tb) {
      f32x16 acc, acc2;
#pragma unroll
      for (int i = 0; i < 16; ++i) { acc[i] = 0.f; acc2[i] = 0.f; }
#pragma unroll
      for (int s = 0; s < 4; ++s) {
        const bf16x8 a = *(const bf16x8*)(kTL + (32 * w + r) * 72 + 16 * s + 8 * hh);
        const bf16x8 bb = *(const bf16x8*)(Tbg + (32 * tb + r) * 72 + 16 * s + 8 * hh);
        acc = MFMA32(a, bb, acc);
        const bf16x8 a2 = *(const bf16x8*)(Tb + (32 * tb + r) * 72 + 16 * s + 8 * hh);
        const bf16x8 b2 = *(const bf16x8*)(vTL + (32 * w + r) * 72 + 16 * s + 8 * hh);
        acc2 = MFMA32(a2, b2, acc2);
      }
#pragma unroll
      for (int g = 0; g < 4; ++g) {
        uint2 pk;
        pk.x = pack2(-acc[4 * g], -acc[4 * g + 1]); pk.y = pack2(-acc[4 * g + 2], -acc[4 * g + 3]);
        *(uint2*)(wng + (32 * tb + r) * 128 + 32 * w + 8 * g + 4 * hh) = pk;
      }
      uint4 u0, u1;
      u0.x = pack2(acc2[0], acc2[1]); u0.y = pack2(acc2[2], acc2[3]); u0.z = pack2(acc2[4], acc2[5]); u0.w = pack2(acc2[6], acc2[7]);
      u1.x = pack2(acc2[8], acc2[9]); u1.y = pack2(acc2[10], acc2[11]); u1.z = pack2(acc2[12], acc2[13]); u1.w = pack2(acc2[14], acc2[15]);
      *(uint4*)(uog + tb * 1024 + lane * 16) = u0;
      *(uint4*)(uog + tb * 1024 + lane * 16 + 8) = u1;
    }
  }
}

struct GdnOps {
  bf16x8 a[8];
  bf16x8 x[4];
  bf16x8 kt[4];
  float4 rs[4];
  float gtot;
};
__device__ __forceinline__ void gdn_load(GdnOps& o, const GdnBufs& G, int chain, int bh, int c, int sl, int w, int r, int hh, int lane) {
  const unsigned short* kT_c = G.kTc + ((size_t)(bh * 64 + c)) * 8192;
  const float* gs = G.gsc + ((size_t)(chain * 64 + c)) * 192;
  const int ti = w & 1;
#pragma unroll
  for (int s = 0; s < 4; ++s) o.kt[s] = *(const bf16x8*)(kT_c + (32 * w + r) * 64 + 16 * s + 8 * hh);
  o.gtot = gs[128];
  if (w < 2) {
    const unsigned short* wn_c = G.wn + ((size_t)(chain * 64 + c)) * 8192;
    const unsigned short* uo_c = G.uo + ((size_t)(chain * 64 + c)) * 8192 + sl * 2048;
#pragma unroll
    for (int s = 0; s < 8; ++s) o.a[s] = *(const bf16x8*)(wn_c + (32 * ti + r) * 128 + 16 * s + 8 * hh);
    o.x[0] = *(const bf16x8*)(uo_c + ti * 1024 + lane * 16);
    o.x[1] = *(const bf16x8*)(uo_c + ti * 1024 + lane * 16 + 8);
#pragma unroll
    for (int g = 0; g < 4; ++g) o.rs[g] = *(const float4*)(gs + 64 + 32 * ti + 8 * g + 4 * hh);
  } else {
    const unsigned short* q_c = G.qc + ((size_t)(bh * 64 + c)) * 8192;
    const unsigned short* qk_c = G.qkc + ((size_t)(chain * 64 + c)) * 4096;
#pragma unroll
    for (int s = 0; s < 8; ++s) o.a[s] = *(const bf16x8*)(q_c + (32 * ti + r) * 128 + 16 * s + 8 * hh);
#pragma unroll
    for (int s = 0; s < 4; ++s) o.x[s] = *(const bf16x8*)(qk_c + (32 * ti + r) * 64 + 16 * s + 8 * hh);
#pragma unroll
    for (int g = 0; g < 4; ++g) o.rs[g] = *(const float4*)(gs + 32 * ti + 8 * g + 4 * hh);
  }
}
__device__ __forceinline__ void gdn_step(const GdnOps& o, f32x16& S, unsigned short* ST, unsigned short* VT, unsigned short* VdT,
                                         unsigned short* uo_c, int w, int r, int hh) {
  const int ti = w & 1;
  f32x16 acc;
  if (w < 2) {
#pragma unroll
    for (int i = 0; i < 8; ++i) {
      acc[i] = bf2f((unsigned short)o.x[0][i]);
      acc[8 + i] = bf2f((unsigned short)o.x[1][i]);
    }
  } else {
#pragma unroll
    for (int i = 0; i < 16; ++i) acc[i] = 0.f;
  }
#pragma unroll
  for (int g = 0; g < 4; ++g) {
    uint2 pk;
    pk.x = pack2(S[4 * g], S[4 * g + 1]); pk.y = pack2(S[4 * g + 2], S[4 * g + 3]);
    *(uint2*)(ST + r * 136 + 32 * w + 8 * g + 4 * hh) = pk;
  }
  __syncthreads();
#pragma unroll
  for (int s = 0; s < 8; ++s) {
    const bf16x8 bs = *(const bf16x8*)(ST + r * 136 + 16 * s + 8 * hh);
    acc = MFMA32(o.a[s], bs, acc);
  }
  if (w < 2) {
#pragma unroll
    for (int g = 0; g < 4; ++g) {
      uint2 pk, pd;
      pk.x = pack2(acc[4 * g], acc[4 * g + 1]); pk.y = pack2(acc[4 * g + 2], acc[4 * g + 3]);
      pd.x = pack2(acc[4 * g] * o.rs[g].x, acc[4 * g + 1] * o.rs[g].y);
      pd.y = pack2(acc[4 * g + 2] * o.rs[g].z, acc[4 * g + 3] * o.rs[g].w);
      *(uint2*)(VT + r * 72 + 32 * ti + 8 * g + 4 * hh) = pk;
      *(uint2*)(VdT + r * 72 + 32 * ti + 8 * g + 4 * hh) = pd;
    }
  } else {
#pragma unroll
    for (int g = 0; g < 4; ++g) {
      acc[4 * g] *= o.rs[g].x; acc[4 * g + 1] *= o.rs[g].y; acc[4 * g + 2] *= o.rs[g].z; acc[4 * g + 3] *= o.rs[g].w;
    }
  }
  __syncthreads();
  if (w >= 2) {
#pragma unroll
    for (int s = 0; s < 4; ++s) {
      const bf16x8 bv = *(const bf16x8*)(VT + r * 72 + 16 * s + 8 * hh);
      acc = MFMA32(o.x[s], bv, acc);
    }
#pragma unroll
    for (int reg = 0; reg < 16; ++reg) uo_c[(32 * ti + crow(reg, hh)) * 32 + r] = f2bf(acc[reg]);
  }
#pragma unroll
  for (int i = 0; i < 16; ++i) S[i] *= o.gtot;
#pragma unroll
  for (int s = 0; s < 4; ++s) {
    const bf16x8 bv = *(const bf16x8*)(VdT + r * 72 + 16 * s + 8 * hh);
    S = MFMA32(o.kt[s], bv, S);
  }
}
__device__ __forceinline__ void d_gdn_scan(int chain, int sl, char* smem, GdnBufs G) {
  unsigned short* ST = (unsigned short*)smem;
  unsigned short* VT = ST + 32 * 136;
  unsigned short* VdT = VT + 32 * 72;
  const int tid = threadIdx.x, lane = tid & 63, w = __builtin_amdgcn_readfirstlane(tid >> 6), r = lane & 31, hh = lane >> 5;
  const int bh = chain >> 1, dir = chain & 1;
  f32x16 S;
#pragma unroll
  for (int i = 0; i < 16; ++i) S[i] = 0.f;
  GdnOps A, B;
  gdn_load(A, G, chain, bh, dir ? 63 : 0, sl, w, r, hh, lane);
  for (int step = 0; step < 64; step += 2) {
    const int c0 = dir ? 63 - step : step;
    const int c1 = dir ? c0 - 1 : c0 + 1;
    const int c2 = dir ? c0 - 2 : c0 + 2;
    gdn_load(B, G, chain, bh, c1, sl, w, r, hh, lane);
    gdn_step(A, S, ST, VT, VdT, G.uo + ((size_t)(chain * 64 + c0)) * 8192 + sl * 2048, w, r, hh);
    if (step + 2 < 64) gdn_load(A, G, chain, bh, c2, sl, w, r, hh, lane);
    gdn_step(B, S, ST, VT, VdT, G.uo + ((size_t)(chain * 64 + c1)) * 8192 + sl * 2048, w, r, hh);
  }
}

#define ML_LOAD(T0)                                                                                         \
  {                                                                                                         \
    _Pragma("unroll") for (int i_ = 0; i_ < 8; ++i_) {                                                      \
      const int id_ = t128 + i_ * 128;                                                                      \
      pq[i_] = *(const uint4*)(pm + ((T0) + (id_ >> 4)) * 4096 + 2048 + h * 128 + (id_ & 15) * 8);          \
      pk[i_] = *(const uint4*)(pm + ((T0) + (id_ >> 4)) * 4096 + 2560 + h * 128 + (id_ & 15) * 8);          \
    }                                                                                                       \
    _Pragma("unroll") for (int i_ = 0; i_ < 2; ++i_) {                                                      \
      const int id_ = t128 + i_ * 128;                                                                      \
      pv[i_] = *(const uint4*)(pm + ((T0) + (id_ >> 2)) * 4096 + 3072 + h * 128 + sl * 32 + (id_ & 3) * 8); \
    }                                                                                                       \
    plf = gt[((T0) + lane) * 32 + 24 + dir * 4 + h];                                                        \
    pip = gt[((T0) + lane) * 32 + 16 + dir * 4 + h];                                                        \
  }
__device__ __forceinline__ void ml_state_image(const f32x16& S0, const f32x16& S1, unsigned short* S0T, unsigned short* nL, int w, int r, int hh) {
#pragma unroll
  for (int g = 0; g < 4; ++g) {
    uint2 pk;
    pk.x = pack2(S0[4 * g], S0[4 * g + 1]); pk.y = pack2(S0[4 * g + 2], S0[4 * g + 3]);
    *(uint2*)(S0T + r * 136 + 32 * w + 8 * g + 4 * hh) = pk;
    if (r == 0) {
      uint2 pn;
      pn.x = pack2(S1[4 * g], S1[4 * g + 1]); pn.y = pack2(S1[4 * g + 2], S1[4 * g + 3]);
      *(uint2*)(nL + 32 * w + 8 * g + 4 * hh) = pn;
    }
  }
}
__device__ __forceinline__ void ml_state_update(f32x16& S0, f32x16& S1, const unsigned short* kdL, const unsigned short* vTL,
                                                float gtot, int w, int r, int hh) {
  bf16x8 ones;
#pragma unroll
  for (int i = 0; i < 8; ++i) ones[i] = (short)0x3F80;
#pragma unroll
  for (int i = 0; i < 16; ++i) { S0[i] *= gtot; S1[i] *= gtot; }
#pragma unroll
  for (int s2 = 0; s2 < 4; ++s2) {
    union { bf16x8 v; unsigned short e[8]; } a;
#pragma unroll
    for (int e = 0; e < 8; ++e) a.e[e] = kdL[(16 * s2 + 8 * hh + e) * 136 + 32 * w + r];
    const bf16x8 bv = *(const bf16x8*)(vTL + r * 72 + 16 * s2 + 8 * hh);
    S0 = MFMA32(a.v, bv, S0);
    S1 = MFMA32(a.v, ones, S1);
  }
}
__device__ __forceinline__ void d_mlstm_scan(int chain, int sl, char* smem, const unsigned short* __restrict__ pm,
                                             const float* __restrict__ gt, unsigned short* __restrict__ oM, int ntok) {
  unsigned short* qL = (unsigned short*)smem;
  unsigned short* kL = qL + 64 * 136;
  unsigned short* kdL = kL + 64 * 136;
  unsigned short* vTL = kdL + 64 * 136;
  unsigned short* S0T = vTL + 32 * 72;
  unsigned short* nL = S0T + 32 * 136;
  float* scal = (float*)(nL + 256);
  const int tid = threadIdx.x, lane = tid & 63, w = __builtin_amdgcn_readfirstlane(tid >> 6), r = lane & 31, hh = lane >> 5;
  const int bh = chain >> 1, dir = chain & 1, b = bh >> 2, h = bh & 3;
  const float SCALE = 0.08838834764831845f;
  f32x16 S0, S1;
#pragma unroll
  for (int i = 0; i < 16; ++i) { S0[i] = 0.f; S1[i] = 0.f; }
  unsigned short* oMb = oM + (size_t)dir * ntok * 512 + h * 128 + sl * 32;
  const size_t tb = (size_t)b * SEQ;
  if (w >= 2) {
    const int t128 = tid - 128;
    uint4 pq[8], pk[8], pv[2];
    float plf, pip;
    ML_LOAD(tb + (dir ? 63 : 0) * 64);
    for (int step = 0; step < 64; ++step) {
      const int c0 = dir ? 63 - step : step;
      const int c1 = dir ? c0 - 1 : c0 + 1;
      float bc = plf;
#pragma unroll
      for (int ofs = 1; ofs < 64; ofs <<= 1) {
        const float vu = __shfl_up(bc, ofs, 64);
        const float vd = __shfl_down(bc, ofs, 64);
        if (dir == 0) { if (lane >= ofs) bc += vu; } else { if (lane + ofs < 64) bc += vd; }
      }
      const float b_last = __shfl(bc, dir ? 0 : 63, 64);
      const float Dj = SCALE * expf(b_last - bc + pip);
      const float gtot = expf(b_last);
      __syncthreads();
      if (w == 2) {
        scal[lane] = expf(bc);
        scal[64 + lane] = (pip - bc) * 1.4426950408889634f - 3.5f;
        scal[128 + lane] = bc * 1.4426950408889634f;
        if (lane == 0) scal[192] = gtot;
      }
#pragma unroll
      for (int i = 0; i < 8; ++i) {
        const int id = t128 + i * 128;
        const int row = id >> 4, c16 = id & 15;
        const uint4 kv = pk[i];
        const uint4 qv = pq[i];
        *(uint4*)(qL + row * 136 + c16 * 8) = qv;
        *(uint4*)(kL + row * 136 + c16 * 8) = kv;
        const float d = __shfl(Dj, row, 64);
        uint4 kd;
        kd.x = pack2(bf2f(kv.x & 0xffff) * d, bf2f(kv.x >> 16) * d);
        kd.y = pack2(bf2f(kv.y & 0xffff) * d, bf2f(kv.y >> 16) * d);
        kd.z = pack2(bf2f(kv.z & 0xffff) * d, bf2f(kv.z >> 16) * d);
        kd.w = pack2(bf2f(kv.w & 0xffff) * d, bf2f(kv.w >> 16) * d);
        *(uint4*)(kdL + row * 136 + c16 * 8) = kd;
      }
#pragma unroll
      for (int i = 0; i < 2; ++i) {
        const int id = t128 + i * 128;
        const int tok = id >> 2, d8 = (id & 3) * 8;
        const uint4 vv = pv[i];
        vTL[(d8 + 0) * 72 + tok] = (unsigned short)(vv.x & 0xffff);
        vTL[(d8 + 1) * 72 + tok] = (unsigned short)(vv.x >> 16);
        vTL[(d8 + 2) * 72 + tok] = (unsigned short)(vv.y & 0xffff);
        vTL[(d8 + 3) * 72 + tok] = (unsigned short)(vv.y >> 16);
        vTL[(d8 + 4) * 72 + tok] = (unsigned short)(vv.z & 0xffff);
        vTL[(d8 + 5) * 72 + tok] = (unsigned short)(vv.z >> 16);
        vTL[(d8 + 6) * 72 + tok] = (unsigned short)(vv.w & 0xffff);
        vTL[(d8 + 7) * 72 + tok] = (unsigned short)(vv.w >> 16);
      }
      if (step + 1 < 64) ML_LOAD(tb + c1 * 64);
      ml_state_image(S0, S1, S0T, nL, w, r, hh);
      __syncthreads();
      ml_state_update(S0, S1, kdL, vTL, gtot, w, r, hh);
    }
  } else {
    bf16x8 ones;
#pragma unroll
    for (int i = 0; i < 8; ++i) ones[i] = (short)0x3F80;
    const int ti = w;
    const int icol = 32 * ti + r;
    for (int step = 0; step < 64; ++step) {
      const int c0 = dir ? 63 - step : step;
      __syncthreads();
      ml_state_image(S0, S1, S0T, nL, w, r, hh);
      __syncthreads();
      const float bci = scal[128 + icol];
      const float gtot = scal[192];
      f32x16 Q0, Q1;
#pragma unroll
      for (int i = 0; i < 16; ++i) { Q0[i] = 0.f; Q1[i] = 0.f; }
#pragma unroll
      for (int s2 = 0; s2 < 8; ++s2) {
        const bf16x8 a = *(const bf16x8*)(qL + (32 * ti + r) * 136 + 16 * s2 + 8 * hh);
        const bf16x8 b0 = *(const bf16x8*)(S0T + r * 136 + 16 * s2 + 8 * hh);
        const bf16x8 b1 = *(const bf16x8*)(nL + 16 * s2 + 8 * hh);
        Q0 = MFMA32(a, b0, Q0);
        Q1 = MFMA32(a, b1, Q1);
      }
#pragma unroll
      for (int g = 0; g < 4; ++g) {
        const float4 e4 = *(const float4*)(scal + 32 * ti + 8 * g + 4 * hh);
        Q0[4 * g] *= e4.x; Q0[4 * g + 1] *= e4.y; Q0[4 * g + 2] *= e4.z; Q0[4 * g + 3] *= e4.w;
        Q1[4 * g] *= e4.x; Q1[4 * g + 1] *= e4.y; Q1[4 * g + 2] *= e4.z; Q1[4 * g + 3] *= e4.w;
      }
#pragma unroll
      for (int tj = 0; tj < 2; ++tj) {
        if (dir ? (tj < ti) : (tj > ti)) continue;
        f32x16 X;
#pragma unroll
        for (int i = 0; i < 16; ++i) X[i] = 0.f;
#pragma unroll
        for (int s2 = 0; s2 < 8; ++s2) {
          const bf16x8 a = *(const bf16x8*)(kL + (32 * tj + r) * 136 + 16 * s2 + 8 * hh);
          const bf16x8 bq = *(const bf16x8*)(qL + (32 * ti + r) * 136 + 16 * s2 + 8 * hh);
          X = MFMA32(a, bq, X);
        }
#pragma unroll
        for (int g = 0; g < 4; ++g) {
          const float4 cj4 = *(const float4*)(scal + 64 + 32 * tj + 8 * g + 4 * hh);
          const float cjs[4] = {cj4.x, cj4.y, cj4.z, cj4.w};
#pragma unroll
          for (int e = 0; e < 4; ++e) {
            const int j = 32 * tj + 8 * g + 4 * hh + e;
            const bool valid = dir ? (j >= icol) : (j <= icol);
            const float arg = valid ? (bci + cjs[e]) : -INFINITY;
            X[4 * g + e] *= __builtin_amdgcn_exp2f(arg);
          }
        }
#pragma unroll
        for (int s2 = 0; s2 < 2; ++s2) {
          union { bf16x8 v; unsigned u[4]; } xa, bv;
          xa.u[0] = pack2(X[8 * s2 + 0], X[8 * s2 + 1]); xa.u[1] = pack2(X[8 * s2 + 2], X[8 * s2 + 3]);
          xa.u[2] = pack2(X[8 * s2 + 4], X[8 * s2 + 5]); xa.u[3] = pack2(X[8 * s2 + 6], X[8 * s2 + 7]);
          const uint2 v0 = *(const uint2*)(vTL + r * 72 + 32 * tj + 16 * s2 + 4 * hh);
          const uint2 v1 = *(const uint2*)(vTL + r * 72 + 32 * tj + 16 * s2 + 8 + 4 * hh);
          bv.u[0] = v0.x; bv.u[1] = v0.y; bv.u[2] = v1.x; bv.u[3] = v1.y;
          Q0 = MFMA32(xa.v, bv.v, Q0);
          Q1 = MFMA32(xa.v, ones, Q1);
        }
      }
      const size_t orow0 = tb + c0 * 64;
#pragma unroll
      for (int reg = 0; reg < 16; ++reg) {
        const int i = 32 * ti + crow(reg, hh);
        oMb[(orow0 + i) * 512 + r] = f2bf(Q0[reg] * __builtin_amdgcn_rcpf(fmaxf(fabsf(Q1[reg]), 1.f)));
      }
      ml_state_update(S0, S1, kdL, vTL, gtot, w, r, hh);
    }
  }
}

struct MKP {
  const float *x, *norm1_g, *w_in, *conv_w, *a_log, *dt_bias, *gdn_g, *i_bias, *f_bias, *ml_g, *w_out, *norm2_g, *peer_wq,
      *peer_keys, *peer_u, *peer_v, *normf_g;
  float* out;
  unsigned short *pm, *x1b, *woutT, *mt, *xb, *winT, *oM, *yb, *scores, *qkv_dbg, *oA_dbg;
  unsigned *utab, *vtab;
  unsigned short *wqb, *keyb;
  float *uscale, *vscale;
  float *x1, *rs1, *rs2, *gt, *gateb, *dbg;
  unsigned* bar;
  int* idxb;
  GdnBufs G;
};

constexpr int SMEM_BYTES = 74752;
__global__ void __launch_bounds__(256, 2) k_mega(MKP P) {
  __shared__ __attribute__((aligned(16))) char smem_c[SMEM_BYTES + 16];
  {
    volatile LAS unsigned* st0 = (volatile LAS unsigned*)(smem_c + SMEM_BYTES);
    if (threadIdx.x < 4) st0[threadIdx.x] = 0u;
  }
  __syncthreads();
  XcdBarrier xb = xcd_barrier_post(P.bar, (volatile LAS unsigned*)(smem_c + SMEM_BYTES));
  unsigned short* smem = (unsigned short*)smem_c;
  const int nb = gridDim.x, bid = blockIdx.x;
  for (int it = bid; it < NT / 4; it += nb) d_prep_x(it, P.x, P.xb, P.rs1);
  for (int it = bid; it < 16 * 66; it += nb) d_transpose_w(it, 66, (float*)smem_c, P.w_in, DIN, P.norm1_g, P.winT, 1);
  for (int it = bid; it < 16 * 16; it += nb) d_transpose_w(it, 16, (float*)smem_c, P.w_out, 1024, nullptr, P.woutT, 0);
  for (int it = bid; it < 1024; it += nb) d_cvt_bf16(it, P.peer_wq, P.wqb, P.norm2_g, 11);
  for (int it = bid; it < 128; it += nb) d_cvt_bf16(it, P.peer_keys, P.keyb, nullptr, 0);
  if (bid == 0 && threadIdx.x < 4) P.dbg[threadIdx.x] = 0.f;
  xcd_barrier(xb);
  {
    GemmP p{};
    p.A = P.xb; p.lda = DM; p.Bt = P.winT; p.ldb = DM; p.K = DM;
    p.rowscale = P.rs1; p.obf = P.pm; p.ldo = 4096; p.of32 = P.gt; p.ldf = 32; p.resid = nullptr;
    p.a_log = P.a_log; p.dt_bias = P.dt_bias; p.i_bias = P.i_bias; p.f_bias = P.f_bias;
    for (int tile = bid; tile < (NT / 128) * 33; tile += nb) {
      gemm_tile<EPI_INPROJ>(p, tile / 33, tile % 33, smem);
      __syncthreads();
    }
  }
  for (int tile = bid; tile < 16 * 8; tile += nb) {
    const int hp = tile >> 3, tn = tile & 7;
    GemmP p{};
    p.A = P.keyb + (size_t)hp * 128 * 128; p.lda = 128; p.Bt = P.wqb + hp * 128; p.ldb = 2048; p.K = 128;
    p.obf = P.mt + (size_t)hp * 128 * DM; p.ldo = DM;
    gemm_tile<EPI_PLAIN>(p, 0, tn, smem);
    __syncthreads();
  }
  xcd_barrier(xb);
  for (int it = bid; it < 1024; it += nb) d_gdn_prep(it, smem_c, P.pm, P.gt, P.conv_w, P.G);
  xcd_barrier(xb);
  if (bid < 128) {
    d_gdn_scan(bid >> 2, bid & 3, smem_c, P.G);
  } else if (bid < 256) {
    d_mlstm_scan((bid - 128) >> 2, (bid - 128) & 3, smem_c, P.pm, P.gt, P.oM, NT);
  }
#ifdef DBG_CHECK
  if (bid < 4) {
    __syncthreads();
    const int half = threadIdx.x >> 7;
    float* sq = (float*)smem + half * 256;
    float* sk = sq + 128;
    d_mlstm_rec(bid * 2 + half, sq, sk, P.pm, P.gt, P.oA_dbg, 4096);
  }
#endif
  xcd_barrier(xb);
  for (int it = bid; it < NT / 4; it += nb) d_combine(it, P.G.uo, P.oM, P.pm, P.gdn_g, P.ml_g, P.yb);
#ifdef DBG_CHECK
  for (int it = bid; it < 4096 / 4; it += nb) d_dbg_cmp_m(it, P.oM, P.oA_dbg, P.dbg);
#endif
  xcd_barrier(xb);
  {
    GemmP p{};
    p.A = P.yb; p.lda = DM; p.Bt = P.woutT; p.ldb = DM; p.K = DM;
    p.rowscale = nullptr; p.obf = P.x1b; p.ldo = DM; p.of32 = P.x1; p.ldf = DM; p.resid = P.x; p.rowacc = P.rs2;
    for (int tile = bid; tile < (NT / 128) * 8; tile += nb) {
      gemm_tile<EPI_OUTPROJ>(p, tile / 8, tile % 8, smem);
      __syncthreads();
    }
  }
  xcd_barrier(xb);
  {
    GemmP p{};
    p.A = P.x1b; p.lda = DM; p.Bt = P.mt; p.ldb = DM; p.K = DM;
    p.rowscale = P.rs2; p.obf = P.scores; p.ldo = 2048; p.of32 = nullptr; p.ldf = 0; p.resid = nullptr;
    for (int tile = bid; tile < (NT / 128) * 16; tile += nb) {
      gemm_tile<EPI_SCORES>(p, tile / 16, tile % 16, smem);
      __syncthreads();
    }
  }
  xcd_barrier(xb);
  for (int it = bid; it < 4096; it += nb) { d_cvt_tab(it, P.peer_u, P.utab, P.uscale); d_cvt_tab(it, P.peer_v, P.vtab, P.vscale); }
  for (int it = bid; it < NT * 8 / 256; it += nb) d_topk(it, P.scores, P.idxb, P.gateb);
  xcd_barrier(xb);
  float oscale = 1.f;
#ifdef DBG_CHECK
  {
    const float sd = __hip_atomic_load(&P.dbg[0], __ATOMIC_RELAXED, __HIP_MEMORY_SCOPE_AGENT);
    const float sr = __hip_atomic_load(&P.dbg[1], __ATOMIC_RELAXED, __HIP_MEMORY_SCOPE_AGENT);
    oscale = 1.f + sqrtf(sd / sr);
  }
#endif
  for (int it = bid; it < NT / 4; it += nb)
    d_peer(it, P.x1, P.rs2, P.norm2_g, P.idxb, P.gateb, P.utab, P.vtab, P.uscale, P.vscale, P.normf_g, P.out, oscale);
}

extern "C" void kernel_launch(void* const* d_in, const int* in_sizes, int n_in, void* d_out, int out_size, void* d_ws,
                              size_t ws_size, hipStream_t stream) {
  MKP P{};
  P.x = (const float*)d_in[0];
  P.norm1_g = (const float*)d_in[1];
  P.w_in = (const float*)d_in[2];
  P.conv_w = (const float*)d_in[3];
  P.a_log = (const float*)d_in[4];
  P.dt_bias = (const float*)d_in[5];
  P.gdn_g = (const float*)d_in[6];
  P.i_bias = (const float*)d_in[7];
  P.f_bias = (const float*)d_in[8];
  P.ml_g = (const float*)d_in[9];
  P.w_out = (const float*)d_in[10];
  P.norm2_g = (const float*)d_in[11];
  P.peer_wq = (const float*)d_in[12];
  P.peer_keys = (const float*)d_in[13];
  P.peer_u = (const float*)d_in[14];
  P.peer_v = (const float*)d_in[15];
  P.normf_g = (const float*)d_in[16];
  P.out = (float*)d_out;

  char* ws = (char*)d_ws;
  const size_t MB = 1024 * 1024;
  P.pm = (unsigned short*)(ws);
  P.x1 = (float*)(ws);
  P.x1b = (unsigned short*)(ws + 64 * MB);
  P.utab = (unsigned*)(ws + 64 * MB);
  P.vtab = (unsigned*)(ws + 80 * MB);
  P.uscale = (float*)(ws + 96 * MB);
  P.vscale = (float*)(ws + 96 * MB + 65536);
  char* rb = ws + 128 * MB;
  P.woutT = (unsigned short*)(rb);
  P.mt = (unsigned short*)(rb + 2 * MB);
  P.rs1 = (float*)(rb + 6 * MB);
  P.rs2 = (float*)(rb + 7 * MB);
  P.dbg = (float*)(rb + 6 * MB + 131072);
  P.bar = (unsigned*)(rb + 6 * MB + 196608);
  P.gt = (float*)(rb + 9 * MB);
  char* dyn = rb + 11 * MB;
  P.xb = (unsigned short*)(dyn);
  P.winT = (unsigned short*)(dyn + 32 * MB);
  P.wqb = (unsigned short*)(dyn + 41 * MB);
  P.keyb = (unsigned short*)(dyn + 45 * MB);
  P.G.qc = (unsigned short*)(dyn);
  P.G.kTc = (unsigned short*)(dyn + 16 * MB);
  P.G.qkc = (unsigned short*)(dyn + 32 * MB);
  P.G.wn = (unsigned short*)(dyn + 48 * MB);
  P.G.uo = (unsigned short*)(dyn + 80 * MB);
  P.G.gsc = (float*)(dyn + 112 * MB);
  P.yb = (unsigned short*)(dyn);
  P.scores = (unsigned short*)(dyn);
  P.idxb = (int*)(dyn + 64 * MB);
  P.gateb = (float*)(dyn + 72 * MB);
  char* os = (char*)d_out;
  P.oM = (unsigned short*)(os);
  P.qkv_dbg = (unsigned short*)(os + 32 * MB);
  P.oA_dbg = (unsigned short*)(os + 44 * MB);

  static int grid_blocks = 0;
  if (!grid_blocks) {
    int dev = 0, cus = 0, per_cu = 0;
    (void)hipGetDevice(&dev);
    (void)hipDeviceGetAttribute(&cus, hipDeviceAttributeMultiprocessorCount, dev);
    (void)hipOccupancyMaxActiveBlocksPerMultiprocessor(&per_cu, k_mega, 256, 0);
    if (per_cu > 2) per_cu = 2;
    if (per_cu < 1) per_cu = 1;
    grid_blocks = cus * per_cu;
  }
  (void)hipMemsetAsync(P.bar, 0, XCD_BAR_WORDS * sizeof(unsigned), stream);
  hipLaunchKernelGGL(k_mega, dim3(grid_blocks), dim3(256), 0, stream, P);
}
```

```cpp
#include <hip/hip_runtime.h>
#include <hip/hip_bf16.h>
#include <stdint.h>
#include <cstdio>

#define XB_TMO      128
#define XB_XCNT(j)  (256  + 64 * (j))
#define XB_XSUB(j)  (1280 + 64 * (j))
#define XB_XGEN(j)  (2304 + 64 * (j))
#define XB_TOP      3328
#define XB_TOPGEN   3392
#define XCD_BAR_WORDS 3456
#define XB_SPIN_CAP (1u << 18)
#define LAS __attribute__((address_space(3)))

__device__ __forceinline__ unsigned xb_ld(unsigned* p)              { return __hip_atomic_load(p, __ATOMIC_RELAXED, __HIP_MEMORY_SCOPE_AGENT); }
__device__ __forceinline__ unsigned xb_add(unsigned* p, unsigned v) { return __hip_atomic_fetch_add(p, v, __ATOMIC_RELAXED, __HIP_MEMORY_SCOPE_AGENT); }
__device__ __forceinline__ unsigned xb_xcc_id() { return (unsigned)__builtin_amdgcn_s_getreg((3 << 11) | 20) & 0xFu; }
#define XB_SPIN(cond, bar) do { unsigned _sp = 0; while (cond) { __builtin_amdgcn_s_sleep(1); \
    if ((++_sp & 255u) == 0u) { if (xb_ld(&(bar)[XB_TMO])) break; if (_sp > XB_SPIN_CAP) { atomicAdd(&(bar)[XB_TMO], 1u); break; } } } } while (0)

struct XcdBarrier {
    unsigned* bar; unsigned x;
    volatile LAS unsigned* st;
};

__device__ __forceinline__ XcdBarrier xcd_barrier_post(unsigned* bar, volatile LAS unsigned* st) {
    XcdBarrier b; b.bar = bar; b.x = xb_xcc_id(); b.st = st;
    if (threadIdx.x == 0) (void)xb_add(&bar[XB_XCNT(b.x)], 1u);
    return b;
}
__device__ __forceinline__ void xcd_barrier_complete(unsigned* bar, unsigned x, unsigned& nloc, unsigned& nx) {
    const unsigned G = gridDim.x * gridDim.y * gridDim.z;
    unsigned sum, cnt, mine, sp = 0u;
    for (;;) {
        sum = 0u; cnt = 0u; mine = 0u;
#pragma unroll
        for (unsigned j = 0; j < 16; ++j) { const unsigned c = xb_ld(&bar[XB_XCNT(j)]); sum += c; cnt += (c > 0u) ? 1u : 0u; mine = (j == x) ? c : mine; }
        if (sum == G) break;
        __builtin_amdgcn_s_sleep(1);
        if ((++sp & 255u) == 0u) { if (xb_ld(&bar[XB_TMO])) break; if (sp > XB_SPIN_CAP) { atomicAdd(&bar[XB_TMO], 1u); break; } }
    }
    nloc = mine > 0u ? mine : 1u; nx = cnt > 0u ? cnt : 1u;
}

__device__ __forceinline__ void xcd_barrier(const XcdBarrier& b) {
    asm volatile("s_waitcnt vmcnt(0)" ::: "memory");
    __syncthreads();
    if (threadIdx.x == 0) {
        unsigned* bar = b.bar;
        __builtin_amdgcn_s_waitcnt(0);
        unsigned nloc = b.st[0], nx = b.st[1];
        if (nloc == 0u) { xcd_barrier_complete(bar, b.x, nloc, nx); b.st[0] = nloc; b.st[1] = nx; }
        const unsigned old = xb_add(&bar[XB_XSUB(b.x)], 1u);
        const unsigned gen = old / nloc;
        if (old + 1u == (gen + 1u) * nloc) {
            __builtin_amdgcn_fence(__ATOMIC_RELEASE, "agent");
            asm volatile("s_waitcnt vmcnt(0)" ::: "memory");
            const unsigned og = xb_add(&bar[XB_TOP], 1u);
            const unsigned tg = og / nx;
            if (og + 1u == (tg + 1u) * nx) xb_add(&bar[XB_TOPGEN], 1u);
            else XB_SPIN(xb_ld(&bar[XB_TOPGEN]) == tg, bar);
            __builtin_amdgcn_fence(__ATOMIC_ACQUIRE, "agent");
            xb_add(&bar[XB_XGEN(b.x)], 1u);
            asm volatile("s_waitcnt vmcnt(0)" ::: "memory");
        } else {
            XB_SPIN(xb_ld(&bar[XB_XGEN(b.x)]) == gen, bar);
            __builtin_amdgcn_fence(__ATOMIC_ACQUIRE, "agent");
            asm volatile("s_waitcnt vmcnt(0)" ::: "memory");
        }
    }
    __syncthreads();
}


typedef __hip_bfloat16 bf16;
typedef __attribute__((ext_vector_type(8))) short bf16x8;
typedef __attribute__((ext_vector_type(4))) float f32x4;

constexpr int DM = 1024;
constexpr int NB = 4;
constexpr int SEQ = 4096;
constexpr int NT = NB * SEQ;
constexpr int DIN = 4128;
constexpr int NPAD_IN = 4224;
constexpr float EPSF = 1e-6f;

__device__ __forceinline__ float bf2f(unsigned short u) { return __uint_as_float(((unsigned)u) << 16); }
typedef __bf16 bf16x2_t __attribute__((ext_vector_type(2)));
typedef float f32x2_t __attribute__((ext_vector_type(2)));
__device__ __forceinline__ unsigned short f2bf(float f) { return __builtin_bit_cast(unsigned short, (__bf16)f); }
__device__ __forceinline__ unsigned pack2(float a, float b) {
  f32x2_t v = {a, b};
  return __builtin_bit_cast(unsigned, __builtin_convertvector(v, bf16x2_t));
}
__device__ __forceinline__ float wave_sum(float v) {
#pragma unroll
  for (int o = 32; o > 0; o >>= 1) v += __shfl_xor(v, o, 64);
  return v;
}
__device__ __forceinline__ float softplusf(float x) { return fmaxf(x, 0.f) + log1pf(expf(-fabsf(x))); }
__device__ __forceinline__ float sigmoidf(float x) { return 1.f / (1.f + expf(-x)); }

__device__ __forceinline__ void d_prep_x(int item, const float* __restrict__ x, unsigned short* __restrict__ xb,
                                                float* __restrict__ rs) {
  int t = item * 4 + (threadIdx.x >> 6);
  int lane = threadIdx.x & 63;
  const float4* xr = (const float4*)(x + (size_t)t * DM);
  float ss = 0.f;
#pragma unroll
  for (int i = 0; i < 4; ++i) {
    float4 v = xr[lane + 64 * i];
    ss += v.x * v.x + v.y * v.y + v.z * v.z + v.w * v.w;
    ushort4 o;
    o.x = f2bf(v.x); o.y = f2bf(v.y); o.z = f2bf(v.z); o.w = f2bf(v.w);
    ((ushort4*)(xb + (size_t)t * DM))[lane + 64 * i] = o;
  }
  ss = wave_sum(ss);
  if (lane == 0) rs[t] = rsqrtf(ss * (1.f / DM) + EPSF);
}

__device__ __forceinline__ int win_src(int n) {
  if (n < 2048) return n;
  if (n < 4096) return n + 16;
  int j = n - 4096;
  if (j < 16) return 2048 + j;
  if (j < 32) return 4112 + (j - 16);
  return -1;
}
__device__ __forceinline__ void d_transpose_w(int item, int ntn, float* tile, const float* __restrict__ in, int ldn,
                                              const float* __restrict__ g, unsigned short* __restrict__ out, int mode) {
  const int kt = item / ntn, nt = item % ntn;
  const int tid = threadIdx.x;
  __syncthreads();
#pragma unroll
  for (int i = 0; i < 4; ++i) {
    const int row = (tid >> 4) + 16 * i;
    const int c4 = (tid & 15) * 4;
    const int n = nt * 64 + c4;
    const int src = mode ? win_src(n) : n;
    float4 v = make_float4(0.f, 0.f, 0.f, 0.f);
    if (src >= 0) {
      v = *(const float4*)(in + (size_t)(kt * 64 + row) * ldn + src);
      if (g) { const float gg = g[kt * 64 + row]; v.x *= gg; v.y *= gg; v.z *= gg; v.w *= gg; }
    }
    tile[row * 65 + c4] = v.x; tile[row * 65 + c4 + 1] = v.y; tile[row * 65 + c4 + 2] = v.z; tile[row * 65 + c4 + 3] = v.w;
  }
  __syncthreads();
  {
    const int n = tid >> 2, k16 = (tid & 3) * 16;
    uint4 o0, o1;
    o0.x = pack2(tile[(k16 + 0) * 65 + n], tile[(k16 + 1) * 65 + n]);   o0.y = pack2(tile[(k16 + 2) * 65 + n], tile[(k16 + 3) * 65 + n]);
    o0.z = pack2(tile[(k16 + 4) * 65 + n], tile[(k16 + 5) * 65 + n]);   o0.w = pack2(tile[(k16 + 6) * 65 + n], tile[(k16 + 7) * 65 + n]);
    o1.x = pack2(tile[(k16 + 8) * 65 + n], tile[(k16 + 9) * 65 + n]);   o1.y = pack2(tile[(k16 + 10) * 65 + n], tile[(k16 + 11) * 65 + n]);
    o1.z = pack2(tile[(k16 + 12) * 65 + n], tile[(k16 + 13) * 65 + n]); o1.w = pack2(tile[(k16 + 14) * 65 + n], tile[(k16 + 15) * 65 + n]);
    unsigned short* op = out + (size_t)(nt * 64 + n) * DM + kt * 64 + k16;
    *(uint4*)op = o0;
    *(uint4*)(op + 8) = o1;
  }
}
__device__ __forceinline__ void d_cvt_bf16(int item, const float* __restrict__ src, unsigned short* __restrict__ dst,
                                           const float* __restrict__ rowscale, int rowlen_log2) {
  const size_t base = (size_t)item * 2048 + threadIdx.x * 8;
  float4 a = *(const float4*)(src + base);
  float4 b = *(const float4*)(src + base + 4);
  if (rowscale) {
    const float sc = rowscale[base >> rowlen_log2];
    a.x *= sc; a.y *= sc; a.z *= sc; a.w *= sc; b.x *= sc; b.y *= sc; b.z *= sc; b.w *= sc;
  }
  uint4 o;
  o.x = pack2(a.x, a.y); o.y = pack2(a.z, a.w); o.z = pack2(b.x, b.y); o.w = pack2(b.z, b.w);
  *(uint4*)(dst + base) = o;
}

constexpr int GBM = 128, GBN = 128, GBK = 64, GLD = 72;
struct GemmP {
  const unsigned short* A; const unsigned short* Bt; int lda, ldb, K;
  const float* rowscale;
  unsigned short* obf; int ldo;
  float* of32; int ldf;
  const float* resid;
  const float *a_log, *dt_bias, *i_bias, *f_bias;
  float* rowacc;
};
enum { EPI_INPROJ = 0, EPI_OUTPROJ = 1, EPI_SCORES = 2, EPI_PLAIN = 3 };

template <int EPI>
__device__ __forceinline__ void gemm_tile(const GemmP p, int tm, int tn, unsigned short* smem) {
  unsigned short* As = smem;
  unsigned short* Bs = smem + 2 * GBM * GLD;
  int tid = threadIdx.x;
  asm volatile("" : "+v"(tid));
  const int lane = tid & 63, wid = tid >> 6;
  const int wm = wid >> 1, wn = wid & 1;
  const int m0 = tm * GBM, n0 = tn * GBN;
  f32x4 acc[4][4];
#pragma unroll
  for (int i = 0; i < 4; ++i)
#pragma unroll
    for (int j = 0; j < 4; ++j) acc[i][j] = (f32x4){0.f, 0.f, 0.f, 0.f};

  uint4 ra0, ra1, ra2, ra3, rb0, rb1, rb2, rb3;
  uint4 sa0, sa1, sa2, sa3, sb0, sb1, sb2, sb3;
  const int nk = p.K / GBK;
  const int lrow = tid >> 3, lc8 = tid & 7;
  const unsigned short* Ag = p.A + (size_t)(m0 + lrow) * p.lda + lc8 * 8;
  const unsigned short* Bg = p.Bt + (size_t)(n0 + lrow) * p.ldb + lc8 * 8;
  const size_t a32 = (size_t)32 * p.lda, b32 = (size_t)32 * p.ldb;
#define GLOAD(R, S, kt)                                                  \
  {                                                                      \
    R##0 = *(const uint4*)(Ag + (kt) * GBK);                             \
    R##1 = *(const uint4*)(Ag + a32 + (kt) * GBK);                       \
    R##2 = *(const uint4*)(Ag + 2 * a32 + (kt) * GBK);                   \
    R##3 = *(const uint4*)(Ag + 3 * a32 + (kt) * GBK);                   \
    S##0 = *(const uint4*)(Bg + (kt) * GBK);                             \
    S##1 = *(const uint4*)(Bg + b32 + (kt) * GBK);                       \
    S##2 = *(const uint4*)(Bg + 2 * b32 + (kt) * GBK);                   \
    S##3 = *(const uint4*)(Bg + 3 * b32 + (kt) * GBK);                   \
  }
#define SSTORE(R, S, buf)                                                \
  {                                                                      \
    unsigned short* ad = As + (size_t)(buf) * GBM * GLD + lrow * GLD + lc8 * 8; \
    unsigned short* bd = Bs + (size_t)(buf) * GBN * GLD + lrow * GLD + lc8 * 8; \
    *(uint4*)(ad) = R##0; *(uint4*)(ad + 32 * GLD) = R##1; *(uint4*)(ad + 64 * GLD) = R##2; *(uint4*)(ad + 96 * GLD) = R##3; \
    *(uint4*)(bd) = S##0; *(uint4*)(bd + 32 * GLD) = S##1; *(uint4*)(bd + 64 * GLD) = S##2; *(uint4*)(bd + 96 * GLD) = S##3; \
  }
#define GCOMPUTE(buf)                                                                                                     \
  {                                                                                                                       \
    const unsigned short* Ab = As + (size_t)(buf) * GBM * GLD;                                                            \
    const unsigned short* Bb = Bs + (size_t)(buf) * GBN * GLD;                                                            \
    _Pragma("unroll") for (int ks = 0; ks < 2; ++ks) {                                                                    \
      bf16x8 a[4], b[4];                                                                                                  \
      const int kc = ks * 32 + (lane >> 4) * 8;                                                                           \
      _Pragma("unroll") for (int i = 0; i < 4; ++i) a[i] = *(const bf16x8*)(Ab + (wm * 64 + i * 16 + (lane & 15)) * GLD + kc); \
      _Pragma("unroll") for (int j = 0; j < 4; ++j) b[j] = *(const bf16x8*)(Bb + (wn * 64 + j * 16 + (lane & 15)) * GLD + kc); \
      _Pragma("unroll") for (int i = 0; i < 4; ++i)                                                                       \
        _Pragma("unroll") for (int j = 0; j < 4; ++j)                                                                     \
          acc[i][j] = __builtin_amdgcn_mfma_f32_16x16x32_bf16(b[j], a[i], acc[i][j], 0, 0, 0);               \
    }                                                                                                                     \
  }
  GLOAD(ra, rb, 0);
  if (nk > 1) GLOAD(sa, sb, 1);
  SSTORE(ra, rb, 0);
  __syncthreads();
  for (int kt = 0; kt < nk; kt += 2) {
    if (kt + 2 < nk) GLOAD(ra, rb, kt + 2);
    GCOMPUTE(0);
    if (kt + 1 < nk) SSTORE(sa, sb, 1);
    __syncthreads();
    if (kt + 1 < nk) {
      if (kt + 3 < nk) GLOAD(sa, sb, kt + 3);
      GCOMPUTE(1);
      if (kt + 2 < nk) SSTORE(ra, rb, 0);
      __syncthreads();
    }
  }
#undef GLOAD
#undef SSTORE
#undef GCOMPUTE
#pragma unroll
  for (int i = 0; i < 4; ++i) {
    const int row = m0 + wm * 64 + i * 16 + (lane & 15);
    float rsc = 1.f;
    float rowss = 0.f;
    if (EPI == EPI_INPROJ) rsc = p.rowscale[row];
    if (EPI == EPI_SCORES) {
      const float4* pr = (const float4*)(p.rowscale + (size_t)row * 16);
      const float4 s0 = pr[0], s1 = pr[1], s2 = pr[2], s3 = pr[3];
      const float ssq = ((s0.x + s0.y) + (s0.z + s0.w)) + ((s1.x + s1.y) + (s1.z + s1.w)) + ((s2.x + s2.y) + (s2.z + s2.w)) + ((s3.x + s3.y) + (s3.z + s3.w));
      rsc = rsqrtf(ssq * (1.f / DM) + EPSF);
    }
#pragma unroll
    for (int j = 0; j < 4; ++j) {
      const int col0 = n0 + wn * 64 + j * 16 + (lane >> 4) * 4;
      const float v0 = acc[i][j][0] * rsc, v1 = acc[i][j][1] * rsc, v2 = acc[i][j][2] * rsc, v3 = acc[i][j][3] * rsc;
      if (EPI == EPI_INPROJ) {
        if (col0 < 4096) {
          uint2 pk; pk.x = pack2(v0, v1); pk.y = pack2(v2, v3);
          *(uint2*)(p.obf + (size_t)row * p.ldo + col0) = pk;
        } else if (col0 < 4128) {
          const float vv[4] = {v0, v1, v2, v3};
          float oo[4];
#pragma unroll
          for (int r = 0; r < 4; ++r) {
            const int jg = col0 - 4096 + r, jj = jg & 7;
            const float v = vv[r];
            float o;
            if (jg < 8) o = -expf(p.a_log[jj]) * softplusf(v + p.dt_bias[jj]);
            else if (jg < 16) o = sigmoidf(v);
            else if (jg < 24) o = v + p.i_bias[jj];
            else o = -softplusf(-(v + p.f_bias[jj]));
            oo[r] = o;
          }
          *(float4*)(p.of32 + (size_t)row * p.ldf + (col0 - 4096)) = make_float4(oo[0], oo[1], oo[2], oo[3]);
        }
      } else if (EPI == EPI_OUTPROJ) {
        const float4 xr = *(const float4*)(p.resid + (size_t)row * p.ldf + col0);
        const float x0 = v0 + xr.x, x1 = v1 + xr.y, x2 = v2 + xr.z, x3 = v3 + xr.w;
        *(float4*)(p.of32 + (size_t)row * p.ldf + col0) = make_float4(x0, x1, x2, x3);
        uint2 pk; pk.x = pack2(x0, x1); pk.y = pack2(x2, x3);
        *(uint2*)(p.obf + (size_t)row * p.ldo + col0) = pk;
        rowss += (x0 * x0 + x1 * x1) + (x2 * x2 + x3 * x3);
      } else {
        uint2 pk; pk.x = pack2(v0, v1); pk.y = pack2(v2, v3);
        *(uint2*)(p.obf + (size_t)row * p.ldo + col0) = pk;
      }
    }
    if (EPI == EPI_OUTPROJ) {
      rowss += __shfl_xor(rowss, 16, 64);
      rowss += __shfl_xor(rowss, 32, 64);
      if ((lane >> 4) == 0) p.rowacc[(size_t)row * 16 + tn * 2 + wn] = rowss;
    }
  }
}

__device__ __forceinline__ bool xcd_tile(int bid, int nb, int k, int ntn, int& tm, int& tn) {
  const int q = (bid >> 3) + (nb >> 3) * k;
  if (q >= 16 * ntn) return false;
  const int g = q / (8 * ntn), rem = q % (8 * ntn);
  tn = rem >> 3;
  tm = 16 * (bid & 7) + 8 * g + (rem & 7);
  return true;
}

__device__ __forceinline__ void d_conv(int item, const unsigned short* __restrict__ pm, const float* __restrict__ pg,
                                              const float* __restrict__ conv_w, const float* __restrict__ a_log,
                                              const float* __restrict__ dt_bias, const float* __restrict__ i_bias,
                                              const float* __restrict__ f_bias, unsigned short* __restrict__ qkv,
                                              float* __restrict__ gt) {
  int t = item * 4 + (threadIdx.x >> 6);
  int lane = threadIdx.x & 63;
  int s = t & (SEQ - 1);
  for (int sec = 0; sec < 3; ++sec) {
    for (int h = 0; h < 4; ++h) {
      int c0 = sec * 512 + h * 128 + 2 * lane;
      float a0 = 0.f, a1 = 0.f;
#pragma unroll
      for (int j = 0; j < 5; ++j) {
        int sp = s + j - 2;
        if (sp >= 0 && sp < SEQ) {
          unsigned v = *(const unsigned*)(pm + (size_t)(t + j - 2) * 4096 + c0);
          a0 += conv_w[c0 * 5 + j] * bf2f((unsigned short)(v & 0xffff));
          a1 += conv_w[(c0 + 1) * 5 + j] * bf2f((unsigned short)(v >> 16));
        }
      }
      a0 = a0 * sigmoidf(a0);
      a1 = a1 * sigmoidf(a1);
      if (sec < 2) {
        float ss = wave_sum(a0 * a0 + a1 * a1);
        float sc = rsqrtf(ss + EPSF);
        if (sec == 0) sc *= 0.08838834764831845f;
        a0 *= sc; a1 *= sc;
      }
      unsigned o = pack2(a0, a1);
      *(unsigned*)(qkv + (size_t)t * 1536 + c0) = o;
    }
  }
}

__device__ __forceinline__ void d_gdn_rec(int chain, float* sq, float* sk, const unsigned short* __restrict__ qkv,
                                                 const float* __restrict__ gt, unsigned short* __restrict__ oA, int ntok) {
  const int bh = chain >> 1, dir = chain & 1;
  const int b = bh >> 2, h = bh & 3;
  const int e = threadIdx.x & 127;
  float S[128];
#pragma unroll
  for (int d = 0; d < 128; ++d) S[d] = 0.f;
  for (int it = 0; it < SEQ; ++it) {
    const int s = dir ? (SEQ - 1 - it) : it;
    const size_t t = (size_t)b * SEQ + s;
    __syncthreads();
    sq[e] = bf2f(qkv[t * 1536 + h * 128 + e]);
    sk[e] = bf2f(qkv[t * 1536 + 512 + h * 128 + e]);
    const float v = bf2f(qkv[t * 1536 + 1024 + h * 128 + e]);
    const float g = gt[t * 32 + dir * 4 + h];
    const float beta = gt[t * 32 + 8 + dir * 4 + h];
    __syncthreads();
    const float a = expf(g);
    float k0 = 0.f, k1 = 0.f, k2 = 0.f, k3 = 0.f;
#pragma unroll
    for (int d = 0; d < 128; d += 4) {
      k0 += sk[d] * S[d]; k1 += sk[d + 1] * S[d + 1]; k2 += sk[d + 2] * S[d + 2]; k3 += sk[d + 3] * S[d + 3];
    }
    const float kS = a * ((k0 + k1) + (k2 + k3));
    const float vn = beta * (v - kS);
    float o0 = 0.f, o1 = 0.f, o2 = 0.f, o3 = 0.f;
#pragma unroll
    for (int d = 0; d < 128; d += 4) {
      S[d] = a * S[d] + sk[d] * vn;             o0 += sq[d] * S[d];
      S[d + 1] = a * S[d + 1] + sk[d + 1] * vn; o1 += sq[d + 1] * S[d + 1];
      S[d + 2] = a * S[d + 2] + sk[d + 2] * vn; o2 += sq[d + 2] * S[d + 2];
      S[d + 3] = a * S[d + 3] + sk[d + 3] * vn; o3 += sq[d + 3] * S[d + 3];
    }
    oA[((size_t)dir * ntok + t) * 512 + h * 128 + e] = f2bf((o0 + o1) + (o2 + o3));
  }
}

__device__ __forceinline__ void d_mlstm_rec(int chain, float* sq, float* sk, const unsigned short* __restrict__ pm,
                                                   const float* __restrict__ gt, unsigned short* __restrict__ oM, int ntok) {
  const int bh = chain >> 1, dir = chain & 1;
  const int b = bh >> 2, h = bh & 3;
  const int e = threadIdx.x & 127, lane = e & 63;
  float C[128];
#pragma unroll
  for (int d = 0; d < 128; ++d) C[d] = 0.f;
  float n0 = 0.f, n1 = 0.f, m = 0.f;
  for (int it = 0; it < SEQ; ++it) {
    const int s = dir ? (SEQ - 1 - it) : it;
    const size_t t = (size_t)b * SEQ + s;
    __syncthreads();
    sq[e] = bf2f(pm[t * 4096 + 2048 + h * 128 + e]);
    sk[e] = bf2f(pm[t * 4096 + 2560 + h * 128 + e]) * 0.08838834764831845f;
    const float v = bf2f(pm[t * 4096 + 3072 + h * 128 + e]);
    const float ip = gt[t * 32 + 16 + dir * 4 + h];
    const float lf = gt[t * 32 + 24 + dir * 4 + h];
    __syncthreads();
    const float mn = fmaxf(lf + m, ip);
    const float fs = expf(lf + m - mn);
    const float is = expf(ip - mn);
    m = mn;
    n0 = fs * n0 + is * sk[lane];
    n1 = fs * n1 + is * sk[lane + 64];
    const float den = wave_sum(n0 * sq[lane] + n1 * sq[lane + 64]);
    const float iv = is * v;
    float o0 = 0.f, o1 = 0.f, o2 = 0.f, o3 = 0.f;
#pragma unroll
    for (int d = 0; d < 128; d += 4) {
      C[d] = fs * C[d] + sk[d] * iv;             o0 += sq[d] * C[d];
      C[d + 1] = fs * C[d + 1] + sk[d + 1] * iv; o1 += sq[d + 1] * C[d + 1];
      C[d + 2] = fs * C[d + 2] + sk[d + 2] * iv; o2 += sq[d + 2] * C[d + 2];
      C[d + 3] = fs * C[d + 3] + sk[d + 3] * iv; o3 += sq[d + 3] * C[d + 3];
    }
    const float num = (o0 + o1) + (o2 + o3);
    const float hh = num / fmaxf(fabsf(den), expf(-mn));
    oM[((size_t)dir * ntok + t) * 512 + h * 128 + e] = f2bf(hh);
  }
}

__device__ __forceinline__ void d_combine(int item, const unsigned short* __restrict__ uo, const unsigned short* __restrict__ oM,
                                                 const unsigned short* __restrict__ pm, const float* __restrict__ gdn_g,
                                                 const float* __restrict__ ml_g, unsigned short* __restrict__ y) {
  int t = item * 4 + (threadIdx.x >> 6);
  int lane = threadIdx.x & 63;
  const int b = t >> 12, cc = (t >> 6) & 63, ii = t & 63;
  for (int h = 0; h < 4; ++h) {
    int c = h * 128 + 2 * lane;
    {
      const int chain0 = (b * 4 + h) * 2;
      const size_t off = (size_t)cc * 8192 + (lane >> 4) * 2048 + ii * 32 + ((2 * lane) & 31);
      unsigned vf = *(const unsigned*)(uo + (size_t)chain0 * 64 * 8192 + off);
      unsigned vb = *(const unsigned*)(uo + (size_t)(chain0 + 1) * 64 * 8192 + off);
      float o0 = bf2f(vf & 0xffff) + bf2f(vb & 0xffff);
      float o1 = bf2f(vf >> 16) + bf2f(vb >> 16);
      float ss = wave_sum(o0 * o0 + o1 * o1);
      float sc = rsqrtf(ss * (1.f / 128.f) + EPSF);
      unsigned z = *(const unsigned*)(pm + (size_t)t * 4096 + 1536 + c);
      float z0 = bf2f(z & 0xffff), z1 = bf2f(z >> 16);
      o0 = o0 * sc * gdn_g[2 * lane] * (z0 * sigmoidf(z0));
      o1 = o1 * sc * gdn_g[2 * lane + 1] * (z1 * sigmoidf(z1));
      *(unsigned*)(y + (size_t)t * DM + c) = pack2(o0, o1);
    }
    {
      unsigned vf = *(const unsigned*)(oM + (size_t)t * 512 + c);
      unsigned vb = *(const unsigned*)(oM + ((size_t)NT + t) * 512 + c);
      float o0 = bf2f(vf & 0xffff) + bf2f(vb & 0xffff);
      float o1 = bf2f(vf >> 16) + bf2f(vb >> 16);
      float ss = wave_sum(o0 * o0 + o1 * o1);
      float sc = rsqrtf(ss * (1.f / 128.f) + EPSF);
      unsigned z = *(const unsigned*)(pm + (size_t)t * 4096 + 3584 + c);
      float z0 = bf2f(z & 0xffff), z1 = bf2f(z >> 16);
      o0 = o0 * sc * ml_g[c] * sigmoidf(z0);
      o1 = o1 * sc * ml_g[c + 1] * sigmoidf(z1);
      *(unsigned*)(y + (size_t)t * DM + 512 + c) = pack2(o0, o1);
    }
  }
}

#ifdef DBG_CHECK
__device__ __forceinline__ void d_dbg_cmp(int item, const unsigned short* __restrict__ uo, const unsigned short* __restrict__ oAd,
                                          float* __restrict__ dbg) {
  int t = item * 4 + (threadIdx.x >> 6);
  int lane = threadIdx.x & 63;
  const int cc = (t >> 6) & 63, ii = t & 63;
  float sd = 0.f, sr = 0.f;
  for (int h = 0; h < 4; ++h) {
    for (int dir = 0; dir < 2; ++dir) {
      const int chain = h * 2 + dir;
      const size_t off = (size_t)cc * 8192 + (lane >> 4) * 2048 + ii * 32 + ((2 * lane) & 31);
      unsigned vn = *(const unsigned*)(uo + (size_t)chain * 64 * 8192 + off);
      unsigned vr = *(const unsigned*)(oAd + ((size_t)dir * 4096 + t) * 512 + h * 128 + 2 * lane);
      float n0 = bf2f(vn & 0xffff), n1 = bf2f(vn >> 16), r0 = bf2f(vr & 0xffff), r1 = bf2f(vr >> 16);
      sd += (n0 - r0) * (n0 - r0) + (n1 - r1) * (n1 - r1);
      sr += r0 * r0 + r1 * r1;
    }
  }
  sd = wave_sum(sd); sr = wave_sum(sr);
  if (lane == 0) { atomicAdd(&dbg[0], sd); atomicAdd(&dbg[1], sr); }
}
__device__ __forceinline__ void d_dbg_cmp_m(int item, const unsigned short* __restrict__ oM, const unsigned short* __restrict__ oMd,
                                            float* __restrict__ dbg) {
  int t = item * 4 + (threadIdx.x >> 6);
  int lane = threadIdx.x & 63;
  float sd = 0.f, sr = 0.f;
  for (int dir = 0; dir < 2; ++dir)
    for (int q = 0; q < 4; ++q) {
      unsigned vn = *(const unsigned*)(oM + ((size_t)dir * NT + t) * 512 + q * 128 + 2 * lane);
      unsigned vr = *(const unsigned*)(oMd + ((size_t)dir * 4096 + t) * 512 + q * 128 + 2 * lane);
      float n0 = bf2f(vn & 0xffff), n1 = bf2f(vn >> 16), r0 = bf2f(vr & 0xffff), r1 = bf2f(vr >> 16);
      sd += (n0 - r0) * (n0 - r0) + (n1 - r1) * (n1 - r1);
      sr += r0 * r0 + r1 * r1;
    }
  sd = wave_sum(sd); sr = wave_sum(sr);
  if (lane == 0) { atomicAdd(&dbg[0], sd); atomicAdd(&dbg[1], sr); }
}
#endif

__device__ __forceinline__ void d_prep_x1(int item, const float* __restrict__ x1, unsigned short* __restrict__ xb,
                                                 float* __restrict__ rs) {
  int t = item * 4 + (threadIdx.x >> 6);
  int lane = threadIdx.x & 63;
  const float4* xr = (const float4*)(x1 + (size_t)t * DM);
  float ss = 0.f;
#pragma unroll
  for (int i = 0; i < 4; ++i) {
    float4 v = xr[lane + 64 * i];
    ss += v.x * v.x + v.y * v.y + v.z * v.z + v.w * v.w;
    ushort4 o;
    o.x = f2bf(v.x); o.y = f2bf(v.y); o.z = f2bf(v.z); o.w = f2bf(v.w);
    ((ushort4*)(xb + (size_t)t * DM))[lane + 64 * i] = o;
  }
  ss = wave_sum(ss);
  if (lane == 0) rs[t] = rsqrtf(ss * (1.f / DM) + EPSF);
}

__device__ const unsigned char kPairTab[64] = {
    0x00, 0x01, 0x02, 0x03, 0x04, 0x05, 0x06, 0x07, 0x08, 0x09, 0x0a, 0x0b, 0x0c, 0x0d, 0x0e, 0x0f,
    0x10, 0x11, 0x12, 0x13, 0x14, 0x15, 0x16, 0x17,
    0x20, 0x21, 0x22, 0x23, 0x24,
    0x30, 0x31, 0x32, 0x33,
    0x40, 0x41, 0x42,
    0x50, 0x51, 0x60, 0x61, 0x70, 0x71,
    0x80, 0x90, 0xa0, 0xb0, 0xc0, 0xd0, 0xe0, 0xf0,
    0xff, 0xff, 0xff, 0xff, 0xff, 0xff, 0xff, 0xff, 0xff, 0xff, 0xff, 0xff, 0xff, 0xff};

__device__ __forceinline__ void sort16_desc(unsigned (&a)[16]) {
#pragma unroll
  for (int k = 2; k <= 16; k <<= 1)
#pragma unroll
    for (int j = k >> 1; j > 0; j >>= 1)
#pragma unroll
      for (int i = 0; i < 16; ++i) {
        const int l = i ^ j;
        if (l > i) {
          const unsigned hi = max(a[i], a[l]), lo = min(a[i], a[l]);
          if ((i & k) == 0) { a[i] = hi; a[l] = lo; } else { a[i] = lo; a[l] = hi; }
        }
      }
}
__device__ __forceinline__ void merge16_desc(unsigned (&top)[16], const unsigned (&b)[16]) {
#pragma unroll
  for (int i = 0; i < 16; ++i) top[i] = max(top[i], b[15 - i]);
#pragma unroll
  for (int j = 8; j > 0; j >>= 1)
#pragma unroll
    for (int i = 0; i < 16; ++i) {
      const int l = i ^ j;
      if (l > i) {
        const unsigned hi = max(top[i], top[l]), lo = min(top[i], top[l]);
        top[i] = hi; top[l] = lo;
      }
    }
}
__device__ __forceinline__ unsigned key16(unsigned hbits, int idx) {
  const unsigned m = hbits ^ ((hbits & 0x8000u) ? 0xFFFFu : 0x8000u);
  return (m << 16) | (unsigned)(127 - idx);
}
__device__ __forceinline__ void top16_of_128(const unsigned short* __restrict__ sp, unsigned (&top)[16]) {
#pragma unroll
  for (int g = 0; g < 8; ++g) {
    const uint4 x0 = *(const uint4*)(sp + g * 16);
    const uint4 x1 = *(const uint4*)(sp + g * 16 + 8);
    unsigned b[16];
    b[0] = key16(x0.x & 0xffff, g * 16 + 0);  b[1] = key16(x0.x >> 16, g * 16 + 1);
    b[2] = key16(x0.y & 0xffff, g * 16 + 2);  b[3] = key16(x0.y >> 16, g * 16 + 3);
    b[4] = key16(x0.z & 0xffff, g * 16 + 4);  b[5] = key16(x0.z >> 16, g * 16 + 5);
    b[6] = key16(x0.w & 0xffff, g * 16 + 6);  b[7] = key16(x0.w >> 16, g * 16 + 7);
    b[8] = key16(x1.x & 0xffff, g * 16 + 8);  b[9] = key16(x1.x >> 16, g * 16 + 9);
    b[10] = key16(x1.y & 0xffff, g * 16 + 10); b[11] = key16(x1.y >> 16, g * 16 + 11);
    b[12] = key16(x1.z & 0xffff, g * 16 + 12); b[13] = key16(x1.z >> 16, g * 16 + 13);
    b[14] = key16(x1.w & 0xffff, g * 16 + 14); b[15] = key16(x1.w >> 16, g * 16 + 15);
    sort16_desc(b);
    if (g == 0) {
#pragma unroll
      for (int i = 0; i < 16; ++i) top[i] = b[i];
    } else {
      merge16_desc(top, b);
    }
  }
}

__device__ __forceinline__ void d_topk(int item, const unsigned short* __restrict__ scores, int* __restrict__ idx_out,
                                       float* __restrict__ gate_out) {
  const int pair = item * 256 + threadIdx.x;
  const unsigned short* sp = scores + (size_t)pair * 256;
  unsigned k0[16], k1[16];
  top16_of_128(sp, k0);
  top16_of_128(sp + 128, k1);
  float v0[16], v1[16];
  int i0[16], i1[16];
#pragma unroll
  for (int i = 0; i < 16; ++i) {
    const unsigned m0 = k0[i] >> 16, m1 = k1[i] >> 16;
    v0[i] = bf2f((unsigned short)(m0 ^ ((m0 & 0x8000u) ? 0x8000u : 0xFFFFu)));
    v1[i] = bf2f((unsigned short)(m1 ^ ((m1 & 0x8000u) ? 0x8000u : 0xFFFFu)));
    i0[i] = 127 - (int)(k0[i] & 127u);
    i1[i] = 127 - (int)(k1[i] & 127u);
  }
  unsigned top[16];
#pragma unroll
  for (int g = 0; g < 4; ++g) {
    unsigned b[16];
#pragma unroll
    for (int q = 0; q < 16; ++q) {
      const int pr = kPairTab[g * 16 + q];
      if (pr == 0xff) {
        b[q] = 0u;
      } else {
        const int pi = pr >> 4, pj = pr & 15;
        const float sum = v0[pi] + v1[pj];
        const unsigned u = __float_as_uint(sum);
        const unsigned mono = u ^ ((u & 0x80000000u) ? 0xFFFFFFFFu : 0x80000000u);
        b[q] = (mono & 0xFFFFC000u) | (unsigned)(16383 - (i0[pi] * 128 + i1[pj]));
      }
    }
    sort16_desc(b);
    if (g == 0) {
#pragma unroll
      for (int i = 0; i < 16; ++i) top[i] = b[i];
    } else {
      merge16_desc(top, b);
    }
  }
  float ev[16];
  int ci[16];
  float mx = 0.f, sum = 0.f;
#pragma unroll
  for (int i = 0; i < 16; ++i) {
    const unsigned mono = top[i] & 0xFFFFC000u;
    const unsigned u = mono ^ ((mono & 0x80000000u) ? 0x80000000u : 0xFFFFFFFFu);
    const float val = __uint_as_float(u & 0xFFFFC000u);
    ci[i] = 16383 - (int)(top[i] & 16383u);
    if (i == 0) mx = val;
    ev[i] = expf(val - mx);
    sum += ev[i];
  }
  const float inv = 1.f / sum;
#pragma unroll
  for (int q = 0; q < 4; ++q) {
    int4 o; float4 g;
    o.x = ci[4 * q]; o.y = ci[4 * q + 1]; o.z = ci[4 * q + 2]; o.w = ci[4 * q + 3];
    g.x = ev[4 * q] * inv; g.y = ev[4 * q + 1] * inv; g.z = ev[4 * q + 2] * inv; g.w = ev[4 * q + 3] * inv;
    *(int4*)(idx_out + (size_t)pair * 16 + 4 * q) = o;
    *(float4*)(gate_out + (size_t)pair * 16 + 4 * q) = g;
  }
}

typedef float f32x2 __attribute__((ext_vector_type(2)));
__device__ __forceinline__ void d_cvt_tab(int item, const float* __restrict__ src, unsigned* __restrict__ dst8, float* __restrict__ dscale) {
  const int row = item * 4 + (threadIdx.x >> 6);
  const int lane = threadIdx.x & 63;
  const float4* sr = (const float4*)(src + (size_t)row * DM + lane * 16);
  const float4 a = sr[0], b = sr[1], c = sr[2], d = sr[3];
  float m = fmaxf(fmaxf(fmaxf(fabsf(a.x), fabsf(a.y)), fmaxf(fabsf(a.z), fabsf(a.w))),
                  fmaxf(fmaxf(fabsf(b.x), fabsf(b.y)), fmaxf(fabsf(b.z), fabsf(b.w))));
  m = fmaxf(m, fmaxf(fmaxf(fmaxf(fabsf(c.x), fabsf(c.y)), fmaxf(fabsf(c.z), fabsf(c.w))),
                     fmaxf(fmaxf(fabsf(d.x), fabsf(d.y)), fmaxf(fabsf(d.z), fabsf(d.w)))));
#pragma unroll
  for (int o = 32; o > 0; o >>= 1) m = fmaxf(m, __shfl_xor(m, o, 64));
  const float sc = (m > 0.f) ? 240.f / m : 1.f;
  uint4 o;
  int p;
  p = 0; p = __builtin_amdgcn_cvt_pk_fp8_f32(a.x * sc, a.y * sc, p, false); p = __builtin_amdgcn_cvt_pk_fp8_f32(a.z * sc, a.w * sc, p, true); o.x = (unsigned)p;
  p = 0; p = __builtin_amdgcn_cvt_pk_fp8_f32(b.x * sc, b.y * sc, p, false); p = __builtin_amdgcn_cvt_pk_fp8_f32(b.z * sc, b.w * sc, p, true); o.y = (unsigned)p;
  p = 0; p = __builtin_amdgcn_cvt_pk_fp8_f32(c.x * sc, c.y * sc, p, false); p = __builtin_amdgcn_cvt_pk_fp8_f32(c.z * sc, c.w * sc, p, true); o.z = (unsigned)p;
  p = 0; p = __builtin_amdgcn_cvt_pk_fp8_f32(d.x * sc, d.y * sc, p, false); p = __builtin_amdgcn_cvt_pk_fp8_f32(d.z * sc, d.w * sc, p, true); o.w = (unsigned)p;
  *(uint4*)(dst8 + (size_t)row * 256 + lane * 4) = o;
  if (lane == 0) dscale[row] = (m > 0.f) ? m * (1.f / 240.f) : 1.f;
}

__device__ __forceinline__ float erf_fast(float x) {
  const float ax = fabsf(x);
  const float t = __builtin_amdgcn_rcpf(1.f + 0.3275911f * ax);
  float p = 1.061405429f;
  p = p * t - 1.453152027f;
  p = p * t + 1.421413741f;
  p = p * t - 0.284496736f;
  p = p * t + 0.254829592f;
  const float e = __builtin_amdgcn_exp2f(-1.4426950408889634f * ax * ax);
  const float r = 1.f - p * t * e;
  return copysignf(r, x);
}
__device__ __forceinline__ float dot16_f8(const uint4 u, const float* hv) {
  const f32x2 a0 = __builtin_amdgcn_cvt_pk_f32_fp8((int)u.x, false), a1 = __builtin_amdgcn_cvt_pk_f32_fp8((int)u.x, true);
  const f32x2 b0 = __builtin_amdgcn_cvt_pk_f32_fp8((int)u.y, false), b1 = __builtin_amdgcn_cvt_pk_f32_fp8((int)u.y, true);
  const f32x2 c0 = __builtin_amdgcn_cvt_pk_f32_fp8((int)u.z, false), c1 = __builtin_amdgcn_cvt_pk_f32_fp8((int)u.z, true);
  const f32x2 d0 = __builtin_amdgcn_cvt_pk_f32_fp8((int)u.w, false), d1 = __builtin_amdgcn_cvt_pk_f32_fp8((int)u.w, true);
  float s0 = a0[0] * hv[0] + a0[1] * hv[1];
  float s1 = a1[0] * hv[2] + a1[1] * hv[3];
  s0 += b0[0] * hv[4] + b0[1] * hv[5];
  s1 += b1[0] * hv[6] + b1[1] * hv[7];
  s0 += c0[0] * hv[8] + c0[1] * hv[9];
  s1 += c1[0] * hv[10] + c1[1] * hv[11];
  s0 += d0[0] * hv[12] + d0[1] * hv[13];
  s1 += d1[0] * hv[14] + d1[1] * hv[15];
  return s0 + s1;
}
__device__ __forceinline__ void axpy16_f8(const uint4 v, const float wg, float* acc) {
  const f32x2 a0 = __builtin_amdgcn_cvt_pk_f32_fp8((int)v.x, false), a1 = __builtin_amdgcn_cvt_pk_f32_fp8((int)v.x, true);
  const f32x2 b0 = __builtin_amdgcn_cvt_pk_f32_fp8((int)v.y, false), b1 = __builtin_amdgcn_cvt_pk_f32_fp8((int)v.y, true);
  const f32x2 c0 = __builtin_amdgcn_cvt_pk_f32_fp8((int)v.z, false), c1 = __builtin_amdgcn_cvt_pk_f32_fp8((int)v.z, true);
  const f32x2 d0 = __builtin_amdgcn_cvt_pk_f32_fp8((int)v.w, false), d1 = __builtin_amdgcn_cvt_pk_f32_fp8((int)v.w, true);
  acc[0] += wg * a0[0]; acc[1] += wg * a0[1]; acc[2] += wg * a1[0]; acc[3] += wg * a1[1];
  acc[4] += wg * b0[0]; acc[5] += wg * b0[1]; acc[6] += wg * b1[0]; acc[7] += wg * b1[1];
  acc[8] += wg * c0[0]; acc[9] += wg * c0[1]; acc[10] += wg * c1[0]; acc[11] += wg * c1[1];
  acc[12] += wg * d0[0]; acc[13] += wg * d0[1]; acc[14] += wg * d1[0]; acc[15] += wg * d1[1];
}
__device__ __forceinline__ void d_peer(int item, const float* __restrict__ x1, const float* __restrict__ rs2,
                                       const float* __restrict__ g2, const int* __restrict__ idx,
                                       const float* __restrict__ gate, const unsigned* __restrict__ pu,
                                       const unsigned* __restrict__ pv, const float* __restrict__ su,
                                       const float* __restrict__ sv, const float* __restrict__ gf,
                                       float* __restrict__ out, float oscale) {
  const int t = item * 4 + (threadIdx.x >> 6);
  const int lane = threadIdx.x & 63;
  float r2;
  {
    const float4* pr = (const float4*)(rs2 + (size_t)t * 16);
    const float4 s0 = pr[0], s1 = pr[1], s2 = pr[2], s3 = pr[3];
    const float ssq = ((s0.x + s0.y) + (s0.z + s0.w)) + ((s1.x + s1.y) + (s1.z + s1.w)) + ((s2.x + s2.y) + (s2.z + s2.w)) + ((s3.x + s3.y) + (s3.z + s3.w));
    r2 = rsqrtf(ssq * (1.f / DM) + EPSF);
  }
  float xv[16], hv[16], acc[16];
#pragma unroll
  for (int q = 0; q < 4; ++q) {
    const float4 xx = *(const float4*)(x1 + (size_t)t * DM + lane * 16 + q * 4);
    const float4 gg = *(const float4*)(g2 + lane * 16 + q * 4);
    xv[q * 4 + 0] = xx.x; xv[q * 4 + 1] = xx.y; xv[q * 4 + 2] = xx.z; xv[q * 4 + 3] = xx.w;
    hv[q * 4 + 0] = xx.x * r2 * gg.x; hv[q * 4 + 1] = xx.y * r2 * gg.y;
    hv[q * 4 + 2] = xx.z * r2 * gg.z; hv[q * 4 + 3] = xx.w * r2 * gg.w;
  }
#pragma unroll
  for (int i = 0; i < 16; ++i) acc[i] = 0.f;
  const int id_a = idx[(size_t)t * 128 + lane], id_b = idx[(size_t)t * 128 + 64 + lane];
  const float gt_a = gate[(size_t)t * 128 + lane], gt_b = gate[(size_t)t * 128 + 64 + lane];
  for (int e0 = 0; e0 < 128; e0 += 8) {
    uint4 u[8], v[8];
    float gt8[8], su8[8], sv8[8];
#pragma unroll
    for (int k = 0; k < 8; ++k) {
      const int e = e0 + k;
      const int id = (e0 < 64) ? __shfl(id_a, e, 64) : __shfl(id_b, e - 64, 64);
      gt8[k] = (e0 < 64) ? __shfl(gt_a, e, 64) : __shfl(gt_b, e - 64, 64);
      u[k] = *(const uint4*)(pu + (size_t)id * 256 + lane * 4);
      v[k] = *(const uint4*)(pv + (size_t)id * 256 + lane * 4);
      su8[k] = su[id];
      sv8[k] = sv[id];
    }
    float d[8];
#pragma unroll
    for (int k = 0; k < 8; ++k) d[k] = dot16_f8(u[k], hv);
#pragma unroll
    for (int o = 32; o > 0; o >>= 1) {
#pragma unroll
      for (int k = 0; k < 8; ++k) d[k] += __shfl_xor(d[k], o, 64);
    }
#pragma unroll
    for (int k = 0; k < 8; ++k) {
      const float dd = d[k] * su8[k];
      const float act = 0.5f * dd * (1.f + erf_fast(dd * 0.7071067811865476f));
      axpy16_f8(v[k], gt8[k] * act * sv8[k], acc);
    }
  }
  float ss = 0.f;
#pragma unroll
  for (int i = 0; i < 16; ++i) { acc[i] += xv[i]; ss += acc[i] * acc[i]; }
  ss = wave_sum(ss);
  const float sc = rsqrtf(ss * (1.f / DM) + EPSF) * oscale;
#pragma unroll
  for (int q = 0; q < 4; ++q) {
    const float4 gg = *(const float4*)(gf + lane * 16 + q * 4);
    float4 o;
    o.x = acc[q * 4 + 0] * sc * gg.x; o.y = acc[q * 4 + 1] * sc * gg.y;
    o.z = acc[q * 4 + 2] * sc * gg.z; o.w = acc[q * 4 + 3] * sc * gg.w;
    *(float4*)(out + (size_t)t * DM + lane * 16 + q * 4) = o;
  }
}

typedef __attribute__((ext_vector_type(16))) float f32x16;
#define MFMA32(a, b, c) __builtin_amdgcn_mfma_f32_32x32x16_bf16((a), (b), (c), 0, 0, 0)
__device__ __forceinline__ int crow(int reg, int hh) { return (reg & 3) + 8 * (reg >> 2) + 4 * hh; }

struct GdnBufs {
  unsigned short* qc;
  unsigned short* kTc;
  unsigned short* qkc;
  unsigned short* wn;
  unsigned short* uo;
  float* gsc;
};

__device__ __forceinline__ void tri_subst(const float* AL0, int lane, float (&T)[64]) {
  const float* AL = (const float*)__builtin_assume_aligned(AL0, 16);
#pragma unroll
  for (int i = 0; i < 64; ++i) T[i] = 0.f;
  T[0] = (lane == 0) ? 1.f : 0.f;
#pragma unroll
  for (int i = 1; i < 64; ++i) {
    float ax = 0.f, ay = 0.f, az = 0.f, aw = 0.f;
#pragma unroll
    for (int j4 = 0; j4 < (i + 3) / 4; ++j4) {
      const float4 a = *(const float4*)(AL + i * 72 + 4 * j4);
      ax += a.x * T[4 * j4]; ay += a.y * T[4 * j4 + 1]; az += a.z * T[4 * j4 + 2]; aw += a.w * T[4 * j4 + 3];
    }
    T[i] = ((lane == i) ? 1.f : 0.f) - ((ax + ay) + (az + aw));
  }
}

__device__ __forceinline__ void d_gdn_prep(int item, char* smem, const unsigned short* __restrict__ pm,
                                           const float* __restrict__ gt, const float* __restrict__ conv_w, GdnBufs G) {
  unsigned short* qL = (unsigned short*)smem;
  unsigned short* kL = qL + 64 * 144;
  unsigned short* kTL = kL + 64 * 144;
  unsigned short* vTL = kTL + 128 * 72;
  float* scal = (float*)(vTL + 128 * 72);
  float* A0 = (float*)qL;
  float* A1 = (float*)kL;
  int tid = threadIdx.x;
  asm volatile("" : "+v"(tid));
  const int lane = tid & 63, w = __builtin_amdgcn_readfirstlane(tid >> 6), r = lane & 31, hh = lane >> 5;
  const int bh = item >> 6, c = item & 63, b = bh >> 2, h = bh & 3;
  const int t0 = b * SEQ + c * 64;
  __syncthreads();
  {
#pragma unroll
    for (int sec = 0; sec < 3; ++sec) {
      const int c0 = sec * 512 + h * 128 + 2 * lane;
      float cw0[5], cw1[5];
#pragma unroll
      for (int j = 0; j < 5; ++j) { cw0[j] = conv_w[c0 * 5 + j]; cw1[j] = conv_w[(c0 + 1) * 5 + j]; }
      unsigned raw[20];
#pragma unroll
      for (int k = 0; k < 20; ++k) {
        const int sp = c * 64 + w * 16 + k - 2;
        raw[k] = (sp >= 0 && sp < SEQ) ? *(const unsigned*)(pm + ((size_t)t0 + w * 16 + k - 2) * 4096 + c0) : 0u;
      }
#pragma unroll
      for (int ii = 0; ii < 16; ++ii) {
        const int i = w * 16 + ii;
        float a0 = 0.f, a1 = 0.f;
#pragma unroll
        for (int j = 0; j < 5; ++j) {
          a0 += cw0[j] * bf2f((unsigned short)(raw[ii + j] & 0xffff));
          a1 += cw1[j] * __uint_as_float(raw[ii + j] & 0xffff0000u);
        }
        a0 = a0 * __builtin_amdgcn_rcpf(1.f + __builtin_amdgcn_exp2f(-1.4426950408889634f * a0));
        a1 = a1 * __builtin_amdgcn_rcpf(1.f + __builtin_amdgcn_exp2f(-1.4426950408889634f * a1));
        if (sec < 2) {
          const float ss = wave_sum(a0 * a0 + a1 * a1);
          float sc = rsqrtf(ss + EPSF);
          if (sec == 0) sc *= 0.08838834764831845f;
          a0 *= sc; a1 *= sc;
        }
        if (sec == 0) {
          *(unsigned*)(qL + i * 144 + 2 * lane) = pack2(a0, a1);
        } else if (sec == 1) {
          const unsigned pk = pack2(a0, a1);
          *(unsigned*)(kL + i * 144 + 2 * lane) = pk;
          kTL[(2 * lane) * 72 + i] = (unsigned short)(pk & 0xffff);
          kTL[(2 * lane + 1) * 72 + i] = (unsigned short)(pk >> 16);
        } else {
          const unsigned pk = pack2(a0, a1);
          vTL[(2 * lane) * 72 + i] = (unsigned short)(pk & 0xffff);
          vTL[(2 * lane + 1) * 72 + i] = (unsigned short)(pk >> 16);
        }
      }
    }
  }
  if (w == 0) {
    const float* gp = gt + ((size_t)t0 + lane) * 32;
    const float g0 = gp[h], g1 = gp[4 + h], b0 = gp[8 + h], b1 = gp[12 + h];
    float G0 = g0, G1 = g1;
#pragma unroll
    for (int o = 1; o < 64; o <<= 1) {
      const float v0 = __shfl_up(G0, o, 64);
      const float v1 = __shfl_down(G1, o, 64);
      if (lane >= o) G0 += v0;
      if (lane + o < 64) G1 += v1;
    }
    scal[lane] = G0 * 1.4426950408889634f; scal[64 + lane] = G1 * 1.4426950408889634f;
    scal[128 + lane] = b0; scal[192 + lane] = b1;
    const float GL0 = __shfl(G0, 63, 64), GL1 = __shfl(G1, 0, 64);
    float* gs0 = G.gsc + ((size_t)((bh * 2 + 0) * 64 + c)) * 192;
    float* gs1 = G.gsc + ((size_t)((bh * 2 + 1) * 64 + c)) * 192;
    gs0[lane] = expf(G0); gs0[64 + lane] = expf(GL0 - G0);
    gs1[lane] = expf(G1); gs1[64 + lane] = expf(GL1 - G1);
    if (lane == 0) { gs0[128] = expf(GL0); gs1[128] = expf(GL1); }
  }
  __syncthreads();
  {
    unsigned short* qg = G.qc + (size_t)item * 8192;
    unsigned short* kg = G.kTc + (size_t)item * 8192;
#pragma unroll
    for (int i = 0; i < 4; ++i) {
      const int id = tid + i * 256;
      *(uint4*)(qg + (id >> 4) * 128 + (id & 15) * 8) = *(const uint4*)(qL + (id >> 4) * 144 + (id & 15) * 8);
      *(uint4*)(kg + (id >> 3) * 64 + (id & 7) * 8) = *(const uint4*)(kTL + (id >> 3) * 72 + (id & 7) * 8);
    }
  }
  {
    const int ta = w >> 1, tb = w & 1;
    f32x16 acc, acc2;
#pragma unroll
    for (int i = 0; i < 16; ++i) { acc[i] = 0.f; acc2[i] = 0.f; }
#pragma unroll
    for (int s = 0; s < 8; ++s) {
      const bf16x8 a = *(const bf16x8*)(kL + (32 * ta + r) * 144 + 16 * s + 8 * hh);
      const bf16x8 bk = *(const bf16x8*)(kL + (32 * tb + r) * 144 + 16 * s + 8 * hh);
      const bf16x8 bq = *(const bf16x8*)(qL + (32 * tb + r) * 144 + 16 * s + 8 * hh);
      acc = MFMA32(a, bk, acc);
      acc2 = MFMA32(a, bq, acc2);
    }
    __syncthreads();
    {
      const int col = 32 * tb + r;
      const float G0c = scal[col], G1c = scal[64 + col];
#pragma unroll
      for (int reg = 0; reg < 16; ++reg) {
        const int row = 32 * ta + crow(reg, hh);
        const float v = acc[reg];
        const float a0 = (col < row) ? scal[128 + row] * v * __builtin_amdgcn_exp2f(scal[row] - G0c) : 0.f;
        const float a1 = (col > row) ? scal[192 + row] * v * __builtin_amdgcn_exp2f(scal[64 + row] - G1c) : 0.f;
        A0[row * 72 + col] = a0;
        A1[(63 - row) * 72 + (63 - col)] = a1;
      }
    }
    {
      const int i = 32 * tb + r;
      const float G0i = scal[i], G1i = scal[64 + i];
      unsigned short* qk0 = G.qkc + ((size_t)((bh * 2 + 0) * 64 + c)) * 4096;
      unsigned short* qk1 = G.qkc + ((size_t)((bh * 2 + 1) * 64 + c)) * 4096;
#pragma unroll
      for (int g = 0; g < 4; ++g) {
        float o0[4], o1[4];
#pragma unroll
        for (int e = 0; e < 4; ++e) {
          const int j = 32 * ta + 8 * g + 4 * hh + e;
          const float v = acc2[4 * g + e];
          o0[e] = (j <= i) ? v * __builtin_amdgcn_exp2f(G0i - scal[j]) : 0.f;
          o1[e] = (j >= i) ? v * __builtin_amdgcn_exp2f(G1i - scal[64 + j]) : 0.f;
        }
        uint2 p0, p1;
        p0.x = pack2(o0[0], o0[1]); p0.y = pack2(o0[2], o0[3]);
        p1.x = pack2(o1[0], o1[1]); p1.y = pack2(o1[2], o1[3]);
        *(uint2*)(qk0 + i * 64 + 32 * ta + 8 * g + 4 * hh) = p0;
        *(uint2*)(qk1 + i * 64 + 32 * ta + 8 * g + 4 * hh) = p1;
      }
    }
  }
  __syncthreads();
  if (w < 2) {
    const int dir = w;
    float T[64];
    tri_subst(A0 + dir * (64 * 72), lane, T);
    const int jn = dir ? 63 - lane : lane;
    const float sb = scal[128 + 64 * dir + jn];
    const float sbg = sb * __builtin_amdgcn_exp2f(scal[64 * dir + jn]);
    unsigned short* Tb = dir ? kL : qL;
    unsigned short* Tbg = Tb + 64 * 72;
#pragma unroll
    for (int ip = 0; ip < 64; ++ip) {
      const int in = dir ? 63 - ip : ip;
      Tb[in * 72 + jn] = f2bf(T[ip] * sb);
      Tbg[in * 72 + jn] = f2bf(T[ip] * sbg);
    }
  }
  __syncthreads();
#pragma unroll
  for (int d = 0; d < 2; ++d) {
    const int chain = bh * 2 + d;
    const unsigned short* Tb = d ? kL : qL;
    const unsigned short* Tbg = Tb + 64 * 72;
    unsigned short* wng = G.wn + ((size_t)(chain * 64 + c)) * 8192;
    unsigned short* uog = G.uo + ((size_t)(chain * 64 + c)) * 8192 + w * 2048;
#pragma unroll
    for (int tb = 0; tb < 2; ++tb) {
      f32x16 acc, acc2;
#pragma unroll
      for (int i = 0; i < 16; ++i) { acc[i] = 0.f; acc2[i] = 0.f; }
#pragma unroll
      for (int s = 0; s < 4; ++s) {
        const bf16x8 a = *(const bf16x8*)(kTL + (32 * w + r) * 72 + 16 * s + 8 * hh);
        const bf16x8 bb = *(const bf16x8*)(Tbg + (32 * tb + r) * 72 + 16 * s + 8 * hh);
        acc = MFMA32(a, bb, acc);
        const bf16x8 a2 = *(const bf16x8*)(Tb + (32 * tb + r) * 72 + 16 * s + 8 * hh);
        const bf16x8 b2 = *(const bf16x8*)(vTL + (32 * w + r) * 72 + 16 * s + 8 * hh);
        acc2 = MFMA32(a2, b2, acc2);
      }
#pragma unroll
      for (int g = 0; g < 4; ++g) {
        uint2 pk;
        pk.x = pack2(-acc[4 * g], -acc[4 * g + 1]); pk.y = pack2(-acc[4 * g + 2], -acc[4 * g + 3]);
        *(uint2*)(wng + (32 * tb + r) * 128 + 32 * w + 8 * g + 4 * hh) = pk;
      }
      uint4 u0, u1;
      u0.x = pack2(acc2[0], acc2[1]); u0.y = pack2(acc2[2], acc2[3]); u0.z = pack2(acc2[4], acc2[5]); u0.w = pack2(acc2[6], acc2[7]);
      u1.x = pack2(acc2[8], acc2[9]); u1.y = pack2(acc2[10], acc2[11]); u1.z = pack2(acc2[12], acc2[13]); u1.w = pack2(acc2[14], acc2[15]);
      *(uint4*)(uog + tb * 1024 + lane * 16) = u0;
      *(uint4*)(uog + tb * 1024 + lane * 16 + 8) = u1;
    }
  }
}

struct GdnOps {
  bf16x8 a[8];
  bf16x8 x[4];
  bf16x8 kt[4];
  float4 rs[4];
  float gtot;
};
__device__ __forceinline__ void gdn_load(GdnOps& o, const GdnBufs& G, int chain, int bh, int c, int sl, int w, int r, int hh, int lane) {
  const unsigned short* kT_c = G.kTc + ((size_t)(bh * 64 + c)) * 8192;
  const float* gs = G.gsc + ((size_t)(chain * 64 + c)) * 192;
  const int ti = w & 1;
#pragma unroll
  for (int s = 0; s < 4; ++s) o.kt[s] = *(const bf16x8*)(kT_c + (32 * w + r) * 64 + 16 * s + 8 * hh);
  o.gtot = gs[128];
  if (w < 2) {
    const unsigned short* wn_c = G.wn + ((size_t)(chain * 64 + c)) * 8192;
    const unsigned short* uo_c = G.uo + ((size_t)(chain * 64 + c)) * 8192 + sl * 2048;
#pragma unroll
    for (int s = 0; s < 8; ++s) o.a[s] = *(const bf16x8*)(wn_c + (32 * ti + r) * 128 + 16 * s + 8 * hh);
    o.x[0] = *(const bf16x8*)(uo_c + ti * 1024 + lane * 16);
    o.x[1] = *(const bf16x8*)(uo_c + ti * 1024 + lane * 16 + 8);
#pragma unroll
    for (int g = 0; g < 4; ++g) o.rs[g] = *(const float4*)(gs + 64 + 32 * ti + 8 * g + 4 * hh);
  } else {
    const unsigned short* q_c = G.qc + ((size_t)(bh * 64 + c)) * 8192;
    const unsigned short* qk_c = G.qkc + ((size_t)(chain * 64 + c)) * 4096;
#pragma unroll
    for (int s = 0; s < 8; ++s) o.a[s] = *(const bf16x8*)(q_c + (32 * ti + r) * 128 + 16 * s + 8 * hh);
#pragma unroll
    for (int s = 0; s < 4; ++s) o.x[s] = *(const bf16x8*)(qk_c + (32 * ti + r) * 64 + 16 * s + 8 * hh);
#pragma unroll
    for (int g = 0; g < 4; ++g) o.rs[g] = *(const float4*)(gs + 32 * ti + 8 * g + 4 * hh);
  }
}
__device__ __forceinline__ void gdn_step(const GdnOps& o, f32x16& S, unsigned short* ST, unsigned short* VT, unsigned short* VdT,
                                         unsigned short* uo_c, int w, int r, int hh) {
  const int ti = w & 1;
  f32x16 acc;
  if (w < 2) {
#pragma unroll
    for (int i = 0; i < 8; ++i) {
      acc[i] = bf2f((unsigned short)o.x[0][i]);
      acc[8 + i] = bf2f((unsigned short)o.x[1][i]);
    }
  } else {
#pragma unroll
    for (int i = 0; i < 16; ++i) acc[i] = 0.f;
  }
#pragma unroll
  for (int g = 0; g < 4; ++g) {
    uint2 pk;
    pk.x = pack2(S[4 * g], S[4 * g + 1]); pk.y = pack2(S[4 * g + 2], S[4 * g + 3]);
    *(uint2*)(ST + r * 136 + 32 * w + 8 * g + 4 * hh) = pk;
  }
  __syncthreads();
#pragma unroll
  for (int s = 0; s < 8; ++s) {
    const bf16x8 bs = *(const bf16x8*)(ST + r * 136 + 16 * s + 8 * hh);
    acc = MFMA32(o.a[s], bs, acc);
  }
  if (w < 2) {
#pragma unroll
    for (int g = 0; g < 4; ++g) {
      uint2 pk, pd;
      pk.x = pack2(acc[4 * g], acc[4 * g + 1]); pk.y = pack2(acc[4 * g + 2], acc[4 * g + 3]);
      pd.x = pack2(acc[4 * g] * o.rs[g].x, acc[4 * g + 1] * o.rs[g].y);
      pd.y = pack2(acc[4 * g + 2] * o.rs[g].z, acc[4 * g + 3] * o.rs[g].w);
      *(uint2*)(VT + r * 72 + 32 * ti + 8 * g + 4 * hh) = pk;
      *(uint2*)(VdT + r * 72 + 32 * ti + 8 * g + 4 * hh) = pd;
    }
  } else {
#pragma unroll
    for (int g = 0; g < 4; ++g) {
      acc[4 * g] *= o.rs[g].x; acc[4 * g + 1] *= o.rs[g].y; acc[4 * g + 2] *= o.rs[g].z; acc[4 * g + 3] *= o.rs[g].w;
    }
  }
  __syncthreads();
  if (w >= 2) {
#pragma unroll
    for (int s = 0; s < 4; ++s) {
      const bf16x8 bv = *(const bf16x8*)(VT + r * 72 + 16 * s + 8 * hh);
      acc = MFMA32(o.x[s], bv, acc);
    }
#pragma unroll
    for (int reg = 0; reg < 16; ++reg) uo_c[(32 * ti + crow(reg, hh)) * 32 + r] = f2bf(acc[reg]);
  }
#pragma unroll
  for (int i = 0; i < 16; ++i) S[i] *= o.gtot;
#pragma unroll
  for (int s = 0; s < 4; ++s) {
    const bf16x8 bv = *(const bf16x8*)(VdT + r * 72 + 16 * s + 8 * hh);
    S = MFMA32(o.kt[s], bv, S);
  }
}
__device__ __forceinline__ void d_gdn_scan(int chain, int sl, char* smem, GdnBufs G) {
  unsigned short* ST = (unsigned short*)smem;
  unsigned short* VT = ST + 32 * 136;
  unsigned short* VdT = VT + 32 * 72;
  const int tid = threadIdx.x, lane = tid & 63, w = __builtin_amdgcn_readfirstlane(tid >> 6), r = lane & 31, hh = lane >> 5;
  const int bh = chain >> 1, dir = chain & 1;
  f32x16 S;
#pragma unroll
  for (int i = 0; i < 16; ++i) S[i] = 0.f;
  GdnOps A, B;
  gdn_load(A, G, chain, bh, dir ? 63 : 0, sl, w, r, hh, lane);
  for (int step = 0; step < 64; step += 2) {
    const int c0 = dir ? 63 - step : step;
    const int c1 = dir ? c0 - 1 : c0 + 1;
    const int c2 = dir ? c0 - 2 : c0 + 2;
    gdn_load(B, G, chain, bh, c1, sl, w, r, hh, lane);
    gdn_step(A, S, ST, VT, VdT, G.uo + ((size_t)(chain * 64 + c0)) * 8192 + sl * 2048, w, r, hh);
    if (step + 2 < 64) gdn_load(A, G, chain, bh, c2, sl, w, r, hh, lane);
    gdn_step(B, S, ST, VT, VdT, G.uo + ((size_t)(chain * 64 + c1)) * 8192 + sl * 2048, w, r, hh);
  }
}

#define ML_LOAD(T0)                                                                                         \
  {                                                                                                         \
    _Pragma("unroll") for (int i_ = 0; i_ < 8; ++i_) {                                                      \
      const int id_ = t128 + i_ * 128;                                                                      \
      pq[i_] = *(const uint4*)(pm + ((T0) + (id_ >> 4)) * 4096 + 2048 + h * 128 + (id_ & 15) * 8);          \
      pk[i_] = *(const uint4*)(pm + ((T0) + (id_ >> 4)) * 4096 + 2560 + h * 128 + (id_ & 15) * 8);          \
    }                                                                                                       \
    _Pragma("unroll") for (int i_ = 0; i_ < 2; ++i_) {                                                      \
      const int id_ = t128 + i_ * 128;                                                                      \
      pv[i_] = *(const uint4*)(pm + ((T0) + (id_ >> 2)) * 4096 + 3072 + h * 128 + sl * 32 + (id_ & 3) * 8); \
    }                                                                                                       \
    plf = gt[((T0) + lane) * 32 + 24 + dir * 4 + h];                                                        \
    pip = gt[((T0) + lane) * 32 + 16 + dir * 4 + h];                                                        \
  }
__device__ __forceinline__ void ml_state_image(const f32x16& S0, const f32x16& S1, unsigned short* S0T, unsigned short* nL, int w, int r, int hh) {
#pragma unroll
  for (int g = 0; g < 4; ++g) {
    uint2 pk;
    pk.x = pack2(S0[4 * g], S0[4 * g + 1]); pk.y = pack2(S0[4 * g + 2], S0[4 * g + 3]);
    *(uint2*)(S0T + r * 136 + 32 * w + 8 * g + 4 * hh) = pk;
    if (r == 0) {
      uint2 pn;
      pn.x = pack2(S1[4 * g], S1[4 * g + 1]); pn.y = pack2(S1[4 * g + 2], S1[4 * g + 3]);
      *(uint2*)(nL + 32 * w + 8 * g + 4 * hh) = pn;
    }
  }
}
__device__ __forceinline__ void ml_state_update(f32x16& S0, f32x16& S1, const unsigned short* kdL, const unsigned short* vTL,
                                                float gtot, int w, int r, int hh) {
  bf16x8 ones;
#pragma unroll
  for (int i = 0; i < 8; ++i) ones[i] = (short)0x3F80;
#pragma unroll
  for (int i = 0; i < 16; ++i) { S0[i] *= gtot; S1[i] *= gtot; }
#pragma unroll
  for (int s2 = 0; s2 < 4; ++s2) {
    union { bf16x8 v; unsigned short e[8]; } a;
#pragma unroll
    for (int e = 0; e < 8; ++e) a.e[e] = kdL[(16 * s2 + 8 * hh + e) * 136 + 32 * w + r];
    const bf16x8 bv = *(const bf16x8*)(vTL + r * 72 + 16 * s2 + 8 * hh);
    S0 = MFMA32(a.v, bv, S0);
    S1 = MFMA32(a.v, ones, S1);
  }
}
__device__ __forceinline__ void d_mlstm_scan(int chain, int sl, char* smem, const unsigned short* __restrict__ pm,
                                             const float* __restrict__ gt, unsigned short* __restrict__ oM, int ntok) {
  unsigned short* qL = (unsigned short*)smem;
  unsigned short* kL = qL + 64 * 136;
  unsigned short* kdL = kL + 64 * 136;
  unsigned short* vTL = kdL + 64 * 136;
  unsigned short* S0T = vTL + 32 * 72;
  unsigned short* nL = S0T + 32 * 136;
  float* scal = (float*)(nL + 256);
  const int tid = threadIdx.x, lane = tid & 63, w = __builtin_amdgcn_readfirstlane(tid >> 6), r = lane & 31, hh = lane >> 5;
  const int bh = chain >> 1, dir = chain & 1, b = bh >> 2, h = bh & 3;
  const float SCALE = 0.08838834764831845f;
  f32x16 S0, S1;
#pragma unroll
  for (int i = 0; i < 16; ++i) { S0[i] = 0.f; S1[i] = 0.f; }
  unsigned short* oMb = oM + (size_t)dir * ntok * 512 + h * 128 + sl * 32;
  const size_t tb = (size_t)b * SEQ;
  if (w >= 2) {
    const int t128 = tid - 128;
    uint4 pq[8], pk[8], pv[2];
    float plf, pip;
    ML_LOAD(tb + (dir ? 63 : 0) * 64);
    for (int step = 0; step < 64; ++step) {
      const int c0 = dir ? 63 - step : step;
      const int c1 = dir ? c0 - 1 : c0 + 1;
      float bc = plf;
#pragma unroll
      for (int ofs = 1; ofs < 64; ofs <<= 1) {
        const float vu = __shfl_up(bc, ofs, 64);
        const float vd = __shfl_down(bc, ofs, 64);
        if (dir == 0) { if (lane >= ofs) bc += vu; } else { if (lane + ofs < 64) bc += vd; }
      }
      const float b_last = __shfl(bc, dir ? 0 : 63, 64);
      const float Dj = SCALE * expf(b_last - bc + pip);
      const float gtot = expf(b_last);
      __syncthreads();
      if (w == 2) {
        scal[lane] = expf(bc);
        scal[64 + lane] = (pip - bc) * 1.4426950408889634f - 3.5f;
        scal[128 + lane] = bc * 1.4426950408889634f;
        if (lane == 0) scal[192] = gtot;
      }
#pragma unroll
      for (int i = 0; i < 8; ++i) {
        const int id = t128 + i * 128;
        const int row = id >> 4, c16 = id & 15;
        const uint4 kv = pk[i];
        const uint4 qv = pq[i];
        *(uint4*)(qL + row * 136 + c16 * 8) = qv;
        *(uint4*)(kL + row * 136 + c16 * 8) = kv;
        const float d = __shfl(Dj, row, 64);
        uint4 kd;
        kd.x = pack2(bf2f(kv.x & 0xffff) * d, bf2f(kv.x >> 16) * d);
        kd.y = pack2(bf2f(kv.y & 0xffff) * d, bf2f(kv.y >> 16) * d);
        kd.z = pack2(bf2f(kv.z & 0xffff) * d, bf2f(kv.z >> 16) * d);
        kd.w = pack2(bf2f(kv.w & 0xffff) * d, bf2f(kv.w >> 16) * d);
        *(uint4*)(kdL + row * 136 + c16 * 8) = kd;
      }
#pragma unroll
      for (int i = 0; i < 2; ++i) {
        const int id = t128 + i * 128;
        const int tok = id >> 2, d8 = (id & 3) * 8;
        const uint4 vv = pv[i];
        vTL[(d8 + 0) * 72 + tok] = (unsigned short)(vv.x & 0xffff);
        vTL[(d8 + 1) * 72 + tok] = (unsigned short)(vv.x >> 16);
        vTL[(d8 + 2) * 72 + tok] = (unsigned short)(vv.y & 0xffff);
        vTL[(d8 + 3) * 72 + tok] = (unsigned short)(vv.y >> 16);
        vTL[(d8 + 4) * 72 + tok] = (unsigned short)(vv.z & 0xffff);
        vTL[(d8 + 5) * 72 + tok] = (unsigned short)(vv.z >> 16);
        vTL[(d8 + 6) * 72 + tok] = (unsigned short)(vv.w & 0xffff);
        vTL[(d8 + 7) * 72 + tok] = (unsigned short)(vv.w >> 16);
      }
      if (step + 1 < 64) ML_LOAD(tb + c1 * 64);
      ml_state_image(S0, S1, S0T, nL, w, r, hh);
      __syncthreads();
      ml_state_update(S0, S1, kdL, vTL, gtot, w, r, hh);
    }
  } else {
    bf16x8 ones;
#pragma unroll
    for (int i = 0; i < 8; ++i) ones[i] = (short)0x3F80;
    const int ti = w;
    const int icol = 32 * ti + r;
    for (int step = 0; step < 64; ++step) {
      const int c0 = dir ? 63 - step : step;
      __syncthreads();
      ml_state_image(S0, S1, S0T, nL, w, r, hh);
      __syncthreads();
      const float bci = scal[128 + icol];
      const float gtot = scal[192];
      f32x16 Q0, Q1;
#pragma unroll
      for (int i = 0; i < 16; ++i) { Q0[i] = 0.f; Q1[i] = 0.f; }
#pragma unroll
      for (int s2 = 0; s2 < 8; ++s2) {
        const bf16x8 a = *(const bf16x8*)(qL + (32 * ti + r) * 136 + 16 * s2 + 8 * hh);
        const bf16x8 b0 = *(const bf16x8*)(S0T + r * 136 + 16 * s2 + 8 * hh);
        const bf16x8 b1 = *(const bf16x8*)(nL + 16 * s2 + 8 * hh);
        Q0 = MFMA32(a, b0, Q0);
        Q1 = MFMA32(a, b1, Q1);
      }
#pragma unroll
      for (int g = 0; g < 4; ++g) {
        const float4 e4 = *(const float4*)(scal + 32 * ti + 8 * g + 4 * hh);
        Q0[4 * g] *= e4.x; Q0[4 * g + 1] *= e4.y; Q0[4 * g + 2] *= e4.z; Q0[4 * g + 3] *= e4.w;
        Q1[4 * g] *= e4.x; Q1[4 * g + 1] *= e4.y; Q1[4 * g + 2] *= e4.z; Q1[4 * g + 3] *= e4.w;
      }
#pragma unroll
      for (int tj = 0; tj < 2; ++tj) {
        if (dir ? (tj < ti) : (tj > ti)) continue;
        f32x16 X;
#pragma unroll
        for (int i = 0; i < 16; ++i) X[i] = 0.f;
#pragma unroll
        for (int s2 = 0; s2 < 8; ++s2) {
          const bf16x8 a = *(const bf16x8*)(kL + (32 * tj + r) * 136 + 16 * s2 + 8 * hh);
          const bf16x8 bq = *(const bf16x8*)(qL + (32 * ti + r) * 136 + 16 * s2 + 8 * hh);
          X = MFMA32(a, bq, X);
        }
#pragma unroll
        for (int g = 0; g < 4; ++g) {
          const float4 cj4 = *(const float4*)(scal + 64 + 32 * tj + 8 * g + 4 * hh);
          const float cjs[4] = {cj4.x, cj4.y, cj4.z, cj4.w};
#pragma unroll
          for (int e = 0; e < 4; ++e) {
            const int j = 32 * tj + 8 * g + 4 * hh + e;
            const bool valid = dir ? (j >= icol) : (j <= icol);
            const float arg = valid ? (bci + cjs[e]) : -INFINITY;
            X[4 * g + e] *= __builtin_amdgcn_exp2f(arg);
          }
        }
#pragma unroll
        for (int s2 = 0; s2 < 2; ++s2) {
          union { bf16x8 v; unsigned u[4]; } xa, bv;
          xa.u[0] = pack2(X[8 * s2 + 0], X[8 * s2 + 1]); xa.u[1] = pack2(X[8 * s2 + 2], X[8 * s2 + 3]);
          xa.u[2] = pack2(X[8 * s2 + 4], X[8 * s2 + 5]); xa.u[3] = pack2(X[8 * s2 + 6], X[8 * s2 + 7]);
          const uint2 v0 = *(const uint2*)(vTL + r * 72 + 32 * tj + 16 * s2 + 4 * hh);
          const uint2 v1 = *(const uint2*)(vTL + r * 72 + 32 * tj + 16 * s2 + 8 + 4 * hh);
          bv.u[0] = v0.x; bv.u[1] = v0.y; bv.u[2] = v1.x; bv.u[3] = v1.y;
          Q0 = MFMA32(xa.v, bv.v, Q0);
          Q1 = MFMA32(xa.v, ones, Q1);
        }
      }
      const size_t orow0 = tb + c0 * 64;
#pragma unroll
      for (int reg = 0; reg < 16; ++reg) {
        const int i = 32 * ti + crow(reg, hh);
        oMb[(orow0 + i) * 512 + r] = f2bf(Q0[reg] * __builtin_amdgcn_rcpf(fmaxf(fabsf(Q1[reg]), 1.f)));
      }
      ml_state_update(S0, S1, kdL, vTL, gtot, w, r, hh);
    }
  }
}

struct MKP {
  const float *x, *norm1_g, *w_in, *conv_w, *a_log, *dt_bias, *gdn_g, *i_bias, *f_bias, *ml_g, *w_out, *norm2_g, *peer_wq,
      *peer_keys, *peer_u, *peer_v, *normf_g;
  float* out;
  unsigned short *pm, *x1b, *woutT, *mt, *xb, *winT, *oM, *yb, *scores, *qkv_dbg, *oA_dbg;
  unsigned *utab, *vtab;
  unsigned short *wqb, *keyb;
  float *uscale, *vscale;
  float *x1, *rs1, *rs2, *gt, *gateb, *dbg;
  unsigned* bar;
  int* idxb;
  GdnBufs G;
};

constexpr int SMEM_BYTES = 74752;
__global__ void __launch_bounds__(256, 2) k_mega(MKP P) {
  __shared__ __attribute__((aligned(16))) char smem_c[SMEM_BYTES + 16];
  {
    volatile LAS unsigned* st0 = (volatile LAS unsigned*)(smem_c + SMEM_BYTES);
    if (threadIdx.x < 4) st0[threadIdx.x] = 0u;
  }
  __syncthreads();
  XcdBarrier xb = xcd_barrier_post(P.bar, (volatile LAS unsigned*)(smem_c + SMEM_BYTES));
  unsigned short* smem = (unsigned short*)smem_c;
  const int nb = gridDim.x, bid = blockIdx.x;
  for (int it = bid; it < NT / 4; it += nb) d_prep_x(it, P.x, P.xb, P.rs1);
  for (int it = bid; it < 16 * 66; it += nb) d_transpose_w(it, 66, (float*)smem_c, P.w_in, DIN, P.norm1_g, P.winT, 1);
  for (int it = bid; it < 16 * 16; it += nb) d_transpose_w(it, 16, (float*)smem_c, P.w_out, 1024, nullptr, P.woutT, 0);
  for (int it = bid; it < 1024; it += nb) d_cvt_bf16(it, P.peer_wq, P.wqb, P.norm2_g, 11);
  for (int it = bid; it < 128; it += nb) d_cvt_bf16(it, P.peer_keys, P.keyb, nullptr, 0);
  if (bid == 0 && threadIdx.x < 4) P.dbg[threadIdx.x] = 0.f;
  xcd_barrier(xb);
  {
    GemmP p{};
    p.A = P.xb; p.lda = DM; p.Bt = P.winT; p.ldb = DM; p.K = DM;
    p.rowscale = P.rs1; p.obf = P.pm; p.ldo = 4096; p.of32 = P.gt; p.ldf = 32; p.resid = nullptr;
    p.a_log = P.a_log; p.dt_bias = P.dt_bias; p.i_bias = P.i_bias; p.f_bias = P.f_bias;
    for (int k = 0;; ++k) {
      int tm, tn;
      if (!xcd_tile(bid, nb, k, 33, tm, tn)) break;
      gemm_tile<EPI_INPROJ>(p, tm, tn, smem);
      __syncthreads();
    }
  }
  for (int tile = bid; tile < 16 * 8; tile += nb) {
    const int hp = tile >> 3, tn = tile & 7;
    GemmP p{};
    p.A = P.keyb + (size_t)hp * 128 * 128; p.lda = 128; p.Bt = P.wqb + hp * 128; p.ldb = 2048; p.K = 128;
    p.obf = P.mt + (size_t)hp * 128 * DM; p.ldo = DM;
    gemm_tile<EPI_PLAIN>(p, 0, tn, smem);
    __syncthreads();
  }
  xcd_barrier(xb);
  for (int it = bid; it < 1024; it += nb) d_gdn_prep(it, smem_c, P.pm, P.gt, P.conv_w, P.G);
  xcd_barrier(xb);
  if (bid < 128) {
    d_gdn_scan(bid >> 2, bid & 3, smem_c, P.G);
  } else if (bid < 256) {
    d_mlstm_scan((bid - 128) >> 2, (bid - 128) & 3, smem_c, P.pm, P.gt, P.oM, NT);
  }
#ifdef DBG_CHECK
  if (bid < 4) {
    __syncthreads();
    const int half = threadIdx.x >> 7;
    float* sq = (float*)smem + half * 256;
    float* sk = sq + 128;
    d_mlstm_rec(bid * 2 + half, sq, sk, P.pm, P.gt, P.oA_dbg, 4096);
  }
#endif
  xcd_barrier(xb);
  for (int it = bid; it < NT / 4; it += nb) d_combine(it, P.G.uo, P.oM, P.pm, P.gdn_g, P.ml_g, P.yb);
#ifdef DBG_CHECK
  for (int it = bid; it < 4096 / 4; it += nb) d_dbg_cmp_m(it, P.oM, P.oA_dbg, P.dbg);
#endif
  xcd_barrier(xb);
  {
    GemmP p{};
    p.A = P.yb; p.lda = DM; p.Bt = P.woutT; p.ldb = DM; p.K = DM;
    p.rowscale = nullptr; p.obf = P.x1b; p.ldo = DM; p.of32 = P.x1; p.ldf = DM; p.resid = P.x; p.rowacc = P.rs2;
    for (int k = 0;; ++k) {
      int tm, tn;
      if (!xcd_tile(bid, nb, k, 8, tm, tn)) break;
      gemm_tile<EPI_OUTPROJ>(p, tm, tn, smem);
      __syncthreads();
    }
  }
  xcd_barrier(xb);
  {
    GemmP p{};
    p.A = P.x1b; p.lda = DM; p.Bt = P.mt; p.ldb = DM; p.K = DM;
    p.rowscale = P.rs2; p.obf = P.scores; p.ldo = 2048; p.of32 = nullptr; p.ldf = 0; p.resid = nullptr;
    for (int k = 0;; ++k) {
      int tm, tn;
      if (!xcd_tile(bid, nb, k, 16, tm, tn)) break;
      gemm_tile<EPI_SCORES>(p, tm, tn, smem);
      __syncthreads();
    }
  }
  xcd_barrier(xb);
  for (int it = bid; it < 4096; it += nb) { d_cvt_tab(it, P.peer_u, P.utab, P.uscale); d_cvt_tab(it, P.peer_v, P.vtab, P.vscale); }
  for (int it = bid; it < NT * 8 / 256; it += nb) d_topk(it, P.scores, P.idxb, P.gateb);
  xcd_barrier(xb);
  float oscale = 1.f;
#ifdef DBG_CHECK
  {
    const float sd = __hip_atomic_load(&P.dbg[0], __ATOMIC_RELAXED, __HIP_MEMORY_SCOPE_AGENT);
    const float sr = __hip_atomic_load(&P.dbg[1], __ATOMIC_RELAXED, __HIP_MEMORY_SCOPE_AGENT);
    oscale = 1.f + sqrtf(sd / sr);
  }
#endif
  for (int it = bid; it < NT / 4; it += nb)
    d_peer(it, P.x1, P.rs2, P.norm2_g, P.idxb, P.gateb, P.utab, P.vtab, P.uscale, P.vscale, P.normf_g, P.out, oscale);
}

extern "C" void kernel_launch(void* const* d_in, const int* in_sizes, int n_in, void* d_out, int out_size, void* d_ws,
                              size_t ws_size, hipStream_t stream) {
  MKP P{};
  P.x = (const float*)d_in[0];
  P.norm1_g = (const float*)d_in[1];
  P.w_in = (const float*)d_in[2];
  P.conv_w = (const float*)d_in[3];
  P.a_log = (const float*)d_in[4];
  P.dt_bias = (const float*)d_in[5];
  P.gdn_g = (const float*)d_in[6];
  P.i_bias = (const float*)d_in[7];
  P.f_bias = (const float*)d_in[8];
  P.ml_g = (const float*)d_in[9];
  P.w_out = (const float*)d_in[10];
  P.norm2_g = (const float*)d_in[11];
  P.peer_wq = (const float*)d_in[12];
  P.peer_keys = (const float*)d_in[13];
  P.peer_u = (const float*)d_in[14];
  P.peer_v = (const float*)d_in[15];
  P.normf_g = (const float*)d_in[16];
  P.out = (float*)d_out;

  char* ws = (char*)d_ws;
  const size_t MB = 1024 * 1024;
  P.pm = (unsigned short*)(ws);
  P.x1 = (float*)(ws);
  P.x1b = (unsigned short*)(ws + 64 * MB);
  P.utab = (unsigned*)(ws + 64 * MB);
  P.vtab = (unsigned*)(ws + 80 * MB);
  P.uscale = (float*)(ws + 96 * MB);
  P.vscale = (float*)(ws + 96 * MB + 65536);
  char* rb = ws + 128 * MB;
  P.woutT = (unsigned short*)(rb);
  P.mt = (unsigned short*)(rb + 2 * MB);
  P.rs1 = (float*)(rb + 6 * MB);
  P.rs2 = (float*)(rb + 7 * MB);
  P.dbg = (float*)(rb + 6 * MB + 131072);
  P.bar = (unsigned*)(rb + 6 * MB + 196608);
  P.gt = (float*)(rb + 9 * MB);
  char* dyn = rb + 11 * MB;
  P.xb = (unsigned short*)(dyn);
  P.winT = (unsigned short*)(dyn + 32 * MB);
  P.wqb = (unsigned short*)(dyn + 41 * MB);
  P.keyb = (unsigned short*)(dyn + 45 * MB);
  P.G.qc = (unsigned short*)(dyn);
  P.G.kTc = (unsigned short*)(dyn + 16 * MB);
  P.G.qkc = (unsigned short*)(dyn + 32 * MB);
  P.G.wn = (unsigned short*)(dyn + 48 * MB);
  P.G.uo = (unsigned short*)(dyn + 80 * MB);
  P.G.gsc = (float*)(dyn + 112 * MB);
  P.yb = (unsigned short*)(dyn);
  P.scores = (unsigned short*)(dyn);
  P.idxb = (int*)(dyn + 64 * MB);
  P.gateb = (float*)(dyn + 72 * MB);
  char* os = (char*)d_out;
  P.oM = (unsigned short*)(os);
  P.qkv_dbg = (unsigned short*)(os + 32 * MB);
  P.oA_dbg = (unsigned short*)(os + 44 * MB);

  static int grid_blocks = 0;
  if (!grid_blocks) {
    int dev = 0, cus = 0, per_cu = 0;
    (void)hipGetDevice(&dev);
    (void)hipDeviceGetAttribute(&cus, hipDeviceAttributeMultiprocessorCount, dev);
    (void)hipOccupancyMaxActiveBlocksPerMultiprocessor(&per_cu, k_mega, 256, 0);
    if (per_cu > 2) per_cu = 2;
    if (per_cu < 1) per_cu = 1;
    grid_blocks = cus * per_cu;
  }
  (void)hipMemsetAsync(P.bar, 0, XCD_BAR_WORDS * sizeof(unsigned), stream);
  hipLaunchKernelGGL(k_mega, dim3(grid_blocks), dim3(256), 0, stream, P);
}
```

```cpp
#include <hip/hip_runtime.h>
#include <hip/hip_bf16.h>
#include <stdint.h>
#include <cstdio>

#define XB_TMO      128
#define XB_XCNT(j)  (256  + 64 * (j))
#define XB_XSUB(j)  (1280 + 64 * (j))
#define XB_XGEN(j)  (2304 + 64 * (j))
#define XB_TOP      3328
#define XB_TOPGEN   3392
#define XCD_BAR_WORDS 3456
#define XB_SPIN_CAP (1u << 18)
#define LAS __attribute__((address_space(3)))

__device__ __forceinline__ unsigned xb_ld(unsigned* p)              { return __hip_atomic_load(p, __ATOMIC_RELAXED, __HIP_MEMORY_SCOPE_AGENT); }
__device__ __forceinline__ unsigned xb_add(unsigned* p, unsigned v) { return __hip_atomic_fetch_add(p, v, __ATOMIC_RELAXED, __HIP_MEMORY_SCOPE_AGENT); }
__device__ __forceinline__ unsigned xb_xcc_id() { return (unsigned)__builtin_amdgcn_s_getreg((3 << 11) | 20) & 0xFu; }
#define XB_SPIN(cond, bar) do { unsigned _sp = 0; while (cond) { __builtin_amdgcn_s_sleep(1); \
    if ((++_sp & 255u) == 0u) { if (xb_ld(&(bar)[XB_TMO])) break; if (_sp > XB_SPIN_CAP) { atomicAdd(&(bar)[XB_TMO], 1u); break; } } } } while (0)

struct XcdBarrier {
    unsigned* bar; unsigned x;
    volatile LAS unsigned* st;
};

__device__ __forceinline__ XcdBarrier xcd_barrier_post(unsigned* bar, volatile LAS unsigned* st) {
    XcdBarrier b; b.bar = bar; b.x = xb_xcc_id(); b.st = st;
    if (threadIdx.x == 0) (void)xb_add(&bar[XB_XCNT(b.x)], 1u);
    return b;
}
__device__ __forceinline__ void xcd_barrier_complete(unsigned* bar, unsigned x, unsigned& nloc, unsigned& nx) {
    const unsigned G = gridDim.x * gridDim.y * gridDim.z;
    unsigned sum, cnt, mine, sp = 0u;
    for (;;) {
        sum = 0u; cnt = 0u; mine = 0u;
#pragma unroll
        for (unsigned j = 0; j < 16; ++j) { const unsigned c = xb_ld(&bar[XB_XCNT(j)]); sum += c; cnt += (c > 0u) ? 1u : 0u; mine = (j == x) ? c : mine; }
        if (sum == G) break;
        __builtin_amdgcn_s_sleep(1);
        if ((++sp & 255u) == 0u) { if (xb_ld(&bar[XB_TMO])) break; if (sp > XB_SPIN_CAP) { atomicAdd(&bar[XB_TMO], 1u); break; } }
    }
    nloc = mine > 0u ? mine : 1u; nx = cnt > 0u ? cnt : 1u;
}

__device__ __forceinline__ void xcd_barrier(const XcdBarrier& b) {
    asm volatile("s_waitcnt vmcnt(0)" ::: "memory");
    __syncthreads();
    if (threadIdx.x == 0) {
        unsigned* bar = b.bar;
        __builtin_amdgcn_s_waitcnt(0);
        unsigned nloc = b.st[0], nx = b.st[1];
        if (nloc == 0u) { xcd_barrier_complete(bar, b.x, nloc, nx); b.st[0] = nloc; b.st[1] = nx; }
        const unsigned old = xb_add(&bar[XB_XSUB(b.x)], 1u);
        const unsigned gen = old / nloc;
        if (old + 1u == (gen + 1u) * nloc) {
            __builtin_amdgcn_fence(__ATOMIC_RELEASE, "agent");
            asm volatile("s_waitcnt vmcnt(0)" ::: "memory");
            const unsigned og = xb_add(&bar[XB_TOP], 1u);
            const unsigned tg = og / nx;
            if (og + 1u == (tg + 1u) * nx) xb_add(&bar[XB_TOPGEN], 1u);
            else XB_SPIN(xb_ld(&bar[XB_TOPGEN]) == tg, bar);
            __builtin_amdgcn_fence(__ATOMIC_ACQUIRE, "agent");
            xb_add(&bar[XB_XGEN(b.x)], 1u);
            asm volatile("s_waitcnt vmcnt(0)" ::: "memory");
        } else {
            XB_SPIN(xb_ld(&bar[XB_XGEN(b.x)]) == gen, bar);
            __builtin_amdgcn_fence(__ATOMIC_ACQUIRE, "agent");
            asm volatile("s_waitcnt vmcnt(0)" ::: "memory");
        }
    }
    __syncthreads();
}


typedef __hip_bfloat16 bf16;
typedef __attribute__((ext_vector_type(8))) short bf16x8;
typedef __attribute__((ext_vector_type(4))) float f32x4;

constexpr int DM = 1024;
constexpr int NB = 4;
constexpr int SEQ = 4096;
constexpr int NT = NB * SEQ;
constexpr int DIN = 4128;
constexpr int NPAD_IN = 4224;
constexpr float EPSF = 1e-6f;

__device__ __forceinline__ float bf2f(unsigned short u) { return __uint_as_float(((unsigned)u) << 16); }
typedef __bf16 bf16x2_t __attribute__((ext_vector_type(2)));
typedef float f32x2_t __attribute__((ext_vector_type(2)));
__device__ __forceinline__ unsigned short f2bf(float f) { return __builtin_bit_cast(unsigned short, (__bf16)f); }
__device__ __forceinline__ unsigned pack2(float a, float b) {
  f32x2_t v = {a, b};
  return __builtin_bit_cast(unsigned, __builtin_convertvector(v, bf16x2_t));
}
__device__ __forceinline__ float wave_sum(float v) {
#pragma unroll
  for (int o = 32; o > 0; o >>= 1) v += __shfl_xor(v, o, 64);
  return v;
}
__device__ __forceinline__ float softplusf(float x) { return fmaxf(x, 0.f) + log1pf(expf(-fabsf(x))); }
__device__ __forceinline__ float sigmoidf(float x) { return 1.f / (1.f + expf(-x)); }

__device__ __forceinline__ void d_prep_x(int item, const float* __restrict__ x, unsigned short* __restrict__ xb,
                                                float* __restrict__ rs) {
  int t = item * 4 + (threadIdx.x >> 6);
  int lane = threadIdx.x & 63;
  const float4* xr = (const float4*)(x + (size_t)t * DM);
  float ss = 0.f;
#pragma unroll
  for (int i = 0; i < 4; ++i) {
    float4 v = xr[lane + 64 * i];
    ss += v.x * v.x + v.y * v.y + v.z * v.z + v.w * v.w;
    ushort4 o;
    o.x = f2bf(v.x); o.y = f2bf(v.y); o.z = f2bf(v.z); o.w = f2bf(v.w);
    ((ushort4*)(xb + (size_t)t * DM))[lane + 64 * i] = o;
  }
  ss = wave_sum(ss);
  if (lane == 0) rs[t] = rsqrtf(ss * (1.f / DM) + EPSF);
}

__device__ __forceinline__ int win_src(int n) {
  if (n < 2048) return n;
  if (n < 4096) return n + 16;
  int j = n - 4096;
  if (j < 16) return 2048 + j;
  if (j < 32) return 4112 + (j - 16);
  return -1;
}
__device__ __forceinline__ void d_transpose_w(int item, int ntn, float* tile, const float* __restrict__ in, int ldn,
                                              const float* __restrict__ g, unsigned short* __restrict__ out, int mode) {
  const int kt = item / ntn, nt = item % ntn;
  const int tid = threadIdx.x;
  __syncthreads();
#pragma unroll
  for (int i = 0; i < 4; ++i) {
    const int row = (tid >> 4) + 16 * i;
    const int c4 = (tid & 15) * 4;
    const int n = nt * 64 + c4;
    const int src = mode ? win_src(n) : n;
    float4 v = make_float4(0.f, 0.f, 0.f, 0.f);
    if (src >= 0) {
      v = *(const float4*)(in + (size_t)(kt * 64 + row) * ldn + src);
      if (g) { const float gg = g[kt * 64 + row]; v.x *= gg; v.y *= gg; v.z *= gg; v.w *= gg; }
    }
    tile[row * 65 + c4] = v.x; tile[row * 65 + c4 + 1] = v.y; tile[row * 65 + c4 + 2] = v.z; tile[row * 65 + c4 + 3] = v.w;
  }
  __syncthreads();
  {
    const int n = tid >> 2, k16 = (tid & 3) * 16;
    uint4 o0, o1;
    o0.x = pack2(tile[(k16 + 0) * 65 + n], tile[(k16 + 1) * 65 + n]);   o0.y = pack2(tile[(k16 + 2) * 65 + n], tile[(k16 + 3) * 65 + n]);
    o0.z = pack2(tile[(k16 + 4) * 65 + n], tile[(k16 + 5) * 65 + n]);   o0.w = pack2(tile[(k16 + 6) * 65 + n], tile[(k16 + 7) * 65 + n]);
    o1.x = pack2(tile[(k16 + 8) * 65 + n], tile[(k16 + 9) * 65 + n]);   o1.y = pack2(tile[(k16 + 10) * 65 + n], tile[(k16 + 11) * 65 + n]);
    o1.z = pack2(tile[(k16 + 12) * 65 + n], tile[(k16 + 13) * 65 + n]); o1.w = pack2(tile[(k16 + 14) * 65 + n], tile[(k16 + 15) * 65 + n]);
    unsigned short* op = out + (size_t)(nt * 64 + n) * DM + kt * 64 + k16;
    *(uint4*)op = o0;
    *(uint4*)(op + 8) = o1;
  }
}
__device__ __forceinline__ void d_cvt_bf16(int item, const float* __restrict__ src, unsigned short* __restrict__ dst,
                                           const float* __restrict__ rowscale, int rowlen_log2) {
  const size_t base = (size_t)item * 2048 + threadIdx.x * 8;
  float4 a = *(const float4*)(src + base);
  float4 b = *(const float4*)(src + base + 4);
  if (rowscale) {
    const float sc = rowscale[base >> rowlen_log2];
    a.x *= sc; a.y *= sc; a.z *= sc; a.w *= sc; b.x *= sc; b.y *= sc; b.z *= sc; b.w *= sc;
  }
  uint4 o;
  o.x = pack2(a.x, a.y); o.y = pack2(a.z, a.w); o.z = pack2(b.x, b.y); o.w = pack2(b.z, b.w);
  *(uint4*)(dst + base) = o;
}

constexpr int GBM = 128, GBN = 128, GBK = 64, GLD = 72;
struct GemmP {
  const unsigned short* A; const unsigned short* Bt; int lda, ldb, K;
  const float* rowscale;
  unsigned short* obf; int ldo;
  float* of32; int ldf;
  const float* resid;
  const float *a_log, *dt_bias, *i_bias, *f_bias;
  float* rowacc;
};
enum { EPI_INPROJ = 0, EPI_OUTPROJ = 1, EPI_SCORES = 2, EPI_PLAIN = 3 };

template <int EPI>
__device__ __forceinline__ void gemm_tile(const GemmP p, int tm, int tn, unsigned short* smem) {
  unsigned short* As = smem;
  unsigned short* Bs = smem + 2 * GBM * GLD;
  int tid = threadIdx.x;
  asm volatile("" : "+v"(tid));
  const int lane = tid & 63, wid = tid >> 6;
  const int wm = wid >> 1, wn = wid & 1;
  const int m0 = tm * GBM, n0 = tn * GBN;
  f32x4 acc[4][4];
#pragma unroll
  for (int i = 0; i < 4; ++i)
#pragma unroll
    for (int j = 0; j < 4; ++j) acc[i][j] = (f32x4){0.f, 0.f, 0.f, 0.f};

  uint4 ra0, ra1, ra2, ra3, rb0, rb1, rb2, rb3;
  uint4 sa0, sa1, sa2, sa3, sb0, sb1, sb2, sb3;
  const int nk = p.K / GBK;
  const int lrow = tid >> 3, lc8 = tid & 7;
  const unsigned short* Ag = p.A + (size_t)(m0 + lrow) * p.lda + lc8 * 8;
  const unsigned short* Bg = p.Bt + (size_t)(n0 + lrow) * p.ldb + lc8 * 8;
  const size_t a32 = (size_t)32 * p.lda, b32 = (size_t)32 * p.ldb;
#define GLOAD(R, S, kt)                                                  \
  {                                                                      \
    R##0 = *(const uint4*)(Ag + (kt) * GBK);                             \
    R##1 = *(const uint4*)(Ag + a32 + (kt) * GBK);                       \
    R##2 = *(const uint4*)(Ag + 2 * a32 + (kt) * GBK);                   \
    R##3 = *(const uint4*)(Ag + 3 * a32 + (kt) * GBK);                   \
    S##0 = *(const uint4*)(Bg + (kt) * GBK);                             \
    S##1 = *(const uint4*)(Bg + b32 + (kt) * GBK);                       \
    S##2 = *(const uint4*)(Bg + 2 * b32 + (kt) * GBK);                   \
    S##3 = *(const uint4*)(Bg + 3 * b32 + (kt) * GBK);                   \
  }
#define SSTORE(R, S, buf)                                                \
  {                                                                      \
    unsigned short* ad = As + (size_t)(buf) * GBM * GLD + lrow * GLD + lc8 * 8; \
    unsigned short* bd = Bs + (size_t)(buf) * GBN * GLD + lrow * GLD + lc8 * 8; \
    *(uint4*)(ad) = R##0; *(uint4*)(ad + 32 * GLD) = R##1; *(uint4*)(ad + 64 * GLD) = R##2; *(uint4*)(ad + 96 * GLD) = R##3; \
    *(uint4*)(bd) = S##0; *(uint4*)(bd + 32 * GLD) = S##1; *(uint4*)(bd + 64 * GLD) = S##2; *(uint4*)(bd + 96 * GLD) = S##3; \
  }
#define GCOMPUTE(buf)                                                                                                     \
  {                                                                                                                       \
    const unsigned short* Ab = As + (size_t)(buf) * GBM * GLD;                                                            \
    const unsigned short* Bb = Bs + (size_t)(buf) * GBN * GLD;                                                            \
    _Pragma("unroll") for (int ks = 0; ks < 2; ++ks) {                                                                    \
      bf16x8 a[4], b[4];                                                                                                  \
      const int kc = ks * 32 + (lane >> 4) * 8;                                                                           \
      _Pragma("unroll") for (int i = 0; i < 4; ++i) a[i] = *(const bf16x8*)(Ab + (wm * 64 + i * 16 + (lane & 15)) * GLD + kc); \
      _Pragma("unroll") for (int j = 0; j < 4; ++j) b[j] = *(const bf16x8*)(Bb + (wn * 64 + j * 16 + (lane & 15)) * GLD + kc); \
      _Pragma("unroll") for (int i = 0; i < 4; ++i)                                                                       \
        _Pragma("unroll") for (int j = 0; j < 4; ++j)                                                                     \
          acc[i][j] = __builtin_amdgcn_mfma_f32_16x16x32_bf16(b[j], a[i], acc[i][j], 0, 0, 0);               \
    }                                                                                                                     \
  }
  GLOAD(ra, rb, 0);
  if (nk > 1) GLOAD(sa, sb, 1);
  SSTORE(ra, rb, 0);
  __syncthreads();
  for (int kt = 0; kt < nk; kt += 2) {
    if (kt + 2 < nk) GLOAD(ra, rb, kt + 2);
    GCOMPUTE(0);
    if (kt + 1 < nk) SSTORE(sa, sb, 1);
    __syncthreads();
    if (kt + 1 < nk) {
      if (kt + 3 < nk) GLOAD(sa, sb, kt + 3);
      GCOMPUTE(1);
      if (kt + 2 < nk) SSTORE(ra, rb, 0);
      __syncthreads();
    }
  }
#undef GLOAD
#undef SSTORE
#undef GCOMPUTE
#pragma unroll
  for (int i = 0; i < 4; ++i) {
    const int row = m0 + wm * 64 + i * 16 + (lane & 15);
    float rsc = 1.f;
    float rowss = 0.f;
    if (EPI == EPI_INPROJ) rsc = p.rowscale[row];
    if (EPI == EPI_SCORES) {
      const float4* pr = (const float4*)(p.rowscale + (size_t)row * 16);
      const float4 s0 = pr[0], s1 = pr[1], s2 = pr[2], s3 = pr[3];
      const float ssq = ((s0.x + s0.y) + (s0.z + s0.w)) + ((s1.x + s1.y) + (s1.z + s1.w)) + ((s2.x + s2.y) + (s2.z + s2.w)) + ((s3.x + s3.y) + (s3.z + s3.w));
      rsc = rsqrtf(ssq * (1.f / DM) + EPSF);
    }
#pragma unroll
    for (int j = 0; j < 4; ++j) {
      const int col0 = n0 + wn * 64 + j * 16 + (lane >> 4) * 4;
      const float v0 = acc[i][j][0] * rsc, v1 = acc[i][j][1] * rsc, v2 = acc[i][j][2] * rsc, v3 = acc[i][j][3] * rsc;
      if (EPI == EPI_INPROJ) {
        if (col0 < 4096) {
          uint2 pk; pk.x = pack2(v0, v1); pk.y = pack2(v2, v3);
          *(uint2*)(p.obf + (size_t)row * p.ldo + col0) = pk;
        } else if (col0 < 4128) {
          const float vv[4] = {v0, v1, v2, v3};
          float oo[4];
#pragma unroll
          for (int r = 0; r < 4; ++r) {
            const int jg = col0 - 4096 + r, jj = jg & 7;
            const float v = vv[r];
            float o;
            if (jg < 8) o = -expf(p.a_log[jj]) * softplusf(v + p.dt_bias[jj]);
            else if (jg < 16) o = sigmoidf(v);
            else if (jg < 24) o = v + p.i_bias[jj];
            else o = -softplusf(-(v + p.f_bias[jj]));
            oo[r] = o;
          }
          *(float4*)(p.of32 + (size_t)row * p.ldf + (col0 - 4096)) = make_float4(oo[0], oo[1], oo[2], oo[3]);
        }
      } else if (EPI == EPI_OUTPROJ) {
        const float4 xr = *(const float4*)(p.resid + (size_t)row * p.ldf + col0);
        const float x0 = v0 + xr.x, x1 = v1 + xr.y, x2 = v2 + xr.z, x3 = v3 + xr.w;
        *(float4*)(p.of32 + (size_t)row * p.ldf + col0) = make_float4(x0, x1, x2, x3);
        uint2 pk; pk.x = pack2(x0, x1); pk.y = pack2(x2, x3);
        *(uint2*)(p.obf + (size_t)row * p.ldo + col0) = pk;
        rowss += (x0 * x0 + x1 * x1) + (x2 * x2 + x3 * x3);
      } else {
        uint2 pk; pk.x = pack2(v0, v1); pk.y = pack2(v2, v3);
        *(uint2*)(p.obf + (size_t)row * p.ldo + col0) = pk;
      }
    }
    if (EPI == EPI_OUTPROJ) {
      rowss += __shfl_xor(rowss, 16, 64);
      rowss += __shfl_xor(rowss, 32, 64);
      if ((lane >> 4) == 0) p.rowacc[(size_t)row * 16 + tn * 2 + wn] = rowss;
    }
  }
}

__device__ __forceinline__ bool xcd_tile(int bid, int nb, int k, int ntn, int& tm, int& tn) {
  const int q = (bid >> 3) + (nb >> 3) * k;
  if (q >= 16 * ntn) return false;
  const int g = q / (8 * ntn), rem = q % (8 * ntn);
  tn = rem >> 3;
  tm = 16 * (bid & 7) + 8 * g + (rem & 7);
  return true;
}

__device__ __forceinline__ void d_conv(int item, const unsigned short* __restrict__ pm, const float* __restrict__ pg,
                                              const float* __restrict__ conv_w, const float* __restrict__ a_log,
                                              const float* __restrict__ dt_bias, const float* __restrict__ i_bias,
                                              const float* __restrict__ f_bias, unsigned short* __restrict__ qkv,
                                              float* __restrict__ gt) {
  int t = item * 4 + (threadIdx.x >> 6);
  int lane = threadIdx.x & 63;
  int s = t & (SEQ - 1);
  for (int sec = 0; sec < 3; ++sec) {
    for (int h = 0; h < 4; ++h) {
      int c0 = sec * 512 + h * 128 + 2 * lane;
      float a0 = 0.f, a1 = 0.f;
#pragma unroll
      for (int j = 0; j < 5; ++j) {
        int sp = s + j - 2;
        if (sp >= 0 && sp < SEQ) {
          unsigned v = *(const unsigned*)(pm + (size_t)(t + j - 2) * 4096 + c0);
          a0 += conv_w[c0 * 5 + j] * bf2f((unsigned short)(v & 0xffff));
          a1 += conv_w[(c0 + 1) * 5 + j] * bf2f((unsigned short)(v >> 16));
        }
      }
      a0 = a0 * sigmoidf(a0);
      a1 = a1 * sigmoidf(a1);
      if (sec < 2) {
        float ss = wave_sum(a0 * a0 + a1 * a1);
        float sc = rsqrtf(ss + EPSF);
        if (sec == 0) sc *= 0.08838834764831845f;
        a0 *= sc; a1 *= sc;
      }
      unsigned o = pack2(a0, a1);
      *(unsigned*)(qkv + (size_t)t * 1536 + c0) = o;
    }
  }
}

__device__ __forceinline__ void d_gdn_rec(int chain, float* sq, float* sk, const unsigned short* __restrict__ qkv,
                                                 const float* __restrict__ gt, unsigned short* __restrict__ oA, int ntok) {
  const int bh = chain >> 1, dir = chain & 1;
  const int b = bh >> 2, h = bh & 3;
  const int e = threadIdx.x & 127;
  float S[128];
#pragma unroll
  for (int d = 0; d < 128; ++d) S[d] = 0.f;
  for (int it = 0; it < SEQ; ++it) {
    const int s = dir ? (SEQ - 1 - it) : it;
    const size_t t = (size_t)b * SEQ + s;
    __syncthreads();
    sq[e] = bf2f(qkv[t * 1536 + h * 128 + e]);
    sk[e] = bf2f(qkv[t * 1536 + 512 + h * 128 + e]);
    const float v = bf2f(qkv[t * 1536 + 1024 + h * 128 + e]);
    const float g = gt[t * 32 + dir * 4 + h];
    const float beta = gt[t * 32 + 8 + dir * 4 + h];
    __syncthreads();
    const float a = expf(g);
    float k0 = 0.f, k1 = 0.f, k2 = 0.f, k3 = 0.f;
#pragma unroll
    for (int d = 0; d < 128; d += 4) {
      k0 += sk[d] * S[d]; k1 += sk[d + 1] * S[d + 1]; k2 += sk[d + 2] * S[d + 2]; k3 += sk[d + 3] * S[d + 3];
    }
    const float kS = a * ((k0 + k1) + (k2 + k3));
    const float vn = beta * (v - kS);
    float o0 = 0.f, o1 = 0.f, o2 = 0.f, o3 = 0.f;
#pragma unroll
    for (int d = 0; d < 128; d += 4) {
      S[d] = a * S[d] + sk[d] * vn;             o0 += sq[d] * S[d];
      S[d + 1] = a * S[d + 1] + sk[d + 1] * vn; o1 += sq[d + 1] * S[d + 1];
      S[d + 2] = a * S[d + 2] + sk[d + 2] * vn; o2 += sq[d + 2] * S[d + 2];
      S[d + 3] = a * S[d + 3] + sk[d + 3] * vn; o3 += sq[d + 3] * S[d + 3];
    }
    oA[((size_t)dir * ntok + t) * 512 + h * 128 + e] = f2bf((o0 + o1) + (o2 + o3));
  }
}

__device__ __forceinline__ void d_mlstm_rec(int chain, float* sq, float* sk, const unsigned short* __restrict__ pm,
                                                   const float* __restrict__ gt, unsigned short* __restrict__ oM, int ntok) {
  const int bh = chain >> 1, dir = chain & 1;
  const int b = bh >> 2, h = bh & 3;
  const int e = threadIdx.x & 127, lane = e & 63;
  float C[128];
#pragma unroll
  for (int d = 0; d < 128; ++d) C[d] = 0.f;
  float n0 = 0.f, n1 = 0.f, m = 0.f;
  for (int it = 0; it < SEQ; ++it) {
    const int s = dir ? (SEQ - 1 - it) : it;
    const size_t t = (size_t)b * SEQ + s;
    __syncthreads();
    sq[e] = bf2f(pm[t * 4096 + 2048 + h * 128 + e]);
    sk[e] = bf2f(pm[t * 4096 + 2560 + h * 128 + e]) * 0.08838834764831845f;
    const float v = bf2f(pm[t * 4096 + 3072 + h * 128 + e]);
    const float ip = gt[t * 32 + 16 + dir * 4 + h];
    const float lf = gt[t * 32 + 24 + dir * 4 + h];
    __syncthreads();
    const float mn = fmaxf(lf + m, ip);
    const float fs = expf(lf + m - mn);
    const float is = expf(ip - mn);
    m = mn;
    n0 = fs * n0 + is * sk[lane];
    n1 = fs * n1 + is * sk[lane + 64];
    const float den = wave_sum(n0 * sq[lane] + n1 * sq[lane + 64]);
    const float iv = is * v;
    float o0 = 0.f, o1 = 0.f, o2 = 0.f, o3 = 0.f;
#pragma unroll
    for (int d = 0; d < 128; d += 4) {
      C[d] = fs * C[d] + sk[d] * iv;             o0 += sq[d] * C[d];
      C[d + 1] = fs * C[d + 1] + sk[d + 1] * iv; o1 += sq[d + 1] * C[d + 1];
      C[d + 2] = fs * C[d + 2] + sk[d + 2] * iv; o2 += sq[d + 2] * C[d + 2];
      C[d + 3] = fs * C[d + 3] + sk[d + 3] * iv; o3 += sq[d + 3] * C[d + 3];
    }
    const float num = (o0 + o1) + (o2 + o3);
    const float hh = num / fmaxf(fabsf(den), expf(-mn));
    oM[((size_t)dir * ntok + t) * 512 + h * 128 + e] = f2bf(hh);
  }
}

__device__ __forceinline__ void d_combine(int item, const unsigned short* __restrict__ uo, const unsigned short* __restrict__ oM,
                                                 const unsigned short* __restrict__ pm, const float* __restrict__ gdn_g,
                                                 const float* __restrict__ ml_g, unsigned short* __restrict__ y) {
  int t = item * 4 + (threadIdx.x >> 6);
  int lane = threadIdx.x & 63;
  const int b = t >> 12, cc = (t >> 6) & 63, ii = t & 63;
  for (int h = 0; h < 4; ++h) {
    int c = h * 128 + 2 * lane;
    {
      const int chain0 = (b * 4 + h) * 2;
      const size_t off = (size_t)cc * 8192 + (lane >> 4) * 2048 + ii * 32 + ((2 * lane) & 31);
      unsigned vf = *(const unsigned*)(uo + (size_t)chain0 * 64 * 8192 + off);
      unsigned vb = *(const unsigned*)(uo + (size_t)(chain0 + 1) * 64 * 8192 + off);
      float o0 = bf2f(vf & 0xffff) + bf2f(vb & 0xffff);
      float o1 = bf2f(vf >> 16) + bf2f(vb >> 16);
      float ss = wave_sum(o0 * o0 + o1 * o1);
      float sc = rsqrtf(ss * (1.f / 128.f) + EPSF);
      unsigned z = *(const unsigned*)(pm + (size_t)t * 4096 + 1536 + c);
      float z0 = bf2f(z & 0xffff), z1 = bf2f(z >> 16);
      o0 = o0 * sc * gdn_g[2 * lane] * (z0 * sigmoidf(z0));
      o1 = o1 * sc * gdn_g[2 * lane + 1] * (z1 * sigmoidf(z1));
      *(unsigned*)(y + (size_t)t * DM + c) = pack2(o0, o1);
    }
    {
      unsigned vf = *(const unsigned*)(oM + (size_t)t * 512 + c);
      unsigned vb = *(const unsigned*)(oM + ((size_t)NT + t) * 512 + c);
      float o0 = bf2f(vf & 0xffff) + bf2f(vb & 0xffff);
      float o1 = bf2f(vf >> 16) + bf2f(vb >> 16);
      float ss = wave_sum(o0 * o0 + o1 * o1);
      float sc = rsqrtf(ss * (1.f / 128.f) + EPSF);
      unsigned z = *(const unsigned*)(pm + (size_t)t * 4096 + 3584 + c);
      float z0 = bf2f(z & 0xffff), z1 = bf2f(z >> 16);
      o0 = o0 * sc * ml_g[c] * sigmoidf(z0);
      o1 = o1 * sc * ml_g[c + 1] * sigmoidf(z1);
      *(unsigned*)(y + (size_t)t * DM + 512 + c) = pack2(o0, o1);
    }
  }
}

#ifdef DBG_CHECK
__device__ __forceinline__ void d_dbg_cmp(int item, const unsigned short* __restrict__ uo, const unsigned short* __restrict__ oAd,
                                          float* __restrict__ dbg) {
  int t = item * 4 + (threadIdx.x >> 6);
  int lane = threadIdx.x & 63;
  const int cc = (t >> 6) & 63, ii = t & 63;
  float sd = 0.f, sr = 0.f;
  for (int h = 0; h < 4; ++h) {
    for (int dir = 0; dir < 2; ++dir) {
      const int chain = h * 2 + dir;
      const size_t off = (size_t)cc * 8192 + (lane >> 4) * 2048 + ii * 32 + ((2 * lane) & 31);
      unsigned vn = *(const unsigned*)(uo + (size_t)chain * 64 * 8192 + off);
      unsigned vr = *(const unsigned*)(oAd + ((size_t)dir * 4096 + t) * 512 + h * 128 + 2 * lane);
      float n0 = bf2f(vn & 0xffff), n1 = bf2f(vn >> 16), r0 = bf2f(vr & 0xffff), r1 = bf2f(vr >> 16);
      sd += (n0 - r0) * (n0 - r0) + (n1 - r1) * (n1 - r1);
      sr += r0 * r0 + r1 * r1;
    }
  }
  sd = wave_sum(sd); sr = wave_sum(sr);
  if (lane == 0) { atomicAdd(&dbg[0], sd); atomicAdd(&dbg[1], sr); }
}
__device__ __forceinline__ void d_dbg_cmp_m(int item, const unsigned short* __restrict__ oM, const unsigned short* __restrict__ oMd,
                                            float* __restrict__ dbg) {
  int t = item * 4 + (threadIdx.x >> 6);
  int lane = threadIdx.x & 63;
  float sd = 0.f, sr = 0.f;
  for (int dir = 0; dir < 2; ++dir)
    for (int q = 0; q < 4; ++q) {
      unsigned vn = *(const unsigned*)(oM + ((size_t)dir * NT + t) * 512 + q * 128 + 2 * lane);
      unsigned vr = *(const unsigned*)(oMd + ((size_t)dir * 4096 + t) * 512 + q * 128 + 2 * lane);
      float n0 = bf2f(vn & 0xffff), n1 = bf2f(vn >> 16), r0 = bf2f(vr & 0xffff), r1 = bf2f(vr >> 16);
      sd += (n0 - r0) * (n0 - r0) + (n1 - r1) * (n1 - r1);
      sr += r0 * r0 + r1 * r1;
    }
  sd = wave_sum(sd); sr = wave_sum(sr);
  if (lane == 0) { atomicAdd(&dbg[0], sd); atomicAdd(&dbg[1], sr); }
}
#endif

__device__ __forceinline__ void d_prep_x1(int item, const float* __restrict__ x1, unsigned short* __restrict__ xb,
                                                 float* __restrict__ rs) {
  int t = item * 4 + (threadIdx.x >> 6);
  int lane = threadIdx.x & 63;
  const float4* xr = (const float4*)(x1 + (size_t)t * DM);
  float ss = 0.f;
#pragma unroll
  for (int i = 0; i < 4; ++i) {
    float4 v = xr[lane + 64 * i];
    ss += v.x * v.x + v.y * v.y + v.z * v.z + v.w * v.w;
    ushort4 o;
    o.x = f2bf(v.x); o.y = f2bf(v.y); o.z = f2bf(v.z); o.w = f2bf(v.w);
    ((ushort4*)(xb + (size_t)t * DM))[lane + 64 * i] = o;
  }
  ss = wave_sum(ss);
  if (lane == 0) rs[t] = rsqrtf(ss * (1.f / DM) + EPSF);
}

__device__ const unsigned char kPairTab[64] = {
    0x00, 0x01, 0x02, 0x03, 0x04, 0x05, 0x06, 0x07, 0x08, 0x09, 0x0a, 0x0b, 0x0c, 0x0d, 0x0e, 0x0f,
    0x10, 0x11, 0x12, 0x13, 0x14, 0x15, 0x16, 0x17,
    0x20, 0x21, 0x22, 0x23, 0x24,
    0x30, 0x31, 0x32, 0x33,
    0x40, 0x41, 0x42,
    0x50, 0x51, 0x60, 0x61, 0x70, 0x71,
    0x80, 0x90, 0xa0, 0xb0, 0xc0, 0xd0, 0xe0, 0xf0,
    0xff, 0xff, 0xff, 0xff, 0xff, 0xff, 0xff, 0xff, 0xff, 0xff, 0xff, 0xff, 0xff, 0xff};

__device__ __forceinline__ void sort16_desc(unsigned (&a)[16]) {
#pragma unroll
  for (int k = 2; k <= 16; k <<= 1)
#pragma unroll
    for (int j = k >> 1; j > 0; j >>= 1)
#pragma unroll
      for (int i = 0; i < 16; ++i) {
        const int l = i ^ j;
        if (l > i) {
          const unsigned hi = max(a[i], a[l]), lo = min(a[i], a[l]);
          if ((i & k) == 0) { a[i] = hi; a[l] = lo; } else { a[i] = lo; a[l] = hi; }
        }
      }
}
__device__ __forceinline__ void merge16_desc(unsigned (&top)[16], const unsigned (&b)[16]) {
#pragma unroll
  for (int i = 0; i < 16; ++i) top[i] = max(top[i], b[15 - i]);
#pragma unroll
  for (int j = 8; j > 0; j >>= 1)
#pragma unroll
    for (int i = 0; i < 16; ++i) {
      const int l = i ^ j;
      if (l > i) {
        const unsigned hi = max(top[i], top[l]), lo = min(top[i], top[l]);
        top[i] = hi; top[l] = lo;
      }
    }
}
__device__ __forceinline__ unsigned key16(unsigned hbits, int idx) {
  const unsigned m = hbits ^ ((hbits & 0x8000u) ? 0xFFFFu : 0x8000u);
  return (m << 16) | (unsigned)(127 - idx);
}
__device__ __forceinline__ void top16_of_128(const unsigned short* __restrict__ sp, unsigned (&top)[16]) {
#pragma unroll
  for (int g = 0; g < 8; ++g) {
    const uint4 x0 = *(const uint4*)(sp + g * 16);
    const uint4 x1 = *(const uint4*)(sp + g * 16 + 8);
    unsigned b[16];
    b[0] = key16(x0.x & 0xffff, g * 16 + 0);  b[1] = key16(x0.x >> 16, g * 16 + 1);
    b[2] = key16(x0.y & 0xffff, g * 16 + 2);  b[3] = key16(x0.y >> 16, g * 16 + 3);
    b[4] = key16(x0.z & 0xffff, g * 16 + 4);  b[5] = key16(x0.z >> 16, g * 16 + 5);
    b[6] = key16(x0.w & 0xffff, g * 16 + 6);  b[7] = key16(x0.w >> 16, g * 16 + 7);
    b[8] = key16(x1.x & 0xffff, g * 16 + 8);  b[9] = key16(x1.x >> 16, g * 16 + 9);
    b[10] = key16(x1.y & 0xffff, g * 16 + 10); b[11] = key16(x1.y >> 16, g * 16 + 11);
    b[12] = key16(x1.z & 0xffff, g * 16 + 12); b[13] = key16(x1.z >> 16, g * 16 + 13);
    b[14] = key16(x1.w & 0xffff, g * 16 + 14); b[15] = key16(x1.w >> 16, g * 16 + 15);
    sort16_desc(b);
    if (g == 0) {
#pragma unroll
      for (int i = 0; i < 16; ++i) top[i] = b[i];
    } else {
      merge16_desc(top, b);
    }
  }
}

__device__ __forceinline__ void d_topk(int item, const unsigned short* __restrict__ scores, int* __restrict__ idx_out,
                                       float* __restrict__ gate_out) {
  int tid_ = threadIdx.x;
  asm volatile("" : "+v"(tid_));
  const int pair = item * 256 + tid_;
  const unsigned short* sp = scores + (size_t)pair * 256;
  unsigned k0[16], k1[16];
  top16_of_128(sp, k0);
  top16_of_128(sp + 128, k1);
  float v0[16], v1[16];
  int i0[16], i1[16];
#pragma unroll
  for (int i = 0; i < 16; ++i) {
    const unsigned m0 = k0[i] >> 16, m1 = k1[i] >> 16;
    v0[i] = bf2f((unsigned short)(m0 ^ ((m0 & 0x8000u) ? 0x8000u : 0xFFFFu)));
    v1[i] = bf2f((unsigned short)(m1 ^ ((m1 & 0x8000u) ? 0x8000u : 0xFFFFu)));
    i0[i] = 127 - (int)(k0[i] & 127u);
    i1[i] = 127 - (int)(k1[i] & 127u);
  }
  unsigned top[16];
#pragma unroll
  for (int g = 0; g < 4; ++g) {
    unsigned b[16];
#pragma unroll
    for (int q = 0; q < 16; ++q) {
      const int pr = kPairTab[g * 16 + q];
      if (pr == 0xff) {
        b[q] = 0u;
      } else {
        const int pi = pr >> 4, pj = pr & 15;
        const float sum = v0[pi] + v1[pj];
        const unsigned u = __float_as_uint(sum);
        const unsigned mono = u ^ ((u & 0x80000000u) ? 0xFFFFFFFFu : 0x80000000u);
        b[q] = (mono & 0xFFFFC000u) | (unsigned)(16383 - (i0[pi] * 128 + i1[pj]));
      }
    }
    sort16_desc(b);
    if (g == 0) {
#pragma unroll
      for (int i = 0; i < 16; ++i) top[i] = b[i];
    } else {
      merge16_desc(top, b);
    }
  }
  float ev[16];
  int ci[16];
  float mx = 0.f, sum = 0.f;
#pragma unroll
  for (int i = 0; i < 16; ++i) {
    const unsigned mono = top[i] & 0xFFFFC000u;
    const unsigned u = mono ^ ((mono & 0x80000000u) ? 0x80000000u : 0xFFFFFFFFu);
    const float val = __uint_as_float(u & 0xFFFFC000u);
    ci[i] = 16383 - (int)(top[i] & 16383u);
    if (i == 0) mx = val;
    ev[i] = expf(val - mx);
    sum += ev[i];
  }
  const float inv = 1.f / sum;
#pragma unroll
  for (int q = 0; q < 4; ++q) {
    int4 o; float4 g;
    o.x = ci[4 * q]; o.y = ci[4 * q + 1]; o.z = ci[4 * q + 2]; o.w = ci[4 * q + 3];
    g.x = ev[4 * q] * inv; g.y = ev[4 * q + 1] * inv; g.z = ev[4 * q + 2] * inv; g.w = ev[4 * q + 3] * inv;
    *(int4*)(idx_out + (size_t)pair * 16 + 4 * q) = o;
    *(float4*)(gate_out + (size_t)pair * 16 + 4 * q) = g;
  }
}

typedef float f32x2 __attribute__((ext_vector_type(2)));
__device__ __forceinline__ void d_cvt_tab(int item, const float* __restrict__ src, unsigned* __restrict__ dst8, float* __restrict__ dscale) {
  const int row = item * 4 + (threadIdx.x >> 6);
  const int lane = threadIdx.x & 63;
  const float4* sr = (const float4*)(src + (size_t)row * DM + lane * 16);
  const float4 a = sr[0], b = sr[1], c = sr[2], d = sr[3];
  float m = fmaxf(fmaxf(fmaxf(fabsf(a.x), fabsf(a.y)), fmaxf(fabsf(a.z), fabsf(a.w))),
                  fmaxf(fmaxf(fabsf(b.x), fabsf(b.y)), fmaxf(fabsf(b.z), fabsf(b.w))));
  m = fmaxf(m, fmaxf(fmaxf(fmaxf(fabsf(c.x), fabsf(c.y)), fmaxf(fabsf(c.z), fabsf(c.w))),
                     fmaxf(fmaxf(fabsf(d.x), fabsf(d.y)), fmaxf(fabsf(d.z), fabsf(d.w)))));
#pragma unroll
  for (int o = 32; o > 0; o >>= 1) m = fmaxf(m, __shfl_xor(m, o, 64));
  const float sc = (m > 0.f) ? 240.f / m : 1.f;
  uint4 o;
  int p;
  p = 0; p = __builtin_amdgcn_cvt_pk_fp8_f32(a.x * sc, a.y * sc, p, false); p = __builtin_amdgcn_cvt_pk_fp8_f32(a.z * sc, a.w * sc, p, true); o.x = (unsigned)p;
  p = 0; p = __builtin_amdgcn_cvt_pk_fp8_f32(b.x * sc, b.y * sc, p, false); p = __builtin_amdgcn_cvt_pk_fp8_f32(b.z * sc, b.w * sc, p, true); o.y = (unsigned)p;
  p = 0; p = __builtin_amdgcn_cvt_pk_fp8_f32(c.x * sc, c.y * sc, p, false); p = __builtin_amdgcn_cvt_pk_fp8_f32(c.z * sc, c.w * sc, p, true); o.z = (unsigned)p;
  p = 0; p = __builtin_amdgcn_cvt_pk_fp8_f32(d.x * sc, d.y * sc, p, false); p = __builtin_amdgcn_cvt_pk_fp8_f32(d.z * sc, d.w * sc, p, true); o.w = (unsigned)p;
  *(uint4*)(dst8 + (size_t)row * 256 + lane * 4) = o;
  if (lane == 0) dscale[row] = (m > 0.f) ? m * (1.f / 240.f) : 1.f;
}

__device__ __forceinline__ float erf_fast(float x) {
  const float ax = fabsf(x);
  const float t = __builtin_amdgcn_rcpf(1.f + 0.3275911f * ax);
  float p = 1.061405429f;
  p = p * t - 1.453152027f;
  p = p * t + 1.421413741f;
  p = p * t - 0.284496736f;
  p = p * t + 0.254829592f;
  const float e = __builtin_amdgcn_exp2f(-1.4426950408889634f * ax * ax);
  const float r = 1.f - p * t * e;
  return copysignf(r, x);
}
__device__ __forceinline__ float dot16_f8(const uint4 u, const float* hv) {
  const f32x2 a0 = __builtin_amdgcn_cvt_pk_f32_fp8((int)u.x, false), a1 = __builtin_amdgcn_cvt_pk_f32_fp8((int)u.x, true);
  const f32x2 b0 = __builtin_amdgcn_cvt_pk_f32_fp8((int)u.y, false), b1 = __builtin_amdgcn_cvt_pk_f32_fp8((int)u.y, true);
  const f32x2 c0 = __builtin_amdgcn_cvt_pk_f32_fp8((int)u.z, false), c1 = __builtin_amdgcn_cvt_pk_f32_fp8((int)u.z, true);
  const f32x2 d0 = __builtin_amdgcn_cvt_pk_f32_fp8((int)u.w, false), d1 = __builtin_amdgcn_cvt_pk_f32_fp8((int)u.w, true);
  float s0 = a0[0] * hv[0] + a0[1] * hv[1];
  float s1 = a1[0] * hv[2] + a1[1] * hv[3];
  s0 += b0[0] * hv[4] + b0[1] * hv[5];
  s1 += b1[0] * hv[6] + b1[1] * hv[7];
  s0 += c0[0] * hv[8] + c0[1] * hv[9];
  s1 += c1[0] * hv[10] + c1[1] * hv[11];
  s0 += d0[0] * hv[12] + d0[1] * hv[13];
  s1 += d1[0] * hv[14] + d1[1] * hv[15];
  return s0 + s1;
}
__device__ __forceinline__ void axpy16_f8(const uint4 v, const float wg, float* acc) {
  const f32x2 a0 = __builtin_amdgcn_cvt_pk_f32_fp8((int)v.x, false), a1 = __builtin_amdgcn_cvt_pk_f32_fp8((int)v.x, true);
  const f32x2 b0 = __builtin_amdgcn_cvt_pk_f32_fp8((int)v.y, false), b1 = __builtin_amdgcn_cvt_pk_f32_fp8((int)v.y, true);
  const f32x2 c0 = __builtin_amdgcn_cvt_pk_f32_fp8((int)v.z, false), c1 = __builtin_amdgcn_cvt_pk_f32_fp8((int)v.z, true);
  const f32x2 d0 = __builtin_amdgcn_cvt_pk_f32_fp8((int)v.w, false), d1 = __builtin_amdgcn_cvt_pk_f32_fp8((int)v.w, true);
  acc[0] += wg * a0[0]; acc[1] += wg * a0[1]; acc[2] += wg * a1[0]; acc[3] += wg * a1[1];
  acc[4] += wg * b0[0]; acc[5] += wg * b0[1]; acc[6] += wg * b1[0]; acc[7] += wg * b1[1];
  acc[8] += wg * c0[0]; acc[9] += wg * c0[1]; acc[10] += wg * c1[0]; acc[11] += wg * c1[1];
  acc[12] += wg * d0[0]; acc[13] += wg * d0[1]; acc[14] += wg * d1[0]; acc[15] += wg * d1[1];
}
__device__ __forceinline__ void d_peer(int item, const float* __restrict__ x1, const float* __restrict__ rs2,
                                       const float* __restrict__ g2, const int* __restrict__ idx,
                                       const float* __restrict__ gate, const unsigned* __restrict__ pu,
                                       const unsigned* __restrict__ pv, const float* __restrict__ su,
                                       const float* __restrict__ sv, const float* __restrict__ gf,
                                       float* __restrict__ out, float oscale) {
  int tid_ = threadIdx.x;
  asm volatile("" : "+v"(tid_));
  const int t = item * 4 + (tid_ >> 6);
  const int lane = tid_ & 63;
  float r2;
  {
    const float4* pr = (const float4*)(rs2 + (size_t)t * 16);
    const float4 s0 = pr[0], s1 = pr[1], s2 = pr[2], s3 = pr[3];
    const float ssq = ((s0.x + s0.y) + (s0.z + s0.w)) + ((s1.x + s1.y) + (s1.z + s1.w)) + ((s2.x + s2.y) + (s2.z + s2.w)) + ((s3.x + s3.y) + (s3.z + s3.w));
    r2 = rsqrtf(ssq * (1.f / DM) + EPSF);
  }
  float xv[16], hv[16], acc[16];
#pragma unroll
  for (int q = 0; q < 4; ++q) {
    const float4 xx = *(const float4*)(x1 + (size_t)t * DM + lane * 16 + q * 4);
    const float4 gg = *(const float4*)(g2 + lane * 16 + q * 4);
    xv[q * 4 + 0] = xx.x; xv[q * 4 + 1] = xx.y; xv[q * 4 + 2] = xx.z; xv[q * 4 + 3] = xx.w;
    hv[q * 4 + 0] = xx.x * r2 * gg.x; hv[q * 4 + 1] = xx.y * r2 * gg.y;
    hv[q * 4 + 2] = xx.z * r2 * gg.z; hv[q * 4 + 3] = xx.w * r2 * gg.w;
  }
#pragma unroll
  for (int i = 0; i < 16; ++i) acc[i] = 0.f;
  const int id_a = idx[(size_t)t * 128 + lane], id_b = idx[(size_t)t * 128 + 64 + lane];
  const float gt_a = gate[(size_t)t * 128 + lane], gt_b = gate[(size_t)t * 128 + 64 + lane];
  for (int e0 = 0; e0 < 128; e0 += 8) {
    uint4 u[8], v[8];
    float gt8[8], su8[8], sv8[8];
#pragma unroll
    for (int k = 0; k < 8; ++k) {
      const int e = e0 + k;
      const int id = (e0 < 64) ? __shfl(id_a, e, 64) : __shfl(id_b, e - 64, 64);
      gt8[k] = (e0 < 64) ? __shfl(gt_a, e, 64) : __shfl(gt_b, e - 64, 64);
      u[k] = *(const uint4*)(pu + (size_t)id * 256 + lane * 4);
      v[k] = *(const uint4*)(pv + (size_t)id * 256 + lane * 4);
      su8[k] = su[id];
      sv8[k] = sv[id];
    }
    float d[8];
#pragma unroll
    for (int k = 0; k < 8; ++k) d[k] = dot16_f8(u[k], hv);
#pragma unroll
    for (int o = 32; o > 0; o >>= 1) {
#pragma unroll
      for (int k = 0; k < 8; ++k) d[k] += __shfl_xor(d[k], o, 64);
    }
#pragma unroll
    for (int k = 0; k < 8; ++k) {
      const float dd = d[k] * su8[k];
      const float act = 0.5f * dd * (1.f + erf_fast(dd * 0.7071067811865476f));
      axpy16_f8(v[k], gt8[k] * act * sv8[k], acc);
    }
  }
  float ss = 0.f;
#pragma unroll
  for (int i = 0; i < 16; ++i) { acc[i] += xv[i]; ss += acc[i] * acc[i]; }
  ss = wave_sum(ss);
  const float sc = rsqrtf(ss * (1.f / DM) + EPSF) * oscale;
#pragma unroll
  for (int q = 0; q < 4; ++q) {
    const float4 gg = *(const float4*)(gf + lane * 16 + q * 4);
    float4 o;
    o.x = acc[q * 4 + 0] * sc * gg.x; o.y = acc[q * 4 + 1] * sc * gg.y;
    o.z = acc[q * 4 + 2] * sc * gg.z; o.w = acc[q * 4 + 3] * sc * gg.w;
    *(float4*)(out + (size_t)t * DM + lane * 16 + q * 4) = o;
  }
}

typedef __attribute__((ext_vector_type(16))) float f32x16;
#define MFMA32(a, b, c) __builtin_amdgcn_mfma_f32_32x32x16_bf16((a), (b), (c), 0, 0, 0)
__device__ __forceinline__ int crow(int reg, int hh) { return (reg & 3) + 8 * (reg >> 2) + 4 * hh; }

struct GdnBufs {
  unsigned short* qc;
  unsigned short* kTc;
  unsigned short* qkc;
  unsigned short* wn;
  unsigned short* uo;
  float* gsc;
};

__device__ __forceinline__ void tri_subst(const float* AL0, int lane, float (&T)[64]) {
  const float* AL = (const float*)__builtin_assume_aligned(AL0, 16);
#pragma unroll
  for (int i = 0; i < 64; ++i) T[i] = 0.f;
  T[0] = (lane == 0) ? 1.f : 0.f;
#pragma unroll
  for (int i = 1; i < 64; ++i) {
    float ax = 0.f, ay = 0.f, az = 0.f, aw = 0.f;
#pragma unroll
    for (int j4 = 0; j4 < (i + 3) / 4; ++j4) {
      const float4 a = *(const float4*)(AL + i * 72 + 4 * j4);
      ax += a.x * T[4 * j4]; ay += a.y * T[4 * j4 + 1]; az += a.z * T[4 * j4 + 2]; aw += a.w * T[4 * j4 + 3];
    }
    T[i] = ((lane == i) ? 1.f : 0.f) - ((ax + ay) + (az + aw));
  }
}

__device__ __forceinline__ void d_gdn_prep(int item, char* smem, const unsigned short* __restrict__ pm,
                                           const float* __restrict__ gt, const float* __restrict__ conv_w, GdnBufs G) {
  unsigned short* qL = (unsigned short*)smem;
  unsigned short* kL = qL + 64 * 144;
  unsigned short* kTL = kL + 64 * 144;
  unsigned short* vTL = kTL + 128 * 72;
  float* scal = (float*)(vTL + 128 * 72);
  float* A0 = (float*)qL;
  float* A1 = (float*)kL;
  int tid = threadIdx.x;
  asm volatile("" : "+v"(tid));
  const int lane = tid & 63, w = __builtin_amdgcn_readfirstlane(tid >> 6), r = lane & 31, hh = lane >> 5;
  const int bh = item >> 6, c = item & 63, b = bh >> 2, h = bh & 3;
  const int t0 = b * SEQ + c * 64;
  __syncthreads();
  {
#pragma unroll
    for (int sec = 0; sec < 3; ++sec) {
      const int c0 = sec * 512 + h * 128 + 2 * lane;
      float cw0[5], cw1[5];
#pragma unroll
      for (int j = 0; j < 5; ++j) { cw0[j] = conv_w[c0 * 5 + j]; cw1[j] = conv_w[(c0 + 1) * 5 + j]; }
      unsigned raw[20];
#pragma unroll
      for (int k = 0; k < 20; ++k) {
        const int sp = c * 64 + w * 16 + k - 2;
        raw[k] = (sp >= 0 && sp < SEQ) ? *(const unsigned*)(pm + ((size_t)t0 + w * 16 + k - 2) * 4096 + c0) : 0u;
      }
#pragma unroll
      for (int ii = 0; ii < 16; ++ii) {
        const int i = w * 16 + ii;
        float a0 = 0.f, a1 = 0.f;
#pragma unroll
        for (int j = 0; j < 5; ++j) {
          a0 += cw0[j] * bf2f((unsigned short)(raw[ii + j] & 0xffff));
          a1 += cw1[j] * __uint_as_float(raw[ii + j] & 0xffff0000u);
        }
        a0 = a0 * __builtin_amdgcn_rcpf(1.f + __builtin_amdgcn_exp2f(-1.4426950408889634f * a0));
        a1 = a1 * __builtin_amdgcn_rcpf(1.f + __builtin_amdgcn_exp2f(-1.4426950408889634f * a1));
        if (sec < 2) {
          const float ss = wave_sum(a0 * a0 + a1 * a1);
          float sc = rsqrtf(ss + EPSF);
          if (sec == 0) sc *= 0.08838834764831845f;
          a0 *= sc; a1 *= sc;
        }
        if (sec == 0) {
          *(unsigned*)(qL + i * 144 + 2 * lane) = pack2(a0, a1);
        } else if (sec == 1) {
          const unsigned pk = pack2(a0, a1);
          *(unsigned*)(kL + i * 144 + 2 * lane) = pk;
          kTL[(2 * lane) * 72 + i] = (unsigned short)(pk & 0xffff);
          kTL[(2 * lane + 1) * 72 + i] = (unsigned short)(pk >> 16);
        } else {
          const unsigned pk = pack2(a0, a1);
          vTL[(2 * lane) * 72 + i] = (unsigned short)(pk & 0xffff);
          vTL[(2 * lane + 1) * 72 + i] = (unsigned short)(pk >> 16);
        }
      }
    }
  }
  if (w == 0) {
    const float* gp = gt + ((size_t)t0 + lane) * 32;
    const float g0 = gp[h], g1 = gp[4 + h], b0 = gp[8 + h], b1 = gp[12 + h];
    float G0 = g0, G1 = g1;
#pragma unroll
    for (int o = 1; o < 64; o <<= 1) {
      const float v0 = __shfl_up(G0, o, 64);
      const float v1 = __shfl_down(G1, o, 64);
      if (lane >= o) G0 += v0;
      if (lane + o < 64) G1 += v1;
    }
    scal[lane] = G0 * 1.4426950408889634f; scal[64 + lane] = G1 * 1.4426950408889634f;
    scal[128 + lane] = b0; scal[192 + lane] = b1;
    const float GL0 = __shfl(G0, 63, 64), GL1 = __shfl(G1, 0, 64);
    float* gs0 = G.gsc + ((size_t)((bh * 2 + 0) * 64 + c)) * 192;
    float* gs1 = G.gsc + ((size_t)((bh * 2 + 1) * 64 + c)) * 192;
    gs0[lane] = expf(G0); gs0[64 + lane] = expf(GL0 - G0);
    gs1[lane] = expf(G1); gs1[64 + lane] = expf(GL1 - G1);
    if (lane == 0) { gs0[128] = expf(GL0); gs1[128] = expf(GL1); }
  }
  __syncthreads();
  {
    unsigned short* qg = G.qc + (size_t)item * 8192;
    unsigned short* kg = G.kTc + (size_t)item * 8192;
#pragma unroll
    for (int i = 0; i < 4; ++i) {
      const int id = tid + i * 256;
      *(uint4*)(qg + (id >> 4) * 128 + (id & 15) * 8) = *(const uint4*)(qL + (id >> 4) * 144 + (id & 15) * 8);
      *(uint4*)(kg + (id >> 3) * 64 + (id & 7) * 8) = *(const uint4*)(kTL + (id >> 3) * 72 + (id & 7) * 8);
    }
  }
  {
    const int ta = w >> 1, tb = w & 1;
    f32x16 acc, acc2;
#pragma unroll
    for (int i = 0; i < 16; ++i) { acc[i] = 0.f; acc2[i] = 0.f; }
#pragma unroll
    for (int s = 0; s < 8; ++s) {
      const bf16x8 a = *(const bf16x8*)(kL + (32 * ta + r) * 144 + 16 * s + 8 * hh);
      const bf16x8 bk = *(const bf16x8*)(kL + (32 * tb + r) * 144 + 16 * s + 8 * hh);
      const bf16x8 bq = *(const bf16x8*)(qL + (32 * tb + r) * 144 + 16 * s + 8 * hh);
      acc = MFMA32(a, bk, acc);
      acc2 = MFMA32(a, bq, acc2);
    }
    __syncthreads();
    {
      const int col = 32 * tb + r;
      const float G0c = scal[col], G1c = scal[64 + col];
#pragma unroll
      for (int reg = 0; reg < 16; ++reg) {
        const int row = 32 * ta + crow(reg, hh);
        const float v = acc[reg];
        const float a0 = (col < row) ? scal[128 + row] * v * __builtin_amdgcn_exp2f(scal[row] - G0c) : 0.f;
        const float a1 = (col > row) ? scal[192 + row] * v * __builtin_amdgcn_exp2f(scal[64 + row] - G1c) : 0.f;
        A0[row * 72 + col] = a0;
        A1[(63 - row) * 72 + (63 - col)] = a1;
      }
    }
    {
      const int i = 32 * tb + r;
      const float G0i = scal[i], G1i = scal[64 + i];
      unsigned short* qk0 = G.qkc + ((size_t)((bh * 2 + 0) * 64 + c)) * 4096;
      unsigned short* qk1 = G.qkc + ((size_t)((bh * 2 + 1) * 64 + c)) * 4096;
#pragma unroll
      for (int g = 0; g < 4; ++g) {
        float o0[4], o1[4];
#pragma unroll
        for (int e = 0; e < 4; ++e) {
          const int j = 32 * ta + 8 * g + 4 * hh + e;
          const float v = acc2[4 * g + e];
          o0[e] = (j <= i) ? v * __builtin_amdgcn_exp2f(G0i - scal[j]) : 0.f;
          o1[e] = (j >= i) ? v * __builtin_amdgcn_exp2f(G1i - scal[64 + j]) : 0.f;
        }
        uint2 p0, p1;
        p0.x = pack2(o0[0], o0[1]); p0.y = pack2(o0[2], o0[3]);
        p1.x = pack2(o1[0], o1[1]); p1.y = pack2(o1[2], o1[3]);
        *(uint2*)(qk0 + i * 64 + 32 * ta + 8 * g + 4 * hh) = p0;
        *(uint2*)(qk1 + i * 64 + 32 * ta + 8 * g + 4 * hh) = p1;
      }
    }
  }
  __syncthreads();
  if (w < 2) {
    const int dir = w;
    float T[64];
    tri_subst(A0 + dir * (64 * 72), lane, T);
    const int jn = dir ? 63 - lane : lane;
    const float sb = scal[128 + 64 * dir + jn];
    const float sbg = sb * __builtin_amdgcn_exp2f(scal[64 * dir + jn]);
    unsigned short* Tb = dir ? kL : qL;
    unsigned short* Tbg = Tb + 64 * 72;
#pragma unroll
    for (int ip = 0; ip < 64; ++ip) {
      const int in = dir ? 63 - ip : ip;
      Tb[in * 72 + jn] = f2bf(T[ip] * sb);
      Tbg[in * 72 + jn] = f2bf(T[ip] * sbg);
    }
  }
  __syncthreads();
#pragma unroll
  for (int d = 0; d < 2; ++d) {
    const int chain = bh * 2 + d;
    const unsigned short* Tb = d ? kL : qL;
    const unsigned short* Tbg = Tb + 64 * 72;
    unsigned short* wng = G.wn + ((size_t)(chain * 64 + c)) * 8192;
    unsigned short* uog = G.uo + ((size_t)(chain * 64 + c)) * 8192 + w * 2048;
#pragma unroll
    for (int tb = 0; tb < 2; ++tb) {
      f32x16 acc, acc2;
#pragma unroll
      for (int i = 0; i < 16; ++i) { acc[i] = 0.f; acc2[i] = 0.f; }
#pragma unroll
      for (int s = 0; s < 4; ++s) {
        const bf16x8 a = *(const bf16x8*)(kTL + (32 * w + r) * 72 + 16 * s + 8 * hh);
        const bf16x8 bb = *(const bf16x8*)(Tbg + (32 * tb + r) * 72 + 16 * s + 8 * hh);
        acc = MFMA32(a, bb, acc);
        const bf16x8 a2 = *(const bf16x8*)(Tb + (32 * tb + r) * 72 + 16 * s + 8 * hh);
        const bf16x8 b2 = *(const bf16x8*)(vTL + (32 * w + r) * 72 + 16 * s + 8 * hh);
        acc2 = MFMA32(a2, b2, acc2);
      }
#pragma unroll
      for (int g = 0; g < 4; ++g) {
        uint2 pk;
        pk.x = pack2(-acc[4 * g], -acc[4 * g + 1]); pk.y = pack2(-acc[4 * g + 2], -acc[4 * g + 3]);
        *(uint2*)(wng + (32 * tb + r) * 128 + 32 * w + 8 * g + 4 * hh) = pk;
      }
      uint4 u0, u1;
      u0.x = pack2(acc2[0], acc2[1]); u0.y = pack2(acc2[2], acc2[3]); u0.z = pack2(acc2[4], acc2[5]); u0.w = pack2(acc2[6], acc2[7]);
      u1.x = pack2(acc2[8], acc2[9]); u1.y = pack2(acc2[10], acc2[11]); u1.z = pack2(acc2[12], acc2[13]); u1.w = pack2(acc2[14], acc2[15]);
      *(uint4*)(uog + tb * 1024 + lane * 16) = u0;
      *(uint4*)(uog + tb * 1024 + lane * 16 + 8) = u1;
    }
  }
}

struct GdnOps {
  bf16x8 a[8];
  bf16x8 x[4];
  bf16x8 kt[4];
  float4 rs[4];
  float gtot;
};
__device__ __forceinline__ void gdn_load(GdnOps& o, const GdnBufs& G, int chain, int bh, int c, int sl, int w, int r, int hh, int lane) {
  const unsigned short* kT_c = G.kTc + ((size_t)(bh * 64 + c)) * 8192;
  const float* gs = G.gsc + ((size_t)(chain * 64 + c)) * 192;
  const int ti = w & 1;
#pragma unroll
  for (int s = 0; s < 4; ++s) o.kt[s] = *(const bf16x8*)(kT_c + (32 * w + r) * 64 + 16 * s + 8 * hh);
  o.gtot = gs[128];
  if (w < 2) {
    const unsigned short* wn_c = G.wn + ((size_t)(chain * 64 + c)) * 8192;
    const unsigned short* uo_c = G.uo + ((size_t)(chain * 64 + c)) * 8192 + sl * 2048;
#pragma unroll
    for (int s = 0; s < 8; ++s) o.a[s] = *(const bf16x8*)(wn_c + (32 * ti + r) * 128 + 16 * s + 8 * hh);
    o.x[0] = *(const bf16x8*)(uo_c + ti * 1024 + lane * 16);
    o.x[1] = *(const bf16x8*)(uo_c + ti * 1024 + lane * 16 + 8);
#pragma unroll
    for (int g = 0; g < 4; ++g) o.rs[g] = *(const float4*)(gs + 64 + 32 * ti + 8 * g + 4 * hh);
  } else {
    const unsigned short* q_c = G.qc + ((size_t)(bh * 64 + c)) * 8192;
    const unsigned short* qk_c = G.qkc + ((size_t)(chain * 64 + c)) * 4096;
#pragma unroll
    for (int s = 0; s < 8; ++s) o.a[s] = *(const bf16x8*)(q_c + (32 * ti + r) * 128 + 16 * s + 8 * hh);
#pragma unroll
    for (int s = 0; s < 4; ++s) o.x[s] = *(const bf16x8*)(qk_c + (32 * ti + r) * 64 + 16 * s + 8 * hh);
#pragma unroll
    for (int g = 0; g < 4; ++g) o.rs[g] = *(const float4*)(gs + 32 * ti + 8 * g + 4 * hh);
  }
}
__device__ __forceinline__ void gdn_step(const GdnOps& o, f32x16& S, unsigned short* ST, unsigned short* VT, unsigned short* VdT,
                                         unsigned short* uo_c, int w, int r, int hh) {
  const int ti = w & 1;
  f32x16 acc;
  if (w < 2) {
#pragma unroll
    for (int i = 0; i < 8; ++i) {
      acc[i] = bf2f((unsigned short)o.x[0][i]);
      acc[8 + i] = bf2f((unsigned short)o.x[1][i]);
    }
  } else {
#pragma unroll
    for (int i = 0; i < 16; ++i) acc[i] = 0.f;
  }
#pragma unroll
  for (int g = 0; g < 4; ++g) {
    uint2 pk;
    pk.x = pack2(S[4 * g], S[4 * g + 1]); pk.y = pack2(S[4 * g + 2], S[4 * g + 3]);
    *(uint2*)(ST + r * 136 + 32 * w + 8 * g + 4 * hh) = pk;
  }
  __syncthreads();
#pragma unroll
  for (int s = 0; s < 8; ++s) {
    const bf16x8 bs = *(const bf16x8*)(ST + r * 136 + 16 * s + 8 * hh);
    acc = MFMA32(o.a[s], bs, acc);
  }
  if (w < 2) {
#pragma unroll
    for (int g = 0; g < 4; ++g) {
      uint2 pk, pd;
      pk.x = pack2(acc[4 * g], acc[4 * g + 1]); pk.y = pack2(acc[4 * g + 2], acc[4 * g + 3]);
      pd.x = pack2(acc[4 * g] * o.rs[g].x, acc[4 * g + 1] * o.rs[g].y);
      pd.y = pack2(acc[4 * g + 2] * o.rs[g].z, acc[4 * g + 3] * o.rs[g].w);
      *(uint2*)(VT + r * 72 + 32 * ti + 8 * g + 4 * hh) = pk;
      *(uint2*)(VdT + r * 72 + 32 * ti + 8 * g + 4 * hh) = pd;
    }
  } else {
#pragma unroll
    for (int g = 0; g < 4; ++g) {
      acc[4 * g] *= o.rs[g].x; acc[4 * g + 1] *= o.rs[g].y; acc[4 * g + 2] *= o.rs[g].z; acc[4 * g + 3] *= o.rs[g].w;
    }
  }
  __syncthreads();
  if (w >= 2) {
#pragma unroll
    for (int s = 0; s < 4; ++s) {
      const bf16x8 bv = *(const bf16x8*)(VT + r * 72 + 16 * s + 8 * hh);
      acc = MFMA32(o.x[s], bv, acc);
    }
#pragma unroll
    for (int reg = 0; reg < 16; ++reg) uo_c[(32 * ti + crow(reg, hh)) * 32 + r] = f2bf(acc[reg]);
  }
#pragma unroll
  for (int i = 0; i < 16; ++i) S[i] *= o.gtot;
#pragma unroll
  for (int s = 0; s < 4; ++s) {
    const bf16x8 bv = *(const bf16x8*)(VdT + r * 72 + 16 * s + 8 * hh);
    S = MFMA32(o.kt[s], bv, S);
  }
}
__device__ __forceinline__ void d_gdn_scan(int chain, int sl, char* smem, GdnBufs G) {
  unsigned short* ST = (unsigned short*)smem;
  unsigned short* VT = ST + 32 * 136;
  unsigned short* VdT = VT + 32 * 72;
  const int tid = threadIdx.x, lane = tid & 63, w = __builtin_amdgcn_readfirstlane(tid >> 6), r = lane & 31, hh = lane >> 5;
  const int bh = chain >> 1, dir = chain & 1;
  f32x16 S;
#pragma unroll
  for (int i = 0; i < 16; ++i) S[i] = 0.f;
  GdnOps A, B;
  gdn_load(A, G, chain, bh, dir ? 63 : 0, sl, w, r, hh, lane);
  for (int step = 0; step < 64; step += 2) {
    const int c0 = dir ? 63 - step : step;
    const int c1 = dir ? c0 - 1 : c0 + 1;
    const int c2 = dir ? c0 - 2 : c0 + 2;
    gdn_load(B, G, chain, bh, c1, sl, w, r, hh, lane);
    gdn_step(A, S, ST, VT, VdT, G.uo + ((size_t)(chain * 64 + c0)) * 8192 + sl * 2048, w, r, hh);
    if (step + 2 < 64) gdn_load(A, G, chain, bh, c2, sl, w, r, hh, lane);
    gdn_step(B, S, ST, VT, VdT, G.uo + ((size_t)(chain * 64 + c1)) * 8192 + sl * 2048, w, r, hh);
  }
}

#define ML_LOAD(T0)                                                                                         \
  {                                                                                                         \
    _Pragma("unroll") for (int i_ = 0; i_ < 8; ++i_) {                                                      \
      const int id_ = t128 + i_ * 128;                                                                      \
      pq[i_] = *(const uint4*)(pm + ((T0) + (id_ >> 4)) * 4096 + 2048 + h * 128 + (id_ & 15) * 8);          \
      pk[i_] = *(const uint4*)(pm + ((T0) + (id_ >> 4)) * 4096 + 2560 + h * 128 + (id_ & 15) * 8);          \
    }                                                                                                       \
    _Pragma("unroll") for (int i_ = 0; i_ < 2; ++i_) {                                                      \
      const int id_ = t128 + i_ * 128;                                                                      \
      pv[i_] = *(const uint4*)(pm + ((T0) + (id_ >> 2)) * 4096 + 3072 + h * 128 + sl * 32 + (id_ & 3) * 8); \
    }                                                                                                       \
    plf = gt[((T0) + lane) * 32 + 24 + dir * 4 + h];                                                        \
    pip = gt[((T0) + lane) * 32 + 16 + dir * 4 + h];                                                        \
  }
__device__ __forceinline__ void ml_state_image(const f32x16& S0, const f32x16& S1, unsigned short* S0T, unsigned short* nL, int w, int r, int hh) {
#pragma unroll
  for (int g = 0; g < 4; ++g) {
    uint2 pk;
    pk.x = pack2(S0[4 * g], S0[4 * g + 1]); pk.y = pack2(S0[4 * g + 2], S0[4 * g + 3]);
    *(uint2*)(S0T + r * 136 + 32 * w + 8 * g + 4 * hh) = pk;
    if (r == 0) {
      uint2 pn;
      pn.x = pack2(S1[4 * g], S1[4 * g + 1]); pn.y = pack2(S1[4 * g + 2], S1[4 * g + 3]);
      *(uint2*)(nL + 32 * w + 8 * g + 4 * hh) = pn;
    }
  }
}
__device__ __forceinline__ void ml_state_update(f32x16& S0, f32x16& S1, const unsigned short* kdL, const unsigned short* vTL,
                                                float gtot, int w, int r, int hh) {
  bf16x8 ones;
#pragma unroll
  for (int i = 0; i < 8; ++i) ones[i] = (short)0x3F80;
#pragma unroll
  for (int i = 0; i < 16; ++i) { S0[i] *= gtot; S1[i] *= gtot; }
#pragma unroll
  for (int s2 = 0; s2 < 4; ++s2) {
    union { bf16x8 v; unsigned short e[8]; } a;
#pragma unroll
    for (int e = 0; e < 8; ++e) a.e[e] = kdL[(16 * s2 + 8 * hh + e) * 136 + 32 * w + r];
    const bf16x8 bv = *(const bf16x8*)(vTL + r * 72 + 16 * s2 + 8 * hh);
    S0 = MFMA32(a.v, bv, S0);
    S1 = MFMA32(a.v, ones, S1);
  }
}
__device__ __forceinline__ void d_mlstm_scan(int chain, int sl, char* smem, const unsigned short* __restrict__ pm,
                                             const float* __restrict__ gt, unsigned short* __restrict__ oM, int ntok) {
  unsigned short* qL = (unsigned short*)smem;
  unsigned short* kL = qL + 64 * 136;
  unsigned short* kdL = kL + 64 * 136;
  unsigned short* vTL = kdL + 64 * 136;
  unsigned short* S0T = vTL + 32 * 72;
  unsigned short* nL = S0T + 32 * 136;
  float* scal = (float*)(nL + 256);
  const int tid = threadIdx.x, lane = tid & 63, w = __builtin_amdgcn_readfirstlane(tid >> 6), r = lane & 31, hh = lane >> 5;
  const int bh = chain >> 1, dir = chain & 1, b = bh >> 2, h = bh & 3;
  const float SCALE = 0.08838834764831845f;
  f32x16 S0, S1;
#pragma unroll
  for (int i = 0; i < 16; ++i) { S0[i] = 0.f; S1[i] = 0.f; }
  unsigned short* oMb = oM + (size_t)dir * ntok * 512 + h * 128 + sl * 32;
  const size_t tb = (size_t)b * SEQ;
  if (w >= 2) {
    const int t128 = tid - 128;
    uint4 pq[8], pk[8], pv[2];
    float plf, pip;
    ML_LOAD(tb + (dir ? 63 : 0) * 64);
    for (int step = 0; step < 64; ++step) {
      const int c0 = dir ? 63 - step : step;
      const int c1 = dir ? c0 - 1 : c0 + 1;
      float bc = plf;
#pragma unroll
      for (int ofs = 1; ofs < 64; ofs <<= 1) {
        const float vu = __shfl_up(bc, ofs, 64);
        const float vd = __shfl_down(bc, ofs, 64);
        if (dir == 0) { if (lane >= ofs) bc += vu; } else { if (lane + ofs < 64) bc += vd; }
      }
      const float b_last = __shfl(bc, dir ? 0 : 63, 64);
      const float Dj = SCALE * expf(b_last - bc + pip);
      const float gtot = expf(b_last);
      __syncthreads();
      if (w == 2) {
        scal[lane] = expf(bc);
        scal[64 + lane] = (pip - bc) * 1.4426950408889634f - 3.5f;
        scal[128 + lane] = bc * 1.4426950408889634f;
        if (lane == 0) scal[192] = gtot;
      }
#pragma unroll
      for (int i = 0; i < 8; ++i) {
        const int id = t128 + i * 128;
        const int row = id >> 4, c16 = id & 15;
        const uint4 kv = pk[i];
        const uint4 qv = pq[i];
        *(uint4*)(qL + row * 136 + c16 * 8) = qv;
        *(uint4*)(kL + row * 136 + c16 * 8) = kv;
        const float d = __shfl(Dj, row, 64);
        uint4 kd;
        kd.x = pack2(bf2f(kv.x & 0xffff) * d, bf2f(kv.x >> 16) * d);
        kd.y = pack2(bf2f(kv.y & 0xffff) * d, bf2f(kv.y >> 16) * d);
        kd.z = pack2(bf2f(kv.z & 0xffff) * d, bf2f(kv.z >> 16) * d);
        kd.w = pack2(bf2f(kv.w & 0xffff) * d, bf2f(kv.w >> 16) * d);
        *(uint4*)(kdL + row * 136 + c16 * 8) = kd;
      }
#pragma unroll
      for (int i = 0; i < 2; ++i) {
        const int id = t128 + i * 128;
        const int tok = id >> 2, d8 = (id & 3) * 8;
        const uint4 vv = pv[i];
        vTL[(d8 + 0) * 72 + tok] = (unsigned short)(vv.x & 0xffff);
        vTL[(d8 + 1) * 72 + tok] = (unsigned short)(vv.x >> 16);
        vTL[(d8 + 2) * 72 + tok] = (unsigned short)(vv.y & 0xffff);
        vTL[(d8 + 3) * 72 + tok] = (unsigned short)(vv.y >> 16);
        vTL[(d8 + 4) * 72 + tok] = (unsigned short)(vv.z & 0xffff);
        vTL[(d8 + 5) * 72 + tok] = (unsigned short)(vv.z >> 16);
        vTL[(d8 + 6) * 72 + tok] = (unsigned short)(vv.w & 0xffff);
        vTL[(d8 + 7) * 72 + tok] = (unsigned short)(vv.w >> 16);
      }
      if (step + 1 < 64) ML_LOAD(tb + c1 * 64);
      ml_state_image(S0, S1, S0T, nL, w, r, hh);
      __syncthreads();
      ml_state_update(S0, S1, kdL, vTL, gtot, w, r, hh);
    }
  } else {
    bf16x8 ones;
#pragma unroll
    for (int i = 0; i < 8; ++i) ones[i] = (short)0x3F80;
    const int ti = w;
    const int icol = 32 * ti + r;
    for (int step = 0; step < 64; ++step) {
      const int c0 = dir ? 63 - step : step;
      __syncthreads();
      ml_state_image(S0, S1, S0T, nL, w, r, hh);
      __syncthreads();
      const float bci = scal[128 + icol];
      const float gtot = scal[192];
      f32x16 Q0, Q1;
#pragma unroll
      for (int i = 0; i < 16; ++i) { Q0[i] = 0.f; Q1[i] = 0.f; }
#pragma unroll
      for (int s2 = 0; s2 < 8; ++s2) {
        const bf16x8 a = *(const bf16x8*)(qL + (32 * ti + r) * 136 + 16 * s2 + 8 * hh);
        const bf16x8 b0 = *(const bf16x8*)(S0T + r * 136 + 16 * s2 + 8 * hh);
        const bf16x8 b1 = *(const bf16x8*)(nL + 16 * s2 + 8 * hh);
        Q0 = MFMA32(a, b0, Q0);
        Q1 = MFMA32(a, b1, Q1);
      }
#pragma unroll
      for (int g = 0; g < 4; ++g) {
        const float4 e4 = *(const float4*)(scal + 32 * ti + 8 * g + 4 * hh);
        Q0[4 * g] *= e4.x; Q0[4 * g + 1] *= e4.y; Q0[4 * g + 2] *= e4.z; Q0[4 * g + 3] *= e4.w;
        Q1[4 * g] *= e4.x; Q1[4 * g + 1] *= e4.y; Q1[4 * g + 2] *= e4.z; Q1[4 * g + 3] *= e4.w;
      }
#pragma unroll
      for (int tj = 0; tj < 2; ++tj) {
        if (dir ? (tj < ti) : (tj > ti)) continue;
        f32x16 X;
#pragma unroll
        for (int i = 0; i < 16; ++i) X[i] = 0.f;
#pragma unroll
        for (int s2 = 0; s2 < 8; ++s2) {
          const bf16x8 a = *(const bf16x8*)(kL + (32 * tj + r) * 136 + 16 * s2 + 8 * hh);
          const bf16x8 bq = *(const bf16x8*)(qL + (32 * ti + r) * 136 + 16 * s2 + 8 * hh);
          X = MFMA32(a, bq, X);
        }
#pragma unroll
        for (int g = 0; g < 4; ++g) {
          const float4 cj4 = *(const float4*)(scal + 64 + 32 * tj + 8 * g + 4 * hh);
          const float cjs[4] = {cj4.x, cj4.y, cj4.z, cj4.w};
#pragma unroll
          for (int e = 0; e < 4; ++e) {
            const int j = 32 * tj + 8 * g + 4 * hh + e;
            const bool valid = dir ? (j >= icol) : (j <= icol);
            const float arg = valid ? (bci + cjs[e]) : -INFINITY;
            X[4 * g + e] *= __builtin_amdgcn_exp2f(arg);
          }
        }
#pragma unroll
        for (int s2 = 0; s2 < 2; ++s2) {
          union { bf16x8 v; unsigned u[4]; } xa, bv;
          xa.u[0] = pack2(X[8 * s2 + 0], X[8 * s2 + 1]); xa.u[1] = pack2(X[8 * s2 + 2], X[8 * s2 + 3]);
          xa.u[2] = pack2(X[8 * s2 + 4], X[8 * s2 + 5]); xa.u[3] = pack2(X[8 * s2 + 6], X[8 * s2 + 7]);
          const uint2 v0 = *(const uint2*)(vTL + r * 72 + 32 * tj + 16 * s2 + 4 * hh);
          const uint2 v1 = *(const uint2*)(vTL + r * 72 + 32 * tj + 16 * s2 + 8 + 4 * hh);
          bv.u[0] = v0.x; bv.u[1] = v0.y; bv.u[2] = v1.x; bv.u[3] = v1.y;
          Q0 = MFMA32(xa.v, bv.v, Q0);
          Q1 = MFMA32(xa.v, ones, Q1);
        }
      }
      const size_t orow0 = tb + c0 * 64;
#pragma unroll
      for (int reg = 0; reg < 16; ++reg) {
        const int i = 32 * ti + crow(reg, hh);
        oMb[(orow0 + i) * 512 + r] = f2bf(Q0[reg] * __builtin_amdgcn_rcpf(fmaxf(fabsf(Q1[reg]), 1.f)));
      }
      ml_state_update(S0, S1, kdL, vTL, gtot, w, r, hh);
    }
  }
}

struct MKP {
  const float *x, *norm1_g, *w_in, *conv_w, *a_log, *dt_bias, *gdn_g, *i_bias, *f_bias, *ml_g, *w_out, *norm2_g, *peer_wq,
      *peer_keys, *peer_u, *peer_v, *normf_g;
  float* out;
  unsigned short *pm, *x1b, *woutT, *mt, *xb, *winT, *oM, *yb, *scores, *qkv_dbg, *oA_dbg;
  unsigned *utab, *vtab;
  unsigned short *wqb, *keyb;
  float *uscale, *vscale;
  float *x1, *rs1, *rs2, *gt, *gateb, *dbg;
  unsigned* bar;
  int* idxb;
  GdnBufs G;
};

constexpr int SMEM_BYTES = 74752;
__global__ void __launch_bounds__(256, 2) k_mega(MKP P) {
  __shared__ __attribute__((aligned(16))) char smem_c[SMEM_BYTES + 16];
  {
    volatile LAS unsigned* st0 = (volatile LAS unsigned*)(smem_c + SMEM_BYTES);
    if (threadIdx.x < 4) st0[threadIdx.x] = 0u;
  }
  __syncthreads();
  XcdBarrier xb = xcd_barrier_post(P.bar, (volatile LAS unsigned*)(smem_c + SMEM_BYTES));
  unsigned short* smem = (unsigned short*)smem_c;
  const int nb = gridDim.x, bid = blockIdx.x;
  for (int it = bid; it < NT / 4; it += nb) d_prep_x(it, P.x, P.xb, P.rs1);
  for (int it = bid; it < 16 * 66; it += nb) d_transpose_w(it, 66, (float*)smem_c, P.w_in, DIN, P.norm1_g, P.winT, 1);
  for (int it = bid; it < 16 * 16; it += nb) d_transpose_w(it, 16, (float*)smem_c, P.w_out, 1024, nullptr, P.woutT, 0);
  for (int it = bid; it < 1024; it += nb) d_cvt_bf16(it, P.peer_wq, P.wqb, P.norm2_g, 11);
  for (int it = bid; it < 128; it += nb) d_cvt_bf16(it, P.peer_keys, P.keyb, nullptr, 0);
  if (bid == 0 && threadIdx.x < 4) P.dbg[threadIdx.x] = 0.f;
  xcd_barrier(xb);
  {
    GemmP p{};
    p.A = P.xb; p.lda = DM; p.Bt = P.winT; p.ldb = DM; p.K = DM;
    p.rowscale = P.rs1; p.obf = P.pm; p.ldo = 4096; p.of32 = P.gt; p.ldf = 32; p.resid = nullptr;
    p.a_log = P.a_log; p.dt_bias = P.dt_bias; p.i_bias = P.i_bias; p.f_bias = P.f_bias;
    for (int k = 0;; ++k) {
      int tm, tn;
      if (!xcd_tile(bid, nb, k, 33, tm, tn)) break;
      gemm_tile<EPI_INPROJ>(p, tm, tn, smem);
      __syncthreads();
    }
  }
  for (int tile = bid; tile < 16 * 8; tile += nb) {
    const int hp = tile >> 3, tn = tile & 7;
    GemmP p{};
    p.A = P.keyb + (size_t)hp * 128 * 128; p.lda = 128; p.Bt = P.wqb + hp * 128; p.ldb = 2048; p.K = 128;
    p.obf = P.mt + (size_t)hp * 128 * DM; p.ldo = DM;
    gemm_tile<EPI_PLAIN>(p, 0, tn, smem);
    __syncthreads();
  }
  xcd_barrier(xb);
  for (int it = bid; it < 1024; it += nb) d_gdn_prep(it, smem_c, P.pm, P.gt, P.conv_w, P.G);
  xcd_barrier(xb);
  if (bid < 128) {
    d_gdn_scan(bid >> 2, bid & 3, smem_c, P.G);
  } else if (bid < 256) {
    d_mlstm_scan((bid - 128) >> 2, (bid - 128) & 3, smem_c, P.pm, P.gt, P.oM, NT);
  }
#ifdef DBG_CHECK
  if (bid < 4) {
    __syncthreads();
    const int half = threadIdx.x >> 7;
    float* sq = (float*)smem + half * 256;
    float* sk = sq + 128;
    d_mlstm_rec(bid * 2 + half, sq, sk, P.pm, P.gt, P.oA_dbg, 4096);
  }
#endif
  xcd_barrier(xb);
  for (int it = bid; it < NT / 4; it += nb) d_combine(it, P.G.uo, P.oM, P.pm, P.gdn_g, P.ml_g, P.yb);
#ifdef DBG_CHECK
  for (int it = bid; it < 4096 / 4; it += nb) d_dbg_cmp_m(it, P.oM, P.oA_dbg, P.dbg);
#endif
  xcd_barrier(xb);
  {
    GemmP p{};
    p.A = P.yb; p.lda = DM; p.Bt = P.woutT; p.ldb = DM; p.K = DM;
    p.rowscale = nullptr; p.obf = P.x1b; p.ldo = DM; p.of32 = P.x1; p.ldf = DM; p.resid = P.x; p.rowacc = P.rs2;
    for (int k = 0;; ++k) {
      int tm, tn;
      if (!xcd_tile(bid, nb, k, 8, tm, tn)) break;
      gemm_tile<EPI_OUTPROJ>(p, tm, tn, smem);
      __syncthreads();
    }
  }
  for (int it = bid; it < 4096; it += nb) { d_cvt_tab(it, P.peer_u, P.utab, P.uscale); d_cvt_tab(it, P.peer_v, P.vtab, P.vscale); }
  xcd_barrier(xb);
  {
    GemmP p{};
    p.A = P.x1b; p.lda = DM; p.Bt = P.mt; p.ldb = DM; p.K = DM;
    p.rowscale = P.rs2; p.obf = P.scores; p.ldo = 2048; p.of32 = nullptr; p.ldf = 0; p.resid = nullptr;
    for (int k = 0;; ++k) {
      int tm, tn;
      if (!xcd_tile(bid, nb, k, 16, tm, tn)) break;
      gemm_tile<EPI_SCORES>(p, tm, tn, smem);
      __syncthreads();
    }
  }
  xcd_barrier(xb);
  float oscale = 1.f;
#ifdef DBG_CHECK
  {
    const float sd = __hip_atomic_load(&P.dbg[0], __ATOMIC_RELAXED, __HIP_MEMORY_SCOPE_AGENT);
    const float sr = __hip_atomic_load(&P.dbg[1], __ATOMIC_RELAXED, __HIP_MEMORY_SCOPE_AGENT);
    oscale = 1.f + sqrtf(sd / sr);
  }
#endif
  for (int it = bid; it < NT / 32; it += nb) {
    d_topk(it, P.scores, P.idxb, P.gateb);
    __threadfence_block();
    __syncthreads();
#pragma unroll 1
    for (int sub = 0; sub < 8; ++sub)
      d_peer(it * 8 + sub, P.x1, P.rs2, P.norm2_g, P.idxb, P.gateb, P.utab, P.vtab, P.uscale, P.vscale, P.normf_g, P.out, oscale);
  }
}

extern "C" void kernel_launch(void* const* d_in, const int* in_sizes, int n_in, void* d_out, int out_size, void* d_ws,
                              size_t ws_size, hipStream_t stream) {
  MKP P{};
  P.x = (const float*)d_in[0];
  P.norm1_g = (const float*)d_in[1];
  P.w_in = (const float*)d_in[2];
  P.conv_w = (const float*)d_in[3];
  P.a_log = (const float*)d_in[4];
  P.dt_bias = (const float*)d_in[5];
  P.gdn_g = (const float*)d_in[6];
  P.i_bias = (const float*)d_in[7];
  P.f_bias = (const float*)d_in[8];
  P.ml_g = (const float*)d_in[9];
  P.w_out = (const float*)d_in[10];
  P.norm2_g = (const float*)d_in[11];
  P.peer_wq = (const float*)d_in[12];
  P.peer_keys = (const float*)d_in[13];
  P.peer_u = (const float*)d_in[14];
  P.peer_v = (const float*)d_in[15];
  P.normf_g = (const float*)d_in[16];
  P.out = (float*)d_out;

  char* ws = (char*)d_ws;
  const size_t MB = 1024 * 1024;
  P.pm = (unsigned short*)(ws);
  P.x1 = (float*)(ws);
  P.x1b = (unsigned short*)(ws + 64 * MB);
  P.utab = (unsigned*)(ws + 96 * MB);
  P.vtab = (unsigned*)(ws + 112 * MB);
  P.uscale = (float*)(ws + 136 * MB);
  P.vscale = (float*)(ws + 136 * MB + 65536);
  char* rb = ws + 128 * MB;
  P.woutT = (unsigned short*)(rb);
  P.mt = (unsigned short*)(rb + 2 * MB);
  P.rs1 = (float*)(rb + 6 * MB);
  P.rs2 = (float*)(rb + 7 * MB);
  P.dbg = (float*)(rb + 6 * MB + 131072);
  P.bar = (unsigned*)(rb + 6 * MB + 196608);
  P.gt = (float*)(rb + 9 * MB);
  char* dyn = rb + 11 * MB;
  P.xb = (unsigned short*)(dyn);
  P.winT = (unsigned short*)(dyn + 32 * MB);
  P.wqb = (unsigned short*)(dyn + 41 * MB);
  P.keyb = (unsigned short*)(dyn + 45 * MB);
  P.G.qc = (unsigned short*)(dyn);
  P.G.kTc = (unsigned short*)(dyn + 16 * MB);
  P.G.qkc = (unsigned short*)(dyn + 32 * MB);
  P.G.wn = (unsigned short*)(dyn + 48 * MB);
  P.G.uo = (unsigned short*)(dyn + 80 * MB);
  P.G.gsc = (float*)(dyn + 112 * MB);
  P.yb = (unsigned short*)(dyn);
  P.scores = (unsigned short*)(dyn);
  P.idxb = (int*)(dyn + 64 * MB);
  P.gateb = (float*)(dyn + 72 * MB);
  char* os = (char*)d_out;
  P.oM = (unsigned short*)(os);
  P.qkv_dbg = (unsigned short*)(os + 32 * MB);
  P.oA_dbg = (unsigned short*)(os + 44 * MB);

  static int grid_blocks = 0;
  if (!grid_blocks) {
    int dev = 0, cus = 0, per_cu = 0;
    (void)hipGetDevice(&dev);
    (void)hipDeviceGetAttribute(&cus, hipDeviceAttributeMultiprocessorCount, dev);
    (void)hipOccupancyMaxActiveBlocksPerMultiprocessor(&per_cu, k_mega, 256, 0);
    if (per_cu > 2) per_cu = 2;
    if (per_cu < 1) per_cu = 1;
    grid_blocks = cus * per_cu;
  }
  (void)hipMemsetAsync(P.bar, 0, XCD_BAR_WORDS * sizeof(unsigned), stream);
  hipLaunchKernelGGL(k_mega, dim3(grid_blocks), dim3(256), 0, stream, P);
}
```

```cpp
#include <hip/hip_runtime.h>
#include <hip/hip_bf16.h>
#include <stdint.h>
#include <cstdio>

#define XB_TMO      128
#define XB_XCNT(j)  (256  + 64 * (j))
#define XB_XSUB(j)  (1280 + 64 * (j))
#define XB_XGEN(j)  (2304 + 64 * (j))
#define XB_TOP      3328
#define XB_TOPGEN   3392
#define XCD_BAR_WORDS 3456
#define XB_SPIN_CAP (1u << 18)
#define LAS __attribute__((address_space(3)))

__device__ __forceinline__ unsigned xb_ld(unsigned* p)              { return __hip_atomic_load(p, __ATOMIC_RELAXED, __HIP_MEMORY_SCOPE_AGENT); }
__device__ __forceinline__ unsigned xb_add(unsigned* p, unsigned v) { return __hip_atomic_fetch_add(p, v, __ATOMIC_RELAXED, __HIP_MEMORY_SCOPE_AGENT); }
__device__ __forceinline__ unsigned xb_xcc_id() { return (unsigned)__builtin_amdgcn_s_getreg((3 << 11) | 20) & 0xFu; }
#define XB_SPIN(cond, bar) do { unsigned _sp = 0; while (cond) { __builtin_amdgcn_s_sleep(1); \
    if ((++_sp & 255u) == 0u) { if (xb_ld(&(bar)[XB_TMO])) break; if (_sp > XB_SPIN_CAP) { atomicAdd(&(bar)[XB_TMO], 1u); break; } } } } while (0)

struct XcdBarrier {
    unsigned* bar; unsigned x;
    volatile LAS unsigned* st;
};

__device__ __forceinline__ XcdBarrier xcd_barrier_post(unsigned* bar, volatile LAS unsigned* st) {
    XcdBarrier b; b.bar = bar; b.x = xb_xcc_id(); b.st = st;
    if (threadIdx.x == 0) (void)xb_add(&bar[XB_XCNT(b.x)], 1u);
    return b;
}
__device__ __forceinline__ void xcd_barrier_complete(unsigned* bar, unsigned x, unsigned& nloc, unsigned& nx) {
    const unsigned G = gridDim.x * gridDim.y * gridDim.z;
    unsigned sum, cnt, mine, sp = 0u;
    for (;;) {
        sum = 0u; cnt = 0u; mine = 0u;
#pragma unroll
        for (unsigned j = 0; j < 16; ++j) { const unsigned c = xb_ld(&bar[XB_XCNT(j)]); sum += c; cnt += (c > 0u) ? 1u : 0u; mine = (j == x) ? c : mine; }
        if (sum == G) break;
        __builtin_amdgcn_s_sleep(1);
        if ((++sp & 255u) == 0u) { if (xb_ld(&bar[XB_TMO])) break; if (sp > XB_SPIN_CAP) { atomicAdd(&bar[XB_TMO], 1u); break; } }
    }
    nloc = mine > 0u ? mine : 1u; nx = cnt > 0u ? cnt : 1u;
}

__device__ __forceinline__ void xcd_barrier(const XcdBarrier& b) {
    asm volatile("s_waitcnt vmcnt(0)" ::: "memory");
    __syncthreads();
    if (threadIdx.x == 0) {
        unsigned* bar = b.bar;
        __builtin_amdgcn_s_waitcnt(0);
        unsigned nloc = b.st[0], nx = b.st[1];
        if (nloc == 0u) { xcd_barrier_complete(bar, b.x, nloc, nx); b.st[0] = nloc; b.st[1] = nx; }
        const unsigned old = xb_add(&bar[XB_XSUB(b.x)], 1u);
        const unsigned gen = old / nloc;
        if (old + 1u == (gen + 1u) * nloc) {
            __builtin_amdgcn_fence(__ATOMIC_RELEASE, "agent");
            asm volatile("s_waitcnt vmcnt(0)" ::: "memory");
            const unsigned og = xb_add(&bar[XB_TOP], 1u);
            const unsigned tg = og / nx;
            if (og + 1u == (tg + 1u) * nx) xb_add(&bar[XB_TOPGEN], 1u);
            else XB_SPIN(xb_ld(&bar[XB_TOPGEN]) == tg, bar);
            __builtin_amdgcn_fence(__ATOMIC_ACQUIRE, "agent");
            xb_add(&bar[XB_XGEN(b.x)], 1u);
            asm volatile("s_waitcnt vmcnt(0)" ::: "memory");
        } else {
            XB_SPIN(xb_ld(&bar[XB_XGEN(b.x)]) == gen, bar);
            __builtin_amdgcn_fence(__ATOMIC_ACQUIRE, "agent");
            asm volatile("s_waitcnt vmcnt(0)" ::: "memory");
        }
    }
    __syncthreads();
}


typedef __hip_bfloat16 bf16;
typedef __attribute__((ext_vector_type(8))) short bf16x8;
typedef __attribute__((ext_vector_type(4))) float f32x4;

constexpr int DM = 1024;
constexpr int NB = 4;
constexpr int SEQ = 4096;
constexpr int NT = NB * SEQ;
constexpr int DIN = 4128;
constexpr int NPAD_IN = 4224;
constexpr float EPSF = 1e-6f;

__device__ __forceinline__ float bf2f(unsigned short u) { return __uint_as_float(((unsigned)u) << 16); }
typedef __bf16 bf16x2_t __attribute__((ext_vector_type(2)));
typedef float f32x2_t __attribute__((ext_vector_type(2)));
__device__ __forceinline__ unsigned short f2bf(float f) { return __builtin_bit_cast(unsigned short, (__bf16)f); }
__device__ __forceinline__ unsigned pack2(float a, float b) {
  f32x2_t v = {a, b};
  return __builtin_bit_cast(unsigned, __builtin_convertvector(v, bf16x2_t));
}
__device__ __forceinline__ float wave_sum(float v) {
#pragma unroll
  for (int o = 32; o > 0; o >>= 1) v += __shfl_xor(v, o, 64);
  return v;
}
__device__ __forceinline__ float softplusf(float x) { return fmaxf(x, 0.f) + log1pf(expf(-fabsf(x))); }
__device__ __forceinline__ float sigmoidf(float x) { return __builtin_amdgcn_rcpf(1.f + __builtin_amdgcn_exp2f(-1.4426950408889634f * x)); }

__device__ __forceinline__ void d_prep_x(int item, const float* __restrict__ x, unsigned short* __restrict__ xb,
                                                float* __restrict__ rs) {
  int t = item * 4 + (threadIdx.x >> 6);
  int lane = threadIdx.x & 63;
  const float4* xr = (const float4*)(x + (size_t)t * DM);
  float ss = 0.f;
#pragma unroll
  for (int i = 0; i < 4; ++i) {
    float4 v = xr[lane + 64 * i];
    ss += v.x * v.x + v.y * v.y + v.z * v.z + v.w * v.w;
    ushort4 o;
    o.x = f2bf(v.x); o.y = f2bf(v.y); o.z = f2bf(v.z); o.w = f2bf(v.w);
    ((ushort4*)(xb + (size_t)t * DM))[lane + 64 * i] = o;
  }
  ss = wave_sum(ss);
  if (lane == 0) rs[t] = rsqrtf(ss * (1.f / DM) + EPSF);
}

__device__ __forceinline__ int win_src(int n) {
  if (n < 2048) return n;
  if (n < 4096) return n + 16;
  int j = n - 4096;
  if (j < 16) return 2048 + j;
  if (j < 32) return 4112 + (j - 16);
  return -1;
}
__device__ __forceinline__ void d_transpose_w(int item, int ntn, float* tile, const float* __restrict__ in, int ldn,
                                              const float* __restrict__ g, unsigned short* __restrict__ out, int mode) {
  const int kt = item / ntn, nt = item % ntn;
  const int tid = threadIdx.x;
  __syncthreads();
#pragma unroll
  for (int i = 0; i < 4; ++i) {
    const int row = (tid >> 4) + 16 * i;
    const int c4 = (tid & 15) * 4;
    const int n = nt * 64 + c4;
    const int src = mode ? win_src(n) : n;
    float4 v = make_float4(0.f, 0.f, 0.f, 0.f);
    if (src >= 0) {
      v = *(const float4*)(in + (size_t)(kt * 64 + row) * ldn + src);
      if (g) { const float gg = g[kt * 64 + row]; v.x *= gg; v.y *= gg; v.z *= gg; v.w *= gg; }
    }
    tile[row * 65 + c4] = v.x; tile[row * 65 + c4 + 1] = v.y; tile[row * 65 + c4 + 2] = v.z; tile[row * 65 + c4 + 3] = v.w;
  }
  __syncthreads();
  {
    const int n = tid >> 2, k16 = (tid & 3) * 16;
    uint4 o0, o1;
    o0.x = pack2(tile[(k16 + 0) * 65 + n], tile[(k16 + 1) * 65 + n]);   o0.y = pack2(tile[(k16 + 2) * 65 + n], tile[(k16 + 3) * 65 + n]);
    o0.z = pack2(tile[(k16 + 4) * 65 + n], tile[(k16 + 5) * 65 + n]);   o0.w = pack2(tile[(k16 + 6) * 65 + n], tile[(k16 + 7) * 65 + n]);
    o1.x = pack2(tile[(k16 + 8) * 65 + n], tile[(k16 + 9) * 65 + n]);   o1.y = pack2(tile[(k16 + 10) * 65 + n], tile[(k16 + 11) * 65 + n]);
    o1.z = pack2(tile[(k16 + 12) * 65 + n], tile[(k16 + 13) * 65 + n]); o1.w = pack2(tile[(k16 + 14) * 65 + n], tile[(k16 + 15) * 65 + n]);
    unsigned short* op = out + (size_t)(nt * 64 + n) * DM + kt * 64 + k16;
    *(uint4*)op = o0;
    *(uint4*)(op + 8) = o1;
  }
}
__device__ __forceinline__ void d_cvt_bf16(int item, const float* __restrict__ src, unsigned short* __restrict__ dst,
                                           const float* __restrict__ rowscale, int rowlen_log2) {
  const size_t base = (size_t)item * 2048 + threadIdx.x * 8;
  float4 a = *(const float4*)(src + base);
  float4 b = *(const float4*)(src + base + 4);
  if (rowscale) {
    const float sc = rowscale[base >> rowlen_log2];
    a.x *= sc; a.y *= sc; a.z *= sc; a.w *= sc; b.x *= sc; b.y *= sc; b.z *= sc; b.w *= sc;
  }
  uint4 o;
  o.x = pack2(a.x, a.y); o.y = pack2(a.z, a.w); o.z = pack2(b.x, b.y); o.w = pack2(b.z, b.w);
  *(uint4*)(dst + base) = o;
}

constexpr int GBM = 128, GBN = 128, GBK = 64, GLD = 64;
struct GemmP {
  const unsigned short* A; const unsigned short* Bt; int lda, ldb, K;
  const float* rowscale;
  unsigned short* obf; int ldo;
  float* of32; int ldf;
  const float* resid;
  const float *a_log, *dt_bias, *i_bias, *f_bias;
  float* rowacc;
};
enum { EPI_INPROJ = 0, EPI_OUTPROJ = 1, EPI_SCORES = 2, EPI_PLAIN = 3 };

template <int EPI>
__device__ __forceinline__ void gemm_tile(const GemmP p, int tm, int tn, unsigned short* smem) {
  unsigned short* As = smem;
  unsigned short* Bs = smem + 2 * GBM * GLD;
  int tid = threadIdx.x;
  asm volatile("" : "+v"(tid));
  const int lane = tid & 63, wid = tid >> 6;
  const int wm = wid >> 1, wn = wid & 1;
  const int m0 = tm * GBM, n0 = tn * GBN;
  f32x4 acc[4][4];
#pragma unroll
  for (int i = 0; i < 4; ++i)
#pragma unroll
    for (int j = 0; j < 4; ++j) acc[i][j] = (f32x4){0.f, 0.f, 0.f, 0.f};

  uint4 ra0, ra1, ra2, ra3, rb0, rb1, rb2, rb3;
  uint4 sa0, sa1, sa2, sa3, sb0, sb1, sb2, sb3;
  const int nk = p.K / GBK;
  const int lrow = tid >> 3, lc8 = tid & 7;
  const unsigned short* Ag = p.A + (size_t)(m0 + lrow) * p.lda + lc8 * 8;
  const unsigned short* Bg = p.Bt + (size_t)(n0 + lrow) * p.ldb + lc8 * 8;
  const size_t a32 = (size_t)32 * p.lda, b32 = (size_t)32 * p.ldb;
#define GLOAD(R, S, kt)                                                  \
  {                                                                      \
    R##0 = *(const uint4*)(Ag + (kt) * GBK);                             \
    R##1 = *(const uint4*)(Ag + a32 + (kt) * GBK);                       \
    R##2 = *(const uint4*)(Ag + 2 * a32 + (kt) * GBK);                   \
    R##3 = *(const uint4*)(Ag + 3 * a32 + (kt) * GBK);                   \
    S##0 = *(const uint4*)(Bg + (kt) * GBK);                             \
    S##1 = *(const uint4*)(Bg + b32 + (kt) * GBK);                       \
    S##2 = *(const uint4*)(Bg + 2 * b32 + (kt) * GBK);                   \
    S##3 = *(const uint4*)(Bg + 3 * b32 + (kt) * GBK);                   \
  }
#define SSTORE(R, S, buf)                                                \
  {                                                                      \
    unsigned short* ad = As + (size_t)(buf) * GBM * GLD + lrow * GLD + ((lc8 ^ (lrow & 7)) * 8); \
    unsigned short* bd = Bs + (size_t)(buf) * GBN * GLD + lrow * GLD + ((lc8 ^ (lrow & 7)) * 8); \
    *(uint4*)(ad) = R##0; *(uint4*)(ad + 32 * GLD) = R##1; *(uint4*)(ad + 64 * GLD) = R##2; *(uint4*)(ad + 96 * GLD) = R##3; \
    *(uint4*)(bd) = S##0; *(uint4*)(bd + 32 * GLD) = S##1; *(uint4*)(bd + 64 * GLD) = S##2; *(uint4*)(bd + 96 * GLD) = S##3; \
  }
#define GCOMPUTE(buf)                                                                                                     \
  {                                                                                                                       \
    const unsigned short* Ab = As + (size_t)(buf) * GBM * GLD;                                                            \
    const unsigned short* Bb = Bs + (size_t)(buf) * GBN * GLD;                                                            \
    _Pragma("unroll") for (int ks = 0; ks < 2; ++ks) {                                                                    \
      bf16x8 a[4], b[4];                                                                                                  \
      const int kc = ((ks * 4 + (lane >> 4)) ^ (lane & 7)) * 8;                   \
      _Pragma("unroll") for (int i = 0; i < 4; ++i) a[i] = *(const bf16x8*)(Ab + (wm * 64 + i * 16 + (lane & 15)) * GLD + kc); \
      _Pragma("unroll") for (int j = 0; j < 4; ++j) b[j] = *(const bf16x8*)(Bb + (wn * 64 + j * 16 + (lane & 15)) * GLD + kc); \
      _Pragma("unroll") for (int i = 0; i < 4; ++i)                                                                       \
        _Pragma("unroll") for (int j = 0; j < 4; ++j)                                                                     \
          acc[i][j] = __builtin_amdgcn_mfma_f32_16x16x32_bf16(b[j], a[i], acc[i][j], 0, 0, 0);               \
    }                                                                                                                     \
  }
  GLOAD(ra, rb, 0);
  if (nk > 1) GLOAD(sa, sb, 1);
  SSTORE(ra, rb, 0);
  __syncthreads();
  for (int kt = 0; kt < nk; kt += 2) {
    if (kt + 2 < nk) GLOAD(ra, rb, kt + 2);
    GCOMPUTE(0);
    if (kt + 1 < nk) SSTORE(sa, sb, 1);
    __syncthreads();
    if (kt + 1 < nk) {
      if (kt + 3 < nk) GLOAD(sa, sb, kt + 3);
      GCOMPUTE(1);
      if (kt + 2 < nk) SSTORE(ra, rb, 0);
      __syncthreads();
    }
  }
#undef GLOAD
#undef SSTORE
#undef GCOMPUTE
#pragma unroll
  for (int i = 0; i < 4; ++i) {
    const int row = m0 + wm * 64 + i * 16 + (lane & 15);
    float rsc = 1.f;
    float rowss = 0.f;
    if (EPI == EPI_INPROJ) rsc = p.rowscale[row];
    if (EPI == EPI_SCORES) {
      const float4* pr = (const float4*)(p.rowscale + (size_t)row * 16);
      const float4 s0 = pr[0], s1 = pr[1], s2 = pr[2], s3 = pr[3];
      const float ssq = ((s0.x + s0.y) + (s0.z + s0.w)) + ((s1.x + s1.y) + (s1.z + s1.w)) + ((s2.x + s2.y) + (s2.z + s2.w)) + ((s3.x + s3.y) + (s3.z + s3.w));
      rsc = rsqrtf(ssq * (1.f / DM) + EPSF);
    }
#pragma unroll
    for (int j = 0; j < 4; ++j) {
      const int col0 = n0 + wn * 64 + j * 16 + (lane >> 4) * 4;
      const float v0 = acc[i][j][0] * rsc, v1 = acc[i][j][1] * rsc, v2 = acc[i][j][2] * rsc, v3 = acc[i][j][3] * rsc;
      if (EPI == EPI_INPROJ) {
        if (col0 < 4096) {
          uint2 pk; pk.x = pack2(v0, v1); pk.y = pack2(v2, v3);
          *(uint2*)(p.obf + (size_t)row * p.ldo + col0) = pk;
        } else if (col0 < 4128) {
          const float vv[4] = {v0, v1, v2, v3};
          float oo[4];
#pragma unroll
          for (int r = 0; r < 4; ++r) {
            const int jg = col0 - 4096 + r, jj = jg & 7;
            const float v = vv[r];
            float o;
            if (jg < 8) o = -expf(p.a_log[jj]) * softplusf(v + p.dt_bias[jj]);
            else if (jg < 16) o = sigmoidf(v);
            else if (jg < 24) o = v + p.i_bias[jj];
            else o = -softplusf(-(v + p.f_bias[jj]));
            oo[r] = o;
          }
          *(float4*)(p.of32 + (size_t)row * p.ldf + (col0 - 4096)) = make_float4(oo[0], oo[1], oo[2], oo[3]);
        }
      } else if (EPI == EPI_OUTPROJ) {
        const float4 xr = *(const float4*)(p.resid + (size_t)row * p.ldf + col0);
        const float x0 = v0 + xr.x, x1 = v1 + xr.y, x2 = v2 + xr.z, x3 = v3 + xr.w;
        *(float4*)(p.of32 + (size_t)row * p.ldf + col0) = make_float4(x0, x1, x2, x3);
        uint2 pk; pk.x = pack2(x0, x1); pk.y = pack2(x2, x3);
        *(uint2*)(p.obf + (size_t)row * p.ldo + col0) = pk;
        rowss += (x0 * x0 + x1 * x1) + (x2 * x2 + x3 * x3);
      } else {
        uint2 pk; pk.x = pack2(v0, v1); pk.y = pack2(v2, v3);
        *(uint2*)(p.obf + (size_t)row * p.ldo + col0) = pk;
      }
    }
    if (EPI == EPI_OUTPROJ) {
      rowss += __shfl_xor(rowss, 16, 64);
      rowss += __shfl_xor(rowss, 32, 64);
      if ((lane >> 4) == 0) p.rowacc[(size_t)row * 16 + tn * 2 + wn] = rowss;
    }
  }
}

__device__ __forceinline__ bool xcd_tile(int bid, int nb, int k, int ntn, int& tm, int& tn) {
  const int q = (bid >> 3) + (nb >> 3) * k;
  if (q >= 16 * ntn) return false;
  const int g = q / (8 * ntn), rem = q % (8 * ntn);
  tn = rem >> 3;
  tm = 16 * (bid & 7) + 8 * g + (rem & 7);
  return true;
}

__device__ __forceinline__ void d_conv(int item, const unsigned short* __restrict__ pm, const float* __restrict__ pg,
                                              const float* __restrict__ conv_w, const float* __restrict__ a_log,
                                              const float* __restrict__ dt_bias, const float* __restrict__ i_bias,
                                              const float* __restrict__ f_bias, unsigned short* __restrict__ qkv,
                                              float* __restrict__ gt) {
  int t = item * 4 + (threadIdx.x >> 6);
  int lane = threadIdx.x & 63;
  int s = t & (SEQ - 1);
  for (int sec = 0; sec < 3; ++sec) {
    for (int h = 0; h < 4; ++h) {
      int c0 = sec * 512 + h * 128 + 2 * lane;
      float a0 = 0.f, a1 = 0.f;
#pragma unroll
      for (int j = 0; j < 5; ++j) {
        int sp = s + j - 2;
        if (sp >= 0 && sp < SEQ) {
          unsigned v = *(const unsigned*)(pm + (size_t)(t + j - 2) * 4096 + c0);
          a0 += conv_w[c0 * 5 + j] * bf2f((unsigned short)(v & 0xffff));
          a1 += conv_w[(c0 + 1) * 5 + j] * bf2f((unsigned short)(v >> 16));
        }
      }
      a0 = a0 * sigmoidf(a0);
      a1 = a1 * sigmoidf(a1);
      if (sec < 2) {
        float ss = wave_sum(a0 * a0 + a1 * a1);
        float sc = rsqrtf(ss + EPSF);
        if (sec == 0) sc *= 0.08838834764831845f;
        a0 *= sc; a1 *= sc;
      }
      unsigned o = pack2(a0, a1);
      *(unsigned*)(qkv + (size_t)t * 1536 + c0) = o;
    }
  }
}

__device__ __forceinline__ void d_gdn_rec(int chain, float* sq, float* sk, const unsigned short* __restrict__ qkv,
                                                 const float* __restrict__ gt, unsigned short* __restrict__ oA, int ntok) {
  const int bh = chain >> 1, dir = chain & 1;
  const int b = bh >> 2, h = bh & 3;
  const int e = threadIdx.x & 127;
  float S[128];
#pragma unroll
  for (int d = 0; d < 128; ++d) S[d] = 0.f;
  for (int it = 0; it < SEQ; ++it) {
    const int s = dir ? (SEQ - 1 - it) : it;
    const size_t t = (size_t)b * SEQ + s;
    __syncthreads();
    sq[e] = bf2f(qkv[t * 1536 + h * 128 + e]);
    sk[e] = bf2f(qkv[t * 1536 + 512 + h * 128 + e]);
    const float v = bf2f(qkv[t * 1536 + 1024 + h * 128 + e]);
    const float g = gt[t * 32 + dir * 4 + h];
    const float beta = gt[t * 32 + 8 + dir * 4 + h];
    __syncthreads();
    const float a = expf(g);
    float k0 = 0.f, k1 = 0.f, k2 = 0.f, k3 = 0.f;
#pragma unroll
    for (int d = 0; d < 128; d += 4) {
      k0 += sk[d] * S[d]; k1 += sk[d + 1] * S[d + 1]; k2 += sk[d + 2] * S[d + 2]; k3 += sk[d + 3] * S[d + 3];
    }
    const float kS = a * ((k0 + k1) + (k2 + k3));
    const float vn = beta * (v - kS);
    float o0 = 0.f, o1 = 0.f, o2 = 0.f, o3 = 0.f;
#pragma unroll
    for (int d = 0; d < 128; d += 4) {
      S[d] = a * S[d] + sk[d] * vn;             o0 += sq[d] * S[d];
      S[d + 1] = a * S[d + 1] + sk[d + 1] * vn; o1 += sq[d + 1] * S[d + 1];
      S[d + 2] = a * S[d + 2] + sk[d + 2] * vn; o2 += sq[d + 2] * S[d + 2];
      S[d + 3] = a * S[d + 3] + sk[d + 3] * vn; o3 += sq[d + 3] * S[d + 3];
    }
    oA[((size_t)dir * ntok + t) * 512 + h * 128 + e] = f2bf((o0 + o1) + (o2 + o3));
  }
}

__device__ __forceinline__ void d_mlstm_rec(int chain, float* sq, float* sk, const unsigned short* __restrict__ pm,
                                                   const float* __restrict__ gt, unsigned short* __restrict__ oM, int ntok) {
  const int bh = chain >> 1, dir = chain & 1;
  const int b = bh >> 2, h = bh & 3;
  const int e = threadIdx.x & 127, lane = e & 63;
  float C[128];
#pragma unroll
  for (int d = 0; d < 128; ++d) C[d] = 0.f;
  float n0 = 0.f, n1 = 0.f, m = 0.f;
  for (int it = 0; it < SEQ; ++it) {
    const int s = dir ? (SEQ - 1 - it) : it;
    const size_t t = (size_t)b * SEQ + s;
    __syncthreads();
    sq[e] = bf2f(pm[t * 4096 + 2048 + h * 128 + e]);
    sk[e] = bf2f(pm[t * 4096 + 2560 + h * 128 + e]) * 0.08838834764831845f;
    const float v = bf2f(pm[t * 4096 + 3072 + h * 128 + e]);
    const float ip = gt[t * 32 + 16 + dir * 4 + h];
    const float lf = gt[t * 32 + 24 + dir * 4 + h];
    __syncthreads();
    const float mn = fmaxf(lf + m, ip);
    const float fs = expf(lf + m - mn);
    const float is = expf(ip - mn);
    m = mn;
    n0 = fs * n0 + is * sk[lane];
    n1 = fs * n1 + is * sk[lane + 64];
    const float den = wave_sum(n0 * sq[lane] + n1 * sq[lane + 64]);
    const float iv = is * v;
    float o0 = 0.f, o1 = 0.f, o2 = 0.f, o3 = 0.f;
#pragma unroll
    for (int d = 0; d < 128; d += 4) {
      C[d] = fs * C[d] + sk[d] * iv;             o0 += sq[d] * C[d];
      C[d + 1] = fs * C[d + 1] + sk[d + 1] * iv; o1 += sq[d + 1] * C[d + 1];
      C[d + 2] = fs * C[d + 2] + sk[d + 2] * iv; o2 += sq[d + 2] * C[d + 2];
      C[d + 3] = fs * C[d + 3] + sk[d + 3] * iv; o3 += sq[d + 3] * C[d + 3];
    }
    const float num = (o0 + o1) + (o2 + o3);
    const float hh = num / fmaxf(fabsf(den), expf(-mn));
    oM[((size_t)dir * ntok + t) * 512 + h * 128 + e] = f2bf(hh);
  }
}

__device__ __forceinline__ void d_combine(int item, const unsigned short* __restrict__ uo, const unsigned short* __restrict__ oM,
                                                 const unsigned short* __restrict__ pm, const float* __restrict__ gdn_g,
                                                 const float* __restrict__ ml_g, unsigned short* __restrict__ y) {
  int tid_ = threadIdx.x;
  asm volatile("" : "+v"(tid_));
  const int t = item * 4 + (tid_ >> 6);
  const int lane = tid_ & 63;
  const int b = t >> 12, cc = (t >> 6) & 63, ii = t & 63;
  unsigned gf_[4], gb_[4], mf_[4], mb_[4], zg_[4], zo_[4];
  const size_t off = (size_t)cc * 8192 + (lane >> 4) * 2048 + ii * 32 + ((2 * lane) & 31);
#pragma unroll
  for (int h = 0; h < 4; ++h) {
    const int c = h * 128 + 2 * lane;
    const int chain0 = (b * 4 + h) * 2;
    gf_[h] = *(const unsigned*)(uo + (size_t)chain0 * 64 * 8192 + off);
    gb_[h] = *(const unsigned*)(uo + (size_t)(chain0 + 1) * 64 * 8192 + off);
    mf_[h] = *(const unsigned*)(oM + (size_t)t * 512 + c);
    mb_[h] = *(const unsigned*)(oM + ((size_t)NT + t) * 512 + c);
    zg_[h] = *(const unsigned*)(pm + (size_t)t * 4096 + 1536 + c);
    zo_[h] = *(const unsigned*)(pm + (size_t)t * 4096 + 3584 + c);
  }
  const float gg0 = gdn_g[2 * lane], gg1 = gdn_g[2 * lane + 1];
  float a0[4], a1[4], m0[4], m1[4], sa[4], sm[4];
#pragma unroll
  for (int h = 0; h < 4; ++h) {
    a0[h] = bf2f(gf_[h] & 0xffff) + bf2f(gb_[h] & 0xffff);
    a1[h] = __uint_as_float(gf_[h] & 0xffff0000u) + __uint_as_float(gb_[h] & 0xffff0000u);
    m0[h] = bf2f(mf_[h] & 0xffff) + bf2f(mb_[h] & 0xffff);
    m1[h] = __uint_as_float(mf_[h] & 0xffff0000u) + __uint_as_float(mb_[h] & 0xffff0000u);
    sa[h] = a0[h] * a0[h] + a1[h] * a1[h];
    sm[h] = m0[h] * m0[h] + m1[h] * m1[h];
  }
#pragma unroll
  for (int o = 32; o > 0; o >>= 1) {
#pragma unroll
    for (int h = 0; h < 4; ++h) { sa[h] += __shfl_xor(sa[h], o, 64); sm[h] += __shfl_xor(sm[h], o, 64); }
  }
#pragma unroll
  for (int h = 0; h < 4; ++h) {
    const int c = h * 128 + 2 * lane;
    const float sca = rsqrtf(sa[h] * (1.f / 128.f) + EPSF);
    const float scm = rsqrtf(sm[h] * (1.f / 128.f) + EPSF);
    const float z0 = bf2f(zg_[h] & 0xffff), z1 = __uint_as_float(zg_[h] & 0xffff0000u);
    const float q0 = bf2f(zo_[h] & 0xffff), q1 = __uint_as_float(zo_[h] & 0xffff0000u);
    const float o0 = a0[h] * sca * gg0 * (z0 * sigmoidf(z0));
    const float o1 = a1[h] * sca * gg1 * (z1 * sigmoidf(z1));
    const float p0 = m0[h] * scm * ml_g[c] * sigmoidf(q0);
    const float p1 = m1[h] * scm * ml_g[c + 1] * sigmoidf(q1);
    *(unsigned*)(y + (size_t)t * DM + c) = pack2(o0, o1);
    *(unsigned*)(y + (size_t)t * DM + 512 + c) = pack2(p0, p1);
  }
}

#ifdef DBG_CHECK
__device__ __forceinline__ void d_dbg_cmp(int item, const unsigned short* __restrict__ uo, const unsigned short* __restrict__ oAd,
                                          float* __restrict__ dbg) {
  int t = item * 4 + (threadIdx.x >> 6);
  int lane = threadIdx.x & 63;
  const int cc = (t >> 6) & 63, ii = t & 63;
  float sd = 0.f, sr = 0.f;
  for (int h = 0; h < 4; ++h) {
    for (int dir = 0; dir < 2; ++dir) {
      const int chain = h * 2 + dir;
      const size_t off = (size_t)cc * 8192 + (lane >> 4) * 2048 + ii * 32 + ((2 * lane) & 31);
      unsigned vn = *(const unsigned*)(uo + (size_t)chain * 64 * 8192 + off);
      unsigned vr = *(const unsigned*)(oAd + ((size_t)dir * 4096 + t) * 512 + h * 128 + 2 * lane);
      float n0 = bf2f(vn & 0xffff), n1 = bf2f(vn >> 16), r0 = bf2f(vr & 0xffff), r1 = bf2f(vr >> 16);
      sd += (n0 - r0) * (n0 - r0) + (n1 - r1) * (n1 - r1);
      sr += r0 * r0 + r1 * r1;
    }
  }
  sd = wave_sum(sd); sr = wave_sum(sr);
  if (lane == 0) { atomicAdd(&dbg[0], sd); atomicAdd(&dbg[1], sr); }
}
__device__ __forceinline__ void d_dbg_cmp_m(int item, const unsigned short* __restrict__ oM, const unsigned short* __restrict__ oMd,
                                            float* __restrict__ dbg) {
  int t = item * 4 + (threadIdx.x >> 6);
  int lane = threadIdx.x & 63;
  float sd = 0.f, sr = 0.f;
  for (int dir = 0; dir < 2; ++dir)
    for (int q = 0; q < 4; ++q) {
      unsigned vn = *(const unsigned*)(oM + ((size_t)dir * NT + t) * 512 + q * 128 + 2 * lane);
      unsigned vr = *(const unsigned*)(oMd + ((size_t)dir * 4096 + t) * 512 + q * 128 + 2 * lane);
      float n0 = bf2f(vn & 0xffff), n1 = bf2f(vn >> 16), r0 = bf2f(vr & 0xffff), r1 = bf2f(vr >> 16);
      sd += (n0 - r0) * (n0 - r0) + (n1 - r1) * (n1 - r1);
      sr += r0 * r0 + r1 * r1;
    }
  sd = wave_sum(sd); sr = wave_sum(sr);
  if (lane == 0) { atomicAdd(&dbg[0], sd); atomicAdd(&dbg[1], sr); }
}
#endif

__device__ __forceinline__ void d_prep_x1(int item, const float* __restrict__ x1, unsigned short* __restrict__ xb,
                                                 float* __restrict__ rs) {
  int t = item * 4 + (threadIdx.x >> 6);
  int lane = threadIdx.x & 63;
  const float4* xr = (const float4*)(x1 + (size_t)t * DM);
  float ss = 0.f;
#pragma unroll
  for (int i = 0; i < 4; ++i) {
    float4 v = xr[lane + 64 * i];
    ss += v.x * v.x + v.y * v.y + v.z * v.z + v.w * v.w;
    ushort4 o;
    o.x = f2bf(v.x); o.y = f2bf(v.y); o.z = f2bf(v.z); o.w = f2bf(v.w);
    ((ushort4*)(xb + (size_t)t * DM))[lane + 64 * i] = o;
  }
  ss = wave_sum(ss);
  if (lane == 0) rs[t] = rsqrtf(ss * (1.f / DM) + EPSF);
}

__device__ const unsigned char kPairTab[64] = {
    0x00, 0x01, 0x02, 0x03, 0x04, 0x05, 0x06, 0x07, 0x08, 0x09, 0x0a, 0x0b, 0x0c, 0x0d, 0x0e, 0x0f,
    0x10, 0x11, 0x12, 0x13, 0x14, 0x15, 0x16, 0x17,
    0x20, 0x21, 0x22, 0x23, 0x24,
    0x30, 0x31, 0x32, 0x33,
    0x40, 0x41, 0x42,
    0x50, 0x51, 0x60, 0x61, 0x70, 0x71,
    0x80, 0x90, 0xa0, 0xb0, 0xc0, 0xd0, 0xe0, 0xf0,
    0xff, 0xff, 0xff, 0xff, 0xff, 0xff, 0xff, 0xff, 0xff, 0xff, 0xff, 0xff, 0xff, 0xff};

__device__ __forceinline__ void sort16_desc(unsigned (&a)[16]) {
#pragma unroll
  for (int k = 2; k <= 16; k <<= 1)
#pragma unroll
    for (int j = k >> 1; j > 0; j >>= 1)
#pragma unroll
      for (int i = 0; i < 16; ++i) {
        const int l = i ^ j;
        if (l > i) {
          const unsigned hi = max(a[i], a[l]), lo = min(a[i], a[l]);
          if ((i & k) == 0) { a[i] = hi; a[l] = lo; } else { a[i] = lo; a[l] = hi; }
        }
      }
}
__device__ __forceinline__ void merge16_desc(unsigned (&top)[16], const unsigned (&b)[16]) {
#pragma unroll
  for (int i = 0; i < 16; ++i) top[i] = max(top[i], b[15 - i]);
#pragma unroll
  for (int j = 8; j > 0; j >>= 1)
#pragma unroll
    for (int i = 0; i < 16; ++i) {
      const int l = i ^ j;
      if (l > i) {
        const unsigned hi = max(top[i], top[l]), lo = min(top[i], top[l]);
        top[i] = hi; top[l] = lo;
      }
    }
}
__device__ __forceinline__ unsigned key16(unsigned hbits, int idx) {
  const unsigned m = hbits ^ ((hbits & 0x8000u) ? 0xFFFFu : 0x8000u);
  return (m << 16) | (unsigned)(127 - idx);
}
__device__ __forceinline__ void top16_of_128(const unsigned short* __restrict__ sp, unsigned (&top)[16]) {
#pragma unroll
  for (int g = 0; g < 8; ++g) {
    const uint4 x0 = *(const uint4*)(sp + g * 16);
    const uint4 x1 = *(const uint4*)(sp + g * 16 + 8);
    unsigned b[16];
    b[0] = key16(x0.x & 0xffff, g * 16 + 0);  b[1] = key16(x0.x >> 16, g * 16 + 1);
    b[2] = key16(x0.y & 0xffff, g * 16 + 2);  b[3] = key16(x0.y >> 16, g * 16 + 3);
    b[4] = key16(x0.z & 0xffff, g * 16 + 4);  b[5] = key16(x0.z >> 16, g * 16 + 5);
    b[6] = key16(x0.w & 0xffff, g * 16 + 6);  b[7] = key16(x0.w >> 16, g * 16 + 7);
    b[8] = key16(x1.x & 0xffff, g * 16 + 8);  b[9] = key16(x1.x >> 16, g * 16 + 9);
    b[10] = key16(x1.y & 0xffff, g * 16 + 10); b[11] = key16(x1.y >> 16, g * 16 + 11);
    b[12] = key16(x1.z & 0xffff, g * 16 + 12); b[13] = key16(x1.z >> 16, g * 16 + 13);
    b[14] = key16(x1.w & 0xffff, g * 16 + 14); b[15] = key16(x1.w >> 16, g * 16 + 15);
    sort16_desc(b);
    if (g == 0) {
#pragma unroll
      for (int i = 0; i < 16; ++i) top[i] = b[i];
    } else {
      merge16_desc(top, b);
    }
  }
}

__device__ __forceinline__ void d_topk(int item, const unsigned short* __restrict__ scores, int* __restrict__ idx_out,
                                       float* __restrict__ gate_out) {
  int tid_ = threadIdx.x;
  asm volatile("" : "+v"(tid_));
  const int pair = item * 256 + tid_;
  const unsigned short* sp = scores + (size_t)pair * 256;
  unsigned k0[16], k1[16];
  top16_of_128(sp, k0);
  top16_of_128(sp + 128, k1);
  float v0[16], v1[16];
  int i0[16], i1[16];
#pragma unroll
  for (int i = 0; i < 16; ++i) {
    const unsigned m0 = k0[i] >> 16, m1 = k1[i] >> 16;
    v0[i] = bf2f((unsigned short)(m0 ^ ((m0 & 0x8000u) ? 0x8000u : 0xFFFFu)));
    v1[i] = bf2f((unsigned short)(m1 ^ ((m1 & 0x8000u) ? 0x8000u : 0xFFFFu)));
    i0[i] = 127 - (int)(k0[i] & 127u);
    i1[i] = 127 - (int)(k1[i] & 127u);
  }
  unsigned top[16];
#pragma unroll
  for (int g = 0; g < 4; ++g) {
    unsigned b[16];
#pragma unroll
    for (int q = 0; q < 16; ++q) {
      const int pr = kPairTab[g * 16 + q];
      if (pr == 0xff) {
        b[q] = 0u;
      } else {
        const int pi = pr >> 4, pj = pr & 15;
        const float sum = v0[pi] + v1[pj];
        const unsigned u = __float_as_uint(sum);
        const unsigned mono = u ^ ((u & 0x80000000u) ? 0xFFFFFFFFu : 0x80000000u);
        b[q] = (mono & 0xFFFFC000u) | (unsigned)(16383 - (i0[pi] * 128 + i1[pj]));
      }
    }
    sort16_desc(b);
    if (g == 0) {
#pragma unroll
      for (int i = 0; i < 16; ++i) top[i] = b[i];
    } else {
      merge16_desc(top, b);
    }
  }
  float ev[16];
  int ci[16];
  float mx = 0.f, sum = 0.f;
#pragma unroll
  for (int i = 0; i < 16; ++i) {
    const unsigned mono = top[i] & 0xFFFFC000u;
    const unsigned u = mono ^ ((mono & 0x80000000u) ? 0x80000000u : 0xFFFFFFFFu);
    const float val = __uint_as_float(u & 0xFFFFC000u);
    ci[i] = 16383 - (int)(top[i] & 16383u);
    if (i == 0) mx = val;
    ev[i] = expf(val - mx);
    sum += ev[i];
  }
  const float inv = 1.f / sum;
#pragma unroll
  for (int q = 0; q < 4; ++q) {
    int4 o; float4 g;
    o.x = ci[4 * q]; o.y = ci[4 * q + 1]; o.z = ci[4 * q + 2]; o.w = ci[4 * q + 3];
    g.x = ev[4 * q] * inv; g.y = ev[4 * q + 1] * inv; g.z = ev[4 * q + 2] * inv; g.w = ev[4 * q + 3] * inv;
    *(int4*)(idx_out + (size_t)pair * 16 + 4 * q) = o;
    *(float4*)(gate_out + (size_t)pair * 16 + 4 * q) = g;
  }
}

typedef float f32x2 __attribute__((ext_vector_type(2)));
__device__ __forceinline__ void d_cvt_tab(int item, const float* __restrict__ src, unsigned* __restrict__ dst8, float* __restrict__ dscale) {
  const int row = item * 4 + (threadIdx.x >> 6);
  const int lane = threadIdx.x & 63;
  const float4* sr = (const float4*)(src + (size_t)row * DM + lane * 16);
  const float4 a = sr[0], b = sr[1], c = sr[2], d = sr[3];
  float m = fmaxf(fmaxf(fmaxf(fabsf(a.x), fabsf(a.y)), fmaxf(fabsf(a.z), fabsf(a.w))),
                  fmaxf(fmaxf(fabsf(b.x), fabsf(b.y)), fmaxf(fabsf(b.z), fabsf(b.w))));
  m = fmaxf(m, fmaxf(fmaxf(fmaxf(fabsf(c.x), fabsf(c.y)), fmaxf(fabsf(c.z), fabsf(c.w))),
                     fmaxf(fmaxf(fabsf(d.x), fabsf(d.y)), fmaxf(fabsf(d.z), fabsf(d.w)))));
#pragma unroll
  for (int o = 32; o > 0; o >>= 1) m = fmaxf(m, __shfl_xor(m, o, 64));
  const float sc = (m > 0.f) ? 240.f / m : 1.f;
  uint4 o;
  int p;
  p = 0; p = __builtin_amdgcn_cvt_pk_fp8_f32(a.x * sc, a.y * sc, p, false); p = __builtin_amdgcn_cvt_pk_fp8_f32(a.z * sc, a.w * sc, p, true); o.x = (unsigned)p;
  p = 0; p = __builtin_amdgcn_cvt_pk_fp8_f32(b.x * sc, b.y * sc, p, false); p = __builtin_amdgcn_cvt_pk_fp8_f32(b.z * sc, b.w * sc, p, true); o.y = (unsigned)p;
  p = 0; p = __builtin_amdgcn_cvt_pk_fp8_f32(c.x * sc, c.y * sc, p, false); p = __builtin_amdgcn_cvt_pk_fp8_f32(c.z * sc, c.w * sc, p, true); o.z = (unsigned)p;
  p = 0; p = __builtin_amdgcn_cvt_pk_fp8_f32(d.x * sc, d.y * sc, p, false); p = __builtin_amdgcn_cvt_pk_fp8_f32(d.z * sc, d.w * sc, p, true); o.w = (unsigned)p;
  *(uint4*)(dst8 + (size_t)row * 256 + lane * 4) = o;
  if (lane == 0) dscale[row] = (m > 0.f) ? m * (1.f / 240.f) : 1.f;
}

__device__ __forceinline__ float erf_fast(float x) {
  const float ax = fabsf(x);
  const float t = __builtin_amdgcn_rcpf(1.f + 0.3275911f * ax);
  float p = 1.061405429f;
  p = p * t - 1.453152027f;
  p = p * t + 1.421413741f;
  p = p * t - 0.284496736f;
  p = p * t + 0.254829592f;
  const float e = __builtin_amdgcn_exp2f(-1.4426950408889634f * ax * ax);
  const float r = 1.f - p * t * e;
  return copysignf(r, x);
}
__device__ __forceinline__ float dot16_f8(const uint4 u, const float* hv) {
  const f32x2 a0 = __builtin_amdgcn_cvt_pk_f32_fp8((int)u.x, false), a1 = __builtin_amdgcn_cvt_pk_f32_fp8((int)u.x, true);
  const f32x2 b0 = __builtin_amdgcn_cvt_pk_f32_fp8((int)u.y, false), b1 = __builtin_amdgcn_cvt_pk_f32_fp8((int)u.y, true);
  const f32x2 c0 = __builtin_amdgcn_cvt_pk_f32_fp8((int)u.z, false), c1 = __builtin_amdgcn_cvt_pk_f32_fp8((int)u.z, true);
  const f32x2 d0 = __builtin_amdgcn_cvt_pk_f32_fp8((int)u.w, false), d1 = __builtin_amdgcn_cvt_pk_f32_fp8((int)u.w, true);
  float s0 = a0[0] * hv[0] + a0[1] * hv[1];
  float s1 = a1[0] * hv[2] + a1[1] * hv[3];
  s0 += b0[0] * hv[4] + b0[1] * hv[5];
  s1 += b1[0] * hv[6] + b1[1] * hv[7];
  s0 += c0[0] * hv[8] + c0[1] * hv[9];
  s1 += c1[0] * hv[10] + c1[1] * hv[11];
  s0 += d0[0] * hv[12] + d0[1] * hv[13];
  s1 += d1[0] * hv[14] + d1[1] * hv[15];
  return s0 + s1;
}
__device__ __forceinline__ void axpy16_f8(const uint4 v, const float wg, float* acc) {
  const f32x2 a0 = __builtin_amdgcn_cvt_pk_f32_fp8((int)v.x, false), a1 = __builtin_amdgcn_cvt_pk_f32_fp8((int)v.x, true);
  const f32x2 b0 = __builtin_amdgcn_cvt_pk_f32_fp8((int)v.y, false), b1 = __builtin_amdgcn_cvt_pk_f32_fp8((int)v.y, true);
  const f32x2 c0 = __builtin_amdgcn_cvt_pk_f32_fp8((int)v.z, false), c1 = __builtin_amdgcn_cvt_pk_f32_fp8((int)v.z, true);
  const f32x2 d0 = __builtin_amdgcn_cvt_pk_f32_fp8((int)v.w, false), d1 = __builtin_amdgcn_cvt_pk_f32_fp8((int)v.w, true);
  acc[0] += wg * a0[0]; acc[1] += wg * a0[1]; acc[2] += wg * a1[0]; acc[3] += wg * a1[1];
  acc[4] += wg * b0[0]; acc[5] += wg * b0[1]; acc[6] += wg * b1[0]; acc[7] += wg * b1[1];
  acc[8] += wg * c0[0]; acc[9] += wg * c0[1]; acc[10] += wg * c1[0]; acc[11] += wg * c1[1];
  acc[12] += wg * d0[0]; acc[13] += wg * d0[1]; acc[14] += wg * d1[0]; acc[15] += wg * d1[1];
}
__device__ __forceinline__ void d_peer(int item, const float* __restrict__ x1, const float* __restrict__ rs2,
                                       const float* __restrict__ g2, const int* __restrict__ idx,
                                       const float* __restrict__ gate, const unsigned* __restrict__ pu,
                                       const unsigned* __restrict__ pv, const float* __restrict__ su,
                                       const float* __restrict__ sv, const float* __restrict__ gf,
                                       float* __restrict__ out, float oscale) {
  int tid_ = threadIdx.x;
  asm volatile("" : "+v"(tid_));
  const int t = item * 4 + (tid_ >> 6);
  const int lane = tid_ & 63;
  float r2;
  {
    const float4* pr = (const float4*)(rs2 + (size_t)t * 16);
    const float4 s0 = pr[0], s1 = pr[1], s2 = pr[2], s3 = pr[3];
    const float ssq = ((s0.x + s0.y) + (s0.z + s0.w)) + ((s1.x + s1.y) + (s1.z + s1.w)) + ((s2.x + s2.y) + (s2.z + s2.w)) + ((s3.x + s3.y) + (s3.z + s3.w));
    r2 = rsqrtf(ssq * (1.f / DM) + EPSF);
  }
  float xv[16], hv[16], acc[16];
#pragma unroll
  for (int q = 0; q < 4; ++q) {
    const float4 xx = *(const float4*)(x1 + (size_t)t * DM + lane * 16 + q * 4);
    const float4 gg = *(const float4*)(g2 + lane * 16 + q * 4);
    xv[q * 4 + 0] = xx.x; xv[q * 4 + 1] = xx.y; xv[q * 4 + 2] = xx.z; xv[q * 4 + 3] = xx.w;
    hv[q * 4 + 0] = xx.x * r2 * gg.x; hv[q * 4 + 1] = xx.y * r2 * gg.y;
    hv[q * 4 + 2] = xx.z * r2 * gg.z; hv[q * 4 + 3] = xx.w * r2 * gg.w;
  }
#pragma unroll
  for (int i = 0; i < 16; ++i) acc[i] = 0.f;
  const int id_a = idx[(size_t)t * 128 + lane], id_b = idx[(size_t)t * 128 + 64 + lane];
  const float gt_a = gate[(size_t)t * 128 + lane], gt_b = gate[(size_t)t * 128 + 64 + lane];
  for (int e0 = 0; e0 < 128; e0 += 8) {
    uint4 u[8], v[8];
    float gt8[8], su8[8], sv8[8];
#pragma unroll
    for (int k = 0; k < 8; ++k) {
      const int e = e0 + k;
      const int id = (e0 < 64) ? __shfl(id_a, e, 64) : __shfl(id_b, e - 64, 64);
      gt8[k] = (e0 < 64) ? __shfl(gt_a, e, 64) : __shfl(gt_b, e - 64, 64);
      u[k] = *(const uint4*)(pu + (size_t)id * 256 + lane * 4);
      v[k] = *(const uint4*)(pv + (size_t)id * 256 + lane * 4);
      su8[k] = su[id];
      sv8[k] = sv[id];
    }
    float d[8];
#pragma unroll
    for (int k = 0; k < 8; ++k) d[k] = dot16_f8(u[k], hv);
#pragma unroll
    for (int o = 32; o > 0; o >>= 1) {
#pragma unroll
      for (int k = 0; k < 8; ++k) d[k] += __shfl_xor(d[k], o, 64);
    }
#pragma unroll
    for (int k = 0; k < 8; ++k) {
      const float dd = d[k] * su8[k];
      const float act = 0.5f * dd * (1.f + erf_fast(dd * 0.7071067811865476f));
      axpy16_f8(v[k], gt8[k] * act * sv8[k], acc);
    }
  }
  float ss = 0.f;
#pragma unroll
  for (int i = 0; i < 16; ++i) { acc[i] += xv[i]; ss += acc[i] * acc[i]; }
  ss = wave_sum(ss);
  const float sc = rsqrtf(ss * (1.f / DM) + EPSF) * oscale;
#pragma unroll
  for (int q = 0; q < 4; ++q) {
    const float4 gg = *(const float4*)(gf + lane * 16 + q * 4);
    float4 o;
    o.x = acc[q * 4 + 0] * sc * gg.x; o.y = acc[q * 4 + 1] * sc * gg.y;
    o.z = acc[q * 4 + 2] * sc * gg.z; o.w = acc[q * 4 + 3] * sc * gg.w;
    *(float4*)(out + (size_t)t * DM + lane * 16 + q * 4) = o;
  }
}

typedef __attribute__((ext_vector_type(16))) float f32x16;
#define MFMA32(a, b, c) __builtin_amdgcn_mfma_f32_32x32x16_bf16((a), (b), (c), 0, 0, 0)
__device__ __forceinline__ int crow(int reg, int hh) { return (reg & 3) + 8 * (reg >> 2) + 4 * hh; }

struct GdnBufs {
  unsigned short* qc;
  unsigned short* kTc;
  unsigned short* qkc;
  unsigned short* wn;
  unsigned short* uo;
  float* gsc;
};

__device__ __forceinline__ void tri_subst(const float* AL0, int lane, float (&T)[64]) {
  const float* AL = (const float*)__builtin_assume_aligned(AL0, 16);
#pragma unroll
  for (int i = 0; i < 64; ++i) T[i] = 0.f;
  T[0] = (lane == 0) ? 1.f : 0.f;
#pragma unroll
  for (int i = 1; i < 64; ++i) {
    float ax = 0.f, ay = 0.f, az = 0.f, aw = 0.f;
#pragma unroll
    for (int j4 = 0; j4 < (i + 3) / 4; ++j4) {
      const float4 a = *(const float4*)(AL + i * 72 + 4 * j4);
      ax += a.x * T[4 * j4]; ay += a.y * T[4 * j4 + 1]; az += a.z * T[4 * j4 + 2]; aw += a.w * T[4 * j4 + 3];
    }
    T[i] = ((lane == i) ? 1.f : 0.f) - ((ax + ay) + (az + aw));
  }
}

__device__ __forceinline__ void d_gdn_prep(int item, char* smem, const unsigned short* __restrict__ pm,
                                           const float* __restrict__ gt, const float* __restrict__ conv_w, GdnBufs G) {
  unsigned short* qL = (unsigned short*)smem;
  unsigned short* kL = qL + 64 * 144;
  unsigned short* kTL = kL + 64 * 144;
  unsigned short* vTL = kTL + 128 * 72;
  float* scal = (float*)(vTL + 128 * 72);
  float* A0 = (float*)qL;
  float* A1 = (float*)kL;
  int tid = threadIdx.x;
  asm volatile("" : "+v"(tid));
  const int lane = tid & 63, w = __builtin_amdgcn_readfirstlane(tid >> 6), r = lane & 31, hh = lane >> 5;
  const int bh = item >> 6, c = item & 63, b = bh >> 2, h = bh & 3;
  const int t0 = b * SEQ + c * 64;
  __syncthreads();
  {
#pragma unroll
    for (int sec = 0; sec < 3; ++sec) {
      const int c0 = sec * 512 + h * 128 + 2 * lane;
      float cw0[5], cw1[5];
#pragma unroll
      for (int j = 0; j < 5; ++j) { cw0[j] = conv_w[c0 * 5 + j]; cw1[j] = conv_w[(c0 + 1) * 5 + j]; }
      unsigned raw[20];
#pragma unroll
      for (int k = 0; k < 20; ++k) {
        const int sp = c * 64 + w * 16 + k - 2;
        raw[k] = (sp >= 0 && sp < SEQ) ? *(const unsigned*)(pm + ((size_t)t0 + w * 16 + k - 2) * 4096 + c0) : 0u;
      }
#pragma unroll
      for (int ii = 0; ii < 16; ++ii) {
        const int i = w * 16 + ii;
        float a0 = 0.f, a1 = 0.f;
#pragma unroll
        for (int j = 0; j < 5; ++j) {
          a0 += cw0[j] * bf2f((unsigned short)(raw[ii + j] & 0xffff));
          a1 += cw1[j] * __uint_as_float(raw[ii + j] & 0xffff0000u);
        }
        a0 = a0 * __builtin_amdgcn_rcpf(1.f + __builtin_amdgcn_exp2f(-1.4426950408889634f * a0));
        a1 = a1 * __builtin_amdgcn_rcpf(1.f + __builtin_amdgcn_exp2f(-1.4426950408889634f * a1));
        if (sec < 2) {
          const float ss = wave_sum(a0 * a0 + a1 * a1);
          float sc = rsqrtf(ss + EPSF);
          if (sec == 0) sc *= 0.08838834764831845f;
          a0 *= sc; a1 *= sc;
        }
        if (sec == 0) {
          *(unsigned*)(qL + i * 144 + 2 * lane) = pack2(a0, a1);
        } else if (sec == 1) {
          const unsigned pk = pack2(a0, a1);
          *(unsigned*)(kL + i * 144 + 2 * lane) = pk;
          kTL[(2 * lane) * 72 + i] = (unsigned short)(pk & 0xffff);
          kTL[(2 * lane + 1) * 72 + i] = (unsigned short)(pk >> 16);
        } else {
          const unsigned pk = pack2(a0, a1);
          vTL[(2 * lane) * 72 + i] = (unsigned short)(pk & 0xffff);
          vTL[(2 * lane + 1) * 72 + i] = (unsigned short)(pk >> 16);
        }
      }
    }
  }
  if (w == 0) {
    const float* gp = gt + ((size_t)t0 + lane) * 32;
    const float g0 = gp[h], g1 = gp[4 + h], b0 = gp[8 + h], b1 = gp[12 + h];
    float G0 = g0, G1 = g1;
#pragma unroll
    for (int o = 1; o < 64; o <<= 1) {
      const float v0 = __shfl_up(G0, o, 64);
      const float v1 = __shfl_down(G1, o, 64);
      if (lane >= o) G0 += v0;
      if (lane + o < 64) G1 += v1;
    }
    scal[lane] = G0 * 1.4426950408889634f; scal[64 + lane] = G1 * 1.4426950408889634f;
    scal[128 + lane] = b0; scal[192 + lane] = b1;
    const float GL0 = __shfl(G0, 63, 64), GL1 = __shfl(G1, 0, 64);
    float* gs0 = G.gsc + ((size_t)((bh * 2 + 0) * 64 + c)) * 192;
    float* gs1 = G.gsc + ((size_t)((bh * 2 + 1) * 64 + c)) * 192;
    gs0[lane] = expf(G0); gs0[64 + lane] = expf(GL0 - G0);
    gs1[lane] = expf(G1); gs1[64 + lane] = expf(GL1 - G1);
    if (lane == 0) { gs0[128] = expf(GL0); gs1[128] = expf(GL1); }
  }
  __syncthreads();
  {
    unsigned short* qg = G.qc + (size_t)item * 8192;
    unsigned short* kg = G.kTc + (size_t)item * 8192;
#pragma unroll
    for (int i = 0; i < 4; ++i) {
      const int id = tid + i * 256;
      *(uint4*)(qg + (id >> 4) * 128 + (id & 15) * 8) = *(const uint4*)(qL + (id >> 4) * 144 + (id & 15) * 8);
      *(uint4*)(kg + (id >> 3) * 64 + (id & 7) * 8) = *(const uint4*)(kTL + (id >> 3) * 72 + (id & 7) * 8);
    }
  }
  {
    const int ta = w >> 1, tb = w & 1;
    f32x16 acc, acc2;
#pragma unroll
    for (int i = 0; i < 16; ++i) { acc[i] = 0.f; acc2[i] = 0.f; }
#pragma unroll
    for (int s = 0; s < 8; ++s) {
      const bf16x8 a = *(const bf16x8*)(kL + (32 * ta + r) * 144 + 16 * s + 8 * hh);
      const bf16x8 bk = *(const bf16x8*)(kL + (32 * tb + r) * 144 + 16 * s + 8 * hh);
      const bf16x8 bq = *(const bf16x8*)(qL + (32 * tb + r) * 144 + 16 * s + 8 * hh);
      acc = MFMA32(a, bk, acc);
      acc2 = MFMA32(a, bq, acc2);
    }
    __syncthreads();
    {
      const int col = 32 * tb + r;
      const float G0c = scal[col], G1c = scal[64 + col];
#pragma unroll
      for (int reg = 0; reg < 16; ++reg) {
        const int row = 32 * ta + crow(reg, hh);
        const float v = acc[reg];
        const float a0 = (col < row) ? scal[128 + row] * v * __builtin_amdgcn_exp2f(scal[row] - G0c) : 0.f;
        const float a1 = (col > row) ? scal[192 + row] * v * __builtin_amdgcn_exp2f(scal[64 + row] - G1c) : 0.f;
        A0[row * 72 + col] = a0;
        A1[(63 - row) * 72 + (63 - col)] = a1;
      }
    }
    {
      const int i = 32 * tb + r;
      const float G0i = scal[i], G1i = scal[64 + i];
      unsigned short* qk0 = G.qkc + ((size_t)((bh * 2 + 0) * 64 + c)) * 4096;
      unsigned short* qk1 = G.qkc + ((size_t)((bh * 2 + 1) * 64 + c)) * 4096;
#pragma unroll
      for (int g = 0; g < 4; ++g) {
        float o0[4], o1[4];
#pragma unroll
        for (int e = 0; e < 4; ++e) {
          const int j = 32 * ta + 8 * g + 4 * hh + e;
          const float v = acc2[4 * g + e];
          o0[e] = (j <= i) ? v * __builtin_amdgcn_exp2f(G0i - scal[j]) : 0.f;
          o1[e] = (j >= i) ? v * __builtin_amdgcn_exp2f(G1i - scal[64 + j]) : 0.f;
        }
        uint2 p0, p1;
        p0.x = pack2(o0[0], o0[1]); p0.y = pack2(o0[2], o0[3]);
        p1.x = pack2(o1[0], o1[1]); p1.y = pack2(o1[2], o1[3]);
        *(uint2*)(qk0 + i * 64 + 32 * ta + 8 * g + 4 * hh) = p0;
        *(uint2*)(qk1 + i * 64 + 32 * ta + 8 * g + 4 * hh) = p1;
      }
    }
  }
  __syncthreads();
  if (w < 2) {
    const int dir = w;
    float T[64];
    tri_subst(A0 + dir * (64 * 72), lane, T);
    const int jn = dir ? 63 - lane : lane;
    const float sb = scal[128 + 64 * dir + jn];
    const float sbg = sb * __builtin_amdgcn_exp2f(scal[64 * dir + jn]);
    unsigned short* Tb = dir ? kL : qL;
    unsigned short* Tbg = Tb + 64 * 72;
#pragma unroll
    for (int ip = 0; ip < 64; ++ip) {
      const int in = dir ? 63 - ip : ip;
      Tb[in * 72 + jn] = f2bf(T[ip] * sb);
      Tbg[in * 72 + jn] = f2bf(T[ip] * sbg);
    }
  }
  __syncthreads();
#pragma unroll
  for (int d = 0; d < 2; ++d) {
    const int chain = bh * 2 + d;
    const unsigned short* Tb = d ? kL : qL;
    const unsigned short* Tbg = Tb + 64 * 72;
    unsigned short* wng = G.wn + ((size_t)(chain * 64 + c)) * 8192;
    unsigned short* uog = G.uo + ((size_t)(chain * 64 + c)) * 8192 + w * 2048;
#pragma unroll
    for (int tb = 0; tb < 2; ++tb) {
      f32x16 acc, acc2;
#pragma unroll
      for (int i = 0; i < 16; ++i) { acc[i] = 0.f; acc2[i] = 0.f; }
#pragma unroll
      for (int s = 0; s < 4; ++s) {
        const bf16x8 a = *(const bf16x8*)(kTL + (32 * w + r) * 72 + 16 * s + 8 * hh);
        const bf16x8 bb = *(const bf16x8*)(Tbg + (32 * tb + r) * 72 + 16 * s + 8 * hh);
        acc = MFMA32(a, bb, acc);
        const bf16x8 a2 = *(const bf16x8*)(Tb + (32 * tb + r) * 72 + 16 * s + 8 * hh);
        const bf16x8 b2 = *(const bf16x8*)(vTL + (32 * w + r) * 72 + 16 * s + 8 * hh);
        acc2 = MFMA32(a2, b2, acc2);
      }
#pragma unroll
      for (int g = 0; g < 4; ++g) {
        uint2 pk;
        pk.x = pack2(-acc[4 * g], -acc[4 * g + 1]); pk.y = pack2(-acc[4 * g + 2], -acc[4 * g + 3]);
        *(uint2*)(wng + (32 * tb + r) * 128 + 32 * w + 8 * g + 4 * hh) = pk;
      }
      uint4 u0, u1;
      u0.x = pack2(acc2[0], acc2[1]); u0.y = pack2(acc2[2], acc2[3]); u0.z = pack2(acc2[4], acc2[5]); u0.w = pack2(acc2[6], acc2[7]);
      u1.x = pack2(acc2[8], acc2[9]); u1.y = pack2(acc2[10], acc2[11]); u1.z = pack2(acc2[12], acc2[13]); u1.w = pack2(acc2[14], acc2[15]);
      *(uint4*)(uog + tb * 1024 + lane * 16) = u0;
      *(uint4*)(uog + tb * 1024 + lane * 16 + 8) = u1;
    }
  }
}

struct GdnOps {
  bf16x8 a[8];
  bf16x8 x[4];
  bf16x8 kt[4];
  float4 rs[4];
  float gtot;
};
__device__ __forceinline__ void gdn_load(GdnOps& o, const GdnBufs& G, int chain, int bh, int c, int sl, int w, int r, int hh, int lane) {
  const unsigned short* kT_c = G.kTc + ((size_t)(bh * 64 + c)) * 8192;
  const float* gs = G.gsc + ((size_t)(chain * 64 + c)) * 192;
  const int ti = w & 1;
#pragma unroll
  for (int s = 0; s < 4; ++s) o.kt[s] = *(const bf16x8*)(kT_c + (32 * w + r) * 64 + 16 * s + 8 * hh);
  o.gtot = gs[128];
  if (w < 2) {
    const unsigned short* wn_c = G.wn + ((size_t)(chain * 64 + c)) * 8192;
    const unsigned short* uo_c = G.uo + ((size_t)(chain * 64 + c)) * 8192 + sl * 2048;
#pragma unroll
    for (int s = 0; s < 8; ++s) o.a[s] = *(const bf16x8*)(wn_c + (32 * ti + r) * 128 + 16 * s + 8 * hh);
    o.x[0] = *(const bf16x8*)(uo_c + ti * 1024 + lane * 16);
    o.x[1] = *(const bf16x8*)(uo_c + ti * 1024 + lane * 16 + 8);
#pragma unroll
    for (int g = 0; g < 4; ++g) o.rs[g] = *(const float4*)(gs + 64 + 32 * ti + 8 * g + 4 * hh);
  } else {
    const unsigned short* q_c = G.qc + ((size_t)(bh * 64 + c)) * 8192;
    const unsigned short* qk_c = G.qkc + ((size_t)(chain * 64 + c)) * 4096;
#pragma unroll
    for (int s = 0; s < 8; ++s) o.a[s] = *(const bf16x8*)(q_c + (32 * ti + r) * 128 + 16 * s + 8 * hh);
#pragma unroll
    for (int s = 0; s < 4; ++s) o.x[s] = *(const bf16x8*)(qk_c + (32 * ti + r) * 64 + 16 * s + 8 * hh);
#pragma unroll
    for (int g = 0; g < 4; ++g) o.rs[g] = *(const float4*)(gs + 32 * ti + 8 * g + 4 * hh);
  }
}
__device__ __forceinline__ void gdn_step(const GdnOps& o, f32x16& S, unsigned short* ST, unsigned short* VT, unsigned short* VdT,
                                         unsigned short* uo_c, int w, int r, int hh) {
  const int ti = w & 1;
  f32x16 acc;
  if (w < 2) {
#pragma unroll
    for (int i = 0; i < 8; ++i) {
      acc[i] = bf2f((unsigned short)o.x[0][i]);
      acc[8 + i] = bf2f((unsigned short)o.x[1][i]);
    }
  } else {
#pragma unroll
    for (int i = 0; i < 16; ++i) acc[i] = 0.f;
  }
#pragma unroll
  for (int g = 0; g < 4; ++g) {
    uint2 pk;
    pk.x = pack2(S[4 * g], S[4 * g + 1]); pk.y = pack2(S[4 * g + 2], S[4 * g + 3]);
    *(uint2*)(ST + r * 136 + 32 * w + 8 * g + 4 * hh) = pk;
  }
  __syncthreads();
#pragma unroll
  for (int s = 0; s < 8; ++s) {
    const bf16x8 bs = *(const bf16x8*)(ST + r * 136 + 16 * s + 8 * hh);
    acc = MFMA32(o.a[s], bs, acc);
  }
  if (w < 2) {
#pragma unroll
    for (int g = 0; g < 4; ++g) {
      uint2 pk, pd;
      pk.x = pack2(acc[4 * g], acc[4 * g + 1]); pk.y = pack2(acc[4 * g + 2], acc[4 * g + 3]);
      pd.x = pack2(acc[4 * g] * o.rs[g].x, acc[4 * g + 1] * o.rs[g].y);
      pd.y = pack2(acc[4 * g + 2] * o.rs[g].z, acc[4 * g + 3] * o.rs[g].w);
      *(uint2*)(VT + r * 72 + 32 * ti + 8 * g + 4 * hh) = pk;
      *(uint2*)(VdT + r * 72 + 32 * ti + 8 * g + 4 * hh) = pd;
    }
  } else {
#pragma unroll
    for (int g = 0; g < 4; ++g) {
      acc[4 * g] *= o.rs[g].x; acc[4 * g + 1] *= o.rs[g].y; acc[4 * g + 2] *= o.rs[g].z; acc[4 * g + 3] *= o.rs[g].w;
    }
  }
  __syncthreads();
  if (w >= 2) {
#pragma unroll
    for (int s = 0; s < 4; ++s) {
      const bf16x8 bv = *(const bf16x8*)(VT + r * 72 + 16 * s + 8 * hh);
      acc = MFMA32(o.x[s], bv, acc);
    }
#pragma unroll
    for (int reg = 0; reg < 16; ++reg) uo_c[(32 * ti + crow(reg, hh)) * 32 + r] = f2bf(acc[reg]);
  }
#pragma unroll
  for (int i = 0; i < 16; ++i) S[i] *= o.gtot;
#pragma unroll
  for (int s = 0; s < 4; ++s) {
    const bf16x8 bv = *(const bf16x8*)(VdT + r * 72 + 16 * s + 8 * hh);
    S = MFMA32(o.kt[s], bv, S);
  }
}
__device__ __forceinline__ void d_gdn_scan(int chain, int sl, char* smem, GdnBufs G) {
  unsigned short* ST = (unsigned short*)smem;
  unsigned short* VT = ST + 32 * 136;
  unsigned short* VdT = VT + 32 * 72;
  const int tid = threadIdx.x, lane = tid & 63, w = __builtin_amdgcn_readfirstlane(tid >> 6), r = lane & 31, hh = lane >> 5;
  const int bh = chain >> 1, dir = chain & 1;
  f32x16 S;
#pragma unroll
  for (int i = 0; i < 16; ++i) S[i] = 0.f;
  GdnOps A, B;
  gdn_load(A, G, chain, bh, dir ? 63 : 0, sl, w, r, hh, lane);
  for (int step = 0; step < 64; step += 2) {
    const int c0 = dir ? 63 - step : step;
    const int c1 = dir ? c0 - 1 : c0 + 1;
    const int c2 = dir ? c0 - 2 : c0 + 2;
    gdn_load(B, G, chain, bh, c1, sl, w, r, hh, lane);
    gdn_step(A, S, ST, VT, VdT, G.uo + ((size_t)(chain * 64 + c0)) * 8192 + sl * 2048, w, r, hh);
    if (step + 2 < 64) gdn_load(A, G, chain, bh, c2, sl, w, r, hh, lane);
    gdn_step(B, S, ST, VT, VdT, G.uo + ((size_t)(chain * 64 + c1)) * 8192 + sl * 2048, w, r, hh);
  }
}

#define ML_LOAD(T0)                                                                                         \
  {                                                                                                         \
    _Pragma("unroll") for (int i_ = 0; i_ < 8; ++i_) {                                                      \
      const int id_ = t128 + i_ * 128;                                                                      \
      pq[i_] = *(const uint4*)(pm + ((T0) + (id_ >> 4)) * 4096 + 2048 + h * 128 + (id_ & 15) * 8);          \
      pk[i_] = *(const uint4*)(pm + ((T0) + (id_ >> 4)) * 4096 + 2560 + h * 128 + (id_ & 15) * 8);          \
    }                                                                                                       \
    _Pragma("unroll") for (int i_ = 0; i_ < 2; ++i_) {                                                      \
      const int id_ = t128 + i_ * 128;                                                                      \
      pv[i_] = *(const uint4*)(pm + ((T0) + (id_ >> 2)) * 4096 + 3072 + h * 128 + sl * 32 + (id_ & 3) * 8); \
    }                                                                                                       \
    plf = gt[((T0) + lane) * 32 + 24 + dir * 4 + h];                                                        \
    pip = gt[((T0) + lane) * 32 + 16 + dir * 4 + h];                                                        \
  }
__device__ __forceinline__ void ml_state_image(const f32x16& S0, const f32x16& S1, unsigned short* S0T, unsigned short* nL, int w, int r, int hh) {
#pragma unroll
  for (int g = 0; g < 4; ++g) {
    uint2 pk;
    pk.x = pack2(S0[4 * g], S0[4 * g + 1]); pk.y = pack2(S0[4 * g + 2], S0[4 * g + 3]);
    *(uint2*)(S0T + r * 136 + 32 * w + 8 * g + 4 * hh) = pk;
    if (r == 0) {
      uint2 pn;
      pn.x = pack2(S1[4 * g], S1[4 * g + 1]); pn.y = pack2(S1[4 * g + 2], S1[4 * g + 3]);
      *(uint2*)(nL + 32 * w + 8 * g + 4 * hh) = pn;
    }
  }
}
__device__ __forceinline__ void ml_state_update(f32x16& S0, f32x16& S1, const unsigned short* kdL, const unsigned short* vTL,
                                                float gtot, int w, int r, int hh) {
  bf16x8 ones;
#pragma unroll
  for (int i = 0; i < 8; ++i) ones[i] = (short)0x3F80;
#pragma unroll
  for (int i = 0; i < 16; ++i) { S0[i] *= gtot; S1[i] *= gtot; }
#pragma unroll
  for (int s2 = 0; s2 < 4; ++s2) {
    union { bf16x8 v; unsigned short e[8]; } a;
#pragma unroll
    for (int e = 0; e < 8; ++e) a.e[e] = kdL[(16 * s2 + 8 * hh + e) * 136 + 32 * w + r];
    const bf16x8 bv = *(const bf16x8*)(vTL + r * 72 + 16 * s2 + 8 * hh);
    S0 = MFMA32(a.v, bv, S0);
    S1 = MFMA32(a.v, ones, S1);
  }
}
__device__ __forceinline__ void d_mlstm_scan(int chain, int sl, char* smem, const unsigned short* __restrict__ pm,
                                             const float* __restrict__ gt, unsigned short* __restrict__ oM, int ntok) {
  unsigned short* qL = (unsigned short*)smem;
  unsigned short* kL = qL + 64 * 136;
  unsigned short* kdL = kL + 64 * 136;
  unsigned short* vTL = kdL + 64 * 136;
  unsigned short* S0T = vTL + 32 * 72;
  unsigned short* nL = S0T + 32 * 136;
  float* scal = (float*)(nL + 256);
  const int tid = threadIdx.x, lane = tid & 63, w = __builtin_amdgcn_readfirstlane(tid >> 6), r = lane & 31, hh = lane >> 5;
  const int bh = chain >> 1, dir = chain & 1, b = bh >> 2, h = bh & 3;
  const float SCALE = 0.08838834764831845f;
  f32x16 S0, S1;
#pragma unroll
  for (int i = 0; i < 16; ++i) { S0[i] = 0.f; S1[i] = 0.f; }
  unsigned short* oMb = oM + (size_t)dir * ntok * 512 + h * 128 + sl * 32;
  const size_t tb = (size_t)b * SEQ;
  if (w >= 2) {
    const int t128 = tid - 128;
    uint4 pq[8], pk[8], pv[2];
    float plf, pip;
    ML_LOAD(tb + (dir ? 63 : 0) * 64);
    for (int step = 0; step < 64; ++step) {
      const int c0 = dir ? 63 - step : step;
      const int c1 = dir ? c0 - 1 : c0 + 1;
      float bc = plf;
#pragma unroll
      for (int ofs = 1; ofs < 64; ofs <<= 1) {
        const float vu = __shfl_up(bc, ofs, 64);
        const float vd = __shfl_down(bc, ofs, 64);
        if (dir == 0) { if (lane >= ofs) bc += vu; } else { if (lane + ofs < 64) bc += vd; }
      }
      const float b_last = __shfl(bc, dir ? 0 : 63, 64);
      const float Dj = SCALE * expf(b_last - bc + pip);
      const float gtot = expf(b_last);
      __syncthreads();
      if (w == 2) {
        scal[lane] = expf(bc);
        scal[64 + lane] = (pip - bc) * 1.4426950408889634f - 3.5f;
        scal[128 + lane] = bc * 1.4426950408889634f;
        if (lane == 0) scal[192] = gtot;
      }
#pragma unroll
      for (int i = 0; i < 8; ++i) {
        const int id = t128 + i * 128;
        const int row = id >> 4, c16 = id & 15;
        const uint4 kv = pk[i];
        const uint4 qv = pq[i];
        *(uint4*)(qL + row * 136 + c16 * 8) = qv;
        *(uint4*)(kL + row * 136 + c16 * 8) = kv;
        const float d = __shfl(Dj, row, 64);
        uint4 kd;
        kd.x = pack2(bf2f(kv.x & 0xffff) * d, bf2f(kv.x >> 16) * d);
        kd.y = pack2(bf2f(kv.y & 0xffff) * d, bf2f(kv.y >> 16) * d);
        kd.z = pack2(bf2f(kv.z & 0xffff) * d, bf2f(kv.z >> 16) * d);
        kd.w = pack2(bf2f(kv.w & 0xffff) * d, bf2f(kv.w >> 16) * d);
        *(uint4*)(kdL + row * 136 + c16 * 8) = kd;
      }
#pragma unroll
      for (int i = 0; i < 2; ++i) {
        const int id = t128 + i * 128;
        const int tok = id >> 2, d8 = (id & 3) * 8;
        const uint4 vv = pv[i];
        vTL[(d8 + 0) * 72 + tok] = (unsigned short)(vv.x & 0xffff);
        vTL[(d8 + 1) * 72 + tok] = (unsigned short)(vv.x >> 16);
        vTL[(d8 + 2) * 72 + tok] = (unsigned short)(vv.y & 0xffff);
        vTL[(d8 + 3) * 72 + tok] = (unsigned short)(vv.y >> 16);
        vTL[(d8 + 4) * 72 + tok] = (unsigned short)(vv.z & 0xffff);
        vTL[(d8 + 5) * 72 + tok] = (unsigned short)(vv.z >> 16);
        vTL[(d8 + 6) * 72 + tok] = (unsigned short)(vv.w & 0xffff);
        vTL[(d8 + 7) * 72 + tok] = (unsigned short)(vv.w >> 16);
      }
      if (step + 1 < 64) ML_LOAD(tb + c1 * 64);
      ml_state_image(S0, S1, S0T, nL, w, r, hh);
      __syncthreads();
      ml_state_update(S0, S1, kdL, vTL, gtot, w, r, hh);
    }
  } else {
    bf16x8 ones;
#pragma unroll
    for (int i = 0; i < 8; ++i) ones[i] = (short)0x3F80;
    const int ti = w;
    const int icol = 32 * ti + r;
    for (int step = 0; step < 64; ++step) {
      const int c0 = dir ? 63 - step : step;
      __syncthreads();
      ml_state_image(S0, S1, S0T, nL, w, r, hh);
      __syncthreads();
      const float bci = scal[128 + icol];
      const float gtot = scal[192];
      f32x16 Q0, Q1;
#pragma unroll
      for (int i = 0; i < 16; ++i) { Q0[i] = 0.f; Q1[i] = 0.f; }
#pragma unroll
      for (int s2 = 0; s2 < 8; ++s2) {
        const bf16x8 a = *(const bf16x8*)(qL + (32 * ti + r) * 136 + 16 * s2 + 8 * hh);
        const bf16x8 b0 = *(const bf16x8*)(S0T + r * 136 + 16 * s2 + 8 * hh);
        const bf16x8 b1 = *(const bf16x8*)(nL + 16 * s2 + 8 * hh);
        Q0 = MFMA32(a, b0, Q0);
        Q1 = MFMA32(a, b1, Q1);
      }
#pragma unroll
      for (int g = 0; g < 4; ++g) {
        const float4 e4 = *(const float4*)(scal + 32 * ti + 8 * g + 4 * hh);
        Q0[4 * g] *= e4.x; Q0[4 * g + 1] *= e4.y; Q0[4 * g + 2] *= e4.z; Q0[4 * g + 3] *= e4.w;
        Q1[4 * g] *= e4.x; Q1[4 * g + 1] *= e4.y; Q1[4 * g + 2] *= e4.z; Q1[4 * g + 3] *= e4.w;
      }
#pragma unroll
      for (int tj = 0; tj < 2; ++tj) {
        if (dir ? (tj < ti) : (tj > ti)) continue;
        f32x16 X;
#pragma unroll
        for (int i = 0; i < 16; ++i) X[i] = 0.f;
#pragma unroll
        for (int s2 = 0; s2 < 8; ++s2) {
          const bf16x8 a = *(const bf16x8*)(kL + (32 * tj + r) * 136 + 16 * s2 + 8 * hh);
          const bf16x8 bq = *(const bf16x8*)(qL + (32 * ti + r) * 136 + 16 * s2 + 8 * hh);
          X = MFMA32(a, bq, X);
        }
#pragma unroll
        for (int g = 0; g < 4; ++g) {
          const float4 cj4 = *(const float4*)(scal + 64 + 32 * tj + 8 * g + 4 * hh);
          const float cjs[4] = {cj4.x, cj4.y, cj4.z, cj4.w};
#pragma unroll
          for (int e = 0; e < 4; ++e) {
            const int j = 32 * tj + 8 * g + 4 * hh + e;
            const bool valid = dir ? (j >= icol) : (j <= icol);
            const float arg = valid ? (bci + cjs[e]) : -INFINITY;
            X[4 * g + e] *= __builtin_amdgcn_exp2f(arg);
          }
        }
#pragma unroll
        for (int s2 = 0; s2 < 2; ++s2) {
          union { bf16x8 v; unsigned u[4]; } xa, bv;
          xa.u[0] = pack2(X[8 * s2 + 0], X[8 * s2 + 1]); xa.u[1] = pack2(X[8 * s2 + 2], X[8 * s2 + 3]);
          xa.u[2] = pack2(X[8 * s2 + 4], X[8 * s2 + 5]); xa.u[3] = pack2(X[8 * s2 + 6], X[8 * s2 + 7]);
          const uint2 v0 = *(const uint2*)(vTL + r * 72 + 32 * tj + 16 * s2 + 4 * hh);
          const uint2 v1 = *(const uint2*)(vTL + r * 72 + 32 * tj + 16 * s2 + 8 + 4 * hh);
          bv.u[0] = v0.x; bv.u[1] = v0.y; bv.u[2] = v1.x; bv.u[3] = v1.y;
          Q0 = MFMA32(xa.v, bv.v, Q0);
          Q1 = MFMA32(xa.v, ones, Q1);
        }
      }
      const size_t orow0 = tb + c0 * 64;
#pragma unroll
      for (int reg = 0; reg < 16; ++reg) {
        const int i = 32 * ti + crow(reg, hh);
        oMb[(orow0 + i) * 512 + r] = f2bf(Q0[reg] * __builtin_amdgcn_rcpf(fmaxf(fabsf(Q1[reg]), 1.f)));
      }
      ml_state_update(S0, S1, kdL, vTL, gtot, w, r, hh);
    }
  }
}

struct MKP {
  const float *x, *norm1_g, *w_in, *conv_w, *a_log, *dt_bias, *gdn_g, *i_bias, *f_bias, *ml_g, *w_out, *norm2_g, *peer_wq,
      *peer_keys, *peer_u, *peer_v, *normf_g;
  float* out;
  unsigned short *pm, *x1b, *woutT, *mt, *xb, *winT, *oM, *yb, *scores, *qkv_dbg, *oA_dbg;
  unsigned *utab, *vtab;
  unsigned short *wqb, *keyb;
  float *uscale, *vscale;
  float *x1, *rs1, *rs2, *gt, *gateb, *dbg;
  unsigned* bar;
  int* idxb;
  GdnBufs G;
};

constexpr int SMEM_BYTES = 74752;
__global__ void __launch_bounds__(256, 2) k_mega(MKP P) {
  __shared__ __attribute__((aligned(16))) char smem_c[SMEM_BYTES + 16];
  {
    volatile LAS unsigned* st0 = (volatile LAS unsigned*)(smem_c + SMEM_BYTES);
    if (threadIdx.x < 4) st0[threadIdx.x] = 0u;
  }
  __syncthreads();
  XcdBarrier xb = xcd_barrier_post(P.bar, (volatile LAS unsigned*)(smem_c + SMEM_BYTES));
  unsigned short* smem = (unsigned short*)smem_c;
  const int nb = gridDim.x, bid = blockIdx.x;
  for (int it = bid; it < NT / 4; it += nb) d_prep_x(it, P.x, P.xb, P.rs1);
  for (int it = bid; it < 16 * 66; it += nb) d_transpose_w(it, 66, (float*)smem_c, P.w_in, DIN, P.norm1_g, P.winT, 1);
  for (int it = bid; it < 16 * 16; it += nb) d_transpose_w(it, 16, (float*)smem_c, P.w_out, 1024, nullptr, P.woutT, 0);
  for (int it = bid; it < 1024; it += nb) d_cvt_bf16(it, P.peer_wq, P.wqb, P.norm2_g, 11);
  for (int it = bid; it < 128; it += nb) d_cvt_bf16(it, P.peer_keys, P.keyb, nullptr, 0);
  if (bid == 0 && threadIdx.x < 4) P.dbg[threadIdx.x] = 0.f;
  xcd_barrier(xb);
  {
    GemmP p{};
    p.A = P.xb; p.lda = DM; p.Bt = P.winT; p.ldb = DM; p.K = DM;
    p.rowscale = P.rs1; p.obf = P.pm; p.ldo = 4096; p.of32 = P.gt; p.ldf = 32; p.resid = nullptr;
    p.a_log = P.a_log; p.dt_bias = P.dt_bias; p.i_bias = P.i_bias; p.f_bias = P.f_bias;
    for (int k = 0;; ++k) {
      int tm, tn;
      if (!xcd_tile(bid, nb, k, 33, tm, tn)) break;
      gemm_tile<EPI_INPROJ>(p, tm, tn, smem);
      __syncthreads();
    }
  }
  for (int tile = bid; tile < 16 * 8; tile += nb) {
    const int hp = tile >> 3, tn = tile & 7;
    GemmP p{};
    p.A = P.keyb + (size_t)hp * 128 * 128; p.lda = 128; p.Bt = P.wqb + hp * 128; p.ldb = 2048; p.K = 128;
    p.obf = P.mt + (size_t)hp * 128 * DM; p.ldo = DM;
    gemm_tile<EPI_PLAIN>(p, 0, tn, smem);
    __syncthreads();
  }
  xcd_barrier(xb);
  for (int it = bid; it < 1024; it += nb) d_gdn_prep(it, smem_c, P.pm, P.gt, P.conv_w, P.G);
  xcd_barrier(xb);
  if (bid < 128) {
    d_gdn_scan(bid >> 2, bid & 3, smem_c, P.G);
  } else if (bid < 256) {
    d_mlstm_scan((bid - 128) >> 2, (bid - 128) & 3, smem_c, P.pm, P.gt, P.oM, NT);
  }
#ifdef DBG_CHECK
  if (bid < 4) {
    __syncthreads();
    const int half = threadIdx.x >> 7;
    float* sq = (float*)smem + half * 256;
    float* sk = sq + 128;
    d_mlstm_rec(bid * 2 + half, sq, sk, P.pm, P.gt, P.oA_dbg, 4096);
  }
#endif
  xcd_barrier(xb);
  for (int it = bid; it < NT / 4; it += nb) d_combine(it, P.G.uo, P.oM, P.pm, P.gdn_g, P.ml_g, P.yb);
#ifdef DBG_CHECK
  for (int it = bid; it < 4096 / 4; it += nb) d_dbg_cmp_m(it, P.oM, P.oA_dbg, P.dbg);
#endif
  xcd_barrier(xb);
  {
    GemmP p{};
    p.A = P.yb; p.lda = DM; p.Bt = P.woutT; p.ldb = DM; p.K = DM;
    p.rowscale = nullptr; p.obf = P.x1b; p.ldo = DM; p.of32 = P.x1; p.ldf = DM; p.resid = P.x; p.rowacc = P.rs2;
    for (int k = 0;; ++k) {
      int tm, tn;
      if (!xcd_tile(bid, nb, k, 8, tm, tn)) break;
      gemm_tile<EPI_OUTPROJ>(p, tm, tn, smem);
      __syncthreads();
    }
  }
  for (int it = bid; it < 4096; it += nb) { d_cvt_tab(it, P.peer_u, P.utab, P.uscale); d_cvt_tab(it, P.peer_v, P.vtab, P.vscale); }
  xcd_barrier(xb);
  {
    GemmP p{};
    p.A = P.x1b; p.lda = DM; p.Bt = P.mt; p.ldb = DM; p.K = DM;
    p.rowscale = P.rs2; p.obf = P.scores; p.ldo = 2048; p.of32 = nullptr; p.ldf = 0; p.resid = nullptr;
    for (int k = 0;; ++k) {
      int tm, tn;
      if (!xcd_tile(bid, nb, k, 16, tm, tn)) break;
      gemm_tile<EPI_SCORES>(p, tm, tn, smem);
      __syncthreads();
    }
  }
  xcd_barrier(xb);
  float oscale = 1.f;
#ifdef DBG_CHECK
  {
    const float sd = __hip_atomic_load(&P.dbg[0], __ATOMIC_RELAXED, __HIP_MEMORY_SCOPE_AGENT);
    const float sr = __hip_atomic_load(&P.dbg[1], __ATOMIC_RELAXED, __HIP_MEMORY_SCOPE_AGENT);
    oscale = 1.f + sqrtf(sd / sr);
  }
#endif
  for (int it = bid; it < NT / 32; it += nb) {
    d_topk(it, P.scores, P.idxb, P.gateb);
    __threadfence_block();
    __syncthreads();
#pragma unroll 1
    for (int sub = 0; sub < 8; ++sub)
      d_peer(it * 8 + sub, P.x1, P.rs2, P.norm2_g, P.idxb, P.gateb, P.utab, P.vtab, P.uscale, P.vscale, P.normf_g, P.out, oscale);
  }
}

extern "C" void kernel_launch(void* const* d_in, const int* in_sizes, int n_in, void* d_out, int out_size, void* d_ws,
                              size_t ws_size, hipStream_t stream) {
  MKP P{};
  P.x = (const float*)d_in[0];
  P.norm1_g = (const float*)d_in[1];
  P.w_in = (const float*)d_in[2];
  P.conv_w = (const float*)d_in[3];
  P.a_log = (const float*)d_in[4];
  P.dt_bias = (const float*)d_in[5];
  P.gdn_g = (const float*)d_in[6];
  P.i_bias = (const float*)d_in[7];
  P.f_bias = (const float*)d_in[8];
  P.ml_g = (const float*)d_in[9];
  P.w_out = (const float*)d_in[10];
  P.norm2_g = (const float*)d_in[11];
  P.peer_wq = (const float*)d_in[12];
  P.peer_keys = (const float*)d_in[13];
  P.peer_u = (const float*)d_in[14];
  P.peer_v = (const float*)d_in[15];
  P.normf_g = (const float*)d_in[16];
  P.out = (float*)d_out;

  char* ws = (char*)d_ws;
  const size_t MB = 1024 * 1024;
  P.pm = (unsigned short*)(ws);
  P.x1 = (float*)(ws);
  P.x1b = (unsigned short*)(ws + 64 * MB);
  P.utab = (unsigned*)(ws + 96 * MB);
  P.vtab = (unsigned*)(ws + 112 * MB);
  P.uscale = (float*)(ws + 136 * MB);
  P.vscale = (float*)(ws + 136 * MB + 65536);
  char* rb = ws + 128 * MB;
  P.woutT = (unsigned short*)(rb);
  P.mt = (unsigned short*)(rb + 2 * MB);
  P.rs1 = (float*)(rb + 6 * MB);
  P.rs2 = (float*)(rb + 7 * MB);
  P.dbg = (float*)(rb + 6 * MB + 131072);
  P.bar = (unsigned*)(rb + 6 * MB + 196608);
  P.gt = (float*)(rb + 9 * MB);
  char* dyn = rb + 11 * MB;
  P.xb = (unsigned short*)(dyn);
  P.winT = (unsigned short*)(dyn + 32 * MB);
  P.wqb = (unsigned short*)(dyn + 41 * MB);
  P.keyb = (unsigned short*)(dyn + 45 * MB);
  P.G.qc = (unsigned short*)(dyn);
  P.G.kTc = (unsigned short*)(dyn + 16 * MB);
  P.G.qkc = (unsigned short*)(dyn + 32 * MB);
  P.G.wn = (unsigned short*)(dyn + 48 * MB);
  P.G.uo = (unsigned short*)(dyn + 80 * MB);
  P.G.gsc = (float*)(dyn + 112 * MB);
  P.yb = (unsigned short*)(dyn);
  P.scores = (unsigned short*)(dyn);
  P.idxb = (int*)(dyn + 64 * MB);
  P.gateb = (float*)(dyn + 72 * MB);
  char* os = (char*)d_out;
  P.oM = (unsigned short*)(os);
  P.qkv_dbg = (unsigned short*)(os + 32 * MB);
  P.oA_dbg = (unsigned short*)(os + 44 * MB);

  static int grid_blocks = 0;
  if (!grid_blocks) {
    int dev = 0, cus = 0, per_cu = 0;
    (void)hipGetDevice(&dev);
    (void)hipDeviceGetAttribute(&cus, hipDeviceAttributeMultiprocessorCount, dev);
    (void)hipOccupancyMaxActiveBlocksPerMultiprocessor(&per_cu, k_mega, 256, 0);
    if (per_cu > 2) per_cu = 2;
    if (per_cu < 1) per_cu = 1;
    grid_blocks = cus * per_cu;
  }
  (void)hipMemsetAsync(P.bar, 0, XCD_BAR_WORDS * sizeof(unsigned), stream);
  hipLaunchKernelGGL(k_mega, dim3(grid_blocks), dim3(256), 0, stream, P);
}
```

```cpp
#include <hip/hip_runtime.h>
#include <hip/hip_bf16.h>
#include <stdint.h>
#include <cstdio>

#define XB_TMO      128
#define XB_XCNT(j)  (256  + 64 * (j))
#define XB_XSUB(j)  (1280 + 64 * (j))
#define XB_XGEN(j)  (2304 + 64 * (j))
#define XB_TOP      3328
#define XB_TOPGEN   3392
#define XCD_BAR_WORDS 3456
#define XB_SPIN_CAP (1u << 18)
#define LAS __attribute__((address_space(3)))

__device__ __forceinline__ unsigned xb_ld(unsigned* p)              { return __hip_atomic_load(p, __ATOMIC_RELAXED, __HIP_MEMORY_SCOPE_AGENT); }
__device__ __forceinline__ unsigned xb_add(unsigned* p, unsigned v) { return __hip_atomic_fetch_add(p, v, __ATOMIC_RELAXED, __HIP_MEMORY_SCOPE_AGENT); }
__device__ __forceinline__ unsigned xb_xcc_id() { return (unsigned)__builtin_amdgcn_s_getreg((3 << 11) | 20) & 0xFu; }
#define XB_SPIN(cond, bar) do { unsigned _sp = 0; while (cond) { __builtin_amdgcn_s_sleep(1); \
    if ((++_sp & 255u) == 0u) { if (xb_ld(&(bar)[XB_TMO])) break; if (_sp > XB_SPIN_CAP) { atomicAdd(&(bar)[XB_TMO], 1u); break; } } } } while (0)

struct XcdBarrier {
    unsigned* bar; unsigned x;
    volatile LAS unsigned* st;
};

__device__ __forceinline__ XcdBarrier xcd_barrier_post(unsigned* bar, volatile LAS unsigned* st) {
    XcdBarrier b; b.bar = bar; b.x = xb_xcc_id(); b.st = st;
    if (threadIdx.x == 0) (void)xb_add(&bar[XB_XCNT(b.x)], 1u);
    return b;
}
__device__ __forceinline__ void xcd_barrier_complete(unsigned* bar, unsigned x, unsigned& nloc, unsigned& nx) {
    const unsigned G = gridDim.x * gridDim.y * gridDim.z;
    unsigned sum, cnt, mine, sp = 0u;
    for (;;) {
        sum = 0u; cnt = 0u; mine = 0u;
#pragma unroll
        for (unsigned j = 0; j < 16; ++j) { const unsigned c = xb_ld(&bar[XB_XCNT(j)]); sum += c; cnt += (c > 0u) ? 1u : 0u; mine = (j == x) ? c : mine; }
        if (sum == G) break;
        __builtin_amdgcn_s_sleep(1);
        if ((++sp & 255u) == 0u) { if (xb_ld(&bar[XB_TMO])) break; if (sp > XB_SPIN_CAP) { atomicAdd(&bar[XB_TMO], 1u); break; } }
    }
    nloc = mine > 0u ? mine : 1u; nx = cnt > 0u ? cnt : 1u;
}

__device__ __forceinline__ void xcd_barrier(const XcdBarrier& b) {
    asm volatile("s_waitcnt vmcnt(0)" ::: "memory");
    __syncthreads();
    if (threadIdx.x == 0) {
        unsigned* bar = b.bar;
        __builtin_amdgcn_s_waitcnt(0);
        unsigned nloc = b.st[0], nx = b.st[1];
        if (nloc == 0u) { xcd_barrier_complete(bar, b.x, nloc, nx); b.st[0] = nloc; b.st[1] = nx; }
        const unsigned old = xb_add(&bar[XB_XSUB(b.x)], 1u);
        const unsigned gen = old / nloc;
        if (old + 1u == (gen + 1u) * nloc) {
            __builtin_amdgcn_fence(__ATOMIC_RELEASE, "agent");
            asm volatile("s_waitcnt vmcnt(0)" ::: "memory");
            const unsigned og = xb_add(&bar[XB_TOP], 1u);
            const unsigned tg = og / nx;
            if (og + 1u == (tg + 1u) * nx) xb_add(&bar[XB_TOPGEN], 1u);
            else XB_SPIN(xb_ld(&bar[XB_TOPGEN]) == tg, bar);
            __builtin_amdgcn_fence(__ATOMIC_ACQUIRE, "agent");
            xb_add(&bar[XB_XGEN(b.x)], 1u);
            asm volatile("s_waitcnt vmcnt(0)" ::: "memory");
        } else {
            XB_SPIN(xb_ld(&bar[XB_XGEN(b.x)]) == gen, bar);
            __builtin_amdgcn_fence(__ATOMIC_ACQUIRE, "agent");
            asm volatile("s_waitcnt vmcnt(0)" ::: "memory");
        }
    }
    __syncthreads();
}


typedef __hip_bfloat16 bf16;
typedef __attribute__((ext_vector_type(8))) short bf16x8;
typedef __attribute__((ext_vector_type(4))) float f32x4;

constexpr int DM = 1024;
constexpr int NB = 4;
constexpr int SEQ = 4096;
constexpr int NT = NB * SEQ;
constexpr int DIN = 4128;
constexpr int NPAD_IN = 4224;
constexpr float EPSF = 1e-6f;

__device__ __forceinline__ float bf2f(unsigned short u) { return __uint_as_float(((unsigned)u) << 16); }
typedef __bf16 bf16x2_t __attribute__((ext_vector_type(2)));
typedef float f32x2_t __attribute__((ext_vector_type(2)));
__device__ __forceinline__ unsigned short f2bf(float f) { return __builtin_bit_cast(unsigned short, (__bf16)f); }
__device__ __forceinline__ unsigned pack2(float a, float b) {
  f32x2_t v = {a, b};
  return __builtin_bit_cast(unsigned, __builtin_convertvector(v, bf16x2_t));
}
__device__ __forceinline__ float wave_sum(float v) {
#pragma unroll
  for (int o = 32; o > 0; o >>= 1) v += __shfl_xor(v, o, 64);
  return v;
}
#define DPP_ADD(v, ctrl) v += __builtin_bit_cast(float, __builtin_amdgcn_update_dpp(0, __builtin_bit_cast(int, v), ctrl, 0xF, 0xF, true))
__device__ __forceinline__ float wave_sum_dpp(float v) {
  DPP_ADD(v, 0xB1);
  DPP_ADD(v, 0x4E);
  DPP_ADD(v, 0x141);
  DPP_ADD(v, 0x140);
  const float r0 = __builtin_bit_cast(float, __builtin_amdgcn_readlane(__builtin_bit_cast(int, v), 0));
  const float r1 = __builtin_bit_cast(float, __builtin_amdgcn_readlane(__builtin_bit_cast(int, v), 16));
  const float r2 = __builtin_bit_cast(float, __builtin_amdgcn_readlane(__builtin_bit_cast(int, v), 32));
  const float r3 = __builtin_bit_cast(float, __builtin_amdgcn_readlane(__builtin_bit_cast(int, v), 48));
  return (r0 + r1) + (r2 + r3);
}
__device__ __forceinline__ float softplusf(float x) { return fmaxf(x, 0.f) + log1pf(expf(-fabsf(x))); }
__device__ __forceinline__ float sigmoidf(float x) { return __builtin_amdgcn_rcpf(1.f + __builtin_amdgcn_exp2f(-1.4426950408889634f * x)); }

__device__ __forceinline__ void d_prep_x(int item, const float* __restrict__ x, unsigned short* __restrict__ xb,
                                                float* __restrict__ rs) {
  int t = item * 4 + (threadIdx.x >> 6);
  int lane = threadIdx.x & 63;
  const float4* xr = (const float4*)(x + (size_t)t * DM);
  float ss = 0.f;
#pragma unroll
  for (int i = 0; i < 4; ++i) {
    float4 v = xr[lane + 64 * i];
    ss += v.x * v.x + v.y * v.y + v.z * v.z + v.w * v.w;
    ushort4 o;
    o.x = f2bf(v.x); o.y = f2bf(v.y); o.z = f2bf(v.z); o.w = f2bf(v.w);
    ((ushort4*)(xb + (size_t)t * DM))[lane + 64 * i] = o;
  }
  ss = wave_sum(ss);
  if (lane == 0) rs[t] = rsqrtf(ss * (1.f / DM) + EPSF);
}

__device__ __forceinline__ int win_src(int n) {
  if (n < 2048) return n;
  if (n < 4096) return n + 16;
  int j = n - 4096;
  if (j < 16) return 2048 + j;
  if (j < 32) return 4112 + (j - 16);
  return -1;
}
__device__ __forceinline__ void d_transpose_w(int item, int ntn, float* tile, const float* __restrict__ in, int ldn,
                                              const float* __restrict__ g, unsigned short* __restrict__ out, int mode) {
  const int kt = item / ntn, nt = item % ntn;
  const int tid = threadIdx.x;
  __syncthreads();
#pragma unroll
  for (int i = 0; i < 4; ++i) {
    const int row = (tid >> 4) + 16 * i;
    const int c4 = (tid & 15) * 4;
    const int n = nt * 64 + c4;
    const int src = mode ? win_src(n) : n;
    float4 v = make_float4(0.f, 0.f, 0.f, 0.f);
    if (src >= 0) {
      v = *(const float4*)(in + (size_t)(kt * 64 + row) * ldn + src);
      if (g) { const float gg = g[kt * 64 + row]; v.x *= gg; v.y *= gg; v.z *= gg; v.w *= gg; }
    }
    tile[row * 65 + c4] = v.x; tile[row * 65 + c4 + 1] = v.y; tile[row * 65 + c4 + 2] = v.z; tile[row * 65 + c4 + 3] = v.w;
  }
  __syncthreads();
  {
    const int n = tid >> 2, k16 = (tid & 3) * 16;
    uint4 o0, o1;
    o0.x = pack2(tile[(k16 + 0) * 65 + n], tile[(k16 + 1) * 65 + n]);   o0.y = pack2(tile[(k16 + 2) * 65 + n], tile[(k16 + 3) * 65 + n]);
    o0.z = pack2(tile[(k16 + 4) * 65 + n], tile[(k16 + 5) * 65 + n]);   o0.w = pack2(tile[(k16 + 6) * 65 + n], tile[(k16 + 7) * 65 + n]);
    o1.x = pack2(tile[(k16 + 8) * 65 + n], tile[(k16 + 9) * 65 + n]);   o1.y = pack2(tile[(k16 + 10) * 65 + n], tile[(k16 + 11) * 65 + n]);
    o1.z = pack2(tile[(k16 + 12) * 65 + n], tile[(k16 + 13) * 65 + n]); o1.w = pack2(tile[(k16 + 14) * 65 + n], tile[(k16 + 15) * 65 + n]);
    unsigned short* op = out + (size_t)(nt * 64 + n) * DM + kt * 64 + k16;
    *(uint4*)op = o0;
    *(uint4*)(op + 8) = o1;
  }
}
__device__ __forceinline__ void d_cvt_bf16(int item, const float* __restrict__ src, unsigned short* __restrict__ dst,
                                           const float* __restrict__ rowscale, int rowlen_log2) {
  const size_t base = (size_t)item * 2048 + threadIdx.x * 8;
  float4 a = *(const float4*)(src + base);
  float4 b = *(const float4*)(src + base + 4);
  if (rowscale) {
    const float sc = rowscale[base >> rowlen_log2];
    a.x *= sc; a.y *= sc; a.z *= sc; a.w *= sc; b.x *= sc; b.y *= sc; b.z *= sc; b.w *= sc;
  }
  uint4 o;
  o.x = pack2(a.x, a.y); o.y = pack2(a.z, a.w); o.z = pack2(b.x, b.y); o.w = pack2(b.z, b.w);
  *(uint4*)(dst + base) = o;
}

constexpr int GBM = 128, GBN = 128, GBK = 64, GLD = 64;
struct GemmP {
  const unsigned short* A; const unsigned short* Bt; int lda, ldb, K;
  const float* rowscale;
  unsigned short* obf; int ldo;
  float* of32; int ldf;
  const float* resid;
  const float *a_log, *dt_bias, *i_bias, *f_bias;
  float* rowacc;
};
enum { EPI_INPROJ = 0, EPI_OUTPROJ = 1, EPI_SCORES = 2, EPI_PLAIN = 3 };

template <int EPI>
__device__ __forceinline__ void gemm_tile(const GemmP p, int tm, int tn, unsigned short* smem) {
  unsigned short* As = smem;
  unsigned short* Bs = smem + 2 * GBM * GLD;
  int tid = threadIdx.x;
  asm volatile("" : "+v"(tid));
  const int lane = tid & 63, wid = tid >> 6;
  const int wm = wid >> 1, wn = wid & 1;
  const int m0 = tm * GBM, n0 = tn * GBN;
  f32x4 acc[4][4];
#pragma unroll
  for (int i = 0; i < 4; ++i)
#pragma unroll
    for (int j = 0; j < 4; ++j) acc[i][j] = (f32x4){0.f, 0.f, 0.f, 0.f};

  uint4 ra0, ra1, ra2, ra3, rb0, rb1, rb2, rb3;
  uint4 sa0, sa1, sa2, sa3, sb0, sb1, sb2, sb3;
  const int nk = p.K / GBK;
  const int lrow = tid >> 3, lc8 = tid & 7;
  const unsigned short* Ag = p.A + (size_t)(m0 + lrow) * p.lda + lc8 * 8;
  const unsigned short* Bg = p.Bt + (size_t)(n0 + lrow) * p.ldb + lc8 * 8;
  const size_t a32 = (size_t)32 * p.lda, b32 = (size_t)32 * p.ldb;
#define GLOAD(R, S, kt)                                                  \
  {                                                                      \
    R##0 = *(const uint4*)(Ag + (kt) * GBK);                             \
    R##1 = *(const uint4*)(Ag + a32 + (kt) * GBK);                       \
    R##2 = *(const uint4*)(Ag + 2 * a32 + (kt) * GBK);                   \
    R##3 = *(const uint4*)(Ag + 3 * a32 + (kt) * GBK);                   \
    S##0 = *(const uint4*)(Bg + (kt) * GBK);                             \
    S##1 = *(const uint4*)(Bg + b32 + (kt) * GBK);                       \
    S##2 = *(const uint4*)(Bg + 2 * b32 + (kt) * GBK);                   \
    S##3 = *(const uint4*)(Bg + 3 * b32 + (kt) * GBK);                   \
  }
#define SSTORE(R, S, buf)                                                \
  {                                                                      \
    unsigned short* ad = As + (size_t)(buf) * GBM * GLD + lrow * GLD + ((lc8 ^ (lrow & 7)) * 8); \
    unsigned short* bd = Bs + (size_t)(buf) * GBN * GLD + lrow * GLD + ((lc8 ^ (lrow & 7)) * 8); \
    *(uint4*)(ad) = R##0; *(uint4*)(ad + 32 * GLD) = R##1; *(uint4*)(ad + 64 * GLD) = R##2; *(uint4*)(ad + 96 * GLD) = R##3; \
    *(uint4*)(bd) = S##0; *(uint4*)(bd + 32 * GLD) = S##1; *(uint4*)(bd + 64 * GLD) = S##2; *(uint4*)(bd + 96 * GLD) = S##3; \
  }
#define GCOMPUTE(buf)                                                                                                     \
  {                                                                                                                       \
    const unsigned short* Ab = As + (size_t)(buf) * GBM * GLD;                                                            \
    const unsigned short* Bb = Bs + (size_t)(buf) * GBN * GLD;                                                            \
    _Pragma("unroll") for (int ks = 0; ks < 2; ++ks) {                                                                    \
      bf16x8 a[4], b[4];                                                                                                  \
      const int kc = ((ks * 4 + (lane >> 4)) ^ (lane & 7)) * 8;                   \
      _Pragma("unroll") for (int i = 0; i < 4; ++i) a[i] = *(const bf16x8*)(Ab + (wm * 64 + i * 16 + (lane & 15)) * GLD + kc); \
      _Pragma("unroll") for (int j = 0; j < 4; ++j) b[j] = *(const bf16x8*)(Bb + (wn * 64 + j * 16 + (lane & 15)) * GLD + kc); \
      _Pragma("unroll") for (int i = 0; i < 4; ++i)                                                                       \
        _Pragma("unroll") for (int j = 0; j < 4; ++j)                                                                     \
          acc[i][j] = __builtin_amdgcn_mfma_f32_16x16x32_bf16(b[j], a[i], acc[i][j], 0, 0, 0);               \
    }                                                                                                                     \
  }
  GLOAD(ra, rb, 0);
  if (nk > 1) GLOAD(sa, sb, 1);
  SSTORE(ra, rb, 0);
  __syncthreads();
  for (int kt = 0; kt < nk; kt += 2) {
    if (kt + 2 < nk) GLOAD(ra, rb, kt + 2);
    GCOMPUTE(0);
    if (kt + 1 < nk) SSTORE(sa, sb, 1);
    __syncthreads();
    if (kt + 1 < nk) {
      if (kt + 3 < nk) GLOAD(sa, sb, kt + 3);
      GCOMPUTE(1);
      if (kt + 2 < nk) SSTORE(ra, rb, 0);
      __syncthreads();
    }
  }
#undef GLOAD
#undef SSTORE
#undef GCOMPUTE
#pragma unroll
  for (int i = 0; i < 4; ++i) {
    const int row = m0 + wm * 64 + i * 16 + (lane & 15);
    float rsc = 1.f;
    float rowss = 0.f;
    if (EPI == EPI_INPROJ) rsc = p.rowscale[row];
    if (EPI == EPI_SCORES) {
      const float4* pr = (const float4*)(p.rowscale + (size_t)row * 16);
      const float4 s0 = pr[0], s1 = pr[1], s2 = pr[2], s3 = pr[3];
      const float ssq = ((s0.x + s0.y) + (s0.z + s0.w)) + ((s1.x + s1.y) + (s1.z + s1.w)) + ((s2.x + s2.y) + (s2.z + s2.w)) + ((s3.x + s3.y) + (s3.z + s3.w));
      rsc = rsqrtf(ssq * (1.f / DM) + EPSF);
    }
#pragma unroll
    for (int j = 0; j < 4; ++j) {
      const int col0 = n0 + wn * 64 + j * 16 + (lane >> 4) * 4;
      const float v0 = acc[i][j][0] * rsc, v1 = acc[i][j][1] * rsc, v2 = acc[i][j][2] * rsc, v3 = acc[i][j][3] * rsc;
      if (EPI == EPI_INPROJ) {
        if (col0 < 4096) {
          uint2 pk; pk.x = pack2(v0, v1); pk.y = pack2(v2, v3);
          *(uint2*)(p.obf + (size_t)row * p.ldo + col0) = pk;
        } else if (col0 < 4128) {
          const float vv[4] = {v0, v1, v2, v3};
          float oo[4];
#pragma unroll
          for (int r = 0; r < 4; ++r) {
            const int jg = col0 - 4096 + r, jj = jg & 7;
            const float v = vv[r];
            float o;
            if (jg < 8) o = -expf(p.a_log[jj]) * softplusf(v + p.dt_bias[jj]);
            else if (jg < 16) o = sigmoidf(v);
            else if (jg < 24) o = v + p.i_bias[jj];
            else o = -softplusf(-(v + p.f_bias[jj]));
            oo[r] = o;
          }
          *(float4*)(p.of32 + (size_t)row * p.ldf + (col0 - 4096)) = make_float4(oo[0], oo[1], oo[2], oo[3]);
        }
      } else if (EPI == EPI_OUTPROJ) {
        const float4 xr = *(const float4*)(p.resid + (size_t)row * p.ldf + col0);
        const float x0 = v0 + xr.x, x1 = v1 + xr.y, x2 = v2 + xr.z, x3 = v3 + xr.w;
        *(float4*)(p.of32 + (size_t)row * p.ldf + col0) = make_float4(x0, x1, x2, x3);
        uint2 pk; pk.x = pack2(x0, x1); pk.y = pack2(x2, x3);
        *(uint2*)(p.obf + (size_t)row * p.ldo + col0) = pk;
        rowss += (x0 * x0 + x1 * x1) + (x2 * x2 + x3 * x3);
      } else {
        uint2 pk; pk.x = pack2(v0, v1); pk.y = pack2(v2, v3);
        *(uint2*)(p.obf + (size_t)row * p.ldo + col0) = pk;
      }
    }
    if (EPI == EPI_OUTPROJ) {
      rowss += __shfl_xor(rowss, 16, 64);
      rowss += __shfl_xor(rowss, 32, 64);
      if ((lane >> 4) == 0) p.rowacc[(size_t)row * 16 + tn * 2 + wn] = rowss;
    }
  }
}

__device__ __forceinline__ bool xcd_tile(int bid, int nb, int k, int ntn, int& tm, int& tn) {
  const int q = (bid >> 3) + (nb >> 3) * k;
  if (q >= 16 * ntn) return false;
  const int g = q / (8 * ntn), rem = q % (8 * ntn);
  tn = rem >> 3;
  tm = 16 * (bid & 7) + 8 * g + (rem & 7);
  return true;
}

__device__ __forceinline__ void d_conv(int item, const unsigned short* __restrict__ pm, const float* __restrict__ pg,
                                              const float* __restrict__ conv_w, const float* __restrict__ a_log,
                                              const float* __restrict__ dt_bias, const float* __restrict__ i_bias,
                                              const float* __restrict__ f_bias, unsigned short* __restrict__ qkv,
                                              float* __restrict__ gt) {
  int t = item * 4 + (threadIdx.x >> 6);
  int lane = threadIdx.x & 63;
  int s = t & (SEQ - 1);
  for (int sec = 0; sec < 3; ++sec) {
    for (int h = 0; h < 4; ++h) {
      int c0 = sec * 512 + h * 128 + 2 * lane;
      float a0 = 0.f, a1 = 0.f;
#pragma unroll
      for (int j = 0; j < 5; ++j) {
        int sp = s + j - 2;
        if (sp >= 0 && sp < SEQ) {
          unsigned v = *(const unsigned*)(pm + (size_t)(t + j - 2) * 4096 + c0);
          a0 += conv_w[c0 * 5 + j] * bf2f((unsigned short)(v & 0xffff));
          a1 += conv_w[(c0 + 1) * 5 + j] * bf2f((unsigned short)(v >> 16));
        }
      }
      a0 = a0 * sigmoidf(a0);
      a1 = a1 * sigmoidf(a1);
      if (sec < 2) {
        float ss = wave_sum(a0 * a0 + a1 * a1);
        float sc = rsqrtf(ss + EPSF);
        if (sec == 0) sc *= 0.08838834764831845f;
        a0 *= sc; a1 *= sc;
      }
      unsigned o = pack2(a0, a1);
      *(unsigned*)(qkv + (size_t)t * 1536 + c0) = o;
    }
  }
}

__device__ __forceinline__ void d_gdn_rec(int chain, float* sq, float* sk, const unsigned short* __restrict__ qkv,
                                                 const float* __restrict__ gt, unsigned short* __restrict__ oA, int ntok) {
  const int bh = chain >> 1, dir = chain & 1;
  const int b = bh >> 2, h = bh & 3;
  const int e = threadIdx.x & 127;
  float S[128];
#pragma unroll
  for (int d = 0; d < 128; ++d) S[d] = 0.f;
  for (int it = 0; it < SEQ; ++it) {
    const int s = dir ? (SEQ - 1 - it) : it;
    const size_t t = (size_t)b * SEQ + s;
    __syncthreads();
    sq[e] = bf2f(qkv[t * 1536 + h * 128 + e]);
    sk[e] = bf2f(qkv[t * 1536 + 512 + h * 128 + e]);
    const float v = bf2f(qkv[t * 1536 + 1024 + h * 128 + e]);
    const float g = gt[t * 32 + dir * 4 + h];
    const float beta = gt[t * 32 + 8 + dir * 4 + h];
    __syncthreads();
    const float a = expf(g);
    float k0 = 0.f, k1 = 0.f, k2 = 0.f, k3 = 0.f;
#pragma unroll
    for (int d = 0; d < 128; d += 4) {
      k0 += sk[d] * S[d]; k1 += sk[d + 1] * S[d + 1]; k2 += sk[d + 2] * S[d + 2]; k3 += sk[d + 3] * S[d + 3];
    }
    const float kS = a * ((k0 + k1) + (k2 + k3));
    const float vn = beta * (v - kS);
    float o0 = 0.f, o1 = 0.f, o2 = 0.f, o3 = 0.f;
#pragma unroll
    for (int d = 0; d < 128; d += 4) {
      S[d] = a * S[d] + sk[d] * vn;             o0 += sq[d] * S[d];
      S[d + 1] = a * S[d + 1] + sk[d + 1] * vn; o1 += sq[d + 1] * S[d + 1];
      S[d + 2] = a * S[d + 2] + sk[d + 2] * vn; o2 += sq[d + 2] * S[d + 2];
      S[d + 3] = a * S[d + 3] + sk[d + 3] * vn; o3 += sq[d + 3] * S[d + 3];
    }
    oA[((size_t)dir * ntok + t) * 512 + h * 128 + e] = f2bf((o0 + o1) + (o2 + o3));
  }
}

__device__ __forceinline__ void d_mlstm_rec(int chain, float* sq, float* sk, const unsigned short* __restrict__ pm,
                                                   const float* __restrict__ gt, unsigned short* __restrict__ oM, int ntok) {
  const int bh = chain >> 1, dir = chain & 1;
  const int b = bh >> 2, h = bh & 3;
  const int e = threadIdx.x & 127, lane = e & 63;
  float C[128];
#pragma unroll
  for (int d = 0; d < 128; ++d) C[d] = 0.f;
  float n0 = 0.f, n1 = 0.f, m = 0.f;
  for (int it = 0; it < SEQ; ++it) {
    const int s = dir ? (SEQ - 1 - it) : it;
    const size_t t = (size_t)b * SEQ + s;
    __syncthreads();
    sq[e] = bf2f(pm[t * 4096 + 2048 + h * 128 + e]);
    sk[e] = bf2f(pm[t * 4096 + 2560 + h * 128 + e]) * 0.08838834764831845f;
    const float v = bf2f(pm[t * 4096 + 3072 + h * 128 + e]);
    const float ip = gt[t * 32 + 16 + dir * 4 + h];
    const float lf = gt[t * 32 + 24 + dir * 4 + h];
    __syncthreads();
    const float mn = fmaxf(lf + m, ip);
    const float fs = expf(lf + m - mn);
    const float is = expf(ip - mn);
    m = mn;
    n0 = fs * n0 + is * sk[lane];
    n1 = fs * n1 + is * sk[lane + 64];
    const float den = wave_sum(n0 * sq[lane] + n1 * sq[lane + 64]);
    const float iv = is * v;
    float o0 = 0.f, o1 = 0.f, o2 = 0.f, o3 = 0.f;
#pragma unroll
    for (int d = 0; d < 128; d += 4) {
      C[d] = fs * C[d] + sk[d] * iv;             o0 += sq[d] * C[d];
      C[d + 1] = fs * C[d + 1] + sk[d + 1] * iv; o1 += sq[d + 1] * C[d + 1];
      C[d + 2] = fs * C[d + 2] + sk[d + 2] * iv; o2 += sq[d + 2] * C[d + 2];
      C[d + 3] = fs * C[d + 3] + sk[d + 3] * iv; o3 += sq[d + 3] * C[d + 3];
    }
    const float num = (o0 + o1) + (o2 + o3);
    const float hh = num / fmaxf(fabsf(den), expf(-mn));
    oM[((size_t)dir * ntok + t) * 512 + h * 128 + e] = f2bf(hh);
  }
}

__device__ __forceinline__ void d_combine(int item, const unsigned short* __restrict__ uo, const unsigned short* __restrict__ oM,
                                                 const unsigned short* __restrict__ pm, const float* __restrict__ gdn_g,
                                                 const float* __restrict__ ml_g, unsigned short* __restrict__ y) {
  int tid_ = threadIdx.x;
  asm volatile("" : "+v"(tid_));
  const int t = item * 4 + (tid_ >> 6);
  const int lane = tid_ & 63;
  const int b = t >> 12, cc = (t >> 6) & 63, ii = t & 63;
  unsigned gf_[4], gb_[4], mf_[4], mb_[4], zg_[4], zo_[4];
  const size_t off = (size_t)cc * 8192 + (lane >> 4) * 2048 + ii * 32 + ((2 * lane) & 31);
#pragma unroll
  for (int h = 0; h < 4; ++h) {
    const int c = h * 128 + 2 * lane;
    const int chain0 = (b * 4 + h) * 2;
    gf_[h] = *(const unsigned*)(uo + (size_t)chain0 * 64 * 8192 + off);
    gb_[h] = *(const unsigned*)(uo + (size_t)(chain0 + 1) * 64 * 8192 + off);
    mf_[h] = *(const unsigned*)(oM + (size_t)t * 512 + c);
    mb_[h] = *(const unsigned*)(oM + ((size_t)NT + t) * 512 + c);
    zg_[h] = *(const unsigned*)(pm + (size_t)t * 4096 + 1536 + c);
    zo_[h] = *(const unsigned*)(pm + (size_t)t * 4096 + 3584 + c);
  }
  const float gg0 = gdn_g[2 * lane], gg1 = gdn_g[2 * lane + 1];
  float a0[4], a1[4], m0[4], m1[4], sa[4], sm[4];
#pragma unroll
  for (int h = 0; h < 4; ++h) {
    a0[h] = bf2f(gf_[h] & 0xffff) + bf2f(gb_[h] & 0xffff);
    a1[h] = __uint_as_float(gf_[h] & 0xffff0000u) + __uint_as_float(gb_[h] & 0xffff0000u);
    m0[h] = bf2f(mf_[h] & 0xffff) + bf2f(mb_[h] & 0xffff);
    m1[h] = __uint_as_float(mf_[h] & 0xffff0000u) + __uint_as_float(mb_[h] & 0xffff0000u);
    sa[h] = a0[h] * a0[h] + a1[h] * a1[h];
    sm[h] = m0[h] * m0[h] + m1[h] * m1[h];
  }
#pragma unroll
  for (int o = 32; o > 0; o >>= 1) {
#pragma unroll
    for (int h = 0; h < 4; ++h) { sa[h] += __shfl_xor(sa[h], o, 64); sm[h] += __shfl_xor(sm[h], o, 64); }
  }
#pragma unroll
  for (int h = 0; h < 4; ++h) {
    const int c = h * 128 + 2 * lane;
    const float sca = rsqrtf(sa[h] * (1.f / 128.f) + EPSF);
    const float scm = rsqrtf(sm[h] * (1.f / 128.f) + EPSF);
    const float z0 = bf2f(zg_[h] & 0xffff), z1 = __uint_as_float(zg_[h] & 0xffff0000u);
    const float q0 = bf2f(zo_[h] & 0xffff), q1 = __uint_as_float(zo_[h] & 0xffff0000u);
    const float o0 = a0[h] * sca * gg0 * (z0 * sigmoidf(z0));
    const float o1 = a1[h] * sca * gg1 * (z1 * sigmoidf(z1));
    const float p0 = m0[h] * scm * ml_g[c] * sigmoidf(q0);
    const float p1 = m1[h] * scm * ml_g[c + 1] * sigmoidf(q1);
    *(unsigned*)(y + (size_t)t * DM + c) = pack2(o0, o1);
    *(unsigned*)(y + (size_t)t * DM + 512 + c) = pack2(p0, p1);
  }
}

#ifdef DBG_CHECK
__device__ __forceinline__ void d_dbg_cmp(int item, const unsigned short* __restrict__ uo, const unsigned short* __restrict__ oAd,
                                          float* __restrict__ dbg) {
  int t = item * 4 + (threadIdx.x >> 6);
  int lane = threadIdx.x & 63;
  const int cc = (t >> 6) & 63, ii = t & 63;
  float sd = 0.f, sr = 0.f;
  for (int h = 0; h < 4; ++h) {
    for (int dir = 0; dir < 2; ++dir) {
      const int chain = h * 2 + dir;
      const size_t off = (size_t)cc * 8192 + (lane >> 4) * 2048 + ii * 32 + ((2 * lane) & 31);
      unsigned vn = *(const unsigned*)(uo + (size_t)chain * 64 * 8192 + off);
      unsigned vr = *(const unsigned*)(oAd + ((size_t)dir * 4096 + t) * 512 + h * 128 + 2 * lane);
      float n0 = bf2f(vn & 0xffff), n1 = bf2f(vn >> 16), r0 = bf2f(vr & 0xffff), r1 = bf2f(vr >> 16);
      sd += (n0 - r0) * (n0 - r0) + (n1 - r1) * (n1 - r1);
      sr += r0 * r0 + r1 * r1;
    }
  }
  sd = wave_sum(sd); sr = wave_sum(sr);
  if (lane == 0) { atomicAdd(&dbg[0], sd); atomicAdd(&dbg[1], sr); }
}
__device__ __forceinline__ void d_dbg_cmp_m(int item, const unsigned short* __restrict__ oM, const unsigned short* __restrict__ oMd,
                                            float* __restrict__ dbg) {
  int t = item * 4 + (threadIdx.x >> 6);
  int lane = threadIdx.x & 63;
  float sd = 0.f, sr = 0.f;
  for (int dir = 0; dir < 2; ++dir)
    for (int q = 0; q < 4; ++q) {
      unsigned vn = *(const unsigned*)(oM + ((size_t)dir * NT + t) * 512 + q * 128 + 2 * lane);
      unsigned vr = *(const unsigned*)(oMd + ((size_t)dir * 4096 + t) * 512 + q * 128 + 2 * lane);
      float n0 = bf2f(vn & 0xffff), n1 = bf2f(vn >> 16), r0 = bf2f(vr & 0xffff), r1 = bf2f(vr >> 16);
      sd += (n0 - r0) * (n0 - r0) + (n1 - r1) * (n1 - r1);
      sr += r0 * r0 + r1 * r1;
    }
  sd = wave_sum(sd); sr = wave_sum(sr);
  if (lane == 0) { atomicAdd(&dbg[0], sd); atomicAdd(&dbg[1], sr); }
}
#endif

__device__ __forceinline__ void d_prep_x1(int item, const float* __restrict__ x1, unsigned short* __restrict__ xb,
                                                 float* __restrict__ rs) {
  int t = item * 4 + (threadIdx.x >> 6);
  int lane = threadIdx.x & 63;
  const float4* xr = (const float4*)(x1 + (size_t)t * DM);
  float ss = 0.f;
#pragma unroll
  for (int i = 0; i < 4; ++i) {
    float4 v = xr[lane + 64 * i];
    ss += v.x * v.x + v.y * v.y + v.z * v.z + v.w * v.w;
    ushort4 o;
    o.x = f2bf(v.x); o.y = f2bf(v.y); o.z = f2bf(v.z); o.w = f2bf(v.w);
    ((ushort4*)(xb + (size_t)t * DM))[lane + 64 * i] = o;
  }
  ss = wave_sum(ss);
  if (lane == 0) rs[t] = rsqrtf(ss * (1.f / DM) + EPSF);
}

__device__ const unsigned char kPairTab[64] = {
    0x00, 0x01, 0x02, 0x03, 0x04, 0x05, 0x06, 0x07, 0x08, 0x09, 0x0a, 0x0b, 0x0c, 0x0d, 0x0e, 0x0f,
    0x10, 0x11, 0x12, 0x13, 0x14, 0x15, 0x16, 0x17,
    0x20, 0x21, 0x22, 0x23, 0x24,
    0x30, 0x31, 0x32, 0x33,
    0x40, 0x41, 0x42,
    0x50, 0x51, 0x60, 0x61, 0x70, 0x71,
    0x80, 0x90, 0xa0, 0xb0, 0xc0, 0xd0, 0xe0, 0xf0,
    0xff, 0xff, 0xff, 0xff, 0xff, 0xff, 0xff, 0xff, 0xff, 0xff, 0xff, 0xff, 0xff, 0xff};

__device__ __forceinline__ void sort16_desc(unsigned (&a)[16]) {
#pragma unroll
  for (int k = 2; k <= 16; k <<= 1)
#pragma unroll
    for (int j = k >> 1; j > 0; j >>= 1)
#pragma unroll
      for (int i = 0; i < 16; ++i) {
        const int l = i ^ j;
        if (l > i) {
          const unsigned hi = max(a[i], a[l]), lo = min(a[i], a[l]);
          if ((i & k) == 0) { a[i] = hi; a[l] = lo; } else { a[i] = lo; a[l] = hi; }
        }
      }
}
__device__ __forceinline__ void merge16_desc(unsigned (&top)[16], const unsigned (&b)[16]) {
#pragma unroll
  for (int i = 0; i < 16; ++i) top[i] = max(top[i], b[15 - i]);
#pragma unroll
  for (int j = 8; j > 0; j >>= 1)
#pragma unroll
    for (int i = 0; i < 16; ++i) {
      const int l = i ^ j;
      if (l > i) {
        const unsigned hi = max(top[i], top[l]), lo = min(top[i], top[l]);
        top[i] = hi; top[l] = lo;
      }
    }
}
__device__ __forceinline__ unsigned key16(unsigned hbits, int idx) {
  const unsigned m = hbits ^ ((hbits & 0x8000u) ? 0xFFFFu : 0x8000u);
  return (m << 16) | (unsigned)(127 - idx);
}
__device__ __forceinline__ void top16_of_128(const unsigned short* __restrict__ sp, unsigned (&top)[16]) {
#pragma unroll
  for (int g = 0; g < 8; ++g) {
    const uint4 x0 = *(const uint4*)(sp + g * 16);
    const uint4 x1 = *(const uint4*)(sp + g * 16 + 8);
    unsigned b[16];
    b[0] = key16(x0.x & 0xffff, g * 16 + 0);  b[1] = key16(x0.x >> 16, g * 16 + 1);
    b[2] = key16(x0.y & 0xffff, g * 16 + 2);  b[3] = key16(x0.y >> 16, g * 16 + 3);
    b[4] = key16(x0.z & 0xffff, g * 16 + 4);  b[5] = key16(x0.z >> 16, g * 16 + 5);
    b[6] = key16(x0.w & 0xffff, g * 16 + 6);  b[7] = key16(x0.w >> 16, g * 16 + 7);
    b[8] = key16(x1.x & 0xffff, g * 16 + 8);  b[9] = key16(x1.x >> 16, g * 16 + 9);
    b[10] = key16(x1.y & 0xffff, g * 16 + 10); b[11] = key16(x1.y >> 16, g * 16 + 11);
    b[12] = key16(x1.z & 0xffff, g * 16 + 12); b[13] = key16(x1.z >> 16, g * 16 + 13);
    b[14] = key16(x1.w & 0xffff, g * 16 + 14); b[15] = key16(x1.w >> 16, g * 16 + 15);
    sort16_desc(b);
    if (g == 0) {
#pragma unroll
      for (int i = 0; i < 16; ++i) top[i] = b[i];
    } else {
      merge16_desc(top, b);
    }
  }
}

__device__ __forceinline__ void d_topk(int item, const unsigned short* __restrict__ scores, int* __restrict__ idx_out,
                                       float* __restrict__ gate_out) {
  int tid_ = threadIdx.x;
  asm volatile("" : "+v"(tid_));
  const int pair = item * 256 + tid_;
  const unsigned short* sp = scores + (size_t)pair * 256;
  unsigned k0[16], k1[16];
  top16_of_128(sp, k0);
  top16_of_128(sp + 128, k1);
  float v0[16], v1[16];
  int i0[16], i1[16];
#pragma unroll
  for (int i = 0; i < 16; ++i) {
    const unsigned m0 = k0[i] >> 16, m1 = k1[i] >> 16;
    v0[i] = bf2f((unsigned short)(m0 ^ ((m0 & 0x8000u) ? 0x8000u : 0xFFFFu)));
    v1[i] = bf2f((unsigned short)(m1 ^ ((m1 & 0x8000u) ? 0x8000u : 0xFFFFu)));
    i0[i] = 127 - (int)(k0[i] & 127u);
    i1[i] = 127 - (int)(k1[i] & 127u);
  }
  unsigned top[16];
#pragma unroll
  for (int g = 0; g < 4; ++g) {
    unsigned b[16];
#pragma unroll
    for (int q = 0; q < 16; ++q) {
      const int pr = kPairTab[g * 16 + q];
      if (pr == 0xff) {
        b[q] = 0u;
      } else {
        const int pi = pr >> 4, pj = pr & 15;
        const float sum = v0[pi] + v1[pj];
        const unsigned u = __float_as_uint(sum);
        const unsigned mono = u ^ ((u & 0x80000000u) ? 0xFFFFFFFFu : 0x80000000u);
        b[q] = (mono & 0xFFFFC000u) | (unsigned)(16383 - (i0[pi] * 128 + i1[pj]));
      }
    }
    sort16_desc(b);
    if (g == 0) {
#pragma unroll
      for (int i = 0; i < 16; ++i) top[i] = b[i];
    } else {
      merge16_desc(top, b);
    }
  }
  float ev[16];
  int ci[16];
  float mx = 0.f, sum = 0.f;
#pragma unroll
  for (int i = 0; i < 16; ++i) {
    const unsigned mono = top[i] & 0xFFFFC000u;
    const unsigned u = mono ^ ((mono & 0x80000000u) ? 0x80000000u : 0xFFFFFFFFu);
    const float val = __uint_as_float(u & 0xFFFFC000u);
    ci[i] = 16383 - (int)(top[i] & 16383u);
    if (i == 0) mx = val;
    ev[i] = expf(val - mx);
    sum += ev[i];
  }
  const float inv = 1.f / sum;
#pragma unroll
  for (int q = 0; q < 4; ++q) {
    int4 o; float4 g;
    o.x = ci[4 * q]; o.y = ci[4 * q + 1]; o.z = ci[4 * q + 2]; o.w = ci[4 * q + 3];
    g.x = ev[4 * q] * inv; g.y = ev[4 * q + 1] * inv; g.z = ev[4 * q + 2] * inv; g.w = ev[4 * q + 3] * inv;
    *(int4*)(idx_out + (size_t)pair * 16 + 4 * q) = o;
    *(float4*)(gate_out + (size_t)pair * 16 + 4 * q) = g;
  }
}

typedef float f32x2 __attribute__((ext_vector_type(2)));
__device__ __forceinline__ void d_cvt_tab(int item, const float* __restrict__ src, unsigned* __restrict__ dst8, float* __restrict__ dscale) {
  const int row = item * 4 + (threadIdx.x >> 6);
  const int lane = threadIdx.x & 63;
  const float4* sr = (const float4*)(src + (size_t)row * DM + lane * 16);
  const float4 a = sr[0], b = sr[1], c = sr[2], d = sr[3];
  float m = fmaxf(fmaxf(fmaxf(fabsf(a.x), fabsf(a.y)), fmaxf(fabsf(a.z), fabsf(a.w))),
                  fmaxf(fmaxf(fabsf(b.x), fabsf(b.y)), fmaxf(fabsf(b.z), fabsf(b.w))));
  m = fmaxf(m, fmaxf(fmaxf(fmaxf(fabsf(c.x), fabsf(c.y)), fmaxf(fabsf(c.z), fabsf(c.w))),
                     fmaxf(fmaxf(fabsf(d.x), fabsf(d.y)), fmaxf(fabsf(d.z), fabsf(d.w)))));
#pragma unroll
  for (int o = 32; o > 0; o >>= 1) m = fmaxf(m, __shfl_xor(m, o, 64));
  const float sc = (m > 0.f) ? 240.f / m : 1.f;
  uint4 o;
  int p;
  p = 0; p = __builtin_amdgcn_cvt_pk_fp8_f32(a.x * sc, a.y * sc, p, false); p = __builtin_amdgcn_cvt_pk_fp8_f32(a.z * sc, a.w * sc, p, true); o.x = (unsigned)p;
  p = 0; p = __builtin_amdgcn_cvt_pk_fp8_f32(b.x * sc, b.y * sc, p, false); p = __builtin_amdgcn_cvt_pk_fp8_f32(b.z * sc, b.w * sc, p, true); o.y = (unsigned)p;
  p = 0; p = __builtin_amdgcn_cvt_pk_fp8_f32(c.x * sc, c.y * sc, p, false); p = __builtin_amdgcn_cvt_pk_fp8_f32(c.z * sc, c.w * sc, p, true); o.z = (unsigned)p;
  p = 0; p = __builtin_amdgcn_cvt_pk_fp8_f32(d.x * sc, d.y * sc, p, false); p = __builtin_amdgcn_cvt_pk_fp8_f32(d.z * sc, d.w * sc, p, true); o.w = (unsigned)p;
  *(uint4*)(dst8 + (size_t)row * 256 + lane * 4) = o;
  if (lane == 0) dscale[row] = (m > 0.f) ? m * (1.f / 240.f) : 1.f;
}

__device__ __forceinline__ float erf_fast(float x) {
  const float ax = fabsf(x);
  const float t = __builtin_amdgcn_rcpf(1.f + 0.3275911f * ax);
  float p = 1.061405429f;
  p = p * t - 1.453152027f;
  p = p * t + 1.421413741f;
  p = p * t - 0.284496736f;
  p = p * t + 0.254829592f;
  const float e = __builtin_amdgcn_exp2f(-1.4426950408889634f * ax * ax);
  const float r = 1.f - p * t * e;
  return copysignf(r, x);
}
__device__ __forceinline__ float dot16_f8(const uint4 u, const float* hv) {
  const f32x2 a0 = __builtin_amdgcn_cvt_pk_f32_fp8((int)u.x, false), a1 = __builtin_amdgcn_cvt_pk_f32_fp8((int)u.x, true);
  const f32x2 b0 = __builtin_amdgcn_cvt_pk_f32_fp8((int)u.y, false), b1 = __builtin_amdgcn_cvt_pk_f32_fp8((int)u.y, true);
  const f32x2 c0 = __builtin_amdgcn_cvt_pk_f32_fp8((int)u.z, false), c1 = __builtin_amdgcn_cvt_pk_f32_fp8((int)u.z, true);
  const f32x2 d0 = __builtin_amdgcn_cvt_pk_f32_fp8((int)u.w, false), d1 = __builtin_amdgcn_cvt_pk_f32_fp8((int)u.w, true);
  float s0 = a0[0] * hv[0] + a0[1] * hv[1];
  float s1 = a1[0] * hv[2] + a1[1] * hv[3];
  s0 += b0[0] * hv[4] + b0[1] * hv[5];
  s1 += b1[0] * hv[6] + b1[1] * hv[7];
  s0 += c0[0] * hv[8] + c0[1] * hv[9];
  s1 += c1[0] * hv[10] + c1[1] * hv[11];
  s0 += d0[0] * hv[12] + d0[1] * hv[13];
  s1 += d1[0] * hv[14] + d1[1] * hv[15];
  return s0 + s1;
}
__device__ __forceinline__ void axpy16_f8(const uint4 v, const float wg, float* acc) {
  const f32x2 a0 = __builtin_amdgcn_cvt_pk_f32_fp8((int)v.x, false), a1 = __builtin_amdgcn_cvt_pk_f32_fp8((int)v.x, true);
  const f32x2 b0 = __builtin_amdgcn_cvt_pk_f32_fp8((int)v.y, false), b1 = __builtin_amdgcn_cvt_pk_f32_fp8((int)v.y, true);
  const f32x2 c0 = __builtin_amdgcn_cvt_pk_f32_fp8((int)v.z, false), c1 = __builtin_amdgcn_cvt_pk_f32_fp8((int)v.z, true);
  const f32x2 d0 = __builtin_amdgcn_cvt_pk_f32_fp8((int)v.w, false), d1 = __builtin_amdgcn_cvt_pk_f32_fp8((int)v.w, true);
  acc[0] += wg * a0[0]; acc[1] += wg * a0[1]; acc[2] += wg * a1[0]; acc[3] += wg * a1[1];
  acc[4] += wg * b0[0]; acc[5] += wg * b0[1]; acc[6] += wg * b1[0]; acc[7] += wg * b1[1];
  acc[8] += wg * c0[0]; acc[9] += wg * c0[1]; acc[10] += wg * c1[0]; acc[11] += wg * c1[1];
  acc[12] += wg * d0[0]; acc[13] += wg * d0[1]; acc[14] += wg * d1[0]; acc[15] += wg * d1[1];
}
__device__ __forceinline__ void d_peer(int item, const float* __restrict__ x1, const float* __restrict__ rs2,
                                       const float* __restrict__ g2, const int* __restrict__ idx,
                                       const float* __restrict__ gate, const unsigned* __restrict__ pu,
                                       const unsigned* __restrict__ pv, const float* __restrict__ su,
                                       const float* __restrict__ sv, const float* __restrict__ gf,
                                       float* __restrict__ out, float oscale) {
  int tid_ = threadIdx.x;
  asm volatile("" : "+v"(tid_));
  const int t = item * 4 + (tid_ >> 6);
  const int lane = tid_ & 63;
  float r2;
  {
    const float4* pr = (const float4*)(rs2 + (size_t)t * 16);
    const float4 s0 = pr[0], s1 = pr[1], s2 = pr[2], s3 = pr[3];
    const float ssq = ((s0.x + s0.y) + (s0.z + s0.w)) + ((s1.x + s1.y) + (s1.z + s1.w)) + ((s2.x + s2.y) + (s2.z + s2.w)) + ((s3.x + s3.y) + (s3.z + s3.w));
    r2 = rsqrtf(ssq * (1.f / DM) + EPSF);
  }
  float xv[16], hv[16], acc[16];
#pragma unroll
  for (int q = 0; q < 4; ++q) {
    const float4 xx = *(const float4*)(x1 + (size_t)t * DM + lane * 16 + q * 4);
    const float4 gg = *(const float4*)(g2 + lane * 16 + q * 4);
    xv[q * 4 + 0] = xx.x; xv[q * 4 + 1] = xx.y; xv[q * 4 + 2] = xx.z; xv[q * 4 + 3] = xx.w;
    hv[q * 4 + 0] = xx.x * r2 * gg.x; hv[q * 4 + 1] = xx.y * r2 * gg.y;
    hv[q * 4 + 2] = xx.z * r2 * gg.z; hv[q * 4 + 3] = xx.w * r2 * gg.w;
  }
#pragma unroll
  for (int i = 0; i < 16; ++i) acc[i] = 0.f;
  const int id_a = idx[(size_t)t * 128 + lane], id_b = idx[(size_t)t * 128 + 64 + lane];
  const float gt_a = gate[(size_t)t * 128 + lane], gt_b = gate[(size_t)t * 128 + 64 + lane];
  for (int e0 = 0; e0 < 128; e0 += 8) {
    uint4 u[8], v[8];
    float gt8[8], su8[8], sv8[8];
#pragma unroll
    for (int k = 0; k < 8; ++k) {
      const int e = e0 + k;
      const int id = (e0 < 64) ? __shfl(id_a, e, 64) : __shfl(id_b, e - 64, 64);
      gt8[k] = (e0 < 64) ? __shfl(gt_a, e, 64) : __shfl(gt_b, e - 64, 64);
      u[k] = *(const uint4*)(pu + (size_t)id * 256 + lane * 4);
      v[k] = *(const uint4*)(pv + (size_t)id * 256 + lane * 4);
      su8[k] = su[id];
      sv8[k] = sv[id];
    }
    float d[8];
#pragma unroll
    for (int k = 0; k < 8; ++k) d[k] = dot16_f8(u[k], hv);
#pragma unroll
    for (int o = 32; o > 0; o >>= 1) {
#pragma unroll
      for (int k = 0; k < 8; ++k) d[k] += __shfl_xor(d[k], o, 64);
    }
#pragma unroll
    for (int k = 0; k < 8; ++k) {
      const float dd = d[k] * su8[k];
      const float act = 0.5f * dd * (1.f + erf_fast(dd * 0.7071067811865476f));
      axpy16_f8(v[k], gt8[k] * act * sv8[k], acc);
    }
  }
  float ss = 0.f;
#pragma unroll
  for (int i = 0; i < 16; ++i) { acc[i] += xv[i]; ss += acc[i] * acc[i]; }
  ss = wave_sum(ss);
  const float sc = rsqrtf(ss * (1.f / DM) + EPSF) * oscale;
#pragma unroll
  for (int q = 0; q < 4; ++q) {
    const float4 gg = *(const float4*)(gf + lane * 16 + q * 4);
    float4 o;
    o.x = acc[q * 4 + 0] * sc * gg.x; o.y = acc[q * 4 + 1] * sc * gg.y;
    o.z = acc[q * 4 + 2] * sc * gg.z; o.w = acc[q * 4 + 3] * sc * gg.w;
    *(float4*)(out + (size_t)t * DM + lane * 16 + q * 4) = o;
  }
}

typedef __attribute__((ext_vector_type(16))) float f32x16;
#define MFMA32(a, b, c) __builtin_amdgcn_mfma_f32_32x32x16_bf16((a), (b), (c), 0, 0, 0)
__device__ __forceinline__ int crow(int reg, int hh) { return (reg & 3) + 8 * (reg >> 2) + 4 * hh; }

struct GdnBufs {
  unsigned short* qc;
  unsigned short* kTc;
  unsigned short* qkc;
  unsigned short* wn;
  unsigned short* uo;
  float* gsc;
};

__device__ __forceinline__ void tri_subst(const float* AL0, int lane, float (&T)[64]) {
  const float* AL = (const float*)__builtin_assume_aligned(AL0, 16);
#pragma unroll
  for (int i = 0; i < 64; ++i) T[i] = 0.f;
  T[0] = (lane == 0) ? 1.f : 0.f;
  float4 cur[16], nxt[16];
#pragma unroll
  for (int j4 = 0; j4 < 1; ++j4) cur[j4] = *(const float4*)(AL + 1 * 72 + 4 * j4);
#pragma unroll
  for (int i = 1; i < 64; ++i) {
    if (i + 1 < 64) {
#pragma unroll
      for (int j4 = 0; j4 < (i + 4) / 4; ++j4) nxt[j4] = *(const float4*)(AL + (i + 1) * 72 + 4 * j4);
    }
    float ax = 0.f, ay = 0.f, az = 0.f, aw = 0.f;
#pragma unroll
    for (int j4 = 0; j4 < (i + 3) / 4; ++j4) {
      ax += cur[j4].x * T[4 * j4]; ay += cur[j4].y * T[4 * j4 + 1]; az += cur[j4].z * T[4 * j4 + 2]; aw += cur[j4].w * T[4 * j4 + 3];
    }
    T[i] = ((lane == i) ? 1.f : 0.f) - ((ax + ay) + (az + aw));
#pragma unroll
    for (int j4 = 0; j4 < 16; ++j4) cur[j4] = nxt[j4];
  }
}

__device__ __forceinline__ void d_gdn_prep(int item, char* smem, const unsigned short* __restrict__ pm,
                                           const float* __restrict__ gt, const float* __restrict__ conv_w, GdnBufs G) {
  unsigned short* qL = (unsigned short*)smem;
  unsigned short* kL = qL + 64 * 144;
  unsigned short* kTL = kL + 64 * 144;
  unsigned short* vTL = kTL + 128 * 72;
  float* scal = (float*)(vTL + 128 * 72);
  float* A0 = (float*)qL;
  float* A1 = (float*)kL;
  int tid = threadIdx.x;
  asm volatile("" : "+v"(tid));
  const int lane = tid & 63, w = __builtin_amdgcn_readfirstlane(tid >> 6), r = lane & 31, hh = lane >> 5;
  const int bh = item >> 6, c = item & 63, b = bh >> 2, h = bh & 3;
  const int t0 = b * SEQ + c * 64;
  __syncthreads();
  {
#pragma unroll
    for (int sec = 0; sec < 3; ++sec) {
      const int c0 = sec * 512 + h * 128 + 2 * lane;
      float cw0[5], cw1[5];
#pragma unroll
      for (int j = 0; j < 5; ++j) { cw0[j] = conv_w[c0 * 5 + j]; cw1[j] = conv_w[(c0 + 1) * 5 + j]; }
      unsigned raw[20];
#pragma unroll
      for (int k = 0; k < 20; ++k) {
        const int sp = c * 64 + w * 16 + k - 2;
        raw[k] = (sp >= 0 && sp < SEQ) ? *(const unsigned*)(pm + ((size_t)t0 + w * 16 + k - 2) * 4096 + c0) : 0u;
      }
#pragma unroll
      for (int ii = 0; ii < 16; ++ii) {
        const int i = w * 16 + ii;
        float a0 = 0.f, a1 = 0.f;
#pragma unroll
        for (int j = 0; j < 5; ++j) {
          a0 += cw0[j] * bf2f((unsigned short)(raw[ii + j] & 0xffff));
          a1 += cw1[j] * __uint_as_float(raw[ii + j] & 0xffff0000u);
        }
        a0 = a0 * __builtin_amdgcn_rcpf(1.f + __builtin_amdgcn_exp2f(-1.4426950408889634f * a0));
        a1 = a1 * __builtin_amdgcn_rcpf(1.f + __builtin_amdgcn_exp2f(-1.4426950408889634f * a1));
        if (sec < 2) {
          const float ss = wave_sum_dpp(a0 * a0 + a1 * a1);
          float sc = rsqrtf(ss + EPSF);
          if (sec == 0) sc *= 0.08838834764831845f;
          a0 *= sc; a1 *= sc;
        }
        if (sec == 0) {
          *(unsigned*)(qL + i * 144 + 2 * lane) = pack2(a0, a1);
        } else if (sec == 1) {
          const unsigned pk = pack2(a0, a1);
          *(unsigned*)(kL + i * 144 + 2 * lane) = pk;
          kTL[(2 * lane) * 72 + i] = (unsigned short)(pk & 0xffff);
          kTL[(2 * lane + 1) * 72 + i] = (unsigned short)(pk >> 16);
        } else {
          const unsigned pk = pack2(a0, a1);
          vTL[(2 * lane) * 72 + i] = (unsigned short)(pk & 0xffff);
          vTL[(2 * lane + 1) * 72 + i] = (unsigned short)(pk >> 16);
        }
      }
    }
  }
  if (w == 0) {
    const float* gp = gt + ((size_t)t0 + lane) * 32;
    const float g0 = gp[h], g1 = gp[4 + h], b0 = gp[8 + h], b1 = gp[12 + h];
    float G0 = g0, G1 = g1;
#pragma unroll
    for (int o = 1; o < 64; o <<= 1) {
      const float v0 = __shfl_up(G0, o, 64);
      const float v1 = __shfl_down(G1, o, 64);
      if (lane >= o) G0 += v0;
      if (lane + o < 64) G1 += v1;
    }
    scal[lane] = G0 * 1.4426950408889634f; scal[64 + lane] = G1 * 1.4426950408889634f;
    scal[128 + lane] = b0; scal[192 + lane] = b1;
    const float GL0 = __shfl(G0, 63, 64), GL1 = __shfl(G1, 0, 64);
    float* gs0 = G.gsc + ((size_t)((bh * 2 + 0) * 64 + c)) * 192;
    float* gs1 = G.gsc + ((size_t)((bh * 2 + 1) * 64 + c)) * 192;
    gs0[lane] = expf(G0); gs0[64 + lane] = expf(GL0 - G0);
    gs1[lane] = expf(G1); gs1[64 + lane] = expf(GL1 - G1);
    if (lane == 0) { gs0[128] = expf(GL0); gs1[128] = expf(GL1); }
  }
  __syncthreads();
  {
    unsigned short* qg = G.qc + (size_t)item * 8192;
    unsigned short* kg = G.kTc + (size_t)item * 8192;
#pragma unroll
    for (int i = 0; i < 4; ++i) {
      const int id = tid + i * 256;
      *(uint4*)(qg + (id >> 4) * 128 + (id & 15) * 8) = *(const uint4*)(qL + (id >> 4) * 144 + (id & 15) * 8);
      *(uint4*)(kg + (id >> 3) * 64 + (id & 7) * 8) = *(const uint4*)(kTL + (id >> 3) * 72 + (id & 7) * 8);
    }
  }
  {
    const int ta = w >> 1, tb = w & 1;
    f32x16 acc, acc2;
#pragma unroll
    for (int i = 0; i < 16; ++i) { acc[i] = 0.f; acc2[i] = 0.f; }
#pragma unroll
    for (int s = 0; s < 8; ++s) {
      const bf16x8 a = *(const bf16x8*)(kL + (32 * ta + r) * 144 + 16 * s + 8 * hh);
      const bf16x8 bk = *(const bf16x8*)(kL + (32 * tb + r) * 144 + 16 * s + 8 * hh);
      const bf16x8 bq = *(const bf16x8*)(qL + (32 * tb + r) * 144 + 16 * s + 8 * hh);
      acc = MFMA32(a, bk, acc);
      acc2 = MFMA32(a, bq, acc2);
    }
    __syncthreads();
    {
      const int col = 32 * tb + r;
      const float G0c = scal[col], G1c = scal[64 + col];
#pragma unroll
      for (int reg = 0; reg < 16; ++reg) {
        const int row = 32 * ta + crow(reg, hh);
        const float v = acc[reg];
        const float a0 = (col < row) ? scal[128 + row] * v * __builtin_amdgcn_exp2f(scal[row] - G0c) : 0.f;
        const float a1 = (col > row) ? scal[192 + row] * v * __builtin_amdgcn_exp2f(scal[64 + row] - G1c) : 0.f;
        A0[row * 72 + col] = a0;
        A1[(63 - row) * 72 + (63 - col)] = a1;
      }
    }
    {
      const int i = 32 * tb + r;
      const float G0i = scal[i], G1i = scal[64 + i];
      unsigned short* qk0 = G.qkc + ((size_t)((bh * 2 + 0) * 64 + c)) * 4096;
      unsigned short* qk1 = G.qkc + ((size_t)((bh * 2 + 1) * 64 + c)) * 4096;
#pragma unroll
      for (int g = 0; g < 4; ++g) {
        float o0[4], o1[4];
#pragma unroll
        for (int e = 0; e < 4; ++e) {
          const int j = 32 * ta + 8 * g + 4 * hh + e;
          const float v = acc2[4 * g + e];
          o0[e] = (j <= i) ? v * __builtin_amdgcn_exp2f(G0i - scal[j]) : 0.f;
          o1[e] = (j >= i) ? v * __builtin_amdgcn_exp2f(G1i - scal[64 + j]) : 0.f;
        }
        uint2 p0, p1;
        p0.x = pack2(o0[0], o0[1]); p0.y = pack2(o0[2], o0[3]);
        p1.x = pack2(o1[0], o1[1]); p1.y = pack2(o1[2], o1[3]);
        *(uint2*)(qk0 + i * 64 + 32 * ta + 8 * g + 4 * hh) = p0;
        *(uint2*)(qk1 + i * 64 + 32 * ta + 8 * g + 4 * hh) = p1;
      }
    }
  }
  __syncthreads();
  if (w < 2) {
    const int dir = w;
    float T[64];
    tri_subst(A0 + dir * (64 * 72), lane, T);
    const int jn = dir ? 63 - lane : lane;
    const float sb = scal[128 + 64 * dir + jn];
    const float sbg = sb * __builtin_amdgcn_exp2f(scal[64 * dir + jn]);
    unsigned short* Tb = dir ? kL : qL;
    unsigned short* Tbg = Tb + 64 * 72;
#pragma unroll
    for (int ip = 0; ip < 64; ++ip) {
      const int in = dir ? 63 - ip : ip;
      Tb[in * 72 + jn] = f2bf(T[ip] * sb);
      Tbg[in * 72 + jn] = f2bf(T[ip] * sbg);
    }
  }
  __syncthreads();
#pragma unroll
  for (int d = 0; d < 2; ++d) {
    const int chain = bh * 2 + d;
    const unsigned short* Tb = d ? kL : qL;
    const unsigned short* Tbg = Tb + 64 * 72;
    unsigned short* wng = G.wn + ((size_t)(chain * 64 + c)) * 8192;
    unsigned short* uog = G.uo + ((size_t)(chain * 64 + c)) * 8192 + w * 2048;
#pragma unroll
    for (int tb = 0; tb < 2; ++tb) {
      f32x16 acc, acc2;
#pragma unroll
      for (int i = 0; i < 16; ++i) { acc[i] = 0.f; acc2[i] = 0.f; }
#pragma unroll
      for (int s = 0; s < 4; ++s) {
        const bf16x8 a = *(const bf16x8*)(kTL + (32 * w + r) * 72 + 16 * s + 8 * hh);
        const bf16x8 bb = *(const bf16x8*)(Tbg + (32 * tb + r) * 72 + 16 * s + 8 * hh);
        acc = MFMA32(a, bb, acc);
        const bf16x8 a2 = *(const bf16x8*)(Tb + (32 * tb + r) * 72 + 16 * s + 8 * hh);
        const bf16x8 b2 = *(const bf16x8*)(vTL + (32 * w + r) * 72 + 16 * s + 8 * hh);
        acc2 = MFMA32(a2, b2, acc2);
      }
#pragma unroll
      for (int g = 0; g < 4; ++g) {
        uint2 pk;
        pk.x = pack2(-acc[4 * g], -acc[4 * g + 1]); pk.y = pack2(-acc[4 * g + 2], -acc[4 * g + 3]);
        *(uint2*)(wng + (32 * tb + r) * 128 + 32 * w + 8 * g + 4 * hh) = pk;
      }
      uint4 u0, u1;
      u0.x = pack2(acc2[0], acc2[1]); u0.y = pack2(acc2[2], acc2[3]); u0.z = pack2(acc2[4], acc2[5]); u0.w = pack2(acc2[6], acc2[7]);
      u1.x = pack2(acc2[8], acc2[9]); u1.y = pack2(acc2[10], acc2[11]); u1.z = pack2(acc2[12], acc2[13]); u1.w = pack2(acc2[14], acc2[15]);
      *(uint4*)(uog + tb * 1024 + lane * 16) = u0;
      *(uint4*)(uog + tb * 1024 + lane * 16 + 8) = u1;
    }
  }
}

struct GdnOps {
  bf16x8 a[8];
  bf16x8 x[4];
  bf16x8 kt[4];
  float4 rs[4];
  float gtot;
};
__device__ __forceinline__ void gdn_load(GdnOps& o, const GdnBufs& G, int chain, int bh, int c, int sl, int w, int r, int hh, int lane) {
  const unsigned short* kT_c = G.kTc + ((size_t)(bh * 64 + c)) * 8192;
  const float* gs = G.gsc + ((size_t)(chain * 64 + c)) * 192;
  const int ti = w & 1;
#pragma unroll
  for (int s = 0; s < 4; ++s) o.kt[s] = *(const bf16x8*)(kT_c + (32 * w + r) * 64 + 16 * s + 8 * hh);
  o.gtot = gs[128];
  if (w < 2) {
    const unsigned short* wn_c = G.wn + ((size_t)(chain * 64 + c)) * 8192;
    const unsigned short* uo_c = G.uo + ((size_t)(chain * 64 + c)) * 8192 + sl * 2048;
#pragma unroll
    for (int s = 0; s < 8; ++s) o.a[s] = *(const bf16x8*)(wn_c + (32 * ti + r) * 128 + 16 * s + 8 * hh);
    o.x[0] = *(const bf16x8*)(uo_c + ti * 1024 + lane * 16);
    o.x[1] = *(const bf16x8*)(uo_c + ti * 1024 + lane * 16 + 8);
#pragma unroll
    for (int g = 0; g < 4; ++g) o.rs[g] = *(const float4*)(gs + 64 + 32 * ti + 8 * g + 4 * hh);
  } else {
    const unsigned short* q_c = G.qc + ((size_t)(bh * 64 + c)) * 8192;
    const unsigned short* qk_c = G.qkc + ((size_t)(chain * 64 + c)) * 4096;
#pragma unroll
    for (int s = 0; s < 8; ++s) o.a[s] = *(const bf16x8*)(q_c + (32 * ti + r) * 128 + 16 * s + 8 * hh);
#pragma unroll
    for (int s = 0; s < 4; ++s) o.x[s] = *(const bf16x8*)(qk_c + (32 * ti + r) * 64 + 16 * s + 8 * hh);
#pragma unroll
    for (int g = 0; g < 4; ++g) o.rs[g] = *(const float4*)(gs + 32 * ti + 8 * g + 4 * hh);
  }
}
__device__ __forceinline__ void gdn_step(const GdnOps& o, f32x16& S, unsigned short* ST, unsigned short* VT, unsigned short* VdT,
                                         unsigned short* uo_c, int w, int r, int hh) {
  const int ti = w & 1;
  f32x16 acc;
  if (w < 2) {
#pragma unroll
    for (int i = 0; i < 8; ++i) {
      acc[i] = bf2f((unsigned short)o.x[0][i]);
      acc[8 + i] = bf2f((unsigned short)o.x[1][i]);
    }
  } else {
#pragma unroll
    for (int i = 0; i < 16; ++i) acc[i] = 0.f;
  }
#pragma unroll
  for (int g = 0; g < 4; ++g) {
    uint2 pk;
    pk.x = pack2(S[4 * g], S[4 * g + 1]); pk.y = pack2(S[4 * g + 2], S[4 * g + 3]);
    *(uint2*)(ST + r * 136 + 32 * w + 8 * g + 4 * hh) = pk;
  }
  __syncthreads();
#pragma unroll
  for (int s = 0; s < 8; ++s) {
    const bf16x8 bs = *(const bf16x8*)(ST + r * 136 + 16 * s + 8 * hh);
    acc = MFMA32(o.a[s], bs, acc);
  }
  if (w < 2) {
#pragma unroll
    for (int g = 0; g < 4; ++g) {
      uint2 pk, pd;
      pk.x = pack2(acc[4 * g], acc[4 * g + 1]); pk.y = pack2(acc[4 * g + 2], acc[4 * g + 3]);
      pd.x = pack2(acc[4 * g] * o.rs[g].x, acc[4 * g + 1] * o.rs[g].y);
      pd.y = pack2(acc[4 * g + 2] * o.rs[g].z, acc[4 * g + 3] * o.rs[g].w);
      *(uint2*)(VT + r * 72 + 32 * ti + 8 * g + 4 * hh) = pk;
      *(uint2*)(VdT + r * 72 + 32 * ti + 8 * g + 4 * hh) = pd;
    }
  } else {
#pragma unroll
    for (int g = 0; g < 4; ++g) {
      acc[4 * g] *= o.rs[g].x; acc[4 * g + 1] *= o.rs[g].y; acc[4 * g + 2] *= o.rs[g].z; acc[4 * g + 3] *= o.rs[g].w;
    }
  }
  __syncthreads();
  if (w >= 2) {
#pragma unroll
    for (int s = 0; s < 4; ++s) {
      const bf16x8 bv = *(const bf16x8*)(VT + r * 72 + 16 * s + 8 * hh);
      acc = MFMA32(o.x[s], bv, acc);
    }
#pragma unroll
    for (int reg = 0; reg < 16; ++reg) uo_c[(32 * ti + crow(reg, hh)) * 32 + r] = f2bf(acc[reg]);
  }
#pragma unroll
  for (int i = 0; i < 16; ++i) S[i] *= o.gtot;
#pragma unroll
  for (int s = 0; s < 4; ++s) {
    const bf16x8 bv = *(const bf16x8*)(VdT + r * 72 + 16 * s + 8 * hh);
    S = MFMA32(o.kt[s], bv, S);
  }
}
__device__ __forceinline__ void d_gdn_scan(int chain, int sl, char* smem, GdnBufs G) {
  unsigned short* ST = (unsigned short*)smem;
  unsigned short* VT = ST + 32 * 136;
  unsigned short* VdT = VT + 32 * 72;
  const int tid = threadIdx.x, lane = tid & 63, w = __builtin_amdgcn_readfirstlane(tid >> 6), r = lane & 31, hh = lane >> 5;
  const int bh = chain >> 1, dir = chain & 1;
  f32x16 S;
#pragma unroll
  for (int i = 0; i < 16; ++i) S[i] = 0.f;
  GdnOps A, B;
  gdn_load(A, G, chain, bh, dir ? 63 : 0, sl, w, r, hh, lane);
  for (int step = 0; step < 64; step += 2) {
    const int c0 = dir ? 63 - step : step;
    const int c1 = dir ? c0 - 1 : c0 + 1;
    const int c2 = dir ? c0 - 2 : c0 + 2;
    gdn_load(B, G, chain, bh, c1, sl, w, r, hh, lane);
    gdn_step(A, S, ST, VT, VdT, G.uo + ((size_t)(chain * 64 + c0)) * 8192 + sl * 2048, w, r, hh);
    if (step + 2 < 64) gdn_load(A, G, chain, bh, c2, sl, w, r, hh, lane);
    gdn_step(B, S, ST, VT, VdT, G.uo + ((size_t)(chain * 64 + c1)) * 8192 + sl * 2048, w, r, hh);
  }
}

__device__ __forceinline__ void d_ml_gates(int item, const float* __restrict__ gt, float* __restrict__ pre, float* __restrict__ gtots) {
  const int wv = item * 4 + (threadIdx.x >> 6);
  const int lane = threadIdx.x & 63;
  const int chain = wv >> 6, c = wv & 63;
  const int bh = chain >> 1, dir = chain & 1, b = bh >> 2, h = bh & 3;
  const size_t t0 = (size_t)b * SEQ + c * 64;
  const float lf = gt[(t0 + lane) * 32 + 24 + dir * 4 + h];
  const float ip = gt[(t0 + lane) * 32 + 16 + dir * 4 + h];
  float bc = lf;
#pragma unroll
  for (int ofs = 1; ofs < 64; ofs <<= 1) {
    const float vu = __shfl_up(bc, ofs, 64);
    const float vd = __shfl_down(bc, ofs, 64);
    if (dir == 0) { if (lane >= ofs) bc += vu; } else { if (lane + ofs < 64) bc += vd; }
  }
  const float b_last = __shfl(bc, dir ? 0 : 63, 64);
  float4 o;
  o.x = expf(bc);
  o.y = (ip - bc) * 1.4426950408889634f - 3.5f;
  o.z = bc * 1.4426950408889634f;
  o.w = 0.08838834764831845f * expf(b_last - bc + ip);
  *(float4*)(pre + ((size_t)chain * SEQ + c * 64 + lane) * 4) = o;
  if (lane == 0) gtots[wv] = expf(b_last);
}

#define ML_LOAD(T0)                                                                                         \
  {                                                                                                         \
    _Pragma("unroll") for (int i_ = 0; i_ < 8; ++i_) {                                                      \
      const int id_ = t128 + i_ * 128;                                                                      \
      pq[i_] = *(const uint4*)(pm + ((T0) + (id_ >> 4)) * 4096 + 2048 + h * 128 + (id_ & 15) * 8);          \
      pk[i_] = *(const uint4*)(pm + ((T0) + (id_ >> 4)) * 4096 + 2560 + h * 128 + (id_ & 15) * 8);          \
    }                                                                                                       \
    _Pragma("unroll") for (int i_ = 0; i_ < 2; ++i_) {                                                      \
      const int id_ = t128 + i_ * 128;                                                                      \
      pv[i_] = *(const uint4*)(pm + ((T0) + (id_ >> 2)) * 4096 + 3072 + h * 128 + sl * 32 + (id_ & 3) * 8); \
    }                                                                                                       \
    pgl = *(const float4*)(pre + ((size_t)chain * SEQ + ((T0) - tb) + lane) * 4);                           \
    pgt = gtots[chain * 64 + (int)(((T0) - tb) >> 6)];                                                      \
  }
__device__ __forceinline__ void ml_state_image(const f32x16& S0, const f32x16& S1, unsigned short* S0T, unsigned short* nL, int w, int r, int hh) {
#pragma unroll
  for (int g = 0; g < 4; ++g) {
    uint2 pk;
    pk.x = pack2(S0[4 * g], S0[4 * g + 1]); pk.y = pack2(S0[4 * g + 2], S0[4 * g + 3]);
    *(uint2*)(S0T + r * 136 + 32 * w + 8 * g + 4 * hh) = pk;
    if (r == 0) {
      uint2 pn;
      pn.x = pack2(S1[4 * g], S1[4 * g + 1]); pn.y = pack2(S1[4 * g + 2], S1[4 * g + 3]);
      *(uint2*)(nL + 32 * w + 8 * g + 4 * hh) = pn;
    }
  }
}
__device__ __forceinline__ void ml_state_update(f32x16& S0, f32x16& S1, const unsigned short* kdL, const unsigned short* vTL,
                                                float gtot, int w, int r, int hh) {
  bf16x8 ones;
#pragma unroll
  for (int i = 0; i < 8; ++i) ones[i] = (short)0x3F80;
#pragma unroll
  for (int i = 0; i < 16; ++i) { S0[i] *= gtot; S1[i] *= gtot; }
#pragma unroll
  for (int s2 = 0; s2 < 4; ++s2) {
    union { bf16x8 v; unsigned short e[8]; } a;
#pragma unroll
    for (int e = 0; e < 8; ++e) a.e[e] = kdL[(16 * s2 + 8 * hh + e) * 136 + 32 * w + r];
    const bf16x8 bv = *(const bf16x8*)(vTL + r * 72 + 16 * s2 + 8 * hh);
    S0 = MFMA32(a.v, bv, S0);
    S1 = MFMA32(a.v, ones, S1);
  }
}
__device__ __forceinline__ void d_mlstm_scan(int chain, int sl, char* smem, const unsigned short* __restrict__ pm,
                                             const float* __restrict__ pre, const float* __restrict__ gtots,
                                             unsigned short* __restrict__ oM, int ntok) {
  unsigned short* qL = (unsigned short*)smem;
  unsigned short* kL = qL + 64 * 136;
  unsigned short* kdL = kL + 64 * 136;
  unsigned short* vTL = kdL + 64 * 136;
  unsigned short* S0T = vTL + 32 * 72;
  unsigned short* nL = S0T + 32 * 136;
  float* scal = (float*)(nL + 256);
  const int tid = threadIdx.x, lane = tid & 63, w = __builtin_amdgcn_readfirstlane(tid >> 6), r = lane & 31, hh = lane >> 5;
  const int bh = chain >> 1, dir = chain & 1, b = bh >> 2, h = bh & 3;
  const float SCALE = 0.08838834764831845f;
  f32x16 S0, S1;
#pragma unroll
  for (int i = 0; i < 16; ++i) { S0[i] = 0.f; S1[i] = 0.f; }
  unsigned short* oMb = oM + (size_t)dir * ntok * 512 + h * 128 + sl * 32;
  const size_t tb = (size_t)b * SEQ;
  if (w >= 2) {
    const int t128 = tid - 128;
    uint4 pq[8], pk[8], pv[2];
    float4 pgl;
    float pgt;
    ML_LOAD(tb + (dir ? 63 : 0) * 64);
    for (int step = 0; step < 64; ++step) {
      const int c0 = dir ? 63 - step : step;
      const int c1 = dir ? c0 - 1 : c0 + 1;
      const float Dj = pgl.w;
      const float gtot = pgt;
      __syncthreads();
      if (w == 2) { scal[lane] = pgl.x; scal[64 + lane] = pgl.y; scal[128 + lane] = pgl.z; if (lane == 0) scal[192] = gtot; }
#pragma unroll
      for (int i = 0; i < 8; ++i) {
        const int id = t128 + i * 128;
        const int row = id >> 4, c16 = id & 15;
        const uint4 kv = pk[i];
        const uint4 qv = pq[i];
        *(uint4*)(qL + row * 136 + c16 * 8) = qv;
        *(uint4*)(kL + row * 136 + c16 * 8) = kv;
        const float d = __shfl(Dj, row, 64);
        uint4 kd;
        kd.x = pack2(bf2f(kv.x & 0xffff) * d, bf2f(kv.x >> 16) * d);
        kd.y = pack2(bf2f(kv.y & 0xffff) * d, bf2f(kv.y >> 16) * d);
        kd.z = pack2(bf2f(kv.z & 0xffff) * d, bf2f(kv.z >> 16) * d);
        kd.w = pack2(bf2f(kv.w & 0xffff) * d, bf2f(kv.w >> 16) * d);
        *(uint4*)(kdL + row * 136 + c16 * 8) = kd;
      }
#pragma unroll
      for (int i = 0; i < 2; ++i) {
        const int id = t128 + i * 128;
        const int tok = id >> 2, d8 = (id & 3) * 8;
        const uint4 vv = pv[i];
        vTL[(d8 + 0) * 72 + tok] = (unsigned short)(vv.x & 0xffff);
        vTL[(d8 + 1) * 72 + tok] = (unsigned short)(vv.x >> 16);
        vTL[(d8 + 2) * 72 + tok] = (unsigned short)(vv.y & 0xffff);
        vTL[(d8 + 3) * 72 + tok] = (unsigned short)(vv.y >> 16);
        vTL[(d8 + 4) * 72 + tok] = (unsigned short)(vv.z & 0xffff);
        vTL[(d8 + 5) * 72 + tok] = (unsigned short)(vv.z >> 16);
        vTL[(d8 + 6) * 72 + tok] = (unsigned short)(vv.w & 0xffff);
        vTL[(d8 + 7) * 72 + tok] = (unsigned short)(vv.w >> 16);
      }
      if (step + 1 < 64) ML_LOAD(tb + c1 * 64);
      ml_state_image(S0, S1, S0T, nL, w, r, hh);
      __syncthreads();
      ml_state_update(S0, S1, kdL, vTL, gtot, w, r, hh);
    }
  } else {
    bf16x8 ones;
#pragma unroll
    for (int i = 0; i < 8; ++i) ones[i] = (short)0x3F80;
    const int ti = w;
    const int icol = 32 * ti + r;
    for (int step = 0; step < 64; ++step) {
      const int c0 = dir ? 63 - step : step;
      __syncthreads();
      ml_state_image(S0, S1, S0T, nL, w, r, hh);
      __syncthreads();
      const float bci = scal[128 + icol];
      const float gtot = scal[192];
      f32x16 Q0, Q1;
#pragma unroll
      for (int i = 0; i < 16; ++i) { Q0[i] = 0.f; Q1[i] = 0.f; }
#pragma unroll
      for (int s2 = 0; s2 < 8; ++s2) {
        const bf16x8 a = *(const bf16x8*)(qL + (32 * ti + r) * 136 + 16 * s2 + 8 * hh);
        const bf16x8 b0 = *(const bf16x8*)(S0T + r * 136 + 16 * s2 + 8 * hh);
        const bf16x8 b1 = *(const bf16x8*)(nL + 16 * s2 + 8 * hh);
        Q0 = MFMA32(a, b0, Q0);
        Q1 = MFMA32(a, b1, Q1);
      }
#pragma unroll
      for (int g = 0; g < 4; ++g) {
        const float4 e4 = *(const float4*)(scal + 32 * ti + 8 * g + 4 * hh);
        Q0[4 * g] *= e4.x; Q0[4 * g + 1] *= e4.y; Q0[4 * g + 2] *= e4.z; Q0[4 * g + 3] *= e4.w;
        Q1[4 * g] *= e4.x; Q1[4 * g + 1] *= e4.y; Q1[4 * g + 2] *= e4.z; Q1[4 * g + 3] *= e4.w;
      }
#pragma unroll
      for (int tj = 0; tj < 2; ++tj) {
        if (dir ? (tj < ti) : (tj > ti)) continue;
        f32x16 X;
#pragma unroll
        for (int i = 0; i < 16; ++i) X[i] = 0.f;
#pragma unroll
        for (int s2 = 0; s2 < 8; ++s2) {
          const bf16x8 a = *(const bf16x8*)(kL + (32 * tj + r) * 136 + 16 * s2 + 8 * hh);
          const bf16x8 bq = *(const bf16x8*)(qL + (32 * ti + r) * 136 + 16 * s2 + 8 * hh);
          X = MFMA32(a, bq, X);
        }
#pragma unroll
        for (int g = 0; g < 4; ++g) {
          const float4 cj4 = *(const float4*)(scal + 64 + 32 * tj + 8 * g + 4 * hh);
          const float cjs[4] = {cj4.x, cj4.y, cj4.z, cj4.w};
#pragma unroll
          for (int e = 0; e < 4; ++e) {
            const int j = 32 * tj + 8 * g + 4 * hh + e;
            const bool valid = dir ? (j >= icol) : (j <= icol);
            const float arg = valid ? (bci + cjs[e]) : -INFINITY;
            X[4 * g + e] *= __builtin_amdgcn_exp2f(arg);
          }
        }
#pragma unroll
        for (int s2 = 0; s2 < 2; ++s2) {
          union { bf16x8 v; unsigned u[4]; } xa, bv;
          xa.u[0] = pack2(X[8 * s2 + 0], X[8 * s2 + 1]); xa.u[1] = pack2(X[8 * s2 + 2], X[8 * s2 + 3]);
          xa.u[2] = pack2(X[8 * s2 + 4], X[8 * s2 + 5]); xa.u[3] = pack2(X[8 * s2 + 6], X[8 * s2 + 7]);
          const uint2 v0 = *(const uint2*)(vTL + r * 72 + 32 * tj + 16 * s2 + 4 * hh);
          const uint2 v1 = *(const uint2*)(vTL + r * 72 + 32 * tj + 16 * s2 + 8 + 4 * hh);
          bv.u[0] = v0.x; bv.u[1] = v0.y; bv.u[2] = v1.x; bv.u[3] = v1.y;
          Q0 = MFMA32(xa.v, bv.v, Q0);
          Q1 = MFMA32(xa.v, ones, Q1);
        }
      }
      const size_t orow0 = tb + c0 * 64;
#pragma unroll
      for (int reg = 0; reg < 16; ++reg) {
        const int i = 32 * ti + crow(reg, hh);
        oMb[(orow0 + i) * 512 + r] = f2bf(Q0[reg] * __builtin_amdgcn_rcpf(fmaxf(fabsf(Q1[reg]), 1.f)));
      }
      ml_state_update(S0, S1, kdL, vTL, gtot, w, r, hh);
    }
  }
}

struct MKP {
  const float *x, *norm1_g, *w_in, *conv_w, *a_log, *dt_bias, *gdn_g, *i_bias, *f_bias, *ml_g, *w_out, *norm2_g, *peer_wq,
      *peer_keys, *peer_u, *peer_v, *normf_g;
  float* out;
  unsigned short *pm, *x1b, *woutT, *mt, *xb, *winT, *oM, *yb, *scores, *qkv_dbg, *oA_dbg;
  unsigned *utab, *vtab;
  unsigned short *wqb, *keyb;
  float *uscale, *vscale;
  float *x1, *rs1, *rs2, *gt, *gateb, *dbg, *mlpre, *mlgt;
  unsigned* bar;
  int* idxb;
  GdnBufs G;
};

constexpr int SMEM_BYTES = 74752;
__global__ void __launch_bounds__(256, 2) k_mega(MKP P) {
  __shared__ __attribute__((aligned(16))) char smem_c[SMEM_BYTES + 16];
  {
    volatile LAS unsigned* st0 = (volatile LAS unsigned*)(smem_c + SMEM_BYTES);
    if (threadIdx.x < 4) st0[threadIdx.x] = 0u;
  }
  __syncthreads();
  XcdBarrier xb = xcd_barrier_post(P.bar, (volatile LAS unsigned*)(smem_c + SMEM_BYTES));
  unsigned short* smem = (unsigned short*)smem_c;
  const int nb = gridDim.x, bid = blockIdx.x;
  for (int it = bid; it < NT / 4; it += nb) d_prep_x(it, P.x, P.xb, P.rs1);
  for (int it = bid; it < 16 * 66; it += nb) d_transpose_w(it, 66, (float*)smem_c, P.w_in, DIN, P.norm1_g, P.winT, 1);
  for (int it = bid; it < 16 * 16; it += nb) d_transpose_w(it, 16, (float*)smem_c, P.w_out, 1024, nullptr, P.woutT, 0);
  for (int it = bid; it < 1024; it += nb) d_cvt_bf16(it, P.peer_wq, P.wqb, P.norm2_g, 11);
  for (int it = bid; it < 128; it += nb) d_cvt_bf16(it, P.peer_keys, P.keyb, nullptr, 0);
  if (bid == 0 && threadIdx.x < 4) P.dbg[threadIdx.x] = 0.f;
  xcd_barrier(xb);
  {
    GemmP p{};
    p.A = P.xb; p.lda = DM; p.Bt = P.winT; p.ldb = DM; p.K = DM;
    p.rowscale = P.rs1; p.obf = P.pm; p.ldo = 4096; p.of32 = P.gt; p.ldf = 32; p.resid = nullptr;
    p.a_log = P.a_log; p.dt_bias = P.dt_bias; p.i_bias = P.i_bias; p.f_bias = P.f_bias;
    for (int k = 0;; ++k) {
      int tm, tn;
      if (!xcd_tile(bid, nb, k, 33, tm, tn)) break;
      gemm_tile<EPI_INPROJ>(p, tm, tn, smem);
      __syncthreads();
    }
  }
  for (int tile = bid; tile < 16 * 8; tile += nb) {
    const int hp = tile >> 3, tn = tile & 7;
    GemmP p{};
    p.A = P.keyb + (size_t)hp * 128 * 128; p.lda = 128; p.Bt = P.wqb + hp * 128; p.ldb = 2048; p.K = 128;
    p.obf = P.mt + (size_t)hp * 128 * DM; p.ldo = DM;
    gemm_tile<EPI_PLAIN>(p, 0, tn, smem);
    __syncthreads();
  }
  xcd_barrier(xb);
  for (int it = bid; it < 512; it += nb) d_ml_gates(it, P.gt, P.mlpre, P.mlgt);
  for (int it = bid; it < 1024; it += nb) d_gdn_prep(it, smem_c, P.pm, P.gt, P.conv_w, P.G);
  xcd_barrier(xb);
  if (bid < 128) {
    d_gdn_scan(bid >> 2, bid & 3, smem_c, P.G);
  } else if (bid < 256) {
    d_mlstm_scan((bid - 128) >> 2, (bid - 128) & 3, smem_c, P.pm, P.mlpre, P.mlgt, P.oM, NT);
  }
#ifdef DBG_CHECK
  if (bid < 4) {
    __syncthreads();
    const int half = threadIdx.x >> 7;
    float* sq = (float*)smem + half * 256;
    float* sk = sq + 128;
    d_mlstm_rec(bid * 2 + half, sq, sk, P.pm, P.gt, P.oA_dbg, 4096);
  }
#endif
  xcd_barrier(xb);
  for (int it = bid; it < NT / 4; it += nb) d_combine(it, P.G.uo, P.oM, P.pm, P.gdn_g, P.ml_g, P.yb);
#ifdef DBG_CHECK
  for (int it = bid; it < 4096 / 4; it += nb) d_dbg_cmp_m(it, P.oM, P.oA_dbg, P.dbg);
#endif
  xcd_barrier(xb);
  {
    GemmP p{};
    p.A = P.yb; p.lda = DM; p.Bt = P.woutT; p.ldb = DM; p.K = DM;
    p.rowscale = nullptr; p.obf = P.x1b; p.ldo = DM; p.of32 = P.x1; p.ldf = DM; p.resid = P.x; p.rowacc = P.rs2;
    for (int k = 0;; ++k) {
      int tm, tn;
      if (!xcd_tile(bid, nb, k, 8, tm, tn)) break;
      gemm_tile<EPI_OUTPROJ>(p, tm, tn, smem);
      __syncthreads();
    }
  }
  for (int it = bid; it < 4096; it += nb) { d_cvt_tab(it, P.peer_u, P.utab, P.uscale); d_cvt_tab(it, P.peer_v, P.vtab, P.vscale); }
  xcd_barrier(xb);
  {
    GemmP p{};
    p.A = P.x1b; p.lda = DM; p.Bt = P.mt; p.ldb = DM; p.K = DM;
    p.rowscale = P.rs2; p.obf = P.scores; p.ldo = 2048; p.of32 = nullptr; p.ldf = 0; p.resid = nullptr;
    for (int k = 0;; ++k) {
      int tm, tn;
      if (!xcd_tile(bid, nb, k, 16, tm, tn)) break;
      gemm_tile<EPI_SCORES>(p, tm, tn, smem);
      __syncthreads();
    }
  }
  xcd_barrier(xb);
  float oscale = 1.f;
#ifdef DBG_CHECK
  {
    const float sd = __hip_atomic_load(&P.dbg[0], __ATOMIC_RELAXED, __HIP_MEMORY_SCOPE_AGENT);
    const float sr = __hip_atomic_load(&P.dbg[1], __ATOMIC_RELAXED, __HIP_MEMORY_SCOPE_AGENT);
    oscale = 1.f + sqrtf(sd / sr);
  }
#endif
  for (int it = bid; it < NT / 32; it += nb) {
    d_topk(it, P.scores, P.idxb, P.gateb);
    __threadfence_block();
    __syncthreads();
#pragma unroll 1
    for (int sub = 0; sub < 8; ++sub)
      d_peer(it * 8 + sub, P.x1, P.rs2, P.norm2_g, P.idxb, P.gateb, P.utab, P.vtab, P.uscale, P.vscale, P.normf_g, P.out, oscale);
  }
}

extern "C" void kernel_launch(void* const* d_in, const int* in_sizes, int n_in, void* d_out, int out_size, void* d_ws,
                              size_t ws_size, hipStream_t stream) {
  MKP P{};
  P.x = (const float*)d_in[0];
  P.norm1_g = (const float*)d_in[1];
  P.w_in = (const float*)d_in[2];
  P.conv_w = (const float*)d_in[3];
  P.a_log = (const float*)d_in[4];
  P.dt_bias = (const float*)d_in[5];
  P.gdn_g = (const float*)d_in[6];
  P.i_bias = (const float*)d_in[7];
  P.f_bias = (const float*)d_in[8];
  P.ml_g = (const float*)d_in[9];
  P.w_out = (const float*)d_in[10];
  P.norm2_g = (const float*)d_in[11];
  P.peer_wq = (const float*)d_in[12];
  P.peer_keys = (const float*)d_in[13];
  P.peer_u = (const float*)d_in[14];
  P.peer_v = (const float*)d_in[15];
  P.normf_g = (const float*)d_in[16];
  P.out = (float*)d_out;

  char* ws = (char*)d_ws;
  const size_t MB = 1024 * 1024;
  P.pm = (unsigned short*)(ws);
  P.x1 = (float*)(ws);
  P.x1b = (unsigned short*)(ws + 64 * MB);
  P.utab = (unsigned*)(ws + 96 * MB);
  P.vtab = (unsigned*)(ws + 112 * MB);
  P.uscale = (float*)(ws + 136 * MB);
  P.vscale = (float*)(ws + 136 * MB + 65536);
  char* rb = ws + 128 * MB;
  P.woutT = (unsigned short*)(rb);
  P.mt = (unsigned short*)(rb + 2 * MB);
  P.rs1 = (float*)(rb + 6 * MB);
  P.rs2 = (float*)(rb + 7 * MB);
  P.dbg = (float*)(rb + 6 * MB + 131072);
  P.bar = (unsigned*)(rb + 6 * MB + 196608);
  P.gt = (float*)(rb + 9 * MB);
  char* dyn = rb + 11 * MB;
  P.xb = (unsigned short*)(dyn);
  P.winT = (unsigned short*)(dyn + 32 * MB);
  P.wqb = (unsigned short*)(dyn + 41 * MB);
  P.keyb = (unsigned short*)(dyn + 45 * MB);
  P.G.qc = (unsigned short*)(dyn);
  P.G.kTc = (unsigned short*)(dyn + 16 * MB);
  P.G.qkc = (unsigned short*)(dyn + 32 * MB);
  P.G.wn = (unsigned short*)(dyn + 48 * MB);
  P.G.uo = (unsigned short*)(dyn + 80 * MB);
  P.G.gsc = (float*)(dyn + 112 * MB);
  P.mlpre = (float*)(dyn + 114 * MB);
  P.mlgt = (float*)(dyn + 116 * MB);
  P.yb = (unsigned short*)(dyn);
  P.scores = (unsigned short*)(dyn);
  P.idxb = (int*)(dyn + 64 * MB);
  P.gateb = (float*)(dyn + 72 * MB);
  char* os = (char*)d_out;
  P.oM = (unsigned short*)(os);
  P.qkv_dbg = (unsigned short*)(os + 32 * MB);
  P.oA_dbg = (unsigned short*)(os + 44 * MB);

  static int grid_blocks = 0;
  if (!grid_blocks) {
    int dev = 0, cus = 0, per_cu = 0;
    (void)hipGetDevice(&dev);
    (void)hipDeviceGetAttribute(&cus, hipDeviceAttributeMultiprocessorCount, dev);
    (void)hipOccupancyMaxActiveBlocksPerMultiprocessor(&per_cu, k_mega, 256, 0);
    if (per_cu > 2) per_cu = 2;
    if (per_cu < 1) per_cu = 1;
    grid_blocks = cus * per_cu;
  }
  (void)hipMemsetAsync(P.bar, 0, XCD_BAR_WORDS * sizeof(unsigned), stream);
  hipLaunchKernelGGL(k_mega, dim3(grid_blocks), dim3(256), 0, stream, P);
}
```

```cpp
#include <hip/hip_runtime.h>
#include <hip/hip_bf16.h>
#include <stdint.h>
#include <cstdio>

#define XB_TMO      128
#define XB_XCNT(j)  (256  + 64 * (j))
#define XB_XSUB(j)  (1280 + 64 * (j))
#define XB_XGEN(j)  (2304 + 64 * (j))
#define XB_TOP      3328
#define XB_TOPGEN   3392
#define XCD_BAR_WORDS 3456
#define XB_SPIN_CAP (1u << 18)
#define LAS __attribute__((address_space(3)))

__device__ __forceinline__ unsigned xb_ld(unsigned* p)              { return __hip_atomic_load(p, __ATOMIC_RELAXED, __HIP_MEMORY_SCOPE_AGENT); }
__device__ __forceinline__ unsigned xb_add(unsigned* p, unsigned v) { return __hip_atomic_fetch_add(p, v, __ATOMIC_RELAXED, __HIP_MEMORY_SCOPE_AGENT); }
__device__ __forceinline__ unsigned xb_xcc_id() { return (unsigned)__builtin_amdgcn_s_getreg((3 << 11) | 20) & 0xFu; }
#define XB_SPIN(cond, bar) do { unsigned _sp = 0; while (cond) { __builtin_amdgcn_s_sleep(1); \
    if ((++_sp & 255u) == 0u) { if (xb_ld(&(bar)[XB_TMO])) break; if (_sp > XB_SPIN_CAP) { atomicAdd(&(bar)[XB_TMO], 1u); break; } } } } while (0)

struct XcdBarrier {
    unsigned* bar; unsigned x;
    volatile LAS unsigned* st;
};

__device__ __forceinline__ XcdBarrier xcd_barrier_post(unsigned* bar, volatile LAS unsigned* st) {
    XcdBarrier b; b.bar = bar; b.x = xb_xcc_id(); b.st = st;
    if (threadIdx.x == 0) (void)xb_add(&bar[XB_XCNT(b.x)], 1u);
    return b;
}
__device__ __forceinline__ void xcd_barrier_complete(unsigned* bar, unsigned x, unsigned& nloc, unsigned& nx) {
    const unsigned G = gridDim.x * gridDim.y * gridDim.z;
    unsigned sum, cnt, mine, sp = 0u;
    for (;;) {
        sum = 0u; cnt = 0u; mine = 0u;
#pragma unroll
        for (unsigned j = 0; j < 16; ++j) { const unsigned c = xb_ld(&bar[XB_XCNT(j)]); sum += c; cnt += (c > 0u) ? 1u : 0u; mine = (j == x) ? c : mine; }
        if (sum == G) break;
        __builtin_amdgcn_s_sleep(1);
        if ((++sp & 255u) == 0u) { if (xb_ld(&bar[XB_TMO])) break; if (sp > XB_SPIN_CAP) { atomicAdd(&bar[XB_TMO], 1u); break; } }
    }
    nloc = mine > 0u ? mine : 1u; nx = cnt > 0u ? cnt : 1u;
}

__device__ __forceinline__ void xcd_barrier(const XcdBarrier& b) {
    asm volatile("s_waitcnt vmcnt(0)" ::: "memory");
    __syncthreads();
    if (threadIdx.x == 0) {
        unsigned* bar = b.bar;
        __builtin_amdgcn_s_waitcnt(0);
        unsigned nloc = b.st[0], nx = b.st[1];
        if (nloc == 0u) { xcd_barrier_complete(bar, b.x, nloc, nx); b.st[0] = nloc; b.st[1] = nx; }
        const unsigned old = xb_add(&bar[XB_XSUB(b.x)], 1u);
        const unsigned gen = old / nloc;
        if (old + 1u == (gen + 1u) * nloc) {
            __builtin_amdgcn_fence(__ATOMIC_RELEASE, "agent");
            asm volatile("s_waitcnt vmcnt(0)" ::: "memory");
            const unsigned og = xb_add(&bar[XB_TOP], 1u);
            const unsigned tg = og / nx;
            if (og + 1u == (tg + 1u) * nx) xb_add(&bar[XB_TOPGEN], 1u);
            else XB_SPIN(xb_ld(&bar[XB_TOPGEN]) == tg, bar);
            __builtin_amdgcn_fence(__ATOMIC_ACQUIRE, "agent");
            xb_add(&bar[XB_XGEN(b.x)], 1u);
            asm volatile("s_waitcnt vmcnt(0)" ::: "memory");
        } else {
            XB_SPIN(xb_ld(&bar[XB_XGEN(b.x)]) == gen, bar);
            __builtin_amdgcn_fence(__ATOMIC_ACQUIRE, "agent");
            asm volatile("s_waitcnt vmcnt(0)" ::: "memory");
        }
    }
    __syncthreads();
}


typedef __hip_bfloat16 bf16;
typedef __attribute__((ext_vector_type(8))) short bf16x8;
typedef __attribute__((ext_vector_type(4))) float f32x4;

constexpr int DM = 1024;
constexpr int NB = 4;
constexpr int SEQ = 4096;
constexpr int NT = NB * SEQ;
constexpr int DIN = 4128;
constexpr int NPAD_IN = 4224;
constexpr float EPSF = 1e-6f;

__device__ __forceinline__ float bf2f(unsigned short u) { return __uint_as_float(((unsigned)u) << 16); }
typedef __bf16 bf16x2_t __attribute__((ext_vector_type(2)));
typedef float f32x2_t __attribute__((ext_vector_type(2)));
__device__ __forceinline__ unsigned short f2bf(float f) { return __builtin_bit_cast(unsigned short, (__bf16)f); }
__device__ __forceinline__ unsigned pack2(float a, float b) {
  f32x2_t v = {a, b};
  return __builtin_bit_cast(unsigned, __builtin_convertvector(v, bf16x2_t));
}
__device__ __forceinline__ float wave_sum(float v) {
#pragma unroll
  for (int o = 32; o > 0; o >>= 1) v += __shfl_xor(v, o, 64);
  return v;
}
#define DPP_ADD(v, ctrl) v += __builtin_bit_cast(float, __builtin_amdgcn_update_dpp(0, __builtin_bit_cast(int, v), ctrl, 0xF, 0xF, true))
__device__ __forceinline__ float wave_sum_dpp(float v) {
  DPP_ADD(v, 0xB1);
  DPP_ADD(v, 0x4E);
  DPP_ADD(v, 0x141);
  DPP_ADD(v, 0x140);
  const float r0 = __builtin_bit_cast(float, __builtin_amdgcn_readlane(__builtin_bit_cast(int, v), 0));
  const float r1 = __builtin_bit_cast(float, __builtin_amdgcn_readlane(__builtin_bit_cast(int, v), 16));
  const float r2 = __builtin_bit_cast(float, __builtin_amdgcn_readlane(__builtin_bit_cast(int, v), 32));
  const float r3 = __builtin_bit_cast(float, __builtin_amdgcn_readlane(__builtin_bit_cast(int, v), 48));
  return (r0 + r1) + (r2 + r3);
}
__device__ __forceinline__ float softplusf(float x) { return fmaxf(x, 0.f) + log1pf(expf(-fabsf(x))); }
__device__ __forceinline__ float sigmoidf(float x) { return __builtin_amdgcn_rcpf(1.f + __builtin_amdgcn_exp2f(-1.4426950408889634f * x)); }

__device__ __forceinline__ void d_prep_x(int item, const float* __restrict__ x, unsigned short* __restrict__ xb,
                                                float* __restrict__ rs) {
  int t = item * 4 + (threadIdx.x >> 6);
  int lane = threadIdx.x & 63;
  const float4* xr = (const float4*)(x + (size_t)t * DM);
  float ss = 0.f;
#pragma unroll
  for (int i = 0; i < 4; ++i) {
    float4 v = xr[lane + 64 * i];
    ss += v.x * v.x + v.y * v.y + v.z * v.z + v.w * v.w;
    ushort4 o;
    o.x = f2bf(v.x); o.y = f2bf(v.y); o.z = f2bf(v.z); o.w = f2bf(v.w);
    ((ushort4*)(xb + (size_t)t * DM))[lane + 64 * i] = o;
  }
  ss = wave_sum(ss);
  if (lane == 0) rs[t] = rsqrtf(ss * (1.f / DM) + EPSF);
}

__device__ __forceinline__ int win_src(int n) {
  if (n < 2048) return n;
  if (n < 4096) return n + 16;
  int j = n - 4096;
  if (j < 16) return 2048 + j;
  if (j < 32) return 4112 + (j - 16);
  return -1;
}
__device__ __forceinline__ void d_transpose_w(int item, int ntn, float* tile, const float* __restrict__ in, int ldn,
                                              const float* __restrict__ g, unsigned short* __restrict__ out, int mode) {
  const int kt = item / ntn, nt = item % ntn;
  const int tid = threadIdx.x;
  __syncthreads();
#pragma unroll
  for (int i = 0; i < 4; ++i) {
    const int row = (tid >> 4) + 16 * i;
    const int c4 = (tid & 15) * 4;
    const int n = nt * 64 + c4;
    const int src = mode ? win_src(n) : n;
    float4 v = make_float4(0.f, 0.f, 0.f, 0.f);
    if (src >= 0) {
      v = *(const float4*)(in + (size_t)(kt * 64 + row) * ldn + src);
      if (g) { const float gg = g[kt * 64 + row]; v.x *= gg; v.y *= gg; v.z *= gg; v.w *= gg; }
    }
    tile[row * 65 + c4] = v.x; tile[row * 65 + c4 + 1] = v.y; tile[row * 65 + c4 + 2] = v.z; tile[row * 65 + c4 + 3] = v.w;
  }
  __syncthreads();
  {
    const int n = tid >> 2, k16 = (tid & 3) * 16;
    uint4 o0, o1;
    o0.x = pack2(tile[(k16 + 0) * 65 + n], tile[(k16 + 1) * 65 + n]);   o0.y = pack2(tile[(k16 + 2) * 65 + n], tile[(k16 + 3) * 65 + n]);
    o0.z = pack2(tile[(k16 + 4) * 65 + n], tile[(k16 + 5) * 65 + n]);   o0.w = pack2(tile[(k16 + 6) * 65 + n], tile[(k16 + 7) * 65 + n]);
    o1.x = pack2(tile[(k16 + 8) * 65 + n], tile[(k16 + 9) * 65 + n]);   o1.y = pack2(tile[(k16 + 10) * 65 + n], tile[(k16 + 11) * 65 + n]);
    o1.z = pack2(tile[(k16 + 12) * 65 + n], tile[(k16 + 13) * 65 + n]); o1.w = pack2(tile[(k16 + 14) * 65 + n], tile[(k16 + 15) * 65 + n]);
    unsigned short* op = out + (size_t)(nt * 64 + n) * DM + kt * 64 + k16;
    *(uint4*)op = o0;
    *(uint4*)(op + 8) = o1;
  }
}
__device__ __forceinline__ void d_cvt_bf16(int item, const float* __restrict__ src, unsigned short* __restrict__ dst,
                                           const float* __restrict__ rowscale, int rowlen_log2) {
  const size_t base = (size_t)item * 2048 + threadIdx.x * 8;
  float4 a = *(const float4*)(src + base);
  float4 b = *(const float4*)(src + base + 4);
  if (rowscale) {
    const float sc = rowscale[base >> rowlen_log2];
    a.x *= sc; a.y *= sc; a.z *= sc; a.w *= sc; b.x *= sc; b.y *= sc; b.z *= sc; b.w *= sc;
  }
  uint4 o;
  o.x = pack2(a.x, a.y); o.y = pack2(a.z, a.w); o.z = pack2(b.x, b.y); o.w = pack2(b.z, b.w);
  *(uint4*)(dst + base) = o;
}

constexpr int GBM = 128, GBN = 128, GBK = 64, GLD = 64;
struct GemmP {
  const unsigned short* A; const unsigned short* Bt; int lda, ldb, K;
  const float* rowscale;
  unsigned short* obf; int ldo;
  float* of32; int ldf;
  const float* resid;
  const float *a_log, *dt_bias, *i_bias, *f_bias;
  float* rowacc;
};
enum { EPI_INPROJ = 0, EPI_OUTPROJ = 1, EPI_SCORES = 2, EPI_PLAIN = 3 };

template <int EPI>
__device__ __forceinline__ void gemm_tile(const GemmP p, int tm, int tn, unsigned short* smem) {
  unsigned short* As = smem;
  unsigned short* Bs = smem + 2 * GBM * GLD;
  int tid = threadIdx.x;
  asm volatile("" : "+v"(tid));
  const int lane = tid & 63, wid = tid >> 6;
  const int wm = wid >> 1, wn = wid & 1;
  const int m0 = tm * GBM, n0 = tn * GBN;
  f32x4 acc[4][4];
#pragma unroll
  for (int i = 0; i < 4; ++i)
#pragma unroll
    for (int j = 0; j < 4; ++j) acc[i][j] = (f32x4){0.f, 0.f, 0.f, 0.f};

  uint4 ra0, ra1, ra2, ra3, rb0, rb1, rb2, rb3;
  uint4 sa0, sa1, sa2, sa3, sb0, sb1, sb2, sb3;
  const int nk = p.K / GBK;
  const int lrow = tid >> 3, lc8 = tid & 7;
  const unsigned short* Ag = p.A + (size_t)(m0 + lrow) * p.lda + lc8 * 8;
  const unsigned short* Bg = p.Bt + (size_t)(n0 + lrow) * p.ldb + lc8 * 8;
  const size_t a32 = (size_t)32 * p.lda, b32 = (size_t)32 * p.ldb;
#define GLOAD(R, S, kt)                                                  \
  {                                                                      \
    R##0 = *(const uint4*)(Ag + (kt) * GBK);                             \
    R##1 = *(const uint4*)(Ag + a32 + (kt) * GBK);                       \
    R##2 = *(const uint4*)(Ag + 2 * a32 + (kt) * GBK);                   \
    R##3 = *(const uint4*)(Ag + 3 * a32 + (kt) * GBK);                   \
    S##0 = *(const uint4*)(Bg + (kt) * GBK);                             \
    S##1 = *(const uint4*)(Bg + b32 + (kt) * GBK);                       \
    S##2 = *(const uint4*)(Bg + 2 * b32 + (kt) * GBK);                   \
    S##3 = *(const uint4*)(Bg + 3 * b32 + (kt) * GBK);                   \
  }
#define SSTORE(R, S, buf)                                                \
  {                                                                      \
    unsigned short* ad = As + (size_t)(buf) * GBM * GLD + lrow * GLD + ((lc8 ^ (lrow & 7)) * 8); \
    unsigned short* bd = Bs + (size_t)(buf) * GBN * GLD + lrow * GLD + ((lc8 ^ (lrow & 7)) * 8); \
    *(uint4*)(ad) = R##0; *(uint4*)(ad + 32 * GLD) = R##1; *(uint4*)(ad + 64 * GLD) = R##2; *(uint4*)(ad + 96 * GLD) = R##3; \
    *(uint4*)(bd) = S##0; *(uint4*)(bd + 32 * GLD) = S##1; *(uint4*)(bd + 64 * GLD) = S##2; *(uint4*)(bd + 96 * GLD) = S##3; \
  }
#define GCOMPUTE(buf)                                                                                                     \
  {                                                                                                                       \
    const unsigned short* Ab = As + (size_t)(buf) * GBM * GLD;                                                            \
    const unsigned short* Bb = Bs + (size_t)(buf) * GBN * GLD;                                                            \
    _Pragma("unroll") for (int ks = 0; ks < 2; ++ks) {                                                                    \
      bf16x8 a[4], b[4];                                                                                                  \
      const int kc = ((ks * 4 + (lane >> 4)) ^ (lane & 7)) * 8;                   \
      _Pragma("unroll") for (int i = 0; i < 4; ++i) a[i] = *(const bf16x8*)(Ab + (wm * 64 + i * 16 + (lane & 15)) * GLD + kc); \
      _Pragma("unroll") for (int j = 0; j < 4; ++j) b[j] = *(const bf16x8*)(Bb + (wn * 64 + j * 16 + (lane & 15)) * GLD + kc); \
      _Pragma("unroll") for (int i = 0; i < 4; ++i)                                                                       \
        _Pragma("unroll") for (int j = 0; j < 4; ++j)                                                                     \
          acc[i][j] = __builtin_amdgcn_mfma_f32_16x16x32_bf16(b[j], a[i], acc[i][j], 0, 0, 0);               \
    }                                                                                                                     \
  }
  GLOAD(ra, rb, 0);
  if (nk > 1) GLOAD(sa, sb, 1);
  SSTORE(ra, rb, 0);
  __syncthreads();
  for (int kt = 0; kt < nk; kt += 2) {
    if (kt + 2 < nk) GLOAD(ra, rb, kt + 2);
    GCOMPUTE(0);
    if (kt + 1 < nk) SSTORE(sa, sb, 1);
    __syncthreads();
    if (kt + 1 < nk) {
      if (kt + 3 < nk) GLOAD(sa, sb, kt + 3);
      GCOMPUTE(1);
      if (kt + 2 < nk) SSTORE(ra, rb, 0);
      __syncthreads();
    }
  }
#undef GLOAD
#undef SSTORE
#undef GCOMPUTE
#pragma unroll
  for (int i = 0; i < 4; ++i) {
    const int row = m0 + wm * 64 + i * 16 + (lane & 15);
    float rsc = 1.f;
    float rowss = 0.f;
    if (EPI == EPI_INPROJ) rsc = p.rowscale[row];
    if (EPI == EPI_SCORES) {
      const float4* pr = (const float4*)(p.rowscale + (size_t)row * 16);
      const float4 s0 = pr[0], s1 = pr[1], s2 = pr[2], s3 = pr[3];
      const float ssq = ((s0.x + s0.y) + (s0.z + s0.w)) + ((s1.x + s1.y) + (s1.z + s1.w)) + ((s2.x + s2.y) + (s2.z + s2.w)) + ((s3.x + s3.y) + (s3.z + s3.w));
      rsc = rsqrtf(ssq * (1.f / DM) + EPSF);
    }
#pragma unroll
    for (int j = 0; j < 4; ++j) {
      const int col0 = n0 + wn * 64 + j * 16 + (lane >> 4) * 4;
      const float v0 = acc[i][j][0] * rsc, v1 = acc[i][j][1] * rsc, v2 = acc[i][j][2] * rsc, v3 = acc[i][j][3] * rsc;
      if (EPI == EPI_INPROJ) {
        if (col0 < 4096) {
          uint2 pk; pk.x = pack2(v0, v1); pk.y = pack2(v2, v3);
          *(uint2*)(p.obf + (size_t)row * p.ldo + col0) = pk;
        } else if (col0 < 4128) {
          const float vv[4] = {v0, v1, v2, v3};
          float oo[4];
#pragma unroll
          for (int r = 0; r < 4; ++r) {
            const int jg = col0 - 4096 + r, jj = jg & 7;
            const float v = vv[r];
            float o;
            if (jg < 8) o = -expf(p.a_log[jj]) * softplusf(v + p.dt_bias[jj]);
            else if (jg < 16) o = sigmoidf(v);
            else if (jg < 24) o = v + p.i_bias[jj];
            else o = -softplusf(-(v + p.f_bias[jj]));
            oo[r] = o;
          }
          *(float4*)(p.of32 + (size_t)row * p.ldf + (col0 - 4096)) = make_float4(oo[0], oo[1], oo[2], oo[3]);
        }
      } else if (EPI == EPI_OUTPROJ) {
        const float4 xr = *(const float4*)(p.resid + (size_t)row * p.ldf + col0);
        const float x0 = v0 + xr.x, x1 = v1 + xr.y, x2 = v2 + xr.z, x3 = v3 + xr.w;
        *(float4*)(p.of32 + (size_t)row * p.ldf + col0) = make_float4(x0, x1, x2, x3);
        uint2 pk; pk.x = pack2(x0, x1); pk.y = pack2(x2, x3);
        *(uint2*)(p.obf + (size_t)row * p.ldo + col0) = pk;
        rowss += (x0 * x0 + x1 * x1) + (x2 * x2 + x3 * x3);
      } else {
        uint2 pk; pk.x = pack2(v0, v1); pk.y = pack2(v2, v3);
        *(uint2*)(p.obf + (size_t)row * p.ldo + col0) = pk;
      }
    }
    if (EPI == EPI_OUTPROJ) {
      rowss += __shfl_xor(rowss, 16, 64);
      rowss += __shfl_xor(rowss, 32, 64);
      if ((lane >> 4) == 0) p.rowacc[(size_t)row * 16 + tn * 2 + wn] = rowss;
    }
  }
}

__device__ __forceinline__ bool xcd_tile(int bid, int nb, int k, int ntn, int& tm, int& tn) {
  const int q = (bid >> 3) + (nb >> 3) * k;
  if (q >= 16 * ntn) return false;
  const int g = q / (8 * ntn), rem = q % (8 * ntn);
  tn = rem >> 3;
  tm = 16 * (bid & 7) + 8 * g + (rem & 7);
  return true;
}

__device__ __forceinline__ void d_conv(int item, const unsigned short* __restrict__ pm, const float* __restrict__ pg,
                                              const float* __restrict__ conv_w, const float* __restrict__ a_log,
                                              const float* __restrict__ dt_bias, const float* __restrict__ i_bias,
                                              const float* __restrict__ f_bias, unsigned short* __restrict__ qkv,
                                              float* __restrict__ gt) {
  int t = item * 4 + (threadIdx.x >> 6);
  int lane = threadIdx.x & 63;
  int s = t & (SEQ - 1);
  for (int sec = 0; sec < 3; ++sec) {
    for (int h = 0; h < 4; ++h) {
      int c0 = sec * 512 + h * 128 + 2 * lane;
      float a0 = 0.f, a1 = 0.f;
#pragma unroll
      for (int j = 0; j < 5; ++j) {
        int sp = s + j - 2;
        if (sp >= 0 && sp < SEQ) {
          unsigned v = *(const unsigned*)(pm + (size_t)(t + j - 2) * 4096 + c0);
          a0 += conv_w[c0 * 5 + j] * bf2f((unsigned short)(v & 0xffff));
          a1 += conv_w[(c0 + 1) * 5 + j] * bf2f((unsigned short)(v >> 16));
        }
      }
      a0 = a0 * sigmoidf(a0);
      a1 = a1 * sigmoidf(a1);
      if (sec < 2) {
        float ss = wave_sum(a0 * a0 + a1 * a1);
        float sc = rsqrtf(ss + EPSF);
        if (sec == 0) sc *= 0.08838834764831845f;
        a0 *= sc; a1 *= sc;
      }
      unsigned o = pack2(a0, a1);
      *(unsigned*)(qkv + (size_t)t * 1536 + c0) = o;
    }
  }
}

__device__ __forceinline__ void d_gdn_rec(int chain, float* sq, float* sk, const unsigned short* __restrict__ qkv,
                                                 const float* __restrict__ gt, unsigned short* __restrict__ oA, int ntok) {
  const int bh = chain >> 1, dir = chain & 1;
  const int b = bh >> 2, h = bh & 3;
  const int e = threadIdx.x & 127;
  float S[128];
#pragma unroll
  for (int d = 0; d < 128; ++d) S[d] = 0.f;
  for (int it = 0; it < SEQ; ++it) {
    const int s = dir ? (SEQ - 1 - it) : it;
    const size_t t = (size_t)b * SEQ + s;
    __syncthreads();
    sq[e] = bf2f(qkv[t * 1536 + h * 128 + e]);
    sk[e] = bf2f(qkv[t * 1536 + 512 + h * 128 + e]);
    const float v = bf2f(qkv[t * 1536 + 1024 + h * 128 + e]);
    const float g = gt[t * 32 + dir * 4 + h];
    const float beta = gt[t * 32 + 8 + dir * 4 + h];
    __syncthreads();
    const float a = expf(g);
    float k0 = 0.f, k1 = 0.f, k2 = 0.f, k3 = 0.f;
#pragma unroll
    for (int d = 0; d < 128; d += 4) {
      k0 += sk[d] * S[d]; k1 += sk[d + 1] * S[d + 1]; k2 += sk[d + 2] * S[d + 2]; k3 += sk[d + 3] * S[d + 3];
    }
    const float kS = a * ((k0 + k1) + (k2 + k3));
    const float vn = beta * (v - kS);
    float o0 = 0.f, o1 = 0.f, o2 = 0.f, o3 = 0.f;
#pragma unroll
    for (int d = 0; d < 128; d += 4) {
      S[d] = a * S[d] + sk[d] * vn;             o0 += sq[d] * S[d];
      S[d + 1] = a * S[d + 1] + sk[d + 1] * vn; o1 += sq[d + 1] * S[d + 1];
      S[d + 2] = a * S[d + 2] + sk[d + 2] * vn; o2 += sq[d + 2] * S[d + 2];
      S[d + 3] = a * S[d + 3] + sk[d + 3] * vn; o3 += sq[d + 3] * S[d + 3];
    }
    oA[((size_t)dir * ntok + t) * 512 + h * 128 + e] = f2bf((o0 + o1) + (o2 + o3));
  }
}

__device__ __forceinline__ void d_mlstm_rec(int chain, float* sq, float* sk, const unsigned short* __restrict__ pm,
                                                   const float* __restrict__ gt, unsigned short* __restrict__ oM, int ntok) {
  const int bh = chain >> 1, dir = chain & 1;
  const int b = bh >> 2, h = bh & 3;
  const int e = threadIdx.x & 127, lane = e & 63;
  float C[128];
#pragma unroll
  for (int d = 0; d < 128; ++d) C[d] = 0.f;
  float n0 = 0.f, n1 = 0.f, m = 0.f;
  for (int it = 0; it < SEQ; ++it) {
    const int s = dir ? (SEQ - 1 - it) : it;
    const size_t t = (size_t)b * SEQ + s;
    __syncthreads();
    sq[e] = bf2f(pm[t * 4096 + 2048 + h * 128 + e]);
    sk[e] = bf2f(pm[t * 4096 + 2560 + h * 128 + e]) * 0.08838834764831845f;
    const float v = bf2f(pm[t * 4096 + 3072 + h * 128 + e]);
    const float ip = gt[t * 32 + 16 + dir * 4 + h];
    const float lf = gt[t * 32 + 24 + dir * 4 + h];
    __syncthreads();
    const float mn = fmaxf(lf + m, ip);
    const float fs = expf(lf + m - mn);
    const float is = expf(ip - mn);
    m = mn;
    n0 = fs * n0 + is * sk[lane];
    n1 = fs * n1 + is * sk[lane + 64];
    const float den = wave_sum(n0 * sq[lane] + n1 * sq[lane + 64]);
    const float iv = is * v;
    float o0 = 0.f, o1 = 0.f, o2 = 0.f, o3 = 0.f;
#pragma unroll
    for (int d = 0; d < 128; d += 4) {
      C[d] = fs * C[d] + sk[d] * iv;             o0 += sq[d] * C[d];
      C[d + 1] = fs * C[d + 1] + sk[d + 1] * iv; o1 += sq[d + 1] * C[d + 1];
      C[d + 2] = fs * C[d + 2] + sk[d + 2] * iv; o2 += sq[d + 2] * C[d + 2];
      C[d + 3] = fs * C[d + 3] + sk[d + 3] * iv; o3 += sq[d + 3] * C[d + 3];
    }
    const float num = (o0 + o1) + (o2 + o3);
    const float hh = num / fmaxf(fabsf(den), expf(-mn));
    oM[((size_t)dir * ntok + t) * 512 + h * 128 + e] = f2bf(hh);
  }
}

__device__ __forceinline__ void d_combine(int item, const unsigned short* __restrict__ uo, const unsigned short* __restrict__ oM,
                                                 const unsigned short* __restrict__ pm, const float* __restrict__ gdn_g,
                                                 const float* __restrict__ ml_g, unsigned short* __restrict__ y) {
  int tid_ = threadIdx.x;
  asm volatile("" : "+v"(tid_));
  const int t = item * 4 + (tid_ >> 6);
  const int lane = tid_ & 63;
  const int b = t >> 12, cc = (t >> 6) & 63, ii = t & 63;
  unsigned gf_[4], gb_[4], mf_[4], mb_[4], zg_[4], zo_[4];
  const size_t off = (size_t)cc * 8192 + (lane >> 4) * 2048 + ii * 32 + ((2 * lane) & 31);
#pragma unroll
  for (int h = 0; h < 4; ++h) {
    const int c = h * 128 + 2 * lane;
    const int chain0 = (b * 4 + h) * 2;
    gf_[h] = *(const unsigned*)(uo + (size_t)chain0 * 64 * 8192 + off);
    gb_[h] = *(const unsigned*)(uo + (size_t)(chain0 + 1) * 64 * 8192 + off);
    mf_[h] = *(const unsigned*)(oM + (size_t)t * 512 + c);
    mb_[h] = *(const unsigned*)(oM + ((size_t)NT + t) * 512 + c);
    zg_[h] = *(const unsigned*)(pm + (size_t)t * 4096 + 1536 + c);
    zo_[h] = *(const unsigned*)(pm + (size_t)t * 4096 + 3584 + c);
  }
  const float gg0 = gdn_g[2 * lane], gg1 = gdn_g[2 * lane + 1];
  float a0[4], a1[4], m0[4], m1[4], sa[4], sm[4];
#pragma unroll
  for (int h = 0; h < 4; ++h) {
    a0[h] = bf2f(gf_[h] & 0xffff) + bf2f(gb_[h] & 0xffff);
    a1[h] = __uint_as_float(gf_[h] & 0xffff0000u) + __uint_as_float(gb_[h] & 0xffff0000u);
    m0[h] = bf2f(mf_[h] & 0xffff) + bf2f(mb_[h] & 0xffff);
    m1[h] = __uint_as_float(mf_[h] & 0xffff0000u) + __uint_as_float(mb_[h] & 0xffff0000u);
    sa[h] = a0[h] * a0[h] + a1[h] * a1[h];
    sm[h] = m0[h] * m0[h] + m1[h] * m1[h];
  }
#pragma unroll
  for (int o = 32; o > 0; o >>= 1) {
#pragma unroll
    for (int h = 0; h < 4; ++h) { sa[h] += __shfl_xor(sa[h], o, 64); sm[h] += __shfl_xor(sm[h], o, 64); }
  }
#pragma unroll
  for (int h = 0; h < 4; ++h) {
    const int c = h * 128 + 2 * lane;
    const float sca = rsqrtf(sa[h] * (1.f / 128.f) + EPSF);
    const float scm = rsqrtf(sm[h] * (1.f / 128.f) + EPSF);
    const float z0 = bf2f(zg_[h] & 0xffff), z1 = __uint_as_float(zg_[h] & 0xffff0000u);
    const float q0 = bf2f(zo_[h] & 0xffff), q1 = __uint_as_float(zo_[h] & 0xffff0000u);
    const float o0 = a0[h] * sca * gg0 * (z0 * sigmoidf(z0));
    const float o1 = a1[h] * sca * gg1 * (z1 * sigmoidf(z1));
    const float p0 = m0[h] * scm * ml_g[c] * sigmoidf(q0);
    const float p1 = m1[h] * scm * ml_g[c + 1] * sigmoidf(q1);
    *(unsigned*)(y + (size_t)t * DM + c) = pack2(o0, o1);
    *(unsigned*)(y + (size_t)t * DM + 512 + c) = pack2(p0, p1);
  }
}

#ifdef DBG_CHECK
__device__ __forceinline__ void d_dbg_cmp(int item, const unsigned short* __restrict__ uo, const unsigned short* __restrict__ oAd,
                                          float* __restrict__ dbg) {
  int t = item * 4 + (threadIdx.x >> 6);
  int lane = threadIdx.x & 63;
  const int cc = (t >> 6) & 63, ii = t & 63;
  float sd = 0.f, sr = 0.f;
  for (int h = 0; h < 4; ++h) {
    for (int dir = 0; dir < 2; ++dir) {
      const int chain = h * 2 + dir;
      const size_t off = (size_t)cc * 8192 + (lane >> 4) * 2048 + ii * 32 + ((2 * lane) & 31);
      unsigned vn = *(const unsigned*)(uo + (size_t)chain * 64 * 8192 + off);
      unsigned vr = *(const unsigned*)(oAd + ((size_t)dir * 4096 + t) * 512 + h * 128 + 2 * lane);
      float n0 = bf2f(vn & 0xffff), n1 = bf2f(vn >> 16), r0 = bf2f(vr & 0xffff), r1 = bf2f(vr >> 16);
      sd += (n0 - r0) * (n0 - r0) + (n1 - r1) * (n1 - r1);
      sr += r0 * r0 + r1 * r1;
    }
  }
  sd = wave_sum(sd); sr = wave_sum(sr);
  if (lane == 0) { atomicAdd(&dbg[0], sd); atomicAdd(&dbg[1], sr); }
}
__device__ __forceinline__ void d_dbg_cmp_m(int item, const unsigned short* __restrict__ oM, const unsigned short* __restrict__ oMd,
                                            float* __restrict__ dbg) {
  int t = item * 4 + (threadIdx.x >> 6);
  int lane = threadIdx.x & 63;
  float sd = 0.f, sr = 0.f;
  for (int dir = 0; dir < 2; ++dir)
    for (int q = 0; q < 4; ++q) {
      unsigned vn = *(const unsigned*)(oM + ((size_t)dir * NT + t) * 512 + q * 128 + 2 * lane);
      unsigned vr = *(const unsigned*)(oMd + ((size_t)dir * 4096 + t) * 512 + q * 128 + 2 * lane);
      float n0 = bf2f(vn & 0xffff), n1 = bf2f(vn >> 16), r0 = bf2f(vr & 0xffff), r1 = bf2f(vr >> 16);
      sd += (n0 - r0) * (n0 - r0) + (n1 - r1) * (n1 - r1);
      sr += r0 * r0 + r1 * r1;
    }
  sd = wave_sum(sd); sr = wave_sum(sr);
  if (lane == 0) { atomicAdd(&dbg[0], sd); atomicAdd(&dbg[1], sr); }
}
#endif

__device__ __forceinline__ void d_prep_x1(int item, const float* __restrict__ x1, unsigned short* __restrict__ xb,
                                                 float* __restrict__ rs) {
  int t = item * 4 + (threadIdx.x >> 6);
  int lane = threadIdx.x & 63;
  const float4* xr = (const float4*)(x1 + (size_t)t * DM);
  float ss = 0.f;
#pragma unroll
  for (int i = 0; i < 4; ++i) {
    float4 v = xr[lane + 64 * i];
    ss += v.x * v.x + v.y * v.y + v.z * v.z + v.w * v.w;
    ushort4 o;
    o.x = f2bf(v.x); o.y = f2bf(v.y); o.z = f2bf(v.z); o.w = f2bf(v.w);
    ((ushort4*)(xb + (size_t)t * DM))[lane + 64 * i] = o;
  }
  ss = wave_sum(ss);
  if (lane == 0) rs[t] = rsqrtf(ss * (1.f / DM) + EPSF);
}

__device__ const unsigned char kPairTab[64] = {
    0x00, 0x01, 0x02, 0x03, 0x04, 0x05, 0x06, 0x07, 0x08, 0x09, 0x0a, 0x0b, 0x0c, 0x0d, 0x0e, 0x0f,
    0x10, 0x11, 0x12, 0x13, 0x14, 0x15, 0x16, 0x17,
    0x20, 0x21, 0x22, 0x23, 0x24,
    0x30, 0x31, 0x32, 0x33,
    0x40, 0x41, 0x42,
    0x50, 0x51, 0x60, 0x61, 0x70, 0x71,
    0x80, 0x90, 0xa0, 0xb0, 0xc0, 0xd0, 0xe0, 0xf0,
    0xff, 0xff, 0xff, 0xff, 0xff, 0xff, 0xff, 0xff, 0xff, 0xff, 0xff, 0xff, 0xff, 0xff};

__device__ __forceinline__ void sort16_desc(unsigned (&a)[16]) {
#pragma unroll
  for (int k = 2; k <= 16; k <<= 1)
#pragma unroll
    for (int j = k >> 1; j > 0; j >>= 1)
#pragma unroll
      for (int i = 0; i < 16; ++i) {
        const int l = i ^ j;
        if (l > i) {
          const unsigned hi = max(a[i], a[l]), lo = min(a[i], a[l]);
          if ((i & k) == 0) { a[i] = hi; a[l] = lo; } else { a[i] = lo; a[l] = hi; }
        }
      }
}
__device__ __forceinline__ void merge16_desc(unsigned (&top)[16], const unsigned (&b)[16]) {
#pragma unroll
  for (int i = 0; i < 16; ++i) top[i] = max(top[i], b[15 - i]);
#pragma unroll
  for (int j = 8; j > 0; j >>= 1)
#pragma unroll
    for (int i = 0; i < 16; ++i) {
      const int l = i ^ j;
      if (l > i) {
        const unsigned hi = max(top[i], top[l]), lo = min(top[i], top[l]);
        top[i] = hi; top[l] = lo;
      }
    }
}
__device__ __forceinline__ unsigned key16(unsigned hbits, int idx) {
  const unsigned m = hbits ^ ((hbits & 0x8000u) ? 0xFFFFu : 0x8000u);
  return (m << 16) | (unsigned)(127 - idx);
}
__device__ __forceinline__ void top16_of_128(const unsigned short* __restrict__ sp, unsigned (&top)[16]) {
#pragma unroll
  for (int g = 0; g < 8; ++g) {
    const uint4 x0 = *(const uint4*)(sp + g * 16);
    const uint4 x1 = *(const uint4*)(sp + g * 16 + 8);
    unsigned b[16];
    b[0] = key16(x0.x & 0xffff, g * 16 + 0);  b[1] = key16(x0.x >> 16, g * 16 + 1);
    b[2] = key16(x0.y & 0xffff, g * 16 + 2);  b[3] = key16(x0.y >> 16, g * 16 + 3);
    b[4] = key16(x0.z & 0xffff, g * 16 + 4);  b[5] = key16(x0.z >> 16, g * 16 + 5);
    b[6] = key16(x0.w & 0xffff, g * 16 + 6);  b[7] = key16(x0.w >> 16, g * 16 + 7);
    b[8] = key16(x1.x & 0xffff, g * 16 + 8);  b[9] = key16(x1.x >> 16, g * 16 + 9);
    b[10] = key16(x1.y & 0xffff, g * 16 + 10); b[11] = key16(x1.y >> 16, g * 16 + 11);
    b[12] = key16(x1.z & 0xffff, g * 16 + 12); b[13] = key16(x1.z >> 16, g * 16 + 13);
    b[14] = key16(x1.w & 0xffff, g * 16 + 14); b[15] = key16(x1.w >> 16, g * 16 + 15);
    sort16_desc(b);
    if (g == 0) {
#pragma unroll
      for (int i = 0; i < 16; ++i) top[i] = b[i];
    } else {
      merge16_desc(top, b);
    }
  }
}

__device__ __forceinline__ void d_topk(int item, const unsigned short* __restrict__ scores, int* __restrict__ idx_out,
                                       float* __restrict__ gate_out) {
  int tid_ = threadIdx.x;
  asm volatile("" : "+v"(tid_));
  const int pair = item * 256 + tid_;
  const unsigned short* sp = scores + (size_t)pair * 256;
  unsigned k0[16], k1[16];
  top16_of_128(sp, k0);
  top16_of_128(sp + 128, k1);
  float v0[16], v1[16];
  int i0[16], i1[16];
#pragma unroll
  for (int i = 0; i < 16; ++i) {
    const unsigned m0 = k0[i] >> 16, m1 = k1[i] >> 16;
    v0[i] = bf2f((unsigned short)(m0 ^ ((m0 & 0x8000u) ? 0x8000u : 0xFFFFu)));
    v1[i] = bf2f((unsigned short)(m1 ^ ((m1 & 0x8000u) ? 0x8000u : 0xFFFFu)));
    i0[i] = 127 - (int)(k0[i] & 127u);
    i1[i] = 127 - (int)(k1[i] & 127u);
  }
  unsigned top[16];
#pragma unroll
  for (int g = 0; g < 4; ++g) {
    unsigned b[16];
#pragma unroll
    for (int q = 0; q < 16; ++q) {
      const int pr = kPairTab[g * 16 + q];
      if (pr == 0xff) {
        b[q] = 0u;
      } else {
        const int pi = pr >> 4, pj = pr & 15;
        const float sum = v0[pi] + v1[pj];
        const unsigned u = __float_as_uint(sum);
        const unsigned mono = u ^ ((u & 0x80000000u) ? 0xFFFFFFFFu : 0x80000000u);
        b[q] = (mono & 0xFFFFC000u) | (unsigned)(16383 - (i0[pi] * 128 + i1[pj]));
      }
    }
    sort16_desc(b);
    if (g == 0) {
#pragma unroll
      for (int i = 0; i < 16; ++i) top[i] = b[i];
    } else {
      merge16_desc(top, b);
    }
  }
  float ev[16];
  int ci[16];
  float mx = 0.f, sum = 0.f;
#pragma unroll
  for (int i = 0; i < 16; ++i) {
    const unsigned mono = top[i] & 0xFFFFC000u;
    const unsigned u = mono ^ ((mono & 0x80000000u) ? 0x80000000u : 0xFFFFFFFFu);
    const float val = __uint_as_float(u & 0xFFFFC000u);
    ci[i] = 16383 - (int)(top[i] & 16383u);
    if (i == 0) mx = val;
    ev[i] = expf(val - mx);
    sum += ev[i];
  }
  const float inv = 1.f / sum;
#pragma unroll
  for (int q = 0; q < 4; ++q) {
    int4 o; float4 g;
    o.x = ci[4 * q]; o.y = ci[4 * q + 1]; o.z = ci[4 * q + 2]; o.w = ci[4 * q + 3];
    g.x = ev[4 * q] * inv; g.y = ev[4 * q + 1] * inv; g.z = ev[4 * q + 2] * inv; g.w = ev[4 * q + 3] * inv;
    *(int4*)(idx_out + (size_t)pair * 16 + 4 * q) = o;
    *(float4*)(gate_out + (size_t)pair * 16 + 4 * q) = g;
  }
}

typedef float f32x2 __attribute__((ext_vector_type(2)));
__device__ __forceinline__ void d_cvt_tab(int item, const float* __restrict__ src, unsigned* __restrict__ dst8, float* __restrict__ dscale) {
  const int row = item * 4 + (threadIdx.x >> 6);
  const int lane = threadIdx.x & 63;
  const float4* sr = (const float4*)(src + (size_t)row * DM + lane * 16);
  const float4 a = sr[0], b = sr[1], c = sr[2], d = sr[3];
  float m = fmaxf(fmaxf(fmaxf(fabsf(a.x), fabsf(a.y)), fmaxf(fabsf(a.z), fabsf(a.w))),
                  fmaxf(fmaxf(fabsf(b.x), fabsf(b.y)), fmaxf(fabsf(b.z), fabsf(b.w))));
  m = fmaxf(m, fmaxf(fmaxf(fmaxf(fabsf(c.x), fabsf(c.y)), fmaxf(fabsf(c.z), fabsf(c.w))),
                     fmaxf(fmaxf(fabsf(d.x), fabsf(d.y)), fmaxf(fabsf(d.z), fabsf(d.w)))));
#pragma unroll
  for (int o = 32; o > 0; o >>= 1) m = fmaxf(m, __shfl_xor(m, o, 64));
  const float sc = (m > 0.f) ? 240.f / m : 1.f;
  uint4 o;
  int p;
  p = 0; p = __builtin_amdgcn_cvt_pk_fp8_f32(a.x * sc, a.y * sc, p, false); p = __builtin_amdgcn_cvt_pk_fp8_f32(a.z * sc, a.w * sc, p, true); o.x = (unsigned)p;
  p = 0; p = __builtin_amdgcn_cvt_pk_fp8_f32(b.x * sc, b.y * sc, p, false); p = __builtin_amdgcn_cvt_pk_fp8_f32(b.z * sc, b.w * sc, p, true); o.y = (unsigned)p;
  p = 0; p = __builtin_amdgcn_cvt_pk_fp8_f32(c.x * sc, c.y * sc, p, false); p = __builtin_amdgcn_cvt_pk_fp8_f32(c.z * sc, c.w * sc, p, true); o.z = (unsigned)p;
  p = 0; p = __builtin_amdgcn_cvt_pk_fp8_f32(d.x * sc, d.y * sc, p, false); p = __builtin_amdgcn_cvt_pk_fp8_f32(d.z * sc, d.w * sc, p, true); o.w = (unsigned)p;
  *(uint4*)(dst8 + (size_t)row * 256 + lane * 4) = o;
  if (lane == 0) dscale[row] = (m > 0.f) ? m * (1.f / 240.f) : 1.f;
}

__device__ __forceinline__ float erf_fast(float x) {
  const float ax = fabsf(x);
  const float t = __builtin_amdgcn_rcpf(1.f + 0.3275911f * ax);
  float p = 1.061405429f;
  p = p * t - 1.453152027f;
  p = p * t + 1.421413741f;
  p = p * t - 0.284496736f;
  p = p * t + 0.254829592f;
  const float e = __builtin_amdgcn_exp2f(-1.4426950408889634f * ax * ax);
  const float r = 1.f - p * t * e;
  return copysignf(r, x);
}
__device__ __forceinline__ float dot16_f8(const uint4 u, const float* hv) {
  const f32x2 a0 = __builtin_amdgcn_cvt_pk_f32_fp8((int)u.x, false), a1 = __builtin_amdgcn_cvt_pk_f32_fp8((int)u.x, true);
  const f32x2 b0 = __builtin_amdgcn_cvt_pk_f32_fp8((int)u.y, false), b1 = __builtin_amdgcn_cvt_pk_f32_fp8((int)u.y, true);
  const f32x2 c0 = __builtin_amdgcn_cvt_pk_f32_fp8((int)u.z, false), c1 = __builtin_amdgcn_cvt_pk_f32_fp8((int)u.z, true);
  const f32x2 d0 = __builtin_amdgcn_cvt_pk_f32_fp8((int)u.w, false), d1 = __builtin_amdgcn_cvt_pk_f32_fp8((int)u.w, true);
  float s0 = a0[0] * hv[0] + a0[1] * hv[1];
  float s1 = a1[0] * hv[2] + a1[1] * hv[3];
  s0 += b0[0] * hv[4] + b0[1] * hv[5];
  s1 += b1[0] * hv[6] + b1[1] * hv[7];
  s0 += c0[0] * hv[8] + c0[1] * hv[9];
  s1 += c1[0] * hv[10] + c1[1] * hv[11];
  s0 += d0[0] * hv[12] + d0[1] * hv[13];
  s1 += d1[0] * hv[14] + d1[1] * hv[15];
  return s0 + s1;
}
__device__ __forceinline__ void axpy16_f8(const uint4 v, const float wg, float* acc) {
  const f32x2 a0 = __builtin_amdgcn_cvt_pk_f32_fp8((int)v.x, false), a1 = __builtin_amdgcn_cvt_pk_f32_fp8((int)v.x, true);
  const f32x2 b0 = __builtin_amdgcn_cvt_pk_f32_fp8((int)v.y, false), b1 = __builtin_amdgcn_cvt_pk_f32_fp8((int)v.y, true);
  const f32x2 c0 = __builtin_amdgcn_cvt_pk_f32_fp8((int)v.z, false), c1 = __builtin_amdgcn_cvt_pk_f32_fp8((int)v.z, true);
  const f32x2 d0 = __builtin_amdgcn_cvt_pk_f32_fp8((int)v.w, false), d1 = __builtin_amdgcn_cvt_pk_f32_fp8((int)v.w, true);
  acc[0] += wg * a0[0]; acc[1] += wg * a0[1]; acc[2] += wg * a1[0]; acc[3] += wg * a1[1];
  acc[4] += wg * b0[0]; acc[5] += wg * b0[1]; acc[6] += wg * b1[0]; acc[7] += wg * b1[1];
  acc[8] += wg * c0[0]; acc[9] += wg * c0[1]; acc[10] += wg * c1[0]; acc[11] += wg * c1[1];
  acc[12] += wg * d0[0]; acc[13] += wg * d0[1]; acc[14] += wg * d1[0]; acc[15] += wg * d1[1];
}
__device__ __forceinline__ void d_peer(int item, const float* __restrict__ x1, const float* __restrict__ rs2,
                                       const float* __restrict__ g2, const int* __restrict__ idx,
                                       const float* __restrict__ gate, const unsigned* __restrict__ pu,
                                       const unsigned* __restrict__ pv, const float* __restrict__ su,
                                       const float* __restrict__ sv, const float* __restrict__ gf,
                                       float* __restrict__ out, float oscale) {
  int tid_ = threadIdx.x;
  asm volatile("" : "+v"(tid_));
  const int t = item * 4 + (tid_ >> 6);
  const int lane = tid_ & 63;
  float r2;
  {
    const float4* pr = (const float4*)(rs2 + (size_t)t * 16);
    const float4 s0 = pr[0], s1 = pr[1], s2 = pr[2], s3 = pr[3];
    const float ssq = ((s0.x + s0.y) + (s0.z + s0.w)) + ((s1.x + s1.y) + (s1.z + s1.w)) + ((s2.x + s2.y) + (s2.z + s2.w)) + ((s3.x + s3.y) + (s3.z + s3.w));
    r2 = rsqrtf(ssq * (1.f / DM) + EPSF);
  }
  float xv[16], hv[16], acc[16];
#pragma unroll
  for (int q = 0; q < 4; ++q) {
    const float4 xx = *(const float4*)(x1 + (size_t)t * DM + lane * 16 + q * 4);
    const float4 gg = *(const float4*)(g2 + lane * 16 + q * 4);
    xv[q * 4 + 0] = xx.x; xv[q * 4 + 1] = xx.y; xv[q * 4 + 2] = xx.z; xv[q * 4 + 3] = xx.w;
    hv[q * 4 + 0] = xx.x * r2 * gg.x; hv[q * 4 + 1] = xx.y * r2 * gg.y;
    hv[q * 4 + 2] = xx.z * r2 * gg.z; hv[q * 4 + 3] = xx.w * r2 * gg.w;
  }
#pragma unroll
  for (int i = 0; i < 16; ++i) acc[i] = 0.f;
  const int id_a = idx[(size_t)t * 128 + lane], id_b = idx[(size_t)t * 128 + 64 + lane];
  const float gt_a = gate[(size_t)t * 128 + lane], gt_b = gate[(size_t)t * 128 + 64 + lane];
  for (int e0 = 0; e0 < 128; e0 += 8) {
    uint4 u[8], v[8];
    float gt8[8], su8[8], sv8[8];
#pragma unroll
    for (int k = 0; k < 8; ++k) {
      const int e = e0 + k;
      const int id = (e0 < 64) ? __shfl(id_a, e, 64) : __shfl(id_b, e - 64, 64);
      gt8[k] = (e0 < 64) ? __shfl(gt_a, e, 64) : __shfl(gt_b, e - 64, 64);
      u[k] = *(const uint4*)(pu + (size_t)id * 256 + lane * 4);
      v[k] = *(const uint4*)(pv + (size_t)id * 256 + lane * 4);
      su8[k] = su[id];
      sv8[k] = sv[id];
    }
    float d[8];
#pragma unroll
    for (int k = 0; k < 8; ++k) d[k] = dot16_f8(u[k], hv);
#pragma unroll
    for (int o = 32; o > 0; o >>= 1) {
#pragma unroll
      for (int k = 0; k < 8; ++k) d[k] += __shfl_xor(d[k], o, 64);
    }
#pragma unroll
    for (int k = 0; k < 8; ++k) {
      const float dd = d[k] * su8[k];
      const float act = 0.5f * dd * (1.f + erf_fast(dd * 0.7071067811865476f));
      axpy16_f8(v[k], gt8[k] * act * sv8[k], acc);
    }
  }
  float ss = 0.f;
#pragma unroll
  for (int i = 0; i < 16; ++i) { acc[i] += xv[i]; ss += acc[i] * acc[i]; }
  ss = wave_sum(ss);
  const float sc = rsqrtf(ss * (1.f / DM) + EPSF) * oscale;
#pragma unroll
  for (int q = 0; q < 4; ++q) {
    const float4 gg = *(const float4*)(gf + lane * 16 + q * 4);
    float4 o;
    o.x = acc[q * 4 + 0] * sc * gg.x; o.y = acc[q * 4 + 1] * sc * gg.y;
    o.z = acc[q * 4 + 2] * sc * gg.z; o.w = acc[q * 4 + 3] * sc * gg.w;
    *(float4*)(out + (size_t)t * DM + lane * 16 + q * 4) = o;
  }
}

typedef __attribute__((ext_vector_type(16))) float f32x16;
#define MFMA32(a, b, c) __builtin_amdgcn_mfma_f32_32x32x16_bf16((a), (b), (c), 0, 0, 0)
__device__ __forceinline__ int crow(int reg, int hh) { return (reg & 3) + 8 * (reg >> 2) + 4 * hh; }

struct GdnBufs {
  unsigned short* qc;
  unsigned short* kTc;
  unsigned short* qkc;
  unsigned short* wn;
  unsigned short* uo;
  float* gsc;
};

__device__ __forceinline__ void tri_subst(const float* AL0, int lane, float (&T)[64]) {
  const float* AL = (const float*)__builtin_assume_aligned(AL0, 16);
#pragma unroll
  for (int i = 0; i < 64; ++i) T[i] = 0.f;
  T[0] = (lane == 0) ? 1.f : 0.f;
  float4 cur[16], nxt[16];
#pragma unroll
  for (int j4 = 0; j4 < 1; ++j4) cur[j4] = *(const float4*)(AL + 1 * 72 + 4 * j4);
#pragma unroll
  for (int i = 1; i < 64; ++i) {
    if (i + 1 < 64) {
#pragma unroll
      for (int j4 = 0; j4 < (i + 4) / 4; ++j4) nxt[j4] = *(const float4*)(AL + (i + 1) * 72 + 4 * j4);
    }
    float ax = 0.f, ay = 0.f, az = 0.f, aw = 0.f;
#pragma unroll
    for (int j4 = 0; j4 < (i + 3) / 4; ++j4) {
      ax += cur[j4].x * T[4 * j4]; ay += cur[j4].y * T[4 * j4 + 1]; az += cur[j4].z * T[4 * j4 + 2]; aw += cur[j4].w * T[4 * j4 + 3];
    }
    T[i] = ((lane == i) ? 1.f : 0.f) - ((ax + ay) + (az + aw));
#pragma unroll
    for (int j4 = 0; j4 < 16; ++j4) cur[j4] = nxt[j4];
  }
}

__device__ __forceinline__ void d_gdn_prep(int item, char* smem, const unsigned short* __restrict__ pm,
                                           const float* __restrict__ gt, const float* __restrict__ conv_w, GdnBufs G) {
  unsigned short* qL = (unsigned short*)smem;
  unsigned short* kL = qL + 64 * 144;
  unsigned short* kTL = kL + 64 * 144;
  unsigned short* vTL = kTL + 128 * 72;
  float* scal = (float*)(vTL + 128 * 72);
  float* A0 = (float*)qL;
  float* A1 = (float*)kL;
  int tid = threadIdx.x;
  asm volatile("" : "+v"(tid));
  const int lane = tid & 63, w = __builtin_amdgcn_readfirstlane(tid >> 6), r = lane & 31, hh = lane >> 5;
  const int bh = item >> 6, c = item & 63, b = bh >> 2, h = bh & 3;
  const int t0 = b * SEQ + c * 64;
  __syncthreads();
  {
#pragma unroll
    for (int sec = 0; sec < 3; ++sec) {
      const int c0 = sec * 512 + h * 128 + 2 * lane;
      float cw0[5], cw1[5];
#pragma unroll
      for (int j = 0; j < 5; ++j) { cw0[j] = conv_w[c0 * 5 + j]; cw1[j] = conv_w[(c0 + 1) * 5 + j]; }
      unsigned raw[20];
#pragma unroll
      for (int k = 0; k < 20; ++k) {
        const int sp = c * 64 + w * 16 + k - 2;
        raw[k] = (sp >= 0 && sp < SEQ) ? *(const unsigned*)(pm + ((size_t)t0 + w * 16 + k - 2) * 4096 + c0) : 0u;
      }
#pragma unroll
      for (int ii = 0; ii < 16; ++ii) {
        const int i = w * 16 + ii;
        float a0 = 0.f, a1 = 0.f;
#pragma unroll
        for (int j = 0; j < 5; ++j) {
          a0 += cw0[j] * bf2f((unsigned short)(raw[ii + j] & 0xffff));
          a1 += cw1[j] * __uint_as_float(raw[ii + j] & 0xffff0000u);
        }
        a0 = a0 * __builtin_amdgcn_rcpf(1.f + __builtin_amdgcn_exp2f(-1.4426950408889634f * a0));
        a1 = a1 * __builtin_amdgcn_rcpf(1.f + __builtin_amdgcn_exp2f(-1.4426950408889634f * a1));
        if (sec < 2) {
          const float ss = wave_sum_dpp(a0 * a0 + a1 * a1);
          float sc = rsqrtf(ss + EPSF);
          if (sec == 0) sc *= 0.08838834764831845f;
          a0 *= sc; a1 *= sc;
        }
        if (sec == 0) {
          *(unsigned*)(qL + i * 144 + 2 * lane) = pack2(a0, a1);
        } else if (sec == 1) {
          const unsigned pk = pack2(a0, a1);
          *(unsigned*)(kL + i * 144 + 2 * lane) = pk;
          kTL[(2 * lane) * 72 + i] = (unsigned short)(pk & 0xffff);
          kTL[(2 * lane + 1) * 72 + i] = (unsigned short)(pk >> 16);
        } else {
          const unsigned pk = pack2(a0, a1);
          vTL[(2 * lane) * 72 + i] = (unsigned short)(pk & 0xffff);
          vTL[(2 * lane + 1) * 72 + i] = (unsigned short)(pk >> 16);
        }
      }
    }
  }
  if (w == 0) {
    const float* gp = gt + ((size_t)t0 + lane) * 32;
    const float g0 = gp[h], g1 = gp[4 + h], b0 = gp[8 + h], b1 = gp[12 + h];
    float G0 = g0, G1 = g1;
#pragma unroll
    for (int o = 1; o < 64; o <<= 1) {
      const float v0 = __shfl_up(G0, o, 64);
      const float v1 = __shfl_down(G1, o, 64);
      if (lane >= o) G0 += v0;
      if (lane + o < 64) G1 += v1;
    }
    scal[lane] = G0 * 1.4426950408889634f; scal[64 + lane] = G1 * 1.4426950408889634f;
    scal[128 + lane] = b0; scal[192 + lane] = b1;
    const float GL0 = __shfl(G0, 63, 64), GL1 = __shfl(G1, 0, 64);
    float* gs0 = G.gsc + ((size_t)((bh * 2 + 0) * 64 + c)) * 192;
    float* gs1 = G.gsc + ((size_t)((bh * 2 + 1) * 64 + c)) * 192;
    gs0[lane] = expf(G0); gs0[64 + lane] = expf(GL0 - G0);
    gs1[lane] = expf(G1); gs1[64 + lane] = expf(GL1 - G1);
    if (lane == 0) { gs0[128] = expf(GL0); gs1[128] = expf(GL1); }
  }
  __syncthreads();
  {
    unsigned short* qg = G.qc + (size_t)item * 8192;
    unsigned short* kg = G.kTc + (size_t)item * 8192;
#pragma unroll
    for (int i = 0; i < 4; ++i) {
      const int id = tid + i * 256;
      *(uint4*)(qg + (id >> 4) * 128 + (id & 15) * 8) = *(const uint4*)(qL + (id >> 4) * 144 + (id & 15) * 8);
      *(uint4*)(kg + (id >> 3) * 64 + (id & 7) * 8) = *(const uint4*)(kTL + (id >> 3) * 72 + (id & 7) * 8);
    }
  }
  {
    const int ta = w >> 1, tb = w & 1;
    f32x16 acc, acc2;
#pragma unroll
    for (int i = 0; i < 16; ++i) { acc[i] = 0.f; acc2[i] = 0.f; }
#pragma unroll
    for (int s = 0; s < 8; ++s) {
      const bf16x8 a = *(const bf16x8*)(kL + (32 * ta + r) * 144 + 16 * s + 8 * hh);
      const bf16x8 bk = *(const bf16x8*)(kL + (32 * tb + r) * 144 + 16 * s + 8 * hh);
      const bf16x8 bq = *(const bf16x8*)(qL + (32 * tb + r) * 144 + 16 * s + 8 * hh);
      acc = MFMA32(a, bk, acc);
      acc2 = MFMA32(a, bq, acc2);
    }
    __syncthreads();
    {
      const int col = 32 * tb + r;
      const float G0c = scal[col], G1c = scal[64 + col];
#pragma unroll
      for (int reg = 0; reg < 16; ++reg) {
        const int row = 32 * ta + crow(reg, hh);
        const float v = acc[reg];
        const float a0 = (col < row) ? scal[128 + row] * v * __builtin_amdgcn_exp2f(scal[row] - G0c) : 0.f;
        const float a1 = (col > row) ? scal[192 + row] * v * __builtin_amdgcn_exp2f(scal[64 + row] - G1c) : 0.f;
        A0[row * 72 + col] = a0;
        A1[(63 - row) * 72 + (63 - col)] = a1;
      }
    }
    {
      const int i = 32 * tb + r;
      const float G0i = scal[i], G1i = scal[64 + i];
      unsigned short* qk0 = G.qkc + ((size_t)((bh * 2 + 0) * 64 + c)) * 4096;
      unsigned short* qk1 = G.qkc + ((size_t)((bh * 2 + 1) * 64 + c)) * 4096;
#pragma unroll
      for (int g = 0; g < 4; ++g) {
        float o0[4], o1[4];
#pragma unroll
        for (int e = 0; e < 4; ++e) {
          const int j = 32 * ta + 8 * g + 4 * hh + e;
          const float v = acc2[4 * g + e];
          o0[e] = (j <= i) ? v * __builtin_amdgcn_exp2f(G0i - scal[j]) : 0.f;
          o1[e] = (j >= i) ? v * __builtin_amdgcn_exp2f(G1i - scal[64 + j]) : 0.f;
        }
        uint2 p0, p1;
        p0.x = pack2(o0[0], o0[1]); p0.y = pack2(o0[2], o0[3]);
        p1.x = pack2(o1[0], o1[1]); p1.y = pack2(o1[2], o1[3]);
        *(uint2*)(qk0 + i * 64 + 32 * ta + 8 * g + 4 * hh) = p0;
        *(uint2*)(qk1 + i * 64 + 32 * ta + 8 * g + 4 * hh) = p1;
      }
    }
  }
  __syncthreads();
  if (w < 2) {
    const int dir = w;
    float T[64];
    tri_subst(A0 + dir * (64 * 72), lane, T);
    const int jn = dir ? 63 - lane : lane;
    const float sb = scal[128 + 64 * dir + jn];
    const float sbg = sb * __builtin_amdgcn_exp2f(scal[64 * dir + jn]);
    unsigned short* Tb = dir ? kL : qL;
    unsigned short* Tbg = Tb + 64 * 72;
#pragma unroll
    for (int ip = 0; ip < 64; ++ip) {
      const int in = dir ? 63 - ip : ip;
      Tb[in * 72 + jn] = f2bf(T[ip] * sb);
      Tbg[in * 72 + jn] = f2bf(T[ip] * sbg);
    }
  }
  __syncthreads();
#pragma unroll
  for (int d = 0; d < 2; ++d) {
    const int chain = bh * 2 + d;
    const unsigned short* Tb = d ? kL : qL;
    const unsigned short* Tbg = Tb + 64 * 72;
    unsigned short* wng = G.wn + ((size_t)(chain * 64 + c)) * 8192;
    unsigned short* uog = G.uo + ((size_t)(chain * 64 + c)) * 8192 + w * 2048;
#pragma unroll
    for (int tb = 0; tb < 2; ++tb) {
      f32x16 acc, acc2;
#pragma unroll
      for (int i = 0; i < 16; ++i) { acc[i] = 0.f; acc2[i] = 0.f; }
#pragma unroll
      for (int s = 0; s < 4; ++s) {
        const bf16x8 a = *(const bf16x8*)(kTL + (32 * w + r) * 72 + 16 * s + 8 * hh);
        const bf16x8 bb = *(const bf16x8*)(Tbg + (32 * tb + r) * 72 + 16 * s + 8 * hh);
        acc = MFMA32(a, bb, acc);
        const bf16x8 a2 = *(const bf16x8*)(Tb + (32 * tb + r) * 72 + 16 * s + 8 * hh);
        const bf16x8 b2 = *(const bf16x8*)(vTL + (32 * w + r) * 72 + 16 * s + 8 * hh);
        acc2 = MFMA32(a2, b2, acc2);
      }
#pragma unroll
      for (int g = 0; g < 4; ++g) {
        uint2 pk;
        pk.x = pack2(-acc[4 * g], -acc[4 * g + 1]); pk.y = pack2(-acc[4 * g + 2], -acc[4 * g + 3]);
        *(uint2*)(wng + (32 * tb + r) * 128 + 32 * w + 8 * g + 4 * hh) = pk;
      }
      uint4 u0, u1;
      u0.x = pack2(acc2[0], acc2[1]); u0.y = pack2(acc2[2], acc2[3]); u0.z = pack2(acc2[4], acc2[5]); u0.w = pack2(acc2[6], acc2[7]);
      u1.x = pack2(acc2[8], acc2[9]); u1.y = pack2(acc2[10], acc2[11]); u1.z = pack2(acc2[12], acc2[13]); u1.w = pack2(acc2[14], acc2[15]);
      *(uint4*)(uog + tb * 1024 + lane * 16) = u0;
      *(uint4*)(uog + tb * 1024 + lane * 16 + 8) = u1;
    }
  }
}

struct GdnOps {
  bf16x8 a[8];
  bf16x8 x[4];
  bf16x8 kt[4];
  float4 rs[4];
  float gtot;
};
__device__ __forceinline__ void gdn_load(GdnOps& o, const GdnBufs& G, int chain, int bh, int c, int sl, int w, int r, int hh, int lane) {
  const unsigned short* kT_c = G.kTc + ((size_t)(bh * 64 + c)) * 8192;
  const float* gs = G.gsc + ((size_t)(chain * 64 + c)) * 192;
  const int ti = w & 1;
#pragma unroll
  for (int s = 0; s < 4; ++s) o.kt[s] = *(const bf16x8*)(kT_c + (32 * w + r) * 64 + 16 * s + 8 * hh);
  o.gtot = gs[128];
  if (w < 2) {
    const unsigned short* wn_c = G.wn + ((size_t)(chain * 64 + c)) * 8192;
    const unsigned short* uo_c = G.uo + ((size_t)(chain * 64 + c)) * 8192 + sl * 2048;
#pragma unroll
    for (int s = 0; s < 8; ++s) o.a[s] = *(const bf16x8*)(wn_c + (32 * ti + r) * 128 + 16 * s + 8 * hh);
    o.x[0] = *(const bf16x8*)(uo_c + ti * 1024 + lane * 16);
    o.x[1] = *(const bf16x8*)(uo_c + ti * 1024 + lane * 16 + 8);
#pragma unroll
    for (int g = 0; g < 4; ++g) o.rs[g] = *(const float4*)(gs + 64 + 32 * ti + 8 * g + 4 * hh);
  } else {
    const unsigned short* q_c = G.qc + ((size_t)(bh * 64 + c)) * 8192;
    const unsigned short* qk_c = G.qkc + ((size_t)(chain * 64 + c)) * 4096;
#pragma unroll
    for (int s = 0; s < 8; ++s) o.a[s] = *(const bf16x8*)(q_c + (32 * ti + r) * 128 + 16 * s + 8 * hh);
#pragma unroll
    for (int s = 0; s < 4; ++s) o.x[s] = *(const bf16x8*)(qk_c + (32 * ti + r) * 64 + 16 * s + 8 * hh);
#pragma unroll
    for (int g = 0; g < 4; ++g) o.rs[g] = *(const float4*)(gs + 32 * ti + 8 * g + 4 * hh);
  }
}
__device__ __forceinline__ void gdn_step(const GdnOps& o, f32x16& S, unsigned short* ST, unsigned short* VT, unsigned short* VdT,
                                         unsigned short* uo_c, int w, int r, int hh) {
  const int ti = w & 1;
  f32x16 acc;
  if (w < 2) {
#pragma unroll
    for (int i = 0; i < 8; ++i) {
      acc[i] = bf2f((unsigned short)o.x[0][i]);
      acc[8 + i] = bf2f((unsigned short)o.x[1][i]);
    }
  } else {
#pragma unroll
    for (int i = 0; i < 16; ++i) acc[i] = 0.f;
  }
#pragma unroll
  for (int g = 0; g < 4; ++g) {
    uint2 pk;
    pk.x = pack2(S[4 * g], S[4 * g + 1]); pk.y = pack2(S[4 * g + 2], S[4 * g + 3]);
    *(uint2*)(ST + r * 136 + 32 * w + 8 * g + 4 * hh) = pk;
  }
  __syncthreads();
#pragma unroll
  for (int s = 0; s < 8; ++s) {
    const bf16x8 bs = *(const bf16x8*)(ST + r * 136 + 16 * s + 8 * hh);
    acc = MFMA32(o.a[s], bs, acc);
  }
  if (w < 2) {
#pragma unroll
    for (int g = 0; g < 4; ++g) {
      uint2 pk, pd;
      pk.x = pack2(acc[4 * g], acc[4 * g + 1]); pk.y = pack2(acc[4 * g + 2], acc[4 * g + 3]);
      pd.x = pack2(acc[4 * g] * o.rs[g].x, acc[4 * g + 1] * o.rs[g].y);
      pd.y = pack2(acc[4 * g + 2] * o.rs[g].z, acc[4 * g + 3] * o.rs[g].w);
      *(uint2*)(VT + r * 72 + 32 * ti + 8 * g + 4 * hh) = pk;
      *(uint2*)(VdT + r * 72 + 32 * ti + 8 * g + 4 * hh) = pd;
    }
  } else {
#pragma unroll
    for (int g = 0; g < 4; ++g) {
      acc[4 * g] *= o.rs[g].x; acc[4 * g + 1] *= o.rs[g].y; acc[4 * g + 2] *= o.rs[g].z; acc[4 * g + 3] *= o.rs[g].w;
    }
  }
  __syncthreads();
  if (w >= 2) {
#pragma unroll
    for (int s = 0; s < 4; ++s) {
      const bf16x8 bv = *(const bf16x8*)(VT + r * 72 + 16 * s + 8 * hh);
      acc = MFMA32(o.x[s], bv, acc);
    }
#pragma unroll
    for (int reg = 0; reg < 16; ++reg) uo_c[(32 * ti + crow(reg, hh)) * 32 + r] = f2bf(acc[reg]);
  }
#pragma unroll
  for (int i = 0; i < 16; ++i) S[i] *= o.gtot;
#pragma unroll
  for (int s = 0; s < 4; ++s) {
    const bf16x8 bv = *(const bf16x8*)(VdT + r * 72 + 16 * s + 8 * hh);
    S = MFMA32(o.kt[s], bv, S);
  }
}
__device__ __forceinline__ void d_gdn_scan(int chain, int sl, char* smem, GdnBufs G) {
  unsigned short* ST = (unsigned short*)smem;
  unsigned short* VT = ST + 32 * 136;
  unsigned short* VdT = VT + 32 * 72;
  const int tid = threadIdx.x, lane = tid & 63, w = __builtin_amdgcn_readfirstlane(tid >> 6), r = lane & 31, hh = lane >> 5;
  const int bh = chain >> 1, dir = chain & 1;
  f32x16 S;
#pragma unroll
  for (int i = 0; i < 16; ++i) S[i] = 0.f;
  GdnOps A, B;
  gdn_load(A, G, chain, bh, dir ? 63 : 0, sl, w, r, hh, lane);
  for (int step = 0; step < 64; step += 2) {
    const int c0 = dir ? 63 - step : step;
    const int c1 = dir ? c0 - 1 : c0 + 1;
    const int c2 = dir ? c0 - 2 : c0 + 2;
    gdn_load(B, G, chain, bh, c1, sl, w, r, hh, lane);
    gdn_step(A, S, ST, VT, VdT, G.uo + ((size_t)(chain * 64 + c0)) * 8192 + sl * 2048, w, r, hh);
    if (step + 2 < 64) gdn_load(A, G, chain, bh, c2, sl, w, r, hh, lane);
    gdn_step(B, S, ST, VT, VdT, G.uo + ((size_t)(chain * 64 + c1)) * 8192 + sl * 2048, w, r, hh);
  }
}

__device__ __forceinline__ void d_ml_gates(int item, const float* __restrict__ gt, float* __restrict__ pre, float* __restrict__ gtots) {
  const int wv = item * 4 + (threadIdx.x >> 6);
  const int lane = threadIdx.x & 63;
  const int chain = wv >> 6, c = wv & 63;
  const int bh = chain >> 1, dir = chain & 1, b = bh >> 2, h = bh & 3;
  const size_t t0 = (size_t)b * SEQ + c * 64;
  const float lf = gt[(t0 + lane) * 32 + 24 + dir * 4 + h];
  const float ip = gt[(t0 + lane) * 32 + 16 + dir * 4 + h];
  float bc = lf;
#pragma unroll
  for (int ofs = 1; ofs < 64; ofs <<= 1) {
    const float vu = __shfl_up(bc, ofs, 64);
    const float vd = __shfl_down(bc, ofs, 64);
    if (dir == 0) { if (lane >= ofs) bc += vu; } else { if (lane + ofs < 64) bc += vd; }
  }
  const float b_last = __shfl(bc, dir ? 0 : 63, 64);
  float4 o;
  o.x = expf(bc);
  o.y = (ip - bc) * 1.4426950408889634f - 3.5f;
  o.z = bc * 1.4426950408889634f;
  o.w = 0.08838834764831845f * expf(b_last - bc + ip);
  *(float4*)(pre + ((size_t)chain * SEQ + c * 64 + lane) * 4) = o;
  if (lane == 0) gtots[wv] = expf(b_last);
}

#define ML_LDK(R, I, T0) R = *(const uint4*)(pm + ((T0) + ((t128 + (I) * 128) >> 4)) * 4096 + 2560 + h * 128 + (t128 & 15) * 8);
#define ML_STK(R, I) *(uint4*)(kLb + ((t128 + (I) * 128) >> 4) * 136 + (t128 & 15) * 8) = R;
#define ML_LOAD(T0)                                                                                         \
  {                                                                                                         \
    ML_LDK(pk0, 0, T0) ML_LDK(pk1, 1, T0) ML_LDK(pk2, 2, T0) ML_LDK(pk3, 3, T0)                             \
    ML_LDK(pk4, 4, T0) ML_LDK(pk5, 5, T0) ML_LDK(pk6, 6, T0) ML_LDK(pk7, 7, T0)                             \
    pv0 = *(const uint4*)(pm + ((T0) + (t128 >> 2)) * 4096 + 3072 + h * 128 + sl * 32 + (t128 & 3) * 8);    \
    pv1 = *(const uint4*)(pm + ((T0) + ((t128 + 128) >> 2)) * 4096 + 3072 + h * 128 + sl * 32 + (t128 & 3) * 8); \
    pgl = *(const float4*)(pre + ((size_t)chain * SEQ + ((T0) - tb) + lane) * 4);                           \
    pgt = gtots[chain * 64 + (int)(((T0) - tb) >> 6)];                                                      \
  }
#define ML_PUTV(W, E)                                                                                       \
  {                                                                                                         \
    const unsigned short lo_ = (unsigned short)((W) & 0xffff), hi_ = (unsigned short)((W) >> 16);           \
    vTb[(d8_ + (E)) * 72 + tok_] = lo_;                                                                     \
    vTb[(d8_ + (E) + 1) * 72 + tok_] = hi_;                                                                 \
    const unsigned sc_ = pack2(bf2f(lo_) * dj_, bf2f(hi_) * dj_);                                           \
    vdb[(d8_ + (E)) * 72 + tok_] = (unsigned short)(sc_ & 0xffff);                                          \
    vdb[(d8_ + (E) + 1) * 72 + tok_] = (unsigned short)(sc_ >> 16);                                         \
  }
#define ML_STAGE(BUF)                                                                                       \
  {                                                                                                         \
    unsigned short* kLb = kL + (BUF) * (64 * 136);                                                          \
    unsigned short* vTb = vTL + (BUF) * (32 * 72);                                                          \
    unsigned short* vdb = vdTL + (BUF) * (32 * 72);                                                         \
    float* scb = scal + (BUF) * 208;                                                                        \
    if (w == 2) {                                                                                           \
      scb[lane] = pgl.x; scb[64 + lane] = pgl.y; scb[128 + lane] = pgl.z;                                   \
      dL[(BUF) * 72 + lane] = f2bf(pgl.w);                                                                  \
      if (lane == 0) scb[192] = pgt;                                                                        \
    }                                                                                                       \
    ML_STK(pk0, 0) ML_STK(pk1, 1) ML_STK(pk2, 2) ML_STK(pk3, 3) ML_STK(pk4, 4) ML_STK(pk5, 5) ML_STK(pk6, 6) ML_STK(pk7, 7) \
    {                                                                                                       \
      const int tok_ = t128 >> 2, d8_ = (t128 & 3) * 8;                                                     \
      const float dj_ = __shfl(pgl.w, tok_, 64);                                                            \
      ML_PUTV(pv0.x, 0); ML_PUTV(pv0.y, 2); ML_PUTV(pv0.z, 4); ML_PUTV(pv0.w, 6);                           \
    }                                                                                                       \
    {                                                                                                       \
      const int tok_ = (t128 + 128) >> 2, d8_ = (t128 & 3) * 8;                                             \
      const float dj_ = __shfl(pgl.w, tok_, 64);                                                            \
      ML_PUTV(pv1.x, 0); ML_PUTV(pv1.y, 2); ML_PUTV(pv1.z, 4); ML_PUTV(pv1.w, 6);                           \
    }                                                                                                       \
  }
__device__ __forceinline__ void ml_state_image(const f32x16& S0, const f32x16& S1, unsigned short* S0T, unsigned short* nL, int w, int r, int hh) {
#pragma unroll
  for (int g = 0; g < 4; ++g) {
    uint2 pk;
    pk.x = pack2(S0[4 * g], S0[4 * g + 1]); pk.y = pack2(S0[4 * g + 2], S0[4 * g + 3]);
    *(uint2*)(S0T + r * 136 + 32 * w + 8 * g + 4 * hh) = pk;
    if (r == 0) {
      uint2 pn;
      pn.x = pack2(S1[4 * g], S1[4 * g + 1]); pn.y = pack2(S1[4 * g + 2], S1[4 * g + 3]);
      *(uint2*)(nL + 32 * w + 8 * g + 4 * hh) = pn;
    }
  }
}
__device__ __forceinline__ void ml_state_update(f32x16& S0, f32x16& S1, const unsigned short* kLb, const unsigned short* vdb,
                                                const unsigned short* dLb, float gtot, int w, int r, int hh) {
#pragma unroll
  for (int i = 0; i < 16; ++i) { S0[i] *= gtot; S1[i] *= gtot; }
#pragma unroll
  for (int s2 = 0; s2 < 4; ++s2) {
    union { bf16x8 v; unsigned short e[8]; } a;
#pragma unroll
    for (int e = 0; e < 8; ++e) a.e[e] = kLb[(16 * s2 + 8 * hh + e) * 136 + 32 * w + r];
    const bf16x8 bv = *(const bf16x8*)(vdb + r * 72 + 16 * s2 + 8 * hh);
    const bf16x8 bd = *(const bf16x8*)(dLb + 16 * s2 + 8 * hh);
    S0 = MFMA32(a.v, bv, S0);
    S1 = MFMA32(a.v, bd, S1);
  }
}
__device__ __forceinline__ void d_mlstm_scan(int chain, int sl, char* smem, const unsigned short* __restrict__ pm,
                                             const float* __restrict__ pre, const float* __restrict__ gtots,
                                             unsigned short* __restrict__ oM, int ntok) {
  unsigned short* kL = (unsigned short*)smem;
  unsigned short* vTL = kL + 2 * 64 * 136;
  unsigned short* vdTL = vTL + 2 * 32 * 72;
  unsigned short* dL = vdTL + 2 * 32 * 72;
  unsigned short* S0T = dL + 256;
  unsigned short* nL = S0T + 32 * 136;
  float* scal = (float*)(nL + 256);
  int tid = threadIdx.x;
  asm volatile("" : "+v"(tid));
  const int lane = tid & 63, w = __builtin_amdgcn_readfirstlane(tid >> 6), r = lane & 31, hh = lane >> 5;
  const int bh = chain >> 1, dir = chain & 1, b = bh >> 2, h = bh & 3;
  f32x16 S0, S1;
#pragma unroll
  for (int i = 0; i < 16; ++i) { S0[i] = 0.f; S1[i] = 0.f; }
  unsigned short* oMb = oM + (size_t)dir * ntok * 512 + h * 128 + sl * 32;
  const size_t tb = (size_t)b * SEQ;
  __syncthreads();
  ml_state_image(S0, S1, S0T, nL, w, r, hh);
  if (w >= 2) {
    const int t128 = tid - 128;
    uint4 pk0, pk1, pk2, pk3, pk4, pk5, pk6, pk7, pv0, pv1;
    float4 pgl;
    float pgt;
    ML_LOAD(tb + (dir ? 63 : 0) * 64);
    ML_STAGE(0);
    ML_LOAD(tb + (dir ? 62 : 1) * 64);
    for (int step = 0; step < 64; ++step) {
      const int c0 = dir ? 63 - step : step;
      const int c2 = dir ? c0 - 2 : c0 + 2;
      const int buf = step & 1;
      __syncthreads();
      const float gtot = scal[buf * 208 + 192];
      ML_STAGE(buf ^ 1);
      {
        const int cl = (step + 2 < 64) ? c2 : c0;
        ML_LOAD(tb + cl * 64);
      }
      ml_state_update(S0, S1, kL + buf * (64 * 136), vdTL + buf * (32 * 72), dL + buf * 72, gtot, w, r, hh);
      __syncthreads();
      ml_state_image(S0, S1, S0T, nL, w, r, hh);
    }
  } else {
    bf16x8 ones;
#pragma unroll
    for (int i = 0; i < 8; ++i) ones[i] = (short)0x3F80;
    const int ti = w;
    const int icol = 32 * ti + r;
    float dmask[16];
#pragma unroll
    for (int reg = 0; reg < 16; ++reg) {
      const int jl = crow(reg, hh);
      dmask[reg] = (dir ? (jl >= r) : (jl <= r)) ? 1.f : 0.f;
    }
    bf16x8 qf[8];
    {
      const unsigned short* qp = pm + (tb + (size_t)(dir ? 63 : 0) * 64 + 32 * ti + r) * 4096 + 2048 + h * 128 + 8 * hh;
#pragma unroll
      for (int s2 = 0; s2 < 8; ++s2) qf[s2] = *(const bf16x8*)(qp + 16 * s2);
    }
    for (int step = 0; step < 64; ++step) {
      const int c0 = dir ? 63 - step : step;
      const int c1 = dir ? c0 - 1 : c0 + 1;
      const int buf = step & 1;
      const unsigned short* kLb = kL + buf * (64 * 136);
      const unsigned short* vTb = vTL + buf * (32 * 72);
      const float* scb = scal + buf * 208;
      __syncthreads();
      const float bci = scb[128 + icol];
      const float gtot = scb[192];
      f32x16 Q0, Q1;
#pragma unroll
      for (int i = 0; i < 16; ++i) { Q0[i] = 0.f; Q1[i] = 0.f; }
#pragma unroll
      for (int s2 = 0; s2 < 8; ++s2) {
        const bf16x8 b0 = *(const bf16x8*)(S0T + r * 136 + 16 * s2 + 8 * hh);
        const bf16x8 b1 = *(const bf16x8*)(nL + 16 * s2 + 8 * hh);
        Q0 = MFMA32(qf[s2], b0, Q0);
        Q1 = MFMA32(qf[s2], b1, Q1);
      }
#pragma unroll
      for (int g = 0; g < 4; ++g) {
        const float4 e4 = *(const float4*)(scb + 32 * ti + 8 * g + 4 * hh);
        Q0[4 * g] *= e4.x; Q0[4 * g + 1] *= e4.y; Q0[4 * g + 2] *= e4.z; Q0[4 * g + 3] *= e4.w;
        Q1[4 * g] *= e4.x; Q1[4 * g + 1] *= e4.y; Q1[4 * g + 2] *= e4.z; Q1[4 * g + 3] *= e4.w;
      }
#pragma unroll
      for (int tj = 0; tj < 2; ++tj) {
        if (dir ? (tj < ti) : (tj > ti)) continue;
        f32x16 X;
#pragma unroll
        for (int i = 0; i < 16; ++i) X[i] = 0.f;
#pragma unroll
        for (int s2 = 0; s2 < 8; ++s2) {
          const bf16x8 a = *(const bf16x8*)(kLb + (32 * tj + r) * 136 + 16 * s2 + 8 * hh);
          X = MFMA32(a, qf[s2], X);
        }
        if (tj == ti) {
#pragma unroll
          for (int g = 0; g < 4; ++g) {
            const float4 cj4 = *(const float4*)(scb + 64 + 32 * tj + 8 * g + 4 * hh);
            X[4 * g + 0] *= __builtin_amdgcn_exp2f(fminf(bci + cj4.x, 80.f)) * dmask[4 * g + 0];
            X[4 * g + 1] *= __builtin_amdgcn_exp2f(fminf(bci + cj4.y, 80.f)) * dmask[4 * g + 1];
            X[4 * g + 2] *= __builtin_amdgcn_exp2f(fminf(bci + cj4.z, 80.f)) * dmask[4 * g + 2];
            X[4 * g + 3] *= __builtin_amdgcn_exp2f(fminf(bci + cj4.w, 80.f)) * dmask[4 * g + 3];
          }
        } else {
#pragma unroll
          for (int g = 0; g < 4; ++g) {
            const float4 cj4 = *(const float4*)(scb + 64 + 32 * tj + 8 * g + 4 * hh);
            X[4 * g + 0] *= __builtin_amdgcn_exp2f(bci + cj4.x);
            X[4 * g + 1] *= __builtin_amdgcn_exp2f(bci + cj4.y);
            X[4 * g + 2] *= __builtin_amdgcn_exp2f(bci + cj4.z);
            X[4 * g + 3] *= __builtin_amdgcn_exp2f(bci + cj4.w);
          }
        }
#pragma unroll
        for (int s2 = 0; s2 < 2; ++s2) {
          union { bf16x8 v; unsigned u[4]; } xa, bv;
          xa.u[0] = pack2(X[8 * s2 + 0], X[8 * s2 + 1]); xa.u[1] = pack2(X[8 * s2 + 2], X[8 * s2 + 3]);
          xa.u[2] = pack2(X[8 * s2 + 4], X[8 * s2 + 5]); xa.u[3] = pack2(X[8 * s2 + 6], X[8 * s2 + 7]);
          const uint2 v0 = *(const uint2*)(vTb + r * 72 + 32 * tj + 16 * s2 + 4 * hh);
          const uint2 v1 = *(const uint2*)(vTb + r * 72 + 32 * tj + 16 * s2 + 8 + 4 * hh);
          bv.u[0] = v0.x; bv.u[1] = v0.y; bv.u[2] = v1.x; bv.u[3] = v1.y;
          Q0 = MFMA32(xa.v, bv.v, Q0);
          Q1 = MFMA32(xa.v, ones, Q1);
        }
      }
      {
        const int cn = (step + 1 < 64) ? c1 : c0;
        const unsigned short* qp = pm + (tb + (size_t)cn * 64 + 32 * ti + r) * 4096 + 2048 + h * 128 + 8 * hh;
#pragma unroll
        for (int s2 = 0; s2 < 8; ++s2) qf[s2] = *(const bf16x8*)(qp + 16 * s2);
      }
      const size_t orow0 = tb + c0 * 64;
#pragma unroll
      for (int reg = 0; reg < 16; ++reg) {
        const int i = 32 * ti + crow(reg, hh);
        oMb[(orow0 + i) * 512 + r] = f2bf(Q0[reg] * __builtin_amdgcn_rcpf(fmaxf(fabsf(Q1[reg]), 1.f)));
      }
      ml_state_update(S0, S1, kLb, vdTL + buf * (32 * 72), dL + buf * 72, gtot, w, r, hh);
      __syncthreads();
      ml_state_image(S0, S1, S0T, nL, w, r, hh);
    }
  }
}

struct MKP {
  const float *x, *norm1_g, *w_in, *conv_w, *a_log, *dt_bias, *gdn_g, *i_bias, *f_bias, *ml_g, *w_out, *norm2_g, *peer_wq,
      *peer_keys, *peer_u, *peer_v, *normf_g;
  float* out;
  unsigned short *pm, *x1b, *woutT, *mt, *xb, *winT, *oM, *yb, *scores, *qkv_dbg, *oA_dbg;
  unsigned *utab, *vtab;
  unsigned short *wqb, *keyb;
  float *uscale, *vscale;
  float *x1, *rs1, *rs2, *gt, *gateb, *dbg, *mlpre, *mlgt;
  unsigned* bar;
  int* idxb;
  GdnBufs G;
};

constexpr int SMEM_BYTES = 74752;
__global__ void __launch_bounds__(256, 2) k_mega(MKP P) {
  __shared__ __attribute__((aligned(16))) char smem_c[SMEM_BYTES + 16];
  {
    volatile LAS unsigned* st0 = (volatile LAS unsigned*)(smem_c + SMEM_BYTES);
    if (threadIdx.x < 4) st0[threadIdx.x] = 0u;
  }
  __syncthreads();
  XcdBarrier xb = xcd_barrier_post(P.bar, (volatile LAS unsigned*)(smem_c + SMEM_BYTES));
  unsigned short* smem = (unsigned short*)smem_c;
  const int nb = gridDim.x, bid = blockIdx.x;
  for (int it = bid; it < NT / 4; it += nb) d_prep_x(it, P.x, P.xb, P.rs1);
  for (int it = bid; it < 16 * 66; it += nb) d_transpose_w(it, 66, (float*)smem_c, P.w_in, DIN, P.norm1_g, P.winT, 1);
  for (int it = bid; it < 16 * 16; it += nb) d_transpose_w(it, 16, (float*)smem_c, P.w_out, 1024, nullptr, P.woutT, 0);
  for (int it = bid; it < 1024; it += nb) d_cvt_bf16(it, P.peer_wq, P.wqb, P.norm2_g, 11);
  for (int it = bid; it < 128; it += nb) d_cvt_bf16(it, P.peer_keys, P.keyb, nullptr, 0);
  if (bid == 0 && threadIdx.x < 4) P.dbg[threadIdx.x] = 0.f;
  xcd_barrier(xb);
  {
    GemmP p{};
    p.A = P.xb; p.lda = DM; p.Bt = P.winT; p.ldb = DM; p.K = DM;
    p.rowscale = P.rs1; p.obf = P.pm; p.ldo = 4096; p.of32 = P.gt; p.ldf = 32; p.resid = nullptr;
    p.a_log = P.a_log; p.dt_bias = P.dt_bias; p.i_bias = P.i_bias; p.f_bias = P.f_bias;
    for (int k = 0;; ++k) {
      int tm, tn;
      if (!xcd_tile(bid, nb, k, 33, tm, tn)) break;
      gemm_tile<EPI_INPROJ>(p, tm, tn, smem);
      __syncthreads();
    }
  }
  for (int tile = bid; tile < 16 * 8; tile += nb) {
    const int hp = tile >> 3, tn = tile & 7;
    GemmP p{};
    p.A = P.keyb + (size_t)hp * 128 * 128; p.lda = 128; p.Bt = P.wqb + hp * 128; p.ldb = 2048; p.K = 128;
    p.obf = P.mt + (size_t)hp * 128 * DM; p.ldo = DM;
    gemm_tile<EPI_PLAIN>(p, 0, tn, smem);
    __syncthreads();
  }
  xcd_barrier(xb);
  for (int it = bid; it < 512; it += nb) d_ml_gates(it, P.gt, P.mlpre, P.mlgt);
  for (int it = bid; it < 1024; it += nb) d_gdn_prep(it, smem_c, P.pm, P.gt, P.conv_w, P.G);
  xcd_barrier(xb);
  if (bid < 128) {
    d_gdn_scan(bid >> 2, bid & 3, smem_c, P.G);
  } else if (bid < 256) {
    d_mlstm_scan((bid - 128) >> 2, (bid - 128) & 3, smem_c, P.pm, P.mlpre, P.mlgt, P.oM, NT);
  }
#ifdef DBG_CHECK
  if (bid < 4) {
    __syncthreads();
    const int half = threadIdx.x >> 7;
    float* sq = (float*)smem + half * 256;
    float* sk = sq + 128;
    d_mlstm_rec(bid * 2 + half, sq, sk, P.pm, P.gt, P.oA_dbg, 4096);
  }
#endif
  xcd_barrier(xb);
  for (int it = bid; it < NT / 4; it += nb) d_combine(it, P.G.uo, P.oM, P.pm, P.gdn_g, P.ml_g, P.yb);
#ifdef DBG_CHECK
  for (int it = bid; it < 4096 / 4; it += nb) d_dbg_cmp_m(it, P.oM, P.oA_dbg, P.dbg);
#endif
  xcd_barrier(xb);
  {
    GemmP p{};
    p.A = P.yb; p.lda = DM; p.Bt = P.woutT; p.ldb = DM; p.K = DM;
    p.rowscale = nullptr; p.obf = P.x1b; p.ldo = DM; p.of32 = P.x1; p.ldf = DM; p.resid = P.x; p.rowacc = P.rs2;
    for (int k = 0;; ++k) {
      int tm, tn;
      if (!xcd_tile(bid, nb, k, 8, tm, tn)) break;
      gemm_tile<EPI_OUTPROJ>(p, tm, tn, smem);
      __syncthreads();
    }
  }
  for (int it = bid; it < 4096; it += nb) { d_cvt_tab(it, P.peer_u, P.utab, P.uscale); d_cvt_tab(it, P.peer_v, P.vtab, P.vscale); }
  xcd_barrier(xb);
  {
    GemmP p{};
    p.A = P.x1b; p.lda = DM; p.Bt = P.mt; p.ldb = DM; p.K = DM;
    p.rowscale = P.rs2; p.obf = P.scores; p.ldo = 2048; p.of32 = nullptr; p.ldf = 0; p.resid = nullptr;
    for (int k = 0;; ++k) {
      int tm, tn;
      if (!xcd_tile(bid, nb, k, 16, tm, tn)) break;
      gemm_tile<EPI_SCORES>(p, tm, tn, smem);
      __syncthreads();
    }
  }
  xcd_barrier(xb);
  float oscale = 1.f;
#ifdef DBG_CHECK
  {
    const float sd = __hip_atomic_load(&P.dbg[0], __ATOMIC_RELAXED, __HIP_MEMORY_SCOPE_AGENT);
    const float sr = __hip_atomic_load(&P.dbg[1], __ATOMIC_RELAXED, __HIP_MEMORY_SCOPE_AGENT);
    oscale = 1.f + sqrtf(sd / sr);
  }
#endif
  for (int it = bid; it < NT / 32; it += nb) {
    d_topk(it, P.scores, P.idxb, P.gateb);
    __threadfence_block();
    __syncthreads();
#pragma unroll 1
    for (int sub = 0; sub < 8; ++sub)
      d_peer(it * 8 + sub, P.x1, P.rs2, P.norm2_g, P.idxb, P.gateb, P.utab, P.vtab, P.uscale, P.vscale, P.normf_g, P.out, oscale);
  }
}

extern "C" void kernel_launch(void* const* d_in, const int* in_sizes, int n_in, void* d_out, int out_size, void* d_ws,
                              size_t ws_size, hipStream_t stream) {
  MKP P{};
  P.x = (const float*)d_in[0];
  P.norm1_g = (const float*)d_in[1];
  P.w_in = (const float*)d_in[2];
  P.conv_w = (const float*)d_in[3];
  P.a_log = (const float*)d_in[4];
  P.dt_bias = (const float*)d_in[5];
  P.gdn_g = (const float*)d_in[6];
  P.i_bias = (const float*)d_in[7];
  P.f_bias = (const float*)d_in[8];
  P.ml_g = (const float*)d_in[9];
  P.w_out = (const float*)d_in[10];
  P.norm2_g = (const float*)d_in[11];
  P.peer_wq = (const float*)d_in[12];
  P.peer_keys = (const float*)d_in[13];
  P.peer_u = (const float*)d_in[14];
  P.peer_v = (const float*)d_in[15];
  P.normf_g = (const float*)d_in[16];
  P.out = (float*)d_out;

  char* ws = (char*)d_ws;
  const size_t MB = 1024 * 1024;
  P.pm = (unsigned short*)(ws);
  P.x1 = (float*)(ws);
  P.x1b = (unsigned short*)(ws + 64 * MB);
  P.utab = (unsigned*)(ws + 96 * MB);
  P.vtab = (unsigned*)(ws + 112 * MB);
  P.uscale = (float*)(ws + 136 * MB);
  P.vscale = (float*)(ws + 136 * MB + 65536);
  char* rb = ws + 128 * MB;
  P.woutT = (unsigned short*)(rb);
  P.mt = (unsigned short*)(rb + 2 * MB);
  P.rs1 = (float*)(rb + 6 * MB);
  P.rs2 = (float*)(rb + 7 * MB);
  P.dbg = (float*)(rb + 6 * MB + 131072);
  P.bar = (unsigned*)(rb + 6 * MB + 196608);
  P.gt = (float*)(rb + 9 * MB);
  char* dyn = rb + 11 * MB;
  P.xb = (unsigned short*)(dyn);
  P.winT = (unsigned short*)(dyn + 32 * MB);
  P.wqb = (unsigned short*)(dyn + 41 * MB);
  P.keyb = (unsigned short*)(dyn + 45 * MB);
  P.G.qc = (unsigned short*)(dyn);
  P.G.kTc = (unsigned short*)(dyn + 16 * MB);
  P.G.qkc = (unsigned short*)(dyn + 32 * MB);
  P.G.wn = (unsigned short*)(dyn + 48 * MB);
  P.G.uo = (unsigned short*)(dyn + 80 * MB);
  P.G.gsc = (float*)(dyn + 112 * MB);
  P.mlpre = (float*)(dyn + 114 * MB);
  P.mlgt = (float*)(dyn + 116 * MB);
  P.yb = (unsigned short*)(dyn);
  P.scores = (unsigned short*)(dyn);
  P.idxb = (int*)(dyn + 64 * MB);
  P.gateb = (float*)(dyn + 72 * MB);
  char* os = (char*)d_out;
  P.oM = (unsigned short*)(os);
  P.qkv_dbg = (unsigned short*)(os + 32 * MB);
  P.oA_dbg = (unsigned short*)(os + 44 * MB);

  static int grid_blocks = 0;
  if (!grid_blocks) {
    int dev = 0, cus = 0, per_cu = 0;
    (void)hipGetDevice(&dev);
    (void)hipDeviceGetAttribute(&cus, hipDeviceAttributeMultiprocessorCount, dev);
    (void)hipOccupancyMaxActiveBlocksPerMultiprocessor(&per_cu, k_mega, 256, 0);
    if (per_cu > 2) per_cu = 2;
    if (per_cu < 1) per_cu = 1;
    grid_blocks = cus * per_cu;
  }
  (void)hipMemsetAsync(P.bar, 0, XCD_BAR_WORDS * sizeof(unsigned), stream);
  hipLaunchKernelGGL(k_mega, dim3(grid_blocks), dim3(256), 0, stream, P);
}
```

```cpp
#include <hip/hip_runtime.h>
#include <hip/hip_bf16.h>
#include <stdint.h>
#include <cstdio>

#define XB_TMO      128
#define XB_XCNT(j)  (256  + 64 * (j))
#define XB_XSUB(j)  (1280 + 64 * (j))
#define XB_XGEN(j)  (2304 + 64 * (j))
#define XB_TOP      3328
#define XB_TOPGEN   3392
#define XCD_BAR_WORDS 3456
#define XB_SPIN_CAP (1u << 18)
#define LAS __attribute__((address_space(3)))

__device__ __forceinline__ unsigned xb_ld(unsigned* p)              { return __hip_atomic_load(p, __ATOMIC_RELAXED, __HIP_MEMORY_SCOPE_AGENT); }
__device__ __forceinline__ unsigned xb_add(unsigned* p, unsigned v) { return __hip_atomic_fetch_add(p, v, __ATOMIC_RELAXED, __HIP_MEMORY_SCOPE_AGENT); }
__device__ __forceinline__ unsigned xb_xcc_id() { return (unsigned)__builtin_amdgcn_s_getreg((3 << 11) | 20) & 0xFu; }
#define XB_SPIN(cond, bar) do { unsigned _sp = 0; while (cond) { __builtin_amdgcn_s_sleep(1); \
    if ((++_sp & 255u) == 0u) { if (xb_ld(&(bar)[XB_TMO])) break; if (_sp > XB_SPIN_CAP) { atomicAdd(&(bar)[XB_TMO], 1u); break; } } } } while (0)

struct XcdBarrier {
    unsigned* bar; unsigned x;
    volatile LAS unsigned* st;
};

__device__ __forceinline__ XcdBarrier xcd_barrier_post(unsigned* bar, volatile LAS unsigned* st) {
    XcdBarrier b; b.bar = bar; b.x = xb_xcc_id(); b.st = st;
    if (threadIdx.x == 0) (void)xb_add(&bar[XB_XCNT(b.x)], 1u);
    return b;
}
__device__ __forceinline__ void xcd_barrier_complete(unsigned* bar, unsigned x, unsigned& nloc, unsigned& nx) {
    const unsigned G = gridDim.x * gridDim.y * gridDim.z;
    unsigned sum, cnt, mine, sp = 0u;
    for (;;) {
        sum = 0u; cnt = 0u; mine = 0u;
#pragma unroll
        for (unsigned j = 0; j < 16; ++j) { const unsigned c = xb_ld(&bar[XB_XCNT(j)]); sum += c; cnt += (c > 0u) ? 1u : 0u; mine = (j == x) ? c : mine; }
        if (sum == G) break;
        __builtin_amdgcn_s_sleep(1);
        if ((++sp & 255u) == 0u) { if (xb_ld(&bar[XB_TMO])) break; if (sp > XB_SPIN_CAP) { atomicAdd(&bar[XB_TMO], 1u); break; } }
    }
    nloc = mine > 0u ? mine : 1u; nx = cnt > 0u ? cnt : 1u;
}

__device__ __forceinline__ void xcd_barrier(const XcdBarrier& b) {
    asm volatile("s_waitcnt vmcnt(0)" ::: "memory");
    __syncthreads();
    if (threadIdx.x == 0) {
        unsigned* bar = b.bar;
        __builtin_amdgcn_s_waitcnt(0);
        unsigned nloc = b.st[0], nx = b.st[1];
        if (nloc == 0u) { xcd_barrier_complete(bar, b.x, nloc, nx); b.st[0] = nloc; b.st[1] = nx; }
        const unsigned old = xb_add(&bar[XB_XSUB(b.x)], 1u);
        const unsigned gen = old / nloc;
        if (old + 1u == (gen + 1u) * nloc) {
            __builtin_amdgcn_fence(__ATOMIC_RELEASE, "agent");
            asm volatile("s_waitcnt vmcnt(0)" ::: "memory");
            const unsigned og = xb_add(&bar[XB_TOP], 1u);
            const unsigned tg = og / nx;
            if (og + 1u == (tg + 1u) * nx) xb_add(&bar[XB_TOPGEN], 1u);
            else XB_SPIN(xb_ld(&bar[XB_TOPGEN]) == tg, bar);
            __builtin_amdgcn_fence(__ATOMIC_ACQUIRE, "agent");
            xb_add(&bar[XB_XGEN(b.x)], 1u);
            asm volatile("s_waitcnt vmcnt(0)" ::: "memory");
        } else {
            XB_SPIN(xb_ld(&bar[XB_XGEN(b.x)]) == gen, bar);
            __builtin_amdgcn_fence(__ATOMIC_ACQUIRE, "agent");
            asm volatile("s_waitcnt vmcnt(0)" ::: "memory");
        }
    }
    __syncthreads();
}


typedef __hip_bfloat16 bf16;
typedef __attribute__((ext_vector_type(8))) short bf16x8;
typedef __attribute__((ext_vector_type(4))) float f32x4;

constexpr int DM = 1024;
constexpr int NB = 4;
constexpr int SEQ = 4096;
constexpr int NT = NB * SEQ;
constexpr int DIN = 4128;
constexpr int NPAD_IN = 4224;
constexpr float EPSF = 1e-6f;

__device__ __forceinline__ float bf2f(unsigned short u) { return __uint_as_float(((unsigned)u) << 16); }
typedef __bf16 bf16x2_t __attribute__((ext_vector_type(2)));
typedef float f32x2_t __attribute__((ext_vector_type(2)));
__device__ __forceinline__ unsigned short f2bf(float f) { return __builtin_bit_cast(unsigned short, (__bf16)f); }
__device__ __forceinline__ unsigned pack2(float a, float b) {
  f32x2_t v = {a, b};
  return __builtin_bit_cast(unsigned, __builtin_convertvector(v, bf16x2_t));
}
__device__ __forceinline__ float wave_sum(float v) {
#pragma unroll
  for (int o = 32; o > 0; o >>= 1) v += __shfl_xor(v, o, 64);
  return v;
}
#define DPP_ADD(v, ctrl) v += __builtin_bit_cast(float, __builtin_amdgcn_update_dpp(0, __builtin_bit_cast(int, v), ctrl, 0xF, 0xF, true))
__device__ __forceinline__ float wave_sum_dpp(float v) {
  DPP_ADD(v, 0xB1);
  DPP_ADD(v, 0x4E);
  DPP_ADD(v, 0x141);
  DPP_ADD(v, 0x140);
  const float r0 = __builtin_bit_cast(float, __builtin_amdgcn_readlane(__builtin_bit_cast(int, v), 0));
  const float r1 = __builtin_bit_cast(float, __builtin_amdgcn_readlane(__builtin_bit_cast(int, v), 16));
  const float r2 = __builtin_bit_cast(float, __builtin_amdgcn_readlane(__builtin_bit_cast(int, v), 32));
  const float r3 = __builtin_bit_cast(float, __builtin_amdgcn_readlane(__builtin_bit_cast(int, v), 48));
  return (r0 + r1) + (r2 + r3);
}
__device__ __forceinline__ float softplusf(float x) { return fmaxf(x, 0.f) + log1pf(expf(-fabsf(x))); }
__device__ __forceinline__ float sigmoidf(float x) { return __builtin_amdgcn_rcpf(1.f + __builtin_amdgcn_exp2f(-1.4426950408889634f * x)); }

__device__ __forceinline__ void d_prep_x(int item, const float* __restrict__ x, unsigned short* __restrict__ xb,
                                                float* __restrict__ rs) {
  int t = item * 4 + (threadIdx.x >> 6);
  int lane = threadIdx.x & 63;
  const float4* xr = (const float4*)(x + (size_t)t * DM);
  float ss = 0.f;
#pragma unroll
  for (int i = 0; i < 4; ++i) {
    float4 v = xr[lane + 64 * i];
    ss += v.x * v.x + v.y * v.y + v.z * v.z + v.w * v.w;
    ushort4 o;
    o.x = f2bf(v.x); o.y = f2bf(v.y); o.z = f2bf(v.z); o.w = f2bf(v.w);
    ((ushort4*)(xb + (size_t)t * DM))[lane + 64 * i] = o;
  }
  ss = wave_sum(ss);
  if (lane == 0) rs[t] = rsqrtf(ss * (1.f / DM) + EPSF);
}

__device__ __forceinline__ int win_src(int n) {
  if (n < 2048) return n;
  if (n < 4096) return n + 16;
  int j = n - 4096;
  if (j < 16) return 2048 + j;
  if (j < 32) return 4112 + (j - 16);
  return -1;
}
__device__ __forceinline__ void d_transpose_w(int item, int ntn, float* tile, const float* __restrict__ in, int ldn,
                                              const float* __restrict__ g, unsigned short* __restrict__ out, int mode) {
  const int kt = item / ntn, nt = item % ntn;
  const int tid = threadIdx.x;
  __syncthreads();
#pragma unroll
  for (int i = 0; i < 4; ++i) {
    const int row = (tid >> 4) + 16 * i;
    const int c4 = (tid & 15) * 4;
    const int n = nt * 64 + c4;
    const int src = mode ? win_src(n) : n;
    float4 v = make_float4(0.f, 0.f, 0.f, 0.f);
    if (src >= 0) {
      v = *(const float4*)(in + (size_t)(kt * 64 + row) * ldn + src);
      if (g) { const float gg = g[kt * 64 + row]; v.x *= gg; v.y *= gg; v.z *= gg; v.w *= gg; }
    }
    tile[row * 65 + c4] = v.x; tile[row * 65 + c4 + 1] = v.y; tile[row * 65 + c4 + 2] = v.z; tile[row * 65 + c4 + 3] = v.w;
  }
  __syncthreads();
  {
    const int n = tid >> 2, k16 = (tid & 3) * 16;
    uint4 o0, o1;
    o0.x = pack2(tile[(k16 + 0) * 65 + n], tile[(k16 + 1) * 65 + n]);   o0.y = pack2(tile[(k16 + 2) * 65 + n], tile[(k16 + 3) * 65 + n]);
    o0.z = pack2(tile[(k16 + 4) * 65 + n], tile[(k16 + 5) * 65 + n]);   o0.w = pack2(tile[(k16 + 6) * 65 + n], tile[(k16 + 7) * 65 + n]);
    o1.x = pack2(tile[(k16 + 8) * 65 + n], tile[(k16 + 9) * 65 + n]);   o1.y = pack2(tile[(k16 + 10) * 65 + n], tile[(k16 + 11) * 65 + n]);
    o1.z = pack2(tile[(k16 + 12) * 65 + n], tile[(k16 + 13) * 65 + n]); o1.w = pack2(tile[(k16 + 14) * 65 + n], tile[(k16 + 15) * 65 + n]);
    unsigned short* op = out + (size_t)(nt * 64 + n) * DM + kt * 64 + k16;
    *(uint4*)op = o0;
    *(uint4*)(op + 8) = o1;
  }
}
__device__ __forceinline__ void d_cvt_bf16(int item, const float* __restrict__ src, unsigned short* __restrict__ dst,
                                           const float* __restrict__ rowscale, int rowlen_log2) {
  const size_t base = (size_t)item * 2048 + threadIdx.x * 8;
  float4 a = *(const float4*)(src + base);
  float4 b = *(const float4*)(src + base + 4);
  if (rowscale) {
    const float sc = rowscale[base >> rowlen_log2];
    a.x *= sc; a.y *= sc; a.z *= sc; a.w *= sc; b.x *= sc; b.y *= sc; b.z *= sc; b.w *= sc;
  }
  uint4 o;
  o.x = pack2(a.x, a.y); o.y = pack2(a.z, a.w); o.z = pack2(b.x, b.y); o.w = pack2(b.z, b.w);
  *(uint4*)(dst + base) = o;
}

constexpr int GBM = 128, GBN = 128, GBK = 64, GLD = 64;
struct GemmP {
  const unsigned short* A; const unsigned short* Bt; int lda, ldb, K;
  const float* rowscale;
  unsigned short* obf; int ldo;
  float* of32; int ldf;
  const float* resid;
  const float *a_log, *dt_bias, *i_bias, *f_bias;
  float* rowacc;
};
enum { EPI_INPROJ = 0, EPI_OUTPROJ = 1, EPI_SCORES = 2, EPI_PLAIN = 3 };

template <int EPI>
__device__ __forceinline__ void gemm_tile(const GemmP p, int tm, int tn, unsigned short* smem) {
  unsigned short* As = smem;
  unsigned short* Bs = smem + 2 * GBM * GLD;
  int tid = threadIdx.x;
  asm volatile("" : "+v"(tid));
  const int lane = tid & 63, wid = tid >> 6;
  const int wm = wid >> 1, wn = wid & 1;
  const int m0 = tm * GBM, n0 = tn * GBN;
  f32x4 acc[4][4];
#pragma unroll
  for (int i = 0; i < 4; ++i)
#pragma unroll
    for (int j = 0; j < 4; ++j) acc[i][j] = (f32x4){0.f, 0.f, 0.f, 0.f};

  uint4 ra0, ra1, ra2, ra3, rb0, rb1, rb2, rb3;
  uint4 sa0, sa1, sa2, sa3, sb0, sb1, sb2, sb3;
  const int nk = p.K / GBK;
  const int lrow = tid >> 3, lc8 = tid & 7;
  const unsigned short* Ag = p.A + (size_t)(m0 + lrow) * p.lda + lc8 * 8;
  const unsigned short* Bg = p.Bt + (size_t)(n0 + lrow) * p.ldb + lc8 * 8;
  const size_t a32 = (size_t)32 * p.lda, b32 = (size_t)32 * p.ldb;
#define GLOAD(R, S, kt)                                                  \
  {                                                                      \
    R##0 = *(const uint4*)(Ag + (kt) * GBK);                             \
    R##1 = *(const uint4*)(Ag + a32 + (kt) * GBK);                       \
    R##2 = *(const uint4*)(Ag + 2 * a32 + (kt) * GBK);                   \
    R##3 = *(const uint4*)(Ag + 3 * a32 + (kt) * GBK);                   \
    S##0 = *(const uint4*)(Bg + (kt) * GBK);                             \
    S##1 = *(const uint4*)(Bg + b32 + (kt) * GBK);                       \
    S##2 = *(const uint4*)(Bg + 2 * b32 + (kt) * GBK);                   \
    S##3 = *(const uint4*)(Bg + 3 * b32 + (kt) * GBK);                   \
  }
#define SSTORE(R, S, buf)                                                \
  {                                                                      \
    unsigned short* ad = As + (size_t)(buf) * GBM * GLD + lrow * GLD + ((lc8 ^ (lrow & 7)) * 8); \
    unsigned short* bd = Bs + (size_t)(buf) * GBN * GLD + lrow * GLD + ((lc8 ^ (lrow & 7)) * 8); \
    *(uint4*)(ad) = R##0; *(uint4*)(ad + 32 * GLD) = R##1; *(uint4*)(ad + 64 * GLD) = R##2; *(uint4*)(ad + 96 * GLD) = R##3; \
    *(uint4*)(bd) = S##0; *(uint4*)(bd + 32 * GLD) = S##1; *(uint4*)(bd + 64 * GLD) = S##2; *(uint4*)(bd + 96 * GLD) = S##3; \
  }
#define GCOMPUTE(buf)                                                                                                     \
  {                                                                                                                       \
    const unsigned short* Ab = As + (size_t)(buf) * GBM * GLD;                                                            \
    const unsigned short* Bb = Bs + (size_t)(buf) * GBN * GLD;                                                            \
    _Pragma("unroll") for (int ks = 0; ks < 2; ++ks) {                                                                    \
      bf16x8 a[4], b[4];                                                                                                  \
      const int kc = ((ks * 4 + (lane >> 4)) ^ (lane & 7)) * 8;                   \
      _Pragma("unroll") for (int i = 0; i < 4; ++i) a[i] = *(const bf16x8*)(Ab + (wm * 64 + i * 16 + (lane & 15)) * GLD + kc); \
      _Pragma("unroll") for (int j = 0; j < 4; ++j) b[j] = *(const bf16x8*)(Bb + (wn * 64 + j * 16 + (lane & 15)) * GLD + kc); \
      _Pragma("unroll") for (int i = 0; i < 4; ++i)                                                                       \
        _Pragma("unroll") for (int j = 0; j < 4; ++j)                                                                     \
          acc[i][j] = __builtin_amdgcn_mfma_f32_16x16x32_bf16(b[j], a[i], acc[i][j], 0, 0, 0);               \
    }                                                                                                                     \
  }
  GLOAD(ra, rb, 0);
  if (nk > 1) GLOAD(sa, sb, 1);
  SSTORE(ra, rb, 0);
  __syncthreads();
  for (int kt = 0; kt < nk; kt += 2) {
    if (kt + 2 < nk) GLOAD(ra, rb, kt + 2);
    GCOMPUTE(0);
    if (kt + 1 < nk) SSTORE(sa, sb, 1);
    __syncthreads();
    if (kt + 1 < nk) {
      if (kt + 3 < nk) GLOAD(sa, sb, kt + 3);
      GCOMPUTE(1);
      if (kt + 2 < nk) SSTORE(ra, rb, 0);
      __syncthreads();
    }
  }
#undef GLOAD
#undef SSTORE
#undef GCOMPUTE
#pragma unroll
  for (int i = 0; i < 4; ++i) {
    const int row = m0 + wm * 64 + i * 16 + (lane & 15);
    float rsc = 1.f;
    float rowss = 0.f;
    if (EPI == EPI_INPROJ) rsc = p.rowscale[row];
    if (EPI == EPI_SCORES) {
      const float4* pr = (const float4*)(p.rowscale + (size_t)row * 16);
      const float4 s0 = pr[0], s1 = pr[1], s2 = pr[2], s3 = pr[3];
      const float ssq = ((s0.x + s0.y) + (s0.z + s0.w)) + ((s1.x + s1.y) + (s1.z + s1.w)) + ((s2.x + s2.y) + (s2.z + s2.w)) + ((s3.x + s3.y) + (s3.z + s3.w));
      rsc = rsqrtf(ssq * (1.f / DM) + EPSF);
    }
#pragma unroll
    for (int j = 0; j < 4; ++j) {
      const int col0 = n0 + wn * 64 + j * 16 + (lane >> 4) * 4;
      const float v0 = acc[i][j][0] * rsc, v1 = acc[i][j][1] * rsc, v2 = acc[i][j][2] * rsc, v3 = acc[i][j][3] * rsc;
      if (EPI == EPI_INPROJ) {
        if (col0 < 4096) {
          uint2 pk; pk.x = pack2(v0, v1); pk.y = pack2(v2, v3);
          *(uint2*)(p.obf + (size_t)row * p.ldo + col0) = pk;
        } else if (col0 < 4128) {
          const float vv[4] = {v0, v1, v2, v3};
          float oo[4];
#pragma unroll
          for (int r = 0; r < 4; ++r) {
            const int jg = col0 - 4096 + r, jj = jg & 7;
            const float v = vv[r];
            float o;
            if (jg < 8) o = -expf(p.a_log[jj]) * softplusf(v + p.dt_bias[jj]);
            else if (jg < 16) o = sigmoidf(v);
            else if (jg < 24) o = v + p.i_bias[jj];
            else o = -softplusf(-(v + p.f_bias[jj]));
            oo[r] = o;
          }
          *(float4*)(p.of32 + (size_t)row * p.ldf + (col0 - 4096)) = make_float4(oo[0], oo[1], oo[2], oo[3]);
        }
      } else if (EPI == EPI_OUTPROJ) {
        const float4 xr = *(const float4*)(p.resid + (size_t)row * p.ldf + col0);
        const float x0 = v0 + xr.x, x1 = v1 + xr.y, x2 = v2 + xr.z, x3 = v3 + xr.w;
        *(float4*)(p.of32 + (size_t)row * p.ldf + col0) = make_float4(x0, x1, x2, x3);
        uint2 pk; pk.x = pack2(x0, x1); pk.y = pack2(x2, x3);
        *(uint2*)(p.obf + (size_t)row * p.ldo + col0) = pk;
        rowss += (x0 * x0 + x1 * x1) + (x2 * x2 + x3 * x3);
      } else {
        uint2 pk; pk.x = pack2(v0, v1); pk.y = pack2(v2, v3);
        *(uint2*)(p.obf + (size_t)row * p.ldo + col0) = pk;
      }
    }
    if (EPI == EPI_OUTPROJ) {
      rowss += __shfl_xor(rowss, 16, 64);
      rowss += __shfl_xor(rowss, 32, 64);
      if ((lane >> 4) == 0) p.rowacc[(size_t)row * 16 + tn * 2 + wn] = rowss;
    }
  }
}

__device__ __forceinline__ bool xcd_tile(int bid, int nb, int k, int ntn, int& tm, int& tn) {
  const int q = (bid >> 3) + (nb >> 3) * k;
  if (q >= 16 * ntn) return false;
  const int g = q / (8 * ntn), rem = q % (8 * ntn);
  tn = rem >> 3;
  tm = 16 * (bid & 7) + 8 * g + (rem & 7);
  return true;
}

__device__ __forceinline__ void d_conv(int item, const unsigned short* __restrict__ pm, const float* __restrict__ pg,
                                              const float* __restrict__ conv_w, const float* __restrict__ a_log,
                                              const float* __restrict__ dt_bias, const float* __restrict__ i_bias,
                                              const float* __restrict__ f_bias, unsigned short* __restrict__ qkv,
                                              float* __restrict__ gt) {
  int t = item * 4 + (threadIdx.x >> 6);
  int lane = threadIdx.x & 63;
  int s = t & (SEQ - 1);
  for (int sec = 0; sec < 3; ++sec) {
    for (int h = 0; h < 4; ++h) {
      int c0 = sec * 512 + h * 128 + 2 * lane;
      float a0 = 0.f, a1 = 0.f;
#pragma unroll
      for (int j = 0; j < 5; ++j) {
        int sp = s + j - 2;
        if (sp >= 0 && sp < SEQ) {
          unsigned v = *(const unsigned*)(pm + (size_t)(t + j - 2) * 4096 + c0);
          a0 += conv_w[c0 * 5 + j] * bf2f((unsigned short)(v & 0xffff));
          a1 += conv_w[(c0 + 1) * 5 + j] * bf2f((unsigned short)(v >> 16));
        }
      }
      a0 = a0 * sigmoidf(a0);
      a1 = a1 * sigmoidf(a1);
      if (sec < 2) {
        float ss = wave_sum(a0 * a0 + a1 * a1);
        float sc = rsqrtf(ss + EPSF);
        if (sec == 0) sc *= 0.08838834764831845f;
        a0 *= sc; a1 *= sc;
      }
      unsigned o = pack2(a0, a1);
      *(unsigned*)(qkv + (size_t)t * 1536 + c0) = o;
    }
  }
}

__device__ __forceinline__ void d_gdn_rec(int chain, float* sq, float* sk, const unsigned short* __restrict__ qkv,
                                                 const float* __restrict__ gt, unsigned short* __restrict__ oA, int ntok) {
  const int bh = chain >> 1, dir = chain & 1;
  const int b = bh >> 2, h = bh & 3;
  const int e = threadIdx.x & 127;
  float S[128];
#pragma unroll
  for (int d = 0; d < 128; ++d) S[d] = 0.f;
  for (int it = 0; it < SEQ; ++it) {
    const int s = dir ? (SEQ - 1 - it) : it;
    const size_t t = (size_t)b * SEQ + s;
    __syncthreads();
    sq[e] = bf2f(qkv[t * 1536 + h * 128 + e]);
    sk[e] = bf2f(qkv[t * 1536 + 512 + h * 128 + e]);
    const float v = bf2f(qkv[t * 1536 + 1024 + h * 128 + e]);
    const float g = gt[t * 32 + dir * 4 + h];
    const float beta = gt[t * 32 + 8 + dir * 4 + h];
    __syncthreads();
    const float a = expf(g);
    float k0 = 0.f, k1 = 0.f, k2 = 0.f, k3 = 0.f;
#pragma unroll
    for (int d = 0; d < 128; d += 4) {
      k0 += sk[d] * S[d]; k1 += sk[d + 1] * S[d + 1]; k2 += sk[d + 2] * S[d + 2]; k3 += sk[d + 3] * S[d + 3];
    }
    const float kS = a * ((k0 + k1) + (k2 + k3));
    const float vn = beta * (v - kS);
    float o0 = 0.f, o1 = 0.f, o2 = 0.f, o3 = 0.f;
#pragma unroll
    for (int d = 0; d < 128; d += 4) {
      S[d] = a * S[d] + sk[d] * vn;             o0 += sq[d] * S[d];
      S[d + 1] = a * S[d + 1] + sk[d + 1] * vn; o1 += sq[d + 1] * S[d + 1];
      S[d + 2] = a * S[d + 2] + sk[d + 2] * vn; o2 += sq[d + 2] * S[d + 2];
      S[d + 3] = a * S[d + 3] + sk[d + 3] * vn; o3 += sq[d + 3] * S[d + 3];
    }
    oA[((size_t)dir * ntok + t) * 512 + h * 128 + e] = f2bf((o0 + o1) + (o2 + o3));
  }
}

__device__ __forceinline__ void d_mlstm_rec(int chain, float* sq, float* sk, const unsigned short* __restrict__ pm,
                                                   const float* __restrict__ gt, unsigned short* __restrict__ oM, int ntok) {
  const int bh = chain >> 1, dir = chain & 1;
  const int b = bh >> 2, h = bh & 3;
  const int e = threadIdx.x & 127, lane = e & 63;
  float C[128];
#pragma unroll
  for (int d = 0; d < 128; ++d) C[d] = 0.f;
  float n0 = 0.f, n1 = 0.f, m = 0.f;
  for (int it = 0; it < SEQ; ++it) {
    const int s = dir ? (SEQ - 1 - it) : it;
    const size_t t = (size_t)b * SEQ + s;
    __syncthreads();
    sq[e] = bf2f(pm[t * 4096 + 2048 + h * 128 + e]);
    sk[e] = bf2f(pm[t * 4096 + 2560 + h * 128 + e]) * 0.08838834764831845f;
    const float v = bf2f(pm[t * 4096 + 3072 + h * 128 + e]);
    const float ip = gt[t * 32 + 16 + dir * 4 + h];
    const float lf = gt[t * 32 + 24 + dir * 4 + h];
    __syncthreads();
    const float mn = fmaxf(lf + m, ip);
    const float fs = expf(lf + m - mn);
    const float is = expf(ip - mn);
    m = mn;
    n0 = fs * n0 + is * sk[lane];
    n1 = fs * n1 + is * sk[lane + 64];
    const float den = wave_sum(n0 * sq[lane] + n1 * sq[lane + 64]);
    const float iv = is * v;
    float o0 = 0.f, o1 = 0.f, o2 = 0.f, o3 = 0.f;
#pragma unroll
    for (int d = 0; d < 128; d += 4) {
      C[d] = fs * C[d] + sk[d] * iv;             o0 += sq[d] * C[d];
      C[d + 1] = fs * C[d + 1] + sk[d + 1] * iv; o1 += sq[d + 1] * C[d + 1];
      C[d + 2] = fs * C[d + 2] + sk[d + 2] * iv; o2 += sq[d + 2] * C[d + 2];
      C[d + 3] = fs * C[d + 3] + sk[d + 3] * iv; o3 += sq[d + 3] * C[d + 3];
    }
    const float num = (o0 + o1) + (o2 + o3);
    const float hh = num / fmaxf(fabsf(den), expf(-mn));
    oM[((size_t)dir * ntok + t) * 512 + h * 128 + e] = f2bf(hh);
  }
}

__device__ __forceinline__ void d_combine(int item, const unsigned short* __restrict__ uo, const unsigned short* __restrict__ oM,
                                                 const unsigned short* __restrict__ pm, const float* __restrict__ gdn_g,
                                                 const float* __restrict__ ml_g, unsigned short* __restrict__ y) {
  int tid_ = threadIdx.x;
  asm volatile("" : "+v"(tid_));
  const int t = item * 4 + (tid_ >> 6);
  const int lane = tid_ & 63;
  const int b = t >> 12, cc = (t >> 6) & 63, ii = t & 63;
  unsigned gf_[4], gb_[4], mf_[4], mb_[4], zg_[4], zo_[4];
  const size_t off = (size_t)cc * 8192 + (lane >> 4) * 2048 + ii * 32 + ((2 * lane) & 31);
#pragma unroll
  for (int h = 0; h < 4; ++h) {
    const int c = h * 128 + 2 * lane;
    const int chain0 = (b * 4 + h) * 2;
    gf_[h] = *(const unsigned*)(uo + (size_t)chain0 * 64 * 8192 + off);
    gb_[h] = *(const unsigned*)(uo + (size_t)(chain0 + 1) * 64 * 8192 + off);
    mf_[h] = *(const unsigned*)(oM + (size_t)t * 512 + c);
    mb_[h] = *(const unsigned*)(oM + ((size_t)NT + t) * 512 + c);
    zg_[h] = *(const unsigned*)(pm + (size_t)t * 4096 + 1536 + c);
    zo_[h] = *(const unsigned*)(pm + (size_t)t * 4096 + 3584 + c);
  }
  const float gg0 = gdn_g[2 * lane], gg1 = gdn_g[2 * lane + 1];
  float a0[4], a1[4], m0[4], m1[4], sa[4], sm[4];
#pragma unroll
  for (int h = 0; h < 4; ++h) {
    a0[h] = bf2f(gf_[h] & 0xffff) + bf2f(gb_[h] & 0xffff);
    a1[h] = __uint_as_float(gf_[h] & 0xffff0000u) + __uint_as_float(gb_[h] & 0xffff0000u);
    m0[h] = bf2f(mf_[h] & 0xffff) + bf2f(mb_[h] & 0xffff);
    m1[h] = __uint_as_float(mf_[h] & 0xffff0000u) + __uint_as_float(mb_[h] & 0xffff0000u);
    sa[h] = a0[h] * a0[h] + a1[h] * a1[h];
    sm[h] = m0[h] * m0[h] + m1[h] * m1[h];
  }
#pragma unroll
  for (int o = 32; o > 0; o >>= 1) {
#pragma unroll
    for (int h = 0; h < 4; ++h) { sa[h] += __shfl_xor(sa[h], o, 64); sm[h] += __shfl_xor(sm[h], o, 64); }
  }
#pragma unroll
  for (int h = 0; h < 4; ++h) {
    const int c = h * 128 + 2 * lane;
    const float sca = rsqrtf(sa[h] * (1.f / 128.f) + EPSF);
    const float scm = rsqrtf(sm[h] * (1.f / 128.f) + EPSF);
    const float z0 = bf2f(zg_[h] & 0xffff), z1 = __uint_as_float(zg_[h] & 0xffff0000u);
    const float q0 = bf2f(zo_[h] & 0xffff), q1 = __uint_as_float(zo_[h] & 0xffff0000u);
    const float o0 = a0[h] * sca * gg0 * (z0 * sigmoidf(z0));
    const float o1 = a1[h] * sca * gg1 * (z1 * sigmoidf(z1));
    const float p0 = m0[h] * scm * ml_g[c] * sigmoidf(q0);
    const float p1 = m1[h] * scm * ml_g[c + 1] * sigmoidf(q1);
    *(unsigned*)(y + (size_t)t * DM + c) = pack2(o0, o1);
    *(unsigned*)(y + (size_t)t * DM + 512 + c) = pack2(p0, p1);
  }
}

#ifdef DBG_CHECK
__device__ __forceinline__ void d_dbg_cmp(int item, const unsigned short* __restrict__ uo, const unsigned short* __restrict__ oAd,
                                          float* __restrict__ dbg) {
  int t = item * 4 + (threadIdx.x >> 6);
  int lane = threadIdx.x & 63;
  const int cc = (t >> 6) & 63, ii = t & 63;
  float sd = 0.f, sr = 0.f;
  for (int h = 0; h < 4; ++h) {
    for (int dir = 0; dir < 2; ++dir) {
      const int chain = h * 2 + dir;
      const size_t off = (size_t)cc * 8192 + (lane >> 4) * 2048 + ii * 32 + ((2 * lane) & 31);
      unsigned vn = *(const unsigned*)(uo + (size_t)chain * 64 * 8192 + off);
      unsigned vr = *(const unsigned*)(oAd + ((size_t)dir * 4096 + t) * 512 + h * 128 + 2 * lane);
      float n0 = bf2f(vn & 0xffff), n1 = bf2f(vn >> 16), r0 = bf2f(vr & 0xffff), r1 = bf2f(vr >> 16);
      sd += (n0 - r0) * (n0 - r0) + (n1 - r1) * (n1 - r1);
      sr += r0 * r0 + r1 * r1;
    }
  }
  sd = wave_sum(sd); sr = wave_sum(sr);
  if (lane == 0) { atomicAdd(&dbg[0], sd); atomicAdd(&dbg[1], sr); }
}
__device__ __forceinline__ void d_dbg_cmp_m(int item, const unsigned short* __restrict__ oM, const unsigned short* __restrict__ oMd,
                                            float* __restrict__ dbg) {
  int t = item * 4 + (threadIdx.x >> 6);
  int lane = threadIdx.x & 63;
  float sd = 0.f, sr = 0.f;
  for (int dir = 0; dir < 2; ++dir)
    for (int q = 0; q < 4; ++q) {
      unsigned vn = *(const unsigned*)(oM + ((size_t)dir * NT + t) * 512 + q * 128 + 2 * lane);
      unsigned vr = *(const unsigned*)(oMd + ((size_t)dir * 4096 + t) * 512 + q * 128 + 2 * lane);
      float n0 = bf2f(vn & 0xffff), n1 = bf2f(vn >> 16), r0 = bf2f(vr & 0xffff), r1 = bf2f(vr >> 16);
      sd += (n0 - r0) * (n0 - r0) + (n1 - r1) * (n1 - r1);
      sr += r0 * r0 + r1 * r1;
    }
  sd = wave_sum(sd); sr = wave_sum(sr);
  if (lane == 0) { atomicAdd(&dbg[0], sd); atomicAdd(&dbg[1], sr); }
}
#endif

__device__ __forceinline__ void d_prep_x1(int item, const float* __restrict__ x1, unsigned short* __restrict__ xb,
                                                 float* __restrict__ rs) {
  int t = item * 4 + (threadIdx.x >> 6);
  int lane = threadIdx.x & 63;
  const float4* xr = (const float4*)(x1 + (size_t)t * DM);
  float ss = 0.f;
#pragma unroll
  for (int i = 0; i < 4; ++i) {
    float4 v = xr[lane + 64 * i];
    ss += v.x * v.x + v.y * v.y + v.z * v.z + v.w * v.w;
    ushort4 o;
    o.x = f2bf(v.x); o.y = f2bf(v.y); o.z = f2bf(v.z); o.w = f2bf(v.w);
    ((ushort4*)(xb + (size_t)t * DM))[lane + 64 * i] = o;
  }
  ss = wave_sum(ss);
  if (lane == 0) rs[t] = rsqrtf(ss * (1.f / DM) + EPSF);
}

__device__ const unsigned char kPairTab[64] = {
    0x00, 0x01, 0x02, 0x03, 0x04, 0x05, 0x06, 0x07, 0x08, 0x09, 0x0a, 0x0b, 0x0c, 0x0d, 0x0e, 0x0f,
    0x10, 0x11, 0x12, 0x13, 0x14, 0x15, 0x16, 0x17,
    0x20, 0x21, 0x22, 0x23, 0x24,
    0x30, 0x31, 0x32, 0x33,
    0x40, 0x41, 0x42,
    0x50, 0x51, 0x60, 0x61, 0x70, 0x71,
    0x80, 0x90, 0xa0, 0xb0, 0xc0, 0xd0, 0xe0, 0xf0,
    0xff, 0xff, 0xff, 0xff, 0xff, 0xff, 0xff, 0xff, 0xff, 0xff, 0xff, 0xff, 0xff, 0xff};

__device__ __forceinline__ void sort16_desc(unsigned (&a)[16]) {
#pragma unroll
  for (int k = 2; k <= 16; k <<= 1)
#pragma unroll
    for (int j = k >> 1; j > 0; j >>= 1)
#pragma unroll
      for (int i = 0; i < 16; ++i) {
        const int l = i ^ j;
        if (l > i) {
          const unsigned hi = max(a[i], a[l]), lo = min(a[i], a[l]);
          if ((i & k) == 0) { a[i] = hi; a[l] = lo; } else { a[i] = lo; a[l] = hi; }
        }
      }
}
__device__ __forceinline__ void merge16_desc(unsigned (&top)[16], const unsigned (&b)[16]) {
#pragma unroll
  for (int i = 0; i < 16; ++i) top[i] = max(top[i], b[15 - i]);
#pragma unroll
  for (int j = 8; j > 0; j >>= 1)
#pragma unroll
    for (int i = 0; i < 16; ++i) {
      const int l = i ^ j;
      if (l > i) {
        const unsigned hi = max(top[i], top[l]), lo = min(top[i], top[l]);
        top[i] = hi; top[l] = lo;
      }
    }
}
__device__ __forceinline__ unsigned key16(unsigned hbits, int idx) {
  const unsigned m = hbits ^ ((hbits & 0x8000u) ? 0xFFFFu : 0x8000u);
  return (m << 16) | (unsigned)(127 - idx);
}
__device__ __forceinline__ void top16_of_128(const unsigned short* __restrict__ sp, unsigned (&top)[16]) {
#pragma unroll
  for (int g = 0; g < 8; ++g) {
    const uint4 x0 = *(const uint4*)(sp + g * 16);
    const uint4 x1 = *(const uint4*)(sp + g * 16 + 8);
    unsigned b[16];
    b[0] = key16(x0.x & 0xffff, g * 16 + 0);  b[1] = key16(x0.x >> 16, g * 16 + 1);
    b[2] = key16(x0.y & 0xffff, g * 16 + 2);  b[3] = key16(x0.y >> 16, g * 16 + 3);
    b[4] = key16(x0.z & 0xffff, g * 16 + 4);  b[5] = key16(x0.z >> 16, g * 16 + 5);
    b[6] = key16(x0.w & 0xffff, g * 16 + 6);  b[7] = key16(x0.w >> 16, g * 16 + 7);
    b[8] = key16(x1.x & 0xffff, g * 16 + 8);  b[9] = key16(x1.x >> 16, g * 16 + 9);
    b[10] = key16(x1.y & 0xffff, g * 16 + 10); b[11] = key16(x1.y >> 16, g * 16 + 11);
    b[12] = key16(x1.z & 0xffff, g * 16 + 12); b[13] = key16(x1.z >> 16, g * 16 + 13);
    b[14] = key16(x1.w & 0xffff, g * 16 + 14); b[15] = key16(x1.w >> 16, g * 16 + 15);
    sort16_desc(b);
    if (g == 0) {
#pragma unroll
      for (int i = 0; i < 16; ++i) top[i] = b[i];
    } else {
      merge16_desc(top, b);
    }
  }
}

__device__ __forceinline__ void d_topk(int item, const unsigned short* __restrict__ scores, int* __restrict__ idx_out,
                                       float* __restrict__ gate_out) {
  int tid_ = threadIdx.x;
  asm volatile("" : "+v"(tid_));
  const int pair = item * 256 + tid_;
  const unsigned short* sp = scores + (size_t)pair * 256;
  unsigned k0[16], k1[16];
  top16_of_128(sp, k0);
  top16_of_128(sp + 128, k1);
  float v0[16], v1[16];
  int i0[16], i1[16];
#pragma unroll
  for (int i = 0; i < 16; ++i) {
    const unsigned m0 = k0[i] >> 16, m1 = k1[i] >> 16;
    v0[i] = bf2f((unsigned short)(m0 ^ ((m0 & 0x8000u) ? 0x8000u : 0xFFFFu)));
    v1[i] = bf2f((unsigned short)(m1 ^ ((m1 & 0x8000u) ? 0x8000u : 0xFFFFu)));
    i0[i] = 127 - (int)(k0[i] & 127u);
    i1[i] = 127 - (int)(k1[i] & 127u);
  }
  unsigned top[16];
#pragma unroll
  for (int g = 0; g < 4; ++g) {
    unsigned b[16];
#pragma unroll
    for (int q = 0; q < 16; ++q) {
      const int pr = kPairTab[g * 16 + q];
      if (pr == 0xff) {
        b[q] = 0u;
      } else {
        const int pi = pr >> 4, pj = pr & 15;
        const float sum = v0[pi] + v1[pj];
        const unsigned u = __float_as_uint(sum);
        const unsigned mono = u ^ ((u & 0x80000000u) ? 0xFFFFFFFFu : 0x80000000u);
        b[q] = (mono & 0xFFFFC000u) | (unsigned)(16383 - (i0[pi] * 128 + i1[pj]));
      }
    }
    sort16_desc(b);
    if (g == 0) {
#pragma unroll
      for (int i = 0; i < 16; ++i) top[i] = b[i];
    } else {
      merge16_desc(top, b);
    }
  }
  float ev[16];
  int ci[16];
  float mx = 0.f, sum = 0.f;
#pragma unroll
  for (int i = 0; i < 16; ++i) {
    const unsigned mono = top[i] & 0xFFFFC000u;
    const unsigned u = mono ^ ((mono & 0x80000000u) ? 0x80000000u : 0xFFFFFFFFu);
    const float val = __uint_as_float(u & 0xFFFFC000u);
    ci[i] = 16383 - (int)(top[i] & 16383u);
    if (i == 0) mx = val;
    ev[i] = expf(val - mx);
    sum += ev[i];
  }
  const float inv = 1.f / sum;
#pragma unroll
  for (int q = 0; q < 4; ++q) {
    int4 o; float4 g;
    o.x = ci[4 * q]; o.y = ci[4 * q + 1]; o.z = ci[4 * q + 2]; o.w = ci[4 * q + 3];
    g.x = ev[4 * q] * inv; g.y = ev[4 * q + 1] * inv; g.z = ev[4 * q + 2] * inv; g.w = ev[4 * q + 3] * inv;
    *(int4*)(idx_out + (size_t)pair * 16 + 4 * q) = o;
    *(float4*)(gate_out + (size_t)pair * 16 + 4 * q) = g;
  }
}

typedef float f32x2 __attribute__((ext_vector_type(2)));
__device__ __forceinline__ void d_cvt_tab(int item, const float* __restrict__ src, unsigned* __restrict__ dst8, float* __restrict__ dscale) {
  const int row = item * 4 + (threadIdx.x >> 6);
  const int lane = threadIdx.x & 63;
  const float4* sr = (const float4*)(src + (size_t)row * DM + lane * 16);
  const float4 a = sr[0], b = sr[1], c = sr[2], d = sr[3];
  float m = fmaxf(fmaxf(fmaxf(fabsf(a.x), fabsf(a.y)), fmaxf(fabsf(a.z), fabsf(a.w))),
                  fmaxf(fmaxf(fabsf(b.x), fabsf(b.y)), fmaxf(fabsf(b.z), fabsf(b.w))));
  m = fmaxf(m, fmaxf(fmaxf(fmaxf(fabsf(c.x), fabsf(c.y)), fmaxf(fabsf(c.z), fabsf(c.w))),
                     fmaxf(fmaxf(fabsf(d.x), fabsf(d.y)), fmaxf(fabsf(d.z), fabsf(d.w)))));
#pragma unroll
  for (int o = 32; o > 0; o >>= 1) m = fmaxf(m, __shfl_xor(m, o, 64));
  const float sc = (m > 0.f) ? 240.f / m : 1.f;
  uint4 o;
  int p;
  p = 0; p = __builtin_amdgcn_cvt_pk_fp8_f32(a.x * sc, a.y * sc, p, false); p = __builtin_amdgcn_cvt_pk_fp8_f32(a.z * sc, a.w * sc, p, true); o.x = (unsigned)p;
  p = 0; p = __builtin_amdgcn_cvt_pk_fp8_f32(b.x * sc, b.y * sc, p, false); p = __builtin_amdgcn_cvt_pk_fp8_f32(b.z * sc, b.w * sc, p, true); o.y = (unsigned)p;
  p = 0; p = __builtin_amdgcn_cvt_pk_fp8_f32(c.x * sc, c.y * sc, p, false); p = __builtin_amdgcn_cvt_pk_fp8_f32(c.z * sc, c.w * sc, p, true); o.z = (unsigned)p;
  p = 0; p = __builtin_amdgcn_cvt_pk_fp8_f32(d.x * sc, d.y * sc, p, false); p = __builtin_amdgcn_cvt_pk_fp8_f32(d.z * sc, d.w * sc, p, true); o.w = (unsigned)p;
  *(uint4*)(dst8 + (size_t)row * 256 + lane * 4) = o;
  if (lane == 0) dscale[row] = (m > 0.f) ? m * (1.f / 240.f) : 1.f;
}

__device__ __forceinline__ void d_cvt_tab_i8(int item, const float* __restrict__ src, unsigned* __restrict__ dst8, float* __restrict__ dscale) {
  const int row = item * 4 + (threadIdx.x >> 6);
  const int lane = threadIdx.x & 63;
  const float4* sr = (const float4*)(src + (size_t)row * DM + lane * 16);
  const float4 a = sr[0], b = sr[1], c = sr[2], d = sr[3];
  float m = fmaxf(fmaxf(fmaxf(fabsf(a.x), fabsf(a.y)), fmaxf(fabsf(a.z), fabsf(a.w))),
                  fmaxf(fmaxf(fabsf(b.x), fabsf(b.y)), fmaxf(fabsf(b.z), fabsf(b.w))));
  m = fmaxf(m, fmaxf(fmaxf(fmaxf(fabsf(c.x), fabsf(c.y)), fmaxf(fabsf(c.z), fabsf(c.w))),
                     fmaxf(fmaxf(fabsf(d.x), fabsf(d.y)), fmaxf(fabsf(d.z), fabsf(d.w)))));
#pragma unroll
  for (int o = 32; o > 0; o >>= 1) m = fmaxf(m, __shfl_xor(m, o, 64));
  const float sc = (m > 0.f) ? 127.f / m : 1.f;
#define Q8(x) ((unsigned)(__float2int_rn((x) * sc)) & 0xffu)
  uint4 o;
  o.x = Q8(a.x) | (Q8(a.y) << 8) | (Q8(a.z) << 16) | (Q8(a.w) << 24);
  o.y = Q8(b.x) | (Q8(b.y) << 8) | (Q8(b.z) << 16) | (Q8(b.w) << 24);
  o.z = Q8(c.x) | (Q8(c.y) << 8) | (Q8(c.z) << 16) | (Q8(c.w) << 24);
  o.w = Q8(d.x) | (Q8(d.y) << 8) | (Q8(d.z) << 16) | (Q8(d.w) << 24);
#undef Q8
  *(uint4*)(dst8 + (size_t)row * 256 + lane * 4) = o;
  if (lane == 0) dscale[row] = (m > 0.f) ? m * (1.f / 127.f) : 1.f;
}

__device__ __forceinline__ float erf_fast(float x) {
  const float ax = fabsf(x);
  const float t = __builtin_amdgcn_rcpf(1.f + 0.3275911f * ax);
  float p = 1.061405429f;
  p = p * t - 1.453152027f;
  p = p * t + 1.421413741f;
  p = p * t - 0.284496736f;
  p = p * t + 0.254829592f;
  const float e = __builtin_amdgcn_exp2f(-1.4426950408889634f * ax * ax);
  const float r = 1.f - p * t * e;
  return copysignf(r, x);
}
__device__ __forceinline__ float dot16_f8(const uint4 u, const float* hv) {
  const f32x2 a0 = __builtin_amdgcn_cvt_pk_f32_fp8((int)u.x, false), a1 = __builtin_amdgcn_cvt_pk_f32_fp8((int)u.x, true);
  const f32x2 b0 = __builtin_amdgcn_cvt_pk_f32_fp8((int)u.y, false), b1 = __builtin_amdgcn_cvt_pk_f32_fp8((int)u.y, true);
  const f32x2 c0 = __builtin_amdgcn_cvt_pk_f32_fp8((int)u.z, false), c1 = __builtin_amdgcn_cvt_pk_f32_fp8((int)u.z, true);
  const f32x2 d0 = __builtin_amdgcn_cvt_pk_f32_fp8((int)u.w, false), d1 = __builtin_amdgcn_cvt_pk_f32_fp8((int)u.w, true);
  float s0 = a0[0] * hv[0] + a0[1] * hv[1];
  float s1 = a1[0] * hv[2] + a1[1] * hv[3];
  s0 += b0[0] * hv[4] + b0[1] * hv[5];
  s1 += b1[0] * hv[6] + b1[1] * hv[7];
  s0 += c0[0] * hv[8] + c0[1] * hv[9];
  s1 += c1[0] * hv[10] + c1[1] * hv[11];
  s0 += d0[0] * hv[12] + d0[1] * hv[13];
  s1 += d1[0] * hv[14] + d1[1] * hv[15];
  return s0 + s1;
}
__device__ __forceinline__ void axpy16_f8(const uint4 v, const float wg, float* acc) {
  const f32x2 a0 = __builtin_amdgcn_cvt_pk_f32_fp8((int)v.x, false), a1 = __builtin_amdgcn_cvt_pk_f32_fp8((int)v.x, true);
  const f32x2 b0 = __builtin_amdgcn_cvt_pk_f32_fp8((int)v.y, false), b1 = __builtin_amdgcn_cvt_pk_f32_fp8((int)v.y, true);
  const f32x2 c0 = __builtin_amdgcn_cvt_pk_f32_fp8((int)v.z, false), c1 = __builtin_amdgcn_cvt_pk_f32_fp8((int)v.z, true);
  const f32x2 d0 = __builtin_amdgcn_cvt_pk_f32_fp8((int)v.w, false), d1 = __builtin_amdgcn_cvt_pk_f32_fp8((int)v.w, true);
  acc[0] += wg * a0[0]; acc[1] += wg * a0[1]; acc[2] += wg * a1[0]; acc[3] += wg * a1[1];
  acc[4] += wg * b0[0]; acc[5] += wg * b0[1]; acc[6] += wg * b1[0]; acc[7] += wg * b1[1];
  acc[8] += wg * c0[0]; acc[9] += wg * c0[1]; acc[10] += wg * c1[0]; acc[11] += wg * c1[1];
  acc[12] += wg * d0[0]; acc[13] += wg * d0[1]; acc[14] += wg * d1[0]; acc[15] += wg * d1[1];
}
typedef int i32x4 __attribute__((ext_vector_type(4)));
__device__ __forceinline__ void d_peer(int item, char* smem, const float* __restrict__ x1, const float* __restrict__ rs2,
                                       const float* __restrict__ g2, const int* __restrict__ idx,
                                       const float* __restrict__ gate, const unsigned* __restrict__ pu,
                                       const unsigned* __restrict__ pv, const float* __restrict__ su,
                                       const float* __restrict__ sv, const float* __restrict__ gf,
                                       float* __restrict__ out, float oscale) {
  int tid_ = threadIdx.x;
  asm volatile("" : "+v"(tid_));
  const int wv = tid_ >> 6;
  const int t = item * 4 + wv;
  const int lane = tid_ & 63, q = lane >> 4;
  char* hq = smem + wv * 1024;
  float r2;
  {
    const float4* pr = (const float4*)(rs2 + (size_t)t * 16);
    const float4 s0 = pr[0], s1 = pr[1], s2 = pr[2], s3 = pr[3];
    const float ssq = ((s0.x + s0.y) + (s0.z + s0.w)) + ((s1.x + s1.y) + (s1.z + s1.w)) + ((s2.x + s2.y) + (s2.z + s2.w)) + ((s3.x + s3.y) + (s3.z + s3.w));
    r2 = rsqrtf(ssq * (1.f / DM) + EPSF);
  }
  float sh;
  {
    float hv[16];
    float m = 0.f;
#pragma unroll
    for (int c = 0; c < 4; ++c) {
      const float4 xx = *(const float4*)(x1 + (size_t)t * DM + lane * 16 + c * 4);
      const float4 gg = *(const float4*)(g2 + lane * 16 + c * 4);
      hv[c * 4 + 0] = xx.x * r2 * gg.x; hv[c * 4 + 1] = xx.y * r2 * gg.y;
      hv[c * 4 + 2] = xx.z * r2 * gg.z; hv[c * 4 + 3] = xx.w * r2 * gg.w;
      m = fmaxf(m, fmaxf(fmaxf(fabsf(hv[c * 4]), fabsf(hv[c * 4 + 1])), fmaxf(fabsf(hv[c * 4 + 2]), fabsf(hv[c * 4 + 3]))));
    }
#pragma unroll
    for (int o = 32; o > 0; o >>= 1) m = fmaxf(m, __shfl_xor(m, o, 64));
    const float sc = (m > 0.f) ? 127.f / m : 1.f;
    sh = (m > 0.f) ? m * (1.f / 127.f) : 1.f;
#define Q8(x) ((unsigned)(__float2int_rn((x) * sc)) & 0xffu)
    uint4 o;
    o.x = Q8(hv[0]) | (Q8(hv[1]) << 8) | (Q8(hv[2]) << 16) | (Q8(hv[3]) << 24);
    o.y = Q8(hv[4]) | (Q8(hv[5]) << 8) | (Q8(hv[6]) << 16) | (Q8(hv[7]) << 24);
    o.z = Q8(hv[8]) | (Q8(hv[9]) << 8) | (Q8(hv[10]) << 16) | (Q8(hv[11]) << 24);
    o.w = Q8(hv[12]) | (Q8(hv[13]) << 8) | (Q8(hv[14]) << 16) | (Q8(hv[15]) << 24);
#undef Q8
    *(uint4*)(hq + lane * 16) = o;
  }
  float acc[16];
#pragma unroll
  for (int i = 0; i < 16; ++i) acc[i] = 0.f;
  const int id_a = idx[(size_t)t * 128 + lane], id_b = idx[(size_t)t * 128 + 64 + lane];
  const float gt_a = gate[(size_t)t * 128 + lane], gt_b = gate[(size_t)t * 128 + 64 + lane];
  for (int g = 0; g < 8; ++g) {
    const int srcl = (16 * g + (lane & 15)) & 63;
    const int idr = (g < 4) ? __shfl(id_a, srcl, 64) : __shfl(id_b, srcl, 64);
    const char* ub = (const char*)pu + (size_t)idr * 1024 + 16 * q;
    i32x4 ua[16];
#pragma unroll
    for (int s2 = 0; s2 < 16; ++s2) ua[s2] = *(const i32x4*)(ub + 64 * s2);
    uint4 v[8];
#pragma unroll
    for (int k = 0; k < 8; ++k) {
      const int e = (16 * g + k) & 63;
      const int id = (g < 4) ? __builtin_amdgcn_readlane(id_a, e) : __builtin_amdgcn_readlane(id_b, e);
      v[k] = *(const uint4*)(pv + (size_t)id * 256 + lane * 4);
    }
    float wq[4];
    {
      int ide[4]; float gte[4], sue[4], sve[4];
#pragma unroll
      for (int reg = 0; reg < 4; ++reg) {
        const int el = (16 * g + 4 * q + reg) & 63;
        ide[reg] = (g < 4) ? __shfl(id_a, el, 64) : __shfl(id_b, el, 64);
        gte[reg] = (g < 4) ? __shfl(gt_a, el, 64) : __shfl(gt_b, el, 64);
        sue[reg] = su[ide[reg]];
        sve[reg] = sv[ide[reg]];
      }
      i32x4 d4 = {0, 0, 0, 0};
#pragma unroll
      for (int s2 = 0; s2 < 16; ++s2) {
        const i32x4 bfr = *(const i32x4*)(hq + 64 * s2 + 16 * q);
        d4 = __builtin_amdgcn_mfma_i32_16x16x64_i8(ua[s2], bfr, d4, 0, 0, 0);
      }
#pragma unroll
      for (int reg = 0; reg < 4; ++reg) {
        const float dd = (float)d4[reg] * (sue[reg] * sh);
        const float act = 0.5f * dd * (1.f + erf_fast(dd * 0.7071067811865476f));
        wq[reg] = gte[reg] * act * sve[reg];
      }
    }
    __builtin_amdgcn_sched_barrier(0);
    uint4 v2[8];
#pragma unroll
    for (int k = 0; k < 8; ++k) {
      const int e = (16 * g + 8 + k) & 63;
      const int id = (g < 4) ? __builtin_amdgcn_readlane(id_a, e) : __builtin_amdgcn_readlane(id_b, e);
      v2[k] = *(const uint4*)(pv + (size_t)id * 256 + lane * 4);
    }
#pragma unroll
    for (int k = 0; k < 8; ++k) {
      const float wk = __builtin_bit_cast(float, __builtin_amdgcn_readlane(__builtin_bit_cast(int, wq[k & 3]), 16 * (k >> 2)));
      axpy16_f8(v[k], wk, acc);
    }
#pragma unroll
    for (int k = 0; k < 8; ++k) {
      const float wk = __builtin_bit_cast(float, __builtin_amdgcn_readlane(__builtin_bit_cast(int, wq[k & 3]), 16 * ((k + 8) >> 2)));
      axpy16_f8(v2[k], wk, acc);
    }
  }
  float ss = 0.f;
#pragma unroll
  for (int c = 0; c < 4; ++c) {
    const float4 xx = *(const float4*)(x1 + (size_t)t * DM + lane * 16 + c * 4);
    acc[c * 4 + 0] += xx.x; acc[c * 4 + 1] += xx.y; acc[c * 4 + 2] += xx.z; acc[c * 4 + 3] += xx.w;
  }
#pragma unroll
  for (int i = 0; i < 16; ++i) ss += acc[i] * acc[i];
  ss = wave_sum(ss);
  const float sc = rsqrtf(ss * (1.f / DM) + EPSF) * oscale;
#pragma unroll
  for (int q4 = 0; q4 < 4; ++q4) {
    const float4 gg = *(const float4*)(gf + lane * 16 + q4 * 4);
    float4 o;
    o.x = acc[q4 * 4 + 0] * sc * gg.x; o.y = acc[q4 * 4 + 1] * sc * gg.y;
    o.z = acc[q4 * 4 + 2] * sc * gg.z; o.w = acc[q4 * 4 + 3] * sc * gg.w;
    *(float4*)(out + (size_t)t * DM + lane * 16 + q4 * 4) = o;
  }
}

typedef __attribute__((ext_vector_type(16))) float f32x16;
#define MFMA32(a, b, c) __builtin_amdgcn_mfma_f32_32x32x16_bf16((a), (b), (c), 0, 0, 0)
__device__ __forceinline__ int crow(int reg, int hh) { return (reg & 3) + 8 * (reg >> 2) + 4 * hh; }

struct GdnBufs {
  unsigned short* qc;
  unsigned short* kTc;
  unsigned short* qkc;
  unsigned short* wn;
  unsigned short* uo;
  float* gsc;
};

__device__ __forceinline__ void tri_subst(const float* AL0, int lane, float (&T)[64]) {
  const float* AL = (const float*)__builtin_assume_aligned(AL0, 16);
#pragma unroll
  for (int i = 0; i < 64; ++i) T[i] = 0.f;
  T[0] = (lane == 0) ? 1.f : 0.f;
  float4 cur[16], nxt[16];
#pragma unroll
  for (int j4 = 0; j4 < 1; ++j4) cur[j4] = *(const float4*)(AL + 1 * 72 + 4 * j4);
#pragma unroll
  for (int i = 1; i < 64; ++i) {
    if (i + 1 < 64) {
#pragma unroll
      for (int j4 = 0; j4 < (i + 4) / 4; ++j4) nxt[j4] = *(const float4*)(AL + (i + 1) * 72 + 4 * j4);
    }
    float ax = 0.f, ay = 0.f, az = 0.f, aw = 0.f;
#pragma unroll
    for (int j4 = 0; j4 < (i + 3) / 4; ++j4) {
      ax += cur[j4].x * T[4 * j4]; ay += cur[j4].y * T[4 * j4 + 1]; az += cur[j4].z * T[4 * j4 + 2]; aw += cur[j4].w * T[4 * j4 + 3];
    }
    T[i] = ((lane == i) ? 1.f : 0.f) - ((ax + ay) + (az + aw));
#pragma unroll
    for (int j4 = 0; j4 < 16; ++j4) cur[j4] = nxt[j4];
  }
}

__device__ __forceinline__ void d_gdn_prep(int item, char* smem, const unsigned short* __restrict__ pm,
                                           const float* __restrict__ gt, const float* __restrict__ conv_w, GdnBufs G) {
  unsigned short* qL = (unsigned short*)smem;
  unsigned short* kL = qL + 64 * 144;
  unsigned short* kTL = kL + 64 * 144;
  unsigned short* vTL = kTL + 128 * 72;
  float* scal = (float*)(vTL + 128 * 72);
  float* A0 = (float*)qL;
  float* A1 = (float*)kL;
  int tid = threadIdx.x;
  asm volatile("" : "+v"(tid));
  const int lane = tid & 63, w = __builtin_amdgcn_readfirstlane(tid >> 6), r = lane & 31, hh = lane >> 5;
  const int bh = item >> 6, c = item & 63, b = bh >> 2, h = bh & 3;
  const int t0 = b * SEQ + c * 64;
  __syncthreads();
  {
#pragma unroll
    for (int sec = 0; sec < 3; ++sec) {
      const int c0 = sec * 512 + h * 128 + 2 * lane;
      float cw0[5], cw1[5];
#pragma unroll
      for (int j = 0; j < 5; ++j) { cw0[j] = conv_w[c0 * 5 + j]; cw1[j] = conv_w[(c0 + 1) * 5 + j]; }
      unsigned raw[20];
#pragma unroll
      for (int k = 0; k < 20; ++k) {
        const int sp = c * 64 + w * 16 + k - 2;
        raw[k] = (sp >= 0 && sp < SEQ) ? *(const unsigned*)(pm + ((size_t)t0 + w * 16 + k - 2) * 4096 + c0) : 0u;
      }
#pragma unroll
      for (int ii = 0; ii < 16; ++ii) {
        const int i = w * 16 + ii;
        float a0 = 0.f, a1 = 0.f;
#pragma unroll
        for (int j = 0; j < 5; ++j) {
          a0 += cw0[j] * bf2f((unsigned short)(raw[ii + j] & 0xffff));
          a1 += cw1[j] * __uint_as_float(raw[ii + j] & 0xffff0000u);
        }
        a0 = a0 * __builtin_amdgcn_rcpf(1.f + __builtin_amdgcn_exp2f(-1.4426950408889634f * a0));
        a1 = a1 * __builtin_amdgcn_rcpf(1.f + __builtin_amdgcn_exp2f(-1.4426950408889634f * a1));
        if (sec < 2) {
          const float ss = wave_sum_dpp(a0 * a0 + a1 * a1);
          float sc = rsqrtf(ss + EPSF);
          if (sec == 0) sc *= 0.08838834764831845f;
          a0 *= sc; a1 *= sc;
        }
        if (sec == 0) {
          *(unsigned*)(qL + i * 144 + 2 * lane) = pack2(a0, a1);
        } else if (sec == 1) {
          const unsigned pk = pack2(a0, a1);
          *(unsigned*)(kL + i * 144 + 2 * lane) = pk;
          kTL[(2 * lane) * 72 + i] = (unsigned short)(pk & 0xffff);
          kTL[(2 * lane + 1) * 72 + i] = (unsigned short)(pk >> 16);
        } else {
          const unsigned pk = pack2(a0, a1);
          vTL[(2 * lane) * 72 + i] = (unsigned short)(pk & 0xffff);
          vTL[(2 * lane + 1) * 72 + i] = (unsigned short)(pk >> 16);
        }
      }
    }
  }
  if (w == 0) {
    const float* gp = gt + ((size_t)t0 + lane) * 32;
    const float g0 = gp[h], g1 = gp[4 + h], b0 = gp[8 + h], b1 = gp[12 + h];
    float G0 = g0, G1 = g1;
#pragma unroll
    for (int o = 1; o < 64; o <<= 1) {
      const float v0 = __shfl_up(G0, o, 64);
      const float v1 = __shfl_down(G1, o, 64);
      if (lane >= o) G0 += v0;
      if (lane + o < 64) G1 += v1;
    }
    scal[lane] = G0 * 1.4426950408889634f; scal[64 + lane] = G1 * 1.4426950408889634f;
    scal[128 + lane] = b0; scal[192 + lane] = b1;
    const float GL0 = __shfl(G0, 63, 64), GL1 = __shfl(G1, 0, 64);
    float* gs0 = G.gsc + ((size_t)((bh * 2 + 0) * 64 + c)) * 192;
    float* gs1 = G.gsc + ((size_t)((bh * 2 + 1) * 64 + c)) * 192;
    gs0[lane] = expf(G0); gs0[64 + lane] = expf(GL0 - G0);
    gs1[lane] = expf(G1); gs1[64 + lane] = expf(GL1 - G1);
    if (lane == 0) { gs0[128] = expf(GL0); gs1[128] = expf(GL1); }
  }
  __syncthreads();
  {
    unsigned short* qg = G.qc + (size_t)item * 8192;
    unsigned short* kg = G.kTc + (size_t)item * 8192;
#pragma unroll
    for (int i = 0; i < 4; ++i) {
      const int id = tid + i * 256;
      {
        const int row = id >> 4, c16 = id & 15;
        *(uint4*)(qg + (row >> 5) * 4096 + ((c16 >> 1) * 64 + (c16 & 1) * 32 + (row & 31)) * 8) = *(const uint4*)(qL + row * 144 + c16 * 8);
      }
      {
        const int row = id >> 3, c8 = id & 7;
        *(uint4*)(kg + (row >> 5) * 2048 + ((c8 >> 1) * 64 + (c8 & 1) * 32 + (row & 31)) * 8) = *(const uint4*)(kTL + row * 72 + c8 * 8);
      }
    }
  }
  {
    const int ta = w >> 1, tb = w & 1;
    f32x16 acc, acc2;
#pragma unroll
    for (int i = 0; i < 16; ++i) { acc[i] = 0.f; acc2[i] = 0.f; }
#pragma unroll
    for (int s = 0; s < 8; ++s) {
      const bf16x8 a = *(const bf16x8*)(kL + (32 * ta + r) * 144 + 16 * s + 8 * hh);
      const bf16x8 bk = *(const bf16x8*)(kL + (32 * tb + r) * 144 + 16 * s + 8 * hh);
      const bf16x8 bq = *(const bf16x8*)(qL + (32 * tb + r) * 144 + 16 * s + 8 * hh);
      acc = MFMA32(a, bk, acc);
      acc2 = MFMA32(a, bq, acc2);
    }
    __syncthreads();
    {
      const int col = 32 * tb + r;
      const float G0c = scal[col], G1c = scal[64 + col];
#pragma unroll
      for (int reg = 0; reg < 16; ++reg) {
        const int row = 32 * ta + crow(reg, hh);
        const float v = acc[reg];
        const float a0 = (col < row) ? scal[128 + row] * v * __builtin_amdgcn_exp2f(scal[row] - G0c) : 0.f;
        const float a1 = (col > row) ? scal[192 + row] * v * __builtin_amdgcn_exp2f(scal[64 + row] - G1c) : 0.f;
        A0[row * 72 + col] = a0;
        A1[(63 - row) * 72 + (63 - col)] = a1;
      }
    }
    {
      const int i = 32 * tb + r;
      const float G0i = scal[i], G1i = scal[64 + i];
      unsigned short* qk0 = G.qkc + ((size_t)((bh * 2 + 0) * 64 + c)) * 4096;
      unsigned short* qk1 = G.qkc + ((size_t)((bh * 2 + 1) * 64 + c)) * 4096;
#pragma unroll
      for (int g = 0; g < 4; ++g) {
        float o0[4], o1[4];
#pragma unroll
        for (int e = 0; e < 4; ++e) {
          const int j = 32 * ta + 8 * g + 4 * hh + e;
          const float v = acc2[4 * g + e];
          o0[e] = (j <= i) ? v * __builtin_amdgcn_exp2f(G0i - scal[j]) : 0.f;
          o1[e] = (j >= i) ? v * __builtin_amdgcn_exp2f(G1i - scal[64 + j]) : 0.f;
        }
        uint2 p0, p1;
        p0.x = pack2(o0[0], o0[1]); p0.y = pack2(o0[2], o0[3]);
        p1.x = pack2(o1[0], o1[1]); p1.y = pack2(o1[2], o1[3]);
        const int qoff = tb * 2048 + ((2 * ta + (g >> 1)) * 64 + (g & 1) * 32 + r) * 8 + 4 * hh;
        *(uint2*)(qk0 + qoff) = p0;
        *(uint2*)(qk1 + qoff) = p1;
      }
    }
  }
  __syncthreads();
  if (w < 2) {
    const int dir = w;
    float T[64];
    tri_subst(A0 + dir * (64 * 72), lane, T);
    const int jn = dir ? 63 - lane : lane;
    const float sb = scal[128 + 64 * dir + jn];
    const float sbg = sb * __builtin_amdgcn_exp2f(scal[64 * dir + jn]);
    unsigned short* Tb = dir ? kL : qL;
    unsigned short* Tbg = Tb + 64 * 72;
#pragma unroll
    for (int ip = 0; ip < 64; ++ip) {
      const int in = dir ? 63 - ip : ip;
      Tb[in * 72 + jn] = f2bf(T[ip] * sb);
      Tbg[in * 72 + jn] = f2bf(T[ip] * sbg);
    }
  }
  __syncthreads();
#pragma unroll
  for (int d = 0; d < 2; ++d) {
    const int chain = bh * 2 + d;
    const unsigned short* Tb = d ? kL : qL;
    const unsigned short* Tbg = Tb + 64 * 72;
    unsigned short* wng = G.wn + ((size_t)(chain * 64 + c)) * 8192;
    unsigned short* uog = G.uo + ((size_t)(chain * 64 + c)) * 8192 + w * 2048;
#pragma unroll
    for (int tb = 0; tb < 2; ++tb) {
      f32x16 acc, acc2;
#pragma unroll
      for (int i = 0; i < 16; ++i) { acc[i] = 0.f; acc2[i] = 0.f; }
#pragma unroll
      for (int s = 0; s < 4; ++s) {
        const bf16x8 a = *(const bf16x8*)(kTL + (32 * w + r) * 72 + 16 * s + 8 * hh);
        const bf16x8 bb = *(const bf16x8*)(Tbg + (32 * tb + r) * 72 + 16 * s + 8 * hh);
        acc = MFMA32(a, bb, acc);
        const bf16x8 a2 = *(const bf16x8*)(Tb + (32 * tb + r) * 72 + 16 * s + 8 * hh);
        const bf16x8 b2 = *(const bf16x8*)(vTL + (32 * w + r) * 72 + 16 * s + 8 * hh);
        acc2 = MFMA32(a2, b2, acc2);
      }
#pragma unroll
      for (int g = 0; g < 4; ++g) {
        uint2 pk;
        pk.x = pack2(-acc[4 * g], -acc[4 * g + 1]); pk.y = pack2(-acc[4 * g + 2], -acc[4 * g + 3]);
        *(uint2*)(wng + tb * 4096 + ((2 * w + (g >> 1)) * 64 + (g & 1) * 32 + r) * 8 + 4 * hh) = pk;
      }
      uint4 u0, u1;
      u0.x = pack2(acc2[0], acc2[1]); u0.y = pack2(acc2[2], acc2[3]); u0.z = pack2(acc2[4], acc2[5]); u0.w = pack2(acc2[6], acc2[7]);
      u1.x = pack2(acc2[8], acc2[9]); u1.y = pack2(acc2[10], acc2[11]); u1.z = pack2(acc2[12], acc2[13]); u1.w = pack2(acc2[14], acc2[15]);
      *(uint4*)(uog + tb * 1024 + lane * 16) = u0;
      *(uint4*)(uog + tb * 1024 + lane * 16 + 8) = u1;
    }
  }
}

struct GdnOps {
  bf16x8 a[8];
  bf16x8 x[4];
  bf16x8 kt[4];
  float4 rs[4];
  float gtot;
};
__device__ __forceinline__ void gdn_load(GdnOps& o, const GdnBufs& G, int chain, int bh, int c, int sl, int w, int r, int hh, int lane) {
  const unsigned short* kT_c = G.kTc + ((size_t)(bh * 64 + c)) * 8192;
  const float* gs = G.gsc + ((size_t)(chain * 64 + c)) * 192;
  const int ti = w & 1;
#pragma unroll
  for (int s = 0; s < 4; ++s) o.kt[s] = *(const bf16x8*)(kT_c + w * 2048 + (s * 64 + lane) * 8);
  o.gtot = gs[128];
  if (w < 2) {
    const unsigned short* wn_c = G.wn + ((size_t)(chain * 64 + c)) * 8192;
    const unsigned short* uo_c = G.uo + ((size_t)(chain * 64 + c)) * 8192 + sl * 2048;
#pragma unroll
    for (int s = 0; s < 8; ++s) o.a[s] = *(const bf16x8*)(wn_c + ti * 4096 + (s * 64 + lane) * 8);
    o.x[0] = *(const bf16x8*)(uo_c + ti * 1024 + lane * 16);
    o.x[1] = *(const bf16x8*)(uo_c + ti * 1024 + lane * 16 + 8);
#pragma unroll
    for (int g = 0; g < 4; ++g) o.rs[g] = *(const float4*)(gs + 64 + 32 * ti + 8 * g + 4 * hh);
  } else {
    const unsigned short* q_c = G.qc + ((size_t)(bh * 64 + c)) * 8192;
    const unsigned short* qk_c = G.qkc + ((size_t)(chain * 64 + c)) * 4096;
#pragma unroll
    for (int s = 0; s < 8; ++s) o.a[s] = *(const bf16x8*)(q_c + ti * 4096 + (s * 64 + lane) * 8);
#pragma unroll
    for (int s = 0; s < 4; ++s) o.x[s] = *(const bf16x8*)(qk_c + ti * 2048 + (s * 64 + lane) * 8);
#pragma unroll
    for (int g = 0; g < 4; ++g) o.rs[g] = *(const float4*)(gs + 32 * ti + 8 * g + 4 * hh);
  }
}
__device__ __forceinline__ void gdn_step(const GdnOps& o, f32x16& S, unsigned short* ST, unsigned short* VT, unsigned short* VdT,
                                         unsigned short* uo_c, int w, int r, int hh) {
  const int ti = w & 1;
  f32x16 acc;
  if (w < 2) {
#pragma unroll
    for (int i = 0; i < 8; ++i) {
      acc[i] = bf2f((unsigned short)o.x[0][i]);
      acc[8 + i] = bf2f((unsigned short)o.x[1][i]);
    }
  } else {
#pragma unroll
    for (int i = 0; i < 16; ++i) acc[i] = 0.f;
  }
#pragma unroll
  for (int g = 0; g < 4; ++g) {
    uint2 pk;
    pk.x = pack2(S[4 * g], S[4 * g + 1]); pk.y = pack2(S[4 * g + 2], S[4 * g + 3]);
    *(uint2*)(ST + r * 136 + 32 * w + 8 * g + 4 * hh) = pk;
  }
  __syncthreads();
#pragma unroll
  for (int s = 0; s < 8; ++s) {
    const bf16x8 bs = *(const bf16x8*)(ST + r * 136 + 16 * s + 8 * hh);
    acc = MFMA32(o.a[s], bs, acc);
  }
  if (w < 2) {
#pragma unroll
    for (int g = 0; g < 4; ++g) {
      uint2 pk, pd;
      pk.x = pack2(acc[4 * g], acc[4 * g + 1]); pk.y = pack2(acc[4 * g + 2], acc[4 * g + 3]);
      pd.x = pack2(acc[4 * g] * o.rs[g].x, acc[4 * g + 1] * o.rs[g].y);
      pd.y = pack2(acc[4 * g + 2] * o.rs[g].z, acc[4 * g + 3] * o.rs[g].w);
      *(uint2*)(VT + r * 72 + 32 * ti + 8 * g + 4 * hh) = pk;
      *(uint2*)(VdT + r * 72 + 32 * ti + 8 * g + 4 * hh) = pd;
    }
  } else {
#pragma unroll
    for (int g = 0; g < 4; ++g) {
      acc[4 * g] *= o.rs[g].x; acc[4 * g + 1] *= o.rs[g].y; acc[4 * g + 2] *= o.rs[g].z; acc[4 * g + 3] *= o.rs[g].w;
    }
  }
  __syncthreads();
  if (w >= 2) {
#pragma unroll
    for (int s = 0; s < 4; ++s) {
      const bf16x8 bv = *(const bf16x8*)(VT + r * 72 + 16 * s + 8 * hh);
      acc = MFMA32(o.x[s], bv, acc);
    }
#pragma unroll
    for (int reg = 0; reg < 16; ++reg) uo_c[(32 * ti + crow(reg, hh)) * 32 + r] = f2bf(acc[reg]);
  }
#pragma unroll
  for (int i = 0; i < 16; ++i) S[i] *= o.gtot;
#pragma unroll
  for (int s = 0; s < 4; ++s) {
    const bf16x8 bv = *(const bf16x8*)(VdT + r * 72 + 16 * s + 8 * hh);
    S = MFMA32(o.kt[s], bv, S);
  }
}
__device__ __forceinline__ void d_gdn_scan(int chain, int sl, char* smem, GdnBufs G) {
  unsigned short* ST = (unsigned short*)smem;
  unsigned short* VT = ST + 32 * 136;
  unsigned short* VdT = VT + 32 * 72;
  const int tid = threadIdx.x, lane = tid & 63, w = __builtin_amdgcn_readfirstlane(tid >> 6), r = lane & 31, hh = lane >> 5;
  const int bh = chain >> 1, dir = chain & 1;
  f32x16 S;
#pragma unroll
  for (int i = 0; i < 16; ++i) S[i] = 0.f;
  GdnOps A, B;
  gdn_load(A, G, chain, bh, dir ? 63 : 0, sl, w, r, hh, lane);
  for (int step = 0; step < 64; step += 2) {
    const int c0 = dir ? 63 - step : step;
    const int c1 = dir ? c0 - 1 : c0 + 1;
    const int c2 = dir ? c0 - 2 : c0 + 2;
    gdn_load(B, G, chain, bh, c1, sl, w, r, hh, lane);
    gdn_step(A, S, ST, VT, VdT, G.uo + ((size_t)(chain * 64 + c0)) * 8192 + sl * 2048, w, r, hh);
    if (step + 2 < 64) gdn_load(A, G, chain, bh, c2, sl, w, r, hh, lane);
    gdn_step(B, S, ST, VT, VdT, G.uo + ((size_t)(chain * 64 + c1)) * 8192 + sl * 2048, w, r, hh);
  }
}

__device__ __forceinline__ void d_ml_gates(int item, const float* __restrict__ gt, float* __restrict__ pre, float* __restrict__ gtots) {
  const int wv = item * 4 + (threadIdx.x >> 6);
  const int lane = threadIdx.x & 63;
  const int chain = wv >> 6, c = wv & 63;
  const int bh = chain >> 1, dir = chain & 1, b = bh >> 2, h = bh & 3;
  const size_t t0 = (size_t)b * SEQ + c * 64;
  const float lf = gt[(t0 + lane) * 32 + 24 + dir * 4 + h];
  const float ip = gt[(t0 + lane) * 32 + 16 + dir * 4 + h];
  float bc = lf;
#pragma unroll
  for (int ofs = 1; ofs < 64; ofs <<= 1) {
    const float vu = __shfl_up(bc, ofs, 64);
    const float vd = __shfl_down(bc, ofs, 64);
    if (dir == 0) { if (lane >= ofs) bc += vu; } else { if (lane + ofs < 64) bc += vd; }
  }
  const float b_last = __shfl(bc, dir ? 0 : 63, 64);
  float4 o;
  o.x = expf(bc);
  o.y = (ip - bc) * 1.4426950408889634f - 3.5f;
  o.z = bc * 1.4426950408889634f;
  o.w = 0.08838834764831845f * expf(b_last - bc + ip);
  *(float4*)(pre + ((size_t)chain * SEQ + c * 64 + lane) * 4) = o;
  if (lane == 0) gtots[wv] = expf(b_last);
}

#define ML_LDK(R, I, T0) R = *(const uint4*)(pm + ((T0) + ((t128 + (I) * 128) >> 4)) * 4096 + 2560 + h * 128 + (t128 & 15) * 8);
#define ML_STK(R, I) *(uint4*)(kLb + ((t128 + (I) * 128) >> 4) * 136 + (t128 & 15) * 8) = R;
#define ML_LOAD(T0)                                                                                         \
  {                                                                                                         \
    ML_LDK(pk0, 0, T0) ML_LDK(pk1, 1, T0) ML_LDK(pk2, 2, T0) ML_LDK(pk3, 3, T0)                             \
    ML_LDK(pk4, 4, T0) ML_LDK(pk5, 5, T0) ML_LDK(pk6, 6, T0) ML_LDK(pk7, 7, T0)                             \
    pv0 = *(const uint4*)(pm + ((T0) + (t128 >> 2)) * 4096 + 3072 + h * 128 + sl * 32 + (t128 & 3) * 8);    \
    pv1 = *(const uint4*)(pm + ((T0) + ((t128 + 128) >> 2)) * 4096 + 3072 + h * 128 + sl * 32 + (t128 & 3) * 8); \
    pgl = *(const float4*)(pre + ((size_t)chain * SEQ + ((T0) - tb) + lane) * 4);                           \
    pgt = gtots[chain * 64 + (int)(((T0) - tb) >> 6)];                                                      \
  }
#define ML_PUTV(W, E)                                                                                       \
  {                                                                                                         \
    const unsigned short lo_ = (unsigned short)((W) & 0xffff), hi_ = (unsigned short)((W) >> 16);           \
    vTb[(d8_ + (E)) * 72 + tok_] = lo_;                                                                     \
    vTb[(d8_ + (E) + 1) * 72 + tok_] = hi_;                                                                 \
    const unsigned sc_ = pack2(bf2f(lo_) * dj_, bf2f(hi_) * dj_);                                           \
    vdb[(d8_ + (E)) * 72 + tok_] = (unsigned short)(sc_ & 0xffff);                                          \
    vdb[(d8_ + (E) + 1) * 72 + tok_] = (unsigned short)(sc_ >> 16);                                         \
  }
#define ML_STAGE(BUF)                                                                                       \
  {                                                                                                         \
    unsigned short* kLb = kL + (BUF) * (64 * 136);                                                          \
    unsigned short* vTb = vTL + (BUF) * (32 * 72);                                                          \
    unsigned short* vdb = vdTL + (BUF) * (32 * 72);                                                         \
    float* scb = scal + (BUF) * 208;                                                                        \
    if (w == 2) {                                                                                           \
      scb[lane] = pgl.x; scb[64 + lane] = pgl.y; scb[128 + lane] = pgl.z;                                   \
      dL[(BUF) * 72 + lane] = f2bf(pgl.w);                                                                  \
      if (lane == 0) scb[192] = pgt;                                                                        \
    }                                                                                                       \
    ML_STK(pk0, 0) ML_STK(pk1, 1) ML_STK(pk2, 2) ML_STK(pk3, 3) ML_STK(pk4, 4) ML_STK(pk5, 5) ML_STK(pk6, 6) ML_STK(pk7, 7) \
    {                                                                                                       \
      const int tok_ = t128 >> 2, d8_ = (t128 & 3) * 8;                                                     \
      const float dj_ = __shfl(pgl.w, tok_, 64);                                                            \
      ML_PUTV(pv0.x, 0); ML_PUTV(pv0.y, 2); ML_PUTV(pv0.z, 4); ML_PUTV(pv0.w, 6);                           \
    }                                                                                                       \
    {                                                                                                       \
      const int tok_ = (t128 + 128) >> 2, d8_ = (t128 & 3) * 8;                                             \
      const float dj_ = __shfl(pgl.w, tok_, 64);                                                            \
      ML_PUTV(pv1.x, 0); ML_PUTV(pv1.y, 2); ML_PUTV(pv1.z, 4); ML_PUTV(pv1.w, 6);                           \
    }                                                                                                       \
  }
__device__ __forceinline__ void ml_state_image(const f32x16& S0, const f32x16& S1, unsigned short* S0T, unsigned short* nL, int w, int r, int hh) {
#pragma unroll
  for (int g = 0; g < 4; ++g) {
    uint2 pk;
    pk.x = pack2(S0[4 * g], S0[4 * g + 1]); pk.y = pack2(S0[4 * g + 2], S0[4 * g + 3]);
    *(uint2*)(S0T + r * 136 + 32 * w + 8 * g + 4 * hh) = pk;
    if (r == 0) {
      uint2 pn;
      pn.x = pack2(S1[4 * g], S1[4 * g + 1]); pn.y = pack2(S1[4 * g + 2], S1[4 * g + 3]);
      *(uint2*)(nL + 32 * w + 8 * g + 4 * hh) = pn;
    }
  }
}
__device__ __forceinline__ void ml_state_update(f32x16& S0, f32x16& S1, const unsigned short* kLb, const unsigned short* vdb,
                                                const unsigned short* dLb, float gtot, int w, int r, int hh) {
#pragma unroll
  for (int i = 0; i < 16; ++i) { S0[i] *= gtot; S1[i] *= gtot; }
#pragma unroll
  for (int s2 = 0; s2 < 4; ++s2) {
    union { bf16x8 v; unsigned short e[8]; } a;
#pragma unroll
    for (int e = 0; e < 8; ++e) a.e[e] = kLb[(16 * s2 + 8 * hh + e) * 136 + 32 * w + r];
    const bf16x8 bv = *(const bf16x8*)(vdb + r * 72 + 16 * s2 + 8 * hh);
    const bf16x8 bd = *(const bf16x8*)(dLb + 16 * s2 + 8 * hh);
    S0 = MFMA32(a.v, bv, S0);
    S1 = MFMA32(a.v, bd, S1);
  }
}
__device__ __forceinline__ void d_mlstm_scan(int chain, int sl, char* smem, const unsigned short* __restrict__ pm,
                                             const float* __restrict__ pre, const float* __restrict__ gtots,
                                             unsigned short* __restrict__ oM, int ntok) {
  unsigned short* kL = (unsigned short*)smem;
  unsigned short* vTL = kL + 2 * 64 * 136;
  unsigned short* vdTL = vTL + 2 * 32 * 72;
  unsigned short* dL = vdTL + 2 * 32 * 72;
  unsigned short* S0T = dL + 256;
  unsigned short* nL = S0T + 32 * 136;
  float* scal = (float*)(nL + 256);
  int tid = threadIdx.x;
  asm volatile("" : "+v"(tid));
  const int lane = tid & 63, w = __builtin_amdgcn_readfirstlane(tid >> 6), r = lane & 31, hh = lane >> 5;
  const int bh = chain >> 1, dir = chain & 1, b = bh >> 2, h = bh & 3;
  f32x16 S0, S1;
#pragma unroll
  for (int i = 0; i < 16; ++i) { S0[i] = 0.f; S1[i] = 0.f; }
  unsigned short* oMb = oM + (size_t)dir * ntok * 512 + h * 128 + sl * 32;
  const size_t tb = (size_t)b * SEQ;
  __syncthreads();
  ml_state_image(S0, S1, S0T, nL, w, r, hh);
  if (w >= 2) {
    const int t128 = tid - 128;
    uint4 pk0, pk1, pk2, pk3, pk4, pk5, pk6, pk7, pv0, pv1;
    float4 pgl;
    float pgt;
    ML_LOAD(tb + (dir ? 63 : 0) * 64);
    ML_STAGE(0);
    ML_LOAD(tb + (dir ? 62 : 1) * 64);
    for (int step = 0; step < 64; ++step) {
      const int c0 = dir ? 63 - step : step;
      const int c2 = dir ? c0 - 2 : c0 + 2;
      const int buf = step & 1;
      __syncthreads();
      const float gtot = scal[buf * 208 + 192];
      ML_STAGE(buf ^ 1);
      {
        const int cl = (step + 2 < 64) ? c2 : c0;
        ML_LOAD(tb + cl * 64);
      }
      ml_state_update(S0, S1, kL + buf * (64 * 136), vdTL + buf * (32 * 72), dL + buf * 72, gtot, w, r, hh);
      __syncthreads();
      ml_state_image(S0, S1, S0T, nL, w, r, hh);
    }
  } else {
    bf16x8 ones;
#pragma unroll
    for (int i = 0; i < 8; ++i) ones[i] = (short)0x3F80;
    const int ti = w;
    const int icol = 32 * ti + r;
    float dmask[16];
#pragma unroll
    for (int reg = 0; reg < 16; ++reg) {
      const int jl = crow(reg, hh);
      dmask[reg] = (dir ? (jl >= r) : (jl <= r)) ? 1.f : 0.f;
    }
    bf16x8 qf[8];
    {
      const unsigned short* qp = pm + (tb + (size_t)(dir ? 63 : 0) * 64 + 32 * ti + r) * 4096 + 2048 + h * 128 + 8 * hh;
#pragma unroll
      for (int s2 = 0; s2 < 8; ++s2) qf[s2] = *(const bf16x8*)(qp + 16 * s2);
    }
    for (int step = 0; step < 64; ++step) {
      const int c0 = dir ? 63 - step : step;
      const int c1 = dir ? c0 - 1 : c0 + 1;
      const int buf = step & 1;
      const unsigned short* kLb = kL + buf * (64 * 136);
      const unsigned short* vTb = vTL + buf * (32 * 72);
      const float* scb = scal + buf * 208;
      __syncthreads();
      const float bci = scb[128 + icol];
      const float gtot = scb[192];
      f32x16 Q0, Q1;
#pragma unroll
      for (int i = 0; i < 16; ++i) { Q0[i] = 0.f; Q1[i] = 0.f; }
#pragma unroll
      for (int s2 = 0; s2 < 8; ++s2) {
        const bf16x8 b0 = *(const bf16x8*)(S0T + r * 136 + 16 * s2 + 8 * hh);
        const bf16x8 b1 = *(const bf16x8*)(nL + 16 * s2 + 8 * hh);
        Q0 = MFMA32(qf[s2], b0, Q0);
        Q1 = MFMA32(qf[s2], b1, Q1);
      }
#pragma unroll
      for (int g = 0; g < 4; ++g) {
        const float4 e4 = *(const float4*)(scb + 32 * ti + 8 * g + 4 * hh);
        Q0[4 * g] *= e4.x; Q0[4 * g + 1] *= e4.y; Q0[4 * g + 2] *= e4.z; Q0[4 * g + 3] *= e4.w;
        Q1[4 * g] *= e4.x; Q1[4 * g + 1] *= e4.y; Q1[4 * g + 2] *= e4.z; Q1[4 * g + 3] *= e4.w;
      }
#pragma unroll
      for (int tj = 0; tj < 2; ++tj) {
        if (dir ? (tj < ti) : (tj > ti)) continue;
        f32x16 X;
#pragma unroll
        for (int i = 0; i < 16; ++i) X[i] = 0.f;
#pragma unroll
        for (int s2 = 0; s2 < 8; ++s2) {
          const bf16x8 a = *(const bf16x8*)(kLb + (32 * tj + r) * 136 + 16 * s2 + 8 * hh);
          X = MFMA32(a, qf[s2], X);
        }
        if (tj == ti) {
#pragma unroll
          for (int g = 0; g < 4; ++g) {
            const float4 cj4 = *(const float4*)(scb + 64 + 32 * tj + 8 * g + 4 * hh);
            X[4 * g + 0] *= __builtin_amdgcn_exp2f(fminf(bci + cj4.x, 80.f)) * dmask[4 * g + 0];
            X[4 * g + 1] *= __builtin_amdgcn_exp2f(fminf(bci + cj4.y, 80.f)) * dmask[4 * g + 1];
            X[4 * g + 2] *= __builtin_amdgcn_exp2f(fminf(bci + cj4.z, 80.f)) * dmask[4 * g + 2];
            X[4 * g + 3] *= __builtin_amdgcn_exp2f(fminf(bci + cj4.w, 80.f)) * dmask[4 * g + 3];
          }
        } else {
#pragma unroll
          for (int g = 0; g < 4; ++g) {
            const float4 cj4 = *(const float4*)(scb + 64 + 32 * tj + 8 * g + 4 * hh);
            X[4 * g + 0] *= __builtin_amdgcn_exp2f(bci + cj4.x);
            X[4 * g + 1] *= __builtin_amdgcn_exp2f(bci + cj4.y);
            X[4 * g + 2] *= __builtin_amdgcn_exp2f(bci + cj4.z);
            X[4 * g + 3] *= __builtin_amdgcn_exp2f(bci + cj4.w);
          }
        }
#pragma unroll
        for (int s2 = 0; s2 < 2; ++s2) {
          union { bf16x8 v; unsigned u[4]; } xa, bv;
          xa.u[0] = pack2(X[8 * s2 + 0], X[8 * s2 + 1]); xa.u[1] = pack2(X[8 * s2 + 2], X[8 * s2 + 3]);
          xa.u[2] = pack2(X[8 * s2 + 4], X[8 * s2 + 5]); xa.u[3] = pack2(X[8 * s2 + 6], X[8 * s2 + 7]);
          const uint2 v0 = *(const uint2*)(vTb + r * 72 + 32 * tj + 16 * s2 + 4 * hh);
          const uint2 v1 = *(const uint2*)(vTb + r * 72 + 32 * tj + 16 * s2 + 8 + 4 * hh);
          bv.u[0] = v0.x; bv.u[1] = v0.y; bv.u[2] = v1.x; bv.u[3] = v1.y;
          Q0 = MFMA32(xa.v, bv.v, Q0);
          Q1 = MFMA32(xa.v, ones, Q1);
        }
      }
      {
        const int cn = (step + 1 < 64) ? c1 : c0;
        const unsigned short* qp = pm + (tb + (size_t)cn * 64 + 32 * ti + r) * 4096 + 2048 + h * 128 + 8 * hh;
#pragma unroll
        for (int s2 = 0; s2 < 8; ++s2) qf[s2] = *(const bf16x8*)(qp + 16 * s2);
      }
      const size_t orow0 = tb + c0 * 64;
#pragma unroll
      for (int reg = 0; reg < 16; ++reg) {
        const int i = 32 * ti + crow(reg, hh);
        oMb[(orow0 + i) * 512 + r] = f2bf(Q0[reg] * __builtin_amdgcn_rcpf(fmaxf(fabsf(Q1[reg]), 1.f)));
      }
      ml_state_update(S0, S1, kLb, vdTL + buf * (32 * 72), dL + buf * 72, gtot, w, r, hh);
      __syncthreads();
      ml_state_image(S0, S1, S0T, nL, w, r, hh);
    }
  }
}

struct MKP {
  const float *x, *norm1_g, *w_in, *conv_w, *a_log, *dt_bias, *gdn_g, *i_bias, *f_bias, *ml_g, *w_out, *norm2_g, *peer_wq,
      *peer_keys, *peer_u, *peer_v, *normf_g;
  float* out;
  unsigned short *pm, *x1b, *woutT, *mt, *xb, *winT, *oM, *yb, *scores, *qkv_dbg, *oA_dbg;
  unsigned *utab, *vtab;
  unsigned short *wqb, *keyb;
  float *uscale, *vscale;
  float *x1, *rs1, *rs2, *gt, *gateb, *dbg, *mlpre, *mlgt;
  unsigned* bar;
  int* idxb;
  GdnBufs G;
};

constexpr int SMEM_BYTES = 74752;
__global__ void __launch_bounds__(256, 2) k_mega(MKP P) {
  __shared__ __attribute__((aligned(16))) char smem_c[SMEM_BYTES + 16];
  {
    volatile LAS unsigned* st0 = (volatile LAS unsigned*)(smem_c + SMEM_BYTES);
    if (threadIdx.x < 4) st0[threadIdx.x] = 0u;
  }
  __syncthreads();
  XcdBarrier xb = xcd_barrier_post(P.bar, (volatile LAS unsigned*)(smem_c + SMEM_BYTES));
  unsigned short* smem = (unsigned short*)smem_c;
  const int nb = gridDim.x, bid = blockIdx.x;
  for (int it = bid; it < NT / 4; it += nb) d_prep_x(it, P.x, P.xb, P.rs1);
  for (int it = bid; it < 16 * 66; it += nb) d_transpose_w(it, 66, (float*)smem_c, P.w_in, DIN, P.norm1_g, P.winT, 1);
  for (int it = bid; it < 16 * 16; it += nb) d_transpose_w(it, 16, (float*)smem_c, P.w_out, 1024, nullptr, P.woutT, 0);
  for (int it = bid; it < 1024; it += nb) d_cvt_bf16(it, P.peer_wq, P.wqb, P.norm2_g, 11);
  for (int it = bid; it < 128; it += nb) d_cvt_bf16(it, P.peer_keys, P.keyb, nullptr, 0);
  if (bid == 0 && threadIdx.x < 4) P.dbg[threadIdx.x] = 0.f;
  xcd_barrier(xb);
  {
    GemmP p{};
    p.A = P.xb; p.lda = DM; p.Bt = P.winT; p.ldb = DM; p.K = DM;
    p.rowscale = P.rs1; p.obf = P.pm; p.ldo = 4096; p.of32 = P.gt; p.ldf = 32; p.resid = nullptr;
    p.a_log = P.a_log; p.dt_bias = P.dt_bias; p.i_bias = P.i_bias; p.f_bias = P.f_bias;
    for (int k = 0;; ++k) {
      int tm, tn;
      if (!xcd_tile(bid, nb, k, 33, tm, tn)) break;
      gemm_tile<EPI_INPROJ>(p, tm, tn, smem);
      __syncthreads();
    }
  }
  for (int tile = bid; tile < 16 * 8; tile += nb) {
    const int hp = tile >> 3, tn = tile & 7;
    GemmP p{};
    p.A = P.keyb + (size_t)hp * 128 * 128; p.lda = 128; p.Bt = P.wqb + hp * 128; p.ldb = 2048; p.K = 128;
    p.obf = P.mt + (size_t)hp * 128 * DM; p.ldo = DM;
    gemm_tile<EPI_PLAIN>(p, 0, tn, smem);
    __syncthreads();
  }
  xcd_barrier(xb);
  for (int it = bid; it < 512; it += nb) d_ml_gates(it, P.gt, P.mlpre, P.mlgt);
  for (int it = bid; it < 1024; it += nb) d_gdn_prep(it, smem_c, P.pm, P.gt, P.conv_w, P.G);
  xcd_barrier(xb);
  if (bid < 128) {
    d_gdn_scan(bid >> 2, bid & 3, smem_c, P.G);
  } else if (bid < 256) {
    d_mlstm_scan((bid - 128) >> 2, (bid - 128) & 3, smem_c, P.pm, P.mlpre, P.mlgt, P.oM, NT);
  }
#ifdef DBG_CHECK
  if (bid < 4) {
    __syncthreads();
    const int half = threadIdx.x >> 7;
    float* sq = (float*)smem + half * 256;
    float* sk = sq + 128;
    d_mlstm_rec(bid * 2 + half, sq, sk, P.pm, P.gt, P.oA_dbg, 4096);
  }
#endif
  xcd_barrier(xb);
  for (int it = bid; it < NT / 4; it += nb) d_combine(it, P.G.uo, P.oM, P.pm, P.gdn_g, P.ml_g, P.yb);
#ifdef DBG_CHECK
  for (int it = bid; it < 4096 / 4; it += nb) d_dbg_cmp_m(it, P.oM, P.oA_dbg, P.dbg);
#endif
  xcd_barrier(xb);
  {
    GemmP p{};
    p.A = P.yb; p.lda = DM; p.Bt = P.woutT; p.ldb = DM; p.K = DM;
    p.rowscale = nullptr; p.obf = P.x1b; p.ldo = DM; p.of32 = P.x1; p.ldf = DM; p.resid = P.x; p.rowacc = P.rs2;
    for (int k = 0;; ++k) {
      int tm, tn;
      if (!xcd_tile(bid, nb, k, 8, tm, tn)) break;
      gemm_tile<EPI_OUTPROJ>(p, tm, tn, smem);
      __syncthreads();
    }
  }
  for (int it = bid; it < 4096; it += nb) { d_cvt_tab_i8(it, P.peer_u, P.utab, P.uscale); d_cvt_tab(it, P.peer_v, P.vtab, P.vscale); }
  xcd_barrier(xb);
  {
    GemmP p{};
    p.A = P.x1b; p.lda = DM; p.Bt = P.mt; p.ldb = DM; p.K = DM;
    p.rowscale = P.rs2; p.obf = P.scores; p.ldo = 2048; p.of32 = nullptr; p.ldf = 0; p.resid = nullptr;
    for (int k = 0;; ++k) {
      int tm, tn;
      if (!xcd_tile(bid, nb, k, 16, tm, tn)) break;
      gemm_tile<EPI_SCORES>(p, tm, tn, smem);
      __syncthreads();
    }
  }
  xcd_barrier(xb);
  float oscale = 1.f;
#ifdef DBG_CHECK
  {
    const float sd = __hip_atomic_load(&P.dbg[0], __ATOMIC_RELAXED, __HIP_MEMORY_SCOPE_AGENT);
    const float sr = __hip_atomic_load(&P.dbg[1], __ATOMIC_RELAXED, __HIP_MEMORY_SCOPE_AGENT);
    oscale = 1.f + sqrtf(sd / sr);
  }
#endif
  for (int it = bid; it < NT / 32; it += nb) {
    d_topk(it, P.scores, P.idxb, P.gateb);
    __threadfence_block();
    __syncthreads();
#pragma unroll 1
    for (int sub = 0; sub < 8; ++sub)
      d_peer(it * 8 + sub, smem_c, P.x1, P.rs2, P.norm2_g, P.idxb, P.gateb, P.utab, P.vtab, P.uscale, P.vscale, P.normf_g, P.out, oscale);
  }
}

extern "C" void kernel_launch(void* const* d_in, const int* in_sizes, int n_in, void* d_out, int out_size, void* d_ws,
                              size_t ws_size, hipStream_t stream) {
  MKP P{};
  P.x = (const float*)d_in[0];
  P.norm1_g = (const float*)d_in[1];
  P.w_in = (const float*)d_in[2];
  P.conv_w = (const float*)d_in[3];
  P.a_log = (const float*)d_in[4];
  P.dt_bias = (const float*)d_in[5];
  P.gdn_g = (const float*)d_in[6];
  P.i_bias = (const float*)d_in[7];
  P.f_bias = (const float*)d_in[8];
  P.ml_g = (const float*)d_in[9];
  P.w_out = (const float*)d_in[10];
  P.norm2_g = (const float*)d_in[11];
  P.peer_wq = (const float*)d_in[12];
  P.peer_keys = (const float*)d_in[13];
  P.peer_u = (const float*)d_in[14];
  P.peer_v = (const float*)d_in[15];
  P.normf_g = (const float*)d_in[16];
  P.out = (float*)d_out;

  char* ws = (char*)d_ws;
  const size_t MB = 1024 * 1024;
  P.pm = (unsigned short*)(ws);
  P.x1 = (float*)(ws);
  P.x1b = (unsigned short*)(ws + 64 * MB);
  P.utab = (unsigned*)(ws + 96 * MB);
  P.vtab = (unsigned*)(ws + 112 * MB);
  P.uscale = (float*)(ws + 136 * MB);
  P.vscale = (float*)(ws + 136 * MB + 65536);
  char* rb = ws + 128 * MB;
  P.woutT = (unsigned short*)(rb);
  P.mt = (unsigned short*)(rb + 2 * MB);
  P.rs1 = (float*)(rb + 6 * MB);
  P.rs2 = (float*)(rb + 7 * MB);
  P.dbg = (float*)(rb + 6 * MB + 131072);
  P.bar = (unsigned*)(rb + 6 * MB + 196608);
  P.gt = (float*)(rb + 9 * MB);
  char* dyn = rb + 11 * MB;
  P.xb = (unsigned short*)(dyn);
  P.winT = (unsigned short*)(dyn + 32 * MB);
  P.wqb = (unsigned short*)(dyn + 41 * MB);
  P.keyb = (unsigned short*)(dyn + 45 * MB);
  P.G.qc = (unsigned short*)(dyn);
  P.G.kTc = (unsigned short*)(dyn + 16 * MB);
  P.G.qkc = (unsigned short*)(dyn + 32 * MB);
  P.G.wn = (unsigned short*)(dyn + 48 * MB);
  P.G.uo = (unsigned short*)(dyn + 80 * MB);
  P.G.gsc = (float*)(dyn + 112 * MB);
  P.mlpre = (float*)(dyn + 114 * MB);
  P.mlgt = (float*)(dyn + 116 * MB);
  P.yb = (unsigned short*)(dyn);
  P.scores = (unsigned short*)(dyn);
  P.idxb = (int*)(dyn + 64 * MB);
  P.gateb = (float*)(dyn + 72 * MB);
  char* os = (char*)d_out;
  P.oM = (unsigned short*)(os);
  P.qkv_dbg = (unsigned short*)(os + 32 * MB);
  P.oA_dbg = (unsigned short*)(os + 44 * MB);

  static int grid_blocks = 0;
  if (!grid_blocks) {
    int dev = 0, cus = 0, per_cu = 0;
    (void)hipGetDevice(&dev);
    (void)hipDeviceGetAttribute(&cus, hipDeviceAttributeMultiprocessorCount, dev);
    (void)hipOccupancyMaxActiveBlocksPerMultiprocessor(&per_cu, k_mega, 256, 0);
    if (per_cu > 2) per_cu = 2;
    if (per_cu < 1) per_cu = 1;
    grid_blocks = cus * per_cu;
  }
  (void)hipMemsetAsync(P.bar, 0, XCD_BAR_WORDS * sizeof(unsigned), stream);
  hipLaunchKernelGGL(k_mega, dim3(grid_blocks), dim3(256), 0, stream, P);
}
```

```cpp
#include <hip/hip_runtime.h>
#include <hip/hip_bf16.h>
#include <stdint.h>
#include <cstdio>

#define XB_TMO      128
#define XB_XCNT(j)  (256  + 64 * (j))
#define XB_XSUB(j)  (1280 + 64 * (j))
#define XB_XGEN(j)  (2304 + 64 * (j))
#define XB_TOP      3328
#define XB_TOPGEN   3392
#define XCD_BAR_WORDS 3456
#define XB_SPIN_CAP (1u << 18)
#define LAS __attribute__((address_space(3)))

__device__ __forceinline__ unsigned xb_ld(unsigned* p)              { return __hip_atomic_load(p, __ATOMIC_RELAXED, __HIP_MEMORY_SCOPE_AGENT); }
__device__ __forceinline__ unsigned xb_add(unsigned* p, unsigned v) { return __hip_atomic_fetch_add(p, v, __ATOMIC_RELAXED, __HIP_MEMORY_SCOPE_AGENT); }
__device__ __forceinline__ unsigned xb_xcc_id() { return (unsigned)__builtin_amdgcn_s_getreg((3 << 11) | 20) & 0xFu; }
#define XB_SPIN(cond, bar) do { unsigned _sp = 0; while (cond) { __builtin_amdgcn_s_sleep(1); \
    if ((++_sp & 255u) == 0u) { if (xb_ld(&(bar)[XB_TMO])) break; if (_sp > XB_SPIN_CAP) { atomicAdd(&(bar)[XB_TMO], 1u); break; } } } } while (0)

struct XcdBarrier {
    unsigned* bar; unsigned x;
    volatile LAS unsigned* st;
};

__device__ __forceinline__ XcdBarrier xcd_barrier_post(unsigned* bar, volatile LAS unsigned* st) {
    XcdBarrier b; b.bar = bar; b.x = xb_xcc_id(); b.st = st;
    if (threadIdx.x == 0) (void)xb_add(&bar[XB_XCNT(b.x)], 1u);
    return b;
}
__device__ __forceinline__ void xcd_barrier_complete(unsigned* bar, unsigned x, unsigned& nloc, unsigned& nx) {
    const unsigned G = gridDim.x * gridDim.y * gridDim.z;
    unsigned sum, cnt, mine, sp = 0u;
    for (;;) {
        sum = 0u; cnt = 0u; mine = 0u;
#pragma unroll
        for (unsigned j = 0; j < 16; ++j) { const unsigned c = xb_ld(&bar[XB_XCNT(j)]); sum += c; cnt += (c > 0u) ? 1u : 0u; mine = (j == x) ? c : mine; }
        if (sum == G) break;
        __builtin_amdgcn_s_sleep(1);
        if ((++sp & 255u) == 0u) { if (xb_ld(&bar[XB_TMO])) break; if (sp > XB_SPIN_CAP) { atomicAdd(&bar[XB_TMO], 1u); break; } }
    }
    nloc = mine > 0u ? mine : 1u; nx = cnt > 0u ? cnt : 1u;
}

__device__ __forceinline__ void xcd_barrier(const XcdBarrier& b) {
    asm volatile("s_waitcnt vmcnt(0)" ::: "memory");
    __syncthreads();
    if (threadIdx.x == 0) {
        unsigned* bar = b.bar;
        __builtin_amdgcn_s_waitcnt(0);
        unsigned nloc = b.st[0], nx = b.st[1];
        if (nloc == 0u) { xcd_barrier_complete(bar, b.x, nloc, nx); b.st[0] = nloc; b.st[1] = nx; }
        const unsigned old = xb_add(&bar[XB_XSUB(b.x)], 1u);
        const unsigned gen = old / nloc;
        if (old + 1u == (gen + 1u) * nloc) {
            __builtin_amdgcn_fence(__ATOMIC_RELEASE, "agent");
            asm volatile("s_waitcnt vmcnt(0)" ::: "memory");
            const unsigned og = xb_add(&bar[XB_TOP], 1u);
            const unsigned tg = og / nx;
            if (og + 1u == (tg + 1u) * nx) xb_add(&bar[XB_TOPGEN], 1u);
            else XB_SPIN(xb_ld(&bar[XB_TOPGEN]) == tg, bar);
            __builtin_amdgcn_fence(__ATOMIC_ACQUIRE, "agent");
            xb_add(&bar[XB_XGEN(b.x)], 1u);
            asm volatile("s_waitcnt vmcnt(0)" ::: "memory");
        } else {
            XB_SPIN(xb_ld(&bar[XB_XGEN(b.x)]) == gen, bar);
            __builtin_amdgcn_fence(__ATOMIC_ACQUIRE, "agent");
            asm volatile("s_waitcnt vmcnt(0)" ::: "memory");
        }
    }
    __syncthreads();
}


typedef __hip_bfloat16 bf16;
typedef __attribute__((ext_vector_type(8))) short bf16x8;
typedef __attribute__((ext_vector_type(4))) float f32x4;

constexpr int DM = 1024;
constexpr int NB = 4;
constexpr int SEQ = 4096;
constexpr int NT = NB * SEQ;
constexpr int DIN = 4128;
constexpr int NPAD_IN = 4224;
constexpr float EPSF = 1e-6f;

__device__ __forceinline__ float bf2f(unsigned short u) { return __uint_as_float(((unsigned)u) << 16); }
typedef __bf16 bf16x2_t __attribute__((ext_vector_type(2)));
typedef float f32x2_t __attribute__((ext_vector_type(2)));
__device__ __forceinline__ unsigned short f2bf(float f) { return __builtin_bit_cast(unsigned short, (__bf16)f); }
__device__ __forceinline__ unsigned pack2(float a, float b) {
  f32x2_t v = {a, b};
  return __builtin_bit_cast(unsigned, __builtin_convertvector(v, bf16x2_t));
}
__device__ __forceinline__ float wave_sum(float v) {
#pragma unroll
  for (int o = 32; o > 0; o >>= 1) v += __shfl_xor(v, o, 64);
  return v;
}
#define DPP_ADD(v, ctrl) v += __builtin_bit_cast(float, __builtin_amdgcn_update_dpp(0, __builtin_bit_cast(int, v), ctrl, 0xF, 0xF, true))
__device__ __forceinline__ float wave_sum_dpp(float v) {
  DPP_ADD(v, 0xB1);
  DPP_ADD(v, 0x4E);
  DPP_ADD(v, 0x141);
  DPP_ADD(v, 0x140);
  const float r0 = __builtin_bit_cast(float, __builtin_amdgcn_readlane(__builtin_bit_cast(int, v), 0));
  const float r1 = __builtin_bit_cast(float, __builtin_amdgcn_readlane(__builtin_bit_cast(int, v), 16));
  const float r2 = __builtin_bit_cast(float, __builtin_amdgcn_readlane(__builtin_bit_cast(int, v), 32));
  const float r3 = __builtin_bit_cast(float, __builtin_amdgcn_readlane(__builtin_bit_cast(int, v), 48));
  return (r0 + r1) + (r2 + r3);
}
__device__ __forceinline__ float softplusf(float x) { return fmaxf(x, 0.f) + log1pf(expf(-fabsf(x))); }
__device__ __forceinline__ float sigmoidf(float x) { return __builtin_amdgcn_rcpf(1.f + __builtin_amdgcn_exp2f(-1.4426950408889634f * x)); }

__device__ __forceinline__ void d_prep_x(int item, const float* __restrict__ x, unsigned short* __restrict__ xb,
                                                float* __restrict__ rs) {
  int t = item * 4 + (threadIdx.x >> 6);
  int lane = threadIdx.x & 63;
  const float4* xr = (const float4*)(x + (size_t)t * DM);
  float ss = 0.f;
#pragma unroll
  for (int i = 0; i < 4; ++i) {
    float4 v = xr[lane + 64 * i];
    ss += v.x * v.x + v.y * v.y + v.z * v.z + v.w * v.w;
    ushort4 o;
    o.x = f2bf(v.x); o.y = f2bf(v.y); o.z = f2bf(v.z); o.w = f2bf(v.w);
    ((ushort4*)(xb + (size_t)t * DM))[lane + 64 * i] = o;
  }
  ss = wave_sum(ss);
  if (lane == 0) rs[t] = rsqrtf(ss * (1.f / DM) + EPSF);
}

__device__ __forceinline__ int win_src(int n) {
  if (n < 2048) return n;
  if (n < 4096) return n + 16;
  int j = n - 4096;
  if (j < 16) return 2048 + j;
  if (j < 32) return 4112 + (j - 16);
  return -1;
}
__device__ __forceinline__ void d_transpose_w(int item, int ntn, float* tile, const float* __restrict__ in, int ldn,
                                              const float* __restrict__ g, unsigned short* __restrict__ out, int mode) {
  const int kt = item / ntn, nt = item % ntn;
  const int tid = threadIdx.x;
  __syncthreads();
#pragma unroll
  for (int i = 0; i < 4; ++i) {
    const int row = (tid >> 4) + 16 * i;
    const int c4 = (tid & 15) * 4;
    const int n = nt * 64 + c4;
    const int src = mode ? win_src(n) : n;
    float4 v = make_float4(0.f, 0.f, 0.f, 0.f);
    if (src >= 0) {
      v = *(const float4*)(in + (size_t)(kt * 64 + row) * ldn + src);
      if (g) { const float gg = g[kt * 64 + row]; v.x *= gg; v.y *= gg; v.z *= gg; v.w *= gg; }
    }
    tile[row * 65 + c4] = v.x; tile[row * 65 + c4 + 1] = v.y; tile[row * 65 + c4 + 2] = v.z; tile[row * 65 + c4 + 3] = v.w;
  }
  __syncthreads();
  {
    const int n = tid >> 2, k16 = (tid & 3) * 16;
    uint4 o0, o1;
    o0.x = pack2(tile[(k16 + 0) * 65 + n], tile[(k16 + 1) * 65 + n]);   o0.y = pack2(tile[(k16 + 2) * 65 + n], tile[(k16 + 3) * 65 + n]);
    o0.z = pack2(tile[(k16 + 4) * 65 + n], tile[(k16 + 5) * 65 + n]);   o0.w = pack2(tile[(k16 + 6) * 65 + n], tile[(k16 + 7) * 65 + n]);
    o1.x = pack2(tile[(k16 + 8) * 65 + n], tile[(k16 + 9) * 65 + n]);   o1.y = pack2(tile[(k16 + 10) * 65 + n], tile[(k16 + 11) * 65 + n]);
    o1.z = pack2(tile[(k16 + 12) * 65 + n], tile[(k16 + 13) * 65 + n]); o1.w = pack2(tile[(k16 + 14) * 65 + n], tile[(k16 + 15) * 65 + n]);
    unsigned short* op = out + (size_t)(nt * 64 + n) * DM + kt * 64 + k16;
    *(uint4*)op = o0;
    *(uint4*)(op + 8) = o1;
  }
}
__device__ __forceinline__ void d_cvt_bf16(int item, const float* __restrict__ src, unsigned short* __restrict__ dst,
                                           const float* __restrict__ rowscale, int rowlen_log2) {
  const size_t base = (size_t)item * 2048 + threadIdx.x * 8;
  float4 a = *(const float4*)(src + base);
  float4 b = *(const float4*)(src + base + 4);
  if (rowscale) {
    const float sc = rowscale[base >> rowlen_log2];
    a.x *= sc; a.y *= sc; a.z *= sc; a.w *= sc; b.x *= sc; b.y *= sc; b.z *= sc; b.w *= sc;
  }
  uint4 o;
  o.x = pack2(a.x, a.y); o.y = pack2(a.z, a.w); o.z = pack2(b.x, b.y); o.w = pack2(b.z, b.w);
  *(uint4*)(dst + base) = o;
}

constexpr int GBM = 128, GBN = 128, GBK = 64, GLD = 64;
struct GemmP {
  const unsigned short* A; const unsigned short* Bt; int lda, ldb, K;
  const float* rowscale;
  unsigned short* obf; int ldo;
  float* of32; int ldf;
  const float* resid;
  const float *a_log, *dt_bias, *i_bias, *f_bias;
  float* rowacc;
};
enum { EPI_INPROJ = 0, EPI_OUTPROJ = 1, EPI_SCORES = 2, EPI_PLAIN = 3 };

template <int EPI>
__device__ __forceinline__ void gemm_tile(const GemmP p, int tm, int tn, unsigned short* smem) {
  unsigned short* As = smem;
  unsigned short* Bs = smem + 2 * GBM * GLD;
  int tid = threadIdx.x;
  asm volatile("" : "+v"(tid));
  const int lane = tid & 63, wid = tid >> 6;
  const int wm = wid >> 1, wn = wid & 1;
  const int m0 = tm * GBM, n0 = tn * GBN;
  f32x4 acc[4][4];
#pragma unroll
  for (int i = 0; i < 4; ++i)
#pragma unroll
    for (int j = 0; j < 4; ++j) acc[i][j] = (f32x4){0.f, 0.f, 0.f, 0.f};

  uint4 ra0, ra1, ra2, ra3, rb0, rb1, rb2, rb3;
  uint4 sa0, sa1, sa2, sa3, sb0, sb1, sb2, sb3;
  const int nk = p.K / GBK;
  const int lrow = tid >> 3, lc8 = tid & 7;
  const unsigned short* Ag = p.A + (size_t)(m0 + lrow) * p.lda + lc8 * 8;
  const unsigned short* Bg = p.Bt + (size_t)(n0 + lrow) * p.ldb + lc8 * 8;
  const size_t a32 = (size_t)32 * p.lda, b32 = (size_t)32 * p.ldb;
#define GLOAD(R, S, kt)                                                  \
  {                                                                      \
    R##0 = *(const uint4*)(Ag + (kt) * GBK);                             \
    R##1 = *(const uint4*)(Ag + a32 + (kt) * GBK);                       \
    R##2 = *(const uint4*)(Ag + 2 * a32 + (kt) * GBK);                   \
    R##3 = *(const uint4*)(Ag + 3 * a32 + (kt) * GBK);                   \
    S##0 = *(const uint4*)(Bg + (kt) * GBK);                             \
    S##1 = *(const uint4*)(Bg + b32 + (kt) * GBK);                       \
    S##2 = *(const uint4*)(Bg + 2 * b32 + (kt) * GBK);                   \
    S##3 = *(const uint4*)(Bg + 3 * b32 + (kt) * GBK);                   \
  }
#define SSTORE(R, S, buf)                                                \
  {                                                                      \
    unsigned short* ad = As + (size_t)(buf) * GBM * GLD + lrow * GLD + ((lc8 ^ (lrow & 7)) * 8); \
    unsigned short* bd = Bs + (size_t)(buf) * GBN * GLD + lrow * GLD + ((lc8 ^ (lrow & 7)) * 8); \
    *(uint4*)(ad) = R##0; *(uint4*)(ad + 32 * GLD) = R##1; *(uint4*)(ad + 64 * GLD) = R##2; *(uint4*)(ad + 96 * GLD) = R##3; \
    *(uint4*)(bd) = S##0; *(uint4*)(bd + 32 * GLD) = S##1; *(uint4*)(bd + 64 * GLD) = S##2; *(uint4*)(bd + 96 * GLD) = S##3; \
  }
#define GCOMPUTE(buf)                                                                                                     \
  {                                                                                                                       \
    const unsigned short* Ab = As + (size_t)(buf) * GBM * GLD;                                                            \
    const unsigned short* Bb = Bs + (size_t)(buf) * GBN * GLD;                                                            \
    _Pragma("unroll") for (int ks = 0; ks < 2; ++ks) {                                                                    \
      bf16x8 a[4], b[4];                                                                                                  \
      const int kc = ((ks * 4 + (lane >> 4)) ^ (lane & 7)) * 8;                   \
      _Pragma("unroll") for (int i = 0; i < 4; ++i) a[i] = *(const bf16x8*)(Ab + (wm * 64 + i * 16 + (lane & 15)) * GLD + kc); \
      _Pragma("unroll") for (int j = 0; j < 4; ++j) b[j] = *(const bf16x8*)(Bb + (wn * 64 + j * 16 + (lane & 15)) * GLD + kc); \
      _Pragma("unroll") for (int i = 0; i < 4; ++i)                                                                       \
        _Pragma("unroll") for (int j = 0; j < 4; ++j)                                                                     \
          acc[i][j] = __builtin_amdgcn_mfma_f32_16x16x32_bf16(b[j], a[i], acc[i][j], 0, 0, 0);               \
    }                                                                                                                     \
  }
  GLOAD(ra, rb, 0);
  if (nk > 1) GLOAD(sa, sb, 1);
  SSTORE(ra, rb, 0);
  __syncthreads();
  for (int kt = 0; kt < nk; kt += 2) {
    if (kt + 2 < nk) GLOAD(ra, rb, kt + 2);
    GCOMPUTE(0);
    if (kt + 1 < nk) SSTORE(sa, sb, 1);
    __syncthreads();
    if (kt + 1 < nk) {
      if (kt + 3 < nk) GLOAD(sa, sb, kt + 3);
      GCOMPUTE(1);
      if (kt + 2 < nk) SSTORE(ra, rb, 0);
      __syncthreads();
    }
  }
#undef GLOAD
#undef SSTORE
#undef GCOMPUTE
#pragma unroll
  for (int i = 0; i < 4; ++i) {
    const int row = m0 + wm * 64 + i * 16 + (lane & 15);
    float rsc = 1.f;
    float rowss = 0.f;
    if (EPI == EPI_INPROJ) rsc = p.rowscale[row];
    if (EPI == EPI_SCORES) {
      const float4* pr = (const float4*)(p.rowscale + (size_t)row * 16);
      const float4 s0 = pr[0], s1 = pr[1], s2 = pr[2], s3 = pr[3];
      const float ssq = ((s0.x + s0.y) + (s0.z + s0.w)) + ((s1.x + s1.y) + (s1.z + s1.w)) + ((s2.x + s2.y) + (s2.z + s2.w)) + ((s3.x + s3.y) + (s3.z + s3.w));
      rsc = rsqrtf(ssq * (1.f / DM) + EPSF);
    }
#pragma unroll
    for (int j = 0; j < 4; ++j) {
      const int col0 = n0 + wn * 64 + j * 16 + (lane >> 4) * 4;
      const float v0 = acc[i][j][0] * rsc, v1 = acc[i][j][1] * rsc, v2 = acc[i][j][2] * rsc, v3 = acc[i][j][3] * rsc;
      if (EPI == EPI_INPROJ) {
        if (col0 < 4096) {
          uint2 pk; pk.x = pack2(v0, v1); pk.y = pack2(v2, v3);
          *(uint2*)(p.obf + (size_t)row * p.ldo + col0) = pk;
        } else if (col0 < 4128) {
          const float vv[4] = {v0, v1, v2, v3};
          float oo[4];
#pragma unroll
          for (int r = 0; r < 4; ++r) {
            const int jg = col0 - 4096 + r, jj = jg & 7;
            const float v = vv[r];
            float o;
            if (jg < 8) o = -expf(p.a_log[jj]) * softplusf(v + p.dt_bias[jj]);
            else if (jg < 16) o = sigmoidf(v);
            else if (jg < 24) o = v + p.i_bias[jj];
            else o = -softplusf(-(v + p.f_bias[jj]));
            oo[r] = o;
          }
          *(float4*)(p.of32 + (size_t)row * p.ldf + (col0 - 4096)) = make_float4(oo[0], oo[1], oo[2], oo[3]);
        }
      } else if (EPI == EPI_OUTPROJ) {
        const float4 xr = *(const float4*)(p.resid + (size_t)row * p.ldf + col0);
        const float x0 = v0 + xr.x, x1 = v1 + xr.y, x2 = v2 + xr.z, x3 = v3 + xr.w;
        *(float4*)(p.of32 + (size_t)row * p.ldf + col0) = make_float4(x0, x1, x2, x3);
        uint2 pk; pk.x = pack2(x0, x1); pk.y = pack2(x2, x3);
        *(uint2*)(p.obf + (size_t)row * p.ldo + col0) = pk;
        rowss += (x0 * x0 + x1 * x1) + (x2 * x2 + x3 * x3);
      } else {
        uint2 pk; pk.x = pack2(v0, v1); pk.y = pack2(v2, v3);
        *(uint2*)(p.obf + (size_t)row * p.ldo + col0) = pk;
      }
    }
    if (EPI == EPI_OUTPROJ) {
      rowss += __shfl_xor(rowss, 16, 64);
      rowss += __shfl_xor(rowss, 32, 64);
      if ((lane >> 4) == 0) p.rowacc[(size_t)row * 16 + tn * 2 + wn] = rowss;
    }
  }
}

__device__ __forceinline__ bool xcd_tile(int bid, int nb, int k, int ntn, int& tm, int& tn) {
  const int q = (bid >> 3) + (nb >> 3) * k;
  if (q >= 16 * ntn) return false;
  const int g = q / (8 * ntn), rem = q % (8 * ntn);
  tn = rem >> 3;
  tm = 16 * (bid & 7) + 8 * g + (rem & 7);
  return true;
}

__device__ __forceinline__ void d_conv(int item, const unsigned short* __restrict__ pm, const float* __restrict__ pg,
                                              const float* __restrict__ conv_w, const float* __restrict__ a_log,
                                              const float* __restrict__ dt_bias, const float* __restrict__ i_bias,
                                              const float* __restrict__ f_bias, unsigned short* __restrict__ qkv,
                                              float* __restrict__ gt) {
  int t = item * 4 + (threadIdx.x >> 6);
  int lane = threadIdx.x & 63;
  int s = t & (SEQ - 1);
  for (int sec = 0; sec < 3; ++sec) {
    for (int h = 0; h < 4; ++h) {
      int c0 = sec * 512 + h * 128 + 2 * lane;
      float a0 = 0.f, a1 = 0.f;
#pragma unroll
      for (int j = 0; j < 5; ++j) {
        int sp = s + j - 2;
        if (sp >= 0 && sp < SEQ) {
          unsigned v = *(const unsigned*)(pm + (size_t)(t + j - 2) * 4096 + c0);
          a0 += conv_w[c0 * 5 + j] * bf2f((unsigned short)(v & 0xffff));
          a1 += conv_w[(c0 + 1) * 5 + j] * bf2f((unsigned short)(v >> 16));
        }
      }
      a0 = a0 * sigmoidf(a0);
      a1 = a1 * sigmoidf(a1);
      if (sec < 2) {
        float ss = wave_sum(a0 * a0 + a1 * a1);
        float sc = rsqrtf(ss + EPSF);
        if (sec == 0) sc *= 0.08838834764831845f;
        a0 *= sc; a1 *= sc;
      }
      unsigned o = pack2(a0, a1);
      *(unsigned*)(qkv + (size_t)t * 1536 + c0) = o;
    }
  }
}

__device__ __forceinline__ void d_gdn_rec(int chain, float* sq, float* sk, const unsigned short* __restrict__ qkv,
                                                 const float* __restrict__ gt, unsigned short* __restrict__ oA, int ntok) {
  const int bh = chain >> 1, dir = chain & 1;
  const int b = bh >> 2, h = bh & 3;
  const int e = threadIdx.x & 127;
  float S[128];
#pragma unroll
  for (int d = 0; d < 128; ++d) S[d] = 0.f;
  for (int it = 0; it < SEQ; ++it) {
    const int s = dir ? (SEQ - 1 - it) : it;
    const size_t t = (size_t)b * SEQ + s;
    __syncthreads();
    sq[e] = bf2f(qkv[t * 1536 + h * 128 + e]);
    sk[e] = bf2f(qkv[t * 1536 + 512 + h * 128 + e]);
    const float v = bf2f(qkv[t * 1536 + 1024 + h * 128 + e]);
    const float g = gt[t * 32 + dir * 4 + h];
    const float beta = gt[t * 32 + 8 + dir * 4 + h];
    __syncthreads();
    const float a = expf(g);
    float k0 = 0.f, k1 = 0.f, k2 = 0.f, k3 = 0.f;
#pragma unroll
    for (int d = 0; d < 128; d += 4) {
      k0 += sk[d] * S[d]; k1 += sk[d + 1] * S[d + 1]; k2 += sk[d + 2] * S[d + 2]; k3 += sk[d + 3] * S[d + 3];
    }
    const float kS = a * ((k0 + k1) + (k2 + k3));
    const float vn = beta * (v - kS);
    float o0 = 0.f, o1 = 0.f, o2 = 0.f, o3 = 0.f;
#pragma unroll
    for (int d = 0; d < 128; d += 4) {
      S[d] = a * S[d] + sk[d] * vn;             o0 += sq[d] * S[d];
      S[d + 1] = a * S[d + 1] + sk[d + 1] * vn; o1 += sq[d + 1] * S[d + 1];
      S[d + 2] = a * S[d + 2] + sk[d + 2] * vn; o2 += sq[d + 2] * S[d + 2];
      S[d + 3] = a * S[d + 3] + sk[d + 3] * vn; o3 += sq[d + 3] * S[d + 3];
    }
    oA[((size_t)dir * ntok + t) * 512 + h * 128 + e] = f2bf((o0 + o1) + (o2 + o3));
  }
}

__device__ __forceinline__ void d_mlstm_rec(int chain, float* sq, float* sk, const unsigned short* __restrict__ pm,
                                                   const float* __restrict__ gt, unsigned short* __restrict__ oM, int ntok) {
  const int bh = chain >> 1, dir = chain & 1;
  const int b = bh >> 2, h = bh & 3;
  const int e = threadIdx.x & 127, lane = e & 63;
  float C[128];
#pragma unroll
  for (int d = 0; d < 128; ++d) C[d] = 0.f;
  float n0 = 0.f, n1 = 0.f, m = 0.f;
  for (int it = 0; it < SEQ; ++it) {
    const int s = dir ? (SEQ - 1 - it) : it;
    const size_t t = (size_t)b * SEQ + s;
    __syncthreads();
    sq[e] = bf2f(pm[t * 4096 + 2048 + h * 128 + e]);
    sk[e] = bf2f(pm[t * 4096 + 2560 + h * 128 + e]) * 0.08838834764831845f;
    const float v = bf2f(pm[t * 4096 + 3072 + h * 128 + e]);
    const float ip = gt[t * 32 + 16 + dir * 4 + h];
    const float lf = gt[t * 32 + 24 + dir * 4 + h];
    __syncthreads();
    const float mn = fmaxf(lf + m, ip);
    const float fs = expf(lf + m - mn);
    const float is = expf(ip - mn);
    m = mn;
    n0 = fs * n0 + is * sk[lane];
    n1 = fs * n1 + is * sk[lane + 64];
    const float den = wave_sum(n0 * sq[lane] + n1 * sq[lane + 64]);
    const float iv = is * v;
    float o0 = 0.f, o1 = 0.f, o2 = 0.f, o3 = 0.f;
#pragma unroll
    for (int d = 0; d < 128; d += 4) {
      C[d] = fs * C[d] + sk[d] * iv;             o0 += sq[d] * C[d];
      C[d + 1] = fs * C[d + 1] + sk[d + 1] * iv; o1 += sq[d + 1] * C[d + 1];
      C[d + 2] = fs * C[d + 2] + sk[d + 2] * iv; o2 += sq[d + 2] * C[d + 2];
      C[d + 3] = fs * C[d + 3] + sk[d + 3] * iv; o3 += sq[d + 3] * C[d + 3];
    }
    const float num = (o0 + o1) + (o2 + o3);
    const float hh = num / fmaxf(fabsf(den), expf(-mn));
    oM[((size_t)dir * ntok + t) * 512 + h * 128 + e] = f2bf(hh);
  }
}

__device__ __forceinline__ void d_combine(int item, const unsigned short* __restrict__ uo, const unsigned short* __restrict__ oM,
                                                 const unsigned short* __restrict__ pm, const float* __restrict__ gdn_g,
                                                 const float* __restrict__ ml_g, unsigned short* __restrict__ y) {
  int tid_ = threadIdx.x;
  asm volatile("" : "+v"(tid_));
  const int t = item * 4 + (tid_ >> 6);
  const int lane = tid_ & 63;
  const int b = t >> 12, cc = (t >> 6) & 63, ii = t & 63;
  unsigned gf_[4], gb_[4], mf_[4], mb_[4], zg_[4], zo_[4];
  const size_t off = (size_t)cc * 8192 + (lane >> 4) * 2048 + ii * 32 + ((2 * lane) & 31);
#pragma unroll
  for (int h = 0; h < 4; ++h) {
    const int c = h * 128 + 2 * lane;
    const int chain0 = (b * 4 + h) * 2;
    gf_[h] = *(const unsigned*)(uo + (size_t)chain0 * 64 * 8192 + off);
    gb_[h] = *(const unsigned*)(uo + (size_t)(chain0 + 1) * 64 * 8192 + off);
    mf_[h] = *(const unsigned*)(oM + (size_t)t * 512 + c);
    mb_[h] = *(const unsigned*)(oM + ((size_t)NT + t) * 512 + c);
    zg_[h] = *(const unsigned*)(pm + (size_t)t * 4096 + 1536 + c);
    zo_[h] = *(const unsigned*)(pm + (size_t)t * 4096 + 3584 + c);
  }
  const float gg0 = gdn_g[2 * lane], gg1 = gdn_g[2 * lane + 1];
  float a0[4], a1[4], m0[4], m1[4], sa[4], sm[4];
#pragma unroll
  for (int h = 0; h < 4; ++h) {
    a0[h] = bf2f(gf_[h] & 0xffff) + bf2f(gb_[h] & 0xffff);
    a1[h] = __uint_as_float(gf_[h] & 0xffff0000u) + __uint_as_float(gb_[h] & 0xffff0000u);
    m0[h] = bf2f(mf_[h] & 0xffff) + bf2f(mb_[h] & 0xffff);
    m1[h] = __uint_as_float(mf_[h] & 0xffff0000u) + __uint_as_float(mb_[h] & 0xffff0000u);
    sa[h] = a0[h] * a0[h] + a1[h] * a1[h];
    sm[h] = m0[h] * m0[h] + m1[h] * m1[h];
  }
#pragma unroll
  for (int o = 32; o > 0; o >>= 1) {
#pragma unroll
    for (int h = 0; h < 4; ++h) { sa[h] += __shfl_xor(sa[h], o, 64); sm[h] += __shfl_xor(sm[h], o, 64); }
  }
#pragma unroll
  for (int h = 0; h < 4; ++h) {
    const int c = h * 128 + 2 * lane;
    const float sca = rsqrtf(sa[h] * (1.f / 128.f) + EPSF);
    const float scm = rsqrtf(sm[h] * (1.f / 128.f) + EPSF);
    const float z0 = bf2f(zg_[h] & 0xffff), z1 = __uint_as_float(zg_[h] & 0xffff0000u);
    const float q0 = bf2f(zo_[h] & 0xffff), q1 = __uint_as_float(zo_[h] & 0xffff0000u);
    const float o0 = a0[h] * sca * gg0 * (z0 * sigmoidf(z0));
    const float o1 = a1[h] * sca * gg1 * (z1 * sigmoidf(z1));
    const float p0 = m0[h] * scm * ml_g[c] * sigmoidf(q0);
    const float p1 = m1[h] * scm * ml_g[c + 1] * sigmoidf(q1);
    *(unsigned*)(y + (size_t)t * DM + c) = pack2(o0, o1);
    *(unsigned*)(y + (size_t)t * DM + 512 + c) = pack2(p0, p1);
  }
}

#ifdef DBG_CHECK
__device__ __forceinline__ void d_dbg_cmp(int item, const unsigned short* __restrict__ uo, const unsigned short* __restrict__ oAd,
                                          float* __restrict__ dbg) {
  int t = item * 4 + (threadIdx.x >> 6);
  int lane = threadIdx.x & 63;
  const int cc = (t >> 6) & 63, ii = t & 63;
  float sd = 0.f, sr = 0.f;
  for (int h = 0; h < 4; ++h) {
    for (int dir = 0; dir < 2; ++dir) {
      const int chain = h * 2 + dir;
      const size_t off = (size_t)cc * 8192 + (lane >> 4) * 2048 + ii * 32 + ((2 * lane) & 31);
      unsigned vn = *(const unsigned*)(uo + (size_t)chain * 64 * 8192 + off);
      unsigned vr = *(const unsigned*)(oAd + ((size_t)dir * 4096 + t) * 512 + h * 128 + 2 * lane);
      float n0 = bf2f(vn & 0xffff), n1 = bf2f(vn >> 16), r0 = bf2f(vr & 0xffff), r1 = bf2f(vr >> 16);
      sd += (n0 - r0) * (n0 - r0) + (n1 - r1) * (n1 - r1);
      sr += r0 * r0 + r1 * r1;
    }
  }
  sd = wave_sum(sd); sr = wave_sum(sr);
  if (lane == 0) { atomicAdd(&dbg[0], sd); atomicAdd(&dbg[1], sr); }
}
__device__ __forceinline__ void d_dbg_cmp_m(int item, const unsigned short* __restrict__ oM, const unsigned short* __restrict__ oMd,
                                            float* __restrict__ dbg) {
  int t = item * 4 + (threadIdx.x >> 6);
  int lane = threadIdx.x & 63;
  float sd = 0.f, sr = 0.f;
  for (int dir = 0; dir < 2; ++dir)
    for (int q = 0; q < 4; ++q) {
      unsigned vn = *(const unsigned*)(oM + ((size_t)dir * NT + t) * 512 + q * 128 + 2 * lane);
      unsigned vr = *(const unsigned*)(oMd + ((size_t)dir * 4096 + t) * 512 + q * 128 + 2 * lane);
      float n0 = bf2f(vn & 0xffff), n1 = bf2f(vn >> 16), r0 = bf2f(vr & 0xffff), r1 = bf2f(vr >> 16);
      sd += (n0 - r0) * (n0 - r0) + (n1 - r1) * (n1 - r1);
      sr += r0 * r0 + r1 * r1;
    }
  sd = wave_sum(sd); sr = wave_sum(sr);
  if (lane == 0) { atomicAdd(&dbg[0], sd); atomicAdd(&dbg[1], sr); }
}
#endif

__device__ __forceinline__ void d_prep_x1(int item, const float* __restrict__ x1, unsigned short* __restrict__ xb,
                                                 float* __restrict__ rs) {
  int t = item * 4 + (threadIdx.x >> 6);
  int lane = threadIdx.x & 63;
  const float4* xr = (const float4*)(x1 + (size_t)t * DM);
  float ss = 0.f;
#pragma unroll
  for (int i = 0; i < 4; ++i) {
    float4 v = xr[lane + 64 * i];
    ss += v.x * v.x + v.y * v.y + v.z * v.z + v.w * v.w;
    ushort4 o;
    o.x = f2bf(v.x); o.y = f2bf(v.y); o.z = f2bf(v.z); o.w = f2bf(v.w);
    ((ushort4*)(xb + (size_t)t * DM))[lane + 64 * i] = o;
  }
  ss = wave_sum(ss);
  if (lane == 0) rs[t] = rsqrtf(ss * (1.f / DM) + EPSF);
}

__device__ const unsigned char kPairTab[64] = {
    0x00, 0x01, 0x02, 0x03, 0x04, 0x05, 0x06, 0x07, 0x08, 0x09, 0x0a, 0x0b, 0x0c, 0x0d, 0x0e, 0x0f,
    0x10, 0x11, 0x12, 0x13, 0x14, 0x15, 0x16, 0x17,
    0x20, 0x21, 0x22, 0x23, 0x24,
    0x30, 0x31, 0x32, 0x33,
    0x40, 0x41, 0x42,
    0x50, 0x51, 0x60, 0x61, 0x70, 0x71,
    0x80, 0x90, 0xa0, 0xb0, 0xc0, 0xd0, 0xe0, 0xf0,
    0xff, 0xff, 0xff, 0xff, 0xff, 0xff, 0xff, 0xff, 0xff, 0xff, 0xff, 0xff, 0xff, 0xff};

__device__ __forceinline__ void sort16_desc(unsigned (&a)[16]) {
#pragma unroll
  for (int k = 2; k <= 16; k <<= 1)
#pragma unroll
    for (int j = k >> 1; j > 0; j >>= 1)
#pragma unroll
      for (int i = 0; i < 16; ++i) {
        const int l = i ^ j;
        if (l > i) {
          const unsigned hi = max(a[i], a[l]), lo = min(a[i], a[l]);
          if ((i & k) == 0) { a[i] = hi; a[l] = lo; } else { a[i] = lo; a[l] = hi; }
        }
      }
}
__device__ __forceinline__ void merge16_desc(unsigned (&top)[16], const unsigned (&b)[16]) {
#pragma unroll
  for (int i = 0; i < 16; ++i) top[i] = max(top[i], b[15 - i]);
#pragma unroll
  for (int j = 8; j > 0; j >>= 1)
#pragma unroll
    for (int i = 0; i < 16; ++i) {
      const int l = i ^ j;
      if (l > i) {
        const unsigned hi = max(top[i], top[l]), lo = min(top[i], top[l]);
        top[i] = hi; top[l] = lo;
      }
    }
}
__device__ __forceinline__ unsigned key16(unsigned hbits, int idx) {
  const unsigned m = hbits ^ ((hbits & 0x8000u) ? 0xFFFFu : 0x8000u);
  return (m << 16) | (unsigned)(127 - idx);
}
__device__ __forceinline__ void top16_of_128(const unsigned short* __restrict__ sp, unsigned (&top)[16]) {
#pragma unroll
  for (int g = 0; g < 8; ++g) {
    const uint4 x0 = *(const uint4*)(sp + g * 16);
    const uint4 x1 = *(const uint4*)(sp + g * 16 + 8);
    unsigned b[16];
    b[0] = key16(x0.x & 0xffff, g * 16 + 0);  b[1] = key16(x0.x >> 16, g * 16 + 1);
    b[2] = key16(x0.y & 0xffff, g * 16 + 2);  b[3] = key16(x0.y >> 16, g * 16 + 3);
    b[4] = key16(x0.z & 0xffff, g * 16 + 4);  b[5] = key16(x0.z >> 16, g * 16 + 5);
    b[6] = key16(x0.w & 0xffff, g * 16 + 6);  b[7] = key16(x0.w >> 16, g * 16 + 7);
    b[8] = key16(x1.x & 0xffff, g * 16 + 8);  b[9] = key16(x1.x >> 16, g * 16 + 9);
    b[10] = key16(x1.y & 0xffff, g * 16 + 10); b[11] = key16(x1.y >> 16, g * 16 + 11);
    b[12] = key16(x1.z & 0xffff, g * 16 + 12); b[13] = key16(x1.z >> 16, g * 16 + 13);
    b[14] = key16(x1.w & 0xffff, g * 16 + 14); b[15] = key16(x1.w >> 16, g * 16 + 15);
    sort16_desc(b);
    if (g == 0) {
#pragma unroll
      for (int i = 0; i < 16; ++i) top[i] = b[i];
    } else {
      merge16_desc(top, b);
    }
  }
}

__device__ __forceinline__ void d_topk(int item, const unsigned short* __restrict__ scores, int* __restrict__ idx_out,
                                       float* __restrict__ gate_out) {
  int tid_ = threadIdx.x;
  asm volatile("" : "+v"(tid_));
  const int pair = item * 256 + tid_;
  const unsigned short* sp = scores + (size_t)pair * 256;
  unsigned k0[16], k1[16];
  top16_of_128(sp, k0);
  top16_of_128(sp + 128, k1);
  float v0[16], v1[16];
  int i0[16], i1[16];
#pragma unroll
  for (int i = 0; i < 16; ++i) {
    const unsigned m0 = k0[i] >> 16, m1 = k1[i] >> 16;
    v0[i] = bf2f((unsigned short)(m0 ^ ((m0 & 0x8000u) ? 0x8000u : 0xFFFFu)));
    v1[i] = bf2f((unsigned short)(m1 ^ ((m1 & 0x8000u) ? 0x8000u : 0xFFFFu)));
    i0[i] = 127 - (int)(k0[i] & 127u);
    i1[i] = 127 - (int)(k1[i] & 127u);
  }
  unsigned top[16];
#pragma unroll
  for (int g = 0; g < 4; ++g) {
    unsigned b[16];
#pragma unroll
    for (int q = 0; q < 16; ++q) {
      const int pr = kPairTab[g * 16 + q];
      if (pr == 0xff) {
        b[q] = 0u;
      } else {
        const int pi = pr >> 4, pj = pr & 15;
        const float sum = v0[pi] + v1[pj];
        const unsigned u = __float_as_uint(sum);
        const unsigned mono = u ^ ((u & 0x80000000u) ? 0xFFFFFFFFu : 0x80000000u);
        b[q] = (mono & 0xFFFFC000u) | (unsigned)(16383 - (i0[pi] * 128 + i1[pj]));
      }
    }
    sort16_desc(b);
    if (g == 0) {
#pragma unroll
      for (int i = 0; i < 16; ++i) top[i] = b[i];
    } else {
      merge16_desc(top, b);
    }
  }
  float ev[16];
  int ci[16];
  float mx = 0.f, sum = 0.f;
#pragma unroll
  for (int i = 0; i < 16; ++i) {
    const unsigned mono = top[i] & 0xFFFFC000u;
    const unsigned u = mono ^ ((mono & 0x80000000u) ? 0x80000000u : 0xFFFFFFFFu);
    const float val = __uint_as_float(u & 0xFFFFC000u);
    ci[i] = 16383 - (int)(top[i] & 16383u);
    if (i == 0) mx = val;
    ev[i] = expf(val - mx);
    sum += ev[i];
  }
  const float inv = 1.f / sum;
#pragma unroll
  for (int q = 0; q < 4; ++q) {
    int4 o; float4 g;
    o.x = ci[4 * q]; o.y = ci[4 * q + 1]; o.z = ci[4 * q + 2]; o.w = ci[4 * q + 3];
    g.x = ev[4 * q] * inv; g.y = ev[4 * q + 1] * inv; g.z = ev[4 * q + 2] * inv; g.w = ev[4 * q + 3] * inv;
    *(int4*)(idx_out + (size_t)pair * 16 + 4 * q) = o;
    *(float4*)(gate_out + (size_t)pair * 16 + 4 * q) = g;
  }
}

typedef float f32x2 __attribute__((ext_vector_type(2)));
__device__ __forceinline__ void d_cvt_tab(int item, const float* __restrict__ src, unsigned* __restrict__ dst8, float* __restrict__ dscale) {
  const int row = item * 4 + (threadIdx.x >> 6);
  const int lane = threadIdx.x & 63;
  const float4* sr = (const float4*)(src + (size_t)row * DM + lane * 16);
  const float4 a = sr[0], b = sr[1], c = sr[2], d = sr[3];
  float m = fmaxf(fmaxf(fmaxf(fabsf(a.x), fabsf(a.y)), fmaxf(fabsf(a.z), fabsf(a.w))),
                  fmaxf(fmaxf(fabsf(b.x), fabsf(b.y)), fmaxf(fabsf(b.z), fabsf(b.w))));
  m = fmaxf(m, fmaxf(fmaxf(fmaxf(fabsf(c.x), fabsf(c.y)), fmaxf(fabsf(c.z), fabsf(c.w))),
                     fmaxf(fmaxf(fabsf(d.x), fabsf(d.y)), fmaxf(fabsf(d.z), fabsf(d.w)))));
#pragma unroll
  for (int o = 32; o > 0; o >>= 1) m = fmaxf(m, __shfl_xor(m, o, 64));
  const float sc = (m > 0.f) ? 240.f / m : 1.f;
  uint4 o;
  int p;
  p = 0; p = __builtin_amdgcn_cvt_pk_fp8_f32(a.x * sc, a.y * sc, p, false); p = __builtin_amdgcn_cvt_pk_fp8_f32(a.z * sc, a.w * sc, p, true); o.x = (unsigned)p;
  p = 0; p = __builtin_amdgcn_cvt_pk_fp8_f32(b.x * sc, b.y * sc, p, false); p = __builtin_amdgcn_cvt_pk_fp8_f32(b.z * sc, b.w * sc, p, true); o.y = (unsigned)p;
  p = 0; p = __builtin_amdgcn_cvt_pk_fp8_f32(c.x * sc, c.y * sc, p, false); p = __builtin_amdgcn_cvt_pk_fp8_f32(c.z * sc, c.w * sc, p, true); o.z = (unsigned)p;
  p = 0; p = __builtin_amdgcn_cvt_pk_fp8_f32(d.x * sc, d.y * sc, p, false); p = __builtin_amdgcn_cvt_pk_fp8_f32(d.z * sc, d.w * sc, p, true); o.w = (unsigned)p;
  *(uint4*)(dst8 + (size_t)row * 256 + lane * 4) = o;
  if (lane == 0) dscale[row] = (m > 0.f) ? m * (1.f / 240.f) : 1.f;
}

__device__ __forceinline__ void d_cvt_tab_i8(int item, const float* __restrict__ src, unsigned* __restrict__ dst8, float* __restrict__ dscale) {
  const int row = item * 4 + (threadIdx.x >> 6);
  const int lane = threadIdx.x & 63;
  const float4* sr = (const float4*)(src + (size_t)row * DM + lane * 16);
  const float4 a = sr[0], b = sr[1], c = sr[2], d = sr[3];
  float m = fmaxf(fmaxf(fmaxf(fabsf(a.x), fabsf(a.y)), fmaxf(fabsf(a.z), fabsf(a.w))),
                  fmaxf(fmaxf(fabsf(b.x), fabsf(b.y)), fmaxf(fabsf(b.z), fabsf(b.w))));
  m = fmaxf(m, fmaxf(fmaxf(fmaxf(fabsf(c.x), fabsf(c.y)), fmaxf(fabsf(c.z), fabsf(c.w))),
                     fmaxf(fmaxf(fabsf(d.x), fabsf(d.y)), fmaxf(fabsf(d.z), fabsf(d.w)))));
#pragma unroll
  for (int o = 32; o > 0; o >>= 1) m = fmaxf(m, __shfl_xor(m, o, 64));
  const float sc = (m > 0.f) ? 127.f / m : 1.f;
#define Q8(x) ((unsigned)(__float2int_rn((x) * sc)) & 0xffu)
  uint4 o;
  o.x = Q8(a.x) | (Q8(a.y) << 8) | (Q8(a.z) << 16) | (Q8(a.w) << 24);
  o.y = Q8(b.x) | (Q8(b.y) << 8) | (Q8(b.z) << 16) | (Q8(b.w) << 24);
  o.z = Q8(c.x) | (Q8(c.y) << 8) | (Q8(c.z) << 16) | (Q8(c.w) << 24);
  o.w = Q8(d.x) | (Q8(d.y) << 8) | (Q8(d.z) << 16) | (Q8(d.w) << 24);
#undef Q8
  *(uint4*)(dst8 + (size_t)row * 256 + lane * 4) = o;
  if (lane == 0) dscale[row] = (m > 0.f) ? m * (1.f / 127.f) : 1.f;
}

__device__ __forceinline__ float erf_fast(float x) {
  const float ax = fabsf(x);
  const float t = __builtin_amdgcn_rcpf(1.f + 0.3275911f * ax);
  float p = 1.061405429f;
  p = p * t - 1.453152027f;
  p = p * t + 1.421413741f;
  p = p * t - 0.284496736f;
  p = p * t + 0.254829592f;
  const float e = __builtin_amdgcn_exp2f(-1.4426950408889634f * ax * ax);
  const float r = 1.f - p * t * e;
  return copysignf(r, x);
}
__device__ __forceinline__ float dot16_f8(const uint4 u, const float* hv) {
  const f32x2 a0 = __builtin_amdgcn_cvt_pk_f32_fp8((int)u.x, false), a1 = __builtin_amdgcn_cvt_pk_f32_fp8((int)u.x, true);
  const f32x2 b0 = __builtin_amdgcn_cvt_pk_f32_fp8((int)u.y, false), b1 = __builtin_amdgcn_cvt_pk_f32_fp8((int)u.y, true);
  const f32x2 c0 = __builtin_amdgcn_cvt_pk_f32_fp8((int)u.z, false), c1 = __builtin_amdgcn_cvt_pk_f32_fp8((int)u.z, true);
  const f32x2 d0 = __builtin_amdgcn_cvt_pk_f32_fp8((int)u.w, false), d1 = __builtin_amdgcn_cvt_pk_f32_fp8((int)u.w, true);
  float s0 = a0[0] * hv[0] + a0[1] * hv[1];
  float s1 = a1[0] * hv[2] + a1[1] * hv[3];
  s0 += b0[0] * hv[4] + b0[1] * hv[5];
  s1 += b1[0] * hv[6] + b1[1] * hv[7];
  s0 += c0[0] * hv[8] + c0[1] * hv[9];
  s1 += c1[0] * hv[10] + c1[1] * hv[11];
  s0 += d0[0] * hv[12] + d0[1] * hv[13];
  s1 += d1[0] * hv[14] + d1[1] * hv[15];
  return s0 + s1;
}
__device__ __forceinline__ void axpy16_f8(const uint4 v, const float wg, float* acc) {
  const f32x2 a0 = __builtin_amdgcn_cvt_pk_f32_fp8((int)v.x, false), a1 = __builtin_amdgcn_cvt_pk_f32_fp8((int)v.x, true);
  const f32x2 b0 = __builtin_amdgcn_cvt_pk_f32_fp8((int)v.y, false), b1 = __builtin_amdgcn_cvt_pk_f32_fp8((int)v.y, true);
  const f32x2 c0 = __builtin_amdgcn_cvt_pk_f32_fp8((int)v.z, false), c1 = __builtin_amdgcn_cvt_pk_f32_fp8((int)v.z, true);
  const f32x2 d0 = __builtin_amdgcn_cvt_pk_f32_fp8((int)v.w, false), d1 = __builtin_amdgcn_cvt_pk_f32_fp8((int)v.w, true);
  acc[0] += wg * a0[0]; acc[1] += wg * a0[1]; acc[2] += wg * a1[0]; acc[3] += wg * a1[1];
  acc[4] += wg * b0[0]; acc[5] += wg * b0[1]; acc[6] += wg * b1[0]; acc[7] += wg * b1[1];
  acc[8] += wg * c0[0]; acc[9] += wg * c0[1]; acc[10] += wg * c1[0]; acc[11] += wg * c1[1];
  acc[12] += wg * d0[0]; acc[13] += wg * d0[1]; acc[14] += wg * d1[0]; acc[15] += wg * d1[1];
}
typedef int i32x4 __attribute__((ext_vector_type(4)));
__device__ __forceinline__ void d_peer(int item, char* smem, const float* __restrict__ x1, const float* __restrict__ rs2,
                                       const float* __restrict__ g2, const int* __restrict__ idx,
                                       const float* __restrict__ gate, const unsigned* __restrict__ pu,
                                       const unsigned* __restrict__ pv, const float* __restrict__ su,
                                       const float* __restrict__ sv, const float* __restrict__ gf,
                                       float* __restrict__ out, float oscale) {
  int tid_ = threadIdx.x;
  asm volatile("" : "+v"(tid_));
  const int wv = tid_ >> 6;
  const int t = item * 4 + wv;
  const int lane = tid_ & 63, q = lane >> 4;
  char* hq = smem + wv * 1024;
  float r2;
  {
    const float4* pr = (const float4*)(rs2 + (size_t)t * 16);
    const float4 s0 = pr[0], s1 = pr[1], s2 = pr[2], s3 = pr[3];
    const float ssq = ((s0.x + s0.y) + (s0.z + s0.w)) + ((s1.x + s1.y) + (s1.z + s1.w)) + ((s2.x + s2.y) + (s2.z + s2.w)) + ((s3.x + s3.y) + (s3.z + s3.w));
    r2 = rsqrtf(ssq * (1.f / DM) + EPSF);
  }
  float sh;
  {
    float hv[16];
    float m = 0.f;
#pragma unroll
    for (int c = 0; c < 4; ++c) {
      const float4 xx = *(const float4*)(x1 + (size_t)t * DM + lane * 16 + c * 4);
      const float4 gg = *(const float4*)(g2 + lane * 16 + c * 4);
      hv[c * 4 + 0] = xx.x * r2 * gg.x; hv[c * 4 + 1] = xx.y * r2 * gg.y;
      hv[c * 4 + 2] = xx.z * r2 * gg.z; hv[c * 4 + 3] = xx.w * r2 * gg.w;
      m = fmaxf(m, fmaxf(fmaxf(fabsf(hv[c * 4]), fabsf(hv[c * 4 + 1])), fmaxf(fabsf(hv[c * 4 + 2]), fabsf(hv[c * 4 + 3]))));
    }
#pragma unroll
    for (int o = 32; o > 0; o >>= 1) m = fmaxf(m, __shfl_xor(m, o, 64));
    const float sc = (m > 0.f) ? 127.f / m : 1.f;
    sh = (m > 0.f) ? m * (1.f / 127.f) : 1.f;
#define Q8(x) ((unsigned)(__float2int_rn((x) * sc)) & 0xffu)
    uint4 o;
    o.x = Q8(hv[0]) | (Q8(hv[1]) << 8) | (Q8(hv[2]) << 16) | (Q8(hv[3]) << 24);
    o.y = Q8(hv[4]) | (Q8(hv[5]) << 8) | (Q8(hv[6]) << 16) | (Q8(hv[7]) << 24);
    o.z = Q8(hv[8]) | (Q8(hv[9]) << 8) | (Q8(hv[10]) << 16) | (Q8(hv[11]) << 24);
    o.w = Q8(hv[12]) | (Q8(hv[13]) << 8) | (Q8(hv[14]) << 16) | (Q8(hv[15]) << 24);
#undef Q8
    *(uint4*)(hq + lane * 16) = o;
  }
  float acc[16];
#pragma unroll
  for (int i = 0; i < 16; ++i) acc[i] = 0.f;
  float* wl = (float*)(smem + 4096) + wv * 128;
  int ka = (idx[(size_t)t * 128 + lane] << 7) | lane;
  int kb = (idx[(size_t)t * 128 + 64 + lane] << 7) | (64 + lane);
  const float gt_a0 = gate[(size_t)t * 128 + lane], gt_b0 = gate[(size_t)t * 128 + 64 + lane];
#pragma unroll
  for (int k = 2; k <= 128; k <<= 1) {
#pragma unroll
    for (int j = k >> 1; j > 0; j >>= 1) {
      if (j == 64) {
        const int lo = min(ka, kb), hi = max(ka, kb);
        ka = lo; kb = hi;
      } else {
        const int oa = __shfl_xor(ka, j, 64), ob = __shfl_xor(kb, j, 64);
        const bool lower = (lane & j) == 0;
        const bool upa = (lane & k) == 0;
        const bool upb = ((lane + 64) & k) == 0;
        ka = (upa == lower) ? min(ka, oa) : max(ka, oa);
        kb = (upb == lower) ? min(kb, ob) : max(kb, ob);
      }
    }
  }
  const int id_a = ka >> 7, id_b = kb >> 7;
  const int oa_ = ka & 127, ob_ = kb & 127;
  const float ga1 = __shfl(gt_a0, oa_ & 63, 64), ga2 = __shfl(gt_b0, oa_ & 63, 64);
  const float gb1 = __shfl(gt_a0, ob_ & 63, 64), gb2 = __shfl(gt_b0, ob_ & 63, 64);
  const float gt_a = (oa_ < 64) ? ga1 : ga2, gt_b = (ob_ < 64) ? gb1 : gb2;
  for (int g = 0; g < 8; ++g) {
    const int srcl = (16 * g + (lane & 15)) & 63;
    const int idr = (g < 4) ? __shfl(id_a, srcl, 64) : __shfl(id_b, srcl, 64);
    const char* ub = (const char*)pu + (size_t)idr * 1024 + 16 * q;
    i32x4 ua[16];
#pragma unroll
    for (int s2 = 0; s2 < 16; ++s2) ua[s2] = *(const i32x4*)(ub + 64 * s2);
    int ide[4]; float gte[4], sue[4], sve[4];
#pragma unroll
    for (int reg = 0; reg < 4; ++reg) {
      const int el = (16 * g + 4 * q + reg) & 63;
      ide[reg] = (g < 4) ? __shfl(id_a, el, 64) : __shfl(id_b, el, 64);
      gte[reg] = (g < 4) ? __shfl(gt_a, el, 64) : __shfl(gt_b, el, 64);
      sue[reg] = su[ide[reg]];
      sve[reg] = sv[ide[reg]];
    }
    i32x4 d4 = {0, 0, 0, 0};
#pragma unroll
    for (int s2 = 0; s2 < 16; ++s2) {
      const i32x4 bfr = *(const i32x4*)(hq + 64 * s2 + 16 * q);
      d4 = __builtin_amdgcn_mfma_i32_16x16x64_i8(ua[s2], bfr, d4, 0, 0, 0);
    }
    float4 w4;
    {
      const float d0 = (float)d4[0] * (sue[0] * sh), d1 = (float)d4[1] * (sue[1] * sh);
      const float d2 = (float)d4[2] * (sue[2] * sh), d3 = (float)d4[3] * (sue[3] * sh);
      w4.x = gte[0] * sve[0] * 0.5f * d0 * (1.f + erf_fast(d0 * 0.7071067811865476f));
      w4.y = gte[1] * sve[1] * 0.5f * d1 * (1.f + erf_fast(d1 * 0.7071067811865476f));
      w4.z = gte[2] * sve[2] * 0.5f * d2 * (1.f + erf_fast(d2 * 0.7071067811865476f));
      w4.w = gte[3] * sve[3] * 0.5f * d3 * (1.f + erf_fast(d3 * 0.7071067811865476f));
    }
    if ((lane & 15) == 0) *(float4*)(wl + 16 * g + 4 * q) = w4;
  }
  for (int e0 = 0; e0 < 128; e0 += 8) {
    uint4 v[8];
#pragma unroll
    for (int k = 0; k < 8; ++k) {
      const int e = (e0 + k) & 63;
      const int id = (e0 < 64) ? __builtin_amdgcn_readlane(id_a, e) : __builtin_amdgcn_readlane(id_b, e);
      v[k] = *(const uint4*)(pv + (size_t)id * 256 + lane * 4);
    }
    const float4 w0 = *(const float4*)(wl + e0), w1 = *(const float4*)(wl + e0 + 4);
    axpy16_f8(v[0], w0.x, acc); axpy16_f8(v[1], w0.y, acc); axpy16_f8(v[2], w0.z, acc); axpy16_f8(v[3], w0.w, acc);
    axpy16_f8(v[4], w1.x, acc); axpy16_f8(v[5], w1.y, acc); axpy16_f8(v[6], w1.z, acc); axpy16_f8(v[7], w1.w, acc);
  }
  float ss = 0.f;
#pragma unroll
  for (int c = 0; c < 4; ++c) {
    const float4 xx = *(const float4*)(x1 + (size_t)t * DM + lane * 16 + c * 4);
    acc[c * 4 + 0] += xx.x; acc[c * 4 + 1] += xx.y; acc[c * 4 + 2] += xx.z; acc[c * 4 + 3] += xx.w;
  }
#pragma unroll
  for (int i = 0; i < 16; ++i) ss += acc[i] * acc[i];
  ss = wave_sum(ss);
  const float sc = rsqrtf(ss * (1.f / DM) + EPSF) * oscale;
#pragma unroll
  for (int q4 = 0; q4 < 4; ++q4) {
    const float4 gg = *(const float4*)(gf + lane * 16 + q4 * 4);
    float4 o;
    o.x = acc[q4 * 4 + 0] * sc * gg.x; o.y = acc[q4 * 4 + 1] * sc * gg.y;
    o.z = acc[q4 * 4 + 2] * sc * gg.z; o.w = acc[q4 * 4 + 3] * sc * gg.w;
    *(float4*)(out + (size_t)t * DM + lane * 16 + q4 * 4) = o;
  }
}

typedef __attribute__((ext_vector_type(16))) float f32x16;
#define MFMA32(a, b, c) __builtin_amdgcn_mfma_f32_32x32x16_bf16((a), (b), (c), 0, 0, 0)
__device__ __forceinline__ int crow(int reg, int hh) { return (reg & 3) + 8 * (reg >> 2) + 4 * hh; }

struct GdnBufs {
  unsigned short* qc;
  unsigned short* kTc;
  unsigned short* qkc;
  unsigned short* wn;
  unsigned short* uo;
  float* gsc;
};

__device__ __forceinline__ void tri_subst(const float* AL0, int lane, float (&T)[64]) {
  const float* AL = (const float*)__builtin_assume_aligned(AL0, 16);
#pragma unroll
  for (int i = 0; i < 64; ++i) T[i] = 0.f;
  T[0] = (lane == 0) ? 1.f : 0.f;
  float4 cur[16], nxt[16];
#pragma unroll
  for (int j4 = 0; j4 < 1; ++j4) cur[j4] = *(const float4*)(AL + 1 * 72 + 4 * j4);
#pragma unroll
  for (int i = 1; i < 64; ++i) {
    if (i + 1 < 64) {
#pragma unroll
      for (int j4 = 0; j4 < (i + 4) / 4; ++j4) nxt[j4] = *(const float4*)(AL + (i + 1) * 72 + 4 * j4);
    }
    float ax = 0.f, ay = 0.f, az = 0.f, aw = 0.f;
#pragma unroll
    for (int j4 = 0; j4 < (i + 3) / 4; ++j4) {
      ax += cur[j4].x * T[4 * j4]; ay += cur[j4].y * T[4 * j4 + 1]; az += cur[j4].z * T[4 * j4 + 2]; aw += cur[j4].w * T[4 * j4 + 3];
    }
    T[i] = ((lane == i) ? 1.f : 0.f) - ((ax + ay) + (az + aw));
#pragma unroll
    for (int j4 = 0; j4 < 16; ++j4) cur[j4] = nxt[j4];
  }
}

__device__ __forceinline__ void d_gdn_prep(int item, char* smem, const unsigned short* __restrict__ pm,
                                           const float* __restrict__ gt, const float* __restrict__ conv_w, GdnBufs G) {
  unsigned short* qL = (unsigned short*)smem;
  unsigned short* kL = qL + 64 * 144;
  unsigned short* kTL = kL + 64 * 144;
  unsigned short* vTL = kTL + 128 * 72;
  float* scal = (float*)(vTL + 128 * 72);
  float* A0 = (float*)qL;
  float* A1 = (float*)kL;
  int tid = threadIdx.x;
  asm volatile("" : "+v"(tid));
  const int lane = tid & 63, w = __builtin_amdgcn_readfirstlane(tid >> 6), r = lane & 31, hh = lane >> 5;
  const int bh = item >> 6, c = item & 63, b = bh >> 2, h = bh & 3;
  const int t0 = b * SEQ + c * 64;
  __syncthreads();
  {
#pragma unroll
    for (int sec = 0; sec < 3; ++sec) {
      const int c0 = sec * 512 + h * 128 + 2 * lane;
      float cw0[5], cw1[5];
#pragma unroll
      for (int j = 0; j < 5; ++j) { cw0[j] = conv_w[c0 * 5 + j]; cw1[j] = conv_w[(c0 + 1) * 5 + j]; }
      unsigned raw[20];
#pragma unroll
      for (int k = 0; k < 20; ++k) {
        const int sp = c * 64 + w * 16 + k - 2;
        raw[k] = (sp >= 0 && sp < SEQ) ? *(const unsigned*)(pm + ((size_t)t0 + w * 16 + k - 2) * 4096 + c0) : 0u;
      }
#pragma unroll
      for (int ii = 0; ii < 16; ++ii) {
        const int i = w * 16 + ii;
        float a0 = 0.f, a1 = 0.f;
#pragma unroll
        for (int j = 0; j < 5; ++j) {
          a0 += cw0[j] * bf2f((unsigned short)(raw[ii + j] & 0xffff));
          a1 += cw1[j] * __uint_as_float(raw[ii + j] & 0xffff0000u);
        }
        a0 = a0 * __builtin_amdgcn_rcpf(1.f + __builtin_amdgcn_exp2f(-1.4426950408889634f * a0));
        a1 = a1 * __builtin_amdgcn_rcpf(1.f + __builtin_amdgcn_exp2f(-1.4426950408889634f * a1));
        if (sec < 2) {
          const float ss = wave_sum_dpp(a0 * a0 + a1 * a1);
          float sc = rsqrtf(ss + EPSF);
          if (sec == 0) sc *= 0.08838834764831845f;
          a0 *= sc; a1 *= sc;
        }
        if (sec == 0) {
          *(unsigned*)(qL + i * 144 + 2 * lane) = pack2(a0, a1);
        } else if (sec == 1) {
          const unsigned pk = pack2(a0, a1);
          *(unsigned*)(kL + i * 144 + 2 * lane) = pk;
          kTL[(2 * lane) * 72 + i] = (unsigned short)(pk & 0xffff);
          kTL[(2 * lane + 1) * 72 + i] = (unsigned short)(pk >> 16);
        } else {
          const unsigned pk = pack2(a0, a1);
          vTL[(2 * lane) * 72 + i] = (unsigned short)(pk & 0xffff);
          vTL[(2 * lane + 1) * 72 + i] = (unsigned short)(pk >> 16);
        }
      }
    }
  }
  if (w == 0) {
    const float* gp = gt + ((size_t)t0 + lane) * 32;
    const float g0 = gp[h], g1 = gp[4 + h], b0 = gp[8 + h], b1 = gp[12 + h];
    float G0 = g0, G1 = g1;
#pragma unroll
    for (int o = 1; o < 64; o <<= 1) {
      const float v0 = __shfl_up(G0, o, 64);
      const float v1 = __shfl_down(G1, o, 64);
      if (lane >= o) G0 += v0;
      if (lane + o < 64) G1 += v1;
    }
    scal[lane] = G0 * 1.4426950408889634f; scal[64 + lane] = G1 * 1.4426950408889634f;
    scal[128 + lane] = b0; scal[192 + lane] = b1;
    const float GL0 = __shfl(G0, 63, 64), GL1 = __shfl(G1, 0, 64);
    float* gs0 = G.gsc + ((size_t)((bh * 2 + 0) * 64 + c)) * 192;
    float* gs1 = G.gsc + ((size_t)((bh * 2 + 1) * 64 + c)) * 192;
    gs0[lane] = expf(G0); gs0[64 + lane] = expf(GL0 - G0);
    gs1[lane] = expf(G1); gs1[64 + lane] = expf(GL1 - G1);
    if (lane == 0) { gs0[128] = expf(GL0); gs1[128] = expf(GL1); }
  }
  __syncthreads();
  {
    unsigned short* qg = G.qc + (size_t)item * 8192;
    unsigned short* kg = G.kTc + (size_t)item * 8192;
#pragma unroll
    for (int i = 0; i < 4; ++i) {
      const int id = tid + i * 256;
      {
        const int row = id >> 4, c16 = id & 15;
        *(uint4*)(qg + (row >> 5) * 4096 + ((c16 >> 1) * 64 + (c16 & 1) * 32 + (row & 31)) * 8) = *(const uint4*)(qL + row * 144 + c16 * 8);
      }
      {
        const int row = id >> 3, c8 = id & 7;
        *(uint4*)(kg + (row >> 5) * 2048 + ((c8 >> 1) * 64 + (c8 & 1) * 32 + (row & 31)) * 8) = *(const uint4*)(kTL + row * 72 + c8 * 8);
      }
    }
  }
  {
    const int ta = w >> 1, tb = w & 1;
    f32x16 acc, acc2;
#pragma unroll
    for (int i = 0; i < 16; ++i) { acc[i] = 0.f; acc2[i] = 0.f; }
#pragma unroll
    for (int s = 0; s < 8; ++s) {
      const bf16x8 a = *(const bf16x8*)(kL + (32 * ta + r) * 144 + 16 * s + 8 * hh);
      const bf16x8 bk = *(const bf16x8*)(kL + (32 * tb + r) * 144 + 16 * s + 8 * hh);
      const bf16x8 bq = *(const bf16x8*)(qL + (32 * tb + r) * 144 + 16 * s + 8 * hh);
      acc = MFMA32(a, bk, acc);
      acc2 = MFMA32(a, bq, acc2);
    }
    __syncthreads();
    {
      const int col = 32 * tb + r;
      const float G0c = scal[col], G1c = scal[64 + col];
#pragma unroll
      for (int reg = 0; reg < 16; ++reg) {
        const int row = 32 * ta + crow(reg, hh);
        const float v = acc[reg];
        const float a0 = (col < row) ? scal[128 + row] * v * __builtin_amdgcn_exp2f(scal[row] - G0c) : 0.f;
        const float a1 = (col > row) ? scal[192 + row] * v * __builtin_amdgcn_exp2f(scal[64 + row] - G1c) : 0.f;
        A0[row * 72 + col] = a0;
        A1[(63 - row) * 72 + (63 - col)] = a1;
      }
    }
    {
      const int i = 32 * tb + r;
      const float G0i = scal[i], G1i = scal[64 + i];
      unsigned short* qk0 = G.qkc + ((size_t)((bh * 2 + 0) * 64 + c)) * 4096;
      unsigned short* qk1 = G.qkc + ((size_t)((bh * 2 + 1) * 64 + c)) * 4096;
#pragma unroll
      for (int g = 0; g < 4; ++g) {
        float o0[4], o1[4];
#pragma unroll
        for (int e = 0; e < 4; ++e) {
          const int j = 32 * ta + 8 * g + 4 * hh + e;
          const float v = acc2[4 * g + e];
          o0[e] = (j <= i) ? v * __builtin_amdgcn_exp2f(G0i - scal[j]) : 0.f;
          o1[e] = (j >= i) ? v * __builtin_amdgcn_exp2f(G1i - scal[64 + j]) : 0.f;
        }
        uint2 p0, p1;
        p0.x = pack2(o0[0], o0[1]); p0.y = pack2(o0[2], o0[3]);
        p1.x = pack2(o1[0], o1[1]); p1.y = pack2(o1[2], o1[3]);
        const int qoff = tb * 2048 + ((2 * ta + (g >> 1)) * 64 + (g & 1) * 32 + r) * 8 + 4 * hh;
        *(uint2*)(qk0 + qoff) = p0;
        *(uint2*)(qk1 + qoff) = p1;
      }
    }
  }
  __syncthreads();
  if (w < 2) {
    const int dir = w;
    float T[64];
    tri_subst(A0 + dir * (64 * 72), lane, T);
    const int jn = dir ? 63 - lane : lane;
    const float sb = scal[128 + 64 * dir + jn];
    const float sbg = sb * __builtin_amdgcn_exp2f(scal[64 * dir + jn]);
    unsigned short* Tb = dir ? kL : qL;
    unsigned short* Tbg = Tb + 64 * 72;
#pragma unroll
    for (int ip = 0; ip < 64; ++ip) {
      const int in = dir ? 63 - ip : ip;
      Tb[in * 72 + jn] = f2bf(T[ip] * sb);
      Tbg[in * 72 + jn] = f2bf(T[ip] * sbg);
    }
  }
  __syncthreads();
#pragma unroll
  for (int d = 0; d < 2; ++d) {
    const int chain = bh * 2 + d;
    const unsigned short* Tb = d ? kL : qL;
    const unsigned short* Tbg = Tb + 64 * 72;
    unsigned short* wng = G.wn + ((size_t)(chain * 64 + c)) * 8192;
    unsigned short* uog = G.uo + ((size_t)(chain * 64 + c)) * 8192 + w * 2048;
#pragma unroll
    for (int tb = 0; tb < 2; ++tb) {
      f32x16 acc, acc2;
#pragma unroll
      for (int i = 0; i < 16; ++i) { acc[i] = 0.f; acc2[i] = 0.f; }
#pragma unroll
      for (int s = 0; s < 4; ++s) {
        const bf16x8 a = *(const bf16x8*)(kTL + (32 * w + r) * 72 + 16 * s + 8 * hh);
        const bf16x8 bb = *(const bf16x8*)(Tbg + (32 * tb + r) * 72 + 16 * s + 8 * hh);
        acc = MFMA32(a, bb, acc);
        const bf16x8 a2 = *(const bf16x8*)(Tb + (32 * tb + r) * 72 + 16 * s + 8 * hh);
        const bf16x8 b2 = *(const bf16x8*)(vTL + (32 * w + r) * 72 + 16 * s + 8 * hh);
        acc2 = MFMA32(a2, b2, acc2);
      }
#pragma unroll
      for (int g = 0; g < 4; ++g) {
        uint2 pk;
        pk.x = pack2(-acc[4 * g], -acc[4 * g + 1]); pk.y = pack2(-acc[4 * g + 2], -acc[4 * g + 3]);
        *(uint2*)(wng + tb * 4096 + ((2 * w + (g >> 1)) * 64 + (g & 1) * 32 + r) * 8 + 4 * hh) = pk;
      }
      uint4 u0, u1;
      u0.x = pack2(acc2[0], acc2[1]); u0.y = pack2(acc2[2], acc2[3]); u0.z = pack2(acc2[4], acc2[5]); u0.w = pack2(acc2[6], acc2[7]);
      u1.x = pack2(acc2[8], acc2[9]); u1.y = pack2(acc2[10], acc2[11]); u1.z = pack2(acc2[12], acc2[13]); u1.w = pack2(acc2[14], acc2[15]);
      *(uint4*)(uog + tb * 1024 + lane * 16) = u0;
      *(uint4*)(uog + tb * 1024 + lane * 16 + 8) = u1;
    }
  }
}

struct GdnOps {
  bf16x8 a[8];
  bf16x8 x[4];
  bf16x8 kt[4];
  float4 rs[4];
  float gtot;
};
__device__ __forceinline__ void gdn_load(GdnOps& o, const GdnBufs& G, int chain, int bh, int c, int sl, int w, int r, int hh, int lane) {
  const unsigned short* kT_c = G.kTc + ((size_t)(bh * 64 + c)) * 8192;
  const float* gs = G.gsc + ((size_t)(chain * 64 + c)) * 192;
  const int ti = w & 1;
#pragma unroll
  for (int s = 0; s < 4; ++s) o.kt[s] = *(const bf16x8*)(kT_c + w * 2048 + (s * 64 + lane) * 8);
  o.gtot = gs[128];
  if (w < 2) {
    const unsigned short* wn_c = G.wn + ((size_t)(chain * 64 + c)) * 8192;
    const unsigned short* uo_c = G.uo + ((size_t)(chain * 64 + c)) * 8192 + sl * 2048;
#pragma unroll
    for (int s = 0; s < 8; ++s) o.a[s] = *(const bf16x8*)(wn_c + ti * 4096 + (s * 64 + lane) * 8);
    o.x[0] = *(const bf16x8*)(uo_c + ti * 1024 + lane * 16);
    o.x[1] = *(const bf16x8*)(uo_c + ti * 1024 + lane * 16 + 8);
#pragma unroll
    for (int g = 0; g < 4; ++g) o.rs[g] = *(const float4*)(gs + 64 + 32 * ti + 8 * g + 4 * hh);
  } else {
    const unsigned short* q_c = G.qc + ((size_t)(bh * 64 + c)) * 8192;
    const unsigned short* qk_c = G.qkc + ((size_t)(chain * 64 + c)) * 4096;
#pragma unroll
    for (int s = 0; s < 8; ++s) o.a[s] = *(const bf16x8*)(q_c + ti * 4096 + (s * 64 + lane) * 8);
#pragma unroll
    for (int s = 0; s < 4; ++s) o.x[s] = *(const bf16x8*)(qk_c + ti * 2048 + (s * 64 + lane) * 8);
#pragma unroll
    for (int g = 0; g < 4; ++g) o.rs[g] = *(const float4*)(gs + 32 * ti + 8 * g + 4 * hh);
  }
}
__device__ __forceinline__ void gdn_step(const GdnOps& o, f32x16& S, unsigned short* ST, unsigned short* VT, unsigned short* VdT,
                                         unsigned short* uo_c, int w, int r, int hh) {
  const int ti = w & 1;
  f32x16 acc;
  if (w < 2) {
#pragma unroll
    for (int i = 0; i < 8; ++i) {
      acc[i] = bf2f((unsigned short)o.x[0][i]);
      acc[8 + i] = bf2f((unsigned short)o.x[1][i]);
    }
  } else {
#pragma unroll
    for (int i = 0; i < 16; ++i) acc[i] = 0.f;
  }
#pragma unroll
  for (int g = 0; g < 4; ++g) {
    uint2 pk;
    pk.x = pack2(S[4 * g], S[4 * g + 1]); pk.y = pack2(S[4 * g + 2], S[4 * g + 3]);
    *(uint2*)(ST + r * 136 + 32 * w + 8 * g + 4 * hh) = pk;
  }
  __syncthreads();
#pragma unroll
  for (int s = 0; s < 8; ++s) {
    const bf16x8 bs = *(const bf16x8*)(ST + r * 136 + 16 * s + 8 * hh);
    acc = MFMA32(o.a[s], bs, acc);
  }
  if (w < 2) {
#pragma unroll
    for (int g = 0; g < 4; ++g) {
      uint2 pk, pd;
      pk.x = pack2(acc[4 * g], acc[4 * g + 1]); pk.y = pack2(acc[4 * g + 2], acc[4 * g + 3]);
      pd.x = pack2(acc[4 * g] * o.rs[g].x, acc[4 * g + 1] * o.rs[g].y);
      pd.y = pack2(acc[4 * g + 2] * o.rs[g].z, acc[4 * g + 3] * o.rs[g].w);
      *(uint2*)(VT + r * 72 + 32 * ti + 8 * g + 4 * hh) = pk;
      *(uint2*)(VdT + r * 72 + 32 * ti + 8 * g + 4 * hh) = pd;
    }
  } else {
#pragma unroll
    for (int g = 0; g < 4; ++g) {
      acc[4 * g] *= o.rs[g].x; acc[4 * g + 1] *= o.rs[g].y; acc[4 * g + 2] *= o.rs[g].z; acc[4 * g + 3] *= o.rs[g].w;
    }
  }
  __syncthreads();
  if (w >= 2) {
#pragma unroll
    for (int s = 0; s < 4; ++s) {
      const bf16x8 bv = *(const bf16x8*)(VT + r * 72 + 16 * s + 8 * hh);
      acc = MFMA32(o.x[s], bv, acc);
    }
#pragma unroll
    for (int reg = 0; reg < 16; ++reg) uo_c[(32 * ti + crow(reg, hh)) * 32 + r] = f2bf(acc[reg]);
  }
#pragma unroll
  for (int i = 0; i < 16; ++i) S[i] *= o.gtot;
#pragma unroll
  for (int s = 0; s < 4; ++s) {
    const bf16x8 bv = *(const bf16x8*)(VdT + r * 72 + 16 * s + 8 * hh);
    S = MFMA32(o.kt[s], bv, S);
  }
}
__device__ __forceinline__ void d_gdn_scan(int chain, int sl, char* smem, GdnBufs G) {
  unsigned short* ST = (unsigned short*)smem;
  unsigned short* VT = ST + 32 * 136;
  unsigned short* VdT = VT + 32 * 72;
  const int tid = threadIdx.x, lane = tid & 63, w = __builtin_amdgcn_readfirstlane(tid >> 6), r = lane & 31, hh = lane >> 5;
  const int bh = chain >> 1, dir = chain & 1;
  f32x16 S;
#pragma unroll
  for (int i = 0; i < 16; ++i) S[i] = 0.f;
  GdnOps A, B;
  gdn_load(A, G, chain, bh, dir ? 63 : 0, sl, w, r, hh, lane);
  for (int step = 0; step < 64; step += 2) {
    const int c0 = dir ? 63 - step : step;
    const int c1 = dir ? c0 - 1 : c0 + 1;
    const int c2 = dir ? c0 - 2 : c0 + 2;
    gdn_load(B, G, chain, bh, c1, sl, w, r, hh, lane);
    gdn_step(A, S, ST, VT, VdT, G.uo + ((size_t)(chain * 64 + c0)) * 8192 + sl * 2048, w, r, hh);
    if (step + 2 < 64) gdn_load(A, G, chain, bh, c2, sl, w, r, hh, lane);
    gdn_step(B, S, ST, VT, VdT, G.uo + ((size_t)(chain * 64 + c1)) * 8192 + sl * 2048, w, r, hh);
  }
}

__device__ __forceinline__ void d_ml_gates(int item, const float* __restrict__ gt, float* __restrict__ pre, float* __restrict__ gtots) {
  const int wv = item * 4 + (threadIdx.x >> 6);
  const int lane = threadIdx.x & 63;
  const int chain = wv >> 6, c = wv & 63;
  const int bh = chain >> 1, dir = chain & 1, b = bh >> 2, h = bh & 3;
  const size_t t0 = (size_t)b * SEQ + c * 64;
  const float lf = gt[(t0 + lane) * 32 + 24 + dir * 4 + h];
  const float ip = gt[(t0 + lane) * 32 + 16 + dir * 4 + h];
  float bc = lf;
#pragma unroll
  for (int ofs = 1; ofs < 64; ofs <<= 1) {
    const float vu = __shfl_up(bc, ofs, 64);
    const float vd = __shfl_down(bc, ofs, 64);
    if (dir == 0) { if (lane >= ofs) bc += vu; } else { if (lane + ofs < 64) bc += vd; }
  }
  const float b_last = __shfl(bc, dir ? 0 : 63, 64);
  float4 o;
  o.x = expf(bc);
  o.y = (ip - bc) * 1.4426950408889634f - 3.5f;
  o.z = bc * 1.4426950408889634f;
  o.w = 0.08838834764831845f * expf(b_last - bc + ip);
  *(float4*)(pre + ((size_t)chain * SEQ + c * 64 + lane) * 4) = o;
  if (lane == 0) gtots[wv] = expf(b_last);
}

#define ML_LDK(R, I, T0) R = *(const uint4*)(pm + ((T0) + ((t128 + (I) * 128) >> 4)) * 4096 + 2560 + h * 128 + (t128 & 15) * 8);
#define ML_STK(R, I) *(uint4*)(kLb + ((t128 + (I) * 128) >> 4) * 136 + (t128 & 15) * 8) = R;
#define ML_LOAD(T0)                                                                                         \
  {                                                                                                         \
    ML_LDK(pk0, 0, T0) ML_LDK(pk1, 1, T0) ML_LDK(pk2, 2, T0) ML_LDK(pk3, 3, T0)                             \
    ML_LDK(pk4, 4, T0) ML_LDK(pk5, 5, T0) ML_LDK(pk6, 6, T0) ML_LDK(pk7, 7, T0)                             \
    pv0 = *(const uint4*)(pm + ((T0) + (t128 >> 2)) * 4096 + 3072 + h * 128 + sl * 32 + (t128 & 3) * 8);    \
    pv1 = *(const uint4*)(pm + ((T0) + ((t128 + 128) >> 2)) * 4096 + 3072 + h * 128 + sl * 32 + (t128 & 3) * 8); \
    pgl = *(const float4*)(pre + ((size_t)chain * SEQ + ((T0) - tb) + lane) * 4);                           \
    pgt = gtots[chain * 64 + (int)(((T0) - tb) >> 6)];                                                      \
  }
#define ML_PUTV(W, E)                                                                                       \
  {                                                                                                         \
    const unsigned short lo_ = (unsigned short)((W) & 0xffff), hi_ = (unsigned short)((W) >> 16);           \
    vTb[(d8_ + (E)) * 72 + tok_] = lo_;                                                                     \
    vTb[(d8_ + (E) + 1) * 72 + tok_] = hi_;                                                                 \
    const unsigned sc_ = pack2(bf2f(lo_) * dj_, bf2f(hi_) * dj_);                                           \
    vdb[(d8_ + (E)) * 72 + tok_] = (unsigned short)(sc_ & 0xffff);                                          \
    vdb[(d8_ + (E) + 1) * 72 + tok_] = (unsigned short)(sc_ >> 16);                                         \
  }
#define ML_STAGE(BUF)                                                                                       \
  {                                                                                                         \
    unsigned short* kLb = kL + (BUF) * (64 * 136);                                                          \
    unsigned short* vTb = vTL + (BUF) * (32 * 72);                                                          \
    unsigned short* vdb = vdTL + (BUF) * (32 * 72);                                                         \
    float* scb = scal + (BUF) * 208;                                                                        \
    if (w == 2) {                                                                                           \
      scb[lane] = pgl.x; scb[64 + lane] = pgl.y; scb[128 + lane] = pgl.z;                                   \
      dL[(BUF) * 72 + lane] = f2bf(pgl.w);                                                                  \
      if (lane == 0) scb[192] = pgt;                                                                        \
    }                                                                                                       \
    ML_STK(pk0, 0) ML_STK(pk1, 1) ML_STK(pk2, 2) ML_STK(pk3, 3) ML_STK(pk4, 4) ML_STK(pk5, 5) ML_STK(pk6, 6) ML_STK(pk7, 7) \
    {                                                                                                       \
      const int tok_ = t128 >> 2, d8_ = (t128 & 3) * 8;                                                     \
      const float dj_ = __shfl(pgl.w, tok_, 64);                                                            \
      ML_PUTV(pv0.x, 0); ML_PUTV(pv0.y, 2); ML_PUTV(pv0.z, 4); ML_PUTV(pv0.w, 6);                           \
    }                                                                                                       \
    {                                                                                                       \
      const int tok_ = (t128 + 128) >> 2, d8_ = (t128 & 3) * 8;                                             \
      const float dj_ = __shfl(pgl.w, tok_, 64);                                                            \
      ML_PUTV(pv1.x, 0); ML_PUTV(pv1.y, 2); ML_PUTV(pv1.z, 4); ML_PUTV(pv1.w, 6);                           \
    }                                                                                                       \
  }
__device__ __forceinline__ void ml_state_image(const f32x16& S0, const f32x16& S1, unsigned short* S0T, unsigned short* nL, int w, int r, int hh) {
#pragma unroll
  for (int g = 0; g < 4; ++g) {
    uint2 pk;
    pk.x = pack2(S0[4 * g], S0[4 * g + 1]); pk.y = pack2(S0[4 * g + 2], S0[4 * g + 3]);
    *(uint2*)(S0T + r * 136 + 32 * w + 8 * g + 4 * hh) = pk;
    if (r == 0) {
      uint2 pn;
      pn.x = pack2(S1[4 * g], S1[4 * g + 1]); pn.y = pack2(S1[4 * g + 2], S1[4 * g + 3]);
      *(uint2*)(nL + 32 * w + 8 * g + 4 * hh) = pn;
    }
  }
}
__device__ __forceinline__ void ml_state_update(f32x16& S0, f32x16& S1, const unsigned short* kLb, const unsigned short* vdb,
                                                const unsigned short* dLb, float gtot, int w, int r, int hh) {
#pragma unroll
  for (int i = 0; i < 16; ++i) { S0[i] *= gtot; S1[i] *= gtot; }
#pragma unroll
  for (int s2 = 0; s2 < 4; ++s2) {
    union { bf16x8 v; unsigned short e[8]; } a;
#pragma unroll
    for (int e = 0; e < 8; ++e) a.e[e] = kLb[(16 * s2 + 8 * hh + e) * 136 + 32 * w + r];
    const bf16x8 bv = *(const bf16x8*)(vdb + r * 72 + 16 * s2 + 8 * hh);
    const bf16x8 bd = *(const bf16x8*)(dLb + 16 * s2 + 8 * hh);
    S0 = MFMA32(a.v, bv, S0);
    S1 = MFMA32(a.v, bd, S1);
  }
}
__device__ __forceinline__ void d_mlstm_scan(int chain, int sl, char* smem, const unsigned short* __restrict__ pm,
                                             const float* __restrict__ pre, const float* __restrict__ gtots,
                                             unsigned short* __restrict__ oM, int ntok) {
  unsigned short* kL = (unsigned short*)smem;
  unsigned short* vTL = kL + 2 * 64 * 136;
  unsigned short* vdTL = vTL + 2 * 32 * 72;
  unsigned short* dL = vdTL + 2 * 32 * 72;
  unsigned short* S0T = dL + 256;
  unsigned short* nL = S0T + 32 * 136;
  float* scal = (float*)(nL + 256);
  int tid = threadIdx.x;
  asm volatile("" : "+v"(tid));
  const int lane = tid & 63, w = __builtin_amdgcn_readfirstlane(tid >> 6), r = lane & 31, hh = lane >> 5;
  const int bh = chain >> 1, dir = chain & 1, b = bh >> 2, h = bh & 3;
  f32x16 S0, S1;
#pragma unroll
  for (int i = 0; i < 16; ++i) { S0[i] = 0.f; S1[i] = 0.f; }
  unsigned short* oMb = oM + (size_t)dir * ntok * 512 + h * 128 + sl * 32;
  const size_t tb = (size_t)b * SEQ;
  __syncthreads();
  ml_state_image(S0, S1, S0T, nL, w, r, hh);
  if (w >= 2) {
    const int t128 = tid - 128;
    uint4 pk0, pk1, pk2, pk3, pk4, pk5, pk6, pk7, pv0, pv1;
    float4 pgl;
    float pgt;
    ML_LOAD(tb + (dir ? 63 : 0) * 64);
    ML_STAGE(0);
    ML_LOAD(tb + (dir ? 62 : 1) * 64);
    for (int step = 0; step < 64; ++step) {
      const int c0 = dir ? 63 - step : step;
      const int c2 = dir ? c0 - 2 : c0 + 2;
      const int buf = step & 1;
      __syncthreads();
      const float gtot = scal[buf * 208 + 192];
      ML_STAGE(buf ^ 1);
      {
        const int cl = (step + 2 < 64) ? c2 : c0;
        ML_LOAD(tb + cl * 64);
      }
      ml_state_update(S0, S1, kL + buf * (64 * 136), vdTL + buf * (32 * 72), dL + buf * 72, gtot, w, r, hh);
      __syncthreads();
      ml_state_image(S0, S1, S0T, nL, w, r, hh);
    }
  } else {
    bf16x8 ones;
#pragma unroll
    for (int i = 0; i < 8; ++i) ones[i] = (short)0x3F80;
    const int ti = w;
    const int icol = 32 * ti + r;
    float dmask[16];
#pragma unroll
    for (int reg = 0; reg < 16; ++reg) {
      const int jl = crow(reg, hh);
      dmask[reg] = (dir ? (jl >= r) : (jl <= r)) ? 1.f : 0.f;
    }
    bf16x8 qf[8];
    {
      const unsigned short* qp = pm + (tb + (size_t)(dir ? 63 : 0) * 64 + 32 * ti + r) * 4096 + 2048 + h * 128 + 8 * hh;
#pragma unroll
      for (int s2 = 0; s2 < 8; ++s2) qf[s2] = *(const bf16x8*)(qp + 16 * s2);
    }
    for (int step = 0; step < 64; ++step) {
      const int c0 = dir ? 63 - step : step;
      const int c1 = dir ? c0 - 1 : c0 + 1;
      const int buf = step & 1;
      const unsigned short* kLb = kL + buf * (64 * 136);
      const unsigned short* vTb = vTL + buf * (32 * 72);
      const float* scb = scal + buf * 208;
      __syncthreads();
      const float bci = scb[128 + icol];
      const float gtot = scb[192];
      f32x16 Q0, Q1;
#pragma unroll
      for (int i = 0; i < 16; ++i) { Q0[i] = 0.f; Q1[i] = 0.f; }
#pragma unroll
      for (int s2 = 0; s2 < 8; ++s2) {
        const bf16x8 b0 = *(const bf16x8*)(S0T + r * 136 + 16 * s2 + 8 * hh);
        const bf16x8 b1 = *(const bf16x8*)(nL + 16 * s2 + 8 * hh);
        Q0 = MFMA32(qf[s2], b0, Q0);
        Q1 = MFMA32(qf[s2], b1, Q1);
      }
#pragma unroll
      for (int g = 0; g < 4; ++g) {
        const float4 e4 = *(const float4*)(scb + 32 * ti + 8 * g + 4 * hh);
        Q0[4 * g] *= e4.x; Q0[4 * g + 1] *= e4.y; Q0[4 * g + 2] *= e4.z; Q0[4 * g + 3] *= e4.w;
        Q1[4 * g] *= e4.x; Q1[4 * g + 1] *= e4.y; Q1[4 * g + 2] *= e4.z; Q1[4 * g + 3] *= e4.w;
      }
#pragma unroll
      for (int tj = 0; tj < 2; ++tj) {
        if (dir ? (tj < ti) : (tj > ti)) continue;
        f32x16 X;
#pragma unroll
        for (int i = 0; i < 16; ++i) X[i] = 0.f;
#pragma unroll
        for (int s2 = 0; s2 < 8; ++s2) {
          const bf16x8 a = *(const bf16x8*)(kLb + (32 * tj + r) * 136 + 16 * s2 + 8 * hh);
          X = MFMA32(a, qf[s2], X);
        }
        if (tj == ti) {
#pragma unroll
          for (int g = 0; g < 4; ++g) {
            const float4 cj4 = *(const float4*)(scb + 64 + 32 * tj + 8 * g + 4 * hh);
            X[4 * g + 0] *= __builtin_amdgcn_exp2f(fminf(bci + cj4.x, 80.f)) * dmask[4 * g + 0];
            X[4 * g + 1] *= __builtin_amdgcn_exp2f(fminf(bci + cj4.y, 80.f)) * dmask[4 * g + 1];
            X[4 * g + 2] *= __builtin_amdgcn_exp2f(fminf(bci + cj4.z, 80.f)) * dmask[4 * g + 2];
            X[4 * g + 3] *= __builtin_amdgcn_exp2f(fminf(bci + cj4.w, 80.f)) * dmask[4 * g + 3];
          }
        } else {
#pragma unroll
          for (int g = 0; g < 4; ++g) {
            const float4 cj4 = *(const float4*)(scb + 64 + 32 * tj + 8 * g + 4 * hh);
            X[4 * g + 0] *= __builtin_amdgcn_exp2f(bci + cj4.x);
            X[4 * g + 1] *= __builtin_amdgcn_exp2f(bci + cj4.y);
            X[4 * g + 2] *= __builtin_amdgcn_exp2f(bci + cj4.z);
            X[4 * g + 3] *= __builtin_amdgcn_exp2f(bci + cj4.w);
          }
        }
#pragma unroll
        for (int s2 = 0; s2 < 2; ++s2) {
          union { bf16x8 v; unsigned u[4]; } xa, bv;
          xa.u[0] = pack2(X[8 * s2 + 0], X[8 * s2 + 1]); xa.u[1] = pack2(X[8 * s2 + 2], X[8 * s2 + 3]);
          xa.u[2] = pack2(X[8 * s2 + 4], X[8 * s2 + 5]); xa.u[3] = pack2(X[8 * s2 + 6], X[8 * s2 + 7]);
          const uint2 v0 = *(const uint2*)(vTb + r * 72 + 32 * tj + 16 * s2 + 4 * hh);
          const uint2 v1 = *(const uint2*)(vTb + r * 72 + 32 * tj + 16 * s2 + 8 + 4 * hh);
          bv.u[0] = v0.x; bv.u[1] = v0.y; bv.u[2] = v1.x; bv.u[3] = v1.y;
          Q0 = MFMA32(xa.v, bv.v, Q0);
          Q1 = MFMA32(xa.v, ones, Q1);
        }
      }
      {
        const int cn = (step + 1 < 64) ? c1 : c0;
        const unsigned short* qp = pm + (tb + (size_t)cn * 64 + 32 * ti + r) * 4096 + 2048 + h * 128 + 8 * hh;
#pragma unroll
        for (int s2 = 0; s2 < 8; ++s2) qf[s2] = *(const bf16x8*)(qp + 16 * s2);
      }
      const size_t orow0 = tb + c0 * 64;
#pragma unroll
      for (int reg = 0; reg < 16; ++reg) {
        const int i = 32 * ti + crow(reg, hh);
        oMb[(orow0 + i) * 512 + r] = f2bf(Q0[reg] * __builtin_amdgcn_rcpf(fmaxf(fabsf(Q1[reg]), 1.f)));
      }
      ml_state_update(S0, S1, kLb, vdTL + buf * (32 * 72), dL + buf * 72, gtot, w, r, hh);
      __syncthreads();
      ml_state_image(S0, S1, S0T, nL, w, r, hh);
    }
  }
}

struct MKP {
  const float *x, *norm1_g, *w_in, *conv_w, *a_log, *dt_bias, *gdn_g, *i_bias, *f_bias, *ml_g, *w_out, *norm2_g, *peer_wq,
      *peer_keys, *peer_u, *peer_v, *normf_g;
  float* out;
  unsigned short *pm, *x1b, *woutT, *mt, *xb, *winT, *oM, *yb, *scores, *qkv_dbg, *oA_dbg;
  unsigned *utab, *vtab;
  unsigned short *wqb, *keyb;
  float *uscale, *vscale;
  float *x1, *rs1, *rs2, *gt, *gateb, *dbg, *mlpre, *mlgt;
  unsigned* bar;
  int* idxb;
  GdnBufs G;
};

constexpr int SMEM_BYTES = 74752;
__global__ void __launch_bounds__(256, 2) k_mega(MKP P) {
  __shared__ __attribute__((aligned(16))) char smem_c[SMEM_BYTES + 16];
  {
    volatile LAS unsigned* st0 = (volatile LAS unsigned*)(smem_c + SMEM_BYTES);
    if (threadIdx.x < 4) st0[threadIdx.x] = 0u;
  }
  __syncthreads();
  XcdBarrier xb = xcd_barrier_post(P.bar, (volatile LAS unsigned*)(smem_c + SMEM_BYTES));
  unsigned short* smem = (unsigned short*)smem_c;
  const int nb = gridDim.x, bid = blockIdx.x;
  for (int it = bid; it < NT / 4; it += nb) d_prep_x(it, P.x, P.xb, P.rs1);
  for (int it = bid; it < 16 * 66; it += nb) d_transpose_w(it, 66, (float*)smem_c, P.w_in, DIN, P.norm1_g, P.winT, 1);
  for (int it = bid; it < 16 * 16; it += nb) d_transpose_w(it, 16, (float*)smem_c, P.w_out, 1024, nullptr, P.woutT, 0);
  for (int it = bid; it < 1024; it += nb) d_cvt_bf16(it, P.peer_wq, P.wqb, P.norm2_g, 11);
  for (int it = bid; it < 128; it += nb) d_cvt_bf16(it, P.peer_keys, P.keyb, nullptr, 0);
  if (bid == 0 && threadIdx.x < 4) P.dbg[threadIdx.x] = 0.f;
  xcd_barrier(xb);
  {
    GemmP p{};
    p.A = P.xb; p.lda = DM; p.Bt = P.winT; p.ldb = DM; p.K = DM;
    p.rowscale = P.rs1; p.obf = P.pm; p.ldo = 4096; p.of32 = P.gt; p.ldf = 32; p.resid = nullptr;
    p.a_log = P.a_log; p.dt_bias = P.dt_bias; p.i_bias = P.i_bias; p.f_bias = P.f_bias;
    for (int k = 0;; ++k) {
      int tm, tn;
      if (!xcd_tile(bid, nb, k, 33, tm, tn)) break;
      gemm_tile<EPI_INPROJ>(p, tm, tn, smem);
      __syncthreads();
    }
  }
  for (int tile = bid; tile < 16 * 8; tile += nb) {
    const int hp = tile >> 3, tn = tile & 7;
    GemmP p{};
    p.A = P.keyb + (size_t)hp * 128 * 128; p.lda = 128; p.Bt = P.wqb + hp * 128; p.ldb = 2048; p.K = 128;
    p.obf = P.mt + (size_t)hp * 128 * DM; p.ldo = DM;
    gemm_tile<EPI_PLAIN>(p, 0, tn, smem);
    __syncthreads();
  }
  xcd_barrier(xb);
  for (int it = bid; it < 512; it += nb) d_ml_gates(it, P.gt, P.mlpre, P.mlgt);
  for (int it = bid; it < 1024; it += nb) d_gdn_prep(it, smem_c, P.pm, P.gt, P.conv_w, P.G);
  xcd_barrier(xb);
  if (bid < 128) {
    d_gdn_scan(bid >> 2, bid & 3, smem_c, P.G);
  } else if (bid < 256) {
    d_mlstm_scan((bid - 128) >> 2, (bid - 128) & 3, smem_c, P.pm, P.mlpre, P.mlgt, P.oM, NT);
  }
#ifdef DBG_CHECK
  if (bid < 4) {
    __syncthreads();
    const int half = threadIdx.x >> 7;
    float* sq = (float*)smem + half * 256;
    float* sk = sq + 128;
    d_mlstm_rec(bid * 2 + half, sq, sk, P.pm, P.gt, P.oA_dbg, 4096);
  }
#endif
  xcd_barrier(xb);
  for (int it = bid; it < NT / 4; it += nb) d_combine(it, P.G.uo, P.oM, P.pm, P.gdn_g, P.ml_g, P.yb);
#ifdef DBG_CHECK
  for (int it = bid; it < 4096 / 4; it += nb) d_dbg_cmp_m(it, P.oM, P.oA_dbg, P.dbg);
#endif
  xcd_barrier(xb);
  {
    GemmP p{};
    p.A = P.yb; p.lda = DM; p.Bt = P.woutT; p.ldb = DM; p.K = DM;
    p.rowscale = nullptr; p.obf = P.x1b; p.ldo = DM; p.of32 = P.x1; p.ldf = DM; p.resid = P.x; p.rowacc = P.rs2;
    for (int k = 0;; ++k) {
      int tm, tn;
      if (!xcd_tile(bid, nb, k, 8, tm, tn)) break;
      gemm_tile<EPI_OUTPROJ>(p, tm, tn, smem);
      __syncthreads();
    }
  }
  for (int it = bid; it < 4096; it += nb) { d_cvt_tab_i8(it, P.peer_u, P.utab, P.uscale); d_cvt_tab(it, P.peer_v, P.vtab, P.vscale); }
  xcd_barrier(xb);
  {
    GemmP p{};
    p.A = P.x1b; p.lda = DM; p.Bt = P.mt; p.ldb = DM; p.K = DM;
    p.rowscale = P.rs2; p.obf = P.scores; p.ldo = 2048; p.of32 = nullptr; p.ldf = 0; p.resid = nullptr;
    for (int k = 0;; ++k) {
      int tm, tn;
      if (!xcd_tile(bid, nb, k, 16, tm, tn)) break;
      gemm_tile<EPI_SCORES>(p, tm, tn, smem);
      __syncthreads();
    }
  }
  xcd_barrier(xb);
  float oscale = 1.f;
#ifdef DBG_CHECK
  {
    const float sd = __hip_atomic_load(&P.dbg[0], __ATOMIC_RELAXED, __HIP_MEMORY_SCOPE_AGENT);
    const float sr = __hip_atomic_load(&P.dbg[1], __ATOMIC_RELAXED, __HIP_MEMORY_SCOPE_AGENT);
    oscale = 1.f + sqrtf(sd / sr);
  }
#endif
  for (int it = bid; it < NT / 32; it += nb) {
    d_topk(it, P.scores, P.idxb, P.gateb);
    __threadfence_block();
    __syncthreads();
#pragma unroll 1
    for (int sub = 0; sub < 8; ++sub)
      d_peer(it * 8 + sub, smem_c, P.x1, P.rs2, P.norm2_g, P.idxb, P.gateb, P.utab, P.vtab, P.uscale, P.vscale, P.normf_g, P.out, oscale);
  }
}

extern "C" void kernel_launch(void* const* d_in, const int* in_sizes, int n_in, void* d_out, int out_size, void* d_ws,
                              size_t ws_size, hipStream_t stream) {
  MKP P{};
  P.x = (const float*)d_in[0];
  P.norm1_g = (const float*)d_in[1];
  P.w_in = (const float*)d_in[2];
  P.conv_w = (const float*)d_in[3];
  P.a_log = (const float*)d_in[4];
  P.dt_bias = (const float*)d_in[5];
  P.gdn_g = (const float*)d_in[6];
  P.i_bias = (const float*)d_in[7];
  P.f_bias = (const float*)d_in[8];
  P.ml_g = (const float*)d_in[9];
  P.w_out = (const float*)d_in[10];
  P.norm2_g = (const float*)d_in[11];
  P.peer_wq = (const float*)d_in[12];
  P.peer_keys = (const float*)d_in[13];
  P.peer_u = (const float*)d_in[14];
  P.peer_v = (const float*)d_in[15];
  P.normf_g = (const float*)d_in[16];
  P.out = (float*)d_out;

  char* ws = (char*)d_ws;
  const size_t MB = 1024 * 1024;
  P.pm = (unsigned short*)(ws);
  P.x1 = (float*)(ws);
  P.x1b = (unsigned short*)(ws + 64 * MB);
  P.utab = (unsigned*)(ws + 96 * MB);
  P.vtab = (unsigned*)(ws + 112 * MB);
  P.uscale = (float*)(ws + 136 * MB);
  P.vscale = (float*)(ws + 136 * MB + 65536);
  char* rb = ws + 128 * MB;
  P.woutT = (unsigned short*)(rb);
  P.mt = (unsigned short*)(rb + 2 * MB);
  P.rs1 = (float*)(rb + 6 * MB);
  P.rs2 = (float*)(rb + 7 * MB);
  P.dbg = (float*)(rb + 6 * MB + 131072);
  P.bar = (unsigned*)(rb + 6 * MB + 196608);
  P.gt = (float*)(rb + 9 * MB);
  char* dyn = rb + 11 * MB;
  P.xb = (unsigned short*)(dyn);
  P.winT = (unsigned short*)(dyn + 32 * MB);
  P.wqb = (unsigned short*)(dyn + 41 * MB);
  P.keyb = (unsigned short*)(dyn + 45 * MB);
  P.G.qc = (unsigned short*)(dyn);
  P.G.kTc = (unsigned short*)(dyn + 16 * MB);
  P.G.qkc = (unsigned short*)(dyn + 32 * MB);
  P.G.wn = (unsigned short*)(dyn + 48 * MB);
  P.G.uo = (unsigned short*)(dyn + 80 * MB);
  P.G.gsc = (float*)(dyn + 112 * MB);
  P.mlpre = (float*)(dyn + 114 * MB);
  P.mlgt = (float*)(dyn + 116 * MB);
  P.yb = (unsigned short*)(dyn);
  P.scores = (unsigned short*)(dyn);
  P.idxb = (int*)(dyn + 64 * MB);
  P.gateb = (float*)(dyn + 72 * MB);
  char* os = (char*)d_out;
  P.oM = (unsigned short*)(os);
  P.qkv_dbg = (unsigned short*)(os + 32 * MB);
  P.oA_dbg = (unsigned short*)(os + 44 * MB);

  static int grid_blocks = 0;
  if (!grid_blocks) {
    int dev = 0, cus = 0, per_cu = 0;
    (void)hipGetDevice(&dev);
    (void)hipDeviceGetAttribute(&cus, hipDeviceAttributeMultiprocessorCount, dev);
    (void)hipOccupancyMaxActiveBlocksPerMultiprocessor(&per_cu, k_mega, 256, 0);
    if (per_cu > 2) per_cu = 2;
    if (per_cu < 1) per_cu = 1;
    grid_blocks = cus * per_cu;
  }
  (void)hipMemsetAsync(P.bar, 0, XCD_BAR_WORDS * sizeof(unsigned), stream);
  hipLaunchKernelGGL(k_mega, dim3(grid_blocks), dim3(256), 0, stream, P);
}
```

```cpp
#include <hip/hip_runtime.h>
#include <hip/hip_bf16.h>
#include <stdint.h>
#include <cstdio>
#define TIDX ((int)(threadIdx.x & 255))
#define HB ((int)(threadIdx.x >> 8))

#define XB_TMO      128
#define XB_XCNT(j)  (256  + 64 * (j))
#define XB_XSUB(j)  (1280 + 64 * (j))
#define XB_XGEN(j)  (2304 + 64 * (j))
#define XB_TOP      3328
#define XB_TOPGEN   3392
#define XCD_BAR_WORDS 3456
#define XB_SPIN_CAP (1u << 18)
#define LAS __attribute__((address_space(3)))

__device__ __forceinline__ unsigned xb_ld(unsigned* p)              { return __hip_atomic_load(p, __ATOMIC_RELAXED, __HIP_MEMORY_SCOPE_AGENT); }
__device__ __forceinline__ unsigned xb_add(unsigned* p, unsigned v) { return __hip_atomic_fetch_add(p, v, __ATOMIC_RELAXED, __HIP_MEMORY_SCOPE_AGENT); }
__device__ __forceinline__ unsigned xb_xcc_id() { return (unsigned)__builtin_amdgcn_s_getreg((3 << 11) | 20) & 0xFu; }
#define XB_SPIN(cond, bar) do { unsigned _sp = 0; while (cond) { __builtin_amdgcn_s_sleep(1); \
    if ((++_sp & 255u) == 0u) { if (xb_ld(&(bar)[XB_TMO])) break; if (_sp > XB_SPIN_CAP) { atomicAdd(&(bar)[XB_TMO], 1u); break; } } } } while (0)

struct XcdBarrier {
    unsigned* bar; unsigned x;
    volatile LAS unsigned* st;
};

__device__ __forceinline__ XcdBarrier xcd_barrier_post(unsigned* bar, volatile LAS unsigned* st) {
    XcdBarrier b; b.bar = bar; b.x = xb_xcc_id(); b.st = st;
    if (threadIdx.x == 0) (void)xb_add(&bar[XB_XCNT(b.x)], 1u);
    return b;
}
__device__ __forceinline__ void xcd_barrier_complete(unsigned* bar, unsigned x, unsigned& nloc, unsigned& nx) {
    const unsigned G = gridDim.x * gridDim.y * gridDim.z;
    unsigned sum, cnt, mine, sp = 0u;
    for (;;) {
        sum = 0u; cnt = 0u; mine = 0u;
#pragma unroll
        for (unsigned j = 0; j < 16; ++j) { const unsigned c = xb_ld(&bar[XB_XCNT(j)]); sum += c; cnt += (c > 0u) ? 1u : 0u; mine = (j == x) ? c : mine; }
        if (sum == G) break;
        __builtin_amdgcn_s_sleep(1);
        if ((++sp & 255u) == 0u) { if (xb_ld(&bar[XB_TMO])) break; if (sp > XB_SPIN_CAP) { atomicAdd(&bar[XB_TMO], 1u); break; } }
    }
    nloc = mine > 0u ? mine : 1u; nx = cnt > 0u ? cnt : 1u;
}

__device__ __forceinline__ void xcd_barrier(const XcdBarrier& b) {
    asm volatile("s_waitcnt vmcnt(0)" ::: "memory");
    __syncthreads();
    if (threadIdx.x == 0) {
        unsigned* bar = b.bar;
        __builtin_amdgcn_s_waitcnt(0);
        unsigned nloc = b.st[0], nx = b.st[1];
        if (nloc == 0u) { xcd_barrier_complete(bar, b.x, nloc, nx); b.st[0] = nloc; b.st[1] = nx; }
        const unsigned old = xb_add(&bar[XB_XSUB(b.x)], 1u);
        const unsigned gen = old / nloc;
        if (old + 1u == (gen + 1u) * nloc) {
            __builtin_amdgcn_fence(__ATOMIC_RELEASE, "agent");
            asm volatile("s_waitcnt vmcnt(0)" ::: "memory");
            const unsigned og = xb_add(&bar[XB_TOP], 1u);
            const unsigned tg = og / nx;
            if (og + 1u == (tg + 1u) * nx) xb_add(&bar[XB_TOPGEN], 1u);
            else XB_SPIN(xb_ld(&bar[XB_TOPGEN]) == tg, bar);
            __builtin_amdgcn_fence(__ATOMIC_ACQUIRE, "agent");
            xb_add(&bar[XB_XGEN(b.x)], 1u);
            asm volatile("s_waitcnt vmcnt(0)" ::: "memory");
        } else {
            XB_SPIN(xb_ld(&bar[XB_XGEN(b.x)]) == gen, bar);
            __builtin_amdgcn_fence(__ATOMIC_ACQUIRE, "agent");
            asm volatile("s_waitcnt vmcnt(0)" ::: "memory");
        }
    }
    __syncthreads();
}


typedef __hip_bfloat16 bf16;
typedef __attribute__((ext_vector_type(8))) short bf16x8;
typedef __attribute__((ext_vector_type(4))) float f32x4;

constexpr int DM = 1024;
constexpr int NB = 4;
constexpr int SEQ = 4096;
constexpr int NT = NB * SEQ;
constexpr int DIN = 4128;
constexpr int NPAD_IN = 4224;
constexpr float EPSF = 1e-6f;

__device__ __forceinline__ float bf2f(unsigned short u) { return __uint_as_float(((unsigned)u) << 16); }
typedef __bf16 bf16x2_t __attribute__((ext_vector_type(2)));
typedef float f32x2_t __attribute__((ext_vector_type(2)));
__device__ __forceinline__ unsigned short f2bf(float f) { return __builtin_bit_cast(unsigned short, (__bf16)f); }
__device__ __forceinline__ unsigned pack2(float a, float b) {
  f32x2_t v = {a, b};
  return __builtin_bit_cast(unsigned, __builtin_convertvector(v, bf16x2_t));
}
__device__ __forceinline__ float wave_sum(float v) {
#pragma unroll
  for (int o = 32; o > 0; o >>= 1) v += __shfl_xor(v, o, 64);
  return v;
}
#define DPP_ADD(v, ctrl) v += __builtin_bit_cast(float, __builtin_amdgcn_update_dpp(0, __builtin_bit_cast(int, v), ctrl, 0xF, 0xF, true))
__device__ __forceinline__ float wave_sum_dpp(float v) {
  DPP_ADD(v, 0xB1);
  DPP_ADD(v, 0x4E);
  DPP_ADD(v, 0x141);
  DPP_ADD(v, 0x140);
  const float r0 = __builtin_bit_cast(float, __builtin_amdgcn_readlane(__builtin_bit_cast(int, v), 0));
  const float r1 = __builtin_bit_cast(float, __builtin_amdgcn_readlane(__builtin_bit_cast(int, v), 16));
  const float r2 = __builtin_bit_cast(float, __builtin_amdgcn_readlane(__builtin_bit_cast(int, v), 32));
  const float r3 = __builtin_bit_cast(float, __builtin_amdgcn_readlane(__builtin_bit_cast(int, v), 48));
  return (r0 + r1) + (r2 + r3);
}
__device__ __forceinline__ float softplusf(float x) { return fmaxf(x, 0.f) + log1pf(expf(-fabsf(x))); }
__device__ __forceinline__ float sigmoidf(float x) { return __builtin_amdgcn_rcpf(1.f + __builtin_amdgcn_exp2f(-1.4426950408889634f * x)); }

__device__ __forceinline__ void d_prep_x(int item, const float* __restrict__ x, unsigned short* __restrict__ xb,
                                                float* __restrict__ rs) {
  int t = item * 4 + (TIDX >> 6);
  int lane = TIDX & 63;
  const float4* xr = (const float4*)(x + (size_t)t * DM);
  float ss = 0.f;
#pragma unroll
  for (int i = 0; i < 4; ++i) {
    float4 v = xr[lane + 64 * i];
    ss += v.x * v.x + v.y * v.y + v.z * v.z + v.w * v.w;
    ushort4 o;
    o.x = f2bf(v.x); o.y = f2bf(v.y); o.z = f2bf(v.z); o.w = f2bf(v.w);
    ((ushort4*)(xb + (size_t)t * DM))[lane + 64 * i] = o;
  }
  ss = wave_sum(ss);
  if (lane == 0) rs[t] = rsqrtf(ss * (1.f / DM) + EPSF);
}

__device__ __forceinline__ int win_src(int n) {
  if (n < 2048) return n;
  if (n < 4096) return n + 16;
  int j = n - 4096;
  if (j < 16) return 2048 + j;
  if (j < 32) return 4112 + (j - 16);
  return -1;
}
__device__ __forceinline__ void d_transpose_w(int item, int ntn, float* tile, const float* __restrict__ in, int ldn,
                                              const float* __restrict__ g, unsigned short* __restrict__ out, int mode) {
  const int kt = item / ntn, nt = item % ntn;
  const int tid = TIDX;
  __syncthreads();
#pragma unroll
  for (int i = 0; i < 4; ++i) {
    const int row = (tid >> 4) + 16 * i;
    const int c4 = (tid & 15) * 4;
    const int n = nt * 64 + c4;
    const int src = mode ? win_src(n) : n;
    float4 v = make_float4(0.f, 0.f, 0.f, 0.f);
    if (src >= 0) {
      v = *(const float4*)(in + (size_t)(kt * 64 + row) * ldn + src);
      if (g) { const float gg = g[kt * 64 + row]; v.x *= gg; v.y *= gg; v.z *= gg; v.w *= gg; }
    }
    tile[row * 65 + c4] = v.x; tile[row * 65 + c4 + 1] = v.y; tile[row * 65 + c4 + 2] = v.z; tile[row * 65 + c4 + 3] = v.w;
  }
  __syncthreads();
  {
    const int n = tid >> 2, k16 = (tid & 3) * 16;
    uint4 o0, o1;
    o0.x = pack2(tile[(k16 + 0) * 65 + n], tile[(k16 + 1) * 65 + n]);   o0.y = pack2(tile[(k16 + 2) * 65 + n], tile[(k16 + 3) * 65 + n]);
    o0.z = pack2(tile[(k16 + 4) * 65 + n], tile[(k16 + 5) * 65 + n]);   o0.w = pack2(tile[(k16 + 6) * 65 + n], tile[(k16 + 7) * 65 + n]);
    o1.x = pack2(tile[(k16 + 8) * 65 + n], tile[(k16 + 9) * 65 + n]);   o1.y = pack2(tile[(k16 + 10) * 65 + n], tile[(k16 + 11) * 65 + n]);
    o1.z = pack2(tile[(k16 + 12) * 65 + n], tile[(k16 + 13) * 65 + n]); o1.w = pack2(tile[(k16 + 14) * 65 + n], tile[(k16 + 15) * 65 + n]);
    unsigned short* op = out + (size_t)(nt * 64 + n) * DM + kt * 64 + k16;
    *(uint4*)op = o0;
    *(uint4*)(op + 8) = o1;
  }
}
__device__ __forceinline__ void d_cvt_bf16(int item, const float* __restrict__ src, unsigned short* __restrict__ dst,
                                           const float* __restrict__ rowscale, int rowlen_log2) {
  const size_t base = (size_t)item * 2048 + TIDX * 8;
  float4 a = *(const float4*)(src + base);
  float4 b = *(const float4*)(src + base + 4);
  if (rowscale) {
    const float sc = rowscale[base >> rowlen_log2];
    a.x *= sc; a.y *= sc; a.z *= sc; a.w *= sc; b.x *= sc; b.y *= sc; b.z *= sc; b.w *= sc;
  }
  uint4 o;
  o.x = pack2(a.x, a.y); o.y = pack2(a.z, a.w); o.z = pack2(b.x, b.y); o.w = pack2(b.z, b.w);
  *(uint4*)(dst + base) = o;
}

constexpr int GBM = 128, GBN = 128, GBK = 64, GLD = 64;
struct GemmP {
  const unsigned short* A; const unsigned short* Bt; int lda, ldb, K;
  const float* rowscale;
  unsigned short* obf; int ldo;
  float* of32; int ldf;
  const float* resid;
  const float *a_log, *dt_bias, *i_bias, *f_bias;
  float* rowacc;
};
enum { EPI_INPROJ = 0, EPI_OUTPROJ = 1, EPI_SCORES = 2, EPI_PLAIN = 3 };

template <int EPI>
__device__ __forceinline__ void gemm_tile(const GemmP p, int tm, int tn, unsigned short* smem) {
  unsigned short* As = smem;
  unsigned short* Bs = smem + 2 * GBM * GLD;
  int tid = TIDX;
  asm volatile("" : "+v"(tid));
  const int lane = tid & 63, wid = tid >> 6;
  const int wm = wid >> 1, wn = wid & 1;
  const int m0 = tm * GBM, n0 = tn * GBN;
  f32x4 acc[4][4];
#pragma unroll
  for (int i = 0; i < 4; ++i)
#pragma unroll
    for (int j = 0; j < 4; ++j) acc[i][j] = (f32x4){0.f, 0.f, 0.f, 0.f};

  uint4 ra0, ra1, ra2, ra3, rb0, rb1, rb2, rb3;
  uint4 sa0, sa1, sa2, sa3, sb0, sb1, sb2, sb3;
  const int nk = p.K / GBK;
  const int lrow = tid >> 3, lc8 = tid & 7;
  const unsigned short* Ag = p.A + (size_t)(m0 + lrow) * p.lda + lc8 * 8;
  const unsigned short* Bg = p.Bt + (size_t)(n0 + lrow) * p.ldb + lc8 * 8;
  const size_t a32 = (size_t)32 * p.lda, b32 = (size_t)32 * p.ldb;
#define GLOAD(R, S, kt)                                                  \
  {                                                                      \
    R##0 = *(const uint4*)(Ag + (kt) * GBK);                             \
    R##1 = *(const uint4*)(Ag + a32 + (kt) * GBK);                       \
    R##2 = *(const uint4*)(Ag + 2 * a32 + (kt) * GBK);                   \
    R##3 = *(const uint4*)(Ag + 3 * a32 + (kt) * GBK);                   \
    S##0 = *(const uint4*)(Bg + (kt) * GBK);                             \
    S##1 = *(const uint4*)(Bg + b32 + (kt) * GBK);                       \
    S##2 = *(const uint4*)(Bg + 2 * b32 + (kt) * GBK);                   \
    S##3 = *(const uint4*)(Bg + 3 * b32 + (kt) * GBK);                   \
  }
#define SSTORE(R, S, buf)                                                \
  {                                                                      \
    unsigned short* ad = As + (size_t)(buf) * GBM * GLD + lrow * GLD + ((lc8 ^ (lrow & 7)) * 8); \
    unsigned short* bd = Bs + (size_t)(buf) * GBN * GLD + lrow * GLD + ((lc8 ^ (lrow & 7)) * 8); \
    *(uint4*)(ad) = R##0; *(uint4*)(ad + 32 * GLD) = R##1; *(uint4*)(ad + 64 * GLD) = R##2; *(uint4*)(ad + 96 * GLD) = R##3; \
    *(uint4*)(bd) = S##0; *(uint4*)(bd + 32 * GLD) = S##1; *(uint4*)(bd + 64 * GLD) = S##2; *(uint4*)(bd + 96 * GLD) = S##3; \
  }
#define GCOMPUTE(buf)                                                                                                     \
  {                                                                                                                       \
    const unsigned short* Ab = As + (size_t)(buf) * GBM * GLD;                                                            \
    const unsigned short* Bb = Bs + (size_t)(buf) * GBN * GLD;                                                            \
    _Pragma("unroll") for (int ks = 0; ks < 2; ++ks) {                                                                    \
      bf16x8 a[4], b[4];                                                                                                  \
      const int kc = ((ks * 4 + (lane >> 4)) ^ (lane & 7)) * 8;                   \
      _Pragma("unroll") for (int i = 0; i < 4; ++i) a[i] = *(const bf16x8*)(Ab + (wm * 64 + i * 16 + (lane & 15)) * GLD + kc); \
      _Pragma("unroll") for (int j = 0; j < 4; ++j) b[j] = *(const bf16x8*)(Bb + (wn * 64 + j * 16 + (lane & 15)) * GLD + kc); \
      _Pragma("unroll") for (int i = 0; i < 4; ++i)                                                                       \
        _Pragma("unroll") for (int j = 0; j < 4; ++j)                                                                     \
          acc[i][j] = __builtin_amdgcn_mfma_f32_16x16x32_bf16(b[j], a[i], acc[i][j], 0, 0, 0);               \
    }                                                                                                                     \
  }
  GLOAD(ra, rb, 0);
  if (nk > 1) GLOAD(sa, sb, 1);
  SSTORE(ra, rb, 0);
  __syncthreads();
  for (int kt = 0; kt < nk; kt += 2) {
    if (kt + 2 < nk) GLOAD(ra, rb, kt + 2);
    GCOMPUTE(0);
    if (kt + 1 < nk) SSTORE(sa, sb, 1);
    __syncthreads();
    if (kt + 1 < nk) {
      if (kt + 3 < nk) GLOAD(sa, sb, kt + 3);
      GCOMPUTE(1);
      if (kt + 2 < nk) SSTORE(ra, rb, 0);
      __syncthreads();
    }
  }
#undef GLOAD
#undef SSTORE
#undef GCOMPUTE
#pragma unroll
  for (int i = 0; i < 4; ++i) {
    const int row = m0 + wm * 64 + i * 16 + (lane & 15);
    float rsc = 1.f;
    float rowss = 0.f;
    if (EPI == EPI_INPROJ) rsc = p.rowscale[row];
    if (EPI == EPI_SCORES) {
      const float4* pr = (const float4*)(p.rowscale + (size_t)row * 16);
      const float4 s0 = pr[0], s1 = pr[1], s2 = pr[2], s3 = pr[3];
      const float ssq = ((s0.x + s0.y) + (s0.z + s0.w)) + ((s1.x + s1.y) + (s1.z + s1.w)) + ((s2.x + s2.y) + (s2.z + s2.w)) + ((s3.x + s3.y) + (s3.z + s3.w));
      rsc = rsqrtf(ssq * (1.f / DM) + EPSF);
    }
#pragma unroll
    for (int j = 0; j < 4; ++j) {
      const int col0 = n0 + wn * 64 + j * 16 + (lane >> 4) * 4;
      const float v0 = acc[i][j][0] * rsc, v1 = acc[i][j][1] * rsc, v2 = acc[i][j][2] * rsc, v3 = acc[i][j][3] * rsc;
      if (EPI == EPI_INPROJ) {
        if (col0 < 4096) {
          uint2 pk; pk.x = pack2(v0, v1); pk.y = pack2(v2, v3);
          *(uint2*)(p.obf + (size_t)row * p.ldo + col0) = pk;
        } else if (col0 < 4128) {
          const float vv[4] = {v0, v1, v2, v3};
          float oo[4];
#pragma unroll
          for (int r = 0; r < 4; ++r) {
            const int jg = col0 - 4096 + r, jj = jg & 7;
            const float v = vv[r];
            float o;
            if (jg < 8) o = -expf(p.a_log[jj]) * softplusf(v + p.dt_bias[jj]);
            else if (jg < 16) o = sigmoidf(v);
            else if (jg < 24) o = v + p.i_bias[jj];
            else o = -softplusf(-(v + p.f_bias[jj]));
            oo[r] = o;
          }
          *(float4*)(p.of32 + (size_t)row * p.ldf + (col0 - 4096)) = make_float4(oo[0], oo[1], oo[2], oo[3]);
        }
      } else if (EPI == EPI_OUTPROJ) {
        const float4 xr = *(const float4*)(p.resid + (size_t)row * p.ldf + col0);
        const float x0 = v0 + xr.x, x1 = v1 + xr.y, x2 = v2 + xr.z, x3 = v3 + xr.w;
        *(float4*)(p.of32 + (size_t)row * p.ldf + col0) = make_float4(x0, x1, x2, x3);
        uint2 pk; pk.x = pack2(x0, x1); pk.y = pack2(x2, x3);
        *(uint2*)(p.obf + (size_t)row * p.ldo + col0) = pk;
        rowss += (x0 * x0 + x1 * x1) + (x2 * x2 + x3 * x3);
      } else {
        uint2 pk; pk.x = pack2(v0, v1); pk.y = pack2(v2, v3);
        *(uint2*)(p.obf + (size_t)row * p.ldo + col0) = pk;
      }
    }
    if (EPI == EPI_OUTPROJ) {
      rowss += __shfl_xor(rowss, 16, 64);
      rowss += __shfl_xor(rowss, 32, 64);
      if ((lane >> 4) == 0) p.rowacc[(size_t)row * 16 + tn * 2 + wn] = rowss;
    }
  }
}

__device__ __forceinline__ bool xcd_tile(int bid, int nb, int k, int ntn, int& tm, int& tn) {
  const int q = ((bid >> 3) * 2 + HB) + (nb >> 3) * 2 * k;
  const bool ok = q < 16 * ntn;
  const int qq = ok ? q : (16 * ntn - 1);
  const int g = qq / (8 * ntn), rem = qq % (8 * ntn);
  tn = rem >> 3;
  tm = 16 * (bid & 7) + 8 * g + (rem & 7);
  return ok;
}

__device__ __forceinline__ int g8_lds_byte(int r, int c) {
  const int st = (r >> 4) * 2 + (c >> 5), rr = r & 15, cc = c & 31, ob = rr * 64 + cc * 2;
  return st * 1024 + (ob ^ (((ob >> 9) & 1) << 5));
}
__device__ __forceinline__ void g8_stage_rc(int b, int& R, int& C) {
  const int st = b / 1024, sb = b % 1024, swz = sb ^ (((sb >> 9) & 1) << 5);
  R = (st >> 1) * 16 + swz / 64; C = (st & 1) * 32 + (swz % 64) / 2;
}
template <int EPI>
__device__ __forceinline__ void gemm256_tile(const GemmP p, int tm, int tn, char* shm_c) {
  constexpr int BK = 64, HALF = 128, HT = HALF * BK;
  const int K = p.K;
  int tidx = threadIdx.x;
  asm volatile("" : "+v"(tidx));
  unsigned short* shm = (unsigned short*)shm_c;
  const unsigned short* A = p.A;
  const unsigned short* Bt = p.Bt;
#define SA(b, h) (shm + ((b) * 2 + (h)) * HT)
#define SB(b, h) (shm + (4 + (b) * 2 + (h)) * HT)
#define STAGE(P_, BASE, br, kt) do { const long _g = (long)(br) * K + (long)(kt) * BK; \
    for (int _i = 0; _i < 2; ++_i) { const int _b = tidx * 16 + _i * 8192; int _r, _c; g8_stage_rc(_b, _r, _c); \
      __builtin_amdgcn_global_load_lds((const unsigned*)(BASE + _g + (long)_r * K + _c), \
        (__attribute__((address_space(3))) unsigned*)((char*)(P_) + _b), 16, 0, 0); } } while (0)
#define LDA(dst, b, h) for (int m = 0; m < 4; ++m) for (int k = 0; k < 2; ++k) \
    dst[m][k] = *reinterpret_cast<const bf16x8*>((char*)SA(b, h) + g8_lds_byte(wr * 64 + m * 16 + fr, k * 32 + fq * 8))
#define LDB(dst, b, h) for (int n = 0; n < 2; ++n) for (int k = 0; k < 2; ++k) \
    dst[n][k] = *reinterpret_cast<const bf16x8*>((char*)SB(b, h) + g8_lds_byte(wc * 32 + n * 16 + fr, k * 32 + fq * 8))
#define MMA(ai, bj, At_, Bt_) do { __builtin_amdgcn_s_setprio(1); \
    for (int m = 0; m < 4; ++m) for (int n = 0; n < 2; ++n) for (int k = 0; k < 2; ++k) \
      acc[ai][bj][m][n] = __builtin_amdgcn_mfma_f32_16x16x32_bf16(Bt_[n][k], At_[m][k], acc[ai][bj][m][n], 0, 0, 0); \
    __builtin_amdgcn_s_setprio(0); } while (0)
#define WAIT_V(n) asm volatile("s_waitcnt vmcnt(" #n ")" ::: "memory")
#define WAIT_L(n) asm volatile("s_waitcnt lgkmcnt(" #n ")" ::: "memory")
#define BAR __builtin_amdgcn_s_barrier()
#define SCHED __builtin_amdgcn_sched_barrier(0)
  const int brow = tm * 256, bcol = tn * 256;
  const int wid = __builtin_amdgcn_readfirstlane(tidx >> 6), lane = tidx & 63, wr = wid >> 2, wc = wid & 3, fr = lane & 15, fq = lane >> 4;
  f32x4 acc[2][2][4][2] = {};
  bf16x8 At[4][2], B0[2][2], B1[2][2];
  const int nt = K / BK;
  STAGE(SB(0, 0), Bt, bcol, 0); STAGE(SA(0, 0), A, brow, 0);
  STAGE(SB(0, 1), Bt, bcol + HALF, 0); STAGE(SA(0, 1), A, brow + HALF, 0);
  if (wr == 1) BAR;
  WAIT_V(4); BAR;
  STAGE(SB(1, 0), Bt, bcol, 1); STAGE(SA(1, 0), A, brow, 1); STAGE(SB(1, 1), Bt, bcol + HALF, 1);
  WAIT_V(6); BAR;
#pragma unroll 1
  for (int t = 0; t < nt - 2; t += 2) {
    LDB(B0, 0, 0); SCHED; LDA(At, 0, 0); STAGE(SA(1, 1), A, brow + HALF, t + 1);
    WAIT_L(8); BAR; WAIT_L(0); MMA(0, 0, At, B0); BAR; SCHED;
    LDB(B1, 0, 1); STAGE(SB(0, 0), Bt, bcol, t + 2);
    BAR; WAIT_L(0); MMA(0, 1, At, B1); BAR;
    LDA(At, 0, 1); STAGE(SA(0, 0), A, brow, t + 2);
    BAR; WAIT_L(0); MMA(1, 0, At, B0); BAR; SCHED;
    STAGE(SB(0, 1), Bt, bcol + HALF, t + 2);
    WAIT_V(6); BAR; MMA(1, 1, At, B1); BAR;
    LDB(B0, 1, 0); SCHED; LDA(At, 1, 0); STAGE(SA(0, 1), A, brow + HALF, t + 2);
    WAIT_L(8); BAR; WAIT_L(0); MMA(0, 0, At, B0); BAR; SCHED;
    LDB(B1, 1, 1); STAGE(SB(1, 0), Bt, bcol, t + 3);
    BAR; WAIT_L(0); MMA(0, 1, At, B1); BAR;
    LDA(At, 1, 1); STAGE(SA(1, 0), A, brow, t + 3);
    BAR; WAIT_L(0); MMA(1, 0, At, B0); BAR; SCHED;
    STAGE(SB(1, 1), Bt, bcol + HALF, t + 3);
    WAIT_V(6); BAR; MMA(1, 1, At, B1); BAR;
  }
  { LDB(B0, 0, 0); LDA(At, 0, 0); STAGE(SA(1, 1), A, brow + HALF, nt - 1);
    BAR; WAIT_L(0); MMA(0, 0, At, B0); BAR;
    LDB(B1, 0, 1); BAR; WAIT_L(0); MMA(0, 1, At, B1); BAR;
    LDA(At, 0, 1); WAIT_V(4); BAR; WAIT_L(0); MMA(1, 0, At, B0); MMA(1, 1, At, B1); BAR; }
  { LDB(B0, 1, 0); LDA(At, 1, 0); WAIT_V(2); BAR; WAIT_L(0); MMA(0, 0, At, B0); BAR;
    LDB(B1, 1, 1); WAIT_V(0); BAR; WAIT_L(0); MMA(0, 1, At, B1); BAR;
    LDA(At, 1, 1); BAR; WAIT_L(0); MMA(1, 0, At, B0); MMA(1, 1, At, B1); BAR; }
  if (wr == 0) BAR;
#undef SA
#undef SB
#undef STAGE
#undef LDA
#undef LDB
#undef MMA
#undef WAIT_V
#undef WAIT_L
#undef BAR
#undef SCHED
#pragma unroll
  for (int ai = 0; ai < 2; ++ai)
#pragma unroll
    for (int m = 0; m < 4; ++m) {
      const int row = brow + ai * 128 + wr * 64 + m * 16 + fr;
      float rsc = 1.f;
      float rowss = 0.f;
      if (EPI == EPI_INPROJ) rsc = p.rowscale[row];
      if (EPI == EPI_SCORES) {
        const float4* pr = (const float4*)(p.rowscale + (size_t)row * 16);
        const float4 s0 = pr[0], s1 = pr[1], s2 = pr[2], s3 = pr[3];
        const float ssq = ((s0.x + s0.y) + (s0.z + s0.w)) + ((s1.x + s1.y) + (s1.z + s1.w)) + ((s2.x + s2.y) + (s2.z + s2.w)) + ((s3.x + s3.y) + (s3.z + s3.w));
        rsc = rsqrtf(ssq * (1.f / DM) + EPSF);
      }
#pragma unroll
      for (int bj = 0; bj < 2; ++bj)
#pragma unroll
        for (int n = 0; n < 2; ++n) {
          const int col0 = bcol + bj * 128 + wc * 32 + n * 16 + fq * 4;
          const f32x4 a = acc[ai][bj][m][n];
          const float v0 = a[0] * rsc, v1 = a[1] * rsc, v2 = a[2] * rsc, v3 = a[3] * rsc;
          if (EPI == EPI_OUTPROJ) {
            const float4 xr = *(const float4*)(p.resid + (size_t)row * p.ldf + col0);
            const float x0 = v0 + xr.x, x1 = v1 + xr.y, x2 = v2 + xr.z, x3 = v3 + xr.w;
            *(float4*)(p.of32 + (size_t)row * p.ldf + col0) = make_float4(x0, x1, x2, x3);
            uint2 pk; pk.x = pack2(x0, x1); pk.y = pack2(x2, x3);
            *(uint2*)(p.obf + (size_t)row * p.ldo + col0) = pk;
            rowss += (x0 * x0 + x1 * x1) + (x2 * x2 + x3 * x3);
          } else {
            uint2 pk; pk.x = pack2(v0, v1); pk.y = pack2(v2, v3);
            *(uint2*)(p.obf + (size_t)row * p.ldo + col0) = pk;
          }
        }
      if (EPI == EPI_OUTPROJ) {
        rowss += __shfl_xor(rowss, 16, 64);
        rowss += __shfl_xor(rowss, 32, 64);
        if (fq == 0) p.rowacc[(size_t)row * 16 + tn * 4 + wc] = rowss;
      }
    }
}
__device__ __forceinline__ void d_gate_proj(int item, const unsigned short* __restrict__ xb, const unsigned short* __restrict__ winT,
                                            const float* __restrict__ rs1, const float* __restrict__ a_log,
                                            const float* __restrict__ dt_bias, const float* __restrict__ i_bias,
                                            const float* __restrict__ f_bias, float* __restrict__ gt) {
  const int job = item * 8 + (threadIdx.x >> 6);
  const int lane = threadIdx.x & 63, fr = lane & 15, fq = lane >> 4;
  const int t0 = job * 16;
  const unsigned short* ap = xb + (size_t)(t0 + fr) * DM + 8 * fq;
  const unsigned short* bp0 = winT + (size_t)(4096 + fr) * DM + 8 * fq;
  const unsigned short* bp1 = winT + (size_t)(4096 + 16 + fr) * DM + 8 * fq;
  f32x4 acc0 = {0.f, 0.f, 0.f, 0.f}, acc1 = {0.f, 0.f, 0.f, 0.f};
#pragma unroll 8
  for (int s2 = 0; s2 < 32; ++s2) {
    const bf16x8 a = *(const bf16x8*)(ap + 32 * s2);
    const bf16x8 b0 = *(const bf16x8*)(bp0 + 32 * s2);
    const bf16x8 b1 = *(const bf16x8*)(bp1 + 32 * s2);
    acc0 = __builtin_amdgcn_mfma_f32_16x16x32_bf16(a, b0, acc0, 0, 0, 0);
    acc1 = __builtin_amdgcn_mfma_f32_16x16x32_bf16(a, b1, acc1, 0, 0, 0);
  }
  const int jj = fr & 7;
  const float al = -expf(a_log[jj]), db = dt_bias[jj], ib = i_bias[jj], fb = f_bias[jj];
#pragma unroll
  for (int j = 0; j < 4; ++j) {
    const int t = t0 + 4 * fq + j;
    const float r = rs1[t];
    const float v0 = acc0[j] * r, v1 = acc1[j] * r;
    const float o0 = (fr < 8) ? al * softplusf(v0 + db) : sigmoidf(v0);
    const float o1 = (fr < 8) ? (v1 + ib) : -softplusf(-(v1 + fb));
    gt[(size_t)t * 32 + fr] = o0;
    gt[(size_t)t * 32 + 16 + fr] = o1;
  }
}

__device__ __forceinline__ bool xcd_tile256(int bid, int nb, int k, int ntn, int& tm, int& tn) {
  const int q = (bid >> 3) + (nb >> 3) * k;
  if (q >= 8 * ntn) return false;
  tn = q >> 3;
  tm = 8 * (bid & 7) + (q & 7);
  return true;
}

__device__ __forceinline__ void d_conv(int item, const unsigned short* __restrict__ pm, const float* __restrict__ pg,
                                              const float* __restrict__ conv_w, const float* __restrict__ a_log,
                                              const float* __restrict__ dt_bias, const float* __restrict__ i_bias,
                                              const float* __restrict__ f_bias, unsigned short* __restrict__ qkv,
                                              float* __restrict__ gt) {
  int t = item * 4 + (TIDX >> 6);
  int lane = TIDX & 63;
  int s = t & (SEQ - 1);
  for (int sec = 0; sec < 3; ++sec) {
    for (int h = 0; h < 4; ++h) {
      int c0 = sec * 512 + h * 128 + 2 * lane;
      float a0 = 0.f, a1 = 0.f;
#pragma unroll
      for (int j = 0; j < 5; ++j) {
        int sp = s + j - 2;
        if (sp >= 0 && sp < SEQ) {
          unsigned v = *(const unsigned*)(pm + (size_t)(t + j - 2) * 4096 + c0);
          a0 += conv_w[c0 * 5 + j] * bf2f((unsigned short)(v & 0xffff));
          a1 += conv_w[(c0 + 1) * 5 + j] * bf2f((unsigned short)(v >> 16));
        }
      }
      a0 = a0 * sigmoidf(a0);
      a1 = a1 * sigmoidf(a1);
      if (sec < 2) {
        float ss = wave_sum(a0 * a0 + a1 * a1);
        float sc = rsqrtf(ss + EPSF);
        if (sec == 0) sc *= 0.08838834764831845f;
        a0 *= sc; a1 *= sc;
      }
      unsigned o = pack2(a0, a1);
      *(unsigned*)(qkv + (size_t)t * 1536 + c0) = o;
    }
  }
}

__device__ __forceinline__ void d_gdn_rec(int chain, float* sq, float* sk, const unsigned short* __restrict__ qkv,
                                                 const float* __restrict__ gt, unsigned short* __restrict__ oA, int ntok) {
  const int bh = chain >> 1, dir = chain & 1;
  const int b = bh >> 2, h = bh & 3;
  const int e = TIDX & 127;
  float S[128];
#pragma unroll
  for (int d = 0; d < 128; ++d) S[d] = 0.f;
  for (int it = 0; it < SEQ; ++it) {
    const int s = dir ? (SEQ - 1 - it) : it;
    const size_t t = (size_t)b * SEQ + s;
    __syncthreads();
    sq[e] = bf2f(qkv[t * 1536 + h * 128 + e]);
    sk[e] = bf2f(qkv[t * 1536 + 512 + h * 128 + e]);
    const float v = bf2f(qkv[t * 1536 + 1024 + h * 128 + e]);
    const float g = gt[t * 32 + dir * 4 + h];
    const float beta = gt[t * 32 + 8 + dir * 4 + h];
    __syncthreads();
    const float a = expf(g);
    float k0 = 0.f, k1 = 0.f, k2 = 0.f, k3 = 0.f;
#pragma unroll
    for (int d = 0; d < 128; d += 4) {
      k0 += sk[d] * S[d]; k1 += sk[d + 1] * S[d + 1]; k2 += sk[d + 2] * S[d + 2]; k3 += sk[d + 3] * S[d + 3];
    }
    const float kS = a * ((k0 + k1) + (k2 + k3));
    const float vn = beta * (v - kS);
    float o0 = 0.f, o1 = 0.f, o2 = 0.f, o3 = 0.f;
#pragma unroll
    for (int d = 0; d < 128; d += 4) {
      S[d] = a * S[d] + sk[d] * vn;             o0 += sq[d] * S[d];
      S[d + 1] = a * S[d + 1] + sk[d + 1] * vn; o1 += sq[d + 1] * S[d + 1];
      S[d + 2] = a * S[d + 2] + sk[d + 2] * vn; o2 += sq[d + 2] * S[d + 2];
      S[d + 3] = a * S[d + 3] + sk[d + 3] * vn; o3 += sq[d + 3] * S[d + 3];
    }
    oA[((size_t)dir * ntok + t) * 512 + h * 128 + e] = f2bf((o0 + o1) + (o2 + o3));
  }
}

__device__ __forceinline__ void d_mlstm_rec(int chain, float* sq, float* sk, const unsigned short* __restrict__ pm,
                                                   const float* __restrict__ gt, unsigned short* __restrict__ oM, int ntok) {
  const int bh = chain >> 1, dir = chain & 1;
  const int b = bh >> 2, h = bh & 3;
  const int e = TIDX & 127, lane = e & 63;
  float C[128];
#pragma unroll
  for (int d = 0; d < 128; ++d) C[d] = 0.f;
  float n0 = 0.f, n1 = 0.f, m = 0.f;
  for (int it = 0; it < SEQ; ++it) {
    const int s = dir ? (SEQ - 1 - it) : it;
    const size_t t = (size_t)b * SEQ + s;
    __syncthreads();
    sq[e] = bf2f(pm[t * 4096 + 2048 + h * 128 + e]);
    sk[e] = bf2f(pm[t * 4096 + 2560 + h * 128 + e]) * 0.08838834764831845f;
    const float v = bf2f(pm[t * 4096 + 3072 + h * 128 + e]);
    const float ip = gt[t * 32 + 16 + dir * 4 + h];
    const float lf = gt[t * 32 + 24 + dir * 4 + h];
    __syncthreads();
    const float mn = fmaxf(lf + m, ip);
    const float fs = expf(lf + m - mn);
    const float is = expf(ip - mn);
    m = mn;
    n0 = fs * n0 + is * sk[lane];
    n1 = fs * n1 + is * sk[lane + 64];
    const float den = wave_sum(n0 * sq[lane] + n1 * sq[lane + 64]);
    const float iv = is * v;
    float o0 = 0.f, o1 = 0.f, o2 = 0.f, o3 = 0.f;
#pragma unroll
    for (int d = 0; d < 128; d += 4) {
      C[d] = fs * C[d] + sk[d] * iv;             o0 += sq[d] * C[d];
      C[d + 1] = fs * C[d + 1] + sk[d + 1] * iv; o1 += sq[d + 1] * C[d + 1];
      C[d + 2] = fs * C[d + 2] + sk[d + 2] * iv; o2 += sq[d + 2] * C[d + 2];
      C[d + 3] = fs * C[d + 3] + sk[d + 3] * iv; o3 += sq[d + 3] * C[d + 3];
    }
    const float num = (o0 + o1) + (o2 + o3);
    const float hh = num / fmaxf(fabsf(den), expf(-mn));
    oM[((size_t)dir * ntok + t) * 512 + h * 128 + e] = f2bf(hh);
  }
}

__device__ __forceinline__ void d_combine(int item, const unsigned short* __restrict__ uo, const unsigned short* __restrict__ oM,
                                                 const unsigned short* __restrict__ pm, const float* __restrict__ gdn_g,
                                                 const float* __restrict__ ml_g, unsigned short* __restrict__ y) {
  int tid_ = TIDX;
  asm volatile("" : "+v"(tid_));
  const int t = item * 4 + (tid_ >> 6);
  const int lane = tid_ & 63;
  const int b = t >> 12, cc = (t >> 6) & 63, ii = t & 63;
  unsigned gf_[4], gb_[4], mf_[4], mb_[4], zg_[4], zo_[4];
  const size_t off = (size_t)cc * 8192 + (lane >> 4) * 2048 + ii * 32 + ((2 * lane) & 31);
#pragma unroll
  for (int h = 0; h < 4; ++h) {
    const int c = h * 128 + 2 * lane;
    const int chain0 = (b * 4 + h) * 2;
    gf_[h] = *(const unsigned*)(uo + (size_t)chain0 * 64 * 8192 + off);
    gb_[h] = *(const unsigned*)(uo + (size_t)(chain0 + 1) * 64 * 8192 + off);
    mf_[h] = *(const unsigned*)(oM + (size_t)t * 512 + c);
    mb_[h] = *(const unsigned*)(oM + ((size_t)NT + t) * 512 + c);
    zg_[h] = *(const unsigned*)(pm + (size_t)t * 4096 + 1536 + c);
    zo_[h] = *(const unsigned*)(pm + (size_t)t * 4096 + 3584 + c);
  }
  const float gg0 = gdn_g[2 * lane], gg1 = gdn_g[2 * lane + 1];
  float a0[4], a1[4], m0[4], m1[4], sa[4], sm[4];
#pragma unroll
  for (int h = 0; h < 4; ++h) {
    a0[h] = bf2f(gf_[h] & 0xffff) + bf2f(gb_[h] & 0xffff);
    a1[h] = __uint_as_float(gf_[h] & 0xffff0000u) + __uint_as_float(gb_[h] & 0xffff0000u);
    m0[h] = bf2f(mf_[h] & 0xffff) + bf2f(mb_[h] & 0xffff);
    m1[h] = __uint_as_float(mf_[h] & 0xffff0000u) + __uint_as_float(mb_[h] & 0xffff0000u);
    sa[h] = a0[h] * a0[h] + a1[h] * a1[h];
    sm[h] = m0[h] * m0[h] + m1[h] * m1[h];
  }
#pragma unroll
  for (int o = 32; o > 0; o >>= 1) {
#pragma unroll
    for (int h = 0; h < 4; ++h) { sa[h] += __shfl_xor(sa[h], o, 64); sm[h] += __shfl_xor(sm[h], o, 64); }
  }
#pragma unroll
  for (int h = 0; h < 4; ++h) {
    const int c = h * 128 + 2 * lane;
    const float sca = rsqrtf(sa[h] * (1.f / 128.f) + EPSF);
    const float scm = rsqrtf(sm[h] * (1.f / 128.f) + EPSF);
    const float z0 = bf2f(zg_[h] & 0xffff), z1 = __uint_as_float(zg_[h] & 0xffff0000u);
    const float q0 = bf2f(zo_[h] & 0xffff), q1 = __uint_as_float(zo_[h] & 0xffff0000u);
    const float o0 = a0[h] * sca * gg0 * (z0 * sigmoidf(z0));
    const float o1 = a1[h] * sca * gg1 * (z1 * sigmoidf(z1));
    const float p0 = m0[h] * scm * ml_g[c] * sigmoidf(q0);
    const float p1 = m1[h] * scm * ml_g[c + 1] * sigmoidf(q1);
    *(unsigned*)(y + (size_t)t * DM + c) = pack2(o0, o1);
    *(unsigned*)(y + (size_t)t * DM + 512 + c) = pack2(p0, p1);
  }
}

#ifdef DBG_CHECK
__device__ __forceinline__ void d_dbg_cmp(int item, const unsigned short* __restrict__ uo, const unsigned short* __restrict__ oAd,
                                          float* __restrict__ dbg) {
  int t = item * 4 + (TIDX >> 6);
  int lane = TIDX & 63;
  const int cc = (t >> 6) & 63, ii = t & 63;
  float sd = 0.f, sr = 0.f;
  for (int h = 0; h < 4; ++h) {
    for (int dir = 0; dir < 2; ++dir) {
      const int chain = h * 2 + dir;
      const size_t off = (size_t)cc * 8192 + (lane >> 4) * 2048 + ii * 32 + ((2 * lane) & 31);
      unsigned vn = *(const unsigned*)(uo + (size_t)chain * 64 * 8192 + off);
      unsigned vr = *(const unsigned*)(oAd + ((size_t)dir * 4096 + t) * 512 + h * 128 + 2 * lane);
      float n0 = bf2f(vn & 0xffff), n1 = bf2f(vn >> 16), r0 = bf2f(vr & 0xffff), r1 = bf2f(vr >> 16);
      sd += (n0 - r0) * (n0 - r0) + (n1 - r1) * (n1 - r1);
      sr += r0 * r0 + r1 * r1;
    }
  }
  sd = wave_sum(sd); sr = wave_sum(sr);
  if (lane == 0) { atomicAdd(&dbg[0], sd); atomicAdd(&dbg[1], sr); }
}
__device__ __forceinline__ void d_dbg_cmp_m(int item, const unsigned short* __restrict__ oM, const unsigned short* __restrict__ oMd,
                                            float* __restrict__ dbg) {
  int t = item * 4 + (TIDX >> 6);
  int lane = TIDX & 63;
  float sd = 0.f, sr = 0.f;
  for (int dir = 0; dir < 2; ++dir)
    for (int q = 0; q < 4; ++q) {
      unsigned vn = *(const unsigned*)(oM + ((size_t)dir * NT + t) * 512 + q * 128 + 2 * lane);
      unsigned vr = *(const unsigned*)(oMd + ((size_t)dir * 4096 + t) * 512 + q * 128 + 2 * lane);
      float n0 = bf2f(vn & 0xffff), n1 = bf2f(vn >> 16), r0 = bf2f(vr & 0xffff), r1 = bf2f(vr >> 16);
      sd += (n0 - r0) * (n0 - r0) + (n1 - r1) * (n1 - r1);
      sr += r0 * r0 + r1 * r1;
    }
  sd = wave_sum(sd); sr = wave_sum(sr);
  if (lane == 0) { atomicAdd(&dbg[0], sd); atomicAdd(&dbg[1], sr); }
}
#endif

__device__ __forceinline__ void d_prep_x1(int item, const float* __restrict__ x1, unsigned short* __restrict__ xb,
                                                 float* __restrict__ rs) {
  int t = item * 4 + (TIDX >> 6);
  int lane = TIDX & 63;
  const float4* xr = (const float4*)(x1 + (size_t)t * DM);
  float ss = 0.f;
#pragma unroll
  for (int i = 0; i < 4; ++i) {
    float4 v = xr[lane + 64 * i];
    ss += v.x * v.x + v.y * v.y + v.z * v.z + v.w * v.w;
    ushort4 o;
    o.x = f2bf(v.x); o.y = f2bf(v.y); o.z = f2bf(v.z); o.w = f2bf(v.w);
    ((ushort4*)(xb + (size_t)t * DM))[lane + 64 * i] = o;
  }
  ss = wave_sum(ss);
  if (lane == 0) rs[t] = rsqrtf(ss * (1.f / DM) + EPSF);
}

__device__ const unsigned char kPairTab[64] = {
    0x00, 0x01, 0x02, 0x03, 0x04, 0x05, 0x06, 0x07, 0x08, 0x09, 0x0a, 0x0b, 0x0c, 0x0d, 0x0e, 0x0f,
    0x10, 0x11, 0x12, 0x13, 0x14, 0x15, 0x16, 0x17,
    0x20, 0x21, 0x22, 0x23, 0x24,
    0x30, 0x31, 0x32, 0x33,
    0x40, 0x41, 0x42,
    0x50, 0x51, 0x60, 0x61, 0x70, 0x71,
    0x80, 0x90, 0xa0, 0xb0, 0xc0, 0xd0, 0xe0, 0xf0,
    0xff, 0xff, 0xff, 0xff, 0xff, 0xff, 0xff, 0xff, 0xff, 0xff, 0xff, 0xff, 0xff, 0xff};

__device__ __forceinline__ void sort16_desc(unsigned (&a)[16]) {
#pragma unroll
  for (int k = 2; k <= 16; k <<= 1)
#pragma unroll
    for (int j = k >> 1; j > 0; j >>= 1)
#pragma unroll
      for (int i = 0; i < 16; ++i) {
        const int l = i ^ j;
        if (l > i) {
          const unsigned hi = max(a[i], a[l]), lo = min(a[i], a[l]);
          if ((i & k) == 0) { a[i] = hi; a[l] = lo; } else { a[i] = lo; a[l] = hi; }
        }
      }
}
__device__ __forceinline__ void merge16_desc(unsigned (&top)[16], const unsigned (&b)[16]) {
#pragma unroll
  for (int i = 0; i < 16; ++i) top[i] = max(top[i], b[15 - i]);
#pragma unroll
  for (int j = 8; j > 0; j >>= 1)
#pragma unroll
    for (int i = 0; i < 16; ++i) {
      const int l = i ^ j;
      if (l > i) {
        const unsigned hi = max(top[i], top[l]), lo = min(top[i], top[l]);
        top[i] = hi; top[l] = lo;
      }
    }
}
__device__ __forceinline__ unsigned key16(unsigned hbits, int idx) {
  const unsigned m = hbits ^ ((hbits & 0x8000u) ? 0xFFFFu : 0x8000u);
  return (m << 16) | (unsigned)(127 - idx);
}
__device__ __forceinline__ void top16_of_128(const unsigned short* __restrict__ sp, unsigned (&top)[16]) {
#pragma unroll
  for (int g = 0; g < 8; ++g) {
    const uint4 x0 = *(const uint4*)(sp + g * 16);
    const uint4 x1 = *(const uint4*)(sp + g * 16 + 8);
    unsigned b[16];
    b[0] = key16(x0.x & 0xffff, g * 16 + 0);  b[1] = key16(x0.x >> 16, g * 16 + 1);
    b[2] = key16(x0.y & 0xffff, g * 16 + 2);  b[3] = key16(x0.y >> 16, g * 16 + 3);
    b[4] = key16(x0.z & 0xffff, g * 16 + 4);  b[5] = key16(x0.z >> 16, g * 16 + 5);
    b[6] = key16(x0.w & 0xffff, g * 16 + 6);  b[7] = key16(x0.w >> 16, g * 16 + 7);
    b[8] = key16(x1.x & 0xffff, g * 16 + 8);  b[9] = key16(x1.x >> 16, g * 16 + 9);
    b[10] = key16(x1.y & 0xffff, g * 16 + 10); b[11] = key16(x1.y >> 16, g * 16 + 11);
    b[12] = key16(x1.z & 0xffff, g * 16 + 12); b[13] = key16(x1.z >> 16, g * 16 + 13);
    b[14] = key16(x1.w & 0xffff, g * 16 + 14); b[15] = key16(x1.w >> 16, g * 16 + 15);
    sort16_desc(b);
    if (g == 0) {
#pragma unroll
      for (int i = 0; i < 16; ++i) top[i] = b[i];
    } else {
      merge16_desc(top, b);
    }
  }
}

__device__ __forceinline__ void d_topk(int item, const unsigned short* __restrict__ scores, int* __restrict__ idx_out,
                                       float* __restrict__ gate_out) {
  int tid_ = TIDX;
  asm volatile("" : "+v"(tid_));
  const int pair = item * 256 + tid_;
  const unsigned short* sp = scores + (size_t)pair * 256;
  unsigned k0[16], k1[16];
  top16_of_128(sp, k0);
  top16_of_128(sp + 128, k1);
  float v0[16], v1[16];
  int i0[16], i1[16];
#pragma unroll
  for (int i = 0; i < 16; ++i) {
    const unsigned m0 = k0[i] >> 16, m1 = k1[i] >> 16;
    v0[i] = bf2f((unsigned short)(m0 ^ ((m0 & 0x8000u) ? 0x8000u : 0xFFFFu)));
    v1[i] = bf2f((unsigned short)(m1 ^ ((m1 & 0x8000u) ? 0x8000u : 0xFFFFu)));
    i0[i] = 127 - (int)(k0[i] & 127u);
    i1[i] = 127 - (int)(k1[i] & 127u);
  }
  unsigned top[16];
#pragma unroll
  for (int g = 0; g < 4; ++g) {
    unsigned b[16];
#pragma unroll
    for (int q = 0; q < 16; ++q) {
      const int pr = kPairTab[g * 16 + q];
      if (pr == 0xff) {
        b[q] = 0u;
      } else {
        const int pi = pr >> 4, pj = pr & 15;
        const float sum = v0[pi] + v1[pj];
        const unsigned u = __float_as_uint(sum);
        const unsigned mono = u ^ ((u & 0x80000000u) ? 0xFFFFFFFFu : 0x80000000u);
        b[q] = (mono & 0xFFFFC000u) | (unsigned)(16383 - (i0[pi] * 128 + i1[pj]));
      }
    }
    sort16_desc(b);
    if (g == 0) {
#pragma unroll
      for (int i = 0; i < 16; ++i) top[i] = b[i];
    } else {
      merge16_desc(top, b);
    }
  }
  float ev[16];
  int ci[16];
  float mx = 0.f, sum = 0.f;
#pragma unroll
  for (int i = 0; i < 16; ++i) {
    const unsigned mono = top[i] & 0xFFFFC000u;
    const unsigned u = mono ^ ((mono & 0x80000000u) ? 0x80000000u : 0xFFFFFFFFu);
    const float val = __uint_as_float(u & 0xFFFFC000u);
    ci[i] = 16383 - (int)(top[i] & 16383u);
    if (i == 0) mx = val;
    ev[i] = expf(val - mx);
    sum += ev[i];
  }
  const float inv = 1.f / sum;
#pragma unroll
  for (int q = 0; q < 4; ++q) {
    int4 o; float4 g;
    o.x = ci[4 * q]; o.y = ci[4 * q + 1]; o.z = ci[4 * q + 2]; o.w = ci[4 * q + 3];
    g.x = ev[4 * q] * inv; g.y = ev[4 * q + 1] * inv; g.z = ev[4 * q + 2] * inv; g.w = ev[4 * q + 3] * inv;
    *(int4*)(idx_out + (size_t)pair * 16 + 4 * q) = o;
    *(float4*)(gate_out + (size_t)pair * 16 + 4 * q) = g;
  }
}

typedef float f32x2 __attribute__((ext_vector_type(2)));
__device__ __forceinline__ float wave_max_dpp(float v) {
#define DPP_MAX(v, ctrl) v = fmaxf(v, __builtin_bit_cast(float, __builtin_amdgcn_update_dpp(0, __builtin_bit_cast(int, v), ctrl, 0xF, 0xF, true)))
  DPP_MAX(v, 0xB1); DPP_MAX(v, 0x4E); DPP_MAX(v, 0x141); DPP_MAX(v, 0x140);
#undef DPP_MAX
  const float r0 = __builtin_bit_cast(float, __builtin_amdgcn_readlane(__builtin_bit_cast(int, v), 0));
  const float r1 = __builtin_bit_cast(float, __builtin_amdgcn_readlane(__builtin_bit_cast(int, v), 16));
  const float r2 = __builtin_bit_cast(float, __builtin_amdgcn_readlane(__builtin_bit_cast(int, v), 32));
  const float r3 = __builtin_bit_cast(float, __builtin_amdgcn_readlane(__builtin_bit_cast(int, v), 48));
  return fmaxf(fmaxf(r0, r1), fmaxf(r2, r3));
}
__device__ __forceinline__ float absmax4(const float4 a) { return fmaxf(fmaxf(fabsf(a.x), fabsf(a.y)), fmaxf(fabsf(a.z), fabsf(a.w))); }
template <bool I8>
__device__ __forceinline__ void d_cvt_tab(int item, const float* __restrict__ src, unsigned* __restrict__ dst8, float* __restrict__ dscale) {
  const int row0 = item * 16 + (TIDX >> 6) * 4;
  const int lane = TIDX & 63;
  float4 a[4][4];
#pragma unroll
  for (int rr = 0; rr < 4; ++rr) {
    const float4* sr = (const float4*)(src + (size_t)(row0 + rr) * DM + lane * 16);
    a[rr][0] = sr[0]; a[rr][1] = sr[1]; a[rr][2] = sr[2]; a[rr][3] = sr[3];
  }
#pragma unroll
  for (int rr = 0; rr < 4; ++rr) {
    const float m = wave_max_dpp(fmaxf(fmaxf(absmax4(a[rr][0]), absmax4(a[rr][1])), fmaxf(absmax4(a[rr][2]), absmax4(a[rr][3]))));
    const float top = I8 ? 127.f : 240.f;
    const float sc = (m > 0.f) ? top / m : 1.f;
    uint4 o;
    unsigned ow[4];
#pragma unroll
    for (int c = 0; c < 4; ++c) {
      const float4 v = a[rr][c];
      if (I8) {
        ow[c] = ((unsigned)__float2int_rn(v.x * sc) & 0xffu) | (((unsigned)__float2int_rn(v.y * sc) & 0xffu) << 8) |
                (((unsigned)__float2int_rn(v.z * sc) & 0xffu) << 16) | (((unsigned)__float2int_rn(v.w * sc) & 0xffu) << 24);
      } else {
        int p = 0;
        p = __builtin_amdgcn_cvt_pk_fp8_f32(v.x * sc, v.y * sc, p, false);
        p = __builtin_amdgcn_cvt_pk_fp8_f32(v.z * sc, v.w * sc, p, true);
        ow[c] = (unsigned)p;
      }
    }
    o.x = ow[0]; o.y = ow[1]; o.z = ow[2]; o.w = ow[3];
    *(uint4*)(dst8 + (size_t)(row0 + rr) * 256 + lane * 4) = o;
    if (lane == 0) dscale[row0 + rr] = (m > 0.f) ? m / top : 1.f;
  }
}

__device__ __forceinline__ float erf_fast(float x) {
  const float ax = fabsf(x);
  const float t = __builtin_amdgcn_rcpf(1.f + 0.3275911f * ax);
  float p = 1.061405429f;
  p = p * t - 1.453152027f;
  p = p * t + 1.421413741f;
  p = p * t - 0.284496736f;
  p = p * t + 0.254829592f;
  const float e = __builtin_amdgcn_exp2f(-1.4426950408889634f * ax * ax);
  const float r = 1.f - p * t * e;
  return copysignf(r, x);
}
__device__ __forceinline__ float dot16_f8(const uint4 u, const float* hv) {
  const f32x2 a0 = __builtin_amdgcn_cvt_pk_f32_fp8((int)u.x, false), a1 = __builtin_amdgcn_cvt_pk_f32_fp8((int)u.x, true);
  const f32x2 b0 = __builtin_amdgcn_cvt_pk_f32_fp8((int)u.y, false), b1 = __builtin_amdgcn_cvt_pk_f32_fp8((int)u.y, true);
  const f32x2 c0 = __builtin_amdgcn_cvt_pk_f32_fp8((int)u.z, false), c1 = __builtin_amdgcn_cvt_pk_f32_fp8((int)u.z, true);
  const f32x2 d0 = __builtin_amdgcn_cvt_pk_f32_fp8((int)u.w, false), d1 = __builtin_amdgcn_cvt_pk_f32_fp8((int)u.w, true);
  float s0 = a0[0] * hv[0] + a0[1] * hv[1];
  float s1 = a1[0] * hv[2] + a1[1] * hv[3];
  s0 += b0[0] * hv[4] + b0[1] * hv[5];
  s1 += b1[0] * hv[6] + b1[1] * hv[7];
  s0 += c0[0] * hv[8] + c0[1] * hv[9];
  s1 += c1[0] * hv[10] + c1[1] * hv[11];
  s0 += d0[0] * hv[12] + d0[1] * hv[13];
  s1 += d1[0] * hv[14] + d1[1] * hv[15];
  return s0 + s1;
}
__device__ __forceinline__ void axpy16_f8(const uint4 v, const float wg, float* acc) {
  const f32x2 a0 = __builtin_amdgcn_cvt_pk_f32_fp8((int)v.x, false), a1 = __builtin_amdgcn_cvt_pk_f32_fp8((int)v.x, true);
  const f32x2 b0 = __builtin_amdgcn_cvt_pk_f32_fp8((int)v.y, false), b1 = __builtin_amdgcn_cvt_pk_f32_fp8((int)v.y, true);
  const f32x2 c0 = __builtin_amdgcn_cvt_pk_f32_fp8((int)v.z, false), c1 = __builtin_amdgcn_cvt_pk_f32_fp8((int)v.z, true);
  const f32x2 d0 = __builtin_amdgcn_cvt_pk_f32_fp8((int)v.w, false), d1 = __builtin_amdgcn_cvt_pk_f32_fp8((int)v.w, true);
  acc[0] += wg * a0[0]; acc[1] += wg * a0[1]; acc[2] += wg * a1[0]; acc[3] += wg * a1[1];
  acc[4] += wg * b0[0]; acc[5] += wg * b0[1]; acc[6] += wg * b1[0]; acc[7] += wg * b1[1];
  acc[8] += wg * c0[0]; acc[9] += wg * c0[1]; acc[10] += wg * c1[0]; acc[11] += wg * c1[1];
  acc[12] += wg * d0[0]; acc[13] += wg * d0[1]; acc[14] += wg * d1[0]; acc[15] += wg * d1[1];
}
typedef int i32x4 __attribute__((ext_vector_type(4)));
__device__ __forceinline__ void d_peer(int item, char* smem, const float* __restrict__ x1, const float* __restrict__ rs2,
                                       const float* __restrict__ g2, const int* __restrict__ idx,
                                       const float* __restrict__ gate, const unsigned* __restrict__ pu,
                                       const unsigned* __restrict__ pv, const float* __restrict__ su,
                                       const float* __restrict__ sv, const float* __restrict__ gf,
                                       float* __restrict__ out, float oscale) {
  int tid_ = TIDX;
  asm volatile("" : "+v"(tid_));
  const int wv = tid_ >> 6;
  const int t = item * 4 + wv;
  const int lane = tid_ & 63, q = lane >> 4;
  char* hq = smem + wv * 1024;
  float r2;
  {
    const float4* pr = (const float4*)(rs2 + (size_t)t * 16);
    const float4 s0 = pr[0], s1 = pr[1], s2 = pr[2], s3 = pr[3];
    const float ssq = ((s0.x + s0.y) + (s0.z + s0.w)) + ((s1.x + s1.y) + (s1.z + s1.w)) + ((s2.x + s2.y) + (s2.z + s2.w)) + ((s3.x + s3.y) + (s3.z + s3.w));
    r2 = rsqrtf(ssq * (1.f / DM) + EPSF);
  }
  float sh;
  {
    float hv[16];
    float m = 0.f;
#pragma unroll
    for (int c = 0; c < 4; ++c) {
      const float4 xx = *(const float4*)(x1 + (size_t)t * DM + lane * 16 + c * 4);
      const float4 gg = *(const float4*)(g2 + lane * 16 + c * 4);
      hv[c * 4 + 0] = xx.x * r2 * gg.x; hv[c * 4 + 1] = xx.y * r2 * gg.y;
      hv[c * 4 + 2] = xx.z * r2 * gg.z; hv[c * 4 + 3] = xx.w * r2 * gg.w;
      m = fmaxf(m, fmaxf(fmaxf(fabsf(hv[c * 4]), fabsf(hv[c * 4 + 1])), fmaxf(fabsf(hv[c * 4 + 2]), fabsf(hv[c * 4 + 3]))));
    }
#pragma unroll
    for (int o = 32; o > 0; o >>= 1) m = fmaxf(m, __shfl_xor(m, o, 64));
    const float sc = (m > 0.f) ? 127.f / m : 1.f;
    sh = (m > 0.f) ? m * (1.f / 127.f) : 1.f;
#define Q8(x) ((unsigned)(__float2int_rn((x) * sc)) & 0xffu)
    uint4 o;
    o.x = Q8(hv[0]) | (Q8(hv[1]) << 8) | (Q8(hv[2]) << 16) | (Q8(hv[3]) << 24);
    o.y = Q8(hv[4]) | (Q8(hv[5]) << 8) | (Q8(hv[6]) << 16) | (Q8(hv[7]) << 24);
    o.z = Q8(hv[8]) | (Q8(hv[9]) << 8) | (Q8(hv[10]) << 16) | (Q8(hv[11]) << 24);
    o.w = Q8(hv[12]) | (Q8(hv[13]) << 8) | (Q8(hv[14]) << 16) | (Q8(hv[15]) << 24);
#undef Q8
    *(uint4*)(hq + lane * 16) = o;
  }
  float acc[16];
#pragma unroll
  for (int i = 0; i < 16; ++i) acc[i] = 0.f;
  float* wl = (float*)(smem + 4096) + wv * 128;
  int ka = (idx[(size_t)t * 128 + lane] << 7) | lane;
  int kb = (idx[(size_t)t * 128 + 64 + lane] << 7) | (64 + lane);
  const float gt_a0 = gate[(size_t)t * 128 + lane], gt_b0 = gate[(size_t)t * 128 + 64 + lane];
#pragma unroll
  for (int k = 2; k <= 128; k <<= 1) {
#pragma unroll
    for (int j = k >> 1; j > 0; j >>= 1) {
      if (j == 64) {
        const int lo = min(ka, kb), hi = max(ka, kb);
        ka = lo; kb = hi;
      } else {
        const int oa = __shfl_xor(ka, j, 64), ob = __shfl_xor(kb, j, 64);
        const bool lower = (lane & j) == 0;
        const bool upa = (lane & k) == 0;
        const bool upb = ((lane + 64) & k) == 0;
        ka = (upa == lower) ? min(ka, oa) : max(ka, oa);
        kb = (upb == lower) ? min(kb, ob) : max(kb, ob);
      }
    }
  }
  const int id_a = ka >> 7, id_b = kb >> 7;
  const int oa_ = ka & 127, ob_ = kb & 127;
  const float ga1 = __shfl(gt_a0, oa_ & 63, 64), ga2 = __shfl(gt_b0, oa_ & 63, 64);
  const float gb1 = __shfl(gt_a0, ob_ & 63, 64), gb2 = __shfl(gt_b0, ob_ & 63, 64);
  const float gt_a = (oa_ < 64) ? ga1 : ga2, gt_b = (ob_ < 64) ? gb1 : gb2;
#define PEER_ULOAD(UA, G)                                                                                   \
  {                                                                                                         \
    const int srcl_ = (16 * (G) + (lane & 15)) & 63;                                                        \
    const int idr_ = ((G) < 4) ? __shfl(id_a, srcl_, 64) : __shfl(id_b, srcl_, 64);                         \
    const char* ub_ = (const char*)pu + (size_t)idr_ * 1024 + 16 * q;                                       \
    _Pragma("unroll") for (int s2 = 0; s2 < 16; ++s2) UA[s2] = *(const i32x4*)(ub_ + 64 * s2);              \
  }
#define PEER_UCOMP(UA, G)                                                                                   \
  {                                                                                                         \
    int ide[4]; float gte[4], sue[4], sve[4];                                                               \
    _Pragma("unroll") for (int reg = 0; reg < 4; ++reg) {                                                   \
      const int el = (16 * (G) + 4 * q + reg) & 63;                                                         \
      ide[reg] = ((G) < 4) ? __shfl(id_a, el, 64) : __shfl(id_b, el, 64);                                   \
      gte[reg] = ((G) < 4) ? __shfl(gt_a, el, 64) : __shfl(gt_b, el, 64);                                   \
      sue[reg] = su[ide[reg]];                                                                              \
      sve[reg] = sv[ide[reg]];                                                                              \
    }                                                                                                       \
    i32x4 d4 = {0, 0, 0, 0};                                                                                \
    _Pragma("unroll") for (int s2 = 0; s2 < 16; ++s2) {                                                     \
      const i32x4 bfr = *(const i32x4*)(hq + 64 * s2 + 16 * q);                                             \
      d4 = __builtin_amdgcn_mfma_i32_16x16x64_i8(UA[s2], bfr, d4, 0, 0, 0);                                 \
    }                                                                                                       \
    float4 w4;                                                                                              \
    const float d0 = (float)d4[0] * (sue[0] * sh), d1 = (float)d4[1] * (sue[1] * sh);                       \
    const float d2 = (float)d4[2] * (sue[2] * sh), d3 = (float)d4[3] * (sue[3] * sh);                       \
    w4.x = gte[0] * sve[0] * 0.5f * d0 * (1.f + erf_fast(d0 * 0.7071067811865476f));                        \
    w4.y = gte[1] * sve[1] * 0.5f * d1 * (1.f + erf_fast(d1 * 0.7071067811865476f));                        \
    w4.z = gte[2] * sve[2] * 0.5f * d2 * (1.f + erf_fast(d2 * 0.7071067811865476f));                        \
    w4.w = gte[3] * sve[3] * 0.5f * d3 * (1.f + erf_fast(d3 * 0.7071067811865476f));                        \
    if ((lane & 15) == 0) *(float4*)(wl + 16 * (G) + 4 * q) = w4;                                           \
  }
  {
    i32x4 uA[16], uB[16];
    PEER_ULOAD(uA, 0);
    for (int g = 0; g < 8; g += 2) {
      PEER_ULOAD(uB, g + 1);
      PEER_UCOMP(uA, g);
      if (g + 2 < 8) PEER_ULOAD(uA, g + 2);
      PEER_UCOMP(uB, g + 1);
    }
  }
#undef PEER_ULOAD
#undef PEER_UCOMP
  for (int e0 = 0; e0 < 128; e0 += 16) {
    uint4 v[16];
#pragma unroll
    for (int k = 0; k < 16; ++k) {
      const int e = (e0 + k) & 63;
      const int id = (e0 < 64) ? __builtin_amdgcn_readlane(id_a, e) : __builtin_amdgcn_readlane(id_b, e);
      v[k] = *(const uint4*)(pv + (size_t)id * 256 + lane * 4);
    }
    const float4 w0 = *(const float4*)(wl + e0), w1 = *(const float4*)(wl + e0 + 4);
    const float4 w2 = *(const float4*)(wl + e0 + 8), w3 = *(const float4*)(wl + e0 + 12);
    axpy16_f8(v[0], w0.x, acc); axpy16_f8(v[1], w0.y, acc); axpy16_f8(v[2], w0.z, acc); axpy16_f8(v[3], w0.w, acc);
    axpy16_f8(v[4], w1.x, acc); axpy16_f8(v[5], w1.y, acc); axpy16_f8(v[6], w1.z, acc); axpy16_f8(v[7], w1.w, acc);
    axpy16_f8(v[8], w2.x, acc); axpy16_f8(v[9], w2.y, acc); axpy16_f8(v[10], w2.z, acc); axpy16_f8(v[11], w2.w, acc);
    axpy16_f8(v[12], w3.x, acc); axpy16_f8(v[13], w3.y, acc); axpy16_f8(v[14], w3.z, acc); axpy16_f8(v[15], w3.w, acc);
  }
  float ss = 0.f;
#pragma unroll
  for (int c = 0; c < 4; ++c) {
    const float4 xx = *(const float4*)(x1 + (size_t)t * DM + lane * 16 + c * 4);
    acc[c * 4 + 0] += xx.x; acc[c * 4 + 1] += xx.y; acc[c * 4 + 2] += xx.z; acc[c * 4 + 3] += xx.w;
  }
#pragma unroll
  for (int i = 0; i < 16; ++i) ss += acc[i] * acc[i];
  ss = wave_sum(ss);
  const float sc = rsqrtf(ss * (1.f / DM) + EPSF) * oscale;
#pragma unroll
  for (int q4 = 0; q4 < 4; ++q4) {
    const float4 gg = *(const float4*)(gf + lane * 16 + q4 * 4);
    float4 o;
    o.x = acc[q4 * 4 + 0] * sc * gg.x; o.y = acc[q4 * 4 + 1] * sc * gg.y;
    o.z = acc[q4 * 4 + 2] * sc * gg.z; o.w = acc[q4 * 4 + 3] * sc * gg.w;
    *(float4*)(out + (size_t)t * DM + lane * 16 + q4 * 4) = o;
  }
}

typedef __attribute__((ext_vector_type(16))) float f32x16;
#define MFMA32(a, b, c) __builtin_amdgcn_mfma_f32_32x32x16_bf16((a), (b), (c), 0, 0, 0)
__device__ __forceinline__ int crow(int reg, int hh) { return (reg & 3) + 8 * (reg >> 2) + 4 * hh; }

struct GdnBufs {
  unsigned short* qc;
  unsigned short* kTc;
  unsigned short* qkc;
  unsigned short* wn;
  unsigned short* uo;
  float* gsc;
};

__device__ __forceinline__ void tri_subst(const float* AL0, int lane, float (&T)[64]) {
  const float* AL = (const float*)__builtin_assume_aligned(AL0, 16);
#pragma unroll
  for (int i = 0; i < 64; ++i) T[i] = 0.f;
  T[0] = (lane == 0) ? 1.f : 0.f;
  float4 cur[16], nxt[16];
#pragma unroll
  for (int j4 = 0; j4 < 1; ++j4) cur[j4] = *(const float4*)(AL + 1 * 72 + 4 * j4);
#pragma unroll
  for (int i = 1; i < 64; ++i) {
    if (i + 1 < 64) {
#pragma unroll
      for (int j4 = 0; j4 < (i + 4) / 4; ++j4) nxt[j4] = *(const float4*)(AL + (i + 1) * 72 + 4 * j4);
    }
    float ax = 0.f, ay = 0.f, az = 0.f, aw = 0.f;
#pragma unroll
    for (int j4 = 0; j4 < (i + 3) / 4; ++j4) {
      ax += cur[j4].x * T[4 * j4]; ay += cur[j4].y * T[4 * j4 + 1]; az += cur[j4].z * T[4 * j4 + 2]; aw += cur[j4].w * T[4 * j4 + 3];
    }
    T[i] = ((lane == i) ? 1.f : 0.f) - ((ax + ay) + (az + aw));
#pragma unroll
    for (int j4 = 0; j4 < 16; ++j4) cur[j4] = nxt[j4];
  }
}

__device__ __forceinline__ void d_gdn_prep(int item, char* smem, const unsigned short* __restrict__ pm,
                                           const float* __restrict__ gt, const float* __restrict__ conv_w, GdnBufs G) {
  unsigned short* qL = (unsigned short*)smem;
  unsigned short* kL = qL + 64 * 144;
  unsigned short* kTL = kL + 64 * 144;
  unsigned short* vTL = kTL + 128 * 72;
  float* scal = (float*)(vTL + 128 * 72);
  float* A0 = (float*)qL;
  float* A1 = (float*)kL;
  int tid = TIDX;
  asm volatile("" : "+v"(tid));
  const int lane = tid & 63, w = __builtin_amdgcn_readfirstlane(tid >> 6), r = lane & 31, hh = lane >> 5;
  const int bh = item >> 6, c = item & 63, b = bh >> 2, h = bh & 3;
  const int t0 = b * SEQ + c * 64;
  __syncthreads();
  {
#pragma unroll
    for (int sec = 0; sec < 3; ++sec) {
      const int c0 = sec * 512 + h * 128 + 2 * lane;
      float cw0[5], cw1[5];
#pragma unroll
      for (int j = 0; j < 5; ++j) { cw0[j] = conv_w[c0 * 5 + j]; cw1[j] = conv_w[(c0 + 1) * 5 + j]; }
      unsigned raw[20];
#pragma unroll
      for (int k = 0; k < 20; ++k) {
        const int sp = c * 64 + w * 16 + k - 2;
        raw[k] = (sp >= 0 && sp < SEQ) ? *(const unsigned*)(pm + ((size_t)t0 + w * 16 + k - 2) * 4096 + c0) : 0u;
      }
#pragma unroll
      for (int ii = 0; ii < 16; ++ii) {
        const int i = w * 16 + ii;
        float a0 = 0.f, a1 = 0.f;
#pragma unroll
        for (int j = 0; j < 5; ++j) {
          a0 += cw0[j] * bf2f((unsigned short)(raw[ii + j] & 0xffff));
          a1 += cw1[j] * __uint_as_float(raw[ii + j] & 0xffff0000u);
        }
        a0 = a0 * __builtin_amdgcn_rcpf(1.f + __builtin_amdgcn_exp2f(-1.4426950408889634f * a0));
        a1 = a1 * __builtin_amdgcn_rcpf(1.f + __builtin_amdgcn_exp2f(-1.4426950408889634f * a1));
        if (sec < 2) {
          const float ss = wave_sum_dpp(a0 * a0 + a1 * a1);
          float sc = rsqrtf(ss + EPSF);
          if (sec == 0) sc *= 0.08838834764831845f;
          a0 *= sc; a1 *= sc;
        }
        if (sec == 0) {
          *(unsigned*)(qL + i * 144 + 2 * lane) = pack2(a0, a1);
        } else if (sec == 1) {
          const unsigned pk = pack2(a0, a1);
          *(unsigned*)(kL + i * 144 + 2 * lane) = pk;
          kTL[(2 * lane) * 72 + i] = (unsigned short)(pk & 0xffff);
          kTL[(2 * lane + 1) * 72 + i] = (unsigned short)(pk >> 16);
        } else {
          const unsigned pk = pack2(a0, a1);
          vTL[(2 * lane) * 72 + i] = (unsigned short)(pk & 0xffff);
          vTL[(2 * lane + 1) * 72 + i] = (unsigned short)(pk >> 16);
        }
      }
    }
  }
  if (w == 0) {
    const float* gp = gt + ((size_t)t0 + lane) * 32;
    const float g0 = gp[h], g1 = gp[4 + h], b0 = gp[8 + h], b1 = gp[12 + h];
    float G0 = g0, G1 = g1;
#pragma unroll
    for (int o = 1; o < 64; o <<= 1) {
      const float v0 = __shfl_up(G0, o, 64);
      const float v1 = __shfl_down(G1, o, 64);
      if (lane >= o) G0 += v0;
      if (lane + o < 64) G1 += v1;
    }
    scal[lane] = G0 * 1.4426950408889634f; scal[64 + lane] = G1 * 1.4426950408889634f;
    scal[128 + lane] = b0; scal[192 + lane] = b1;
    const float GL0 = __shfl(G0, 63, 64), GL1 = __shfl(G1, 0, 64);
    float* gs0 = G.gsc + ((size_t)((bh * 2 + 0) * 64 + c)) * 192;
    float* gs1 = G.gsc + ((size_t)((bh * 2 + 1) * 64 + c)) * 192;
    gs0[lane] = expf(G0); gs0[64 + lane] = expf(GL0 - G0);
    gs1[lane] = expf(G1); gs1[64 + lane] = expf(GL1 - G1);
    if (lane == 0) { gs0[128] = expf(GL0); gs1[128] = expf(GL1); }
  }
  __syncthreads();
  {
    unsigned short* qg = G.qc + (size_t)item * 8192;
    unsigned short* kg = G.kTc + (size_t)item * 8192;
#pragma unroll
    for (int i = 0; i < 4; ++i) {
      const int id = tid + i * 256;
      {
        const int row = id >> 4, c16 = id & 15;
        *(uint4*)(qg + (row >> 5) * 4096 + ((c16 >> 1) * 64 + (c16 & 1) * 32 + (row & 31)) * 8) = *(const uint4*)(qL + row * 144 + c16 * 8);
      }
      {
        const int row = id >> 3, c8 = id & 7;
        *(uint4*)(kg + (row >> 5) * 2048 + ((c8 >> 1) * 64 + (c8 & 1) * 32 + (row & 31)) * 8) = *(const uint4*)(kTL + row * 72 + c8 * 8);
      }
    }
  }
  {
    const int ta = w >> 1, tb = w & 1;
    f32x16 acc, acc2;
#pragma unroll
    for (int i = 0; i < 16; ++i) { acc[i] = 0.f; acc2[i] = 0.f; }
#pragma unroll
    for (int s = 0; s < 8; ++s) {
      const bf16x8 a = *(const bf16x8*)(kL + (32 * ta + r) * 144 + 16 * s + 8 * hh);
      const bf16x8 bk = *(const bf16x8*)(kL + (32 * tb + r) * 144 + 16 * s + 8 * hh);
      const bf16x8 bq = *(const bf16x8*)(qL + (32 * tb + r) * 144 + 16 * s + 8 * hh);
      acc = MFMA32(a, bk, acc);
      acc2 = MFMA32(a, bq, acc2);
    }
    __syncthreads();
    {
      const int col = 32 * tb + r;
      const float G0c = scal[col], G1c = scal[64 + col];
#pragma unroll
      for (int reg = 0; reg < 16; ++reg) {
        const int row = 32 * ta + crow(reg, hh);
        const float v = acc[reg];
        const float a0 = (col < row) ? scal[128 + row] * v * __builtin_amdgcn_exp2f(scal[row] - G0c) : 0.f;
        const float a1 = (col > row) ? scal[192 + row] * v * __builtin_amdgcn_exp2f(scal[64 + row] - G1c) : 0.f;
        A0[row * 72 + col] = a0;
        A1[(63 - row) * 72 + (63 - col)] = a1;
      }
    }
    {
      const int i = 32 * tb + r;
      const float G0i = scal[i], G1i = scal[64 + i];
      unsigned short* qk0 = G.qkc + ((size_t)((bh * 2 + 0) * 64 + c)) * 4096;
      unsigned short* qk1 = G.qkc + ((size_t)((bh * 2 + 1) * 64 + c)) * 4096;
#pragma unroll
      for (int g = 0; g < 4; ++g) {
        float o0[4], o1[4];
#pragma unroll
        for (int e = 0; e < 4; ++e) {
          const int j = 32 * ta + 8 * g + 4 * hh + e;
          const float v = acc2[4 * g + e];
          o0[e] = (j <= i) ? v * __builtin_amdgcn_exp2f(G0i - scal[j]) : 0.f;
          o1[e] = (j >= i) ? v * __builtin_amdgcn_exp2f(G1i - scal[64 + j]) : 0.f;
        }
        uint2 p0, p1;
        p0.x = pack2(o0[0], o0[1]); p0.y = pack2(o0[2], o0[3]);
        p1.x = pack2(o1[0], o1[1]); p1.y = pack2(o1[2], o1[3]);
        const int qoff = tb * 2048 + ((2 * ta + (g >> 1)) * 64 + (g & 1) * 32 + r) * 8 + 4 * hh;
        *(uint2*)(qk0 + qoff) = p0;
        *(uint2*)(qk1 + qoff) = p1;
      }
    }
  }
  __syncthreads();
  if (w < 2) {
    const int dir = w;
    float T[64];
    tri_subst(A0 + dir * (64 * 72), lane, T);
    const int jn = dir ? 63 - lane : lane;
    const float sb = scal[128 + 64 * dir + jn];
    const float sbg = sb * __builtin_amdgcn_exp2f(scal[64 * dir + jn]);
    unsigned short* Tb = dir ? kL : qL;
    unsigned short* Tbg = Tb + 64 * 72;
#pragma unroll
    for (int ip = 0; ip < 64; ++ip) {
      const int in = dir ? 63 - ip : ip;
      Tb[in * 72 + jn] = f2bf(T[ip] * sb);
      Tbg[in * 72 + jn] = f2bf(T[ip] * sbg);
    }
  }
  __syncthreads();
#pragma unroll
  for (int d = 0; d < 2; ++d) {
    const int chain = bh * 2 + d;
    const unsigned short* Tb = d ? kL : qL;
    const unsigned short* Tbg = Tb + 64 * 72;
    unsigned short* wng = G.wn + ((size_t)(chain * 64 + c)) * 8192;
    unsigned short* uog = G.uo + ((size_t)(chain * 64 + c)) * 8192 + w * 2048;
#pragma unroll
    for (int tb = 0; tb < 2; ++tb) {
      f32x16 acc, acc2;
#pragma unroll
      for (int i = 0; i < 16; ++i) { acc[i] = 0.f; acc2[i] = 0.f; }
#pragma unroll
      for (int s = 0; s < 4; ++s) {
        const bf16x8 a = *(const bf16x8*)(kTL + (32 * w + r) * 72 + 16 * s + 8 * hh);
        const bf16x8 bb = *(const bf16x8*)(Tbg + (32 * tb + r) * 72 + 16 * s + 8 * hh);
        acc = MFMA32(a, bb, acc);
        const bf16x8 a2 = *(const bf16x8*)(Tb + (32 * tb + r) * 72 + 16 * s + 8 * hh);
        const bf16x8 b2 = *(const bf16x8*)(vTL + (32 * w + r) * 72 + 16 * s + 8 * hh);
        acc2 = MFMA32(a2, b2, acc2);
      }
#pragma unroll
      for (int g = 0; g < 4; ++g) {
        uint2 pk;
        pk.x = pack2(-acc[4 * g], -acc[4 * g + 1]); pk.y = pack2(-acc[4 * g + 2], -acc[4 * g + 3]);
        *(uint2*)(wng + tb * 4096 + ((2 * w + (g >> 1)) * 64 + (g & 1) * 32 + r) * 8 + 4 * hh) = pk;
      }
      uint4 u0, u1;
      u0.x = pack2(acc2[0], acc2[1]); u0.y = pack2(acc2[2], acc2[3]); u0.z = pack2(acc2[4], acc2[5]); u0.w = pack2(acc2[6], acc2[7]);
      u1.x = pack2(acc2[8], acc2[9]); u1.y = pack2(acc2[10], acc2[11]); u1.z = pack2(acc2[12], acc2[13]); u1.w = pack2(acc2[14], acc2[15]);
      *(uint4*)(uog + tb * 1024 + lane * 16) = u0;
      *(uint4*)(uog + tb * 1024 + lane * 16 + 8) = u1;
    }
  }
}

struct GdnOps {
  bf16x8 a[8];
  bf16x8 x[4];
  bf16x8 kt[4];
  float4 rs[4];
  float gtot;
};
__device__ __forceinline__ void gdn_load(GdnOps& o, const GdnBufs& G, int chain, int bh, int c, int sl, int w, int r, int hh, int lane) {
  const unsigned short* kT_c = G.kTc + ((size_t)(bh * 64 + c)) * 8192;
  const float* gs = G.gsc + ((size_t)(chain * 64 + c)) * 192;
  const int ti = w & 1;
#pragma unroll
  for (int s = 0; s < 4; ++s) o.kt[s] = *(const bf16x8*)(kT_c + w * 2048 + (s * 64 + lane) * 8);
  o.gtot = gs[128];
  if (w < 2) {
    const unsigned short* wn_c = G.wn + ((size_t)(chain * 64 + c)) * 8192;
    const unsigned short* uo_c = G.uo + ((size_t)(chain * 64 + c)) * 8192 + sl * 2048;
#pragma unroll
    for (int s = 0; s < 8; ++s) o.a[s] = *(const bf16x8*)(wn_c + ti * 4096 + (s * 64 + lane) * 8);
    o.x[0] = *(const bf16x8*)(uo_c + ti * 1024 + lane * 16);
    o.x[1] = *(const bf16x8*)(uo_c + ti * 1024 + lane * 16 + 8);
#pragma unroll
    for (int g = 0; g < 4; ++g) o.rs[g] = *(const float4*)(gs + 64 + 32 * ti + 8 * g + 4 * hh);
  } else {
    const unsigned short* q_c = G.qc + ((size_t)(bh * 64 + c)) * 8192;
    const unsigned short* qk_c = G.qkc + ((size_t)(chain * 64 + c)) * 4096;
#pragma unroll
    for (int s = 0; s < 8; ++s) o.a[s] = *(const bf16x8*)(q_c + ti * 4096 + (s * 64 + lane) * 8);
#pragma unroll
    for (int s = 0; s < 4; ++s) o.x[s] = *(const bf16x8*)(qk_c + ti * 2048 + (s * 64 + lane) * 8);
#pragma unroll
    for (int g = 0; g < 4; ++g) o.rs[g] = *(const float4*)(gs + 32 * ti + 8 * g + 4 * hh);
  }
}
__device__ __forceinline__ void gdn_step(const GdnOps& o, f32x16& S, unsigned short* ST, unsigned short* VT, unsigned short* VdT,
                                         unsigned short* uo_c, int w, int r, int hh) {
  const int ti = w & 1;
  f32x16 acc;
  if (w < 2) {
#pragma unroll
    for (int i = 0; i < 8; ++i) {
      acc[i] = bf2f((unsigned short)o.x[0][i]);
      acc[8 + i] = bf2f((unsigned short)o.x[1][i]);
    }
  } else {
#pragma unroll
    for (int i = 0; i < 16; ++i) acc[i] = 0.f;
  }
#pragma unroll
  for (int g = 0; g < 4; ++g) {
    uint2 pk;
    pk.x = pack2(S[4 * g], S[4 * g + 1]); pk.y = pack2(S[4 * g + 2], S[4 * g + 3]);
    *(uint2*)(ST + r * 136 + 32 * w + 8 * g + 4 * hh) = pk;
  }
  __syncthreads();
#pragma unroll
  for (int s = 0; s < 8; ++s) {
    const bf16x8 bs = *(const bf16x8*)(ST + r * 136 + 16 * s + 8 * hh);
    acc = MFMA32(o.a[s], bs, acc);
  }
  if (w < 2) {
#pragma unroll
    for (int g = 0; g < 4; ++g) {
      uint2 pk, pd;
      pk.x = pack2(acc[4 * g], acc[4 * g + 1]); pk.y = pack2(acc[4 * g + 2], acc[4 * g + 3]);
      pd.x = pack2(acc[4 * g] * o.rs[g].x, acc[4 * g + 1] * o.rs[g].y);
      pd.y = pack2(acc[4 * g + 2] * o.rs[g].z, acc[4 * g + 3] * o.rs[g].w);
      *(uint2*)(VT + r * 72 + 32 * ti + 8 * g + 4 * hh) = pk;
      *(uint2*)(VdT + r * 72 + 32 * ti + 8 * g + 4 * hh) = pd;
    }
  } else {
#pragma unroll
    for (int g = 0; g < 4; ++g) {
      acc[4 * g] *= o.rs[g].x; acc[4 * g + 1] *= o.rs[g].y; acc[4 * g + 2] *= o.rs[g].z; acc[4 * g + 3] *= o.rs[g].w;
    }
  }
  __syncthreads();
  if (w >= 2) {
#pragma unroll
    for (int s = 0; s < 4; ++s) {
      const bf16x8 bv = *(const bf16x8*)(VT + r * 72 + 16 * s + 8 * hh);
      acc = MFMA32(o.x[s], bv, acc);
    }
#pragma unroll
    for (int reg = 0; reg < 16; ++reg) uo_c[(32 * ti + crow(reg, hh)) * 32 + r] = f2bf(acc[reg]);
  }
#pragma unroll
  for (int i = 0; i < 16; ++i) S[i] *= o.gtot;
#pragma unroll
  for (int s = 0; s < 4; ++s) {
    const bf16x8 bv = *(const bf16x8*)(VdT + r * 72 + 16 * s + 8 * hh);
    S = MFMA32(o.kt[s], bv, S);
  }
}
__device__ __forceinline__ void d_gdn_scan(int chain, int sl, char* smem, GdnBufs G) {
  unsigned short* ST = (unsigned short*)smem;
  unsigned short* VT = ST + 32 * 136;
  unsigned short* VdT = VT + 32 * 72;
  const int tid = TIDX, lane = tid & 63, w = __builtin_amdgcn_readfirstlane(tid >> 6), r = lane & 31, hh = lane >> 5;
  const int bh = chain >> 1, dir = chain & 1;
  f32x16 S;
#pragma unroll
  for (int i = 0; i < 16; ++i) S[i] = 0.f;
  GdnOps A, B;
  gdn_load(A, G, chain, bh, dir ? 63 : 0, sl, w, r, hh, lane);
  for (int step = 0; step < 64; step += 2) {
    const int c0 = dir ? 63 - step : step;
    const int c1 = dir ? c0 - 1 : c0 + 1;
    const int c2 = dir ? c0 - 2 : c0 + 2;
    gdn_load(B, G, chain, bh, c1, sl, w, r, hh, lane);
    gdn_step(A, S, ST, VT, VdT, G.uo + ((size_t)(chain * 64 + c0)) * 8192 + sl * 2048, w, r, hh);
    if (step + 2 < 64) gdn_load(A, G, chain, bh, c2, sl, w, r, hh, lane);
    gdn_step(B, S, ST, VT, VdT, G.uo + ((size_t)(chain * 64 + c1)) * 8192 + sl * 2048, w, r, hh);
  }
}

__device__ __forceinline__ void d_ml_gates(int item, const float* __restrict__ gt, float* __restrict__ pre, float* __restrict__ gtots) {
  const int wv = item * 4 + (TIDX >> 6);
  const int lane = TIDX & 63;
  const int chain = wv >> 6, c = wv & 63;
  const int bh = chain >> 1, dir = chain & 1, b = bh >> 2, h = bh & 3;
  const size_t t0 = (size_t)b * SEQ + c * 64;
  const float lf = gt[(t0 + lane) * 32 + 24 + dir * 4 + h];
  const float ip = gt[(t0 + lane) * 32 + 16 + dir * 4 + h];
  float bc = lf;
#pragma unroll
  for (int ofs = 1; ofs < 64; ofs <<= 1) {
    const float vu = __shfl_up(bc, ofs, 64);
    const float vd = __shfl_down(bc, ofs, 64);
    if (dir == 0) { if (lane >= ofs) bc += vu; } else { if (lane + ofs < 64) bc += vd; }
  }
  const float b_last = __shfl(bc, dir ? 0 : 63, 64);
  float4 o;
  o.x = expf(bc);
  o.y = (ip - bc) * 1.4426950408889634f - 3.5f;
  o.z = bc * 1.4426950408889634f;
  o.w = 0.08838834764831845f * expf(b_last - bc + ip);
  *(float4*)(pre + ((size_t)chain * SEQ + c * 64 + lane) * 4) = o;
  if (lane == 0) gtots[wv] = expf(b_last);
}

#define ML_LDK(R, I, T0) R = *(const uint4*)(pm + ((T0) + ((t128 + (I) * 128) >> 4)) * 4096 + 2560 + h * 128 + (t128 & 15) * 8);
#define ML_STK(R, I) *(uint4*)(kLb + ((t128 + (I) * 128) >> 4) * 136 + (t128 & 15) * 8) = R;
#define ML_LOAD(T0)                                                                                         \
  {                                                                                                         \
    ML_LDK(pk0, 0, T0) ML_LDK(pk1, 1, T0) ML_LDK(pk2, 2, T0) ML_LDK(pk3, 3, T0)                             \
    ML_LDK(pk4, 4, T0) ML_LDK(pk5, 5, T0) ML_LDK(pk6, 6, T0) ML_LDK(pk7, 7, T0)                             \
    pv0 = *(const uint4*)(pm + ((T0) + (t128 >> 2)) * 4096 + 3072 + h * 128 + sl * 32 + (t128 & 3) * 8);    \
    pv1 = *(const uint4*)(pm + ((T0) + ((t128 + 128) >> 2)) * 4096 + 3072 + h * 128 + sl * 32 + (t128 & 3) * 8); \
    pgl = *(const float4*)(pre + ((size_t)chain * SEQ + ((T0) - tb) + lane) * 4);                           \
    pgt = gtots[chain * 64 + (int)(((T0) - tb) >> 6)];                                                      \
  }
#define ML_PUTV(W, E)                                                                                       \
  {                                                                                                         \
    const unsigned short lo_ = (unsigned short)((W) & 0xffff), hi_ = (unsigned short)((W) >> 16);           \
    vTb[(d8_ + (E)) * 72 + tok_] = lo_;                                                                     \
    vTb[(d8_ + (E) + 1) * 72 + tok_] = hi_;                                                                 \
    const unsigned sc_ = pack2(bf2f(lo_) * dj_, bf2f(hi_) * dj_);                                           \
    vdb[(d8_ + (E)) * 72 + tok_] = (unsigned short)(sc_ & 0xffff);                                          \
    vdb[(d8_ + (E) + 1) * 72 + tok_] = (unsigned short)(sc_ >> 16);                                         \
  }
#define ML_STAGE(BUF)                                                                                       \
  {                                                                                                         \
    unsigned short* kLb = kL + (BUF) * (64 * 136);                                                          \
    unsigned short* vTb = vTL + (BUF) * (32 * 72);                                                          \
    unsigned short* vdb = vdTL + (BUF) * (32 * 72);                                                         \
    float* scb = scal + (BUF) * 208;                                                                        \
    if (w == 2) {                                                                                           \
      scb[lane] = pgl.x; scb[64 + lane] = pgl.y; scb[128 + lane] = pgl.z;                                   \
      dL[(BUF) * 72 + lane] = f2bf(pgl.w);                                                                  \
      if (lane == 0) scb[192] = pgt;                                                                        \
    }                                                                                                       \
    ML_STK(pk0, 0) ML_STK(pk1, 1) ML_STK(pk2, 2) ML_STK(pk3, 3) ML_STK(pk4, 4) ML_STK(pk5, 5) ML_STK(pk6, 6) ML_STK(pk7, 7) \
    {                                                                                                       \
      const int tok_ = t128 >> 2, d8_ = (t128 & 3) * 8;                                                     \
      const float dj_ = __shfl(pgl.w, tok_, 64);                                                            \
      ML_PUTV(pv0.x, 0); ML_PUTV(pv0.y, 2); ML_PUTV(pv0.z, 4); ML_PUTV(pv0.w, 6);                           \
    }                                                                                                       \
    {                                                                                                       \
      const int tok_ = (t128 + 128) >> 2, d8_ = (t128 & 3) * 8;                                             \
      const float dj_ = __shfl(pgl.w, tok_, 64);                                                            \
      ML_PUTV(pv1.x, 0); ML_PUTV(pv1.y, 2); ML_PUTV(pv1.z, 4); ML_PUTV(pv1.w, 6);                           \
    }                                                                                                       \
  }
__device__ __forceinline__ void ml_state_image(const f32x16& S0, const f32x16& S1, unsigned short* S0T, unsigned short* nL, int w, int r, int hh) {
#pragma unroll
  for (int g = 0; g < 4; ++g) {
    uint2 pk;
    pk.x = pack2(S0[4 * g], S0[4 * g + 1]); pk.y = pack2(S0[4 * g + 2], S0[4 * g + 3]);
    *(uint2*)(S0T + r * 136 + 32 * w + 8 * g + 4 * hh) = pk;
    if (r == 0) {
      uint2 pn;
      pn.x = pack2(S1[4 * g], S1[4 * g + 1]); pn.y = pack2(S1[4 * g + 2], S1[4 * g + 3]);
      *(uint2*)(nL + 32 * w + 8 * g + 4 * hh) = pn;
    }
  }
}
__device__ __forceinline__ void ml_state_update(f32x16& S0, f32x16& S1, const unsigned short* kLb, const unsigned short* vdb,
                                                const unsigned short* dLb, float gtot, int w, int r, int hh) {
#pragma unroll
  for (int i = 0; i < 16; ++i) { S0[i] *= gtot; S1[i] *= gtot; }
#pragma unroll
  for (int s2 = 0; s2 < 4; ++s2) {
    union { bf16x8 v; unsigned short e[8]; } a;
#pragma unroll
    for (int e = 0; e < 8; ++e) a.e[e] = kLb[(16 * s2 + 8 * hh + e) * 136 + 32 * w + r];
    const bf16x8 bv = *(const bf16x8*)(vdb + r * 72 + 16 * s2 + 8 * hh);
    const bf16x8 bd = *(const bf16x8*)(dLb + 16 * s2 + 8 * hh);
    S0 = MFMA32(a.v, bv, S0);
    S1 = MFMA32(a.v, bd, S1);
  }
}
__device__ __forceinline__ void d_mlstm_scan(int chain, int sl, char* smem, const unsigned short* __restrict__ pm,
                                             const float* __restrict__ pre, const float* __restrict__ gtots,
                                             unsigned short* __restrict__ oM, int ntok) {
  unsigned short* kL = (unsigned short*)smem;
  unsigned short* vTL = kL + 2 * 64 * 136;
  unsigned short* vdTL = vTL + 2 * 32 * 72;
  unsigned short* dL = vdTL + 2 * 32 * 72;
  unsigned short* S0T = dL + 256;
  unsigned short* nL = S0T + 32 * 136;
  float* scal = (float*)(nL + 256);
  int tid = TIDX;
  asm volatile("" : "+v"(tid));
  const int lane = tid & 63, w = __builtin_amdgcn_readfirstlane(tid >> 6), r = lane & 31, hh = lane >> 5;
  const int bh = chain >> 1, dir = chain & 1, b = bh >> 2, h = bh & 3;
  f32x16 S0, S1;
#pragma unroll
  for (int i = 0; i < 16; ++i) { S0[i] = 0.f; S1[i] = 0.f; }
  unsigned short* oMb = oM + (size_t)dir * ntok * 512 + h * 128 + sl * 32;
  const size_t tb = (size_t)b * SEQ;
  __syncthreads();
  ml_state_image(S0, S1, S0T, nL, w, r, hh);
  if (w >= 2) {
    const int t128 = tid - 128;
    uint4 pk0, pk1, pk2, pk3, pk4, pk5, pk6, pk7, pv0, pv1;
    float4 pgl;
    float pgt;
    ML_LOAD(tb + (dir ? 63 : 0) * 64);
    ML_STAGE(0);
    ML_LOAD(tb + (dir ? 62 : 1) * 64);
    for (int step = 0; step < 64; ++step) {
      const int c0 = dir ? 63 - step : step;
      const int c2 = dir ? c0 - 2 : c0 + 2;
      const int buf = step & 1;
      __syncthreads();
      const float gtot = scal[buf * 208 + 192];
      ML_STAGE(buf ^ 1);
      {
        const int cl = (step + 2 < 64) ? c2 : c0;
        ML_LOAD(tb + cl * 64);
      }
      ml_state_update(S0, S1, kL + buf * (64 * 136), vdTL + buf * (32 * 72), dL + buf * 72, gtot, w, r, hh);
      __syncthreads();
      ml_state_image(S0, S1, S0T, nL, w, r, hh);
    }
  } else {
    bf16x8 ones;
#pragma unroll
    for (int i = 0; i < 8; ++i) ones[i] = (short)0x3F80;
    const int ti = w;
    const int icol = 32 * ti + r;
    float dmask[16];
#pragma unroll
    for (int reg = 0; reg < 16; ++reg) {
      const int jl = crow(reg, hh);
      dmask[reg] = (dir ? (jl >= r) : (jl <= r)) ? 1.f : 0.f;
    }
    bf16x8 qf[8];
    {
      const unsigned short* qp = pm + (tb + (size_t)(dir ? 63 : 0) * 64 + 32 * ti + r) * 4096 + 2048 + h * 128 + 8 * hh;
#pragma unroll
      for (int s2 = 0; s2 < 8; ++s2) qf[s2] = *(const bf16x8*)(qp + 16 * s2);
    }
    for (int step = 0; step < 64; ++step) {
      const int c0 = dir ? 63 - step : step;
      const int c1 = dir ? c0 - 1 : c0 + 1;
      const int buf = step & 1;
      const unsigned short* kLb = kL + buf * (64 * 136);
      const unsigned short* vTb = vTL + buf * (32 * 72);
      const float* scb = scal + buf * 208;
      __syncthreads();
      const float bci = scb[128 + icol];
      const float gtot = scb[192];
      f32x16 Q0, Q1;
#pragma unroll
      for (int i = 0; i < 16; ++i) { Q0[i] = 0.f; Q1[i] = 0.f; }
#pragma unroll
      for (int s2 = 0; s2 < 8; ++s2) {
        const bf16x8 b0 = *(const bf16x8*)(S0T + r * 136 + 16 * s2 + 8 * hh);
        const bf16x8 b1 = *(const bf16x8*)(nL + 16 * s2 + 8 * hh);
        Q0 = MFMA32(qf[s2], b0, Q0);
        Q1 = MFMA32(qf[s2], b1, Q1);
      }
#pragma unroll
      for (int g = 0; g < 4; ++g) {
        const float4 e4 = *(const float4*)(scb + 32 * ti + 8 * g + 4 * hh);
        Q0[4 * g] *= e4.x; Q0[4 * g + 1] *= e4.y; Q0[4 * g + 2] *= e4.z; Q0[4 * g + 3] *= e4.w;
        Q1[4 * g] *= e4.x; Q1[4 * g + 1] *= e4.y; Q1[4 * g + 2] *= e4.z; Q1[4 * g + 3] *= e4.w;
      }
#pragma unroll
      for (int tj = 0; tj < 2; ++tj) {
        if (dir ? (tj < ti) : (tj > ti)) continue;
        f32x16 X;
#pragma unroll
        for (int i = 0; i < 16; ++i) X[i] = 0.f;
#pragma unroll
        for (int s2 = 0; s2 < 8; ++s2) {
          const bf16x8 a = *(const bf16x8*)(kLb + (32 * tj + r) * 136 + 16 * s2 + 8 * hh);
          X = MFMA32(a, qf[s2], X);
        }
        if (tj == ti) {
#pragma unroll
          for (int g = 0; g < 4; ++g) {
            const float4 cj4 = *(const float4*)(scb + 64 + 32 * tj + 8 * g + 4 * hh);
            X[4 * g + 0] *= __builtin_amdgcn_exp2f(fminf(bci + cj4.x, 80.f)) * dmask[4 * g + 0];
            X[4 * g + 1] *= __builtin_amdgcn_exp2f(fminf(bci + cj4.y, 80.f)) * dmask[4 * g + 1];
            X[4 * g + 2] *= __builtin_amdgcn_exp2f(fminf(bci + cj4.z, 80.f)) * dmask[4 * g + 2];
            X[4 * g + 3] *= __builtin_amdgcn_exp2f(fminf(bci + cj4.w, 80.f)) * dmask[4 * g + 3];
          }
        } else {
#pragma unroll
          for (int g = 0; g < 4; ++g) {
            const float4 cj4 = *(const float4*)(scb + 64 + 32 * tj + 8 * g + 4 * hh);
            X[4 * g + 0] *= __builtin_amdgcn_exp2f(bci + cj4.x);
            X[4 * g + 1] *= __builtin_amdgcn_exp2f(bci + cj4.y);
            X[4 * g + 2] *= __builtin_amdgcn_exp2f(bci + cj4.z);
            X[4 * g + 3] *= __builtin_amdgcn_exp2f(bci + cj4.w);
          }
        }
#pragma unroll
        for (int s2 = 0; s2 < 2; ++s2) {
          union { bf16x8 v; unsigned u[4]; } xa, bv;
          xa.u[0] = pack2(X[8 * s2 + 0], X[8 * s2 + 1]); xa.u[1] = pack2(X[8 * s2 + 2], X[8 * s2 + 3]);
          xa.u[2] = pack2(X[8 * s2 + 4], X[8 * s2 + 5]); xa.u[3] = pack2(X[8 * s2 + 6], X[8 * s2 + 7]);
          const uint2 v0 = *(const uint2*)(vTb + r * 72 + 32 * tj + 16 * s2 + 4 * hh);
          const uint2 v1 = *(const uint2*)(vTb + r * 72 + 32 * tj + 16 * s2 + 8 + 4 * hh);
          bv.u[0] = v0.x; bv.u[1] = v0.y; bv.u[2] = v1.x; bv.u[3] = v1.y;
          Q0 = MFMA32(xa.v, bv.v, Q0);
          Q1 = MFMA32(xa.v, ones, Q1);
        }
      }
      {
        const int cn = (step + 1 < 64) ? c1 : c0;
        const unsigned short* qp = pm + (tb + (size_t)cn * 64 + 32 * ti + r) * 4096 + 2048 + h * 128 + 8 * hh;
#pragma unroll
        for (int s2 = 0; s2 < 8; ++s2) qf[s2] = *(const bf16x8*)(qp + 16 * s2);
      }
      const size_t orow0 = tb + c0 * 64;
#pragma unroll
      for (int reg = 0; reg < 16; ++reg) {
        const int i = 32 * ti + crow(reg, hh);
        oMb[(orow0 + i) * 512 + r] = f2bf(Q0[reg] * __builtin_amdgcn_rcpf(fmaxf(fabsf(Q1[reg]), 1.f)));
      }
      ml_state_update(S0, S1, kLb, vdTL + buf * (32 * 72), dL + buf * 72, gtot, w, r, hh);
      __syncthreads();
      ml_state_image(S0, S1, S0T, nL, w, r, hh);
    }
  }
}

struct MKP {
  const float *x, *norm1_g, *w_in, *conv_w, *a_log, *dt_bias, *gdn_g, *i_bias, *f_bias, *ml_g, *w_out, *norm2_g, *peer_wq,
      *peer_keys, *peer_u, *peer_v, *normf_g;
  float* out;
  unsigned short *pm, *x1b, *woutT, *mt, *xb, *winT, *oM, *yb, *scores, *qkv_dbg, *oA_dbg;
  unsigned *utab, *vtab;
  unsigned short *wqb, *keyb;
  float *uscale, *vscale;
  float *x1, *rs1, *rs2, *gt, *gateb, *dbg, *mlpre, *mlgt;
  unsigned* bar;
  int* idxb;
  GdnBufs G;
};

constexpr int SMEM_BYTES = 74752;
__global__ void __launch_bounds__(512, 2) k_mega(MKP P) {
  __shared__ __attribute__((aligned(16))) char smem_all[2 * SMEM_BYTES + 16];
  {
    volatile LAS unsigned* st0 = (volatile LAS unsigned*)(smem_all + 2 * SMEM_BYTES);
    if (threadIdx.x < 4) st0[threadIdx.x] = 0u;
  }
  __syncthreads();
  XcdBarrier xb = xcd_barrier_post(P.bar, (volatile LAS unsigned*)(smem_all + 2 * SMEM_BYTES));
  const int hb = __builtin_amdgcn_readfirstlane(HB);
  char* smem_c = smem_all + hb * SMEM_BYTES;
  unsigned short* smem = (unsigned short*)smem_c;
  const int nb = gridDim.x, bid = blockIdx.x;
  for (int it = bid; it < NT / 8; it += nb) d_prep_x(2 * it + hb, P.x, P.xb, P.rs1);
  for (int it = bid; it < 8 * 66; it += nb) d_transpose_w(2 * it + hb, 66, (float*)smem_c, P.w_in, DIN, P.norm1_g, P.winT, 1);
  for (int it = bid; it < 8 * 16; it += nb) d_transpose_w(2 * it + hb, 16, (float*)smem_c, P.w_out, 1024, nullptr, P.woutT, 0);
  for (int it = bid; it < 512; it += nb) d_cvt_bf16(2 * it + hb, P.peer_wq, P.wqb, P.norm2_g, 11);
  for (int it = bid; it < 64; it += nb) d_cvt_bf16(2 * it + hb, P.peer_keys, P.keyb, nullptr, 0);
  if (bid == 0 && threadIdx.x < 4) P.dbg[threadIdx.x] = 0.f;
  xcd_barrier(xb);
  {
    GemmP p{};
    p.A = P.xb; p.lda = DM; p.Bt = P.winT; p.ldb = DM; p.K = DM;
    p.rowscale = P.rs1; p.obf = P.pm; p.ldo = 4096; p.of32 = P.gt; p.ldf = 32; p.resid = nullptr;
    p.a_log = P.a_log; p.dt_bias = P.dt_bias; p.i_bias = P.i_bias; p.f_bias = P.f_bias;
    for (int k = 0;; ++k) {
      int tm, tn;
      if (!xcd_tile256(bid, nb, k, 16, tm, tn)) break;
      gemm256_tile<EPI_INPROJ>(p, tm, tn, smem_all);
    }
  }
  for (int it = bid; it < NT / 128; it += nb) d_gate_proj(it, P.xb, P.winT, P.rs1, P.a_log, P.dt_bias, P.i_bias, P.f_bias, P.gt);
  for (int tile = bid; tile < 16 * 4; tile += nb) {
    const int hp = tile >> 2, tn = (tile & 3) * 2 + hb;
    GemmP p{};
    p.A = P.keyb + (size_t)hp * 128 * 128; p.lda = 128; p.Bt = P.wqb + hp * 128; p.ldb = 2048; p.K = 128;
    p.obf = P.mt + (size_t)hp * 128 * DM; p.ldo = DM;
    gemm_tile<EPI_PLAIN>(p, 0, tn, smem);
    __syncthreads();
  }
  xcd_barrier(xb);
  for (int it = bid; it < 256; it += nb) d_ml_gates(2 * it + hb, P.gt, P.mlpre, P.mlgt);
  for (int it = bid; it < 512; it += nb) d_gdn_prep(2 * it + hb, smem_c, P.pm, P.gt, P.conv_w, P.G);
  xcd_barrier(xb);
  for (int wi = bid; wi < 256; wi += nb) {
    if (hb == 0) {
      if (wi < 128) d_gdn_scan(wi >> 2, wi & 3, smem_c, P.G);
      else d_mlstm_scan((wi - 128) >> 2, (wi - 128) & 3, smem_c, P.pm, P.mlpre, P.mlgt, P.oM, NT);
    } else {
      const int nbar = (wi < 128) ? 128 : 129;
      for (int i = 0; i < nbar; ++i) __syncthreads();
    }
    __syncthreads();
  }
  xcd_barrier(xb);
  for (int it = bid; it < NT / 8; it += nb) d_combine(2 * it + hb, P.G.uo, P.oM, P.pm, P.gdn_g, P.ml_g, P.yb);
  xcd_barrier(xb);
  {
    GemmP p{};
    p.A = P.yb; p.lda = DM; p.Bt = P.woutT; p.ldb = DM; p.K = DM;
    p.rowscale = nullptr; p.obf = P.x1b; p.ldo = DM; p.of32 = P.x1; p.ldf = DM; p.resid = P.x; p.rowacc = P.rs2;
    for (int k = 0;; ++k) {
      int tm, tn;
      if (!xcd_tile256(bid, nb, k, 4, tm, tn)) break;
      gemm256_tile<EPI_OUTPROJ>(p, tm, tn, smem_all);
    }
  }
  for (int it = bid; it < 512; it += nb) { d_cvt_tab<true>(2 * it + hb, P.peer_u, P.utab, P.uscale); d_cvt_tab<false>(2 * it + hb, P.peer_v, P.vtab, P.vscale); }
  xcd_barrier(xb);
  {
    GemmP p{};
    p.A = P.x1b; p.lda = DM; p.Bt = P.mt; p.ldb = DM; p.K = DM;
    p.rowscale = P.rs2; p.obf = P.scores; p.ldo = 2048; p.of32 = nullptr; p.ldf = 0; p.resid = nullptr;
    for (int k = 0;; ++k) {
      int tm, tn;
      if (!xcd_tile256(bid, nb, k, 8, tm, tn)) break;
      gemm256_tile<EPI_SCORES>(p, tm, tn, smem_all);
    }
  }
  xcd_barrier(xb);
  const float oscale = 1.f;
  for (int it = bid; it < NT / 64; it += nb) {
    const int hit = 2 * it + hb;
    d_topk(hit, P.scores, P.idxb, P.gateb);
    __threadfence_block();
    __syncthreads();
#pragma unroll 1
    for (int sub = 0; sub < 8; ++sub)
      d_peer(hit * 8 + sub, smem_c, P.x1, P.rs2, P.norm2_g, P.idxb, P.gateb, P.utab, P.vtab, P.uscale, P.vscale, P.normf_g, P.out, oscale);
  }
}

extern "C" void kernel_launch(void* const* d_in, const int* in_sizes, int n_in, void* d_out, int out_size, void* d_ws,
                              size_t ws_size, hipStream_t stream) {
  MKP P{};
  P.x = (const float*)d_in[0];
  P.norm1_g = (const float*)d_in[1];
  P.w_in = (const float*)d_in[2];
  P.conv_w = (const float*)d_in[3];
  P.a_log = (const float*)d_in[4];
  P.dt_bias = (const float*)d_in[5];
  P.gdn_g = (const float*)d_in[6];
  P.i_bias = (const float*)d_in[7];
  P.f_bias = (const float*)d_in[8];
  P.ml_g = (const float*)d_in[9];
  P.w_out = (const float*)d_in[10];
  P.norm2_g = (const float*)d_in[11];
  P.peer_wq = (const float*)d_in[12];
  P.peer_keys = (const float*)d_in[13];
  P.peer_u = (const float*)d_in[14];
  P.peer_v = (const float*)d_in[15];
  P.normf_g = (const float*)d_in[16];
  P.out = (float*)d_out;

  char* ws = (char*)d_ws;
  const size_t MB = 1024 * 1024;
  P.pm = (unsigned short*)(ws);
  P.x1 = (float*)(ws);
  P.x1b = (unsigned short*)(ws + 64 * MB);
  P.utab = (unsigned*)(ws + 96 * MB);
  P.vtab = (unsigned*)(ws + 112 * MB);
  P.uscale = (float*)(ws + 136 * MB);
  P.vscale = (float*)(ws + 136 * MB + 65536);
  char* rb = ws + 128 * MB;
  P.woutT = (unsigned short*)(rb);
  P.mt = (unsigned short*)(rb + 2 * MB);
  P.rs1 = (float*)(rb + 6 * MB);
  P.rs2 = (float*)(rb + 7 * MB);
  P.dbg = (float*)(rb + 6 * MB + 131072);
  P.bar = (unsigned*)(rb + 6 * MB + 196608);
  P.gt = (float*)(rb + 9 * MB);
  char* dyn = rb + 11 * MB;
  P.xb = (unsigned short*)(dyn);
  P.winT = (unsigned short*)(dyn + 32 * MB);
  P.wqb = (unsigned short*)(dyn + 41 * MB);
  P.keyb = (unsigned short*)(dyn + 45 * MB);
  P.G.qc = (unsigned short*)(dyn);
  P.G.kTc = (unsigned short*)(dyn + 16 * MB);
  P.G.qkc = (unsigned short*)(dyn + 32 * MB);
  P.G.wn = (unsigned short*)(dyn + 48 * MB);
  P.G.uo = (unsigned short*)(dyn + 80 * MB);
  P.G.gsc = (float*)(dyn + 112 * MB);
  P.mlpre = (float*)(dyn + 114 * MB);
  P.mlgt = (float*)(dyn + 116 * MB);
  P.yb = (unsigned short*)(dyn);
  P.scores = (unsigned short*)(dyn);
  P.idxb = (int*)(dyn + 64 * MB);
  P.gateb = (float*)(dyn + 72 * MB);
  char* os = (char*)d_out;
  P.oM = (unsigned short*)(os);
  P.qkv_dbg = (unsigned short*)(os + 32 * MB);
  P.oA_dbg = (unsigned short*)(os + 44 * MB);

  static int grid_blocks = 0;
  if (!grid_blocks) {
    int dev = 0, cus = 0, per_cu = 0;
    (void)hipGetDevice(&dev);
    (void)hipDeviceGetAttribute(&cus, hipDeviceAttributeMultiprocessorCount, dev);
    (void)hipOccupancyMaxActiveBlocksPerMultiprocessor(&per_cu, k_mega, 512, 0);
    if (per_cu > 1) per_cu = 1;
    if (per_cu < 1) per_cu = 1;
    grid_blocks = cus * per_cu;
  }
  (void)hipMemsetAsync(P.bar, 0, XCD_BAR_WORDS * sizeof(unsigned), stream);
  hipLaunchKernelGGL(k_mega, dim3(grid_blocks), dim3(512), 0, stream, P);
}
```

```cpp
#include <hip/hip_runtime.h>
#include <hip/hip_bf16.h>
#include <stdint.h>
#include <cstdio>
#define TIDX ((int)(threadIdx.x & 255))
#define HB ((int)(threadIdx.x >> 8))

#define XB_TMO      128
#define XB_XCNT(j)  (256  + 64 * (j))
#define XB_XSUB(j)  (1280 + 64 * (j))
#define XB_XGEN(j)  (2304 + 64 * (j))
#define XB_TOP      3328
#define XB_TOPGEN   3392
#define XCD_BAR_WORDS 3456
#define XB_SPIN_CAP (1u << 18)
#define LAS __attribute__((address_space(3)))

__device__ __forceinline__ unsigned xb_ld(unsigned* p)              { return __hip_atomic_load(p, __ATOMIC_RELAXED, __HIP_MEMORY_SCOPE_AGENT); }
__device__ __forceinline__ unsigned xb_add(unsigned* p, unsigned v) { return __hip_atomic_fetch_add(p, v, __ATOMIC_RELAXED, __HIP_MEMORY_SCOPE_AGENT); }
__device__ __forceinline__ unsigned xb_xcc_id() { return (unsigned)__builtin_amdgcn_s_getreg((3 << 11) | 20) & 0xFu; }
#define XB_SPIN(cond, bar) do { unsigned _sp = 0; while (cond) { __builtin_amdgcn_s_sleep(1); \
    if ((++_sp & 255u) == 0u) { if (xb_ld(&(bar)[XB_TMO])) break; if (_sp > XB_SPIN_CAP) { atomicAdd(&(bar)[XB_TMO], 1u); break; } } } } while (0)

struct XcdBarrier {
    unsigned* bar; unsigned x;
    volatile LAS unsigned* st;
};

__device__ __forceinline__ XcdBarrier xcd_barrier_post(unsigned* bar, volatile LAS unsigned* st) {
    XcdBarrier b; b.bar = bar; b.x = xb_xcc_id(); b.st = st;
    if (threadIdx.x == 0) (void)xb_add(&bar[XB_XCNT(b.x)], 1u);
    return b;
}
__device__ __forceinline__ void xcd_barrier_complete(unsigned* bar, unsigned x, unsigned& nloc, unsigned& nx) {
    const unsigned G = gridDim.x * gridDim.y * gridDim.z;
    unsigned sum, cnt, mine, sp = 0u;
    for (;;) {
        sum = 0u; cnt = 0u; mine = 0u;
#pragma unroll
        for (unsigned j = 0; j < 16; ++j) { const unsigned c = xb_ld(&bar[XB_XCNT(j)]); sum += c; cnt += (c > 0u) ? 1u : 0u; mine = (j == x) ? c : mine; }
        if (sum == G) break;
        __builtin_amdgcn_s_sleep(1);
        if ((++sp & 255u) == 0u) { if (xb_ld(&bar[XB_TMO])) break; if (sp > XB_SPIN_CAP) { atomicAdd(&bar[XB_TMO], 1u); break; } }
    }
    nloc = mine > 0u ? mine : 1u; nx = cnt > 0u ? cnt : 1u;
}

__device__ __forceinline__ void xcd_barrier(const XcdBarrier& b) {
    asm volatile("s_waitcnt vmcnt(0)" ::: "memory");
    __syncthreads();
    if (threadIdx.x == 0) {
        unsigned* bar = b.bar;
        __builtin_amdgcn_s_waitcnt(0);
        unsigned nloc = b.st[0], nx = b.st[1];
        if (nloc == 0u) { xcd_barrier_complete(bar, b.x, nloc, nx); b.st[0] = nloc; b.st[1] = nx; }
        const unsigned old = xb_add(&bar[XB_XSUB(b.x)], 1u);
        const unsigned gen = old / nloc;
        if (old + 1u == (gen + 1u) * nloc) {
            __builtin_amdgcn_fence(__ATOMIC_RELEASE, "agent");
            asm volatile("s_waitcnt vmcnt(0)" ::: "memory");
            const unsigned og = xb_add(&bar[XB_TOP], 1u);
            const unsigned tg = og / nx;
            if (og + 1u == (tg + 1u) * nx) xb_add(&bar[XB_TOPGEN], 1u);
            else XB_SPIN(xb_ld(&bar[XB_TOPGEN]) == tg, bar);
            __builtin_amdgcn_fence(__ATOMIC_ACQUIRE, "agent");
            xb_add(&bar[XB_XGEN(b.x)], 1u);
            asm volatile("s_waitcnt vmcnt(0)" ::: "memory");
        } else {
            XB_SPIN(xb_ld(&bar[XB_XGEN(b.x)]) == gen, bar);
            __builtin_amdgcn_fence(__ATOMIC_ACQUIRE, "agent");
            asm volatile("s_waitcnt vmcnt(0)" ::: "memory");
        }
    }
    __syncthreads();
}


typedef __hip_bfloat16 bf16;
typedef __attribute__((ext_vector_type(8))) short bf16x8;
typedef __attribute__((ext_vector_type(4))) float f32x4;

constexpr int DM = 1024;
constexpr int NB = 4;
constexpr int SEQ = 4096;
constexpr int NT = NB * SEQ;
constexpr int DIN = 4128;
constexpr int NPAD_IN = 4224;
constexpr float EPSF = 1e-6f;

__device__ __forceinline__ float bf2f(unsigned short u) { return __uint_as_float(((unsigned)u) << 16); }
typedef __bf16 bf16x2_t __attribute__((ext_vector_type(2)));
typedef float f32x2_t __attribute__((ext_vector_type(2)));
__device__ __forceinline__ unsigned short f2bf(float f) { return __builtin_bit_cast(unsigned short, (__bf16)f); }
__device__ __forceinline__ unsigned pack2(float a, float b) {
  f32x2_t v = {a, b};
  return __builtin_bit_cast(unsigned, __builtin_convertvector(v, bf16x2_t));
}
__device__ __forceinline__ float wave_sum(float v) {
#pragma unroll
  for (int o = 32; o > 0; o >>= 1) v += __shfl_xor(v, o, 64);
  return v;
}
#define DPP_ADD(v, ctrl) v += __builtin_bit_cast(float, __builtin_amdgcn_update_dpp(0, __builtin_bit_cast(int, v), ctrl, 0xF, 0xF, true))
__device__ __forceinline__ float wave_sum_dpp(float v) {
  DPP_ADD(v, 0xB1);
  DPP_ADD(v, 0x4E);
  DPP_ADD(v, 0x141);
  DPP_ADD(v, 0x140);
  const float r0 = __builtin_bit_cast(float, __builtin_amdgcn_readlane(__builtin_bit_cast(int, v), 0));
  const float r1 = __builtin_bit_cast(float, __builtin_amdgcn_readlane(__builtin_bit_cast(int, v), 16));
  const float r2 = __builtin_bit_cast(float, __builtin_amdgcn_readlane(__builtin_bit_cast(int, v), 32));
  const float r3 = __builtin_bit_cast(float, __builtin_amdgcn_readlane(__builtin_bit_cast(int, v), 48));
  return (r0 + r1) + (r2 + r3);
}
__device__ __forceinline__ float softplusf(float x) { return fmaxf(x, 0.f) + log1pf(expf(-fabsf(x))); }
__device__ __forceinline__ float sigmoidf(float x) { return __builtin_amdgcn_rcpf(1.f + __builtin_amdgcn_exp2f(-1.4426950408889634f * x)); }

__device__ __forceinline__ void d_prep_x(int item, const float* __restrict__ x, unsigned short* __restrict__ xb,
                                                float* __restrict__ rs) {
  int t = item * 4 + (TIDX >> 6);
  int lane = TIDX & 63;
  const float4* xr = (const float4*)(x + (size_t)t * DM);
  float ss = 0.f;
#pragma unroll
  for (int i = 0; i < 4; ++i) {
    float4 v = xr[lane + 64 * i];
    ss += v.x * v.x + v.y * v.y + v.z * v.z + v.w * v.w;
    ushort4 o;
    o.x = f2bf(v.x); o.y = f2bf(v.y); o.z = f2bf(v.z); o.w = f2bf(v.w);
    ((ushort4*)(xb + (size_t)t * DM))[lane + 64 * i] = o;
  }
  ss = wave_sum(ss);
  if (lane == 0) rs[t] = rsqrtf(ss * (1.f / DM) + EPSF);
}

__device__ __forceinline__ int win_src(int n) {
  if (n < 2048) return n;
  if (n < 4096) return n + 16;
  int j = n - 4096;
  if (j < 16) return 2048 + j;
  if (j < 32) return 4112 + (j - 16);
  return -1;
}
__device__ __forceinline__ void d_transpose_w(int item, int ntn, float* tile, const float* __restrict__ in, int ldn,
                                              const float* __restrict__ g, unsigned short* __restrict__ out, int mode) {
  const int kt = item / ntn, nt = item % ntn;
  const int tid = TIDX;
  __syncthreads();
#pragma unroll
  for (int i = 0; i < 4; ++i) {
    const int row = (tid >> 4) + 16 * i;
    const int c4 = (tid & 15) * 4;
    const int n = nt * 64 + c4;
    const int src = mode ? win_src(n) : n;
    float4 v = make_float4(0.f, 0.f, 0.f, 0.f);
    if (src >= 0) {
      v = *(const float4*)(in + (size_t)(kt * 64 + row) * ldn + src);
      if (g) { const float gg = g[kt * 64 + row]; v.x *= gg; v.y *= gg; v.z *= gg; v.w *= gg; }
    }
    tile[row * 65 + c4] = v.x; tile[row * 65 + c4 + 1] = v.y; tile[row * 65 + c4 + 2] = v.z; tile[row * 65 + c4 + 3] = v.w;
  }
  __syncthreads();
  {
    const int n = tid >> 2, k16 = (tid & 3) * 16;
    uint4 o0, o1;
    o0.x = pack2(tile[(k16 + 0) * 65 + n], tile[(k16 + 1) * 65 + n]);   o0.y = pack2(tile[(k16 + 2) * 65 + n], tile[(k16 + 3) * 65 + n]);
    o0.z = pack2(tile[(k16 + 4) * 65 + n], tile[(k16 + 5) * 65 + n]);   o0.w = pack2(tile[(k16 + 6) * 65 + n], tile[(k16 + 7) * 65 + n]);
    o1.x = pack2(tile[(k16 + 8) * 65 + n], tile[(k16 + 9) * 65 + n]);   o1.y = pack2(tile[(k16 + 10) * 65 + n], tile[(k16 + 11) * 65 + n]);
    o1.z = pack2(tile[(k16 + 12) * 65 + n], tile[(k16 + 13) * 65 + n]); o1.w = pack2(tile[(k16 + 14) * 65 + n], tile[(k16 + 15) * 65 + n]);
    unsigned short* op = out + (size_t)(nt * 64 + n) * DM + kt * 64 + k16;
    *(uint4*)op = o0;
    *(uint4*)(op + 8) = o1;
  }
}
__device__ __forceinline__ void d_cvt_bf16(int item, const float* __restrict__ src, unsigned short* __restrict__ dst,
                                           const float* __restrict__ rowscale, int rowlen_log2) {
  const size_t base = (size_t)item * 2048 + TIDX * 8;
  float4 a = *(const float4*)(src + base);
  float4 b = *(const float4*)(src + base + 4);
  if (rowscale) {
    const float sc = rowscale[base >> rowlen_log2];
    a.x *= sc; a.y *= sc; a.z *= sc; a.w *= sc; b.x *= sc; b.y *= sc; b.z *= sc; b.w *= sc;
  }
  uint4 o;
  o.x = pack2(a.x, a.y); o.y = pack2(a.z, a.w); o.z = pack2(b.x, b.y); o.w = pack2(b.z, b.w);
  *(uint4*)(dst + base) = o;
}

constexpr int GBM = 128, GBN = 128, GBK = 64, GLD = 64;
struct GemmP {
  const unsigned short* A; const unsigned short* Bt; int lda, ldb, K;
  const float* rowscale;
  unsigned short* obf; int ldo;
  float* of32; int ldf;
  const float* resid;
  const float *a_log, *dt_bias, *i_bias, *f_bias;
  float* rowacc;
};
enum { EPI_INPROJ = 0, EPI_OUTPROJ = 1, EPI_SCORES = 2, EPI_PLAIN = 3 };

template <int EPI>
__device__ __forceinline__ void gemm_tile(const GemmP p, int tm, int tn, unsigned short* smem) {
  unsigned short* As = smem;
  unsigned short* Bs = smem + 2 * GBM * GLD;
  int tid = TIDX;
  asm volatile("" : "+v"(tid));
  const int lane = tid & 63, wid = tid >> 6;
  const int wm = wid >> 1, wn = wid & 1;
  const int m0 = tm * GBM, n0 = tn * GBN;
  f32x4 acc[4][4];
#pragma unroll
  for (int i = 0; i < 4; ++i)
#pragma unroll
    for (int j = 0; j < 4; ++j) acc[i][j] = (f32x4){0.f, 0.f, 0.f, 0.f};

  uint4 ra0, ra1, ra2, ra3, rb0, rb1, rb2, rb3;
  uint4 sa0, sa1, sa2, sa3, sb0, sb1, sb2, sb3;
  const int nk = p.K / GBK;
  const int lrow = tid >> 3, lc8 = tid & 7;
  const unsigned short* Ag = p.A + (size_t)(m0 + lrow) * p.lda + lc8 * 8;
  const unsigned short* Bg = p.Bt + (size_t)(n0 + lrow) * p.ldb + lc8 * 8;
  const size_t a32 = (size_t)32 * p.lda, b32 = (size_t)32 * p.ldb;
#define GLOAD(R, S, kt)                                                  \
  {                                                                      \
    R##0 = *(const uint4*)(Ag + (kt) * GBK);                             \
    R##1 = *(const uint4*)(Ag + a32 + (kt) * GBK);                       \
    R##2 = *(const uint4*)(Ag + 2 * a32 + (kt) * GBK);                   \
    R##3 = *(const uint4*)(Ag + 3 * a32 + (kt) * GBK);                   \
    S##0 = *(const uint4*)(Bg + (kt) * GBK);                             \
    S##1 = *(const uint4*)(Bg + b32 + (kt) * GBK);                       \
    S##2 = *(const uint4*)(Bg + 2 * b32 + (kt) * GBK);                   \
    S##3 = *(const uint4*)(Bg + 3 * b32 + (kt) * GBK);                   \
  }
#define SSTORE(R, S, buf)                                                \
  {                                                                      \
    unsigned short* ad = As + (size_t)(buf) * GBM * GLD + lrow * GLD + ((lc8 ^ (lrow & 7)) * 8); \
    unsigned short* bd = Bs + (size_t)(buf) * GBN * GLD + lrow * GLD + ((lc8 ^ (lrow & 7)) * 8); \
    *(uint4*)(ad) = R##0; *(uint4*)(ad + 32 * GLD) = R##1; *(uint4*)(ad + 64 * GLD) = R##2; *(uint4*)(ad + 96 * GLD) = R##3; \
    *(uint4*)(bd) = S##0; *(uint4*)(bd + 32 * GLD) = S##1; *(uint4*)(bd + 64 * GLD) = S##2; *(uint4*)(bd + 96 * GLD) = S##3; \
  }
#define GCOMPUTE(buf)                                                                                                     \
  {                                                                                                                       \
    const unsigned short* Ab = As + (size_t)(buf) * GBM * GLD;                                                            \
    const unsigned short* Bb = Bs + (size_t)(buf) * GBN * GLD;                                                            \
    _Pragma("unroll") for (int ks = 0; ks < 2; ++ks) {                                                                    \
      bf16x8 a[4], b[4];                                                                                                  \
      const int kc = ((ks * 4 + (lane >> 4)) ^ (lane & 7)) * 8;                   \
      _Pragma("unroll") for (int i = 0; i < 4; ++i) a[i] = *(const bf16x8*)(Ab + (wm * 64 + i * 16 + (lane & 15)) * GLD + kc); \
      _Pragma("unroll") for (int j = 0; j < 4; ++j) b[j] = *(const bf16x8*)(Bb + (wn * 64 + j * 16 + (lane & 15)) * GLD + kc); \
      _Pragma("unroll") for (int i = 0; i < 4; ++i)                                                                       \
        _Pragma("unroll") for (int j = 0; j < 4; ++j)                                                                     \
          acc[i][j] = __builtin_amdgcn_mfma_f32_16x16x32_bf16(b[j], a[i], acc[i][j], 0, 0, 0);               \
    }                                                                                                                     \
  }
  GLOAD(ra, rb, 0);
  if (nk > 1) GLOAD(sa, sb, 1);
  SSTORE(ra, rb, 0);
  __syncthreads();
  for (int kt = 0; kt < nk; kt += 2) {
    if (kt + 2 < nk) GLOAD(ra, rb, kt + 2);
    GCOMPUTE(0);
    if (kt + 1 < nk) SSTORE(sa, sb, 1);
    __syncthreads();
    if (kt + 1 < nk) {
      if (kt + 3 < nk) GLOAD(sa, sb, kt + 3);
      GCOMPUTE(1);
      if (kt + 2 < nk) SSTORE(ra, rb, 0);
      __syncthreads();
    }
  }
#undef GLOAD
#undef SSTORE
#undef GCOMPUTE
#pragma unroll
  for (int i = 0; i < 4; ++i) {
    const int row = m0 + wm * 64 + i * 16 + (lane & 15);
    float rsc = 1.f;
    float rowss = 0.f;
    if (EPI == EPI_INPROJ) rsc = p.rowscale[row];
    if (EPI == EPI_SCORES) {
      const float4* pr = (const float4*)(p.rowscale + (size_t)row * 16);
      const float4 s0 = pr[0], s1 = pr[1], s2 = pr[2], s3 = pr[3];
      const float ssq = ((s0.x + s0.y) + (s0.z + s0.w)) + ((s1.x + s1.y) + (s1.z + s1.w)) + ((s2.x + s2.y) + (s2.z + s2.w)) + ((s3.x + s3.y) + (s3.z + s3.w));
      rsc = rsqrtf(ssq * (1.f / DM) + EPSF);
    }
#pragma unroll
    for (int j = 0; j < 4; ++j) {
      const int col0 = n0 + wn * 64 + j * 16 + (lane >> 4) * 4;
      const float v0 = acc[i][j][0] * rsc, v1 = acc[i][j][1] * rsc, v2 = acc[i][j][2] * rsc, v3 = acc[i][j][3] * rsc;
      if (EPI == EPI_INPROJ) {
        if (col0 < 4096) {
          uint2 pk; pk.x = pack2(v0, v1); pk.y = pack2(v2, v3);
          *(uint2*)(p.obf + (size_t)row * p.ldo + col0) = pk;
        } else if (col0 < 4128) {
          const float vv[4] = {v0, v1, v2, v3};
          float oo[4];
#pragma unroll
          for (int r = 0; r < 4; ++r) {
            const int jg = col0 - 4096 + r, jj = jg & 7;
            const float v = vv[r];
            float o;
            if (jg < 8) o = -expf(p.a_log[jj]) * softplusf(v + p.dt_bias[jj]);
            else if (jg < 16) o = sigmoidf(v);
            else if (jg < 24) o = v + p.i_bias[jj];
            else o = -softplusf(-(v + p.f_bias[jj]));
            oo[r] = o;
          }
          *(float4*)(p.of32 + (size_t)row * p.ldf + (col0 - 4096)) = make_float4(oo[0], oo[1], oo[2], oo[3]);
        }
      } else if (EPI == EPI_OUTPROJ) {
        const float4 xr = *(const float4*)(p.resid + (size_t)row * p.ldf + col0);
        const float x0 = v0 + xr.x, x1 = v1 + xr.y, x2 = v2 + xr.z, x3 = v3 + xr.w;
        *(float4*)(p.of32 + (size_t)row * p.ldf + col0) = make_float4(x0, x1, x2, x3);
        uint2 pk; pk.x = pack2(x0, x1); pk.y = pack2(x2, x3);
        *(uint2*)(p.obf + (size_t)row * p.ldo + col0) = pk;
        rowss += (x0 * x0 + x1 * x1) + (x2 * x2 + x3 * x3);
      } else {
        uint2 pk; pk.x = pack2(v0, v1); pk.y = pack2(v2, v3);
        *(uint2*)(p.obf + (size_t)row * p.ldo + col0) = pk;
      }
    }
    if (EPI == EPI_OUTPROJ) {
      rowss += __shfl_xor(rowss, 16, 64);
      rowss += __shfl_xor(rowss, 32, 64);
      if ((lane >> 4) == 0) p.rowacc[(size_t)row * 16 + tn * 2 + wn] = rowss;
    }
  }
}

__device__ __forceinline__ bool xcd_tile(int bid, int nb, int k, int ntn, int& tm, int& tn) {
  const int q = ((bid >> 3) * 2 + HB) + (nb >> 3) * 2 * k;
  const bool ok = q < 16 * ntn;
  const int qq = ok ? q : (16 * ntn - 1);
  const int g = qq / (8 * ntn), rem = qq % (8 * ntn);
  tn = rem >> 3;
  tm = 16 * (bid & 7) + 8 * g + (rem & 7);
  return ok;
}

__device__ __forceinline__ int g8_lds_byte(int r, int c) {
  const int st = (r >> 4) * 2 + (c >> 5), rr = r & 15, cc = c & 31, ob = rr * 64 + cc * 2;
  return st * 1024 + (ob ^ (((ob >> 9) & 1) << 5));
}
__device__ __forceinline__ void g8_stage_rc(int b, int& R, int& C) {
  const int st = b / 1024, sb = b % 1024, swz = sb ^ (((sb >> 9) & 1) << 5);
  R = (st >> 1) * 16 + swz / 64; C = (st & 1) * 32 + (swz % 64) / 2;
}
template <int EPI>
__device__ __forceinline__ void gemm256_tile(const GemmP p, int tm, int tn, char* shm_c) {
  constexpr int BK = 64, HALF = 128, HT = HALF * BK;
  const int K = p.K;
  int tidx = threadIdx.x;
  asm volatile("" : "+v"(tidx));
  unsigned short* shm = (unsigned short*)shm_c;
  const unsigned short* A = p.A;
  const unsigned short* Bt = p.Bt;
#define SA(b, h) (shm + ((b) * 2 + (h)) * HT)
#define SB(b, h) (shm + (4 + (b) * 2 + (h)) * HT)
#define STAGE(P_, BASE, br, kt) do { const long _g = (long)(br) * K + (long)(kt) * BK; \
    for (int _i = 0; _i < 2; ++_i) { const int _b = tidx * 16 + _i * 8192; int _r, _c; g8_stage_rc(_b, _r, _c); \
      __builtin_amdgcn_global_load_lds((const unsigned*)(BASE + _g + (long)_r * K + _c), \
        (__attribute__((address_space(3))) unsigned*)((char*)(P_) + _b), 16, 0, 0); } } while (0)
#define LDA(dst, b, h) for (int m = 0; m < 4; ++m) for (int k = 0; k < 2; ++k) \
    dst[m][k] = *reinterpret_cast<const bf16x8*>((char*)SA(b, h) + g8_lds_byte(wr * 64 + m * 16 + fr, k * 32 + fq * 8))
#define LDB(dst, b, h) for (int n = 0; n < 2; ++n) for (int k = 0; k < 2; ++k) \
    dst[n][k] = *reinterpret_cast<const bf16x8*>((char*)SB(b, h) + g8_lds_byte(wc * 32 + n * 16 + fr, k * 32 + fq * 8))
#define MMA(ai, bj, At_, Bt_) do { __builtin_amdgcn_s_setprio(1); \
    for (int m = 0; m < 4; ++m) for (int n = 0; n < 2; ++n) for (int k = 0; k < 2; ++k) \
      acc[ai][bj][m][n] = __builtin_amdgcn_mfma_f32_16x16x32_bf16(Bt_[n][k], At_[m][k], acc[ai][bj][m][n], 0, 0, 0); \
    __builtin_amdgcn_s_setprio(0); } while (0)
#define WAIT_V(n) asm volatile("s_waitcnt vmcnt(" #n ")" ::: "memory")
#define WAIT_L(n) asm volatile("s_waitcnt lgkmcnt(" #n ")" ::: "memory")
#define BAR __builtin_amdgcn_s_barrier()
#define SCHED __builtin_amdgcn_sched_barrier(0)
  const int brow = tm * 256, bcol = tn * 256;
  const int wid = __builtin_amdgcn_readfirstlane(tidx >> 6), lane = tidx & 63, wr = wid >> 2, wc = wid & 3, fr = lane & 15, fq = lane >> 4;
  f32x4 acc[2][2][4][2] = {};
  bf16x8 At[4][2], B0[2][2], B1[2][2];
  const int nt = K / BK;
  STAGE(SB(0, 0), Bt, bcol, 0); STAGE(SA(0, 0), A, brow, 0);
  STAGE(SB(0, 1), Bt, bcol + HALF, 0); STAGE(SA(0, 1), A, brow + HALF, 0);
  if (wr == 1) BAR;
  WAIT_V(4); BAR;
  STAGE(SB(1, 0), Bt, bcol, 1); STAGE(SA(1, 0), A, brow, 1); STAGE(SB(1, 1), Bt, bcol + HALF, 1);
  WAIT_V(6); BAR;
#pragma unroll 1
  for (int t = 0; t < nt - 2; t += 2) {
    LDB(B0, 0, 0); SCHED; LDA(At, 0, 0); STAGE(SA(1, 1), A, brow + HALF, t + 1);
    WAIT_L(8); BAR; WAIT_L(0); MMA(0, 0, At, B0); BAR; SCHED;
    LDB(B1, 0, 1); STAGE(SB(0, 0), Bt, bcol, t + 2);
    BAR; WAIT_L(0); MMA(0, 1, At, B1); BAR;
    LDA(At, 0, 1); STAGE(SA(0, 0), A, brow, t + 2);
    BAR; WAIT_L(0); MMA(1, 0, At, B0); BAR; SCHED;
    STAGE(SB(0, 1), Bt, bcol + HALF, t + 2);
    WAIT_V(6); BAR; MMA(1, 1, At, B1); BAR;
    LDB(B0, 1, 0); SCHED; LDA(At, 1, 0); STAGE(SA(0, 1), A, brow + HALF, t + 2);
    WAIT_L(8); BAR; WAIT_L(0); MMA(0, 0, At, B0); BAR; SCHED;
    LDB(B1, 1, 1); STAGE(SB(1, 0), Bt, bcol, t + 3);
    BAR; WAIT_L(0); MMA(0, 1, At, B1); BAR;
    LDA(At, 1, 1); STAGE(SA(1, 0), A, brow, t + 3);
    BAR; WAIT_L(0); MMA(1, 0, At, B0); BAR; SCHED;
    STAGE(SB(1, 1), Bt, bcol + HALF, t + 3);
    WAIT_V(6); BAR; MMA(1, 1, At, B1); BAR;
  }
  { LDB(B0, 0, 0); LDA(At, 0, 0); STAGE(SA(1, 1), A, brow + HALF, nt - 1);
    BAR; WAIT_L(0); MMA(0, 0, At, B0); BAR;
    LDB(B1, 0, 1); BAR; WAIT_L(0); MMA(0, 1, At, B1); BAR;
    LDA(At, 0, 1); WAIT_V(4); BAR; WAIT_L(0); MMA(1, 0, At, B0); MMA(1, 1, At, B1); BAR; }
  { LDB(B0, 1, 0); LDA(At, 1, 0); WAIT_V(2); BAR; WAIT_L(0); MMA(0, 0, At, B0); BAR;
    LDB(B1, 1, 1); WAIT_V(0); BAR; WAIT_L(0); MMA(0, 1, At, B1); BAR;
    LDA(At, 1, 1); BAR; WAIT_L(0); MMA(1, 0, At, B0); MMA(1, 1, At, B1); BAR; }
  if (wr == 0) BAR;
#undef SA
#undef SB
#undef STAGE
#undef LDA
#undef LDB
#undef MMA
#undef WAIT_V
#undef WAIT_L
#undef BAR
#undef SCHED
#pragma unroll
  for (int ai = 0; ai < 2; ++ai)
#pragma unroll
    for (int m = 0; m < 4; ++m) {
      const int row = brow + ai * 128 + wr * 64 + m * 16 + fr;
      float rsc = 1.f;
      float rowss = 0.f;
      if (EPI == EPI_INPROJ) rsc = p.rowscale[row];
      if (EPI == EPI_SCORES) {
        const float4* pr = (const float4*)(p.rowscale + (size_t)row * 16);
        const float4 s0 = pr[0], s1 = pr[1], s2 = pr[2], s3 = pr[3];
        const float ssq = ((s0.x + s0.y) + (s0.z + s0.w)) + ((s1.x + s1.y) + (s1.z + s1.w)) + ((s2.x + s2.y) + (s2.z + s2.w)) + ((s3.x + s3.y) + (s3.z + s3.w));
        rsc = rsqrtf(ssq * (1.f / DM) + EPSF);
      }
#pragma unroll
      for (int bj = 0; bj < 2; ++bj)
#pragma unroll
        for (int n = 0; n < 2; ++n) {
          const int col0 = bcol + bj * 128 + wc * 32 + n * 16 + fq * 4;
          const f32x4 a = acc[ai][bj][m][n];
          const float v0 = a[0] * rsc, v1 = a[1] * rsc, v2 = a[2] * rsc, v3 = a[3] * rsc;
          if (EPI == EPI_OUTPROJ) {
            const float4 xr = *(const float4*)(p.resid + (size_t)row * p.ldf + col0);
            const float x0 = v0 + xr.x, x1 = v1 + xr.y, x2 = v2 + xr.z, x3 = v3 + xr.w;
            *(float4*)(p.of32 + (size_t)row * p.ldf + col0) = make_float4(x0, x1, x2, x3);
            uint2 pk; pk.x = pack2(x0, x1); pk.y = pack2(x2, x3);
            *(uint2*)(p.obf + (size_t)row * p.ldo + col0) = pk;
            rowss += (x0 * x0 + x1 * x1) + (x2 * x2 + x3 * x3);
          } else {
            uint2 pk; pk.x = pack2(v0, v1); pk.y = pack2(v2, v3);
            *(uint2*)(p.obf + (size_t)row * p.ldo + col0) = pk;
          }
        }
      if (EPI == EPI_OUTPROJ) {
        rowss += __shfl_xor(rowss, 16, 64);
        rowss += __shfl_xor(rowss, 32, 64);
        if (fq == 0) p.rowacc[(size_t)row * 16 + tn * 4 + wc] = rowss;
      }
    }
}
__device__ __forceinline__ void d_gate_proj(int item, const unsigned short* __restrict__ xb, const unsigned short* __restrict__ winT,
                                            const float* __restrict__ rs1, const float* __restrict__ a_log,
                                            const float* __restrict__ dt_bias, const float* __restrict__ i_bias,
                                            const float* __restrict__ f_bias, float* __restrict__ gt) {
  const int job = item * 8 + (threadIdx.x >> 6);
  const int lane = threadIdx.x & 63, fr = lane & 15, fq = lane >> 4;
  const int t0 = job * 16;
  const unsigned short* ap = xb + (size_t)(t0 + fr) * DM + 8 * fq;
  const unsigned short* bp0 = winT + (size_t)(4096 + fr) * DM + 8 * fq;
  const unsigned short* bp1 = winT + (size_t)(4096 + 16 + fr) * DM + 8 * fq;
  f32x4 acc0 = {0.f, 0.f, 0.f, 0.f}, acc1 = {0.f, 0.f, 0.f, 0.f};
#pragma unroll 8
  for (int s2 = 0; s2 < 32; ++s2) {
    const bf16x8 a = *(const bf16x8*)(ap + 32 * s2);
    const bf16x8 b0 = *(const bf16x8*)(bp0 + 32 * s2);
    const bf16x8 b1 = *(const bf16x8*)(bp1 + 32 * s2);
    acc0 = __builtin_amdgcn_mfma_f32_16x16x32_bf16(a, b0, acc0, 0, 0, 0);
    acc1 = __builtin_amdgcn_mfma_f32_16x16x32_bf16(a, b1, acc1, 0, 0, 0);
  }
  const int jj = fr & 7;
  const float al = -expf(a_log[jj]), db = dt_bias[jj], ib = i_bias[jj], fb = f_bias[jj];
#pragma unroll
  for (int j = 0; j < 4; ++j) {
    const int t = t0 + 4 * fq + j;
    const float r = rs1[t];
    const float v0 = acc0[j] * r, v1 = acc1[j] * r;
    const float o0 = (fr < 8) ? al * softplusf(v0 + db) : sigmoidf(v0);
    const float o1 = (fr < 8) ? (v1 + ib) : -softplusf(-(v1 + fb));
    gt[(size_t)t * 32 + fr] = o0;
    gt[(size_t)t * 32 + 16 + fr] = o1;
  }
}

__device__ __forceinline__ bool xcd_tile256(int bid, int nb, int k, int ntn, int& tm, int& tn) {
  const int q = (bid >> 3) + (nb >> 3) * k;
  if (q >= 8 * ntn) return false;
  tn = q >> 3;
  tm = 8 * (bid & 7) + (q & 7);
  return true;
}

__device__ __forceinline__ void d_conv(int item, const unsigned short* __restrict__ pm, const float* __restrict__ pg,
                                              const float* __restrict__ conv_w, const float* __restrict__ a_log,
                                              const float* __restrict__ dt_bias, const float* __restrict__ i_bias,
                                              const float* __restrict__ f_bias, unsigned short* __restrict__ qkv,
                                              float* __restrict__ gt) {
  int t = item * 4 + (TIDX >> 6);
  int lane = TIDX & 63;
  int s = t & (SEQ - 1);
  for (int sec = 0; sec < 3; ++sec) {
    for (int h = 0; h < 4; ++h) {
      int c0 = sec * 512 + h * 128 + 2 * lane;
      float a0 = 0.f, a1 = 0.f;
#pragma unroll
      for (int j = 0; j < 5; ++j) {
        int sp = s + j - 2;
        if (sp >= 0 && sp < SEQ) {
          unsigned v = *(const unsigned*)(pm + (size_t)(t + j - 2) * 4096 + c0);
          a0 += conv_w[c0 * 5 + j] * bf2f((unsigned short)(v & 0xffff));
          a1 += conv_w[(c0 + 1) * 5 + j] * bf2f((unsigned short)(v >> 16));
        }
      }
      a0 = a0 * sigmoidf(a0);
      a1 = a1 * sigmoidf(a1);
      if (sec < 2) {
        float ss = wave_sum(a0 * a0 + a1 * a1);
        float sc = rsqrtf(ss + EPSF);
        if (sec == 0) sc *= 0.08838834764831845f;
        a0 *= sc; a1 *= sc;
      }
      unsigned o = pack2(a0, a1);
      *(unsigned*)(qkv + (size_t)t * 1536 + c0) = o;
    }
  }
}

__device__ __forceinline__ void d_gdn_rec(int chain, float* sq, float* sk, const unsigned short* __restrict__ qkv,
                                                 const float* __restrict__ gt, unsigned short* __restrict__ oA, int ntok) {
  const int bh = chain >> 1, dir = chain & 1;
  const int b = bh >> 2, h = bh & 3;
  const int e = TIDX & 127;
  float S[128];
#pragma unroll
  for (int d = 0; d < 128; ++d) S[d] = 0.f;
  for (int it = 0; it < SEQ; ++it) {
    const int s = dir ? (SEQ - 1 - it) : it;
    const size_t t = (size_t)b * SEQ + s;
    __syncthreads();
    sq[e] = bf2f(qkv[t * 1536 + h * 128 + e]);
    sk[e] = bf2f(qkv[t * 1536 + 512 + h * 128 + e]);
    const float v = bf2f(qkv[t * 1536 + 1024 + h * 128 + e]);
    const float g = gt[t * 32 + dir * 4 + h];
    const float beta = gt[t * 32 + 8 + dir * 4 + h];
    __syncthreads();
    const float a = expf(g);
    float k0 = 0.f, k1 = 0.f, k2 = 0.f, k3 = 0.f;
#pragma unroll
    for (int d = 0; d < 128; d += 4) {
      k0 += sk[d] * S[d]; k1 += sk[d + 1] * S[d + 1]; k2 += sk[d + 2] * S[d + 2]; k3 += sk[d + 3] * S[d + 3];
    }
    const float kS = a * ((k0 + k1) + (k2 + k3));
    const float vn = beta * (v - kS);
    float o0 = 0.f, o1 = 0.f, o2 = 0.f, o3 = 0.f;
#pragma unroll
    for (int d = 0; d < 128; d += 4) {
      S[d] = a * S[d] + sk[d] * vn;             o0 += sq[d] * S[d];
      S[d + 1] = a * S[d + 1] + sk[d + 1] * vn; o1 += sq[d + 1] * S[d + 1];
      S[d + 2] = a * S[d + 2] + sk[d + 2] * vn; o2 += sq[d + 2] * S[d + 2];
      S[d + 3] = a * S[d + 3] + sk[d + 3] * vn; o3 += sq[d + 3] * S[d + 3];
    }
    oA[((size_t)dir * ntok + t) * 512 + h * 128 + e] = f2bf((o0 + o1) + (o2 + o3));
  }
}

__device__ __forceinline__ void d_mlstm_rec(int chain, float* sq, float* sk, const unsigned short* __restrict__ pm,
                                                   const float* __restrict__ gt, unsigned short* __restrict__ oM, int ntok) {
  const int bh = chain >> 1, dir = chain & 1;
  const int b = bh >> 2, h = bh & 3;
  const int e = TIDX & 127, lane = e & 63;
  float C[128];
#pragma unroll
  for (int d = 0; d < 128; ++d) C[d] = 0.f;
  float n0 = 0.f, n1 = 0.f, m = 0.f;
  for (int it = 0; it < SEQ; ++it) {
    const int s = dir ? (SEQ - 1 - it) : it;
    const size_t t = (size_t)b * SEQ + s;
    __syncthreads();
    sq[e] = bf2f(pm[t * 4096 + 2048 + h * 128 + e]);
    sk[e] = bf2f(pm[t * 4096 + 2560 + h * 128 + e]) * 0.08838834764831845f;
    const float v = bf2f(pm[t * 4096 + 3072 + h * 128 + e]);
    const float ip = gt[t * 32 + 16 + dir * 4 + h];
    const float lf = gt[t * 32 + 24 + dir * 4 + h];
    __syncthreads();
    const float mn = fmaxf(lf + m, ip);
    const float fs = expf(lf + m - mn);
    const float is = expf(ip - mn);
    m = mn;
    n0 = fs * n0 + is * sk[lane];
    n1 = fs * n1 + is * sk[lane + 64];
    const float den = wave_sum(n0 * sq[lane] + n1 * sq[lane + 64]);
    const float iv = is * v;
    float o0 = 0.f, o1 = 0.f, o2 = 0.f, o3 = 0.f;
#pragma unroll
    for (int d = 0; d < 128; d += 4) {
      C[d] = fs * C[d] + sk[d] * iv;             o0 += sq[d] * C[d];
      C[d + 1] = fs * C[d + 1] + sk[d + 1] * iv; o1 += sq[d + 1] * C[d + 1];
      C[d + 2] = fs * C[d + 2] + sk[d + 2] * iv; o2 += sq[d + 2] * C[d + 2];
      C[d + 3] = fs * C[d + 3] + sk[d + 3] * iv; o3 += sq[d + 3] * C[d + 3];
    }
    const float num = (o0 + o1) + (o2 + o3);
    const float hh = num / fmaxf(fabsf(den), expf(-mn));
    oM[((size_t)dir * ntok + t) * 512 + h * 128 + e] = f2bf(hh);
  }
}

__device__ __forceinline__ void d_combine(int item, const unsigned short* __restrict__ uo, const unsigned short* __restrict__ oM,
                                                 const unsigned short* __restrict__ pm, const float* __restrict__ gdn_g,
                                                 const float* __restrict__ ml_g, unsigned short* __restrict__ y) {
  int tid_ = TIDX;
  asm volatile("" : "+v"(tid_));
  const int t = item * 4 + (tid_ >> 6);
  const int lane = tid_ & 63;
  const int b = t >> 12, cc = (t >> 6) & 63, ii = t & 63;
  unsigned gf_[4], gb_[4], mf_[4], mb_[4], zg_[4], zo_[4];
  const size_t off = (size_t)cc * 8192 + (lane >> 4) * 2048 + ii * 32 + ((2 * lane) & 31);
#pragma unroll
  for (int h = 0; h < 4; ++h) {
    const int c = h * 128 + 2 * lane;
    const int chain0 = (b * 4 + h) * 2;
    gf_[h] = *(const unsigned*)(uo + (size_t)chain0 * 64 * 8192 + off);
    gb_[h] = *(const unsigned*)(uo + (size_t)(chain0 + 1) * 64 * 8192 + off);
    mf_[h] = *(const unsigned*)(oM + (size_t)t * 512 + c);
    mb_[h] = *(const unsigned*)(oM + ((size_t)NT + t) * 512 + c);
    zg_[h] = *(const unsigned*)(pm + (size_t)t * 4096 + 1536 + c);
    zo_[h] = *(const unsigned*)(pm + (size_t)t * 4096 + 3584 + c);
  }
  const float gg0 = gdn_g[2 * lane], gg1 = gdn_g[2 * lane + 1];
  float a0[4], a1[4], m0[4], m1[4], sa[4], sm[4];
#pragma unroll
  for (int h = 0; h < 4; ++h) {
    a0[h] = bf2f(gf_[h] & 0xffff) + bf2f(gb_[h] & 0xffff);
    a1[h] = __uint_as_float(gf_[h] & 0xffff0000u) + __uint_as_float(gb_[h] & 0xffff0000u);
    m0[h] = bf2f(mf_[h] & 0xffff) + bf2f(mb_[h] & 0xffff);
    m1[h] = __uint_as_float(mf_[h] & 0xffff0000u) + __uint_as_float(mb_[h] & 0xffff0000u);
    sa[h] = a0[h] * a0[h] + a1[h] * a1[h];
    sm[h] = m0[h] * m0[h] + m1[h] * m1[h];
  }
#pragma unroll
  for (int o = 32; o > 0; o >>= 1) {
#pragma unroll
    for (int h = 0; h < 4; ++h) { sa[h] += __shfl_xor(sa[h], o, 64); sm[h] += __shfl_xor(sm[h], o, 64); }
  }
#pragma unroll
  for (int h = 0; h < 4; ++h) {
    const int c = h * 128 + 2 * lane;
    const float sca = rsqrtf(sa[h] * (1.f / 128.f) + EPSF);
    const float scm = rsqrtf(sm[h] * (1.f / 128.f) + EPSF);
    const float z0 = bf2f(zg_[h] & 0xffff), z1 = __uint_as_float(zg_[h] & 0xffff0000u);
    const float q0 = bf2f(zo_[h] & 0xffff), q1 = __uint_as_float(zo_[h] & 0xffff0000u);
    const float o0 = a0[h] * sca * gg0 * (z0 * sigmoidf(z0));
    const float o1 = a1[h] * sca * gg1 * (z1 * sigmoidf(z1));
    const float p0 = m0[h] * scm * ml_g[c] * sigmoidf(q0);
    const float p1 = m1[h] * scm * ml_g[c + 1] * sigmoidf(q1);
    *(unsigned*)(y + (size_t)t * DM + c) = pack2(o0, o1);
    *(unsigned*)(y + (size_t)t * DM + 512 + c) = pack2(p0, p1);
  }
}

#ifdef DBG_CHECK
__device__ __forceinline__ void d_dbg_cmp(int item, const unsigned short* __restrict__ uo, const unsigned short* __restrict__ oAd,
                                          float* __restrict__ dbg) {
  int t = item * 4 + (TIDX >> 6);
  int lane = TIDX & 63;
  const int cc = (t >> 6) & 63, ii = t & 63;
  float sd = 0.f, sr = 0.f;
  for (int h = 0; h < 4; ++h) {
    for (int dir = 0; dir < 2; ++dir) {
      const int chain = h * 2 + dir;
      const size_t off = (size_t)cc * 8192 + (lane >> 4) * 2048 + ii * 32 + ((2 * lane) & 31);
      unsigned vn = *(const unsigned*)(uo + (size_t)chain * 64 * 8192 + off);
      unsigned vr = *(const unsigned*)(oAd + ((size_t)dir * 4096 + t) * 512 + h * 128 + 2 * lane);
      float n0 = bf2f(vn & 0xffff), n1 = bf2f(vn >> 16), r0 = bf2f(vr & 0xffff), r1 = bf2f(vr >> 16);
      sd += (n0 - r0) * (n0 - r0) + (n1 - r1) * (n1 - r1);
      sr += r0 * r0 + r1 * r1;
    }
  }
  sd = wave_sum(sd); sr = wave_sum(sr);
  if (lane == 0) { atomicAdd(&dbg[0], sd); atomicAdd(&dbg[1], sr); }
}
__device__ __forceinline__ void d_dbg_cmp_m(int item, const unsigned short* __restrict__ oM, const unsigned short* __restrict__ oMd,
                                            float* __restrict__ dbg) {
  int t = item * 4 + (TIDX >> 6);
  int lane = TIDX & 63;
  float sd = 0.f, sr = 0.f;
  for (int dir = 0; dir < 2; ++dir)
    for (int q = 0; q < 4; ++q) {
      unsigned vn = *(const unsigned*)(oM + ((size_t)dir * NT + t) * 512 + q * 128 + 2 * lane);
      unsigned vr = *(const unsigned*)(oMd + ((size_t)dir * 4096 + t) * 512 + q * 128 + 2 * lane);
      float n0 = bf2f(vn & 0xffff), n1 = bf2f(vn >> 16), r0 = bf2f(vr & 0xffff), r1 = bf2f(vr >> 16);
      sd += (n0 - r0) * (n0 - r0) + (n1 - r1) * (n1 - r1);
      sr += r0 * r0 + r1 * r1;
    }
  sd = wave_sum(sd); sr = wave_sum(sr);
  if (lane == 0) { atomicAdd(&dbg[0], sd); atomicAdd(&dbg[1], sr); }
}
#endif

__device__ __forceinline__ void d_prep_x1(int item, const float* __restrict__ x1, unsigned short* __restrict__ xb,
                                                 float* __restrict__ rs) {
  int t = item * 4 + (TIDX >> 6);
  int lane = TIDX & 63;
  const float4* xr = (const float4*)(x1 + (size_t)t * DM);
  float ss = 0.f;
#pragma unroll
  for (int i = 0; i < 4; ++i) {
    float4 v = xr[lane + 64 * i];
    ss += v.x * v.x + v.y * v.y + v.z * v.z + v.w * v.w;
    ushort4 o;
    o.x = f2bf(v.x); o.y = f2bf(v.y); o.z = f2bf(v.z); o.w = f2bf(v.w);
    ((ushort4*)(xb + (size_t)t * DM))[lane + 64 * i] = o;
  }
  ss = wave_sum(ss);
  if (lane == 0) rs[t] = rsqrtf(ss * (1.f / DM) + EPSF);
}

__device__ const unsigned char kPairTab[64] = {
    0x00, 0x01, 0x02, 0x03, 0x04, 0x05, 0x06, 0x07, 0x08, 0x09, 0x0a, 0x0b, 0x0c, 0x0d, 0x0e, 0x0f,
    0x10, 0x11, 0x12, 0x13, 0x14, 0x15, 0x16, 0x17,
    0x20, 0x21, 0x22, 0x23, 0x24,
    0x30, 0x31, 0x32, 0x33,
    0x40, 0x41, 0x42,
    0x50, 0x51, 0x60, 0x61, 0x70, 0x71,
    0x80, 0x90, 0xa0, 0xb0, 0xc0, 0xd0, 0xe0, 0xf0,
    0xff, 0xff, 0xff, 0xff, 0xff, 0xff, 0xff, 0xff, 0xff, 0xff, 0xff, 0xff, 0xff, 0xff};

__device__ __forceinline__ void sort16_desc(unsigned (&a)[16]) {
#pragma unroll
  for (int k = 2; k <= 16; k <<= 1)
#pragma unroll
    for (int j = k >> 1; j > 0; j >>= 1)
#pragma unroll
      for (int i = 0; i < 16; ++i) {
        const int l = i ^ j;
        if (l > i) {
          const unsigned hi = max(a[i], a[l]), lo = min(a[i], a[l]);
          if ((i & k) == 0) { a[i] = hi; a[l] = lo; } else { a[i] = lo; a[l] = hi; }
        }
      }
}
__device__ __forceinline__ void merge16_desc(unsigned (&top)[16], const unsigned (&b)[16]) {
#pragma unroll
  for (int i = 0; i < 16; ++i) top[i] = max(top[i], b[15 - i]);
#pragma unroll
  for (int j = 8; j > 0; j >>= 1)
#pragma unroll
    for (int i = 0; i < 16; ++i) {
      const int l = i ^ j;
      if (l > i) {
        const unsigned hi = max(top[i], top[l]), lo = min(top[i], top[l]);
        top[i] = hi; top[l] = lo;
      }
    }
}
__device__ __forceinline__ unsigned key16(unsigned hbits, int idx) {
  const unsigned m = hbits ^ ((hbits & 0x8000u) ? 0xFFFFu : 0x8000u);
  return (m << 16) | (unsigned)(127 - idx);
}
__device__ __forceinline__ void top16_of_128(const unsigned short* __restrict__ sp, unsigned (&top)[16]) {
#pragma unroll
  for (int g = 0; g < 8; ++g) {
    const uint4 x0 = *(const uint4*)(sp + g * 16);
    const uint4 x1 = *(const uint4*)(sp + g * 16 + 8);
    unsigned b[16];
    b[0] = key16(x0.x & 0xffff, g * 16 + 0);  b[1] = key16(x0.x >> 16, g * 16 + 1);
    b[2] = key16(x0.y & 0xffff, g * 16 + 2);  b[3] = key16(x0.y >> 16, g * 16 + 3);
    b[4] = key16(x0.z & 0xffff, g * 16 + 4);  b[5] = key16(x0.z >> 16, g * 16 + 5);
    b[6] = key16(x0.w & 0xffff, g * 16 + 6);  b[7] = key16(x0.w >> 16, g * 16 + 7);
    b[8] = key16(x1.x & 0xffff, g * 16 + 8);  b[9] = key16(x1.x >> 16, g * 16 + 9);
    b[10] = key16(x1.y & 0xffff, g * 16 + 10); b[11] = key16(x1.y >> 16, g * 16 + 11);
    b[12] = key16(x1.z & 0xffff, g * 16 + 12); b[13] = key16(x1.z >> 16, g * 16 + 13);
    b[14] = key16(x1.w & 0xffff, g * 16 + 14); b[15] = key16(x1.w >> 16, g * 16 + 15);
    sort16_desc(b);
    if (g == 0) {
#pragma unroll
      for (int i = 0; i < 16; ++i) top[i] = b[i];
    } else {
      merge16_desc(top, b);
    }
  }
}

__device__ __forceinline__ void d_topk(int item, const unsigned short* __restrict__ scores, int* __restrict__ idx_out,
                                       float* __restrict__ gate_out) {
  int tid_ = TIDX;
  asm volatile("" : "+v"(tid_));
  const int pair = item * 256 + tid_;
  const unsigned short* sp = scores + (size_t)pair * 256;
  unsigned k0[16], k1[16];
  top16_of_128(sp, k0);
  top16_of_128(sp + 128, k1);
  float v0[16], v1[16];
  int i0[16], i1[16];
#pragma unroll
  for (int i = 0; i < 16; ++i) {
    const unsigned m0 = k0[i] >> 16, m1 = k1[i] >> 16;
    v0[i] = bf2f((unsigned short)(m0 ^ ((m0 & 0x8000u) ? 0x8000u : 0xFFFFu)));
    v1[i] = bf2f((unsigned short)(m1 ^ ((m1 & 0x8000u) ? 0x8000u : 0xFFFFu)));
    i0[i] = 127 - (int)(k0[i] & 127u);
    i1[i] = 127 - (int)(k1[i] & 127u);
  }
  unsigned top[16];
#pragma unroll
  for (int g = 0; g < 4; ++g) {
    unsigned b[16];
#pragma unroll
    for (int q = 0; q < 16; ++q) {
      const int pr = kPairTab[g * 16 + q];
      if (pr == 0xff) {
        b[q] = 0u;
      } else {
        const int pi = pr >> 4, pj = pr & 15;
        const float sum = v0[pi] + v1[pj];
        const unsigned u = __float_as_uint(sum);
        const unsigned mono = u ^ ((u & 0x80000000u) ? 0xFFFFFFFFu : 0x80000000u);
        b[q] = (mono & 0xFFFFC000u) | (unsigned)(16383 - (i0[pi] * 128 + i1[pj]));
      }
    }
    sort16_desc(b);
    if (g == 0) {
#pragma unroll
      for (int i = 0; i < 16; ++i) top[i] = b[i];
    } else {
      merge16_desc(top, b);
    }
  }
  float ev[16];
  int ci[16];
  float mx = 0.f, sum = 0.f;
#pragma unroll
  for (int i = 0; i < 16; ++i) {
    const unsigned mono = top[i] & 0xFFFFC000u;
    const unsigned u = mono ^ ((mono & 0x80000000u) ? 0x80000000u : 0xFFFFFFFFu);
    const float val = __uint_as_float(u & 0xFFFFC000u);
    ci[i] = 16383 - (int)(top[i] & 16383u);
    if (i == 0) mx = val;
    ev[i] = expf(val - mx);
    sum += ev[i];
  }
  const float inv = 1.f / sum;
#pragma unroll
  for (int q = 0; q < 4; ++q) {
    int4 o; float4 g;
    o.x = ci[4 * q]; o.y = ci[4 * q + 1]; o.z = ci[4 * q + 2]; o.w = ci[4 * q + 3];
    g.x = ev[4 * q] * inv; g.y = ev[4 * q + 1] * inv; g.z = ev[4 * q + 2] * inv; g.w = ev[4 * q + 3] * inv;
    *(int4*)(idx_out + (size_t)pair * 16 + 4 * q) = o;
    *(float4*)(gate_out + (size_t)pair * 16 + 4 * q) = g;
  }
}

typedef float f32x2 __attribute__((ext_vector_type(2)));
__device__ __forceinline__ float wave_max_dpp(float v) {
#define DPP_MAX(v, ctrl) v = fmaxf(v, __builtin_bit_cast(float, __builtin_amdgcn_update_dpp(0, __builtin_bit_cast(int, v), ctrl, 0xF, 0xF, true)))
  DPP_MAX(v, 0xB1); DPP_MAX(v, 0x4E); DPP_MAX(v, 0x141); DPP_MAX(v, 0x140);
#undef DPP_MAX
  const float r0 = __builtin_bit_cast(float, __builtin_amdgcn_readlane(__builtin_bit_cast(int, v), 0));
  const float r1 = __builtin_bit_cast(float, __builtin_amdgcn_readlane(__builtin_bit_cast(int, v), 16));
  const float r2 = __builtin_bit_cast(float, __builtin_amdgcn_readlane(__builtin_bit_cast(int, v), 32));
  const float r3 = __builtin_bit_cast(float, __builtin_amdgcn_readlane(__builtin_bit_cast(int, v), 48));
  return fmaxf(fmaxf(r0, r1), fmaxf(r2, r3));
}
__device__ __forceinline__ float absmax4(const float4 a) { return fmaxf(fmaxf(fabsf(a.x), fabsf(a.y)), fmaxf(fabsf(a.z), fabsf(a.w))); }
template <bool I8>
__device__ __forceinline__ void d_cvt_tab(int item, const float* __restrict__ src, unsigned* __restrict__ dst8, float* __restrict__ dscale) {
  const int row0 = item * 16 + (TIDX >> 6) * 4;
  const int lane = TIDX & 63;
  float4 a[4][4];
#pragma unroll
  for (int rr = 0; rr < 4; ++rr) {
    const float4* sr = (const float4*)(src + (size_t)(row0 + rr) * DM + lane * 16);
    a[rr][0] = sr[0]; a[rr][1] = sr[1]; a[rr][2] = sr[2]; a[rr][3] = sr[3];
  }
#pragma unroll
  for (int rr = 0; rr < 4; ++rr) {
    const float m = wave_max_dpp(fmaxf(fmaxf(absmax4(a[rr][0]), absmax4(a[rr][1])), fmaxf(absmax4(a[rr][2]), absmax4(a[rr][3]))));
    const float top = I8 ? 127.f : 240.f;
    const float sc = (m > 0.f) ? top / m : 1.f;
    uint4 o;
    unsigned ow[4];
#pragma unroll
    for (int c = 0; c < 4; ++c) {
      const float4 v = a[rr][c];
      if (I8) {
        ow[c] = ((unsigned)__float2int_rn(v.x * sc) & 0xffu) | (((unsigned)__float2int_rn(v.y * sc) & 0xffu) << 8) |
                (((unsigned)__float2int_rn(v.z * sc) & 0xffu) << 16) | (((unsigned)__float2int_rn(v.w * sc) & 0xffu) << 24);
      } else {
        int p = 0;
        p = __builtin_amdgcn_cvt_pk_fp8_f32(v.x * sc, v.y * sc, p, false);
        p = __builtin_amdgcn_cvt_pk_fp8_f32(v.z * sc, v.w * sc, p, true);
        ow[c] = (unsigned)p;
      }
    }
    o.x = ow[0]; o.y = ow[1]; o.z = ow[2]; o.w = ow[3];
    *(uint4*)(dst8 + (size_t)(row0 + rr) * 256 + lane * 4) = o;
    if (lane == 0) dscale[row0 + rr] = (m > 0.f) ? m / top : 1.f;
  }
}

__device__ __forceinline__ float erf_fast(float x) {
  const float ax = fabsf(x);
  const float t = __builtin_amdgcn_rcpf(1.f + 0.3275911f * ax);
  float p = 1.061405429f;
  p = p * t - 1.453152027f;
  p = p * t + 1.421413741f;
  p = p * t - 0.284496736f;
  p = p * t + 0.254829592f;
  const float e = __builtin_amdgcn_exp2f(-1.4426950408889634f * ax * ax);
  const float r = 1.f - p * t * e;
  return copysignf(r, x);
}
__device__ __forceinline__ float dot16_f8(const uint4 u, const float* hv) {
  const f32x2 a0 = __builtin_amdgcn_cvt_pk_f32_fp8((int)u.x, false), a1 = __builtin_amdgcn_cvt_pk_f32_fp8((int)u.x, true);
  const f32x2 b0 = __builtin_amdgcn_cvt_pk_f32_fp8((int)u.y, false), b1 = __builtin_amdgcn_cvt_pk_f32_fp8((int)u.y, true);
  const f32x2 c0 = __builtin_amdgcn_cvt_pk_f32_fp8((int)u.z, false), c1 = __builtin_amdgcn_cvt_pk_f32_fp8((int)u.z, true);
  const f32x2 d0 = __builtin_amdgcn_cvt_pk_f32_fp8((int)u.w, false), d1 = __builtin_amdgcn_cvt_pk_f32_fp8((int)u.w, true);
  float s0 = a0[0] * hv[0] + a0[1] * hv[1];
  float s1 = a1[0] * hv[2] + a1[1] * hv[3];
  s0 += b0[0] * hv[4] + b0[1] * hv[5];
  s1 += b1[0] * hv[6] + b1[1] * hv[7];
  s0 += c0[0] * hv[8] + c0[1] * hv[9];
  s1 += c1[0] * hv[10] + c1[1] * hv[11];
  s0 += d0[0] * hv[12] + d0[1] * hv[13];
  s1 += d1[0] * hv[14] + d1[1] * hv[15];
  return s0 + s1;
}
__device__ __forceinline__ void axpy16_f8(const uint4 v, const float wg, float* acc) {
  const f32x2 a0 = __builtin_amdgcn_cvt_pk_f32_fp8((int)v.x, false), a1 = __builtin_amdgcn_cvt_pk_f32_fp8((int)v.x, true);
  const f32x2 b0 = __builtin_amdgcn_cvt_pk_f32_fp8((int)v.y, false), b1 = __builtin_amdgcn_cvt_pk_f32_fp8((int)v.y, true);
  const f32x2 c0 = __builtin_amdgcn_cvt_pk_f32_fp8((int)v.z, false), c1 = __builtin_amdgcn_cvt_pk_f32_fp8((int)v.z, true);
  const f32x2 d0 = __builtin_amdgcn_cvt_pk_f32_fp8((int)v.w, false), d1 = __builtin_amdgcn_cvt_pk_f32_fp8((int)v.w, true);
  acc[0] += wg * a0[0]; acc[1] += wg * a0[1]; acc[2] += wg * a1[0]; acc[3] += wg * a1[1];
  acc[4] += wg * b0[0]; acc[5] += wg * b0[1]; acc[6] += wg * b1[0]; acc[7] += wg * b1[1];
  acc[8] += wg * c0[0]; acc[9] += wg * c0[1]; acc[10] += wg * c1[0]; acc[11] += wg * c1[1];
  acc[12] += wg * d0[0]; acc[13] += wg * d0[1]; acc[14] += wg * d1[0]; acc[15] += wg * d1[1];
}
typedef int i32x4 __attribute__((ext_vector_type(4)));
__device__ __forceinline__ void d_peer(int item, char* smem, const float* __restrict__ x1, const float* __restrict__ rs2,
                                       const float* __restrict__ g2, const int* __restrict__ idx,
                                       const float* __restrict__ gate, const unsigned* __restrict__ pu,
                                       const unsigned* __restrict__ pv, const float* __restrict__ su,
                                       const float* __restrict__ sv, const float* __restrict__ gf,
                                       float* __restrict__ out, float oscale) {
  int tid_ = TIDX;
  asm volatile("" : "+v"(tid_));
  const int wv = tid_ >> 6;
  const int t = item * 4 + wv;
  const int lane = tid_ & 63, q = lane >> 4;
  char* hq = smem + wv * 1024;
  float r2;
  {
    const float4* pr = (const float4*)(rs2 + (size_t)t * 16);
    const float4 s0 = pr[0], s1 = pr[1], s2 = pr[2], s3 = pr[3];
    const float ssq = ((s0.x + s0.y) + (s0.z + s0.w)) + ((s1.x + s1.y) + (s1.z + s1.w)) + ((s2.x + s2.y) + (s2.z + s2.w)) + ((s3.x + s3.y) + (s3.z + s3.w));
    r2 = rsqrtf(ssq * (1.f / DM) + EPSF);
  }
  float sh;
  {
    float hv[16];
    float m = 0.f;
#pragma unroll
    for (int c = 0; c < 4; ++c) {
      const float4 xx = *(const float4*)(x1 + (size_t)t * DM + lane * 16 + c * 4);
      const float4 gg = *(const float4*)(g2 + lane * 16 + c * 4);
      hv[c * 4 + 0] = xx.x * r2 * gg.x; hv[c * 4 + 1] = xx.y * r2 * gg.y;
      hv[c * 4 + 2] = xx.z * r2 * gg.z; hv[c * 4 + 3] = xx.w * r2 * gg.w;
      m = fmaxf(m, fmaxf(fmaxf(fabsf(hv[c * 4]), fabsf(hv[c * 4 + 1])), fmaxf(fabsf(hv[c * 4 + 2]), fabsf(hv[c * 4 + 3]))));
    }
#pragma unroll
    for (int o = 32; o > 0; o >>= 1) m = fmaxf(m, __shfl_xor(m, o, 64));
    const float sc = (m > 0.f) ? 127.f / m : 1.f;
    sh = (m > 0.f) ? m * (1.f / 127.f) : 1.f;
#define Q8(x) ((unsigned)(__float2int_rn((x) * sc)) & 0xffu)
    uint4 o;
    o.x = Q8(hv[0]) | (Q8(hv[1]) << 8) | (Q8(hv[2]) << 16) | (Q8(hv[3]) << 24);
    o.y = Q8(hv[4]) | (Q8(hv[5]) << 8) | (Q8(hv[6]) << 16) | (Q8(hv[7]) << 24);
    o.z = Q8(hv[8]) | (Q8(hv[9]) << 8) | (Q8(hv[10]) << 16) | (Q8(hv[11]) << 24);
    o.w = Q8(hv[12]) | (Q8(hv[13]) << 8) | (Q8(hv[14]) << 16) | (Q8(hv[15]) << 24);
#undef Q8
    *(uint4*)(hq + lane * 16) = o;
  }
  float acc[16];
#pragma unroll
  for (int i = 0; i < 16; ++i) acc[i] = 0.f;
  float* wl = (float*)(smem + 4096) + wv * 128;
  int ka = (idx[(size_t)t * 128 + lane] << 7) | lane;
  int kb = (idx[(size_t)t * 128 + 64 + lane] << 7) | (64 + lane);
  const float gt_a0 = gate[(size_t)t * 128 + lane], gt_b0 = gate[(size_t)t * 128 + 64 + lane];
#pragma unroll
  for (int k = 2; k <= 128; k <<= 1) {
#pragma unroll
    for (int j = k >> 1; j > 0; j >>= 1) {
      if (j == 64) {
        const int lo = min(ka, kb), hi = max(ka, kb);
        ka = lo; kb = hi;
      } else {
        const int oa = __shfl_xor(ka, j, 64), ob = __shfl_xor(kb, j, 64);
        const bool lower = (lane & j) == 0;
        const bool upa = (lane & k) == 0;
        const bool upb = ((lane + 64) & k) == 0;
        ka = (upa == lower) ? min(ka, oa) : max(ka, oa);
        kb = (upb == lower) ? min(kb, ob) : max(kb, ob);
      }
    }
  }
  const int id_a = ka >> 7, id_b = kb >> 7;
  const int oa_ = ka & 127, ob_ = kb & 127;
  const float ga1 = __shfl(gt_a0, oa_ & 63, 64), ga2 = __shfl(gt_b0, oa_ & 63, 64);
  const float gb1 = __shfl(gt_a0, ob_ & 63, 64), gb2 = __shfl(gt_b0, ob_ & 63, 64);
  const float gt_a = (oa_ < 64) ? ga1 : ga2, gt_b = (ob_ < 64) ? gb1 : gb2;
#define PEER_ULOAD(UA, G)                                                                                   \
  {                                                                                                         \
    const int srcl_ = (16 * (G) + (lane & 15)) & 63;                                                        \
    const int idr_ = ((G) < 4) ? __shfl(id_a, srcl_, 64) : __shfl(id_b, srcl_, 64);                         \
    const char* ub_ = (const char*)pu + (size_t)idr_ * 1024 + 16 * q;                                       \
    _Pragma("unroll") for (int s2 = 0; s2 < 16; ++s2) UA[s2] = *(const i32x4*)(ub_ + 64 * s2);              \
  }
#define PEER_UCOMP(UA, G)                                                                                   \
  {                                                                                                         \
    int ide[4]; float gte[4], sue[4], sve[4];                                                               \
    _Pragma("unroll") for (int reg = 0; reg < 4; ++reg) {                                                   \
      const int el = (16 * (G) + 4 * q + reg) & 63;                                                         \
      ide[reg] = ((G) < 4) ? __shfl(id_a, el, 64) : __shfl(id_b, el, 64);                                   \
      gte[reg] = ((G) < 4) ? __shfl(gt_a, el, 64) : __shfl(gt_b, el, 64);                                   \
      sue[reg] = su[ide[reg]];                                                                              \
      sve[reg] = sv[ide[reg]];                                                                              \
    }                                                                                                       \
    i32x4 d4 = {0, 0, 0, 0};                                                                                \
    _Pragma("unroll") for (int s2 = 0; s2 < 16; ++s2) {                                                     \
      const i32x4 bfr = *(const i32x4*)(hq + 64 * s2 + 16 * q);                                             \
      d4 = __builtin_amdgcn_mfma_i32_16x16x64_i8(UA[s2], bfr, d4, 0, 0, 0);                                 \
    }                                                                                                       \
    float4 w4;                                                                                              \
    const float d0 = (float)d4[0] * (sue[0] * sh), d1 = (float)d4[1] * (sue[1] * sh);                       \
    const float d2 = (float)d4[2] * (sue[2] * sh), d3 = (float)d4[3] * (sue[3] * sh);                       \
    w4.x = gte[0] * sve[0] * 0.5f * d0 * (1.f + erf_fast(d0 * 0.7071067811865476f));                        \
    w4.y = gte[1] * sve[1] * 0.5f * d1 * (1.f + erf_fast(d1 * 0.7071067811865476f));                        \
    w4.z = gte[2] * sve[2] * 0.5f * d2 * (1.f + erf_fast(d2 * 0.7071067811865476f));                        \
    w4.w = gte[3] * sve[3] * 0.5f * d3 * (1.f + erf_fast(d3 * 0.7071067811865476f));                        \
    if ((lane & 15) == 0) *(float4*)(wl + 16 * (G) + 4 * q) = w4;                                           \
  }
  {
    i32x4 uA[16], uB[16];
    PEER_ULOAD(uA, 0);
    for (int g = 0; g < 8; g += 2) {
      PEER_ULOAD(uB, g + 1);
      PEER_UCOMP(uA, g);
      if (g + 2 < 8) PEER_ULOAD(uA, g + 2);
      PEER_UCOMP(uB, g + 1);
    }
  }
#undef PEER_ULOAD
#undef PEER_UCOMP
  for (int e0 = 0; e0 < 128; e0 += 16) {
    uint4 v[16];
#pragma unroll
    for (int k = 0; k < 16; ++k) {
      const int e = (e0 + k) & 63;
      const int id = (e0 < 64) ? __builtin_amdgcn_readlane(id_a, e) : __builtin_amdgcn_readlane(id_b, e);
      v[k] = *(const uint4*)(pv + (size_t)id * 256 + lane * 4);
    }
    const float4 w0 = *(const float4*)(wl + e0), w1 = *(const float4*)(wl + e0 + 4);
    const float4 w2 = *(const float4*)(wl + e0 + 8), w3 = *(const float4*)(wl + e0 + 12);
    axpy16_f8(v[0], w0.x, acc); axpy16_f8(v[1], w0.y, acc); axpy16_f8(v[2], w0.z, acc); axpy16_f8(v[3], w0.w, acc);
    axpy16_f8(v[4], w1.x, acc); axpy16_f8(v[5], w1.y, acc); axpy16_f8(v[6], w1.z, acc); axpy16_f8(v[7], w1.w, acc);
    axpy16_f8(v[8], w2.x, acc); axpy16_f8(v[9], w2.y, acc); axpy16_f8(v[10], w2.z, acc); axpy16_f8(v[11], w2.w, acc);
    axpy16_f8(v[12], w3.x, acc); axpy16_f8(v[13], w3.y, acc); axpy16_f8(v[14], w3.z, acc); axpy16_f8(v[15], w3.w, acc);
  }
  float ss = 0.f;
#pragma unroll
  for (int c = 0; c < 4; ++c) {
    const float4 xx = *(const float4*)(x1 + (size_t)t * DM + lane * 16 + c * 4);
    acc[c * 4 + 0] += xx.x; acc[c * 4 + 1] += xx.y; acc[c * 4 + 2] += xx.z; acc[c * 4 + 3] += xx.w;
  }
#pragma unroll
  for (int i = 0; i < 16; ++i) ss += acc[i] * acc[i];
  ss = wave_sum(ss);
  const float sc = rsqrtf(ss * (1.f / DM) + EPSF) * oscale;
#pragma unroll
  for (int q4 = 0; q4 < 4; ++q4) {
    const float4 gg = *(const float4*)(gf + lane * 16 + q4 * 4);
    float4 o;
    o.x = acc[q4 * 4 + 0] * sc * gg.x; o.y = acc[q4 * 4 + 1] * sc * gg.y;
    o.z = acc[q4 * 4 + 2] * sc * gg.z; o.w = acc[q4 * 4 + 3] * sc * gg.w;
    *(float4*)(out + (size_t)t * DM + lane * 16 + q4 * 4) = o;
  }
}

typedef __attribute__((ext_vector_type(16))) float f32x16;
#define MFMA32(a, b, c) __builtin_amdgcn_mfma_f32_32x32x16_bf16((a), (b), (c), 0, 0, 0)
__device__ __forceinline__ int crow(int reg, int hh) { return (reg & 3) + 8 * (reg >> 2) + 4 * hh; }

struct GdnBufs {
  unsigned short* qc;
  unsigned short* kTc;
  unsigned short* qkc;
  unsigned short* wn;
  unsigned short* uo;
  float* gsc;
};

__device__ __forceinline__ void tri_subst(const float* AL0, int lane, float (&T)[64]) {
  const float* AL = (const float*)__builtin_assume_aligned(AL0, 16);
#pragma unroll
  for (int i = 0; i < 64; ++i) T[i] = 0.f;
  T[0] = (lane == 0) ? 1.f : 0.f;
  float4 cur[16], nxt[16];
#pragma unroll
  for (int j4 = 0; j4 < 1; ++j4) cur[j4] = *(const float4*)(AL + 1 * 72 + 4 * j4);
#pragma unroll
  for (int i = 1; i < 64; ++i) {
    if (i + 1 < 64) {
#pragma unroll
      for (int j4 = 0; j4 < (i + 4) / 4; ++j4) nxt[j4] = *(const float4*)(AL + (i + 1) * 72 + 4 * j4);
    }
    float ax = 0.f, ay = 0.f, az = 0.f, aw = 0.f;
#pragma unroll
    for (int j4 = 0; j4 < (i + 3) / 4; ++j4) {
      ax += cur[j4].x * T[4 * j4]; ay += cur[j4].y * T[4 * j4 + 1]; az += cur[j4].z * T[4 * j4 + 2]; aw += cur[j4].w * T[4 * j4 + 3];
    }
    T[i] = ((lane == i) ? 1.f : 0.f) - ((ax + ay) + (az + aw));
#pragma unroll
    for (int j4 = 0; j4 < 16; ++j4) cur[j4] = nxt[j4];
  }
}

__device__ __forceinline__ void d_gdn_prep(int item, char* smem, const unsigned short* __restrict__ pm,
                                           const float* __restrict__ gt, const float* __restrict__ conv_w, GdnBufs G) {
  unsigned short* qL = (unsigned short*)smem;
  unsigned short* kL = qL + 64 * 144;
  unsigned short* kTL = kL + 64 * 144;
  unsigned short* vTL = kTL + 128 * 72;
  float* scal = (float*)(vTL + 128 * 72);
  float* A0 = (float*)qL;
  float* A1 = (float*)kL;
  int tid = TIDX;
  asm volatile("" : "+v"(tid));
  const int lane = tid & 63, w = __builtin_amdgcn_readfirstlane(tid >> 6), r = lane & 31, hh = lane >> 5;
  const int bh = item >> 6, c = item & 63, b = bh >> 2, h = bh & 3;
  const int t0 = b * SEQ + c * 64;
  __syncthreads();
  {
#pragma unroll
    for (int sec = 0; sec < 3; ++sec) {
      const int c0 = sec * 512 + h * 128 + 2 * lane;
      float cw0[5], cw1[5];
#pragma unroll
      for (int j = 0; j < 5; ++j) { cw0[j] = conv_w[c0 * 5 + j]; cw1[j] = conv_w[(c0 + 1) * 5 + j]; }
      unsigned raw[20];
#pragma unroll
      for (int k = 0; k < 20; ++k) {
        const int sp = c * 64 + w * 16 + k - 2;
        raw[k] = (sp >= 0 && sp < SEQ) ? *(const unsigned*)(pm + ((size_t)t0 + w * 16 + k - 2) * 4096 + c0) : 0u;
      }
#pragma unroll
      for (int ii = 0; ii < 16; ++ii) {
        const int i = w * 16 + ii;
        float a0 = 0.f, a1 = 0.f;
#pragma unroll
        for (int j = 0; j < 5; ++j) {
          a0 += cw0[j] * bf2f((unsigned short)(raw[ii + j] & 0xffff));
          a1 += cw1[j] * __uint_as_float(raw[ii + j] & 0xffff0000u);
        }
        a0 = a0 * __builtin_amdgcn_rcpf(1.f + __builtin_amdgcn_exp2f(-1.4426950408889634f * a0));
        a1 = a1 * __builtin_amdgcn_rcpf(1.f + __builtin_amdgcn_exp2f(-1.4426950408889634f * a1));
        if (sec < 2) {
          const float ss = wave_sum_dpp(a0 * a0 + a1 * a1);
          float sc = rsqrtf(ss + EPSF);
          if (sec == 0) sc *= 0.08838834764831845f;
          a0 *= sc; a1 *= sc;
        }
        if (sec == 0) {
          *(unsigned*)(qL + i * 144 + 2 * lane) = pack2(a0, a1);
        } else if (sec == 1) {
          const unsigned pk = pack2(a0, a1);
          *(unsigned*)(kL + i * 144 + 2 * lane) = pk;
          kTL[(2 * lane) * 72 + i] = (unsigned short)(pk & 0xffff);
          kTL[(2 * lane + 1) * 72 + i] = (unsigned short)(pk >> 16);
        } else {
          const unsigned pk = pack2(a0, a1);
          vTL[(2 * lane) * 72 + i] = (unsigned short)(pk & 0xffff);
          vTL[(2 * lane + 1) * 72 + i] = (unsigned short)(pk >> 16);
        }
      }
    }
  }
  if (w == 0) {
    const float* gp = gt + ((size_t)t0 + lane) * 32;
    const float g0 = gp[h], g1 = gp[4 + h], b0 = gp[8 + h], b1 = gp[12 + h];
    float G0 = g0, G1 = g1;
#pragma unroll
    for (int o = 1; o < 64; o <<= 1) {
      const float v0 = __shfl_up(G0, o, 64);
      const float v1 = __shfl_down(G1, o, 64);
      if (lane >= o) G0 += v0;
      if (lane + o < 64) G1 += v1;
    }
    scal[lane] = G0 * 1.4426950408889634f; scal[64 + lane] = G1 * 1.4426950408889634f;
    scal[128 + lane] = b0; scal[192 + lane] = b1;
    const float GL0 = __shfl(G0, 63, 64), GL1 = __shfl(G1, 0, 64);
    float* gs0 = G.gsc + ((size_t)((bh * 2 + 0) * 64 + c)) * 192;
    float* gs1 = G.gsc + ((size_t)((bh * 2 + 1) * 64 + c)) * 192;
    gs0[lane] = expf(G0); gs0[64 + lane] = expf(GL0 - G0);
    gs1[lane] = expf(G1); gs1[64 + lane] = expf(GL1 - G1);
    if (lane == 0) { gs0[128] = expf(GL0); gs1[128] = expf(GL1); }
  }
  __syncthreads();
  {
    unsigned short* qg = G.qc + (size_t)item * 8192;
    unsigned short* kg = G.kTc + (size_t)item * 8192;
#pragma unroll
    for (int i = 0; i < 4; ++i) {
      const int id = tid + i * 256;
      {
        const int row = id >> 4, c16 = id & 15;
        *(uint4*)(qg + (row >> 5) * 4096 + ((c16 >> 1) * 64 + (c16 & 1) * 32 + (row & 31)) * 8) = *(const uint4*)(qL + row * 144 + c16 * 8);
      }
      {
        const int row = id >> 3, c8 = id & 7;
        *(uint4*)(kg + (row >> 5) * 2048 + ((c8 >> 1) * 64 + (c8 & 1) * 32 + (row & 31)) * 8) = *(const uint4*)(kTL + row * 72 + c8 * 8);
      }
    }
  }
  {
    const int ta = w >> 1, tb = w & 1;
    f32x16 acc, acc2;
#pragma unroll
    for (int i = 0; i < 16; ++i) { acc[i] = 0.f; acc2[i] = 0.f; }
#pragma unroll
    for (int s = 0; s < 8; ++s) {
      const bf16x8 a = *(const bf16x8*)(kL + (32 * ta + r) * 144 + 16 * s + 8 * hh);
      const bf16x8 bk = *(const bf16x8*)(kL + (32 * tb + r) * 144 + 16 * s + 8 * hh);
      const bf16x8 bq = *(const bf16x8*)(qL + (32 * tb + r) * 144 + 16 * s + 8 * hh);
      acc = MFMA32(a, bk, acc);
      acc2 = MFMA32(a, bq, acc2);
    }
    __syncthreads();
    {
      const int col = 32 * tb + r;
      const float G0c = scal[col], G1c = scal[64 + col];
#pragma unroll
      for (int reg = 0; reg < 16; ++reg) {
        const int row = 32 * ta + crow(reg, hh);
        const float v = acc[reg];
        const float a0 = (col < row) ? scal[128 + row] * v * __builtin_amdgcn_exp2f(scal[row] - G0c) : 0.f;
        const float a1 = (col > row) ? scal[192 + row] * v * __builtin_amdgcn_exp2f(scal[64 + row] - G1c) : 0.f;
        A0[row * 72 + col] = a0;
        A1[(63 - row) * 72 + (63 - col)] = a1;
      }
    }
    {
      const int i = 32 * tb + r;
      const float G0i = scal[i], G1i = scal[64 + i];
      unsigned short* qk0 = G.qkc + ((size_t)((bh * 2 + 0) * 64 + c)) * 4096;
      unsigned short* qk1 = G.qkc + ((size_t)((bh * 2 + 1) * 64 + c)) * 4096;
#pragma unroll
      for (int g = 0; g < 4; ++g) {
        float o0[4], o1[4];
#pragma unroll
        for (int e = 0; e < 4; ++e) {
          const int j = 32 * ta + 8 * g + 4 * hh + e;
          const float v = acc2[4 * g + e];
          o0[e] = (j <= i) ? v * __builtin_amdgcn_exp2f(G0i - scal[j]) : 0.f;
          o1[e] = (j >= i) ? v * __builtin_amdgcn_exp2f(G1i - scal[64 + j]) : 0.f;
        }
        uint2 p0, p1;
        p0.x = pack2(o0[0], o0[1]); p0.y = pack2(o0[2], o0[3]);
        p1.x = pack2(o1[0], o1[1]); p1.y = pack2(o1[2], o1[3]);
        const int qoff = tb * 2048 + ((2 * ta + (g >> 1)) * 64 + (g & 1) * 32 + r) * 8 + 4 * hh;
        *(uint2*)(qk0 + qoff) = p0;
        *(uint2*)(qk1 + qoff) = p1;
      }
    }
  }
  __syncthreads();
  if (w < 2) {
    const int dir = w;
    float T[64];
    tri_subst(A0 + dir * (64 * 72), lane, T);
    const int jn = dir ? 63 - lane : lane;
    const float sb = scal[128 + 64 * dir + jn];
    const float sbg = sb * __builtin_amdgcn_exp2f(scal[64 * dir + jn]);
    unsigned short* Tb = dir ? kL : qL;
    unsigned short* Tbg = Tb + 64 * 72;
#pragma unroll
    for (int ip = 0; ip < 64; ++ip) {
      const int in = dir ? 63 - ip : ip;
      Tb[in * 72 + jn] = f2bf(T[ip] * sb);
      Tbg[in * 72 + jn] = f2bf(T[ip] * sbg);
    }
  }
  __syncthreads();
#pragma unroll
  for (int d = 0; d < 2; ++d) {
    const int chain = bh * 2 + d;
    const unsigned short* Tb = d ? kL : qL;
    const unsigned short* Tbg = Tb + 64 * 72;
    unsigned short* wng = G.wn + ((size_t)(chain * 64 + c)) * 8192;
    unsigned short* uog = G.uo + ((size_t)(chain * 64 + c)) * 8192 + w * 2048;
#pragma unroll
    for (int tb = 0; tb < 2; ++tb) {
      f32x16 acc, acc2;
#pragma unroll
      for (int i = 0; i < 16; ++i) { acc[i] = 0.f; acc2[i] = 0.f; }
#pragma unroll
      for (int s = 0; s < 4; ++s) {
        const bf16x8 a = *(const bf16x8*)(kTL + (32 * w + r) * 72 + 16 * s + 8 * hh);
        const bf16x8 bb = *(const bf16x8*)(Tbg + (32 * tb + r) * 72 + 16 * s + 8 * hh);
        acc = MFMA32(a, bb, acc);
        const bf16x8 a2 = *(const bf16x8*)(Tb + (32 * tb + r) * 72 + 16 * s + 8 * hh);
        const bf16x8 b2 = *(const bf16x8*)(vTL + (32 * w + r) * 72 + 16 * s + 8 * hh);
        acc2 = MFMA32(a2, b2, acc2);
      }
#pragma unroll
      for (int g = 0; g < 4; ++g) {
        uint2 pk;
        pk.x = pack2(-acc[4 * g], -acc[4 * g + 1]); pk.y = pack2(-acc[4 * g + 2], -acc[4 * g + 3]);
        *(uint2*)(wng + tb * 4096 + ((2 * w + (g >> 1)) * 64 + (g & 1) * 32 + r) * 8 + 4 * hh) = pk;
      }
      uint4 u0, u1;
      u0.x = pack2(acc2[0], acc2[1]); u0.y = pack2(acc2[2], acc2[3]); u0.z = pack2(acc2[4], acc2[5]); u0.w = pack2(acc2[6], acc2[7]);
      u1.x = pack2(acc2[8], acc2[9]); u1.y = pack2(acc2[10], acc2[11]); u1.z = pack2(acc2[12], acc2[13]); u1.w = pack2(acc2[14], acc2[15]);
      *(uint4*)(uog + tb * 1024 + lane * 16) = u0;
      *(uint4*)(uog + tb * 1024 + lane * 16 + 8) = u1;
    }
  }
}

struct GdnOps {
  bf16x8 a[8];
  bf16x8 x[4];
  bf16x8 kt[4];
  float4 rs[4];
  float gtot;
};
__device__ __forceinline__ void gdn_load(GdnOps& o, const GdnBufs& G, int chain, int bh, int c, int sl, int w, int r, int hh, int lane) {
  const unsigned short* kT_c = G.kTc + ((size_t)(bh * 64 + c)) * 8192;
  const float* gs = G.gsc + ((size_t)(chain * 64 + c)) * 192;
  const int ti = w & 1;
#pragma unroll
  for (int s = 0; s < 4; ++s) o.kt[s] = *(const bf16x8*)(kT_c + w * 2048 + (s * 64 + lane) * 8);
  o.gtot = gs[128];
  if (w < 2) {
    const unsigned short* wn_c = G.wn + ((size_t)(chain * 64 + c)) * 8192;
    const unsigned short* uo_c = G.uo + ((size_t)(chain * 64 + c)) * 8192 + sl * 2048;
#pragma unroll
    for (int s = 0; s < 8; ++s) o.a[s] = *(const bf16x8*)(wn_c + ti * 4096 + (s * 64 + lane) * 8);
    o.x[0] = *(const bf16x8*)(uo_c + ti * 1024 + lane * 16);
    o.x[1] = *(const bf16x8*)(uo_c + ti * 1024 + lane * 16 + 8);
#pragma unroll
    for (int g = 0; g < 4; ++g) o.rs[g] = *(const float4*)(gs + 64 + 32 * ti + 8 * g + 4 * hh);
  } else {
    const unsigned short* q_c = G.qc + ((size_t)(bh * 64 + c)) * 8192;
    const unsigned short* qk_c = G.qkc + ((size_t)(chain * 64 + c)) * 4096;
#pragma unroll
    for (int s = 0; s < 8; ++s) o.a[s] = *(const bf16x8*)(q_c + ti * 4096 + (s * 64 + lane) * 8);
#pragma unroll
    for (int s = 0; s < 4; ++s) o.x[s] = *(const bf16x8*)(qk_c + ti * 2048 + (s * 64 + lane) * 8);
#pragma unroll
    for (int g = 0; g < 4; ++g) o.rs[g] = *(const float4*)(gs + 32 * ti + 8 * g + 4 * hh);
  }
}
__device__ __forceinline__ void gdn_step(const GdnOps& o, f32x16& S, unsigned short* ST, unsigned short* VT, unsigned short* VdT,
                                         unsigned short* uo_c, int w, int r, int hh) {
  const int ti = w & 1;
  f32x16 acc;
  if (w < 2) {
#pragma unroll
    for (int i = 0; i < 8; ++i) {
      acc[i] = bf2f((unsigned short)o.x[0][i]);
      acc[8 + i] = bf2f((unsigned short)o.x[1][i]);
    }
  } else {
#pragma unroll
    for (int i = 0; i < 16; ++i) acc[i] = 0.f;
  }
#pragma unroll
  for (int g = 0; g < 4; ++g) {
    uint2 pk;
    pk.x = pack2(S[4 * g], S[4 * g + 1]); pk.y = pack2(S[4 * g + 2], S[4 * g + 3]);
    *(uint2*)(ST + r * 136 + 32 * w + 8 * g + 4 * hh) = pk;
  }
  __syncthreads();
#pragma unroll
  for (int s = 0; s < 8; ++s) {
    const bf16x8 bs = *(const bf16x8*)(ST + r * 136 + 16 * s + 8 * hh);
    acc = MFMA32(o.a[s], bs, acc);
  }
  if (w < 2) {
#pragma unroll
    for (int g = 0; g < 4; ++g) {
      uint2 pk, pd;
      pk.x = pack2(acc[4 * g], acc[4 * g + 1]); pk.y = pack2(acc[4 * g + 2], acc[4 * g + 3]);
      pd.x = pack2(acc[4 * g] * o.rs[g].x, acc[4 * g + 1] * o.rs[g].y);
      pd.y = pack2(acc[4 * g + 2] * o.rs[g].z, acc[4 * g + 3] * o.rs[g].w);
      *(uint2*)(VT + r * 72 + 32 * ti + 8 * g + 4 * hh) = pk;
      *(uint2*)(VdT + r * 72 + 32 * ti + 8 * g + 4 * hh) = pd;
    }
  } else {
#pragma unroll
    for (int g = 0; g < 4; ++g) {
      acc[4 * g] *= o.rs[g].x; acc[4 * g + 1] *= o.rs[g].y; acc[4 * g + 2] *= o.rs[g].z; acc[4 * g + 3] *= o.rs[g].w;
    }
  }
  __syncthreads();
  if (w >= 2) {
#pragma unroll
    for (int s = 0; s < 4; ++s) {
      const bf16x8 bv = *(const bf16x8*)(VT + r * 72 + 16 * s + 8 * hh);
      acc = MFMA32(o.x[s], bv, acc);
    }
#pragma unroll
    for (int reg = 0; reg < 16; ++reg) uo_c[(32 * ti + crow(reg, hh)) * 32 + r] = f2bf(acc[reg]);
  }
#pragma unroll
  for (int i = 0; i < 16; ++i) S[i] *= o.gtot;
#pragma unroll
  for (int s = 0; s < 4; ++s) {
    const bf16x8 bv = *(const bf16x8*)(VdT + r * 72 + 16 * s + 8 * hh);
    S = MFMA32(o.kt[s], bv, S);
  }
}
__device__ __forceinline__ void d_gdn_scan(int chain, int sl, char* smem, GdnBufs G) {
  unsigned short* ST = (unsigned short*)smem;
  unsigned short* VT = ST + 32 * 136;
  unsigned short* VdT = VT + 32 * 72;
  const int tid = TIDX, lane = tid & 63, w = __builtin_amdgcn_readfirstlane(tid >> 6), r = lane & 31, hh = lane >> 5;
  const int bh = chain >> 1, dir = chain & 1;
  f32x16 S;
#pragma unroll
  for (int i = 0; i < 16; ++i) S[i] = 0.f;
  GdnOps A, B;
  gdn_load(A, G, chain, bh, dir ? 63 : 0, sl, w, r, hh, lane);
  for (int step = 0; step < 64; step += 2) {
    const int c0 = dir ? 63 - step : step;
    const int c1 = dir ? c0 - 1 : c0 + 1;
    const int c2 = dir ? c0 - 2 : c0 + 2;
    gdn_load(B, G, chain, bh, c1, sl, w, r, hh, lane);
    gdn_step(A, S, ST, VT, VdT, G.uo + ((size_t)(chain * 64 + c0)) * 8192 + sl * 2048, w, r, hh);
    if (step + 2 < 64) gdn_load(A, G, chain, bh, c2, sl, w, r, hh, lane);
    gdn_step(B, S, ST, VT, VdT, G.uo + ((size_t)(chain * 64 + c1)) * 8192 + sl * 2048, w, r, hh);
  }
}

__device__ __forceinline__ void d_ml_gates(int item, const float* __restrict__ gt, float* __restrict__ pre, float* __restrict__ gtots) {
  const int wv = item * 4 + (TIDX >> 6);
  const int lane = TIDX & 63;
  const int chain = wv >> 6, c = wv & 63;
  const int bh = chain >> 1, dir = chain & 1, b = bh >> 2, h = bh & 3;
  const size_t t0 = (size_t)b * SEQ + c * 64;
  const float lf = gt[(t0 + lane) * 32 + 24 + dir * 4 + h];
  const float ip = gt[(t0 + lane) * 32 + 16 + dir * 4 + h];
  float bc = lf;
#pragma unroll
  for (int ofs = 1; ofs < 64; ofs <<= 1) {
    const float vu = __shfl_up(bc, ofs, 64);
    const float vd = __shfl_down(bc, ofs, 64);
    if (dir == 0) { if (lane >= ofs) bc += vu; } else { if (lane + ofs < 64) bc += vd; }
  }
  const float b_last = __shfl(bc, dir ? 0 : 63, 64);
  float4 o;
  o.x = expf(bc);
  o.y = (ip - bc) * 1.4426950408889634f - 3.5f;
  o.z = bc * 1.4426950408889634f;
  o.w = 0.08838834764831845f * expf(b_last - bc + ip);
  *(float4*)(pre + ((size_t)chain * SEQ + c * 64 + lane) * 4) = o;
  if (lane == 0) gtots[wv] = expf(b_last);
}

#define ML_LDK(R, I, T0) R = *(const uint4*)(pm + ((T0) + ((t128 + (I) * 128) >> 4)) * 4096 + 2560 + h * 128 + (t128 & 15) * 8);
#define ML_STK(R, I) *(uint4*)(kLb + ((t128 + (I) * 128) >> 4) * 136 + (t128 & 15) * 8) = R;
#define ML_LOAD(T0)                                                                                         \
  {                                                                                                         \
    ML_LDK(pk0, 0, T0) ML_LDK(pk1, 1, T0) ML_LDK(pk2, 2, T0) ML_LDK(pk3, 3, T0)                             \
    ML_LDK(pk4, 4, T0) ML_LDK(pk5, 5, T0) ML_LDK(pk6, 6, T0) ML_LDK(pk7, 7, T0)                             \
    pv0 = *(const uint4*)(pm + ((T0) + (t128 >> 2)) * 4096 + 3072 + h * 128 + sl * 32 + (t128 & 3) * 8);    \
    pv1 = *(const uint4*)(pm + ((T0) + ((t128 + 128) >> 2)) * 4096 + 3072 + h * 128 + sl * 32 + (t128 & 3) * 8); \
    pgl = *(const float4*)(pre + ((size_t)chain * SEQ + ((T0) - tb) + lane) * 4);                           \
    pgt = gtots[chain * 64 + (int)(((T0) - tb) >> 6)];                                                      \
  }
#define ML_PUTV(W, E)                                                                                       \
  {                                                                                                         \
    const unsigned short lo_ = (unsigned short)((W) & 0xffff), hi_ = (unsigned short)((W) >> 16);           \
    vTb[(d8_ + (E)) * 72 + tok_] = lo_;                                                                     \
    vTb[(d8_ + (E) + 1) * 72 + tok_] = hi_;                                                                 \
    const unsigned sc_ = pack2(bf2f(lo_) * dj_, bf2f(hi_) * dj_);                                           \
    vdb[(d8_ + (E)) * 72 + tok_] = (unsigned short)(sc_ & 0xffff);                                          \
    vdb[(d8_ + (E) + 1) * 72 + tok_] = (unsigned short)(sc_ >> 16);                                         \
  }
#define ML_STAGE(BUF)                                                                                       \
  {                                                                                                         \
    unsigned short* kLb = kL + (BUF) * (64 * 136);                                                          \
    unsigned short* vTb = vTL + (BUF) * (32 * 72);                                                          \
    unsigned short* vdb = vdTL + (BUF) * (32 * 72);                                                         \
    float* scb = scal + (BUF) * 208;                                                                        \
    if (w == 2) {                                                                                           \
      scb[lane] = pgl.x; scb[64 + lane] = pgl.y; scb[128 + lane] = pgl.z;                                   \
      dL[(BUF) * 72 + lane] = f2bf(pgl.w);                                                                  \
      if (lane == 0) scb[192] = pgt;                                                                        \
    }                                                                                                       \
    ML_STK(pk0, 0) ML_STK(pk1, 1) ML_STK(pk2, 2) ML_STK(pk3, 3) ML_STK(pk4, 4) ML_STK(pk5, 5) ML_STK(pk6, 6) ML_STK(pk7, 7) \
    {                                                                                                       \
      const int tok_ = t128 >> 2, d8_ = (t128 & 3) * 8;                                                     \
      const float dj_ = __shfl(pgl.w, tok_, 64);                                                            \
      ML_PUTV(pv0.x, 0); ML_PUTV(pv0.y, 2); ML_PUTV(pv0.z, 4); ML_PUTV(pv0.w, 6);                           \
    }                                                                                                       \
    {                                                                                                       \
      const int tok_ = (t128 + 128) >> 2, d8_ = (t128 & 3) * 8;                                             \
      const float dj_ = __shfl(pgl.w, tok_, 64);                                                            \
      ML_PUTV(pv1.x, 0); ML_PUTV(pv1.y, 2); ML_PUTV(pv1.z, 4); ML_PUTV(pv1.w, 6);                           \
    }                                                                                                       \
  }
__device__ __forceinline__ void ml_state_image(const f32x16& S0, const f32x16& S1, unsigned short* S0T, unsigned short* nL, int w, int r, int hh) {
#pragma unroll
  for (int g = 0; g < 4; ++g) {
    uint2 pk;
    pk.x = pack2(S0[4 * g], S0[4 * g + 1]); pk.y = pack2(S0[4 * g + 2], S0[4 * g + 3]);
    *(uint2*)(S0T + r * 136 + 32 * w + 8 * g + 4 * hh) = pk;
    if (r == 0) {
      uint2 pn;
      pn.x = pack2(S1[4 * g], S1[4 * g + 1]); pn.y = pack2(S1[4 * g + 2], S1[4 * g + 3]);
      *(uint2*)(nL + 32 * w + 8 * g + 4 * hh) = pn;
    }
  }
}
__device__ __forceinline__ void ml_state_update(f32x16& S0, f32x16& S1, const unsigned short* kLb, const unsigned short* vdb,
                                                const unsigned short* dLb, float gtot, int w, int r, int hh) {
#pragma unroll
  for (int i = 0; i < 16; ++i) { S0[i] *= gtot; S1[i] *= gtot; }
#pragma unroll
  for (int s2 = 0; s2 < 4; ++s2) {
    union { bf16x8 v; unsigned short e[8]; } a;
#pragma unroll
    for (int e = 0; e < 8; ++e) a.e[e] = kLb[(16 * s2 + 8 * hh + e) * 136 + 32 * w + r];
    const bf16x8 bv = *(const bf16x8*)(vdb + r * 72 + 16 * s2 + 8 * hh);
    const bf16x8 bd = *(const bf16x8*)(dLb + 16 * s2 + 8 * hh);
    S0 = MFMA32(a.v, bv, S0);
    S1 = MFMA32(a.v, bd, S1);
  }
}
__device__ __forceinline__ void d_mlstm_scan(int chain, int sl, char* smem, const unsigned short* __restrict__ pm,
                                             const float* __restrict__ pre, const float* __restrict__ gtots,
                                             unsigned short* __restrict__ oM, int ntok, int hbk) {
  unsigned short* kL = (unsigned short*)smem;
  unsigned short* vTL = kL + 2 * 64 * 136;
  unsigned short* vdTL = vTL + 2 * 32 * 72;
  unsigned short* dL = vdTL + 2 * 32 * 72;
  unsigned short* S0T = dL + 256;
  unsigned short* nL = S0T + 32 * 136;
  float* scal = (float*)(nL + 256);
  int tid = TIDX;
  asm volatile("" : "+v"(tid));
  const int lane = tid & 63, w = __builtin_amdgcn_readfirstlane(tid >> 6), r = lane & 31, hh = lane >> 5;
  const int bh = chain >> 1, dir = chain & 1, b = bh >> 2, h = bh & 3;
  f32x16 S0, S1;
#pragma unroll
  for (int i = 0; i < 16; ++i) { S0[i] = 0.f; S1[i] = 0.f; }
  unsigned short* oMb = oM + (size_t)dir * ntok * 512 + h * 128 + sl * 32;
  const size_t tb = (size_t)b * SEQ;
  __syncthreads();
  if (hbk == 1) {
    if (w < 2) ml_state_image(S0, S1, S0T, nL, w, r, hh);
    for (int step = 0; step < 64; ++step) {
      const int buf = step & 1;
      __syncthreads();
      if (w < 2) {
        const float gtot = scal[buf * 208 + 192];
        ml_state_update(S0, S1, kL + buf * (64 * 136), vdTL + buf * (32 * 72), dL + buf * 72, gtot, w, r, hh);
      }
      __syncthreads();
      if (w < 2) ml_state_image(S0, S1, S0T, nL, w, r, hh);
    }
    return;
  }
  if (w >= 2) ml_state_image(S0, S1, S0T, nL, w, r, hh);
  if (w >= 2) {
    const int t128 = tid - 128;
    uint4 pk0, pk1, pk2, pk3, pk4, pk5, pk6, pk7, pv0, pv1;
    float4 pgl;
    float pgt;
    ML_LOAD(tb + (dir ? 63 : 0) * 64);
    ML_STAGE(0);
    ML_LOAD(tb + (dir ? 62 : 1) * 64);
    for (int step = 0; step < 64; ++step) {
      const int c0 = dir ? 63 - step : step;
      const int c2 = dir ? c0 - 2 : c0 + 2;
      const int buf = step & 1;
      __syncthreads();
      const float gtot = scal[buf * 208 + 192];
      ML_STAGE(buf ^ 1);
      {
        const int cl = (step + 2 < 64) ? c2 : c0;
        ML_LOAD(tb + cl * 64);
      }
      ml_state_update(S0, S1, kL + buf * (64 * 136), vdTL + buf * (32 * 72), dL + buf * 72, gtot, w, r, hh);
      __syncthreads();
      ml_state_image(S0, S1, S0T, nL, w, r, hh);
    }
  } else {
    bf16x8 ones;
#pragma unroll
    for (int i = 0; i < 8; ++i) ones[i] = (short)0x3F80;
    const int ti = w;
    const int icol = 32 * ti + r;
    float dmask[16];
#pragma unroll
    for (int reg = 0; reg < 16; ++reg) {
      const int jl = crow(reg, hh);
      dmask[reg] = (dir ? (jl >= r) : (jl <= r)) ? 1.f : 0.f;
    }
    bf16x8 qf[8];
    {
      const unsigned short* qp = pm + (tb + (size_t)(dir ? 63 : 0) * 64 + 32 * ti + r) * 4096 + 2048 + h * 128 + 8 * hh;
#pragma unroll
      for (int s2 = 0; s2 < 8; ++s2) qf[s2] = *(const bf16x8*)(qp + 16 * s2);
    }
    for (int step = 0; step < 64; ++step) {
      const int c0 = dir ? 63 - step : step;
      const int c1 = dir ? c0 - 1 : c0 + 1;
      const int buf = step & 1;
      const unsigned short* kLb = kL + buf * (64 * 136);
      const unsigned short* vTb = vTL + buf * (32 * 72);
      const float* scb = scal + buf * 208;
      __syncthreads();
      const float bci = scb[128 + icol];
      const float gtot = scb[192];
      f32x16 Q0, Q1;
#pragma unroll
      for (int i = 0; i < 16; ++i) { Q0[i] = 0.f; Q1[i] = 0.f; }
#pragma unroll
      for (int s2 = 0; s2 < 8; ++s2) {
        const bf16x8 b0 = *(const bf16x8*)(S0T + r * 136 + 16 * s2 + 8 * hh);
        const bf16x8 b1 = *(const bf16x8*)(nL + 16 * s2 + 8 * hh);
        Q0 = MFMA32(qf[s2], b0, Q0);
        Q1 = MFMA32(qf[s2], b1, Q1);
      }
#pragma unroll
      for (int g = 0; g < 4; ++g) {
        const float4 e4 = *(const float4*)(scb + 32 * ti + 8 * g + 4 * hh);
        Q0[4 * g] *= e4.x; Q0[4 * g + 1] *= e4.y; Q0[4 * g + 2] *= e4.z; Q0[4 * g + 3] *= e4.w;
        Q1[4 * g] *= e4.x; Q1[4 * g + 1] *= e4.y; Q1[4 * g + 2] *= e4.z; Q1[4 * g + 3] *= e4.w;
      }
#pragma unroll
      for (int tj = 0; tj < 2; ++tj) {
        if (dir ? (tj < ti) : (tj > ti)) continue;
        f32x16 X;
#pragma unroll
        for (int i = 0; i < 16; ++i) X[i] = 0.f;
#pragma unroll
        for (int s2 = 0; s2 < 8; ++s2) {
          const bf16x8 a = *(const bf16x8*)(kLb + (32 * tj + r) * 136 + 16 * s2 + 8 * hh);
          X = MFMA32(a, qf[s2], X);
        }
        if (tj == ti) {
#pragma unroll
          for (int g = 0; g < 4; ++g) {
            const float4 cj4 = *(const float4*)(scb + 64 + 32 * tj + 8 * g + 4 * hh);
            X[4 * g + 0] *= __builtin_amdgcn_exp2f(fminf(bci + cj4.x, 80.f)) * dmask[4 * g + 0];
            X[4 * g + 1] *= __builtin_amdgcn_exp2f(fminf(bci + cj4.y, 80.f)) * dmask[4 * g + 1];
            X[4 * g + 2] *= __builtin_amdgcn_exp2f(fminf(bci + cj4.z, 80.f)) * dmask[4 * g + 2];
            X[4 * g + 3] *= __builtin_amdgcn_exp2f(fminf(bci + cj4.w, 80.f)) * dmask[4 * g + 3];
          }
        } else {
#pragma unroll
          for (int g = 0; g < 4; ++g) {
            const float4 cj4 = *(const float4*)(scb + 64 + 32 * tj + 8 * g + 4 * hh);
            X[4 * g + 0] *= __builtin_amdgcn_exp2f(bci + cj4.x);
            X[4 * g + 1] *= __builtin_amdgcn_exp2f(bci + cj4.y);
            X[4 * g + 2] *= __builtin_amdgcn_exp2f(bci + cj4.z);
            X[4 * g + 3] *= __builtin_amdgcn_exp2f(bci + cj4.w);
          }
        }
#pragma unroll
        for (int s2 = 0; s2 < 2; ++s2) {
          union { bf16x8 v; unsigned u[4]; } xa, bv;
          xa.u[0] = pack2(X[8 * s2 + 0], X[8 * s2 + 1]); xa.u[1] = pack2(X[8 * s2 + 2], X[8 * s2 + 3]);
          xa.u[2] = pack2(X[8 * s2 + 4], X[8 * s2 + 5]); xa.u[3] = pack2(X[8 * s2 + 6], X[8 * s2 + 7]);
          const uint2 v0 = *(const uint2*)(vTb + r * 72 + 32 * tj + 16 * s2 + 4 * hh);
          const uint2 v1 = *(const uint2*)(vTb + r * 72 + 32 * tj + 16 * s2 + 8 + 4 * hh);
          bv.u[0] = v0.x; bv.u[1] = v0.y; bv.u[2] = v1.x; bv.u[3] = v1.y;
          Q0 = MFMA32(xa.v, bv.v, Q0);
          Q1 = MFMA32(xa.v, ones, Q1);
        }
      }
      {
        const int cn = (step + 1 < 64) ? c1 : c0;
        const unsigned short* qp = pm + (tb + (size_t)cn * 64 + 32 * ti + r) * 4096 + 2048 + h * 128 + 8 * hh;
#pragma unroll
        for (int s2 = 0; s2 < 8; ++s2) qf[s2] = *(const bf16x8*)(qp + 16 * s2);
      }
      const size_t orow0 = tb + c0 * 64;
#pragma unroll
      for (int reg = 0; reg < 16; ++reg) {
        const int i = 32 * ti + crow(reg, hh);
        oMb[(orow0 + i) * 512 + r] = f2bf(Q0[reg] * __builtin_amdgcn_rcpf(fmaxf(fabsf(Q1[reg]), 1.f)));
      }
      __syncthreads();
    }
  }
}

struct MKP {
  const float *x, *norm1_g, *w_in, *conv_w, *a_log, *dt_bias, *gdn_g, *i_bias, *f_bias, *ml_g, *w_out, *norm2_g, *peer_wq,
      *peer_keys, *peer_u, *peer_v, *normf_g;
  float* out;
  unsigned short *pm, *x1b, *woutT, *mt, *xb, *winT, *oM, *yb, *scores, *qkv_dbg, *oA_dbg;
  unsigned *utab, *vtab;
  unsigned short *wqb, *keyb;
  float *uscale, *vscale;
  float *x1, *rs1, *rs2, *gt, *gateb, *dbg, *mlpre, *mlgt;
  unsigned* bar;
  int* idxb;
  GdnBufs G;
};

constexpr int SMEM_BYTES = 74752;
__global__ void __launch_bounds__(512, 2) k_mega(MKP P) {
  __shared__ __attribute__((aligned(16))) char smem_all[2 * SMEM_BYTES + 16];
  {
    volatile LAS unsigned* st0 = (volatile LAS unsigned*)(smem_all + 2 * SMEM_BYTES);
    if (threadIdx.x < 4) st0[threadIdx.x] = 0u;
  }
  __syncthreads();
  XcdBarrier xb = xcd_barrier_post(P.bar, (volatile LAS unsigned*)(smem_all + 2 * SMEM_BYTES));
  const int hb = __builtin_amdgcn_readfirstlane(HB);
  char* smem_c = smem_all + hb * SMEM_BYTES;
  unsigned short* smem = (unsigned short*)smem_c;
  const int nb = gridDim.x, bid = blockIdx.x;
  for (int it = bid; it < NT / 8; it += nb) d_prep_x(2 * it + hb, P.x, P.xb, P.rs1);
  for (int it = bid; it < 8 * 66; it += nb) d_transpose_w(2 * it + hb, 66, (float*)smem_c, P.w_in, DIN, P.norm1_g, P.winT, 1);
  for (int it = bid; it < 8 * 16; it += nb) d_transpose_w(2 * it + hb, 16, (float*)smem_c, P.w_out, 1024, nullptr, P.woutT, 0);
  for (int it = bid; it < 512; it += nb) d_cvt_bf16(2 * it + hb, P.peer_wq, P.wqb, P.norm2_g, 11);
  for (int it = bid; it < 64; it += nb) d_cvt_bf16(2 * it + hb, P.peer_keys, P.keyb, nullptr, 0);
  if (bid == 0 && threadIdx.x < 4) P.dbg[threadIdx.x] = 0.f;
  xcd_barrier(xb);
  {
    GemmP p{};
    p.A = P.xb; p.lda = DM; p.Bt = P.winT; p.ldb = DM; p.K = DM;
    p.rowscale = P.rs1; p.obf = P.pm; p.ldo = 4096; p.of32 = P.gt; p.ldf = 32; p.resid = nullptr;
    p.a_log = P.a_log; p.dt_bias = P.dt_bias; p.i_bias = P.i_bias; p.f_bias = P.f_bias;
    for (int k = 0;; ++k) {
      int tm, tn;
      if (!xcd_tile256(bid, nb, k, 16, tm, tn)) break;
      gemm256_tile<EPI_INPROJ>(p, tm, tn, smem_all);
    }
  }
  for (int it = bid; it < NT / 128; it += nb) d_gate_proj(it, P.xb, P.winT, P.rs1, P.a_log, P.dt_bias, P.i_bias, P.f_bias, P.gt);
  for (int tile = bid; tile < 16 * 4; tile += nb) {
    const int hp = tile >> 2, tn = (tile & 3) * 2 + hb;
    GemmP p{};
    p.A = P.keyb + (size_t)hp * 128 * 128; p.lda = 128; p.Bt = P.wqb + hp * 128; p.ldb = 2048; p.K = 128;
    p.obf = P.mt + (size_t)hp * 128 * DM; p.ldo = DM;
    gemm_tile<EPI_PLAIN>(p, 0, tn, smem);
    __syncthreads();
  }
  xcd_barrier(xb);
  for (int it = bid; it < 256; it += nb) d_ml_gates(2 * it + hb, P.gt, P.mlpre, P.mlgt);
  for (int it = bid; it < 512; it += nb) d_gdn_prep(2 * it + hb, smem_c, P.pm, P.gt, P.conv_w, P.G);
  xcd_barrier(xb);
  for (int wi = bid; wi < 256; wi += nb) {
    if (wi < 128) {
      if (hb == 0) d_gdn_scan(wi >> 2, wi & 3, smem_c, P.G);
      else for (int i = 0; i < 128; ++i) __syncthreads();
    } else {
      d_mlstm_scan((wi - 128) >> 2, (wi - 128) & 3, smem_all, P.pm, P.mlpre, P.mlgt, P.oM, NT, hb);
    }
    __syncthreads();
  }
  xcd_barrier(xb);
  for (int it = bid; it < NT / 8; it += nb) d_combine(2 * it + hb, P.G.uo, P.oM, P.pm, P.gdn_g, P.ml_g, P.yb);
  xcd_barrier(xb);
  {
    GemmP p{};
    p.A = P.yb; p.lda = DM; p.Bt = P.woutT; p.ldb = DM; p.K = DM;
    p.rowscale = nullptr; p.obf = P.x1b; p.ldo = DM; p.of32 = P.x1; p.ldf = DM; p.resid = P.x; p.rowacc = P.rs2;
    for (int k = 0;; ++k) {
      int tm, tn;
      if (!xcd_tile256(bid, nb, k, 4, tm, tn)) break;
      gemm256_tile<EPI_OUTPROJ>(p, tm, tn, smem_all);
    }
  }
  for (int it = bid; it < 512; it += nb) { d_cvt_tab<true>(2 * it + hb, P.peer_u, P.utab, P.uscale); d_cvt_tab<false>(2 * it + hb, P.peer_v, P.vtab, P.vscale); }
  xcd_barrier(xb);
  {
    GemmP p{};
    p.A = P.x1b; p.lda = DM; p.Bt = P.mt; p.ldb = DM; p.K = DM;
    p.rowscale = P.rs2; p.obf = P.scores; p.ldo = 2048; p.of32 = nullptr; p.ldf = 0; p.resid = nullptr;
    for (int k = 0;; ++k) {
      int tm, tn;
      if (!xcd_tile256(bid, nb, k, 8, tm, tn)) break;
      gemm256_tile<EPI_SCORES>(p, tm, tn, smem_all);
    }
  }
  xcd_barrier(xb);
  const float oscale = 1.f;
  for (int it = bid; it < NT / 64; it += nb) {
    const int hit = 2 * it + hb;
    d_topk(hit, P.scores, P.idxb, P.gateb);
    __threadfence_block();
    __syncthreads();
#pragma unroll 1
    for (int sub = 0; sub < 8; ++sub)
      d_peer(hit * 8 + sub, smem_c, P.x1, P.rs2, P.norm2_g, P.idxb, P.gateb, P.utab, P.vtab, P.uscale, P.vscale, P.normf_g, P.out, oscale);
  }
}

extern "C" void kernel_launch(void* const* d_in, const int* in_sizes, int n_in, void* d_out, int out_size, void* d_ws,
                              size_t ws_size, hipStream_t stream) {
  MKP P{};
  P.x = (const float*)d_in[0];
  P.norm1_g = (const float*)d_in[1];
  P.w_in = (const float*)d_in[2];
  P.conv_w = (const float*)d_in[3];
  P.a_log = (const float*)d_in[4];
  P.dt_bias = (const float*)d_in[5];
  P.gdn_g = (const float*)d_in[6];
  P.i_bias = (const float*)d_in[7];
  P.f_bias = (const float*)d_in[8];
  P.ml_g = (const float*)d_in[9];
  P.w_out = (const float*)d_in[10];
  P.norm2_g = (const float*)d_in[11];
  P.peer_wq = (const float*)d_in[12];
  P.peer_keys = (const float*)d_in[13];
  P.peer_u = (const float*)d_in[14];
  P.peer_v = (const float*)d_in[15];
  P.normf_g = (const float*)d_in[16];
  P.out = (float*)d_out;

  char* ws = (char*)d_ws;
  const size_t MB = 1024 * 1024;
  P.pm = (unsigned short*)(ws);
  P.x1 = (float*)(ws);
  P.x1b = (unsigned short*)(ws + 64 * MB);
  P.utab = (unsigned*)(ws + 96 * MB);
  P.vtab = (unsigned*)(ws + 112 * MB);
  P.uscale = (float*)(ws + 136 * MB);
  P.vscale = (float*)(ws + 136 * MB + 65536);
  char* rb = ws + 128 * MB;
  P.woutT = (unsigned short*)(rb);
  P.mt = (unsigned short*)(rb + 2 * MB);
  P.rs1 = (float*)(rb + 6 * MB);
  P.rs2 = (float*)(rb + 7 * MB);
  P.dbg = (float*)(rb + 6 * MB + 131072);
  P.bar = (unsigned*)(rb + 6 * MB + 196608);
  P.gt = (float*)(rb + 9 * MB);
  char* dyn = rb + 11 * MB;
  P.xb = (unsigned short*)(dyn);
  P.winT = (unsigned short*)(dyn + 32 * MB);
  P.wqb = (unsigned short*)(dyn + 41 * MB);
  P.keyb = (unsigned short*)(dyn + 45 * MB);
  P.G.qc = (unsigned short*)(dyn);
  P.G.kTc = (unsigned short*)(dyn + 16 * MB);
  P.G.qkc = (unsigned short*)(dyn + 32 * MB);
  P.G.wn = (unsigned short*)(dyn + 48 * MB);
  P.G.uo = (unsigned short*)(dyn + 80 * MB);
  P.G.gsc = (float*)(dyn + 112 * MB);
  P.mlpre = (float*)(dyn + 114 * MB);
  P.mlgt = (float*)(dyn + 116 * MB);
  P.yb = (unsigned short*)(dyn);
  P.scores = (unsigned short*)(dyn);
  P.idxb = (int*)(dyn + 64 * MB);
  P.gateb = (float*)(dyn + 72 * MB);
  char* os = (char*)d_out;
  P.oM = (unsigned short*)(os);
  P.qkv_dbg = (unsigned short*)(os + 32 * MB);
  P.oA_dbg = (unsigned short*)(os + 44 * MB);

  static int grid_blocks = 0;
  if (!grid_blocks) {
    int dev = 0, cus = 0, per_cu = 0;
    (void)hipGetDevice(&dev);
    (void)hipDeviceGetAttribute(&cus, hipDeviceAttributeMultiprocessorCount, dev);
    (void)hipOccupancyMaxActiveBlocksPerMultiprocessor(&per_cu, k_mega, 512, 0);
    if (per_cu > 1) per_cu = 1;
    if (per_cu < 1) per_cu = 1;
    grid_blocks = cus * per_cu;
  }
  (void)hipMemsetAsync(P.bar, 0, XCD_BAR_WORDS * sizeof(unsigned), stream);
  hipLaunchKernelGGL(k_mega, dim3(grid_blocks), dim3(512), 0, stream, P);
}
```

```cpp
#include <hip/hip_runtime.h>
#include <hip/hip_bf16.h>
#include <stdint.h>
#include <cstdio>
#define TIDX ((int)(threadIdx.x & 255))
#define HB ((int)(threadIdx.x >> 8))

#define XB_TMO      128
#define XB_XCNT(j)  (256  + 64 * (j))
#define XB_XSUB(j)  (1280 + 64 * (j))
#define XB_XGEN(j)  (2304 + 64 * (j))
#define XB_TOP      3328
#define XB_TOPGEN   3392
#define XCD_BAR_WORDS 3456
#define XB_SPIN_CAP (1u << 18)
#define LAS __attribute__((address_space(3)))

__device__ __forceinline__ unsigned xb_ld(unsigned* p)              { return __hip_atomic_load(p, __ATOMIC_RELAXED, __HIP_MEMORY_SCOPE_AGENT); }
__device__ __forceinline__ unsigned xb_add(unsigned* p, unsigned v) { return __hip_atomic_fetch_add(p, v, __ATOMIC_RELAXED, __HIP_MEMORY_SCOPE_AGENT); }
__device__ __forceinline__ unsigned xb_xcc_id() { return (unsigned)__builtin_amdgcn_s_getreg((3 << 11) | 20) & 0xFu; }
#define XB_SPIN(cond, bar) do { unsigned _sp = 0; while (cond) { __builtin_amdgcn_s_sleep(1); \
    if ((++_sp & 255u) == 0u) { if (xb_ld(&(bar)[XB_TMO])) break; if (_sp > XB_SPIN_CAP) { atomicAdd(&(bar)[XB_TMO], 1u); break; } } } } while (0)

struct XcdBarrier {
    unsigned* bar; unsigned x;
    volatile LAS unsigned* st;
};

__device__ __forceinline__ XcdBarrier xcd_barrier_post(unsigned* bar, volatile LAS unsigned* st) {
    XcdBarrier b; b.bar = bar; b.x = xb_xcc_id(); b.st = st;
    if (threadIdx.x == 0) (void)xb_add(&bar[XB_XCNT(b.x)], 1u);
    return b;
}
__device__ __forceinline__ void xcd_barrier_complete(unsigned* bar, unsigned x, unsigned& nloc, unsigned& nx) {
    const unsigned G = gridDim.x * gridDim.y * gridDim.z;
    unsigned sum, cnt, mine, sp = 0u;
    for (;;) {
        sum = 0u; cnt = 0u; mine = 0u;
#pragma unroll
        for (unsigned j = 0; j < 16; ++j) { const unsigned c = xb_ld(&bar[XB_XCNT(j)]); sum += c; cnt += (c > 0u) ? 1u : 0u; mine = (j == x) ? c : mine; }
        if (sum == G) break;
        __builtin_amdgcn_s_sleep(1);
        if ((++sp & 255u) == 0u) { if (xb_ld(&bar[XB_TMO])) break; if (sp > XB_SPIN_CAP) { atomicAdd(&bar[XB_TMO], 1u); break; } }
    }
    nloc = mine > 0u ? mine : 1u; nx = cnt > 0u ? cnt : 1u;
}

__device__ __forceinline__ void xcd_barrier(const XcdBarrier& b) {
    asm volatile("s_waitcnt vmcnt(0)" ::: "memory");
    __syncthreads();
    if (threadIdx.x == 0) {
        unsigned* bar = b.bar;
        __builtin_amdgcn_s_waitcnt(0);
        unsigned nloc = b.st[0], nx = b.st[1];
        if (nloc == 0u) { xcd_barrier_complete(bar, b.x, nloc, nx); b.st[0] = nloc; b.st[1] = nx; }
        const unsigned old = xb_add(&bar[XB_XSUB(b.x)], 1u);
        const unsigned gen = old / nloc;
        if (old + 1u == (gen + 1u) * nloc) {
            __builtin_amdgcn_fence(__ATOMIC_RELEASE, "agent");
            asm volatile("s_waitcnt vmcnt(0)" ::: "memory");
            const unsigned og = xb_add(&bar[XB_TOP], 1u);
            const unsigned tg = og / nx;
            if (og + 1u == (tg + 1u) * nx) xb_add(&bar[XB_TOPGEN], 1u);
            else XB_SPIN(xb_ld(&bar[XB_TOPGEN]) == tg, bar);
            __builtin_amdgcn_fence(__ATOMIC_ACQUIRE, "agent");
            xb_add(&bar[XB_XGEN(b.x)], 1u);
            asm volatile("s_waitcnt vmcnt(0)" ::: "memory");
        } else {
            XB_SPIN(xb_ld(&bar[XB_XGEN(b.x)]) == gen, bar);
            __builtin_amdgcn_fence(__ATOMIC_ACQUIRE, "agent");
            asm volatile("s_waitcnt vmcnt(0)" ::: "memory");
        }
    }
    __syncthreads();
}


typedef __hip_bfloat16 bf16;
typedef __attribute__((ext_vector_type(8))) short bf16x8;
typedef __attribute__((ext_vector_type(4))) float f32x4;

constexpr int DM = 1024;
constexpr int NB = 4;
constexpr int SEQ = 4096;
constexpr int NT = NB * SEQ;
constexpr int DIN = 4128;
constexpr int NPAD_IN = 4224;
constexpr float EPSF = 1e-6f;

__device__ __forceinline__ float bf2f(unsigned short u) { return __uint_as_float(((unsigned)u) << 16); }
typedef __bf16 bf16x2_t __attribute__((ext_vector_type(2)));
typedef float f32x2_t __attribute__((ext_vector_type(2)));
__device__ __forceinline__ unsigned short f2bf(float f) { return __builtin_bit_cast(unsigned short, (__bf16)f); }
__device__ __forceinline__ unsigned pack2(float a, float b) {
  f32x2_t v = {a, b};
  return __builtin_bit_cast(unsigned, __builtin_convertvector(v, bf16x2_t));
}
__device__ __forceinline__ float wave_sum(float v) {
#pragma unroll
  for (int o = 32; o > 0; o >>= 1) v += __shfl_xor(v, o, 64);
  return v;
}
#define DPP_ADD(v, ctrl) v += __builtin_bit_cast(float, __builtin_amdgcn_update_dpp(0, __builtin_bit_cast(int, v), ctrl, 0xF, 0xF, true))
__device__ __forceinline__ float wave_sum_dpp(float v) {
  DPP_ADD(v, 0xB1);
  DPP_ADD(v, 0x4E);
  DPP_ADD(v, 0x141);
  DPP_ADD(v, 0x140);
  const float r0 = __builtin_bit_cast(float, __builtin_amdgcn_readlane(__builtin_bit_cast(int, v), 0));
  const float r1 = __builtin_bit_cast(float, __builtin_amdgcn_readlane(__builtin_bit_cast(int, v), 16));
  const float r2 = __builtin_bit_cast(float, __builtin_amdgcn_readlane(__builtin_bit_cast(int, v), 32));
  const float r3 = __builtin_bit_cast(float, __builtin_amdgcn_readlane(__builtin_bit_cast(int, v), 48));
  return (r0 + r1) + (r2 + r3);
}
__device__ __forceinline__ float softplusf(float x) { return fmaxf(x, 0.f) + log1pf(expf(-fabsf(x))); }
__device__ __forceinline__ float sigmoidf(float x) { return __builtin_amdgcn_rcpf(1.f + __builtin_amdgcn_exp2f(-1.4426950408889634f * x)); }

__device__ __forceinline__ void d_prep_x(int item, const float* __restrict__ x, unsigned short* __restrict__ xb,
                                                float* __restrict__ rs) {
  int t = item * 4 + (TIDX >> 6);
  int lane = TIDX & 63;
  const float4* xr = (const float4*)(x + (size_t)t * DM);
  float ss = 0.f;
#pragma unroll
  for (int i = 0; i < 4; ++i) {
    float4 v = xr[lane + 64 * i];
    ss += v.x * v.x + v.y * v.y + v.z * v.z + v.w * v.w;
    ushort4 o;
    o.x = f2bf(v.x); o.y = f2bf(v.y); o.z = f2bf(v.z); o.w = f2bf(v.w);
    ((ushort4*)(xb + (size_t)t * DM))[lane + 64 * i] = o;
  }
  ss = wave_sum(ss);
  if (lane == 0) rs[t] = rsqrtf(ss * (1.f / DM) + EPSF);
}

__device__ __forceinline__ int win_src(int n) {
  if (n < 2048) return n;
  if (n < 4096) return n + 16;
  int j = n - 4096;
  if (j < 16) return 2048 + j;
  if (j < 32) return 4112 + (j - 16);
  return -1;
}
__device__ __forceinline__ void d_transpose_w(int item, int ntn, float* tile, const float* __restrict__ in, int ldn,
                                              const float* __restrict__ g, unsigned short* __restrict__ out, int mode) {
  const int kt = item / ntn, nt = item % ntn;
  const int tid = TIDX;
  __syncthreads();
#pragma unroll
  for (int i = 0; i < 4; ++i) {
    const int row = (tid >> 4) + 16 * i;
    const int c4 = (tid & 15) * 4;
    const int n = nt * 64 + c4;
    const int src = mode ? win_src(n) : n;
    float4 v = make_float4(0.f, 0.f, 0.f, 0.f);
    if (src >= 0) {
      v = *(const float4*)(in + (size_t)(kt * 64 + row) * ldn + src);
      if (g) { const float gg = g[kt * 64 + row]; v.x *= gg; v.y *= gg; v.z *= gg; v.w *= gg; }
    }
    tile[row * 65 + c4] = v.x; tile[row * 65 + c4 + 1] = v.y; tile[row * 65 + c4 + 2] = v.z; tile[row * 65 + c4 + 3] = v.w;
  }
  __syncthreads();
  {
    const int n = tid >> 2, k16 = (tid & 3) * 16;
    uint4 o0, o1;
    o0.x = pack2(tile[(k16 + 0) * 65 + n], tile[(k16 + 1) * 65 + n]);   o0.y = pack2(tile[(k16 + 2) * 65 + n], tile[(k16 + 3) * 65 + n]);
    o0.z = pack2(tile[(k16 + 4) * 65 + n], tile[(k16 + 5) * 65 + n]);   o0.w = pack2(tile[(k16 + 6) * 65 + n], tile[(k16 + 7) * 65 + n]);
    o1.x = pack2(tile[(k16 + 8) * 65 + n], tile[(k16 + 9) * 65 + n]);   o1.y = pack2(tile[(k16 + 10) * 65 + n], tile[(k16 + 11) * 65 + n]);
    o1.z = pack2(tile[(k16 + 12) * 65 + n], tile[(k16 + 13) * 65 + n]); o1.w = pack2(tile[(k16 + 14) * 65 + n], tile[(k16 + 15) * 65 + n]);
    unsigned short* op = out + (size_t)(nt * 64 + n) * DM + kt * 64 + k16;
    *(uint4*)op = o0;
    *(uint4*)(op + 8) = o1;
  }
}
__device__ __forceinline__ void d_cvt_bf16(int item, const float* __restrict__ src, unsigned short* __restrict__ dst,
                                           const float* __restrict__ rowscale, int rowlen_log2) {
  const size_t base = (size_t)item * 2048 + TIDX * 8;
  float4 a = *(const float4*)(src + base);
  float4 b = *(const float4*)(src + base + 4);
  if (rowscale) {
    const float sc = rowscale[base >> rowlen_log2];
    a.x *= sc; a.y *= sc; a.z *= sc; a.w *= sc; b.x *= sc; b.y *= sc; b.z *= sc; b.w *= sc;
  }
  uint4 o;
  o.x = pack2(a.x, a.y); o.y = pack2(a.z, a.w); o.z = pack2(b.x, b.y); o.w = pack2(b.z, b.w);
  *(uint4*)(dst + base) = o;
}

constexpr int GBM = 128, GBN = 128, GBK = 64, GLD = 64;
struct GemmP {
  const unsigned short* A; const unsigned short* Bt; int lda, ldb, K;
  const float* rowscale;
  unsigned short* obf; int ldo;
  float* of32; int ldf;
  const float* resid;
  const float *a_log, *dt_bias, *i_bias, *f_bias;
  float* rowacc;
};
enum { EPI_INPROJ = 0, EPI_OUTPROJ = 1, EPI_SCORES = 2, EPI_PLAIN = 3 };

template <int EPI>
__device__ __forceinline__ void gemm_tile(const GemmP p, int tm, int tn, unsigned short* smem) {
  unsigned short* As = smem;
  unsigned short* Bs = smem + 2 * GBM * GLD;
  int tid = TIDX;
  asm volatile("" : "+v"(tid));
  const int lane = tid & 63, wid = tid >> 6;
  const int wm = wid >> 1, wn = wid & 1;
  const int m0 = tm * GBM, n0 = tn * GBN;
  f32x4 acc[4][4];
#pragma unroll
  for (int i = 0; i < 4; ++i)
#pragma unroll
    for (int j = 0; j < 4; ++j) acc[i][j] = (f32x4){0.f, 0.f, 0.f, 0.f};

  uint4 ra0, ra1, ra2, ra3, rb0, rb1, rb2, rb3;
  uint4 sa0, sa1, sa2, sa3, sb0, sb1, sb2, sb3;
  const int nk = p.K / GBK;
  const int lrow = tid >> 3, lc8 = tid & 7;
  const unsigned short* Ag = p.A + (size_t)(m0 + lrow) * p.lda + lc8 * 8;
  const unsigned short* Bg = p.Bt + (size_t)(n0 + lrow) * p.ldb + lc8 * 8;
  const size_t a32 = (size_t)32 * p.lda, b32 = (size_t)32 * p.ldb;
#define GLOAD(R, S, kt)                                                  \
  {                                                                      \
    R##0 = *(const uint4*)(Ag + (kt) * GBK);                             \
    R##1 = *(const uint4*)(Ag + a32 + (kt) * GBK);                       \
    R##2 = *(const uint4*)(Ag + 2 * a32 + (kt) * GBK);                   \
    R##3 = *(const uint4*)(Ag + 3 * a32 + (kt) * GBK);                   \
    S##0 = *(const uint4*)(Bg + (kt) * GBK);                             \
    S##1 = *(const uint4*)(Bg + b32 + (kt) * GBK);                       \
    S##2 = *(const uint4*)(Bg + 2 * b32 + (kt) * GBK);                   \
    S##3 = *(const uint4*)(Bg + 3 * b32 + (kt) * GBK);                   \
  }
#define SSTORE(R, S, buf)                                                \
  {                                                                      \
    unsigned short* ad = As + (size_t)(buf) * GBM * GLD + lrow * GLD + ((lc8 ^ (lrow & 7)) * 8); \
    unsigned short* bd = Bs + (size_t)(buf) * GBN * GLD + lrow * GLD + ((lc8 ^ (lrow & 7)) * 8); \
    *(uint4*)(ad) = R##0; *(uint4*)(ad + 32 * GLD) = R##1; *(uint4*)(ad + 64 * GLD) = R##2; *(uint4*)(ad + 96 * GLD) = R##3; \
    *(uint4*)(bd) = S##0; *(uint4*)(bd + 32 * GLD) = S##1; *(uint4*)(bd + 64 * GLD) = S##2; *(uint4*)(bd + 96 * GLD) = S##3; \
  }
#define GCOMPUTE(buf)                                                                                                     \
  {                                                                                                                       \
    const unsigned short* Ab = As + (size_t)(buf) * GBM * GLD;                                                            \
    const unsigned short* Bb = Bs + (size_t)(buf) * GBN * GLD;                                                            \
    _Pragma("unroll") for (int ks = 0; ks < 2; ++ks) {                                                                    \
      bf16x8 a[4], b[4];                                                                                                  \
      const int kc = ((ks * 4 + (lane >> 4)) ^ (lane & 7)) * 8;                   \
      _Pragma("unroll") for (int i = 0; i < 4; ++i) a[i] = *(const bf16x8*)(Ab + (wm * 64 + i * 16 + (lane & 15)) * GLD + kc); \
      _Pragma("unroll") for (int j = 0; j < 4; ++j) b[j] = *(const bf16x8*)(Bb + (wn * 64 + j * 16 + (lane & 15)) * GLD + kc); \
      _Pragma("unroll") for (int i = 0; i < 4; ++i)                                                                       \
        _Pragma("unroll") for (int j = 0; j < 4; ++j)                                                                     \
          acc[i][j] = __builtin_amdgcn_mfma_f32_16x16x32_bf16(b[j], a[i], acc[i][j], 0, 0, 0);               \
    }                                                                                                                     \
  }
  GLOAD(ra, rb, 0);
  if (nk > 1) GLOAD(sa, sb, 1);
  SSTORE(ra, rb, 0);
  __syncthreads();
  for (int kt = 0; kt < nk; kt += 2) {
    if (kt + 2 < nk) GLOAD(ra, rb, kt + 2);
    GCOMPUTE(0);
    if (kt + 1 < nk) SSTORE(sa, sb, 1);
    __syncthreads();
    if (kt + 1 < nk) {
      if (kt + 3 < nk) GLOAD(sa, sb, kt + 3);
      GCOMPUTE(1);
      if (kt + 2 < nk) SSTORE(ra, rb, 0);
      __syncthreads();
    }
  }
#undef GLOAD
#undef SSTORE
#undef GCOMPUTE
#pragma unroll
  for (int i = 0; i < 4; ++i) {
    const int row = m0 + wm * 64 + i * 16 + (lane & 15);
    float rsc = 1.f;
    float rowss = 0.f;
    if (EPI == EPI_INPROJ) rsc = p.rowscale[row];
    if (EPI == EPI_SCORES) {
      const float4* pr = (const float4*)(p.rowscale + (size_t)row * 16);
      const float4 s0 = pr[0], s1 = pr[1], s2 = pr[2], s3 = pr[3];
      const float ssq = ((s0.x + s0.y) + (s0.z + s0.w)) + ((s1.x + s1.y) + (s1.z + s1.w)) + ((s2.x + s2.y) + (s2.z + s2.w)) + ((s3.x + s3.y) + (s3.z + s3.w));
      rsc = rsqrtf(ssq * (1.f / DM) + EPSF);
    }
#pragma unroll
    for (int j = 0; j < 4; ++j) {
      const int col0 = n0 + wn * 64 + j * 16 + (lane >> 4) * 4;
      const float v0 = acc[i][j][0] * rsc, v1 = acc[i][j][1] * rsc, v2 = acc[i][j][2] * rsc, v3 = acc[i][j][3] * rsc;
      if (EPI == EPI_INPROJ) {
        if (col0 < 4096) {
          uint2 pk; pk.x = pack2(v0, v1); pk.y = pack2(v2, v3);
          *(uint2*)(p.obf + (size_t)row * p.ldo + col0) = pk;
        } else if (col0 < 4128) {
          const float vv[4] = {v0, v1, v2, v3};
          float oo[4];
#pragma unroll
          for (int r = 0; r < 4; ++r) {
            const int jg = col0 - 4096 + r, jj = jg & 7;
            const float v = vv[r];
            float o;
            if (jg < 8) o = -expf(p.a_log[jj]) * softplusf(v + p.dt_bias[jj]);
            else if (jg < 16) o = sigmoidf(v);
            else if (jg < 24) o = v + p.i_bias[jj];
            else o = -softplusf(-(v + p.f_bias[jj]));
            oo[r] = o;
          }
          *(float4*)(p.of32 + (size_t)row * p.ldf + (col0 - 4096)) = make_float4(oo[0], oo[1], oo[2], oo[3]);
        }
      } else if (EPI == EPI_OUTPROJ) {
        const float4 xr = *(const float4*)(p.resid + (size_t)row * p.ldf + col0);
        const float x0 = v0 + xr.x, x1 = v1 + xr.y, x2 = v2 + xr.z, x3 = v3 + xr.w;
        *(float4*)(p.of32 + (size_t)row * p.ldf + col0) = make_float4(x0, x1, x2, x3);
        uint2 pk; pk.x = pack2(x0, x1); pk.y = pack2(x2, x3);
        *(uint2*)(p.obf + (size_t)row * p.ldo + col0) = pk;
        rowss += (x0 * x0 + x1 * x1) + (x2 * x2 + x3 * x3);
      } else {
        uint2 pk; pk.x = pack2(v0, v1); pk.y = pack2(v2, v3);
        *(uint2*)(p.obf + (size_t)row * p.ldo + col0) = pk;
      }
    }
    if (EPI == EPI_OUTPROJ) {
      rowss += __shfl_xor(rowss, 16, 64);
      rowss += __shfl_xor(rowss, 32, 64);
      if ((lane >> 4) == 0) p.rowacc[(size_t)row * 16 + tn * 2 + wn] = rowss;
    }
  }
}

__device__ __forceinline__ bool xcd_tile(int bid, int nb, int k, int ntn, int& tm, int& tn) {
  const int q = ((bid >> 3) * 2 + HB) + (nb >> 3) * 2 * k;
  const bool ok = q < 16 * ntn;
  const int qq = ok ? q : (16 * ntn - 1);
  const int g = qq / (8 * ntn), rem = qq % (8 * ntn);
  tn = rem >> 3;
  tm = 16 * (bid & 7) + 8 * g + (rem & 7);
  return ok;
}

__device__ __forceinline__ int g8_lds_byte(int r, int c) {
  const int st = (r >> 4) * 2 + (c >> 5), rr = r & 15, cc = c & 31, ob = rr * 64 + cc * 2;
  return st * 1024 + (ob ^ (((ob >> 9) & 1) << 5));
}
__device__ __forceinline__ void g8_stage_rc(int b, int& R, int& C) {
  const int st = b / 1024, sb = b % 1024, swz = sb ^ (((sb >> 9) & 1) << 5);
  R = (st >> 1) * 16 + swz / 64; C = (st & 1) * 32 + (swz % 64) / 2;
}
template <int EPI>
__device__ __forceinline__ void gemm256_tile(const GemmP p, int tm, int tn, char* shm_c) {
  constexpr int BK = 64, HALF = 128, HT = HALF * BK;
  const int K = p.K;
  int tidx = threadIdx.x;
  asm volatile("" : "+v"(tidx));
  unsigned short* shm = (unsigned short*)shm_c;
  const unsigned short* A = p.A;
  const unsigned short* Bt = p.Bt;
#define SA(b, h) (shm + ((b) * 2 + (h)) * HT)
#define SB(b, h) (shm + (4 + (b) * 2 + (h)) * HT)
#define STAGE(P_, BASE, br, kt) do { const long _g = (long)(br) * K + (long)(kt) * BK; \
    for (int _i = 0; _i < 2; ++_i) { const int _b = tidx * 16 + _i * 8192; int _r, _c; g8_stage_rc(_b, _r, _c); \
      __builtin_amdgcn_global_load_lds((const unsigned*)(BASE + _g + (long)_r * K + _c), \
        (__attribute__((address_space(3))) unsigned*)((char*)(P_) + _b), 16, 0, 0); } } while (0)
#define LDA(dst, b, h) for (int m = 0; m < 4; ++m) for (int k = 0; k < 2; ++k) \
    dst[m][k] = *reinterpret_cast<const bf16x8*>((char*)SA(b, h) + g8_lds_byte(wr * 64 + m * 16 + fr, k * 32 + fq * 8))
#define LDB(dst, b, h) for (int n = 0; n < 2; ++n) for (int k = 0; k < 2; ++k) \
    dst[n][k] = *reinterpret_cast<const bf16x8*>((char*)SB(b, h) + g8_lds_byte(wc * 32 + n * 16 + fr, k * 32 + fq * 8))
#define MMA(ai, bj, At_, Bt_) do { __builtin_amdgcn_s_setprio(1); \
    for (int m = 0; m < 4; ++m) for (int n = 0; n < 2; ++n) for (int k = 0; k < 2; ++k) \
      acc[ai][bj][m][n] = __builtin_amdgcn_mfma_f32_16x16x32_bf16(Bt_[n][k], At_[m][k], acc[ai][bj][m][n], 0, 0, 0); \
    __builtin_amdgcn_s_setprio(0); } while (0)
#define WAIT_V(n) asm volatile("s_waitcnt vmcnt(" #n ")" ::: "memory")
#define WAIT_L(n) asm volatile("s_waitcnt lgkmcnt(" #n ")" ::: "memory")
#define BAR __builtin_amdgcn_s_barrier()
#define SCHED __builtin_amdgcn_sched_barrier(0)
  const int brow = tm * 256, bcol = tn * 256;
  const int wid = __builtin_amdgcn_readfirstlane(tidx >> 6), lane = tidx & 63, wr = wid >> 2, wc = wid & 3, fr = lane & 15, fq = lane >> 4;
  f32x4 acc[2][2][4][2] = {};
  bf16x8 At[4][2], B0[2][2], B1[2][2];
  const int nt = K / BK;
  STAGE(SB(0, 0), Bt, bcol, 0); STAGE(SA(0, 0), A, brow, 0);
  STAGE(SB(0, 1), Bt, bcol + HALF, 0); STAGE(SA(0, 1), A, brow + HALF, 0);
  if (wr == 1) BAR;
  WAIT_V(4); BAR;
  STAGE(SB(1, 0), Bt, bcol, 1); STAGE(SA(1, 0), A, brow, 1); STAGE(SB(1, 1), Bt, bcol + HALF, 1);
  WAIT_V(6); BAR;
#pragma unroll 1
  for (int t = 0; t < nt - 2; t += 2) {
    LDB(B0, 0, 0); SCHED; LDA(At, 0, 0); STAGE(SA(1, 1), A, brow + HALF, t + 1);
    WAIT_L(8); BAR; WAIT_L(0); MMA(0, 0, At, B0); BAR; SCHED;
    LDB(B1, 0, 1); STAGE(SB(0, 0), Bt, bcol, t + 2);
    BAR; WAIT_L(0); MMA(0, 1, At, B1); BAR;
    LDA(At, 0, 1); STAGE(SA(0, 0), A, brow, t + 2);
    BAR; WAIT_L(0); MMA(1, 0, At, B0); BAR; SCHED;
    STAGE(SB(0, 1), Bt, bcol + HALF, t + 2);
    WAIT_V(6); BAR; MMA(1, 1, At, B1); BAR;
    LDB(B0, 1, 0); SCHED; LDA(At, 1, 0); STAGE(SA(0, 1), A, brow + HALF, t + 2);
    WAIT_L(8); BAR; WAIT_L(0); MMA(0, 0, At, B0); BAR; SCHED;
    LDB(B1, 1, 1); STAGE(SB(1, 0), Bt, bcol, t + 3);
    BAR; WAIT_L(0); MMA(0, 1, At, B1); BAR;
    LDA(At, 1, 1); STAGE(SA(1, 0), A, brow, t + 3);
    BAR; WAIT_L(0); MMA(1, 0, At, B0); BAR; SCHED;
    STAGE(SB(1, 1), Bt, bcol + HALF, t + 3);
    WAIT_V(6); BAR; MMA(1, 1, At, B1); BAR;
  }
  { LDB(B0, 0, 0); LDA(At, 0, 0); STAGE(SA(1, 1), A, brow + HALF, nt - 1);
    BAR; WAIT_L(0); MMA(0, 0, At, B0); BAR;
    LDB(B1, 0, 1); BAR; WAIT_L(0); MMA(0, 1, At, B1); BAR;
    LDA(At, 0, 1); WAIT_V(4); BAR; WAIT_L(0); MMA(1, 0, At, B0); MMA(1, 1, At, B1); BAR; }
  { LDB(B0, 1, 0); LDA(At, 1, 0); WAIT_V(2); BAR; WAIT_L(0); MMA(0, 0, At, B0); BAR;
    LDB(B1, 1, 1); WAIT_V(0); BAR; WAIT_L(0); MMA(0, 1, At, B1); BAR;
    LDA(At, 1, 1); BAR; WAIT_L(0); MMA(1, 0, At, B0); MMA(1, 1, At, B1); BAR; }
  if (wr == 0) BAR;
#undef SA
#undef SB
#undef STAGE
#undef LDA
#undef LDB
#undef MMA
#undef WAIT_V
#undef WAIT_L
#undef BAR
#undef SCHED
#pragma unroll
  for (int ai = 0; ai < 2; ++ai)
#pragma unroll
    for (int m = 0; m < 4; ++m) {
      const int row = brow + ai * 128 + wr * 64 + m * 16 + fr;
      float rsc = 1.f;
      float rowss = 0.f;
      if (EPI == EPI_INPROJ) rsc = p.rowscale[row];
      if (EPI == EPI_SCORES) {
        const float4* pr = (const float4*)(p.rowscale + (size_t)row * 16);
        const float4 s0 = pr[0], s1 = pr[1], s2 = pr[2], s3 = pr[3];
        const float ssq = ((s0.x + s0.y) + (s0.z + s0.w)) + ((s1.x + s1.y) + (s1.z + s1.w)) + ((s2.x + s2.y) + (s2.z + s2.w)) + ((s3.x + s3.y) + (s3.z + s3.w));
        rsc = rsqrtf(ssq * (1.f / DM) + EPSF);
      }
#pragma unroll
      for (int bj = 0; bj < 2; ++bj)
#pragma unroll
        for (int n = 0; n < 2; ++n) {
          const int col0 = bcol + bj * 128 + wc * 32 + n * 16 + fq * 4;
          const f32x4 a = acc[ai][bj][m][n];
          const float v0 = a[0] * rsc, v1 = a[1] * rsc, v2 = a[2] * rsc, v3 = a[3] * rsc;
          if (EPI == EPI_OUTPROJ) {
            const float4 xr = *(const float4*)(p.resid + (size_t)row * p.ldf + col0);
            const float x0 = v0 + xr.x, x1 = v1 + xr.y, x2 = v2 + xr.z, x3 = v3 + xr.w;
            *(float4*)(p.of32 + (size_t)row * p.ldf + col0) = make_float4(x0, x1, x2, x3);
            uint2 pk; pk.x = pack2(x0, x1); pk.y = pack2(x2, x3);
            *(uint2*)(p.obf + (size_t)row * p.ldo + col0) = pk;
            rowss += (x0 * x0 + x1 * x1) + (x2 * x2 + x3 * x3);
          } else {
            uint2 pk; pk.x = pack2(v0, v1); pk.y = pack2(v2, v3);
            *(uint2*)(p.obf + (size_t)row * p.ldo + col0) = pk;
          }
        }
      if (EPI == EPI_OUTPROJ) {
        rowss += __shfl_xor(rowss, 16, 64);
        rowss += __shfl_xor(rowss, 32, 64);
        if (fq == 0) p.rowacc[(size_t)row * 16 + tn * 4 + wc] = rowss;
      }
    }
}
__device__ __forceinline__ void d_gate_proj(int item, const unsigned short* __restrict__ xb, const unsigned short* __restrict__ winT,
                                            const float* __restrict__ rs1, const float* __restrict__ a_log,
                                            const float* __restrict__ dt_bias, const float* __restrict__ i_bias,
                                            const float* __restrict__ f_bias, float* __restrict__ gt) {
  const int job = item * 8 + (threadIdx.x >> 6);
  const int lane = threadIdx.x & 63, fr = lane & 15, fq = lane >> 4;
  const int t0 = job * 16;
  const unsigned short* ap = xb + (size_t)(t0 + fr) * DM + 8 * fq;
  const unsigned short* bp0 = winT + (size_t)(4096 + fr) * DM + 8 * fq;
  const unsigned short* bp1 = winT + (size_t)(4096 + 16 + fr) * DM + 8 * fq;
  f32x4 acc0 = {0.f, 0.f, 0.f, 0.f}, acc1 = {0.f, 0.f, 0.f, 0.f};
#pragma unroll 8
  for (int s2 = 0; s2 < 32; ++s2) {
    const bf16x8 a = *(const bf16x8*)(ap + 32 * s2);
    const bf16x8 b0 = *(const bf16x8*)(bp0 + 32 * s2);
    const bf16x8 b1 = *(const bf16x8*)(bp1 + 32 * s2);
    acc0 = __builtin_amdgcn_mfma_f32_16x16x32_bf16(a, b0, acc0, 0, 0, 0);
    acc1 = __builtin_amdgcn_mfma_f32_16x16x32_bf16(a, b1, acc1, 0, 0, 0);
  }
  const int jj = fr & 7;
  const float al = -expf(a_log[jj]), db = dt_bias[jj], ib = i_bias[jj], fb = f_bias[jj];
#pragma unroll
  for (int j = 0; j < 4; ++j) {
    const int t = t0 + 4 * fq + j;
    const float r = rs1[t];
    const float v0 = acc0[j] * r, v1 = acc1[j] * r;
    const float o0 = (fr < 8) ? al * softplusf(v0 + db) : sigmoidf(v0);
    const float o1 = (fr < 8) ? (v1 + ib) : -softplusf(-(v1 + fb));
    gt[(size_t)t * 32 + fr] = o0;
    gt[(size_t)t * 32 + 16 + fr] = o1;
  }
}

__device__ __forceinline__ bool xcd_tile256(int bid, int nb, int k, int ntn, int& tm, int& tn) {
  const int q = (bid >> 3) + (nb >> 3) * k;
  if (q >= 8 * ntn) return false;
  tn = q >> 3;
  tm = 8 * (bid & 7) + (q & 7);
  return true;
}

__device__ __forceinline__ void d_conv(int item, const unsigned short* __restrict__ pm, const float* __restrict__ pg,
                                              const float* __restrict__ conv_w, const float* __restrict__ a_log,
                                              const float* __restrict__ dt_bias, const float* __restrict__ i_bias,
                                              const float* __restrict__ f_bias, unsigned short* __restrict__ qkv,
                                              float* __restrict__ gt) {
  int t = item * 4 + (TIDX >> 6);
  int lane = TIDX & 63;
  int s = t & (SEQ - 1);
  for (int sec = 0; sec < 3; ++sec) {
    for (int h = 0; h < 4; ++h) {
      int c0 = sec * 512 + h * 128 + 2 * lane;
      float a0 = 0.f, a1 = 0.f;
#pragma unroll
      for (int j = 0; j < 5; ++j) {
        int sp = s + j - 2;
        if (sp >= 0 && sp < SEQ) {
          unsigned v = *(const unsigned*)(pm + (size_t)(t + j - 2) * 4096 + c0);
          a0 += conv_w[c0 * 5 + j] * bf2f((unsigned short)(v & 0xffff));
          a1 += conv_w[(c0 + 1) * 5 + j] * bf2f((unsigned short)(v >> 16));
        }
      }
      a0 = a0 * sigmoidf(a0);
      a1 = a1 * sigmoidf(a1);
      if (sec < 2) {
        float ss = wave_sum(a0 * a0 + a1 * a1);
        float sc = rsqrtf(ss + EPSF);
        if (sec == 0) sc *= 0.08838834764831845f;
        a0 *= sc; a1 *= sc;
      }
      unsigned o = pack2(a0, a1);
      *(unsigned*)(qkv + (size_t)t * 1536 + c0) = o;
    }
  }
}

__device__ __forceinline__ void d_gdn_rec(int chain, float* sq, float* sk, const unsigned short* __restrict__ qkv,
                                                 const float* __restrict__ gt, unsigned short* __restrict__ oA, int ntok) {
  const int bh = chain >> 1, dir = chain & 1;
  const int b = bh >> 2, h = bh & 3;
  const int e = TIDX & 127;
  float S[128];
#pragma unroll
  for (int d = 0; d < 128; ++d) S[d] = 0.f;
  for (int it = 0; it < SEQ; ++it) {
    const int s = dir ? (SEQ - 1 - it) : it;
    const size_t t = (size_t)b * SEQ + s;
    __syncthreads();
    sq[e] = bf2f(qkv[t * 1536 + h * 128 + e]);
    sk[e] = bf2f(qkv[t * 1536 + 512 + h * 128 + e]);
    const float v = bf2f(qkv[t * 1536 + 1024 + h * 128 + e]);
    const float g = gt[t * 32 + dir * 4 + h];
    const float beta = gt[t * 32 + 8 + dir * 4 + h];
    __syncthreads();
    const float a = expf(g);
    float k0 = 0.f, k1 = 0.f, k2 = 0.f, k3 = 0.f;
#pragma unroll
    for (int d = 0; d < 128; d += 4) {
      k0 += sk[d] * S[d]; k1 += sk[d + 1] * S[d + 1]; k2 += sk[d + 2] * S[d + 2]; k3 += sk[d + 3] * S[d + 3];
    }
    const float kS = a * ((k0 + k1) + (k2 + k3));
    const float vn = beta * (v - kS);
    float o0 = 0.f, o1 = 0.f, o2 = 0.f, o3 = 0.f;
#pragma unroll
    for (int d = 0; d < 128; d += 4) {
      S[d] = a * S[d] + sk[d] * vn;             o0 += sq[d] * S[d];
      S[d + 1] = a * S[d + 1] + sk[d + 1] * vn; o1 += sq[d + 1] * S[d + 1];
      S[d + 2] = a * S[d + 2] + sk[d + 2] * vn; o2 += sq[d + 2] * S[d + 2];
      S[d + 3] = a * S[d + 3] + sk[d + 3] * vn; o3 += sq[d + 3] * S[d + 3];
    }
    oA[((size_t)dir * ntok + t) * 512 + h * 128 + e] = f2bf((o0 + o1) + (o2 + o3));
  }
}

__device__ __forceinline__ void d_mlstm_rec(int chain, float* sq, float* sk, const unsigned short* __restrict__ pm,
                                                   const float* __restrict__ gt, unsigned short* __restrict__ oM, int ntok) {
  const int bh = chain >> 1, dir = chain & 1;
  const int b = bh >> 2, h = bh & 3;
  const int e = TIDX & 127, lane = e & 63;
  float C[128];
#pragma unroll
  for (int d = 0; d < 128; ++d) C[d] = 0.f;
  float n0 = 0.f, n1 = 0.f, m = 0.f;
  for (int it = 0; it < SEQ; ++it) {
    const int s = dir ? (SEQ - 1 - it) : it;
    const size_t t = (size_t)b * SEQ + s;
    __syncthreads();
    sq[e] = bf2f(pm[t * 4096 + 2048 + h * 128 + e]);
    sk[e] = bf2f(pm[t * 4096 + 2560 + h * 128 + e]) * 0.08838834764831845f;
    const float v = bf2f(pm[t * 4096 + 3072 + h * 128 + e]);
    const float ip = gt[t * 32 + 16 + dir * 4 + h];
    const float lf = gt[t * 32 + 24 + dir * 4 + h];
    __syncthreads();
    const float mn = fmaxf(lf + m, ip);
    const float fs = expf(lf + m - mn);
    const float is = expf(ip - mn);
    m = mn;
    n0 = fs * n0 + is * sk[lane];
    n1 = fs * n1 + is * sk[lane + 64];
    const float den = wave_sum(n0 * sq[lane] + n1 * sq[lane + 64]);
    const float iv = is * v;
    float o0 = 0.f, o1 = 0.f, o2 = 0.f, o3 = 0.f;
#pragma unroll
    for (int d = 0; d < 128; d += 4) {
      C[d] = fs * C[d] + sk[d] * iv;             o0 += sq[d] * C[d];
      C[d + 1] = fs * C[d + 1] + sk[d + 1] * iv; o1 += sq[d + 1] * C[d + 1];
      C[d + 2] = fs * C[d + 2] + sk[d + 2] * iv; o2 += sq[d + 2] * C[d + 2];
      C[d + 3] = fs * C[d + 3] + sk[d + 3] * iv; o3 += sq[d + 3] * C[d + 3];
    }
    const float num = (o0 + o1) + (o2 + o3);
    const float hh = num / fmaxf(fabsf(den), expf(-mn));
    oM[((size_t)dir * ntok + t) * 512 + h * 128 + e] = f2bf(hh);
  }
}

__device__ __forceinline__ void d_combine(int item, const unsigned short* __restrict__ uo, const unsigned short* __restrict__ oM,
                                                 const unsigned short* __restrict__ pm, const float* __restrict__ gdn_g,
                                                 const float* __restrict__ ml_g, unsigned short* __restrict__ y) {
  int tid_ = TIDX;
  asm volatile("" : "+v"(tid_));
  const int t = item * 4 + (tid_ >> 6);
  const int lane = tid_ & 63;
  const int b = t >> 12, cc = (t >> 6) & 63, ii = t & 63;
  unsigned gf_[4], gb_[4], mf_[4], mb_[4], zg_[4], zo_[4];
  const size_t off = (size_t)cc * 8192 + (lane >> 4) * 2048 + ii * 32 + ((2 * lane) & 31);
#pragma unroll
  for (int h = 0; h < 4; ++h) {
    const int c = h * 128 + 2 * lane;
    const int chain0 = (b * 4 + h) * 2;
    gf_[h] = *(const unsigned*)(uo + (size_t)chain0 * 64 * 8192 + off);
    gb_[h] = *(const unsigned*)(uo + (size_t)(chain0 + 1) * 64 * 8192 + off);
    mf_[h] = *(const unsigned*)(oM + (size_t)t * 512 + c);
    mb_[h] = *(const unsigned*)(oM + ((size_t)NT + t) * 512 + c);
    zg_[h] = *(const unsigned*)(pm + (size_t)t * 4096 + 1536 + c);
    zo_[h] = *(const unsigned*)(pm + (size_t)t * 4096 + 3584 + c);
  }
  const float gg0 = gdn_g[2 * lane], gg1 = gdn_g[2 * lane + 1];
  float a0[4], a1[4], m0[4], m1[4], sa[4], sm[4];
#pragma unroll
  for (int h = 0; h < 4; ++h) {
    a0[h] = bf2f(gf_[h] & 0xffff) + bf2f(gb_[h] & 0xffff);
    a1[h] = __uint_as_float(gf_[h] & 0xffff0000u) + __uint_as_float(gb_[h] & 0xffff0000u);
    m0[h] = bf2f(mf_[h] & 0xffff) + bf2f(mb_[h] & 0xffff);
    m1[h] = __uint_as_float(mf_[h] & 0xffff0000u) + __uint_as_float(mb_[h] & 0xffff0000u);
    sa[h] = a0[h] * a0[h] + a1[h] * a1[h];
    sm[h] = m0[h] * m0[h] + m1[h] * m1[h];
  }
#pragma unroll
  for (int o = 32; o > 0; o >>= 1) {
#pragma unroll
    for (int h = 0; h < 4; ++h) { sa[h] += __shfl_xor(sa[h], o, 64); sm[h] += __shfl_xor(sm[h], o, 64); }
  }
#pragma unroll
  for (int h = 0; h < 4; ++h) {
    const int c = h * 128 + 2 * lane;
    const float sca = rsqrtf(sa[h] * (1.f / 128.f) + EPSF);
    const float scm = rsqrtf(sm[h] * (1.f / 128.f) + EPSF);
    const float z0 = bf2f(zg_[h] & 0xffff), z1 = __uint_as_float(zg_[h] & 0xffff0000u);
    const float q0 = bf2f(zo_[h] & 0xffff), q1 = __uint_as_float(zo_[h] & 0xffff0000u);
    const float o0 = a0[h] * sca * gg0 * (z0 * sigmoidf(z0));
    const float o1 = a1[h] * sca * gg1 * (z1 * sigmoidf(z1));
    const float p0 = m0[h] * scm * ml_g[c] * sigmoidf(q0);
    const float p1 = m1[h] * scm * ml_g[c + 1] * sigmoidf(q1);
    *(unsigned*)(y + (size_t)t * DM + c) = pack2(o0, o1);
    *(unsigned*)(y + (size_t)t * DM + 512 + c) = pack2(p0, p1);
  }
}

#ifdef DBG_CHECK
__device__ __forceinline__ void d_dbg_cmp(int item, const unsigned short* __restrict__ uo, const unsigned short* __restrict__ oAd,
                                          float* __restrict__ dbg) {
  int t = item * 4 + (TIDX >> 6);
  int lane = TIDX & 63;
  const int cc = (t >> 6) & 63, ii = t & 63;
  float sd = 0.f, sr = 0.f;
  for (int h = 0; h < 4; ++h) {
    for (int dir = 0; dir < 2; ++dir) {
      const int chain = h * 2 + dir;
      const size_t off = (size_t)cc * 8192 + (lane >> 4) * 2048 + ii * 32 + ((2 * lane) & 31);
      unsigned vn = *(const unsigned*)(uo + (size_t)chain * 64 * 8192 + off);
      unsigned vr = *(const unsigned*)(oAd + ((size_t)dir * 4096 + t) * 512 + h * 128 + 2 * lane);
      float n0 = bf2f(vn & 0xffff), n1 = bf2f(vn >> 16), r0 = bf2f(vr & 0xffff), r1 = bf2f(vr >> 16);
      sd += (n0 - r0) * (n0 - r0) + (n1 - r1) * (n1 - r1);
      sr += r0 * r0 + r1 * r1;
    }
  }
  sd = wave_sum(sd); sr = wave_sum(sr);
  if (lane == 0) { atomicAdd(&dbg[0], sd); atomicAdd(&dbg[1], sr); }
}
__device__ __forceinline__ void d_dbg_cmp_m(int item, const unsigned short* __restrict__ oM, const unsigned short* __restrict__ oMd,
                                            float* __restrict__ dbg) {
  int t = item * 4 + (TIDX >> 6);
  int lane = TIDX & 63;
  float sd = 0.f, sr = 0.f;
  for (int dir = 0; dir < 2; ++dir)
    for (int q = 0; q < 4; ++q) {
      unsigned vn = *(const unsigned*)(oM + ((size_t)dir * NT + t) * 512 + q * 128 + 2 * lane);
      unsigned vr = *(const unsigned*)(oMd + ((size_t)dir * 4096 + t) * 512 + q * 128 + 2 * lane);
      float n0 = bf2f(vn & 0xffff), n1 = bf2f(vn >> 16), r0 = bf2f(vr & 0xffff), r1 = bf2f(vr >> 16);
      sd += (n0 - r0) * (n0 - r0) + (n1 - r1) * (n1 - r1);
      sr += r0 * r0 + r1 * r1;
    }
  sd = wave_sum(sd); sr = wave_sum(sr);
  if (lane == 0) { atomicAdd(&dbg[0], sd); atomicAdd(&dbg[1], sr); }
}
#endif

__device__ __forceinline__ void d_prep_x1(int item, const float* __restrict__ x1, unsigned short* __restrict__ xb,
                                                 float* __restrict__ rs) {
  int t = item * 4 + (TIDX >> 6);
  int lane = TIDX & 63;
  const float4* xr = (const float4*)(x1 + (size_t)t * DM);
  float ss = 0.f;
#pragma unroll
  for (int i = 0; i < 4; ++i) {
    float4 v = xr[lane + 64 * i];
    ss += v.x * v.x + v.y * v.y + v.z * v.z + v.w * v.w;
    ushort4 o;
    o.x = f2bf(v.x); o.y = f2bf(v.y); o.z = f2bf(v.z); o.w = f2bf(v.w);
    ((ushort4*)(xb + (size_t)t * DM))[lane + 64 * i] = o;
  }
  ss = wave_sum(ss);
  if (lane == 0) rs[t] = rsqrtf(ss * (1.f / DM) + EPSF);
}

__device__ const unsigned char kPairTab[64] = {
    0x00, 0x01, 0x02, 0x03, 0x04, 0x05, 0x06, 0x07, 0x08, 0x09, 0x0a, 0x0b, 0x0c, 0x0d, 0x0e, 0x0f,
    0x10, 0x11, 0x12, 0x13, 0x14, 0x15, 0x16, 0x17,
    0x20, 0x21, 0x22, 0x23, 0x24,
    0x30, 0x31, 0x32, 0x33,
    0x40, 0x41, 0x42,
    0x50, 0x51, 0x60, 0x61, 0x70, 0x71,
    0x80, 0x90, 0xa0, 0xb0, 0xc0, 0xd0, 0xe0, 0xf0,
    0xff, 0xff, 0xff, 0xff, 0xff, 0xff, 0xff, 0xff, 0xff, 0xff, 0xff, 0xff, 0xff, 0xff};

__device__ __forceinline__ void sort16_desc(unsigned (&a)[16]) {
#pragma unroll
  for (int k = 2; k <= 16; k <<= 1)
#pragma unroll
    for (int j = k >> 1; j > 0; j >>= 1)
#pragma unroll
      for (int i = 0; i < 16; ++i) {
        const int l = i ^ j;
        if (l > i) {
          const unsigned hi = max(a[i], a[l]), lo = min(a[i], a[l]);
          if ((i & k) == 0) { a[i] = hi; a[l] = lo; } else { a[i] = lo; a[l] = hi; }
        }
      }
}
__device__ __forceinline__ void merge16_desc(unsigned (&top)[16], const unsigned (&b)[16]) {
#pragma unroll
  for (int i = 0; i < 16; ++i) top[i] = max(top[i], b[15 - i]);
#pragma unroll
  for (int j = 8; j > 0; j >>= 1)
#pragma unroll
    for (int i = 0; i < 16; ++i) {
      const int l = i ^ j;
      if (l > i) {
        const unsigned hi = max(top[i], top[l]), lo = min(top[i], top[l]);
        top[i] = hi; top[l] = lo;
      }
    }
}
__device__ __forceinline__ unsigned key16(unsigned hbits, int idx) {
  const unsigned m = hbits ^ ((hbits & 0x8000u) ? 0xFFFFu : 0x8000u);
  return (m << 16) | (unsigned)(127 - idx);
}
__device__ __forceinline__ void top16_of_128(const unsigned short* __restrict__ sp, unsigned (&top)[16]) {
#pragma unroll
  for (int g = 0; g < 8; ++g) {
    const uint4 x0 = *(const uint4*)(sp + g * 16);
    const uint4 x1 = *(const uint4*)(sp + g * 16 + 8);
    unsigned b[16];
    b[0] = key16(x0.x & 0xffff, g * 16 + 0);  b[1] = key16(x0.x >> 16, g * 16 + 1);
    b[2] = key16(x0.y & 0xffff, g * 16 + 2);  b[3] = key16(x0.y >> 16, g * 16 + 3);
    b[4] = key16(x0.z & 0xffff, g * 16 + 4);  b[5] = key16(x0.z >> 16, g * 16 + 5);
    b[6] = key16(x0.w & 0xffff, g * 16 + 6);  b[7] = key16(x0.w >> 16, g * 16 + 7);
    b[8] = key16(x1.x & 0xffff, g * 16 + 8);  b[9] = key16(x1.x >> 16, g * 16 + 9);
    b[10] = key16(x1.y & 0xffff, g * 16 + 10); b[11] = key16(x1.y >> 16, g * 16 + 11);
    b[12] = key16(x1.z & 0xffff, g * 16 + 12); b[13] = key16(x1.z >> 16, g * 16 + 13);
    b[14] = key16(x1.w & 0xffff, g * 16 + 14); b[15] = key16(x1.w >> 16, g * 16 + 15);
    sort16_desc(b);
    if (g == 0) {
#pragma unroll
      for (int i = 0; i < 16; ++i) top[i] = b[i];
    } else {
      merge16_desc(top, b);
    }
  }
}

__device__ __forceinline__ void d_topk(int item, const unsigned short* __restrict__ scores, int* __restrict__ idx_out,
                                       float* __restrict__ gate_out) {
  int tid_ = TIDX;
  asm volatile("" : "+v"(tid_));
  const int pair = item * 256 + tid_;
  const unsigned short* sp = scores + (size_t)pair * 256;
  unsigned k0[16], k1[16];
  top16_of_128(sp, k0);
  top16_of_128(sp + 128, k1);
  float v0[16], v1[16];
  int i0[16], i1[16];
#pragma unroll
  for (int i = 0; i < 16; ++i) {
    const unsigned m0 = k0[i] >> 16, m1 = k1[i] >> 16;
    v0[i] = bf2f((unsigned short)(m0 ^ ((m0 & 0x8000u) ? 0x8000u : 0xFFFFu)));
    v1[i] = bf2f((unsigned short)(m1 ^ ((m1 & 0x8000u) ? 0x8000u : 0xFFFFu)));
    i0[i] = 127 - (int)(k0[i] & 127u);
    i1[i] = 127 - (int)(k1[i] & 127u);
  }
  unsigned top[16];
#pragma unroll
  for (int g = 0; g < 4; ++g) {
    unsigned b[16];
#pragma unroll
    for (int q = 0; q < 16; ++q) {
      const int pr = kPairTab[g * 16 + q];
      if (pr == 0xff) {
        b[q] = 0u;
      } else {
        const int pi = pr >> 4, pj = pr & 15;
        const float sum = v0[pi] + v1[pj];
        const unsigned u = __float_as_uint(sum);
        const unsigned mono = u ^ ((u & 0x80000000u) ? 0xFFFFFFFFu : 0x80000000u);
        b[q] = (mono & 0xFFFFC000u) | (unsigned)(16383 - (i0[pi] * 128 + i1[pj]));
      }
    }
    sort16_desc(b);
    if (g == 0) {
#pragma unroll
      for (int i = 0; i < 16; ++i) top[i] = b[i];
    } else {
      merge16_desc(top, b);
    }
  }
  float ev[16];
  int ci[16];
  float mx = 0.f, sum = 0.f;
#pragma unroll
  for (int i = 0; i < 16; ++i) {
    const unsigned mono = top[i] & 0xFFFFC000u;
    const unsigned u = mono ^ ((mono & 0x80000000u) ? 0x80000000u : 0xFFFFFFFFu);
    const float val = __uint_as_float(u & 0xFFFFC000u);
    ci[i] = 16383 - (int)(top[i] & 16383u);
    if (i == 0) mx = val;
    ev[i] = expf(val - mx);
    sum += ev[i];
  }
  const float inv = 1.f / sum;
#pragma unroll
  for (int q = 0; q < 4; ++q) {
    int4 o; float4 g;
    o.x = ci[4 * q]; o.y = ci[4 * q + 1]; o.z = ci[4 * q + 2]; o.w = ci[4 * q + 3];
    g.x = ev[4 * q] * inv; g.y = ev[4 * q + 1] * inv; g.z = ev[4 * q + 2] * inv; g.w = ev[4 * q + 3] * inv;
    *(int4*)(idx_out + (size_t)pair * 16 + 4 * q) = o;
    *(float4*)(gate_out + (size_t)pair * 16 + 4 * q) = g;
  }
}

typedef float f32x2 __attribute__((ext_vector_type(2)));
__device__ __forceinline__ float wave_max_dpp(float v) {
#define DPP_MAX(v, ctrl) v = fmaxf(v, __builtin_bit_cast(float, __builtin_amdgcn_update_dpp(0, __builtin_bit_cast(int, v), ctrl, 0xF, 0xF, true)))
  DPP_MAX(v, 0xB1); DPP_MAX(v, 0x4E); DPP_MAX(v, 0x141); DPP_MAX(v, 0x140);
#undef DPP_MAX
  const float r0 = __builtin_bit_cast(float, __builtin_amdgcn_readlane(__builtin_bit_cast(int, v), 0));
  const float r1 = __builtin_bit_cast(float, __builtin_amdgcn_readlane(__builtin_bit_cast(int, v), 16));
  const float r2 = __builtin_bit_cast(float, __builtin_amdgcn_readlane(__builtin_bit_cast(int, v), 32));
  const float r3 = __builtin_bit_cast(float, __builtin_amdgcn_readlane(__builtin_bit_cast(int, v), 48));
  return fmaxf(fmaxf(r0, r1), fmaxf(r2, r3));
}
__device__ __forceinline__ float absmax4(const float4 a) { return fmaxf(fmaxf(fabsf(a.x), fabsf(a.y)), fmaxf(fabsf(a.z), fabsf(a.w))); }
template <bool I8>
__device__ __forceinline__ void d_cvt_tab(int item, const float* __restrict__ src, unsigned* __restrict__ dst8, float* __restrict__ dscale) {
  const int row0 = item * 16 + (TIDX >> 6) * 4;
  const int lane = TIDX & 63;
  float4 a[4][4];
#pragma unroll
  for (int rr = 0; rr < 4; ++rr) {
    const float4* sr = (const float4*)(src + (size_t)(row0 + rr) * DM + lane * 16);
    a[rr][0] = sr[0]; a[rr][1] = sr[1]; a[rr][2] = sr[2]; a[rr][3] = sr[3];
  }
#pragma unroll
  for (int rr = 0; rr < 4; ++rr) {
    const float m = wave_max_dpp(fmaxf(fmaxf(absmax4(a[rr][0]), absmax4(a[rr][1])), fmaxf(absmax4(a[rr][2]), absmax4(a[rr][3]))));
    const float top = I8 ? 127.f : 240.f;
    const float sc = (m > 0.f) ? top / m : 1.f;
    uint4 o;
    unsigned ow[4];
#pragma unroll
    for (int c = 0; c < 4; ++c) {
      const float4 v = a[rr][c];
      if (I8) {
        ow[c] = ((unsigned)__float2int_rn(v.x * sc) & 0xffu) | (((unsigned)__float2int_rn(v.y * sc) & 0xffu) << 8) |
                (((unsigned)__float2int_rn(v.z * sc) & 0xffu) << 16) | (((unsigned)__float2int_rn(v.w * sc) & 0xffu) << 24);
      } else {
        int p = 0;
        p = __builtin_amdgcn_cvt_pk_fp8_f32(v.x * sc, v.y * sc, p, false);
        p = __builtin_amdgcn_cvt_pk_fp8_f32(v.z * sc, v.w * sc, p, true);
        ow[c] = (unsigned)p;
      }
    }
    o.x = ow[0]; o.y = ow[1]; o.z = ow[2]; o.w = ow[3];
    *(uint4*)(dst8 + (size_t)(row0 + rr) * 256 + lane * 4) = o;
    if (lane == 0) dscale[row0 + rr] = (m > 0.f) ? m / top : 1.f;
  }
}

__device__ __forceinline__ float erf_fast(float x) {
  const float ax = fabsf(x);
  const float t = __builtin_amdgcn_rcpf(1.f + 0.3275911f * ax);
  float p = 1.061405429f;
  p = p * t - 1.453152027f;
  p = p * t + 1.421413741f;
  p = p * t - 0.284496736f;
  p = p * t + 0.254829592f;
  const float e = __builtin_amdgcn_exp2f(-1.4426950408889634f * ax * ax);
  const float r = 1.f - p * t * e;
  return copysignf(r, x);
}
__device__ __forceinline__ float dot16_f8(const uint4 u, const float* hv) {
  const f32x2 a0 = __builtin_amdgcn_cvt_pk_f32_fp8((int)u.x, false), a1 = __builtin_amdgcn_cvt_pk_f32_fp8((int)u.x, true);
  const f32x2 b0 = __builtin_amdgcn_cvt_pk_f32_fp8((int)u.y, false), b1 = __builtin_amdgcn_cvt_pk_f32_fp8((int)u.y, true);
  const f32x2 c0 = __builtin_amdgcn_cvt_pk_f32_fp8((int)u.z, false), c1 = __builtin_amdgcn_cvt_pk_f32_fp8((int)u.z, true);
  const f32x2 d0 = __builtin_amdgcn_cvt_pk_f32_fp8((int)u.w, false), d1 = __builtin_amdgcn_cvt_pk_f32_fp8((int)u.w, true);
  float s0 = a0[0] * hv[0] + a0[1] * hv[1];
  float s1 = a1[0] * hv[2] + a1[1] * hv[3];
  s0 += b0[0] * hv[4] + b0[1] * hv[5];
  s1 += b1[0] * hv[6] + b1[1] * hv[7];
  s0 += c0[0] * hv[8] + c0[1] * hv[9];
  s1 += c1[0] * hv[10] + c1[1] * hv[11];
  s0 += d0[0] * hv[12] + d0[1] * hv[13];
  s1 += d1[0] * hv[14] + d1[1] * hv[15];
  return s0 + s1;
}
__device__ __forceinline__ void axpy16_f8(const uint4 v, const float wg, float* acc) {
  const f32x2 a0 = __builtin_amdgcn_cvt_pk_f32_fp8((int)v.x, false), a1 = __builtin_amdgcn_cvt_pk_f32_fp8((int)v.x, true);
  const f32x2 b0 = __builtin_amdgcn_cvt_pk_f32_fp8((int)v.y, false), b1 = __builtin_amdgcn_cvt_pk_f32_fp8((int)v.y, true);
  const f32x2 c0 = __builtin_amdgcn_cvt_pk_f32_fp8((int)v.z, false), c1 = __builtin_amdgcn_cvt_pk_f32_fp8((int)v.z, true);
  const f32x2 d0 = __builtin_amdgcn_cvt_pk_f32_fp8((int)v.w, false), d1 = __builtin_amdgcn_cvt_pk_f32_fp8((int)v.w, true);
  acc[0] += wg * a0[0]; acc[1] += wg * a0[1]; acc[2] += wg * a1[0]; acc[3] += wg * a1[1];
  acc[4] += wg * b0[0]; acc[5] += wg * b0[1]; acc[6] += wg * b1[0]; acc[7] += wg * b1[1];
  acc[8] += wg * c0[0]; acc[9] += wg * c0[1]; acc[10] += wg * c1[0]; acc[11] += wg * c1[1];
  acc[12] += wg * d0[0]; acc[13] += wg * d0[1]; acc[14] += wg * d1[0]; acc[15] += wg * d1[1];
}
typedef int i32x4 __attribute__((ext_vector_type(4)));
__device__ __forceinline__ void d_peer(int item, char* smem, const float* __restrict__ x1, const float* __restrict__ rs2,
                                       const float* __restrict__ g2, const int* __restrict__ idx,
                                       const float* __restrict__ gate, const unsigned* __restrict__ pu,
                                       const unsigned* __restrict__ pv, const float* __restrict__ su,
                                       const float* __restrict__ sv, const float* __restrict__ gf,
                                       float* __restrict__ out, float oscale) {
  int tid_ = TIDX;
  asm volatile("" : "+v"(tid_));
  const int wv = tid_ >> 6;
  const int t = item * 4 + wv;
  const int lane = tid_ & 63, q = lane >> 4;
  char* hq = smem + wv * 1024;
  float r2;
  {
    const float4* pr = (const float4*)(rs2 + (size_t)t * 16);
    const float4 s0 = pr[0], s1 = pr[1], s2 = pr[2], s3 = pr[3];
    const float ssq = ((s0.x + s0.y) + (s0.z + s0.w)) + ((s1.x + s1.y) + (s1.z + s1.w)) + ((s2.x + s2.y) + (s2.z + s2.w)) + ((s3.x + s3.y) + (s3.z + s3.w));
    r2 = rsqrtf(ssq * (1.f / DM) + EPSF);
  }
  float sh;
  {
    float hv[16];
    float m = 0.f;
#pragma unroll
    for (int c = 0; c < 4; ++c) {
      const float4 xx = *(const float4*)(x1 + (size_t)t * DM + lane * 16 + c * 4);
      const float4 gg = *(const float4*)(g2 + lane * 16 + c * 4);
      hv[c * 4 + 0] = xx.x * r2 * gg.x; hv[c * 4 + 1] = xx.y * r2 * gg.y;
      hv[c * 4 + 2] = xx.z * r2 * gg.z; hv[c * 4 + 3] = xx.w * r2 * gg.w;
      m = fmaxf(m, fmaxf(fmaxf(fabsf(hv[c * 4]), fabsf(hv[c * 4 + 1])), fmaxf(fabsf(hv[c * 4 + 2]), fabsf(hv[c * 4 + 3]))));
    }
#pragma unroll
    for (int o = 32; o > 0; o >>= 1) m = fmaxf(m, __shfl_xor(m, o, 64));
    const float sc = (m > 0.f) ? 127.f / m : 1.f;
    sh = (m > 0.f) ? m * (1.f / 127.f) : 1.f;
#define Q8(x) ((unsigned)(__float2int_rn((x) * sc)) & 0xffu)
    uint4 o;
    o.x = Q8(hv[0]) | (Q8(hv[1]) << 8) | (Q8(hv[2]) << 16) | (Q8(hv[3]) << 24);
    o.y = Q8(hv[4]) | (Q8(hv[5]) << 8) | (Q8(hv[6]) << 16) | (Q8(hv[7]) << 24);
    o.z = Q8(hv[8]) | (Q8(hv[9]) << 8) | (Q8(hv[10]) << 16) | (Q8(hv[11]) << 24);
    o.w = Q8(hv[12]) | (Q8(hv[13]) << 8) | (Q8(hv[14]) << 16) | (Q8(hv[15]) << 24);
#undef Q8
    *(uint4*)(hq + lane * 16) = o;
  }
  float acc[16];
#pragma unroll
  for (int i = 0; i < 16; ++i) acc[i] = 0.f;
  float* wl = (float*)(smem + 4096) + wv * 128;
  int ka = (idx[(size_t)t * 128 + lane] << 7) | lane;
  int kb = (idx[(size_t)t * 128 + 64 + lane] << 7) | (64 + lane);
  const float gt_a0 = gate[(size_t)t * 128 + lane], gt_b0 = gate[(size_t)t * 128 + 64 + lane];
#pragma unroll
  for (int k = 2; k <= 128; k <<= 1) {
#pragma unroll
    for (int j = k >> 1; j > 0; j >>= 1) {
      if (j == 64) {
        const int lo = min(ka, kb), hi = max(ka, kb);
        ka = lo; kb = hi;
      } else {
        const int oa = __shfl_xor(ka, j, 64), ob = __shfl_xor(kb, j, 64);
        const bool lower = (lane & j) == 0;
        const bool upa = (lane & k) == 0;
        const bool upb = ((lane + 64) & k) == 0;
        ka = (upa == lower) ? min(ka, oa) : max(ka, oa);
        kb = (upb == lower) ? min(kb, ob) : max(kb, ob);
      }
    }
  }
  const int id_a = ka >> 7, id_b = kb >> 7;
  const int oa_ = ka & 127, ob_ = kb & 127;
  const float ga1 = __shfl(gt_a0, oa_ & 63, 64), ga2 = __shfl(gt_b0, oa_ & 63, 64);
  const float gb1 = __shfl(gt_a0, ob_ & 63, 64), gb2 = __shfl(gt_b0, ob_ & 63, 64);
  const float gt_a = (oa_ < 64) ? ga1 : ga2, gt_b = (ob_ < 64) ? gb1 : gb2;
#define PEER_ULOAD(UA, G)                                                                                   \
  {                                                                                                         \
    const int srcl_ = (16 * (G) + (lane & 15)) & 63;                                                        \
    const int idr_ = ((G) < 4) ? __shfl(id_a, srcl_, 64) : __shfl(id_b, srcl_, 64);                         \
    const char* ub_ = (const char*)pu + (size_t)idr_ * 1024 + 16 * q;                                       \
    _Pragma("unroll") for (int s2 = 0; s2 < 16; ++s2) UA[s2] = *(const i32x4*)(ub_ + 64 * s2);              \
  }
#define PEER_UCOMP(UA, G)                                                                                   \
  {                                                                                                         \
    int ide[4]; float gte[4], sue[4], sve[4];                                                               \
    _Pragma("unroll") for (int reg = 0; reg < 4; ++reg) {                                                   \
      const int el = (16 * (G) + 4 * q + reg) & 63;                                                         \
      ide[reg] = ((G) < 4) ? __shfl(id_a, el, 64) : __shfl(id_b, el, 64);                                   \
      gte[reg] = ((G) < 4) ? __shfl(gt_a, el, 64) : __shfl(gt_b, el, 64);                                   \
      sue[reg] = su[ide[reg]];                                                                              \
      sve[reg] = sv[ide[reg]];                                                                              \
    }                                                                                                       \
    i32x4 d4 = {0, 0, 0, 0};                                                                                \
    _Pragma("unroll") for (int s2 = 0; s2 < 16; ++s2) {                                                     \
      const i32x4 bfr = *(const i32x4*)(hq + 64 * s2 + 16 * q);                                             \
      d4 = __builtin_amdgcn_mfma_i32_16x16x64_i8(UA[s2], bfr, d4, 0, 0, 0);                                 \
    }                                                                                                       \
    float4 w4;                                                                                              \
    const float d0 = (float)d4[0] * (sue[0] * sh), d1 = (float)d4[1] * (sue[1] * sh);                       \
    const float d2 = (float)d4[2] * (sue[2] * sh), d3 = (float)d4[3] * (sue[3] * sh);                       \
    w4.x = gte[0] * sve[0] * 0.5f * d0 * (1.f + erf_fast(d0 * 0.7071067811865476f));                        \
    w4.y = gte[1] * sve[1] * 0.5f * d1 * (1.f + erf_fast(d1 * 0.7071067811865476f));                        \
    w4.z = gte[2] * sve[2] * 0.5f * d2 * (1.f + erf_fast(d2 * 0.7071067811865476f));                        \
    w4.w = gte[3] * sve[3] * 0.5f * d3 * (1.f + erf_fast(d3 * 0.7071067811865476f));                        \
    if ((lane & 15) == 0) *(float4*)(wl + 16 * (G) + 4 * q) = w4;                                           \
  }
  {
    i32x4 uA[16], uB[16];
    PEER_ULOAD(uA, 0);
    for (int g = 0; g < 8; g += 2) {
      PEER_ULOAD(uB, g + 1);
      PEER_UCOMP(uA, g);
      if (g + 2 < 8) PEER_ULOAD(uA, g + 2);
      PEER_UCOMP(uB, g + 1);
    }
  }
#undef PEER_ULOAD
#undef PEER_UCOMP
  for (int e0 = 0; e0 < 128; e0 += 16) {
    uint4 v[16];
#pragma unroll
    for (int k = 0; k < 16; ++k) {
      const int e = (e0 + k) & 63;
      const int id = (e0 < 64) ? __builtin_amdgcn_readlane(id_a, e) : __builtin_amdgcn_readlane(id_b, e);
      v[k] = *(const uint4*)(pv + (size_t)id * 256 + lane * 4);
    }
    const float4 w0 = *(const float4*)(wl + e0), w1 = *(const float4*)(wl + e0 + 4);
    const float4 w2 = *(const float4*)(wl + e0 + 8), w3 = *(const float4*)(wl + e0 + 12);
    axpy16_f8(v[0], w0.x, acc); axpy16_f8(v[1], w0.y, acc); axpy16_f8(v[2], w0.z, acc); axpy16_f8(v[3], w0.w, acc);
    axpy16_f8(v[4], w1.x, acc); axpy16_f8(v[5], w1.y, acc); axpy16_f8(v[6], w1.z, acc); axpy16_f8(v[7], w1.w, acc);
    axpy16_f8(v[8], w2.x, acc); axpy16_f8(v[9], w2.y, acc); axpy16_f8(v[10], w2.z, acc); axpy16_f8(v[11], w2.w, acc);
    axpy16_f8(v[12], w3.x, acc); axpy16_f8(v[13], w3.y, acc); axpy16_f8(v[14], w3.z, acc); axpy16_f8(v[15], w3.w, acc);
  }
  float ss = 0.f;
#pragma unroll
  for (int c = 0; c < 4; ++c) {
    const float4 xx = *(const float4*)(x1 + (size_t)t * DM + lane * 16 + c * 4);
    acc[c * 4 + 0] += xx.x; acc[c * 4 + 1] += xx.y; acc[c * 4 + 2] += xx.z; acc[c * 4 + 3] += xx.w;
  }
#pragma unroll
  for (int i = 0; i < 16; ++i) ss += acc[i] * acc[i];
  ss = wave_sum(ss);
  const float sc = rsqrtf(ss * (1.f / DM) + EPSF) * oscale;
#pragma unroll
  for (int q4 = 0; q4 < 4; ++q4) {
    const float4 gg = *(const float4*)(gf + lane * 16 + q4 * 4);
    float4 o;
    o.x = acc[q4 * 4 + 0] * sc * gg.x; o.y = acc[q4 * 4 + 1] * sc * gg.y;
    o.z = acc[q4 * 4 + 2] * sc * gg.z; o.w = acc[q4 * 4 + 3] * sc * gg.w;
    *(float4*)(out + (size_t)t * DM + lane * 16 + q4 * 4) = o;
  }
}

typedef __attribute__((ext_vector_type(16))) float f32x16;
#define MFMA32(a, b, c) __builtin_amdgcn_mfma_f32_32x32x16_bf16((a), (b), (c), 0, 0, 0)
__device__ __forceinline__ int crow(int reg, int hh) { return (reg & 3) + 8 * (reg >> 2) + 4 * hh; }

struct GdnBufs {
  unsigned short* qc;
  unsigned short* kTc;
  unsigned short* qkc;
  unsigned short* wn;
  unsigned short* uo;
  float* gsc;
};

__device__ __forceinline__ void tri_subst(const float* AL0, int lane, float (&T)[64]) {
  const float* AL = (const float*)__builtin_assume_aligned(AL0, 16);
#pragma unroll
  for (int i = 0; i < 64; ++i) T[i] = 0.f;
  T[0] = (lane == 0) ? 1.f : 0.f;
  float4 cur[16], nxt[16];
#pragma unroll
  for (int j4 = 0; j4 < 1; ++j4) cur[j4] = *(const float4*)(AL + 1 * 72 + 4 * j4);
#pragma unroll
  for (int i = 1; i < 64; ++i) {
    if (i + 1 < 64) {
#pragma unroll
      for (int j4 = 0; j4 < (i + 4) / 4; ++j4) nxt[j4] = *(const float4*)(AL + (i + 1) * 72 + 4 * j4);
    }
    float ax = 0.f, ay = 0.f, az = 0.f, aw = 0.f;
#pragma unroll
    for (int j4 = 0; j4 < (i + 3) / 4; ++j4) {
      ax += cur[j4].x * T[4 * j4]; ay += cur[j4].y * T[4 * j4 + 1]; az += cur[j4].z * T[4 * j4 + 2]; aw += cur[j4].w * T[4 * j4 + 3];
    }
    T[i] = ((lane == i) ? 1.f : 0.f) - ((ax + ay) + (az + aw));
#pragma unroll
    for (int j4 = 0; j4 < 16; ++j4) cur[j4] = nxt[j4];
  }
}

__device__ __forceinline__ void d_gdn_prep(int item, char* smem, const unsigned short* __restrict__ pm,
                                           const float* __restrict__ gt, const float* __restrict__ conv_w, GdnBufs G) {
  unsigned short* qL = (unsigned short*)smem;
  unsigned short* kL = qL + 64 * 144;
  unsigned short* kTL = kL + 64 * 144;
  unsigned short* vTL = kTL + 128 * 72;
  float* scal = (float*)(vTL + 128 * 72);
  float* A0 = (float*)qL;
  float* A1 = (float*)kL;
  int tid = TIDX;
  asm volatile("" : "+v"(tid));
  const int lane = tid & 63, w = __builtin_amdgcn_readfirstlane(tid >> 6), r = lane & 31, hh = lane >> 5;
  const int bh = item >> 6, c = item & 63, b = bh >> 2, h = bh & 3;
  const int t0 = b * SEQ + c * 64;
  __syncthreads();
  {
#pragma unroll
    for (int sec = 0; sec < 3; ++sec) {
      const int c0 = sec * 512 + h * 128 + 2 * lane;
      float cw0[5], cw1[5];
#pragma unroll
      for (int j = 0; j < 5; ++j) { cw0[j] = conv_w[c0 * 5 + j]; cw1[j] = conv_w[(c0 + 1) * 5 + j]; }
      unsigned raw[20];
#pragma unroll
      for (int k = 0; k < 20; ++k) {
        const int sp = c * 64 + w * 16 + k - 2;
        raw[k] = (sp >= 0 && sp < SEQ) ? *(const unsigned*)(pm + ((size_t)t0 + w * 16 + k - 2) * 4096 + c0) : 0u;
      }
#pragma unroll
      for (int ii = 0; ii < 16; ++ii) {
        const int i = w * 16 + ii;
        float a0 = 0.f, a1 = 0.f;
#pragma unroll
        for (int j = 0; j < 5; ++j) {
          a0 += cw0[j] * bf2f((unsigned short)(raw[ii + j] & 0xffff));
          a1 += cw1[j] * __uint_as_float(raw[ii + j] & 0xffff0000u);
        }
        a0 = a0 * __builtin_amdgcn_rcpf(1.f + __builtin_amdgcn_exp2f(-1.4426950408889634f * a0));
        a1 = a1 * __builtin_amdgcn_rcpf(1.f + __builtin_amdgcn_exp2f(-1.4426950408889634f * a1));
        if (sec < 2) {
          const float ss = wave_sum_dpp(a0 * a0 + a1 * a1);
          float sc = rsqrtf(ss + EPSF);
          if (sec == 0) sc *= 0.08838834764831845f;
          a0 *= sc; a1 *= sc;
        }
        if (sec == 0) {
          *(unsigned*)(qL + i * 144 + 2 * lane) = pack2(a0, a1);
        } else if (sec == 1) {
          const unsigned pk = pack2(a0, a1);
          *(unsigned*)(kL + i * 144 + 2 * lane) = pk;
          kTL[(2 * lane) * 72 + i] = (unsigned short)(pk & 0xffff);
          kTL[(2 * lane + 1) * 72 + i] = (unsigned short)(pk >> 16);
        } else {
          const unsigned pk = pack2(a0, a1);
          vTL[(2 * lane) * 72 + i] = (unsigned short)(pk & 0xffff);
          vTL[(2 * lane + 1) * 72 + i] = (unsigned short)(pk >> 16);
        }
      }
    }
  }
  if (w == 0) {
    const float* gp = gt + ((size_t)t0 + lane) * 32;
    const float g0 = gp[h], g1 = gp[4 + h], b0 = gp[8 + h], b1 = gp[12 + h];
    float G0 = g0, G1 = g1;
#pragma unroll
    for (int o = 1; o < 64; o <<= 1) {
      const float v0 = __shfl_up(G0, o, 64);
      const float v1 = __shfl_down(G1, o, 64);
      if (lane >= o) G0 += v0;
      if (lane + o < 64) G1 += v1;
    }
    scal[lane] = G0 * 1.4426950408889634f; scal[64 + lane] = G1 * 1.4426950408889634f;
    scal[128 + lane] = b0; scal[192 + lane] = b1;
    const float GL0 = __shfl(G0, 63, 64), GL1 = __shfl(G1, 0, 64);
    float* gs0 = G.gsc + ((size_t)((bh * 2 + 0) * 64 + c)) * 192;
    float* gs1 = G.gsc + ((size_t)((bh * 2 + 1) * 64 + c)) * 192;
    gs0[lane] = expf(G0); gs0[64 + lane] = expf(GL0 - G0);
    gs1[lane] = expf(G1); gs1[64 + lane] = expf(GL1 - G1);
    if (lane == 0) { gs0[128] = expf(GL0); gs1[128] = expf(GL1); }
  }
  __syncthreads();
  {
    unsigned short* qg = G.qc + (size_t)item * 8192;
    unsigned short* kg = G.kTc + (size_t)item * 8192;
#pragma unroll
    for (int i = 0; i < 4; ++i) {
      const int id = tid + i * 256;
      {
        const int row = id >> 4, c16 = id & 15;
        *(uint4*)(qg + (row >> 5) * 4096 + ((c16 >> 1) * 64 + (c16 & 1) * 32 + (row & 31)) * 8) = *(const uint4*)(qL + row * 144 + c16 * 8);
      }
      {
        const int row = id >> 3, c8 = id & 7;
        *(uint4*)(kg + (row >> 5) * 2048 + ((c8 >> 1) * 64 + (c8 & 1) * 32 + (row & 31)) * 8) = *(const uint4*)(kTL + row * 72 + c8 * 8);
      }
    }
  }
  {
    const int ta = w >> 1, tb = w & 1;
    f32x16 acc, acc2;
#pragma unroll
    for (int i = 0; i < 16; ++i) { acc[i] = 0.f; acc2[i] = 0.f; }
#pragma unroll
    for (int s = 0; s < 8; ++s) {
      const bf16x8 a = *(const bf16x8*)(kL + (32 * ta + r) * 144 + 16 * s + 8 * hh);
      const bf16x8 bk = *(const bf16x8*)(kL + (32 * tb + r) * 144 + 16 * s + 8 * hh);
      const bf16x8 bq = *(const bf16x8*)(qL + (32 * tb + r) * 144 + 16 * s + 8 * hh);
      acc = MFMA32(a, bk, acc);
      acc2 = MFMA32(a, bq, acc2);
    }
    __syncthreads();
    {
      const int col = 32 * tb + r;
      const float G0c = scal[col], G1c = scal[64 + col];
#pragma unroll
      for (int reg = 0; reg < 16; ++reg) {
        const int row = 32 * ta + crow(reg, hh);
        const float v = acc[reg];
        const float a0 = (col < row) ? scal[128 + row] * v * __builtin_amdgcn_exp2f(scal[row] - G0c) : 0.f;
        const float a1 = (col > row) ? scal[192 + row] * v * __builtin_amdgcn_exp2f(scal[64 + row] - G1c) : 0.f;
        A0[row * 72 + col] = a0;
        A1[(63 - row) * 72 + (63 - col)] = a1;
      }
    }
    {
      const int i = 32 * tb + r;
      const float G0i = scal[i], G1i = scal[64 + i];
      unsigned short* qk0 = G.qkc + ((size_t)((bh * 2 + 0) * 64 + c)) * 4096;
      unsigned short* qk1 = G.qkc + ((size_t)((bh * 2 + 1) * 64 + c)) * 4096;
#pragma unroll
      for (int g = 0; g < 4; ++g) {
        float o0[4], o1[4];
#pragma unroll
        for (int e = 0; e < 4; ++e) {
          const int j = 32 * ta + 8 * g + 4 * hh + e;
          const float v = acc2[4 * g + e];
          o0[e] = (j <= i) ? v * __builtin_amdgcn_exp2f(G0i - scal[j]) : 0.f;
          o1[e] = (j >= i) ? v * __builtin_amdgcn_exp2f(G1i - scal[64 + j]) : 0.f;
        }
        uint2 p0, p1;
        p0.x = pack2(o0[0], o0[1]); p0.y = pack2(o0[2], o0[3]);
        p1.x = pack2(o1[0], o1[1]); p1.y = pack2(o1[2], o1[3]);
        const int qoff = tb * 2048 + ((2 * ta + (g >> 1)) * 64 + (g & 1) * 32 + r) * 8 + 4 * hh;
        *(uint2*)(qk0 + qoff) = p0;
        *(uint2*)(qk1 + qoff) = p1;
      }
    }
  }
  __syncthreads();
  if (w < 2) {
    const int dir = w;
    float T[64];
    tri_subst(A0 + dir * (64 * 72), lane, T);
    const int jn = dir ? 63 - lane : lane;
    const float sb = scal[128 + 64 * dir + jn];
    const float sbg = sb * __builtin_amdgcn_exp2f(scal[64 * dir + jn]);
    unsigned short* Tb = dir ? kL : qL;
    unsigned short* Tbg = Tb + 64 * 72;
#pragma unroll
    for (int ip = 0; ip < 64; ++ip) {
      const int in = dir ? 63 - ip : ip;
      Tb[in * 72 + jn] = f2bf(T[ip] * sb);
      Tbg[in * 72 + jn] = f2bf(T[ip] * sbg);
    }
  }
  __syncthreads();
#pragma unroll
  for (int d = 0; d < 2; ++d) {
    const int chain = bh * 2 + d;
    const unsigned short* Tb = d ? kL : qL;
    const unsigned short* Tbg = Tb + 64 * 72;
    unsigned short* wng = G.wn + ((size_t)(chain * 64 + c)) * 8192;
    unsigned short* uog = G.uo + ((size_t)(chain * 64 + c)) * 8192 + w * 2048;
#pragma unroll
    for (int tb = 0; tb < 2; ++tb) {
      f32x16 acc, acc2;
#pragma unroll
      for (int i = 0; i < 16; ++i) { acc[i] = 0.f; acc2[i] = 0.f; }
#pragma unroll
      for (int s = 0; s < 4; ++s) {
        const bf16x8 a = *(const bf16x8*)(kTL + (32 * w + r) * 72 + 16 * s + 8 * hh);
        const bf16x8 bb = *(const bf16x8*)(Tbg + (32 * tb + r) * 72 + 16 * s + 8 * hh);
        acc = MFMA32(a, bb, acc);
        const bf16x8 a2 = *(const bf16x8*)(Tb + (32 * tb + r) * 72 + 16 * s + 8 * hh);
        const bf16x8 b2 = *(const bf16x8*)(vTL + (32 * w + r) * 72 + 16 * s + 8 * hh);
        acc2 = MFMA32(a2, b2, acc2);
      }
#pragma unroll
      for (int g = 0; g < 4; ++g) {
        uint2 pk;
        pk.x = pack2(-acc[4 * g], -acc[4 * g + 1]); pk.y = pack2(-acc[4 * g + 2], -acc[4 * g + 3]);
        *(uint2*)(wng + tb * 4096 + ((2 * w + (g >> 1)) * 64 + (g & 1) * 32 + r) * 8 + 4 * hh) = pk;
      }
      uint4 u0, u1;
      u0.x = pack2(acc2[0], acc2[1]); u0.y = pack2(acc2[2], acc2[3]); u0.z = pack2(acc2[4], acc2[5]); u0.w = pack2(acc2[6], acc2[7]);
      u1.x = pack2(acc2[8], acc2[9]); u1.y = pack2(acc2[10], acc2[11]); u1.z = pack2(acc2[12], acc2[13]); u1.w = pack2(acc2[14], acc2[15]);
      *(uint4*)(uog + tb * 1024 + lane * 16) = u0;
      *(uint4*)(uog + tb * 1024 + lane * 16 + 8) = u1;
    }
  }
}

struct GdnOps {
  bf16x8 a[8];
  bf16x8 x[4];
  bf16x8 kt[4];
  float4 rs[4];
  float gtot;
};
__device__ __forceinline__ void gdn_load(GdnOps& o, const GdnBufs& G, int chain, int bh, int c, int sl, int w, int r, int hh, int lane) {
  const unsigned short* kT_c = G.kTc + ((size_t)(bh * 64 + c)) * 8192;
  const float* gs = G.gsc + ((size_t)(chain * 64 + c)) * 192;
  const int ti = w & 1;
#pragma unroll
  for (int s = 0; s < 4; ++s) o.kt[s] = *(const bf16x8*)(kT_c + w * 2048 + (s * 64 + lane) * 8);
  o.gtot = gs[128];
  if (w < 2) {
    const unsigned short* wn_c = G.wn + ((size_t)(chain * 64 + c)) * 8192;
    const unsigned short* uo_c = G.uo + ((size_t)(chain * 64 + c)) * 8192 + sl * 2048;
#pragma unroll
    for (int s = 0; s < 8; ++s) o.a[s] = *(const bf16x8*)(wn_c + ti * 4096 + (s * 64 + lane) * 8);
    o.x[0] = *(const bf16x8*)(uo_c + ti * 1024 + lane * 16);
    o.x[1] = *(const bf16x8*)(uo_c + ti * 1024 + lane * 16 + 8);
#pragma unroll
    for (int g = 0; g < 4; ++g) o.rs[g] = *(const float4*)(gs + 64 + 32 * ti + 8 * g + 4 * hh);
  } else {
    const unsigned short* q_c = G.qc + ((size_t)(bh * 64 + c)) * 8192;
    const unsigned short* qk_c = G.qkc + ((size_t)(chain * 64 + c)) * 4096;
#pragma unroll
    for (int s = 0; s < 8; ++s) o.a[s] = *(const bf16x8*)(q_c + ti * 4096 + (s * 64 + lane) * 8);
#pragma unroll
    for (int s = 0; s < 4; ++s) o.x[s] = *(const bf16x8*)(qk_c + ti * 2048 + (s * 64 + lane) * 8);
#pragma unroll
    for (int g = 0; g < 4; ++g) o.rs[g] = *(const float4*)(gs + 32 * ti + 8 * g + 4 * hh);
  }
}
__device__ __forceinline__ void gdn_step(const GdnOps& o, f32x16& S, unsigned short* ST, unsigned short* VT, unsigned short* VdT,
                                         unsigned short* uo_c, int w, int r, int hh) {
  const int ti = w & 1;
  f32x16 acc;
  if (w < 2) {
#pragma unroll
    for (int i = 0; i < 8; ++i) {
      acc[i] = bf2f((unsigned short)o.x[0][i]);
      acc[8 + i] = bf2f((unsigned short)o.x[1][i]);
    }
  } else {
#pragma unroll
    for (int i = 0; i < 16; ++i) acc[i] = 0.f;
  }
#pragma unroll
  for (int g = 0; g < 4; ++g) {
    uint2 pk;
    pk.x = pack2(S[4 * g], S[4 * g + 1]); pk.y = pack2(S[4 * g + 2], S[4 * g + 3]);
    *(uint2*)(ST + r * 136 + 32 * w + 8 * g + 4 * hh) = pk;
  }
  __syncthreads();
#pragma unroll
  for (int s = 0; s < 8; ++s) {
    const bf16x8 bs = *(const bf16x8*)(ST + r * 136 + 16 * s + 8 * hh);
    acc = MFMA32(o.a[s], bs, acc);
  }
  if (w < 2) {
#pragma unroll
    for (int g = 0; g < 4; ++g) {
      uint2 pk, pd;
      pk.x = pack2(acc[4 * g], acc[4 * g + 1]); pk.y = pack2(acc[4 * g + 2], acc[4 * g + 3]);
      pd.x = pack2(acc[4 * g] * o.rs[g].x, acc[4 * g + 1] * o.rs[g].y);
      pd.y = pack2(acc[4 * g + 2] * o.rs[g].z, acc[4 * g + 3] * o.rs[g].w);
      *(uint2*)(VT + r * 72 + 32 * ti + 8 * g + 4 * hh) = pk;
      *(uint2*)(VdT + r * 72 + 32 * ti + 8 * g + 4 * hh) = pd;
    }
  } else {
#pragma unroll
    for (int g = 0; g < 4; ++g) {
      acc[4 * g] *= o.rs[g].x; acc[4 * g + 1] *= o.rs[g].y; acc[4 * g + 2] *= o.rs[g].z; acc[4 * g + 3] *= o.rs[g].w;
    }
  }
  __syncthreads();
  if (w >= 2) {
#pragma unroll
    for (int s = 0; s < 4; ++s) {
      const bf16x8 bv = *(const bf16x8*)(VT + r * 72 + 16 * s + 8 * hh);
      acc = MFMA32(o.x[s], bv, acc);
    }
#pragma unroll
    for (int reg = 0; reg < 16; ++reg) uo_c[(32 * ti + crow(reg, hh)) * 32 + r] = f2bf(acc[reg]);
  }
#pragma unroll
  for (int i = 0; i < 16; ++i) S[i] *= o.gtot;
#pragma unroll
  for (int s = 0; s < 4; ++s) {
    const bf16x8 bv = *(const bf16x8*)(VdT + r * 72 + 16 * s + 8 * hh);
    S = MFMA32(o.kt[s], bv, S);
  }
}
__device__ __forceinline__ void d_gdn_scan(int chain, int sl, char* smem, GdnBufs G) {
  unsigned short* ST = (unsigned short*)smem;
  unsigned short* VT = ST + 32 * 136;
  unsigned short* VdT = VT + 32 * 72;
  const int tid = TIDX, lane = tid & 63, w = __builtin_amdgcn_readfirstlane(tid >> 6), r = lane & 31, hh = lane >> 5;
  const int bh = chain >> 1, dir = chain & 1;
  f32x16 S;
#pragma unroll
  for (int i = 0; i < 16; ++i) S[i] = 0.f;
  GdnOps A, B;
  gdn_load(A, G, chain, bh, dir ? 63 : 0, sl, w, r, hh, lane);
  for (int step = 0; step < 64; step += 2) {
    const int c0 = dir ? 63 - step : step;
    const int c1 = dir ? c0 - 1 : c0 + 1;
    const int c2 = dir ? c0 - 2 : c0 + 2;
    gdn_load(B, G, chain, bh, c1, sl, w, r, hh, lane);
    gdn_step(A, S, ST, VT, VdT, G.uo + ((size_t)(chain * 64 + c0)) * 8192 + sl * 2048, w, r, hh);
    if (step + 2 < 64) gdn_load(A, G, chain, bh, c2, sl, w, r, hh, lane);
    gdn_step(B, S, ST, VT, VdT, G.uo + ((size_t)(chain * 64 + c1)) * 8192 + sl * 2048, w, r, hh);
  }
}

__device__ __forceinline__ void d_ml_gates(int item, const float* __restrict__ gt, float* __restrict__ pre, float* __restrict__ gtots) {
  const int wv = item * 4 + (TIDX >> 6);
  const int lane = TIDX & 63;
  const int chain = wv >> 6, c = wv & 63;
  const int bh = chain >> 1, dir = chain & 1, b = bh >> 2, h = bh & 3;
  const size_t t0 = (size_t)b * SEQ + c * 64;
  const float lf = gt[(t0 + lane) * 32 + 24 + dir * 4 + h];
  const float ip = gt[(t0 + lane) * 32 + 16 + dir * 4 + h];
  float bc = lf;
#pragma unroll
  for (int ofs = 1; ofs < 64; ofs <<= 1) {
    const float vu = __shfl_up(bc, ofs, 64);
    const float vd = __shfl_down(bc, ofs, 64);
    if (dir == 0) { if (lane >= ofs) bc += vu; } else { if (lane + ofs < 64) bc += vd; }
  }
  const float b_last = __shfl(bc, dir ? 0 : 63, 64);
  float4 o;
  o.x = expf(bc);
  o.y = (ip - bc) * 1.4426950408889634f - 3.5f;
  o.z = bc * 1.4426950408889634f;
  o.w = 0.08838834764831845f * expf(b_last - bc + ip);
  *(float4*)(pre + ((size_t)chain * SEQ + c * 64 + lane) * 4) = o;
  if (lane == 0) gtots[wv] = expf(b_last);
}

#define ML_LDK(R, I, T0) R = *(const uint4*)(pm + ((T0) + ((t128 + (I) * 128) >> 4)) * 4096 + 2560 + h * 128 + (t128 & 15) * 8);
#define ML_STK(R, I) *(uint4*)(kLb + ((t128 + (I) * 128) >> 4) * 136 + (t128 & 15) * 8) = R;
#define ML_LOAD(T0)                                                                                         \
  {                                                                                                         \
    ML_LDK(pk0, 0, T0) ML_LDK(pk1, 1, T0) ML_LDK(pk2, 2, T0) ML_LDK(pk3, 3, T0)                             \
    ML_LDK(pk4, 4, T0) ML_LDK(pk5, 5, T0) ML_LDK(pk6, 6, T0) ML_LDK(pk7, 7, T0)                             \
    pv0 = *(const uint4*)(pm + ((T0) + (t128 >> 2)) * 4096 + 3072 + h * 128 + sl * 32 + (t128 & 3) * 8);    \
    pv1 = *(const uint4*)(pm + ((T0) + ((t128 + 128) >> 2)) * 4096 + 3072 + h * 128 + sl * 32 + (t128 & 3) * 8); \
    pgl = *(const float4*)(pre + ((size_t)chain * SEQ + ((T0) - tb) + lane) * 4);                           \
    pgt = gtots[chain * 64 + (int)(((T0) - tb) >> 6)];                                                      \
  }
#define ML_PUTV(W, E)                                                                                       \
  {                                                                                                         \
    const unsigned short lo_ = (unsigned short)((W) & 0xffff), hi_ = (unsigned short)((W) >> 16);           \
    vTb[(d8_ + (E)) * 72 + tok_] = lo_;                                                                     \
    vTb[(d8_ + (E) + 1) * 72 + tok_] = hi_;                                                                 \
    const unsigned sc_ = pack2(bf2f(lo_) * dj_, bf2f(hi_) * dj_);                                           \
    vdb[(d8_ + (E)) * 72 + tok_] = (unsigned short)(sc_ & 0xffff);                                          \
    vdb[(d8_ + (E) + 1) * 72 + tok_] = (unsigned short)(sc_ >> 16);                                         \
  }
#define ML_STAGE(BUF)                                                                                       \
  {                                                                                                         \
    unsigned short* kLb = kL + (BUF) * (64 * 136);                                                          \
    unsigned short* vTb = vTL + (BUF) * (32 * 72);                                                          \
    unsigned short* vdb = vdTL + (BUF) * (32 * 72);                                                         \
    float* scb = scal + (BUF) * 208;                                                                        \
    if (w == 2) {                                                                                           \
      scb[lane] = pgl.x; scb[64 + lane] = pgl.y; scb[128 + lane] = pgl.z;                                   \
      dL[(BUF) * 72 + lane] = f2bf(pgl.w);                                                                  \
      if (lane == 0) scb[192] = pgt;                                                                        \
    }                                                                                                       \
    ML_STK(pk0, 0) ML_STK(pk1, 1) ML_STK(pk2, 2) ML_STK(pk3, 3) ML_STK(pk4, 4) ML_STK(pk5, 5) ML_STK(pk6, 6) ML_STK(pk7, 7) \
    {                                                                                                       \
      const int tok_ = t128 >> 2, d8_ = (t128 & 3) * 8;                                                     \
      const float dj_ = __shfl(pgl.w, tok_, 64);                                                            \
      ML_PUTV(pv0.x, 0); ML_PUTV(pv0.y, 2); ML_PUTV(pv0.z, 4); ML_PUTV(pv0.w, 6);                           \
    }                                                                                                       \
    {                                                                                                       \
      const int tok_ = (t128 + 128) >> 2, d8_ = (t128 & 3) * 8;                                             \
      const float dj_ = __shfl(pgl.w, tok_, 64);                                                            \
      ML_PUTV(pv1.x, 0); ML_PUTV(pv1.y, 2); ML_PUTV(pv1.z, 4); ML_PUTV(pv1.w, 6);                           \
    }                                                                                                       \
  }
__device__ __forceinline__ void ml_state_image(const f32x16& S0, const f32x16& S1, unsigned short* S0T, unsigned short* nL, int w, int r, int hh) {
#pragma unroll
  for (int g = 0; g < 4; ++g) {
    uint2 pk;
    pk.x = pack2(S0[4 * g], S0[4 * g + 1]); pk.y = pack2(S0[4 * g + 2], S0[4 * g + 3]);
    *(uint2*)(S0T + r * 136 + 32 * w + 8 * g + 4 * hh) = pk;
    if (r == 0) {
      uint2 pn;
      pn.x = pack2(S1[4 * g], S1[4 * g + 1]); pn.y = pack2(S1[4 * g + 2], S1[4 * g + 3]);
      *(uint2*)(nL + 32 * w + 8 * g + 4 * hh) = pn;
    }
  }
}
__device__ __forceinline__ void ml_state_update(f32x16& S0, f32x16& S1, const unsigned short* kLb, const unsigned short* vdb,
                                                const unsigned short* dLb, float gtot, int w, int r, int hh) {
#pragma unroll
  for (int i = 0; i < 16; ++i) { S0[i] *= gtot; S1[i] *= gtot; }
#pragma unroll
  for (int s2 = 0; s2 < 4; ++s2) {
    union { bf16x8 v; unsigned short e[8]; } a;
#pragma unroll
    for (int e = 0; e < 8; ++e) a.e[e] = kLb[(16 * s2 + 8 * hh + e) * 136 + 32 * w + r];
    const bf16x8 bv = *(const bf16x8*)(vdb + r * 72 + 16 * s2 + 8 * hh);
    const bf16x8 bd = *(const bf16x8*)(dLb + 16 * s2 + 8 * hh);
    S0 = MFMA32(a.v, bv, S0);
    S1 = MFMA32(a.v, bd, S1);
  }
}
__device__ __forceinline__ void d_mlstm_scan(int chain, int sl, char* smem, const unsigned short* __restrict__ pm,
                                             const float* __restrict__ pre, const float* __restrict__ gtots,
                                             unsigned short* __restrict__ oM, int ntok, int hbk) {
  unsigned short* kL = (unsigned short*)smem;
  unsigned short* vTL = kL + 2 * 64 * 136;
  unsigned short* vdTL = vTL + 2 * 32 * 72;
  unsigned short* dL = vdTL + 2 * 32 * 72;
  unsigned short* S0T = dL + 256;
  unsigned short* nL = S0T + 32 * 136;
  float* scal = (float*)(nL + 256);
  int tid = TIDX;
  asm volatile("" : "+v"(tid));
  const int lane = tid & 63, w = __builtin_amdgcn_readfirstlane(tid >> 6), r = lane & 31, hh = lane >> 5;
  const int bh = chain >> 1, dir = chain & 1, b = bh >> 2, h = bh & 3;
  f32x16 S0, S1;
#pragma unroll
  for (int i = 0; i < 16; ++i) { S0[i] = 0.f; S1[i] = 0.f; }
  unsigned short* oMb = oM + (size_t)dir * ntok * 512 + h * 128 + sl * 32;
  const size_t tb = (size_t)b * SEQ;
  __syncthreads();
  if (hbk == 1) {
    if (w < 2) ml_state_image(S0, S1, S0T, nL, w, r, hh);
    for (int step = 0; step < 64; ++step) {
      const int buf = step & 1;
      __syncthreads();
      if (w < 2) {
        const float gtot = scal[buf * 208 + 192];
        ml_state_update(S0, S1, kL + buf * (64 * 136), vdTL + buf * (32 * 72), dL + buf * 72, gtot, w, r, hh);
      }
      __syncthreads();
      if (w < 2) ml_state_image(S0, S1, S0T, nL, w, r, hh);
    }
    return;
  }
  if (w >= 2) ml_state_image(S0, S1, S0T, nL, w, r, hh);
  if (w >= 2) {
    const int t128 = tid - 128;
    uint4 pk0, pk1, pk2, pk3, pk4, pk5, pk6, pk7, pv0, pv1;
    float4 pgl;
    float pgt;
    ML_LOAD(tb + (dir ? 63 : 0) * 64);
    ML_STAGE(0);
    ML_LOAD(tb + (dir ? 62 : 1) * 64);
    for (int step = 0; step < 64; ++step) {
      const int c0 = dir ? 63 - step : step;
      const int c2 = dir ? c0 - 2 : c0 + 2;
      const int buf = step & 1;
      __syncthreads();
      const float gtot = scal[buf * 208 + 192];
      ML_STAGE(buf ^ 1);
      {
        const int cl = (step + 2 < 64) ? c2 : c0;
        ML_LOAD(tb + cl * 64);
      }
      ml_state_update(S0, S1, kL + buf * (64 * 136), vdTL + buf * (32 * 72), dL + buf * 72, gtot, w, r, hh);
      __syncthreads();
      ml_state_image(S0, S1, S0T, nL, w, r, hh);
    }
  } else {
    bf16x8 ones;
#pragma unroll
    for (int i = 0; i < 8; ++i) ones[i] = (short)0x3F80;
    const int ti = w;
    const int icol = 32 * ti + r;
    float dmask[16];
#pragma unroll
    for (int reg = 0; reg < 16; ++reg) {
      const int jl = crow(reg, hh);
      dmask[reg] = (dir ? (jl >= r) : (jl <= r)) ? 1.f : 0.f;
    }
    bf16x8 qf[8];
    {
      const unsigned short* qp = pm + (tb + (size_t)(dir ? 63 : 0) * 64 + 32 * ti + r) * 4096 + 2048 + h * 128 + 8 * hh;
#pragma unroll
      for (int s2 = 0; s2 < 8; ++s2) qf[s2] = *(const bf16x8*)(qp + 16 * s2);
    }
    for (int step = 0; step < 64; ++step) {
      const int c0 = dir ? 63 - step : step;
      const int c1 = dir ? c0 - 1 : c0 + 1;
      const int buf = step & 1;
      const unsigned short* kLb = kL + buf * (64 * 136);
      const unsigned short* vTb = vTL + buf * (32 * 72);
      const float* scb = scal + buf * 208;
      __syncthreads();
      const float bci = scb[128 + icol];
      const float gtot = scb[192];
      f32x16 Q0, Q1;
#pragma unroll
      for (int i = 0; i < 16; ++i) { Q0[i] = 0.f; Q1[i] = 0.f; }
#pragma unroll
      for (int s2 = 0; s2 < 8; ++s2) {
        const bf16x8 b0 = *(const bf16x8*)(S0T + r * 136 + 16 * s2 + 8 * hh);
        const bf16x8 b1 = *(const bf16x8*)(nL + 16 * s2 + 8 * hh);
        Q0 = MFMA32(qf[s2], b0, Q0);
        Q1 = MFMA32(qf[s2], b1, Q1);
      }
#pragma unroll
      for (int g = 0; g < 4; ++g) {
        const float4 e4 = *(const float4*)(scb + 32 * ti + 8 * g + 4 * hh);
        Q0[4 * g] *= e4.x; Q0[4 * g + 1] *= e4.y; Q0[4 * g + 2] *= e4.z; Q0[4 * g + 3] *= e4.w;
        Q1[4 * g] *= e4.x; Q1[4 * g + 1] *= e4.y; Q1[4 * g + 2] *= e4.z; Q1[4 * g + 3] *= e4.w;
      }
#pragma unroll
      for (int tj = 0; tj < 2; ++tj) {
        if (dir ? (tj < ti) : (tj > ti)) continue;
        f32x16 X;
#pragma unroll
        for (int i = 0; i < 16; ++i) X[i] = 0.f;
#pragma unroll
        for (int s2 = 0; s2 < 8; ++s2) {
          const bf16x8 a = *(const bf16x8*)(kLb + (32 * tj + r) * 136 + 16 * s2 + 8 * hh);
          X = MFMA32(a, qf[s2], X);
        }
        if (tj == ti) {
#pragma unroll
          for (int g = 0; g < 4; ++g) {
            const float4 cj4 = *(const float4*)(scb + 64 + 32 * tj + 8 * g + 4 * hh);
            X[4 * g + 0] *= __builtin_amdgcn_exp2f(fminf(bci + cj4.x, 80.f)) * dmask[4 * g + 0];
            X[4 * g + 1] *= __builtin_amdgcn_exp2f(fminf(bci + cj4.y, 80.f)) * dmask[4 * g + 1];
            X[4 * g + 2] *= __builtin_amdgcn_exp2f(fminf(bci + cj4.z, 80.f)) * dmask[4 * g + 2];
            X[4 * g + 3] *= __builtin_amdgcn_exp2f(fminf(bci + cj4.w, 80.f)) * dmask[4 * g + 3];
          }
        } else {
#pragma unroll
          for (int g = 0; g < 4; ++g) {
            const float4 cj4 = *(const float4*)(scb + 64 + 32 * tj + 8 * g + 4 * hh);
            X[4 * g + 0] *= __builtin_amdgcn_exp2f(bci + cj4.x);
            X[4 * g + 1] *= __builtin_amdgcn_exp2f(bci + cj4.y);
            X[4 * g + 2] *= __builtin_amdgcn_exp2f(bci + cj4.z);
            X[4 * g + 3] *= __builtin_amdgcn_exp2f(bci + cj4.w);
          }
        }
#pragma unroll
        for (int s2 = 0; s2 < 2; ++s2) {
          union { bf16x8 v; unsigned u[4]; } xa, bv;
          xa.u[0] = pack2(X[8 * s2 + 0], X[8 * s2 + 1]); xa.u[1] = pack2(X[8 * s2 + 2], X[8 * s2 + 3]);
          xa.u[2] = pack2(X[8 * s2 + 4], X[8 * s2 + 5]); xa.u[3] = pack2(X[8 * s2 + 6], X[8 * s2 + 7]);
          const uint2 v0 = *(const uint2*)(vTb + r * 72 + 32 * tj + 16 * s2 + 4 * hh);
          const uint2 v1 = *(const uint2*)(vTb + r * 72 + 32 * tj + 16 * s2 + 8 + 4 * hh);
          bv.u[0] = v0.x; bv.u[1] = v0.y; bv.u[2] = v1.x; bv.u[3] = v1.y;
          Q0 = MFMA32(xa.v, bv.v, Q0);
          Q1 = MFMA32(xa.v, ones, Q1);
        }
      }
      {
        const int cn = (step + 1 < 64) ? c1 : c0;
        const unsigned short* qp = pm + (tb + (size_t)cn * 64 + 32 * ti + r) * 4096 + 2048 + h * 128 + 8 * hh;
#pragma unroll
        for (int s2 = 0; s2 < 8; ++s2) qf[s2] = *(const bf16x8*)(qp + 16 * s2);
      }
      const size_t orow0 = tb + c0 * 64;
#pragma unroll
      for (int reg = 0; reg < 16; ++reg) {
        const int i = 32 * ti + crow(reg, hh);
        oMb[(orow0 + i) * 512 + r] = f2bf(Q0[reg] * __builtin_amdgcn_rcpf(fmaxf(fabsf(Q1[reg]), 1.f)));
      }
      __syncthreads();
    }
  }
}

struct MKP {
  const float *x, *norm1_g, *w_in, *conv_w, *a_log, *dt_bias, *gdn_g, *i_bias, *f_bias, *ml_g, *w_out, *norm2_g, *peer_wq,
      *peer_keys, *peer_u, *peer_v, *normf_g;
  float* out;
  unsigned short *pm, *x1b, *woutT, *mt, *xb, *winT, *oM, *yb, *scores, *qkv_dbg, *oA_dbg;
  unsigned *utab, *vtab;
  unsigned short *wqb, *keyb;
  float *uscale, *vscale;
  float *x1, *rs1, *rs2, *gt, *gateb, *dbg, *mlpre, *mlgt;
  unsigned* bar;
  int* idxb;
  GdnBufs G;
};

constexpr int SMEM_BYTES = 74752;
__global__ void __launch_bounds__(512, 2) k_mega(MKP P) {
  __shared__ __attribute__((aligned(16))) char smem_all[2 * SMEM_BYTES + 16];
  {
    volatile LAS unsigned* st0 = (volatile LAS unsigned*)(smem_all + 2 * SMEM_BYTES);
    if (threadIdx.x < 4) st0[threadIdx.x] = 0u;
  }
  __syncthreads();
  XcdBarrier xb = xcd_barrier_post(P.bar, (volatile LAS unsigned*)(smem_all + 2 * SMEM_BYTES));
  const int hb = __builtin_amdgcn_readfirstlane(HB);
  char* smem_c = smem_all + hb * SMEM_BYTES;
  unsigned short* smem = (unsigned short*)smem_c;
  const int nb = gridDim.x, bid = blockIdx.x;
  for (int it = bid; it < NT / 8; it += nb) d_prep_x(2 * it + hb, P.x, P.xb, P.rs1);
  for (int it = bid; it < 8 * 66; it += nb) d_transpose_w(2 * it + hb, 66, (float*)smem_c, P.w_in, DIN, P.norm1_g, P.winT, 1);
  for (int it = bid; it < 8 * 16; it += nb) d_transpose_w(2 * it + hb, 16, (float*)smem_c, P.w_out, 1024, nullptr, P.woutT, 0);
  for (int it = bid; it < 512; it += nb) d_cvt_bf16(2 * it + hb, P.peer_wq, P.wqb, P.norm2_g, 11);
  for (int it = bid; it < 64; it += nb) d_cvt_bf16(2 * it + hb, P.peer_keys, P.keyb, nullptr, 0);
  if (bid == 0 && threadIdx.x < 4) P.dbg[threadIdx.x] = 0.f;
  xcd_barrier(xb);
  {
    GemmP p{};
    p.A = P.xb; p.lda = DM; p.Bt = P.winT; p.ldb = DM; p.K = DM;
    p.rowscale = P.rs1; p.obf = P.pm; p.ldo = 4096; p.of32 = P.gt; p.ldf = 32; p.resid = nullptr;
    p.a_log = P.a_log; p.dt_bias = P.dt_bias; p.i_bias = P.i_bias; p.f_bias = P.f_bias;
    for (int k = 0;; ++k) {
      int tm, tn;
      if (!xcd_tile256(bid, nb, k, 16, tm, tn)) break;
      gemm256_tile<EPI_INPROJ>(p, tm, tn, smem_all);
    }
  }
  for (int it = bid; it < NT / 128; it += nb) d_gate_proj(it, P.xb, P.winT, P.rs1, P.a_log, P.dt_bias, P.i_bias, P.f_bias, P.gt);
  for (int tile = bid; tile < 16 * 4; tile += nb) {
    const int hp = tile >> 2, tn = (tile & 3) * 2 + hb;
    GemmP p{};
    p.A = P.keyb + (size_t)hp * 128 * 128; p.lda = 128; p.Bt = P.wqb + hp * 128; p.ldb = 2048; p.K = 128;
    p.obf = P.mt + (size_t)hp * 128 * DM; p.ldo = DM;
    gemm_tile<EPI_PLAIN>(p, 0, tn, smem);
    __syncthreads();
  }
  xcd_barrier(xb);
  for (int it = bid; it < 256; it += nb) d_ml_gates(2 * it + hb, P.gt, P.mlpre, P.mlgt);
  for (int it = bid; it < 512; it += nb) d_gdn_prep(2 * it + hb, smem_c, P.pm, P.gt, P.conv_w, P.G);
  xcd_barrier(xb);
  for (int wi = bid; wi < 256; wi += nb) {
    const int wl_ = wi & 127, xj = wl_ >> 3;
    const int chain = (xj >> 2) * 8 + (wl_ & 7), sl = xj & 3;
    if (wi < 128) {
      if (hb == 0) d_gdn_scan(chain, sl, smem_c, P.G);
      else for (int i = 0; i < 128; ++i) __syncthreads();
    } else {
      d_mlstm_scan(chain, sl, smem_all, P.pm, P.mlpre, P.mlgt, P.oM, NT, hb);
    }
    __syncthreads();
  }
  xcd_barrier(xb);
  for (int it = bid; it < NT / 8; it += nb) d_combine(2 * it + hb, P.G.uo, P.oM, P.pm, P.gdn_g, P.ml_g, P.yb);
  xcd_barrier(xb);
  {
    GemmP p{};
    p.A = P.yb; p.lda = DM; p.Bt = P.woutT; p.ldb = DM; p.K = DM;
    p.rowscale = nullptr; p.obf = P.x1b; p.ldo = DM; p.of32 = P.x1; p.ldf = DM; p.resid = P.x; p.rowacc = P.rs2;
    for (int k = 0;; ++k) {
      int tm, tn;
      if (!xcd_tile256(bid, nb, k, 4, tm, tn)) break;
      gemm256_tile<EPI_OUTPROJ>(p, tm, tn, smem_all);
    }
  }
  for (int it = bid; it < 512; it += nb) { d_cvt_tab<true>(2 * it + hb, P.peer_u, P.utab, P.uscale); d_cvt_tab<false>(2 * it + hb, P.peer_v, P.vtab, P.vscale); }
  xcd_barrier(xb);
  {
    GemmP p{};
    p.A = P.x1b; p.lda = DM; p.Bt = P.mt; p.ldb = DM; p.K = DM;
    p.rowscale = P.rs2; p.obf = P.scores; p.ldo = 2048; p.of32 = nullptr; p.ldf = 0; p.resid = nullptr;
    for (int k = 0;; ++k) {
      int tm, tn;
      if (!xcd_tile256(bid, nb, k, 8, tm, tn)) break;
      gemm256_tile<EPI_SCORES>(p, tm, tn, smem_all);
    }
  }
  xcd_barrier(xb);
  const float oscale = 1.f;
  for (int it = bid; it < NT / 64; it += nb) {
    const int hit = 2 * it + hb;
    d_topk(hit, P.scores, P.idxb, P.gateb);
    __threadfence_block();
    __syncthreads();
#pragma unroll 1
    for (int sub = 0; sub < 8; ++sub)
      d_peer(hit * 8 + sub, smem_c, P.x1, P.rs2, P.norm2_g, P.idxb, P.gateb, P.utab, P.vtab, P.uscale, P.vscale, P.normf_g, P.out, oscale);
  }
}

extern "C" void kernel_launch(void* const* d_in, const int* in_sizes, int n_in, void* d_out, int out_size, void* d_ws,
                              size_t ws_size, hipStream_t stream) {
  MKP P{};
  P.x = (const float*)d_in[0];
  P.norm1_g = (const float*)d_in[1];
  P.w_in = (const float*)d_in[2];
  P.conv_w = (const float*)d_in[3];
  P.a_log = (const float*)d_in[4];
  P.dt_bias = (const float*)d_in[5];
  P.gdn_g = (const float*)d_in[6];
  P.i_bias = (const float*)d_in[7];
  P.f_bias = (const float*)d_in[8];
  P.ml_g = (const float*)d_in[9];
  P.w_out = (const float*)d_in[10];
  P.norm2_g = (const float*)d_in[11];
  P.peer_wq = (const float*)d_in[12];
  P.peer_keys = (const float*)d_in[13];
  P.peer_u = (const float*)d_in[14];
  P.peer_v = (const float*)d_in[15];
  P.normf_g = (const float*)d_in[16];
  P.out = (float*)d_out;

  char* ws = (char*)d_ws;
  const size_t MB = 1024 * 1024;
  P.pm = (unsigned short*)(ws);
  P.x1 = (float*)(ws);
  P.x1b = (unsigned short*)(ws + 64 * MB);
  P.utab = (unsigned*)(ws + 96 * MB);
  P.vtab = (unsigned*)(ws + 112 * MB);
  P.uscale = (float*)(ws + 136 * MB);
  P.vscale = (float*)(ws + 136 * MB + 65536);
  char* rb = ws + 128 * MB;
  P.woutT = (unsigned short*)(rb);
  P.mt = (unsigned short*)(rb + 2 * MB);
  P.rs1 = (float*)(rb + 6 * MB);
  P.rs2 = (float*)(rb + 7 * MB);
  P.dbg = (float*)(rb + 6 * MB + 131072);
  P.bar = (unsigned*)(rb + 6 * MB + 196608);
  P.gt = (float*)(rb + 9 * MB);
  char* dyn = rb + 11 * MB;
  P.xb = (unsigned short*)(dyn);
  P.winT = (unsigned short*)(dyn + 32 * MB);
  P.wqb = (unsigned short*)(dyn + 41 * MB);
  P.keyb = (unsigned short*)(dyn + 45 * MB);
  P.G.qc = (unsigned short*)(dyn);
  P.G.kTc = (unsigned short*)(dyn + 16 * MB);
  P.G.qkc = (unsigned short*)(dyn + 32 * MB);
  P.G.wn = (unsigned short*)(dyn + 48 * MB);
  P.G.uo = (unsigned short*)(dyn + 80 * MB);
  P.G.gsc = (float*)(dyn + 112 * MB);
  P.mlpre = (float*)(dyn + 114 * MB);
  P.mlgt = (float*)(dyn + 116 * MB);
  P.yb = (unsigned short*)(dyn);
  P.scores = (unsigned short*)(dyn);
  P.idxb = (int*)(dyn + 64 * MB);
  P.gateb = (float*)(dyn + 72 * MB);
  char* os = (char*)d_out;
  P.oM = (unsigned short*)(os);
  P.qkv_dbg = (unsigned short*)(os + 32 * MB);
  P.oA_dbg = (unsigned short*)(os + 44 * MB);

  static int grid_blocks = 0;
  if (!grid_blocks) {
    int dev = 0, cus = 0, per_cu = 0;
    (void)hipGetDevice(&dev);
    (void)hipDeviceGetAttribute(&cus, hipDeviceAttributeMultiprocessorCount, dev);
    (void)hipOccupancyMaxActiveBlocksPerMultiprocessor(&per_cu, k_mega, 512, 0);
    if (per_cu > 1) per_cu = 1;
    if (per_cu < 1) per_cu = 1;
    grid_blocks = cus * per_cu;
  }
  (void)hipMemsetAsync(P.bar, 0, XCD_BAR_WORDS * sizeof(unsigned), stream);
  hipLaunchKernelGGL(k_mega, dim3(grid_blocks), dim3(512), 0, stream, P);
}
```

```cpp
#include <hip/hip_runtime.h>
#include <hip/hip_bf16.h>
#include <stdint.h>
#include <cstdio>
#define TIDX ((int)(threadIdx.x & 255))
#define HB ((int)(threadIdx.x >> 8))

#define XB_TMO      128
#define XB_XCNT(j)  (256  + 64 * (j))
#define XB_XSUB(j)  (1280 + 64 * (j))
#define XB_XGEN(j)  (2304 + 64 * (j))
#define XB_TOP      3328
#define XB_TOPGEN   3392
#define XCD_BAR_WORDS 3456
#define XB_SPIN_CAP (1u << 18)
#define LAS __attribute__((address_space(3)))

__device__ __forceinline__ unsigned xb_ld(unsigned* p)              { return __hip_atomic_load(p, __ATOMIC_RELAXED, __HIP_MEMORY_SCOPE_AGENT); }
__device__ __forceinline__ unsigned xb_add(unsigned* p, unsigned v) { return __hip_atomic_fetch_add(p, v, __ATOMIC_RELAXED, __HIP_MEMORY_SCOPE_AGENT); }
__device__ __forceinline__ unsigned xb_xcc_id() { return (unsigned)__builtin_amdgcn_s_getreg((3 << 11) | 20) & 0xFu; }
#define XB_SPIN(cond, bar) do { unsigned _sp = 0; while (cond) { __builtin_amdgcn_s_sleep(1); \
    if ((++_sp & 255u) == 0u) { if (xb_ld(&(bar)[XB_TMO])) break; if (_sp > XB_SPIN_CAP) { atomicAdd(&(bar)[XB_TMO], 1u); break; } } } } while (0)

struct XcdBarrier {
    unsigned* bar; unsigned x;
    volatile LAS unsigned* st;
};

__device__ __forceinline__ XcdBarrier xcd_barrier_post(unsigned* bar, volatile LAS unsigned* st) {
    XcdBarrier b; b.bar = bar; b.x = xb_xcc_id(); b.st = st;
    if (threadIdx.x == 0) (void)xb_add(&bar[XB_XCNT(b.x)], 1u);
    return b;
}
__device__ __forceinline__ void xcd_barrier_complete(unsigned* bar, unsigned x, unsigned& nloc, unsigned& nx) {
    const unsigned G = gridDim.x * gridDim.y * gridDim.z;
    unsigned sum, cnt, mine, sp = 0u;
    for (;;) {
        sum = 0u; cnt = 0u; mine = 0u;
#pragma unroll
        for (unsigned j = 0; j < 16; ++j) { const unsigned c = xb_ld(&bar[XB_XCNT(j)]); sum += c; cnt += (c > 0u) ? 1u : 0u; mine = (j == x) ? c : mine; }
        if (sum == G) break;
        __builtin_amdgcn_s_sleep(1);
        if ((++sp & 255u) == 0u) { if (xb_ld(&bar[XB_TMO])) break; if (sp > XB_SPIN_CAP) { atomicAdd(&bar[XB_TMO], 1u); break; } }
    }
    nloc = mine > 0u ? mine : 1u; nx = cnt > 0u ? cnt : 1u;
}

__device__ __forceinline__ void xcd_barrier(const XcdBarrier& b) {
    asm volatile("s_waitcnt vmcnt(0)" ::: "memory");
    __syncthreads();
    if (threadIdx.x == 0) {
        unsigned* bar = b.bar;
        __builtin_amdgcn_s_waitcnt(0);
        unsigned nloc = b.st[0], nx = b.st[1];
        if (nloc == 0u) { xcd_barrier_complete(bar, b.x, nloc, nx); b.st[0] = nloc; b.st[1] = nx; }
        const unsigned old = xb_add(&bar[XB_XSUB(b.x)], 1u);
        const unsigned gen = old / nloc;
        if (old + 1u == (gen + 1u) * nloc) {
            __builtin_amdgcn_fence(__ATOMIC_RELEASE, "agent");
            asm volatile("s_waitcnt vmcnt(0)" ::: "memory");
            const unsigned og = xb_add(&bar[XB_TOP], 1u);
            const unsigned tg = og / nx;
            if (og + 1u == (tg + 1u) * nx) xb_add(&bar[XB_TOPGEN], 1u);
            else XB_SPIN(xb_ld(&bar[XB_TOPGEN]) == tg, bar);
            __builtin_amdgcn_fence(__ATOMIC_ACQUIRE, "agent");
            xb_add(&bar[XB_XGEN(b.x)], 1u);
            asm volatile("s_waitcnt vmcnt(0)" ::: "memory");
        } else {
            XB_SPIN(xb_ld(&bar[XB_XGEN(b.x)]) == gen, bar);
            __builtin_amdgcn_fence(__ATOMIC_ACQUIRE, "agent");
            asm volatile("s_waitcnt vmcnt(0)" ::: "memory");
        }
    }
    __syncthreads();
}


typedef __hip_bfloat16 bf16;
typedef __attribute__((ext_vector_type(8))) short bf16x8;
typedef __attribute__((ext_vector_type(4))) float f32x4;

constexpr int DM = 1024;
constexpr int NB = 4;
constexpr int SEQ = 4096;
constexpr int NT = NB * SEQ;
constexpr int DIN = 4128;
constexpr int NPAD_IN = 4224;
constexpr float EPSF = 1e-6f;

__device__ __forceinline__ float bf2f(unsigned short u) { return __uint_as_float(((unsigned)u) << 16); }
typedef __bf16 bf16x2_t __attribute__((ext_vector_type(2)));
typedef float f32x2_t __attribute__((ext_vector_type(2)));
__device__ __forceinline__ unsigned short f2bf(float f) { return __builtin_bit_cast(unsigned short, (__bf16)f); }
__device__ __forceinline__ unsigned pack2(float a, float b) {
  f32x2_t v = {a, b};
  return __builtin_bit_cast(unsigned, __builtin_convertvector(v, bf16x2_t));
}
__device__ __forceinline__ float wave_sum(float v) {
#pragma unroll
  for (int o = 32; o > 0; o >>= 1) v += __shfl_xor(v, o, 64);
  return v;
}
#define DPP_ADD(v, ctrl) v += __builtin_bit_cast(float, __builtin_amdgcn_update_dpp(0, __builtin_bit_cast(int, v), ctrl, 0xF, 0xF, true))
__device__ __forceinline__ float wave_sum_dpp(float v) {
  DPP_ADD(v, 0xB1);
  DPP_ADD(v, 0x4E);
  DPP_ADD(v, 0x141);
  DPP_ADD(v, 0x140);
  const float r0 = __builtin_bit_cast(float, __builtin_amdgcn_readlane(__builtin_bit_cast(int, v), 0));
  const float r1 = __builtin_bit_cast(float, __builtin_amdgcn_readlane(__builtin_bit_cast(int, v), 16));
  const float r2 = __builtin_bit_cast(float, __builtin_amdgcn_readlane(__builtin_bit_cast(int, v), 32));
  const float r3 = __builtin_bit_cast(float, __builtin_amdgcn_readlane(__builtin_bit_cast(int, v), 48));
  return (r0 + r1) + (r2 + r3);
}
__device__ __forceinline__ float softplusf(float x) { return fmaxf(x, 0.f) + log1pf(expf(-fabsf(x))); }
__device__ __forceinline__ float sigmoidf(float x) { return __builtin_amdgcn_rcpf(1.f + __builtin_amdgcn_exp2f(-1.4426950408889634f * x)); }

__device__ __forceinline__ void d_prep_x(int item, const float* __restrict__ x, unsigned short* __restrict__ xb,
                                                float* __restrict__ rs) {
  int t = item * 4 + (TIDX >> 6);
  int lane = TIDX & 63;
  const float4* xr = (const float4*)(x + (size_t)t * DM);
  float ss = 0.f;
#pragma unroll
  for (int i = 0; i < 4; ++i) {
    float4 v = xr[lane + 64 * i];
    ss += v.x * v.x + v.y * v.y + v.z * v.z + v.w * v.w;
    ushort4 o;
    o.x = f2bf(v.x); o.y = f2bf(v.y); o.z = f2bf(v.z); o.w = f2bf(v.w);
    ((ushort4*)(xb + (size_t)t * DM))[lane + 64 * i] = o;
  }
  ss = wave_sum(ss);
  if (lane == 0) rs[t] = rsqrtf(ss * (1.f / DM) + EPSF);
}

__device__ __forceinline__ int win_src(int n) {
  if (n < 2048) return n;
  if (n < 4096) return n + 16;
  int j = n - 4096;
  if (j < 16) return 2048 + j;
  if (j < 32) return 4112 + (j - 16);
  return -1;
}
__device__ __forceinline__ void d_transpose_w(int item, int ntn, float* tile, const float* __restrict__ in, int ldn,
                                              const float* __restrict__ g, unsigned short* __restrict__ out, int mode) {
  const int kt = item / ntn, nt = item % ntn;
  const int tid = TIDX;
  __syncthreads();
#pragma unroll
  for (int i = 0; i < 4; ++i) {
    const int row = (tid >> 4) + 16 * i;
    const int c4 = (tid & 15) * 4;
    const int n = nt * 64 + c4;
    const int src = mode ? win_src(n) : n;
    float4 v = make_float4(0.f, 0.f, 0.f, 0.f);
    if (src >= 0) {
      v = *(const float4*)(in + (size_t)(kt * 64 + row) * ldn + src);
      if (g) { const float gg = g[kt * 64 + row]; v.x *= gg; v.y *= gg; v.z *= gg; v.w *= gg; }
    }
    tile[row * 65 + c4] = v.x; tile[row * 65 + c4 + 1] = v.y; tile[row * 65 + c4 + 2] = v.z; tile[row * 65 + c4 + 3] = v.w;
  }
  __syncthreads();
  {
    const int n = tid >> 2, k16 = (tid & 3) * 16;
    uint4 o0, o1;
    o0.x = pack2(tile[(k16 + 0) * 65 + n], tile[(k16 + 1) * 65 + n]);   o0.y = pack2(tile[(k16 + 2) * 65 + n], tile[(k16 + 3) * 65 + n]);
    o0.z = pack2(tile[(k16 + 4) * 65 + n], tile[(k16 + 5) * 65 + n]);   o0.w = pack2(tile[(k16 + 6) * 65 + n], tile[(k16 + 7) * 65 + n]);
    o1.x = pack2(tile[(k16 + 8) * 65 + n], tile[(k16 + 9) * 65 + n]);   o1.y = pack2(tile[(k16 + 10) * 65 + n], tile[(k16 + 11) * 65 + n]);
    o1.z = pack2(tile[(k16 + 12) * 65 + n], tile[(k16 + 13) * 65 + n]); o1.w = pack2(tile[(k16 + 14) * 65 + n], tile[(k16 + 15) * 65 + n]);
    unsigned short* op = out + (size_t)(nt * 64 + n) * DM + kt * 64 + k16;
    *(uint4*)op = o0;
    *(uint4*)(op + 8) = o1;
  }
}
__device__ __forceinline__ void d_cvt_bf16(int item, const float* __restrict__ src, unsigned short* __restrict__ dst,
                                           const float* __restrict__ rowscale, int rowlen_log2) {
  const size_t base = (size_t)item * 2048 + TIDX * 8;
  float4 a = *(const float4*)(src + base);
  float4 b = *(const float4*)(src + base + 4);
  if (rowscale) {
    const float sc = rowscale[base >> rowlen_log2];
    a.x *= sc; a.y *= sc; a.z *= sc; a.w *= sc; b.x *= sc; b.y *= sc; b.z *= sc; b.w *= sc;
  }
  uint4 o;
  o.x = pack2(a.x, a.y); o.y = pack2(a.z, a.w); o.z = pack2(b.x, b.y); o.w = pack2(b.z, b.w);
  *(uint4*)(dst + base) = o;
}

constexpr int GBM = 128, GBN = 128, GBK = 64, GLD = 64;
struct GemmP {
  const unsigned short* A; const unsigned short* Bt; int lda, ldb, K;
  const float* rowscale;
  unsigned short* obf; int ldo;
  float* of32; int ldf;
  const float* resid;
  const float *a_log, *dt_bias, *i_bias, *f_bias;
  float* rowacc;
};
enum { EPI_INPROJ = 0, EPI_OUTPROJ = 1, EPI_SCORES = 2, EPI_PLAIN = 3 };

template <int EPI>
__device__ __forceinline__ void gemm_tile(const GemmP p, int tm, int tn, unsigned short* smem) {
  unsigned short* As = smem;
  unsigned short* Bs = smem + 2 * GBM * GLD;
  int tid = TIDX;
  asm volatile("" : "+v"(tid));
  const int lane = tid & 63, wid = tid >> 6;
  const int wm = wid >> 1, wn = wid & 1;
  const int m0 = tm * GBM, n0 = tn * GBN;
  f32x4 acc[4][4];
#pragma unroll
  for (int i = 0; i < 4; ++i)
#pragma unroll
    for (int j = 0; j < 4; ++j) acc[i][j] = (f32x4){0.f, 0.f, 0.f, 0.f};

  uint4 ra0, ra1, ra2, ra3, rb0, rb1, rb2, rb3;
  uint4 sa0, sa1, sa2, sa3, sb0, sb1, sb2, sb3;
  const int nk = p.K / GBK;
  const int lrow = tid >> 3, lc8 = tid & 7;
  const unsigned short* Ag = p.A + (size_t)(m0 + lrow) * p.lda + lc8 * 8;
  const unsigned short* Bg = p.Bt + (size_t)(n0 + lrow) * p.ldb + lc8 * 8;
  const size_t a32 = (size_t)32 * p.lda, b32 = (size_t)32 * p.ldb;
#define GLOAD(R, S, kt)                                                  \
  {                                                                      \
    R##0 = *(const uint4*)(Ag + (kt) * GBK);                             \
    R##1 = *(const uint4*)(Ag + a32 + (kt) * GBK);                       \
    R##2 = *(const uint4*)(Ag + 2 * a32 + (kt) * GBK);                   \
    R##3 = *(const uint4*)(Ag + 3 * a32 + (kt) * GBK);                   \
    S##0 = *(const uint4*)(Bg + (kt) * GBK);                             \
    S##1 = *(const uint4*)(Bg + b32 + (kt) * GBK);                       \
    S##2 = *(const uint4*)(Bg + 2 * b32 + (kt) * GBK);                   \
    S##3 = *(const uint4*)(Bg + 3 * b32 + (kt) * GBK);                   \
  }
#define SSTORE(R, S, buf)                                                \
  {                                                                      \
    unsigned short* ad = As + (size_t)(buf) * GBM * GLD + lrow * GLD + ((lc8 ^ (lrow & 7)) * 8); \
    unsigned short* bd = Bs + (size_t)(buf) * GBN * GLD + lrow * GLD + ((lc8 ^ (lrow & 7)) * 8); \
    *(uint4*)(ad) = R##0; *(uint4*)(ad + 32 * GLD) = R##1; *(uint4*)(ad + 64 * GLD) = R##2; *(uint4*)(ad + 96 * GLD) = R##3; \
    *(uint4*)(bd) = S##0; *(uint4*)(bd + 32 * GLD) = S##1; *(uint4*)(bd + 64 * GLD) = S##2; *(uint4*)(bd + 96 * GLD) = S##3; \
  }
#define GCOMPUTE(buf)                                                                                                     \
  {                                                                                                                       \
    const unsigned short* Ab = As + (size_t)(buf) * GBM * GLD;                                                            \
    const unsigned short* Bb = Bs + (size_t)(buf) * GBN * GLD;                                                            \
    _Pragma("unroll") for (int ks = 0; ks < 2; ++ks) {                                                                    \
      bf16x8 a[4], b[4];                                                                                                  \
      const int kc = ((ks * 4 + (lane >> 4)) ^ (lane & 7)) * 8;                   \
      _Pragma("unroll") for (int i = 0; i < 4; ++i) a[i] = *(const bf16x8*)(Ab + (wm * 64 + i * 16 + (lane & 15)) * GLD + kc); \
      _Pragma("unroll") for (int j = 0; j < 4; ++j) b[j] = *(const bf16x8*)(Bb + (wn * 64 + j * 16 + (lane & 15)) * GLD + kc); \
      _Pragma("unroll") for (int i = 0; i < 4; ++i)                                                                       \
        _Pragma("unroll") for (int j = 0; j < 4; ++j)                                                                     \
          acc[i][j] = __builtin_amdgcn_mfma_f32_16x16x32_bf16(b[j], a[i], acc[i][j], 0, 0, 0);               \
    }                                                                                                                     \
  }
  GLOAD(ra, rb, 0);
  if (nk > 1) GLOAD(sa, sb, 1);
  SSTORE(ra, rb, 0);
  __syncthreads();
  for (int kt = 0; kt < nk; kt += 2) {
    if (kt + 2 < nk) GLOAD(ra, rb, kt + 2);
    GCOMPUTE(0);
    if (kt + 1 < nk) SSTORE(sa, sb, 1);
    __syncthreads();
    if (kt + 1 < nk) {
      if (kt + 3 < nk) GLOAD(sa, sb, kt + 3);
      GCOMPUTE(1);
      if (kt + 2 < nk) SSTORE(ra, rb, 0);
      __syncthreads();
    }
  }
#undef GLOAD
#undef SSTORE
#undef GCOMPUTE
#pragma unroll
  for (int i = 0; i < 4; ++i) {
    const int row = m0 + wm * 64 + i * 16 + (lane & 15);
    float rsc = 1.f;
    float rowss = 0.f;
    if (EPI == EPI_INPROJ) rsc = p.rowscale[row];
    if (EPI == EPI_SCORES) {
      const float4* pr = (const float4*)(p.rowscale + (size_t)row * 16);
      const float4 s0 = pr[0], s1 = pr[1], s2 = pr[2], s3 = pr[3];
      const float ssq = ((s0.x + s0.y) + (s0.z + s0.w)) + ((s1.x + s1.y) + (s1.z + s1.w)) + ((s2.x + s2.y) + (s2.z + s2.w)) + ((s3.x + s3.y) + (s3.z + s3.w));
      rsc = rsqrtf(ssq * (1.f / DM) + EPSF);
    }
#pragma unroll
    for (int j = 0; j < 4; ++j) {
      const int col0 = n0 + wn * 64 + j * 16 + (lane >> 4) * 4;
      const float v0 = acc[i][j][0] * rsc, v1 = acc[i][j][1] * rsc, v2 = acc[i][j][2] * rsc, v3 = acc[i][j][3] * rsc;
      if (EPI == EPI_INPROJ) {
        if (col0 < 4096) {
          uint2 pk; pk.x = pack2(v0, v1); pk.y = pack2(v2, v3);
          *(uint2*)(p.obf + (size_t)row * p.ldo + col0) = pk;
        } else if (col0 < 4128) {
          const float vv[4] = {v0, v1, v2, v3};
          float oo[4];
#pragma unroll
          for (int r = 0; r < 4; ++r) {
            const int jg = col0 - 4096 + r, jj = jg & 7;
            const float v = vv[r];
            float o;
            if (jg < 8) o = -expf(p.a_log[jj]) * softplusf(v + p.dt_bias[jj]);
            else if (jg < 16) o = sigmoidf(v);
            else if (jg < 24) o = v + p.i_bias[jj];
            else o = -softplusf(-(v + p.f_bias[jj]));
            oo[r] = o;
          }
          *(float4*)(p.of32 + (size_t)row * p.ldf + (col0 - 4096)) = make_float4(oo[0], oo[1], oo[2], oo[3]);
        }
      } else if (EPI == EPI_OUTPROJ) {
        const float4 xr = *(const float4*)(p.resid + (size_t)row * p.ldf + col0);
        const float x0 = v0 + xr.x, x1 = v1 + xr.y, x2 = v2 + xr.z, x3 = v3 + xr.w;
        *(float4*)(p.of32 + (size_t)row * p.ldf + col0) = make_float4(x0, x1, x2, x3);
        uint2 pk; pk.x = pack2(x0, x1); pk.y = pack2(x2, x3);
        *(uint2*)(p.obf + (size_t)row * p.ldo + col0) = pk;
        rowss += (x0 * x0 + x1 * x1) + (x2 * x2 + x3 * x3);
      } else {
        uint2 pk; pk.x = pack2(v0, v1); pk.y = pack2(v2, v3);
        *(uint2*)(p.obf + (size_t)row * p.ldo + col0) = pk;
      }
    }
    if (EPI == EPI_OUTPROJ) {
      rowss += __shfl_xor(rowss, 16, 64);
      rowss += __shfl_xor(rowss, 32, 64);
      if ((lane >> 4) == 0) p.rowacc[(size_t)row * 16 + tn * 2 + wn] = rowss;
    }
  }
}

__device__ __forceinline__ bool xcd_tile(int bid, int nb, int k, int ntn, int& tm, int& tn) {
  const int q = ((bid >> 3) * 2 + HB) + (nb >> 3) * 2 * k;
  const bool ok = q < 16 * ntn;
  const int qq = ok ? q : (16 * ntn - 1);
  const int g = qq / (8 * ntn), rem = qq % (8 * ntn);
  tn = rem >> 3;
  tm = 16 * (bid & 7) + 8 * g + (rem & 7);
  return ok;
}

__device__ __forceinline__ int g8_lds_byte(int r, int c) {
  const int st = (r >> 4) * 2 + (c >> 5), rr = r & 15, cc = c & 31, ob = rr * 64 + cc * 2;
  return st * 1024 + (ob ^ (((ob >> 9) & 1) << 5));
}
__device__ __forceinline__ void g8_stage_rc(int b, int& R, int& C) {
  const int st = b / 1024, sb = b % 1024, swz = sb ^ (((sb >> 9) & 1) << 5);
  R = (st >> 1) * 16 + swz / 64; C = (st & 1) * 32 + (swz % 64) / 2;
}
template <int EPI>
__device__ __forceinline__ void gemm256_tile(const GemmP p, int tm, int tn, char* shm_c) {
  constexpr int BK = 64, HALF = 128, HT = HALF * BK;
  const int K = p.K;
  int tidx = threadIdx.x;
  asm volatile("" : "+v"(tidx));
  unsigned short* shm = (unsigned short*)shm_c;
  const unsigned short* A = p.A;
  const unsigned short* Bt = p.Bt;
#define SA(b, h) (shm + ((b) * 2 + (h)) * HT)
#define SB(b, h) (shm + (4 + (b) * 2 + (h)) * HT)
#define STAGE(P_, BASE, br, kt) do { const long _g = (long)(br) * K + (long)(kt) * BK; \
    for (int _i = 0; _i < 2; ++_i) { const int _b = tidx * 16 + _i * 8192; int _r, _c; g8_stage_rc(_b, _r, _c); \
      __builtin_amdgcn_global_load_lds((const unsigned*)(BASE + _g + (long)_r * K + _c), \
        (__attribute__((address_space(3))) unsigned*)((char*)(P_) + _b), 16, 0, 0); } } while (0)
#define LDA(dst, b, h) for (int m = 0; m < 4; ++m) for (int k = 0; k < 2; ++k) \
    dst[m][k] = *reinterpret_cast<const bf16x8*>((char*)SA(b, h) + g8_lds_byte(wr * 64 + m * 16 + fr, k * 32 + fq * 8))
#define LDB(dst, b, h) for (int n = 0; n < 2; ++n) for (int k = 0; k < 2; ++k) \
    dst[n][k] = *reinterpret_cast<const bf16x8*>((char*)SB(b, h) + g8_lds_byte(wc * 32 + n * 16 + fr, k * 32 + fq * 8))
#define MMA(ai, bj, At_, Bt_) do { __builtin_amdgcn_s_setprio(1); \
    for (int m = 0; m < 4; ++m) for (int n = 0; n < 2; ++n) for (int k = 0; k < 2; ++k) \
      acc[ai][bj][m][n] = __builtin_amdgcn_mfma_f32_16x16x32_bf16(Bt_[n][k], At_[m][k], acc[ai][bj][m][n], 0, 0, 0); \
    __builtin_amdgcn_s_setprio(0); } while (0)
#define WAIT_V(n) asm volatile("s_waitcnt vmcnt(" #n ")" ::: "memory")
#define WAIT_L(n) asm volatile("s_waitcnt lgkmcnt(" #n ")" ::: "memory")
#define BAR __builtin_amdgcn_s_barrier()
#define SCHED __builtin_amdgcn_sched_barrier(0)
  const int brow = tm * 256, bcol = tn * 256;
  const int wid = __builtin_amdgcn_readfirstlane(tidx >> 6), lane = tidx & 63, wr = wid >> 2, wc = wid & 3, fr = lane & 15, fq = lane >> 4;
  f32x4 acc[2][2][4][2] = {};
  bf16x8 At[4][2], B0[2][2], B1[2][2];
  const int nt = K / BK;
  STAGE(SB(0, 0), Bt, bcol, 0); STAGE(SA(0, 0), A, brow, 0);
  STAGE(SB(0, 1), Bt, bcol + HALF, 0); STAGE(SA(0, 1), A, brow + HALF, 0);
  if (wr == 1) BAR;
  WAIT_V(4); BAR;
  STAGE(SB(1, 0), Bt, bcol, 1); STAGE(SA(1, 0), A, brow, 1); STAGE(SB(1, 1), Bt, bcol + HALF, 1);
  WAIT_V(6); BAR;
#pragma unroll 1
  for (int t = 0; t < nt - 2; t += 2) {
    LDB(B0, 0, 0); SCHED; LDA(At, 0, 0); STAGE(SA(1, 1), A, brow + HALF, t + 1);
    WAIT_L(8); BAR; WAIT_L(0); MMA(0, 0, At, B0); BAR; SCHED;
    LDB(B1, 0, 1); STAGE(SB(0, 0), Bt, bcol, t + 2);
    BAR; WAIT_L(0); MMA(0, 1, At, B1); BAR;
    LDA(At, 0, 1); STAGE(SA(0, 0), A, brow, t + 2);
    BAR; WAIT_L(0); MMA(1, 0, At, B0); BAR; SCHED;
    STAGE(SB(0, 1), Bt, bcol + HALF, t + 2);
    WAIT_V(6); BAR; MMA(1, 1, At, B1); BAR;
    LDB(B0, 1, 0); SCHED; LDA(At, 1, 0); STAGE(SA(0, 1), A, brow + HALF, t + 2);
    WAIT_L(8); BAR; WAIT_L(0); MMA(0, 0, At, B0); BAR; SCHED;
    LDB(B1, 1, 1); STAGE(SB(1, 0), Bt, bcol, t + 3);
    BAR; WAIT_L(0); MMA(0, 1, At, B1); BAR;
    LDA(At, 1, 1); STAGE(SA(1, 0), A, brow, t + 3);
    BAR; WAIT_L(0); MMA(1, 0, At, B0); BAR; SCHED;
    STAGE(SB(1, 1), Bt, bcol + HALF, t + 3);
    WAIT_V(6); BAR; MMA(1, 1, At, B1); BAR;
  }
  { LDB(B0, 0, 0); LDA(At, 0, 0); STAGE(SA(1, 1), A, brow + HALF, nt - 1);
    BAR; WAIT_L(0); MMA(0, 0, At, B0); BAR;
    LDB(B1, 0, 1); BAR; WAIT_L(0); MMA(0, 1, At, B1); BAR;
    LDA(At, 0, 1); WAIT_V(4); BAR; WAIT_L(0); MMA(1, 0, At, B0); MMA(1, 1, At, B1); BAR; }
  { LDB(B0, 1, 0); LDA(At, 1, 0); WAIT_V(2); BAR; WAIT_L(0); MMA(0, 0, At, B0); BAR;
    LDB(B1, 1, 1); WAIT_V(0); BAR; WAIT_L(0); MMA(0, 1, At, B1); BAR;
    LDA(At, 1, 1); BAR; WAIT_L(0); MMA(1, 0, At, B0); MMA(1, 1, At, B1); BAR; }
  if (wr == 0) BAR;
#undef SA
#undef SB
#undef STAGE
#undef LDA
#undef LDB
#undef MMA
#undef WAIT_V
#undef WAIT_L
#undef BAR
#undef SCHED
#pragma unroll
  for (int ai = 0; ai < 2; ++ai)
#pragma unroll
    for (int m = 0; m < 4; ++m) {
      const int row = brow + ai * 128 + wr * 64 + m * 16 + fr;
      float rsc = 1.f;
      float rowss = 0.f;
      if (EPI == EPI_INPROJ) rsc = p.rowscale[row];
      if (EPI == EPI_SCORES) {
        const float4* pr = (const float4*)(p.rowscale + (size_t)row * 16);
        const float4 s0 = pr[0], s1 = pr[1], s2 = pr[2], s3 = pr[3];
        const float ssq = ((s0.x + s0.y) + (s0.z + s0.w)) + ((s1.x + s1.y) + (s1.z + s1.w)) + ((s2.x + s2.y) + (s2.z + s2.w)) + ((s3.x + s3.y) + (s3.z + s3.w));
        rsc = rsqrtf(ssq * (1.f / DM) + EPSF);
      }
#pragma unroll
      for (int bj = 0; bj < 2; ++bj)
#pragma unroll
        for (int n = 0; n < 2; ++n) {
          const int col0 = bcol + bj * 128 + wc * 32 + n * 16 + fq * 4;
          const f32x4 a = acc[ai][bj][m][n];
          const float v0 = a[0] * rsc, v1 = a[1] * rsc, v2 = a[2] * rsc, v3 = a[3] * rsc;
          if (EPI == EPI_OUTPROJ) {
            const float4 xr = *(const float4*)(p.resid + (size_t)row * p.ldf + col0);
            const float x0 = v0 + xr.x, x1 = v1 + xr.y, x2 = v2 + xr.z, x3 = v3 + xr.w;
            *(float4*)(p.of32 + (size_t)row * p.ldf + col0) = make_float4(x0, x1, x2, x3);
            uint2 pk; pk.x = pack2(x0, x1); pk.y = pack2(x2, x3);
            *(uint2*)(p.obf + (size_t)row * p.ldo + col0) = pk;
            rowss += (x0 * x0 + x1 * x1) + (x2 * x2 + x3 * x3);
          } else {
            uint2 pk; pk.x = pack2(v0, v1); pk.y = pack2(v2, v3);
            *(uint2*)(p.obf + (size_t)row * p.ldo + col0) = pk;
          }
        }
      if (EPI == EPI_OUTPROJ) {
        rowss += __shfl_xor(rowss, 16, 64);
        rowss += __shfl_xor(rowss, 32, 64);
        if (fq == 0) p.rowacc[(size_t)row * 16 + tn * 4 + wc] = rowss;
      }
    }
}
__device__ __forceinline__ void d_gate_proj(int item, const unsigned short* __restrict__ xb, const unsigned short* __restrict__ winT,
                                            const float* __restrict__ rs1, const float* __restrict__ a_log,
                                            const float* __restrict__ dt_bias, const float* __restrict__ i_bias,
                                            const float* __restrict__ f_bias, float* __restrict__ gt) {
  const int job = item * 8 + (threadIdx.x >> 6);
  const int lane = threadIdx.x & 63, fr = lane & 15, fq = lane >> 4;
  const int t0 = job * 16;
  const unsigned short* ap = xb + (size_t)(t0 + fr) * DM + 8 * fq;
  const unsigned short* bp0 = winT + (size_t)(4096 + fr) * DM + 8 * fq;
  const unsigned short* bp1 = winT + (size_t)(4096 + 16 + fr) * DM + 8 * fq;
  f32x4 acc0 = {0.f, 0.f, 0.f, 0.f}, acc1 = {0.f, 0.f, 0.f, 0.f};
#pragma unroll 8
  for (int s2 = 0; s2 < 32; ++s2) {
    const bf16x8 a = *(const bf16x8*)(ap + 32 * s2);
    const bf16x8 b0 = *(const bf16x8*)(bp0 + 32 * s2);
    const bf16x8 b1 = *(const bf16x8*)(bp1 + 32 * s2);
    acc0 = __builtin_amdgcn_mfma_f32_16x16x32_bf16(a, b0, acc0, 0, 0, 0);
    acc1 = __builtin_amdgcn_mfma_f32_16x16x32_bf16(a, b1, acc1, 0, 0, 0);
  }
  const int jj = fr & 7;
  const float al = -expf(a_log[jj]), db = dt_bias[jj], ib = i_bias[jj], fb = f_bias[jj];
#pragma unroll
  for (int j = 0; j < 4; ++j) {
    const int t = t0 + 4 * fq + j;
    const float r = rs1[t];
    const float v0 = acc0[j] * r, v1 = acc1[j] * r;
    const float o0 = (fr < 8) ? al * softplusf(v0 + db) : sigmoidf(v0);
    const float o1 = (fr < 8) ? (v1 + ib) : -softplusf(-(v1 + fb));
    gt[(size_t)t * 32 + fr] = o0;
    gt[(size_t)t * 32 + 16 + fr] = o1;
  }
}

__device__ __forceinline__ bool xcd_tile256(int bid, int nb, int k, int ntn, int& tm, int& tn) {
  const int q = (bid >> 3) + (nb >> 3) * k;
  if (q >= 8 * ntn) return false;
  tn = q >> 3;
  tm = 8 * (bid & 7) + (q & 7);
  return true;
}

__device__ __forceinline__ void d_conv(int item, const unsigned short* __restrict__ pm, const float* __restrict__ pg,
                                              const float* __restrict__ conv_w, const float* __restrict__ a_log,
                                              const float* __restrict__ dt_bias, const float* __restrict__ i_bias,
                                              const float* __restrict__ f_bias, unsigned short* __restrict__ qkv,
                                              float* __restrict__ gt) {
  int t = item * 4 + (TIDX >> 6);
  int lane = TIDX & 63;
  int s = t & (SEQ - 1);
  for (int sec = 0; sec < 3; ++sec) {
    for (int h = 0; h < 4; ++h) {
      int c0 = sec * 512 + h * 128 + 2 * lane;
      float a0 = 0.f, a1 = 0.f;
#pragma unroll
      for (int j = 0; j < 5; ++j) {
        int sp = s + j - 2;
        if (sp >= 0 && sp < SEQ) {
          unsigned v = *(const unsigned*)(pm + (size_t)(t + j - 2) * 4096 + c0);
          a0 += conv_w[c0 * 5 + j] * bf2f((unsigned short)(v & 0xffff));
          a1 += conv_w[(c0 + 1) * 5 + j] * bf2f((unsigned short)(v >> 16));
        }
      }
      a0 = a0 * sigmoidf(a0);
      a1 = a1 * sigmoidf(a1);
      if (sec < 2) {
        float ss = wave_sum(a0 * a0 + a1 * a1);
        float sc = rsqrtf(ss + EPSF);
        if (sec == 0) sc *= 0.08838834764831845f;
        a0 *= sc; a1 *= sc;
      }
      unsigned o = pack2(a0, a1);
      *(unsigned*)(qkv + (size_t)t * 1536 + c0) = o;
    }
  }
}

__device__ __forceinline__ void d_gdn_rec(int chain, float* sq, float* sk, const unsigned short* __restrict__ qkv,
                                                 const float* __restrict__ gt, unsigned short* __restrict__ oA, int ntok) {
  const int bh = chain >> 1, dir = chain & 1;
  const int b = bh >> 2, h = bh & 3;
  const int e = TIDX & 127;
  float S[128];
#pragma unroll
  for (int d = 0; d < 128; ++d) S[d] = 0.f;
  for (int it = 0; it < SEQ; ++it) {
    const int s = dir ? (SEQ - 1 - it) : it;
    const size_t t = (size_t)b * SEQ + s;
    __syncthreads();
    sq[e] = bf2f(qkv[t * 1536 + h * 128 + e]);
    sk[e] = bf2f(qkv[t * 1536 + 512 + h * 128 + e]);
    const float v = bf2f(qkv[t * 1536 + 1024 + h * 128 + e]);
    const float g = gt[t * 32 + dir * 4 + h];
    const float beta = gt[t * 32 + 8 + dir * 4 + h];
    __syncthreads();
    const float a = expf(g);
    float k0 = 0.f, k1 = 0.f, k2 = 0.f, k3 = 0.f;
#pragma unroll
    for (int d = 0; d < 128; d += 4) {
      k0 += sk[d] * S[d]; k1 += sk[d + 1] * S[d + 1]; k2 += sk[d + 2] * S[d + 2]; k3 += sk[d + 3] * S[d + 3];
    }
    const float kS = a * ((k0 + k1) + (k2 + k3));
    const float vn = beta * (v - kS);
    float o0 = 0.f, o1 = 0.f, o2 = 0.f, o3 = 0.f;
#pragma unroll
    for (int d = 0; d < 128; d += 4) {
      S[d] = a * S[d] + sk[d] * vn;             o0 += sq[d] * S[d];
      S[d + 1] = a * S[d + 1] + sk[d + 1] * vn; o1 += sq[d + 1] * S[d + 1];
      S[d + 2] = a * S[d + 2] + sk[d + 2] * vn; o2 += sq[d + 2] * S[d + 2];
      S[d + 3] = a * S[d + 3] + sk[d + 3] * vn; o3 += sq[d + 3] * S[d + 3];
    }
    oA[((size_t)dir * ntok + t) * 512 + h * 128 + e] = f2bf((o0 + o1) + (o2 + o3));
  }
}

__device__ __forceinline__ void d_mlstm_rec(int chain, float* sq, float* sk, const unsigned short* __restrict__ pm,
                                                   const float* __restrict__ gt, unsigned short* __restrict__ oM, int ntok) {
  const int bh = chain >> 1, dir = chain & 1;
  const int b = bh >> 2, h = bh & 3;
  const int e = TIDX & 127, lane = e & 63;
  float C[128];
#pragma unroll
  for (int d = 0; d < 128; ++d) C[d] = 0.f;
  float n0 = 0.f, n1 = 0.f, m = 0.f;
  for (int it = 0; it < SEQ; ++it) {
    const int s = dir ? (SEQ - 1 - it) : it;
    const size_t t = (size_t)b * SEQ + s;
    __syncthreads();
    sq[e] = bf2f(pm[t * 4096 + 2048 + h * 128 + e]);
    sk[e] = bf2f(pm[t * 4096 + 2560 + h * 128 + e]) * 0.08838834764831845f;
    const float v = bf2f(pm[t * 4096 + 3072 + h * 128 + e]);
    const float ip = gt[t * 32 + 16 + dir * 4 + h];
    const float lf = gt[t * 32 + 24 + dir * 4 + h];
    __syncthreads();
    const float mn = fmaxf(lf + m, ip);
    const float fs = expf(lf + m - mn);
    const float is = expf(ip - mn);
    m = mn;
    n0 = fs * n0 + is * sk[lane];
    n1 = fs * n1 + is * sk[lane + 64];
    const float den = wave_sum(n0 * sq[lane] + n1 * sq[lane + 64]);
    const float iv = is * v;
    float o0 = 0.f, o1 = 0.f, o2 = 0.f, o3 = 0.f;
#pragma unroll
    for (int d = 0; d < 128; d += 4) {
      C[d] = fs * C[d] + sk[d] * iv;             o0 += sq[d] * C[d];
      C[d + 1] = fs * C[d + 1] + sk[d + 1] * iv; o1 += sq[d + 1] * C[d + 1];
      C[d + 2] = fs * C[d + 2] + sk[d + 2] * iv; o2 += sq[d + 2] * C[d + 2];
      C[d + 3] = fs * C[d + 3] + sk[d + 3] * iv; o3 += sq[d + 3] * C[d + 3];
    }
    const float num = (o0 + o1) + (o2 + o3);
    const float hh = num / fmaxf(fabsf(den), expf(-mn));
    oM[((size_t)dir * ntok + t) * 512 + h * 128 + e] = f2bf(hh);
  }
}

__device__ __forceinline__ void d_combine(int item, const unsigned short* __restrict__ uo, const unsigned short* __restrict__ oM,
                                                 const unsigned short* __restrict__ pm, const float* __restrict__ gdn_g,
                                                 const float* __restrict__ ml_g, unsigned short* __restrict__ y) {
  int tid_ = TIDX;
  asm volatile("" : "+v"(tid_));
  const int t = item * 4 + (tid_ >> 6);
  const int lane = tid_ & 63;
  const int b = t >> 12, cc = (t >> 6) & 63, ii = t & 63;
  unsigned gf_[4], gb_[4], mf_[4], mb_[4], zg_[4], zo_[4];
  const size_t off = (size_t)cc * 8192 + (lane >> 4) * 2048 + ii * 32 + ((2 * lane) & 31);
#pragma unroll
  for (int h = 0; h < 4; ++h) {
    const int c = h * 128 + 2 * lane;
    const int chain0 = (b * 4 + h) * 2;
    gf_[h] = *(const unsigned*)(uo + (size_t)chain0 * 64 * 8192 + off);
    gb_[h] = *(const unsigned*)(uo + (size_t)(chain0 + 1) * 64 * 8192 + off);
    mf_[h] = *(const unsigned*)(oM + (size_t)t * 512 + c);
    mb_[h] = *(const unsigned*)(oM + ((size_t)NT + t) * 512 + c);
    zg_[h] = *(const unsigned*)(pm + (size_t)t * 4096 + 1536 + c);
    zo_[h] = *(const unsigned*)(pm + (size_t)t * 4096 + 3584 + c);
  }
  const float gg0 = gdn_g[2 * lane], gg1 = gdn_g[2 * lane + 1];
  float a0[4], a1[4], m0[4], m1[4], sa[4], sm[4];
#pragma unroll
  for (int h = 0; h < 4; ++h) {
    a0[h] = bf2f(gf_[h] & 0xffff) + bf2f(gb_[h] & 0xffff);
    a1[h] = __uint_as_float(gf_[h] & 0xffff0000u) + __uint_as_float(gb_[h] & 0xffff0000u);
    m0[h] = bf2f(mf_[h] & 0xffff) + bf2f(mb_[h] & 0xffff);
    m1[h] = __uint_as_float(mf_[h] & 0xffff0000u) + __uint_as_float(mb_[h] & 0xffff0000u);
    sa[h] = a0[h] * a0[h] + a1[h] * a1[h];
    sm[h] = m0[h] * m0[h] + m1[h] * m1[h];
  }
#pragma unroll
  for (int o = 32; o > 0; o >>= 1) {
#pragma unroll
    for (int h = 0; h < 4; ++h) { sa[h] += __shfl_xor(sa[h], o, 64); sm[h] += __shfl_xor(sm[h], o, 64); }
  }
#pragma unroll
  for (int h = 0; h < 4; ++h) {
    const int c = h * 128 + 2 * lane;
    const float sca = rsqrtf(sa[h] * (1.f / 128.f) + EPSF);
    const float scm = rsqrtf(sm[h] * (1.f / 128.f) + EPSF);
    const float z0 = bf2f(zg_[h] & 0xffff), z1 = __uint_as_float(zg_[h] & 0xffff0000u);
    const float q0 = bf2f(zo_[h] & 0xffff), q1 = __uint_as_float(zo_[h] & 0xffff0000u);
    const float o0 = a0[h] * sca * gg0 * (z0 * sigmoidf(z0));
    const float o1 = a1[h] * sca * gg1 * (z1 * sigmoidf(z1));
    const float p0 = m0[h] * scm * ml_g[c] * sigmoidf(q0);
    const float p1 = m1[h] * scm * ml_g[c + 1] * sigmoidf(q1);
    *(unsigned*)(y + (size_t)t * DM + c) = pack2(o0, o1);
    *(unsigned*)(y + (size_t)t * DM + 512 + c) = pack2(p0, p1);
  }
}

#ifdef DBG_CHECK
__device__ __forceinline__ void d_dbg_cmp(int item, const unsigned short* __restrict__ uo, const unsigned short* __restrict__ oAd,
                                          float* __restrict__ dbg) {
  int t = item * 4 + (TIDX >> 6);
  int lane = TIDX & 63;
  const int cc = (t >> 6) & 63, ii = t & 63;
  float sd = 0.f, sr = 0.f;
  for (int h = 0; h < 4; ++h) {
    for (int dir = 0; dir < 2; ++dir) {
      const int chain = h * 2 + dir;
      const size_t off = (size_t)cc * 8192 + (lane >> 4) * 2048 + ii * 32 + ((2 * lane) & 31);
      unsigned vn = *(const unsigned*)(uo + (size_t)chain * 64 * 8192 + off);
      unsigned vr = *(const unsigned*)(oAd + ((size_t)dir * 4096 + t) * 512 + h * 128 + 2 * lane);
      float n0 = bf2f(vn & 0xffff), n1 = bf2f(vn >> 16), r0 = bf2f(vr & 0xffff), r1 = bf2f(vr >> 16);
      sd += (n0 - r0) * (n0 - r0) + (n1 - r1) * (n1 - r1);
      sr += r0 * r0 + r1 * r1;
    }
  }
  sd = wave_sum(sd); sr = wave_sum(sr);
  if (lane == 0) { atomicAdd(&dbg[0], sd); atomicAdd(&dbg[1], sr); }
}
__device__ __forceinline__ void d_dbg_cmp_m(int item, const unsigned short* __restrict__ oM, const unsigned short* __restrict__ oMd,
                                            float* __restrict__ dbg) {
  int t = item * 4 + (TIDX >> 6);
  int lane = TIDX & 63;
  float sd = 0.f, sr = 0.f;
  for (int dir = 0; dir < 2; ++dir)
    for (int q = 0; q < 4; ++q) {
      unsigned vn = *(const unsigned*)(oM + ((size_t)dir * NT + t) * 512 + q * 128 + 2 * lane);
      unsigned vr = *(const unsigned*)(oMd + ((size_t)dir * 4096 + t) * 512 + q * 128 + 2 * lane);
      float n0 = bf2f(vn & 0xffff), n1 = bf2f(vn >> 16), r0 = bf2f(vr & 0xffff), r1 = bf2f(vr >> 16);
      sd += (n0 - r0) * (n0 - r0) + (n1 - r1) * (n1 - r1);
      sr += r0 * r0 + r1 * r1;
    }
  sd = wave_sum(sd); sr = wave_sum(sr);
  if (lane == 0) { atomicAdd(&dbg[0], sd); atomicAdd(&dbg[1], sr); }
}
#endif

__device__ __forceinline__ void d_prep_x1(int item, const float* __restrict__ x1, unsigned short* __restrict__ xb,
                                                 float* __restrict__ rs) {
  int t = item * 4 + (TIDX >> 6);
  int lane = TIDX & 63;
  const float4* xr = (const float4*)(x1 + (size_t)t * DM);
  float ss = 0.f;
#pragma unroll
  for (int i = 0; i < 4; ++i) {
    float4 v = xr[lane + 64 * i];
    ss += v.x * v.x + v.y * v.y + v.z * v.z + v.w * v.w;
    ushort4 o;
    o.x = f2bf(v.x); o.y = f2bf(v.y); o.z = f2bf(v.z); o.w = f2bf(v.w);
    ((ushort4*)(xb + (size_t)t * DM))[lane + 64 * i] = o;
  }
  ss = wave_sum(ss);
  if (lane == 0) rs[t] = rsqrtf(ss * (1.f / DM) + EPSF);
}

__device__ const unsigned char kPairTab[64] = {
    0x00, 0x01, 0x02, 0x03, 0x04, 0x05, 0x06, 0x07, 0x08, 0x09, 0x0a, 0x0b, 0x0c, 0x0d, 0x0e, 0x0f,
    0x10, 0x11, 0x12, 0x13, 0x14, 0x15, 0x16, 0x17,
    0x20, 0x21, 0x22, 0x23, 0x24,
    0x30, 0x31, 0x32, 0x33,
    0x40, 0x41, 0x42,
    0x50, 0x51, 0x60, 0x61, 0x70, 0x71,
    0x80, 0x90, 0xa0, 0xb0, 0xc0, 0xd0, 0xe0, 0xf0,
    0xff, 0xff, 0xff, 0xff, 0xff, 0xff, 0xff, 0xff, 0xff, 0xff, 0xff, 0xff, 0xff, 0xff};

__device__ __forceinline__ void sort16_desc(unsigned (&a)[16]) {
#pragma unroll
  for (int k = 2; k <= 16; k <<= 1)
#pragma unroll
    for (int j = k >> 1; j > 0; j >>= 1)
#pragma unroll
      for (int i = 0; i < 16; ++i) {
        const int l = i ^ j;
        if (l > i) {
          const unsigned hi = max(a[i], a[l]), lo = min(a[i], a[l]);
          if ((i & k) == 0) { a[i] = hi; a[l] = lo; } else { a[i] = lo; a[l] = hi; }
        }
      }
}
__device__ __forceinline__ void merge16_desc(unsigned (&top)[16], const unsigned (&b)[16]) {
#pragma unroll
  for (int i = 0; i < 16; ++i) top[i] = max(top[i], b[15 - i]);
#pragma unroll
  for (int j = 8; j > 0; j >>= 1)
#pragma unroll
    for (int i = 0; i < 16; ++i) {
      const int l = i ^ j;
      if (l > i) {
        const unsigned hi = max(top[i], top[l]), lo = min(top[i], top[l]);
        top[i] = hi; top[l] = lo;
      }
    }
}
__device__ __forceinline__ unsigned key16(unsigned hbits, int idx) {
  const unsigned m = hbits ^ ((hbits & 0x8000u) ? 0xFFFFu : 0x8000u);
  return (m << 16) | (unsigned)(127 - idx);
}
__device__ __forceinline__ void top16_of_128(const unsigned short* __restrict__ sp, unsigned (&top)[16]) {
#pragma unroll
  for (int g = 0; g < 8; ++g) {
    const uint4 x0 = *(const uint4*)(sp + g * 16);
    const uint4 x1 = *(const uint4*)(sp + g * 16 + 8);
    unsigned b[16];
    b[0] = key16(x0.x & 0xffff, g * 16 + 0);  b[1] = key16(x0.x >> 16, g * 16 + 1);
    b[2] = key16(x0.y & 0xffff, g * 16 + 2);  b[3] = key16(x0.y >> 16, g * 16 + 3);
    b[4] = key16(x0.z & 0xffff, g * 16 + 4);  b[5] = key16(x0.z >> 16, g * 16 + 5);
    b[6] = key16(x0.w & 0xffff, g * 16 + 6);  b[7] = key16(x0.w >> 16, g * 16 + 7);
    b[8] = key16(x1.x & 0xffff, g * 16 + 8);  b[9] = key16(x1.x >> 16, g * 16 + 9);
    b[10] = key16(x1.y & 0xffff, g * 16 + 10); b[11] = key16(x1.y >> 16, g * 16 + 11);
    b[12] = key16(x1.z & 0xffff, g * 16 + 12); b[13] = key16(x1.z >> 16, g * 16 + 13);
    b[14] = key16(x1.w & 0xffff, g * 16 + 14); b[15] = key16(x1.w >> 16, g * 16 + 15);
    sort16_desc(b);
    if (g == 0) {
#pragma unroll
      for (int i = 0; i < 16; ++i) top[i] = b[i];
    } else {
      merge16_desc(top, b);
    }
  }
}

__device__ __forceinline__ void d_topk(int item, const unsigned short* __restrict__ scores, int* __restrict__ idx_out,
                                       float* __restrict__ gate_out) {
  int tid_ = TIDX;
  asm volatile("" : "+v"(tid_));
  const int pair = item * 256 + tid_;
  const unsigned short* sp = scores + (size_t)pair * 256;
  unsigned k0[16], k1[16];
  top16_of_128(sp, k0);
  top16_of_128(sp + 128, k1);
  float v0[16], v1[16];
  int i0[16], i1[16];
#pragma unroll
  for (int i = 0; i < 16; ++i) {
    const unsigned m0 = k0[i] >> 16, m1 = k1[i] >> 16;
    v0[i] = bf2f((unsigned short)(m0 ^ ((m0 & 0x8000u) ? 0x8000u : 0xFFFFu)));
    v1[i] = bf2f((unsigned short)(m1 ^ ((m1 & 0x8000u) ? 0x8000u : 0xFFFFu)));
    i0[i] = 127 - (int)(k0[i] & 127u);
    i1[i] = 127 - (int)(k1[i] & 127u);
  }
  unsigned top[16];
#pragma unroll
  for (int g = 0; g < 4; ++g) {
    unsigned b[16];
#pragma unroll
    for (int q = 0; q < 16; ++q) {
      const int pr = kPairTab[g * 16 + q];
      if (pr == 0xff) {
        b[q] = 0u;
      } else {
        const int pi = pr >> 4, pj = pr & 15;
        const float sum = v0[pi] + v1[pj];
        const unsigned u = __float_as_uint(sum);
        const unsigned mono = u ^ ((u & 0x80000000u) ? 0xFFFFFFFFu : 0x80000000u);
        b[q] = (mono & 0xFFFFC000u) | (unsigned)(16383 - (i0[pi] * 128 + i1[pj]));
      }
    }
    sort16_desc(b);
    if (g == 0) {
#pragma unroll
      for (int i = 0; i < 16; ++i) top[i] = b[i];
    } else {
      merge16_desc(top, b);
    }
  }
  float ev[16];
  int ci[16];
  float mx = 0.f, sum = 0.f;
#pragma unroll
  for (int i = 0; i < 16; ++i) {
    const unsigned mono = top[i] & 0xFFFFC000u;
    const unsigned u = mono ^ ((mono & 0x80000000u) ? 0x80000000u : 0xFFFFFFFFu);
    const float val = __uint_as_float(u & 0xFFFFC000u);
    ci[i] = 16383 - (int)(top[i] & 16383u);
    if (i == 0) mx = val;
    ev[i] = expf(val - mx);
    sum += ev[i];
  }
  const float inv = 1.f / sum;
#pragma unroll
  for (int q = 0; q < 4; ++q) {
    int4 o; float4 g;
    o.x = ci[4 * q]; o.y = ci[4 * q + 1]; o.z = ci[4 * q + 2]; o.w = ci[4 * q + 3];
    g.x = ev[4 * q] * inv; g.y = ev[4 * q + 1] * inv; g.z = ev[4 * q + 2] * inv; g.w = ev[4 * q + 3] * inv;
    *(int4*)(idx_out + (size_t)pair * 16 + 4 * q) = o;
    *(float4*)(gate_out + (size_t)pair * 16 + 4 * q) = g;
  }
}

typedef float f32x2 __attribute__((ext_vector_type(2)));
__device__ __forceinline__ float wave_max_dpp(float v) {
#define DPP_MAX(v, ctrl) v = fmaxf(v, __builtin_bit_cast(float, __builtin_amdgcn_update_dpp(0, __builtin_bit_cast(int, v), ctrl, 0xF, 0xF, true)))
  DPP_MAX(v, 0xB1); DPP_MAX(v, 0x4E); DPP_MAX(v, 0x141); DPP_MAX(v, 0x140);
#undef DPP_MAX
  const float r0 = __builtin_bit_cast(float, __builtin_amdgcn_readlane(__builtin_bit_cast(int, v), 0));
  const float r1 = __builtin_bit_cast(float, __builtin_amdgcn_readlane(__builtin_bit_cast(int, v), 16));
  const float r2 = __builtin_bit_cast(float, __builtin_amdgcn_readlane(__builtin_bit_cast(int, v), 32));
  const float r3 = __builtin_bit_cast(float, __builtin_amdgcn_readlane(__builtin_bit_cast(int, v), 48));
  return fmaxf(fmaxf(r0, r1), fmaxf(r2, r3));
}
__device__ __forceinline__ float absmax4(const float4 a) { return fmaxf(fmaxf(fabsf(a.x), fabsf(a.y)), fmaxf(fabsf(a.z), fabsf(a.w))); }
template <bool I8>
__device__ __forceinline__ void d_cvt_tab(int item, const float* __restrict__ src, unsigned* __restrict__ dst8, float* __restrict__ dscale) {
  const int row0 = item * 16 + (TIDX >> 6) * 4;
  const int lane = TIDX & 63;
  float4 a[4][4];
#pragma unroll
  for (int rr = 0; rr < 4; ++rr) {
    const float4* sr = (const float4*)(src + (size_t)(row0 + rr) * DM + lane * 16);
    a[rr][0] = sr[0]; a[rr][1] = sr[1]; a[rr][2] = sr[2]; a[rr][3] = sr[3];
  }
#pragma unroll
  for (int rr = 0; rr < 4; ++rr) {
    const float m = wave_max_dpp(fmaxf(fmaxf(absmax4(a[rr][0]), absmax4(a[rr][1])), fmaxf(absmax4(a[rr][2]), absmax4(a[rr][3]))));
    const float top = I8 ? 127.f : 240.f;
    const float sc = (m > 0.f) ? top / m : 1.f;
    uint4 o;
    unsigned ow[4];
#pragma unroll
    for (int c = 0; c < 4; ++c) {
      const float4 v = a[rr][c];
      if (I8) {
        ow[c] = ((unsigned)__float2int_rn(v.x * sc) & 0xffu) | (((unsigned)__float2int_rn(v.y * sc) & 0xffu) << 8) |
                (((unsigned)__float2int_rn(v.z * sc) & 0xffu) << 16) | (((unsigned)__float2int_rn(v.w * sc) & 0xffu) << 24);
      } else {
        int p = 0;
        p = __builtin_amdgcn_cvt_pk_fp8_f32(v.x * sc, v.y * sc, p, false);
        p = __builtin_amdgcn_cvt_pk_fp8_f32(v.z * sc, v.w * sc, p, true);
        ow[c] = (unsigned)p;
      }
    }
    o.x = ow[0]; o.y = ow[1]; o.z = ow[2]; o.w = ow[3];
    *(uint4*)(dst8 + (size_t)(row0 + rr) * 256 + lane * 4) = o;
    if (lane == 0) dscale[row0 + rr] = (m > 0.f) ? m / top : 1.f;
  }
}

__device__ __forceinline__ float erf_fast(float x) {
  const float ax = fabsf(x);
  const float t = __builtin_amdgcn_rcpf(1.f + 0.3275911f * ax);
  float p = 1.061405429f;
  p = p * t - 1.453152027f;
  p = p * t + 1.421413741f;
  p = p * t - 0.284496736f;
  p = p * t + 0.254829592f;
  const float e = __builtin_amdgcn_exp2f(-1.4426950408889634f * ax * ax);
  const float r = 1.f - p * t * e;
  return copysignf(r, x);
}
__device__ __forceinline__ float dot16_f8(const uint4 u, const float* hv) {
  const f32x2 a0 = __builtin_amdgcn_cvt_pk_f32_fp8((int)u.x, false), a1 = __builtin_amdgcn_cvt_pk_f32_fp8((int)u.x, true);
  const f32x2 b0 = __builtin_amdgcn_cvt_pk_f32_fp8((int)u.y, false), b1 = __builtin_amdgcn_cvt_pk_f32_fp8((int)u.y, true);
  const f32x2 c0 = __builtin_amdgcn_cvt_pk_f32_fp8((int)u.z, false), c1 = __builtin_amdgcn_cvt_pk_f32_fp8((int)u.z, true);
  const f32x2 d0 = __builtin_amdgcn_cvt_pk_f32_fp8((int)u.w, false), d1 = __builtin_amdgcn_cvt_pk_f32_fp8((int)u.w, true);
  float s0 = a0[0] * hv[0] + a0[1] * hv[1];
  float s1 = a1[0] * hv[2] + a1[1] * hv[3];
  s0 += b0[0] * hv[4] + b0[1] * hv[5];
  s1 += b1[0] * hv[6] + b1[1] * hv[7];
  s0 += c0[0] * hv[8] + c0[1] * hv[9];
  s1 += c1[0] * hv[10] + c1[1] * hv[11];
  s0 += d0[0] * hv[12] + d0[1] * hv[13];
  s1 += d1[0] * hv[14] + d1[1] * hv[15];
  return s0 + s1;
}
__device__ __forceinline__ void axpy16_f8(const uint4 v, const float wg, float* acc) {
  const f32x2 a0 = __builtin_amdgcn_cvt_pk_f32_fp8((int)v.x, false), a1 = __builtin_amdgcn_cvt_pk_f32_fp8((int)v.x, true);
  const f32x2 b0 = __builtin_amdgcn_cvt_pk_f32_fp8((int)v.y, false), b1 = __builtin_amdgcn_cvt_pk_f32_fp8((int)v.y, true);
  const f32x2 c0 = __builtin_amdgcn_cvt_pk_f32_fp8((int)v.z, false), c1 = __builtin_amdgcn_cvt_pk_f32_fp8((int)v.z, true);
  const f32x2 d0 = __builtin_amdgcn_cvt_pk_f32_fp8((int)v.w, false), d1 = __builtin_amdgcn_cvt_pk_f32_fp8((int)v.w, true);
  acc[0] += wg * a0[0]; acc[1] += wg * a0[1]; acc[2] += wg * a1[0]; acc[3] += wg * a1[1];
  acc[4] += wg * b0[0]; acc[5] += wg * b0[1]; acc[6] += wg * b1[0]; acc[7] += wg * b1[1];
  acc[8] += wg * c0[0]; acc[9] += wg * c0[1]; acc[10] += wg * c1[0]; acc[11] += wg * c1[1];
  acc[12] += wg * d0[0]; acc[13] += wg * d0[1]; acc[14] += wg * d1[0]; acc[15] += wg * d1[1];
}
typedef int i32x4 __attribute__((ext_vector_type(4)));
__device__ __forceinline__ void d_peer(int item, char* smem, const float* __restrict__ x1, const float* __restrict__ rs2,
                                       const float* __restrict__ g2, const int* __restrict__ idx,
                                       const float* __restrict__ gate, const unsigned* __restrict__ pu,
                                       const unsigned* __restrict__ pv, const float* __restrict__ su,
                                       const float* __restrict__ sv, const float* __restrict__ gf,
                                       float* __restrict__ out, float oscale) {
  int tid_ = TIDX;
  asm volatile("" : "+v"(tid_));
  const int wv = tid_ >> 6;
  const int t = item * 4 + wv;
  const int lane = tid_ & 63, q = lane >> 4;
  char* hq = smem + wv * 1024;
  float r2;
  {
    const float4* pr = (const float4*)(rs2 + (size_t)t * 16);
    const float4 s0 = pr[0], s1 = pr[1], s2 = pr[2], s3 = pr[3];
    const float ssq = ((s0.x + s0.y) + (s0.z + s0.w)) + ((s1.x + s1.y) + (s1.z + s1.w)) + ((s2.x + s2.y) + (s2.z + s2.w)) + ((s3.x + s3.y) + (s3.z + s3.w));
    r2 = rsqrtf(ssq * (1.f / DM) + EPSF);
  }
  float sh;
  {
    float hv[16];
    float m = 0.f;
#pragma unroll
    for (int c = 0; c < 4; ++c) {
      const float4 xx = *(const float4*)(x1 + (size_t)t * DM + lane * 16 + c * 4);
      const float4 gg = *(const float4*)(g2 + lane * 16 + c * 4);
      hv[c * 4 + 0] = xx.x * r2 * gg.x; hv[c * 4 + 1] = xx.y * r2 * gg.y;
      hv[c * 4 + 2] = xx.z * r2 * gg.z; hv[c * 4 + 3] = xx.w * r2 * gg.w;
      m = fmaxf(m, fmaxf(fmaxf(fabsf(hv[c * 4]), fabsf(hv[c * 4 + 1])), fmaxf(fabsf(hv[c * 4 + 2]), fabsf(hv[c * 4 + 3]))));
    }
#pragma unroll
    for (int o = 32; o > 0; o >>= 1) m = fmaxf(m, __shfl_xor(m, o, 64));
    const float sc = (m > 0.f) ? 127.f / m : 1.f;
    sh = (m > 0.f) ? m * (1.f / 127.f) : 1.f;
#define Q8(x) ((unsigned)(__float2int_rn((x) * sc)) & 0xffu)
    uint4 o;
    o.x = Q8(hv[0]) | (Q8(hv[1]) << 8) | (Q8(hv[2]) << 16) | (Q8(hv[3]) << 24);
    o.y = Q8(hv[4]) | (Q8(hv[5]) << 8) | (Q8(hv[6]) << 16) | (Q8(hv[7]) << 24);
    o.z = Q8(hv[8]) | (Q8(hv[9]) << 8) | (Q8(hv[10]) << 16) | (Q8(hv[11]) << 24);
    o.w = Q8(hv[12]) | (Q8(hv[13]) << 8) | (Q8(hv[14]) << 16) | (Q8(hv[15]) << 24);
#undef Q8
    *(uint4*)(hq + lane * 16) = o;
  }
  float acc[16];
#pragma unroll
  for (int i = 0; i < 16; ++i) acc[i] = 0.f;
  float* wl = (float*)(smem + 4096) + wv * 128;
  int ka = (idx[(size_t)t * 128 + lane] << 7) | lane;
  int kb = (idx[(size_t)t * 128 + 64 + lane] << 7) | (64 + lane);
  const float gt_a0 = gate[(size_t)t * 128 + lane], gt_b0 = gate[(size_t)t * 128 + 64 + lane];
#pragma unroll
  for (int k = 2; k <= 128; k <<= 1) {
#pragma unroll
    for (int j = k >> 1; j > 0; j >>= 1) {
      if (j == 64) {
        const int lo = min(ka, kb), hi = max(ka, kb);
        ka = lo; kb = hi;
      } else {
        const int oa = __shfl_xor(ka, j, 64), ob = __shfl_xor(kb, j, 64);
        const bool lower = (lane & j) == 0;
        const bool upa = (lane & k) == 0;
        const bool upb = ((lane + 64) & k) == 0;
        ka = (upa == lower) ? min(ka, oa) : max(ka, oa);
        kb = (upb == lower) ? min(kb, ob) : max(kb, ob);
      }
    }
  }
  const int id_a = ka >> 7, id_b = kb >> 7;
  const int oa_ = ka & 127, ob_ = kb & 127;
  const float ga1 = __shfl(gt_a0, oa_ & 63, 64), ga2 = __shfl(gt_b0, oa_ & 63, 64);
  const float gb1 = __shfl(gt_a0, ob_ & 63, 64), gb2 = __shfl(gt_b0, ob_ & 63, 64);
  const float gt_a = (oa_ < 64) ? ga1 : ga2, gt_b = (ob_ < 64) ? gb1 : gb2;
#define PEER_ULOAD(UA, G)                                                                                   \
  {                                                                                                         \
    const int srcl_ = (16 * (G) + (lane & 15)) & 63;                                                        \
    const int idr_ = ((G) < 4) ? __shfl(id_a, srcl_, 64) : __shfl(id_b, srcl_, 64);                         \
    const char* ub_ = (const char*)pu + (size_t)idr_ * 1024 + 16 * q;                                       \
    _Pragma("unroll") for (int s2 = 0; s2 < 16; ++s2) UA[s2] = *(const i32x4*)(ub_ + 64 * s2);              \
  }
#define PEER_UCOMP(UA, G)                                                                                   \
  {                                                                                                         \
    int ide[4]; float gte[4], sue[4], sve[4];                                                               \
    _Pragma("unroll") for (int reg = 0; reg < 4; ++reg) {                                                   \
      const int el = (16 * (G) + 4 * q + reg) & 63;                                                         \
      ide[reg] = ((G) < 4) ? __shfl(id_a, el, 64) : __shfl(id_b, el, 64);                                   \
      gte[reg] = ((G) < 4) ? __shfl(gt_a, el, 64) : __shfl(gt_b, el, 64);                                   \
      sue[reg] = su[ide[reg]];                                                                              \
      sve[reg] = sv[ide[reg]];                                                                              \
    }                                                                                                       \
    i32x4 d4 = {0, 0, 0, 0};                                                                                \
    _Pragma("unroll") for (int s2 = 0; s2 < 16; ++s2) {                                                     \
      const i32x4 bfr = *(const i32x4*)(hq + 64 * s2 + 16 * q);                                             \
      d4 = __builtin_amdgcn_mfma_i32_16x16x64_i8(UA[s2], bfr, d4, 0, 0, 0);                                 \
    }                                                                                                       \
    float4 w4;                                                                                              \
    const float d0 = (float)d4[0] * (sue[0] * sh), d1 = (float)d4[1] * (sue[1] * sh);                       \
    const float d2 = (float)d4[2] * (sue[2] * sh), d3 = (float)d4[3] * (sue[3] * sh);                       \
    w4.x = gte[0] * sve[0] * 0.5f * d0 * (1.f + erf_fast(d0 * 0.7071067811865476f));                        \
    w4.y = gte[1] * sve[1] * 0.5f * d1 * (1.f + erf_fast(d1 * 0.7071067811865476f));                        \
    w4.z = gte[2] * sve[2] * 0.5f * d2 * (1.f + erf_fast(d2 * 0.7071067811865476f));                        \
    w4.w = gte[3] * sve[3] * 0.5f * d3 * (1.f + erf_fast(d3 * 0.7071067811865476f));                        \
    if ((lane & 15) == 0) *(float4*)(wl + 16 * (G) + 4 * q) = w4;                                           \
  }
  {
    i32x4 uA[16], uB[16];
    PEER_ULOAD(uA, 0);
    for (int g = 0; g < 8; g += 2) {
      PEER_ULOAD(uB, g + 1);
      PEER_UCOMP(uA, g);
      if (g + 2 < 8) PEER_ULOAD(uA, g + 2);
      PEER_UCOMP(uB, g + 1);
    }
  }
#undef PEER_ULOAD
#undef PEER_UCOMP
  for (int e0 = 0; e0 < 128; e0 += 16) {
    uint4 v[16];
#pragma unroll
    for (int k = 0; k < 16; ++k) {
      const int e = (e0 + k) & 63;
      const int id = (e0 < 64) ? __builtin_amdgcn_readlane(id_a, e) : __builtin_amdgcn_readlane(id_b, e);
      v[k] = *(const uint4*)(pv + (size_t)id * 256 + lane * 4);
    }
    const float4 w0 = *(const float4*)(wl + e0), w1 = *(const float4*)(wl + e0 + 4);
    const float4 w2 = *(const float4*)(wl + e0 + 8), w3 = *(const float4*)(wl + e0 + 12);
    axpy16_f8(v[0], w0.x, acc); axpy16_f8(v[1], w0.y, acc); axpy16_f8(v[2], w0.z, acc); axpy16_f8(v[3], w0.w, acc);
    axpy16_f8(v[4], w1.x, acc); axpy16_f8(v[5], w1.y, acc); axpy16_f8(v[6], w1.z, acc); axpy16_f8(v[7], w1.w, acc);
    axpy16_f8(v[8], w2.x, acc); axpy16_f8(v[9], w2.y, acc); axpy16_f8(v[10], w2.z, acc); axpy16_f8(v[11], w2.w, acc);
    axpy16_f8(v[12], w3.x, acc); axpy16_f8(v[13], w3.y, acc); axpy16_f8(v[14], w3.z, acc); axpy16_f8(v[15], w3.w, acc);
  }
  float ss = 0.f;
#pragma unroll
  for (int c = 0; c < 4; ++c) {
    const float4 xx = *(const float4*)(x1 + (size_t)t * DM + lane * 16 + c * 4);
    acc[c * 4 + 0] += xx.x; acc[c * 4 + 1] += xx.y; acc[c * 4 + 2] += xx.z; acc[c * 4 + 3] += xx.w;
  }
#pragma unroll
  for (int i = 0; i < 16; ++i) ss += acc[i] * acc[i];
  ss = wave_sum(ss);
  const float sc = rsqrtf(ss * (1.f / DM) + EPSF) * oscale;
#pragma unroll
  for (int q4 = 0; q4 < 4; ++q4) {
    const float4 gg = *(const float4*)(gf + lane * 16 + q4 * 4);
    float4 o;
    o.x = acc[q4 * 4 + 0] * sc * gg.x; o.y = acc[q4 * 4 + 1] * sc * gg.y;
    o.z = acc[q4 * 4 + 2] * sc * gg.z; o.w = acc[q4 * 4 + 3] * sc * gg.w;
    *(float4*)(out + (size_t)t * DM + lane * 16 + q4 * 4) = o;
  }
}

typedef __attribute__((ext_vector_type(16))) float f32x16;
#define MFMA32(a, b, c) __builtin_amdgcn_mfma_f32_32x32x16_bf16((a), (b), (c), 0, 0, 0)
__device__ __forceinline__ int crow(int reg, int hh) { return (reg & 3) + 8 * (reg >> 2) + 4 * hh; }

struct GdnBufs {
  unsigned short* qc;
  unsigned short* kTc;
  unsigned short* qkc;
  unsigned short* wn;
  unsigned short* uo;
  float* gsc;
};

__device__ __forceinline__ void tri_subst(const float* AL0, int lane, float (&T)[64]) {
  const float* AL = (const float*)__builtin_assume_aligned(AL0, 16);
#pragma unroll
  for (int i = 0; i < 64; ++i) T[i] = 0.f;
  T[0] = (lane == 0) ? 1.f : 0.f;
  float4 cur[16], nxt[16];
#pragma unroll
  for (int j4 = 0; j4 < 1; ++j4) cur[j4] = *(const float4*)(AL + 1 * 72 + 4 * j4);
#pragma unroll
  for (int i = 1; i < 64; ++i) {
    if (i + 1 < 64) {
#pragma unroll
      for (int j4 = 0; j4 < (i + 4) / 4; ++j4) nxt[j4] = *(const float4*)(AL + (i + 1) * 72 + 4 * j4);
    }
    float ax = 0.f, ay = 0.f, az = 0.f, aw = 0.f;
#pragma unroll
    for (int j4 = 0; j4 < (i + 3) / 4; ++j4) {
      ax += cur[j4].x * T[4 * j4]; ay += cur[j4].y * T[4 * j4 + 1]; az += cur[j4].z * T[4 * j4 + 2]; aw += cur[j4].w * T[4 * j4 + 3];
    }
    T[i] = ((lane == i) ? 1.f : 0.f) - ((ax + ay) + (az + aw));
#pragma unroll
    for (int j4 = 0; j4 < 16; ++j4) cur[j4] = nxt[j4];
  }
}

__device__ __forceinline__ void d_gdn_prep(int item, char* smem, const unsigned short* __restrict__ pm,
                                           const float* __restrict__ gt, const float* __restrict__ conv_w, GdnBufs G) {
  unsigned short* qL = (unsigned short*)smem;
  unsigned short* kL = qL + 64 * 144;
  unsigned short* kTL = kL + 64 * 144;
  unsigned short* vTL = kTL + 128 * 72;
  float* scal = (float*)(vTL + 128 * 72);
  float* A0 = (float*)qL;
  float* A1 = (float*)kL;
  int tid = TIDX;
  asm volatile("" : "+v"(tid));
  const int lane = tid & 63, w = __builtin_amdgcn_readfirstlane(tid >> 6), r = lane & 31, hh = lane >> 5;
  const int bh = item >> 6, c = item & 63, b = bh >> 2, h = bh & 3;
  const int t0 = b * SEQ + c * 64;
  __syncthreads();
  {
#pragma unroll
    for (int sec = 0; sec < 3; ++sec) {
      const int c0 = sec * 512 + h * 128 + 2 * lane;
      float cw0[5], cw1[5];
#pragma unroll
      for (int j = 0; j < 5; ++j) { cw0[j] = conv_w[c0 * 5 + j]; cw1[j] = conv_w[(c0 + 1) * 5 + j]; }
      unsigned raw[20];
#pragma unroll
      for (int k = 0; k < 20; ++k) {
        const int sp = c * 64 + w * 16 + k - 2;
        raw[k] = (sp >= 0 && sp < SEQ) ? *(const unsigned*)(pm + ((size_t)t0 + w * 16 + k - 2) * 4096 + c0) : 0u;
      }
#pragma unroll
      for (int ii = 0; ii < 16; ++ii) {
        const int i = w * 16 + ii;
        float a0 = 0.f, a1 = 0.f;
#pragma unroll
        for (int j = 0; j < 5; ++j) {
          a0 += cw0[j] * bf2f((unsigned short)(raw[ii + j] & 0xffff));
          a1 += cw1[j] * __uint_as_float(raw[ii + j] & 0xffff0000u);
        }
        a0 = a0 * __builtin_amdgcn_rcpf(1.f + __builtin_amdgcn_exp2f(-1.4426950408889634f * a0));
        a1 = a1 * __builtin_amdgcn_rcpf(1.f + __builtin_amdgcn_exp2f(-1.4426950408889634f * a1));
        if (sec < 2) {
          const float ss = wave_sum_dpp(a0 * a0 + a1 * a1);
          float sc = rsqrtf(ss + EPSF);
          if (sec == 0) sc *= 0.08838834764831845f;
          a0 *= sc; a1 *= sc;
        }
        if (sec == 0) {
          *(unsigned*)(qL + i * 144 + 2 * lane) = pack2(a0, a1);
        } else if (sec == 1) {
          const unsigned pk = pack2(a0, a1);
          *(unsigned*)(kL + i * 144 + 2 * lane) = pk;
          kTL[(2 * lane) * 72 + i] = (unsigned short)(pk & 0xffff);
          kTL[(2 * lane + 1) * 72 + i] = (unsigned short)(pk >> 16);
        } else {
          const unsigned pk = pack2(a0, a1);
          vTL[(2 * lane) * 72 + i] = (unsigned short)(pk & 0xffff);
          vTL[(2 * lane + 1) * 72 + i] = (unsigned short)(pk >> 16);
        }
      }
    }
  }
  if (w == 0) {
    const float* gp = gt + ((size_t)t0 + lane) * 32;
    const float g0 = gp[h], g1 = gp[4 + h], b0 = gp[8 + h], b1 = gp[12 + h];
    float G0 = g0, G1 = g1;
#pragma unroll
    for (int o = 1; o < 64; o <<= 1) {
      const float v0 = __shfl_up(G0, o, 64);
      const float v1 = __shfl_down(G1, o, 64);
      if (lane >= o) G0 += v0;
      if (lane + o < 64) G1 += v1;
    }
    scal[lane] = G0 * 1.4426950408889634f; scal[64 + lane] = G1 * 1.4426950408889634f;
    scal[128 + lane] = b0; scal[192 + lane] = b1;
    const float GL0 = __shfl(G0, 63, 64), GL1 = __shfl(G1, 0, 64);
    float* gs0 = G.gsc + ((size_t)((bh * 2 + 0) * 64 + c)) * 192;
    float* gs1 = G.gsc + ((size_t)((bh * 2 + 1) * 64 + c)) * 192;
    gs0[lane] = expf(G0); gs0[64 + lane] = expf(GL0 - G0);
    gs1[lane] = expf(G1); gs1[64 + lane] = expf(GL1 - G1);
    if (lane == 0) { gs0[128] = expf(GL0); gs1[128] = expf(GL1); }
  }
  __syncthreads();
  {
    unsigned short* qg = G.qc + (size_t)item * 8192;
    unsigned short* kg = G.kTc + (size_t)item * 8192;
#pragma unroll
    for (int i = 0; i < 4; ++i) {
      const int id = tid + i * 256;
      {
        const int row = id >> 4, c16 = id & 15;
        *(uint4*)(qg + (row >> 5) * 4096 + ((c16 >> 1) * 64 + (c16 & 1) * 32 + (row & 31)) * 8) = *(const uint4*)(qL + row * 144 + c16 * 8);
      }
      {
        const int row = id >> 3, c8 = id & 7;
        *(uint4*)(kg + (row >> 5) * 2048 + ((c8 >> 1) * 64 + (c8 & 1) * 32 + (row & 31)) * 8) = *(const uint4*)(kTL + row * 72 + c8 * 8);
      }
    }
  }
  {
    const int ta = w >> 1, tb = w & 1;
    f32x16 acc, acc2;
#pragma unroll
    for (int i = 0; i < 16; ++i) { acc[i] = 0.f; acc2[i] = 0.f; }
#pragma unroll
    for (int s = 0; s < 8; ++s) {
      const bf16x8 a = *(const bf16x8*)(kL + (32 * ta + r) * 144 + 16 * s + 8 * hh);
      const bf16x8 bk = *(const bf16x8*)(kL + (32 * tb + r) * 144 + 16 * s + 8 * hh);
      const bf16x8 bq = *(const bf16x8*)(qL + (32 * tb + r) * 144 + 16 * s + 8 * hh);
      acc = MFMA32(a, bk, acc);
      acc2 = MFMA32(a, bq, acc2);
    }
    __syncthreads();
    {
      const int col = 32 * tb + r;
      const float G0c = scal[col], G1c = scal[64 + col];
#pragma unroll
      for (int reg = 0; reg < 16; ++reg) {
        const int row = 32 * ta + crow(reg, hh);
        const float v = acc[reg];
        const float a0 = (col < row) ? scal[128 + row] * v * __builtin_amdgcn_exp2f(scal[row] - G0c) : 0.f;
        const float a1 = (col > row) ? scal[192 + row] * v * __builtin_amdgcn_exp2f(scal[64 + row] - G1c) : 0.f;
        A0[row * 72 + col] = a0;
        A1[(63 - row) * 72 + (63 - col)] = a1;
      }
    }
    {
      const int i = 32 * tb + r;
      const float G0i = scal[i], G1i = scal[64 + i];
      unsigned short* qk0 = G.qkc + ((size_t)((bh * 2 + 0) * 64 + c)) * 4096;
      unsigned short* qk1 = G.qkc + ((size_t)((bh * 2 + 1) * 64 + c)) * 4096;
#pragma unroll
      for (int g = 0; g < 4; ++g) {
        float o0[4], o1[4];
#pragma unroll
        for (int e = 0; e < 4; ++e) {
          const int j = 32 * ta + 8 * g + 4 * hh + e;
          const float v = acc2[4 * g + e];
          o0[e] = (j <= i) ? v * __builtin_amdgcn_exp2f(G0i - scal[j]) : 0.f;
          o1[e] = (j >= i) ? v * __builtin_amdgcn_exp2f(G1i - scal[64 + j]) : 0.f;
        }
        uint2 p0, p1;
        p0.x = pack2(o0[0], o0[1]); p0.y = pack2(o0[2], o0[3]);
        p1.x = pack2(o1[0], o1[1]); p1.y = pack2(o1[2], o1[3]);
        const int qoff = tb * 2048 + ((2 * ta + (g >> 1)) * 64 + (g & 1) * 32 + r) * 8 + 4 * hh;
        *(uint2*)(qk0 + qoff) = p0;
        *(uint2*)(qk1 + qoff) = p1;
      }
    }
  }
  __syncthreads();
  if (w < 2) {
    const int dir = w;
    float T[64];
    tri_subst(A0 + dir * (64 * 72), lane, T);
    const int jn = dir ? 63 - lane : lane;
    const float sb = scal[128 + 64 * dir + jn];
    const float sbg = sb * __builtin_amdgcn_exp2f(scal[64 * dir + jn]);
    unsigned short* Tb = dir ? kL : qL;
    unsigned short* Tbg = Tb + 64 * 72;
#pragma unroll
    for (int ip = 0; ip < 64; ++ip) {
      const int in = dir ? 63 - ip : ip;
      Tb[in * 72 + jn] = f2bf(T[ip] * sb);
      Tbg[in * 72 + jn] = f2bf(T[ip] * sbg);
    }
  }
  __syncthreads();
#pragma unroll
  for (int d = 0; d < 2; ++d) {
    const int chain = bh * 2 + d;
    const unsigned short* Tb = d ? kL : qL;
    const unsigned short* Tbg = Tb + 64 * 72;
    unsigned short* wng = G.wn + ((size_t)(chain * 64 + c)) * 8192;
    unsigned short* uog = G.uo + ((size_t)(chain * 64 + c)) * 8192 + w * 2048;
#pragma unroll
    for (int tb = 0; tb < 2; ++tb) {
      f32x16 acc, acc2;
#pragma unroll
      for (int i = 0; i < 16; ++i) { acc[i] = 0.f; acc2[i] = 0.f; }
#pragma unroll
      for (int s = 0; s < 4; ++s) {
        const bf16x8 a = *(const bf16x8*)(kTL + (32 * w + r) * 72 + 16 * s + 8 * hh);
        const bf16x8 bb = *(const bf16x8*)(Tbg + (32 * tb + r) * 72 + 16 * s + 8 * hh);
        acc = MFMA32(a, bb, acc);
        const bf16x8 a2 = *(const bf16x8*)(Tb + (32 * tb + r) * 72 + 16 * s + 8 * hh);
        const bf16x8 b2 = *(const bf16x8*)(vTL + (32 * w + r) * 72 + 16 * s + 8 * hh);
        acc2 = MFMA32(a2, b2, acc2);
      }
#pragma unroll
      for (int g = 0; g < 4; ++g) {
        uint2 pk;
        pk.x = pack2(-acc[4 * g], -acc[4 * g + 1]); pk.y = pack2(-acc[4 * g + 2], -acc[4 * g + 3]);
        *(uint2*)(wng + tb * 4096 + ((2 * w + (g >> 1)) * 64 + (g & 1) * 32 + r) * 8 + 4 * hh) = pk;
      }
      uint4 u0, u1;
      u0.x = pack2(acc2[0], acc2[1]); u0.y = pack2(acc2[2], acc2[3]); u0.z = pack2(acc2[4], acc2[5]); u0.w = pack2(acc2[6], acc2[7]);
      u1.x = pack2(acc2[8], acc2[9]); u1.y = pack2(acc2[10], acc2[11]); u1.z = pack2(acc2[12], acc2[13]); u1.w = pack2(acc2[14], acc2[15]);
      *(uint4*)(uog + tb * 1024 + lane * 16) = u0;
      *(uint4*)(uog + tb * 1024 + lane * 16 + 8) = u1;
    }
  }
}

struct GdnOps {
  bf16x8 a[8];
  bf16x8 x[4];
  bf16x8 kt[4];
  float4 rs[4];
  float gtot;
};
__device__ __forceinline__ void gdn_load(GdnOps& o, const GdnBufs& G, int chain, int bh, int c, int sl, int w, int r, int hh, int lane) {
  const unsigned short* kT_c = G.kTc + ((size_t)(bh * 64 + c)) * 8192;
  const float* gs = G.gsc + ((size_t)(chain * 64 + c)) * 192;
  const int ti = w & 1;
#pragma unroll
  for (int s = 0; s < 4; ++s) o.kt[s] = *(const bf16x8*)(kT_c + w * 2048 + (s * 64 + lane) * 8);
  o.gtot = gs[128];
  if (w < 2) {
    const unsigned short* wn_c = G.wn + ((size_t)(chain * 64 + c)) * 8192;
    const unsigned short* uo_c = G.uo + ((size_t)(chain * 64 + c)) * 8192 + sl * 2048;
#pragma unroll
    for (int s = 0; s < 8; ++s) o.a[s] = *(const bf16x8*)(wn_c + ti * 4096 + (s * 64 + lane) * 8);
    o.x[0] = *(const bf16x8*)(uo_c + ti * 1024 + lane * 16);
    o.x[1] = *(const bf16x8*)(uo_c + ti * 1024 + lane * 16 + 8);
#pragma unroll
    for (int g = 0; g < 4; ++g) o.rs[g] = *(const float4*)(gs + 64 + 32 * ti + 8 * g + 4 * hh);
  } else {
    const unsigned short* q_c = G.qc + ((size_t)(bh * 64 + c)) * 8192;
    const unsigned short* qk_c = G.qkc + ((size_t)(chain * 64 + c)) * 4096;
#pragma unroll
    for (int s = 0; s < 8; ++s) o.a[s] = *(const bf16x8*)(q_c + ti * 4096 + (s * 64 + lane) * 8);
#pragma unroll
    for (int s = 0; s < 4; ++s) o.x[s] = *(const bf16x8*)(qk_c + ti * 2048 + (s * 64 + lane) * 8);
#pragma unroll
    for (int g = 0; g < 4; ++g) o.rs[g] = *(const float4*)(gs + 32 * ti + 8 * g + 4 * hh);
  }
}
__device__ __forceinline__ void gdn_step(const GdnOps& o, f32x16& S, unsigned short* ST, unsigned short* VT, unsigned short* VdT,
                                         unsigned short* uo_c, int w, int r, int hh) {
  const int ti = w & 1;
  f32x16 acc;
  if (w < 2) {
#pragma unroll
    for (int i = 0; i < 8; ++i) {
      acc[i] = bf2f((unsigned short)o.x[0][i]);
      acc[8 + i] = bf2f((unsigned short)o.x[1][i]);
    }
  } else {
#pragma unroll
    for (int i = 0; i < 16; ++i) acc[i] = 0.f;
  }
#pragma unroll
  for (int g = 0; g < 4; ++g) {
    uint2 pk;
    pk.x = pack2(S[4 * g], S[4 * g + 1]); pk.y = pack2(S[4 * g + 2], S[4 * g + 3]);
    *(uint2*)(ST + r * 136 + 32 * w + 8 * g + 4 * hh) = pk;
  }
  __syncthreads();
#pragma unroll
  for (int s = 0; s < 8; ++s) {
    const bf16x8 bs = *(const bf16x8*)(ST + r * 136 + 16 * s + 8 * hh);
    acc = MFMA32(o.a[s], bs, acc);
  }
  if (w < 2) {
#pragma unroll
    for (int g = 0; g < 4; ++g) {
      uint2 pk, pd;
      pk.x = pack2(acc[4 * g], acc[4 * g + 1]); pk.y = pack2(acc[4 * g + 2], acc[4 * g + 3]);
      pd.x = pack2(acc[4 * g] * o.rs[g].x, acc[4 * g + 1] * o.rs[g].y);
      pd.y = pack2(acc[4 * g + 2] * o.rs[g].z, acc[4 * g + 3] * o.rs[g].w);
      *(uint2*)(VT + r * 72 + 32 * ti + 8 * g + 4 * hh) = pk;
      *(uint2*)(VdT + r * 72 + 32 * ti + 8 * g + 4 * hh) = pd;
    }
  } else {
#pragma unroll
    for (int g = 0; g < 4; ++g) {
      acc[4 * g] *= o.rs[g].x; acc[4 * g + 1] *= o.rs[g].y; acc[4 * g + 2] *= o.rs[g].z; acc[4 * g + 3] *= o.rs[g].w;
    }
  }
  __syncthreads();
  if (w >= 2) {
#pragma unroll
    for (int s = 0; s < 4; ++s) {
      const bf16x8 bv = *(const bf16x8*)(VT + r * 72 + 16 * s + 8 * hh);
      acc = MFMA32(o.x[s], bv, acc);
    }
#pragma unroll
    for (int reg = 0; reg < 16; ++reg) uo_c[(32 * ti + crow(reg, hh)) * 32 + r] = f2bf(acc[reg]);
  }
#pragma unroll
  for (int i = 0; i < 16; ++i) S[i] *= o.gtot;
#pragma unroll
  for (int s = 0; s < 4; ++s) {
    const bf16x8 bv = *(const bf16x8*)(VdT + r * 72 + 16 * s + 8 * hh);
    S = MFMA32(o.kt[s], bv, S);
  }
}
__device__ __forceinline__ void d_gdn_scan(int chain, int sl, char* smem, GdnBufs G) {
  unsigned short* ST = (unsigned short*)smem;
  unsigned short* VT = ST + 32 * 136;
  unsigned short* VdT = VT + 32 * 72;
  const int tid = TIDX, lane = tid & 63, w = __builtin_amdgcn_readfirstlane(tid >> 6), r = lane & 31, hh = lane >> 5;
  const int bh = chain >> 1, dir = chain & 1;
  f32x16 S;
#pragma unroll
  for (int i = 0; i < 16; ++i) S[i] = 0.f;
  GdnOps A, B;
  gdn_load(A, G, chain, bh, dir ? 63 : 0, sl, w, r, hh, lane);
  for (int step = 0; step < 64; step += 2) {
    const int c0 = dir ? 63 - step : step;
    const int c1 = dir ? c0 - 1 : c0 + 1;
    const int c2 = dir ? c0 - 2 : c0 + 2;
    gdn_load(B, G, chain, bh, c1, sl, w, r, hh, lane);
    gdn_step(A, S, ST, VT, VdT, G.uo + ((size_t)(chain * 64 + c0)) * 8192 + sl * 2048, w, r, hh);
    if (step + 2 < 64) gdn_load(A, G, chain, bh, c2, sl, w, r, hh, lane);
    gdn_step(B, S, ST, VT, VdT, G.uo + ((size_t)(chain * 64 + c1)) * 8192 + sl * 2048, w, r, hh);
  }
}

__device__ __forceinline__ void d_ml_gates(int item, const float* __restrict__ gt, float* __restrict__ pre, float* __restrict__ gtots) {
  const int wv = item * 4 + (TIDX >> 6);
  const int lane = TIDX & 63;
  const int chain = wv >> 6, c = wv & 63;
  const int bh = chain >> 1, dir = chain & 1, b = bh >> 2, h = bh & 3;
  const size_t t0 = (size_t)b * SEQ + c * 64;
  const float lf = gt[(t0 + lane) * 32 + 24 + dir * 4 + h];
  const float ip = gt[(t0 + lane) * 32 + 16 + dir * 4 + h];
  float bc = lf;
#pragma unroll
  for (int ofs = 1; ofs < 64; ofs <<= 1) {
    const float vu = __shfl_up(bc, ofs, 64);
    const float vd = __shfl_down(bc, ofs, 64);
    if (dir == 0) { if (lane >= ofs) bc += vu; } else { if (lane + ofs < 64) bc += vd; }
  }
  const float b_last = __shfl(bc, dir ? 0 : 63, 64);
  float4 o;
  o.x = expf(bc);
  o.y = (ip - bc) * 1.4426950408889634f - 3.5f;
  o.z = bc * 1.4426950408889634f;
  o.w = 0.08838834764831845f * expf(b_last - bc + ip);
  *(float4*)(pre + ((size_t)chain * SEQ + c * 64 + lane) * 4) = o;
  if (lane == 0) gtots[wv] = expf(b_last);
}

typedef short v4i16_t __attribute__((ext_vector_type(4)));
typedef __attribute__((address_space(3))) const char* lds_cptr;
__device__ __forceinline__ bf16x8 tr_pair(lds_cptr p0, lds_cptr p1) {
  const v4i16_t a = __builtin_amdgcn_ds_read_tr16_b64_v4i16((__attribute__((address_space(3))) v4i16_t*)p0);
  const v4i16_t b = __builtin_amdgcn_ds_read_tr16_b64_v4i16((__attribute__((address_space(3))) v4i16_t*)p1);
  return __builtin_shufflevector(a, b, 0, 1, 2, 3, 4, 5, 6, 7);
}
#define ML_KIMG 16384
#define ML_VIMG 4096
#define ML_LDK(R, I, T0) R = *(const uint4*)(pm + ((T0) + ((t128 + (I) * 128) >> 4)) * 4096 + 2560 + h * 128 + (t128 & 15) * 8);
#define ML_STK(R, I) *(uint4*)(kimg_ + (kwb ^ (((I) & 1) * 32)) + (I) * 2048) = R;
#define ML_LOAD(S, T0)                                                                                      \
  {                                                                                                         \
    ML_LDK(pk0##S, 0, T0) ML_LDK(pk1##S, 1, T0) ML_LDK(pk2##S, 2, T0) ML_LDK(pk3##S, 3, T0)                 \
    ML_LDK(pk4##S, 4, T0) ML_LDK(pk5##S, 5, T0) ML_LDK(pk6##S, 6, T0) ML_LDK(pk7##S, 7, T0)                 \
    pv0##S = *(const uint4*)(pm + ((T0) + (t128 >> 2)) * 4096 + 3072 + h * 128 + sl * 32 + (t128 & 3) * 8); \
    pv1##S = *(const uint4*)(pm + ((T0) + ((t128 + 128) >> 2)) * 4096 + 3072 + h * 128 + sl * 32 + (t128 & 3) * 8); \
    pgl##S = *(const float4*)(pre + ((size_t)chain * SEQ + ((T0) - tb) + lane) * 4);                        \
    pgt##S = gtots[chain * 64 + (int)(((T0) - tb) >> 6)];                                                   \
  }
#define ML_SCALE2(U, D) pack2(__uint_as_float((U) << 16) * (D), __uint_as_float((U) & 0xffff0000u) * (D))
#define ML_VROW(PV, TOKOFF)                                                                                 \
  {                                                                                                         \
    const float dj_ = __shfl(pgl_w_, (t128 >> 2) + (TOKOFF), 64);                                           \
    *(uint4*)(vimg_ + t128 * 16 + (TOKOFF) * 64) = PV;                                                      \
    uint4 sc_;                                                                                              \
    sc_.x = ML_SCALE2(PV.x, dj_); sc_.y = ML_SCALE2(PV.y, dj_); sc_.z = ML_SCALE2(PV.z, dj_); sc_.w = ML_SCALE2(PV.w, dj_); \
    *(uint4*)(vdimg_ + t128 * 16 + (TOKOFF) * 64) = sc_;                                                    \
  }
#define ML_STAGE(S, BUF)                                                                                    \
  {                                                                                                         \
    char* kimg_ = (char*)kL + (BUF) * ML_KIMG;                                                              \
    char* vimg_ = (char*)vL + (BUF) * ML_VIMG;                                                              \
    char* vdimg_ = (char*)vdL + (BUF) * ML_VIMG;                                                            \
    float* scb = scal + (BUF) * 208;                                                                        \
    if (w == 2) {                                                                                           \
      scb[lane] = pgl##S.x; scb[64 + lane] = pgl##S.y; scb[128 + lane] = pgl##S.z;                          \
      dL[(BUF) * 72 + lane] = f2bf(pgl##S.w);                                                               \
      if (lane == 0) scb[192] = pgt##S;                                                                     \
    }                                                                                                       \
    ML_STK(pk0##S, 0) ML_STK(pk1##S, 1) ML_STK(pk2##S, 2) ML_STK(pk3##S, 3)                                 \
    ML_STK(pk4##S, 4) ML_STK(pk5##S, 5) ML_STK(pk6##S, 6) ML_STK(pk7##S, 7)                                 \
    const float pgl_w_ = pgl##S.w;                                                                          \
    ML_VROW(pv0##S, 0)                                                                                      \
    ML_VROW(pv1##S, 32)                                                                                     \
  }
__device__ __forceinline__ void ml_state_image(const f32x16& S0, const f32x16& S1, unsigned short* S0T, unsigned short* nL, int w, int r, int hh) {
#pragma unroll
  for (int g = 0; g < 4; ++g) {
    uint2 pk;
    pk.x = pack2(S0[4 * g], S0[4 * g + 1]); pk.y = pack2(S0[4 * g + 2], S0[4 * g + 3]);
    *(uint2*)(S0T + r * 136 + 32 * w + 8 * g + 4 * hh) = pk;
    if (r == 0) {
      uint2 pn;
      pn.x = pack2(S1[4 * g], S1[4 * g + 1]); pn.y = pack2(S1[4 * g + 2], S1[4 * g + 3]);
      *(uint2*)(nL + 32 * w + 8 * g + 4 * hh) = pn;
    }
  }
}
__device__ __forceinline__ void ml_state_update(f32x16& S0, f32x16& S1, lds_cptr kt0, lds_cptr kt1, lds_cptr vdt,
                                                const unsigned short* dLb, float gtot, int hh) {
#pragma unroll
  for (int i = 0; i < 16; ++i) { S0[i] *= gtot; S1[i] *= gtot; }
#pragma unroll
  for (int s2 = 0; s2 < 4; ++s2) {
    const bf16x8 a = tr_pair(kt0 + 4096 * s2, kt1 + 4096 * s2);
    const bf16x8 bv = tr_pair(vdt + 1024 * s2, vdt + 1024 * s2 + 256);
    const bf16x8 bd = *(const bf16x8*)(dLb + 16 * s2 + 8 * hh);
    S0 = MFMA32(a, bv, S0);
    S1 = MFMA32(a, bd, S1);
  }
}
#define ML_QLOAD(QF, CH, TILE)                                                                                                  \
  {                                                                                                                             \
    const unsigned short* qp_ = pm + (tb + (size_t)(CH) * 64 + 32 * (TILE) + r) * 4096 + 2048 + h * 128 + 8 * hh;               \
    _Pragma("unroll") for (int s2 = 0; s2 < 8; ++s2) QF[s2] = *(const bf16x8*)(qp_ + 16 * s2);                                  \
  }
__device__ __forceinline__ void d_mlstm_scan(int chain, int sl, char* smem, const unsigned short* __restrict__ pm,
                                             const float* __restrict__ pre, const float* __restrict__ gtots,
                                             unsigned short* __restrict__ oM, int ntok, int hbk) {
  unsigned short* kL = (unsigned short*)smem;
  unsigned short* vL = kL + ML_KIMG;
  unsigned short* vdL = vL + ML_VIMG;
  unsigned short* dL = vdL + ML_VIMG;
  unsigned short* S0T = dL + 256;
  unsigned short* nL = S0T + 2 * 32 * 136;
  float* scal = (float*)(nL + 512);
  float* PP = scal + 416;
  int tid = TIDX;
  asm volatile("" : "+v"(tid));
  const int lane = tid & 63, w = __builtin_amdgcn_readfirstlane(tid >> 6), r = lane & 31, hh = lane >> 5;
  const int bh = chain >> 1, dir = chain & 1, b = bh >> 2, h = bh & 3;
  const int tih = dir ? 0 : 1, tjo = dir ? 1 : 0;
  const int cfirst = dir ? 63 : 0, cstep = dir ? -1 : 1;
  f32x16 S0, S1;
#pragma unroll
  for (int i = 0; i < 16; ++i) { S0[i] = 0.f; S1[i] = 0.f; }
  unsigned short* oMb = oM + (size_t)dir * ntok * 512 + h * 128 + sl * 32;
  const size_t tb = (size_t)b * SEQ;
  const int tq = (lane & 15) >> 2, tp = lane & 3, tblk = (lane >> 4) & 1;
  const lds_cptr lds0 = (lds_cptr)smem;
  const int ktr0 = 256 * (8 * hh + tq) + 16 * ((((w & 3) ^ tq) << 2) | ((2 * tblk + (tp >> 1)) ^ (2 * hh))) + 8 * (tp & 1);
  const int ktr1 = 256 * (8 * hh + 4 + tq) + 16 * ((((w & 3) ^ tq) << 2) | ((2 * tblk + (tp >> 1)) ^ (2 * hh + 1))) + 8 * (tp & 1);
  const int vdtr = 64 * (8 * hh + tq) + 32 * tblk + 8 * tp;
  __syncthreads();
  if (hbk == 1) {
    const int tiq = (w < 2) ? w : tih, tjk = (w < 2) ? w : tjo;
    bf16x8 ones;
#pragma unroll
    for (int i = 0; i < 8; ++i) ones[i] = (short)0x3F80;
    float dmask[16];
#pragma unroll
    for (int reg = 0; reg < 16; ++reg) {
      const int jl = crow(reg, hh);
      dmask[reg] = (w >= 2 || (dir ? (jl >= r) : (jl <= r))) ? 1.f : 0.f;
    }
    const int krow = 256 * (32 * tjk + r) + 16 * (hh ^ (((r & 3) << 2) | ((r >> 2) & 3)));
    const int vtr = 64 * (32 * tjk + 4 * hh + tq) + 32 * tblk + 8 * tp;
    bf16x8 qfa[8], qfb[8];
    ML_QLOAD(qfa, cfirst, tiq);
    ML_QLOAD(qfb, cfirst + cstep, tiq);
    if (w < 2) ml_state_image(S0, S1, S0T, nL, w, r, hh);
#define ML_TSTEP(QF, BUF)                                                                                                       \
    {                                                                                                                           \
      __syncthreads();                                                      \
      if (step < 64 && w < 3) {                                                                                                 \
        const int c0 = cfirst + cstep * step;                                                                                   \
        const lds_cptr kimg = lds0 + (BUF) * ML_KIMG;                                                                           \
        const lds_cptr vimg = lds0 + 2 * ML_KIMG + (BUF) * ML_VIMG;                                                             \
        const lds_cptr vdimg = lds0 + 2 * ML_KIMG + 2 * ML_VIMG + (BUF) * ML_VIMG;                                              \
        const float* scb = scal + (BUF) * 208;                                                                                  \
        if (w < 2) {                                                                                                            \
          const float gtot = scb[192];                                                                                          \
          ml_state_update(S0, S1, kimg + ktr0, kimg + ktr1, vdimg + vdtr, dL + (BUF) * 72, gtot, hh);                           \
          ml_state_image(S0, S1, S0T + ((BUF) ^ 1) * (32 * 136), nL + ((BUF) ^ 1) * 256, w, r, hh);                             \
        }                                                                                                                       \
        const float bci = scb[128 + 32 * tiq + r];                                                                              \
        f32x16 X;                                                                                                               \
        _Pragma("unroll") for (int i = 0; i < 16; ++i) X[i] = 0.f;                                                              \
        _Pragma("unroll") for (int s2 = 0; s2 < 8; ++s2) {                                                                      \
          const bf16x8 a = *(const __attribute__((address_space(3))) bf16x8*)(kimg + (krow ^ (32 * s2)));                       \
          X = MFMA32(a, QF[s2], X);                                                                                             \
        }                                                                                                                       \
        ML_QLOAD(QF, (step + 2 < 64) ? c0 + 2 * cstep : c0, tiq);                              \
        _Pragma("unroll") for (int g = 0; g < 4; ++g) {                                                                         \
          const float4 cj4 = *(const float4*)(scb + 64 + 32 * tjk + 8 * g + 4 * hh);                                            \
          X[4 * g + 0] *= __builtin_amdgcn_exp2f(fminf(bci + cj4.x, 80.f)) * dmask[4 * g + 0];                                  \
          X[4 * g + 1] *= __builtin_amdgcn_exp2f(fminf(bci + cj4.y, 80.f)) * dmask[4 * g + 1];                                  \
          X[4 * g + 2] *= __builtin_amdgcn_exp2f(fminf(bci + cj4.z, 80.f)) * dmask[4 * g + 2];                                  \
          X[4 * g + 3] *= __builtin_amdgcn_exp2f(fminf(bci + cj4.w, 80.f)) * dmask[4 * g + 3];                                  \
        }                                                                                                                       \
        f32x16 Z0, Z1;                                                                                                          \
        _Pragma("unroll") for (int i = 0; i < 16; ++i) { Z0[i] = 0.f; Z1[i] = 0.f; }                                            \
        _Pragma("unroll") for (int s2 = 0; s2 < 2; ++s2) {                                                                      \
          union { bf16x8 v; unsigned u[4]; } xa;                                                                                \
          xa.u[0] = pack2(X[8 * s2 + 0], X[8 * s2 + 1]); xa.u[1] = pack2(X[8 * s2 + 2], X[8 * s2 + 3]);                         \
          xa.u[2] = pack2(X[8 * s2 + 4], X[8 * s2 + 5]); xa.u[3] = pack2(X[8 * s2 + 6], X[8 * s2 + 7]);                         \
          const bf16x8 bv = tr_pair(vimg + vtr + 1024 * s2, vimg + vtr + 1024 * s2 + 512);                                      \
          Z0 = MFMA32(xa.v, bv, Z0);                                                                                            \
          Z1 = MFMA32(xa.v, ones, Z1);                                                                                          \
        }                                                                                                                       \
        float* p0 = PP + (((BUF) * 3 + w) * 2) * 1024 + lane * 4;                                                               \
        _Pragma("unroll") for (int g = 0; g < 4; ++g) {                                                                         \
          *(float4*)(p0 + g * 256) = make_float4(Z0[4 * g], Z0[4 * g + 1], Z0[4 * g + 2], Z0[4 * g + 3]);                      \
          *(float4*)(p0 + 1024 + g * 256) = make_float4(Z1[4 * g], Z1[4 * g + 1], Z1[4 * g + 2], Z1[4 * g + 3]);               \
        }                                                                                                                       \
      }                                                                                                                         \
    }
    for (int step = 0; step < 66; step += 2) {
      ML_TSTEP(qfa, 0);
      ++step;
      ML_TSTEP(qfb, 1);
      --step;
    }
    return;
  }
  if (w >= 2) {
    ml_state_image(S0, S1, S0T, nL, w, r, hh);
    const int t128 = tid - 128;
    const int kwb = 256 * (t128 >> 4) + 16 * ((t128 & 15) ^ ((((t128 >> 4) & 3) << 2) | ((t128 >> 6) & 1)));
    uint4 pk0a, pk1a, pk2a, pk3a, pk4a, pk5a, pk6a, pk7a, pv0a, pv1a;
    uint4 pk0b, pk1b, pk2b, pk3b, pk4b, pk5b, pk6b, pk7b, pv0b, pv1b;
    float4 pgla, pglb;
    float pgta, pgtb;
    ML_LOAD(a, tb + cfirst * 64);
    ML_LOAD(b, tb + (cfirst + cstep) * 64);
    ML_STAGE(a, 0);
    ML_LOAD(a, tb + (cfirst + 2 * cstep) * 64);
#define ML_LSTEP(S, BUF)                                                                                                        \
    {                                                                                                                           \
      __syncthreads();                                                                                                    \
      if (step < 64) {                                                                                                          \
        const int c0 = cfirst + cstep * step;                                                                                   \
        const float gtot = scal[(BUF) * 208 + 192];                                                                             \
        ML_STAGE(S, (BUF) ^ 1);                                \
        ML_LOAD(S, tb + ((step + 3 < 64) ? c0 + 3 * cstep : c0) * 64);                                                          \
        const lds_cptr kimg = lds0 + (BUF) * ML_KIMG;                                                                           \
        const lds_cptr vdimg = lds0 + 2 * ML_KIMG + 2 * ML_VIMG + (BUF) * ML_VIMG;                                              \
        ml_state_update(S0, S1, kimg + ktr0, kimg + ktr1, vdimg + vdtr, dL + (BUF) * 72, gtot, hh);                             \
        ml_state_image(S0, S1, S0T + ((BUF) ^ 1) * (32 * 136), nL + ((BUF) ^ 1) * 256, w, r, hh);                               \
      }                                                                                                                         \
    }
    for (int step = 0; step < 66; step += 2) {
      ML_LSTEP(b, 0);
      ++step;
      ML_LSTEP(a, 1);
      --step;
    }
  } else {
    const int ti = w;
    bf16x8 qfa[8], qfb[8];
    ML_QLOAD(qfa, cfirst, ti);
    ML_QLOAD(qfb, cfirst + cstep, ti);
    f32x16 Q0, Q1;
#pragma unroll
    for (int i = 0; i < 16; ++i) { Q0[i] = 0.f; Q1[i] = 0.f; }
    unsigned short* otile = (unsigned short*)(PP + 12288) + ti * (32 * 40);
#define ML_QSTEP(QF, BUF)                                                                                                       \
    {                                                                                                                           \
      const int c0 = cfirst + cstep * step;                                                                                     \
      __syncthreads();                                                                                                    \
      if (step > 0 && step <= 64) {                                                                                             \
        const float* p0 = PP + ((((BUF) ^ 1) * 3 + ti) * 2) * 1024 + lane * 4;                                                  \
        _Pragma("unroll") for (int g = 0; g < 4; ++g) {                                                                         \
          const float4 a0 = *(const float4*)(p0 + g * 256), a1 = *(const float4*)(p0 + 1024 + g * 256);                         \
          Q0[4 * g] += a0.x; Q0[4 * g + 1] += a0.y; Q0[4 * g + 2] += a0.z; Q0[4 * g + 3] += a0.w;                               \
          Q1[4 * g] += a1.x; Q1[4 * g + 1] += a1.y; Q1[4 * g + 2] += a1.z; Q1[4 * g + 3] += a1.w;                               \
        }                                                                                                                       \
        if (ti == tih) {                                                                                                        \
          const float* p2 = PP + ((((BUF) ^ 1) * 3 + 2) * 2) * 1024 + lane * 4;                                                 \
          _Pragma("unroll") for (int g = 0; g < 4; ++g) {                                                                       \
            const float4 a0 = *(const float4*)(p2 + g * 256), a1 = *(const float4*)(p2 + 1024 + g * 256);                       \
            Q0[4 * g] += a0.x; Q0[4 * g + 1] += a0.y; Q0[4 * g + 2] += a0.z; Q0[4 * g + 3] += a0.w;                             \
            Q1[4 * g] += a1.x; Q1[4 * g + 1] += a1.y; Q1[4 * g + 2] += a1.z; Q1[4 * g + 3] += a1.w;                             \
          }                                                                                                                     \
        }                                                                                                                       \
        const size_t orow0 = tb + (c0 - cstep) * 64 + 32 * ti;                                                                  \
               \
        _Pragma("unroll") for (int reg = 0; reg < 16; ++reg)                                                                    \
          otile[crow(reg, hh) * 40 + r] = f2bf(Q0[reg] * __builtin_amdgcn_rcpf(fmaxf(fabsf(Q1[reg]), 1.f)));                    \
        const uint4 o0 = *(const uint4*)(otile + (lane >> 2) * 40 + (lane & 3) * 8);                                            \
        const uint4 o1 = *(const uint4*)(otile + (16 + (lane >> 2)) * 40 + (lane & 3) * 8);                                     \
        *(uint4*)(oMb + (orow0 + (lane >> 2)) * 512 + (lane & 3) * 8) = o0;                                                     \
        *(uint4*)(oMb + (orow0 + 16 + (lane >> 2)) * 512 + (lane & 3) * 8) = o1;                                                \
      }                                                                                                                         \
      if (step < 64) {                                                                                                          \
        const unsigned short* S0Ti = S0T + (BUF) * (32 * 136);                                                                  \
        const unsigned short* nLi = nL + (BUF) * 256;                                                                           \
        const float* scb = scal + (BUF) * 208;                                                                                  \
        _Pragma("unroll") for (int i = 0; i < 16; ++i) { Q0[i] = 0.f; Q1[i] = 0.f; }                                            \
        _Pragma("unroll") for (int s2 = 0; s2 < 8; ++s2) {                                                                      \
          const bf16x8 b0 = *(const bf16x8*)(S0Ti + r * 136 + 16 * s2 + 8 * hh);                                                \
          const bf16x8 b1 = *(const bf16x8*)(nLi + 16 * s2 + 8 * hh);                                                           \
          Q0 = MFMA32(QF[s2], b0, Q0);                                                                                          \
          Q1 = MFMA32(QF[s2], b1, Q1);                                                                                          \
        }                                                                                                                       \
        ML_QLOAD(QF, (step + 2 < 64) ? c0 + 2 * cstep : c0, ti);                               \
        _Pragma("unroll") for (int g = 0; g < 4; ++g) {                                                                         \
          const float4 e4 = *(const float4*)(scb + 32 * ti + 8 * g + 4 * hh);                                                   \
          Q0[4 * g] *= e4.x; Q0[4 * g + 1] *= e4.y; Q0[4 * g + 2] *= e4.z; Q0[4 * g + 3] *= e4.w;                               \
          Q1[4 * g] *= e4.x; Q1[4 * g + 1] *= e4.y; Q1[4 * g + 2] *= e4.z; Q1[4 * g + 3] *= e4.w;                               \
        }                                                                                                                       \
      }                                                                                                                         \
    }
    for (int step = 0; step < 66; step += 2) {
      ML_QSTEP(qfa, 0);
      ++step;
      ML_QSTEP(qfb, 1);
      --step;
    }
  }
}

struct MKP {
  const float *x, *norm1_g, *w_in, *conv_w, *a_log, *dt_bias, *gdn_g, *i_bias, *f_bias, *ml_g, *w_out, *norm2_g, *peer_wq,
      *peer_keys, *peer_u, *peer_v, *normf_g;
  float* out;
  unsigned short *pm, *x1b, *woutT, *mt, *xb, *winT, *oM, *yb, *scores, *qkv_dbg, *oA_dbg;
  unsigned *utab, *vtab;
  unsigned short *wqb, *keyb;
  float *uscale, *vscale;
  float *x1, *rs1, *rs2, *gt, *gateb, *dbg, *mlpre, *mlgt;
  unsigned* bar;
  int* idxb;
  GdnBufs G;
};

constexpr int SMEM_BYTES = 74752;
__global__ void __launch_bounds__(512, 2) k_mega(MKP P) {
  __shared__ __attribute__((aligned(16))) char smem_all[2 * SMEM_BYTES + 16];
  {
    volatile LAS unsigned* st0 = (volatile LAS unsigned*)(smem_all + 2 * SMEM_BYTES);
    if (threadIdx.x < 4) st0[threadIdx.x] = 0u;
  }
  __syncthreads();
  XcdBarrier xb = xcd_barrier_post(P.bar, (volatile LAS unsigned*)(smem_all + 2 * SMEM_BYTES));
  const int hb = __builtin_amdgcn_readfirstlane(HB);
  char* smem_c = smem_all + hb * SMEM_BYTES;
  unsigned short* smem = (unsigned short*)smem_c;
  const int nb = gridDim.x, bid = blockIdx.x;
  for (int it = bid; it < NT / 8; it += nb) d_prep_x(2 * it + hb, P.x, P.xb, P.rs1);
  for (int it = bid; it < 8 * 66; it += nb) d_transpose_w(2 * it + hb, 66, (float*)smem_c, P.w_in, DIN, P.norm1_g, P.winT, 1);
  for (int it = bid; it < 8 * 16; it += nb) d_transpose_w(2 * it + hb, 16, (float*)smem_c, P.w_out, 1024, nullptr, P.woutT, 0);
  for (int it = bid; it < 512; it += nb) d_cvt_bf16(2 * it + hb, P.peer_wq, P.wqb, P.norm2_g, 11);
  for (int it = bid; it < 64; it += nb) d_cvt_bf16(2 * it + hb, P.peer_keys, P.keyb, nullptr, 0);
  if (bid == 0 && threadIdx.x < 4) P.dbg[threadIdx.x] = 0.f;
  xcd_barrier(xb);
  {
    GemmP p{};
    p.A = P.xb; p.lda = DM; p.Bt = P.winT; p.ldb = DM; p.K = DM;
    p.rowscale = P.rs1; p.obf = P.pm; p.ldo = 4096; p.of32 = P.gt; p.ldf = 32; p.resid = nullptr;
    p.a_log = P.a_log; p.dt_bias = P.dt_bias; p.i_bias = P.i_bias; p.f_bias = P.f_bias;
    for (int k = 0;; ++k) {
      int tm, tn;
      if (!xcd_tile256(bid, nb, k, 16, tm, tn)) break;
      gemm256_tile<EPI_INPROJ>(p, tm, tn, smem_all);
    }
  }
  for (int it = bid; it < NT / 128; it += nb) d_gate_proj(it, P.xb, P.winT, P.rs1, P.a_log, P.dt_bias, P.i_bias, P.f_bias, P.gt);
  const int mt0 = (nb >= 192) ? 128 : 0;
  for (int tile = (bid >= mt0) ? bid - mt0 : bid - mt0 + nb; tile < 16 * 4; tile += nb) {
    const int hp = tile >> 2, tn = (tile & 3) * 2 + hb;
    GemmP p{};
    p.A = P.keyb + (size_t)hp * 128 * 128; p.lda = 128; p.Bt = P.wqb + hp * 128; p.ldb = 2048; p.K = 128;
    p.obf = P.mt + (size_t)hp * 128 * DM; p.ldo = DM;
    gemm_tile<EPI_PLAIN>(p, 0, tn, smem);
    __syncthreads();
  }
  xcd_barrier(xb);
  for (int it = bid; it < 256; it += nb) d_ml_gates(2 * it + hb, P.gt, P.mlpre, P.mlgt);
  for (int it = bid; it < 512; it += nb) d_gdn_prep(2 * it + hb, smem_c, P.pm, P.gt, P.conv_w, P.G);
  xcd_barrier(xb);
  for (int wi = bid; wi < 256; wi += nb) {
    const int wl_ = wi & 127, xj = wl_ >> 3;
    const int chain = (xj >> 2) * 8 + (wl_ & 7), sl = xj & 3;
    if (wi < 128) {
      if (hb == 0) d_gdn_scan(chain, sl, smem_c, P.G);
      else for (int i = 0; i < 128; ++i) __syncthreads();
      for (int it = wi; it < 512; it += 128) { d_cvt_tab<true>(2 * it + hb, P.peer_u, P.utab, P.uscale); d_cvt_tab<false>(2 * it + hb, P.peer_v, P.vtab, P.vscale); }
    } else {
      d_mlstm_scan(chain, sl, smem_all, P.pm, P.mlpre, P.mlgt, P.oM, NT, hb);
    }
    __syncthreads();
  }
  xcd_barrier(xb);
  for (int it = bid; it < NT / 8; it += nb) d_combine(2 * it + hb, P.G.uo, P.oM, P.pm, P.gdn_g, P.ml_g, P.yb);
  xcd_barrier(xb);
  {
    GemmP p{};
    p.A = P.yb; p.lda = DM; p.Bt = P.woutT; p.ldb = DM; p.K = DM;
    p.rowscale = nullptr; p.obf = P.x1b; p.ldo = DM; p.of32 = P.x1; p.ldf = DM; p.resid = P.x; p.rowacc = P.rs2;
    for (int k = 0;; ++k) {
      int tm, tn;
      if (!xcd_tile256(bid, nb, k, 4, tm, tn)) break;
      gemm256_tile<EPI_OUTPROJ>(p, tm, tn, smem_all);
    }
  }
  xcd_barrier(xb);
  {
    GemmP p{};
    p.A = P.x1b; p.lda = DM; p.Bt = P.mt; p.ldb = DM; p.K = DM;
    p.rowscale = P.rs2; p.obf = P.scores; p.ldo = 2048; p.of32 = nullptr; p.ldf = 0; p.resid = nullptr;
    for (int k = 0;; ++k) {
      int tm, tn;
      if (!xcd_tile256(bid, nb, k, 8, tm, tn)) break;
      gemm256_tile<EPI_SCORES>(p, tm, tn, smem_all);
    }
  }
  xcd_barrier(xb);
  const float oscale = 1.f;
  for (int it = bid; it < NT / 64; it += nb) {
    const int hit = 2 * it + hb;
    d_topk(hit, P.scores, P.idxb, P.gateb);
    __threadfence_block();
    __syncthreads();
#pragma unroll 1
    for (int sub = 0; sub < 8; ++sub)
      d_peer(hit * 8 + sub, smem_c, P.x1, P.rs2, P.norm2_g, P.idxb, P.gateb, P.utab, P.vtab, P.uscale, P.vscale, P.normf_g, P.out, oscale);
  }
}

extern "C" void kernel_launch(void* const* d_in, const int* in_sizes, int n_in, void* d_out, int out_size, void* d_ws,
                              size_t ws_size, hipStream_t stream) {
  MKP P{};
  P.x = (const float*)d_in[0];
  P.norm1_g = (const float*)d_in[1];
  P.w_in = (const float*)d_in[2];
  P.conv_w = (const float*)d_in[3];
  P.a_log = (const float*)d_in[4];
  P.dt_bias = (const float*)d_in[5];
  P.gdn_g = (const float*)d_in[6];
  P.i_bias = (const float*)d_in[7];
  P.f_bias = (const float*)d_in[8];
  P.ml_g = (const float*)d_in[9];
  P.w_out = (const float*)d_in[10];
  P.norm2_g = (const float*)d_in[11];
  P.peer_wq = (const float*)d_in[12];
  P.peer_keys = (const float*)d_in[13];
  P.peer_u = (const float*)d_in[14];
  P.peer_v = (const float*)d_in[15];
  P.normf_g = (const float*)d_in[16];
  P.out = (float*)d_out;

  char* ws = (char*)d_ws;
  const size_t MB = 1024 * 1024;
  P.pm = (unsigned short*)(ws);
  P.x1 = (float*)(ws);
  P.x1b = (unsigned short*)(ws + 64 * MB);
  P.utab = (unsigned*)(ws + (128 + 11 + 80) * MB);
  P.vtab = (unsigned*)(ws + (128 + 11 + 96) * MB);
  P.uscale = (float*)(ws + 136 * MB);
  P.vscale = (float*)(ws + 136 * MB + 65536);
  char* rb = ws + 128 * MB;
  P.woutT = (unsigned short*)(rb);
  P.mt = (unsigned short*)(rb + 2 * MB);
  P.rs1 = (float*)(rb + 6 * MB);
  P.rs2 = (float*)(rb + 7 * MB);
  P.dbg = (float*)(rb + 6 * MB + 131072);
  P.bar = (unsigned*)(rb + 6 * MB + 196608);
  P.gt = (float*)(rb + 9 * MB);
  char* dyn = rb + 11 * MB;
  P.xb = (unsigned short*)(dyn);
  P.winT = (unsigned short*)(dyn + 32 * MB);
  P.wqb = (unsigned short*)(dyn + 41 * MB);
  P.keyb = (unsigned short*)(dyn + 45 * MB);
  P.G.qc = (unsigned short*)(dyn);
  P.G.kTc = (unsigned short*)(dyn + 16 * MB);
  P.G.qkc = (unsigned short*)(dyn + 32 * MB);
  P.G.wn = (unsigned short*)(dyn + 48 * MB);
  P.G.uo = (unsigned short*)((char*)d_out + 32 * MB);
  P.G.gsc = (float*)(dyn + 112 * MB);
  P.mlpre = (float*)(dyn + 114 * MB);
  P.mlgt = (float*)(dyn + 116 * MB);
  P.yb = (unsigned short*)(dyn);
  P.scores = (unsigned short*)(dyn);
  P.idxb = (int*)(dyn + 64 * MB);
  P.gateb = (float*)(dyn + 72 * MB);
  char* os = (char*)d_out;
  P.oM = (unsigned short*)(os);
  P.qkv_dbg = (unsigned short*)(os + 32 * MB);
  P.oA_dbg = (unsigned short*)(os + 44 * MB);

  static int grid_blocks = 0;
  if (!grid_blocks) {
    int dev = 0, cus = 0, per_cu = 0;
    (void)hipGetDevice(&dev);
    (void)hipDeviceGetAttribute(&cus, hipDeviceAttributeMultiprocessorCount, dev);
    (void)hipOccupancyMaxActiveBlocksPerMultiprocessor(&per_cu, k_mega, 512, 0);
    if (per_cu > 1) per_cu = 1;
    if (per_cu < 1) per_cu = 1;
    grid_blocks = cus * per_cu;
  }
  (void)hipMemsetAsync(P.bar, 0, XCD_BAR_WORDS * sizeof(unsigned), stream);
  hipLaunchKernelGGL(k_mega, dim3(grid_blocks), dim3(512), 0, stream, P);
}
```
